# Optimizing an MI355X kernel written in HIP

```python
import math
import jax
import jax.numpy as jnp
from jax import lax

D_MODEL = 1024
BATCH = 8
SEQ = 2048
DEPTH = 1

CTX_LEN = 256
GRID_W = 64
EPS = 1e-6
N_MOD = 6
HEAD_DIM = 64
ATTN_HEADS = 8
ATTN_KV_HEADS = 2
ATTN_WIDTH = ATTN_HEADS * HEAD_DIM
KV_WIDTH = ATTN_KV_HEADS * HEAD_DIM
WINDOW = 128
BLOCK = 128
ATTN_SCALE = HEAD_DIM ** -0.5
ROPE_THETA = 10000.0
ROT_PAIRS = HEAD_DIM // 4
SSM_WIDTH = D_MODEL - ATTN_WIDTH
SSM_GROUP = 16
SSM_GROUPS = SSM_WIDTH // SSM_GROUP
SSM_STATE = 64
DT_MIN = 0.001
DT_MAX = 0.1
IN_WIDTH = ATTN_WIDTH + 2 * KV_WIDTH + SSM_WIDTH
N_EXPERTS = 64
EXPERT_DIM = 128
SHARED_DIM = 128
TOP_K = 8
N_EXPERT_GROUPS = 8
TOPK_GROUPS = 4
ROUTED_SCALE = 2.5

kernel_name = 'hybrid_dit_swa_s5_moe_prefix'


def _rmsnorm(t, g):
    tf = t.astype(jnp.float32)
    tf = tf * lax.rsqrt(jnp.mean(tf * tf, axis=-1, keepdims=True) + EPS)
    return tf.astype(t.dtype) * g


def _ada(cond, w, b):
    return jax.nn.silu(cond) @ w + b


def _modulate(h, shift, scale):
    return h * (1.0 + scale[:, None, :]) + shift[:, None, :]


def _split_groups(p):
    B, L, _ = p.shape
    q = p[..., :ATTN_WIDTH].reshape(B, L, ATTN_HEADS, HEAD_DIM)
    k = p[..., ATTN_WIDTH:ATTN_WIDTH + KV_WIDTH].reshape(B, L, ATTN_KV_HEADS, HEAD_DIM)
    v = p[..., ATTN_WIDTH + KV_WIDTH:ATTN_WIDTH + 2 * KV_WIDTH].reshape(B, L, ATTN_KV_HEADS, HEAD_DIM)
    u = p[..., ATTN_WIDTH + 2 * KV_WIDTH:]
    return q, k, v, u


def _rope_tables(rows):
    row = jnp.repeat(jnp.arange(rows, dtype=jnp.float32), GRID_W)
    col = (jnp.arange(rows * GRID_W) % GRID_W).astype(jnp.float32)
    inv = ROPE_THETA ** (-jnp.arange(ROT_PAIRS, dtype=jnp.float32) / ROT_PAIRS)
    ang = jnp.stack([row[:, None] * inv, col[:, None] * inv], axis=1)
    return jnp.cos(ang), jnp.sin(ang)


def _axial_rope(t, cos, sin):
    B, L, H, _ = t.shape
    tf = t.astype(jnp.float32).reshape(B, L, H, 2, 2, ROT_PAIRS)
    x1, x2 = tf[..., 0, :], tf[..., 1, :]
    cs, sn = cos[None, :, None], sin[None, :, None]
    out = jnp.stack([x1 * cs - x2 * sn, x1 * sn + x2 * cs], axis=-2)
    return out.reshape(t.shape).astype(t.dtype)


def _window_attention(q, k, v, k_ctx, v_ctx, sink):
    B, L, H, hd = q.shape
    KVH = k.shape[2]
    G = H // KVH
    nb = L // BLOCK
    C = k_ctx.shape[1]
    qb = q.reshape(B, nb, BLOCK, KVH, G, hd)
    pad = ((0, 0), (BLOCK, BLOCK), (0, 0), (0, 0))

    def bands(t):
        tp = jnp.pad(t, pad).reshape(B, nb + 2, BLOCK, KVH, hd)
        return jnp.concatenate([tp[:, :-2], tp[:, 1:-1], tp[:, 2:]], axis=2)

    kb, vb = bands(k), bands(v)
    q_pos = jnp.arange(L).reshape(nb, BLOCK)
    kp = jnp.arange(-BLOCK, L + BLOCK).reshape(nb + 2, BLOCK)
    k_pos = jnp.concatenate([kp[:-2], kp[1:-1], kp[2:]], axis=1)
    mask = ((jnp.abs(q_pos[:, :, None] - k_pos[:, None, :]) <= WINDOW)
            & (k_pos[:, None, :] >= 0) & (k_pos[:, None, :] < L))
    s_loc = jnp.einsum('bnqkgd,bnjkd->bkgnqj', qb, kb).astype(jnp.float32) * ATTN_SCALE
    s_loc = jnp.where(mask, s_loc, -jnp.inf)
    s_ctx = jnp.einsum('bnqkgd,bckd->bkgnqc', qb, k_ctx).astype(jnp.float32) * ATTN_SCALE
    s_sink = jnp.broadcast_to(sink.astype(jnp.float32).reshape(1, KVH, G, 1, 1, 1), s_loc.shape[:-1] + (1,))
    p = jax.nn.softmax(jnp.concatenate([s_loc, s_ctx, s_sink], axis=-1), axis=-1).astype(v.dtype)
    nk = 3 * BLOCK
    o = (jnp.einsum('bkgnqj,bnjkd->bnqkgd', p[..., :nk], vb)
         + jnp.einsum('bkgnqc,bckd->bnqkgd', p[..., nk:nk + C], v_ctx))
    return o.reshape(B, L, H * hd)


def _context_attention(q, k, v, sink):
    B, C, H, hd = q.shape
    KVH = k.shape[2]
    G = H // KVH
    qg = q.reshape(B, C, KVH, G, hd)
    s = jnp.einsum('bqkgd,bjkd->bkgqj', qg, k).astype(jnp.float32) * ATTN_SCALE
    s_sink = jnp.broadcast_to(sink.astype(jnp.float32).reshape(1, KVH, G, 1, 1), s.shape[:-1] + (1,))
    p = jax.nn.softmax(jnp.concatenate([s, s_sink], axis=-1), axis=-1).astype(v.dtype)
    o = jnp.einsum('bkgqj,bjkd->bqkgd', p[..., :C], v)
    return o.reshape(B, C, H * hd)


def _discretize(a_re, a_im, log_dt, b_re, b_im):
    dt = jnp.exp(log_dt)[:, None]
    mag = jnp.exp(dt * a_re)
    abar_re = mag * jnp.cos(dt * a_im)
    abar_im = mag * jnp.sin(dt * a_im)
    den = a_re * a_re + a_im * a_im
    num_re = abar_re - 1.0
    coef_re = (num_re * a_re + abar_im * a_im) / den
    coef_im = (abar_im * a_re - num_re * a_im) / den
    bb_re = coef_re[..., None] * b_re - coef_im[..., None] * b_im
    bb_im = coef_re[..., None] * b_im + coef_im[..., None] * b_re
    return abar_re, abar_im, bb_re, bb_im


def _complex_combine(e1, e2):
    a1r, a1i, b1r, b1i = e1
    a2r, a2i, b2r, b2i = e2
    return (a2r * a1r - a2i * a1i,
            a2r * a1i + a2i * a1r,
            a2r * b1r - a2i * b1i + b2r,
            a2r * b1i + a2i * b1r + b2i)


def _ssm_states(u, a_re, a_im, log_dt, b_re, b_im, h0, reverse):
    abar_re, abar_im, bb_re, bb_im = _discretize(a_re, a_im, log_dt, b_re, b_im)
    if reverse:
        u = jnp.flip(u, axis=1)
    x_re = jnp.einsum('blgp,gnp->blgn', u, bb_re)
    x_im = jnp.einsum('blgp,gnp->blgn', u, bb_im)
    if h0 is not None:
        h0_re, h0_im = h0
        x_re = x_re.at[:, 0].add(abar_re * h0_re - abar_im * h0_im)
        x_im = x_im.at[:, 0].add(abar_re * h0_im + abar_im * h0_re)
    L = u.shape[1]
    a_re_seq = jnp.broadcast_to(abar_re[None, None], (1, L) + abar_re.shape)
    a_im_seq = jnp.broadcast_to(abar_im[None, None], (1, L) + abar_im.shape)
    _, _, h_re, h_im = lax.associative_scan(_complex_combine, (a_re_seq, a_im_seq, x_re, x_im), axis=1)
    final = (h_re[:, -1], h_im[:, -1])
    if reverse:
        h_re, h_im = jnp.flip(h_re, axis=1), jnp.flip(h_im, axis=1)
    return h_re, h_im, final


def _bidirectional_scan(u_lat, u_ctx, a_re, a_im, log_dt, b_re, b_im):
    B, L, _ = u_lat.shape
    ul = u_lat.astype(jnp.float32).reshape(B, L, SSM_GROUPS, SSM_GROUP)
    uc = u_ctx.astype(jnp.float32).reshape(B, u_ctx.shape[1], SSM_GROUPS, SSM_GROUP)
    lat_states, ctx_states = [], []
    for d, rev in enumerate((False, True)):
        prm = (a_re[d].astype(jnp.float32), a_im[d].astype(jnp.float32), log_dt[d].astype(jnp.float32),
               b_re[d].astype(jnp.float32), b_im[d].astype(jnp.float32))
        c_re_s, c_im_s, c_final = _ssm_states(uc, *prm, None, rev)
        l_re_s, l_im_s, _ = _ssm_states(ul, *prm, c_final, rev)
        lat_states.append((l_re_s, l_im_s))
        ctx_states.append((c_re_s, c_im_s))
    return lat_states, ctx_states


def _readout_dir(states, c_re, c_im):
    h_re, h_im = states
    return (jnp.einsum('blgn,gpn->blgp', h_re, c_re.astype(jnp.float32))
            - jnp.einsum('blgn,gpn->blgp', h_im, c_im.astype(jnp.float32)))


def _ssm_readout(states, u, c_re, c_im, d_skip, w_glu, b_glu):
    B, L, _ = u.shape
    y = _readout_dir(states[0], c_re[0], c_im[0]) + _readout_dir(states[1], c_re[1], c_im[1])
    y = y.reshape(B, L, SSM_WIDTH) + d_skip.astype(jnp.float32) * u.astype(jnp.float32)
    y = jax.nn.gelu(y).astype(u.dtype)
    return y * jax.nn.sigmoid(y @ w_glu + b_glu)


def _merge_groups(attn_o, ssm_o, g_attn, g_ssm, w_out):
    return jnp.concatenate([_rmsnorm(attn_o, g_attn), _rmsnorm(ssm_o, g_ssm)], axis=-1) @ w_out


def _moe(h, w_router, router_bias, w_gate_e, w_up_e, w_down_e, w_gate_s, w_up_s, w_down_s):
    scores = jax.nn.sigmoid((h @ w_router).astype(jnp.float32))
    biased = scores + router_bias.astype(jnp.float32)
    grouped = biased.reshape(biased.shape[:-1] + (N_EXPERT_GROUPS, N_EXPERTS // N_EXPERT_GROUPS))
    group_score = lax.top_k(grouped, 2)[0].sum(axis=-1)
    _, group_idx = lax.top_k(group_score, TOPK_GROUPS)
    group_mask = jax.nn.one_hot(group_idx, N_EXPERT_GROUPS, dtype=jnp.float32).sum(axis=-2)
    expert_mask = jnp.repeat(group_mask, N_EXPERTS // N_EXPERT_GROUPS, axis=-1) > 0
    _, idx = lax.top_k(jnp.where(expert_mask, biased, -jnp.inf), TOP_K)
    sel = jnp.take_along_axis(scores, idx, axis=-1)
    weights = sel / jnp.sum(sel, axis=-1, keepdims=True) * ROUTED_SCALE
    gates = jnp.sum(jax.nn.one_hot(idx, N_EXPERTS, dtype=jnp.float32) * weights[..., None], axis=-2).astype(h.dtype)
    hid = jax.nn.silu(jnp.einsum('bld,edf->blef', h, w_gate_e)) * jnp.einsum('bld,edf->blef', h, w_up_e)
    routed = jnp.einsum('blef,efd->bld', hid * gates[..., None], w_down_e)
    shared = (jax.nn.silu(h @ w_gate_s) * (h @ w_up_s)) @ w_down_s
    return routed + shared


def setup_inputs(seed: int = 0) -> dict:
    key = jax.random.key(seed)
    ks = jax.random.split(key, 32)
    G, N, P, E = SSM_GROUPS, SSM_STATE, SSM_GROUP, N_EXPERTS

    def nrm(i, shape, s):
        return s * jax.random.normal(ks[i], shape, jnp.float32)

    n_idx = jnp.arange(N, dtype=jnp.float32)
    return {
        'x': nrm(0, (BATCH, SEQ, D_MODEL), 1.0),
        'c': nrm(1, (BATCH, D_MODEL), 1.0),
        'ctx': nrm(2, (BATCH, CTX_LEN, D_MODEL), 1.0),
        'c_ctx': nrm(3, (D_MODEL,), 1.0),
        'w_ada': nrm(4, (DEPTH, D_MODEL, N_MOD * D_MODEL), 0.02),
        'b_ada': nrm(5, (DEPTH, N_MOD * D_MODEL), 0.01),
        'norm_mix': 1.0 + nrm(6, (DEPTH, D_MODEL), 0.02),
        'norm_ffn': 1.0 + nrm(7, (DEPTH, D_MODEL), 0.02),
        'w_in': nrm(11, (DEPTH, D_MODEL, IN_WIDTH), D_MODEL ** -0.5),
        'attn_sink': nrm(12, (DEPTH, ATTN_HEADS), 0.5),
        'ssm_a_re': -0.5 + nrm(8, (DEPTH, 2, G, N), 0.01),
        'ssm_a_im': math.pi * n_idx + nrm(9, (DEPTH, 2, G, N), 0.01),
        'ssm_log_dt': jax.random.uniform(ks[10], (DEPTH, 2, G), jnp.float32, math.log(DT_MIN), math.log(DT_MAX)),
        'ssm_b_re': nrm(13, (DEPTH, 2, G, N, P), (2 * P) ** -0.5),
        'ssm_b_im': nrm(14, (DEPTH, 2, G, N, P), (2 * P) ** -0.5),
        'ssm_c_re': nrm(15, (DEPTH, 2, G, P, N), (2 * N) ** -0.5),
        'ssm_c_im': nrm(16, (DEPTH, 2, G, P, N), (2 * N) ** -0.5),
        'ssm_d': nrm(17, (DEPTH, SSM_WIDTH), 1.0),
        'w_glu': nrm(18, (DEPTH, SSM_WIDTH, SSM_WIDTH), SSM_WIDTH ** -0.5),
        'b_glu': nrm(19, (DEPTH, SSM_WIDTH), 0.01),
        'norm_attn_out': 1.0 + nrm(20, (DEPTH, ATTN_WIDTH), 0.02),
        'norm_ssm_out': 1.0 + nrm(21, (DEPTH, SSM_WIDTH), 0.02),
        'w_out': nrm(22, (DEPTH, D_MODEL, D_MODEL), D_MODEL ** -0.5),
        'w_router': nrm(23, (DEPTH, D_MODEL, E), D_MODEL ** -0.5),
        'router_bias': nrm(24, (DEPTH, E), 0.01),
        'w_gate_e': nrm(25, (DEPTH, E, D_MODEL, EXPERT_DIM), D_MODEL ** -0.5),
        'w_up_e': nrm(26, (DEPTH, E, D_MODEL, EXPERT_DIM), D_MODEL ** -0.5),
        'w_down_e': nrm(27, (DEPTH, E, EXPERT_DIM, D_MODEL), EXPERT_DIM ** -0.5),
        'w_gate_s': nrm(28, (DEPTH, D_MODEL, SHARED_DIM), D_MODEL ** -0.5),
        'w_up_s': nrm(29, (DEPTH, D_MODEL, SHARED_DIM), D_MODEL ** -0.5),
        'w_down_s': nrm(30, (DEPTH, SHARED_DIM, D_MODEL), SHARED_DIM ** -0.5),
        'norm_final': 1.0 + nrm(31, (D_MODEL,), 0.02),
    }


def reference(x, c, ctx, c_ctx, w_ada, b_ada, norm_mix, norm_ffn, w_in, attn_sink,
              ssm_a_re, ssm_a_im, ssm_log_dt, ssm_b_re, ssm_b_im, ssm_c_re, ssm_c_im, ssm_d,
              w_glu, b_glu, norm_attn_out, norm_ssm_out, w_out, w_router, router_bias,
              w_gate_e, w_up_e, w_down_e, w_gate_s, w_up_s, w_down_s, norm_final):
    rows = x.shape[1] // GRID_W
    cos, sin = _rope_tables(rows)
    ctx_h = ctx
    for layer in range(DEPTH):
        mod = _ada(c, w_ada[layer], b_ada[layer])
        mod_c = _ada(c_ctx[None, :], w_ada[layer], b_ada[layer])
        sh1, sc1, g1, sh2, sc2, g2 = jnp.split(mod, N_MOD, axis=-1)
        sh1c, sc1c, g1c, sh2c, sc2c, g2c = jnp.split(mod_c, N_MOD, axis=-1)

        h = _modulate(_rmsnorm(x, norm_mix[layer]), sh1, sc1)
        hc = _modulate(_rmsnorm(ctx_h, norm_mix[layer]), sh1c, sc1c)
        q, k, v, u = _split_groups(h @ w_in[layer])
        qc, kc, vc, uc = _split_groups(hc @ w_in[layer])
        q = _axial_rope(q, cos, sin)
        k = _axial_rope(k, cos, sin)
        attn_o = _window_attention(q, k, v, kc, vc, attn_sink[layer])
        lat_states, ctx_states = _bidirectional_scan(u, uc, ssm_a_re[layer], ssm_a_im[layer], ssm_log_dt[layer],
                                                     ssm_b_re[layer], ssm_b_im[layer])
        ssm_o = _ssm_readout(lat_states, u, ssm_c_re[layer], ssm_c_im[layer], ssm_d[layer], w_glu[layer], b_glu[layer])
        x = x + g1[:, None, :] * _merge_groups(attn_o, ssm_o, norm_attn_out[layer], norm_ssm_out[layer], w_out[layer])

        h2 = _modulate(_rmsnorm(x, norm_ffn[layer]), sh2, sc2)
        x = x + g2[:, None, :] * _moe(h2, w_router[layer], router_bias[layer], w_gate_e[layer], w_up_e[layer],
                                      w_down_e[layer], w_gate_s[layer], w_up_s[layer], w_down_s[layer])

        if layer + 1 < DEPTH:
            attn_c = _context_attention(qc, kc, vc, attn_sink[layer])
            ssm_c = _ssm_readout(ctx_states, uc, ssm_c_re[layer], ssm_c_im[layer], ssm_d[layer], w_glu[layer], b_glu[layer])
            ctx_h = ctx_h + g1c[:, None, :] * _merge_groups(attn_c, ssm_c, norm_attn_out[layer], norm_ssm_out[layer], w_out[layer])
            h2c = _modulate(_rmsnorm(ctx_h, norm_ffn[layer]), sh2c, sc2c)
            ctx_h = ctx_h + g2c[:, None, :] * _moe(h2c, w_router[layer], router_bias[layer], w_gate_e[layer], w_up_e[layer],
                                                  w_down_e[layer], w_gate_s[layer], w_up_s[layer], w_down_s[layer])
    return _rmsnorm(x, norm_final)
```

```cpp
#include <hip/hip_runtime.h>
#include <hip/hip_bf16.h>
#include <stdint.h>
#include <stdio.h>

#ifndef MK_MULTI
#define MK_MULTI 0
#endif

typedef __attribute__((ext_vector_type(8))) short bf16x8;
typedef __attribute__((ext_vector_type(4))) short bf16x4;
typedef __attribute__((ext_vector_type(4))) float f32x4;
typedef unsigned short u16;

#define NTHR 256
#define LDS_BYTES 65536

#define D_MODEL 1024
#define BATCH 8
#define SEQ 2048
#define CTXL 256
#define NLAT (BATCH * SEQ)
#define NCTX (BATCH * CTXL)
#define NROWS (NLAT + NCTX)
#define INW 1280
#define NEXP 64
#define VT_LD (SEQ + CTXL)
#define NCHUNK_LAT 1024
#define NCHUNK_ALL 1152
#define EPS 1e-6f

#define XB_TMO      128
#define XB_XCNT(j)  (256  + 64 * (j))
#define XB_XSUB(j)  (1280 + 64 * (j))
#define XB_XGEN(j)  (2304 + 64 * (j))
#define XB_TOP      3328
#define XB_TOPGEN   3392
#define XCD_BAR_WORDS 3456
#define XB_SPIN_CAP (1u << 20)
#define LAS __attribute__((address_space(3)))

__device__ __forceinline__ unsigned xb_ld(unsigned* p)              { return __hip_atomic_load(p, __ATOMIC_RELAXED, __HIP_MEMORY_SCOPE_AGENT); }
__device__ __forceinline__ unsigned xb_add(unsigned* p, unsigned v) { return __hip_atomic_fetch_add(p, v, __ATOMIC_RELAXED, __HIP_MEMORY_SCOPE_AGENT); }
__device__ __forceinline__ unsigned xb_xcc_id() { return (unsigned)__builtin_amdgcn_s_getreg((3 << 11) | 20) & 0xFu; }
#define XB_SPIN(cond, bar) do { unsigned _sp = 0; while (cond) { __builtin_amdgcn_s_sleep(1); \
    if ((++_sp & 255u) == 0u) { if (xb_ld(&(bar)[XB_TMO])) break; if (_sp > XB_SPIN_CAP) { atomicAdd(&(bar)[XB_TMO], 1u); break; } } } } while (0)

struct XcdBarrier { unsigned* bar; unsigned x; volatile LAS unsigned* st; };

__device__ __forceinline__ XcdBarrier xcd_barrier_post(unsigned* bar, volatile LAS unsigned* st) {
    XcdBarrier b; b.bar = bar; b.x = xb_xcc_id(); b.st = st;
    if (threadIdx.x == 0) (void)xb_add(&bar[XB_XCNT(b.x)], 1u);
    return b;
}
__device__ __forceinline__ void xcd_barrier_complete(unsigned* bar, unsigned x, unsigned& nloc, unsigned& nx) {
    const unsigned G = gridDim.x * gridDim.y * gridDim.z;
    unsigned sum, cnt, mine, sp = 0u;
    for (;;) {
        sum = 0u; cnt = 0u; mine = 0u;
#pragma unroll
        for (unsigned j = 0; j < 16; ++j) { const unsigned c = xb_ld(&bar[XB_XCNT(j)]); sum += c; cnt += (c > 0u) ? 1u : 0u; mine = (j == x) ? c : mine; }
        if (sum == G) break;
        __builtin_amdgcn_s_sleep(1);
        if ((++sp & 255u) == 0u) { if (xb_ld(&bar[XB_TMO])) break; if (sp > XB_SPIN_CAP) { atomicAdd(&bar[XB_TMO], 1u); break; } }
    }
    nloc = mine > 0u ? mine : 1u; nx = cnt > 0u ? cnt : 1u;
}
__device__ __forceinline__ void xcd_barrier(const XcdBarrier& b) {
    asm volatile("s_waitcnt vmcnt(0)" ::: "memory");
    __syncthreads();
    if (threadIdx.x == 0) {
        unsigned* bar = b.bar;
        __builtin_amdgcn_s_waitcnt(0);
        unsigned nloc = b.st[0], nx = b.st[1];
        if (nloc == 0u) { xcd_barrier_complete(bar, b.x, nloc, nx); b.st[0] = nloc; b.st[1] = nx; }
        const unsigned old = xb_add(&bar[XB_XSUB(b.x)], 1u);
        const unsigned gen = old / nloc;
        if (old + 1u == (gen + 1u) * nloc) {
            __builtin_amdgcn_fence(__ATOMIC_RELEASE, "agent");
            asm volatile("s_waitcnt vmcnt(0)" ::: "memory");
            const unsigned og = xb_add(&bar[XB_TOP], 1u);
            const unsigned tg = og / nx;
            if (og + 1u == (tg + 1u) * nx) xb_add(&bar[XB_TOPGEN], 1u);
            else XB_SPIN(xb_ld(&bar[XB_TOPGEN]) == tg, bar);
            __builtin_amdgcn_fence(__ATOMIC_ACQUIRE, "agent");
            xb_add(&bar[XB_XGEN(b.x)], 1u);
            asm volatile("s_waitcnt vmcnt(0)" ::: "memory");
        } else {
            XB_SPIN(xb_ld(&bar[XB_XGEN(b.x)]) == gen, bar);
            __builtin_amdgcn_fence(__ATOMIC_ACQUIRE, "agent");
            asm volatile("s_waitcnt vmcnt(0)" ::: "memory");
        }
    }
    __syncthreads();
}

struct Params {
    const float *x, *c, *ctx, *c_ctx, *w_ada, *b_ada, *norm_mix, *norm_ffn, *w_in, *attn_sink,
        *a_re, *a_im, *log_dt, *b_re, *b_im, *c_re, *c_im, *ssm_d, *w_glu, *b_glu, *norm_attn_out, *norm_ssm_out,
        *w_out, *w_router, *router_bias, *w_gate_e, *w_up_e, *w_down_e, *w_gate_s, *w_up_s, *w_down_s, *norm_final;
    float* out;
    unsigned* bar;
    float* mod;
    float2* rope;
    u16 *WinT, *WgluT, *WoutT, *WrT, *WguT, *WdT, *TabS, *TabY;
    u16 *Hb, *Q, *Kb, *Vt, *U, *AO, *Hin, *Y, *SO, *CAT, *H2, *HH;
    float* S;
    unsigned char* IDX;
    float* WGT;
};

extern __shared__ __attribute__((aligned(16))) char smem[];

__device__ __forceinline__ u16 f2bf(float f) {
    unsigned u = __float_as_uint(f);
    u += 0x7fffu + ((u >> 16) & 1u);
    return (u16)(u >> 16);
}
__device__ __forceinline__ float bf2f(u16 h) { return __uint_as_float(((unsigned)h) << 16); }
__device__ __forceinline__ unsigned pack2(float a, float b) { return (unsigned)f2bf(a) | ((unsigned)f2bf(b) << 16); }
__device__ __forceinline__ void glds16(const void* g, void* l) {
    __builtin_amdgcn_global_load_lds((const unsigned*)g, (unsigned*)l, 16, 0, 0);
}
__device__ __forceinline__ int lds_byte(int r, int c) {
    int st = (r >> 4) * 2 + (c >> 5), rr = r & 15, cc = c & 31, ob = rr * 64 + cc * 2;
    return st * 1024 + (ob ^ (((ob >> 9) & 1) << 5));
}
__device__ __forceinline__ float wave_sum(float v) {
#pragma unroll
    for (int o = 32; o > 0; o >>= 1) v += __shfl_xor(v, o);
    return v;
}
__device__ __forceinline__ float sigmoidf_(float x) { return 1.f / (1.f + __expf(-x)); }
__device__ __forceinline__ float siluf_(float x) { return x / (1.f + __expf(-x)); }
__device__ __forceinline__ float gelu_tanh(float x) {
    float u = 0.7978845608028654f * (x + 0.044715f * x * x * x);
    return x / (1.f + __expf(-2.f * u));
}

template <class FA, class FB>
__device__ __forceinline__ void gemm_tile(int nkt, FA fa, FB fb, f32x4 (&acc)[4][4]) {
    const int tid = threadIdx.x, lane = tid & 63, wid = tid >> 6, wr = wid >> 1, wc = wid & 1, fr = lane & 15, fq = lane >> 4;
    const int sb = lane * 16, swz = sb ^ (((sb >> 9) & 1) << 5);
    const int r_in = swz >> 6, c_in = (swz & 63) >> 1;
#pragma unroll
    for (int m = 0; m < 4; ++m)
#pragma unroll
        for (int n = 0; n < 4; ++n) acc[m][n] = (f32x4){0.f, 0.f, 0.f, 0.f};
    __syncthreads();
    auto stage = [&](int kt, int s) {
        char* sa = smem + s * 32768;
        char* sbm = sa + 16384;
#pragma unroll
        for (int i = 0; i < 4; ++i) {
            const int st = wid + 4 * i, R = (st >> 1) * 16 + r_in, C = (st & 1) * 32 + c_in;
            glds16(fa(R, C, kt), sa + tid * 16 + i * 4096);
            glds16(fb(R, C, kt), sbm + tid * 16 + i * 4096);
        }
    };
    stage(0, 0);
    for (int kt = 0; kt < nkt; ++kt) {
        asm volatile("s_waitcnt vmcnt(0)" ::: "memory");
        __syncthreads();
        if (kt + 1 < nkt) stage(kt + 1, (kt + 1) & 1);
        const char* sa = smem + (kt & 1) * 32768;
        const char* sbm = sa + 16384;
#pragma unroll
        for (int ks = 0; ks < 2; ++ks) {
            bf16x8 a[4], b[4];
#pragma unroll
            for (int m = 0; m < 4; ++m) a[m] = *(const bf16x8*)(sa + lds_byte(wr * 64 + m * 16 + fr, ks * 32 + fq * 8));
#pragma unroll
            for (int n = 0; n < 4; ++n) b[n] = *(const bf16x8*)(sbm + lds_byte(wc * 64 + n * 16 + fr, ks * 32 + fq * 8));
#pragma unroll
            for (int m = 0; m < 4; ++m)
#pragma unroll
                for (int n = 0; n < 4; ++n) acc[m][n] = __builtin_amdgcn_mfma_f32_16x16x32_bf16(a[m], b[n], acc[m][n], 0, 0, 0);
        }
    }
    __syncthreads();
}

template <class FD>
__device__ __forceinline__ void wave_store_bf16(const float (&v)[4][4][4], FD dst) {
    const int lane = threadIdx.x & 63, wid = threadIdx.x >> 6, fr = lane & 15, fq = lane >> 4;
    char* base = smem + wid * 9216;
#pragma unroll
    for (int m = 0; m < 4; ++m)
#pragma unroll
        for (int n = 0; n < 4; ++n)
#pragma unroll
            for (int j = 0; j < 4; ++j)
                *(u16*)(base + (m * 16 + fq * 4 + j) * 144 + (n * 16 + fr) * 2) = f2bf(v[m][n][j]);
    asm volatile("s_waitcnt lgkmcnt(0)" ::: "memory");
    __builtin_amdgcn_wave_barrier();
#pragma unroll
    for (int i = 0; i < 8; ++i) {
        const int id = i * 64 + lane, row = id >> 3, ch = id & 7;
        const uint4 d = *(const uint4*)(base + row * 144 + ch * 16);
        u16* p = dst(row);
        if (p) *(uint4*)(p + ch * 8) = d;
    }
    asm volatile("s_waitcnt lgkmcnt(0)" ::: "memory");
    __builtin_amdgcn_wave_barrier();
}

__device__ void conv_tile(const float* src, int ld, int k0, int n0, u16* dst, int ldd, int mode) {
    float* t = (float*)smem;
    const int tid = threadIdx.x;
    __syncthreads();
#pragma unroll
    for (int i = 0; i < 16; ++i) {
        const int r = i * 4 + (tid >> 6), cidx = tid & 63;
        t[r * 65 + cidx] = src[(size_t)(k0 + r) * ld + n0 + cidx];
    }
    __syncthreads();
    const int n = tid >> 2, kq = tid & 3;
    unsigned w[8];
#pragma unroll
    for (int i = 0; i < 8; ++i) w[i] = pack2(t[(kq * 16 + 2 * i) * 65 + n], t[(kq * 16 + 2 * i + 1) * 65 + n]);
    const int gn = n0 + n;
    int row = gn;
    if (mode == 1) row = (gn >> 4) * 32 + (gn & 15);
    else if (mode == 2) row = (gn >> 4) * 32 + 16 + (gn & 15);
    uint4* d = (uint4*)(dst + (size_t)row * ldd + k0 + kq * 16);
    d[0] = make_uint4(w[0], w[1], w[2], w[3]);
    d[1] = make_uint4(w[4], w[5], w[6], w[7]);
}

__device__ void ada_item(const Params& p, int item) {
    float* sc = (float*)smem;
    float* red = sc + 9 * 1024;
    const int tid = threadIdx.x;
    __syncthreads();
    for (int i = tid; i < 9 * 1024; i += NTHR) {
        const int r = i >> 10, k = i & 1023;
        const float cv = (r < 8) ? p.c[r * 1024 + k] : p.c_ctx[k];
        sc[i] = siluf_(cv);
    }
    __syncthreads();
    const int kq = tid >> 6, jl = tid & 63, j = item * 64 + jl;
    float acc[9];
#pragma unroll
    for (int r = 0; r < 9; ++r) acc[r] = 0.f;
#pragma unroll 8
    for (int k = kq; k < 1024; k += 4) {
        const float w = p.w_ada[(size_t)k * 6144 + j];
#pragma unroll
        for (int r = 0; r < 9; ++r) acc[r] += sc[r * 1024 + k] * w;
    }
#pragma unroll
    for (int r = 0; r < 9; ++r) red[(kq * 9 + r) * 64 + jl] = acc[r];
    __syncthreads();
    for (int i = tid; i < 9 * 64; i += NTHR) {
        const int r = i >> 6, l = i & 63;
        const float s = red[(0 * 9 + r) * 64 + l] + red[(1 * 9 + r) * 64 + l] + red[(2 * 9 + r) * 64 + l] + red[(3 * 9 + r) * 64 + l];
        p.mod[r * 6144 + item * 64 + l] = s + p.b_ada[item * 64 + l];
    }
}

__device__ void rope_item(const Params& p) {
    for (int i = threadIdx.x; i < 64 * 16; i += NTHR) {
        const int pos = i >> 4, k = i & 15;
        const float inv = exp2f(-(float)k * (13.287712379549449f / 16.f));
        float s, c;
        sincosf((float)pos * inv, &s, &c);
        p.rope[i] = make_float2(c, s);
    }
}

__device__ void ssm_table_item(const Params& p, int g) {
    float* pw = (float*)smem;
    float* Bb = pw + 17 * 64 * 2;
    float* Cc = Bb + 64 * 16 * 2;
    float* Kf = Cc + 16 * 64 * 2;
    const int tid = threadIdx.x;
    u16* tabS = p.TabS + (size_t)g * 256 * 256;
    u16* tabY = p.TabY + (size_t)g * 256 * 512;
    __syncthreads();
    for (int dir = 0; dir < 2; ++dir) {
        const int pidx = dir * 32 + g;
        const float dt = __expf(p.log_dt[pidx]);
        for (int i = tid; i < 17 * 64; i += NTHR) {
            const int tau = i >> 6, n = i & 63;
            const float are = p.a_re[pidx * 64 + n], aim = p.a_im[pidx * 64 + n];
            const float mag = __expf((float)tau * dt * are);
            float rev = (float)tau * (dt * aim * 0.15915494309189535f);
            rev -= rintf(rev);
            pw[i * 2] = mag * __builtin_amdgcn_cosf(rev);
            pw[i * 2 + 1] = mag * __builtin_amdgcn_sinf(rev);
        }
        __syncthreads();
        for (int i = tid; i < 64 * 16; i += NTHR) {
            const int n = i >> 4;
            const float are = p.a_re[pidx * 64 + n], aim = p.a_im[pidx * 64 + n];
            const float abr = pw[(64 + n) * 2], abi = pw[(64 + n) * 2 + 1];
            const float den = are * are + aim * aim, nre = abr - 1.f;
            const float cre = (nre * are + abi * aim) / den, cim = (abi * are - nre * aim) / den;
            const float br = p.b_re[(size_t)pidx * 1024 + i], bi = p.b_im[(size_t)pidx * 1024 + i];
            Bb[i * 2] = cre * br - cim * bi;
            Bb[i * 2 + 1] = cre * bi + cim * br;
            Cc[i * 2] = p.c_re[(size_t)pidx * 1024 + i];
            Cc[i * 2 + 1] = p.c_im[(size_t)pidx * 1024 + i];
        }
        __syncthreads();
        {
            const int tau = tid >> 4, pp = tid & 15;
            float s[16];
#pragma unroll
            for (int q = 0; q < 16; ++q) s[q] = 0.f;
            for (int n = 0; n < 64; ++n) {
                const float2 cv = *(const float2*)&Cc[(pp * 64 + n) * 2];
                const float2 wv = *(const float2*)&pw[(tau * 64 + n) * 2];
                const float zr = cv.x * wv.x - cv.y * wv.y, zi = cv.x * wv.y + cv.y * wv.x;
#pragma unroll
                for (int q = 0; q < 16; ++q) {
                    const float2 bv = *(const float2*)&Bb[(n * 16 + q) * 2];
                    s[q] += zr * bv.x - zi * bv.y;
                }
            }
#pragma unroll
            for (int q = 0; q < 16; ++q) Kf[dir * 4096 + tau * 256 + pp * 16 + q] = s[q];
        }
        for (int id = tid; id < 128 * 32; id += NTHR) {
            const int rr = id >> 5, ch = id & 31, cpart = rr >> 6, n = rr & 63, s_ = ch >> 1, q0 = (ch & 1) * 8;
            const int e = dir == 0 ? 15 - s_ : s_;
            const float wr_ = pw[(e * 64 + n) * 2], wi_ = pw[(e * 64 + n) * 2 + 1];
            unsigned w[4];
#pragma unroll
            for (int i = 0; i < 4; ++i) {
                float v[2];
#pragma unroll
                for (int h = 0; h < 2; ++h) {
                    const float br = Bb[(n * 16 + q0 + 2 * i + h) * 2], bi = Bb[(n * 16 + q0 + 2 * i + h) * 2 + 1];
                    v[h] = cpart == 0 ? (wr_ * br - wi_ * bi) : (wr_ * bi + wi_ * br);
                }
                w[i] = pack2(v[0], v[1]);
            }
            *(uint4*)(tabS + (size_t)(dir * 128 + rr) * 256 + s_ * 16 + q0) = make_uint4(w[0], w[1], w[2], w[3]);
        }
        for (int id = tid; id < 256 * 16; id += NTHR) {
            const int m = id >> 4, ch = id & 15, t = m >> 4, pp = m & 15, cpart = ch >> 3, n0 = (ch & 7) * 8;
            const int e = dir == 0 ? t + 1 : 16 - t;
            unsigned w[4];
#pragma unroll
            for (int i = 0; i < 4; ++i) {
                float v[2];
#pragma unroll
                for (int h = 0; h < 2; ++h) {
                    const int n = n0 + 2 * i + h;
                    const float cr = Cc[(pp * 64 + n) * 2], ci = Cc[(pp * 64 + n) * 2 + 1];
                    const float wr_ = pw[(e * 64 + n) * 2], wi_ = pw[(e * 64 + n) * 2 + 1];
                    v[h] = cpart == 0 ? (cr * wr_ - ci * wi_) : -(cr * wi_ + ci * wr_);
                }
                w[i] = pack2(v[0], v[1]);
            }
            *(uint4*)(tabY + (size_t)m * 512 + 256 + dir * 128 + cpart * 64 + n0) = make_uint4(w[0], w[1], w[2], w[3]);
        }
        __syncthreads();
    }
    for (int id = tid; id < 256 * 32; id += NTHR) {
        const int m = id >> 5, ch = id & 31, t = m >> 4, pp = m & 15, s_ = ch >> 1, q0 = (ch & 1) * 8;
        unsigned w[4];
#pragma unroll
        for (int i = 0; i < 4; ++i) {
            float v[2];
#pragma unroll
            for (int h = 0; h < 2; ++h) {
                const int q = q0 + 2 * i + h;
                float val;
                if (s_ < t) val = Kf[((t - s_) * 16 + pp) * 16 + q];
                else if (s_ > t) val = Kf[4096 + ((s_ - t) * 16 + pp) * 16 + q];
                else val = Kf[(pp) * 16 + q] + Kf[4096 + pp * 16 + q] + (pp == q ? p.ssm_d[g * 16 + pp] : 0.f);
                v[h] = val;
            }
            w[i] = pack2(v[0], v[1]);
        }
        *(uint4*)(tabY + (size_t)m * 512 + s_ * 16 + q0) = make_uint4(w[0], w[1], w[2], w[3]);
    }
}

#define N_CONV 6896
__device__ void conv_item(const Params& p, int t) {
    if (t < 320) { conv_tile(p.w_in, 1280, (t / 20) * 64, (t % 20) * 64, p.WinT, 1024, 0); return; }
    t -= 320;
    if (t < 64) { conv_tile(p.w_glu, 512, (t / 8) * 64, (t % 8) * 64, p.WgluT, 512, 0); return; }
    t -= 64;
    if (t < 256) { conv_tile(p.w_out, 1024, (t / 16) * 64, (t % 16) * 64, p.WoutT, 1024, 0); return; }
    t -= 256;
    if (t < 16) {
        conv_tile(p.w_router, 64, t * 64, 0, p.WrT, 1024, 0);
        const int r = threadIdx.x >> 2, q = threadIdx.x & 3;
        uint4* d = (uint4*)(p.WrT + (size_t)(64 + r) * 1024 + t * 64 + q * 16);
        d[0] = make_uint4(0, 0, 0, 0); d[1] = make_uint4(0, 0, 0, 0);
        return;
    }
    t -= 16;
    if (t < 2048) { const int e = t >> 5, r = t & 31; conv_tile(p.w_gate_e + (size_t)e * 131072, 128, (r >> 1) * 64, (r & 1) * 64, p.WguT + (size_t)e * 262144, 1024, 1); return; }
    t -= 2048;
    if (t < 2048) { const int e = t >> 5, r = t & 31; conv_tile(p.w_up_e + (size_t)e * 131072, 128, (r >> 1) * 64, (r & 1) * 64, p.WguT + (size_t)e * 262144, 1024, 2); return; }
    t -= 2048;
    if (t < 32) { conv_tile(p.w_gate_s, 128, (t >> 1) * 64, (t & 1) * 64, p.WguT + (size_t)64 * 262144, 1024, 1); return; }
    t -= 32;
    if (t < 32) { conv_tile(p.w_up_s, 128, (t >> 1) * 64, (t & 1) * 64, p.WguT + (size_t)64 * 262144, 1024, 2); return; }
    t -= 32;
    if (t < 2048) { const int e = t >> 5, r = t & 31; conv_tile(p.w_down_e + (size_t)e * 131072, 1024, (r >> 4) * 64, (r & 15) * 64, p.WdT + (size_t)e * 131072, 128, 0); return; }
    t -= 2048;
    conv_tile(p.w_down_s, 1024, (t >> 4) * 64, (t & 15) * 64, p.WdT + (size_t)64 * 131072, 128, 0);
}

__device__ void phase0(const Params& p) {
    const int NU = 32 + 96 + 1 + N_CONV;
    for (int u = blockIdx.x; u < NU; u += gridDim.x) {
        if (u < 32) ssm_table_item(p, u);
        else if (u < 128) ada_item(p, u - 32);
        else if (u == 128) rope_item(p);
        else conv_item(p, u - 129);
    }
}

__device__ __forceinline__ void norm_mod_row(const float* src, const float* gain, const float* sh, const float* scl, u16* dst) {
    const int lane = threadIdx.x & 63;
    float4 v[4];
    float ss = 0.f;
#pragma unroll
    for (int i = 0; i < 4; ++i) {
        v[i] = *(const float4*)(src + i * 256 + lane * 4);
        ss += v[i].x * v[i].x + v[i].y * v[i].y + v[i].z * v[i].z + v[i].w * v[i].w;
    }
    ss = wave_sum(ss);
    const float rs = rsqrtf(ss * (1.f / 1024.f) + EPS);
#pragma unroll
    for (int i = 0; i < 4; ++i) {
        const int c0 = i * 256 + lane * 4;
        const float4 g = *(const float4*)(gain + c0), s = *(const float4*)(sh + c0), k = *(const float4*)(scl + c0);
        const float a = v[i].x * rs * g.x * (1.f + k.x) + s.x, b = v[i].y * rs * g.y * (1.f + k.y) + s.y;
        const float c = v[i].z * rs * g.z * (1.f + k.z) + s.z, d = v[i].w * rs * g.w * (1.f + k.w) + s.w;
        *(uint2*)(dst + c0) = make_uint2(pack2(a, b), pack2(c, d));
    }
}

__device__ void phase1(const Params& p) {
    const int wv = blockIdx.x * 4 + (threadIdx.x >> 6), nwv = gridDim.x * 4;
    for (int r = wv; r < NROWS; r += nwv) {
        const float* src; const float* md;
        if (r < NLAT) { src = p.x + (size_t)r * 1024; md = p.mod + (r >> 11) * 6144; }
        else { src = p.ctx + (size_t)(r - NLAT) * 1024; md = p.mod + 8 * 6144; }
        norm_mod_row(src, p.norm_mix, md, md + 1024, p.Hb + (size_t)r * 1024);
    }
}

__device__ void phase2(const Params& p) {
    const int NU = 128 * 10 + 16 * 6;
    const int lane = threadIdx.x & 63, wid = threadIdx.x >> 6, wr = wid >> 1, wc = wid & 1, fr = lane & 15, fq = lane >> 4;
    for (int u = blockIdx.x; u < NU; u += gridDim.x) {
        int mt, nt;
        if (u < 1280) { mt = u / 10; nt = u % 10; } else { const int v = u - 1280; mt = 128 + v / 6; nt = 4 + v % 6; }
        const u16* A = p.Hb + (size_t)mt * 128 * 1024;
        const u16* B = p.WinT + (size_t)nt * 128 * 1024;
        f32x4 acc[4][4];
        gemm_tile(16,
            [&](int R, int C, int kt) { return (const void*)(A + (size_t)R * 1024 + kt * 64 + C); },
            [&](int R, int C, int kt) { return (const void*)(B + (size_t)R * 1024 + kt * 64 + C); }, acc);
        const int row0 = mt * 128 + wr * 64;
        const int col0 = nt * 128 + wc * 64;
        const bool is_lat = mt < 128;
        if (nt == 5) {
            const int kvh = wc;
#pragma unroll
            for (int m = 0; m < 4; ++m) {
                const int r = row0 + m * 16 + fq * 4;
                int b, pos;
                if (is_lat) { b = r >> 11; pos = r & 2047; } else { const int rc = r - NLAT; b = rc >> 8; pos = SEQ + (rc & 255); }
#pragma unroll
                for (int n = 0; n < 4; ++n) {
                    const int d = n * 16 + fr;
                    u16* dst = p.Vt + ((size_t)(b * 2 + kvh) * 64 + d) * VT_LD + pos;
                    *(uint2*)dst = make_uint2(pack2(acc[m][n][0], acc[m][n][1]), pack2(acc[m][n][2], acc[m][n][3]));
                }
            }
        } else {
            float v[4][4][4];
            const bool do_rope = is_lat && nt <= 4;
#pragma unroll
            for (int m = 0; m < 4; ++m)
#pragma unroll
                for (int j = 0; j < 4; ++j) {
                    if (do_rope) {
                        const int r = row0 + m * 16 + fq * 4 + j, pos = r & 2047;
                        const float2 cr = p.rope[(pos >> 6) * 16 + fr], cc = p.rope[(pos & 63) * 16 + fr];
                        const float x1 = acc[m][0][j], x2 = acc[m][1][j], y1 = acc[m][2][j], y2 = acc[m][3][j];
                        v[m][0][j] = x1 * cr.x - x2 * cr.y; v[m][1][j] = x1 * cr.y + x2 * cr.x;
                        v[m][2][j] = y1 * cc.x - y2 * cc.y; v[m][3][j] = y1 * cc.y + y2 * cc.x;
                    } else {
#pragma unroll
                        for (int n = 0; n < 4; ++n) v[m][n][j] = acc[m][n][j];
                    }
                }
            u16* dbase; int ldd;
            if (nt < 4) { dbase = p.Q + (size_t)row0 * 512 + col0; ldd = 512; }
            else if (nt == 4) { dbase = p.Kb + (size_t)row0 * 128 + (col0 - 512); ldd = 128; }
            else { dbase = p.U + (size_t)row0 * 512 + (col0 - 768); ldd = 512; }
            wave_store_bf16(v, [&](int row) { return dbase + (size_t)row * ldd; });
        }
    }
}

__device__ void attn_unit(const Params& p, int u) {
    const int h = u & 7, qb = (u >> 3) & 15, b = u >> 7, kvh = h >> 2;
    const int tid = threadIdx.x, lane = tid & 63, wid = tid >> 6, fr = lane & 15, fq = lane >> 4;
    const int sb = lane * 16, swz = sb ^ (((sb >> 9) & 1) << 5);
    const int r_in = swz >> 6, c_in = (swz & 63) >> 1;
    const int jstart = qb == 0 ? 2 : 0, jend = qb == 15 ? 4 : 6, nb = jend - jstart, ntile = nb + 4;
    const float SC = 0.125f * 1.4426950408889634f;
    bf16x8 qf[2][2];
    const int qrow0 = b * SEQ + qb * 128 + wid * 32;
#pragma unroll
    for (int qt = 0; qt < 2; ++qt)
#pragma unroll
        for (int ks = 0; ks < 2; ++ks)
            qf[qt][ks] = *(const bf16x8*)(p.Q + (size_t)(qrow0 + qt * 16 + fr) * 512 + h * 64 + ks * 32 + fq * 8);
    f32x4 o[4][2];
#pragma unroll
    for (int dt = 0; dt < 4; ++dt)
#pragma unroll
        for (int qt = 0; qt < 2; ++qt) o[dt][qt] = (f32x4){0.f, 0.f, 0.f, 0.f};
    float mrun[2], lrun[2];
    const float sinkv = p.attn_sink[h] * 1.4426950408889634f;
    mrun[0] = mrun[1] = sinkv;
    lrun[0] = lrun[1] = (fq == 0) ? 1.f : 0.f;
    __syncthreads();
    auto stage = [&](int i, int s) {
        const u16* kbase; const u16* vbase;
        if (i < nb) {
            const int ks0 = qb * 128 - 128 + 64 * (jstart + i);
            kbase = p.Kb + (size_t)(b * SEQ + ks0) * 128 + kvh * 64;
            vbase = p.Vt + (size_t)(b * 2 + kvh) * 64 * VT_LD + ks0;
        } else {
            const int c0 = 64 * (i - nb);
            kbase = p.Kb + (size_t)(NLAT + b * CTXL + c0) * 128 + kvh * 64;
            vbase = p.Vt + (size_t)(b * 2 + kvh) * 64 * VT_LD + SEQ + c0;
        }
        char* sk = smem + s * 16384;
        char* sv = sk + 8192;
#pragma unroll
        for (int it = 0; it < 2; ++it) {
            const int st = wid + 4 * it, R = (st >> 1) * 16 + r_in, C = (st & 1) * 32 + c_in;
            glds16(kbase + (size_t)R * 128 + C, sk + tid * 16 + it * 4096);
            glds16(vbase + (size_t)R * VT_LD + C, sv + tid * 16 + it * 4096);
        }
    };
    stage(0, 0);
    for (int i = 0; i < ntile; ++i) {
        asm volatile("s_waitcnt vmcnt(0)" ::: "memory");
        __syncthreads();
        if (i + 1 < ntile) stage(i + 1, (i + 1) & 1);
        const char* sk = smem + (i & 1) * 16384;
        const char* sv = sk + 8192;
        f32x4 s[4][2];
#pragma unroll
        for (int kt = 0; kt < 4; ++kt)
#pragma unroll
            for (int qt = 0; qt < 2; ++qt) s[kt][qt] = (f32x4){0.f, 0.f, 0.f, 0.f};
#pragma unroll
        for (int ks = 0; ks < 2; ++ks)
#pragma unroll
            for (int kt = 0; kt < 4; ++kt) {
                const bf16x8 kf = *(const bf16x8*)(sk + lds_byte(kt * 16 + fr, ks * 32 + fq * 8));
#pragma unroll
                for (int qt = 0; qt < 2; ++qt) s[kt][qt] = __builtin_amdgcn_mfma_f32_16x16x32_bf16(kf, qf[qt][ks], s[kt][qt], 0, 0, 0);
            }
        const bool band = i < nb;
        const int ks0 = qb * 128 - 128 + 64 * (jstart + i);
        bf16x8 pf[2][2];
#pragma unroll
        for (int qt = 0; qt < 2; ++qt) {
            const int qp = qb * 128 + wid * 32 + qt * 16 + fr;
            float mx = -1e30f;
#pragma unroll
            for (int kt = 0; kt < 4; ++kt)
#pragma unroll
                for (int j = 0; j < 4; ++j) {
                    float v = s[kt][qt][j] * SC;
                    if (band) {
                        const int kp = ks0 + kt * 16 + fq * 4 + j, d = qp - kp;
                        if (d > 128 || d < -128) v = -1e30f;
                    }
                    s[kt][qt][j] = v;
                    mx = fmaxf(mx, v);
                }
            mx = fmaxf(mx, __shfl_xor(mx, 16));
            mx = fmaxf(mx, __shfl_xor(mx, 32));
            const float mnew = fmaxf(mrun[qt], mx);
            const float alpha = __builtin_amdgcn_exp2f(mrun[qt] - mnew);
            mrun[qt] = mnew;
            float ls = 0.f;
#pragma unroll
            for (int kt = 0; kt < 4; ++kt)
#pragma unroll
                for (int j = 0; j < 4; ++j) {
                    const float pv = __builtin_amdgcn_exp2f(s[kt][qt][j] - mnew);
                    s[kt][qt][j] = pv;
                    ls += pv;
                }
            lrun[qt] = lrun[qt] * alpha + ls;
#pragma unroll
            for (int dt = 0; dt < 4; ++dt) o[dt][qt] *= alpha;
#pragma unroll
            for (int k2 = 0; k2 < 2; ++k2) {
                bf16x8 t;
#pragma unroll
                for (int j = 0; j < 4; ++j) { t[j] = (short)f2bf(s[2 * k2][qt][j]); t[4 + j] = (short)f2bf(s[2 * k2 + 1][qt][j]); }
                pf[qt][k2] = t;
            }
        }
#pragma unroll
        for (int k2 = 0; k2 < 2; ++k2)
#pragma unroll
            for (int dt = 0; dt < 4; ++dt) {
                const uint2 lo = *(const uint2*)(sv + lds_byte(dt * 16 + fr, k2 * 32 + fq * 4));
                const uint2 hi = *(const uint2*)(sv + lds_byte(dt * 16 + fr, k2 * 32 + 16 + fq * 4));
                union { uint4 u; bf16x8 v; } cv; cv.u = make_uint4(lo.x, lo.y, hi.x, hi.y);
#pragma unroll
                for (int qt = 0; qt < 2; ++qt) o[dt][qt] = __builtin_amdgcn_mfma_f32_16x16x32_bf16(cv.v, pf[qt][k2], o[dt][qt], 0, 0, 0);
            }
    }
#pragma unroll
    for (int qt = 0; qt < 2; ++qt) {
        float l = lrun[qt];
        l += __shfl_xor(l, 16);
        l += __shfl_xor(l, 32);
        const float inv = 1.f / l;
        u16* dst = p.AO + (size_t)(qrow0 + qt * 16 + fr) * 512 + h * 64 + fq * 4;
#pragma unroll
        for (int dt = 0; dt < 4; ++dt)
            *(uint2*)(dst + dt * 16) = make_uint2(pack2(o[dt][qt][0] * inv, o[dt][qt][1] * inv), pack2(o[dt][qt][2] * inv, o[dt][qt][3] * inv));
    }
}

__device__ void ssm_s1_unit(const Params& p, int u) {
    const int ct = u % 9, mh = (u / 9) & 1, g = u / 18;
    const int lane = threadIdx.x & 63, wid = threadIdx.x >> 6, wr = wid >> 1, wc = wid & 1, fr = lane & 15, fq = lane >> 4;
    const u16* A = p.TabS + ((size_t)g * 256 + mh * 128) * 256;
    const u16* Ub = p.U + (size_t)ct * 128 * 16 * 512 + g * 16;
    f32x4 acc[4][4];
    gemm_tile(4,
        [&](int R, int C, int kt) { return (const void*)(A + (size_t)R * 256 + kt * 64 + C); },
        [&](int R, int C, int kt) { return (const void*)(Ub + (size_t)(R * 16 + kt * 4 + (C >> 4)) * 512 + (C & 15)); }, acc);
#pragma unroll
    for (int m = 0; m < 4; ++m)
#pragma unroll
        for (int n = 0; n < 4; ++n) {
            const int rho = mh * 128 + wr * 64 + m * 16 + fq * 4;
            const int cg = ct * 128 + wc * 64 + n * 16 + fr;
            *(f32x4*)(p.S + ((size_t)cg * 32 + g) * 256 + rho) = acc[m][n];
        }
}

__device__ void phase3(const Params& p) {
    const int NU = 1024 + 576;
    for (int u = blockIdx.x; u < NU; u += gridDim.x) {
        if (u < 1024) attn_unit(p, u); else ssm_s1_unit(p, u - 1024);
    }
}

__device__ void phase4(const Params& p) {
    const int gid = blockIdx.x * NTHR + threadIdx.x;
    if (gid >= BATCH * 2 * 32 * 64) return;
    const int n = gid & 63, g = (gid >> 6) & 31, dir = (gid >> 11) & 1, b = gid >> 12;
    const int pidx = dir * 32 + g;
    const float dt = __expf(p.log_dt[pidx]);
    const float are = p.a_re[pidx * 64 + n], aim = p.a_im[pidx * 64 + n];
    const float mag = __expf(16.f * dt * are);
    float rev = 16.f * (dt * aim * 0.15915494309189535f);
    rev -= rintf(rev);
    const float ar = mag * __builtin_amdgcn_cosf(rev), ai = mag * __builtin_amdgcn_sinf(rev);
    float hr = 0.f, hi = 0.f;
    const size_t so = (size_t)g * 256 + dir * 128 + n;
#pragma unroll 8
    for (int i = 0; i < 16; ++i) {
        const int c = dir == 0 ? i : 15 - i;
        const float* sp = p.S + (size_t)(NCHUNK_LAT + b * 16 + c) * 8192 + so;
        const float sr = sp[0], si = sp[64];
        const float nr = ar * hr - ai * hi + sr, ni = ar * hi + ai * hr + si;
        hr = nr; hi = ni;
    }
#pragma unroll 8
    for (int i = 0; i < 128; ++i) {
        const int c = dir == 0 ? i : 127 - i;
        const size_t cg = (size_t)b * 128 + c;
        const float* sp = p.S + cg * 8192 + so;
        const float sr = sp[0], si = sp[64];
        u16* hp = p.Hin + cg * 8192 + so;
        hp[0] = f2bf(hr); hp[64] = f2bf(hi);
        const float nr = ar * hr - ai * hi + sr, ni = ar * hi + ai * hr + si;
        hr = nr; hi = ni;
    }
}

__device__ void phase5(const Params& p) {
    const int NU = 512;
    const int lane = threadIdx.x & 63, wid = threadIdx.x >> 6, wr = wid >> 1, wc = wid & 1, fr = lane & 15, fq = lane >> 4;
    for (int u = blockIdx.x; u < NU; u += gridDim.x) {
        const int ct = u & 7, mh = (u >> 3) & 1, g = u >> 4;
        const u16* A = p.TabY + ((size_t)g * 256 + mh * 128) * 512;
        const u16* Ub = p.U + (size_t)ct * 128 * 16 * 512 + g * 16;
        const u16* Hb_ = p.Hin + (size_t)ct * 128 * 8192 + g * 256;
        f32x4 acc[4][4];
        gemm_tile(8,
            [&](int R, int C, int kt) { return (const void*)(A + (size_t)R * 512 + kt * 64 + C); },
            [&](int R, int C, int kt) {
                return kt < 4 ? (const void*)(Ub + (size_t)(R * 16 + kt * 4 + (C >> 4)) * 512 + (C & 15))
                              : (const void*)(Hb_ + (size_t)R * 8192 + (kt - 4) * 64 + C);
            }, acc);
#pragma unroll
        for (int m = 0; m < 4; ++m)
#pragma unroll
            for (int n = 0; n < 4; ++n) {
                const int t = mh * 8 + wr * 4 + m;
                const int cg = ct * 128 + wc * 64 + n * 16 + fr;
                u16* dst = p.Y + ((size_t)cg * 16 + t) * 512 + g * 16 + fq * 4;
                *(uint2*)dst = make_uint2(pack2(gelu_tanh(acc[m][n][0]), gelu_tanh(acc[m][n][1])),
                                          pack2(gelu_tanh(acc[m][n][2]), gelu_tanh(acc[m][n][3])));
            }
    }
}

__device__ void phase6(const Params& p) {
    const int NU = 512;
    const int lane = threadIdx.x & 63, wid = threadIdx.x >> 6, wr = wid >> 1, wc = wid & 1, fr = lane & 15, fq = lane >> 4;
    for (int u = blockIdx.x; u < NU; u += gridDim.x) {
        const int mt = u >> 2, nt = u & 3;
        const u16* A = p.Y + (size_t)mt * 128 * 512;
        const u16* B = p.WgluT + (size_t)nt * 128 * 512;
        f32x4 acc[4][4];
        gemm_tile(8,
            [&](int R, int C, int kt) { return (const void*)(A + (size_t)R * 512 + kt * 64 + C); },
            [&](int R, int C, int kt) { return (const void*)(B + (size_t)R * 512 + kt * 64 + C); }, acc);
        const int row0 = mt * 128 + wr * 64, col0 = nt * 128 + wc * 64;
        float v[4][4][4];
#pragma unroll
        for (int m = 0; m < 4; ++m)
#pragma unroll
            for (int n = 0; n < 4; ++n)
#pragma unroll
                for (int j = 0; j < 4; ++j) {
                    const int r = row0 + m * 16 + fq * 4 + j, c = col0 + n * 16 + fr;
                    const float yv = bf2f(p.Y[(size_t)r * 512 + c]);
                    v[m][n][j] = yv * sigmoidf_(acc[m][n][j] + p.b_glu[c]);
                }
        u16* dbase = p.SO + (size_t)row0 * 512 + col0;
        wave_store_bf16(v, [&](int row) { return dbase + (size_t)row * 512; });
    }
}

__device__ void phase7(const Params& p) {
    const int lane = threadIdx.x & 63;
    const int wv = blockIdx.x * 4 + (threadIdx.x >> 6), nwv = gridDim.x * 4;
    for (int it = wv; it < NLAT * 2; it += nwv) {
        const int r = it >> 1, half = it & 1;
        const u16* src = (half ? p.SO : p.AO) + (size_t)r * 512 + lane * 8;
        const float* gain = (half ? p.norm_ssm_out : p.norm_attn_out) + lane * 8;
        const uint4 d = *(const uint4*)src;
        float f[8];
        f[0] = bf2f((u16)(d.x & 0xffff)); f[1] = bf2f((u16)(d.x >> 16));
        f[2] = bf2f((u16)(d.y & 0xffff)); f[3] = bf2f((u16)(d.y >> 16));
        f[4] = bf2f((u16)(d.z & 0xffff)); f[5] = bf2f((u16)(d.z >> 16));
        f[6] = bf2f((u16)(d.w & 0xffff)); f[7] = bf2f((u16)(d.w >> 16));
        float ss = 0.f;
#pragma unroll
        for (int i = 0; i < 8; ++i) ss += f[i] * f[i];
        ss = wave_sum(ss);
        const float rs = rsqrtf(ss * (1.f / 512.f) + EPS);
        const float4 g0 = *(const float4*)gain, g1 = *(const float4*)(gain + 4);
        *(uint4*)(p.CAT + (size_t)r * 1024 + half * 512 + lane * 8) =
            make_uint4(pack2(f[0] * rs * g0.x, f[1] * rs * g0.y), pack2(f[2] * rs * g0.z, f[3] * rs * g0.w),
                       pack2(f[4] * rs * g1.x, f[5] * rs * g1.y), pack2(f[6] * rs * g1.z, f[7] * rs * g1.w));
    }
}

__device__ void phase8(const Params& p) {
    const int NU = 1024;
    const int lane = threadIdx.x & 63, wid = threadIdx.x >> 6, wr = wid >> 1, wc = wid & 1, fr = lane & 15, fq = lane >> 4;
    for (int u = blockIdx.x; u < NU; u += gridDim.x) {
        const int mt = u >> 3, nt = u & 7;
        const u16* A = p.CAT + (size_t)mt * 128 * 1024;
        const u16* B = p.WoutT + (size_t)nt * 128 * 1024;
        f32x4 acc[4][4];
        gemm_tile(16,
            [&](int R, int C, int kt) { return (const void*)(A + (size_t)R * 1024 + kt * 64 + C); },
            [&](int R, int C, int kt) { return (const void*)(B + (size_t)R * 1024 + kt * 64 + C); }, acc);
        const int row0 = mt * 128 + wr * 64, col0 = nt * 128 + wc * 64;
        const float* g1 = p.mod + (mt >> 4) * 6144 + 2048;
#pragma unroll
        for (int m = 0; m < 4; ++m)
#pragma unroll
            for (int n = 0; n < 4; ++n)
#pragma unroll
                for (int j = 0; j < 4; ++j) {
                    const int r = row0 + m * 16 + fq * 4 + j, c = col0 + n * 16 + fr;
                    p.out[(size_t)r * 1024 + c] = p.x[(size_t)r * 1024 + c] + g1[c] * acc[m][n][j];
                }
    }
}

__device__ void phase9(const Params& p) {
    const int wv = blockIdx.x * 4 + (threadIdx.x >> 6), nwv = gridDim.x * 4;
    for (int r = wv; r < NLAT; r += nwv) {
        const float* md = p.mod + (r >> 11) * 6144;
        norm_mod_row(p.out + (size_t)r * 1024, p.norm_ffn, md + 3072, md + 4096, p.H2 + (size_t)r * 1024);
    }
}

__device__ void phase10(const Params& p) {
    const int NU = 128;
    const int lane = threadIdx.x & 63, wid = threadIdx.x >> 6, wr = wid >> 1, wc = wid & 1, fr = lane & 15, fq = lane >> 4;
    float* sc = (float*)smem;
    for (int u = blockIdx.x; u < NU; u += gridDim.x) {
        const u16* A = p.H2 + (size_t)u * 128 * 1024;
        const u16* B = p.WrT;
        f32x4 acc[4][4];
        gemm_tile(16,
            [&](int R, int C, int kt) { return (const void*)(A + (size_t)R * 1024 + kt * 64 + C); },
            [&](int R, int C, int kt) { return (const void*)(B + (size_t)R * 1024 + kt * 64 + C); }, acc);
        if (wc == 0) {
#pragma unroll
            for (int m = 0; m < 4; ++m)
#pragma unroll
                for (int n = 0; n < 4; ++n)
#pragma unroll
                    for (int j = 0; j < 4; ++j)
                        sc[(wr * 64 + m * 16 + fq * 4 + j) * 64 + n * 16 + fr] = sigmoidf_(acc[m][n][j]);
        }
        __syncthreads();
        const float bias = p.router_bias[lane];
        const int grp = lane >> 3;
        for (int rr = 0; rr < 32; ++rr) {
            const int row = wid * 32 + rr, tok = u * 128 + row;
            const float s = sc[row * 64 + lane];
            const float bz = s + bias;
            float m1 = bz;
            m1 = fmaxf(m1, __shfl_xor(m1, 1)); m1 = fmaxf(m1, __shfl_xor(m1, 2)); m1 = fmaxf(m1, __shfl_xor(m1, 4));
            const unsigned long long eq = __ballot(bz == m1);
            const unsigned gb = (unsigned)((eq >> (grp * 8)) & 0xffull);
            const int first = __ffs(gb) - 1;
            float v2 = ((lane & 7) == first) ? -1e30f : bz;
            v2 = fmaxf(v2, __shfl_xor(v2, 1)); v2 = fmaxf(v2, __shfl_xor(v2, 2)); v2 = fmaxf(v2, __shfl_xor(v2, 4));
            const float gs = m1 + v2;
            int cnt = 0;
#pragma unroll
            for (int j = 0; j < 8; ++j) {
                const float gj = __shfl(gs, j * 8);
                cnt += (gj > gs || (gj == gs && j < grp)) ? 1 : 0;
            }
            const bool gsel = cnt < 4;
            const float mv = gsel ? bz : -1e30f;
            int rank = 0;
            for (int j = 0; j < 64; ++j) {
                const float vj = __shfl(mv, j);
                rank += (vj > mv || (vj == mv && j < lane)) ? 1 : 0;
            }
            const bool sel = gsel && rank < 8;
            const float tot = wave_sum(sel ? s : 0.f);
            if (sel) {
                p.IDX[(size_t)tok * 8 + rank] = (unsigned char)lane;
                p.WGT[(size_t)tok * 8 + rank] = s / tot * 2.5f;
            }
        }
    }
}

#define LIST_OFF 0
__device__ int build_list(const Params& p, int e, int seg, int* list  , int* wcnt  ) {
    const int tid = threadIdx.x, lane = tid & 63, wid = tid >> 6;
    if (e == 64) {
        for (int i = tid; i < 2048; i += NTHR) list[i] = (seg * 2048 + i) * 16 + 8;
        __syncthreads();
        return 2048;
    }
    int base = 0;
    for (int it = 0; it < 8; ++it) {
        const int tok = seg * 2048 + it * 256 + tid;
        const uint2 d = *(const uint2*)(p.IDX + (size_t)tok * 8);
        int k = -1;
#pragma unroll
        for (int i = 0; i < 4; ++i) {
            if (((d.x >> (8 * i)) & 0xff) == (unsigned)e) k = i;
            if (((d.y >> (8 * i)) & 0xff) == (unsigned)e) k = 4 + i;
        }
        const unsigned long long bal = __ballot(k >= 0);
        const int pre = __popcll(bal & ((1ull << lane) - 1ull));
        if (lane == 0) wcnt[wid] = __popcll(bal);
        __syncthreads();
        int off = base;
        for (int w = 0; w < wid; ++w) off += wcnt[w];
        if (k >= 0) list[off + pre] = tok * 16 + k;
        base += wcnt[0] + wcnt[1] + wcnt[2] + wcnt[3];
        __syncthreads();
    }
    return base;
}

__device__ void phase11(const Params& p) {
    const int NU = 65 * 8;
    const int lane = threadIdx.x & 63, wid = threadIdx.x >> 6, wr = wid >> 1, wc = wid & 1, fr = lane & 15, fq = lane >> 4;
    int* list = (int*)(smem + 65536);
    int* wcnt = list + 2048;
    for (int u = blockIdx.x; u < NU; u += gridDim.x) {
        const int e = u >> 3, seg = u & 7;
        __syncthreads();
        const int cnt = build_list(p, e, seg, list, wcnt);
        const int nmt = (cnt + 127) >> 7;
        const u16* Bw = p.WguT + (size_t)e * 262144;
        for (int mt = 0; mt < nmt; ++mt)
            for (int nt = 0; nt < 2; ++nt) {
                f32x4 acc[4][4];
                gemm_tile(16,
                    [&](int R, int C, int kt) {
                        int li = mt * 128 + R; li = li < cnt ? li : cnt - 1;
                        return (const void*)(p.H2 + (size_t)(list[li] >> 4) * 1024 + kt * 64 + C);
                    },
                    [&](int R, int C, int kt) { return (const void*)(Bw + (size_t)(nt * 128 + R) * 1024 + kt * 64 + C); }, acc);
#pragma unroll
                for (int m = 0; m < 4; ++m)
#pragma unroll
                    for (int j = 0; j < 4; ++j) {
                        const int li = mt * 128 + wr * 64 + m * 16 + fq * 4 + j;
                        if (li < cnt) {
                            const int ent = list[li], tok = ent >> 4, k = ent & 15;
                            const float w = (k < 8) ? p.WGT[(size_t)tok * 8 + k] : 1.f;
                            u16* dst = p.HH + ((size_t)tok * 9 + k) * 128 + nt * 64 + wc * 32 + fr;
#pragma unroll
                            for (int n2 = 0; n2 < 2; ++n2) {
                                const float gv = acc[m][2 * n2][j], uv = acc[m][2 * n2 + 1][j];
                                dst[n2 * 16] = f2bf(siluf_(gv) * uv * w);
                            }
                        }
                    }
            }
    }
}

__device__ void phase12(const Params& p) {
    const int NU = 65 * 8;
    const int lane = threadIdx.x & 63, wid = threadIdx.x >> 6, wr = wid >> 1, wc = wid & 1, fr = lane & 15, fq = lane >> 4;
    int* list = (int*)(smem + 65536);
    int* wcnt = list + 2048;
    for (int u = blockIdx.x; u < NU; u += gridDim.x) {
        const int e = u >> 3, seg = u & 7;
        __syncthreads();
        const int cnt = build_list(p, e, seg, list, wcnt);
        const int nmt = (cnt + 127) >> 7;
        const u16* Bw = p.WdT + (size_t)e * 131072;
        const float* g2 = p.mod + seg * 6144 + 5120;
        for (int mt = 0; mt < nmt; ++mt)
            for (int nt = 0; nt < 8; ++nt) {
                f32x4 acc[4][4];
                gemm_tile(2,
                    [&](int R, int C, int kt) {
                        int li = mt * 128 + R; li = li < cnt ? li : cnt - 1;
                        const int ent = list[li];
                        return (const void*)(p.HH + ((size_t)(ent >> 4) * 9 + (ent & 15)) * 128 + kt * 64 + C);
                    },
                    [&](int R, int C, int kt) { return (const void*)(Bw + (size_t)(nt * 128 + R) * 128 + kt * 64 + C); }, acc);
#pragma unroll
                for (int m = 0; m < 4; ++m)
#pragma unroll
                    for (int j = 0; j < 4; ++j) {
                        const int li = mt * 128 + wr * 64 + m * 16 + fq * 4 + j;
                        if (li < cnt) {
                            const int tok = list[li] >> 4;
#pragma unroll
                            for (int n = 0; n < 4; ++n) {
                                const int c = nt * 128 + wc * 64 + n * 16 + fr;
                                unsafeAtomicAdd(p.out + (size_t)tok * 1024 + c, g2[c] * acc[m][n][j]);
                            }
                        }
                    }
            }
    }
}

__device__ void phase13(const Params& p) {
    const int lane = threadIdx.x & 63;
    const int wv = blockIdx.x * 4 + (threadIdx.x >> 6), nwv = gridDim.x * 4;
    for (int r = wv; r < NLAT; r += nwv) {
        float* row = p.out + (size_t)r * 1024;
        float4 v[4];
        float ss = 0.f;
#pragma unroll
        for (int i = 0; i < 4; ++i) {
            v[i] = *(const float4*)(row + i * 256 + lane * 4);
            ss += v[i].x * v[i].x + v[i].y * v[i].y + v[i].z * v[i].z + v[i].w * v[i].w;
        }
        ss = wave_sum(ss);
        const float rs = rsqrtf(ss * (1.f / 1024.f) + EPS);
#pragma unroll
        for (int i = 0; i < 4; ++i) {
            const float4 g = *(const float4*)(p.norm_final + i * 256 + lane * 4);
            *(float4*)(row + i * 256 + lane * 4) = make_float4(v[i].x * rs * g.x, v[i].y * rs * g.y, v[i].z * rs * g.z, v[i].w * rs * g.w);
        }
    }
}

#define SMEM_TOTAL (65536 + 8192 + 64)

template <int PH> __device__ __forceinline__ void run_phase(const Params& p) {
    if (PH == 0) phase0(p); else if (PH == 1) phase1(p); else if (PH == 2) phase2(p); else if (PH == 3) phase3(p);
    else if (PH == 4) phase4(p); else if (PH == 5) phase5(p); else if (PH == 6) phase6(p); else if (PH == 7) phase7(p);
    else if (PH == 8) phase8(p); else if (PH == 9) phase9(p); else if (PH == 10) phase10(p); else if (PH == 11) phase11(p);
    else if (PH == 12) phase12(p); else phase13(p);
}

#if MK_MULTI
template <int PH> __global__ void __launch_bounds__(NTHR, 2) k_phase(Params p) { run_phase<PH>(p); }
#else
__global__ void __launch_bounds__(NTHR, 2) k_mega(Params p) {
    volatile LAS unsigned* st = (volatile LAS unsigned*)(smem + SMEM_TOTAL - 16);
    if (threadIdx.x == 0) { st[0] = 0u; st[1] = 0u; st[2] = 0u; st[3] = 0u; }
    __syncthreads();
    XcdBarrier bar = xcd_barrier_post(p.bar, st);
    phase0(p);  xcd_barrier(bar);
    phase1(p);  xcd_barrier(bar);
    phase2(p);  xcd_barrier(bar);
    phase3(p);  xcd_barrier(bar);
    phase4(p);  xcd_barrier(bar);
    phase5(p);  xcd_barrier(bar);
    phase6(p);  xcd_barrier(bar);
    phase7(p);  xcd_barrier(bar);
    phase8(p);  xcd_barrier(bar);
    phase9(p);  xcd_barrier(bar);
    phase10(p); xcd_barrier(bar);
    phase11(p); xcd_barrier(bar);
    phase12(p); xcd_barrier(bar);
    phase13(p);
}
#endif

static inline size_t al256(size_t v) { return (v + 255) & ~(size_t)255; }

extern "C" void kernel_launch(void* const* d_in, const int* in_sizes, int n_in,
                              void* d_out, int out_size, void* d_ws, size_t ws_size,
                              hipStream_t stream) {
    Params p{};
    const float** ip = (const float**)&p.x;
    for (int i = 0; i < 32; ++i) ip[i] = (const float*)d_in[i];
    p.out = (float*)d_out;
    char* w = (char*)d_ws;
    size_t off = 0;
    auto take = [&](size_t bytes) { char* r = w + off; off = al256(off + bytes); return r; };
    p.bar  = (unsigned*)take(XCD_BAR_WORDS * 4);
    p.mod  = (float*)take(9 * 6144 * 4);
    p.rope = (float2*)take(64 * 16 * 8);
    p.WinT = (u16*)take((size_t)1280 * 1024 * 2);
    p.WgluT = (u16*)take((size_t)512 * 512 * 2);
    p.WoutT = (u16*)take((size_t)1024 * 1024 * 2);
    p.WrT = (u16*)take((size_t)128 * 1024 * 2);
    p.WguT = (u16*)take((size_t)65 * 256 * 1024 * 2);
    p.WdT = (u16*)take((size_t)65 * 1024 * 128 * 2);
    p.TabS = (u16*)take((size_t)32 * 256 * 256 * 2);
    p.TabY = (u16*)take((size_t)32 * 256 * 512 * 2);
    p.IDX = (unsigned char*)take((size_t)NLAT * 8);
    p.WGT = (float*)take((size_t)NLAT * 8 * 4);
    char* r1 = take((size_t)NROWS * 1024 * 2);
    p.Hb = (u16*)r1; p.S = (float*)r1; p.H2 = (u16*)r1;
    char* r2 = take((size_t)NLAT * 9 * 128 * 2);
    p.Q = (u16*)r2; p.Kb = (u16*)(r2 + (size_t)NLAT * 512 * 2); p.Vt = (u16*)(r2 + (size_t)NLAT * 512 * 2 + (size_t)NROWS * 128 * 2);
    p.Y = (u16*)r2; p.SO = (u16*)(r2 + (size_t)NLAT * 512 * 2);
    p.HH = (u16*)r2;
    char* r3 = take((size_t)NLAT * 1024 * 2);
    p.U = (u16*)r3; p.CAT = (u16*)r3;
    char* r4 = take((size_t)NLAT * 512 * 2 * 2);
    p.AO = (u16*)r4; p.Hin = (u16*)(r4 + (size_t)NLAT * 512 * 2);
    if (off > ws_size) { fprintf(stderr, "workspace too small: need %zu have %zu\n", off, ws_size); return; }

#if MK_MULTI
    const int grid = 512;
#define LAUNCH(PH) do { hipFuncSetAttribute((const void*)k_phase<PH>, hipFuncAttributeMaxDynamicSharedMemorySize, SMEM_TOTAL); \
        k_phase<PH><<<grid, NTHR, SMEM_TOTAL, stream>>>(p); } while (0)
    LAUNCH(0); LAUNCH(1); LAUNCH(2); LAUNCH(3); LAUNCH(4); LAUNCH(5); LAUNCH(6); LAUNCH(7);
    LAUNCH(8); LAUNCH(9); LAUNCH(10); LAUNCH(11); LAUNCH(12); LAUNCH(13);
#else
    static int grid = 0;
    if (!grid) {
        hipFuncSetAttribute((const void*)k_mega, hipFuncAttributeMaxDynamicSharedMemorySize, SMEM_TOTAL);
        int dev = 0, cus = 0, per_cu = 0;
        hipGetDevice(&dev);
        hipDeviceGetAttribute(&cus, hipDeviceAttributeMultiprocessorCount, dev);
        hipOccupancyMaxActiveBlocksPerMultiprocessor(&per_cu, (const void*)k_mega, NTHR, SMEM_TOTAL);
        if (per_cu < 1) per_cu = 1;
        grid = cus * (per_cu < 2 ? per_cu : 2);
    }
    hipMemsetAsync(p.bar, 0, XCD_BAR_WORDS * 4, stream);
    k_mega<<<grid, NTHR, SMEM_TOTAL, stream>>>(p);
#endif
}
```

```cpp
#include <hip/hip_runtime.h>
#include <hip/hip_bf16.h>
#include <stdint.h>
#include <stdio.h>

#ifndef MK_MULTI
#define MK_MULTI 0
#endif

typedef __attribute__((ext_vector_type(8))) short bf16x8;
typedef __attribute__((ext_vector_type(4))) short bf16x4;
typedef __attribute__((ext_vector_type(4))) float f32x4;
typedef unsigned short u16;

#define NTHR 256
#define LDS_BYTES 65536

#define D_MODEL 1024
#define BATCH 8
#define SEQ 2048
#define CTXL 256
#define NLAT (BATCH * SEQ)
#define NCTX (BATCH * CTXL)
#define NROWS (NLAT + NCTX)
#define INW 1280
#define NEXP 64
#define VT_LD (SEQ + CTXL)
#define NCHUNK_LAT 1024
#define NCHUNK_ALL 1152
#define EPS 1e-6f

#define XB_TMO      128
#define XB_XCNT(j)  (256  + 64 * (j))
#define XB_XSUB(j)  (1280 + 64 * (j))
#define XB_XGEN(j)  (2304 + 64 * (j))
#define XB_TOP      3328
#define XB_TOPGEN   3392
#define XCD_BAR_WORDS 3456
#define XB_SPIN_CAP (1u << 20)
#define LAS __attribute__((address_space(3)))

__device__ __forceinline__ unsigned xb_ld(unsigned* p)              { return __hip_atomic_load(p, __ATOMIC_RELAXED, __HIP_MEMORY_SCOPE_AGENT); }
__device__ __forceinline__ unsigned xb_add(unsigned* p, unsigned v) { return __hip_atomic_fetch_add(p, v, __ATOMIC_RELAXED, __HIP_MEMORY_SCOPE_AGENT); }
__device__ __forceinline__ unsigned xb_xcc_id() { return (unsigned)__builtin_amdgcn_s_getreg((3 << 11) | 20) & 0xFu; }
#define XB_SPIN(cond, bar) do { unsigned _sp = 0; while (cond) { __builtin_amdgcn_s_sleep(1); \
    if ((++_sp & 255u) == 0u) { if (xb_ld(&(bar)[XB_TMO])) break; if (_sp > XB_SPIN_CAP) { atomicAdd(&(bar)[XB_TMO], 1u); break; } } } } while (0)

struct XcdBarrier { unsigned* bar; unsigned x; volatile LAS unsigned* st; };

__device__ __forceinline__ XcdBarrier xcd_barrier_post(unsigned* bar, volatile LAS unsigned* st) {
    XcdBarrier b; b.bar = bar; b.x = xb_xcc_id(); b.st = st;
    if (threadIdx.x == 0) (void)xb_add(&bar[XB_XCNT(b.x)], 1u);
    return b;
}
__device__ __forceinline__ void xcd_barrier_complete(unsigned* bar, unsigned x, unsigned& nloc, unsigned& nx) {
    const unsigned G = gridDim.x * gridDim.y * gridDim.z;
    unsigned sum, cnt, mine, sp = 0u;
    for (;;) {
        sum = 0u; cnt = 0u; mine = 0u;
#pragma unroll
        for (unsigned j = 0; j < 16; ++j) { const unsigned c = xb_ld(&bar[XB_XCNT(j)]); sum += c; cnt += (c > 0u) ? 1u : 0u; mine = (j == x) ? c : mine; }
        if (sum == G) break;
        __builtin_amdgcn_s_sleep(1);
        if ((++sp & 255u) == 0u) { if (xb_ld(&bar[XB_TMO])) break; if (sp > XB_SPIN_CAP) { atomicAdd(&bar[XB_TMO], 1u); break; } }
    }
    nloc = mine > 0u ? mine : 1u; nx = cnt > 0u ? cnt : 1u;
}
__device__ __forceinline__ void xcd_barrier(const XcdBarrier& b) {
    asm volatile("s_waitcnt vmcnt(0)" ::: "memory");
    __syncthreads();
    if (threadIdx.x == 0) {
        unsigned* bar = b.bar;
        __builtin_amdgcn_s_waitcnt(0);
        unsigned nloc = b.st[0], nx = b.st[1];
        if (nloc == 0u) { xcd_barrier_complete(bar, b.x, nloc, nx); b.st[0] = nloc; b.st[1] = nx; }
        const unsigned old = xb_add(&bar[XB_XSUB(b.x)], 1u);
        const unsigned gen = old / nloc;
        if (old + 1u == (gen + 1u) * nloc) {
            __builtin_amdgcn_fence(__ATOMIC_RELEASE, "agent");
            asm volatile("s_waitcnt vmcnt(0)" ::: "memory");
            const unsigned og = xb_add(&bar[XB_TOP], 1u);
            const unsigned tg = og / nx;
            if (og + 1u == (tg + 1u) * nx) xb_add(&bar[XB_TOPGEN], 1u);
            else XB_SPIN(xb_ld(&bar[XB_TOPGEN]) == tg, bar);
            __builtin_amdgcn_fence(__ATOMIC_ACQUIRE, "agent");
            xb_add(&bar[XB_XGEN(b.x)], 1u);
            asm volatile("s_waitcnt vmcnt(0)" ::: "memory");
        } else {
            XB_SPIN(xb_ld(&bar[XB_XGEN(b.x)]) == gen, bar);
            __builtin_amdgcn_fence(__ATOMIC_ACQUIRE, "agent");
            asm volatile("s_waitcnt vmcnt(0)" ::: "memory");
        }
    }
    __syncthreads();
}

struct Params {
    const float *x, *c, *ctx, *c_ctx, *w_ada, *b_ada, *norm_mix, *norm_ffn, *w_in, *attn_sink,
        *a_re, *a_im, *log_dt, *b_re, *b_im, *c_re, *c_im, *ssm_d, *w_glu, *b_glu, *norm_attn_out, *norm_ssm_out,
        *w_out, *w_router, *router_bias, *w_gate_e, *w_up_e, *w_down_e, *w_gate_s, *w_up_s, *w_down_s, *norm_final;
    float* out;
    unsigned* bar;
    float* mod;
    float2* rope;
    u16 *WinT, *WgluT, *WoutT, *WrT, *WguT, *WdT, *TabS, *TabY;
    u16 *Hb, *Q, *Kb, *Vt, *U, *AO, *Hin, *Y, *SO, *CAT, *H2, *HH;
    float* S;
    unsigned char* IDX;
    float* WGT;
};

extern __shared__ __attribute__((aligned(16))) char smem[];

__device__ __forceinline__ u16 f2bf(float f) {
    unsigned u = __float_as_uint(f);
    u += 0x7fffu + ((u >> 16) & 1u);
    return (u16)(u >> 16);
}
__device__ __forceinline__ float bf2f(u16 h) { return __uint_as_float(((unsigned)h) << 16); }
__device__ __forceinline__ unsigned pack2(float a, float b) { return (unsigned)f2bf(a) | ((unsigned)f2bf(b) << 16); }
__device__ __forceinline__ void glds16(const void* g, void* l) {
    __builtin_amdgcn_global_load_lds((const unsigned*)g, (unsigned*)l, 16, 0, 0);
}
__device__ __forceinline__ int lds_byte(int r, int c) {
    int st = (r >> 4) * 2 + (c >> 5), rr = r & 15, cc = c & 31, ob = rr * 64 + cc * 2;
    return st * 1024 + (ob ^ (((ob >> 9) & 1) << 5));
}
__device__ __forceinline__ float wave_sum(float v) {
#pragma unroll
    for (int o = 32; o > 0; o >>= 1) v += __shfl_xor(v, o);
    return v;
}
__device__ __forceinline__ float sigmoidf_(float x) { return 1.f / (1.f + __expf(-x)); }
__device__ __forceinline__ float siluf_(float x) { return x / (1.f + __expf(-x)); }
__device__ __forceinline__ float gelu_tanh(float x) {
    float u = 0.7978845608028654f * (x + 0.044715f * x * x * x);
    return x / (1.f + __expf(-2.f * u));
}

template <class FA, class FB>
__device__ __forceinline__ void gemm_tile(int nkt, FA fa, FB fb, f32x4 (&acc)[4][4]) {
    const int tid = threadIdx.x, lane = tid & 63, wid = tid >> 6, wr = wid >> 1, wc = wid & 1, fr = lane & 15, fq = lane >> 4;
    const int sb = lane * 16, swz = sb ^ (((sb >> 9) & 1) << 5);
    const int r_in = swz >> 6, c_in = (swz & 63) >> 1;
#pragma unroll
    for (int m = 0; m < 4; ++m)
#pragma unroll
        for (int n = 0; n < 4; ++n) acc[m][n] = (f32x4){0.f, 0.f, 0.f, 0.f};
    __syncthreads();
    auto stage = [&](int kt, int s) {
        char* sa = smem + s * 32768;
        char* sbm = sa + 16384;
#pragma unroll
        for (int i = 0; i < 4; ++i) {
            const int st = wid + 4 * i, R = (st >> 1) * 16 + r_in, C = (st & 1) * 32 + c_in;
            glds16(fa(R, C, kt), sa + tid * 16 + i * 4096);
            glds16(fb(R, C, kt), sbm + tid * 16 + i * 4096);
        }
    };
    stage(0, 0);
    for (int kt = 0; kt < nkt; ++kt) {
        asm volatile("s_waitcnt vmcnt(0)" ::: "memory");
        __syncthreads();
        if (kt + 1 < nkt) stage(kt + 1, (kt + 1) & 1);
        const char* sa = smem + (kt & 1) * 32768;
        const char* sbm = sa + 16384;
#pragma unroll
        for (int ks = 0; ks < 2; ++ks) {
            bf16x8 a[4], b[4];
#pragma unroll
            for (int m = 0; m < 4; ++m) a[m] = *(const bf16x8*)(sa + lds_byte(wr * 64 + m * 16 + fr, ks * 32 + fq * 8));
#pragma unroll
            for (int n = 0; n < 4; ++n) b[n] = *(const bf16x8*)(sbm + lds_byte(wc * 64 + n * 16 + fr, ks * 32 + fq * 8));
#pragma unroll
            for (int m = 0; m < 4; ++m)
#pragma unroll
                for (int n = 0; n < 4; ++n) acc[m][n] = __builtin_amdgcn_mfma_f32_16x16x32_bf16(a[m], b[n], acc[m][n], 0, 0, 0);
        }
    }
    __syncthreads();
}

template <class FD>
__device__ __forceinline__ void wave_store_bf16(const float (&v)[4][4][4], FD dst) {
    const int lane = threadIdx.x & 63, wid = threadIdx.x >> 6, fr = lane & 15, fq = lane >> 4;
    char* base = smem + wid * 9216;
#pragma unroll
    for (int m = 0; m < 4; ++m)
#pragma unroll
        for (int n = 0; n < 4; ++n)
#pragma unroll
            for (int j = 0; j < 4; ++j)
                *(u16*)(base + (m * 16 + fq * 4 + j) * 144 + (n * 16 + fr) * 2) = f2bf(v[m][n][j]);
    asm volatile("s_waitcnt lgkmcnt(0)" ::: "memory");
    __builtin_amdgcn_wave_barrier();
#pragma unroll
    for (int i = 0; i < 8; ++i) {
        const int id = i * 64 + lane, row = id >> 3, ch = id & 7;
        const uint4 d = *(const uint4*)(base + row * 144 + ch * 16);
        u16* p = dst(row);
        if (p) *(uint4*)(p + ch * 8) = d;
    }
    asm volatile("s_waitcnt lgkmcnt(0)" ::: "memory");
    __builtin_amdgcn_wave_barrier();
}

__device__ void conv_tile(const float* src, int ld, int k0, int n0, u16* dst, int ldd, int mode) {
    float* t = (float*)smem;
    const int tid = threadIdx.x;
    __syncthreads();
#pragma unroll
    for (int i = 0; i < 16; ++i) {
        const int r = i * 4 + (tid >> 6), cidx = tid & 63;
        t[r * 65 + cidx] = src[(size_t)(k0 + r) * ld + n0 + cidx];
    }
    __syncthreads();
    const int n = tid >> 2, kq = tid & 3;
    unsigned w[8];
#pragma unroll
    for (int i = 0; i < 8; ++i) w[i] = pack2(t[(kq * 16 + 2 * i) * 65 + n], t[(kq * 16 + 2 * i + 1) * 65 + n]);
    const int gn = n0 + n;
    int row = gn;
    if (mode == 1) row = (gn >> 4) * 32 + (gn & 15);
    else if (mode == 2) row = (gn >> 4) * 32 + 16 + (gn & 15);
    uint4* d = (uint4*)(dst + (size_t)row * ldd + k0 + kq * 16);
    d[0] = make_uint4(w[0], w[1], w[2], w[3]);
    d[1] = make_uint4(w[4], w[5], w[6], w[7]);
}

__device__ void ada_item(const Params& p, int item) {
    float* sc = (float*)smem;
    float* red = sc + 9 * 1024;
    const int tid = threadIdx.x;
    __syncthreads();
    for (int i = tid; i < 9 * 1024; i += NTHR) {
        const int r = i >> 10, k = i & 1023;
        const float cv = (r < 8) ? p.c[r * 1024 + k] : p.c_ctx[k];
        sc[i] = siluf_(cv);
    }
    __syncthreads();
    const int kq = tid >> 6, jl = tid & 63, j = item * 64 + jl;
    float acc[9];
#pragma unroll
    for (int r = 0; r < 9; ++r) acc[r] = 0.f;
#pragma unroll 8
    for (int k = kq; k < 1024; k += 4) {
        const float w = p.w_ada[(size_t)k * 6144 + j];
#pragma unroll
        for (int r = 0; r < 9; ++r) acc[r] += sc[r * 1024 + k] * w;
    }
#pragma unroll
    for (int r = 0; r < 9; ++r) red[(kq * 9 + r) * 64 + jl] = acc[r];
    __syncthreads();
    for (int i = tid; i < 9 * 64; i += NTHR) {
        const int r = i >> 6, l = i & 63;
        const float s = red[(0 * 9 + r) * 64 + l] + red[(1 * 9 + r) * 64 + l] + red[(2 * 9 + r) * 64 + l] + red[(3 * 9 + r) * 64 + l];
        p.mod[r * 6144 + item * 64 + l] = s + p.b_ada[item * 64 + l];
    }
}

__device__ void rope_item(const Params& p) {
    for (int i = threadIdx.x; i < 64 * 16; i += NTHR) {
        const int pos = i >> 4, k = i & 15;
        const float inv = exp2f(-(float)k * (13.287712379549449f / 16.f));
        float s, c;
        sincosf((float)pos * inv, &s, &c);
        p.rope[i] = make_float2(c, s);
    }
}

__device__ void ssm_table_item(const Params& p, int g) {
    float* pw = (float*)smem;
    float* Bb = pw + 17 * 64 * 2;
    float* Cc = Bb + 64 * 16 * 2;
    float* Kf = Cc + 16 * 64 * 2;
    const int tid = threadIdx.x;
    u16* tabS = p.TabS + (size_t)g * 256 * 256;
    u16* tabY = p.TabY + (size_t)g * 256 * 512;
    __syncthreads();
    for (int dir = 0; dir < 2; ++dir) {
        const int pidx = dir * 32 + g;
        const float dt = __expf(p.log_dt[pidx]);
        for (int i = tid; i < 17 * 64; i += NTHR) {
            const int tau = i >> 6, n = i & 63;
            const float are = p.a_re[pidx * 64 + n], aim = p.a_im[pidx * 64 + n];
            const float mag = __expf((float)tau * dt * are);
            float rev = (float)tau * (dt * aim * 0.15915494309189535f);
            rev -= rintf(rev);
            pw[i * 2] = mag * __builtin_amdgcn_cosf(rev);
            pw[i * 2 + 1] = mag * __builtin_amdgcn_sinf(rev);
        }
        __syncthreads();
        for (int i = tid; i < 64 * 16; i += NTHR) {
            const int n = i >> 4;
            const float are = p.a_re[pidx * 64 + n], aim = p.a_im[pidx * 64 + n];
            const float abr = pw[(64 + n) * 2], abi = pw[(64 + n) * 2 + 1];
            const float den = are * are + aim * aim, nre = abr - 1.f;
            const float cre = (nre * are + abi * aim) / den, cim = (abi * are - nre * aim) / den;
            const float br = p.b_re[(size_t)pidx * 1024 + i], bi = p.b_im[(size_t)pidx * 1024 + i];
            Bb[i * 2] = cre * br - cim * bi;
            Bb[i * 2 + 1] = cre * bi + cim * br;
            Cc[i * 2] = p.c_re[(size_t)pidx * 1024 + i];
            Cc[i * 2 + 1] = p.c_im[(size_t)pidx * 1024 + i];
        }
        __syncthreads();
        {
            const int tau = tid >> 4, pp = tid & 15;
            float s[16];
#pragma unroll
            for (int q = 0; q < 16; ++q) s[q] = 0.f;
            for (int n = 0; n < 64; ++n) {
                const float2 cv = *(const float2*)&Cc[(pp * 64 + n) * 2];
                const float2 wv = *(const float2*)&pw[(tau * 64 + n) * 2];
                const float zr = cv.x * wv.x - cv.y * wv.y, zi = cv.x * wv.y + cv.y * wv.x;
#pragma unroll
                for (int q = 0; q < 16; ++q) {
                    const float2 bv = *(const float2*)&Bb[(n * 16 + q) * 2];
                    s[q] += zr * bv.x - zi * bv.y;
                }
            }
#pragma unroll
            for (int q = 0; q < 16; ++q) Kf[dir * 4096 + tau * 256 + pp * 16 + q] = s[q];
        }
        for (int id = tid; id < 128 * 32; id += NTHR) {
            const int rr = id >> 5, ch = id & 31, cpart = rr >> 6, n = rr & 63, s_ = ch >> 1, q0 = (ch & 1) * 8;
            const int e = dir == 0 ? 15 - s_ : s_;
            const float wr_ = pw[(e * 64 + n) * 2], wi_ = pw[(e * 64 + n) * 2 + 1];
            unsigned w[4];
#pragma unroll
            for (int i = 0; i < 4; ++i) {
                float v[2];
#pragma unroll
                for (int h = 0; h < 2; ++h) {
                    const float br = Bb[(n * 16 + q0 + 2 * i + h) * 2], bi = Bb[(n * 16 + q0 + 2 * i + h) * 2 + 1];
                    v[h] = cpart == 0 ? (wr_ * br - wi_ * bi) : (wr_ * bi + wi_ * br);
                }
                w[i] = pack2(v[0], v[1]);
            }
            *(uint4*)(tabS + (size_t)(dir * 128 + rr) * 256 + s_ * 16 + q0) = make_uint4(w[0], w[1], w[2], w[3]);
        }
        for (int id = tid; id < 256 * 16; id += NTHR) {
            const int m = id >> 4, ch = id & 15, t = m >> 4, pp = m & 15, cpart = ch >> 3, n0 = (ch & 7) * 8;
            const int e = dir == 0 ? t + 1 : 16 - t;
            unsigned w[4];
#pragma unroll
            for (int i = 0; i < 4; ++i) {
                float v[2];
#pragma unroll
                for (int h = 0; h < 2; ++h) {
                    const int n = n0 + 2 * i + h;
                    const float cr = Cc[(pp * 64 + n) * 2], ci = Cc[(pp * 64 + n) * 2 + 1];
                    const float wr_ = pw[(e * 64 + n) * 2], wi_ = pw[(e * 64 + n) * 2 + 1];
                    v[h] = cpart == 0 ? (cr * wr_ - ci * wi_) : -(cr * wi_ + ci * wr_);
                }
                w[i] = pack2(v[0], v[1]);
            }
            *(uint4*)(tabY + (size_t)m * 512 + 256 + dir * 128 + cpart * 64 + n0) = make_uint4(w[0], w[1], w[2], w[3]);
        }
        __syncthreads();
    }
    for (int id = tid; id < 256 * 32; id += NTHR) {
        const int m = id >> 5, ch = id & 31, t = m >> 4, pp = m & 15, s_ = ch >> 1, q0 = (ch & 1) * 8;
        unsigned w[4];
#pragma unroll
        for (int i = 0; i < 4; ++i) {
            float v[2];
#pragma unroll
            for (int h = 0; h < 2; ++h) {
                const int q = q0 + 2 * i + h;
                float val;
                if (s_ < t) val = Kf[((t - s_) * 16 + pp) * 16 + q];
                else if (s_ > t) val = Kf[4096 + ((s_ - t) * 16 + pp) * 16 + q];
                else val = Kf[(pp) * 16 + q] + Kf[4096 + pp * 16 + q] + (pp == q ? p.ssm_d[g * 16 + pp] : 0.f);
                v[h] = val;
            }
            w[i] = pack2(v[0], v[1]);
        }
        *(uint4*)(tabY + (size_t)m * 512 + s_ * 16 + q0) = make_uint4(w[0], w[1], w[2], w[3]);
    }
}

#define N_CONV 6896
__device__ void conv_item(const Params& p, int t) {
    if (t < 320) { conv_tile(p.w_in, 1280, (t / 20) * 64, (t % 20) * 64, p.WinT, 1024, 0); return; }
    t -= 320;
    if (t < 64) { conv_tile(p.w_glu, 512, (t / 8) * 64, (t % 8) * 64, p.WgluT, 512, 0); return; }
    t -= 64;
    if (t < 256) { conv_tile(p.w_out, 1024, (t / 16) * 64, (t % 16) * 64, p.WoutT, 1024, 0); return; }
    t -= 256;
    if (t < 16) {
        conv_tile(p.w_router, 64, t * 64, 0, p.WrT, 1024, 0);
        const int r = threadIdx.x >> 2, q = threadIdx.x & 3;
        uint4* d = (uint4*)(p.WrT + (size_t)(64 + r) * 1024 + t * 64 + q * 16);
        d[0] = make_uint4(0, 0, 0, 0); d[1] = make_uint4(0, 0, 0, 0);
        return;
    }
    t -= 16;
    if (t < 2048) { const int e = t >> 5, r = t & 31; conv_tile(p.w_gate_e + (size_t)e * 131072, 128, (r >> 1) * 64, (r & 1) * 64, p.WguT + (size_t)e * 262144, 1024, 1); return; }
    t -= 2048;
    if (t < 2048) { const int e = t >> 5, r = t & 31; conv_tile(p.w_up_e + (size_t)e * 131072, 128, (r >> 1) * 64, (r & 1) * 64, p.WguT + (size_t)e * 262144, 1024, 2); return; }
    t -= 2048;
    if (t < 32) { conv_tile(p.w_gate_s, 128, (t >> 1) * 64, (t & 1) * 64, p.WguT + (size_t)64 * 262144, 1024, 1); return; }
    t -= 32;
    if (t < 32) { conv_tile(p.w_up_s, 128, (t >> 1) * 64, (t & 1) * 64, p.WguT + (size_t)64 * 262144, 1024, 2); return; }
    t -= 32;
    if (t < 2048) { const int e = t >> 5, r = t & 31; conv_tile(p.w_down_e + (size_t)e * 131072, 1024, (r >> 4) * 64, (r & 15) * 64, p.WdT + (size_t)e * 131072, 128, 0); return; }
    t -= 2048;
    conv_tile(p.w_down_s, 1024, (t >> 4) * 64, (t & 15) * 64, p.WdT + (size_t)64 * 131072, 128, 0);
}

__device__ void phase0(const Params& p) {
    const int NU = 32 + 96 + 1 + N_CONV;
    for (int u = blockIdx.x; u < NU; u += gridDim.x) {
        if (u < 32) ssm_table_item(p, u);
        else if (u < 128) ada_item(p, u - 32);
        else if (u == 128) rope_item(p);
        else conv_item(p, u - 129);
    }
}

__device__ __forceinline__ void norm_mod_row(const float* src, const float* gain, const float* sh, const float* scl, u16* dst) {
    const int lane = threadIdx.x & 63;
    float4 v[4];
    float ss = 0.f;
#pragma unroll
    for (int i = 0; i < 4; ++i) {
        v[i] = *(const float4*)(src + i * 256 + lane * 4);
        ss += v[i].x * v[i].x + v[i].y * v[i].y + v[i].z * v[i].z + v[i].w * v[i].w;
    }
    ss = wave_sum(ss);
    const float rs = rsqrtf(ss * (1.f / 1024.f) + EPS);
#pragma unroll
    for (int i = 0; i < 4; ++i) {
        const int c0 = i * 256 + lane * 4;
        const float4 g = *(const float4*)(gain + c0), s = *(const float4*)(sh + c0), k = *(const float4*)(scl + c0);
        const float a = v[i].x * rs * g.x * (1.f + k.x) + s.x, b = v[i].y * rs * g.y * (1.f + k.y) + s.y;
        const float c = v[i].z * rs * g.z * (1.f + k.z) + s.z, d = v[i].w * rs * g.w * (1.f + k.w) + s.w;
        *(uint2*)(dst + c0) = make_uint2(pack2(a, b), pack2(c, d));
    }
}

__device__ void phase1(const Params& p) {
    const int wv = blockIdx.x * 4 + (threadIdx.x >> 6), nwv = gridDim.x * 4;
    for (int r = wv; r < NROWS; r += nwv) {
        const float* src; const float* md;
        if (r < NLAT) { src = p.x + (size_t)r * 1024; md = p.mod + (r >> 11) * 6144; }
        else { src = p.ctx + (size_t)(r - NLAT) * 1024; md = p.mod + 8 * 6144; }
        norm_mod_row(src, p.norm_mix, md, md + 1024, p.Hb + (size_t)r * 1024);
    }
}

__device__ void phase2(const Params& p) {
    const int NU = 128 * 10 + 16 * 6;
    const int lane = threadIdx.x & 63, wid = threadIdx.x >> 6, wr = wid >> 1, wc = wid & 1, fr = lane & 15, fq = lane >> 4;
    for (int u = blockIdx.x; u < NU; u += gridDim.x) {
        int mt, nt;
        if (u < 1280) { mt = u / 10; nt = u % 10; } else { const int v = u - 1280; mt = 128 + v / 6; nt = 4 + v % 6; }
        const u16* A = p.Hb + (size_t)mt * 128 * 1024;
        const u16* B = p.WinT + (size_t)nt * 128 * 1024;
        f32x4 acc[4][4];
        gemm_tile(16,
            [&](int R, int C, int kt) { return (const void*)(A + (size_t)R * 1024 + kt * 64 + C); },
            [&](int R, int C, int kt) { return (const void*)(B + (size_t)R * 1024 + kt * 64 + C); }, acc);
        const int row0 = mt * 128 + wr * 64;
        const int col0 = nt * 128 + wc * 64;
        const bool is_lat = mt < 128;
        if (nt == 5) {
            const int kvh = wc;
#pragma unroll
            for (int m = 0; m < 4; ++m) {
                const int r = row0 + m * 16 + fq * 4;
                int b, pos;
                if (is_lat) { b = r >> 11; pos = r & 2047; } else { const int rc = r - NLAT; b = rc >> 8; pos = SEQ + (rc & 255); }
#pragma unroll
                for (int n = 0; n < 4; ++n) {
                    const int d = n * 16 + fr;
                    u16* dst = p.Vt + ((size_t)(b * 2 + kvh) * 64 + d) * VT_LD + pos;
                    *(uint2*)dst = make_uint2(pack2(acc[m][n][0], acc[m][n][1]), pack2(acc[m][n][2], acc[m][n][3]));
                }
            }
        } else {
            float v[4][4][4];
            const bool do_rope = is_lat && nt <= 4;
#pragma unroll
            for (int m = 0; m < 4; ++m)
#pragma unroll
                for (int j = 0; j < 4; ++j) {
                    if (do_rope) {
                        const int r = row0 + m * 16 + fq * 4 + j, pos = r & 2047;
                        const float2 cr = p.rope[(pos >> 6) * 16 + fr], cc = p.rope[(pos & 63) * 16 + fr];
                        const float x1 = acc[m][0][j], x2 = acc[m][1][j], y1 = acc[m][2][j], y2 = acc[m][3][j];
                        v[m][0][j] = x1 * cr.x - x2 * cr.y; v[m][1][j] = x1 * cr.y + x2 * cr.x;
                        v[m][2][j] = y1 * cc.x - y2 * cc.y; v[m][3][j] = y1 * cc.y + y2 * cc.x;
                    } else {
#pragma unroll
                        for (int n = 0; n < 4; ++n) v[m][n][j] = acc[m][n][j];
                    }
                }
            u16* dbase; int ldd;
            if (nt < 4) { dbase = p.Q + (size_t)row0 * 512 + col0; ldd = 512; }
            else if (nt == 4) { dbase = p.Kb + (size_t)row0 * 128 + (col0 - 512); ldd = 128; }
            else { dbase = p.U + (size_t)row0 * 512 + (col0 - 768); ldd = 512; }
            wave_store_bf16(v, [&](int row) { return dbase + (size_t)row * ldd; });
        }
    }
}

__device__ void attn_unit(const Params& p, int u) {
    const int h = u & 7, qb = (u >> 3) & 15, b = u >> 7, kvh = h >> 2;
    const int tid = threadIdx.x, lane = tid & 63, wid = tid >> 6, fr = lane & 15, fq = lane >> 4;
    const int sb = lane * 16, swz = sb ^ (((sb >> 9) & 1) << 5);
    const int r_in = swz >> 6, c_in = (swz & 63) >> 1;
    const int jstart = qb == 0 ? 2 : 0, jend = qb == 15 ? 4 : 6, nb = jend - jstart, ntile = nb + 4;
    const float SC = 0.125f * 1.4426950408889634f;
    bf16x8 qf[2][2];
    const int qrow0 = b * SEQ + qb * 128 + wid * 32;
#pragma unroll
    for (int qt = 0; qt < 2; ++qt)
#pragma unroll
        for (int ks = 0; ks < 2; ++ks)
            qf[qt][ks] = *(const bf16x8*)(p.Q + (size_t)(qrow0 + qt * 16 + fr) * 512 + h * 64 + ks * 32 + fq * 8);
    f32x4 o[4][2];
#pragma unroll
    for (int dt = 0; dt < 4; ++dt)
#pragma unroll
        for (int qt = 0; qt < 2; ++qt) o[dt][qt] = (f32x4){0.f, 0.f, 0.f, 0.f};
    float mrun[2], lrun[2];
    const float sinkv = p.attn_sink[h] * 1.4426950408889634f;
    mrun[0] = mrun[1] = sinkv;
    lrun[0] = lrun[1] = (fq == 0) ? 1.f : 0.f;
    __syncthreads();
    auto stage = [&](int i, int s) {
        const u16* kbase; const u16* vbase;
        if (i < nb) {
            const int ks0 = qb * 128 - 128 + 64 * (jstart + i);
            kbase = p.Kb + (size_t)(b * SEQ + ks0) * 128 + kvh * 64;
            vbase = p.Vt + (size_t)(b * 2 + kvh) * 64 * VT_LD + ks0;
        } else {
            const int c0 = 64 * (i - nb);
            kbase = p.Kb + (size_t)(NLAT + b * CTXL + c0) * 128 + kvh * 64;
            vbase = p.Vt + (size_t)(b * 2 + kvh) * 64 * VT_LD + SEQ + c0;
        }
        char* sk = smem + s * 16384;
        char* sv = sk + 8192;
#pragma unroll
        for (int it = 0; it < 2; ++it) {
            const int st = wid + 4 * it, R = (st >> 1) * 16 + r_in, C = (st & 1) * 32 + c_in;
            glds16(kbase + (size_t)R * 128 + C, sk + tid * 16 + it * 4096);
            glds16(vbase + (size_t)R * VT_LD + C, sv + tid * 16 + it * 4096);
        }
    };
    stage(0, 0);
    for (int i = 0; i < ntile; ++i) {
        asm volatile("s_waitcnt vmcnt(0)" ::: "memory");
        __syncthreads();
        if (i + 1 < ntile) stage(i + 1, (i + 1) & 1);
        const char* sk = smem + (i & 1) * 16384;
        const char* sv = sk + 8192;
        f32x4 s[4][2];
#pragma unroll
        for (int kt = 0; kt < 4; ++kt)
#pragma unroll
            for (int qt = 0; qt < 2; ++qt) s[kt][qt] = (f32x4){0.f, 0.f, 0.f, 0.f};
#pragma unroll
        for (int ks = 0; ks < 2; ++ks)
#pragma unroll
            for (int kt = 0; kt < 4; ++kt) {
                const bf16x8 kf = *(const bf16x8*)(sk + lds_byte(kt * 16 + fr, ks * 32 + fq * 8));
#pragma unroll
                for (int qt = 0; qt < 2; ++qt) s[kt][qt] = __builtin_amdgcn_mfma_f32_16x16x32_bf16(kf, qf[qt][ks], s[kt][qt], 0, 0, 0);
            }
        const bool band = i < nb;
        const int ks0 = qb * 128 - 128 + 64 * (jstart + i);
        bf16x8 pf[2][2];
#pragma unroll
        for (int qt = 0; qt < 2; ++qt) {
            const int qp = qb * 128 + wid * 32 + qt * 16 + fr;
            float mx = -1e30f;
#pragma unroll
            for (int kt = 0; kt < 4; ++kt)
#pragma unroll
                for (int j = 0; j < 4; ++j) {
                    float v = s[kt][qt][j] * SC;
                    if (band) {
                        const int kp = ks0 + kt * 16 + fq * 4 + j, d = qp - kp;
                        if (d > 128 || d < -128) v = -1e30f;
                    }
                    s[kt][qt][j] = v;
                    mx = fmaxf(mx, v);
                }
            mx = fmaxf(mx, __shfl_xor(mx, 16));
            mx = fmaxf(mx, __shfl_xor(mx, 32));
            const float mnew = fmaxf(mrun[qt], mx);
            const float alpha = __builtin_amdgcn_exp2f(mrun[qt] - mnew);
            mrun[qt] = mnew;
            float ls = 0.f;
#pragma unroll
            for (int kt = 0; kt < 4; ++kt)
#pragma unroll
                for (int j = 0; j < 4; ++j) {
                    const float pv = __builtin_amdgcn_exp2f(s[kt][qt][j] - mnew);
                    s[kt][qt][j] = pv;
                    ls += pv;
                }
            lrun[qt] = lrun[qt] * alpha + ls;
#pragma unroll
            for (int dt = 0; dt < 4; ++dt) o[dt][qt] *= alpha;
#pragma unroll
            for (int k2 = 0; k2 < 2; ++k2) {
                bf16x8 t;
#pragma unroll
                for (int j = 0; j < 4; ++j) { t[j] = (short)f2bf(s[2 * k2][qt][j]); t[4 + j] = (short)f2bf(s[2 * k2 + 1][qt][j]); }
                pf[qt][k2] = t;
            }
        }
#pragma unroll
        for (int k2 = 0; k2 < 2; ++k2)
#pragma unroll
            for (int dt = 0; dt < 4; ++dt) {
                const uint2 lo = *(const uint2*)(sv + lds_byte(dt * 16 + fr, k2 * 32 + fq * 4));
                const uint2 hi = *(const uint2*)(sv + lds_byte(dt * 16 + fr, k2 * 32 + 16 + fq * 4));
                union { uint4 u; bf16x8 v; } cv; cv.u = make_uint4(lo.x, lo.y, hi.x, hi.y);
#pragma unroll
                for (int qt = 0; qt < 2; ++qt) o[dt][qt] = __builtin_amdgcn_mfma_f32_16x16x32_bf16(cv.v, pf[qt][k2], o[dt][qt], 0, 0, 0);
            }
    }
#pragma unroll
    for (int qt = 0; qt < 2; ++qt) {
        float l = lrun[qt];
        l += __shfl_xor(l, 16);
        l += __shfl_xor(l, 32);
        const float inv = 1.f / l;
        u16* dst = p.AO + (size_t)(qrow0 + qt * 16 + fr) * 512 + h * 64 + fq * 4;
#pragma unroll
        for (int dt = 0; dt < 4; ++dt)
            *(uint2*)(dst + dt * 16) = make_uint2(pack2(o[dt][qt][0] * inv, o[dt][qt][1] * inv), pack2(o[dt][qt][2] * inv, o[dt][qt][3] * inv));
    }
}

__device__ void ssm_s1_unit(const Params& p, int u) {
    const int ct = u % 9, mh = (u / 9) & 1, g = u / 18;
    const int lane = threadIdx.x & 63, wid = threadIdx.x >> 6, wr = wid >> 1, wc = wid & 1, fr = lane & 15, fq = lane >> 4;
    const u16* A = p.TabS + ((size_t)g * 256 + mh * 128) * 256;
    const u16* Ub = p.U + (size_t)ct * 128 * 16 * 512 + g * 16;
    f32x4 acc[4][4];
    gemm_tile(4,
        [&](int R, int C, int kt) { return (const void*)(A + (size_t)R * 256 + kt * 64 + C); },
        [&](int R, int C, int kt) { return (const void*)(Ub + (size_t)(R * 16 + kt * 4 + (C >> 4)) * 512 + (C & 15)); }, acc);
#pragma unroll
    for (int m = 0; m < 4; ++m)
#pragma unroll
        for (int n = 0; n < 4; ++n) {
            const int rho = mh * 128 + wr * 64 + m * 16 + fq * 4;
            const int cg = ct * 128 + wc * 64 + n * 16 + fr;
            *(f32x4*)(p.S + ((size_t)cg * 32 + g) * 256 + rho) = acc[m][n];
        }
}

__device__ void phase3(const Params& p) {
    const int NU = 1024 + 576;
    for (int u = blockIdx.x; u < NU; u += gridDim.x) {
        if (u < 1024) attn_unit(p, u); else ssm_s1_unit(p, u - 1024);
    }
}

__device__ void phase4(const Params& p) {
    const int gid = blockIdx.x * NTHR + threadIdx.x;
    if (gid >= BATCH * 2 * 32 * 64) return;
    const int n = gid & 63, g = (gid >> 6) & 31, dir = (gid >> 11) & 1, b = gid >> 12;
    const int pidx = dir * 32 + g;
    const float dt = __expf(p.log_dt[pidx]);
    const float are = p.a_re[pidx * 64 + n], aim = p.a_im[pidx * 64 + n];
    const float mag = __expf(16.f * dt * are);
    float rev = 16.f * (dt * aim * 0.15915494309189535f);
    rev -= rintf(rev);
    const float ar = mag * __builtin_amdgcn_cosf(rev), ai = mag * __builtin_amdgcn_sinf(rev);
    float hr = 0.f, hi = 0.f;
    const size_t so = (size_t)g * 256 + dir * 128 + n;
#pragma unroll 8
    for (int i = 0; i < 16; ++i) {
        const int c = dir == 0 ? i : 15 - i;
        const float* sp = p.S + (size_t)(NCHUNK_LAT + b * 16 + c) * 8192 + so;
        const float sr = sp[0], si = sp[64];
        const float nr = ar * hr - ai * hi + sr, ni = ar * hi + ai * hr + si;
        hr = nr; hi = ni;
    }
#pragma unroll 8
    for (int i = 0; i < 128; ++i) {
        const int c = dir == 0 ? i : 127 - i;
        const size_t cg = (size_t)b * 128 + c;
        const float* sp = p.S + cg * 8192 + so;
        const float sr = sp[0], si = sp[64];
        u16* hp = p.Hin + cg * 8192 + so;
        hp[0] = f2bf(hr); hp[64] = f2bf(hi);
        const float nr = ar * hr - ai * hi + sr, ni = ar * hi + ai * hr + si;
        hr = nr; hi = ni;
    }
}

__device__ void phase5(const Params& p) {
    const int NU = 512;
    const int lane = threadIdx.x & 63, wid = threadIdx.x >> 6, wr = wid >> 1, wc = wid & 1, fr = lane & 15, fq = lane >> 4;
    for (int u = blockIdx.x; u < NU; u += gridDim.x) {
        const int ct = u & 7, mh = (u >> 3) & 1, g = u >> 4;
        const u16* A = p.TabY + ((size_t)g * 256 + mh * 128) * 512;
        const u16* Ub = p.U + (size_t)ct * 128 * 16 * 512 + g * 16;
        const u16* Hb_ = p.Hin + (size_t)ct * 128 * 8192 + g * 256;
        f32x4 acc[4][4];
        gemm_tile(8,
            [&](int R, int C, int kt) { return (const void*)(A + (size_t)R * 512 + kt * 64 + C); },
            [&](int R, int C, int kt) {
                return kt < 4 ? (const void*)(Ub + (size_t)(R * 16 + kt * 4 + (C >> 4)) * 512 + (C & 15))
                              : (const void*)(Hb_ + (size_t)R * 8192 + (kt - 4) * 64 + C);
            }, acc);
#pragma unroll
        for (int m = 0; m < 4; ++m)
#pragma unroll
            for (int n = 0; n < 4; ++n) {
                const int t = mh * 8 + wr * 4 + m;
                const int cg = ct * 128 + wc * 64 + n * 16 + fr;
                u16* dst = p.Y + ((size_t)cg * 16 + t) * 512 + g * 16 + fq * 4;
                *(uint2*)dst = make_uint2(pack2(gelu_tanh(acc[m][n][0]), gelu_tanh(acc[m][n][1])),
                                          pack2(gelu_tanh(acc[m][n][2]), gelu_tanh(acc[m][n][3])));
            }
    }
}

__device__ void phase6(const Params& p) {
    const int NU = 512;
    const int lane = threadIdx.x & 63, wid = threadIdx.x >> 6, wr = wid >> 1, wc = wid & 1, fr = lane & 15, fq = lane >> 4;
    for (int u = blockIdx.x; u < NU; u += gridDim.x) {
        const int mt = u >> 2, nt = u & 3;
        const u16* A = p.Y + (size_t)mt * 128 * 512;
        const u16* B = p.WgluT + (size_t)nt * 128 * 512;
        f32x4 acc[4][4];
        gemm_tile(8,
            [&](int R, int C, int kt) { return (const void*)(A + (size_t)R * 512 + kt * 64 + C); },
            [&](int R, int C, int kt) { return (const void*)(B + (size_t)R * 512 + kt * 64 + C); }, acc);
        const int row0 = mt * 128 + wr * 64, col0 = nt * 128 + wc * 64;
        float v[4][4][4];
#pragma unroll
        for (int m = 0; m < 4; ++m)
#pragma unroll
            for (int n = 0; n < 4; ++n)
#pragma unroll
                for (int j = 0; j < 4; ++j) {
                    const int r = row0 + m * 16 + fq * 4 + j, c = col0 + n * 16 + fr;
                    const float yv = bf2f(p.Y[(size_t)r * 512 + c]);
                    v[m][n][j] = yv * sigmoidf_(acc[m][n][j] + p.b_glu[c]);
                }
        u16* dbase = p.SO + (size_t)row0 * 512 + col0;
        wave_store_bf16(v, [&](int row) { return dbase + (size_t)row * 512; });
    }
}

__device__ void phase7(const Params& p) {
    const int lane = threadIdx.x & 63;
    const int wv = blockIdx.x * 4 + (threadIdx.x >> 6), nwv = gridDim.x * 4;
    for (int it = wv; it < NLAT * 2; it += nwv) {
        const int r = it >> 1, half = it & 1;
        const u16* src = (half ? p.SO : p.AO) + (size_t)r * 512 + lane * 8;
        const float* gain = (half ? p.norm_ssm_out : p.norm_attn_out) + lane * 8;
        const uint4 d = *(const uint4*)src;
        float f[8];
        f[0] = bf2f((u16)(d.x & 0xffff)); f[1] = bf2f((u16)(d.x >> 16));
        f[2] = bf2f((u16)(d.y & 0xffff)); f[3] = bf2f((u16)(d.y >> 16));
        f[4] = bf2f((u16)(d.z & 0xffff)); f[5] = bf2f((u16)(d.z >> 16));
        f[6] = bf2f((u16)(d.w & 0xffff)); f[7] = bf2f((u16)(d.w >> 16));
        float ss = 0.f;
#pragma unroll
        for (int i = 0; i < 8; ++i) ss += f[i] * f[i];
        ss = wave_sum(ss);
        const float rs = rsqrtf(ss * (1.f / 512.f) + EPS);
        const float4 g0 = *(const float4*)gain, g1 = *(const float4*)(gain + 4);
        *(uint4*)(p.CAT + (size_t)r * 1024 + half * 512 + lane * 8) =
            make_uint4(pack2(f[0] * rs * g0.x, f[1] * rs * g0.y), pack2(f[2] * rs * g0.z, f[3] * rs * g0.w),
                       pack2(f[4] * rs * g1.x, f[5] * rs * g1.y), pack2(f[6] * rs * g1.z, f[7] * rs * g1.w));
    }
}

__device__ void phase8(const Params& p) {
    const int NU = 1024;
    const int lane = threadIdx.x & 63, wid = threadIdx.x >> 6, wr = wid >> 1, wc = wid & 1, fr = lane & 15, fq = lane >> 4;
    for (int u = blockIdx.x; u < NU; u += gridDim.x) {
        const int mt = u >> 3, nt = u & 7;
        const u16* A = p.CAT + (size_t)mt * 128 * 1024;
        const u16* B = p.WoutT + (size_t)nt * 128 * 1024;
        f32x4 acc[4][4];
        gemm_tile(16,
            [&](int R, int C, int kt) { return (const void*)(A + (size_t)R * 1024 + kt * 64 + C); },
            [&](int R, int C, int kt) { return (const void*)(B + (size_t)R * 1024 + kt * 64 + C); }, acc);
        const int row0 = mt * 128 + wr * 64, col0 = nt * 128 + wc * 64;
        const float* g1 = p.mod + (mt >> 4) * 6144 + 2048;
#pragma unroll
        for (int m = 0; m < 4; ++m)
#pragma unroll
            for (int n = 0; n < 4; ++n)
#pragma unroll
                for (int j = 0; j < 4; ++j) {
                    const int r = row0 + m * 16 + fq * 4 + j, c = col0 + n * 16 + fr;
                    p.out[(size_t)r * 1024 + c] = p.x[(size_t)r * 1024 + c] + g1[c] * acc[m][n][j];
                }
    }
}

__device__ void phase9(const Params& p) {
    const int wv = blockIdx.x * 4 + (threadIdx.x >> 6), nwv = gridDim.x * 4;
    for (int r = wv; r < NLAT; r += nwv) {
        const float* md = p.mod + (r >> 11) * 6144;
        norm_mod_row(p.out + (size_t)r * 1024, p.norm_ffn, md + 3072, md + 4096, p.H2 + (size_t)r * 1024);
    }
}

__device__ void phase10(const Params& p) {
    const int NU = 128;
    const int lane = threadIdx.x & 63, wid = threadIdx.x >> 6, wr = wid >> 1, wc = wid & 1, fr = lane & 15, fq = lane >> 4;
    float* sc = (float*)smem;
    for (int u = blockIdx.x; u < NU; u += gridDim.x) {
        const u16* A = p.H2 + (size_t)u * 128 * 1024;
        const u16* B = p.WrT;
        f32x4 acc[4][4];
        gemm_tile(16,
            [&](int R, int C, int kt) { return (const void*)(A + (size_t)R * 1024 + kt * 64 + C); },
            [&](int R, int C, int kt) { return (const void*)(B + (size_t)R * 1024 + kt * 64 + C); }, acc);
        if (wc == 0) {
#pragma unroll
            for (int m = 0; m < 4; ++m)
#pragma unroll
                for (int n = 0; n < 4; ++n)
#pragma unroll
                    for (int j = 0; j < 4; ++j)
                        sc[(wr * 64 + m * 16 + fq * 4 + j) * 64 + n * 16 + fr] = sigmoidf_(acc[m][n][j]);
        }
        __syncthreads();
        const float bias = p.router_bias[lane];
        const int grp = lane >> 3;
        for (int rr = 0; rr < 32; ++rr) {
            const int row = wid * 32 + rr, tok = u * 128 + row;
            const float s = sc[row * 64 + lane];
            const float bz = s + bias;
            float m1 = bz;
            m1 = fmaxf(m1, __shfl_xor(m1, 1)); m1 = fmaxf(m1, __shfl_xor(m1, 2)); m1 = fmaxf(m1, __shfl_xor(m1, 4));
            const unsigned long long eq = __ballot(bz == m1);
            const unsigned gb = (unsigned)((eq >> (grp * 8)) & 0xffull);
            const int first = __ffs(gb) - 1;
            float v2 = ((lane & 7) == first) ? -1e30f : bz;
            v2 = fmaxf(v2, __shfl_xor(v2, 1)); v2 = fmaxf(v2, __shfl_xor(v2, 2)); v2 = fmaxf(v2, __shfl_xor(v2, 4));
            const float gs = m1 + v2;
            int cnt = 0;
#pragma unroll
            for (int j = 0; j < 8; ++j) {
                const float gj = __shfl(gs, j * 8);
                cnt += (gj > gs || (gj == gs && j < grp)) ? 1 : 0;
            }
            const bool gsel = cnt < 4;
            const float mv = gsel ? bz : -1e30f;
            int rank = 0;
            for (int j = 0; j < 64; ++j) {
                const float vj = __shfl(mv, j);
                rank += (vj > mv || (vj == mv && j < lane)) ? 1 : 0;
            }
            const bool sel = gsel && rank < 8;
            const float tot = wave_sum(sel ? s : 0.f);
            if (sel) {
                p.IDX[(size_t)tok * 8 + rank] = (unsigned char)lane;
                p.WGT[(size_t)tok * 8 + rank] = s / tot * 2.5f;
            }
        }
    }
}

#define LIST_OFF 0
__device__ int build_list(const Params& p, int e, int seg, int* list  , int* wcnt  ) {
    const int tid = threadIdx.x, lane = tid & 63, wid = tid >> 6;
    if (e == 64) {
        for (int i = tid; i < 2048; i += NTHR) list[i] = (seg * 2048 + i) * 16 + 8;
        __syncthreads();
        return 2048;
    }
    int base = 0;
    for (int it = 0; it < 8; ++it) {
        const int tok = seg * 2048 + it * 256 + tid;
        const uint2 d = *(const uint2*)(p.IDX + (size_t)tok * 8);
        int k = -1;
#pragma unroll
        for (int i = 0; i < 4; ++i) {
            if (((d.x >> (8 * i)) & 0xff) == (unsigned)e) k = i;
            if (((d.y >> (8 * i)) & 0xff) == (unsigned)e) k = 4 + i;
        }
        const unsigned long long bal = __ballot(k >= 0);
        const int pre = __popcll(bal & ((1ull << lane) - 1ull));
        if (lane == 0) wcnt[wid] = __popcll(bal);
        __syncthreads();
        int off = base;
        for (int w = 0; w < wid; ++w) off += wcnt[w];
        if (k >= 0) list[off + pre] = tok * 16 + k;
        base += wcnt[0] + wcnt[1] + wcnt[2] + wcnt[3];
        __syncthreads();
    }
    return base;
}

__device__ void phase11(const Params& p) {
    const int NU = 512 + 256;
    const int lane = threadIdx.x & 63, wid = threadIdx.x >> 6, wr = wid >> 1, wc = wid & 1, fr = lane & 15, fq = lane >> 4;
    int* list = (int*)(smem + 65536);
    int* wcnt = list + 2048;
    for (int u = blockIdx.x; u < NU; u += gridDim.x) {
        if (u < 512) {
            const int e = u >> 3, seg = u & 7;
            __syncthreads();
            const int cnt = build_list(p, e, seg, list, wcnt);
            const int nmt = (cnt + 127) >> 7;
            const u16* Bw = p.WguT + (size_t)e * 262144;
            for (int mt = 0; mt < nmt; ++mt)
                for (int nt = 0; nt < 2; ++nt) {
                    f32x4 acc[4][4];
                    gemm_tile(16,
                        [&](int R, int C, int kt) {
                            int li = mt * 128 + R; li = li < cnt ? li : cnt - 1;
                            return (const void*)(p.H2 + (size_t)(list[li] >> 4) * 1024 + kt * 64 + C);
                        },
                        [&](int R, int C, int kt) { return (const void*)(Bw + (size_t)(nt * 128 + R) * 1024 + kt * 64 + C); }, acc);
#pragma unroll
                    for (int m = 0; m < 4; ++m)
#pragma unroll
                        for (int j = 0; j < 4; ++j) {
                            const int li = mt * 128 + wr * 64 + m * 16 + fq * 4 + j;
                            if (li < cnt) {
                                const int ent = list[li], tok = ent >> 4, k = ent & 15;
                                const float w = p.WGT[(size_t)tok * 8 + k];
                                u16* dst = p.HH + ((size_t)tok * 9 + k) * 128 + nt * 64 + wc * 32 + fr;
#pragma unroll
                                for (int n2 = 0; n2 < 2; ++n2) {
                                    const float gv = acc[m][2 * n2][j], uv = acc[m][2 * n2 + 1][j];
                                    dst[n2 * 16] = f2bf(siluf_(gv) * uv * w);
                                }
                            }
                        }
                }
        } else {
            const int v = u - 512, nt = v & 1, mt = v >> 1;
            const u16* A = p.H2 + (size_t)mt * 128 * 1024;
            const u16* Bw = p.WguT + (size_t)64 * 262144;
            f32x4 acc[4][4];
            gemm_tile(16,
                [&](int R, int C, int kt) { return (const void*)(A + (size_t)R * 1024 + kt * 64 + C); },
                [&](int R, int C, int kt) { return (const void*)(Bw + (size_t)(nt * 128 + R) * 1024 + kt * 64 + C); }, acc);
#pragma unroll
            for (int m = 0; m < 4; ++m)
#pragma unroll
                for (int j = 0; j < 4; ++j) {
                    const int tok = mt * 128 + wr * 64 + m * 16 + fq * 4 + j;
                    u16* dst = p.HH + ((size_t)tok * 9 + 8) * 128 + nt * 64 + wc * 32 + fr;
#pragma unroll
                    for (int n2 = 0; n2 < 2; ++n2) {
                        const float gv = acc[m][2 * n2][j], uv = acc[m][2 * n2 + 1][j];
                        dst[n2 * 16] = f2bf(siluf_(gv) * uv);
                    }
                }
        }
    }
}

#define P12_ACC_LD 68
#define P12_ABUF 35072
#define P12_LIST (P12_ABUF + 2 * 12288)
#define P12_CNT (P12_LIST + 6656)
__device__ void phase12(const Params& p) {
    const int NU = 1024;
    const int tid = threadIdx.x, lane = tid & 63, wid = tid >> 6, fr = lane & 15, fq = lane >> 4;
    _Float16* acc = (_Float16*)smem;
    char* abuf = smem + P12_ABUF;
    u16* list = (u16*)(smem + P12_LIST);
    int* cnt = (int*)(smem + P12_CNT);
    int* off = cnt + 66;
    int* fill = off + 66;
    int* items = fill + 66;
    int* nitems = items + 160;
    for (int u = blockIdx.x; u < NU; u += gridDim.x) {
        const int slab = (u & 7) * 2 + ((u >> 3) & 1), tile = u >> 4;
        __syncthreads();
        for (int i = tid; i < 257 * P12_ACC_LD / 2; i += NTHR) ((unsigned*)acc)[i] = 0u;
        for (int i = tid; i < 3328 / 2; i += NTHR) ((unsigned*)list)[i] = 0xFFFFFFFFu;
        if (tid < 66) { cnt[tid] = (tid == 64) ? 256 : 0; fill[tid] = 0; }
        __syncthreads();
        const int tok = tile * 256 + tid;
        const uint2 dd = *(const uint2*)(p.IDX + (size_t)tok * 8);
        int ek[8];
#pragma unroll
        for (int i = 0; i < 4; ++i) { ek[i] = (dd.x >> (8 * i)) & 0xff; ek[4 + i] = (dd.y >> (8 * i)) & 0xff; }
#pragma unroll
        for (int k = 0; k < 8; ++k) atomicAdd(&cnt[ek[k]], 1);
        __syncthreads();
        if (wid == 0) {
            const int c = cnt[lane], pc = (c + 15) & ~15, ni = (pc + 47) / 48;
            int sp = pc, si = ni;
#pragma unroll
            for (int o = 1; o < 64; o <<= 1) {
                const int tp = __shfl_up(sp, o), ti = __shfl_up(si, o);
                if (lane >= o) { sp += tp; si += ti; }
            }
            const int myoff = sp - pc, myitem = si - ni;
            off[lane] = myoff;
            for (int q = 0; q < ni; ++q) {
                const int nr = min(48, pc - q * 48);
                items[myitem + q] = lane | ((myoff + q * 48) << 7) | ((nr >> 4) << 19);
            }
            const int totp = __shfl(sp, 63), toti = __shfl(si, 63);
            if (lane < 6) {
                const int nr = lane < 5 ? 48 : 16;
                items[toti + lane] = 64 | ((totp + lane * 48) << 7) | ((nr >> 4) << 19);
            }
            if (lane == 0) { off[64] = totp; nitems[0] = toti + 6; }
        }
        __syncthreads();
#pragma unroll
        for (int k = 0; k < 8; ++k) {
            const int pos = atomicAdd(&fill[ek[k]], 1);
            list[off[ek[k]] + pos] = (u16)(tid * 16 + k);
        }
        list[off[64] + tid] = (u16)(tid * 16 + 8);
        __syncthreads();
        const int n_it = nitems[0];
        const u16* HHt = p.HH + (size_t)tile * 256 * 9 * 128;
        const u16* Wb = p.WdT + (size_t)(slab * 64 + wid * 16 + fr) * 128 + fq * 8;
        auto stage = [&](int it, int s, bf16x8 (&bf)[4]) {
            const int pk = items[it], e = pk & 127, rs = (pk >> 7) & 4095, nr = ((pk >> 19) & 3) * 16;
#pragma unroll
            for (int q = 0; q < 3; ++q) {
                if (wid * 4 + q * 16 < nr) {
                    const int slot = tid + q * 256, row = slot >> 4;
                    const int ent = list[rs + row];
                    const int so = (ent == 0xFFFF) ? 0 : ((ent >> 4) * 9 + (ent & 15));
                    const int ch = (slot & 15) ^ (row & 15);
                    glds16(HHt + (size_t)so * 128 + ch * 8, abuf + s * 12288 + slot * 16);
                }
            }
#pragma unroll
            for (int ks = 0; ks < 4; ++ks) bf[ks] = *(const bf16x8*)(Wb + (size_t)e * 131072 + ks * 32);
        };
        bf16x8 bcur[4], bnxt[4];
        stage(0, 0, bcur);
        for (int it = 0; it < n_it; ++it) {
            asm volatile("s_waitcnt vmcnt(0)" ::: "memory");
            __syncthreads();
            if (it + 1 < n_it) stage(it + 1, (it + 1) & 1, bnxt);
            const int pk = items[it], rs = (pk >> 7) & 4095, nmt = (pk >> 19) & 3;
            const char* ab = abuf + (it & 1) * 12288;
            for (int mt = 0; mt < nmt; ++mt) {
                f32x4 d = {0.f, 0.f, 0.f, 0.f};
#pragma unroll
                for (int ks = 0; ks < 4; ++ks) {
                    const bf16x8 a = *(const bf16x8*)(ab + (mt * 16 + fr) * 256 + (((ks * 4 + fq) ^ fr) * 16));
                    d = __builtin_amdgcn_mfma_f32_16x16x32_bf16(a, bcur[ks], d, 0, 0, 0);
                }
                const uint2 en = *(const uint2*)(list + rs + mt * 16 + fq * 4);
                const unsigned e4[4] = {en.x & 0xffffu, en.x >> 16, en.y & 0xffffu, en.y >> 16};
#pragma unroll
                for (int j = 0; j < 4; ++j) {
                    if (e4[j] != 0xFFFFu) {
                        _Float16* ap = acc + (e4[j] >> 4) * P12_ACC_LD + wid * 16 + fr;
                        *ap = (_Float16)((float)*ap + d[j]);
                    }
                }
            }
#pragma unroll
            for (int ks = 0; ks < 4; ++ks) bcur[ks] = bnxt[ks];
        }
        __syncthreads();
        const float* g2 = p.mod + (tile >> 3) * 6144 + 5120 + slab * 64;
        const int c4 = (tid & 15) * 4;
        const float4 gv = *(const float4*)(g2 + c4);
#pragma unroll 4
        for (int i = 0; i < 16; ++i) {
            const int row = (tid >> 4) + 16 * i;
            float* op = p.out + (size_t)(tile * 256 + row) * 1024 + slab * 64 + c4;
            const float4 xv = *(const float4*)op;
            const _Float16* ap = acc + row * P12_ACC_LD + c4;
            *(float4*)op = make_float4(xv.x + gv.x * (float)ap[0], xv.y + gv.y * (float)ap[1], xv.z + gv.z * (float)ap[2], xv.w + gv.w * (float)ap[3]);
        }
    }
}

__device__ void phase13(const Params& p) {
    const int lane = threadIdx.x & 63;
    const int wv = blockIdx.x * 4 + (threadIdx.x >> 6), nwv = gridDim.x * 4;
    for (int r = wv; r < NLAT; r += nwv) {
        float* row = p.out + (size_t)r * 1024;
        float4 v[4];
        float ss = 0.f;
#pragma unroll
        for (int i = 0; i < 4; ++i) {
            v[i] = *(const float4*)(row + i * 256 + lane * 4);
            ss += v[i].x * v[i].x + v[i].y * v[i].y + v[i].z * v[i].z + v[i].w * v[i].w;
        }
        ss = wave_sum(ss);
        const float rs = rsqrtf(ss * (1.f / 1024.f) + EPS);
#pragma unroll
        for (int i = 0; i < 4; ++i) {
            const float4 g = *(const float4*)(p.norm_final + i * 256 + lane * 4);
            *(float4*)(row + i * 256 + lane * 4) = make_float4(v[i].x * rs * g.x, v[i].y * rs * g.y, v[i].z * rs * g.z, v[i].w * rs * g.w);
        }
    }
}

#define SMEM_TOTAL (65536 + 8192 + 64)

template <int PH> __device__ __forceinline__ void run_phase(const Params& p) {
    if (PH == 0) phase0(p); else if (PH == 1) phase1(p); else if (PH == 2) phase2(p); else if (PH == 3) phase3(p);
    else if (PH == 4) phase4(p); else if (PH == 5) phase5(p); else if (PH == 6) phase6(p); else if (PH == 7) phase7(p);
    else if (PH == 8) phase8(p); else if (PH == 9) phase9(p); else if (PH == 10) phase10(p); else if (PH == 11) phase11(p);
    else if (PH == 12) phase12(p); else phase13(p);
}

#if MK_MULTI
template <int PH> __global__ void __launch_bounds__(NTHR, 2) k_phase(Params p) { run_phase<PH>(p); }
#else
__global__ void __launch_bounds__(NTHR, 2) k_mega(Params p) {
    volatile LAS unsigned* st = (volatile LAS unsigned*)(smem + SMEM_TOTAL - 16);
    if (threadIdx.x == 0) { st[0] = 0u; st[1] = 0u; st[2] = 0u; st[3] = 0u; }
    __syncthreads();
    XcdBarrier bar = xcd_barrier_post(p.bar, st);
    phase0(p);  xcd_barrier(bar);
    phase1(p);  xcd_barrier(bar);
    phase2(p);  xcd_barrier(bar);
    phase3(p);  xcd_barrier(bar);
    phase4(p);  xcd_barrier(bar);
    phase5(p);  xcd_barrier(bar);
    phase6(p);  xcd_barrier(bar);
    phase7(p);  xcd_barrier(bar);
    phase8(p);  xcd_barrier(bar);
    phase9(p);  xcd_barrier(bar);
    phase10(p); xcd_barrier(bar);
    phase11(p); xcd_barrier(bar);
    phase12(p); xcd_barrier(bar);
    phase13(p);
}
#endif

static inline size_t al256(size_t v) { return (v + 255) & ~(size_t)255; }

extern "C" void kernel_launch(void* const* d_in, const int* in_sizes, int n_in,
                              void* d_out, int out_size, void* d_ws, size_t ws_size,
                              hipStream_t stream) {
    Params p{};
    const float** ip = (const float**)&p.x;
    for (int i = 0; i < 32; ++i) ip[i] = (const float*)d_in[i];
    p.out = (float*)d_out;
    char* w = (char*)d_ws;
    size_t off = 0;
    auto take = [&](size_t bytes) { char* r = w + off; off = al256(off + bytes); return r; };
    p.bar  = (unsigned*)take(XCD_BAR_WORDS * 4);
    p.mod  = (float*)take(9 * 6144 * 4);
    p.rope = (float2*)take(64 * 16 * 8);
    p.WinT = (u16*)take((size_t)1280 * 1024 * 2);
    p.WgluT = (u16*)take((size_t)512 * 512 * 2);
    p.WoutT = (u16*)take((size_t)1024 * 1024 * 2);
    p.WrT = (u16*)take((size_t)128 * 1024 * 2);
    p.WguT = (u16*)take((size_t)65 * 256 * 1024 * 2);
    p.WdT = (u16*)take((size_t)65 * 1024 * 128 * 2);
    p.TabS = (u16*)take((size_t)32 * 256 * 256 * 2);
    p.TabY = (u16*)take((size_t)32 * 256 * 512 * 2);
    p.IDX = (unsigned char*)take((size_t)NLAT * 8);
    p.WGT = (float*)take((size_t)NLAT * 8 * 4);
    char* r1 = take((size_t)NROWS * 1024 * 2);
    p.Hb = (u16*)r1; p.S = (float*)r1; p.H2 = (u16*)r1;
    char* r2 = take((size_t)NLAT * 9 * 128 * 2);
    p.Q = (u16*)r2; p.Kb = (u16*)(r2 + (size_t)NLAT * 512 * 2); p.Vt = (u16*)(r2 + (size_t)NLAT * 512 * 2 + (size_t)NROWS * 128 * 2);
    p.Y = (u16*)r2; p.SO = (u16*)(r2 + (size_t)NLAT * 512 * 2);
    p.HH = (u16*)r2;
    char* r3 = take((size_t)NLAT * 1024 * 2);
    p.U = (u16*)r3; p.CAT = (u16*)r3;
    char* r4 = take((size_t)NLAT * 512 * 2 * 2);
    p.AO = (u16*)r4; p.Hin = (u16*)(r4 + (size_t)NLAT * 512 * 2);
    if (off > ws_size) { fprintf(stderr, "workspace too small: need %zu have %zu\n", off, ws_size); return; }

#if MK_MULTI
    const int grid = 512;
#define LAUNCH(PH) do { hipFuncSetAttribute((const void*)k_phase<PH>, hipFuncAttributeMaxDynamicSharedMemorySize, SMEM_TOTAL); \
        k_phase<PH><<<grid, NTHR, SMEM_TOTAL, stream>>>(p); } while (0)
    LAUNCH(0); LAUNCH(1); LAUNCH(2); LAUNCH(3); LAUNCH(4); LAUNCH(5); LAUNCH(6); LAUNCH(7);
    LAUNCH(8); LAUNCH(9); LAUNCH(10); LAUNCH(11); LAUNCH(12); LAUNCH(13);
#else
    static int grid = 0;
    if (!grid) {
        hipFuncSetAttribute((const void*)k_mega, hipFuncAttributeMaxDynamicSharedMemorySize, SMEM_TOTAL);
        int dev = 0, cus = 0, per_cu = 0;
        hipGetDevice(&dev);
        hipDeviceGetAttribute(&cus, hipDeviceAttributeMultiprocessorCount, dev);
        hipOccupancyMaxActiveBlocksPerMultiprocessor(&per_cu, (const void*)k_mega, NTHR, SMEM_TOTAL);
        if (per_cu < 1) per_cu = 1;
        grid = cus * (per_cu < 2 ? per_cu : 2);
    }
    hipMemsetAsync(p.bar, 0, XCD_BAR_WORDS * 4, stream);
    k_mega<<<grid, NTHR, SMEM_TOTAL, stream>>>(p);
#endif
}
```

```cpp
#include <hip/hip_runtime.h>
#include <hip/hip_bf16.h>
#include <stdint.h>
#include <stdio.h>

#ifndef MK_MULTI
#define MK_MULTI 0
#endif

typedef __attribute__((ext_vector_type(8))) short bf16x8;
typedef __attribute__((ext_vector_type(4))) short bf16x4;
typedef __attribute__((ext_vector_type(4))) float f32x4;
typedef unsigned short u16;
typedef __attribute__((ext_vector_type(4))) unsigned u32x4;

#ifndef PROBE_DUP
#define PROBE_DUP -1
#endif
#define NTHR 256
__device__ __forceinline__ int opaque_tid() { int t = (int)threadIdx.x; asm volatile("" : "+v"(t)); return t; }
#define TIDX opaque_tid()
#define LDS_BYTES 65536

#define D_MODEL 1024
#define BATCH 8
#define SEQ 2048
#define CTXL 256
#define NLAT (BATCH * SEQ)
#define NCTX (BATCH * CTXL)
#define NROWS (NLAT + NCTX)
#define INW 1280
#define NEXP 64
#define VT_LD (SEQ + CTXL)
#define NCHUNK_LAT 1024
#define NCHUNK_ALL 1152
#define EPS 1e-6f

#define XB_TMO      128
#define XB_XCNT(j)  (256  + 64 * (j))
#define XB_XSUB(j)  (1280 + 64 * (j))
#define XB_XGEN(j)  (2304 + 64 * (j))
#define XB_TOP      3328
#define XB_TOPGEN   3392
#define XCD_BAR_WORDS 3456
#define XB_SPIN_CAP (1u << 20)
#define LAS __attribute__((address_space(3)))

__device__ __forceinline__ unsigned xb_ld(unsigned* p)              { return __hip_atomic_load(p, __ATOMIC_RELAXED, __HIP_MEMORY_SCOPE_AGENT); }
__device__ __forceinline__ unsigned xb_add(unsigned* p, unsigned v) { return __hip_atomic_fetch_add(p, v, __ATOMIC_RELAXED, __HIP_MEMORY_SCOPE_AGENT); }
__device__ __forceinline__ unsigned xb_xcc_id() { return (unsigned)__builtin_amdgcn_s_getreg((3 << 11) | 20) & 0xFu; }
#define XB_SPIN(cond, bar) do { unsigned _sp = 0; while (cond) { __builtin_amdgcn_s_sleep(1); \
    if ((++_sp & 255u) == 0u) { if (xb_ld(&(bar)[XB_TMO])) break; if (_sp > XB_SPIN_CAP) { atomicAdd(&(bar)[XB_TMO], 1u); break; } } } } while (0)

struct XcdBarrier { unsigned* bar; unsigned x; volatile LAS unsigned* st; };

__device__ __forceinline__ XcdBarrier xcd_barrier_post(unsigned* bar, volatile LAS unsigned* st) {
    XcdBarrier b; b.bar = bar; b.x = xb_xcc_id(); b.st = st;
    if (TIDX == 0) (void)xb_add(&bar[XB_XCNT(b.x)], 1u);
    return b;
}
__device__ __forceinline__ void xcd_barrier_complete(unsigned* bar, unsigned x, unsigned& nloc, unsigned& nx) {
    const unsigned G = gridDim.x * gridDim.y * gridDim.z;
    unsigned sum, cnt, mine, sp = 0u;
    for (;;) {
        sum = 0u; cnt = 0u; mine = 0u;
#pragma unroll
        for (unsigned j = 0; j < 16; ++j) { const unsigned c = xb_ld(&bar[XB_XCNT(j)]); sum += c; cnt += (c > 0u) ? 1u : 0u; mine = (j == x) ? c : mine; }
        if (sum == G) break;
        __builtin_amdgcn_s_sleep(1);
        if ((++sp & 255u) == 0u) { if (xb_ld(&bar[XB_TMO])) break; if (sp > XB_SPIN_CAP) { atomicAdd(&bar[XB_TMO], 1u); break; } }
    }
    nloc = mine > 0u ? mine : 1u; nx = cnt > 0u ? cnt : 1u;
}
__device__ __forceinline__ void xcd_barrier(const XcdBarrier& b) {
    asm volatile("s_waitcnt vmcnt(0)" ::: "memory");
    __syncthreads();
    if (TIDX == 0) {
        unsigned* bar = b.bar;
        __builtin_amdgcn_s_waitcnt(0);
        unsigned nloc = b.st[0], nx = b.st[1];
        if (nloc == 0u) { xcd_barrier_complete(bar, b.x, nloc, nx); b.st[0] = nloc; b.st[1] = nx; }
        const unsigned old = xb_add(&bar[XB_XSUB(b.x)], 1u);
        const unsigned gen = old / nloc;
        if (old + 1u == (gen + 1u) * nloc) {
            __builtin_amdgcn_fence(__ATOMIC_RELEASE, "agent");
            asm volatile("s_waitcnt vmcnt(0)" ::: "memory");
            const unsigned og = xb_add(&bar[XB_TOP], 1u);
            const unsigned tg = og / nx;
            if (og + 1u == (tg + 1u) * nx) xb_add(&bar[XB_TOPGEN], 1u);
            else XB_SPIN(xb_ld(&bar[XB_TOPGEN]) == tg, bar);
            __builtin_amdgcn_fence(__ATOMIC_ACQUIRE, "agent");
            xb_add(&bar[XB_XGEN(b.x)], 1u);
            asm volatile("buffer_inv sc0 sc1" ::: "memory");
            asm volatile("s_waitcnt vmcnt(0)" ::: "memory");
        } else {
            XB_SPIN(xb_ld(&bar[XB_XGEN(b.x)]) == gen, bar);
            __builtin_amdgcn_fence(__ATOMIC_ACQUIRE, "agent");
            asm volatile("buffer_inv sc0 sc1" ::: "memory");
            asm volatile("s_waitcnt vmcnt(0)" ::: "memory");
        }
    }
    __syncthreads();
}

struct Params {
    const float *x, *c, *ctx, *c_ctx, *w_ada, *b_ada, *norm_mix, *norm_ffn, *w_in, *attn_sink,
        *a_re, *a_im, *log_dt, *b_re, *b_im, *c_re, *c_im, *ssm_d, *w_glu, *b_glu, *norm_attn_out, *norm_ssm_out,
        *w_out, *w_router, *router_bias, *w_gate_e, *w_up_e, *w_down_e, *w_gate_s, *w_up_s, *w_down_s, *norm_final;
    float* out;
    char* ws;
};

constexpr size_t A256(size_t v) { return (v + 255) & ~(size_t)255; }
constexpr size_t OFF_BAR   = 0;
constexpr size_t OFF_MOD   = A256(OFF_BAR + XCD_BAR_WORDS * 4 + 1024);
constexpr size_t OFF_ROPE  = A256(OFF_MOD + 9 * 6144 * 4);
constexpr size_t OFF_KBUF  = A256(OFF_ROPE + 64 * 16 * 8);
constexpr size_t OFF_IDX   = A256(OFF_KBUF + (size_t)32 * 2 * 4096 * 4);
constexpr size_t OFF_WGT   = A256(OFF_IDX + (size_t)NLAT * 8);
constexpr size_t OFF_ELIST = A256(OFF_WGT + (size_t)NLAT * 8 * 4);
constexpr size_t OFF_WINT  = A256(OFF_ELIST + (size_t)2 * 64 * 8192 * 4);
constexpr size_t OFF_WGLUT = A256(OFF_WINT + (size_t)1280 * 1024 * 2);
constexpr size_t OFF_WOUTT = A256(OFF_WGLUT + (size_t)512 * 512 * 2);
constexpr size_t OFF_WRT   = A256(OFF_WOUTT + (size_t)1024 * 1024 * 2);
constexpr size_t OFF_WDT   = A256(OFF_WRT + (size_t)128 * 1024 * 2);
constexpr size_t OFF_HHS   = A256(OFF_WDT + (size_t)65 * 1024 * 128 * 2);
constexpr size_t OFF_ARENA = A256(OFF_HHS + (size_t)2 * 73728 * 128 * 2);
constexpr size_t OFF_WGUT  = OFF_ARENA;
constexpr size_t OFF_TABS  = A256(OFF_WGUT + (size_t)65 * 256 * 1024 * 2);
constexpr size_t OFF_TABY  = A256(OFF_TABS + (size_t)32 * 256 * 256 * 2);
constexpr size_t OFF_R1    = A256(OFF_TABY + (size_t)32 * 256 * 512 * 2);
constexpr size_t OFF_R2    = A256(OFF_R1 + (size_t)NROWS * 1024 * 2);
constexpr size_t OFF_R3    = A256(OFF_R2 + (size_t)NLAT * 1024 * 2);
constexpr size_t OFF_R4    = A256(OFF_R3 + (size_t)NLAT * 1024 * 2);
constexpr size_t OFF_END   = A256(OFF_R4 + (size_t)NLAT * 512 * 2 * 2);
static_assert(OFF_END - OFF_ARENA >= (size_t)8192 * 9 * 1024 * 2, "arena must hold Yd");
#define WSP_bar   ((unsigned*)(p.ws + OFF_BAR))
#define WSP_ctr   ((unsigned*)(p.ws + OFF_BAR) + XCD_BAR_WORDS)
#define WSP_mod   ((float*)(p.ws + OFF_MOD))
#define WSP_rope  ((float2*)(p.ws + OFF_ROPE))
#define WSP_Kbuf  ((float*)(p.ws + OFF_KBUF))
#define WSP_WGT   ((float*)(p.ws + OFF_WGT))
#define WSP_elist ((int*)(p.ws + OFF_ELIST))
#define WSP_WinT  ((u16*)(p.ws + OFF_WINT))
#define WSP_WgluT ((u16*)(p.ws + OFF_WGLUT))
#define WSP_WoutT ((u16*)(p.ws + OFF_WOUTT))
#define WSP_WrT   ((u16*)(p.ws + OFF_WRT))
#define WSP_WdT   ((u16*)(p.ws + OFF_WDT))
#define WSP_HHs   ((u16*)(p.ws + OFF_HHS))
#define WSP_Yd    ((u16*)(p.ws + OFF_ARENA))
#define WSP_WguT  ((u16*)(p.ws + OFF_WGUT))
#define WSP_TabS  ((u16*)(p.ws + OFF_TABS))
#define WSP_TabY  ((u16*)(p.ws + OFF_TABY))
#define WSP_Hb    ((u16*)(p.ws + OFF_R1))
#define WSP_S     ((float*)(p.ws + OFF_R1))
#define WSP_H2    ((u16*)(p.ws + OFF_R1))
#define WSP_Q     ((u16*)(p.ws + OFF_R2))
#define WSP_Kb    ((u16*)(p.ws + OFF_R2 + (size_t)NLAT * 512 * 2))
#define WSP_Vt    ((u16*)(p.ws + OFF_R2 + (size_t)NLAT * 512 * 2 + (size_t)NROWS * 128 * 2))
#define WSP_Y     ((u16*)(p.ws + OFF_R2))
#define WSP_SO    ((u16*)(p.ws + OFF_R2 + (size_t)NLAT * 512 * 2))
#define WSP_U     ((u16*)(p.ws + OFF_R3))
#define WSP_CAT   ((u16*)(p.ws + OFF_R3))
#define WSP_AO    ((u16*)(p.ws + OFF_R4))
#define WSP_Hin   ((u16*)(p.ws + OFF_R4 + (size_t)NLAT * 512 * 2))

extern __shared__ __attribute__((aligned(16))) char smem[];

__device__ __forceinline__ u16 f2bf(float f) {
    unsigned u = __float_as_uint(f);
    u += 0x7fffu + ((u >> 16) & 1u);
    return (u16)(u >> 16);
}
__device__ __forceinline__ float bf2f(u16 h) { return __uint_as_float(((unsigned)h) << 16); }
__device__ __forceinline__ unsigned pack2(float a, float b) { return (unsigned)f2bf(a) | ((unsigned)f2bf(b) << 16); }
__device__ __forceinline__ void glds16(const void* g, void* l) {
    __builtin_amdgcn_global_load_lds((const unsigned*)g, (unsigned*)l, 16, 0, 0);
}
__device__ __forceinline__ int lds_byte(int r, int c) {
    int st = (r >> 4) * 2 + (c >> 5), rr = r & 15, cc = c & 31, ob = rr * 64 + cc * 2;
    return st * 1024 + (ob ^ (((ob >> 9) & 1) << 5));
}
__device__ __forceinline__ float wave_sum(float v) {
#pragma unroll
    for (int o = 32; o > 0; o >>= 1) v += __shfl_xor(v, o);
    return v;
}
__device__ __forceinline__ float sigmoidf_(float x) { return 1.f / (1.f + __expf(-x)); }
__device__ __forceinline__ float siluf_(float x) { return x / (1.f + __expf(-x)); }
__device__ __forceinline__ float gelu_tanh(float x) {
    float u = 0.7978845608028654f * (x + 0.044715f * x * x * x);
    return x / (1.f + __expf(-2.f * u));
}

template <class FA, class FB>
__device__ __forceinline__ void gemm_tile(int nkt, FA fa, FB fb, f32x4 (&acc)[4][4]) {
    const int tid = TIDX, lane = tid & 63, wid = tid >> 6, wr = wid >> 1, wc = wid & 1, fr = lane & 15, fq = lane >> 4;
    const int sb = lane * 16, swz = sb ^ (((sb >> 9) & 1) << 5);
    const int r_in = swz >> 6, c_in = (swz & 63) >> 1;
#pragma unroll
    for (int m = 0; m < 4; ++m)
#pragma unroll
        for (int n = 0; n < 4; ++n) acc[m][n] = (f32x4){0.f, 0.f, 0.f, 0.f};
    __syncthreads();
    auto stage = [&](int kt, int s) {
        char* sa = smem + s * 32768;
        char* sbm = sa + 16384;
#pragma unroll
        for (int i = 0; i < 4; ++i) {
            const int st = wid + 4 * i, R = (st >> 1) * 16 + r_in, C = (st & 1) * 32 + c_in;
            glds16(fa(R, C, kt), sa + tid * 16 + i * 4096);
            glds16(fb(R, C, kt), sbm + tid * 16 + i * 4096);
        }
    };
    stage(0, 0);
    for (int kt = 0; kt < nkt; ++kt) {
        asm volatile("s_waitcnt vmcnt(0)" ::: "memory");
        __syncthreads();
        if (kt + 1 < nkt) stage(kt + 1, (kt + 1) & 1);
        const char* sa = smem + (kt & 1) * 32768;
        const char* sbm = sa + 16384;
#pragma unroll
        for (int ks = 0; ks < 2; ++ks) {
            bf16x8 a[4], b[4];
#pragma unroll
            for (int m = 0; m < 4; ++m) a[m] = *(const bf16x8*)(sa + lds_byte(wr * 64 + m * 16 + fr, ks * 32 + fq * 8));
#pragma unroll
            for (int n = 0; n < 4; ++n) b[n] = *(const bf16x8*)(sbm + lds_byte(wc * 64 + n * 16 + fr, ks * 32 + fq * 8));
#pragma unroll
            for (int m = 0; m < 4; ++m)
#pragma unroll
                for (int n = 0; n < 4; ++n) acc[m][n] = __builtin_amdgcn_mfma_f32_16x16x32_bf16(a[m], b[n], acc[m][n], 0, 0, 0);
        }
    }
    __syncthreads();
}

__device__ __forceinline__ int lds32(int r, int c) {
    const int rr = r & 15;
    return (r >> 4) * 1024 + ((rr * 64 + c * 2) ^ (((rr >> 3) & 1) << 5));
}
template <class FA, class FB>
__device__ __forceinline__ void gemm_tile_w(int nkt, FA fa, FB fb, f32x4 (&acc)[4][8]) {
    const int tid = TIDX, lane = tid & 63, wid = tid >> 6, wr = wid >> 1, wc = wid & 1, fr = lane & 15, fq = lane >> 4;
    const int sb = lane * 16, swz = sb ^ (((sb >> 9) & 1) << 5);
    const int r_in = swz >> 6, c_in = (swz & 63) >> 1;
#pragma unroll
    for (int m = 0; m < 4; ++m)
#pragma unroll
        for (int n = 0; n < 8; ++n) acc[m][n] = (f32x4){0.f, 0.f, 0.f, 0.f};
    __syncthreads();
    auto stage = [&](int kt, int s) {
        char* sa = smem + s * 24576;
#pragma unroll
        for (int i = 0; i < 2; ++i) glds16(fa(i, (wid + 4 * i) * 16 + r_in, c_in, kt), sa + tid * 16 + i * 4096);
#pragma unroll
        for (int i = 0; i < 4; ++i) glds16(fb(i, (wid + 4 * i) * 16 + r_in, c_in, kt), sa + 8192 + tid * 16 + i * 4096);
    };
    stage(0, 0);
    if (nkt > 1) stage(1, 1);
    int s_cur = 0, s_nxt = 2;
    for (int kt = 0; kt < nkt; ++kt) {
        if (kt + 1 < nkt) asm volatile("s_waitcnt vmcnt(6) lgkmcnt(0)\n\ts_barrier" ::: "memory");
        else asm volatile("s_waitcnt vmcnt(0) lgkmcnt(0)\n\ts_barrier" ::: "memory");
        if (kt + 2 < nkt) stage(kt + 2, s_nxt);
        const char* sa = smem + s_cur * 24576;
        bf16x8 a[4];
#pragma unroll
        for (int m = 0; m < 4; ++m) a[m] = *(const bf16x8*)(sa + lds32(wr * 64 + m * 16 + fr, fq * 8));
#pragma unroll
        for (int nh = 0; nh < 2; ++nh) {
            bf16x8 b[4];
#pragma unroll
            for (int n = 0; n < 4; ++n) b[n] = *(const bf16x8*)(sa + 8192 + lds32(wc * 128 + (nh * 4 + n) * 16 + fr, fq * 8));
#pragma unroll
            for (int m = 0; m < 4; ++m)
#pragma unroll
                for (int n = 0; n < 4; ++n) acc[m][nh * 4 + n] = __builtin_amdgcn_mfma_f32_16x16x32_bf16(a[m], b[n], acc[m][nh * 4 + n], 0, 0, 0);
        }
        s_cur = (s_cur == 2) ? 0 : s_cur + 1;
        s_nxt = (s_nxt == 2) ? 0 : s_nxt + 1;
    }
    __syncthreads();
}

template <class FV, class FD>
__device__ __forceinline__ void wave_store_bf16_f(FV val, FD dst) {
    const int lane = TIDX & 63, wid = TIDX >> 6, fr = lane & 15, fq = lane >> 4;
    char* base = smem + wid * 9216;
#pragma unroll
    for (int m = 0; m < 4; ++m)
#pragma unroll
        for (int n = 0; n < 4; ++n)
#pragma unroll
            for (int j = 0; j < 4; ++j)
                *(u16*)(base + (m * 16 + fq * 4 + j) * 144 + (n * 16 + fr) * 2) = f2bf(val(m, n, j));
    asm volatile("s_waitcnt lgkmcnt(0)" ::: "memory");
    __builtin_amdgcn_wave_barrier();
#pragma unroll
    for (int i = 0; i < 8; ++i) {
        const int id = i * 64 + lane, row = id >> 3, ch = id & 7;
        const uint4 d = *(const uint4*)(base + row * 144 + ch * 16);
        u16* p = dst(row);
        if (p) *(uint4*)(p + ch * 8) = d;
    }
    asm volatile("s_waitcnt lgkmcnt(0)" ::: "memory");
    __builtin_amdgcn_wave_barrier();
}

template <class FD>
__device__ __forceinline__ void wave_store_bf16(const float (&v)[4][4][4], FD dst) {
    wave_store_bf16_f([&](int m, int n, int j) { return v[m][n][j]; }, dst);
}

struct ConvD { const float* src; u16* dst; int ld, ldd, k0, n0, mode, zr; };
__device__ __forceinline__ void conv_load(const ConvD& d, float (&v)[16]) {
    const int tid = TIDX;
#pragma unroll
    for (int i = 0; i < 16; ++i) v[i] = d.src[(size_t)(d.k0 + i * 4 + (tid >> 6)) * d.ld + d.n0 + (tid & 63)];
}
__device__ __forceinline__ void conv_store(const Params& p, const ConvD& d, const float (&v)[16]) {
    float* t = (float*)smem;
    const int tid = TIDX;
    __syncthreads();
#pragma unroll
    for (int i = 0; i < 16; ++i) t[(i * 4 + (tid >> 6)) * 65 + (tid & 63)] = v[i];
    __syncthreads();
    const int n = tid >> 2, kq = tid & 3;
    unsigned w[8];
#pragma unroll
    for (int i = 0; i < 8; ++i) w[i] = pack2(t[(kq * 16 + 2 * i) * 65 + n], t[(kq * 16 + 2 * i + 1) * 65 + n]);
    const int gn = d.n0 + n;
    int row = gn;
    if (d.mode == 1) row = (gn >> 4) * 32 + (gn & 15);
    else if (d.mode == 2) row = (gn >> 4) * 32 + 16 + (gn & 15);
    else if (d.mode == 3) row = n;
    uint4* o = (uint4*)(d.dst + (size_t)row * d.ldd + d.k0 + kq * 16);
    o[0] = make_uint4(w[0], w[1], w[2], w[3]);
    o[1] = make_uint4(w[4], w[5], w[6], w[7]);
    if (d.zr) {
        uint4* z = (uint4*)(WSP_WrT + (size_t)(64 + n) * 1024 + d.k0 + kq * 16);
        z[0] = make_uint4(0, 0, 0, 0); z[1] = make_uint4(0, 0, 0, 0);
    }
}

__device__ void ada_item(const Params& p, int item) {
    float* sc = (float*)smem;
    float* red = sc + 9 * 1024;
    const int tid = TIDX;
    __syncthreads();
    for (int i = tid; i < 9 * 1024; i += NTHR) {
        const int r = i >> 10, k = i & 1023;
        const float cv = (r < 8) ? p.c[r * 1024 + k] : p.c_ctx[k];
        sc[i] = siluf_(cv);
    }
    __syncthreads();
    const int kq = tid >> 6, jl = tid & 63, j = item * 64 + jl;
    float acc[9];
#pragma unroll
    for (int r = 0; r < 9; ++r) acc[r] = 0.f;
#pragma unroll 16
    for (int k = kq; k < 1024; k += 4) {
        const float w = p.w_ada[(size_t)k * 6144 + j];
#pragma unroll
        for (int r = 0; r < 9; ++r) acc[r] += sc[r * 1024 + k] * w;
    }
#pragma unroll
    for (int r = 0; r < 9; ++r) red[(kq * 9 + r) * 64 + jl] = acc[r];
    __syncthreads();
    for (int i = tid; i < 9 * 64; i += NTHR) {
        const int r = i >> 6, l = i & 63;
        const float s = red[(0 * 9 + r) * 64 + l] + red[(1 * 9 + r) * 64 + l] + red[(2 * 9 + r) * 64 + l] + red[(3 * 9 + r) * 64 + l];
        WSP_mod[r * 6144 + item * 64 + l] = s + p.b_ada[item * 64 + l];
    }
}

__device__ void rope_item(const Params& p) {
    for (int i = TIDX; i < 64 * 16; i += NTHR) {
        const int pos = i >> 4, k = i & 15;
        const float inv = exp2f(-(float)k * (13.287712379549449f / 16.f));
        float s, c;
        sincosf((float)pos * inv, &s, &c);
        WSP_rope[i] = make_float2(c, s);
    }
}

__device__ void ssm_table_item(const Params& p, int g, int dir) {
    float* pw = (float*)smem;
    float* Bb = pw + 17 * 64 * 2;
    float* Cc = Bb + 64 * 16 * 2;
    const int tid = TIDX;
    u16* tabS = WSP_TabS + (size_t)g * 256 * 256;
    u16* tabY = WSP_TabY + (size_t)g * 256 * 512;
    float* Kf = WSP_Kbuf + (size_t)(g * 2 + dir) * 4096;
    __syncthreads();
    {
        const int pidx = dir * 32 + g;
        const float dt = __expf(p.log_dt[pidx]);
        for (int i = tid; i < 17 * 64; i += NTHR) {
            const int tau = i >> 6, n = i & 63;
            const float are = p.a_re[pidx * 64 + n], aim = p.a_im[pidx * 64 + n];
            const float mag = __expf((float)tau * dt * are);
            float rev = (float)tau * (dt * aim * 0.15915494309189535f);
            rev -= rintf(rev);
            pw[i * 2] = mag * __builtin_amdgcn_cosf(rev);
            pw[i * 2 + 1] = mag * __builtin_amdgcn_sinf(rev);
        }
        __syncthreads();
        for (int i = tid; i < 64 * 16; i += NTHR) {
            const int n = i >> 4;
            const float are = p.a_re[pidx * 64 + n], aim = p.a_im[pidx * 64 + n];
            const float abr = pw[(64 + n) * 2], abi = pw[(64 + n) * 2 + 1];
            const float den = are * are + aim * aim, nre = abr - 1.f;
            const float cre = (nre * are + abi * aim) / den, cim = (abi * are - nre * aim) / den;
            const float br = p.b_re[(size_t)pidx * 1024 + i], bi = p.b_im[(size_t)pidx * 1024 + i];
            Bb[i * 2] = cre * br - cim * bi;
            Bb[i * 2 + 1] = cre * bi + cim * br;
            Cc[i * 2] = p.c_re[(size_t)pidx * 1024 + i];
            Cc[i * 2 + 1] = p.c_im[(size_t)pidx * 1024 + i];
        }
        __syncthreads();
        {
            const int tau = tid >> 4, pp = tid & 15;
            float s[16];
#pragma unroll
            for (int q = 0; q < 16; ++q) s[q] = 0.f;
            for (int n = 0; n < 64; ++n) {
                const float2 cv = *(const float2*)&Cc[(pp * 64 + n) * 2];
                const float2 wv = *(const float2*)&pw[(tau * 64 + n) * 2];
                const float zr = cv.x * wv.x - cv.y * wv.y, zi = cv.x * wv.y + cv.y * wv.x;
#pragma unroll
                for (int q = 0; q < 16; ++q) {
                    const float2 bv = *(const float2*)&Bb[(n * 16 + q) * 2];
                    s[q] += zr * bv.x - zi * bv.y;
                }
            }
#pragma unroll
            for (int q = 0; q < 4; ++q)
                *(float4*)(Kf + tau * 256 + pp * 16 + q * 4) = make_float4(s[4 * q], s[4 * q + 1], s[4 * q + 2], s[4 * q + 3]);
        }
        for (int id = tid; id < 128 * 32; id += NTHR) {
            const int rr = id >> 5, ch = id & 31, cpart = rr >> 6, n = rr & 63, s_ = ch >> 1, q0 = (ch & 1) * 8;
            const int e = dir == 0 ? 15 - s_ : s_;
            const float wr_ = pw[(e * 64 + n) * 2], wi_ = pw[(e * 64 + n) * 2 + 1];
            unsigned w[4];
#pragma unroll
            for (int i = 0; i < 4; ++i) {
                float v[2];
#pragma unroll
                for (int h = 0; h < 2; ++h) {
                    const float br = Bb[(n * 16 + q0 + 2 * i + h) * 2], bi = Bb[(n * 16 + q0 + 2 * i + h) * 2 + 1];
                    v[h] = cpart == 0 ? (wr_ * br - wi_ * bi) : (wr_ * bi + wi_ * br);
                }
                w[i] = pack2(v[0], v[1]);
            }
            *(uint4*)(tabS + (size_t)(dir * 128 + rr) * 256 + s_ * 16 + q0) = make_uint4(w[0], w[1], w[2], w[3]);
        }
        for (int id = tid; id < 256 * 16; id += NTHR) {
            const int m = id >> 4, ch = id & 15, t = m >> 4, pp = m & 15, cpart = ch >> 3, n0 = (ch & 7) * 8;
            const int e = dir == 0 ? t + 1 : 16 - t;
            unsigned w[4];
#pragma unroll
            for (int i = 0; i < 4; ++i) {
                float v[2];
#pragma unroll
                for (int h = 0; h < 2; ++h) {
                    const int n = n0 + 2 * i + h;
                    const float cr = Cc[(pp * 64 + n) * 2], ci = Cc[(pp * 64 + n) * 2 + 1];
                    const float wr_ = pw[(e * 64 + n) * 2], wi_ = pw[(e * 64 + n) * 2 + 1];
                    v[h] = cpart == 0 ? (cr * wr_ - ci * wi_) : -(cr * wi_ + ci * wr_);
                }
                w[i] = pack2(v[0], v[1]);
            }
            *(uint4*)(tabY + (size_t)m * 512 + 256 + dir * 128 + cpart * 64 + n0) = make_uint4(w[0], w[1], w[2], w[3]);
        }
    }
}

__device__ void ssm_toeplitz_item(const Params& p, int g) {
    float* Kf = (float*)smem;
    const int tid = TIDX;
    u16* tabY = WSP_TabY + (size_t)g * 256 * 512;
    __syncthreads();
    for (int i = tid; i < 2048; i += NTHR) ((float4*)Kf)[i] = ((const float4*)(WSP_Kbuf + (size_t)g * 8192))[i];
    __syncthreads();
    for (int id = tid; id < 256 * 32; id += NTHR) {
        const int m = id >> 5, ch = id & 31, t = m >> 4, pp = m & 15, s_ = ch >> 1, q0 = (ch & 1) * 8;
        unsigned w[4];
#pragma unroll
        for (int i = 0; i < 4; ++i) {
            float v[2];
#pragma unroll
            for (int h = 0; h < 2; ++h) {
                const int q = q0 + 2 * i + h;
                float val;
                if (s_ < t) val = Kf[((t - s_) * 16 + pp) * 16 + q];
                else if (s_ > t) val = Kf[4096 + ((s_ - t) * 16 + pp) * 16 + q];
                else val = Kf[(pp) * 16 + q] + Kf[4096 + pp * 16 + q] + (pp == q ? p.ssm_d[g * 16 + pp] : 0.f);
                v[h] = val;
            }
            w[i] = pack2(v[0], v[1]);
        }
        *(uint4*)(tabY + (size_t)m * 512 + s_ * 16 + q0) = make_uint4(w[0], w[1], w[2], w[3]);
    }
    __syncthreads();
}

#define N_CONV 6896
__device__ __forceinline__ ConvD conv_decode(const Params& p, int t) {
    ConvD d; d.mode = 0; d.zr = 0;
    if (t < 320) { d.src = p.w_in; d.ld = 1280; d.k0 = (t / 20) * 64; d.n0 = (t % 20) * 64; d.dst = WSP_WinT; d.ldd = 1024; return d; }
    t -= 320;
    if (t < 64) { d.src = p.w_glu; d.ld = 512; d.k0 = (t / 8) * 64; d.n0 = (t % 8) * 64; d.dst = WSP_WgluT; d.ldd = 512; return d; }
    t -= 64;
    if (t < 256) { d.src = p.w_out; d.ld = 1024; d.k0 = (t / 16) * 64; d.n0 = (t % 16) * 64; d.dst = WSP_WoutT; d.ldd = 1024; return d; }
    t -= 256;
    if (t < 16) { d.src = p.w_router; d.ld = 64; d.k0 = t * 64; d.n0 = 0; d.dst = WSP_WrT; d.ldd = 1024; d.zr = 1; return d; }
    t -= 16;
    if (t < 4096) {
        const int up = t >= 2048; const int tt = t & 2047, e = tt >> 5, r = tt & 31;
        d.src = (up ? p.w_up_e : p.w_gate_e) + (size_t)e * 131072; d.ld = 128; d.k0 = (r >> 1) * 64; d.n0 = (r & 1) * 64;
        d.dst = WSP_WguT + (size_t)e * 262144; d.ldd = 1024; d.mode = 1 + up; return d;
    }
    t -= 4096;
    if (t < 64) {
        const int up = t >= 32; const int r = t & 31;
        d.src = up ? p.w_up_s : p.w_gate_s; d.ld = 128; d.k0 = (r >> 1) * 64; d.n0 = (r & 1) * 64;
        d.dst = WSP_WguT + (size_t)64 * 262144; d.ldd = 1024; d.mode = 1 + up; return d;
    }
    t -= 64;
    if (t < 2048) { const int e = t >> 5, r = t & 31; d.src = p.w_down_e + (size_t)e * 131072; d.ld = 1024; d.k0 = (r >> 4) * 64; d.n0 = (r & 15) * 64; d.dst = WSP_WdT + (size_t)e * 131072; d.ldd = 128; return d; }
    t -= 2048;
    d.src = p.w_down_s; d.ld = 1024; d.k0 = (t >> 4) * 64; d.n0 = (t & 15) * 64; d.dst = WSP_WdT + (size_t)64 * 131072; d.ldd = 128; return d;
}

#define P0_CONV_B0 161
__device__ void phase0(const Params& p) {
    const int b = blockIdx.x, G = gridDim.x;
    if (G > P0_CONV_B0 + 32) {
        if (b < 64) ssm_table_item(p, b >> 1, b & 1);
        else if (b < 160) ada_item(p, b - 64);
        else if (b == 160) rope_item(p);
        else {
            const int stride = G - P0_CONV_B0;
            int t = b - P0_CONV_B0;
            if (t < N_CONV) {
                ConvD d = conv_decode(p, t);
                float v[16];
                conv_load(d, v);
                while (t < N_CONV) {
                    const int tn = t + stride;
                    ConvD dn = d;
                    float vn[16];
                    if (tn < N_CONV) { dn = conv_decode(p, tn); conv_load(dn, vn); }
                    conv_store(p, d, v);
                    d = dn;
#pragma unroll
                    for (int i = 0; i < 16; ++i) v[i] = vn[i];
                    t = tn;
                }
            }
        }
    } else {
        const int NU = 64 + 96 + 1 + N_CONV;
        for (int u = b; u < NU; u += G) {
            if (u < 64) ssm_table_item(p, u >> 1, u & 1);
            else if (u < 160) ada_item(p, u - 64);
            else if (u == 160) rope_item(p);
            else { ConvD d = conv_decode(p, u - 161); float v[16]; conv_load(d, v); conv_store(p, d, v); }
        }
    }
}

__device__ __forceinline__ void norm_mod_row(const float* src, const float* gain, const float* sh, const float* scl, u16* dst) {
    const int lane = TIDX & 63;
    float4 v[4];
    float ss = 0.f;
#pragma unroll
    for (int i = 0; i < 4; ++i) {
        v[i] = *(const float4*)(src + i * 256 + lane * 4);
        ss += v[i].x * v[i].x + v[i].y * v[i].y + v[i].z * v[i].z + v[i].w * v[i].w;
    }
    ss = wave_sum(ss);
    const float rs = rsqrtf(ss * (1.f / 1024.f) + EPS);
#pragma unroll
    for (int i = 0; i < 4; ++i) {
        const int c0 = i * 256 + lane * 4;
        const float4 g = *(const float4*)(gain + c0), s = *(const float4*)(sh + c0), k = *(const float4*)(scl + c0);
        const float a = v[i].x * rs * g.x * (1.f + k.x) + s.x, b = v[i].y * rs * g.y * (1.f + k.y) + s.y;
        const float c = v[i].z * rs * g.z * (1.f + k.z) + s.z, d = v[i].w * rs * g.w * (1.f + k.w) + s.w;
        *(uint2*)(dst + c0) = make_uint2(pack2(a, b), pack2(c, d));
    }
}

__device__ void phase1(const Params& p) {
    for (int g = blockIdx.x; g < 32; g += gridDim.x) ssm_toeplitz_item(p, g);
    const int wv = blockIdx.x * 4 + (TIDX >> 6), nwv = gridDim.x * 4;
    for (int r = wv; r < NROWS; r += nwv) {
        const float* src; const float* md;
        if (r < NLAT) { src = p.x + (size_t)r * 1024; md = WSP_mod + (r >> 11) * 6144; }
        else { src = p.ctx + (size_t)(r - NLAT) * 1024; md = WSP_mod + 8 * 6144; }
        norm_mod_row(src, p.norm_mix, md, md + 1024, WSP_Hb + (size_t)r * 1024);
    }
}

__device__ void phase2(const Params& p) {
    const int NU = 128 * 10 + 16 * 6;
    const int lane = TIDX & 63, wid = TIDX >> 6, wr = wid >> 1, wc = wid & 1, fr = lane & 15, fq = lane >> 4;
    for (int u = blockIdx.x; u < NU; u += gridDim.x) {
        int mt, nt;
        if (u < 1280) { mt = u / 10; nt = u % 10; } else { const int v = u - 1280; mt = 128 + v / 6; nt = 4 + v % 6; }
        const u16* A = WSP_Hb + (size_t)mt * 128 * 1024;
        const u16* B = WSP_WinT + (size_t)nt * 128 * 1024;
        f32x4 acc[4][4];
        gemm_tile(16,
            [&](int R, int C, int kt) { return (const void*)(A + (size_t)R * 1024 + kt * 64 + C); },
            [&](int R, int C, int kt) { return (const void*)(B + (size_t)R * 1024 + kt * 64 + C); }, acc);
        const int row0 = mt * 128 + wr * 64;
        const int col0 = nt * 128 + wc * 64;
        const bool is_lat = mt < 128;
        if (nt == 5) {
            const int kvh = wc;
#pragma unroll
            for (int m = 0; m < 4; ++m) {
                const int r = row0 + m * 16 + fq * 4;
                int b, pos;
                if (is_lat) { b = r >> 11; pos = r & 2047; } else { const int rc = r - NLAT; b = rc >> 8; pos = SEQ + (rc & 255); }
#pragma unroll
                for (int n = 0; n < 4; ++n) {
                    const int d = n * 16 + fr;
                    u16* dst = WSP_Vt + ((size_t)(b * 2 + kvh) * 64 + d) * VT_LD + pos;
                    *(uint2*)dst = make_uint2(pack2(acc[m][n][0], acc[m][n][1]), pack2(acc[m][n][2], acc[m][n][3]));
                }
            }
        } else {
            float v[4][4][4];
            const bool do_rope = is_lat && nt <= 4;
#pragma unroll
            for (int m = 0; m < 4; ++m)
#pragma unroll
                for (int j = 0; j < 4; ++j) {
                    if (do_rope) {
                        const int r = row0 + m * 16 + fq * 4 + j, pos = r & 2047;
                        const float2 cr = WSP_rope[(pos >> 6) * 16 + fr], cc = WSP_rope[(pos & 63) * 16 + fr];
                        const float x1 = acc[m][0][j], x2 = acc[m][1][j], y1 = acc[m][2][j], y2 = acc[m][3][j];
                        v[m][0][j] = x1 * cr.x - x2 * cr.y; v[m][1][j] = x1 * cr.y + x2 * cr.x;
                        v[m][2][j] = y1 * cc.x - y2 * cc.y; v[m][3][j] = y1 * cc.y + y2 * cc.x;
                    } else {
#pragma unroll
                        for (int n = 0; n < 4; ++n) v[m][n][j] = acc[m][n][j];
                    }
                }
            u16* dbase; int ldd;
            if (nt < 4) { dbase = WSP_Q + (size_t)row0 * 512 + col0; ldd = 512; }
            else if (nt == 4) { dbase = WSP_Kb + (size_t)row0 * 128 + (col0 - 512); ldd = 128; }
            else { dbase = WSP_U + (size_t)row0 * 512 + (col0 - 768); ldd = 512; }
            wave_store_bf16(v, [&](int row) { return dbase + (size_t)row * ldd; });
        }
    }
}

__device__ void attn_unit(const Params& p, int u) {
    const int h = u & 7, qb = (u >> 3) & 15, b = u >> 7, kvh = h >> 2;
    const int tid = TIDX, lane = tid & 63, wid = tid >> 6, fr = lane & 15, fq = lane >> 4;
    const int sb = lane * 16, swz = sb ^ (((sb >> 9) & 1) << 5);
    const int r_in = swz >> 6, c_in = (swz & 63) >> 1;
    const int jstart = qb == 0 ? 2 : 0, jend = qb == 15 ? 4 : 6, nb = jend - jstart, ntile = nb + 4;
    const float SC = 0.125f * 1.4426950408889634f;
    bf16x8 qf[2][2];
    const int qrow0 = b * SEQ + qb * 128 + wid * 32;
#pragma unroll
    for (int qt = 0; qt < 2; ++qt)
#pragma unroll
        for (int ks = 0; ks < 2; ++ks)
            qf[qt][ks] = *(const bf16x8*)(WSP_Q + (size_t)(qrow0 + qt * 16 + fr) * 512 + h * 64 + ks * 32 + fq * 8);
    f32x4 o[4][2];
#pragma unroll
    for (int dt = 0; dt < 4; ++dt)
#pragma unroll
        for (int qt = 0; qt < 2; ++qt) o[dt][qt] = (f32x4){0.f, 0.f, 0.f, 0.f};
    float mrun[2], lrun[2];
    const float sinkv = p.attn_sink[h] * 1.4426950408889634f;
    mrun[0] = mrun[1] = sinkv;
    lrun[0] = lrun[1] = (fq == 0) ? 1.f : 0.f;
    __syncthreads();
    auto stage = [&](int i, int s) {
        const u16* kbase; const u16* vbase;
        if (i < nb) {
            const int ks0 = qb * 128 - 128 + 64 * (jstart + i);
            kbase = WSP_Kb + (size_t)(b * SEQ + ks0) * 128 + kvh * 64;
            vbase = WSP_Vt + (size_t)(b * 2 + kvh) * 64 * VT_LD + ks0;
        } else {
            const int c0 = 64 * (i - nb);
            kbase = WSP_Kb + (size_t)(NLAT + b * CTXL + c0) * 128 + kvh * 64;
            vbase = WSP_Vt + (size_t)(b * 2 + kvh) * 64 * VT_LD + SEQ + c0;
        }
        char* sk = smem + s * 16384;
        char* sv = sk + 8192;
#pragma unroll
        for (int it = 0; it < 2; ++it) {
            const int st = wid + 4 * it, R = (st >> 1) * 16 + r_in, C = (st & 1) * 32 + c_in;
            glds16(kbase + (size_t)R * 128 + C, sk + tid * 16 + it * 4096);
            glds16(vbase + (size_t)R * VT_LD + C, sv + tid * 16 + it * 4096);
        }
    };
    stage(0, 0);
    for (int i = 0; i < ntile; ++i) {
        asm volatile("s_waitcnt vmcnt(0)" ::: "memory");
        __syncthreads();
        if (i + 1 < ntile) stage(i + 1, (i + 1) & 1);
        const char* sk = smem + (i & 1) * 16384;
        const char* sv = sk + 8192;
        f32x4 s[4][2];
#pragma unroll
        for (int kt = 0; kt < 4; ++kt)
#pragma unroll
            for (int qt = 0; qt < 2; ++qt) s[kt][qt] = (f32x4){0.f, 0.f, 0.f, 0.f};
#pragma unroll
        for (int ks = 0; ks < 2; ++ks)
#pragma unroll
            for (int kt = 0; kt < 4; ++kt) {
                const bf16x8 kf = *(const bf16x8*)(sk + lds_byte(kt * 16 + fr, ks * 32 + fq * 8));
#pragma unroll
                for (int qt = 0; qt < 2; ++qt) s[kt][qt] = __builtin_amdgcn_mfma_f32_16x16x32_bf16(kf, qf[qt][ks], s[kt][qt], 0, 0, 0);
            }
        const bool band = i < nb;
        const int ks0 = qb * 128 - 128 + 64 * (jstart + i);
        bf16x8 pf[2][2];
#pragma unroll
        for (int qt = 0; qt < 2; ++qt) {
            const int qp = qb * 128 + wid * 32 + qt * 16 + fr;
            float mx = -1e30f;
#pragma unroll
            for (int kt = 0; kt < 4; ++kt)
#pragma unroll
                for (int j = 0; j < 4; ++j) {
                    float v = s[kt][qt][j] * SC;
                    if (band) {
                        const int kp = ks0 + kt * 16 + fq * 4 + j, d = qp - kp;
                        if (d > 128 || d < -128) v = -1e30f;
                    }
                    s[kt][qt][j] = v;
                    mx = fmaxf(mx, v);
                }
            mx = fmaxf(mx, __shfl_xor(mx, 16));
            mx = fmaxf(mx, __shfl_xor(mx, 32));
            const float mnew = fmaxf(mrun[qt], mx);
            const float alpha = __builtin_amdgcn_exp2f(mrun[qt] - mnew);
            mrun[qt] = mnew;
            float ls = 0.f;
#pragma unroll
            for (int kt = 0; kt < 4; ++kt)
#pragma unroll
                for (int j = 0; j < 4; ++j) {
                    const float pv = __builtin_amdgcn_exp2f(s[kt][qt][j] - mnew);
                    s[kt][qt][j] = pv;
                    ls += pv;
                }
            lrun[qt] = lrun[qt] * alpha + ls;
#pragma unroll
            for (int dt = 0; dt < 4; ++dt) o[dt][qt] *= alpha;
#pragma unroll
            for (int k2 = 0; k2 < 2; ++k2) {
                bf16x8 t;
#pragma unroll
                for (int j = 0; j < 4; ++j) { t[j] = (short)f2bf(s[2 * k2][qt][j]); t[4 + j] = (short)f2bf(s[2 * k2 + 1][qt][j]); }
                pf[qt][k2] = t;
            }
        }
#pragma unroll
        for (int k2 = 0; k2 < 2; ++k2)
#pragma unroll
            for (int dt = 0; dt < 4; ++dt) {
                const uint2 lo = *(const uint2*)(sv + lds_byte(dt * 16 + fr, k2 * 32 + fq * 4));
                const uint2 hi = *(const uint2*)(sv + lds_byte(dt * 16 + fr, k2 * 32 + 16 + fq * 4));
                union { uint4 u; bf16x8 v; } cv; cv.u = make_uint4(lo.x, lo.y, hi.x, hi.y);
#pragma unroll
                for (int qt = 0; qt < 2; ++qt) o[dt][qt] = __builtin_amdgcn_mfma_f32_16x16x32_bf16(cv.v, pf[qt][k2], o[dt][qt], 0, 0, 0);
            }
    }
#pragma unroll
    for (int qt = 0; qt < 2; ++qt) {
        float l = lrun[qt];
        l += __shfl_xor(l, 16);
        l += __shfl_xor(l, 32);
        const float inv = 1.f / l;
        u16* dst = WSP_AO + (size_t)(qrow0 + qt * 16 + fr) * 512 + h * 64 + fq * 4;
#pragma unroll
        for (int dt = 0; dt < 4; ++dt)
            *(uint2*)(dst + dt * 16) = make_uint2(pack2(o[dt][qt][0] * inv, o[dt][qt][1] * inv), pack2(o[dt][qt][2] * inv, o[dt][qt][3] * inv));
    }
}

__device__ void ssm_s1_unit(const Params& p, int u) {
    const int ct = u % 9, mh = (u / 9) & 1, g = u / 18;
    const int lane = TIDX & 63, wid = TIDX >> 6, wr = wid >> 1, wc = wid & 1, fr = lane & 15, fq = lane >> 4;
    const u16* A = WSP_TabS + ((size_t)g * 256 + mh * 128) * 256;
    const u16* Ub = WSP_U + (size_t)ct * 128 * 16 * 512 + g * 16;
    f32x4 acc[4][4];
    gemm_tile(4,
        [&](int R, int C, int kt) { return (const void*)(A + (size_t)R * 256 + kt * 64 + C); },
        [&](int R, int C, int kt) { return (const void*)(Ub + (size_t)(R * 16 + kt * 4 + (C >> 4)) * 512 + (C & 15)); }, acc);
#pragma unroll
    for (int m = 0; m < 4; ++m)
#pragma unroll
        for (int n = 0; n < 4; ++n) {
            const int rho = mh * 128 + wr * 64 + m * 16 + fq * 4;
            const int cg = ct * 128 + wc * 64 + n * 16 + fr;
            *(f32x4*)(WSP_S + ((size_t)cg * 32 + g) * 256 + rho) = acc[m][n];
        }
}

__device__ void phase3(const Params& p) {
    const int NU = 1024 + 576;
    for (int u = blockIdx.x; u < NU; u += gridDim.x) {
        if (u < 1024) attn_unit(p, u); else ssm_s1_unit(p, u - 1024);
    }
}

__device__ void phase4(const Params& p) {
    const int gid = blockIdx.x * NTHR + TIDX;
    if (gid >= BATCH * 2 * 32 * 64) return;
    const int n = gid & 63, g = (gid >> 6) & 31, dir = (gid >> 11) & 1, b = gid >> 12;
    const int pidx = dir * 32 + g;
    const float dt = __expf(p.log_dt[pidx]);
    const float are = p.a_re[pidx * 64 + n], aim = p.a_im[pidx * 64 + n];
    const float mag = __expf(16.f * dt * are);
    float rev = 16.f * (dt * aim * 0.15915494309189535f);
    rev -= rintf(rev);
    const float ar = mag * __builtin_amdgcn_cosf(rev), ai = mag * __builtin_amdgcn_sinf(rev);
    float hr = 0.f, hi = 0.f;
    const size_t so = (size_t)g * 256 + dir * 128 + n;
#pragma unroll 8
    for (int i = 0; i < 16; ++i) {
        const int c = dir == 0 ? i : 15 - i;
        const float* sp = WSP_S + (size_t)(NCHUNK_LAT + b * 16 + c) * 8192 + so;
        const float sr = sp[0], si = sp[64];
        const float nr = ar * hr - ai * hi + sr, ni = ar * hi + ai * hr + si;
        hr = nr; hi = ni;
    }
#pragma unroll 8
    for (int i = 0; i < 128; ++i) {
        const int c = dir == 0 ? i : 127 - i;
        const size_t cg = (size_t)b * 128 + c;
        const float* sp = WSP_S + cg * 8192 + so;
        const float sr = sp[0], si = sp[64];
        u16* hp = WSP_Hin + cg * 8192 + so;
        hp[0] = f2bf(hr); hp[64] = f2bf(hi);
        const float nr = ar * hr - ai * hi + sr, ni = ar * hi + ai * hr + si;
        hr = nr; hi = ni;
    }
}

__device__ void phase5(const Params& p) {
    const int NU = 512;
    const int lane = TIDX & 63, wid = TIDX >> 6, wr = wid >> 1, wc = wid & 1, fr = lane & 15, fq = lane >> 4;
    for (int u = blockIdx.x; u < NU; u += gridDim.x) {
        const int ct = u & 7, mh = (u >> 3) & 1, g = u >> 4;
        const u16* A = WSP_TabY + ((size_t)g * 256 + mh * 128) * 512;
        const u16* Ub = WSP_U + (size_t)ct * 128 * 16 * 512 + g * 16;
        const u16* Hb_ = WSP_Hin + (size_t)ct * 128 * 8192 + g * 256;
        f32x4 acc[4][4];
        gemm_tile(8,
            [&](int R, int C, int kt) { return (const void*)(A + (size_t)R * 512 + kt * 64 + C); },
            [&](int R, int C, int kt) {
                return kt < 4 ? (const void*)(Ub + (size_t)(R * 16 + kt * 4 + (C >> 4)) * 512 + (C & 15))
                              : (const void*)(Hb_ + (size_t)R * 8192 + (kt - 4) * 64 + C);
            }, acc);
#pragma unroll
        for (int m = 0; m < 4; ++m)
#pragma unroll
            for (int n = 0; n < 4; ++n) {
                const int t = mh * 8 + wr * 4 + m;
                const int cg = ct * 128 + wc * 64 + n * 16 + fr;
                u16* dst = WSP_Y + ((size_t)cg * 16 + t) * 512 + g * 16 + fq * 4;
                *(uint2*)dst = make_uint2(pack2(gelu_tanh(acc[m][n][0]), gelu_tanh(acc[m][n][1])),
                                          pack2(gelu_tanh(acc[m][n][2]), gelu_tanh(acc[m][n][3])));
            }
    }
}

__device__ void phase6(const Params& p) {
    const int NU = 512;
    const int lane = TIDX & 63, wid = TIDX >> 6, wr = wid >> 1, wc = wid & 1, fr = lane & 15, fq = lane >> 4;
    for (int u = blockIdx.x; u < NU; u += gridDim.x) {
        const int mt = u >> 2, nt = u & 3;
        const u16* A = WSP_Y + (size_t)mt * 128 * 512;
        const u16* B = WSP_WgluT + (size_t)nt * 128 * 512;
        f32x4 acc[4][4];
        gemm_tile(8,
            [&](int R, int C, int kt) { return (const void*)(A + (size_t)R * 512 + kt * 64 + C); },
            [&](int R, int C, int kt) { return (const void*)(B + (size_t)R * 512 + kt * 64 + C); }, acc);
        const int row0 = mt * 128 + wr * 64, col0 = nt * 128 + wc * 64;
        float v[4][4][4];
#pragma unroll
        for (int m = 0; m < 4; ++m)
#pragma unroll
            for (int n = 0; n < 4; ++n)
#pragma unroll
                for (int j = 0; j < 4; ++j) {
                    const int r = row0 + m * 16 + fq * 4 + j, c = col0 + n * 16 + fr;
                    const float yv = bf2f(WSP_Y[(size_t)r * 512 + c]);
                    v[m][n][j] = yv * sigmoidf_(acc[m][n][j] + p.b_glu[c]);
                }
        u16* dbase = WSP_SO + (size_t)row0 * 512 + col0;
        wave_store_bf16(v, [&](int row) { return dbase + (size_t)row * 512; });
    }
}

__device__ void phase7(const Params& p) {
    const int lane = TIDX & 63;
    const int wv = blockIdx.x * 4 + (TIDX >> 6), nwv = gridDim.x * 4;
    for (int it = wv; it < NLAT * 2; it += nwv) {
        const int r = it >> 1, half = it & 1;
        const u16* src = (half ? WSP_SO : WSP_AO) + (size_t)r * 512 + lane * 8;
        const float* gain = (half ? p.norm_ssm_out : p.norm_attn_out) + lane * 8;
        const uint4 d = *(const uint4*)src;
        float f[8];
        f[0] = bf2f((u16)(d.x & 0xffff)); f[1] = bf2f((u16)(d.x >> 16));
        f[2] = bf2f((u16)(d.y & 0xffff)); f[3] = bf2f((u16)(d.y >> 16));
        f[4] = bf2f((u16)(d.z & 0xffff)); f[5] = bf2f((u16)(d.z >> 16));
        f[6] = bf2f((u16)(d.w & 0xffff)); f[7] = bf2f((u16)(d.w >> 16));
        float ss = 0.f;
#pragma unroll
        for (int i = 0; i < 8; ++i) ss += f[i] * f[i];
        ss = wave_sum(ss);
        const float rs = rsqrtf(ss * (1.f / 512.f) + EPS);
        const float4 g0 = *(const float4*)gain, g1 = *(const float4*)(gain + 4);
        *(uint4*)(WSP_CAT + (size_t)r * 1024 + half * 512 + lane * 8) =
            make_uint4(pack2(f[0] * rs * g0.x, f[1] * rs * g0.y), pack2(f[2] * rs * g0.z, f[3] * rs * g0.w),
                       pack2(f[4] * rs * g1.x, f[5] * rs * g1.y), pack2(f[6] * rs * g1.z, f[7] * rs * g1.w));
    }
}

__device__ void phase8(const Params& p) {
    const int NU = 512;
    const int lane = TIDX & 63, wid = TIDX >> 6, wr = wid >> 1, wc = wid & 1, fr = lane & 15, fq = lane >> 4;
    for (int u = blockIdx.x; u < NU; u += gridDim.x) {
        const int mt = u >> 2, nt = u & 3;
        const u16* A = WSP_CAT + (size_t)mt * 128 * 1024;
        const u16* B = WSP_WoutT + (size_t)nt * 256 * 1024;
        f32x4 acc[4][8];
        gemm_tile_w(32,
            [&](int i, int R, int C, int kt) { return (const void*)(A + (size_t)R * 1024 + kt * 32 + C); },
            [&](int i, int R, int C, int kt) { return (const void*)(B + (size_t)R * 1024 + kt * 32 + C); }, acc);
        const int row0 = mt * 128 + wr * 64, col0 = nt * 256 + wc * 128;
        const float* g1 = WSP_mod + (mt >> 4) * 6144 + 2048;
#pragma unroll
        for (int m = 0; m < 4; ++m)
#pragma unroll
            for (int n = 0; n < 8; ++n)
#pragma unroll
                for (int j = 0; j < 4; ++j) {
                    const int r = row0 + m * 16 + fq * 4 + j, c = col0 + n * 16 + fr;
                    p.out[(size_t)r * 1024 + c] = p.x[(size_t)r * 1024 + c] + g1[c] * acc[m][n][j];
                }
    }
}

__device__ void phase9(const Params& p) {
    const int wv = blockIdx.x * 4 + (TIDX >> 6), nwv = gridDim.x * 4;
    for (int r = wv; r < NLAT; r += nwv) {
        const float* md = WSP_mod + (r >> 11) * 6144;
        norm_mod_row(p.out + (size_t)r * 1024, p.norm_ffn, md + 3072, md + 4096, WSP_H2 + (size_t)r * 1024);
    }
}

#define CTR_ECNT 0
#define CTR_Q11 128
#define CTR_Q12 136
#define HALF_TOK 8192
#define HH_HALF_ROWS 73728
#define ELIST_CAP 8192
__device__ void phase10(const Params& p) {
    const int NU = 128;
    const int tid = TIDX, lane = tid & 63, wid = tid >> 6, wr = wid >> 1, wc = wid & 1, fr = lane & 15, fq = lane >> 4;
    float* sc = (float*)smem;
    int* hist = (int*)(smem + 32768);
    int* gbase = hist + 64;
    int* fill = gbase + 64;
    unsigned char* selk = (unsigned char*)(fill + 64);
    for (int u = blockIdx.x; u < NU; u += gridDim.x) {
        const u16* A = WSP_H2 + (size_t)u * 128 * 1024;
        const u16* B = WSP_WrT;
        f32x4 acc[4][4];
        gemm_tile(16,
            [&](int R, int C, int kt) { return (const void*)(A + (size_t)R * 1024 + kt * 64 + C); },
            [&](int R, int C, int kt) { return (const void*)(B + (size_t)R * 1024 + kt * 64 + C); }, acc);
        if (wc == 0) {
#pragma unroll
            for (int m = 0; m < 4; ++m)
#pragma unroll
                for (int n = 0; n < 4; ++n)
#pragma unroll
                    for (int j = 0; j < 4; ++j)
                        sc[(wr * 64 + m * 16 + fq * 4 + j) * 64 + n * 16 + fr] = sigmoidf_(acc[m][n][j]);
        }
        if (tid < 64) hist[tid] = 0;
        __syncthreads();
        const float bias = p.router_bias[lane];
        const int grp = lane >> 3;
        for (int rr = 0; rr < 32; ++rr) {
            const int row = wid * 32 + rr, tok = u * 128 + row;
            const float s = sc[row * 64 + lane];
            const float bz = s + bias;
            float m1 = bz;
            m1 = fmaxf(m1, __shfl_xor(m1, 1)); m1 = fmaxf(m1, __shfl_xor(m1, 2)); m1 = fmaxf(m1, __shfl_xor(m1, 4));
            const unsigned long long eq = __ballot(bz == m1);
            const unsigned gb = (unsigned)((eq >> (grp * 8)) & 0xffull);
            const int first = __ffs(gb) - 1;
            float v2 = ((lane & 7) == first) ? -1e30f : bz;
            v2 = fmaxf(v2, __shfl_xor(v2, 1)); v2 = fmaxf(v2, __shfl_xor(v2, 2)); v2 = fmaxf(v2, __shfl_xor(v2, 4));
            const float gs = m1 + v2;
            int cnt = 0;
#pragma unroll
            for (int j = 0; j < 8; ++j) {
                const float gj = __int_as_float(__builtin_amdgcn_readlane(__float_as_int(gs), j * 8));
                cnt += (gj > gs || (gj == gs && j < grp)) ? 1 : 0;
            }
            const bool gsel = cnt < 4;
            const float mv = gsel ? bz : -1e30f;
            int rank = 0;
#pragma unroll
            for (int j = 0; j < 64; ++j) {
                const float vj = __int_as_float(__builtin_amdgcn_readlane(__float_as_int(mv), j));
                rank += (vj > mv || (vj == mv && j < lane)) ? 1 : 0;
            }
            const bool sel = gsel && rank < 8;
            const float tot = wave_sum(sel ? s : 0.f);
            if (sel) {
                WSP_WGT[(size_t)tok * 8 + rank] = s / tot * 2.5f;
                selk[row * 8 + rank] = (unsigned char)lane;
                atomicAdd(&hist[lane], 1);
            }
        }
        __syncthreads();
        const int h = u >> 6;
        if (tid < 64) {
            gbase[tid] = (int)atomicAdd(&WSP_ctr[CTR_ECNT + h * 64 + tid], (unsigned)hist[tid]);
            fill[tid] = 0;
        }
        __syncthreads();
        for (int i = tid; i < 1024; i += NTHR) {
            const int e = selk[i];
            const int pos = atomicAdd(&fill[e], 1);
            __hip_atomic_store(WSP_elist + (size_t)(h * 64 + e) * ELIST_CAP + gbase[e] + pos, (u * 128 + (i >> 3)) * 8 + (i & 7), __ATOMIC_RELAXED, __HIP_MEMORY_SCOPE_AGENT);
        }
        __syncthreads();
    }
}

struct MoeTab { int cnt[16]; int soff[16]; int pre[17]; };

__device__ void phase11(const Params& p) {
    const int tid = TIDX, lane = tid & 63, wid = tid >> 6, wr = wid >> 1, wc = wid & 1, fr = lane & 15, fq = lane >> 4;
    const int sb = lane * 16, swz = sb ^ (((sb >> 9) & 1) << 5);
    const int r_in = swz >> 6, c_in = (swz & 63) >> 1;
    int* tab = (int*)(smem + 73728);
    int* t_cnt = tab, *t_soff = tab + 16, *t_pre = tab + 32, *t_q = tab + 52;
    const int x = blockIdx.x & 7;
    __syncthreads();
    if (tid < 16) {
        const int i = tid >> 1, h = tid & 1, e = x + 8 * i;
        t_cnt[tid] = (int)WSP_ctr[CTR_ECNT + h * 64 + e];
        int so = 0;
        for (int e2 = 0; e2 < e; ++e2) so += (int)WSP_ctr[CTR_ECNT + h * 64 + e2];
        t_soff[tid] = so;
    }
    __syncthreads();
    if (tid == 0) {
        int s = 0;
        for (int j = 0; j < 16; ++j) { t_pre[j] = s; s += (t_cnt[j] + 127) >> 7; }
        t_pre[16] = s;
    }
    __syncthreads();
    const int T_r = t_pre[16], T_all = T_r + 16;
    for (;;) {
        __syncthreads();
        if (tid == 0) t_q[0] = (int)atomicAdd(&WSP_ctr[CTR_Q11 + x], 1u);
        __syncthreads();
        const int u = __builtin_amdgcn_readfirstlane(t_q[0]);
        if (u >= T_all) break;
        int e, h, mt, c, rowbase;
        const int* el = nullptr;
        if (u < T_r) {
            int j = 0;
#pragma unroll
            for (int q = 1; q < 16; ++q) j += (u >= t_pre[q]) ? 1 : 0;
            e = x + 8 * (j >> 1); h = j & 1; mt = u - t_pre[j]; c = t_cnt[j];
            rowbase = h * HH_HALF_ROWS + t_soff[j];
            el = WSP_elist + (size_t)(h * 64 + e) * ELIST_CAP;
        } else {
            const int ms = x * 16 + (u - T_r);
            e = 64; h = ms >> 6; mt = ms & 63; c = HALF_TOK;
            rowbase = h * HH_HALF_ROWS + 65536;
        }
        e = __builtin_amdgcn_readfirstlane(e); h = __builtin_amdgcn_readfirstlane(h); mt = __builtin_amdgcn_readfirstlane(mt);
        c = __builtin_amdgcn_readfirstlane(c); rowbase = __builtin_amdgcn_readfirstlane(rowbase);
        if (e < 64) el = WSP_elist + (size_t)(h * 64 + e) * ELIST_CAP;
        const u16* aptr[2];
#pragma unroll
        for (int i = 0; i < 2; ++i) {
            int li = mt * 128 + (wid + 4 * i) * 16 + r_in;
            li = li < c ? li : c - 1;
            const int tok = (e < 64) ? (el[li] >> 3) : (h * HALF_TOK + li);
            aptr[i] = WSP_H2 + (size_t)tok * 1024 + c_in;
        }
        const u16* Bw = WSP_WguT + (size_t)e * 262144 + c_in;
        f32x4 acc[4][8];
        gemm_tile_w(32,
            [&](int i, int R, int C, int kt) { return (const void*)(aptr[i] + kt * 32); },
            [&](int i, int R, int C, int kt) { return (const void*)(Bw + (size_t)R * 1024 + kt * 32); }, acc);
        float wgt[4][4];
#pragma unroll
        for (int m = 0; m < 4; ++m)
#pragma unroll
            for (int j = 0; j < 4; ++j) {
                const int li = mt * 128 + wr * 64 + m * 16 + fq * 4 + j;
                float w = 1.f;
                if (e < 64) w = (li < c) ? WSP_WGT[el[li]] : 0.f;
                wgt[m][j] = w;
            }
        u16* dbase = WSP_HHs + ((size_t)rowbase + mt * 128 + wr * 64) * 128 + wc * 64;
        const int vrows = c - mt * 128 - wr * 64;
        wave_store_bf16_f([&](int m, int n2, int j) { return siluf_(acc[m][2 * n2][j]) * acc[m][2 * n2 + 1][j] * wgt[m][j]; },
                          [&](int row) { return row < vrows ? dbase + (size_t)row * 128 : (u16*)nullptr; });
    }
}

__device__ void phase12a(const Params& p, int h) {
    const int tid = TIDX, lane = tid & 63, wid = tid >> 6, wr = wid >> 1, wc = wid & 1, fr = lane & 15, fq = lane >> 4;
    const int sb = lane * 16, swz = sb ^ (((sb >> 9) & 1) << 5);
    const int r_in = swz >> 6, c_in = (swz & 63) >> 1;
    int* tab = (int*)(smem + 73728);
    int* t_cnt = tab, *t_soff = tab + 16, *t_pre = tab + 32, *t_q = tab + 52;
    const int x = blockIdx.x & 7;
    __syncthreads();
    if (tid < 8) {
        const int e = x + 8 * tid;
        t_cnt[tid] = (int)WSP_ctr[CTR_ECNT + h * 64 + e];
        int so = 0;
        for (int e2 = 0; e2 < e; ++e2) so += (int)WSP_ctr[CTR_ECNT + h * 64 + e2];
        t_soff[tid] = so;
    }
    __syncthreads();
    if (tid == 0) {
        int s = 0;
        for (int j = 0; j < 8; ++j) { t_pre[j] = s; s += (t_cnt[j] + 127) >> 7; }
        t_pre[8] = s;
    }
    __syncthreads();
    const int T_r = t_pre[8] * 4, T_all = T_r + 32;
    for (;;) {
        __syncthreads();
        if (tid == 0) t_q[0] = (int)atomicAdd(&WSP_ctr[CTR_Q12 + h * 8 + x], 1u);
        __syncthreads();
        const int u = __builtin_amdgcn_readfirstlane(t_q[0]);
        if (u >= T_all) break;
        int e, mt, nt, c, rowbase;
        const int* el = nullptr;
        if (u < T_r) {
            const int um = u >> 2; nt = u & 3;
            int j = 0;
#pragma unroll
            for (int q = 1; q < 8; ++q) j += (um >= t_pre[q]) ? 1 : 0;
            e = x + 8 * j; mt = um - t_pre[j]; c = t_cnt[j];
            rowbase = h * HH_HALF_ROWS + t_soff[j];
            el = WSP_elist + (size_t)(h * 64 + e) * ELIST_CAP;
        } else {
            const int us = u - T_r; nt = us & 3;
            const int ms = x * 8 + (us >> 2);
            e = 64; mt = ms; c = HALF_TOK; rowbase = h * HH_HALF_ROWS + 65536;
        }
        e = __builtin_amdgcn_readfirstlane(e); mt = __builtin_amdgcn_readfirstlane(mt); nt = __builtin_amdgcn_readfirstlane(nt);
        c = __builtin_amdgcn_readfirstlane(c); rowbase = __builtin_amdgcn_readfirstlane(rowbase);
        if (e < 64) el = WSP_elist + (size_t)(h * 64 + e) * ELIST_CAP;
        const u16* aptr[2];
#pragma unroll
        for (int i = 0; i < 2; ++i) {
            int li = mt * 128 + (wid + 4 * i) * 16 + r_in;
            li = li < c ? li : c - 1;
            aptr[i] = WSP_HHs + ((size_t)rowbase + li) * 128 + c_in;
        }
        const u16* Bw = WSP_WdT + ((size_t)e * 1024 + nt * 256) * 128 + c_in;
        f32x4 acc[4][8];
        gemm_tile_w(4,
            [&](int i, int R, int C, int kt) { return (const void*)(aptr[i] + kt * 32); },
            [&](int i, int R, int C, int kt) { return (const void*)(Bw + (size_t)R * 128 + kt * 32); }, acc);
        const int vrows = c - mt * 128 - wr * 64;
#pragma unroll
        for (int hn = 0; hn < 2; ++hn) {
            const int colo = nt * 256 + wc * 128 + hn * 64;
            wave_store_bf16_f([&](int m, int n, int j) { return acc[m][hn * 4 + n][j]; }, [&](int row) {
                if (row >= vrows) return (u16*)nullptr;
                const int li = mt * 128 + wr * 64 + row;
                int tl, k;
                if (e < 64) { const int ent = el[li]; tl = (ent >> 3) - h * HALF_TOK; k = ent & 7; }
                else { tl = li; k = 8; }
                return WSP_Yd + ((size_t)tl * 9 + k) * 1024 + colo;
            });
        }
    }
}

__device__ void phase12b(const Params& p, int h) {
    const int lane = TIDX & 63;
    const int bb = (blockIdx.x + h) % gridDim.x;
    const int wv = bb * 4 + (TIDX >> 6), nwv = gridDim.x * 4;
    for (int tl = wv; tl < HALF_TOK; tl += nwv) {
        const int tok = h * HALF_TOK + tl;
        float* row = p.out + (size_t)tok * 1024 + lane * 16;
        const float* g2 = WSP_mod + (tok >> 11) * 6144 + 5120 + lane * 16;
        float s[16];
#pragma unroll
        for (int i = 0; i < 16; ++i) s[i] = 0.f;
        const u16* yp = WSP_Yd + (size_t)tl * 9 * 1024 + lane * 16;
#pragma unroll
        for (int k = 0; k < 9; ++k) {
            const uint4 a = *(const uint4*)(yp + k * 1024), b = *(const uint4*)(yp + k * 1024 + 8);
            const unsigned w[8] = {a.x, a.y, a.z, a.w, b.x, b.y, b.z, b.w};
#pragma unroll
            for (int i = 0; i < 8; ++i) { s[2 * i] += bf2f((u16)(w[i] & 0xffffu)); s[2 * i + 1] += bf2f((u16)(w[i] >> 16)); }
        }
        float ss = 0.f;
#pragma unroll
        for (int q = 0; q < 4; ++q) {
            const float4 xv = *(const float4*)(row + q * 4), gv = *(const float4*)(g2 + q * 4);
            s[4 * q] = xv.x + gv.x * s[4 * q]; s[4 * q + 1] = xv.y + gv.y * s[4 * q + 1];
            s[4 * q + 2] = xv.z + gv.z * s[4 * q + 2]; s[4 * q + 3] = xv.w + gv.w * s[4 * q + 3];
            ss += s[4 * q] * s[4 * q] + s[4 * q + 1] * s[4 * q + 1] + s[4 * q + 2] * s[4 * q + 2] + s[4 * q + 3] * s[4 * q + 3];
        }
        ss = wave_sum(ss);
        const float rs = rsqrtf(ss * (1.f / 1024.f) + EPS);
#pragma unroll
        for (int q = 0; q < 4; ++q) {
            const float4 g = *(const float4*)(p.norm_final + lane * 16 + q * 4);
            *(float4*)(row + q * 4) = make_float4(s[4 * q] * rs * g.x, s[4 * q + 1] * rs * g.y, s[4 * q + 2] * rs * g.z, s[4 * q + 3] * rs * g.w);
        }
    }
}

#define SMEM_TOTAL (73728 + 512 + 64)

#if 1
__global__ void __launch_bounds__(NTHR, 2) k_mega(Params p) {
    volatile LAS unsigned* st = (volatile LAS unsigned*)(smem + SMEM_TOTAL - 16);
    if (TIDX == 0) { st[0] = 0u; st[1] = 0u; st[2] = 0u; st[3] = 0u; }
    __syncthreads();
    XcdBarrier bar = xcd_barrier_post(WSP_bar, st);
#define RUNP(N) do { phase##N(p); if (PROBE_DUP == N) phase##N(p); } while (0)
    RUNP(0);  xcd_barrier(bar);
    RUNP(1);  xcd_barrier(bar);
    RUNP(2);  xcd_barrier(bar);
    RUNP(3);  xcd_barrier(bar);
    RUNP(4);  xcd_barrier(bar);
    RUNP(5);  xcd_barrier(bar);
    RUNP(6);  xcd_barrier(bar);
    RUNP(7);  xcd_barrier(bar);
    RUNP(8);  xcd_barrier(bar);
    RUNP(9);  xcd_barrier(bar);
    phase10(p); xcd_barrier(bar);
    phase11(p); xcd_barrier(bar);
    phase12a(p, 0); xcd_barrier(bar);
    phase12b(p, 0); xcd_barrier(bar);
    phase12a(p, 1); xcd_barrier(bar);
    phase12b(p, 1);
}
#endif


extern "C" void kernel_launch(void* const* d_in, const int* in_sizes, int n_in,
                              void* d_out, int out_size, void* d_ws, size_t ws_size,
                              hipStream_t stream) {
    Params p{};
    const float** ip = (const float**)&p.x;
    for (int i = 0; i < 32; ++i) ip[i] = (const float*)d_in[i];
    p.out = (float*)d_out;
    p.ws = (char*)d_ws;
    if (OFF_END > ws_size) { fprintf(stderr, "workspace too small: need %zu have %zu\n", (size_t)OFF_END, ws_size); return; }

    static int grid = 0;
    if (!grid) {
        hipFuncSetAttribute((const void*)k_mega, hipFuncAttributeMaxDynamicSharedMemorySize, SMEM_TOTAL);
        int dev = 0, cus = 0, per_cu = 0;
        hipGetDevice(&dev);
        hipDeviceGetAttribute(&cus, hipDeviceAttributeMultiprocessorCount, dev);
        hipOccupancyMaxActiveBlocksPerMultiprocessor(&per_cu, (const void*)k_mega, NTHR, SMEM_TOTAL);
        if (per_cu < 1) per_cu = 1;
        grid = cus * (per_cu < 2 ? per_cu : 2);
    }
    hipMemsetAsync(p.ws + OFF_BAR, 0, XCD_BAR_WORDS * 4 + 1024, stream);
    k_mega<<<grid, NTHR, SMEM_TOTAL, stream>>>(p);
}
```

```cpp
#include <hip/hip_runtime.h>
#include <hip/hip_bf16.h>
#include <stdint.h>
#include <stdio.h>

#ifndef MK_MULTI
#define MK_MULTI 0
#endif

typedef __attribute__((ext_vector_type(8))) short bf16x8;
typedef __attribute__((ext_vector_type(4))) short bf16x4;
typedef __attribute__((ext_vector_type(4))) float f32x4;
typedef unsigned short u16;
typedef __attribute__((ext_vector_type(4))) unsigned u32x4;

#ifndef PROBE_DUP
#define PROBE_DUP -1
#endif
#define NTHR 256
__device__ __forceinline__ int opaque_tid() { int t = (int)threadIdx.x; asm volatile("" : "+v"(t)); return t; }
#define TIDX opaque_tid()
#define LDS_BYTES 65536

#define D_MODEL 1024
#define BATCH 8
#define SEQ 2048
#define CTXL 256
#define NLAT (BATCH * SEQ)
#define NCTX (BATCH * CTXL)
#define NROWS (NLAT + NCTX)
#define INW 1280
#define NEXP 64
#define VT_LD (SEQ + CTXL)
#define NCHUNK_LAT 1024
#define NCHUNK_ALL 1152
#define EPS 1e-6f

#define XB_TMO      128
#define XB_XCNT(j)  (256  + 64 * (j))
#define XB_XSUB(j)  (1280 + 64 * (j))
#define XB_XGEN(j)  (2304 + 64 * (j))
#define XB_TOP      3328
#define XB_TOPGEN   3392
#define XCD_BAR_WORDS 3456
#define XB_SPIN_CAP (1u << 20)
#define LAS __attribute__((address_space(3)))

__device__ __forceinline__ unsigned xb_ld(unsigned* p)              { return __hip_atomic_load(p, __ATOMIC_RELAXED, __HIP_MEMORY_SCOPE_AGENT); }
__device__ __forceinline__ unsigned xb_add(unsigned* p, unsigned v) { return __hip_atomic_fetch_add(p, v, __ATOMIC_RELAXED, __HIP_MEMORY_SCOPE_AGENT); }
__device__ __forceinline__ unsigned xb_xcc_id() { return (unsigned)__builtin_amdgcn_s_getreg((3 << 11) | 20) & 0xFu; }
#define XB_SPIN(cond, bar) do { unsigned _sp = 0; while (cond) { __builtin_amdgcn_s_sleep(1); \
    if ((++_sp & 255u) == 0u) { if (xb_ld(&(bar)[XB_TMO])) break; if (_sp > XB_SPIN_CAP) { atomicAdd(&(bar)[XB_TMO], 1u); break; } } } } while (0)

struct XcdBarrier { unsigned* bar; unsigned x; volatile LAS unsigned* st; };

__device__ __forceinline__ XcdBarrier xcd_barrier_post(unsigned* bar, volatile LAS unsigned* st) {
    XcdBarrier b; b.bar = bar; b.x = xb_xcc_id(); b.st = st;
    if (TIDX == 0) (void)xb_add(&bar[XB_XCNT(b.x)], 1u);
    return b;
}
__device__ __forceinline__ void xcd_barrier_complete(unsigned* bar, unsigned x, unsigned& nloc, unsigned& nx) {
    const unsigned G = gridDim.x * gridDim.y * gridDim.z;
    unsigned sum, cnt, mine, sp = 0u;
    for (;;) {
        sum = 0u; cnt = 0u; mine = 0u;
#pragma unroll
        for (unsigned j = 0; j < 16; ++j) { const unsigned c = xb_ld(&bar[XB_XCNT(j)]); sum += c; cnt += (c > 0u) ? 1u : 0u; mine = (j == x) ? c : mine; }
        if (sum == G) break;
        __builtin_amdgcn_s_sleep(1);
        if ((++sp & 255u) == 0u) { if (xb_ld(&bar[XB_TMO])) break; if (sp > XB_SPIN_CAP) { atomicAdd(&bar[XB_TMO], 1u); break; } }
    }
    nloc = mine > 0u ? mine : 1u; nx = cnt > 0u ? cnt : 1u;
}
__device__ __forceinline__ void xcd_barrier(const XcdBarrier& b) {
    asm volatile("s_waitcnt vmcnt(0)" ::: "memory");
    __syncthreads();
    if (TIDX == 0) {
        unsigned* bar = b.bar;
        __builtin_amdgcn_s_waitcnt(0);
        unsigned nloc = b.st[0], nx = b.st[1];
        if (nloc == 0u) { xcd_barrier_complete(bar, b.x, nloc, nx); b.st[0] = nloc; b.st[1] = nx; }
        const unsigned old = xb_add(&bar[XB_XSUB(b.x)], 1u);
        const unsigned gen = old / nloc;
        if (old + 1u == (gen + 1u) * nloc) {
            __builtin_amdgcn_fence(__ATOMIC_RELEASE, "agent");
            asm volatile("s_waitcnt vmcnt(0)" ::: "memory");
            const unsigned og = xb_add(&bar[XB_TOP], 1u);
            const unsigned tg = og / nx;
            if (og + 1u == (tg + 1u) * nx) xb_add(&bar[XB_TOPGEN], 1u);
            else XB_SPIN(xb_ld(&bar[XB_TOPGEN]) == tg, bar);
            __builtin_amdgcn_fence(__ATOMIC_ACQUIRE, "agent");
            xb_add(&bar[XB_XGEN(b.x)], 1u);
            asm volatile("s_waitcnt vmcnt(0)" ::: "memory");
        } else {
            XB_SPIN(xb_ld(&bar[XB_XGEN(b.x)]) == gen, bar);
            __builtin_amdgcn_fence(__ATOMIC_ACQUIRE, "agent");
            asm volatile("s_waitcnt vmcnt(0)" ::: "memory");
        }
    }
    __syncthreads();
}

struct Params {
    const float *x, *c, *ctx, *c_ctx, *w_ada, *b_ada, *norm_mix, *norm_ffn, *w_in, *attn_sink,
        *a_re, *a_im, *log_dt, *b_re, *b_im, *c_re, *c_im, *ssm_d, *w_glu, *b_glu, *norm_attn_out, *norm_ssm_out,
        *w_out, *w_router, *router_bias, *w_gate_e, *w_up_e, *w_down_e, *w_gate_s, *w_up_s, *w_down_s, *norm_final;
    float* out;
    char* ws;
};

constexpr size_t A256(size_t v) { return (v + 255) & ~(size_t)255; }
constexpr size_t OFF_BAR   = 0;
constexpr size_t OFF_MOD   = A256(OFF_BAR + XCD_BAR_WORDS * 4 + 1024);
constexpr size_t OFF_ROPE  = A256(OFF_MOD + 9 * 6144 * 4);
constexpr size_t OFF_KBUF  = A256(OFF_ROPE + 64 * 16 * 8);
constexpr size_t OFF_IDX   = A256(OFF_KBUF + (size_t)32 * 2 * 4096 * 4);
constexpr size_t OFF_WGT   = A256(OFF_IDX + (size_t)NLAT * 8);
constexpr size_t OFF_ELIST = A256(OFF_WGT + (size_t)NLAT * 8 * 4);
constexpr size_t OFF_WINT  = A256(OFF_ELIST + (size_t)2 * 64 * 8192 * 4);
constexpr size_t OFF_WGLUT = A256(OFF_WINT + (size_t)1280 * 1024 * 2);
constexpr size_t OFF_WOUTT = A256(OFF_WGLUT + (size_t)512 * 512 * 2);
constexpr size_t OFF_WRT   = A256(OFF_WOUTT + (size_t)1024 * 1024 * 2);
constexpr size_t OFF_WDT   = A256(OFF_WRT + (size_t)128 * 1024 * 2);
constexpr size_t OFF_HHS   = A256(OFF_WDT + (size_t)65 * 1024 * 128 * 2);
constexpr size_t OFF_ARENA = A256(OFF_HHS + (size_t)2 * 73728 * 128 * 2);
constexpr size_t OFF_WGUT  = OFF_ARENA;
constexpr size_t OFF_TABS  = A256(OFF_WGUT + (size_t)65 * 256 * 1024 * 2);
constexpr size_t OFF_TABY  = A256(OFF_TABS + (size_t)32 * 256 * 256 * 2);
constexpr size_t OFF_R1    = A256(OFF_TABY + (size_t)32 * 256 * 512 * 2);
constexpr size_t OFF_R2    = A256(OFF_R1 + (size_t)NROWS * 1024 * 2);
constexpr size_t OFF_R3    = A256(OFF_R2 + (size_t)NLAT * 1024 * 2);
constexpr size_t OFF_R4    = A256(OFF_R3 + (size_t)NLAT * 1024 * 2);
constexpr size_t OFF_END   = A256(OFF_R4 + (size_t)NLAT * 512 * 2 * 2);
static_assert(OFF_END - OFF_ARENA >= (size_t)8192 * 9 * 1024 * 2, "arena must hold Yd");
#define WSP_bar   ((unsigned*)(p.ws + OFF_BAR))
#define WSP_ctr   ((unsigned*)(p.ws + OFF_BAR) + XCD_BAR_WORDS)
#define WSP_mod   ((float*)(p.ws + OFF_MOD))
#define WSP_rope  ((float2*)(p.ws + OFF_ROPE))
#define WSP_Kbuf  ((float*)(p.ws + OFF_KBUF))
#define WSP_WGT   ((float*)(p.ws + OFF_WGT))
#define WSP_elist ((int*)(p.ws + OFF_ELIST))
#define WSP_WinT  ((u16*)(p.ws + OFF_WINT))
#define WSP_WgluT ((u16*)(p.ws + OFF_WGLUT))
#define WSP_WoutT ((u16*)(p.ws + OFF_WOUTT))
#define WSP_WrT   ((u16*)(p.ws + OFF_WRT))
#define WSP_WdT   ((u16*)(p.ws + OFF_WDT))
#define WSP_HHs   ((u16*)(p.ws + OFF_HHS))
#define WSP_Yd    ((u16*)(p.ws + OFF_ARENA))
#define WSP_WguT  ((u16*)(p.ws + OFF_WGUT))
#define WSP_TabS  ((u16*)(p.ws + OFF_TABS))
#define WSP_TabY  ((u16*)(p.ws + OFF_TABY))
#define WSP_Hb    ((u16*)(p.ws + OFF_R1))
#define WSP_S     ((float*)(p.ws + OFF_R1))
#define WSP_H2    ((u16*)(p.ws + OFF_R1))
#define WSP_Q     ((u16*)(p.ws + OFF_R2))
#define WSP_Kb    ((u16*)(p.ws + OFF_R2 + (size_t)NLAT * 512 * 2))
#define WSP_Vt    ((u16*)(p.ws + OFF_R2 + (size_t)NLAT * 512 * 2 + (size_t)NROWS * 128 * 2))
#define WSP_Y     ((u16*)(p.ws + OFF_R2))
#define WSP_SO    ((u16*)(p.ws + OFF_R2 + (size_t)NLAT * 512 * 2))
#define WSP_U     ((u16*)(p.ws + OFF_R3))
#define WSP_CAT   ((u16*)(p.ws + OFF_R3))
#define WSP_AO    ((u16*)(p.ws + OFF_R4))
#define WSP_Hin   ((u16*)(p.ws + OFF_R4 + (size_t)NLAT * 512 * 2))

extern __shared__ __attribute__((aligned(16))) char smem[];

__device__ __forceinline__ u16 f2bf(float f) {
    unsigned u = __float_as_uint(f);
    u += 0x7fffu + ((u >> 16) & 1u);
    return (u16)(u >> 16);
}
__device__ __forceinline__ float bf2f(u16 h) { return __uint_as_float(((unsigned)h) << 16); }
__device__ __forceinline__ unsigned pack2(float a, float b) { return (unsigned)f2bf(a) | ((unsigned)f2bf(b) << 16); }
__device__ __forceinline__ void glds16(const void* g, void* l) {
    __builtin_amdgcn_global_load_lds((const unsigned*)g, (unsigned*)l, 16, 0, 0);
}
__device__ __forceinline__ int lds_byte(int r, int c) {
    int st = (r >> 4) * 2 + (c >> 5), rr = r & 15, cc = c & 31, ob = rr * 64 + cc * 2;
    return st * 1024 + (ob ^ (((ob >> 9) & 1) << 5));
}
__device__ __forceinline__ float wave_sum(float v) {
#pragma unroll
    for (int o = 32; o > 0; o >>= 1) v += __shfl_xor(v, o);
    return v;
}
__device__ __forceinline__ float sigmoidf_(float x) { return 1.f / (1.f + __expf(-x)); }
__device__ __forceinline__ float siluf_(float x) { return x / (1.f + __expf(-x)); }
__device__ __forceinline__ float gelu_tanh(float x) {
    float u = 0.7978845608028654f * (x + 0.044715f * x * x * x);
    return x / (1.f + __expf(-2.f * u));
}

template <class FA, class FB>
__device__ __forceinline__ void gemm_tile(int nkt, FA fa, FB fb, f32x4 (&acc)[4][4]) {
    const int tid = TIDX, lane = tid & 63, wid = tid >> 6, wr = wid >> 1, wc = wid & 1, fr = lane & 15, fq = lane >> 4;
    const int sb = lane * 16, swz = sb ^ (((sb >> 9) & 1) << 5);
    const int r_in = swz >> 6, c_in = (swz & 63) >> 1;
#pragma unroll
    for (int m = 0; m < 4; ++m)
#pragma unroll
        for (int n = 0; n < 4; ++n) acc[m][n] = (f32x4){0.f, 0.f, 0.f, 0.f};
    __syncthreads();
    auto stage = [&](int kt, int s) {
        char* sa = smem + s * 32768;
        char* sbm = sa + 16384;
#pragma unroll
        for (int i = 0; i < 4; ++i) {
            const int st = wid + 4 * i, R = (st >> 1) * 16 + r_in, C = (st & 1) * 32 + c_in;
            glds16(fa(R, C, kt), sa + tid * 16 + i * 4096);
            glds16(fb(R, C, kt), sbm + tid * 16 + i * 4096);
        }
    };
    stage(0, 0);
    for (int kt = 0; kt < nkt; ++kt) {
        asm volatile("s_waitcnt vmcnt(0)" ::: "memory");
        __syncthreads();
        if (kt + 1 < nkt) stage(kt + 1, (kt + 1) & 1);
        const char* sa = smem + (kt & 1) * 32768;
        const char* sbm = sa + 16384;
#pragma unroll
        for (int ks = 0; ks < 2; ++ks) {
            bf16x8 a[4], b[4];
#pragma unroll
            for (int m = 0; m < 4; ++m) a[m] = *(const bf16x8*)(sa + lds_byte(wr * 64 + m * 16 + fr, ks * 32 + fq * 8));
#pragma unroll
            for (int n = 0; n < 4; ++n) b[n] = *(const bf16x8*)(sbm + lds_byte(wc * 64 + n * 16 + fr, ks * 32 + fq * 8));
#pragma unroll
            for (int m = 0; m < 4; ++m)
#pragma unroll
                for (int n = 0; n < 4; ++n) acc[m][n] = __builtin_amdgcn_mfma_f32_16x16x32_bf16(a[m], b[n], acc[m][n], 0, 0, 0);
        }
    }
    __syncthreads();
}

__device__ __forceinline__ int lds32(int r, int c) {
    const int rr = r & 15;
    return (r >> 4) * 1024 + ((rr * 64 + c * 2) ^ (((rr >> 3) & 1) << 5));
}
template <class FA, class FB>
__device__ __forceinline__ void gemm_tile_w(int nkt, FA fa, FB fb, f32x4 (&acc)[4][8]) {
    const int tid = TIDX, lane = tid & 63, wid = tid >> 6, wr = wid >> 1, wc = wid & 1, fr = lane & 15, fq = lane >> 4;
    const int sb = lane * 16, swz = sb ^ (((sb >> 9) & 1) << 5);
    const int r_in = swz >> 6, c_in = (swz & 63) >> 1;
#pragma unroll
    for (int m = 0; m < 4; ++m)
#pragma unroll
        for (int n = 0; n < 8; ++n) acc[m][n] = (f32x4){0.f, 0.f, 0.f, 0.f};
    __syncthreads();
    auto stage = [&](int kt, int s) {
        char* sa = smem + s * 24576;
#pragma unroll
        for (int i = 0; i < 2; ++i) glds16(fa(i, (wid + 4 * i) * 16 + r_in, c_in, kt), sa + tid * 16 + i * 4096);
#pragma unroll
        for (int i = 0; i < 4; ++i) glds16(fb(i, (wid + 4 * i) * 16 + r_in, c_in, kt), sa + 8192 + tid * 16 + i * 4096);
    };
    stage(0, 0);
    if (nkt > 1) stage(1, 1);
    int s_cur = 0, s_nxt = 2;
    for (int kt = 0; kt < nkt; ++kt) {
        if (kt + 1 < nkt) asm volatile("s_waitcnt vmcnt(6) lgkmcnt(0)\n\ts_barrier" ::: "memory");
        else asm volatile("s_waitcnt vmcnt(0) lgkmcnt(0)\n\ts_barrier" ::: "memory");
        if (kt + 2 < nkt) stage(kt + 2, s_nxt);
        const char* sa = smem + s_cur * 24576;
        bf16x8 a[4];
#pragma unroll
        for (int m = 0; m < 4; ++m) a[m] = *(const bf16x8*)(sa + lds32(wr * 64 + m * 16 + fr, fq * 8));
#pragma unroll
        for (int nh = 0; nh < 2; ++nh) {
            bf16x8 b[4];
#pragma unroll
            for (int n = 0; n < 4; ++n) b[n] = *(const bf16x8*)(sa + 8192 + lds32(wc * 128 + (nh * 4 + n) * 16 + fr, fq * 8));
#pragma unroll
            for (int m = 0; m < 4; ++m)
#pragma unroll
                for (int n = 0; n < 4; ++n) acc[m][nh * 4 + n] = __builtin_amdgcn_mfma_f32_16x16x32_bf16(a[m], b[n], acc[m][nh * 4 + n], 0, 0, 0);
        }
        s_cur = (s_cur == 2) ? 0 : s_cur + 1;
        s_nxt = (s_nxt == 2) ? 0 : s_nxt + 1;
    }
    __syncthreads();
}

template <class FV, class FD>
__device__ __forceinline__ void wave_store_bf16_f(FV val, FD dst) {
    const int lane = TIDX & 63, wid = TIDX >> 6, fr = lane & 15, fq = lane >> 4;
    char* base = smem + wid * 9216;
#pragma unroll
    for (int m = 0; m < 4; ++m)
#pragma unroll
        for (int n = 0; n < 4; ++n)
#pragma unroll
            for (int j = 0; j < 4; ++j)
                *(u16*)(base + (m * 16 + fq * 4 + j) * 144 + (n * 16 + fr) * 2) = f2bf(val(m, n, j));
    asm volatile("s_waitcnt lgkmcnt(0)" ::: "memory");
    __builtin_amdgcn_wave_barrier();
#pragma unroll
    for (int i = 0; i < 8; ++i) {
        const int id = i * 64 + lane, row = id >> 3, ch = id & 7;
        const uint4 d = *(const uint4*)(base + row * 144 + ch * 16);
        u16* p = dst(row);
        if (p) *(uint4*)(p + ch * 8) = d;
    }
    asm volatile("s_waitcnt lgkmcnt(0)" ::: "memory");
    __builtin_amdgcn_wave_barrier();
}

template <class FD>
__device__ __forceinline__ void wave_store_bf16(const float (&v)[4][4][4], FD dst) {
    wave_store_bf16_f([&](int m, int n, int j) { return v[m][n][j]; }, dst);
}

struct ConvD { const float* src; u16* dst; int ld, ldd, k0, n0, mode, zr; };
__device__ __forceinline__ void conv_load(const ConvD& d, float (&v)[16]) {
    const int tid = TIDX;
#pragma unroll
    for (int i = 0; i < 16; ++i) v[i] = d.src[(size_t)(d.k0 + i * 4 + (tid >> 6)) * d.ld + d.n0 + (tid & 63)];
}
__device__ __forceinline__ void conv_store(const Params& p, const ConvD& d, const float (&v)[16]) {
    float* t = (float*)smem;
    const int tid = TIDX;
    __syncthreads();
#pragma unroll
    for (int i = 0; i < 16; ++i) t[(i * 4 + (tid >> 6)) * 65 + (tid & 63)] = v[i];
    __syncthreads();
    const int n = tid >> 2, kq = tid & 3;
    unsigned w[8];
#pragma unroll
    for (int i = 0; i < 8; ++i) w[i] = pack2(t[(kq * 16 + 2 * i) * 65 + n], t[(kq * 16 + 2 * i + 1) * 65 + n]);
    const int gn = d.n0 + n;
    int row = gn;
    if (d.mode == 1) row = (gn >> 4) * 32 + (gn & 15);
    else if (d.mode == 2) row = (gn >> 4) * 32 + 16 + (gn & 15);
    else if (d.mode == 3) row = n;
    uint4* o = (uint4*)(d.dst + (size_t)row * d.ldd + d.k0 + kq * 16);
    o[0] = make_uint4(w[0], w[1], w[2], w[3]);
    o[1] = make_uint4(w[4], w[5], w[6], w[7]);
    if (d.zr) {
        uint4* z = (uint4*)(WSP_WrT + (size_t)(64 + n) * 1024 + d.k0 + kq * 16);
        z[0] = make_uint4(0, 0, 0, 0); z[1] = make_uint4(0, 0, 0, 0);
    }
}

__device__ __forceinline__ void ada_item(const Params& p, int item) {
    float* sc = (float*)smem;
    float* red = sc + 9 * 1024;
    const int tid = TIDX;
    __syncthreads();
    for (int i = tid; i < 9 * 1024; i += NTHR) {
        const int r = i >> 10, k = i & 1023;
        const float cv = (r < 8) ? p.c[r * 1024 + k] : p.c_ctx[k];
        sc[i] = siluf_(cv);
    }
    __syncthreads();
    const int kq = tid >> 6, jl = tid & 63, j = item * 64 + jl;
    float acc[9];
#pragma unroll
    for (int r = 0; r < 9; ++r) acc[r] = 0.f;
#pragma unroll 16
    for (int k = kq; k < 1024; k += 4) {
        const float w = p.w_ada[(size_t)k * 6144 + j];
#pragma unroll
        for (int r = 0; r < 9; ++r) acc[r] += sc[r * 1024 + k] * w;
    }
#pragma unroll
    for (int r = 0; r < 9; ++r) red[(kq * 9 + r) * 64 + jl] = acc[r];
    __syncthreads();
    for (int i = tid; i < 9 * 64; i += NTHR) {
        const int r = i >> 6, l = i & 63;
        const float s = red[(0 * 9 + r) * 64 + l] + red[(1 * 9 + r) * 64 + l] + red[(2 * 9 + r) * 64 + l] + red[(3 * 9 + r) * 64 + l];
        WSP_mod[r * 6144 + item * 64 + l] = s + p.b_ada[item * 64 + l];
    }
}

__device__ __forceinline__ void rope_item(const Params& p) {
    for (int i = TIDX; i < 64 * 16; i += NTHR) {
        const int pos = i >> 4, k = i & 15;
        const float inv = exp2f(-(float)k * (13.287712379549449f / 16.f));
        float s, c;
        sincosf((float)pos * inv, &s, &c);
        WSP_rope[i] = make_float2(c, s);
    }
}

__device__ __forceinline__ void ssm_table_item(const Params& p, int g, int dir) {
    float* pw = (float*)smem;
    float* Bb = pw + 17 * 64 * 2;
    float* Cc = Bb + 64 * 16 * 2;
    const int tid = TIDX;
    u16* tabS = WSP_TabS + (size_t)g * 256 * 256;
    u16* tabY = WSP_TabY + (size_t)g * 256 * 512;
    float* Kf = WSP_Kbuf + (size_t)(g * 2 + dir) * 4096;
    __syncthreads();
    {
        const int pidx = dir * 32 + g;
        const float dt = __expf(p.log_dt[pidx]);
        for (int i = tid; i < 17 * 64; i += NTHR) {
            const int tau = i >> 6, n = i & 63;
            const float are = p.a_re[pidx * 64 + n], aim = p.a_im[pidx * 64 + n];
            const float mag = __expf((float)tau * dt * are);
            float rev = (float)tau * (dt * aim * 0.15915494309189535f);
            rev -= rintf(rev);
            pw[i * 2] = mag * __builtin_amdgcn_cosf(rev);
            pw[i * 2 + 1] = mag * __builtin_amdgcn_sinf(rev);
        }
        __syncthreads();
        for (int i = tid; i < 64 * 16; i += NTHR) {
            const int n = i >> 4;
            const float are = p.a_re[pidx * 64 + n], aim = p.a_im[pidx * 64 + n];
            const float abr = pw[(64 + n) * 2], abi = pw[(64 + n) * 2 + 1];
            const float den = are * are + aim * aim, nre = abr - 1.f;
            const float cre = (nre * are + abi * aim) / den, cim = (abi * are - nre * aim) / den;
            const float br = p.b_re[(size_t)pidx * 1024 + i], bi = p.b_im[(size_t)pidx * 1024 + i];
            Bb[i * 2] = cre * br - cim * bi;
            Bb[i * 2 + 1] = cre * bi + cim * br;
            Cc[i * 2] = p.c_re[(size_t)pidx * 1024 + i];
            Cc[i * 2 + 1] = p.c_im[(size_t)pidx * 1024 + i];
        }
        __syncthreads();
        {
            const int tau = tid >> 4, pp = tid & 15;
            float s[16];
#pragma unroll
            for (int q = 0; q < 16; ++q) s[q] = 0.f;
            for (int n = 0; n < 64; ++n) {
                const float2 cv = *(const float2*)&Cc[(pp * 64 + n) * 2];
                const float2 wv = *(const float2*)&pw[(tau * 64 + n) * 2];
                const float zr = cv.x * wv.x - cv.y * wv.y, zi = cv.x * wv.y + cv.y * wv.x;
#pragma unroll
                for (int q = 0; q < 16; ++q) {
                    const float2 bv = *(const float2*)&Bb[(n * 16 + q) * 2];
                    s[q] += zr * bv.x - zi * bv.y;
                }
            }
#pragma unroll
            for (int q = 0; q < 4; ++q)
                *(float4*)(Kf + tau * 256 + pp * 16 + q * 4) = make_float4(s[4 * q], s[4 * q + 1], s[4 * q + 2], s[4 * q + 3]);
        }
        for (int id = tid; id < 128 * 32; id += NTHR) {
            const int rr = id >> 5, ch = id & 31, cpart = rr >> 6, n = rr & 63, s_ = ch >> 1, q0 = (ch & 1) * 8;
            const int e = dir == 0 ? 15 - s_ : s_;
            const float wr_ = pw[(e * 64 + n) * 2], wi_ = pw[(e * 64 + n) * 2 + 1];
            unsigned w[4];
#pragma unroll
            for (int i = 0; i < 4; ++i) {
                float v[2];
#pragma unroll
                for (int h = 0; h < 2; ++h) {
                    const float br = Bb[(n * 16 + q0 + 2 * i + h) * 2], bi = Bb[(n * 16 + q0 + 2 * i + h) * 2 + 1];
                    v[h] = cpart == 0 ? (wr_ * br - wi_ * bi) : (wr_ * bi + wi_ * br);
                }
                w[i] = pack2(v[0], v[1]);
            }
            *(uint4*)(tabS + (size_t)(dir * 128 + rr) * 256 + s_ * 16 + q0) = make_uint4(w[0], w[1], w[2], w[3]);
        }
        for (int id = tid; id < 256 * 16; id += NTHR) {
            const int m = id >> 4, ch = id & 15, t = m >> 4, pp = m & 15, cpart = ch >> 3, n0 = (ch & 7) * 8;
            const int e = dir == 0 ? t + 1 : 16 - t;
            unsigned w[4];
#pragma unroll
            for (int i = 0; i < 4; ++i) {
                float v[2];
#pragma unroll
                for (int h = 0; h < 2; ++h) {
                    const int n = n0 + 2 * i + h;
                    const float cr = Cc[(pp * 64 + n) * 2], ci = Cc[(pp * 64 + n) * 2 + 1];
                    const float wr_ = pw[(e * 64 + n) * 2], wi_ = pw[(e * 64 + n) * 2 + 1];
                    v[h] = cpart == 0 ? (cr * wr_ - ci * wi_) : -(cr * wi_ + ci * wr_);
                }
                w[i] = pack2(v[0], v[1]);
            }
            *(uint4*)(tabY + (size_t)m * 512 + 256 + dir * 128 + cpart * 64 + n0) = make_uint4(w[0], w[1], w[2], w[3]);
        }
    }
}

__device__ __forceinline__ void ssm_toeplitz_item(const Params& p, int g) {
    float* Kf = (float*)smem;
    const int tid = TIDX;
    u16* tabY = WSP_TabY + (size_t)g * 256 * 512;
    __syncthreads();
    for (int i = tid; i < 2048; i += NTHR) ((float4*)Kf)[i] = ((const float4*)(WSP_Kbuf + (size_t)g * 8192))[i];
    __syncthreads();
    for (int id = tid; id < 256 * 32; id += NTHR) {
        const int m = id >> 5, ch = id & 31, t = m >> 4, pp = m & 15, s_ = ch >> 1, q0 = (ch & 1) * 8;
        unsigned w[4];
#pragma unroll
        for (int i = 0; i < 4; ++i) {
            float v[2];
#pragma unroll
            for (int h = 0; h < 2; ++h) {
                const int q = q0 + 2 * i + h;
                float val;
                if (s_ < t) val = Kf[((t - s_) * 16 + pp) * 16 + q];
                else if (s_ > t) val = Kf[4096 + ((s_ - t) * 16 + pp) * 16 + q];
                else val = Kf[(pp) * 16 + q] + Kf[4096 + pp * 16 + q] + (pp == q ? p.ssm_d[g * 16 + pp] : 0.f);
                v[h] = val;
            }
            w[i] = pack2(v[0], v[1]);
        }
        *(uint4*)(tabY + (size_t)m * 512 + s_ * 16 + q0) = make_uint4(w[0], w[1], w[2], w[3]);
    }
    __syncthreads();
}

#define N_CONV 6896
__device__ __forceinline__ ConvD conv_decode(const Params& p, int t) {
    ConvD d; d.mode = 0; d.zr = 0;
    if (t < 320) { d.src = p.w_in; d.ld = 1280; d.k0 = (t / 20) * 64; d.n0 = (t % 20) * 64; d.dst = WSP_WinT; d.ldd = 1024; return d; }
    t -= 320;
    if (t < 64) { d.src = p.w_glu; d.ld = 512; d.k0 = (t / 8) * 64; d.n0 = (t % 8) * 64; d.dst = WSP_WgluT; d.ldd = 512; return d; }
    t -= 64;
    if (t < 256) { d.src = p.w_out; d.ld = 1024; d.k0 = (t / 16) * 64; d.n0 = (t % 16) * 64; d.dst = WSP_WoutT; d.ldd = 1024; return d; }
    t -= 256;
    if (t < 16) { d.src = p.w_router; d.ld = 64; d.k0 = t * 64; d.n0 = 0; d.dst = WSP_WrT; d.ldd = 1024; d.zr = 1; return d; }
    t -= 16;
    if (t < 4096) {
        const int up = t >= 2048; const int tt = t & 2047, e = tt >> 5, r = tt & 31;
        d.src = (up ? p.w_up_e : p.w_gate_e) + (size_t)e * 131072; d.ld = 128; d.k0 = (r >> 1) * 64; d.n0 = (r & 1) * 64;
        d.dst = WSP_WguT + (size_t)e * 262144; d.ldd = 1024; d.mode = 1 + up; return d;
    }
    t -= 4096;
    if (t < 64) {
        const int up = t >= 32; const int r = t & 31;
        d.src = up ? p.w_up_s : p.w_gate_s; d.ld = 128; d.k0 = (r >> 1) * 64; d.n0 = (r & 1) * 64;
        d.dst = WSP_WguT + (size_t)64 * 262144; d.ldd = 1024; d.mode = 1 + up; return d;
    }
    t -= 64;
    if (t < 2048) { const int e = t >> 5, r = t & 31; d.src = p.w_down_e + (size_t)e * 131072; d.ld = 1024; d.k0 = (r >> 4) * 64; d.n0 = (r & 15) * 64; d.dst = WSP_WdT + (size_t)e * 131072; d.ldd = 128; return d; }
    t -= 2048;
    d.src = p.w_down_s; d.ld = 1024; d.k0 = (t >> 4) * 64; d.n0 = (t & 15) * 64; d.dst = WSP_WdT + (size_t)64 * 131072; d.ldd = 128; return d;
}

#define N_CONV_EARLY 656
__device__ __forceinline__ void conv_range(const Params& p, int t0, int stride, int tend, int tbeg = 0) {
    int t = tbeg + t0;
    if (t < tend) {
        ConvD d = conv_decode(p, t);
        float v[16];
        conv_load(d, v);
        while (t < tend) {
            const int tn = t + stride;
            ConvD dn = d;
            float vn[16];
            if (tn < tend) { dn = conv_decode(p, tn); conv_load(dn, vn); }
            conv_store(p, d, v);
            d = dn;
#pragma unroll
            for (int i = 0; i < 16; ++i) v[i] = vn[i];
            t = tn;
        }
    }
}
#define P0_CONV_B0 161
__device__ __forceinline__ void phase0(const Params& p) {
    const int b = blockIdx.x, G = gridDim.x;
    if (G > P0_CONV_B0 + 32) {
        if (b < 64) ssm_table_item(p, b >> 1, b & 1);
        else if (b < 160) ada_item(p, b - 64);
        else if (b == 160) rope_item(p);
        else conv_range(p, b - P0_CONV_B0, G - P0_CONV_B0, N_CONV_EARLY);
    } else {
        const int NU = 64 + 96 + 1 + N_CONV_EARLY;
        for (int u = b; u < NU; u += G) {
            if (u < 64) ssm_table_item(p, u >> 1, u & 1);
            else if (u < 160) ada_item(p, u - 64);
            else if (u == 160) rope_item(p);
            else { ConvD d = conv_decode(p, u - 161); float v[16]; conv_load(d, v); conv_store(p, d, v); }
        }
    }
}
#if 0
    {
        {
            const int stride = G - P0_CONV_B0;
            int t = b - P0_CONV_B0;
            if (t < N_CONV) {
                ConvD d = conv_decode(p, t);
                float v[16];
                conv_load(d, v);
                while (t < N_CONV) {
                    const int tn = t + stride;
                    ConvD dn = d;
                    float vn[16];
                    if (tn < N_CONV) { dn = conv_decode(p, tn); conv_load(dn, vn); }
                    conv_store(p, d, v);
                    d = dn;
#pragma unroll
                    for (int i = 0; i < 16; ++i) v[i] = vn[i];
                    t = tn;
                }
            }
        }
    } else {
        const int NU = 64 + 96 + 1 + N_CONV;
        for (int u = b; u < NU; u += G) {
            if (u < 64) ssm_table_item(p, u >> 1, u & 1);
            else if (u < 160) ada_item(p, u - 64);
            else if (u == 160) rope_item(p);
            else { ConvD d = conv_decode(p, u - 161); float v[16]; conv_load(d, v); conv_store(p, d, v); }
        }
    }
}

#endif

__device__ __forceinline__ void norm_mod_row(const float* src, const float* gain, const float* sh, const float* scl, u16* dst) {
    const int lane = TIDX & 63;
    float4 v[4];
    float ss = 0.f;
#pragma unroll
    for (int i = 0; i < 4; ++i) {
        v[i] = *(const float4*)(src + i * 256 + lane * 4);
        ss += v[i].x * v[i].x + v[i].y * v[i].y + v[i].z * v[i].z + v[i].w * v[i].w;
    }
    ss = wave_sum(ss);
    const float rs = rsqrtf(ss * (1.f / 1024.f) + EPS);
#pragma unroll
    for (int i = 0; i < 4; ++i) {
        const int c0 = i * 256 + lane * 4;
        const float4 g = *(const float4*)(gain + c0), s = *(const float4*)(sh + c0), k = *(const float4*)(scl + c0);
        const float a = v[i].x * rs * g.x * (1.f + k.x) + s.x, b = v[i].y * rs * g.y * (1.f + k.y) + s.y;
        const float c = v[i].z * rs * g.z * (1.f + k.z) + s.z, d = v[i].w * rs * g.w * (1.f + k.w) + s.w;
        *(uint2*)(dst + c0) = make_uint2(pack2(a, b), pack2(c, d));
    }
}

__device__ __forceinline__ void phase1(const Params& p) {
    for (int g = blockIdx.x; g < 32; g += gridDim.x) ssm_toeplitz_item(p, g);
    const int wv = blockIdx.x * 4 + (TIDX >> 6), nwv = gridDim.x * 4;
    for (int r = wv; r < NROWS; r += nwv) {
        const float* src; const float* md;
        if (r < NLAT) { src = p.x + (size_t)r * 1024; md = WSP_mod + (r >> 11) * 6144; }
        else { src = p.ctx + (size_t)(r - NLAT) * 1024; md = WSP_mod + 8 * 6144; }
        norm_mod_row(src, p.norm_mix, md, md + 1024, WSP_Hb + (size_t)r * 1024);
    }
}

__device__ __forceinline__ void phase2(const Params& p) {
    const int NU = 128 * 10 + 16 * 6;
    const int lane = TIDX & 63, wid = TIDX >> 6, wr = wid >> 1, wc = wid & 1, fr = lane & 15, fq = lane >> 4;
    for (int u = blockIdx.x; u < NU; u += gridDim.x) {
        int mt, nt;
        if (u < 1280) { mt = u / 10; nt = u % 10; } else { const int v = u - 1280; mt = 128 + v / 6; nt = 4 + v % 6; }
        const u16* A = WSP_Hb + (size_t)mt * 128 * 1024;
        const u16* B = WSP_WinT + (size_t)nt * 128 * 1024;
        f32x4 acc[4][4];
        gemm_tile(16,
            [&](int R, int C, int kt) { return (const void*)(A + (size_t)R * 1024 + kt * 64 + C); },
            [&](int R, int C, int kt) { return (const void*)(B + (size_t)R * 1024 + kt * 64 + C); }, acc);
        const int row0 = mt * 128 + wr * 64;
        const int col0 = nt * 128 + wc * 64;
        const bool is_lat = mt < 128;
        if (nt == 5) {
            const int kvh = wc;
#pragma unroll
            for (int m = 0; m < 4; ++m) {
                const int r = row0 + m * 16 + fq * 4;
                int b, pos;
                if (is_lat) { b = r >> 11; pos = r & 2047; } else { const int rc = r - NLAT; b = rc >> 8; pos = SEQ + (rc & 255); }
#pragma unroll
                for (int n = 0; n < 4; ++n) {
                    const int d = n * 16 + fr;
                    u16* dst = WSP_Vt + ((size_t)(b * 2 + kvh) * 64 + d) * VT_LD + pos;
                    *(uint2*)dst = make_uint2(pack2(acc[m][n][0], acc[m][n][1]), pack2(acc[m][n][2], acc[m][n][3]));
                }
            }
        } else {
            float v[4][4][4];
            const bool do_rope = is_lat && nt <= 4;
#pragma unroll
            for (int m = 0; m < 4; ++m)
#pragma unroll
                for (int j = 0; j < 4; ++j) {
                    if (do_rope) {
                        const int r = row0 + m * 16 + fq * 4 + j, pos = r & 2047;
                        const float2 cr = WSP_rope[(pos >> 6) * 16 + fr], cc = WSP_rope[(pos & 63) * 16 + fr];
                        const float x1 = acc[m][0][j], x2 = acc[m][1][j], y1 = acc[m][2][j], y2 = acc[m][3][j];
                        v[m][0][j] = x1 * cr.x - x2 * cr.y; v[m][1][j] = x1 * cr.y + x2 * cr.x;
                        v[m][2][j] = y1 * cc.x - y2 * cc.y; v[m][3][j] = y1 * cc.y + y2 * cc.x;
                    } else {
#pragma unroll
                        for (int n = 0; n < 4; ++n) v[m][n][j] = acc[m][n][j];
                    }
                }
            u16* dbase; int ldd;
            if (nt < 4) { dbase = WSP_Q + (size_t)row0 * 512 + col0; ldd = 512; }
            else if (nt == 4) { dbase = WSP_Kb + (size_t)row0 * 128 + (col0 - 512); ldd = 128; }
            else { dbase = WSP_U + (size_t)row0 * 512 + (col0 - 768); ldd = 512; }
            wave_store_bf16(v, [&](int row) { return dbase + (size_t)row * ldd; });
        }
    }
}

__device__ __forceinline__ void attn_unit(const Params& p, int u) {
    const int h = u & 7, qb = (u >> 3) & 15, b = u >> 7, kvh = h >> 2;
    const int tid = TIDX, lane = tid & 63, wid = tid >> 6, fr = lane & 15, fq = lane >> 4;
    const int sb = lane * 16, swz = sb ^ (((sb >> 9) & 1) << 5);
    const int r_in = swz >> 6, c_in = (swz & 63) >> 1;
    const int jstart = qb == 0 ? 2 : 0, jend = qb == 15 ? 4 : 6, nb = jend - jstart, ntile = nb + 4;
    const float SC = 0.125f * 1.4426950408889634f;
    bf16x8 qf[2][2];
    const int qrow0 = b * SEQ + qb * 128 + wid * 32;
#pragma unroll
    for (int qt = 0; qt < 2; ++qt)
#pragma unroll
        for (int ks = 0; ks < 2; ++ks)
            qf[qt][ks] = *(const bf16x8*)(WSP_Q + (size_t)(qrow0 + qt * 16 + fr) * 512 + h * 64 + ks * 32 + fq * 8);
    f32x4 o[4][2];
#pragma unroll
    for (int dt = 0; dt < 4; ++dt)
#pragma unroll
        for (int qt = 0; qt < 2; ++qt) o[dt][qt] = (f32x4){0.f, 0.f, 0.f, 0.f};
    float mrun[2], lrun[2];
    const float sinkv = p.attn_sink[h] * 1.4426950408889634f;
    mrun[0] = mrun[1] = sinkv;
    lrun[0] = lrun[1] = (fq == 0) ? 1.f : 0.f;
    __syncthreads();
    auto stage = [&](int i, int s) {
        const u16* kbase; const u16* vbase;
        if (i < nb) {
            const int ks0 = qb * 128 - 128 + 64 * (jstart + i);
            kbase = WSP_Kb + (size_t)(b * SEQ + ks0) * 128 + kvh * 64;
            vbase = WSP_Vt + (size_t)(b * 2 + kvh) * 64 * VT_LD + ks0;
        } else {
            const int c0 = 64 * (i - nb);
            kbase = WSP_Kb + (size_t)(NLAT + b * CTXL + c0) * 128 + kvh * 64;
            vbase = WSP_Vt + (size_t)(b * 2 + kvh) * 64 * VT_LD + SEQ + c0;
        }
        char* sk = smem + s * 16384;
        char* sv = sk + 8192;
#pragma unroll
        for (int it = 0; it < 2; ++it) {
            const int st = wid + 4 * it, R = (st >> 1) * 16 + r_in, C = (st & 1) * 32 + c_in;
            glds16(kbase + (size_t)R * 128 + C, sk + tid * 16 + it * 4096);
            glds16(vbase + (size_t)R * VT_LD + C, sv + tid * 16 + it * 4096);
        }
    };
    stage(0, 0);
    for (int i = 0; i < ntile; ++i) {
        asm volatile("s_waitcnt vmcnt(0)" ::: "memory");
        __syncthreads();
        if (i + 1 < ntile) stage(i + 1, (i + 1) & 1);
        const char* sk = smem + (i & 1) * 16384;
        const char* sv = sk + 8192;
        f32x4 s[4][2];
#pragma unroll
        for (int kt = 0; kt < 4; ++kt)
#pragma unroll
            for (int qt = 0; qt < 2; ++qt) s[kt][qt] = (f32x4){0.f, 0.f, 0.f, 0.f};
#pragma unroll
        for (int ks = 0; ks < 2; ++ks)
#pragma unroll
            for (int kt = 0; kt < 4; ++kt) {
                const bf16x8 kf = *(const bf16x8*)(sk + lds_byte(kt * 16 + fr, ks * 32 + fq * 8));
#pragma unroll
                for (int qt = 0; qt < 2; ++qt) s[kt][qt] = __builtin_amdgcn_mfma_f32_16x16x32_bf16(kf, qf[qt][ks], s[kt][qt], 0, 0, 0);
            }
        const bool band = i < nb;
        const int ks0 = qb * 128 - 128 + 64 * (jstart + i);
        bf16x8 pf[2][2];
#pragma unroll
        for (int qt = 0; qt < 2; ++qt) {
            const int qp = qb * 128 + wid * 32 + qt * 16 + fr;
            float mx = -1e30f;
#pragma unroll
            for (int kt = 0; kt < 4; ++kt)
#pragma unroll
                for (int j = 0; j < 4; ++j) {
                    float v = s[kt][qt][j] * SC;
                    if (band) {
                        const int kp = ks0 + kt * 16 + fq * 4 + j, d = qp - kp;
                        if (d > 128 || d < -128) v = -1e30f;
                    }
                    s[kt][qt][j] = v;
                    mx = fmaxf(mx, v);
                }
            mx = fmaxf(mx, __shfl_xor(mx, 16));
            mx = fmaxf(mx, __shfl_xor(mx, 32));
            const float mnew = fmaxf(mrun[qt], mx);
            const float alpha = __builtin_amdgcn_exp2f(mrun[qt] - mnew);
            mrun[qt] = mnew;
            float ls = 0.f;
#pragma unroll
            for (int kt = 0; kt < 4; ++kt)
#pragma unroll
                for (int j = 0; j < 4; ++j) {
                    const float pv = __builtin_amdgcn_exp2f(s[kt][qt][j] - mnew);
                    s[kt][qt][j] = pv;
                    ls += pv;
                }
            lrun[qt] = lrun[qt] * alpha + ls;
#pragma unroll
            for (int dt = 0; dt < 4; ++dt) o[dt][qt] *= alpha;
#pragma unroll
            for (int k2 = 0; k2 < 2; ++k2) {
                bf16x8 t;
#pragma unroll
                for (int j = 0; j < 4; ++j) { t[j] = (short)f2bf(s[2 * k2][qt][j]); t[4 + j] = (short)f2bf(s[2 * k2 + 1][qt][j]); }
                pf[qt][k2] = t;
            }
        }
#pragma unroll
        for (int k2 = 0; k2 < 2; ++k2)
#pragma unroll
            for (int dt = 0; dt < 4; ++dt) {
                const uint2 lo = *(const uint2*)(sv + lds_byte(dt * 16 + fr, k2 * 32 + fq * 4));
                const uint2 hi = *(const uint2*)(sv + lds_byte(dt * 16 + fr, k2 * 32 + 16 + fq * 4));
                union { uint4 u; bf16x8 v; } cv; cv.u = make_uint4(lo.x, lo.y, hi.x, hi.y);
#pragma unroll
                for (int qt = 0; qt < 2; ++qt) o[dt][qt] = __builtin_amdgcn_mfma_f32_16x16x32_bf16(cv.v, pf[qt][k2], o[dt][qt], 0, 0, 0);
            }
    }
#pragma unroll
    for (int qt = 0; qt < 2; ++qt) {
        float l = lrun[qt];
        l += __shfl_xor(l, 16);
        l += __shfl_xor(l, 32);
        const float inv = 1.f / l;
        u16* dst = WSP_AO + (size_t)(qrow0 + qt * 16 + fr) * 512 + h * 64 + fq * 4;
#pragma unroll
        for (int dt = 0; dt < 4; ++dt)
            *(uint2*)(dst + dt * 16) = make_uint2(pack2(o[dt][qt][0] * inv, o[dt][qt][1] * inv), pack2(o[dt][qt][2] * inv, o[dt][qt][3] * inv));
    }
}

__device__ __forceinline__ void ssm_s1_unit(const Params& p, int u) {
    const int ct = u % 9, mh = (u / 9) & 1, g = u / 18;
    const int lane = TIDX & 63, wid = TIDX >> 6, wr = wid >> 1, wc = wid & 1, fr = lane & 15, fq = lane >> 4;
    const u16* A = WSP_TabS + ((size_t)g * 256 + mh * 128) * 256;
    const u16* Ub = WSP_U + (size_t)ct * 128 * 16 * 512 + g * 16;
    f32x4 acc[4][4];
    gemm_tile(4,
        [&](int R, int C, int kt) { return (const void*)(A + (size_t)R * 256 + kt * 64 + C); },
        [&](int R, int C, int kt) { return (const void*)(Ub + (size_t)(R * 16 + kt * 4 + (C >> 4)) * 512 + (C & 15)); }, acc);
#pragma unroll
    for (int m = 0; m < 4; ++m)
#pragma unroll
        for (int n = 0; n < 4; ++n) {
            const int rho = mh * 128 + wr * 64 + m * 16 + fq * 4;
            const int cg = ct * 128 + wc * 64 + n * 16 + fr;
            *(f32x4*)(WSP_S + ((size_t)cg * 32 + g) * 256 + rho) = acc[m][n];
        }
}

__device__ __forceinline__ void phase3(const Params& p) {
    const int NU = 1024 + 576;
    for (int u = blockIdx.x; u < NU; u += gridDim.x) {
        if (u < 1024) attn_unit(p, u); else ssm_s1_unit(p, u - 1024);
    }
}

__device__ __forceinline__ void phase4(const Params& p) {
    if ((int)gridDim.x > 160) { if ((int)blockIdx.x >= 128) { conv_range(p, blockIdx.x - 128, gridDim.x - 128, N_CONV, N_CONV_EARLY); return; } }
    else conv_range(p, blockIdx.x, gridDim.x, N_CONV, N_CONV_EARLY);
    const int gid = blockIdx.x * NTHR + TIDX;
    if (gid >= BATCH * 2 * 32 * 64) return;
    const int n = gid & 63, g = (gid >> 6) & 31, dir = (gid >> 11) & 1, b = gid >> 12;
    const int pidx = dir * 32 + g;
    const float dt = __expf(p.log_dt[pidx]);
    const float are = p.a_re[pidx * 64 + n], aim = p.a_im[pidx * 64 + n];
    const float mag = __expf(16.f * dt * are);
    float rev = 16.f * (dt * aim * 0.15915494309189535f);
    rev -= rintf(rev);
    const float ar = mag * __builtin_amdgcn_cosf(rev), ai = mag * __builtin_amdgcn_sinf(rev);
    float hr = 0.f, hi = 0.f;
    const size_t so = (size_t)g * 256 + dir * 128 + n;
#pragma unroll 8
    for (int i = 0; i < 16; ++i) {
        const int c = dir == 0 ? i : 15 - i;
        const float* sp = WSP_S + (size_t)(NCHUNK_LAT + b * 16 + c) * 8192 + so;
        const float sr = sp[0], si = sp[64];
        const float nr = ar * hr - ai * hi + sr, ni = ar * hi + ai * hr + si;
        hr = nr; hi = ni;
    }
#pragma unroll 8
    for (int i = 0; i < 128; ++i) {
        const int c = dir == 0 ? i : 127 - i;
        const size_t cg = (size_t)b * 128 + c;
        const float* sp = WSP_S + cg * 8192 + so;
        const float sr = sp[0], si = sp[64];
        u16* hp = WSP_Hin + cg * 8192 + so;
        hp[0] = f2bf(hr); hp[64] = f2bf(hi);
        const float nr = ar * hr - ai * hi + sr, ni = ar * hi + ai * hr + si;
        hr = nr; hi = ni;
    }
}

__device__ __forceinline__ void phase5(const Params& p) {
    const int NU = 512;
    const int lane = TIDX & 63, wid = TIDX >> 6, wr = wid >> 1, wc = wid & 1, fr = lane & 15, fq = lane >> 4;
    for (int u = blockIdx.x; u < NU; u += gridDim.x) {
        const int ct = u & 7, mh = (u >> 3) & 1, g = u >> 4;
        const u16* A = WSP_TabY + ((size_t)g * 256 + mh * 128) * 512;
        const u16* Ub = WSP_U + (size_t)ct * 128 * 16 * 512 + g * 16;
        const u16* Hb_ = WSP_Hin + (size_t)ct * 128 * 8192 + g * 256;
        f32x4 acc[4][4];
        gemm_tile(8,
            [&](int R, int C, int kt) { return (const void*)(A + (size_t)R * 512 + kt * 64 + C); },
            [&](int R, int C, int kt) {
                return kt < 4 ? (const void*)(Ub + (size_t)(R * 16 + kt * 4 + (C >> 4)) * 512 + (C & 15))
                              : (const void*)(Hb_ + (size_t)R * 8192 + (kt - 4) * 64 + C);
            }, acc);
#pragma unroll
        for (int m = 0; m < 4; ++m)
#pragma unroll
            for (int n = 0; n < 4; ++n) {
                const int t = mh * 8 + wr * 4 + m;
                const int cg = ct * 128 + wc * 64 + n * 16 + fr;
                u16* dst = WSP_Y + ((size_t)cg * 16 + t) * 512 + g * 16 + fq * 4;
                *(uint2*)dst = make_uint2(pack2(gelu_tanh(acc[m][n][0]), gelu_tanh(acc[m][n][1])),
                                          pack2(gelu_tanh(acc[m][n][2]), gelu_tanh(acc[m][n][3])));
            }
    }
}

__device__ __forceinline__ void phase6(const Params& p) {
    const int NU = 512;
    const int lane = TIDX & 63, wid = TIDX >> 6, wr = wid >> 1, wc = wid & 1, fr = lane & 15, fq = lane >> 4;
    for (int u = blockIdx.x; u < NU; u += gridDim.x) {
        const int mt = u >> 2, nt = u & 3;
        const u16* A = WSP_Y + (size_t)mt * 128 * 512;
        const u16* B = WSP_WgluT + (size_t)nt * 128 * 512;
        f32x4 acc[4][4];
        gemm_tile(8,
            [&](int R, int C, int kt) { return (const void*)(A + (size_t)R * 512 + kt * 64 + C); },
            [&](int R, int C, int kt) { return (const void*)(B + (size_t)R * 512 + kt * 64 + C); }, acc);
        const int row0 = mt * 128 + wr * 64, col0 = nt * 128 + wc * 64;
        float v[4][4][4];
#pragma unroll
        for (int m = 0; m < 4; ++m)
#pragma unroll
            for (int n = 0; n < 4; ++n)
#pragma unroll
                for (int j = 0; j < 4; ++j) {
                    const int r = row0 + m * 16 + fq * 4 + j, c = col0 + n * 16 + fr;
                    const float yv = bf2f(WSP_Y[(size_t)r * 512 + c]);
                    v[m][n][j] = yv * sigmoidf_(acc[m][n][j] + p.b_glu[c]);
                }
        u16* dbase = WSP_SO + (size_t)row0 * 512 + col0;
        wave_store_bf16(v, [&](int row) { return dbase + (size_t)row * 512; });
    }
}

__device__ __forceinline__ void phase7(const Params& p) {
    const int lane = TIDX & 63;
    const int wv = blockIdx.x * 4 + (TIDX >> 6), nwv = gridDim.x * 4;
    for (int it = wv; it < NLAT * 2; it += nwv) {
        const int r = it >> 1, half = it & 1;
        const u16* src = (half ? WSP_SO : WSP_AO) + (size_t)r * 512 + lane * 8;
        const float* gain = (half ? p.norm_ssm_out : p.norm_attn_out) + lane * 8;
        const uint4 d = *(const uint4*)src;
        float f[8];
        f[0] = bf2f((u16)(d.x & 0xffff)); f[1] = bf2f((u16)(d.x >> 16));
        f[2] = bf2f((u16)(d.y & 0xffff)); f[3] = bf2f((u16)(d.y >> 16));
        f[4] = bf2f((u16)(d.z & 0xffff)); f[5] = bf2f((u16)(d.z >> 16));
        f[6] = bf2f((u16)(d.w & 0xffff)); f[7] = bf2f((u16)(d.w >> 16));
        float ss = 0.f;
#pragma unroll
        for (int i = 0; i < 8; ++i) ss += f[i] * f[i];
        ss = wave_sum(ss);
        const float rs = rsqrtf(ss * (1.f / 512.f) + EPS);
        const float4 g0 = *(const float4*)gain, g1 = *(const float4*)(gain + 4);
        *(uint4*)(WSP_CAT + (size_t)r * 1024 + half * 512 + lane * 8) =
            make_uint4(pack2(f[0] * rs * g0.x, f[1] * rs * g0.y), pack2(f[2] * rs * g0.z, f[3] * rs * g0.w),
                       pack2(f[4] * rs * g1.x, f[5] * rs * g1.y), pack2(f[6] * rs * g1.z, f[7] * rs * g1.w));
    }
}

__device__ __forceinline__ void phase8(const Params& p) {
    const int NU = 512;
    const int lane = TIDX & 63, wid = TIDX >> 6, wr = wid >> 1, wc = wid & 1, fr = lane & 15, fq = lane >> 4;
    for (int u = blockIdx.x; u < NU; u += gridDim.x) {
        const int mt = u >> 2, nt = u & 3;
        const u16* A = WSP_CAT + (size_t)mt * 128 * 1024;
        const u16* B = WSP_WoutT + (size_t)nt * 256 * 1024;
        f32x4 acc[4][8];
        gemm_tile_w(32,
            [&](int i, int R, int C, int kt) { return (const void*)(A + (size_t)R * 1024 + kt * 32 + C); },
            [&](int i, int R, int C, int kt) { return (const void*)(B + (size_t)R * 1024 + kt * 32 + C); }, acc);
        const int row0 = mt * 128 + wr * 64, col0 = nt * 256 + wc * 128;
        const float* g1 = WSP_mod + (mt >> 4) * 6144 + 2048 + col0;
        float* stg = (float*)(smem + wid * 8448);
#pragma unroll
        for (int m = 0; m < 4; ++m) {
#pragma unroll
            for (int n = 0; n < 8; ++n)
#pragma unroll
                for (int j = 0; j < 4; ++j) stg[(fq * 4 + j) * 132 + n * 16 + fr] = acc[m][n][j];
            asm volatile("s_waitcnt lgkmcnt(0)" ::: "memory");
            __builtin_amdgcn_wave_barrier();
#pragma unroll
            for (int i = 0; i < 8; ++i) {
                const int id = i * 64 + lane, rr = id >> 5, c4 = (id & 31) * 4;
                const float4 v = *(const float4*)(stg + rr * 132 + c4);
                const float4 g = *(const float4*)(g1 + c4);
                const size_t o = (size_t)(row0 + m * 16 + rr) * 1024 + col0 + c4;
                const float4 xv = *(const float4*)(p.x + o);
                *(float4*)(p.out + o) = make_float4(xv.x + g.x * v.x, xv.y + g.y * v.y, xv.z + g.z * v.z, xv.w + g.w * v.w);
            }
            asm volatile("s_waitcnt lgkmcnt(0)" ::: "memory");
            __builtin_amdgcn_wave_barrier();
        }
    }
}

__device__ __forceinline__ void phase9(const Params& p) {
    const int wv = blockIdx.x * 4 + (TIDX >> 6), nwv = gridDim.x * 4;
    for (int r = wv; r < NLAT; r += nwv) {
        const float* md = WSP_mod + (r >> 11) * 6144;
        norm_mod_row(p.out + (size_t)r * 1024, p.norm_ffn, md + 3072, md + 4096, WSP_H2 + (size_t)r * 1024);
    }
}

#define CTR_ECNT 0
#define CTR_Q11 128
#define CTR_Q12 136
#define HALF_TOK 8192
#define HH_HALF_ROWS 73728
#define ELIST_CAP 8192
__device__ __forceinline__ void phase10(const Params& p) {
    const int NU = 128;
    const int tid = TIDX, lane = tid & 63, wid = tid >> 6, wr = wid >> 1, wc = wid & 1, fr = lane & 15, fq = lane >> 4;
    float* sc = (float*)smem;
    int* hist = (int*)(smem + 32768);
    int* gbase = hist + 64;
    int* fill = gbase + 64;
    unsigned char* selk = (unsigned char*)(fill + 64);
    for (int u = blockIdx.x; u < NU; u += gridDim.x) {
        const u16* A = WSP_H2 + (size_t)u * 128 * 1024;
        const u16* B = WSP_WrT;
        f32x4 acc[4][4];
        gemm_tile(16,
            [&](int R, int C, int kt) { return (const void*)(A + (size_t)R * 1024 + kt * 64 + C); },
            [&](int R, int C, int kt) { return (const void*)(B + (size_t)R * 1024 + kt * 64 + C); }, acc);
        if (wc == 0) {
#pragma unroll
            for (int m = 0; m < 4; ++m)
#pragma unroll
                for (int n = 0; n < 4; ++n)
#pragma unroll
                    for (int j = 0; j < 4; ++j)
                        sc[(wr * 64 + m * 16 + fq * 4 + j) * 64 + n * 16 + fr] = sigmoidf_(acc[m][n][j]);
        }
        if (tid < 64) hist[tid] = 0;
        __syncthreads();
        const float bias = p.router_bias[lane];
        const int grp = lane >> 3;
        for (int rr = 0; rr < 32; ++rr) {
            const int row = wid * 32 + rr, tok = u * 128 + row;
            const float s = sc[row * 64 + lane];
            const float bz = s + bias;
            float m1 = bz;
            m1 = fmaxf(m1, __shfl_xor(m1, 1)); m1 = fmaxf(m1, __shfl_xor(m1, 2)); m1 = fmaxf(m1, __shfl_xor(m1, 4));
            const unsigned long long eq = __ballot(bz == m1);
            const unsigned gb = (unsigned)((eq >> (grp * 8)) & 0xffull);
            const int first = __ffs(gb) - 1;
            float v2 = ((lane & 7) == first) ? -1e30f : bz;
            v2 = fmaxf(v2, __shfl_xor(v2, 1)); v2 = fmaxf(v2, __shfl_xor(v2, 2)); v2 = fmaxf(v2, __shfl_xor(v2, 4));
            const float gs = m1 + v2;
            int cnt = 0;
#pragma unroll
            for (int j = 0; j < 8; ++j) {
                const float gj = __int_as_float(__builtin_amdgcn_readlane(__float_as_int(gs), j * 8));
                cnt += (gj > gs || (gj == gs && j < grp)) ? 1 : 0;
            }
            const bool gsel = cnt < 4;
            const float mv = gsel ? bz : -1e30f;
            int rank = 0;
#pragma unroll
            for (int j = 0; j < 64; ++j) {
                const float vj = __int_as_float(__builtin_amdgcn_readlane(__float_as_int(mv), j));
                rank += (vj > mv || (vj == mv && j < lane)) ? 1 : 0;
            }
            const bool sel = gsel && rank < 8;
            const float tot = wave_sum(sel ? s : 0.f);
            if (sel) {
                WSP_WGT[(size_t)tok * 8 + rank] = s / tot * 2.5f;
                selk[row * 8 + rank] = (unsigned char)lane;
                atomicAdd(&hist[lane], 1);
            }
        }
        __syncthreads();
        const int h = u >> 6;
        if (tid < 64) {
            gbase[tid] = (int)atomicAdd(&WSP_ctr[CTR_ECNT + h * 64 + tid], (unsigned)hist[tid]);
            fill[tid] = 0;
        }
        __syncthreads();
        for (int i = tid; i < 1024; i += NTHR) {
            const int e = selk[i];
            const int pos = atomicAdd(&fill[e], 1);
            __hip_atomic_store(WSP_elist + (size_t)(h * 64 + e) * ELIST_CAP + gbase[e] + pos, (u * 128 + (i >> 3)) * 8 + (i & 7), __ATOMIC_RELAXED, __HIP_MEMORY_SCOPE_AGENT);
        }
        __syncthreads();
    }
}

struct MoeTab { int cnt[16]; int soff[16]; int pre[17]; };

__device__ __forceinline__ void phase11(const Params& p) {
    const int tid = TIDX, lane = tid & 63, wid = tid >> 6, wr = wid >> 1, wc = wid & 1, fr = lane & 15, fq = lane >> 4;
    const int sb = lane * 16, swz = sb ^ (((sb >> 9) & 1) << 5);
    const int r_in = swz >> 6, c_in = (swz & 63) >> 1;
    int* tab = (int*)(smem + 73728);
    int* t_cnt = tab, *t_soff = tab + 16, *t_pre = tab + 32, *t_q = tab + 52;
    const int x = blockIdx.x & 7;
    __syncthreads();
    int* t_all = tab + 64;
    if (tid < 128) t_all[tid] = (int)WSP_ctr[CTR_ECNT + tid];
    if (tid == 0) t_q[0] = (int)atomicAdd(&WSP_ctr[CTR_Q11 + x], 1u);
    __syncthreads();
    if (tid < 16) {
        const int i = tid >> 1, h = tid & 1, e = x + 8 * i;
        t_cnt[tid] = t_all[h * 64 + e];
        int so = 0;
        for (int e2 = 0; e2 < e; ++e2) so += t_all[h * 64 + e2];
        t_soff[tid] = so;
    }
    __syncthreads();
    if (tid == 0) {
        int s = 0;
        for (int j = 0; j < 16; ++j) { t_pre[j] = s; s += (t_cnt[j] + 127) >> 7; }
        t_pre[16] = s;
    }
    __syncthreads();
    const int T_r = t_pre[16], T_all = T_r + 16;
    for (;;) {
        __syncthreads();
        const int u = __builtin_amdgcn_readfirstlane(t_q[0]);
        __syncthreads();
        if (u >= T_all) break;
        if (tid == 0) t_q[0] = (int)atomicAdd(&WSP_ctr[CTR_Q11 + x], 1u);
        int e, h, mt, c, rowbase;
        const int* el = nullptr;
        if (u < T_r) {
            int j = 0;
#pragma unroll
            for (int q = 1; q < 16; ++q) j += (u >= t_pre[q]) ? 1 : 0;
            e = x + 8 * (j >> 1); h = j & 1; mt = u - t_pre[j]; c = t_cnt[j];
            rowbase = h * HH_HALF_ROWS + t_soff[j];
            el = WSP_elist + (size_t)(h * 64 + e) * ELIST_CAP;
        } else {
            const int ms = x * 16 + (u - T_r);
            e = 64; h = ms >> 6; mt = ms & 63; c = HALF_TOK;
            rowbase = h * HH_HALF_ROWS + 65536;
        }
        e = __builtin_amdgcn_readfirstlane(e); h = __builtin_amdgcn_readfirstlane(h); mt = __builtin_amdgcn_readfirstlane(mt);
        c = __builtin_amdgcn_readfirstlane(c); rowbase = __builtin_amdgcn_readfirstlane(rowbase);
        if (e < 64) el = WSP_elist + (size_t)(h * 64 + e) * ELIST_CAP;
        const u16* aptr[2];
#pragma unroll
        for (int i = 0; i < 2; ++i) {
            int li = mt * 128 + (wid + 4 * i) * 16 + r_in;
            li = li < c ? li : c - 1;
            const int tok = (e < 64) ? (el[li] >> 3) : (h * HALF_TOK + li);
            aptr[i] = WSP_H2 + (size_t)tok * 1024 + c_in;
        }
        const u16* Bw = WSP_WguT + (size_t)e * 262144 + c_in;
        f32x4 acc[4][8];
        gemm_tile_w(32,
            [&](int i, int R, int C, int kt) { return (const void*)(aptr[i] + kt * 32); },
            [&](int i, int R, int C, int kt) { return (const void*)(Bw + (size_t)R * 1024 + kt * 32); }, acc);
        float wgt[4][4];
#pragma unroll
        for (int m = 0; m < 4; ++m)
#pragma unroll
            for (int j = 0; j < 4; ++j) {
                const int li = mt * 128 + wr * 64 + m * 16 + fq * 4 + j;
                float w = 1.f;
                if (e < 64) w = (li < c) ? WSP_WGT[el[li]] : 0.f;
                wgt[m][j] = w;
            }
        u16* dbase = WSP_HHs + ((size_t)rowbase + mt * 128 + wr * 64) * 128 + wc * 64;
        const int vrows = c - mt * 128 - wr * 64;
        wave_store_bf16_f([&](int m, int n2, int j) { return siluf_(acc[m][2 * n2][j]) * acc[m][2 * n2 + 1][j] * wgt[m][j]; },
                          [&](int row) { return row < vrows ? dbase + (size_t)row * 128 : (u16*)nullptr; });
    }
}

__device__ __forceinline__ void phase12a(const Params& p, int h) {
    const int tid = TIDX, lane = tid & 63, wid = tid >> 6, wr = wid >> 1, wc = wid & 1, fr = lane & 15, fq = lane >> 4;
    const int sb = lane * 16, swz = sb ^ (((sb >> 9) & 1) << 5);
    const int r_in = swz >> 6, c_in = (swz & 63) >> 1;
    int* tab = (int*)(smem + 73728);
    int* t_cnt = tab, *t_soff = tab + 16, *t_pre = tab + 32, *t_q = tab + 52;
    const int x = blockIdx.x & 7;
    __syncthreads();
    int* t_all = tab + 64;
    if (tid < 64) t_all[tid] = (int)WSP_ctr[CTR_ECNT + h * 64 + tid];
    if (tid == 0) t_q[0] = (int)atomicAdd(&WSP_ctr[CTR_Q12 + h * 8 + x], 1u);
    __syncthreads();
    if (tid < 8) {
        const int e = x + 8 * tid;
        t_cnt[tid] = t_all[e];
        int so = 0;
        for (int e2 = 0; e2 < e; ++e2) so += t_all[e2];
        t_soff[tid] = so;
    }
    __syncthreads();
    if (tid == 0) {
        int s = 0;
        for (int j = 0; j < 8; ++j) { t_pre[j] = s; s += (t_cnt[j] + 127) >> 7; }
        t_pre[8] = s;
    }
    __syncthreads();
    const int T_r = t_pre[8] * 4, T_all = T_r + 32;
    for (;;) {
        __syncthreads();
        const int u = __builtin_amdgcn_readfirstlane(t_q[0]);
        __syncthreads();
        if (u >= T_all) break;
        if (tid == 0) t_q[0] = (int)atomicAdd(&WSP_ctr[CTR_Q12 + h * 8 + x], 1u);
        int e, mt, nt, c, rowbase;
        const int* el = nullptr;
        if (u < T_r) {
            const int um = u >> 2; nt = u & 3;
            int j = 0;
#pragma unroll
            for (int q = 1; q < 8; ++q) j += (um >= t_pre[q]) ? 1 : 0;
            e = x + 8 * j; mt = um - t_pre[j]; c = t_cnt[j];
            rowbase = h * HH_HALF_ROWS + t_soff[j];
            el = WSP_elist + (size_t)(h * 64 + e) * ELIST_CAP;
        } else {
            const int us = u - T_r; nt = us & 3;
            const int ms = x * 8 + (us >> 2);
            e = 64; mt = ms; c = HALF_TOK; rowbase = h * HH_HALF_ROWS + 65536;
        }
        e = __builtin_amdgcn_readfirstlane(e); mt = __builtin_amdgcn_readfirstlane(mt); nt = __builtin_amdgcn_readfirstlane(nt);
        c = __builtin_amdgcn_readfirstlane(c); rowbase = __builtin_amdgcn_readfirstlane(rowbase);
        if (e < 64) el = WSP_elist + (size_t)(h * 64 + e) * ELIST_CAP;
        const u16* aptr[2];
#pragma unroll
        for (int i = 0; i < 2; ++i) {
            int li = mt * 128 + (wid + 4 * i) * 16 + r_in;
            li = li < c ? li : c - 1;
            aptr[i] = WSP_HHs + ((size_t)rowbase + li) * 128 + c_in;
        }
        const u16* Bw = WSP_WdT + ((size_t)e * 1024 + nt * 256) * 128 + c_in;
        f32x4 acc[4][8];
        gemm_tile_w(4,
            [&](int i, int R, int C, int kt) { return (const void*)(aptr[i] + kt * 32); },
            [&](int i, int R, int C, int kt) { return (const void*)(Bw + (size_t)R * 128 + kt * 32); }, acc);
        const int vrows = c - mt * 128 - wr * 64;
#pragma unroll
        for (int hn = 0; hn < 2; ++hn) {
            const int colo = nt * 256 + wc * 128 + hn * 64;
            wave_store_bf16_f([&](int m, int n, int j) { return acc[m][hn * 4 + n][j]; }, [&](int row) {
                if (row >= vrows) return (u16*)nullptr;
                const int li = mt * 128 + wr * 64 + row;
                int tl, k;
                if (e < 64) { const int ent = el[li]; tl = (ent >> 3) - h * HALF_TOK; k = ent & 7; }
                else { tl = li; k = 8; }
                return WSP_Yd + ((size_t)tl * 9 + k) * 1024 + colo;
            });
        }
    }
}

__device__ __forceinline__ void phase12b(const Params& p, int h) {
    const int lane = TIDX & 63;
    const int bb = (blockIdx.x + h) % gridDim.x;
    const int wv = bb * 4 + (TIDX >> 6), nwv = gridDim.x * 4;
    for (int tl = wv; tl < HALF_TOK; tl += nwv) {
        const int tok = h * HALF_TOK + tl;
        float* row = p.out + (size_t)tok * 1024 + lane * 16;
        const float* g2 = WSP_mod + (tok >> 11) * 6144 + 5120 + lane * 16;
        float s[16];
#pragma unroll
        for (int i = 0; i < 16; ++i) s[i] = 0.f;
        const u16* yp = WSP_Yd + (size_t)tl * 9 * 1024 + lane * 16;
#pragma unroll
        for (int k = 0; k < 9; ++k) {
            const uint4 a = *(const uint4*)(yp + k * 1024), b = *(const uint4*)(yp + k * 1024 + 8);
            const unsigned w[8] = {a.x, a.y, a.z, a.w, b.x, b.y, b.z, b.w};
#pragma unroll
            for (int i = 0; i < 8; ++i) { s[2 * i] += bf2f((u16)(w[i] & 0xffffu)); s[2 * i + 1] += bf2f((u16)(w[i] >> 16)); }
        }
        float ss = 0.f;
#pragma unroll
        for (int q = 0; q < 4; ++q) {
            const float4 xv = *(const float4*)(row + q * 4), gv = *(const float4*)(g2 + q * 4);
            s[4 * q] = xv.x + gv.x * s[4 * q]; s[4 * q + 1] = xv.y + gv.y * s[4 * q + 1];
            s[4 * q + 2] = xv.z + gv.z * s[4 * q + 2]; s[4 * q + 3] = xv.w + gv.w * s[4 * q + 3];
            ss += s[4 * q] * s[4 * q] + s[4 * q + 1] * s[4 * q + 1] + s[4 * q + 2] * s[4 * q + 2] + s[4 * q + 3] * s[4 * q + 3];
        }
        ss = wave_sum(ss);
        const float rs = rsqrtf(ss * (1.f / 1024.f) + EPS);
#pragma unroll
        for (int q = 0; q < 4; ++q) {
            const float4 g = *(const float4*)(p.norm_final + lane * 16 + q * 4);
            *(float4*)(row + q * 4) = make_float4(s[4 * q] * rs * g.x, s[4 * q + 1] * rs * g.y, s[4 * q + 2] * rs * g.z, s[4 * q + 3] * rs * g.w);
        }
    }
}

#define SMEM_TOTAL (73728 + 1024 + 64)

#if 1
__global__ void __launch_bounds__(NTHR, 2) k_mega(Params p) {
    volatile LAS unsigned* st = (volatile LAS unsigned*)(smem + SMEM_TOTAL - 16);
    if (TIDX == 0) { st[0] = 0u; st[1] = 0u; st[2] = 0u; st[3] = 0u; }
    __syncthreads();
    XcdBarrier bar = xcd_barrier_post(WSP_bar, st);
#define RUNP(N) do { phase##N(p); if (PROBE_DUP == N) phase##N(p); } while (0)
    RUNP(0);  xcd_barrier(bar);
    RUNP(1);  xcd_barrier(bar);
    RUNP(2);  xcd_barrier(bar);
    RUNP(3);  xcd_barrier(bar);
    RUNP(4);  xcd_barrier(bar);
    RUNP(5);  xcd_barrier(bar);
    RUNP(6);  xcd_barrier(bar);
    RUNP(7);  xcd_barrier(bar);
    RUNP(8);  xcd_barrier(bar);
    RUNP(9);  xcd_barrier(bar);
    phase10(p); xcd_barrier(bar);
    phase11(p); xcd_barrier(bar);
    phase12a(p, 0); xcd_barrier(bar);
    phase12b(p, 0); xcd_barrier(bar);
    phase12a(p, 1); xcd_barrier(bar);
    phase12b(p, 1);
}
#endif


extern "C" void kernel_launch(void* const* d_in, const int* in_sizes, int n_in,
                              void* d_out, int out_size, void* d_ws, size_t ws_size,
                              hipStream_t stream) {
    Params p{};
    const float** ip = (const float**)&p.x;
    for (int i = 0; i < 32; ++i) ip[i] = (const float*)d_in[i];
    p.out = (float*)d_out;
    p.ws = (char*)d_ws;
    if (OFF_END > ws_size) { fprintf(stderr, "workspace too small: need %zu have %zu\n", (size_t)OFF_END, ws_size); return; }

    static int grid = 0;
    if (!grid) {
        hipFuncSetAttribute((const void*)k_mega, hipFuncAttributeMaxDynamicSharedMemorySize, SMEM_TOTAL);
        int dev = 0, cus = 0, per_cu = 0;
        hipGetDevice(&dev);
        hipDeviceGetAttribute(&cus, hipDeviceAttributeMultiprocessorCount, dev);
        hipOccupancyMaxActiveBlocksPerMultiprocessor(&per_cu, (const void*)k_mega, NTHR, SMEM_TOTAL);
        if (per_cu < 1) per_cu = 1;
        grid = cus * (per_cu < 2 ? per_cu : 2);
    }
    hipMemsetAsync(p.ws + OFF_BAR, 0, XCD_BAR_WORDS * 4 + 1024, stream);
    k_mega<<<grid, NTHR, SMEM_TOTAL, stream>>>(p);
}
```

```cpp
#include <hip/hip_runtime.h>
#include <hip/hip_bf16.h>
#include <stdint.h>
#include <stdio.h>

#ifndef MK_MULTI
#define MK_MULTI 0
#endif

typedef __attribute__((ext_vector_type(8))) short bf16x8;
typedef __attribute__((ext_vector_type(4))) short bf16x4;
typedef __attribute__((ext_vector_type(4))) float f32x4;
typedef unsigned short u16;
typedef __attribute__((ext_vector_type(4))) unsigned u32x4;

#ifndef PROBE_DUP
#define PROBE_DUP -1
#endif
#define NTHR 256
__device__ __forceinline__ int opaque_tid() { int t = (int)threadIdx.x; asm volatile("" : "+v"(t)); return t; }
#define TIDX opaque_tid()
#define LDS_BYTES 65536

#define D_MODEL 1024
#define BATCH 8
#define SEQ 2048
#define CTXL 256
#define NLAT (BATCH * SEQ)
#define NCTX (BATCH * CTXL)
#define NROWS (NLAT + NCTX)
#define INW 1280
#define NEXP 64
#define VT_LD (SEQ + CTXL)
#define NCHUNK_LAT 1024
#define NCHUNK_ALL 1152
#define EPS 1e-6f

#define XB_TMO      128
#define XB_XCNT(j)  (256  + 64 * (j))
#define XB_XSUB(j)  (1280 + 64 * (j))
#define XB_XGEN(j)  (2304 + 64 * (j))
#define XB_TOP      3328
#define XB_TOPGEN   3392
#define XCD_BAR_WORDS 3456
#define XB_SPIN_CAP (1u << 20)
#define LAS __attribute__((address_space(3)))

__device__ __forceinline__ unsigned xb_ld(unsigned* p)              { return __hip_atomic_load(p, __ATOMIC_RELAXED, __HIP_MEMORY_SCOPE_AGENT); }
__device__ __forceinline__ unsigned xb_add(unsigned* p, unsigned v) { return __hip_atomic_fetch_add(p, v, __ATOMIC_RELAXED, __HIP_MEMORY_SCOPE_AGENT); }
__device__ __forceinline__ unsigned xb_xcc_id() { return (unsigned)__builtin_amdgcn_s_getreg((3 << 11) | 20) & 0xFu; }
#define XB_SPIN(cond, bar) do { unsigned _sp = 0; while (cond) { __builtin_amdgcn_s_sleep(1); \
    if ((++_sp & 255u) == 0u) { if (xb_ld(&(bar)[XB_TMO])) break; if (_sp > XB_SPIN_CAP) { atomicAdd(&(bar)[XB_TMO], 1u); break; } } } } while (0)

struct XcdBarrier { unsigned* bar; unsigned x; volatile LAS unsigned* st; };

__device__ __forceinline__ XcdBarrier xcd_barrier_post(unsigned* bar, volatile LAS unsigned* st) {
    XcdBarrier b; b.bar = bar; b.x = xb_xcc_id(); b.st = st;
    if (TIDX == 0) (void)xb_add(&bar[XB_XCNT(b.x)], 1u);
    return b;
}
__device__ __forceinline__ void xcd_barrier_complete(unsigned* bar, unsigned x, unsigned& nloc, unsigned& nx) {
    const unsigned G = gridDim.x * gridDim.y * gridDim.z;
    unsigned sum, cnt, mine, sp = 0u;
    for (;;) {
        sum = 0u; cnt = 0u; mine = 0u;
#pragma unroll
        for (unsigned j = 0; j < 16; ++j) { const unsigned c = xb_ld(&bar[XB_XCNT(j)]); sum += c; cnt += (c > 0u) ? 1u : 0u; mine = (j == x) ? c : mine; }
        if (sum == G) break;
        __builtin_amdgcn_s_sleep(1);
        if ((++sp & 255u) == 0u) { if (xb_ld(&bar[XB_TMO])) break; if (sp > XB_SPIN_CAP) { atomicAdd(&bar[XB_TMO], 1u); break; } }
    }
    nloc = mine > 0u ? mine : 1u; nx = cnt > 0u ? cnt : 1u;
}
__device__ __forceinline__ void xcd_barrier(const XcdBarrier& b) {
    asm volatile("s_waitcnt vmcnt(0)" ::: "memory");
    __syncthreads();
    if (TIDX == 0) {
        unsigned* bar = b.bar;
        __builtin_amdgcn_s_waitcnt(0);
        unsigned nloc = b.st[0], nx = b.st[1];
        if (nloc == 0u) { xcd_barrier_complete(bar, b.x, nloc, nx); b.st[0] = nloc; b.st[1] = nx; }
        const unsigned old = xb_add(&bar[XB_XSUB(b.x)], 1u);
        const unsigned gen = old / nloc;
        if (old + 1u == (gen + 1u) * nloc) {
            __builtin_amdgcn_fence(__ATOMIC_RELEASE, "agent");
            asm volatile("s_waitcnt vmcnt(0)" ::: "memory");
            const unsigned og = xb_add(&bar[XB_TOP], 1u);
            const unsigned tg = og / nx;
            if (og + 1u == (tg + 1u) * nx) xb_add(&bar[XB_TOPGEN], 1u);
            else XB_SPIN(xb_ld(&bar[XB_TOPGEN]) == tg, bar);
            __builtin_amdgcn_fence(__ATOMIC_ACQUIRE, "agent");
            xb_add(&bar[XB_XGEN(b.x)], 1u);
            asm volatile("s_waitcnt vmcnt(0)" ::: "memory");
        } else {
            XB_SPIN(xb_ld(&bar[XB_XGEN(b.x)]) == gen, bar);
            __builtin_amdgcn_fence(__ATOMIC_ACQUIRE, "agent");
            asm volatile("s_waitcnt vmcnt(0)" ::: "memory");
        }
    }
    __syncthreads();
}

struct Params {
    const float *x, *c, *ctx, *c_ctx, *w_ada, *b_ada, *norm_mix, *norm_ffn, *w_in, *attn_sink,
        *a_re, *a_im, *log_dt, *b_re, *b_im, *c_re, *c_im, *ssm_d, *w_glu, *b_glu, *norm_attn_out, *norm_ssm_out,
        *w_out, *w_router, *router_bias, *w_gate_e, *w_up_e, *w_down_e, *w_gate_s, *w_up_s, *w_down_s, *norm_final;
    float* out;
    char* ws;
};

constexpr size_t A256(size_t v) { return (v + 255) & ~(size_t)255; }
constexpr size_t OFF_BAR   = 0;
constexpr size_t OFF_MOD   = A256(OFF_BAR + XCD_BAR_WORDS * 4 + 1024);
constexpr size_t OFF_ROPE  = A256(OFF_MOD + 9 * 6144 * 4);
constexpr size_t OFF_KBUF  = A256(OFF_ROPE + 64 * 16 * 8);
constexpr size_t OFF_IDX   = A256(OFF_KBUF + (size_t)32 * 2 * 4096 * 4);
constexpr size_t OFF_WGT   = A256(OFF_IDX + (size_t)NLAT * 8);
constexpr size_t OFF_ELIST = A256(OFF_WGT + (size_t)NLAT * 8 * 4);
constexpr size_t OFF_WINT  = A256(OFF_ELIST + (size_t)2 * 64 * 8192 * 4);
constexpr size_t OFF_WGLUT = A256(OFF_WINT + (size_t)1280 * 1024 * 2);
constexpr size_t OFF_WOUTT = A256(OFF_WGLUT + (size_t)512 * 512 * 2);
constexpr size_t OFF_WRT   = A256(OFF_WOUTT + (size_t)1024 * 1024 * 2);
constexpr size_t OFF_WDT   = A256(OFF_WRT + (size_t)128 * 1024 * 2);
constexpr size_t OFF_HHS   = A256(OFF_WDT + (size_t)65 * 1024 * 128 * 2);
constexpr size_t OFF_ARENA = A256(OFF_HHS + (size_t)2 * 73728 * 128 * 2);
constexpr size_t OFF_WGUT  = OFF_ARENA;
constexpr size_t OFF_TABS  = A256(OFF_WGUT + (size_t)65 * 256 * 1024 * 2);
constexpr size_t OFF_TABY  = A256(OFF_TABS + (size_t)32 * 256 * 256 * 2);
constexpr size_t OFF_R1    = A256(OFF_TABY + (size_t)32 * 256 * 512 * 2);
constexpr size_t OFF_R2    = A256(OFF_R1 + (size_t)NROWS * 1024 * 2);
constexpr size_t OFF_R3    = A256(OFF_R2 + (size_t)NLAT * 1024 * 2);
constexpr size_t OFF_R4    = A256(OFF_R3 + (size_t)NLAT * 1024 * 2);
constexpr size_t OFF_END   = A256(OFF_R4 + (size_t)NLAT * 512 * 2 * 2);
static_assert(OFF_END - OFF_ARENA >= (size_t)8192 * 9 * 1024 * 2, "arena must hold Yd");
#define WSP_bar   ((unsigned*)(p.ws + OFF_BAR))
#define WSP_ctr   ((unsigned*)(p.ws + OFF_BAR) + XCD_BAR_WORDS)
#define WSP_mod   ((float*)(p.ws + OFF_MOD))
#define WSP_rope  ((float2*)(p.ws + OFF_ROPE))
#define WSP_Kbuf  ((float*)(p.ws + OFF_KBUF))
#define WSP_WGT   ((float*)(p.ws + OFF_WGT))
#define WSP_elist ((int*)(p.ws + OFF_ELIST))
#define WSP_WinT  ((u16*)(p.ws + OFF_WINT))
#define WSP_WgluT ((u16*)(p.ws + OFF_WGLUT))
#define WSP_WoutT ((u16*)(p.ws + OFF_WOUTT))
#define WSP_WrT   ((u16*)(p.ws + OFF_WRT))
#define WSP_WdT   ((u16*)(p.ws + OFF_WDT))
#define WSP_HHs   ((u16*)(p.ws + OFF_HHS))
#define WSP_Yd    ((u16*)(p.ws + OFF_ARENA))
#define WSP_WguT  ((u16*)(p.ws + OFF_WGUT))
#define WSP_TabS  ((u16*)(p.ws + OFF_TABS))
#define WSP_TabY  ((u16*)(p.ws + OFF_TABY))
#define WSP_Hb    ((u16*)(p.ws + OFF_R1))
#define WSP_S     ((float*)(p.ws + OFF_R1))
#define WSP_H2    ((u16*)(p.ws + OFF_R1))
#define WSP_Q     ((u16*)(p.ws + OFF_R2))
#define WSP_Kb    ((u16*)(p.ws + OFF_R2 + (size_t)NLAT * 512 * 2))
#define WSP_Vt    ((u16*)(p.ws + OFF_R2 + (size_t)NLAT * 512 * 2 + (size_t)NROWS * 128 * 2))
#define WSP_Y     ((u16*)(p.ws + OFF_R2))
#define WSP_SO    ((u16*)(p.ws + OFF_R2 + (size_t)NLAT * 512 * 2))
#define WSP_U     ((u16*)(p.ws + OFF_R3))
#define WSP_CAT   ((u16*)(p.ws + OFF_R3))
#define WSP_AO    ((u16*)(p.ws + OFF_R4))
#define WSP_Hin   ((u16*)(p.ws + OFF_R4 + (size_t)NLAT * 512 * 2))

extern __shared__ __attribute__((aligned(16))) char smem[];

__device__ __forceinline__ u16 f2bf(float f) {
    unsigned u = __float_as_uint(f);
    u += 0x7fffu + ((u >> 16) & 1u);
    return (u16)(u >> 16);
}
__device__ __forceinline__ float bf2f(u16 h) { return __uint_as_float(((unsigned)h) << 16); }
__device__ __forceinline__ unsigned pack2(float a, float b) { return (unsigned)f2bf(a) | ((unsigned)f2bf(b) << 16); }
__device__ __forceinline__ void glds16(const void* g, void* l) {
    __builtin_amdgcn_global_load_lds((const unsigned*)g, (unsigned*)l, 16, 0, 0);
}
__device__ __forceinline__ int lds_byte(int r, int c) {
    int st = (r >> 4) * 2 + (c >> 5), rr = r & 15, cc = c & 31, ob = rr * 64 + cc * 2;
    return st * 1024 + (ob ^ (((ob >> 9) & 1) << 5));
}
__device__ __forceinline__ float wave_sum(float v) {
#pragma unroll
    for (int o = 32; o > 0; o >>= 1) v += __shfl_xor(v, o);
    return v;
}
__device__ __forceinline__ float sigmoidf_(float x) { return 1.f / (1.f + __expf(-x)); }
__device__ __forceinline__ float siluf_(float x) { return x / (1.f + __expf(-x)); }
__device__ __forceinline__ float gelu_tanh(float x) {
    float u = 0.7978845608028654f * (x + 0.044715f * x * x * x);
    return x / (1.f + __expf(-2.f * u));
}

template <class FA, class FB>
__device__ __forceinline__ void gemm_tile(int nkt, FA fa, FB fb, f32x4 (&acc)[4][4]) {
    const int tid = TIDX, lane = tid & 63, wid = tid >> 6, wr = wid >> 1, wc = wid & 1, fr = lane & 15, fq = lane >> 4;
    const int sb = lane * 16, swz = sb ^ (((sb >> 9) & 1) << 5);
    const int r_in = swz >> 6, c_in = (swz & 63) >> 1;
#pragma unroll
    for (int m = 0; m < 4; ++m)
#pragma unroll
        for (int n = 0; n < 4; ++n) acc[m][n] = (f32x4){0.f, 0.f, 0.f, 0.f};
    __syncthreads();
    auto stage = [&](int kt, int s) {
        char* sa = smem + s * 32768;
        char* sbm = sa + 16384;
#pragma unroll
        for (int i = 0; i < 4; ++i) {
            const int st = wid + 4 * i, R = (st >> 1) * 16 + r_in, C = (st & 1) * 32 + c_in;
            glds16(fa(R, C, kt), sa + tid * 16 + i * 4096);
            glds16(fb(R, C, kt), sbm + tid * 16 + i * 4096);
        }
    };
    stage(0, 0);
    for (int kt = 0; kt < nkt; ++kt) {
        asm volatile("s_waitcnt vmcnt(0)" ::: "memory");
        __syncthreads();
        if (kt + 1 < nkt) stage(kt + 1, (kt + 1) & 1);
        const char* sa = smem + (kt & 1) * 32768;
        const char* sbm = sa + 16384;
#pragma unroll
        for (int ks = 0; ks < 2; ++ks) {
            bf16x8 a[4], b[4];
#pragma unroll
            for (int m = 0; m < 4; ++m) a[m] = *(const bf16x8*)(sa + lds_byte(wr * 64 + m * 16 + fr, ks * 32 + fq * 8));
#pragma unroll
            for (int n = 0; n < 4; ++n) b[n] = *(const bf16x8*)(sbm + lds_byte(wc * 64 + n * 16 + fr, ks * 32 + fq * 8));
#pragma unroll
            for (int m = 0; m < 4; ++m)
#pragma unroll
                for (int n = 0; n < 4; ++n) acc[m][n] = __builtin_amdgcn_mfma_f32_16x16x32_bf16(a[m], b[n], acc[m][n], 0, 0, 0);
        }
    }
    __syncthreads();
}

__device__ __forceinline__ int lds32(int r, int c) {
    const int rr = r & 15;
    return (r >> 4) * 1024 + ((rr * 64 + c * 2) ^ (((rr >> 3) & 1) << 5));
}
template <class FA, class FB>
__device__ __forceinline__ void gemm_tile_w(int nkt, FA fa, FB fb, f32x4 (&acc)[4][8]) {
    const int tid = TIDX, lane = tid & 63, wid = tid >> 6, wr = wid >> 1, wc = wid & 1, fr = lane & 15, fq = lane >> 4;
    const int sb = lane * 16, swz = sb ^ (((sb >> 9) & 1) << 5);
    const int r_in = swz >> 6, c_in = (swz & 63) >> 1;
#pragma unroll
    for (int m = 0; m < 4; ++m)
#pragma unroll
        for (int n = 0; n < 8; ++n) acc[m][n] = (f32x4){0.f, 0.f, 0.f, 0.f};
    __syncthreads();
    auto stage = [&](int kt, int s) {
        char* sa = smem + s * 24576;
#pragma unroll
        for (int i = 0; i < 2; ++i) glds16(fa(i, (wid + 4 * i) * 16 + r_in, c_in, kt), sa + tid * 16 + i * 4096);
#pragma unroll
        for (int i = 0; i < 4; ++i) glds16(fb(i, (wid + 4 * i) * 16 + r_in, c_in, kt), sa + 8192 + tid * 16 + i * 4096);
    };
    stage(0, 0);
    if (nkt > 1) stage(1, 1);
    int s_cur = 0, s_nxt = 2;
    for (int kt = 0; kt < nkt; ++kt) {
        if (kt + 1 < nkt) asm volatile("s_waitcnt vmcnt(6) lgkmcnt(0)\n\ts_barrier" ::: "memory");
        else asm volatile("s_waitcnt vmcnt(0) lgkmcnt(0)\n\ts_barrier" ::: "memory");
        if (kt + 2 < nkt) stage(kt + 2, s_nxt);
        const char* sa = smem + s_cur * 24576;
        bf16x8 a[4];
#pragma unroll
        for (int m = 0; m < 4; ++m) a[m] = *(const bf16x8*)(sa + lds32(wr * 64 + m * 16 + fr, fq * 8));
#pragma unroll
        for (int nh = 0; nh < 2; ++nh) {
            bf16x8 b[4];
#pragma unroll
            for (int n = 0; n < 4; ++n) b[n] = *(const bf16x8*)(sa + 8192 + lds32(wc * 128 + (nh * 4 + n) * 16 + fr, fq * 8));
#pragma unroll
            for (int m = 0; m < 4; ++m)
#pragma unroll
                for (int n = 0; n < 4; ++n) acc[m][nh * 4 + n] = __builtin_amdgcn_mfma_f32_16x16x32_bf16(a[m], b[n], acc[m][nh * 4 + n], 0, 0, 0);
        }
        s_cur = (s_cur == 2) ? 0 : s_cur + 1;
        s_nxt = (s_nxt == 2) ? 0 : s_nxt + 1;
    }
    __syncthreads();
}

template <class FV, class FD>
__device__ __forceinline__ void wave_store_bf16_f(FV val, FD dst) {
    const int lane = TIDX & 63, wid = TIDX >> 6, fr = lane & 15, fq = lane >> 4;
    char* base = smem + wid * 9216;
#pragma unroll
    for (int m = 0; m < 4; ++m)
#pragma unroll
        for (int n = 0; n < 4; ++n)
#pragma unroll
            for (int j = 0; j < 4; ++j)
                *(u16*)(base + (m * 16 + fq * 4 + j) * 144 + (n * 16 + fr) * 2) = f2bf(val(m, n, j));
    asm volatile("s_waitcnt lgkmcnt(0)" ::: "memory");
    __builtin_amdgcn_wave_barrier();
#pragma unroll
    for (int i = 0; i < 8; ++i) {
        const int id = i * 64 + lane, row = id >> 3, ch = id & 7;
        const uint4 d = *(const uint4*)(base + row * 144 + ch * 16);
        u16* p = dst(row);
        if (p) *(uint4*)(p + ch * 8) = d;
    }
    asm volatile("s_waitcnt lgkmcnt(0)" ::: "memory");
    __builtin_amdgcn_wave_barrier();
}

template <class FD>
__device__ __forceinline__ void wave_store_bf16(const float (&v)[4][4][4], FD dst) {
    wave_store_bf16_f([&](int m, int n, int j) { return v[m][n][j]; }, dst);
}

struct ConvD { const float* src; u16* dst; int ld, ldd, k0, n0, mode, zr; };
__device__ __forceinline__ void conv_load(const ConvD& d, float (&v)[16]) {
    const int tid = TIDX;
#pragma unroll
    for (int i = 0; i < 16; ++i) v[i] = d.src[(size_t)(d.k0 + i * 4 + (tid >> 6)) * d.ld + d.n0 + (tid & 63)];
}
__device__ __forceinline__ void conv_store(const Params& p, const ConvD& d, const float (&v)[16]) {
    float* t = (float*)smem;
    const int tid = TIDX;
    __syncthreads();
#pragma unroll
    for (int i = 0; i < 16; ++i) t[(i * 4 + (tid >> 6)) * 65 + (tid & 63)] = v[i];
    __syncthreads();
    const int n = tid >> 2, kq = tid & 3;
    unsigned w[8];
#pragma unroll
    for (int i = 0; i < 8; ++i) w[i] = pack2(t[(kq * 16 + 2 * i) * 65 + n], t[(kq * 16 + 2 * i + 1) * 65 + n]);
    const int gn = d.n0 + n;
    int row = gn;
    if (d.mode == 1) row = (gn >> 4) * 32 + (gn & 15);
    else if (d.mode == 2) row = (gn >> 4) * 32 + 16 + (gn & 15);
    else if (d.mode == 3) row = n;
    uint4* o = (uint4*)(d.dst + (size_t)row * d.ldd + d.k0 + kq * 16);
    o[0] = make_uint4(w[0], w[1], w[2], w[3]);
    o[1] = make_uint4(w[4], w[5], w[6], w[7]);
    if (d.zr) {
        uint4* z = (uint4*)(WSP_WrT + (size_t)(64 + n) * 1024 + d.k0 + kq * 16);
        z[0] = make_uint4(0, 0, 0, 0); z[1] = make_uint4(0, 0, 0, 0);
    }
}

__device__ __forceinline__ void ada_item(const Params& p, int item) {
    float* sc = (float*)smem;
    float* red = sc + 9 * 1024;
    const int tid = TIDX;
    __syncthreads();
    for (int i = tid; i < 9 * 1024; i += NTHR) {
        const int r = i >> 10, k = i & 1023;
        const float cv = (r < 8) ? p.c[r * 1024 + k] : p.c_ctx[k];
        sc[i] = siluf_(cv);
    }
    __syncthreads();
    const int kq = tid >> 6, jl = tid & 63, j = item * 64 + jl;
    float acc[9];
#pragma unroll
    for (int r = 0; r < 9; ++r) acc[r] = 0.f;
#pragma unroll 16
    for (int k = kq; k < 1024; k += 4) {
        const float w = p.w_ada[(size_t)k * 6144 + j];
#pragma unroll
        for (int r = 0; r < 9; ++r) acc[r] += sc[r * 1024 + k] * w;
    }
#pragma unroll
    for (int r = 0; r < 9; ++r) red[(kq * 9 + r) * 64 + jl] = acc[r];
    __syncthreads();
    for (int i = tid; i < 9 * 64; i += NTHR) {
        const int r = i >> 6, l = i & 63;
        const float s = red[(0 * 9 + r) * 64 + l] + red[(1 * 9 + r) * 64 + l] + red[(2 * 9 + r) * 64 + l] + red[(3 * 9 + r) * 64 + l];
        WSP_mod[r * 6144 + item * 64 + l] = s + p.b_ada[item * 64 + l];
    }
}

__device__ __forceinline__ void rope_item(const Params& p) {
    for (int i = TIDX; i < 64 * 16; i += NTHR) {
        const int pos = i >> 4, k = i & 15;
        const float inv = exp2f(-(float)k * (13.287712379549449f / 16.f));
        float s, c;
        sincosf((float)pos * inv, &s, &c);
        WSP_rope[i] = make_float2(c, s);
    }
}

__device__ __forceinline__ void ssm_table_item(const Params& p, int g, int dir) {
    float* pw = (float*)smem;
    float* Bb = pw + 17 * 64 * 2;
    float* Cc = Bb + 64 * 16 * 2;
    const int tid = TIDX;
    u16* tabS = WSP_TabS + (size_t)g * 256 * 256;
    u16* tabY = WSP_TabY + (size_t)g * 256 * 512;
    float* Kf = WSP_Kbuf + (size_t)(g * 2 + dir) * 4096;
    __syncthreads();
    {
        const int pidx = dir * 32 + g;
        const float dt = __expf(p.log_dt[pidx]);
        for (int i = tid; i < 17 * 64; i += NTHR) {
            const int tau = i >> 6, n = i & 63;
            const float are = p.a_re[pidx * 64 + n], aim = p.a_im[pidx * 64 + n];
            const float mag = __expf((float)tau * dt * are);
            float rev = (float)tau * (dt * aim * 0.15915494309189535f);
            rev -= rintf(rev);
            pw[i * 2] = mag * __builtin_amdgcn_cosf(rev);
            pw[i * 2 + 1] = mag * __builtin_amdgcn_sinf(rev);
        }
        __syncthreads();
        for (int i = tid; i < 64 * 16; i += NTHR) {
            const int n = i >> 4;
            const float are = p.a_re[pidx * 64 + n], aim = p.a_im[pidx * 64 + n];
            const float abr = pw[(64 + n) * 2], abi = pw[(64 + n) * 2 + 1];
            const float den = are * are + aim * aim, nre = abr - 1.f;
            const float cre = (nre * are + abi * aim) / den, cim = (abi * are - nre * aim) / den;
            const float br = p.b_re[(size_t)pidx * 1024 + i], bi = p.b_im[(size_t)pidx * 1024 + i];
            Bb[i * 2] = cre * br - cim * bi;
            Bb[i * 2 + 1] = cre * bi + cim * br;
            Cc[i * 2] = p.c_re[(size_t)pidx * 1024 + i];
            Cc[i * 2 + 1] = p.c_im[(size_t)pidx * 1024 + i];
        }
        __syncthreads();
        {
            const int tau = tid >> 4, pp = tid & 15;
            float s[16];
#pragma unroll
            for (int q = 0; q < 16; ++q) s[q] = 0.f;
            for (int n = 0; n < 64; ++n) {
                const float2 cv = *(const float2*)&Cc[(pp * 64 + n) * 2];
                const float2 wv = *(const float2*)&pw[(tau * 64 + n) * 2];
                const float zr = cv.x * wv.x - cv.y * wv.y, zi = cv.x * wv.y + cv.y * wv.x;
#pragma unroll
                for (int q = 0; q < 16; ++q) {
                    const float2 bv = *(const float2*)&Bb[(n * 16 + q) * 2];
                    s[q] += zr * bv.x - zi * bv.y;
                }
            }
#pragma unroll
            for (int q = 0; q < 4; ++q)
                *(float4*)(Kf + tau * 256 + pp * 16 + q * 4) = make_float4(s[4 * q], s[4 * q + 1], s[4 * q + 2], s[4 * q + 3]);
        }
        for (int id = tid; id < 128 * 32; id += NTHR) {
            const int rr = id >> 5, ch = id & 31, cpart = rr >> 6, n = rr & 63, s_ = ch >> 1, q0 = (ch & 1) * 8;
            const int e = dir == 0 ? 15 - s_ : s_;
            const float wr_ = pw[(e * 64 + n) * 2], wi_ = pw[(e * 64 + n) * 2 + 1];
            unsigned w[4];
#pragma unroll
            for (int i = 0; i < 4; ++i) {
                float v[2];
#pragma unroll
                for (int h = 0; h < 2; ++h) {
                    const float br = Bb[(n * 16 + q0 + 2 * i + h) * 2], bi = Bb[(n * 16 + q0 + 2 * i + h) * 2 + 1];
                    v[h] = cpart == 0 ? (wr_ * br - wi_ * bi) : (wr_ * bi + wi_ * br);
                }
                w[i] = pack2(v[0], v[1]);
            }
            *(uint4*)(tabS + (size_t)(dir * 128 + rr) * 256 + s_ * 16 + q0) = make_uint4(w[0], w[1], w[2], w[3]);
        }
        for (int id = tid; id < 256 * 16; id += NTHR) {
            const int m = id >> 4, ch = id & 15, t = m >> 4, pp = m & 15, cpart = ch >> 3, n0 = (ch & 7) * 8;
            const int e = dir == 0 ? t + 1 : 16 - t;
            unsigned w[4];
#pragma unroll
            for (int i = 0; i < 4; ++i) {
                float v[2];
#pragma unroll
                for (int h = 0; h < 2; ++h) {
                    const int n = n0 + 2 * i + h;
                    const float cr = Cc[(pp * 64 + n) * 2], ci = Cc[(pp * 64 + n) * 2 + 1];
                    const float wr_ = pw[(e * 64 + n) * 2], wi_ = pw[(e * 64 + n) * 2 + 1];
                    v[h] = cpart == 0 ? (cr * wr_ - ci * wi_) : -(cr * wi_ + ci * wr_);
                }
                w[i] = pack2(v[0], v[1]);
            }
            *(uint4*)(tabY + (size_t)m * 512 + 256 + dir * 128 + cpart * 64 + n0) = make_uint4(w[0], w[1], w[2], w[3]);
        }
    }
}

__device__ __forceinline__ void ssm_toeplitz_item(const Params& p, int g) {
    float* Kf = (float*)smem;
    const int tid = TIDX;
    u16* tabY = WSP_TabY + (size_t)g * 256 * 512;
    __syncthreads();
    for (int i = tid; i < 2048; i += NTHR) ((float4*)Kf)[i] = ((const float4*)(WSP_Kbuf + (size_t)g * 8192))[i];
    __syncthreads();
    for (int id = tid; id < 256 * 32; id += NTHR) {
        const int m = id >> 5, ch = id & 31, t = m >> 4, pp = m & 15, s_ = ch >> 1, q0 = (ch & 1) * 8;
        unsigned w[4];
#pragma unroll
        for (int i = 0; i < 4; ++i) {
            float v[2];
#pragma unroll
            for (int h = 0; h < 2; ++h) {
                const int q = q0 + 2 * i + h;
                float val;
                if (s_ < t) val = Kf[((t - s_) * 16 + pp) * 16 + q];
                else if (s_ > t) val = Kf[4096 + ((s_ - t) * 16 + pp) * 16 + q];
                else val = Kf[(pp) * 16 + q] + Kf[4096 + pp * 16 + q] + (pp == q ? p.ssm_d[g * 16 + pp] : 0.f);
                v[h] = val;
            }
            w[i] = pack2(v[0], v[1]);
        }
        *(uint4*)(tabY + (size_t)m * 512 + s_ * 16 + q0) = make_uint4(w[0], w[1], w[2], w[3]);
    }
    __syncthreads();
}

#define N_CONV 6896
__device__ __forceinline__ ConvD conv_decode(const Params& p, int t) {
    ConvD d; d.mode = 0; d.zr = 0;
    if (t < 320) { d.src = p.w_in; d.ld = 1280; d.k0 = (t / 20) * 64; d.n0 = (t % 20) * 64; d.dst = WSP_WinT; d.ldd = 1024; return d; }
    t -= 320;
    if (t < 64) { d.src = p.w_glu; d.ld = 512; d.k0 = (t / 8) * 64; d.n0 = (t % 8) * 64; d.dst = WSP_WgluT; d.ldd = 512; return d; }
    t -= 64;
    if (t < 256) { d.src = p.w_out; d.ld = 1024; d.k0 = (t / 16) * 64; d.n0 = (t % 16) * 64; d.dst = WSP_WoutT; d.ldd = 1024; return d; }
    t -= 256;
    if (t < 16) { d.src = p.w_router; d.ld = 64; d.k0 = t * 64; d.n0 = 0; d.dst = WSP_WrT; d.ldd = 1024; d.zr = 1; return d; }
    t -= 16;
    if (t < 4096) {
        const int up = t >= 2048; const int tt = t & 2047, e = tt >> 5, r = tt & 31;
        d.src = (up ? p.w_up_e : p.w_gate_e) + (size_t)e * 131072; d.ld = 128; d.k0 = (r >> 1) * 64; d.n0 = (r & 1) * 64;
        d.dst = WSP_WguT + (size_t)e * 262144; d.ldd = 1024; d.mode = 1 + up; return d;
    }
    t -= 4096;
    if (t < 64) {
        const int up = t >= 32; const int r = t & 31;
        d.src = up ? p.w_up_s : p.w_gate_s; d.ld = 128; d.k0 = (r >> 1) * 64; d.n0 = (r & 1) * 64;
        d.dst = WSP_WguT + (size_t)64 * 262144; d.ldd = 1024; d.mode = 1 + up; return d;
    }
    t -= 64;
    if (t < 2048) { const int e = t >> 5, r = t & 31; d.src = p.w_down_e + (size_t)e * 131072; d.ld = 1024; d.k0 = (r >> 4) * 64; d.n0 = (r & 15) * 64; d.dst = WSP_WdT + (size_t)e * 131072; d.ldd = 128; return d; }
    t -= 2048;
    d.src = p.w_down_s; d.ld = 1024; d.k0 = (t >> 4) * 64; d.n0 = (t & 15) * 64; d.dst = WSP_WdT + (size_t)64 * 131072; d.ldd = 128; return d;
}

#define N_CONV_EARLY 656
__device__ __forceinline__ void conv_range(const Params& p, int t0, int stride, int tend, int tbeg = 0) {
    int t = tbeg + t0;
    if (t < tend) {
        ConvD d = conv_decode(p, t);
        float v[16];
        conv_load(d, v);
        while (t < tend) {
            const int tn = t + stride;
            ConvD dn = d;
            float vn[16];
            if (tn < tend) { dn = conv_decode(p, tn); conv_load(dn, vn); }
            conv_store(p, d, v);
            d = dn;
#pragma unroll
            for (int i = 0; i < 16; ++i) v[i] = vn[i];
            t = tn;
        }
    }
}
#define P0_CONV_B0 161
__device__ __forceinline__ void phase0(const Params& p) {
    const int b = blockIdx.x, G = gridDim.x;
    if (G > P0_CONV_B0 + 32) {
        if (b < 64) ssm_table_item(p, b >> 1, b & 1);
        else if (b < 160) ada_item(p, b - 64);
        else if (b == 160) rope_item(p);
        else conv_range(p, b - P0_CONV_B0, G - P0_CONV_B0, N_CONV_EARLY);
    } else {
        const int NU = 64 + 96 + 1 + N_CONV_EARLY;
        for (int u = b; u < NU; u += G) {
            if (u < 64) ssm_table_item(p, u >> 1, u & 1);
            else if (u < 160) ada_item(p, u - 64);
            else if (u == 160) rope_item(p);
            else { ConvD d = conv_decode(p, u - 161); float v[16]; conv_load(d, v); conv_store(p, d, v); }
        }
    }
}
#if 0
    {
        {
            const int stride = G - P0_CONV_B0;
            int t = b - P0_CONV_B0;
            if (t < N_CONV) {
                ConvD d = conv_decode(p, t);
                float v[16];
                conv_load(d, v);
                while (t < N_CONV) {
                    const int tn = t + stride;
                    ConvD dn = d;
                    float vn[16];
                    if (tn < N_CONV) { dn = conv_decode(p, tn); conv_load(dn, vn); }
                    conv_store(p, d, v);
                    d = dn;
#pragma unroll
                    for (int i = 0; i < 16; ++i) v[i] = vn[i];
                    t = tn;
                }
            }
        }
    } else {
        const int NU = 64 + 96 + 1 + N_CONV;
        for (int u = b; u < NU; u += G) {
            if (u < 64) ssm_table_item(p, u >> 1, u & 1);
            else if (u < 160) ada_item(p, u - 64);
            else if (u == 160) rope_item(p);
            else { ConvD d = conv_decode(p, u - 161); float v[16]; conv_load(d, v); conv_store(p, d, v); }
        }
    }
}

#endif

__device__ __forceinline__ void norm_mod_row(const float* src, const float* gain, const float* sh, const float* scl, u16* dst) {
    const int lane = TIDX & 63;
    float4 v[4];
    float ss = 0.f;
#pragma unroll
    for (int i = 0; i < 4; ++i) {
        v[i] = *(const float4*)(src + i * 256 + lane * 4);
        ss += v[i].x * v[i].x + v[i].y * v[i].y + v[i].z * v[i].z + v[i].w * v[i].w;
    }
    ss = wave_sum(ss);
    const float rs = rsqrtf(ss * (1.f / 1024.f) + EPS);
#pragma unroll
    for (int i = 0; i < 4; ++i) {
        const int c0 = i * 256 + lane * 4;
        const float4 g = *(const float4*)(gain + c0), s = *(const float4*)(sh + c0), k = *(const float4*)(scl + c0);
        const float a = v[i].x * rs * g.x * (1.f + k.x) + s.x, b = v[i].y * rs * g.y * (1.f + k.y) + s.y;
        const float c = v[i].z * rs * g.z * (1.f + k.z) + s.z, d = v[i].w * rs * g.w * (1.f + k.w) + s.w;
        *(uint2*)(dst + c0) = make_uint2(pack2(a, b), pack2(c, d));
    }
}

__device__ __forceinline__ void phase1(const Params& p) {
    for (int g = blockIdx.x; g < 32; g += gridDim.x) ssm_toeplitz_item(p, g);
    const int wv = blockIdx.x * 4 + (TIDX >> 6), nwv = gridDim.x * 4;
    for (int r = wv; r < NROWS; r += nwv) {
        const float* src; const float* md;
        if (r < NLAT) { src = p.x + (size_t)r * 1024; md = WSP_mod + (r >> 11) * 6144; }
        else { src = p.ctx + (size_t)(r - NLAT) * 1024; md = WSP_mod + 8 * 6144; }
        norm_mod_row(src, p.norm_mix, md, md + 1024, WSP_Hb + (size_t)r * 1024);
    }
}

__device__ __forceinline__ void phase2(const Params& p) {
    const int NU = 128 * 10 + 16 * 6;
    const int lane = TIDX & 63, wid = TIDX >> 6, wr = wid >> 1, wc = wid & 1, fr = lane & 15, fq = lane >> 4;
    for (int u = blockIdx.x; u < NU; u += gridDim.x) {
        int mt, nt;
        if (u < 1280) { mt = u / 10; nt = u % 10; } else { const int v = u - 1280; mt = 128 + v / 6; nt = 4 + v % 6; }
        const u16* A = WSP_Hb + (size_t)mt * 128 * 1024;
        const u16* B = WSP_WinT + (size_t)nt * 128 * 1024;
        f32x4 acc[4][4];
        gemm_tile(16,
            [&](int R, int C, int kt) { return (const void*)(A + (size_t)R * 1024 + kt * 64 + C); },
            [&](int R, int C, int kt) { return (const void*)(B + (size_t)R * 1024 + kt * 64 + C); }, acc);
        const int row0 = mt * 128 + wr * 64;
        const int col0 = nt * 128 + wc * 64;
        const bool is_lat = mt < 128;
        if (nt == 5) {
            const int kvh = wc;
#pragma unroll
            for (int m = 0; m < 4; ++m) {
                const int r = row0 + m * 16 + fq * 4;
                int b, pos;
                if (is_lat) { b = r >> 11; pos = r & 2047; } else { const int rc = r - NLAT; b = rc >> 8; pos = SEQ + (rc & 255); }
#pragma unroll
                for (int n = 0; n < 4; ++n) {
                    const int d = n * 16 + fr;
                    u16* dst = WSP_Vt + ((size_t)(b * 2 + kvh) * 64 + d) * VT_LD + pos;
                    *(uint2*)dst = make_uint2(pack2(acc[m][n][0], acc[m][n][1]), pack2(acc[m][n][2], acc[m][n][3]));
                }
            }
        } else {
            float v[4][4][4];
            const bool do_rope = is_lat && nt <= 4;
#pragma unroll
            for (int m = 0; m < 4; ++m)
#pragma unroll
                for (int j = 0; j < 4; ++j) {
                    if (do_rope) {
                        const int r = row0 + m * 16 + fq * 4 + j, pos = r & 2047;
                        const float2 cr = WSP_rope[(pos >> 6) * 16 + fr], cc = WSP_rope[(pos & 63) * 16 + fr];
                        const float x1 = acc[m][0][j], x2 = acc[m][1][j], y1 = acc[m][2][j], y2 = acc[m][3][j];
                        v[m][0][j] = x1 * cr.x - x2 * cr.y; v[m][1][j] = x1 * cr.y + x2 * cr.x;
                        v[m][2][j] = y1 * cc.x - y2 * cc.y; v[m][3][j] = y1 * cc.y + y2 * cc.x;
                    } else {
#pragma unroll
                        for (int n = 0; n < 4; ++n) v[m][n][j] = acc[m][n][j];
                    }
                }
            u16* dbase; int ldd;
            if (nt < 4) { dbase = WSP_Q + (size_t)row0 * 512 + col0; ldd = 512; }
            else if (nt == 4) { dbase = WSP_Kb + (size_t)row0 * 128 + (col0 - 512); ldd = 128; }
            else { dbase = WSP_U + (size_t)row0 * 512 + (col0 - 768); ldd = 512; }
            wave_store_bf16(v, [&](int row) { return dbase + (size_t)row * ldd; });
        }
    }
}

__device__ __forceinline__ void attn_unit(const Params& p, int u) {
    const int h = u & 7, qb = (u >> 3) & 15, b = u >> 7, kvh = h >> 2;
    const int tid = TIDX, lane = tid & 63, wid = tid >> 6, fr = lane & 15, fq = lane >> 4;
    const int sb = lane * 16, swz = sb ^ (((sb >> 9) & 1) << 5);
    const int r_in = swz >> 6, c_in = (swz & 63) >> 1;
    const int jstart = qb == 0 ? 2 : 0, jend = qb == 15 ? 4 : 6, nb = jend - jstart, ntile = nb + 4;
    const float SC = 0.125f * 1.4426950408889634f;
    bf16x8 qf[2][2];
    const int qrow0 = b * SEQ + qb * 128 + wid * 32;
#pragma unroll
    for (int qt = 0; qt < 2; ++qt)
#pragma unroll
        for (int ks = 0; ks < 2; ++ks)
            qf[qt][ks] = *(const bf16x8*)(WSP_Q + (size_t)(qrow0 + qt * 16 + fr) * 512 + h * 64 + ks * 32 + fq * 8);
    f32x4 o[4][2];
#pragma unroll
    for (int dt = 0; dt < 4; ++dt)
#pragma unroll
        for (int qt = 0; qt < 2; ++qt) o[dt][qt] = (f32x4){0.f, 0.f, 0.f, 0.f};
    float mrun[2], lrun[2];
    const float sinkv = p.attn_sink[h] * 1.4426950408889634f;
    mrun[0] = mrun[1] = sinkv;
    lrun[0] = lrun[1] = (fq == 0) ? 1.f : 0.f;
    __syncthreads();
    auto stage = [&](int i, int s) {
        const u16* kbase; const u16* vbase;
        if (i < nb) {
            const int ks0 = qb * 128 - 128 + 64 * (jstart + i);
            kbase = WSP_Kb + (size_t)(b * SEQ + ks0) * 128 + kvh * 64;
            vbase = WSP_Vt + (size_t)(b * 2 + kvh) * 64 * VT_LD + ks0;
        } else {
            const int c0 = 64 * (i - nb);
            kbase = WSP_Kb + (size_t)(NLAT + b * CTXL + c0) * 128 + kvh * 64;
            vbase = WSP_Vt + (size_t)(b * 2 + kvh) * 64 * VT_LD + SEQ + c0;
        }
        char* sk = smem + s * 16384;
        char* sv = sk + 8192;
#pragma unroll
        for (int it = 0; it < 2; ++it) {
            const int st = wid + 4 * it, R = (st >> 1) * 16 + r_in, C = (st & 1) * 32 + c_in;
            glds16(kbase + (size_t)R * 128 + C, sk + tid * 16 + it * 4096);
            glds16(vbase + (size_t)R * VT_LD + C, sv + tid * 16 + it * 4096);
        }
    };
    stage(0, 0);
    for (int i = 0; i < ntile; ++i) {
        asm volatile("s_waitcnt vmcnt(0)" ::: "memory");
        __syncthreads();
        if (i + 1 < ntile) stage(i + 1, (i + 1) & 1);
        const char* sk = smem + (i & 1) * 16384;
        const char* sv = sk + 8192;
        f32x4 s[4][2];
#pragma unroll
        for (int kt = 0; kt < 4; ++kt)
#pragma unroll
            for (int qt = 0; qt < 2; ++qt) s[kt][qt] = (f32x4){0.f, 0.f, 0.f, 0.f};
#pragma unroll
        for (int ks = 0; ks < 2; ++ks)
#pragma unroll
            for (int kt = 0; kt < 4; ++kt) {
                const bf16x8 kf = *(const bf16x8*)(sk + lds_byte(kt * 16 + fr, ks * 32 + fq * 8));
#pragma unroll
                for (int qt = 0; qt < 2; ++qt) s[kt][qt] = __builtin_amdgcn_mfma_f32_16x16x32_bf16(kf, qf[qt][ks], s[kt][qt], 0, 0, 0);
            }
        const bool band = i < nb;
        const int ks0 = qb * 128 - 128 + 64 * (jstart + i);
        bf16x8 pf[2][2];
#pragma unroll
        for (int qt = 0; qt < 2; ++qt) {
            const int qp = qb * 128 + wid * 32 + qt * 16 + fr;
            float mx = -1e30f;
#pragma unroll
            for (int kt = 0; kt < 4; ++kt)
#pragma unroll
                for (int j = 0; j < 4; ++j) {
                    float v = s[kt][qt][j] * SC;
                    if (band) {
                        const int kp = ks0 + kt * 16 + fq * 4 + j, d = qp - kp;
                        if (d > 128 || d < -128) v = -1e30f;
                    }
                    s[kt][qt][j] = v;
                    mx = fmaxf(mx, v);
                }
            mx = fmaxf(mx, __shfl_xor(mx, 16));
            mx = fmaxf(mx, __shfl_xor(mx, 32));
            const float mnew = fmaxf(mrun[qt], mx);
            const float alpha = __builtin_amdgcn_exp2f(mrun[qt] - mnew);
            mrun[qt] = mnew;
            float ls = 0.f;
#pragma unroll
            for (int kt = 0; kt < 4; ++kt)
#pragma unroll
                for (int j = 0; j < 4; ++j) {
                    const float pv = __builtin_amdgcn_exp2f(s[kt][qt][j] - mnew);
                    s[kt][qt][j] = pv;
                    ls += pv;
                }
            lrun[qt] = lrun[qt] * alpha + ls;
#pragma unroll
            for (int dt = 0; dt < 4; ++dt) o[dt][qt] *= alpha;
#pragma unroll
            for (int k2 = 0; k2 < 2; ++k2) {
                bf16x8 t;
#pragma unroll
                for (int j = 0; j < 4; ++j) { t[j] = (short)f2bf(s[2 * k2][qt][j]); t[4 + j] = (short)f2bf(s[2 * k2 + 1][qt][j]); }
                pf[qt][k2] = t;
            }
        }
#pragma unroll
        for (int k2 = 0; k2 < 2; ++k2)
#pragma unroll
            for (int dt = 0; dt < 4; ++dt) {
                const uint2 lo = *(const uint2*)(sv + lds_byte(dt * 16 + fr, k2 * 32 + fq * 4));
                const uint2 hi = *(const uint2*)(sv + lds_byte(dt * 16 + fr, k2 * 32 + 16 + fq * 4));
                union { uint4 u; bf16x8 v; } cv; cv.u = make_uint4(lo.x, lo.y, hi.x, hi.y);
#pragma unroll
                for (int qt = 0; qt < 2; ++qt) o[dt][qt] = __builtin_amdgcn_mfma_f32_16x16x32_bf16(cv.v, pf[qt][k2], o[dt][qt], 0, 0, 0);
            }
    }
#pragma unroll
    for (int qt = 0; qt < 2; ++qt) {
        float l = lrun[qt];
        l += __shfl_xor(l, 16);
        l += __shfl_xor(l, 32);
        const float inv = 1.f / l;
        u16* dst = WSP_AO + (size_t)(qrow0 + qt * 16 + fr) * 512 + h * 64 + fq * 4;
#pragma unroll
        for (int dt = 0; dt < 4; ++dt)
            *(uint2*)(dst + dt * 16) = make_uint2(pack2(o[dt][qt][0] * inv, o[dt][qt][1] * inv), pack2(o[dt][qt][2] * inv, o[dt][qt][3] * inv));
    }
}

__device__ __forceinline__ void ssm_s1_unit(const Params& p, int u) {
    const int ct = u % 9, mh = (u / 9) & 1, g = u / 18;
    const int lane = TIDX & 63, wid = TIDX >> 6, wr = wid >> 1, wc = wid & 1, fr = lane & 15, fq = lane >> 4;
    const u16* A = WSP_TabS + ((size_t)g * 256 + mh * 128) * 256;
    const u16* Ub = WSP_U + (size_t)ct * 128 * 16 * 512 + g * 16;
    f32x4 acc[4][4];
    gemm_tile(4,
        [&](int R, int C, int kt) { return (const void*)(A + (size_t)R * 256 + kt * 64 + C); },
        [&](int R, int C, int kt) { return (const void*)(Ub + (size_t)(R * 16 + kt * 4 + (C >> 4)) * 512 + (C & 15)); }, acc);
#pragma unroll
    for (int m = 0; m < 4; ++m)
#pragma unroll
        for (int n = 0; n < 4; ++n) {
            const int rho = mh * 128 + wr * 64 + m * 16 + fq * 4;
            const int cg = ct * 128 + wc * 64 + n * 16 + fr;
            *(f32x4*)(WSP_S + ((size_t)cg * 32 + g) * 256 + rho) = acc[m][n];
        }
}

__device__ __forceinline__ void phase3(const Params& p) {
    const int NU = 1024 + 576;
    for (int u = blockIdx.x; u < NU; u += gridDim.x) {
        if (u < 1024) attn_unit(p, u); else ssm_s1_unit(p, u - 1024);
    }
}

__device__ __forceinline__ void phase4(const Params& p) {
    if ((int)gridDim.x > 160) { if ((int)blockIdx.x >= 128) { conv_range(p, blockIdx.x - 128, gridDim.x - 128, N_CONV, N_CONV_EARLY); return; } }
    else conv_range(p, blockIdx.x, gridDim.x, N_CONV, N_CONV_EARLY);
    const int gid = blockIdx.x * NTHR + TIDX;
    if (gid >= BATCH * 2 * 32 * 64) return;
    const int n = gid & 63, g = (gid >> 6) & 31, dir = (gid >> 11) & 1, b = gid >> 12;
    const int pidx = dir * 32 + g;
    const float dt = __expf(p.log_dt[pidx]);
    const float are = p.a_re[pidx * 64 + n], aim = p.a_im[pidx * 64 + n];
    const float mag = __expf(16.f * dt * are);
    float rev = 16.f * (dt * aim * 0.15915494309189535f);
    rev -= rintf(rev);
    const float ar = mag * __builtin_amdgcn_cosf(rev), ai = mag * __builtin_amdgcn_sinf(rev);
    float hr = 0.f, hi = 0.f;
    const size_t so = (size_t)g * 256 + dir * 128 + n;
#pragma unroll 8
    for (int i = 0; i < 16; ++i) {
        const int c = dir == 0 ? i : 15 - i;
        const float* sp = WSP_S + (size_t)(NCHUNK_LAT + b * 16 + c) * 8192 + so;
        const float sr = sp[0], si = sp[64];
        const float nr = ar * hr - ai * hi + sr, ni = ar * hi + ai * hr + si;
        hr = nr; hi = ni;
    }
#pragma unroll 8
    for (int i = 0; i < 128; ++i) {
        const int c = dir == 0 ? i : 127 - i;
        const size_t cg = (size_t)b * 128 + c;
        const float* sp = WSP_S + cg * 8192 + so;
        const float sr = sp[0], si = sp[64];
        u16* hp = WSP_Hin + cg * 8192 + so;
        hp[0] = f2bf(hr); hp[64] = f2bf(hi);
        const float nr = ar * hr - ai * hi + sr, ni = ar * hi + ai * hr + si;
        hr = nr; hi = ni;
    }
}

__device__ __forceinline__ void phase5(const Params& p) {
    const int NU = 512;
    const int lane = TIDX & 63, wid = TIDX >> 6, wr = wid >> 1, wc = wid & 1, fr = lane & 15, fq = lane >> 4;
    for (int u = blockIdx.x; u < NU; u += gridDim.x) {
        const int ct = u & 7, mh = (u >> 3) & 1, g = u >> 4;
        const u16* A = WSP_TabY + ((size_t)g * 256 + mh * 128) * 512;
        const u16* Ub = WSP_U + (size_t)ct * 128 * 16 * 512 + g * 16;
        const u16* Hb_ = WSP_Hin + (size_t)ct * 128 * 8192 + g * 256;
        f32x4 acc[4][4];
        gemm_tile(8,
            [&](int R, int C, int kt) { return (const void*)(A + (size_t)R * 512 + kt * 64 + C); },
            [&](int R, int C, int kt) {
                return kt < 4 ? (const void*)(Ub + (size_t)(R * 16 + kt * 4 + (C >> 4)) * 512 + (C & 15))
                              : (const void*)(Hb_ + (size_t)R * 8192 + (kt - 4) * 64 + C);
            }, acc);
#pragma unroll
        for (int m = 0; m < 4; ++m)
#pragma unroll
            for (int n = 0; n < 4; ++n) {
                const int t = mh * 8 + wr * 4 + m;
                const int cg = ct * 128 + wc * 64 + n * 16 + fr;
                u16* dst = WSP_Y + ((size_t)cg * 16 + t) * 512 + g * 16 + fq * 4;
                *(uint2*)dst = make_uint2(pack2(gelu_tanh(acc[m][n][0]), gelu_tanh(acc[m][n][1])),
                                          pack2(gelu_tanh(acc[m][n][2]), gelu_tanh(acc[m][n][3])));
            }
    }
}

__device__ __forceinline__ void phase6(const Params& p) {
    const int NU = 512;
    const int lane = TIDX & 63, wid = TIDX >> 6, wr = wid >> 1, wc = wid & 1, fr = lane & 15, fq = lane >> 4;
    for (int u = blockIdx.x; u < NU; u += gridDim.x) {
        const int mt = u >> 2, nt = u & 3;
        const u16* A = WSP_Y + (size_t)mt * 128 * 512;
        const u16* B = WSP_WgluT + (size_t)nt * 128 * 512;
        f32x4 acc[4][4];
        gemm_tile(8,
            [&](int R, int C, int kt) { return (const void*)(A + (size_t)R * 512 + kt * 64 + C); },
            [&](int R, int C, int kt) { return (const void*)(B + (size_t)R * 512 + kt * 64 + C); }, acc);
        const int row0 = mt * 128 + wr * 64, col0 = nt * 128 + wc * 64;
        float v[4][4][4];
#pragma unroll
        for (int m = 0; m < 4; ++m)
#pragma unroll
            for (int n = 0; n < 4; ++n)
#pragma unroll
                for (int j = 0; j < 4; ++j) {
                    const int r = row0 + m * 16 + fq * 4 + j, c = col0 + n * 16 + fr;
                    const float yv = bf2f(WSP_Y[(size_t)r * 512 + c]);
                    v[m][n][j] = yv * sigmoidf_(acc[m][n][j] + p.b_glu[c]);
                }
        u16* dbase = WSP_SO + (size_t)row0 * 512 + col0;
        wave_store_bf16(v, [&](int row) { return dbase + (size_t)row * 512; });
    }
}

__device__ __forceinline__ void phase7(const Params& p) {
    const int lane = TIDX & 63;
    const int wv = blockIdx.x * 4 + (TIDX >> 6), nwv = gridDim.x * 4;
    for (int it = wv; it < NLAT * 2; it += nwv) {
        const int r = it >> 1, half = it & 1;
        const u16* src = (half ? WSP_SO : WSP_AO) + (size_t)r * 512 + lane * 8;
        const float* gain = (half ? p.norm_ssm_out : p.norm_attn_out) + lane * 8;
        const uint4 d = *(const uint4*)src;
        float f[8];
        f[0] = bf2f((u16)(d.x & 0xffff)); f[1] = bf2f((u16)(d.x >> 16));
        f[2] = bf2f((u16)(d.y & 0xffff)); f[3] = bf2f((u16)(d.y >> 16));
        f[4] = bf2f((u16)(d.z & 0xffff)); f[5] = bf2f((u16)(d.z >> 16));
        f[6] = bf2f((u16)(d.w & 0xffff)); f[7] = bf2f((u16)(d.w >> 16));
        float ss = 0.f;
#pragma unroll
        for (int i = 0; i < 8; ++i) ss += f[i] * f[i];
        ss = wave_sum(ss);
        const float rs = rsqrtf(ss * (1.f / 512.f) + EPS);
        const float4 g0 = *(const float4*)gain, g1 = *(const float4*)(gain + 4);
        *(uint4*)(WSP_CAT + (size_t)r * 1024 + half * 512 + lane * 8) =
            make_uint4(pack2(f[0] * rs * g0.x, f[1] * rs * g0.y), pack2(f[2] * rs * g0.z, f[3] * rs * g0.w),
                       pack2(f[4] * rs * g1.x, f[5] * rs * g1.y), pack2(f[6] * rs * g1.z, f[7] * rs * g1.w));
    }
}

__device__ __forceinline__ void phase8(const Params& p) {
    const int NU = 512;
    const int lane = TIDX & 63, wid = TIDX >> 6, wr = wid >> 1, wc = wid & 1, fr = lane & 15, fq = lane >> 4;
    for (int u = blockIdx.x; u < NU; u += gridDim.x) {
        const int mt = u >> 2, nt = u & 3;
        const u16* A = WSP_CAT + (size_t)mt * 128 * 1024;
        const u16* B = WSP_WoutT + (size_t)nt * 256 * 1024;
        f32x4 acc[4][8];
        gemm_tile_w(32,
            [&](int i, int R, int C, int kt) { return (const void*)(A + (size_t)R * 1024 + kt * 32 + C); },
            [&](int i, int R, int C, int kt) { return (const void*)(B + (size_t)R * 1024 + kt * 32 + C); }, acc);
        const int row0 = mt * 128 + wr * 64, col0 = nt * 256 + wc * 128;
        const float* g1 = WSP_mod + (mt >> 4) * 6144 + 2048 + col0;
        float* stg = (float*)(smem + wid * 8448);
#pragma unroll
        for (int m = 0; m < 4; ++m) {
#pragma unroll
            for (int n = 0; n < 8; ++n)
#pragma unroll
                for (int j = 0; j < 4; ++j) stg[(fq * 4 + j) * 132 + n * 16 + fr] = acc[m][n][j];
            asm volatile("s_waitcnt lgkmcnt(0)" ::: "memory");
            __builtin_amdgcn_wave_barrier();
#pragma unroll
            for (int i = 0; i < 8; ++i) {
                const int id = i * 64 + lane, rr = id >> 5, c4 = (id & 31) * 4;
                const float4 v = *(const float4*)(stg + rr * 132 + c4);
                const float4 g = *(const float4*)(g1 + c4);
                const size_t o = (size_t)(row0 + m * 16 + rr) * 1024 + col0 + c4;
                const float4 xv = *(const float4*)(p.x + o);
                *(float4*)(p.out + o) = make_float4(xv.x + g.x * v.x, xv.y + g.y * v.y, xv.z + g.z * v.z, xv.w + g.w * v.w);
            }
            asm volatile("s_waitcnt lgkmcnt(0)" ::: "memory");
            __builtin_amdgcn_wave_barrier();
        }
    }
}

#define CTR_ECNT 0
#define CTR_Q11 128
#define CTR_Q12 136
#define HALF_TOK 8192
#define HH_HALF_ROWS 73728
#define ELIST_CAP 8192
__device__ __forceinline__ void phase9(const Params& p) {
    const int tid = TIDX, lane = tid & 63, wid = tid >> 6, fr = lane & 15, fq = lane >> 4;
    char* At = smem;
    float* sc = (float*)(smem + 32768);
    int* hist = (int*)(smem + 32768 + 4096);
    int* gbase = hist + 64;
    int* fill = gbase + 64;
    unsigned char* selk = (unsigned char*)(fill + 64);
    for (int chunk = blockIdx.x; chunk < NLAT / 32; chunk += gridDim.x) {
        __syncthreads();
        if (tid < 64) hist[tid] = 0;
        for (int grp = 0; grp < 2; ++grp) {
            const int tok0 = chunk * 32 + grp * 16;
            __syncthreads();
            for (int rr = 0; rr < 4; ++rr) {
                const int row = wid * 4 + rr, tok = tok0 + row;
                const float* src = p.out + (size_t)tok * 1024;
                const float* md = WSP_mod + (tok >> 11) * 6144;
                float4 v[4];
                float ss = 0.f;
#pragma unroll
                for (int i = 0; i < 4; ++i) {
                    v[i] = *(const float4*)(src + i * 256 + lane * 4);
                    ss += v[i].x * v[i].x + v[i].y * v[i].y + v[i].z * v[i].z + v[i].w * v[i].w;
                }
                ss = wave_sum(ss);
                const float rs = rsqrtf(ss * (1.f / 1024.f) + EPS);
#pragma unroll
                for (int i = 0; i < 4; ++i) {
                    const int c0 = i * 256 + lane * 4;
                    const float4 g = *(const float4*)(p.norm_ffn + c0), s = *(const float4*)(md + 3072 + c0), k = *(const float4*)(md + 4096 + c0);
                    const float a = v[i].x * rs * g.x * (1.f + k.x) + s.x, b = v[i].y * rs * g.y * (1.f + k.y) + s.y;
                    const float c = v[i].z * rs * g.z * (1.f + k.z) + s.z, d = v[i].w * rs * g.w * (1.f + k.w) + s.w;
                    const uint2 pk = make_uint2(pack2(a, b), pack2(c, d));
                    *(uint2*)(WSP_H2 + (size_t)tok * 1024 + c0) = pk;
                    const int ch = c0 >> 3;
                    *(uint2*)(At + row * 2048 + ((ch ^ row) << 4) + ((c0 & 4) << 1)) = pk;
                }
            }
            __syncthreads();
            f32x4 acc = {0.f, 0.f, 0.f, 0.f};
            const u16* bp = WSP_WrT + (size_t)(wid * 16 + fr) * 1024 + fq * 8;
#pragma unroll
            for (int kb = 0; kb < 4; ++kb) {
                bf16x8 bfr[8];
#pragma unroll
                for (int q = 0; q < 8; ++q) bfr[q] = *(const bf16x8*)(bp + (kb * 8 + q) * 32);
#pragma unroll
                for (int q = 0; q < 8; ++q) {
                    const int ch = (kb * 8 + q) * 4 + fq;
                    const bf16x8 a = *(const bf16x8*)(At + fr * 2048 + ((ch ^ fr) << 4));
                    acc = __builtin_amdgcn_mfma_f32_16x16x32_bf16(a, bfr[q], acc, 0, 0, 0);
                }
            }
#pragma unroll
            for (int j = 0; j < 4; ++j) sc[(fq * 4 + j) * 64 + wid * 16 + fr] = sigmoidf_(acc[j]);
            __syncthreads();
            const float bias = p.router_bias[lane];
            const int eg = lane >> 3;
            for (int rr = 0; rr < 4; ++rr) {
                const int row = wid * 4 + rr, tok = tok0 + row;
                const float s = sc[row * 64 + lane];
                const float bz = s + bias;
                float m1 = bz;
                m1 = fmaxf(m1, __shfl_xor(m1, 1)); m1 = fmaxf(m1, __shfl_xor(m1, 2)); m1 = fmaxf(m1, __shfl_xor(m1, 4));
                const unsigned long long eq = __ballot(bz == m1);
                const unsigned gb = (unsigned)((eq >> (eg * 8)) & 0xffull);
                const int first = __ffs(gb) - 1;
                float v2 = ((lane & 7) == first) ? -1e30f : bz;
                v2 = fmaxf(v2, __shfl_xor(v2, 1)); v2 = fmaxf(v2, __shfl_xor(v2, 2)); v2 = fmaxf(v2, __shfl_xor(v2, 4));
                const float gs = m1 + v2;
                int cnt = 0;
#pragma unroll
                for (int j = 0; j < 8; ++j) {
                    const float gj = __int_as_float(__builtin_amdgcn_readlane(__float_as_int(gs), j * 8));
                    cnt += (gj > gs || (gj == gs && j < eg)) ? 1 : 0;
                }
                const bool gsel = cnt < 4;
                const float mv = gsel ? bz : -1e30f;
                int rank = 0;
#pragma unroll
                for (int j = 0; j < 64; ++j) {
                    const float vj = __int_as_float(__builtin_amdgcn_readlane(__float_as_int(mv), j));
                    rank += (vj > mv || (vj == mv && j < lane)) ? 1 : 0;
                }
                const bool sel = gsel && rank < 8;
                const float tot = wave_sum(sel ? s : 0.f);
                if (sel) {
                    WSP_WGT[(size_t)tok * 8 + rank] = s / tot * 2.5f;
                    selk[(grp * 16 + row) * 8 + rank] = (unsigned char)lane;
                    atomicAdd(&hist[lane], 1);
                }
            }
        }
        __syncthreads();
        const int h = (chunk * 32) >> 13;
        if (tid < 64) {
            gbase[tid] = hist[tid] ? (int)atomicAdd(&WSP_ctr[CTR_ECNT + h * 64 + tid], (unsigned)hist[tid]) : 0;
            fill[tid] = 0;
        }
        __syncthreads();
        {
            const int e = selk[tid];
            const int pos = atomicAdd(&fill[e], 1);
            WSP_elist[(size_t)(h * 64 + e) * ELIST_CAP + gbase[e] + pos] = (chunk * 32 + (tid >> 3)) * 8 + (tid & 7);
        }
    }
}

struct MoeTab { int cnt[16]; int soff[16]; int pre[17]; };

__device__ __forceinline__ void phase11(const Params& p) {
    const int tid = TIDX, lane = tid & 63, wid = tid >> 6, wr = wid >> 1, wc = wid & 1, fr = lane & 15, fq = lane >> 4;
    const int sb = lane * 16, swz = sb ^ (((sb >> 9) & 1) << 5);
    const int r_in = swz >> 6, c_in = (swz & 63) >> 1;
    int* tab = (int*)(smem + 73728);
    int* t_cnt = tab, *t_soff = tab + 16, *t_pre = tab + 32, *t_q = tab + 52;
    const int x = blockIdx.x & 7;
    __syncthreads();
    int* t_all = tab + 64;
    if (tid < 128) t_all[tid] = (int)WSP_ctr[CTR_ECNT + tid];
    if (tid == 0) t_q[0] = (int)atomicAdd(&WSP_ctr[CTR_Q11 + x], 1u);
    __syncthreads();
    if (tid < 16) {
        const int i = tid >> 1, h = tid & 1, e = x + 8 * i;
        t_cnt[tid] = t_all[h * 64 + e];
        int so = 0;
        for (int e2 = 0; e2 < e; ++e2) so += t_all[h * 64 + e2];
        t_soff[tid] = so;
    }
    __syncthreads();
    if (tid == 0) {
        int s = 0;
        for (int j = 0; j < 16; ++j) { t_pre[j] = s; s += (t_cnt[j] + 127) >> 7; }
        t_pre[16] = s;
    }
    __syncthreads();
    const int T_r = t_pre[16], T_all = T_r + 16;
    for (;;) {
        __syncthreads();
        const int u = __builtin_amdgcn_readfirstlane(t_q[0]);
        __syncthreads();
        if (u >= T_all) break;
        if (tid == 0) t_q[0] = (int)atomicAdd(&WSP_ctr[CTR_Q11 + x], 1u);
        int e, h, mt, c, rowbase;
        const int* el = nullptr;
        if (u < T_r) {
            int j = 0;
#pragma unroll
            for (int q = 1; q < 16; ++q) j += (u >= t_pre[q]) ? 1 : 0;
            e = x + 8 * (j >> 1); h = j & 1; mt = u - t_pre[j]; c = t_cnt[j];
            rowbase = h * HH_HALF_ROWS + t_soff[j];
            el = WSP_elist + (size_t)(h * 64 + e) * ELIST_CAP;
        } else {
            const int ms = x * 16 + (u - T_r);
            e = 64; h = ms >> 6; mt = ms & 63; c = HALF_TOK;
            rowbase = h * HH_HALF_ROWS + 65536;
        }
        e = __builtin_amdgcn_readfirstlane(e); h = __builtin_amdgcn_readfirstlane(h); mt = __builtin_amdgcn_readfirstlane(mt);
        c = __builtin_amdgcn_readfirstlane(c); rowbase = __builtin_amdgcn_readfirstlane(rowbase);
        if (e < 64) el = WSP_elist + (size_t)(h * 64 + e) * ELIST_CAP;
        const u16* aptr[2];
#pragma unroll
        for (int i = 0; i < 2; ++i) {
            int li = mt * 128 + (wid + 4 * i) * 16 + r_in;
            li = li < c ? li : c - 1;
            const int tok = (e < 64) ? (el[li] >> 3) : (h * HALF_TOK + li);
            aptr[i] = WSP_H2 + (size_t)tok * 1024 + c_in;
        }
        const u16* Bw = WSP_WguT + (size_t)e * 262144 + c_in;
        f32x4 acc[4][8];
        gemm_tile_w(32,
            [&](int i, int R, int C, int kt) { return (const void*)(aptr[i] + kt * 32); },
            [&](int i, int R, int C, int kt) { return (const void*)(Bw + (size_t)R * 1024 + kt * 32); }, acc);
        float wgt[4][4];
#pragma unroll
        for (int m = 0; m < 4; ++m)
#pragma unroll
            for (int j = 0; j < 4; ++j) {
                const int li = mt * 128 + wr * 64 + m * 16 + fq * 4 + j;
                float w = 1.f;
                if (e < 64) w = (li < c) ? WSP_WGT[el[li]] : 0.f;
                wgt[m][j] = w;
            }
        u16* dbase = WSP_HHs + ((size_t)rowbase + mt * 128 + wr * 64) * 128 + wc * 64;
        const int vrows = c - mt * 128 - wr * 64;
        wave_store_bf16_f([&](int m, int n2, int j) { return siluf_(acc[m][2 * n2][j]) * acc[m][2 * n2 + 1][j] * wgt[m][j]; },
                          [&](int row) { return row < vrows ? dbase + (size_t)row * 128 : (u16*)nullptr; });
    }
}

__device__ __forceinline__ void phase12a(const Params& p, int h) {
    const int tid = TIDX, lane = tid & 63, wid = tid >> 6, wr = wid >> 1, wc = wid & 1, fr = lane & 15, fq = lane >> 4;
    const int sb = lane * 16, swz = sb ^ (((sb >> 9) & 1) << 5);
    const int r_in = swz >> 6, c_in = (swz & 63) >> 1;
    int* tab = (int*)(smem + 73728);
    int* t_cnt = tab, *t_soff = tab + 16, *t_pre = tab + 32, *t_q = tab + 52;
    const int x = blockIdx.x & 7;
    __syncthreads();
    int* t_all = tab + 64;
    if (tid < 64) t_all[tid] = (int)WSP_ctr[CTR_ECNT + h * 64 + tid];
    if (tid == 0) t_q[0] = (int)atomicAdd(&WSP_ctr[CTR_Q12 + h * 8 + x], 1u);
    __syncthreads();
    if (tid < 8) {
        const int e = x + 8 * tid;
        t_cnt[tid] = t_all[e];
        int so = 0;
        for (int e2 = 0; e2 < e; ++e2) so += t_all[e2];
        t_soff[tid] = so;
    }
    __syncthreads();
    if (tid == 0) {
        int s = 0;
        for (int j = 0; j < 8; ++j) { t_pre[j] = s; s += (t_cnt[j] + 127) >> 7; }
        t_pre[8] = s;
    }
    __syncthreads();
    const int T_r = t_pre[8] * 4, T_all = T_r + 32;
    for (;;) {
        __syncthreads();
        const int u = __builtin_amdgcn_readfirstlane(t_q[0]);
        __syncthreads();
        if (u >= T_all) break;
        if (tid == 0) t_q[0] = (int)atomicAdd(&WSP_ctr[CTR_Q12 + h * 8 + x], 1u);
        int e, mt, nt, c, rowbase;
        const int* el = nullptr;
        if (u < T_r) {
            const int um = u >> 2; nt = u & 3;
            int j = 0;
#pragma unroll
            for (int q = 1; q < 8; ++q) j += (um >= t_pre[q]) ? 1 : 0;
            e = x + 8 * j; mt = um - t_pre[j]; c = t_cnt[j];
            rowbase = h * HH_HALF_ROWS + t_soff[j];
            el = WSP_elist + (size_t)(h * 64 + e) * ELIST_CAP;
        } else {
            const int us = u - T_r; nt = us & 3;
            const int ms = x * 8 + (us >> 2);
            e = 64; mt = ms; c = HALF_TOK; rowbase = h * HH_HALF_ROWS + 65536;
        }
        e = __builtin_amdgcn_readfirstlane(e); mt = __builtin_amdgcn_readfirstlane(mt); nt = __builtin_amdgcn_readfirstlane(nt);
        c = __builtin_amdgcn_readfirstlane(c); rowbase = __builtin_amdgcn_readfirstlane(rowbase);
        if (e < 64) el = WSP_elist + (size_t)(h * 64 + e) * ELIST_CAP;
        const u16* aptr[2];
#pragma unroll
        for (int i = 0; i < 2; ++i) {
            int li = mt * 128 + (wid + 4 * i) * 16 + r_in;
            li = li < c ? li : c - 1;
            aptr[i] = WSP_HHs + ((size_t)rowbase + li) * 128 + c_in;
        }
        const u16* Bw = WSP_WdT + ((size_t)e * 1024 + nt * 256) * 128 + c_in;
        f32x4 acc[4][8];
        gemm_tile_w(4,
            [&](int i, int R, int C, int kt) { return (const void*)(aptr[i] + kt * 32); },
            [&](int i, int R, int C, int kt) { return (const void*)(Bw + (size_t)R * 128 + kt * 32); }, acc);
        const int vrows = c - mt * 128 - wr * 64;
#pragma unroll
        for (int hn = 0; hn < 2; ++hn) {
            const int colo = nt * 256 + wc * 128 + hn * 64;
            wave_store_bf16_f([&](int m, int n, int j) { return acc[m][hn * 4 + n][j]; }, [&](int row) {
                if (row >= vrows) return (u16*)nullptr;
                const int li = mt * 128 + wr * 64 + row;
                int tl, k;
                if (e < 64) { const int ent = el[li]; tl = (ent >> 3) - h * HALF_TOK; k = ent & 7; }
                else { tl = li; k = 8; }
                return WSP_Yd + ((size_t)tl * 9 + k) * 1024 + colo;
            });
        }
    }
}

template <bool DUMMY>
__device__ __forceinline__ void phase12b_t(const Params& p, int h) {
    const int lane = TIDX & 63;
    const int bb = (blockIdx.x + h) % gridDim.x;
    const int wv = bb * 4 + (TIDX >> 6), nwv = gridDim.x * 4;
    for (int tl = wv; tl < HALF_TOK; tl += nwv) {
        const int tok = h * HALF_TOK + tl;
        float* row = p.out + (size_t)tok * 1024 + lane * 16;
        float* orow = DUMMY ? (float*)(p.ws + OFF_R4) + (size_t)tl * 1024 + lane * 16 : row;
        const float* g2 = WSP_mod + (tok >> 11) * 6144 + 5120 + lane * 16;
        float s[16];
#pragma unroll
        for (int i = 0; i < 16; ++i) s[i] = 0.f;
        const u16* yp = WSP_Yd + (size_t)tl * 9 * 1024 + lane * 16;
#pragma unroll
        for (int k = 0; k < 9; ++k) {
            const uint4 a = *(const uint4*)(yp + k * 1024), b = *(const uint4*)(yp + k * 1024 + 8);
            const unsigned w[8] = {a.x, a.y, a.z, a.w, b.x, b.y, b.z, b.w};
#pragma unroll
            for (int i = 0; i < 8; ++i) { s[2 * i] += bf2f((u16)(w[i] & 0xffffu)); s[2 * i + 1] += bf2f((u16)(w[i] >> 16)); }
        }
        float ss = 0.f;
#pragma unroll
        for (int q = 0; q < 4; ++q) {
            const float4 xv = *(const float4*)(row + q * 4), gv = *(const float4*)(g2 + q * 4);
            s[4 * q] = xv.x + gv.x * s[4 * q]; s[4 * q + 1] = xv.y + gv.y * s[4 * q + 1];
            s[4 * q + 2] = xv.z + gv.z * s[4 * q + 2]; s[4 * q + 3] = xv.w + gv.w * s[4 * q + 3];
            ss += s[4 * q] * s[4 * q] + s[4 * q + 1] * s[4 * q + 1] + s[4 * q + 2] * s[4 * q + 2] + s[4 * q + 3] * s[4 * q + 3];
        }
        ss = wave_sum(ss);
        const float rs = rsqrtf(ss * (1.f / 1024.f) + EPS);
#pragma unroll
        for (int q = 0; q < 4; ++q) {
            const float4 g = *(const float4*)(p.norm_final + lane * 16 + q * 4);
            *(float4*)(orow + q * 4) = make_float4(s[4 * q] * rs * g.x, s[4 * q + 1] * rs * g.y, s[4 * q + 2] * rs * g.z, s[4 * q + 3] * rs * g.w);
        }
    }
}

#define SMEM_TOTAL (73728 + 1024 + 64)

#if 1
__global__ void __launch_bounds__(NTHR, 2) k_mega(Params p) {
    volatile LAS unsigned* st = (volatile LAS unsigned*)(smem + SMEM_TOTAL - 16);
    if (TIDX == 0) { st[0] = 0u; st[1] = 0u; st[2] = 0u; st[3] = 0u; }
    __syncthreads();
    XcdBarrier bar = xcd_barrier_post(WSP_bar, st);
#define RUNP(N) do { phase##N(p); if (PROBE_DUP == N) phase##N(p); } while (0)
    RUNP(0);  xcd_barrier(bar);
    RUNP(1);  xcd_barrier(bar);
    RUNP(2);  xcd_barrier(bar);
    RUNP(3);  xcd_barrier(bar);
    RUNP(4);  xcd_barrier(bar);
    RUNP(5);  xcd_barrier(bar);
    RUNP(6);  xcd_barrier(bar);
    RUNP(7);  xcd_barrier(bar);
    RUNP(8);  xcd_barrier(bar);
    phase9(p); xcd_barrier(bar);
#if PROBE_DUP == 9
    if (blockIdx.x == 0 && TIDX < 128) WSP_ctr[CTR_ECNT + TIDX] = 0u;
    xcd_barrier(bar); phase9(p); xcd_barrier(bar);
#endif
    phase11(p); xcd_barrier(bar);
#if PROBE_DUP == 11
    if (blockIdx.x == 0 && TIDX < 8) WSP_ctr[CTR_Q11 + TIDX] = 0u;
    xcd_barrier(bar); phase11(p); xcd_barrier(bar);
#endif
    phase12a(p, 0); xcd_barrier(bar);
#if PROBE_DUP == 120
    if (blockIdx.x == 0 && TIDX < 8) WSP_ctr[CTR_Q12 + TIDX] = 0u;
    xcd_barrier(bar); phase12a(p, 0); xcd_barrier(bar);
#endif
#if PROBE_DUP == 121
    phase12b_t<true>(p, 0); xcd_barrier(bar);
#endif
    phase12b_t<false>(p, 0); xcd_barrier(bar);
    phase12a(p, 1); xcd_barrier(bar);
    phase12b_t<false>(p, 1);
}
#endif


extern "C" void kernel_launch(void* const* d_in, const int* in_sizes, int n_in,
                              void* d_out, int out_size, void* d_ws, size_t ws_size,
                              hipStream_t stream) {
    Params p{};
    const float** ip = (const float**)&p.x;
    for (int i = 0; i < 32; ++i) ip[i] = (const float*)d_in[i];
    p.out = (float*)d_out;
    p.ws = (char*)d_ws;
    if (OFF_END > ws_size) { fprintf(stderr, "workspace too small: need %zu have %zu\n", (size_t)OFF_END, ws_size); return; }

    static int grid = 0;
    if (!grid) {
        hipFuncSetAttribute((const void*)k_mega, hipFuncAttributeMaxDynamicSharedMemorySize, SMEM_TOTAL);
        int dev = 0, cus = 0, per_cu = 0;
        hipGetDevice(&dev);
        hipDeviceGetAttribute(&cus, hipDeviceAttributeMultiprocessorCount, dev);
        hipOccupancyMaxActiveBlocksPerMultiprocessor(&per_cu, (const void*)k_mega, NTHR, SMEM_TOTAL);
        if (per_cu < 1) per_cu = 1;
        grid = cus * (per_cu < 2 ? per_cu : 2);
    }
    hipMemsetAsync(p.ws + OFF_BAR, 0, XCD_BAR_WORDS * 4 + 1024, stream);
    k_mega<<<grid, NTHR, SMEM_TOTAL, stream>>>(p);
}
```

```cpp
#include <hip/hip_runtime.h>
#include <hip/hip_bf16.h>
#include <stdint.h>
#include <stdio.h>

#ifndef MK_MULTI
#define MK_MULTI 0
#endif

typedef __attribute__((ext_vector_type(8))) short bf16x8;
typedef __attribute__((ext_vector_type(4))) short bf16x4;
typedef __attribute__((ext_vector_type(4))) float f32x4;
typedef unsigned short u16;
typedef __attribute__((ext_vector_type(4))) unsigned u32x4;

#ifndef PROBE_DUP
#define PROBE_DUP -1
#endif
#define NTHR 256
__device__ __forceinline__ int opaque_tid() { int t = (int)threadIdx.x; asm volatile("" : "+v"(t)); return t; }
#define TIDX opaque_tid()
#define LDS_BYTES 65536

#define D_MODEL 1024
#define BATCH 8
#define SEQ 2048
#define CTXL 256
#define NLAT (BATCH * SEQ)
#define NCTX (BATCH * CTXL)
#define NROWS (NLAT + NCTX)
#define INW 1280
#define NEXP 64
#define VT_LD (SEQ + CTXL)
#define NCHUNK_LAT 1024
#define NCHUNK_ALL 1152
#define EPS 1e-6f

#define XB_TMO      128
#define XB_XCNT(j)  (256  + 64 * (j))
#define XB_XSUB(j)  (1280 + 64 * (j))
#define XB_XGEN(j)  (2304 + 64 * (j))
#define XB_TOP      3328
#define XB_TOPGEN   3392
#define XCD_BAR_WORDS 3456
#define XB_SPIN_CAP (1u << 20)
#define LAS __attribute__((address_space(3)))

__device__ __forceinline__ unsigned xb_ld(unsigned* p)              { return __hip_atomic_load(p, __ATOMIC_RELAXED, __HIP_MEMORY_SCOPE_AGENT); }
__device__ __forceinline__ unsigned xb_add(unsigned* p, unsigned v) { return __hip_atomic_fetch_add(p, v, __ATOMIC_RELAXED, __HIP_MEMORY_SCOPE_AGENT); }
__device__ __forceinline__ unsigned xb_xcc_id() { return (unsigned)__builtin_amdgcn_s_getreg((3 << 11) | 20) & 0xFu; }
#define XB_SPIN(cond, bar) do { unsigned _sp = 0; while (cond) { __builtin_amdgcn_s_sleep(1); \
    if ((++_sp & 255u) == 0u) { if (xb_ld(&(bar)[XB_TMO])) break; if (_sp > XB_SPIN_CAP) { atomicAdd(&(bar)[XB_TMO], 1u); break; } } } } while (0)

struct XcdBarrier { unsigned* bar; unsigned x; volatile LAS unsigned* st; };

__device__ __forceinline__ XcdBarrier xcd_barrier_post(unsigned* bar, volatile LAS unsigned* st) {
    XcdBarrier b; b.bar = bar; b.x = xb_xcc_id(); b.st = st;
    if (TIDX == 0) (void)xb_add(&bar[XB_XCNT(b.x)], 1u);
    return b;
}
__device__ __forceinline__ void xcd_barrier_complete(unsigned* bar, unsigned x, unsigned& nloc, unsigned& nx) {
    const unsigned G = gridDim.x * gridDim.y * gridDim.z;
    unsigned sum, cnt, mine, sp = 0u;
    for (;;) {
        sum = 0u; cnt = 0u; mine = 0u;
#pragma unroll
        for (unsigned j = 0; j < 16; ++j) { const unsigned c = xb_ld(&bar[XB_XCNT(j)]); sum += c; cnt += (c > 0u) ? 1u : 0u; mine = (j == x) ? c : mine; }
        if (sum == G) break;
        __builtin_amdgcn_s_sleep(1);
        if ((++sp & 255u) == 0u) { if (xb_ld(&bar[XB_TMO])) break; if (sp > XB_SPIN_CAP) { atomicAdd(&bar[XB_TMO], 1u); break; } }
    }
    nloc = mine > 0u ? mine : 1u; nx = cnt > 0u ? cnt : 1u;
}
__device__ __forceinline__ void xcd_barrier(const XcdBarrier& b) {
    asm volatile("s_waitcnt vmcnt(0)" ::: "memory");
    __syncthreads();
    if (TIDX == 0) {
        unsigned* bar = b.bar;
        __builtin_amdgcn_s_waitcnt(0);
        unsigned nloc = b.st[0], nx = b.st[1];
        if (nloc == 0u) { xcd_barrier_complete(bar, b.x, nloc, nx); b.st[0] = nloc; b.st[1] = nx; }
        const unsigned old = xb_add(&bar[XB_XSUB(b.x)], 1u);
        const unsigned gen = old / nloc;
        if (old + 1u == (gen + 1u) * nloc) {
            __builtin_amdgcn_fence(__ATOMIC_RELEASE, "agent");
            asm volatile("s_waitcnt vmcnt(0)" ::: "memory");
            const unsigned og = xb_add(&bar[XB_TOP], 1u);
            const unsigned tg = og / nx;
            if (og + 1u == (tg + 1u) * nx) xb_add(&bar[XB_TOPGEN], 1u);
            else XB_SPIN(xb_ld(&bar[XB_TOPGEN]) == tg, bar);
            __builtin_amdgcn_fence(__ATOMIC_ACQUIRE, "agent");
            xb_add(&bar[XB_XGEN(b.x)], 1u);
            asm volatile("s_waitcnt vmcnt(0)" ::: "memory");
        } else {
            XB_SPIN(xb_ld(&bar[XB_XGEN(b.x)]) == gen, bar);
            __builtin_amdgcn_fence(__ATOMIC_ACQUIRE, "agent");
            asm volatile("s_waitcnt vmcnt(0)" ::: "memory");
        }
    }
    __syncthreads();
}

struct Params {
    const float *x, *c, *ctx, *c_ctx, *w_ada, *b_ada, *norm_mix, *norm_ffn, *w_in, *attn_sink,
        *a_re, *a_im, *log_dt, *b_re, *b_im, *c_re, *c_im, *ssm_d, *w_glu, *b_glu, *norm_attn_out, *norm_ssm_out,
        *w_out, *w_router, *router_bias, *w_gate_e, *w_up_e, *w_down_e, *w_gate_s, *w_up_s, *w_down_s, *norm_final;
    float* out;
    char* ws;
};

constexpr size_t A256(size_t v) { return (v + 255) & ~(size_t)255; }
constexpr size_t OFF_BAR   = 0;
constexpr size_t OFF_MOD   = A256(OFF_BAR + XCD_BAR_WORDS * 4 + 1024);
constexpr size_t OFF_ROPE  = A256(OFF_MOD + 9 * 6144 * 4);
constexpr size_t OFF_KBUF  = A256(OFF_ROPE + 64 * 16 * 8);
constexpr size_t OFF_IDX   = A256(OFF_KBUF + (size_t)32 * 2 * 4096 * 4);
constexpr size_t OFF_WGT   = A256(OFF_IDX + (size_t)NLAT * 8);
constexpr size_t OFF_ELIST = A256(OFF_WGT + (size_t)NLAT * 8 * 4);
constexpr size_t OFF_WINT  = A256(OFF_ELIST + (size_t)2 * 64 * 8192 * 4);
constexpr size_t OFF_WGLUT = A256(OFF_WINT + (size_t)1280 * 1024 * 2);
constexpr size_t OFF_WOUTT = A256(OFF_WGLUT + (size_t)512 * 512 * 2);
constexpr size_t OFF_WRT   = A256(OFF_WOUTT + (size_t)1024 * 1024 * 2);
constexpr size_t OFF_WDT   = A256(OFF_WRT + (size_t)128 * 1024 * 2);
constexpr size_t OFF_HHS   = A256(OFF_WDT + (size_t)65 * 1024 * 128 * 2);
constexpr size_t OFF_ARENA = A256(OFF_HHS + (size_t)2 * 73728 * 128 * 2);
constexpr size_t OFF_WGUT  = OFF_ARENA;
constexpr size_t OFF_TABS  = A256(OFF_WGUT + (size_t)65 * 256 * 1024 * 2);
constexpr size_t OFF_TABY  = A256(OFF_TABS + (size_t)32 * 256 * 256 * 2);
constexpr size_t OFF_R1    = A256(OFF_TABY + (size_t)32 * 256 * 512 * 2);
constexpr size_t OFF_R2    = A256(OFF_R1 + (size_t)NROWS * 1024 * 2);
constexpr size_t OFF_R3    = A256(OFF_R2 + (size_t)NLAT * 1024 * 2);
constexpr size_t OFF_R4    = A256(OFF_R3 + (size_t)NLAT * 1024 * 2);
constexpr size_t OFF_END   = A256(OFF_R4 + (size_t)NLAT * 512 * 2 * 2);
static_assert(OFF_END - OFF_ARENA >= (size_t)8192 * 9 * 1024 * 2, "arena must hold Yd");
#define WSP_bar   ((unsigned*)(p.ws + OFF_BAR))
#define WSP_ctr   ((unsigned*)(p.ws + OFF_BAR) + XCD_BAR_WORDS)
#define WSP_mod   ((float*)(p.ws + OFF_MOD))
#define WSP_rope  ((float2*)(p.ws + OFF_ROPE))
#define WSP_Kbuf  ((float*)(p.ws + OFF_KBUF))
#define WSP_WGT   ((float*)(p.ws + OFF_WGT))
#define WSP_elist ((int*)(p.ws + OFF_ELIST))
#define WSP_WinT  ((u16*)(p.ws + OFF_WINT))
#define WSP_WgluT ((u16*)(p.ws + OFF_WGLUT))
#define WSP_WoutT ((u16*)(p.ws + OFF_WOUTT))
#define WSP_WrT   ((u16*)(p.ws + OFF_WRT))
#define WSP_WdT   ((u16*)(p.ws + OFF_WDT))
#define WSP_HHs   ((u16*)(p.ws + OFF_HHS))
#define WSP_Yd    ((u16*)(p.ws + OFF_ARENA))
#define WSP_WguT  ((u16*)(p.ws + OFF_WGUT))
#define WSP_TabS  ((u16*)(p.ws + OFF_TABS))
#define WSP_TabY  ((u16*)(p.ws + OFF_TABY))
#define WSP_Hb    ((u16*)(p.ws + OFF_R1))
#define WSP_S     ((float*)(p.ws + OFF_R1))
#define WSP_H2    ((u16*)(p.ws + OFF_R1))
#define WSP_Q     ((u16*)(p.ws + OFF_R2))
#define WSP_Kb    ((u16*)(p.ws + OFF_R2 + (size_t)NLAT * 512 * 2))
#define WSP_Vt    ((u16*)(p.ws + OFF_R2 + (size_t)NLAT * 512 * 2 + (size_t)NROWS * 128 * 2))
#define WSP_Y     ((u16*)(p.ws + OFF_R2))
#define WSP_SO    ((u16*)(p.ws + OFF_R2 + (size_t)NLAT * 512 * 2))
#define WSP_U     ((u16*)(p.ws + OFF_R3))
#define WSP_CAT   ((u16*)(p.ws + OFF_R3))
#define WSP_AO    ((u16*)(p.ws + OFF_R4))
#define WSP_Hin   ((u16*)(p.ws + OFF_R4 + (size_t)NLAT * 512 * 2))

extern __shared__ __attribute__((aligned(16))) char smem[];

__device__ __forceinline__ u16 f2bf(float f) {
    unsigned u = __float_as_uint(f);
    u += 0x7fffu + ((u >> 16) & 1u);
    return (u16)(u >> 16);
}
__device__ __forceinline__ float bf2f(u16 h) { return __uint_as_float(((unsigned)h) << 16); }
__device__ __forceinline__ unsigned pack2(float a, float b) { return (unsigned)f2bf(a) | ((unsigned)f2bf(b) << 16); }
__device__ __forceinline__ void glds16(const void* g, void* l) {
    __builtin_amdgcn_global_load_lds((const unsigned*)g, (unsigned*)l, 16, 0, 0);
}
__device__ __forceinline__ int lds_byte(int r, int c) {
    int st = (r >> 4) * 2 + (c >> 5), rr = r & 15, cc = c & 31, ob = rr * 64 + cc * 2;
    return st * 1024 + (ob ^ (((ob >> 9) & 1) << 5));
}
__device__ __forceinline__ float wave_sum(float v) {
#pragma unroll
    for (int o = 32; o > 0; o >>= 1) v += __shfl_xor(v, o);
    return v;
}
__device__ __forceinline__ float sigmoidf_(float x) { return 1.f / (1.f + __expf(-x)); }
__device__ __forceinline__ float siluf_(float x) { return x / (1.f + __expf(-x)); }
__device__ __forceinline__ float gelu_tanh(float x) {
    float u = 0.7978845608028654f * (x + 0.044715f * x * x * x);
    return x / (1.f + __expf(-2.f * u));
}

template <class FA, class FB>
__device__ __forceinline__ void gemm_tile(int nkt, FA fa, FB fb, f32x4 (&acc)[4][4]) {
    const int tid = TIDX, lane = tid & 63, wid = tid >> 6, wr = wid >> 1, wc = wid & 1, fr = lane & 15, fq = lane >> 4;
    const int sb = lane * 16, swz = sb ^ (((sb >> 9) & 1) << 5);
    const int r_in = swz >> 6, c_in = (swz & 63) >> 1;
#pragma unroll
    for (int m = 0; m < 4; ++m)
#pragma unroll
        for (int n = 0; n < 4; ++n) acc[m][n] = (f32x4){0.f, 0.f, 0.f, 0.f};
    __syncthreads();
    auto stage = [&](int kt, int s) {
        char* sa = smem + s * 32768;
        char* sbm = sa + 16384;
#pragma unroll
        for (int i = 0; i < 4; ++i) {
            const int st = wid + 4 * i, R = (st >> 1) * 16 + r_in, C = (st & 1) * 32 + c_in;
            glds16(fa(R, C, kt), sa + tid * 16 + i * 4096);
            glds16(fb(R, C, kt), sbm + tid * 16 + i * 4096);
        }
    };
    stage(0, 0);
    for (int kt = 0; kt < nkt; ++kt) {
        asm volatile("s_waitcnt vmcnt(0)" ::: "memory");
        __syncthreads();
        if (kt + 1 < nkt) stage(kt + 1, (kt + 1) & 1);
        const char* sa = smem + (kt & 1) * 32768;
        const char* sbm = sa + 16384;
#pragma unroll
        for (int ks = 0; ks < 2; ++ks) {
            bf16x8 a[4], b[4];
#pragma unroll
            for (int m = 0; m < 4; ++m) a[m] = *(const bf16x8*)(sa + lds_byte(wr * 64 + m * 16 + fr, ks * 32 + fq * 8));
#pragma unroll
            for (int n = 0; n < 4; ++n) b[n] = *(const bf16x8*)(sbm + lds_byte(wc * 64 + n * 16 + fr, ks * 32 + fq * 8));
#pragma unroll
            for (int m = 0; m < 4; ++m)
#pragma unroll
                for (int n = 0; n < 4; ++n) acc[m][n] = __builtin_amdgcn_mfma_f32_16x16x32_bf16(a[m], b[n], acc[m][n], 0, 0, 0);
        }
    }
    __syncthreads();
}

__device__ __forceinline__ int lds32(int r, int c) {
    const int rr = r & 15;
    return (r >> 4) * 1024 + ((rr * 64 + c * 2) ^ (((rr >> 3) & 1) << 5));
}
template <class FA, class FB>
__device__ __forceinline__ void gemm_tile_w(int nkt, FA fa, FB fb, f32x4 (&acc)[4][8]) {
    const int tid = TIDX, lane = tid & 63, wid = tid >> 6, wr = wid >> 1, wc = wid & 1, fr = lane & 15, fq = lane >> 4;
    const int sb = lane * 16, swz = sb ^ (((sb >> 9) & 1) << 5);
    const int r_in = swz >> 6, c_in = (swz & 63) >> 1;
#pragma unroll
    for (int m = 0; m < 4; ++m)
#pragma unroll
        for (int n = 0; n < 8; ++n) acc[m][n] = (f32x4){0.f, 0.f, 0.f, 0.f};
    __syncthreads();
    auto stage = [&](int kt, int s) {
        char* sa = smem + s * 24576;
#pragma unroll
        for (int i = 0; i < 2; ++i) glds16(fa(i, (wid + 4 * i) * 16 + r_in, c_in, kt), sa + tid * 16 + i * 4096);
#pragma unroll
        for (int i = 0; i < 4; ++i) glds16(fb(i, (wid + 4 * i) * 16 + r_in, c_in, kt), sa + 8192 + tid * 16 + i * 4096);
    };
    stage(0, 0);
    if (nkt > 1) stage(1, 1);
    int s_cur = 0, s_nxt = 2;
    for (int kt = 0; kt < nkt; ++kt) {
        if (kt + 1 < nkt) asm volatile("s_waitcnt vmcnt(6) lgkmcnt(0)\n\ts_barrier" ::: "memory");
        else asm volatile("s_waitcnt vmcnt(0) lgkmcnt(0)\n\ts_barrier" ::: "memory");
        if (kt + 2 < nkt) stage(kt + 2, s_nxt);
        const char* sa = smem + s_cur * 24576;
        bf16x8 a[4];
#pragma unroll
        for (int m = 0; m < 4; ++m) a[m] = *(const bf16x8*)(sa + lds32(wr * 64 + m * 16 + fr, fq * 8));
#pragma unroll
        for (int nh = 0; nh < 2; ++nh) {
            bf16x8 b[4];
#pragma unroll
            for (int n = 0; n < 4; ++n) b[n] = *(const bf16x8*)(sa + 8192 + lds32(wc * 128 + (nh * 4 + n) * 16 + fr, fq * 8));
#pragma unroll
            for (int m = 0; m < 4; ++m)
#pragma unroll
                for (int n = 0; n < 4; ++n) acc[m][nh * 4 + n] = __builtin_amdgcn_mfma_f32_16x16x32_bf16(a[m], b[n], acc[m][nh * 4 + n], 0, 0, 0);
        }
        s_cur = (s_cur == 2) ? 0 : s_cur + 1;
        s_nxt = (s_nxt == 2) ? 0 : s_nxt + 1;
    }
    __syncthreads();
}

template <class FV, class FD>
__device__ __forceinline__ void wave_store_bf16_f(FV val, FD dst) {
    const int lane = TIDX & 63, wid = TIDX >> 6, fr = lane & 15, fq = lane >> 4;
    char* base = smem + wid * 9216;
#pragma unroll
    for (int m = 0; m < 4; ++m)
#pragma unroll
        for (int n = 0; n < 4; ++n)
#pragma unroll
            for (int j = 0; j < 4; ++j)
                *(u16*)(base + (m * 16 + fq * 4 + j) * 144 + (n * 16 + fr) * 2) = f2bf(val(m, n, j));
    asm volatile("s_waitcnt lgkmcnt(0)" ::: "memory");
    __builtin_amdgcn_wave_barrier();
#pragma unroll
    for (int i = 0; i < 8; ++i) {
        const int id = i * 64 + lane, row = id >> 3, ch = id & 7;
        const uint4 d = *(const uint4*)(base + row * 144 + ch * 16);
        u16* p = dst(row);
        if (p) *(uint4*)(p + ch * 8) = d;
    }
    asm volatile("s_waitcnt lgkmcnt(0)" ::: "memory");
    __builtin_amdgcn_wave_barrier();
}

template <class FD>
__device__ __forceinline__ void wave_store_bf16(const float (&v)[4][4][4], FD dst) {
    wave_store_bf16_f([&](int m, int n, int j) { return v[m][n][j]; }, dst);
}

struct ConvD { const float* src; u16* dst; int ld, ldd, k0, n0, mode, zr; };
__device__ __forceinline__ void conv_load(const ConvD& d, float (&v)[16]) {
    const int tid = TIDX;
#pragma unroll
    for (int i = 0; i < 16; ++i) v[i] = d.src[(size_t)(d.k0 + i * 4 + (tid >> 6)) * d.ld + d.n0 + (tid & 63)];
}
__device__ __forceinline__ void conv_store(const Params& p, const ConvD& d, const float (&v)[16]) {
    float* t = (float*)smem;
    const int tid = TIDX;
    __syncthreads();
#pragma unroll
    for (int i = 0; i < 16; ++i) t[(i * 4 + (tid >> 6)) * 65 + (tid & 63)] = v[i];
    __syncthreads();
    const int n = tid >> 2, kq = tid & 3;
    unsigned w[8];
#pragma unroll
    for (int i = 0; i < 8; ++i) w[i] = pack2(t[(kq * 16 + 2 * i) * 65 + n], t[(kq * 16 + 2 * i + 1) * 65 + n]);
    const int gn = d.n0 + n;
    int row = gn;
    if (d.mode == 1) row = (gn >> 4) * 32 + (gn & 15);
    else if (d.mode == 2) row = (gn >> 4) * 32 + 16 + (gn & 15);
    else if (d.mode == 3) row = n;
    uint4* o = (uint4*)(d.dst + (size_t)row * d.ldd + d.k0 + kq * 16);
    o[0] = make_uint4(w[0], w[1], w[2], w[3]);
    o[1] = make_uint4(w[4], w[5], w[6], w[7]);
    if (d.zr) {
        uint4* z = (uint4*)(WSP_WrT + (size_t)(64 + n) * 1024 + d.k0 + kq * 16);
        z[0] = make_uint4(0, 0, 0, 0); z[1] = make_uint4(0, 0, 0, 0);
    }
}

__device__ __forceinline__ void ada_item(const Params& p, int item) {
    float* sc = (float*)smem;
    float* red = sc + 9 * 1024;
    const int tid = TIDX;
    __syncthreads();
    for (int i = tid; i < 9 * 1024; i += NTHR) {
        const int r = i >> 10, k = i & 1023;
        const float cv = (r < 8) ? p.c[r * 1024 + k] : p.c_ctx[k];
        sc[i] = siluf_(cv);
    }
    __syncthreads();
    const int kq = tid >> 6, jl = tid & 63, j = item * 64 + jl;
    float acc[9];
#pragma unroll
    for (int r = 0; r < 9; ++r) acc[r] = 0.f;
#pragma unroll 16
    for (int k = kq; k < 1024; k += 4) {
        const float w = p.w_ada[(size_t)k * 6144 + j];
#pragma unroll
        for (int r = 0; r < 9; ++r) acc[r] += sc[r * 1024 + k] * w;
    }
#pragma unroll
    for (int r = 0; r < 9; ++r) red[(kq * 9 + r) * 64 + jl] = acc[r];
    __syncthreads();
    for (int i = tid; i < 9 * 64; i += NTHR) {
        const int r = i >> 6, l = i & 63;
        const float s = red[(0 * 9 + r) * 64 + l] + red[(1 * 9 + r) * 64 + l] + red[(2 * 9 + r) * 64 + l] + red[(3 * 9 + r) * 64 + l];
        WSP_mod[r * 6144 + item * 64 + l] = s + p.b_ada[item * 64 + l];
    }
}

__device__ __forceinline__ void rope_item(const Params& p) {
    for (int i = TIDX; i < 64 * 16; i += NTHR) {
        const int pos = i >> 4, k = i & 15;
        const float inv = exp2f(-(float)k * (13.287712379549449f / 16.f));
        float s, c;
        sincosf((float)pos * inv, &s, &c);
        WSP_rope[i] = make_float2(c, s);
    }
}

__device__ __forceinline__ void ssm_table_item(const Params& p, int g, int dir) {
    float* pw = (float*)smem;
    float* Bb = pw + 17 * 64 * 2;
    float* Cc = Bb + 64 * 16 * 2;
    const int tid = TIDX;
    u16* tabS = WSP_TabS + (size_t)g * 256 * 256;
    u16* tabY = WSP_TabY + (size_t)g * 256 * 512;
    float* Kf = WSP_Kbuf + (size_t)(g * 2 + dir) * 4096;
    __syncthreads();
    {
        const int pidx = dir * 32 + g;
        const float dt = __expf(p.log_dt[pidx]);
        for (int i = tid; i < 17 * 64; i += NTHR) {
            const int tau = i >> 6, n = i & 63;
            const float are = p.a_re[pidx * 64 + n], aim = p.a_im[pidx * 64 + n];
            const float mag = __expf((float)tau * dt * are);
            float rev = (float)tau * (dt * aim * 0.15915494309189535f);
            rev -= rintf(rev);
            pw[i * 2] = mag * __builtin_amdgcn_cosf(rev);
            pw[i * 2 + 1] = mag * __builtin_amdgcn_sinf(rev);
        }
        __syncthreads();
        for (int i = tid; i < 64 * 16; i += NTHR) {
            const int n = i >> 4;
            const float are = p.a_re[pidx * 64 + n], aim = p.a_im[pidx * 64 + n];
            const float abr = pw[(64 + n) * 2], abi = pw[(64 + n) * 2 + 1];
            const float den = are * are + aim * aim, nre = abr - 1.f;
            const float cre = (nre * are + abi * aim) / den, cim = (abi * are - nre * aim) / den;
            const float br = p.b_re[(size_t)pidx * 1024 + i], bi = p.b_im[(size_t)pidx * 1024 + i];
            Bb[i * 2] = cre * br - cim * bi;
            Bb[i * 2 + 1] = cre * bi + cim * br;
            Cc[i * 2] = p.c_re[(size_t)pidx * 1024 + i];
            Cc[i * 2 + 1] = p.c_im[(size_t)pidx * 1024 + i];
        }
        __syncthreads();
        {
            const int tau = tid >> 4, pp = tid & 15;
            float s[16];
#pragma unroll
            for (int q = 0; q < 16; ++q) s[q] = 0.f;
            for (int n = 0; n < 64; ++n) {
                const float2 cv = *(const float2*)&Cc[(pp * 64 + n) * 2];
                const float2 wv = *(const float2*)&pw[(tau * 64 + n) * 2];
                const float zr = cv.x * wv.x - cv.y * wv.y, zi = cv.x * wv.y + cv.y * wv.x;
#pragma unroll
                for (int q = 0; q < 16; ++q) {
                    const float2 bv = *(const float2*)&Bb[(n * 16 + q) * 2];
                    s[q] += zr * bv.x - zi * bv.y;
                }
            }
#pragma unroll
            for (int q = 0; q < 4; ++q)
                *(float4*)(Kf + tau * 256 + pp * 16 + q * 4) = make_float4(s[4 * q], s[4 * q + 1], s[4 * q + 2], s[4 * q + 3]);
        }
        for (int id = tid; id < 128 * 32; id += NTHR) {
            const int rr = id >> 5, ch = id & 31, cpart = rr >> 6, n = rr & 63, s_ = ch >> 1, q0 = (ch & 1) * 8;
            const int e = dir == 0 ? 15 - s_ : s_;
            const float wr_ = pw[(e * 64 + n) * 2], wi_ = pw[(e * 64 + n) * 2 + 1];
            unsigned w[4];
#pragma unroll
            for (int i = 0; i < 4; ++i) {
                float v[2];
#pragma unroll
                for (int h = 0; h < 2; ++h) {
                    const float br = Bb[(n * 16 + q0 + 2 * i + h) * 2], bi = Bb[(n * 16 + q0 + 2 * i + h) * 2 + 1];
                    v[h] = cpart == 0 ? (wr_ * br - wi_ * bi) : (wr_ * bi + wi_ * br);
                }
                w[i] = pack2(v[0], v[1]);
            }
            *(uint4*)(tabS + (size_t)(dir * 128 + rr) * 256 + s_ * 16 + q0) = make_uint4(w[0], w[1], w[2], w[3]);
        }
        for (int id = tid; id < 256 * 16; id += NTHR) {
            const int m = id >> 4, ch = id & 15, t = m >> 4, pp = m & 15, cpart = ch >> 3, n0 = (ch & 7) * 8;
            const int e = dir == 0 ? t + 1 : 16 - t;
            unsigned w[4];
#pragma unroll
            for (int i = 0; i < 4; ++i) {
                float v[2];
#pragma unroll
                for (int h = 0; h < 2; ++h) {
                    const int n = n0 + 2 * i + h;
                    const float cr = Cc[(pp * 64 + n) * 2], ci = Cc[(pp * 64 + n) * 2 + 1];
                    const float wr_ = pw[(e * 64 + n) * 2], wi_ = pw[(e * 64 + n) * 2 + 1];
                    v[h] = cpart == 0 ? (cr * wr_ - ci * wi_) : -(cr * wi_ + ci * wr_);
                }
                w[i] = pack2(v[0], v[1]);
            }
            *(uint4*)(tabY + (size_t)m * 512 + 256 + dir * 128 + cpart * 64 + n0) = make_uint4(w[0], w[1], w[2], w[3]);
        }
    }
}

__device__ __forceinline__ void ssm_toeplitz_item(const Params& p, int g) {
    float* Kf = (float*)smem;
    const int tid = TIDX;
    u16* tabY = WSP_TabY + (size_t)g * 256 * 512;
    __syncthreads();
    for (int i = tid; i < 2048; i += NTHR) ((float4*)Kf)[i] = ((const float4*)(WSP_Kbuf + (size_t)g * 8192))[i];
    __syncthreads();
    for (int id = tid; id < 256 * 32; id += NTHR) {
        const int m = id >> 5, ch = id & 31, t = m >> 4, pp = m & 15, s_ = ch >> 1, q0 = (ch & 1) * 8;
        unsigned w[4];
#pragma unroll
        for (int i = 0; i < 4; ++i) {
            float v[2];
#pragma unroll
            for (int h = 0; h < 2; ++h) {
                const int q = q0 + 2 * i + h;
                float val;
                if (s_ < t) val = Kf[((t - s_) * 16 + pp) * 16 + q];
                else if (s_ > t) val = Kf[4096 + ((s_ - t) * 16 + pp) * 16 + q];
                else val = Kf[(pp) * 16 + q] + Kf[4096 + pp * 16 + q] + (pp == q ? p.ssm_d[g * 16 + pp] : 0.f);
                v[h] = val;
            }
            w[i] = pack2(v[0], v[1]);
        }
        *(uint4*)(tabY + (size_t)m * 512 + s_ * 16 + q0) = make_uint4(w[0], w[1], w[2], w[3]);
    }
    __syncthreads();
}

#define N_CONV 6896
__device__ __forceinline__ ConvD conv_decode(const Params& p, int t) {
    ConvD d; d.mode = 0; d.zr = 0;
    if (t < 320) { d.src = p.w_in; d.ld = 1280; d.k0 = (t / 20) * 64; d.n0 = (t % 20) * 64; d.dst = WSP_WinT; d.ldd = 1024; return d; }
    t -= 320;
    if (t < 64) { d.src = p.w_glu; d.ld = 512; d.k0 = (t / 8) * 64; d.n0 = (t % 8) * 64; d.dst = WSP_WgluT; d.ldd = 512; return d; }
    t -= 64;
    if (t < 256) { d.src = p.w_out; d.ld = 1024; d.k0 = (t / 16) * 64; d.n0 = (t % 16) * 64; d.dst = WSP_WoutT; d.ldd = 1024; return d; }
    t -= 256;
    if (t < 16) { d.src = p.w_router; d.ld = 64; d.k0 = t * 64; d.n0 = 0; d.dst = WSP_WrT; d.ldd = 1024; d.zr = 1; return d; }
    t -= 16;
    if (t < 4096) {
        const int up = t >= 2048; const int tt = t & 2047, e = tt >> 5, r = tt & 31;
        d.src = (up ? p.w_up_e : p.w_gate_e) + (size_t)e * 131072; d.ld = 128; d.k0 = (r >> 1) * 64; d.n0 = (r & 1) * 64;
        d.dst = WSP_WguT + (size_t)e * 262144; d.ldd = 1024; d.mode = 1 + up; return d;
    }
    t -= 4096;
    if (t < 64) {
        const int up = t >= 32; const int r = t & 31;
        d.src = up ? p.w_up_s : p.w_gate_s; d.ld = 128; d.k0 = (r >> 1) * 64; d.n0 = (r & 1) * 64;
        d.dst = WSP_WguT + (size_t)64 * 262144; d.ldd = 1024; d.mode = 1 + up; return d;
    }
    t -= 64;
    if (t < 2048) { const int e = t >> 5, r = t & 31; d.src = p.w_down_e + (size_t)e * 131072; d.ld = 1024; d.k0 = (r >> 4) * 64; d.n0 = (r & 15) * 64; d.dst = WSP_WdT + (size_t)e * 131072; d.ldd = 128; return d; }
    t -= 2048;
    d.src = p.w_down_s; d.ld = 1024; d.k0 = (t >> 4) * 64; d.n0 = (t & 15) * 64; d.dst = WSP_WdT + (size_t)64 * 131072; d.ldd = 128; return d;
}

#define N_CONV_EARLY 656
__device__ __forceinline__ void conv_range(const Params& p, int t0, int stride, int tend, int tbeg = 0) {
    int t = tbeg + t0;
    if (t < tend) {
        ConvD d = conv_decode(p, t);
        float v[16];
        conv_load(d, v);
        while (t < tend) {
            const int tn = t + stride;
            ConvD dn = d;
            float vn[16];
            if (tn < tend) { dn = conv_decode(p, tn); conv_load(dn, vn); }
            conv_store(p, d, v);
            d = dn;
#pragma unroll
            for (int i = 0; i < 16; ++i) v[i] = vn[i];
            t = tn;
        }
    }
}
#define P0_CONV_B0 161
__device__ __forceinline__ void phase0(const Params& p) {
    const int b = blockIdx.x, G = gridDim.x;
    if (G > P0_CONV_B0 + 32) {
        if (b < 64) ssm_table_item(p, b >> 1, b & 1);
        else if (b < 160) ada_item(p, b - 64);
        else if (b == 160) rope_item(p);
        else conv_range(p, b - P0_CONV_B0, G - P0_CONV_B0, N_CONV_EARLY);
    } else {
        const int NU = 64 + 96 + 1 + N_CONV_EARLY;
        for (int u = b; u < NU; u += G) {
            if (u < 64) ssm_table_item(p, u >> 1, u & 1);
            else if (u < 160) ada_item(p, u - 64);
            else if (u == 160) rope_item(p);
            else { ConvD d = conv_decode(p, u - 161); float v[16]; conv_load(d, v); conv_store(p, d, v); }
        }
    }
}
#if 0
    {
        {
            const int stride = G - P0_CONV_B0;
            int t = b - P0_CONV_B0;
            if (t < N_CONV) {
                ConvD d = conv_decode(p, t);
                float v[16];
                conv_load(d, v);
                while (t < N_CONV) {
                    const int tn = t + stride;
                    ConvD dn = d;
                    float vn[16];
                    if (tn < N_CONV) { dn = conv_decode(p, tn); conv_load(dn, vn); }
                    conv_store(p, d, v);
                    d = dn;
#pragma unroll
                    for (int i = 0; i < 16; ++i) v[i] = vn[i];
                    t = tn;
                }
            }
        }
    } else {
        const int NU = 64 + 96 + 1 + N_CONV;
        for (int u = b; u < NU; u += G) {
            if (u < 64) ssm_table_item(p, u >> 1, u & 1);
            else if (u < 160) ada_item(p, u - 64);
            else if (u == 160) rope_item(p);
            else { ConvD d = conv_decode(p, u - 161); float v[16]; conv_load(d, v); conv_store(p, d, v); }
        }
    }
}

#endif

__device__ __forceinline__ void norm_mod_row(const float* src, const float* gain, const float* sh, const float* scl, u16* dst) {
    const int lane = TIDX & 63;
    float4 v[4];
    float ss = 0.f;
#pragma unroll
    for (int i = 0; i < 4; ++i) {
        v[i] = *(const float4*)(src + i * 256 + lane * 4);
        ss += v[i].x * v[i].x + v[i].y * v[i].y + v[i].z * v[i].z + v[i].w * v[i].w;
    }
    ss = wave_sum(ss);
    const float rs = rsqrtf(ss * (1.f / 1024.f) + EPS);
#pragma unroll
    for (int i = 0; i < 4; ++i) {
        const int c0 = i * 256 + lane * 4;
        const float4 g = *(const float4*)(gain + c0), s = *(const float4*)(sh + c0), k = *(const float4*)(scl + c0);
        const float a = v[i].x * rs * g.x * (1.f + k.x) + s.x, b = v[i].y * rs * g.y * (1.f + k.y) + s.y;
        const float c = v[i].z * rs * g.z * (1.f + k.z) + s.z, d = v[i].w * rs * g.w * (1.f + k.w) + s.w;
        *(uint2*)(dst + c0) = make_uint2(pack2(a, b), pack2(c, d));
    }
}

__device__ __forceinline__ void phase1(const Params& p) {
    for (int g = blockIdx.x; g < 32; g += gridDim.x) ssm_toeplitz_item(p, g);
    const int wv = blockIdx.x * 4 + (TIDX >> 6), nwv = gridDim.x * 4;
    for (int r = wv; r < NROWS; r += nwv) {
        const float* src; const float* md;
        if (r < NLAT) { src = p.x + (size_t)r * 1024; md = WSP_mod + (r >> 11) * 6144; }
        else { src = p.ctx + (size_t)(r - NLAT) * 1024; md = WSP_mod + 8 * 6144; }
        norm_mod_row(src, p.norm_mix, md, md + 1024, WSP_Hb + (size_t)r * 1024);
    }
}

__device__ __forceinline__ void phase2(const Params& p) {
    const int NU = 128 * 10 + 16 * 6;
    const int lane = TIDX & 63, wid = TIDX >> 6, wr = wid >> 1, wc = wid & 1, fr = lane & 15, fq = lane >> 4;
    for (int u = blockIdx.x; u < NU; u += gridDim.x) {
        int mt, nt;
        if (u < 1280) { mt = u / 10; nt = u % 10; } else { const int v = u - 1280; mt = 128 + v / 6; nt = 4 + v % 6; }
        const u16* A = WSP_Hb + (size_t)mt * 128 * 1024;
        const u16* B = WSP_WinT + (size_t)nt * 128 * 1024;
        f32x4 acc[4][4];
        gemm_tile(16,
            [&](int R, int C, int kt) { return (const void*)(A + (size_t)R * 1024 + kt * 64 + C); },
            [&](int R, int C, int kt) { return (const void*)(B + (size_t)R * 1024 + kt * 64 + C); }, acc);
        const int row0 = mt * 128 + wr * 64;
        const int col0 = nt * 128 + wc * 64;
        const bool is_lat = mt < 128;
        if (nt == 5) {
            const int kvh = wc;
#pragma unroll
            for (int m = 0; m < 4; ++m) {
                const int r = row0 + m * 16 + fq * 4;
                int b, pos;
                if (is_lat) { b = r >> 11; pos = r & 2047; } else { const int rc = r - NLAT; b = rc >> 8; pos = SEQ + (rc & 255); }
#pragma unroll
                for (int n = 0; n < 4; ++n) {
                    const int d = n * 16 + fr;
                    u16* dst = WSP_Vt + ((size_t)(b * 2 + kvh) * 64 + d) * VT_LD + pos;
                    *(uint2*)dst = make_uint2(pack2(acc[m][n][0], acc[m][n][1]), pack2(acc[m][n][2], acc[m][n][3]));
                }
            }
        } else {
            float v[4][4][4];
            const bool do_rope = is_lat && nt <= 4;
#pragma unroll
            for (int m = 0; m < 4; ++m)
#pragma unroll
                for (int j = 0; j < 4; ++j) {
                    if (do_rope) {
                        const int r = row0 + m * 16 + fq * 4 + j, pos = r & 2047;
                        const float2 cr = WSP_rope[(pos >> 6) * 16 + fr], cc = WSP_rope[(pos & 63) * 16 + fr];
                        const float x1 = acc[m][0][j], x2 = acc[m][1][j], y1 = acc[m][2][j], y2 = acc[m][3][j];
                        v[m][0][j] = x1 * cr.x - x2 * cr.y; v[m][1][j] = x1 * cr.y + x2 * cr.x;
                        v[m][2][j] = y1 * cc.x - y2 * cc.y; v[m][3][j] = y1 * cc.y + y2 * cc.x;
                    } else {
#pragma unroll
                        for (int n = 0; n < 4; ++n) v[m][n][j] = acc[m][n][j];
                    }
                }
            u16* dbase; int ldd;
            if (nt < 4) { dbase = WSP_Q + (size_t)row0 * 512 + col0; ldd = 512; }
            else if (nt == 4) { dbase = WSP_Kb + (size_t)row0 * 128 + (col0 - 512); ldd = 128; }
            else { dbase = WSP_U + (size_t)row0 * 512 + (col0 - 768); ldd = 512; }
            wave_store_bf16(v, [&](int row) { return dbase + (size_t)row * ldd; });
        }
    }
}

__device__ __forceinline__ void attn_unit(const Params& p, int u) {
    const int h = u & 7, qb = (u >> 3) & 15, b = u >> 7, kvh = h >> 2;
    const int tid = TIDX, lane = tid & 63, wid = tid >> 6, fr = lane & 15, fq = lane >> 4;
    const int sb = lane * 16, swz = sb ^ (((sb >> 9) & 1) << 5);
    const int r_in = swz >> 6, c_in = (swz & 63) >> 1;
    const int jstart = qb == 0 ? 2 : 0, jend = qb == 15 ? 4 : 6, nb = jend - jstart, ntile = nb + 4;
    const float SC = 0.125f * 1.4426950408889634f;
    bf16x8 qf[2][2];
    const int qrow0 = b * SEQ + qb * 128 + wid * 32;
#pragma unroll
    for (int qt = 0; qt < 2; ++qt)
#pragma unroll
        for (int ks = 0; ks < 2; ++ks)
            qf[qt][ks] = *(const bf16x8*)(WSP_Q + (size_t)(qrow0 + qt * 16 + fr) * 512 + h * 64 + ks * 32 + fq * 8);
    f32x4 o[4][2];
#pragma unroll
    for (int dt = 0; dt < 4; ++dt)
#pragma unroll
        for (int qt = 0; qt < 2; ++qt) o[dt][qt] = (f32x4){0.f, 0.f, 0.f, 0.f};
    float mrun[2], lrun[2];
    const float sinkv = p.attn_sink[h] * 1.4426950408889634f;
    mrun[0] = mrun[1] = sinkv;
    lrun[0] = lrun[1] = (fq == 0) ? 1.f : 0.f;
    __syncthreads();
    auto stage = [&](int i, int s) {
        const u16* kbase; const u16* vbase;
        if (i < nb) {
            const int ks0 = qb * 128 - 128 + 64 * (jstart + i);
            kbase = WSP_Kb + (size_t)(b * SEQ + ks0) * 128 + kvh * 64;
            vbase = WSP_Vt + (size_t)(b * 2 + kvh) * 64 * VT_LD + ks0;
        } else {
            const int c0 = 64 * (i - nb);
            kbase = WSP_Kb + (size_t)(NLAT + b * CTXL + c0) * 128 + kvh * 64;
            vbase = WSP_Vt + (size_t)(b * 2 + kvh) * 64 * VT_LD + SEQ + c0;
        }
        char* sk = smem + s * 16384;
        char* sv = sk + 8192;
#pragma unroll
        for (int it = 0; it < 2; ++it) {
            const int st = wid + 4 * it, R = (st >> 1) * 16 + r_in, C = (st & 1) * 32 + c_in;
            glds16(kbase + (size_t)R * 128 + C, sk + tid * 16 + it * 4096);
            glds16(vbase + (size_t)R * VT_LD + C, sv + tid * 16 + it * 4096);
        }
    };
    stage(0, 0);
    for (int i = 0; i < ntile; ++i) {
        asm volatile("s_waitcnt vmcnt(0)" ::: "memory");
        __syncthreads();
        if (i + 1 < ntile) stage(i + 1, (i + 1) & 1);
        const char* sk = smem + (i & 1) * 16384;
        const char* sv = sk + 8192;
        f32x4 s[4][2];
#pragma unroll
        for (int kt = 0; kt < 4; ++kt)
#pragma unroll
            for (int qt = 0; qt < 2; ++qt) s[kt][qt] = (f32x4){0.f, 0.f, 0.f, 0.f};
#pragma unroll
        for (int ks = 0; ks < 2; ++ks)
#pragma unroll
            for (int kt = 0; kt < 4; ++kt) {
                const bf16x8 kf = *(const bf16x8*)(sk + lds_byte(kt * 16 + fr, ks * 32 + fq * 8));
#pragma unroll
                for (int qt = 0; qt < 2; ++qt) s[kt][qt] = __builtin_amdgcn_mfma_f32_16x16x32_bf16(kf, qf[qt][ks], s[kt][qt], 0, 0, 0);
            }
        const bool band = i < nb;
        const int ks0 = qb * 128 - 128 + 64 * (jstart + i);
        bf16x8 pf[2][2];
#pragma unroll
        for (int qt = 0; qt < 2; ++qt) {
            const int qp = qb * 128 + wid * 32 + qt * 16 + fr;
            float mx = -1e30f;
#pragma unroll
            for (int kt = 0; kt < 4; ++kt)
#pragma unroll
                for (int j = 0; j < 4; ++j) {
                    float v = s[kt][qt][j] * SC;
                    if (band) {
                        const int kp = ks0 + kt * 16 + fq * 4 + j, d = qp - kp;
                        if (d > 128 || d < -128) v = -1e30f;
                    }
                    s[kt][qt][j] = v;
                    mx = fmaxf(mx, v);
                }
            mx = fmaxf(mx, __shfl_xor(mx, 16));
            mx = fmaxf(mx, __shfl_xor(mx, 32));
            const float mnew = fmaxf(mrun[qt], mx);
            const float alpha = __builtin_amdgcn_exp2f(mrun[qt] - mnew);
            mrun[qt] = mnew;
            float ls = 0.f;
#pragma unroll
            for (int kt = 0; kt < 4; ++kt)
#pragma unroll
                for (int j = 0; j < 4; ++j) {
                    const float pv = __builtin_amdgcn_exp2f(s[kt][qt][j] - mnew);
                    s[kt][qt][j] = pv;
                    ls += pv;
                }
            lrun[qt] = lrun[qt] * alpha + ls;
#pragma unroll
            for (int dt = 0; dt < 4; ++dt) o[dt][qt] *= alpha;
#pragma unroll
            for (int k2 = 0; k2 < 2; ++k2) {
                bf16x8 t;
#pragma unroll
                for (int j = 0; j < 4; ++j) { t[j] = (short)f2bf(s[2 * k2][qt][j]); t[4 + j] = (short)f2bf(s[2 * k2 + 1][qt][j]); }
                pf[qt][k2] = t;
            }
        }
#pragma unroll
        for (int k2 = 0; k2 < 2; ++k2)
#pragma unroll
            for (int dt = 0; dt < 4; ++dt) {
                const uint2 lo = *(const uint2*)(sv + lds_byte(dt * 16 + fr, k2 * 32 + fq * 4));
                const uint2 hi = *(const uint2*)(sv + lds_byte(dt * 16 + fr, k2 * 32 + 16 + fq * 4));
                union { uint4 u; bf16x8 v; } cv; cv.u = make_uint4(lo.x, lo.y, hi.x, hi.y);
#pragma unroll
                for (int qt = 0; qt < 2; ++qt) o[dt][qt] = __builtin_amdgcn_mfma_f32_16x16x32_bf16(cv.v, pf[qt][k2], o[dt][qt], 0, 0, 0);
            }
    }
#pragma unroll
    for (int qt = 0; qt < 2; ++qt) {
        float l = lrun[qt];
        l += __shfl_xor(l, 16);
        l += __shfl_xor(l, 32);
        const float inv = 1.f / l;
        u16* dst = WSP_AO + (size_t)(qrow0 + qt * 16 + fr) * 512 + h * 64 + fq * 4;
#pragma unroll
        for (int dt = 0; dt < 4; ++dt)
            *(uint2*)(dst + dt * 16) = make_uint2(pack2(o[dt][qt][0] * inv, o[dt][qt][1] * inv), pack2(o[dt][qt][2] * inv, o[dt][qt][3] * inv));
    }
}

__device__ __forceinline__ void ssm_s1_unit(const Params& p, int u) {
    const int ct = u % 9, mh = (u / 9) & 1, g = u / 18;
    const int lane = TIDX & 63, wid = TIDX >> 6, wr = wid >> 1, wc = wid & 1, fr = lane & 15, fq = lane >> 4;
    const u16* A = WSP_TabS + ((size_t)g * 256 + mh * 128) * 256;
    const u16* Ub = WSP_U + (size_t)ct * 128 * 16 * 512 + g * 16;
    f32x4 acc[4][4];
    gemm_tile(4,
        [&](int R, int C, int kt) { return (const void*)(A + (size_t)R * 256 + kt * 64 + C); },
        [&](int R, int C, int kt) { return (const void*)(Ub + (size_t)(R * 16 + kt * 4 + (C >> 4)) * 512 + (C & 15)); }, acc);
#pragma unroll
    for (int m = 0; m < 4; ++m)
#pragma unroll
        for (int n = 0; n < 4; ++n) {
            const int rho = mh * 128 + wr * 64 + m * 16 + fq * 4;
            const int cg = ct * 128 + wc * 64 + n * 16 + fr;
            *(f32x4*)(WSP_S + ((size_t)cg * 32 + g) * 256 + rho) = acc[m][n];
        }
}

__device__ __forceinline__ void phase3(const Params& p) {
    const int NU = 1024 + 576;
    for (int u = blockIdx.x; u < NU; u += gridDim.x) {
        if (u < 1024) attn_unit(p, u); else ssm_s1_unit(p, u - 1024);
    }
}

__device__ __forceinline__ void phase4(const Params& p) {
    if ((int)gridDim.x > 160) { if ((int)blockIdx.x >= 128) { conv_range(p, blockIdx.x - 128, gridDim.x - 128, N_CONV, N_CONV_EARLY); return; } }
    else conv_range(p, blockIdx.x, gridDim.x, N_CONV, N_CONV_EARLY);
    const int gid = blockIdx.x * NTHR + TIDX;
    if (gid >= BATCH * 2 * 32 * 64) return;
    const int n = gid & 63, g = (gid >> 6) & 31, dir = (gid >> 11) & 1, b = gid >> 12;
    const int pidx = dir * 32 + g;
    const float dt = __expf(p.log_dt[pidx]);
    const float are = p.a_re[pidx * 64 + n], aim = p.a_im[pidx * 64 + n];
    const float mag = __expf(16.f * dt * are);
    float rev = 16.f * (dt * aim * 0.15915494309189535f);
    rev -= rintf(rev);
    const float ar = mag * __builtin_amdgcn_cosf(rev), ai = mag * __builtin_amdgcn_sinf(rev);
    float hr = 0.f, hi = 0.f;
    const size_t so = (size_t)g * 256 + dir * 128 + n;
#pragma unroll 8
    for (int i = 0; i < 16; ++i) {
        const int c = dir == 0 ? i : 15 - i;
        const float* sp = WSP_S + (size_t)(NCHUNK_LAT + b * 16 + c) * 8192 + so;
        const float sr = sp[0], si = sp[64];
        const float nr = ar * hr - ai * hi + sr, ni = ar * hi + ai * hr + si;
        hr = nr; hi = ni;
    }
#pragma unroll 8
    for (int i = 0; i < 128; ++i) {
        const int c = dir == 0 ? i : 127 - i;
        const size_t cg = (size_t)b * 128 + c;
        const float* sp = WSP_S + cg * 8192 + so;
        const float sr = sp[0], si = sp[64];
        u16* hp = WSP_Hin + cg * 8192 + so;
        hp[0] = f2bf(hr); hp[64] = f2bf(hi);
        const float nr = ar * hr - ai * hi + sr, ni = ar * hi + ai * hr + si;
        hr = nr; hi = ni;
    }
}

__device__ __forceinline__ void phase5(const Params& p) {
    const int NU = 512;
    const int lane = TIDX & 63, wid = TIDX >> 6, wr = wid >> 1, wc = wid & 1, fr = lane & 15, fq = lane >> 4;
    for (int u = blockIdx.x; u < NU; u += gridDim.x) {
        const int ct = u & 7, mh = (u >> 3) & 1, g = u >> 4;
        const u16* A = WSP_TabY + ((size_t)g * 256 + mh * 128) * 512;
        const u16* Ub = WSP_U + (size_t)ct * 128 * 16 * 512 + g * 16;
        const u16* Hb_ = WSP_Hin + (size_t)ct * 128 * 8192 + g * 256;
        f32x4 acc[4][4];
        gemm_tile(8,
            [&](int R, int C, int kt) { return (const void*)(A + (size_t)R * 512 + kt * 64 + C); },
            [&](int R, int C, int kt) {
                return kt < 4 ? (const void*)(Ub + (size_t)(R * 16 + kt * 4 + (C >> 4)) * 512 + (C & 15))
                              : (const void*)(Hb_ + (size_t)R * 8192 + (kt - 4) * 64 + C);
            }, acc);
#pragma unroll
        for (int m = 0; m < 4; ++m)
#pragma unroll
            for (int n = 0; n < 4; ++n) {
                const int t = mh * 8 + wr * 4 + m;
                const int cg = ct * 128 + wc * 64 + n * 16 + fr;
                u16* dst = WSP_Y + ((size_t)cg * 16 + t) * 512 + g * 16 + fq * 4;
                *(uint2*)dst = make_uint2(pack2(gelu_tanh(acc[m][n][0]), gelu_tanh(acc[m][n][1])),
                                          pack2(gelu_tanh(acc[m][n][2]), gelu_tanh(acc[m][n][3])));
            }
    }
}

__device__ __forceinline__ void phase6(const Params& p) {
    const int NU = 512;
    const int lane = TIDX & 63, wid = TIDX >> 6, wr = wid >> 1, wc = wid & 1, fr = lane & 15, fq = lane >> 4;
    for (int u = blockIdx.x; u < NU; u += gridDim.x) {
        const int mt = u >> 2, nt = u & 3;
        const u16* A = WSP_Y + (size_t)mt * 128 * 512;
        const u16* B = WSP_WgluT + (size_t)nt * 128 * 512;
        f32x4 acc[4][4];
        gemm_tile(8,
            [&](int R, int C, int kt) { return (const void*)(A + (size_t)R * 512 + kt * 64 + C); },
            [&](int R, int C, int kt) { return (const void*)(B + (size_t)R * 512 + kt * 64 + C); }, acc);
        const int row0 = mt * 128 + wr * 64, col0 = nt * 128 + wc * 64;
        float v[4][4][4];
#pragma unroll
        for (int m = 0; m < 4; ++m)
#pragma unroll
            for (int n = 0; n < 4; ++n)
#pragma unroll
                for (int j = 0; j < 4; ++j) {
                    const int r = row0 + m * 16 + fq * 4 + j, c = col0 + n * 16 + fr;
                    const float yv = bf2f(WSP_Y[(size_t)r * 512 + c]);
                    v[m][n][j] = yv * sigmoidf_(acc[m][n][j] + p.b_glu[c]);
                }
        u16* dbase = WSP_SO + (size_t)row0 * 512 + col0;
        wave_store_bf16(v, [&](int row) { return dbase + (size_t)row * 512; });
    }
}

__device__ __forceinline__ void phase7(const Params& p) {
    const int lane = TIDX & 63;
    const int wv = blockIdx.x * 4 + (TIDX >> 6), nwv = gridDim.x * 4;
    for (int it = wv; it < NLAT * 2; it += nwv) {
        const int r = it >> 1, half = it & 1;
        const u16* src = (half ? WSP_SO : WSP_AO) + (size_t)r * 512 + lane * 8;
        const float* gain = (half ? p.norm_ssm_out : p.norm_attn_out) + lane * 8;
        const uint4 d = *(const uint4*)src;
        float f[8];
        f[0] = bf2f((u16)(d.x & 0xffff)); f[1] = bf2f((u16)(d.x >> 16));
        f[2] = bf2f((u16)(d.y & 0xffff)); f[3] = bf2f((u16)(d.y >> 16));
        f[4] = bf2f((u16)(d.z & 0xffff)); f[5] = bf2f((u16)(d.z >> 16));
        f[6] = bf2f((u16)(d.w & 0xffff)); f[7] = bf2f((u16)(d.w >> 16));
        float ss = 0.f;
#pragma unroll
        for (int i = 0; i < 8; ++i) ss += f[i] * f[i];
        ss = wave_sum(ss);
        const float rs = rsqrtf(ss * (1.f / 512.f) + EPS);
        const float4 g0 = *(const float4*)gain, g1 = *(const float4*)(gain + 4);
        *(uint4*)(WSP_CAT + (size_t)r * 1024 + half * 512 + lane * 8) =
            make_uint4(pack2(f[0] * rs * g0.x, f[1] * rs * g0.y), pack2(f[2] * rs * g0.z, f[3] * rs * g0.w),
                       pack2(f[4] * rs * g1.x, f[5] * rs * g1.y), pack2(f[6] * rs * g1.z, f[7] * rs * g1.w));
    }
}

__device__ __forceinline__ void phase8(const Params& p) {
    const int NU = 512;
    const int lane = TIDX & 63, wid = TIDX >> 6, wr = wid >> 1, wc = wid & 1, fr = lane & 15, fq = lane >> 4;
    for (int u = blockIdx.x; u < NU; u += gridDim.x) {
        const int mt = u >> 2, nt = u & 3;
        const u16* A = WSP_CAT + (size_t)mt * 128 * 1024;
        const u16* B = WSP_WoutT + (size_t)nt * 256 * 1024;
        f32x4 acc[4][8];
        gemm_tile_w(32,
            [&](int i, int R, int C, int kt) { return (const void*)(A + (size_t)R * 1024 + kt * 32 + C); },
            [&](int i, int R, int C, int kt) { return (const void*)(B + (size_t)R * 1024 + kt * 32 + C); }, acc);
        const int row0 = mt * 128 + wr * 64, col0 = nt * 256 + wc * 128;
        const float* g1 = WSP_mod + (mt >> 4) * 6144 + 2048 + col0;
        float* stg = (float*)(smem + wid * 8448);
#pragma unroll
        for (int m = 0; m < 4; ++m) {
#pragma unroll
            for (int n = 0; n < 8; ++n)
#pragma unroll
                for (int j = 0; j < 4; ++j) stg[(fq * 4 + j) * 132 + n * 16 + fr] = acc[m][n][j];
            asm volatile("s_waitcnt lgkmcnt(0)" ::: "memory");
            __builtin_amdgcn_wave_barrier();
#pragma unroll
            for (int i = 0; i < 8; ++i) {
                const int id = i * 64 + lane, rr = id >> 5, c4 = (id & 31) * 4;
                const float4 v = *(const float4*)(stg + rr * 132 + c4);
                const float4 g = *(const float4*)(g1 + c4);
                const size_t o = (size_t)(row0 + m * 16 + rr) * 1024 + col0 + c4;
                const float4 xv = *(const float4*)(p.x + o);
                *(float4*)(p.out + o) = make_float4(xv.x + g.x * v.x, xv.y + g.y * v.y, xv.z + g.z * v.z, xv.w + g.w * v.w);
            }
            asm volatile("s_waitcnt lgkmcnt(0)" ::: "memory");
            __builtin_amdgcn_wave_barrier();
        }
    }
}

#define CTR_ECNT 0
#define CTR_Q11 128
#define CTR_Q12 136
#define HALF_TOK 8192
#define HH_HALF_ROWS 73728
#define ELIST_CAP 8192
__device__ __forceinline__ void phase9(const Params& p) {
    const int tid = TIDX, lane = tid & 63, wid = tid >> 6, fr = lane & 15, fq = lane >> 4;
    char* At = smem;
    float* sc = (float*)(smem + 32768);
    int* hist = (int*)(smem + 32768 + 4096);
    int* gbase = hist + 64;
    int* fill = gbase + 64;
    unsigned char* selk = (unsigned char*)(fill + 64);
    for (int chunk = blockIdx.x; chunk < NLAT / 32; chunk += gridDim.x) {
        __syncthreads();
        if (tid < 64) hist[tid] = 0;
        for (int grp = 0; grp < 2; ++grp) {
            const int tok0 = chunk * 32 + grp * 16;
            __syncthreads();
            for (int rr = 0; rr < 4; ++rr) {
                const int row = wid * 4 + rr, tok = tok0 + row;
                const float* src = p.out + (size_t)tok * 1024;
                const float* md = WSP_mod + (tok >> 11) * 6144;
                float4 v[4];
                float ss = 0.f;
#pragma unroll
                for (int i = 0; i < 4; ++i) {
                    v[i] = *(const float4*)(src + i * 256 + lane * 4);
                    ss += v[i].x * v[i].x + v[i].y * v[i].y + v[i].z * v[i].z + v[i].w * v[i].w;
                }
                ss = wave_sum(ss);
                const float rs = rsqrtf(ss * (1.f / 1024.f) + EPS);
#pragma unroll
                for (int i = 0; i < 4; ++i) {
                    const int c0 = i * 256 + lane * 4;
                    const float4 g = *(const float4*)(p.norm_ffn + c0), s = *(const float4*)(md + 3072 + c0), k = *(const float4*)(md + 4096 + c0);
                    const float a = v[i].x * rs * g.x * (1.f + k.x) + s.x, b = v[i].y * rs * g.y * (1.f + k.y) + s.y;
                    const float c = v[i].z * rs * g.z * (1.f + k.z) + s.z, d = v[i].w * rs * g.w * (1.f + k.w) + s.w;
                    const uint2 pk = make_uint2(pack2(a, b), pack2(c, d));
                    *(uint2*)(WSP_H2 + (size_t)tok * 1024 + c0) = pk;
                    const int ch = c0 >> 3;
                    *(uint2*)(At + row * 2048 + ((ch ^ row) << 4) + ((c0 & 4) << 1)) = pk;
                }
            }
            __syncthreads();
            f32x4 acc = {0.f, 0.f, 0.f, 0.f};
            const u16* bp = WSP_WrT + (size_t)(wid * 16 + fr) * 1024 + fq * 8;
#pragma unroll
            for (int kb = 0; kb < 4; ++kb) {
                bf16x8 bfr[8];
#pragma unroll
                for (int q = 0; q < 8; ++q) bfr[q] = *(const bf16x8*)(bp + (kb * 8 + q) * 32);
#pragma unroll
                for (int q = 0; q < 8; ++q) {
                    const int ch = (kb * 8 + q) * 4 + fq;
                    const bf16x8 a = *(const bf16x8*)(At + fr * 2048 + ((ch ^ fr) << 4));
                    acc = __builtin_amdgcn_mfma_f32_16x16x32_bf16(a, bfr[q], acc, 0, 0, 0);
                }
            }
#pragma unroll
            for (int j = 0; j < 4; ++j) sc[(fq * 4 + j) * 64 + wid * 16 + fr] = sigmoidf_(acc[j]);
            __syncthreads();
            const float bias = p.router_bias[lane];
            const int eg = lane >> 3;
            for (int rr = 0; rr < 4; ++rr) {
                const int row = wid * 4 + rr, tok = tok0 + row;
                const float s = sc[row * 64 + lane];
                const float bz = s + bias;
                float m1 = bz;
                m1 = fmaxf(m1, __shfl_xor(m1, 1)); m1 = fmaxf(m1, __shfl_xor(m1, 2)); m1 = fmaxf(m1, __shfl_xor(m1, 4));
                const unsigned long long eq = __ballot(bz == m1);
                const unsigned gb = (unsigned)((eq >> (eg * 8)) & 0xffull);
                const int first = __ffs(gb) - 1;
                float v2 = ((lane & 7) == first) ? -1e30f : bz;
                v2 = fmaxf(v2, __shfl_xor(v2, 1)); v2 = fmaxf(v2, __shfl_xor(v2, 2)); v2 = fmaxf(v2, __shfl_xor(v2, 4));
                const float gs = m1 + v2;
                int cnt = 0;
#pragma unroll
                for (int j = 0; j < 8; ++j) {
                    const float gj = __int_as_float(__builtin_amdgcn_readlane(__float_as_int(gs), j * 8));
                    cnt += (gj > gs || (gj == gs && j < eg)) ? 1 : 0;
                }
                const bool gsel = cnt < 4;
                const float mv = gsel ? bz : -1e30f;
                int rank = 0;
#pragma unroll
                for (int j = 0; j < 64; ++j) {
                    const float vj = __int_as_float(__builtin_amdgcn_readlane(__float_as_int(mv), j));
                    rank += (vj > mv || (vj == mv && j < lane)) ? 1 : 0;
                }
                const bool sel = gsel && rank < 8;
                const float tot = wave_sum(sel ? s : 0.f);
                if (sel) {
                    WSP_WGT[(size_t)tok * 8 + rank] = s / tot * 2.5f;
                    selk[(grp * 16 + row) * 8 + rank] = (unsigned char)lane;
                    atomicAdd(&hist[lane], 1);
                }
            }
        }
        __syncthreads();
        const int h = (chunk * 32) >> 13;
        if (tid < 64) {
            gbase[tid] = hist[tid] ? (int)atomicAdd(&WSP_ctr[CTR_ECNT + h * 64 + tid], (unsigned)hist[tid]) : 0;
            fill[tid] = 0;
        }
        __syncthreads();
        {
            const int e = selk[tid];
            const int pos = atomicAdd(&fill[e], 1);
            WSP_elist[(size_t)(h * 64 + e) * ELIST_CAP + gbase[e] + pos] = (chunk * 32 + (tid >> 3)) * 8 + (tid & 7);
        }
    }
}

struct MoeTab { int cnt[16]; int soff[16]; int pre[17]; };

__device__ __forceinline__ void phase11(const Params& p) {
    const int tid = TIDX, lane = tid & 63, wid = tid >> 6, wr = wid >> 1, wc = wid & 1, fr = lane & 15, fq = lane >> 4;
    const int sb = lane * 16, swz = sb ^ (((sb >> 9) & 1) << 5);
    const int r_in = swz >> 6, c_in = (swz & 63) >> 1;
    int* tab = (int*)(smem + 73728);
    int* t_cnt = tab, *t_soff = tab + 16, *t_pre = tab + 32, *t_q = tab + 52;
    const int x = blockIdx.x & 7;
    __syncthreads();
    int* t_all = tab + 64;
    if (tid < 128) t_all[tid] = (int)WSP_ctr[CTR_ECNT + tid];
    if (tid == 0) t_q[0] = (int)atomicAdd(&WSP_ctr[CTR_Q11 + x], 1u);
    __syncthreads();
    if (tid < 16) {
        const int i = tid >> 1, h = tid & 1, e = x + 8 * i;
        t_cnt[tid] = t_all[h * 64 + e];
        int so = 0;
        for (int e2 = 0; e2 < e; ++e2) so += t_all[h * 64 + e2];
        t_soff[tid] = so;
    }
    __syncthreads();
    if (tid == 0) {
        int s = 0;
        for (int j = 0; j < 16; ++j) { t_pre[j] = s; s += (t_cnt[j] + 127) >> 7; }
        t_pre[16] = s;
    }
    __syncthreads();
    const int T_r = t_pre[16], T_all = T_r + 16;
    for (;;) {
        __syncthreads();
        const int u = __builtin_amdgcn_readfirstlane(t_q[0]);
        __syncthreads();
        if (u >= T_all) break;
        if (tid == 0) t_q[0] = (int)atomicAdd(&WSP_ctr[CTR_Q11 + x], 1u);
        int e, h, mt, c, rowbase;
        const int* el = nullptr;
        if (u < T_r) {
            int j = 0;
#pragma unroll
            for (int q = 1; q < 16; ++q) j += (u >= t_pre[q]) ? 1 : 0;
            e = x + 8 * (j >> 1); h = j & 1; mt = u - t_pre[j]; c = t_cnt[j];
            rowbase = h * HH_HALF_ROWS + t_soff[j];
            el = WSP_elist + (size_t)(h * 64 + e) * ELIST_CAP;
        } else {
            const int ms = x * 16 + (u - T_r);
            e = 64; h = ms >> 6; mt = ms & 63; c = HALF_TOK;
            rowbase = h * HH_HALF_ROWS + 65536;
        }
        e = __builtin_amdgcn_readfirstlane(e); h = __builtin_amdgcn_readfirstlane(h); mt = __builtin_amdgcn_readfirstlane(mt);
        c = __builtin_amdgcn_readfirstlane(c); rowbase = __builtin_amdgcn_readfirstlane(rowbase);
        if (e < 64) el = WSP_elist + (size_t)(h * 64 + e) * ELIST_CAP;
        const u16* aptr[2];
#pragma unroll
        for (int i = 0; i < 2; ++i) {
            int li = mt * 128 + (wid + 4 * i) * 16 + r_in;
            li = li < c ? li : c - 1;
            const int tok = (e < 64) ? (el[li] >> 3) : (h * HALF_TOK + li);
            aptr[i] = WSP_H2 + (size_t)tok * 1024 + c_in;
        }
        const u16* Bw = WSP_WguT + (size_t)e * 262144 + c_in;
        f32x4 acc[4][8];
        gemm_tile_w(32,
            [&](int i, int R, int C, int kt) { return (const void*)(aptr[i] + kt * 32); },
            [&](int i, int R, int C, int kt) { return (const void*)(Bw + (size_t)R * 1024 + kt * 32); }, acc);
        float wgt[4][4];
#pragma unroll
        for (int m = 0; m < 4; ++m)
#pragma unroll
            for (int j = 0; j < 4; ++j) {
                const int li = mt * 128 + wr * 64 + m * 16 + fq * 4 + j;
                float w = 1.f;
                if (e < 64) w = (li < c) ? WSP_WGT[el[li]] : 0.f;
                wgt[m][j] = w;
            }
        u16* dbase = WSP_HHs + ((size_t)rowbase + mt * 128 + wr * 64) * 128 + wc * 64;
        const int vrows = c - mt * 128 - wr * 64;
        wave_store_bf16_f([&](int m, int n2, int j) { return siluf_(acc[m][2 * n2][j]) * acc[m][2 * n2 + 1][j] * wgt[m][j]; },
                          [&](int row) { return row < vrows ? dbase + (size_t)row * 128 : (u16*)nullptr; });
    }
}

#define YD_SCALE 8.0f
template <class FV, class FD>
__device__ __forceinline__ void wave_store_fp8_f(FV val, FD dst) {
    const int lane = TIDX & 63, wid = TIDX >> 6, fr = lane & 15, fq = lane >> 4;
    char* base = smem + wid * 9216;
#pragma unroll
    for (int m = 0; m < 4; ++m)
#pragma unroll
        for (int n = 0; n < 8; ++n)
#pragma unroll
            for (int j = 0; j < 4; ++j)
                *(unsigned char*)(base + (m * 16 + fq * 4 + j) * 144 + n * 16 + fr) =
                    (unsigned char)(__builtin_amdgcn_cvt_pk_fp8_f32(val(m, n, j), 0.f, 0, false) & 0xff);
    asm volatile("s_waitcnt lgkmcnt(0)" ::: "memory");
    __builtin_amdgcn_wave_barrier();
#pragma unroll
    for (int i = 0; i < 8; ++i) {
        const int id = i * 64 + lane, row = id >> 3, ch = id & 7;
        const uint4 d = *(const uint4*)(base + row * 144 + ch * 16);
        unsigned char* q = dst(row);
        if (q) *(uint4*)(q + ch * 16) = d;
    }
    asm volatile("s_waitcnt lgkmcnt(0)" ::: "memory");
    __builtin_amdgcn_wave_barrier();
}

__device__ __forceinline__ void phase12a(const Params& p) {
    const int tid = TIDX, lane = tid & 63, wid = tid >> 6, wr = wid >> 1, wc = wid & 1;
    const int sb = lane * 16, swz = sb ^ (((sb >> 9) & 1) << 5);
    const int r_in = swz >> 6, c_in = (swz & 63) >> 1;
    int* tab = (int*)(smem + 73728);
    int* t_cnt = tab, *t_soff = tab + 16, *t_pre = tab + 32, *t_q = tab + 52;
    int* t_all = tab + 64;
    const int x = blockIdx.x & 7;
    __syncthreads();
    if (tid < 128) t_all[tid] = (int)WSP_ctr[CTR_ECNT + tid];
    if (tid == 0) t_q[0] = (int)atomicAdd(&WSP_ctr[CTR_Q12 + x], 1u);
    __syncthreads();
    if (tid < 16) {
        const int i = tid >> 1, h = tid & 1, e = x + 8 * i;
        t_cnt[tid] = t_all[h * 64 + e];
        int so = 0;
        for (int e2 = 0; e2 < e; ++e2) so += t_all[h * 64 + e2];
        t_soff[tid] = so;
    }
    __syncthreads();
    if (tid == 0) {
        int s = 0;
        for (int j = 0; j < 16; ++j) { t_pre[j] = s; s += (t_cnt[j] + 127) >> 7; }
        t_pre[16] = s;
    }
    __syncthreads();
    const int T_r = t_pre[16] * 4, T_all = T_r + 64;
    unsigned char* Yd8 = (unsigned char*)(p.ws + OFF_ARENA);
    for (;;) {
        __syncthreads();
        const int u = __builtin_amdgcn_readfirstlane(t_q[0]);
        __syncthreads();
        if (u >= T_all) break;
        if (tid == 0) t_q[0] = (int)atomicAdd(&WSP_ctr[CTR_Q12 + x], 1u);
        int e, h, mt, nt, c, rowbase;
        if (u < T_r) {
            const int um = u >> 2; nt = u & 3;
            int j = 0;
#pragma unroll
            for (int q = 1; q < 16; ++q) j += (um >= t_pre[q]) ? 1 : 0;
            e = x + 8 * (j >> 1); h = j & 1; mt = um - t_pre[j]; c = t_cnt[j];
            rowbase = h * HH_HALF_ROWS + t_soff[j];
        } else {
            const int us = u - T_r; nt = us & 3;
            const int ms = x * 16 + (us >> 2);
            e = 64; h = ms >> 6; mt = ms & 63; c = HALF_TOK; rowbase = h * HH_HALF_ROWS + 65536;
        }
        e = __builtin_amdgcn_readfirstlane(e); h = __builtin_amdgcn_readfirstlane(h); mt = __builtin_amdgcn_readfirstlane(mt);
        nt = __builtin_amdgcn_readfirstlane(nt); c = __builtin_amdgcn_readfirstlane(c); rowbase = __builtin_amdgcn_readfirstlane(rowbase);
        const int* el = WSP_elist + (size_t)(h * 64 + (e & 63)) * ELIST_CAP;
        const u16* aptr[2];
#pragma unroll
        for (int i = 0; i < 2; ++i) {
            int li = mt * 128 + (wid + 4 * i) * 16 + r_in;
            li = li < c ? li : c - 1;
            aptr[i] = WSP_HHs + ((size_t)rowbase + li) * 128 + c_in;
        }
        const u16* Bw = WSP_WdT + ((size_t)e * 1024 + nt * 256) * 128 + c_in;
        f32x4 acc[4][8];
        gemm_tile_w(4,
            [&](int i, int R, int C, int kt) { return (const void*)(aptr[i] + kt * 32); },
            [&](int i, int R, int C, int kt) { return (const void*)(Bw + (size_t)R * 128 + kt * 32); }, acc);
        const int vrows = c - mt * 128 - wr * 64;
        const int colo = nt * 256 + wc * 128;
        wave_store_fp8_f([&](int m, int n, int j) { return acc[m][n][j] * YD_SCALE; }, [&](int row) {
            if (row >= vrows) return (unsigned char*)nullptr;
            const int li = mt * 128 + wr * 64 + row;
            int tok, k;
            if (e < 64) { const int ent = el[li]; tok = ent >> 3; k = ent & 7; }
            else { tok = h * HALF_TOK + li; k = 8; }
            return Yd8 + ((size_t)tok * 9 + k) * 1024 + colo;
        });
    }
}

template <bool DUMMY>
__device__ __forceinline__ void phase12b_t(const Params& p) {
    const int lane = TIDX & 63;
    const int wv = blockIdx.x * 4 + (TIDX >> 6), nwv = gridDim.x * 4;
    const unsigned char* Yd8 = (const unsigned char*)(p.ws + OFF_ARENA);
    for (int tok = wv; tok < NLAT; tok += nwv) {
        float* row = p.out + (size_t)tok * 1024 + lane * 16;
        float* orow = DUMMY ? (float*)(p.ws + OFF_HHS) + (size_t)(tok & 8191) * 1024 + lane * 16 : row;
        const float* g2 = WSP_mod + (tok >> 11) * 6144 + 5120 + lane * 16;
        float s[16];
#pragma unroll
        for (int i = 0; i < 16; ++i) s[i] = 0.f;
        const unsigned char* yp = Yd8 + (size_t)tok * 9 * 1024 + lane * 16;
        uint4 yv[9];
#pragma unroll
        for (int k = 0; k < 9; ++k) yv[k] = *(const uint4*)(yp + k * 1024);
#pragma unroll
        for (int k = 0; k < 9; ++k) {
            const unsigned w[4] = {yv[k].x, yv[k].y, yv[k].z, yv[k].w};
#pragma unroll
            for (int i = 0; i < 4; ++i) {
                const auto lo = __builtin_amdgcn_cvt_pk_f32_fp8((int)w[i], false);
                const auto hi = __builtin_amdgcn_cvt_pk_f32_fp8((int)w[i], true);
                s[4 * i] += lo[0]; s[4 * i + 1] += lo[1]; s[4 * i + 2] += hi[0]; s[4 * i + 3] += hi[1];
            }
        }
        float ss = 0.f;
#pragma unroll
        for (int q = 0; q < 4; ++q) {
            const float4 xv = *(const float4*)(row + q * 4), gv = *(const float4*)(g2 + q * 4);
            s[4 * q] = xv.x + gv.x * (1.f / YD_SCALE) * s[4 * q]; s[4 * q + 1] = xv.y + gv.y * (1.f / YD_SCALE) * s[4 * q + 1];
            s[4 * q + 2] = xv.z + gv.z * (1.f / YD_SCALE) * s[4 * q + 2]; s[4 * q + 3] = xv.w + gv.w * (1.f / YD_SCALE) * s[4 * q + 3];
            ss += s[4 * q] * s[4 * q] + s[4 * q + 1] * s[4 * q + 1] + s[4 * q + 2] * s[4 * q + 2] + s[4 * q + 3] * s[4 * q + 3];
        }
        ss = wave_sum(ss);
        const float rs = rsqrtf(ss * (1.f / 1024.f) + EPS);
#pragma unroll
        for (int q = 0; q < 4; ++q) {
            const float4 g = *(const float4*)(p.norm_final + lane * 16 + q * 4);
            *(float4*)(orow + q * 4) = make_float4(s[4 * q] * rs * g.x, s[4 * q + 1] * rs * g.y, s[4 * q + 2] * rs * g.z, s[4 * q + 3] * rs * g.w);
        }
    }
}

#define SMEM_TOTAL (73728 + 1024 + 64)

#if 1
__global__ void __launch_bounds__(NTHR, 2) k_mega(Params p) {
    volatile LAS unsigned* st = (volatile LAS unsigned*)(smem + SMEM_TOTAL - 16);
    if (TIDX == 0) { st[0] = 0u; st[1] = 0u; st[2] = 0u; st[3] = 0u; }
    __syncthreads();
    XcdBarrier bar = xcd_barrier_post(WSP_bar, st);
#define RUNP(N) do { phase##N(p); if (PROBE_DUP == N) phase##N(p); } while (0)
    RUNP(0);  xcd_barrier(bar);
    RUNP(1);  xcd_barrier(bar);
    RUNP(2);  xcd_barrier(bar);
    RUNP(3);  xcd_barrier(bar);
    RUNP(4);  xcd_barrier(bar);
    RUNP(5);  xcd_barrier(bar);
    RUNP(6);  xcd_barrier(bar);
    RUNP(7);  xcd_barrier(bar);
    RUNP(8);  xcd_barrier(bar);
    phase9(p); xcd_barrier(bar);
#if PROBE_DUP == 9
    if (blockIdx.x == 0 && TIDX < 128) WSP_ctr[CTR_ECNT + TIDX] = 0u;
    xcd_barrier(bar); phase9(p); xcd_barrier(bar);
#endif
    phase11(p); xcd_barrier(bar);
#if PROBE_DUP == 11
    if (blockIdx.x == 0 && TIDX < 8) WSP_ctr[CTR_Q11 + TIDX] = 0u;
    xcd_barrier(bar); phase11(p); xcd_barrier(bar);
#endif
    phase12a(p); xcd_barrier(bar);
#if PROBE_DUP == 120
    if (blockIdx.x == 0 && TIDX < 8) WSP_ctr[CTR_Q12 + TIDX] = 0u;
    xcd_barrier(bar); phase12a(p); xcd_barrier(bar);
#endif
#if PROBE_DUP == 121
    phase12b_t<true>(p); xcd_barrier(bar);
#endif
    phase12b_t<false>(p);
}
#endif


extern "C" void kernel_launch(void* const* d_in, const int* in_sizes, int n_in,
                              void* d_out, int out_size, void* d_ws, size_t ws_size,
                              hipStream_t stream) {
    Params p{};
    const float** ip = (const float**)&p.x;
    for (int i = 0; i < 32; ++i) ip[i] = (const float*)d_in[i];
    p.out = (float*)d_out;
    p.ws = (char*)d_ws;
    if (OFF_END > ws_size) { fprintf(stderr, "workspace too small: need %zu have %zu\n", (size_t)OFF_END, ws_size); return; }

    static int grid = 0;
    if (!grid) {
        hipFuncSetAttribute((const void*)k_mega, hipFuncAttributeMaxDynamicSharedMemorySize, SMEM_TOTAL);
        int dev = 0, cus = 0, per_cu = 0;
        hipGetDevice(&dev);
        hipDeviceGetAttribute(&cus, hipDeviceAttributeMultiprocessorCount, dev);
        hipOccupancyMaxActiveBlocksPerMultiprocessor(&per_cu, (const void*)k_mega, NTHR, SMEM_TOTAL);
        if (per_cu < 1) per_cu = 1;
        grid = cus * (per_cu < 2 ? per_cu : 2);
    }
    hipMemsetAsync(p.ws + OFF_BAR, 0, XCD_BAR_WORDS * 4 + 1024, stream);
    k_mega<<<grid, NTHR, SMEM_TOTAL, stream>>>(p);
}
```

```cpp
#include <hip/hip_runtime.h>
#include <hip/hip_bf16.h>
#include <stdint.h>
#include <stdio.h>

#ifndef MK_MULTI
#define MK_MULTI 0
#endif

typedef __attribute__((ext_vector_type(8))) short bf16x8;
typedef __attribute__((ext_vector_type(4))) short bf16x4;
typedef __attribute__((ext_vector_type(4))) float f32x4;
typedef unsigned short u16;
typedef __attribute__((ext_vector_type(4))) unsigned u32x4;

#ifndef PROBE_DUP
#define PROBE_DUP -1
#endif
#define NTHR 256
__device__ __forceinline__ int opaque_tid() { int t = (int)threadIdx.x; asm volatile("" : "+v"(t)); return t; }
#define TIDX opaque_tid()
#define LDS_BYTES 65536

#define D_MODEL 1024
#define BATCH 8
#define SEQ 2048
#define CTXL 256
#define NLAT (BATCH * SEQ)
#define NCTX (BATCH * CTXL)
#define NROWS (NLAT + NCTX)
#define INW 1280
#define NEXP 64
#define VT_LD (SEQ + CTXL)
#define NCHUNK_LAT 1024
#define NCHUNK_ALL 1152
#define EPS 1e-6f

#define XB_TMO      128
#define XB_XCNT(j)  (256  + 64 * (j))
#define XB_XSUB(j)  (1280 + 64 * (j))
#define XB_XGEN(j)  (2304 + 64 * (j))
#define XB_TOP      3328
#define XB_TOPGEN   3392
#define XCD_BAR_WORDS 3456
#define XB_SPIN_CAP (1u << 20)
#define LAS __attribute__((address_space(3)))

__device__ __forceinline__ unsigned xb_ld(unsigned* p)              { return __hip_atomic_load(p, __ATOMIC_RELAXED, __HIP_MEMORY_SCOPE_AGENT); }
__device__ __forceinline__ unsigned xb_add(unsigned* p, unsigned v) { return __hip_atomic_fetch_add(p, v, __ATOMIC_RELAXED, __HIP_MEMORY_SCOPE_AGENT); }
__device__ __forceinline__ unsigned xb_xcc_id() { return (unsigned)__builtin_amdgcn_s_getreg((3 << 11) | 20) & 0xFu; }
#define XB_SPIN(cond, bar) do { unsigned _sp = 0; while (cond) { __builtin_amdgcn_s_sleep(1); \
    if ((++_sp & 255u) == 0u) { if (xb_ld(&(bar)[XB_TMO])) break; if (_sp > XB_SPIN_CAP) { atomicAdd(&(bar)[XB_TMO], 1u); break; } } } } while (0)

struct XcdBarrier { unsigned* bar; unsigned x; volatile LAS unsigned* st; };

__device__ __forceinline__ XcdBarrier xcd_barrier_post(unsigned* bar, volatile LAS unsigned* st) {
    XcdBarrier b; b.bar = bar; b.x = xb_xcc_id(); b.st = st;
    if (TIDX == 0) (void)xb_add(&bar[XB_XCNT(b.x)], 1u);
    return b;
}
__device__ __forceinline__ void xcd_barrier_complete(unsigned* bar, unsigned x, unsigned& nloc, unsigned& nx) {
    const unsigned G = gridDim.x * gridDim.y * gridDim.z;
    unsigned sum, cnt, mine, sp = 0u;
    for (;;) {
        sum = 0u; cnt = 0u; mine = 0u;
#pragma unroll
        for (unsigned j = 0; j < 16; ++j) { const unsigned c = xb_ld(&bar[XB_XCNT(j)]); sum += c; cnt += (c > 0u) ? 1u : 0u; mine = (j == x) ? c : mine; }
        if (sum == G) break;
        __builtin_amdgcn_s_sleep(1);
        if ((++sp & 255u) == 0u) { if (xb_ld(&bar[XB_TMO])) break; if (sp > XB_SPIN_CAP) { atomicAdd(&bar[XB_TMO], 1u); break; } }
    }
    nloc = mine > 0u ? mine : 1u; nx = cnt > 0u ? cnt : 1u;
}
__device__ __forceinline__ void xcd_barrier(const XcdBarrier& b) {
    asm volatile("s_waitcnt vmcnt(0)" ::: "memory");
    __syncthreads();
    if (TIDX == 0) {
        unsigned* bar = b.bar;
        __builtin_amdgcn_s_waitcnt(0);
        unsigned nloc = b.st[0], nx = b.st[1];
        if (nloc == 0u) { xcd_barrier_complete(bar, b.x, nloc, nx); b.st[0] = nloc; b.st[1] = nx; }
        const unsigned old = xb_add(&bar[XB_XSUB(b.x)], 1u);
        const unsigned gen = old / nloc;
        if (old + 1u == (gen + 1u) * nloc) {
            __builtin_amdgcn_fence(__ATOMIC_RELEASE, "agent");
            asm volatile("s_waitcnt vmcnt(0)" ::: "memory");
            const unsigned og = xb_add(&bar[XB_TOP], 1u);
            const unsigned tg = og / nx;
            if (og + 1u == (tg + 1u) * nx) xb_add(&bar[XB_TOPGEN], 1u);
            else XB_SPIN(xb_ld(&bar[XB_TOPGEN]) == tg, bar);
            __builtin_amdgcn_fence(__ATOMIC_ACQUIRE, "agent");
            xb_add(&bar[XB_XGEN(b.x)], 1u);
            asm volatile("s_waitcnt vmcnt(0)" ::: "memory");
        } else {
            XB_SPIN(xb_ld(&bar[XB_XGEN(b.x)]) == gen, bar);
            __builtin_amdgcn_fence(__ATOMIC_ACQUIRE, "agent");
            asm volatile("s_waitcnt vmcnt(0)" ::: "memory");
        }
    }
    __syncthreads();
}

struct Params {
    const float *x, *c, *ctx, *c_ctx, *w_ada, *b_ada, *norm_mix, *norm_ffn, *w_in, *attn_sink,
        *a_re, *a_im, *log_dt, *b_re, *b_im, *c_re, *c_im, *ssm_d, *w_glu, *b_glu, *norm_attn_out, *norm_ssm_out,
        *w_out, *w_router, *router_bias, *w_gate_e, *w_up_e, *w_down_e, *w_gate_s, *w_up_s, *w_down_s, *norm_final;
    float* out;
    char* ws;
};

constexpr size_t A256(size_t v) { return (v + 255) & ~(size_t)255; }
constexpr size_t OFF_BAR   = 0;
constexpr size_t OFF_RSQ   = A256(OFF_BAR + XCD_BAR_WORDS * 4 + 1024);
constexpr size_t ZERO_BYTES = OFF_RSQ + (size_t)NLAT * 2 * 4;
constexpr size_t OFF_MOD   = A256(ZERO_BYTES);
constexpr size_t OFF_ROPE  = A256(OFF_MOD + 9 * 6144 * 4);
constexpr size_t OFF_KBUF  = A256(OFF_ROPE + 64 * 16 * 8);
constexpr size_t OFF_IDX   = A256(OFF_KBUF + (size_t)32 * 2 * 4096 * 4);
constexpr size_t OFF_WGT   = A256(OFF_IDX + (size_t)NLAT * 8);
constexpr size_t OFF_ELIST = A256(OFF_WGT + (size_t)NLAT * 8 * 4);
constexpr size_t OFF_WINT  = A256(OFF_ELIST + (size_t)2 * 64 * 8192 * 4);
constexpr size_t OFF_WGLUT = A256(OFF_WINT + (size_t)1280 * 1024 * 2);
constexpr size_t OFF_WOUTT = A256(OFF_WGLUT + (size_t)512 * 512 * 2);
constexpr size_t OFF_WRT   = A256(OFF_WOUTT + (size_t)1024 * 1024 * 2);
constexpr size_t OFF_WDT   = A256(OFF_WRT + (size_t)128 * 1024 * 2);
constexpr size_t OFF_HHS   = A256(OFF_WDT + (size_t)65 * 1024 * 128 * 2);
constexpr size_t OFF_ARENA = A256(OFF_HHS + (size_t)2 * 73728 * 128 * 2);
constexpr size_t OFF_WGUT  = OFF_ARENA;
constexpr size_t OFF_TABS  = A256(OFF_WGUT + (size_t)65 * 256 * 1024 * 2);
constexpr size_t OFF_TABY  = A256(OFF_TABS + (size_t)32 * 256 * 256 * 2);
constexpr size_t OFF_R1    = A256(OFF_TABY + (size_t)32 * 256 * 512 * 2);
constexpr size_t OFF_R2    = A256(OFF_R1 + (size_t)NROWS * 1024 * 2);
constexpr size_t OFF_R3    = A256(OFF_R2 + (size_t)NLAT * 1024 * 2);
constexpr size_t OFF_R4    = A256(OFF_R3 + (size_t)NLAT * 1024 * 2);
constexpr size_t OFF_END   = A256(OFF_R4 + (size_t)NLAT * 512 * 2 * 2);
static_assert(OFF_END - OFF_ARENA >= (size_t)8192 * 9 * 1024 * 2, "arena must hold Yd");
#define WSP_bar   ((unsigned*)(p.ws + OFF_BAR))
#define WSP_ctr   ((unsigned*)(p.ws + OFF_BAR) + XCD_BAR_WORDS)
#define WSP_rsq   ((float*)(p.ws + OFF_RSQ))
#define WSP_mod   ((float*)(p.ws + OFF_MOD))
#define WSP_rope  ((float2*)(p.ws + OFF_ROPE))
#define WSP_Kbuf  ((float*)(p.ws + OFF_KBUF))
#define WSP_WGT   ((float*)(p.ws + OFF_WGT))
#define WSP_elist ((int*)(p.ws + OFF_ELIST))
#define WSP_WinT  ((u16*)(p.ws + OFF_WINT))
#define WSP_WgluT ((u16*)(p.ws + OFF_WGLUT))
#define WSP_WoutT ((u16*)(p.ws + OFF_WOUTT))
#define WSP_WrT   ((u16*)(p.ws + OFF_WRT))
#define WSP_WdT   ((u16*)(p.ws + OFF_WDT))
#define WSP_HHs   ((u16*)(p.ws + OFF_HHS))
#define WSP_Yd    ((u16*)(p.ws + OFF_ARENA))
#define WSP_WguT  ((u16*)(p.ws + OFF_WGUT))
#define WSP_TabS  ((u16*)(p.ws + OFF_TABS))
#define WSP_TabY  ((u16*)(p.ws + OFF_TABY))
#define WSP_Hb    ((u16*)(p.ws + OFF_R1))
#define WSP_S     ((float*)(p.ws + OFF_R1))
#define WSP_H2    ((u16*)(p.ws + OFF_R1))
#define WSP_Q     ((u16*)(p.ws + OFF_R2))
#define WSP_Kb    ((u16*)(p.ws + OFF_R2 + (size_t)NLAT * 512 * 2))
#define WSP_Vt    ((u16*)(p.ws + OFF_R2 + (size_t)NLAT * 512 * 2 + (size_t)NROWS * 128 * 2))
#define WSP_Y     ((u16*)(p.ws + OFF_R2))
#define WSP_SO    ((u16*)(p.ws + OFF_R2 + (size_t)NLAT * 512 * 2))
#define WSP_U     ((u16*)(p.ws + OFF_R3))
#define WSP_CAT   ((u16*)(p.ws + OFF_R3))
#define WSP_AO    ((u16*)(p.ws + OFF_R4))
#define WSP_Hin   ((u16*)(p.ws + OFF_R4 + (size_t)NLAT * 512 * 2))

extern __shared__ __attribute__((aligned(16))) char smem[];

__device__ __forceinline__ u16 f2bf(float f) {
    unsigned u = __float_as_uint(f);
    u += 0x7fffu + ((u >> 16) & 1u);
    return (u16)(u >> 16);
}
__device__ __forceinline__ float bf2f(u16 h) { return __uint_as_float(((unsigned)h) << 16); }
__device__ __forceinline__ unsigned pack2(float a, float b) { return (unsigned)f2bf(a) | ((unsigned)f2bf(b) << 16); }
__device__ __forceinline__ void glds16(const void* g, void* l) {
    __builtin_amdgcn_global_load_lds((const unsigned*)g, (unsigned*)l, 16, 0, 0);
}
__device__ __forceinline__ int lds_byte(int r, int c) {
    int st = (r >> 4) * 2 + (c >> 5), rr = r & 15, cc = c & 31, ob = rr * 64 + cc * 2;
    return st * 1024 + (ob ^ (((ob >> 9) & 1) << 5));
}
__device__ __forceinline__ float wave_sum(float v) {
#pragma unroll
    for (int o = 32; o > 0; o >>= 1) v += __shfl_xor(v, o);
    return v;
}
__device__ __forceinline__ float sigmoidf_(float x) { return 1.f / (1.f + __expf(-x)); }
__device__ __forceinline__ float siluf_(float x) { return x / (1.f + __expf(-x)); }
__device__ __forceinline__ float gelu_tanh(float x) {
    float u = 0.7978845608028654f * (x + 0.044715f * x * x * x);
    return x / (1.f + __expf(-2.f * u));
}

template <class FA, class FB>
__device__ __forceinline__ void gemm_tile(int nkt, FA fa, FB fb, f32x4 (&acc)[4][4]) {
    const int tid = TIDX, lane = tid & 63, wid = tid >> 6, wr = wid >> 1, wc = wid & 1, fr = lane & 15, fq = lane >> 4;
    const int sb = lane * 16, swz = sb ^ (((sb >> 9) & 1) << 5);
    const int r_in = swz >> 6, c_in = (swz & 63) >> 1;
#pragma unroll
    for (int m = 0; m < 4; ++m)
#pragma unroll
        for (int n = 0; n < 4; ++n) acc[m][n] = (f32x4){0.f, 0.f, 0.f, 0.f};
    __syncthreads();
    auto stage = [&](int kt, int s) {
        char* sa = smem + s * 32768;
        char* sbm = sa + 16384;
#pragma unroll
        for (int i = 0; i < 4; ++i) {
            const int st = wid + 4 * i, R = (st >> 1) * 16 + r_in, C = (st & 1) * 32 + c_in;
            glds16(fa(R, C, kt), sa + tid * 16 + i * 4096);
            glds16(fb(R, C, kt), sbm + tid * 16 + i * 4096);
        }
    };
    stage(0, 0);
    for (int kt = 0; kt < nkt; ++kt) {
        asm volatile("s_waitcnt vmcnt(0)" ::: "memory");
        __syncthreads();
        if (kt + 1 < nkt) stage(kt + 1, (kt + 1) & 1);
        const char* sa = smem + (kt & 1) * 32768;
        const char* sbm = sa + 16384;
#pragma unroll
        for (int ks = 0; ks < 2; ++ks) {
            bf16x8 a[4], b[4];
#pragma unroll
            for (int m = 0; m < 4; ++m) a[m] = *(const bf16x8*)(sa + lds_byte(wr * 64 + m * 16 + fr, ks * 32 + fq * 8));
#pragma unroll
            for (int n = 0; n < 4; ++n) b[n] = *(const bf16x8*)(sbm + lds_byte(wc * 64 + n * 16 + fr, ks * 32 + fq * 8));
#pragma unroll
            for (int m = 0; m < 4; ++m)
#pragma unroll
                for (int n = 0; n < 4; ++n) acc[m][n] = __builtin_amdgcn_mfma_f32_16x16x32_bf16(a[m], b[n], acc[m][n], 0, 0, 0);
        }
    }
    __syncthreads();
}

__device__ __forceinline__ int lds32(int r, int c) {
    const int rr = r & 15;
    return (r >> 4) * 1024 + ((rr * 64 + c * 2) ^ (((rr >> 3) & 1) << 5));
}
struct NoHook { __device__ __forceinline__ void operator()(int) const {} };
template <class FA, class FB, class HK = NoHook>
__device__ __forceinline__ void gemm_tile_w(int nkt, FA fa, FB fb, f32x4 (&acc)[4][8], HK hook = HK()) {
    constexpr bool ZERO = true;
    const int tid = TIDX, lane = tid & 63, wid = tid >> 6, wr = wid >> 1, wc = wid & 1, fr = lane & 15, fq = lane >> 4;
    const int sb = lane * 16, swz = sb ^ (((sb >> 9) & 1) << 5);
    const int r_in = swz >> 6, c_in = (swz & 63) >> 1;
    if (ZERO) {
#pragma unroll
        for (int m = 0; m < 4; ++m)
#pragma unroll
            for (int n = 0; n < 8; ++n) acc[m][n] = (f32x4){0.f, 0.f, 0.f, 0.f};
    }
    __syncthreads();
    auto stage = [&](int kt, int s) {
        char* sa = smem + s * 24576;
#pragma unroll
        for (int i = 0; i < 2; ++i) glds16(fa(i, (wid + 4 * i) * 16 + r_in, c_in, kt), sa + tid * 16 + i * 4096);
#pragma unroll
        for (int i = 0; i < 4; ++i) glds16(fb(i, (wid + 4 * i) * 16 + r_in, c_in, kt), sa + 8192 + tid * 16 + i * 4096);
    };
    stage(0, 0);
    if (nkt > 1) stage(1, 1);
    int s_cur = 0, s_nxt = 2;
    for (int kt = 0; kt < nkt; ++kt) {
        hook(kt);
        if (kt + 1 < nkt) asm volatile("s_waitcnt vmcnt(6) lgkmcnt(0)\n\ts_barrier" ::: "memory");
        else asm volatile("s_waitcnt vmcnt(0) lgkmcnt(0)\n\ts_barrier" ::: "memory");
        if (kt + 2 < nkt) stage(kt + 2, s_nxt);
        const char* sa = smem + s_cur * 24576;
        bf16x8 a[4];
#pragma unroll
        for (int m = 0; m < 4; ++m) a[m] = *(const bf16x8*)(sa + lds32(wr * 64 + m * 16 + fr, fq * 8));
#pragma unroll
        for (int nh = 0; nh < 2; ++nh) {
            bf16x8 b[4];
#pragma unroll
            for (int n = 0; n < 4; ++n) b[n] = *(const bf16x8*)(sa + 8192 + lds32(wc * 128 + (nh * 4 + n) * 16 + fr, fq * 8));
#pragma unroll
            for (int m = 0; m < 4; ++m)
#pragma unroll
                for (int n = 0; n < 4; ++n) acc[m][nh * 4 + n] = __builtin_amdgcn_mfma_f32_16x16x32_bf16(a[m], b[n], acc[m][nh * 4 + n], 0, 0, 0);
        }
        s_cur = (s_cur == 2) ? 0 : s_cur + 1;
        s_nxt = (s_nxt == 2) ? 0 : s_nxt + 1;
    }
    __syncthreads();
}

template <class FV, class FD>
__device__ __forceinline__ void wave_store_bf16_f(FV val, FD dst) {
    const int lane = TIDX & 63, wid = TIDX >> 6, fr = lane & 15, fq = lane >> 4;
    char* base = smem + wid * 9216;
#pragma unroll
    for (int m = 0; m < 4; ++m)
#pragma unroll
        for (int n = 0; n < 4; ++n)
#pragma unroll
            for (int j = 0; j < 4; ++j)
                *(u16*)(base + (m * 16 + fq * 4 + j) * 144 + (n * 16 + fr) * 2) = f2bf(val(m, n, j));
    asm volatile("s_waitcnt lgkmcnt(0)" ::: "memory");
    __builtin_amdgcn_wave_barrier();
#pragma unroll
    for (int i = 0; i < 8; ++i) {
        const int id = i * 64 + lane, row = id >> 3, ch = id & 7;
        const uint4 d = *(const uint4*)(base + row * 144 + ch * 16);
        u16* p = dst(row);
        if (p) *(uint4*)(p + ch * 8) = d;
    }
    asm volatile("s_waitcnt lgkmcnt(0)" ::: "memory");
    __builtin_amdgcn_wave_barrier();
}

template <class FD>
__device__ __forceinline__ void wave_store_bf16(const float (&v)[4][4][4], FD dst) {
    wave_store_bf16_f([&](int m, int n, int j) { return v[m][n][j]; }, dst);
}

struct ConvD { const float* src; u16* dst; int ld, ldd, k0, n0, mode, zr; };
__device__ __forceinline__ void conv_load(const Params& p, const ConvD& d, float (&v)[16]) {
    const int tid = TIDX;
#pragma unroll
    for (int i = 0; i < 16; ++i) v[i] = d.src[(size_t)(d.k0 + i * 4 + (tid >> 6)) * d.ld + d.n0 + (tid & 63)];
    if (d.zr == 2) {
#pragma unroll
        for (int i = 0; i < 16; ++i) {
            const int k = d.k0 + i * 4 + (tid >> 6);
            v[i] *= (k < 512) ? p.norm_attn_out[k] : p.norm_ssm_out[k - 512];
        }
    }
}
__device__ __forceinline__ void conv_store(const Params& p, const ConvD& d, const float (&v)[16]) {
    float* t = (float*)smem;
    const int tid = TIDX;
    __syncthreads();
#pragma unroll
    for (int i = 0; i < 16; ++i) t[(i * 4 + (tid >> 6)) * 65 + (tid & 63)] = v[i];
    __syncthreads();
    const int n = tid >> 2, kq = tid & 3;
    unsigned w[8];
#pragma unroll
    for (int i = 0; i < 8; ++i) w[i] = pack2(t[(kq * 16 + 2 * i) * 65 + n], t[(kq * 16 + 2 * i + 1) * 65 + n]);
    const int gn = d.n0 + n;
    int row = gn;
    if (d.mode == 1) row = (gn >> 4) * 32 + (gn & 15);
    else if (d.mode == 2) row = (gn >> 4) * 32 + 16 + (gn & 15);
    else if (d.mode == 3) row = n;
    uint4* o = (uint4*)(d.dst + (size_t)row * d.ldd + d.k0 + kq * 16);
    o[0] = make_uint4(w[0], w[1], w[2], w[3]);
    o[1] = make_uint4(w[4], w[5], w[6], w[7]);
    if (d.zr == 1) {
        uint4* z = (uint4*)(WSP_WrT + (size_t)(64 + n) * 1024 + d.k0 + kq * 16);
        z[0] = make_uint4(0, 0, 0, 0); z[1] = make_uint4(0, 0, 0, 0);
    }
}

__device__ __forceinline__ void ada_item(const Params& p, int item) {
    float* sc = (float*)smem;
    float* red = sc + 9 * 1024;
    const int tid = TIDX;
    __syncthreads();
    for (int i = tid; i < 9 * 1024; i += NTHR) {
        const int r = i >> 10, k = i & 1023;
        const float cv = (r < 8) ? p.c[r * 1024 + k] : p.c_ctx[k];
        sc[i] = siluf_(cv);
    }
    __syncthreads();
    const int kq = tid >> 6, jl = tid & 63, j = item * 64 + jl;
    float acc[9];
#pragma unroll
    for (int r = 0; r < 9; ++r) acc[r] = 0.f;
#pragma unroll 16
    for (int k = kq; k < 1024; k += 4) {
        const float w = p.w_ada[(size_t)k * 6144 + j];
#pragma unroll
        for (int r = 0; r < 9; ++r) acc[r] += sc[r * 1024 + k] * w;
    }
#pragma unroll
    for (int r = 0; r < 9; ++r) red[(kq * 9 + r) * 64 + jl] = acc[r];
    __syncthreads();
    for (int i = tid; i < 9 * 64; i += NTHR) {
        const int r = i >> 6, l = i & 63;
        const float s = red[(0 * 9 + r) * 64 + l] + red[(1 * 9 + r) * 64 + l] + red[(2 * 9 + r) * 64 + l] + red[(3 * 9 + r) * 64 + l];
        WSP_mod[r * 6144 + item * 64 + l] = s + p.b_ada[item * 64 + l];
    }
}

__device__ __forceinline__ void rope_item(const Params& p) {
    for (int i = TIDX; i < 64 * 16; i += NTHR) {
        const int pos = i >> 4, k = i & 15;
        const float inv = exp2f(-(float)k * (13.287712379549449f / 16.f));
        float s, c;
        sincosf((float)pos * inv, &s, &c);
        WSP_rope[i] = make_float2(c, s);
    }
}

__device__ __forceinline__ void ssm_table_item(const Params& p, int g, int dir) {
    float* pw = (float*)smem;
    float* Bb = pw + 17 * 64 * 2;
    float* Cc = Bb + 64 * 16 * 2;
    const int tid = TIDX;
    u16* tabS = WSP_TabS + (size_t)g * 256 * 256;
    u16* tabY = WSP_TabY + (size_t)g * 256 * 512;
    float* Kf = WSP_Kbuf + (size_t)(g * 2 + dir) * 4096;
    __syncthreads();
    {
        const int pidx = dir * 32 + g;
        const float dt = __expf(p.log_dt[pidx]);
        for (int i = tid; i < 17 * 64; i += NTHR) {
            const int tau = i >> 6, n = i & 63;
            const float are = p.a_re[pidx * 64 + n], aim = p.a_im[pidx * 64 + n];
            const float mag = __expf((float)tau * dt * are);
            float rev = (float)tau * (dt * aim * 0.15915494309189535f);
            rev -= rintf(rev);
            pw[i * 2] = mag * __builtin_amdgcn_cosf(rev);
            pw[i * 2 + 1] = mag * __builtin_amdgcn_sinf(rev);
        }
        __syncthreads();
        for (int i = tid; i < 64 * 16; i += NTHR) {
            const int n = i >> 4;
            const float are = p.a_re[pidx * 64 + n], aim = p.a_im[pidx * 64 + n];
            const float abr = pw[(64 + n) * 2], abi = pw[(64 + n) * 2 + 1];
            const float den = are * are + aim * aim, nre = abr - 1.f;
            const float cre = (nre * are + abi * aim) / den, cim = (abi * are - nre * aim) / den;
            const float br = p.b_re[(size_t)pidx * 1024 + i], bi = p.b_im[(size_t)pidx * 1024 + i];
            Bb[i * 2] = cre * br - cim * bi;
            Bb[i * 2 + 1] = cre * bi + cim * br;
            Cc[i * 2] = p.c_re[(size_t)pidx * 1024 + i];
            Cc[i * 2 + 1] = p.c_im[(size_t)pidx * 1024 + i];
        }
        __syncthreads();
        {
            const int tau = tid >> 4, pp = tid & 15;
            float s[16];
#pragma unroll
            for (int q = 0; q < 16; ++q) s[q] = 0.f;
            for (int n = 0; n < 64; ++n) {
                const float2 cv = *(const float2*)&Cc[(pp * 64 + n) * 2];
                const float2 wv = *(const float2*)&pw[(tau * 64 + n) * 2];
                const float zr = cv.x * wv.x - cv.y * wv.y, zi = cv.x * wv.y + cv.y * wv.x;
#pragma unroll
                for (int q = 0; q < 16; ++q) {
                    const float2 bv = *(const float2*)&Bb[(n * 16 + q) * 2];
                    s[q] += zr * bv.x - zi * bv.y;
                }
            }
#pragma unroll
            for (int q = 0; q < 4; ++q)
                *(float4*)(Kf + tau * 256 + pp * 16 + q * 4) = make_float4(s[4 * q], s[4 * q + 1], s[4 * q + 2], s[4 * q + 3]);
        }
        for (int id = tid; id < 128 * 32; id += NTHR) {
            const int rr = id >> 5, ch = id & 31, cpart = rr >> 6, n = rr & 63, s_ = ch >> 1, q0 = (ch & 1) * 8;
            const int e = dir == 0 ? 15 - s_ : s_;
            const float wr_ = pw[(e * 64 + n) * 2], wi_ = pw[(e * 64 + n) * 2 + 1];
            unsigned w[4];
#pragma unroll
            for (int i = 0; i < 4; ++i) {
                float v[2];
#pragma unroll
                for (int h = 0; h < 2; ++h) {
                    const float br = Bb[(n * 16 + q0 + 2 * i + h) * 2], bi = Bb[(n * 16 + q0 + 2 * i + h) * 2 + 1];
                    v[h] = cpart == 0 ? (wr_ * br - wi_ * bi) : (wr_ * bi + wi_ * br);
                }
                w[i] = pack2(v[0], v[1]);
            }
            *(uint4*)(tabS + (size_t)(dir * 128 + rr) * 256 + s_ * 16 + q0) = make_uint4(w[0], w[1], w[2], w[3]);
        }
        for (int id = tid; id < 256 * 16; id += NTHR) {
            const int m = id >> 4, ch = id & 15, t = m >> 4, pp = m & 15, cpart = ch >> 3, n0 = (ch & 7) * 8;
            const int e = dir == 0 ? t + 1 : 16 - t;
            unsigned w[4];
#pragma unroll
            for (int i = 0; i < 4; ++i) {
                float v[2];
#pragma unroll
                for (int h = 0; h < 2; ++h) {
                    const int n = n0 + 2 * i + h;
                    const float cr = Cc[(pp * 64 + n) * 2], ci = Cc[(pp * 64 + n) * 2 + 1];
                    const float wr_ = pw[(e * 64 + n) * 2], wi_ = pw[(e * 64 + n) * 2 + 1];
                    v[h] = cpart == 0 ? (cr * wr_ - ci * wi_) : -(cr * wi_ + ci * wr_);
                }
                w[i] = pack2(v[0], v[1]);
            }
            *(uint4*)(tabY + (size_t)m * 512 + 256 + dir * 128 + cpart * 64 + n0) = make_uint4(w[0], w[1], w[2], w[3]);
        }
    }
}

__device__ __forceinline__ void ssm_toeplitz_item(const Params& p, int g) {
    float* Kf = (float*)smem;
    const int tid = TIDX;
    u16* tabY = WSP_TabY + (size_t)g * 256 * 512;
    __syncthreads();
    for (int i = tid; i < 2048; i += NTHR) ((float4*)Kf)[i] = ((const float4*)(WSP_Kbuf + (size_t)g * 8192))[i];
    __syncthreads();
    for (int id = tid; id < 256 * 32; id += NTHR) {
        const int m = id >> 5, ch = id & 31, t = m >> 4, pp = m & 15, s_ = ch >> 1, q0 = (ch & 1) * 8;
        unsigned w[4];
#pragma unroll
        for (int i = 0; i < 4; ++i) {
            float v[2];
#pragma unroll
            for (int h = 0; h < 2; ++h) {
                const int q = q0 + 2 * i + h;
                float val;
                if (s_ < t) val = Kf[((t - s_) * 16 + pp) * 16 + q];
                else if (s_ > t) val = Kf[4096 + ((s_ - t) * 16 + pp) * 16 + q];
                else val = Kf[(pp) * 16 + q] + Kf[4096 + pp * 16 + q] + (pp == q ? p.ssm_d[g * 16 + pp] : 0.f);
                v[h] = val;
            }
            w[i] = pack2(v[0], v[1]);
        }
        *(uint4*)(tabY + (size_t)m * 512 + s_ * 16 + q0) = make_uint4(w[0], w[1], w[2], w[3]);
    }
    __syncthreads();
}

#define N_CONV 6896
__device__ __forceinline__ ConvD conv_decode(const Params& p, int t) {
    ConvD d; d.mode = 0; d.zr = 0;
    if (t < 320) { d.src = p.w_in; d.ld = 1280; d.k0 = (t / 20) * 64; d.n0 = (t % 20) * 64; d.dst = WSP_WinT; d.ldd = 1024; return d; }
    t -= 320;
    if (t < 64) { d.src = p.w_glu; d.ld = 512; d.k0 = (t / 8) * 64; d.n0 = (t % 8) * 64; d.dst = WSP_WgluT; d.ldd = 512; return d; }
    t -= 64;
    if (t < 256) { d.src = p.w_out; d.ld = 1024; d.k0 = (t / 16) * 64; d.n0 = (t % 16) * 64; d.dst = WSP_WoutT; d.ldd = 1024; d.zr = 2; return d; }
    t -= 256;
    if (t < 16) { d.src = p.w_router; d.ld = 64; d.k0 = t * 64; d.n0 = 0; d.dst = WSP_WrT; d.ldd = 1024; d.zr = 1; return d; }
    t -= 16;
    if (t < 4096) {
        const int up = t >= 2048; const int tt = t & 2047, e = tt >> 5, r = tt & 31;
        d.src = (up ? p.w_up_e : p.w_gate_e) + (size_t)e * 131072; d.ld = 128; d.k0 = (r >> 1) * 64; d.n0 = (r & 1) * 64;
        d.dst = WSP_WguT + (size_t)e * 262144; d.ldd = 1024; d.mode = 1 + up; return d;
    }
    t -= 4096;
    if (t < 64) {
        const int up = t >= 32; const int r = t & 31;
        d.src = up ? p.w_up_s : p.w_gate_s; d.ld = 128; d.k0 = (r >> 1) * 64; d.n0 = (r & 1) * 64;
        d.dst = WSP_WguT + (size_t)64 * 262144; d.ldd = 1024; d.mode = 1 + up; return d;
    }
    t -= 64;
    if (t < 2048) { const int e = t >> 5, r = t & 31; d.src = p.w_down_e + (size_t)e * 131072; d.ld = 1024; d.k0 = (r >> 4) * 64; d.n0 = (r & 15) * 64; d.dst = WSP_WdT + (size_t)e * 131072; d.ldd = 128; return d; }
    t -= 2048;
    d.src = p.w_down_s; d.ld = 1024; d.k0 = (t >> 4) * 64; d.n0 = (t & 15) * 64; d.dst = WSP_WdT + (size_t)64 * 131072; d.ldd = 128; return d;
}

#define N_CONV_EARLY 3200
__device__ __forceinline__ void conv_range(const Params& p, int t0, int stride, int tend, int tbeg = 0) {
    int t = tbeg + t0;
    if (t < tend) {
        ConvD d = conv_decode(p, t);
        float v[16];
        conv_load(p, d, v);
        while (t < tend) {
            const int tn = t + stride;
            ConvD dn = d;
            float vn[16];
            if (tn < tend) { dn = conv_decode(p, tn); conv_load(p, dn, vn); }
            conv_store(p, d, v);
            d = dn;
#pragma unroll
            for (int i = 0; i < 16; ++i) v[i] = vn[i];
            t = tn;
        }
    }
}
#define P0_CONV_B0 161
__device__ __forceinline__ void phase0(const Params& p) {
    const int b = blockIdx.x, G = gridDim.x;
    if (G > P0_CONV_B0 + 32) {
        if (b < 64) ssm_table_item(p, b >> 1, b & 1);
        else if (b < 160) ada_item(p, b - 64);
        else if (b == 160) rope_item(p);
        else conv_range(p, b - P0_CONV_B0, G - P0_CONV_B0, N_CONV_EARLY);
    } else {
        const int NU = 64 + 96 + 1 + N_CONV_EARLY;
        for (int u = b; u < NU; u += G) {
            if (u < 64) ssm_table_item(p, u >> 1, u & 1);
            else if (u < 160) ada_item(p, u - 64);
            else if (u == 160) rope_item(p);
            else { ConvD d = conv_decode(p, u - 161); float v[16]; conv_load(p, d, v); conv_store(p, d, v); }
        }
    }
}
#if 0
    {
        {
            const int stride = G - P0_CONV_B0;
            int t = b - P0_CONV_B0;
            if (t < N_CONV) {
                ConvD d = conv_decode(p, t);
                float v[16];
                conv_load(p, d, v);
                while (t < N_CONV) {
                    const int tn = t + stride;
                    ConvD dn = d;
                    float vn[16];
                    if (tn < N_CONV) { dn = conv_decode(p, tn); conv_load(p, dn, vn); }
                    conv_store(p, d, v);
                    d = dn;
#pragma unroll
                    for (int i = 0; i < 16; ++i) v[i] = vn[i];
                    t = tn;
                }
            }
        }
    } else {
        const int NU = 64 + 96 + 1 + N_CONV;
        for (int u = b; u < NU; u += G) {
            if (u < 64) ssm_table_item(p, u >> 1, u & 1);
            else if (u < 160) ada_item(p, u - 64);
            else if (u == 160) rope_item(p);
            else { ConvD d = conv_decode(p, u - 161); float v[16]; conv_load(p, d, v); conv_store(p, d, v); }
        }
    }
}

#endif

__device__ __forceinline__ void norm_mod_row(const float* src, const float* gain, const float* sh, const float* scl, u16* dst) {
    const int lane = TIDX & 63;
    float4 v[4];
    float ss = 0.f;
#pragma unroll
    for (int i = 0; i < 4; ++i) {
        v[i] = *(const float4*)(src + i * 256 + lane * 4);
        ss += v[i].x * v[i].x + v[i].y * v[i].y + v[i].z * v[i].z + v[i].w * v[i].w;
    }
    ss = wave_sum(ss);
    const float rs = rsqrtf(ss * (1.f / 1024.f) + EPS);
#pragma unroll
    for (int i = 0; i < 4; ++i) {
        const int c0 = i * 256 + lane * 4;
        const float4 g = *(const float4*)(gain + c0), s = *(const float4*)(sh + c0), k = *(const float4*)(scl + c0);
        const float a = v[i].x * rs * g.x * (1.f + k.x) + s.x, b = v[i].y * rs * g.y * (1.f + k.y) + s.y;
        const float c = v[i].z * rs * g.z * (1.f + k.z) + s.z, d = v[i].w * rs * g.w * (1.f + k.w) + s.w;
        *(uint2*)(dst + c0) = make_uint2(pack2(a, b), pack2(c, d));
    }
}

__device__ __forceinline__ void phase1(const Params& p) {
    for (int g = blockIdx.x; g < 32; g += gridDim.x) ssm_toeplitz_item(p, g);
    const int wv = blockIdx.x * 4 + (TIDX >> 6), nwv = gridDim.x * 4;
    const int lane = TIDX & 63;
    for (int r0 = wv * 3; r0 < NROWS; r0 += nwv * 3) {
        const float* src[3]; const float* md[3];
        float4 v[3][4];
#pragma unroll
        for (int q = 0; q < 3; ++q) {
            const int r = r0 + q;
            if (r < NLAT) { src[q] = p.x + (size_t)r * 1024; md[q] = WSP_mod + (r >> 11) * 6144; }
            else { src[q] = p.ctx + (size_t)(r - NLAT) * 1024; md[q] = WSP_mod + 8 * 6144; }
#pragma unroll
            for (int i = 0; i < 4; ++i) v[q][i] = *(const float4*)(src[q] + i * 256 + lane * 4);
        }
#pragma unroll
        for (int q = 0; q < 3; ++q) {
            float ss = 0.f;
#pragma unroll
            for (int i = 0; i < 4; ++i) ss += v[q][i].x * v[q][i].x + v[q][i].y * v[q][i].y + v[q][i].z * v[q][i].z + v[q][i].w * v[q][i].w;
            ss = wave_sum(ss);
            const float rs = rsqrtf(ss * (1.f / 1024.f) + EPS);
            u16* dst = WSP_Hb + (size_t)(r0 + q) * 1024;
#pragma unroll
            for (int i = 0; i < 4; ++i) {
                const int c0 = i * 256 + lane * 4;
                const float4 g = *(const float4*)(p.norm_mix + c0), s = *(const float4*)(md[q] + c0), k = *(const float4*)(md[q] + 1024 + c0);
                const float a = v[q][i].x * rs * g.x * (1.f + k.x) + s.x, b = v[q][i].y * rs * g.y * (1.f + k.y) + s.y;
                const float c = v[q][i].z * rs * g.z * (1.f + k.z) + s.z, d = v[q][i].w * rs * g.w * (1.f + k.w) + s.w;
                *(uint2*)(dst + c0) = make_uint2(pack2(a, b), pack2(c, d));
            }
        }
    }
}

__device__ __forceinline__ void phase2(const Params& p) {
    const int NU = 128 * 10 + 16 * 6;
    const int lane = TIDX & 63, wid = TIDX >> 6, wr = wid >> 1, wc = wid & 1, fr = lane & 15, fq = lane >> 4;
    for (int u = blockIdx.x; u < NU; u += gridDim.x) {
        int mt, nt;
        if (u < 1280) { mt = u / 10; nt = u % 10; } else { const int v = u - 1280; mt = 128 + v / 6; nt = 4 + v % 6; }
        const u16* A = WSP_Hb + (size_t)mt * 128 * 1024;
        const u16* B = WSP_WinT + (size_t)nt * 128 * 1024;
        f32x4 acc[4][4];
        gemm_tile(16,
            [&](int R, int C, int kt) { return (const void*)(A + (size_t)R * 1024 + kt * 64 + C); },
            [&](int R, int C, int kt) { return (const void*)(B + (size_t)R * 1024 + kt * 64 + C); }, acc);
        const int row0 = mt * 128 + wr * 64;
        const int col0 = nt * 128 + wc * 64;
        const bool is_lat = mt < 128;
        if (nt == 5) {
            const int kvh = wc;
#pragma unroll
            for (int m = 0; m < 4; ++m) {
                const int r = row0 + m * 16 + fq * 4;
                int b, pos;
                if (is_lat) { b = r >> 11; pos = r & 2047; } else { const int rc = r - NLAT; b = rc >> 8; pos = SEQ + (rc & 255); }
#pragma unroll
                for (int n = 0; n < 4; ++n) {
                    const int d = n * 16 + fr;
                    u16* dst = WSP_Vt + ((size_t)(b * 2 + kvh) * 64 + d) * VT_LD + pos;
                    *(uint2*)dst = make_uint2(pack2(acc[m][n][0], acc[m][n][1]), pack2(acc[m][n][2], acc[m][n][3]));
                }
            }
        } else {
            float v[4][4][4];
            const bool do_rope = is_lat && nt <= 4;
#pragma unroll
            for (int m = 0; m < 4; ++m)
#pragma unroll
                for (int j = 0; j < 4; ++j) {
                    if (do_rope) {
                        const int r = row0 + m * 16 + fq * 4 + j, pos = r & 2047;
                        const float2 cr = WSP_rope[(pos >> 6) * 16 + fr], cc = WSP_rope[(pos & 63) * 16 + fr];
                        const float x1 = acc[m][0][j], x2 = acc[m][1][j], y1 = acc[m][2][j], y2 = acc[m][3][j];
                        v[m][0][j] = x1 * cr.x - x2 * cr.y; v[m][1][j] = x1 * cr.y + x2 * cr.x;
                        v[m][2][j] = y1 * cc.x - y2 * cc.y; v[m][3][j] = y1 * cc.y + y2 * cc.x;
                    } else {
#pragma unroll
                        for (int n = 0; n < 4; ++n) v[m][n][j] = acc[m][n][j];
                    }
                }
            u16* dbase; int ldd;
            if (nt < 4) { dbase = WSP_Q + (size_t)row0 * 512 + col0; ldd = 512; }
            else if (nt == 4) { dbase = WSP_Kb + (size_t)row0 * 128 + (col0 - 512); ldd = 128; }
            else { dbase = WSP_U + (size_t)row0 * 512 + (col0 - 768); ldd = 512; }
            wave_store_bf16(v, [&](int row) { return dbase + (size_t)row * ldd; });
        }
    }
}

__device__ __forceinline__ void attn_unit(const Params& p, int u) {
    const int h = u & 7, qb = (u >> 3) & 15, b = u >> 7, kvh = h >> 2;
    const int tid = TIDX, lane = tid & 63, wid = tid >> 6, fr = lane & 15, fq = lane >> 4;
    const int sb = lane * 16, swz = sb ^ (((sb >> 9) & 1) << 5);
    const int r_in = swz >> 6, c_in = (swz & 63) >> 1;
    const int jstart = qb == 0 ? 2 : 0, jend = qb == 15 ? 4 : 6, nb = jend - jstart, ntile = nb + 4;
    const float SC = 0.125f * 1.4426950408889634f;
    bf16x8 qf[2][2];
    const int qrow0 = b * SEQ + qb * 128 + wid * 32;
#pragma unroll
    for (int qt = 0; qt < 2; ++qt)
#pragma unroll
        for (int ks = 0; ks < 2; ++ks)
            qf[qt][ks] = *(const bf16x8*)(WSP_Q + (size_t)(qrow0 + qt * 16 + fr) * 512 + h * 64 + ks * 32 + fq * 8);
    f32x4 o[4][2];
#pragma unroll
    for (int dt = 0; dt < 4; ++dt)
#pragma unroll
        for (int qt = 0; qt < 2; ++qt) o[dt][qt] = (f32x4){0.f, 0.f, 0.f, 0.f};
    float mrun[2], lrun[2];
    const float sinkv = p.attn_sink[h] * 1.4426950408889634f;
    mrun[0] = mrun[1] = sinkv;
    lrun[0] = lrun[1] = (fq == 0) ? 1.f : 0.f;
    __syncthreads();
    auto stage = [&](int i, int s) {
        const u16* kbase; const u16* vbase;
        if (i < nb) {
            const int ks0 = qb * 128 - 128 + 64 * (jstart + i);
            kbase = WSP_Kb + (size_t)(b * SEQ + ks0) * 128 + kvh * 64;
            vbase = WSP_Vt + (size_t)(b * 2 + kvh) * 64 * VT_LD + ks0;
        } else {
            const int c0 = 64 * (i - nb);
            kbase = WSP_Kb + (size_t)(NLAT + b * CTXL + c0) * 128 + kvh * 64;
            vbase = WSP_Vt + (size_t)(b * 2 + kvh) * 64 * VT_LD + SEQ + c0;
        }
        char* sk = smem + s * 16384;
        char* sv = sk + 8192;
#pragma unroll
        for (int it = 0; it < 2; ++it) {
            const int st = wid + 4 * it, R = (st >> 1) * 16 + r_in, C = (st & 1) * 32 + c_in;
            glds16(kbase + (size_t)R * 128 + C, sk + tid * 16 + it * 4096);
            glds16(vbase + (size_t)R * VT_LD + C, sv + tid * 16 + it * 4096);
        }
    };
    stage(0, 0);
    for (int i = 0; i < ntile; ++i) {
        asm volatile("s_waitcnt vmcnt(0)" ::: "memory");
        __syncthreads();
        if (i + 1 < ntile) stage(i + 1, (i + 1) & 1);
        const char* sk = smem + (i & 1) * 16384;
        const char* sv = sk + 8192;
        f32x4 s[4][2];
#pragma unroll
        for (int kt = 0; kt < 4; ++kt)
#pragma unroll
            for (int qt = 0; qt < 2; ++qt) s[kt][qt] = (f32x4){0.f, 0.f, 0.f, 0.f};
#pragma unroll
        for (int ks = 0; ks < 2; ++ks)
#pragma unroll
            for (int kt = 0; kt < 4; ++kt) {
                const bf16x8 kf = *(const bf16x8*)(sk + lds_byte(kt * 16 + fr, ks * 32 + fq * 8));
#pragma unroll
                for (int qt = 0; qt < 2; ++qt) s[kt][qt] = __builtin_amdgcn_mfma_f32_16x16x32_bf16(kf, qf[qt][ks], s[kt][qt], 0, 0, 0);
            }
        const int ks0 = qb * 128 - 128 + 64 * (jstart + i);
        const int qlo = qb * 128 + wid * 32;
        const bool band = (i < nb) && ((qlo + 31 - ks0 > 128) || (ks0 + 63 - qlo > 128));
        bf16x8 pf[2][2];
#pragma unroll
        for (int qt = 0; qt < 2; ++qt) {
            const int qp = qb * 128 + wid * 32 + qt * 16 + fr;
            float mx = -1e30f;
#pragma unroll
            for (int kt = 0; kt < 4; ++kt)
#pragma unroll
                for (int j = 0; j < 4; ++j) {
                    float v = s[kt][qt][j] * SC;
                    if (band) {
                        const int kp = ks0 + kt * 16 + fq * 4 + j, d = qp - kp;
                        if (d > 128 || d < -128) v = -1e30f;
                    }
                    s[kt][qt][j] = v;
                    mx = fmaxf(mx, v);
                }
            mx = fmaxf(mx, __shfl_xor(mx, 16));
            mx = fmaxf(mx, __shfl_xor(mx, 32));
            const float mnew = fmaxf(mrun[qt], mx);
            const float alpha = __builtin_amdgcn_exp2f(mrun[qt] - mnew);
            mrun[qt] = mnew;
            float ls = 0.f;
#pragma unroll
            for (int kt = 0; kt < 4; ++kt)
#pragma unroll
                for (int j = 0; j < 4; ++j) {
                    const float pv = __builtin_amdgcn_exp2f(s[kt][qt][j] - mnew);
                    s[kt][qt][j] = pv;
                    ls += pv;
                }
            lrun[qt] = lrun[qt] * alpha + ls;
#pragma unroll
            for (int dt = 0; dt < 4; ++dt) o[dt][qt] *= alpha;
#pragma unroll
            for (int k2 = 0; k2 < 2; ++k2) {
                bf16x8 t;
#pragma unroll
                for (int j = 0; j < 4; ++j) { t[j] = (short)f2bf(s[2 * k2][qt][j]); t[4 + j] = (short)f2bf(s[2 * k2 + 1][qt][j]); }
                pf[qt][k2] = t;
            }
        }
#pragma unroll
        for (int k2 = 0; k2 < 2; ++k2)
#pragma unroll
            for (int dt = 0; dt < 4; ++dt) {
                const uint2 lo = *(const uint2*)(sv + lds_byte(dt * 16 + fr, k2 * 32 + fq * 4));
                const uint2 hi = *(const uint2*)(sv + lds_byte(dt * 16 + fr, k2 * 32 + 16 + fq * 4));
                union { uint4 u; bf16x8 v; } cv; cv.u = make_uint4(lo.x, lo.y, hi.x, hi.y);
#pragma unroll
                for (int qt = 0; qt < 2; ++qt) o[dt][qt] = __builtin_amdgcn_mfma_f32_16x16x32_bf16(cv.v, pf[qt][k2], o[dt][qt], 0, 0, 0);
            }
    }
#pragma unroll
    for (int qt = 0; qt < 2; ++qt) {
        float l = lrun[qt];
        l += __shfl_xor(l, 16);
        l += __shfl_xor(l, 32);
        const float inv = 1.f / l;
        u16* dst = WSP_AO + (size_t)(qrow0 + qt * 16 + fr) * 512 + h * 64 + fq * 4;
        float sq = 0.f;
#pragma unroll
        for (int dt = 0; dt < 4; ++dt) {
            const unsigned w0 = pack2(o[dt][qt][0] * inv, o[dt][qt][1] * inv), w1 = pack2(o[dt][qt][2] * inv, o[dt][qt][3] * inv);
            *(uint2*)(dst + dt * 16) = make_uint2(w0, w1);
            const float a = bf2f((u16)(w0 & 0xffffu)), b = bf2f((u16)(w0 >> 16)), c = bf2f((u16)(w1 & 0xffffu)), d = bf2f((u16)(w1 >> 16));
            sq += a * a + b * b + c * c + d * d;
        }
        sq += __shfl_xor(sq, 16);
        sq += __shfl_xor(sq, 32);
        if (fq == 0) unsafeAtomicAdd(WSP_rsq + (size_t)(qrow0 + qt * 16 + fr) * 2, sq);
    }
}

__device__ __forceinline__ void ssm_s1_unit(const Params& p, int u) {
    const int ct = u % 9, mh = (u / 9) & 1, g = u / 18;
    const int lane = TIDX & 63, wid = TIDX >> 6, wr = wid >> 1, wc = wid & 1, fr = lane & 15, fq = lane >> 4;
    const u16* A = WSP_TabS + ((size_t)g * 256 + mh * 128) * 256;
    const u16* Ub = WSP_U + (size_t)ct * 128 * 16 * 512 + g * 16;
    f32x4 acc[4][4];
    gemm_tile(4,
        [&](int R, int C, int kt) { return (const void*)(A + (size_t)R * 256 + kt * 64 + C); },
        [&](int R, int C, int kt) { return (const void*)(Ub + (size_t)(R * 16 + kt * 4 + (C >> 4)) * 512 + (C & 15)); }, acc);
#pragma unroll
    for (int m = 0; m < 4; ++m)
#pragma unroll
        for (int n = 0; n < 4; ++n) {
            const int rho = mh * 128 + wr * 64 + m * 16 + fq * 4;
            const int cg = ct * 128 + wc * 64 + n * 16 + fr;
            *(f32x4*)(WSP_S + ((size_t)cg * 32 + g) * 256 + rho) = acc[m][n];
        }
}

__device__ __forceinline__ void phase3(const Params& p) {
    const int NU = 1024 + 576;
    for (int u = blockIdx.x; u < NU; u += gridDim.x) {
        if (u < 1024) attn_unit(p, u); else ssm_s1_unit(p, u - 1024);
    }
}

__device__ __forceinline__ void phase4(const Params& p) {
    if ((int)gridDim.x > 160) { if ((int)blockIdx.x >= 128) { conv_range(p, blockIdx.x - 128, gridDim.x - 128, N_CONV, N_CONV_EARLY); return; } }
    else conv_range(p, blockIdx.x, gridDim.x, N_CONV, N_CONV_EARLY);
    const int gid = blockIdx.x * NTHR + TIDX;
    if (gid >= BATCH * 2 * 32 * 64) return;
    const int n = gid & 63, g = (gid >> 6) & 31, dir = (gid >> 11) & 1, b = gid >> 12;
    const int pidx = dir * 32 + g;
    const float dt = __expf(p.log_dt[pidx]);
    const float are = p.a_re[pidx * 64 + n], aim = p.a_im[pidx * 64 + n];
    const float mag = __expf(16.f * dt * are);
    float rev = 16.f * (dt * aim * 0.15915494309189535f);
    rev -= rintf(rev);
    const float ar = mag * __builtin_amdgcn_cosf(rev), ai = mag * __builtin_amdgcn_sinf(rev);
    float hr = 0.f, hi = 0.f;
    const size_t so = (size_t)g * 256 + dir * 128 + n;
#pragma unroll 8
    for (int i = 0; i < 16; ++i) {
        const int c = dir == 0 ? i : 15 - i;
        const float* sp = WSP_S + (size_t)(NCHUNK_LAT + b * 16 + c) * 8192 + so;
        const float sr = sp[0], si = sp[64];
        const float nr = ar * hr - ai * hi + sr, ni = ar * hi + ai * hr + si;
        hr = nr; hi = ni;
    }
#pragma unroll 8
    for (int i = 0; i < 128; ++i) {
        const int c = dir == 0 ? i : 127 - i;
        const size_t cg = (size_t)b * 128 + c;
        const float* sp = WSP_S + cg * 8192 + so;
        const float sr = sp[0], si = sp[64];
        u16* hp = WSP_Hin + cg * 8192 + so;
        hp[0] = f2bf(hr); hp[64] = f2bf(hi);
        const float nr = ar * hr - ai * hi + sr, ni = ar * hi + ai * hr + si;
        hr = nr; hi = ni;
    }
}

__device__ __forceinline__ void phase5(const Params& p) {
    const int NU = 512;
    const int lane = TIDX & 63, wid = TIDX >> 6, wr = wid >> 1, wc = wid & 1, fr = lane & 15, fq = lane >> 4;
    for (int u = blockIdx.x; u < NU; u += gridDim.x) {
        const int ct = u & 7, mh = (u >> 3) & 1, g = u >> 4;
        const u16* A = WSP_TabY + ((size_t)g * 256 + mh * 128) * 512;
        const u16* Ub = WSP_U + (size_t)ct * 128 * 16 * 512 + g * 16;
        const u16* Hb_ = WSP_Hin + (size_t)ct * 128 * 8192 + g * 256;
        f32x4 acc[4][4];
        gemm_tile(8,
            [&](int R, int C, int kt) { return (const void*)(A + (size_t)R * 512 + kt * 64 + C); },
            [&](int R, int C, int kt) {
                return kt < 4 ? (const void*)(Ub + (size_t)(R * 16 + kt * 4 + (C >> 4)) * 512 + (C & 15))
                              : (const void*)(Hb_ + (size_t)R * 8192 + (kt - 4) * 64 + C);
            }, acc);
#pragma unroll
        for (int m = 0; m < 4; ++m)
#pragma unroll
            for (int n = 0; n < 4; ++n) {
                const int t = mh * 8 + wr * 4 + m;
                const int cg = ct * 128 + wc * 64 + n * 16 + fr;
                u16* dst = WSP_Y + ((size_t)cg * 16 + t) * 512 + g * 16 + fq * 4;
                *(uint2*)dst = make_uint2(pack2(gelu_tanh(acc[m][n][0]), gelu_tanh(acc[m][n][1])),
                                          pack2(gelu_tanh(acc[m][n][2]), gelu_tanh(acc[m][n][3])));
            }
    }
}

__device__ __forceinline__ void phase6(const Params& p) {
    const int NU = 512;
    const int lane = TIDX & 63, wid = TIDX >> 6, wr = wid >> 1, wc = wid & 1, fr = lane & 15, fq = lane >> 4;
    for (int u = blockIdx.x; u < NU; u += gridDim.x) {
        const int mt = u >> 2, nt = u & 3;
        const u16* A = WSP_Y + (size_t)mt * 128 * 512;
        const u16* B = WSP_WgluT + (size_t)nt * 128 * 512;
        f32x4 acc[4][4];
        gemm_tile(8,
            [&](int R, int C, int kt) { return (const void*)(A + (size_t)R * 512 + kt * 64 + C); },
            [&](int R, int C, int kt) { return (const void*)(B + (size_t)R * 512 + kt * 64 + C); }, acc);
        const int row0 = mt * 128 + wr * 64, col0 = nt * 128 + wc * 64;
        char* base = smem + wid * 9216;
        float bg[4];
#pragma unroll
        for (int n = 0; n < 4; ++n) bg[n] = p.b_glu[col0 + n * 16 + fr];
#pragma unroll
        for (int m = 0; m < 4; ++m)
#pragma unroll
            for (int j = 0; j < 4; ++j) {
                const int rl = m * 16 + fq * 4 + j, r = row0 + rl;
                float sq = 0.f;
#pragma unroll
                for (int n = 0; n < 4; ++n) {
                    const int c = col0 + n * 16 + fr;
                    const float yv = bf2f(WSP_Y[(size_t)r * 512 + c]);
                    const u16 ob = f2bf(yv * sigmoidf_(acc[m][n][j] + bg[n]));
                    *(u16*)(base + rl * 144 + (n * 16 + fr) * 2) = ob;
                    const float of = bf2f(ob);
                    sq += of * of;
                }
                sq += __shfl_xor(sq, 1); sq += __shfl_xor(sq, 2); sq += __shfl_xor(sq, 4); sq += __shfl_xor(sq, 8);
                if (fr == 0) unsafeAtomicAdd(WSP_rsq + (size_t)r * 2 + 1, sq);
            }
        asm volatile("s_waitcnt lgkmcnt(0)" ::: "memory");
        __builtin_amdgcn_wave_barrier();
        u16* dbase = WSP_SO + (size_t)row0 * 512 + col0;
#pragma unroll
        for (int i = 0; i < 8; ++i) {
            const int id = i * 64 + lane, row = id >> 3, ch = id & 7;
            *(uint4*)(dbase + (size_t)row * 512 + ch * 8) = *(const uint4*)(base + row * 144 + ch * 16);
        }
        asm volatile("s_waitcnt lgkmcnt(0)" ::: "memory");
        __builtin_amdgcn_wave_barrier();
    }
}

__device__ __forceinline__ void phase7(const Params& p) {
    const int lane = TIDX & 63;
    const int wv = blockIdx.x * 4 + (TIDX >> 6), nwv = gridDim.x * 4;
    for (int it = wv; it < NLAT * 2; it += nwv) {
        const int r = it >> 1, half = it & 1;
        const u16* src = (half ? WSP_SO : WSP_AO) + (size_t)r * 512 + lane * 8;
        const float* gain = (half ? p.norm_ssm_out : p.norm_attn_out) + lane * 8;
        const uint4 d = *(const uint4*)src;
        float f[8];
        f[0] = bf2f((u16)(d.x & 0xffff)); f[1] = bf2f((u16)(d.x >> 16));
        f[2] = bf2f((u16)(d.y & 0xffff)); f[3] = bf2f((u16)(d.y >> 16));
        f[4] = bf2f((u16)(d.z & 0xffff)); f[5] = bf2f((u16)(d.z >> 16));
        f[6] = bf2f((u16)(d.w & 0xffff)); f[7] = bf2f((u16)(d.w >> 16));
        float ss = 0.f;
#pragma unroll
        for (int i = 0; i < 8; ++i) ss += f[i] * f[i];
        ss = wave_sum(ss);
        const float rs = rsqrtf(ss * (1.f / 512.f) + EPS);
        const float4 g0 = *(const float4*)gain, g1 = *(const float4*)(gain + 4);
        *(uint4*)(WSP_CAT + (size_t)r * 1024 + half * 512 + lane * 8) =
            make_uint4(pack2(f[0] * rs * g0.x, f[1] * rs * g0.y), pack2(f[2] * rs * g0.z, f[3] * rs * g0.w),
                       pack2(f[4] * rs * g1.x, f[5] * rs * g1.y), pack2(f[6] * rs * g1.z, f[7] * rs * g1.w));
    }
}

__device__ __forceinline__ void phase8(const Params& p) {
    const int NU = 512;
    for (int u = blockIdx.x; u < NU; u += gridDim.x) {
        const int mt = u >> 2, nt = u & 3;
        const u16* A1 = WSP_AO + (size_t)mt * 128 * 512;
        const u16* A2 = WSP_SO + (size_t)mt * 128 * 512;
        const u16* B = WSP_WoutT + (size_t)nt * 256 * 1024;
        f32x4 acc[4][8];
        {
        const int tid1 = TIDX, fq = (tid1 & 63) >> 4, row0 = mt * 128 + (tid1 >> 7) * 64;
        gemm_tile_w(32,
            [&](int i, int R, int C, int kt) { return (const void*)((kt < 16 ? A1 : A2) + (size_t)R * 512 + (kt & 15) * 32 + C); },
            [&](int i, int R, int C, int kt) { return (const void*)(B + (size_t)R * 1024 + kt * 32 + C); }, acc,
            [&](int kt) {
                if (kt == 16) {
#pragma unroll
                    for (int m = 0; m < 4; ++m) {
                        asm volatile("" ::: "memory");
#pragma unroll
                        for (int j = 0; j < 4; ++j) {
                            const float2 q = *(const float2*)(WSP_rsq + (size_t)(row0 + m * 16 + fq * 4 + j) * 2);
                            const float ratio = rsqrtf(q.x * (1.f / 512.f) + EPS) / rsqrtf(q.y * (1.f / 512.f) + EPS);
#pragma unroll
                            for (int n = 0; n < 8; ++n) acc[m][n][j] *= ratio;
                        }
                    }
                }
            });
        }
        const int tid2 = TIDX, lane = tid2 & 63, wid = tid2 >> 6, fr = lane & 15, fq = lane >> 4;
        const int row0 = mt * 128 + (wid >> 1) * 64, col0 = nt * 256 + (wid & 1) * 128;
        const float* g1 = WSP_mod + (mt >> 4) * 6144 + 2048 + col0;
        float* stg = (float*)(smem + wid * 8448);
#pragma unroll
        for (int m = 0; m < 4; ++m) {
#pragma unroll
            for (int n = 0; n < 8; ++n)
#pragma unroll
                for (int j = 0; j < 4; ++j) stg[(fq * 4 + j) * 132 + n * 16 + fr] = acc[m][n][j];
            asm volatile("s_waitcnt lgkmcnt(0)" ::: "memory");
            __builtin_amdgcn_wave_barrier();
#pragma unroll
            for (int i = 0; i < 8; ++i) {
                const int id = i * 64 + lane, rr = id >> 5, c4 = (id & 31) * 4;
                float4 v = *(const float4*)(stg + rr * 132 + c4);
                const float rsv = rsqrtf(WSP_rsq[(size_t)(row0 + m * 16 + rr) * 2 + 1] * (1.f / 512.f) + EPS);
                v.x *= rsv; v.y *= rsv; v.z *= rsv; v.w *= rsv;
                const float4 g = *(const float4*)(g1 + c4);
                const size_t o = (size_t)(row0 + m * 16 + rr) * 1024 + col0 + c4;
                const float4 xv = *(const float4*)(p.x + o);
                *(float4*)(p.out + o) = make_float4(xv.x + g.x * v.x, xv.y + g.y * v.y, xv.z + g.z * v.z, xv.w + g.w * v.w);
            }
            asm volatile("s_waitcnt lgkmcnt(0)" ::: "memory");
            __builtin_amdgcn_wave_barrier();
        }
    }
}

#define CTR_ECNT 0
#define CTR_Q11 128
#define CTR_Q12 136
#define HALF_TOK 8192
#define HH_HALF_ROWS 73728
#define ELIST_CAP 8192
__device__ __forceinline__ void phase9(const Params& p) {
    const int tid = TIDX, lane = tid & 63, wid = tid >> 6, fr = lane & 15, fq = lane >> 4;
    char* At = smem;
    float* sc = (float*)(smem + 32768);
    int* hist = (int*)(smem + 32768 + 4096);
    int* gbase = hist + 64;
    int* fill = gbase + 64;
    unsigned char* selk = (unsigned char*)(fill + 64);
    for (int chunk = blockIdx.x; chunk < NLAT / 32; chunk += gridDim.x) {
        __syncthreads();
        if (tid < 64) hist[tid] = 0;
        for (int grp = 0; grp < 2; ++grp) {
            const int tok0 = chunk * 32 + grp * 16;
            __syncthreads();
            float4 vall[4][4];
#pragma unroll
            for (int rr = 0; rr < 4; ++rr)
#pragma unroll
                for (int i = 0; i < 4; ++i) vall[rr][i] = *(const float4*)(p.out + (size_t)(tok0 + wid * 4 + rr) * 1024 + i * 256 + lane * 4);
#pragma unroll
            for (int rr = 0; rr < 4; ++rr) {
                const int row = wid * 4 + rr, tok = tok0 + row;
                const float* md = WSP_mod + (tok >> 11) * 6144;
                float4 v[4];
                float ss = 0.f;
#pragma unroll
                for (int i = 0; i < 4; ++i) {
                    v[i] = vall[rr][i];
                    ss += v[i].x * v[i].x + v[i].y * v[i].y + v[i].z * v[i].z + v[i].w * v[i].w;
                }
                ss = wave_sum(ss);
                const float rs = rsqrtf(ss * (1.f / 1024.f) + EPS);
#pragma unroll
                for (int i = 0; i < 4; ++i) {
                    const int c0 = i * 256 + lane * 4;
                    const float4 g = *(const float4*)(p.norm_ffn + c0), s = *(const float4*)(md + 3072 + c0), k = *(const float4*)(md + 4096 + c0);
                    const float a = v[i].x * rs * g.x * (1.f + k.x) + s.x, b = v[i].y * rs * g.y * (1.f + k.y) + s.y;
                    const float c = v[i].z * rs * g.z * (1.f + k.z) + s.z, d = v[i].w * rs * g.w * (1.f + k.w) + s.w;
                    const uint2 pk = make_uint2(pack2(a, b), pack2(c, d));
                    *(uint2*)(WSP_H2 + (size_t)tok * 1024 + c0) = pk;
                    const int ch = c0 >> 3;
                    *(uint2*)(At + row * 2048 + ((ch ^ row) << 4) + ((c0 & 4) << 1)) = pk;
                }
            }
            __syncthreads();
            f32x4 acc = {0.f, 0.f, 0.f, 0.f};
            const u16* bp = WSP_WrT + (size_t)(wid * 16 + fr) * 1024 + fq * 8;
#pragma unroll
            for (int kb = 0; kb < 4; ++kb) {
                bf16x8 bfr[8];
#pragma unroll
                for (int q = 0; q < 8; ++q) bfr[q] = *(const bf16x8*)(bp + (kb * 8 + q) * 32);
#pragma unroll
                for (int q = 0; q < 8; ++q) {
                    const int ch = (kb * 8 + q) * 4 + fq;
                    const bf16x8 a = *(const bf16x8*)(At + fr * 2048 + ((ch ^ fr) << 4));
                    acc = __builtin_amdgcn_mfma_f32_16x16x32_bf16(a, bfr[q], acc, 0, 0, 0);
                }
            }
#pragma unroll
            for (int j = 0; j < 4; ++j) sc[(fq * 4 + j) * 64 + wid * 16 + fr] = sigmoidf_(acc[j]);
            __syncthreads();
            const float bias = p.router_bias[lane];
            const int eg = lane >> 3;
            for (int rr = 0; rr < 4; ++rr) {
                const int row = wid * 4 + rr, tok = tok0 + row;
                const float s = sc[row * 64 + lane];
                const float bz = s + bias;
                float m1 = bz;
                m1 = fmaxf(m1, __shfl_xor(m1, 1)); m1 = fmaxf(m1, __shfl_xor(m1, 2)); m1 = fmaxf(m1, __shfl_xor(m1, 4));
                const unsigned long long eq = __ballot(bz == m1);
                const unsigned gb = (unsigned)((eq >> (eg * 8)) & 0xffull);
                const int first = __ffs(gb) - 1;
                float v2 = ((lane & 7) == first) ? -1e30f : bz;
                v2 = fmaxf(v2, __shfl_xor(v2, 1)); v2 = fmaxf(v2, __shfl_xor(v2, 2)); v2 = fmaxf(v2, __shfl_xor(v2, 4));
                const float gs = m1 + v2;
                int cnt = 0;
#pragma unroll
                for (int j = 0; j < 8; ++j) {
                    const float gj = __int_as_float(__builtin_amdgcn_readlane(__float_as_int(gs), j * 8));
                    cnt += (gj > gs || (gj == gs && j < eg)) ? 1 : 0;
                }
                const bool gsel = cnt < 4;
                const float mv = gsel ? bz : -1e30f;
                int rank = 0;
#pragma unroll
                for (int j = 0; j < 64; ++j) {
                    const float vj = __int_as_float(__builtin_amdgcn_readlane(__float_as_int(mv), j));
                    rank += (vj > mv || (vj == mv && j < lane)) ? 1 : 0;
                }
                const bool sel = gsel && rank < 8;
                const float tot = wave_sum(sel ? s : 0.f);
                if (sel) {
                    WSP_WGT[(size_t)tok * 8 + rank] = s / tot * 2.5f;
                    selk[(grp * 16 + row) * 8 + rank] = (unsigned char)lane;
                    atomicAdd(&hist[lane], 1);
                }
            }
        }
        __syncthreads();
        const int h = (chunk * 32) >> 13;
        if (tid < 64) {
            gbase[tid] = hist[tid] ? (int)atomicAdd(&WSP_ctr[CTR_ECNT + h * 64 + tid], (unsigned)hist[tid]) : 0;
            fill[tid] = 0;
        }
        __syncthreads();
        {
            const int e = selk[tid];
            const int pos = atomicAdd(&fill[e], 1);
            WSP_elist[(size_t)(h * 64 + e) * ELIST_CAP + gbase[e] + pos] = (chunk * 32 + (tid >> 3)) * 8 + (tid & 7);
        }
    }
}

struct MoeTab { int cnt[16]; int soff[16]; int pre[17]; };

__device__ __forceinline__ void phase11(const Params& p) {
    const int tid = TIDX, lane = tid & 63, wid = tid >> 6, wr = wid >> 1, wc = wid & 1, fr = lane & 15, fq = lane >> 4;
    const int sb = lane * 16, swz = sb ^ (((sb >> 9) & 1) << 5);
    const int r_in = swz >> 6, c_in = (swz & 63) >> 1;
    int* tab = (int*)(smem + 73728);
    int* t_cnt = tab, *t_soff = tab + 16, *t_pre = tab + 32, *t_q = tab + 52;
    const int x = blockIdx.x & 7;
    __syncthreads();
    int* t_all = tab + 64;
    if (tid < 128) t_all[tid] = (int)WSP_ctr[CTR_ECNT + tid];
    if (tid == 0) t_q[0] = (int)atomicAdd(&WSP_ctr[CTR_Q11 + x], 1u);
    __syncthreads();
    if (tid < 16) {
        const int i = tid >> 1, h = tid & 1, e = x + 8 * i;
        t_cnt[tid] = t_all[h * 64 + e];
        int so = 0;
        for (int e2 = 0; e2 < e; ++e2) so += t_all[h * 64 + e2];
        t_soff[tid] = so;
    }
    __syncthreads();
    if (tid == 0) {
        int s = 0;
        for (int j = 0; j < 16; ++j) { t_pre[j] = s; s += (t_cnt[j] + 127) >> 7; }
        t_pre[16] = s;
    }
    __syncthreads();
    const int T_r = t_pre[16], T_all = T_r + 16;
    for (;;) {
        __syncthreads();
        const int u = __builtin_amdgcn_readfirstlane(t_q[0]);
        __syncthreads();
        if (u >= T_all) break;
        if (tid == 0) t_q[0] = (int)atomicAdd(&WSP_ctr[CTR_Q11 + x], 1u);
        int e, h, mt, c, rowbase;
        const int* el = nullptr;
        if (u < T_r) {
            int j = 0;
#pragma unroll
            for (int q = 1; q < 16; ++q) j += (u >= t_pre[q]) ? 1 : 0;
            e = x + 8 * (j >> 1); h = j & 1; mt = u - t_pre[j]; c = t_cnt[j];
            rowbase = h * HH_HALF_ROWS + t_soff[j];
            el = WSP_elist + (size_t)(h * 64 + e) * ELIST_CAP;
        } else {
            const int ms = x * 16 + (u - T_r);
            e = 64; h = ms >> 6; mt = ms & 63; c = HALF_TOK;
            rowbase = h * HH_HALF_ROWS + 65536;
        }
        e = __builtin_amdgcn_readfirstlane(e); h = __builtin_amdgcn_readfirstlane(h); mt = __builtin_amdgcn_readfirstlane(mt);
        c = __builtin_amdgcn_readfirstlane(c); rowbase = __builtin_amdgcn_readfirstlane(rowbase);
        if (e < 64) el = WSP_elist + (size_t)(h * 64 + e) * ELIST_CAP;
        const u16* aptr[2];
#pragma unroll
        for (int i = 0; i < 2; ++i) {
            int li = mt * 128 + (wid + 4 * i) * 16 + r_in;
            li = li < c ? li : c - 1;
            const int tok = (e < 64) ? (el[li] >> 3) : (h * HALF_TOK + li);
            aptr[i] = WSP_H2 + (size_t)tok * 1024 + c_in;
        }
        const u16* Bw = WSP_WguT + (size_t)e * 262144 + c_in;
        f32x4 acc[4][8];
        gemm_tile_w(32,
            [&](int i, int R, int C, int kt) { return (const void*)(aptr[i] + kt * 32); },
            [&](int i, int R, int C, int kt) { return (const void*)(Bw + (size_t)R * 1024 + kt * 32); }, acc);
        float wgt[4][4];
#pragma unroll
        for (int m = 0; m < 4; ++m)
#pragma unroll
            for (int j = 0; j < 4; ++j) {
                const int li = mt * 128 + wr * 64 + m * 16 + fq * 4 + j;
                float w = 1.f;
                if (e < 64) w = (li < c) ? WSP_WGT[el[li]] : 0.f;
                wgt[m][j] = w;
            }
        u16* dbase = WSP_HHs + ((size_t)rowbase + mt * 128 + wr * 64) * 128 + wc * 64;
        const int vrows = c - mt * 128 - wr * 64;
        wave_store_bf16_f([&](int m, int n2, int j) { return siluf_(acc[m][2 * n2][j]) * acc[m][2 * n2 + 1][j] * wgt[m][j]; },
                          [&](int row) { return row < vrows ? dbase + (size_t)row * 128 : (u16*)nullptr; });
    }
}

#define YD_SCALE 8.0f
template <class FV, class FD>
__device__ __forceinline__ void wave_store_fp8_f(FV val, FD dst) {
    const int lane = TIDX & 63, wid = TIDX >> 6, fr = lane & 15, fq = lane >> 4;
    char* base = smem + wid * 9216;
#pragma unroll
    for (int m = 0; m < 4; ++m)
#pragma unroll
        for (int n = 0; n < 8; ++n)
#pragma unroll
            for (int j = 0; j < 4; ++j)
                *(unsigned char*)(base + (m * 16 + fq * 4 + j) * 144 + n * 16 + fr) =
                    (unsigned char)(__builtin_amdgcn_cvt_pk_fp8_f32(val(m, n, j), 0.f, 0, false) & 0xff);
    asm volatile("s_waitcnt lgkmcnt(0)" ::: "memory");
    __builtin_amdgcn_wave_barrier();
#pragma unroll
    for (int i = 0; i < 8; ++i) {
        const int id = i * 64 + lane, row = id >> 3, ch = id & 7;
        const uint4 d = *(const uint4*)(base + row * 144 + ch * 16);
        unsigned char* q = dst(row);
        if (q) *(uint4*)(q + ch * 16) = d;
    }
    asm volatile("s_waitcnt lgkmcnt(0)" ::: "memory");
    __builtin_amdgcn_wave_barrier();
}

__device__ __forceinline__ void phase12a(const Params& p) {
    const int tid = TIDX, lane = tid & 63, wid = tid >> 6, wr = wid >> 1, wc = wid & 1;
    const int sb = lane * 16, swz = sb ^ (((sb >> 9) & 1) << 5);
    const int r_in = swz >> 6, c_in = (swz & 63) >> 1;
    int* tab = (int*)(smem + 73728);
    int* t_cnt = tab, *t_soff = tab + 16, *t_pre = tab + 32, *t_q = tab + 52;
    int* t_all = tab + 64;
    const int x = blockIdx.x & 7;
    __syncthreads();
    if (tid < 128) t_all[tid] = (int)WSP_ctr[CTR_ECNT + tid];
    if (tid == 0) t_q[0] = (int)atomicAdd(&WSP_ctr[CTR_Q12 + x], 1u);
    __syncthreads();
    if (tid < 16) {
        const int i = tid >> 1, h = tid & 1, e = x + 8 * i;
        t_cnt[tid] = t_all[h * 64 + e];
        int so = 0;
        for (int e2 = 0; e2 < e; ++e2) so += t_all[h * 64 + e2];
        t_soff[tid] = so;
    }
    __syncthreads();
    if (tid == 0) {
        int s = 0;
        for (int j = 0; j < 16; ++j) { t_pre[j] = s; s += (t_cnt[j] + 127) >> 7; }
        t_pre[16] = s;
    }
    __syncthreads();
    const int T_r = t_pre[16] * 4, T_all = T_r + 64;
    unsigned char* Yd8 = (unsigned char*)(p.ws + OFF_ARENA);
    for (;;) {
        __syncthreads();
        const int u = __builtin_amdgcn_readfirstlane(t_q[0]);
        __syncthreads();
        if (u >= T_all) break;
        if (tid == 0) t_q[0] = (int)atomicAdd(&WSP_ctr[CTR_Q12 + x], 1u);
        int e, h, mt, nt, c, rowbase;
        if (u < T_r) {
            const int um = u >> 2; nt = u & 3;
            int j = 0;
#pragma unroll
            for (int q = 1; q < 16; ++q) j += (um >= t_pre[q]) ? 1 : 0;
            e = x + 8 * (j >> 1); h = j & 1; mt = um - t_pre[j]; c = t_cnt[j];
            rowbase = h * HH_HALF_ROWS + t_soff[j];
        } else {
            const int us = u - T_r; nt = us & 3;
            const int ms = x * 16 + (us >> 2);
            e = 64; h = ms >> 6; mt = ms & 63; c = HALF_TOK; rowbase = h * HH_HALF_ROWS + 65536;
        }
        e = __builtin_amdgcn_readfirstlane(e); h = __builtin_amdgcn_readfirstlane(h); mt = __builtin_amdgcn_readfirstlane(mt);
        nt = __builtin_amdgcn_readfirstlane(nt); c = __builtin_amdgcn_readfirstlane(c); rowbase = __builtin_amdgcn_readfirstlane(rowbase);
        const int* el = WSP_elist + (size_t)(h * 64 + (e & 63)) * ELIST_CAP;
        const u16* aptr[2];
#pragma unroll
        for (int i = 0; i < 2; ++i) {
            int li = mt * 128 + (wid + 4 * i) * 16 + r_in;
            li = li < c ? li : c - 1;
            aptr[i] = WSP_HHs + ((size_t)rowbase + li) * 128 + c_in;
        }
        const u16* Bw = WSP_WdT + ((size_t)e * 1024 + nt * 256) * 128 + c_in;
        f32x4 acc[4][8];
        gemm_tile_w(4,
            [&](int i, int R, int C, int kt) { return (const void*)(aptr[i] + kt * 32); },
            [&](int i, int R, int C, int kt) { return (const void*)(Bw + (size_t)R * 128 + kt * 32); }, acc);
        const int vrows = c - mt * 128 - wr * 64;
        const int colo = nt * 256 + wc * 128;
        wave_store_fp8_f([&](int m, int n, int j) { return acc[m][n][j] * YD_SCALE; }, [&](int row) {
            if (row >= vrows) return (unsigned char*)nullptr;
            const int li = mt * 128 + wr * 64 + row;
            int tok, k;
            if (e < 64) { const int ent = el[li]; tok = ent >> 3; k = ent & 7; }
            else { tok = h * HALF_TOK + li; k = 8; }
            return Yd8 + ((size_t)tok * 9 + k) * 1024 + colo;
        });
    }
}

template <bool DUMMY>
__device__ __forceinline__ void phase12b_t(const Params& p) {
    const int lane = TIDX & 63;
    const int wv = blockIdx.x * 4 + (TIDX >> 6), nwv = gridDim.x * 4;
    const unsigned char* Yd8 = (const unsigned char*)(p.ws + OFF_ARENA);
    for (int tok = wv; tok < NLAT; tok += nwv) {
        float* row = p.out + (size_t)tok * 1024 + lane * 16;
        float* orow = DUMMY ? (float*)(p.ws + OFF_HHS) + (size_t)(tok & 8191) * 1024 + lane * 16 : row;
        const float* g2 = WSP_mod + (tok >> 11) * 6144 + 5120 + lane * 16;
        float s[16];
#pragma unroll
        for (int i = 0; i < 16; ++i) s[i] = 0.f;
        const unsigned char* yp = Yd8 + (size_t)tok * 9 * 1024 + lane * 16;
        uint4 yv[9];
#pragma unroll
        for (int k = 0; k < 9; ++k) yv[k] = *(const uint4*)(yp + k * 1024);
#pragma unroll
        for (int k = 0; k < 9; ++k) {
            const unsigned w[4] = {yv[k].x, yv[k].y, yv[k].z, yv[k].w};
#pragma unroll
            for (int i = 0; i < 4; ++i) {
                const auto lo = __builtin_amdgcn_cvt_pk_f32_fp8((int)w[i], false);
                const auto hi = __builtin_amdgcn_cvt_pk_f32_fp8((int)w[i], true);
                s[4 * i] += lo[0]; s[4 * i + 1] += lo[1]; s[4 * i + 2] += hi[0]; s[4 * i + 3] += hi[1];
            }
        }
        float ss = 0.f;
#pragma unroll
        for (int q = 0; q < 4; ++q) {
            const float4 xv = *(const float4*)(row + q * 4), gv = *(const float4*)(g2 + q * 4);
            s[4 * q] = xv.x + gv.x * (1.f / YD_SCALE) * s[4 * q]; s[4 * q + 1] = xv.y + gv.y * (1.f / YD_SCALE) * s[4 * q + 1];
            s[4 * q + 2] = xv.z + gv.z * (1.f / YD_SCALE) * s[4 * q + 2]; s[4 * q + 3] = xv.w + gv.w * (1.f / YD_SCALE) * s[4 * q + 3];
            ss += s[4 * q] * s[4 * q] + s[4 * q + 1] * s[4 * q + 1] + s[4 * q + 2] * s[4 * q + 2] + s[4 * q + 3] * s[4 * q + 3];
        }
        ss = wave_sum(ss);
        const float rs = rsqrtf(ss * (1.f / 1024.f) + EPS);
#pragma unroll
        for (int q = 0; q < 4; ++q) {
            const float4 g = *(const float4*)(p.norm_final + lane * 16 + q * 4);
            *(float4*)(orow + q * 4) = make_float4(s[4 * q] * rs * g.x, s[4 * q + 1] * rs * g.y, s[4 * q + 2] * rs * g.z, s[4 * q + 3] * rs * g.w);
        }
    }
}

#define SMEM_TOTAL (73728 + 1024 + 64)

#if 1
__global__ void __launch_bounds__(NTHR, 2) k_mega(Params p) {
    volatile LAS unsigned* st = (volatile LAS unsigned*)(smem + SMEM_TOTAL - 16);
    if (TIDX == 0) { st[0] = 0u; st[1] = 0u; st[2] = 0u; st[3] = 0u; }
    __syncthreads();
    XcdBarrier bar = xcd_barrier_post(WSP_bar, st);
#define RUNP(N) do { phase##N(p); if (PROBE_DUP == N) phase##N(p); } while (0)
    RUNP(0);  xcd_barrier(bar);
    RUNP(1);  xcd_barrier(bar);
    RUNP(2);  xcd_barrier(bar);
    RUNP(3);  xcd_barrier(bar);
    RUNP(4);  xcd_barrier(bar);
    RUNP(5);  xcd_barrier(bar);
    RUNP(6);  xcd_barrier(bar);
    RUNP(8);  xcd_barrier(bar);
    phase9(p); xcd_barrier(bar);
#if PROBE_DUP == 9
    if (blockIdx.x == 0 && TIDX < 128) WSP_ctr[CTR_ECNT + TIDX] = 0u;
    xcd_barrier(bar); phase9(p); xcd_barrier(bar);
#endif
    phase11(p); xcd_barrier(bar);
#if PROBE_DUP == 11
    if (blockIdx.x == 0 && TIDX < 8) WSP_ctr[CTR_Q11 + TIDX] = 0u;
    xcd_barrier(bar); phase11(p); xcd_barrier(bar);
#endif
    phase12a(p); xcd_barrier(bar);
#if PROBE_DUP == 120
    if (blockIdx.x == 0 && TIDX < 8) WSP_ctr[CTR_Q12 + TIDX] = 0u;
    xcd_barrier(bar); phase12a(p); xcd_barrier(bar);
#endif
#if PROBE_DUP == 121
    phase12b_t<true>(p); xcd_barrier(bar);
#endif
    phase12b_t<false>(p);
}
#endif


extern "C" void kernel_launch(void* const* d_in, const int* in_sizes, int n_in,
                              void* d_out, int out_size, void* d_ws, size_t ws_size,
                              hipStream_t stream) {
    Params p{};
    const float** ip = (const float**)&p.x;
    for (int i = 0; i < 32; ++i) ip[i] = (const float*)d_in[i];
    p.out = (float*)d_out;
    p.ws = (char*)d_ws;
    if (OFF_END > ws_size) { fprintf(stderr, "workspace too small: need %zu have %zu\n", (size_t)OFF_END, ws_size); return; }

    static int grid = 0;
    if (!grid) {
        hipFuncSetAttribute((const void*)k_mega, hipFuncAttributeMaxDynamicSharedMemorySize, SMEM_TOTAL);
        int dev = 0, cus = 0, per_cu = 0;
        hipGetDevice(&dev);
        hipDeviceGetAttribute(&cus, hipDeviceAttributeMultiprocessorCount, dev);
        hipOccupancyMaxActiveBlocksPerMultiprocessor(&per_cu, (const void*)k_mega, NTHR, SMEM_TOTAL);
        if (per_cu < 1) per_cu = 1;
        grid = cus * (per_cu < 2 ? per_cu : 2);
    }
    hipMemsetAsync(p.ws + OFF_BAR, 0, ZERO_BYTES, stream);
    k_mega<<<grid, NTHR, SMEM_TOTAL, stream>>>(p);
}
```

```cpp
#include <hip/hip_runtime.h>
#include <hip/hip_bf16.h>
#include <stdint.h>
#include <stdio.h>

#ifndef MK_MULTI
#define MK_MULTI 0
#endif

typedef __attribute__((ext_vector_type(8))) short bf16x8;
typedef __attribute__((ext_vector_type(4))) short bf16x4;
typedef __attribute__((ext_vector_type(4))) float f32x4;
typedef unsigned short u16;
typedef __attribute__((ext_vector_type(4))) unsigned u32x4;

#ifndef PROBE_DUP
#define PROBE_DUP -1
#endif
#define NTHR 256
__device__ __forceinline__ int opaque_tid() { int t = (int)threadIdx.x; asm volatile("" : "+v"(t)); return t; }
#define TIDX opaque_tid()
#define LDS_BYTES 65536

#define D_MODEL 1024
#define BATCH 8
#define SEQ 2048
#define CTXL 256
#define NLAT (BATCH * SEQ)
#define NCTX (BATCH * CTXL)
#define NROWS (NLAT + NCTX)
#define INW 1280
#define NEXP 64
#define VT_LD (SEQ + CTXL)
#define NCHUNK_LAT 1024
#define NCHUNK_ALL 1152
#define EPS 1e-6f

#define XB_TMO      128
#define XB_XCNT(j)  (256  + 64 * (j))
#define XB_XSUB(j)  (1280 + 64 * (j))
#define XB_XGEN(j)  (2304 + 64 * (j))
#define XB_TOP      3328
#define XB_TOPGEN   3392
#define XCD_BAR_WORDS 3456
#define XB_SPIN_CAP (1u << 20)
#define LAS __attribute__((address_space(3)))

__device__ __forceinline__ unsigned xb_ld(unsigned* p)              { return __hip_atomic_load(p, __ATOMIC_RELAXED, __HIP_MEMORY_SCOPE_AGENT); }
__device__ __forceinline__ unsigned xb_add(unsigned* p, unsigned v) { return __hip_atomic_fetch_add(p, v, __ATOMIC_RELAXED, __HIP_MEMORY_SCOPE_AGENT); }
__device__ __forceinline__ unsigned xb_xcc_id() { return (unsigned)__builtin_amdgcn_s_getreg((3 << 11) | 20) & 0xFu; }
#define XB_SPIN(cond, bar) do { unsigned _sp = 0; while (cond) { __builtin_amdgcn_s_sleep(1); \
    if ((++_sp & 255u) == 0u) { if (xb_ld(&(bar)[XB_TMO])) break; if (_sp > XB_SPIN_CAP) { atomicAdd(&(bar)[XB_TMO], 1u); break; } } } } while (0)

struct XcdBarrier { unsigned* bar; unsigned x; volatile LAS unsigned* st; };

__device__ __forceinline__ XcdBarrier xcd_barrier_post(unsigned* bar, volatile LAS unsigned* st) {
    XcdBarrier b; b.bar = bar; b.x = xb_xcc_id(); b.st = st;
    if (TIDX == 0) (void)xb_add(&bar[XB_XCNT(b.x)], 1u);
    return b;
}
__device__ __forceinline__ void xcd_barrier_complete(unsigned* bar, unsigned x, unsigned& nloc, unsigned& nx) {
    const unsigned G = gridDim.x * gridDim.y * gridDim.z;
    unsigned sum, cnt, mine, sp = 0u;
    for (;;) {
        sum = 0u; cnt = 0u; mine = 0u;
#pragma unroll
        for (unsigned j = 0; j < 16; ++j) { const unsigned c = xb_ld(&bar[XB_XCNT(j)]); sum += c; cnt += (c > 0u) ? 1u : 0u; mine = (j == x) ? c : mine; }
        if (sum == G) break;
        __builtin_amdgcn_s_sleep(1);
        if ((++sp & 255u) == 0u) { if (xb_ld(&bar[XB_TMO])) break; if (sp > XB_SPIN_CAP) { atomicAdd(&bar[XB_TMO], 1u); break; } }
    }
    nloc = mine > 0u ? mine : 1u; nx = cnt > 0u ? cnt : 1u;
}
__device__ __forceinline__ void xcd_barrier(const XcdBarrier& b) {
    asm volatile("s_waitcnt vmcnt(0)" ::: "memory");
    __syncthreads();
    if (TIDX == 0) {
        unsigned* bar = b.bar;
        __builtin_amdgcn_s_waitcnt(0);
        unsigned nloc = b.st[0], nx = b.st[1];
        if (nloc == 0u) { xcd_barrier_complete(bar, b.x, nloc, nx); b.st[0] = nloc; b.st[1] = nx; }
        const unsigned old = xb_add(&bar[XB_XSUB(b.x)], 1u);
        const unsigned gen = old / nloc;
        if (old + 1u == (gen + 1u) * nloc) {
            __builtin_amdgcn_fence(__ATOMIC_RELEASE, "agent");
            asm volatile("s_waitcnt vmcnt(0)" ::: "memory");
            const unsigned og = xb_add(&bar[XB_TOP], 1u);
            const unsigned tg = og / nx;
            if (og + 1u == (tg + 1u) * nx) xb_add(&bar[XB_TOPGEN], 1u);
            else XB_SPIN(xb_ld(&bar[XB_TOPGEN]) == tg, bar);
            __builtin_amdgcn_fence(__ATOMIC_ACQUIRE, "agent");
            xb_add(&bar[XB_XGEN(b.x)], 1u);
            asm volatile("s_waitcnt vmcnt(0)" ::: "memory");
        } else {
            XB_SPIN(xb_ld(&bar[XB_XGEN(b.x)]) == gen, bar);
            __builtin_amdgcn_fence(__ATOMIC_ACQUIRE, "agent");
            asm volatile("s_waitcnt vmcnt(0)" ::: "memory");
        }
    }
    __syncthreads();
}

struct Params {
    const float *x, *c, *ctx, *c_ctx, *w_ada, *b_ada, *norm_mix, *norm_ffn, *w_in, *attn_sink,
        *a_re, *a_im, *log_dt, *b_re, *b_im, *c_re, *c_im, *ssm_d, *w_glu, *b_glu, *norm_attn_out, *norm_ssm_out,
        *w_out, *w_router, *router_bias, *w_gate_e, *w_up_e, *w_down_e, *w_gate_s, *w_up_s, *w_down_s, *norm_final;
    float* out;
    char* ws;
};

constexpr size_t A256(size_t v) { return (v + 255) & ~(size_t)255; }
constexpr size_t OFF_BAR   = 0;
constexpr size_t OFF_RSQ   = A256(OFF_BAR + XCD_BAR_WORDS * 4 + 1024);
constexpr size_t ZERO_BYTES = OFF_RSQ + (size_t)NLAT * 2 * 4;
constexpr size_t OFF_MOD   = A256(ZERO_BYTES);
constexpr size_t OFF_ROPE  = A256(OFF_MOD + 9 * 6144 * 4);
constexpr size_t OFF_KBUF  = A256(OFF_ROPE + 64 * 16 * 8);
constexpr size_t OFF_IDX   = A256(OFF_KBUF + (size_t)32 * 2 * 4096 * 4);
constexpr size_t OFF_WGT   = A256(OFF_IDX + (size_t)NLAT * 8);
constexpr size_t OFF_ELIST = A256(OFF_WGT + (size_t)NLAT * 8 * 4);
constexpr size_t OFF_WSL   = A256(OFF_ELIST + (size_t)2 * 64 * 8192 * 4);
constexpr size_t OFF_WINT  = A256(OFF_WSL + (size_t)2 * 64 * 8192 * 4);
constexpr size_t OFF_WGLUT = A256(OFF_WINT + (size_t)1280 * 1024 * 2);
constexpr size_t OFF_WOUTT = A256(OFF_WGLUT + (size_t)512 * 512 * 2);
constexpr size_t OFF_WRT   = A256(OFF_WOUTT + (size_t)1024 * 1024 * 2);
constexpr size_t OFF_WDT   = A256(OFF_WRT + (size_t)128 * 1024 * 2);
constexpr size_t OFF_HHS   = A256(OFF_WDT + (size_t)65 * 1024 * 128 * 2);
constexpr size_t OFF_ARENA = A256(OFF_HHS + (size_t)2 * 73728 * 128 * 2);
constexpr size_t OFF_WGUT  = OFF_ARENA;
constexpr size_t OFF_TABS  = A256(OFF_WGUT + (size_t)65 * 256 * 1024 * 2);
constexpr size_t OFF_TABY  = A256(OFF_TABS + (size_t)32 * 256 * 256 * 2);
constexpr size_t OFF_R1    = A256(OFF_TABY + (size_t)32 * 256 * 512 * 2);
constexpr size_t OFF_R2    = A256(OFF_R1 + (size_t)NROWS * 1024 * 2);
constexpr size_t OFF_R3    = A256(OFF_R2 + (size_t)NLAT * 1024 * 2);
constexpr size_t OFF_R4    = A256(OFF_R3 + (size_t)NLAT * 1024 * 2);
constexpr size_t OFF_END   = A256(OFF_R4 + (size_t)NLAT * 512 * 2 * 2);
static_assert(OFF_END - OFF_ARENA >= (size_t)8192 * 9 * 1024 * 2, "arena must hold Yd");
#define WSP_bar   ((unsigned*)(p.ws + OFF_BAR))
#define WSP_ctr   ((unsigned*)(p.ws + OFF_BAR) + XCD_BAR_WORDS)
#define WSP_rsq   ((float*)(p.ws + OFF_RSQ))
#define WSP_mod   ((float*)(p.ws + OFF_MOD))
#define WSP_rope  ((float2*)(p.ws + OFF_ROPE))
#define WSP_Kbuf  ((float*)(p.ws + OFF_KBUF))
#define WSP_WGT   ((float*)(p.ws + OFF_WGT))
#define WSP_elist ((int*)(p.ws + OFF_ELIST))
#define WSP_wsl   ((float*)(p.ws + OFF_WSL))
#define WSP_WinT  ((u16*)(p.ws + OFF_WINT))
#define WSP_WgluT ((u16*)(p.ws + OFF_WGLUT))
#define WSP_WoutT ((u16*)(p.ws + OFF_WOUTT))
#define WSP_WrT   ((u16*)(p.ws + OFF_WRT))
#define WSP_WdT   ((u16*)(p.ws + OFF_WDT))
#define WSP_HHs   ((u16*)(p.ws + OFF_HHS))
#define WSP_Yd    ((u16*)(p.ws + OFF_ARENA))
#define WSP_WguT  ((u16*)(p.ws + OFF_WGUT))
#define WSP_TabS  ((u16*)(p.ws + OFF_TABS))
#define WSP_TabY  ((u16*)(p.ws + OFF_TABY))
#define WSP_Hb    ((u16*)(p.ws + OFF_R1))
#define WSP_S     ((float*)(p.ws + OFF_R1))
#define WSP_H2    ((u16*)(p.ws + OFF_R1))
#define WSP_Q     ((u16*)(p.ws + OFF_R2))
#define WSP_Kb    ((u16*)(p.ws + OFF_R2 + (size_t)NLAT * 512 * 2))
#define WSP_Vt    ((u16*)(p.ws + OFF_R2 + (size_t)NLAT * 512 * 2 + (size_t)NROWS * 128 * 2))
#define WSP_Y     ((u16*)(p.ws + OFF_R2))
#define WSP_SO    ((u16*)(p.ws + OFF_R2 + (size_t)NLAT * 512 * 2))
#define WSP_U     ((u16*)(p.ws + OFF_R3))
#define WSP_CAT   ((u16*)(p.ws + OFF_R3))
#define WSP_AO    ((u16*)(p.ws + OFF_R4))
#define WSP_Hin   ((u16*)(p.ws + OFF_R4 + (size_t)NLAT * 512 * 2))

extern __shared__ __attribute__((aligned(16))) char smem[];

typedef __bf16 bf2_t __attribute__((ext_vector_type(2)));
typedef float f2_t __attribute__((ext_vector_type(2)));
__device__ __forceinline__ unsigned pack2(float a, float b) {
    const f2_t v = {a, b};
    return __builtin_bit_cast(unsigned, __builtin_convertvector(v, bf2_t));
}
__device__ __forceinline__ u16 f2bf(float f) { return (u16)(pack2(f, 0.f) & 0xffffu); }
__device__ __forceinline__ float bf2f(u16 h) { return __uint_as_float(((unsigned)h) << 16); }
__device__ __forceinline__ void glds16(const void* g, void* l) {
    __builtin_amdgcn_global_load_lds((const unsigned*)g, (unsigned*)l, 16, 0, 0);
}
__device__ __forceinline__ int lds_byte(int r, int c) {
    int st = (r >> 4) * 2 + (c >> 5), rr = r & 15, cc = c & 31, ob = rr * 64 + cc * 2;
    return st * 1024 + (ob ^ (((ob >> 9) & 1) << 5));
}
__device__ __forceinline__ float wave_sum(float v) {
#pragma unroll
    for (int o = 32; o > 0; o >>= 1) v += __shfl_xor(v, o);
    return v;
}
__device__ __forceinline__ float sigmoidf_(float x) { return 1.f / (1.f + __expf(-x)); }
__device__ __forceinline__ float siluf_(float x) { return x / (1.f + __expf(-x)); }
__device__ __forceinline__ float gelu_tanh(float x) {
    float u = 0.7978845608028654f * (x + 0.044715f * x * x * x);
    return x / (1.f + __expf(-2.f * u));
}

template <class FA, class FB>
__device__ __forceinline__ void gemm_tile(int nkt, FA fa, FB fb, f32x4 (&acc)[4][4]) {
    const int tid = TIDX, lane = tid & 63, wid = tid >> 6, wr = wid >> 1, wc = wid & 1, fr = lane & 15, fq = lane >> 4;
    const int sb = lane * 16, swz = sb ^ (((sb >> 9) & 1) << 5);
    const int r_in = swz >> 6, c_in = (swz & 63) >> 1;
#pragma unroll
    for (int m = 0; m < 4; ++m)
#pragma unroll
        for (int n = 0; n < 4; ++n) acc[m][n] = (f32x4){0.f, 0.f, 0.f, 0.f};
    __syncthreads();
    auto stage = [&](int kt, int s) {
        char* sa = smem + s * 32768;
        char* sbm = sa + 16384;
#pragma unroll
        for (int i = 0; i < 4; ++i) {
            const int st = wid + 4 * i, R = (st >> 1) * 16 + r_in, C = (st & 1) * 32 + c_in;
            glds16(fa(R, C, kt), sa + tid * 16 + i * 4096);
            glds16(fb(R, C, kt), sbm + tid * 16 + i * 4096);
        }
    };
    stage(0, 0);
    for (int kt = 0; kt < nkt; ++kt) {
        asm volatile("s_waitcnt vmcnt(0)" ::: "memory");
        __syncthreads();
        if (kt + 1 < nkt) stage(kt + 1, (kt + 1) & 1);
        const char* sa = smem + (kt & 1) * 32768;
        const char* sbm = sa + 16384;
#pragma unroll
        for (int ks = 0; ks < 2; ++ks) {
            bf16x8 a[4], b[4];
#pragma unroll
            for (int m = 0; m < 4; ++m) a[m] = *(const bf16x8*)(sa + lds_byte(wr * 64 + m * 16 + fr, ks * 32 + fq * 8));
#pragma unroll
            for (int n = 0; n < 4; ++n) b[n] = *(const bf16x8*)(sbm + lds_byte(wc * 64 + n * 16 + fr, ks * 32 + fq * 8));
#pragma unroll
            for (int m = 0; m < 4; ++m)
#pragma unroll
                for (int n = 0; n < 4; ++n) acc[m][n] = __builtin_amdgcn_mfma_f32_16x16x32_bf16(a[m], b[n], acc[m][n], 0, 0, 0);
        }
    }
    __syncthreads();
}

__device__ __forceinline__ int lds32(int r, int c) {
    const int rr = r & 15;
    return (r >> 4) * 1024 + ((rr * 64 + c * 2) ^ (((rr >> 3) & 1) << 5));
}
struct NoHook { __device__ __forceinline__ void operator()(int) const {} };
template <class FA, class FB, class HK = NoHook>
__device__ __forceinline__ void gemm_tile_w(int nkt, FA fa, FB fb, f32x4 (&acc)[4][8], HK hook = HK()) {
    constexpr bool ZERO = true;
    const int tid = TIDX, lane = tid & 63, wid = tid >> 6, wr = wid >> 1, wc = wid & 1, fr = lane & 15, fq = lane >> 4;
    const int sb = lane * 16, swz = sb ^ (((sb >> 9) & 1) << 5);
    const int r_in = swz >> 6, c_in = (swz & 63) >> 1;
    if (ZERO) {
#pragma unroll
        for (int m = 0; m < 4; ++m)
#pragma unroll
            for (int n = 0; n < 8; ++n) acc[m][n] = (f32x4){0.f, 0.f, 0.f, 0.f};
    }
    __syncthreads();
    auto stage = [&](int kt, int s) {
        char* sa = smem + s * 24576;
#pragma unroll
        for (int i = 0; i < 2; ++i) glds16(fa(i, (wid + 4 * i) * 16 + r_in, c_in, kt), sa + tid * 16 + i * 4096);
#pragma unroll
        for (int i = 0; i < 4; ++i) glds16(fb(i, (wid + 4 * i) * 16 + r_in, c_in, kt), sa + 8192 + tid * 16 + i * 4096);
    };
    stage(0, 0);
    if (nkt > 1) stage(1, 1);
    int s_cur = 0, s_nxt = 2;
    for (int kt = 0; kt < nkt; ++kt) {
        hook(kt);
        if (kt + 1 < nkt) asm volatile("s_waitcnt vmcnt(6) lgkmcnt(0)\n\ts_barrier" ::: "memory");
        else asm volatile("s_waitcnt vmcnt(0) lgkmcnt(0)\n\ts_barrier" ::: "memory");
        if (kt + 2 < nkt) stage(kt + 2, s_nxt);
        const char* sa = smem + s_cur * 24576;
        bf16x8 a[4];
#pragma unroll
        for (int m = 0; m < 4; ++m) a[m] = *(const bf16x8*)(sa + lds32(wr * 64 + m * 16 + fr, fq * 8));
#pragma unroll
        for (int nh = 0; nh < 2; ++nh) {
            bf16x8 b[4];
#pragma unroll
            for (int n = 0; n < 4; ++n) b[n] = *(const bf16x8*)(sa + 8192 + lds32(wc * 128 + (nh * 4 + n) * 16 + fr, fq * 8));
#pragma unroll
            for (int m = 0; m < 4; ++m)
#pragma unroll
                for (int n = 0; n < 4; ++n) acc[m][nh * 4 + n] = __builtin_amdgcn_mfma_f32_16x16x32_bf16(a[m], b[n], acc[m][nh * 4 + n], 0, 0, 0);
        }
        s_cur = (s_cur == 2) ? 0 : s_cur + 1;
        s_nxt = (s_nxt == 2) ? 0 : s_nxt + 1;
    }
    __syncthreads();
}

template <class FV, class FD>
__device__ __forceinline__ void wave_store_bf16_f(FV val, FD dst) {
    const int lane = TIDX & 63, wid = TIDX >> 6, fr = lane & 15, fq = lane >> 4;
    char* base = smem + wid * 9216;
#pragma unroll
    for (int m = 0; m < 4; ++m)
#pragma unroll
        for (int n = 0; n < 4; ++n)
#pragma unroll
            for (int j = 0; j < 4; ++j)
                *(u16*)(base + (m * 16 + fq * 4 + j) * 144 + (n * 16 + fr) * 2) = f2bf(val(m, n, j));
    asm volatile("s_waitcnt lgkmcnt(0)" ::: "memory");
    __builtin_amdgcn_wave_barrier();
#pragma unroll
    for (int i = 0; i < 8; ++i) {
        const int id = i * 64 + lane, row = id >> 3, ch = id & 7;
        const uint4 d = *(const uint4*)(base + row * 144 + ch * 16);
        u16* p = dst(row);
        if (p) *(uint4*)(p + ch * 8) = d;
    }
    asm volatile("s_waitcnt lgkmcnt(0)" ::: "memory");
    __builtin_amdgcn_wave_barrier();
}

template <class FD>
__device__ __forceinline__ void wave_store_bf16(const float (&v)[4][4][4], FD dst) {
    wave_store_bf16_f([&](int m, int n, int j) { return v[m][n][j]; }, dst);
}

struct ConvD { const float* src; u16* dst; int ld, ldd, k0, n0, mode, zr; };
__device__ __forceinline__ void conv_load(const Params& p, const ConvD& d, float (&v)[16]) {
    const int tid = TIDX;
#pragma unroll
    for (int i = 0; i < 16; ++i) v[i] = d.src[(size_t)(d.k0 + i * 4 + (tid >> 6)) * d.ld + d.n0 + (tid & 63)];
    if (d.zr == 2) {
#pragma unroll
        for (int i = 0; i < 16; ++i) {
            const int k = d.k0 + i * 4 + (tid >> 6);
            v[i] *= (k < 512) ? p.norm_attn_out[k] : p.norm_ssm_out[k - 512];
        }
    }
}
__device__ __forceinline__ void conv_store(const Params& p, const ConvD& d, const float (&v)[16]) {
    float* t = (float*)smem;
    const int tid = TIDX;
    __syncthreads();
#pragma unroll
    for (int i = 0; i < 16; ++i) t[(i * 4 + (tid >> 6)) * 65 + (tid & 63)] = v[i];
    __syncthreads();
    const int n = tid >> 2, kq = tid & 3;
    unsigned w[8];
#pragma unroll
    for (int i = 0; i < 8; ++i) w[i] = pack2(t[(kq * 16 + 2 * i) * 65 + n], t[(kq * 16 + 2 * i + 1) * 65 + n]);
    const int gn = d.n0 + n;
    int row = gn;
    if (d.mode == 1) row = (gn >> 4) * 32 + (gn & 15);
    else if (d.mode == 2) row = (gn >> 4) * 32 + 16 + (gn & 15);
    else if (d.mode == 3) row = n;
    uint4* o = (uint4*)(d.dst + (size_t)row * d.ldd + d.k0 + kq * 16);
    o[0] = make_uint4(w[0], w[1], w[2], w[3]);
    o[1] = make_uint4(w[4], w[5], w[6], w[7]);
    if (d.zr == 1) {
        uint4* z = (uint4*)(WSP_WrT + (size_t)(64 + n) * 1024 + d.k0 + kq * 16);
        z[0] = make_uint4(0, 0, 0, 0); z[1] = make_uint4(0, 0, 0, 0);
    }
}

__device__ __forceinline__ void ada_item(const Params& p, int item) {
    float* sc = (float*)smem;
    float* red = sc + 9 * 1024;
    const int tid = TIDX;
    __syncthreads();
    for (int i = tid; i < 9 * 1024; i += NTHR) {
        const int r = i >> 10, k = i & 1023;
        const float cv = (r < 8) ? p.c[r * 1024 + k] : p.c_ctx[k];
        sc[i] = siluf_(cv);
    }
    __syncthreads();
    const int kq = tid >> 6, jl = tid & 63, j = item * 64 + jl;
    float acc[9];
#pragma unroll
    for (int r = 0; r < 9; ++r) acc[r] = 0.f;
#pragma unroll 16
    for (int k = kq; k < 1024; k += 4) {
        const float w = p.w_ada[(size_t)k * 6144 + j];
#pragma unroll
        for (int r = 0; r < 9; ++r) acc[r] += sc[r * 1024 + k] * w;
    }
#pragma unroll
    for (int r = 0; r < 9; ++r) red[(kq * 9 + r) * 64 + jl] = acc[r];
    __syncthreads();
    for (int i = tid; i < 9 * 64; i += NTHR) {
        const int r = i >> 6, l = i & 63;
        const float s = red[(0 * 9 + r) * 64 + l] + red[(1 * 9 + r) * 64 + l] + red[(2 * 9 + r) * 64 + l] + red[(3 * 9 + r) * 64 + l];
        WSP_mod[r * 6144 + item * 64 + l] = s + p.b_ada[item * 64 + l];
    }
}

__device__ __forceinline__ void rope_item(const Params& p) {
    for (int i = TIDX; i < 64 * 16; i += NTHR) {
        const int pos = i >> 4, k = i & 15;
        const float inv = exp2f(-(float)k * (13.287712379549449f / 16.f));
        float s, c;
        sincosf((float)pos * inv, &s, &c);
        WSP_rope[i] = make_float2(c, s);
    }
}

__device__ __forceinline__ void ssm_table_item(const Params& p, int g, int dir) {
    float* pw = (float*)smem;
    float* Bb = pw + 17 * 64 * 2;
    float* Cc = Bb + 64 * 16 * 2;
    const int tid = TIDX;
    u16* tabS = WSP_TabS + (size_t)g * 256 * 256;
    u16* tabY = WSP_TabY + (size_t)g * 256 * 512;
    float* Kf = WSP_Kbuf + (size_t)(g * 2 + dir) * 4096;
    __syncthreads();
    {
        const int pidx = dir * 32 + g;
        const float dt = __expf(p.log_dt[pidx]);
        for (int i = tid; i < 17 * 64; i += NTHR) {
            const int tau = i >> 6, n = i & 63;
            const float are = p.a_re[pidx * 64 + n], aim = p.a_im[pidx * 64 + n];
            const float mag = __expf((float)tau * dt * are);
            float rev = (float)tau * (dt * aim * 0.15915494309189535f);
            rev -= rintf(rev);
            pw[i * 2] = mag * __builtin_amdgcn_cosf(rev);
            pw[i * 2 + 1] = mag * __builtin_amdgcn_sinf(rev);
        }
        __syncthreads();
        for (int i = tid; i < 64 * 16; i += NTHR) {
            const int n = i >> 4;
            const float are = p.a_re[pidx * 64 + n], aim = p.a_im[pidx * 64 + n];
            const float abr = pw[(64 + n) * 2], abi = pw[(64 + n) * 2 + 1];
            const float den = are * are + aim * aim, nre = abr - 1.f;
            const float cre = (nre * are + abi * aim) / den, cim = (abi * are - nre * aim) / den;
            const float br = p.b_re[(size_t)pidx * 1024 + i], bi = p.b_im[(size_t)pidx * 1024 + i];
            Bb[i * 2] = cre * br - cim * bi;
            Bb[i * 2 + 1] = cre * bi + cim * br;
            Cc[i * 2] = p.c_re[(size_t)pidx * 1024 + i];
            Cc[i * 2 + 1] = p.c_im[(size_t)pidx * 1024 + i];
        }
        __syncthreads();
        {
            const int tau = tid >> 4, pp = tid & 15;
            float s[16];
#pragma unroll
            for (int q = 0; q < 16; ++q) s[q] = 0.f;
            for (int n = 0; n < 64; ++n) {
                const float2 cv = *(const float2*)&Cc[(pp * 64 + n) * 2];
                const float2 wv = *(const float2*)&pw[(tau * 64 + n) * 2];
                const float zr = cv.x * wv.x - cv.y * wv.y, zi = cv.x * wv.y + cv.y * wv.x;
#pragma unroll
                for (int q = 0; q < 16; ++q) {
                    const float2 bv = *(const float2*)&Bb[(n * 16 + q) * 2];
                    s[q] += zr * bv.x - zi * bv.y;
                }
            }
#pragma unroll
            for (int q = 0; q < 4; ++q)
                *(float4*)(Kf + tau * 256 + pp * 16 + q * 4) = make_float4(s[4 * q], s[4 * q + 1], s[4 * q + 2], s[4 * q + 3]);
        }
        for (int id = tid; id < 128 * 32; id += NTHR) {
            const int rr = id >> 5, ch = id & 31, cpart = rr >> 6, n = rr & 63, s_ = ch >> 1, q0 = (ch & 1) * 8;
            const int e = dir == 0 ? 15 - s_ : s_;
            const float wr_ = pw[(e * 64 + n) * 2], wi_ = pw[(e * 64 + n) * 2 + 1];
            unsigned w[4];
#pragma unroll
            for (int i = 0; i < 4; ++i) {
                float v[2];
#pragma unroll
                for (int h = 0; h < 2; ++h) {
                    const float br = Bb[(n * 16 + q0 + 2 * i + h) * 2], bi = Bb[(n * 16 + q0 + 2 * i + h) * 2 + 1];
                    v[h] = cpart == 0 ? (wr_ * br - wi_ * bi) : (wr_ * bi + wi_ * br);
                }
                w[i] = pack2(v[0], v[1]);
            }
            *(uint4*)(tabS + (size_t)(dir * 128 + rr) * 256 + s_ * 16 + q0) = make_uint4(w[0], w[1], w[2], w[3]);
        }
        for (int id = tid; id < 256 * 16; id += NTHR) {
            const int m = id >> 4, ch = id & 15, t = m >> 4, pp = m & 15, cpart = ch >> 3, n0 = (ch & 7) * 8;
            const int e = dir == 0 ? t + 1 : 16 - t;
            unsigned w[4];
#pragma unroll
            for (int i = 0; i < 4; ++i) {
                float v[2];
#pragma unroll
                for (int h = 0; h < 2; ++h) {
                    const int n = n0 + 2 * i + h;
                    const float cr = Cc[(pp * 64 + n) * 2], ci = Cc[(pp * 64 + n) * 2 + 1];
                    const float wr_ = pw[(e * 64 + n) * 2], wi_ = pw[(e * 64 + n) * 2 + 1];
                    v[h] = cpart == 0 ? (cr * wr_ - ci * wi_) : -(cr * wi_ + ci * wr_);
                }
                w[i] = pack2(v[0], v[1]);
            }
            *(uint4*)(tabY + (size_t)m * 512 + 256 + dir * 128 + cpart * 64 + n0) = make_uint4(w[0], w[1], w[2], w[3]);
        }
    }
}

__device__ __forceinline__ void ssm_toeplitz_item(const Params& p, int g) {
    float* Kf = (float*)smem;
    const int tid = TIDX;
    u16* tabY = WSP_TabY + (size_t)g * 256 * 512;
    __syncthreads();
    for (int i = tid; i < 2048; i += NTHR) ((float4*)Kf)[i] = ((const float4*)(WSP_Kbuf + (size_t)g * 8192))[i];
    __syncthreads();
    for (int id = tid; id < 256 * 32; id += NTHR) {
        const int m = id >> 5, ch = id & 31, t = m >> 4, pp = m & 15, s_ = ch >> 1, q0 = (ch & 1) * 8;
        unsigned w[4];
#pragma unroll
        for (int i = 0; i < 4; ++i) {
            float v[2];
#pragma unroll
            for (int h = 0; h < 2; ++h) {
                const int q = q0 + 2 * i + h;
                float val;
                if (s_ < t) val = Kf[((t - s_) * 16 + pp) * 16 + q];
                else if (s_ > t) val = Kf[4096 + ((s_ - t) * 16 + pp) * 16 + q];
                else val = Kf[(pp) * 16 + q] + Kf[4096 + pp * 16 + q] + (pp == q ? p.ssm_d[g * 16 + pp] : 0.f);
                v[h] = val;
            }
            w[i] = pack2(v[0], v[1]);
        }
        *(uint4*)(tabY + (size_t)m * 512 + s_ * 16 + q0) = make_uint4(w[0], w[1], w[2], w[3]);
    }
    __syncthreads();
}

#define N_CONV 6896
__device__ __forceinline__ ConvD conv_decode(const Params& p, int t) {
    ConvD d; d.mode = 0; d.zr = 0;
    if (t < 320) { d.src = p.w_in; d.ld = 1280; d.k0 = (t / 20) * 64; d.n0 = (t % 20) * 64; d.dst = WSP_WinT; d.ldd = 1024; return d; }
    t -= 320;
    if (t < 64) { d.src = p.w_glu; d.ld = 512; d.k0 = (t / 8) * 64; d.n0 = (t % 8) * 64; d.dst = WSP_WgluT; d.ldd = 512; return d; }
    t -= 64;
    if (t < 256) { d.src = p.w_out; d.ld = 1024; d.k0 = (t / 16) * 64; d.n0 = (t % 16) * 64; d.dst = WSP_WoutT; d.ldd = 1024; d.zr = 2; return d; }
    t -= 256;
    if (t < 16) { d.src = p.w_router; d.ld = 64; d.k0 = t * 64; d.n0 = 0; d.dst = WSP_WrT; d.ldd = 1024; d.zr = 1; return d; }
    t -= 16;
    if (t < 4096) {
        const int up = t >= 2048; const int tt = t & 2047, e = tt >> 5, r = tt & 31;
        d.src = (up ? p.w_up_e : p.w_gate_e) + (size_t)e * 131072; d.ld = 128; d.k0 = (r >> 1) * 64; d.n0 = (r & 1) * 64;
        d.dst = WSP_WguT + (size_t)e * 262144; d.ldd = 1024; d.mode = 1 + up; return d;
    }
    t -= 4096;
    if (t < 64) {
        const int up = t >= 32; const int r = t & 31;
        d.src = up ? p.w_up_s : p.w_gate_s; d.ld = 128; d.k0 = (r >> 1) * 64; d.n0 = (r & 1) * 64;
        d.dst = WSP_WguT + (size_t)64 * 262144; d.ldd = 1024; d.mode = 1 + up; return d;
    }
    t -= 64;
    if (t < 2048) { const int e = t >> 5, r = t & 31; d.src = p.w_down_e + (size_t)e * 131072; d.ld = 1024; d.k0 = (r >> 4) * 64; d.n0 = (r & 15) * 64; d.dst = WSP_WdT + (size_t)e * 131072; d.ldd = 128; return d; }
    t -= 2048;
    d.src = p.w_down_s; d.ld = 1024; d.k0 = (t >> 4) * 64; d.n0 = (t & 15) * 64; d.dst = WSP_WdT + (size_t)64 * 131072; d.ldd = 128; return d;
}

#define N_CONV_EARLY 3200
__device__ __forceinline__ void conv_range(const Params& p, int t0, int stride, int tend, int tbeg = 0) {
    int t = tbeg + t0;
    if (t < tend) {
        ConvD d = conv_decode(p, t);
        float v[16];
        conv_load(p, d, v);
        while (t < tend) {
            const int tn = t + stride;
            ConvD dn = d;
            float vn[16];
            if (tn < tend) { dn = conv_decode(p, tn); conv_load(p, dn, vn); }
            conv_store(p, d, v);
            d = dn;
#pragma unroll
            for (int i = 0; i < 16; ++i) v[i] = vn[i];
            t = tn;
        }
    }
}
#define P0_CONV_B0 161
__device__ __forceinline__ void phase0(const Params& p) {
    const int b = blockIdx.x, G = gridDim.x;
    if (G > P0_CONV_B0 + 32) {
        if (b < 64) ssm_table_item(p, b >> 1, b & 1);
        else if (b < 160) ada_item(p, b - 64);
        else if (b == 160) rope_item(p);
        else conv_range(p, b - P0_CONV_B0, G - P0_CONV_B0, N_CONV_EARLY);
    } else {
        const int NU = 64 + 96 + 1 + N_CONV_EARLY;
        for (int u = b; u < NU; u += G) {
            if (u < 64) ssm_table_item(p, u >> 1, u & 1);
            else if (u < 160) ada_item(p, u - 64);
            else if (u == 160) rope_item(p);
            else { ConvD d = conv_decode(p, u - 161); float v[16]; conv_load(p, d, v); conv_store(p, d, v); }
        }
    }
}
#if 0
    {
        {
            const int stride = G - P0_CONV_B0;
            int t = b - P0_CONV_B0;
            if (t < N_CONV) {
                ConvD d = conv_decode(p, t);
                float v[16];
                conv_load(p, d, v);
                while (t < N_CONV) {
                    const int tn = t + stride;
                    ConvD dn = d;
                    float vn[16];
                    if (tn < N_CONV) { dn = conv_decode(p, tn); conv_load(p, dn, vn); }
                    conv_store(p, d, v);
                    d = dn;
#pragma unroll
                    for (int i = 0; i < 16; ++i) v[i] = vn[i];
                    t = tn;
                }
            }
        }
    } else {
        const int NU = 64 + 96 + 1 + N_CONV;
        for (int u = b; u < NU; u += G) {
            if (u < 64) ssm_table_item(p, u >> 1, u & 1);
            else if (u < 160) ada_item(p, u - 64);
            else if (u == 160) rope_item(p);
            else { ConvD d = conv_decode(p, u - 161); float v[16]; conv_load(p, d, v); conv_store(p, d, v); }
        }
    }
}

#endif

__device__ __forceinline__ void norm_mod_row(const float* src, const float* gain, const float* sh, const float* scl, u16* dst) {
    const int lane = TIDX & 63;
    float4 v[4];
    float ss = 0.f;
#pragma unroll
    for (int i = 0; i < 4; ++i) {
        v[i] = *(const float4*)(src + i * 256 + lane * 4);
        ss += v[i].x * v[i].x + v[i].y * v[i].y + v[i].z * v[i].z + v[i].w * v[i].w;
    }
    ss = wave_sum(ss);
    const float rs = rsqrtf(ss * (1.f / 1024.f) + EPS);
#pragma unroll
    for (int i = 0; i < 4; ++i) {
        const int c0 = i * 256 + lane * 4;
        const float4 g = *(const float4*)(gain + c0), s = *(const float4*)(sh + c0), k = *(const float4*)(scl + c0);
        const float a = v[i].x * rs * g.x * (1.f + k.x) + s.x, b = v[i].y * rs * g.y * (1.f + k.y) + s.y;
        const float c = v[i].z * rs * g.z * (1.f + k.z) + s.z, d = v[i].w * rs * g.w * (1.f + k.w) + s.w;
        *(uint2*)(dst + c0) = make_uint2(pack2(a, b), pack2(c, d));
    }
}

__device__ __forceinline__ void phase1(const Params& p) {
    for (int g = blockIdx.x; g < 32; g += gridDim.x) ssm_toeplitz_item(p, g);
    const int wv = blockIdx.x * 4 + (TIDX >> 6), nwv = gridDim.x * 4;
    const int lane = TIDX & 63;
    for (int r0 = wv * 3; r0 < NROWS; r0 += nwv * 3) {
        const float* src[3]; const float* md[3];
        float4 v[3][4];
#pragma unroll
        for (int q = 0; q < 3; ++q) {
            const int r = r0 + q;
            if (r < NLAT) { src[q] = p.x + (size_t)r * 1024; md[q] = WSP_mod + (r >> 11) * 6144; }
            else { src[q] = p.ctx + (size_t)(r - NLAT) * 1024; md[q] = WSP_mod + 8 * 6144; }
#pragma unroll
            for (int i = 0; i < 4; ++i) v[q][i] = *(const float4*)(src[q] + i * 256 + lane * 4);
        }
#pragma unroll
        for (int q = 0; q < 3; ++q) {
            float ss = 0.f;
#pragma unroll
            for (int i = 0; i < 4; ++i) ss += v[q][i].x * v[q][i].x + v[q][i].y * v[q][i].y + v[q][i].z * v[q][i].z + v[q][i].w * v[q][i].w;
            ss = wave_sum(ss);
            const float rs = rsqrtf(ss * (1.f / 1024.f) + EPS);
            u16* dst = WSP_Hb + (size_t)(r0 + q) * 1024;
#pragma unroll
            for (int i = 0; i < 4; ++i) {
                const int c0 = i * 256 + lane * 4;
                const float4 g = *(const float4*)(p.norm_mix + c0), s = *(const float4*)(md[q] + c0), k = *(const float4*)(md[q] + 1024 + c0);
                const float a = v[q][i].x * rs * g.x * (1.f + k.x) + s.x, b = v[q][i].y * rs * g.y * (1.f + k.y) + s.y;
                const float c = v[q][i].z * rs * g.z * (1.f + k.z) + s.z, d = v[q][i].w * rs * g.w * (1.f + k.w) + s.w;
                *(uint2*)(dst + c0) = make_uint2(pack2(a, b), pack2(c, d));
            }
        }
    }
}

__device__ __forceinline__ void phase2(const Params& p) {
    const int NU = 128 * 10 + 16 * 6;
    const int lane = TIDX & 63, wid = TIDX >> 6, wr = wid >> 1, wc = wid & 1, fr = lane & 15, fq = lane >> 4;
    for (int u = blockIdx.x; u < NU; u += gridDim.x) {
        int mt, nt;
        if (u < 1280) { mt = u / 10; nt = u % 10; } else { const int v = u - 1280; mt = 128 + v / 6; nt = 4 + v % 6; }
        const u16* A = WSP_Hb + (size_t)mt * 128 * 1024;
        const u16* B = WSP_WinT + (size_t)nt * 128 * 1024;
        f32x4 acc[4][4];
        gemm_tile(16,
            [&](int R, int C, int kt) { return (const void*)(A + (size_t)R * 1024 + kt * 64 + C); },
            [&](int R, int C, int kt) { return (const void*)(B + (size_t)R * 1024 + kt * 64 + C); }, acc);
        const int row0 = mt * 128 + wr * 64;
        const int col0 = nt * 128 + wc * 64;
        const bool is_lat = mt < 128;
        if (nt == 5) {
            const int kvh = wc;
#pragma unroll
            for (int m = 0; m < 4; ++m) {
                const int r = row0 + m * 16 + fq * 4;
                int b, pos;
                if (is_lat) { b = r >> 11; pos = r & 2047; } else { const int rc = r - NLAT; b = rc >> 8; pos = SEQ + (rc & 255); }
#pragma unroll
                for (int n = 0; n < 4; ++n) {
                    const int d = n * 16 + fr;
                    u16* dst = WSP_Vt + ((size_t)(b * 2 + kvh) * 64 + d) * VT_LD + pos;
                    *(uint2*)dst = make_uint2(pack2(acc[m][n][0], acc[m][n][1]), pack2(acc[m][n][2], acc[m][n][3]));
                }
            }
        } else {
            float v[4][4][4];
            const bool do_rope = is_lat && nt <= 4;
#pragma unroll
            for (int m = 0; m < 4; ++m)
#pragma unroll
                for (int j = 0; j < 4; ++j) {
                    if (do_rope) {
                        const int r = row0 + m * 16 + fq * 4 + j, pos = r & 2047;
                        const float2 cr = WSP_rope[(pos >> 6) * 16 + fr], cc = WSP_rope[(pos & 63) * 16 + fr];
                        const float x1 = acc[m][0][j], x2 = acc[m][1][j], y1 = acc[m][2][j], y2 = acc[m][3][j];
                        v[m][0][j] = x1 * cr.x - x2 * cr.y; v[m][1][j] = x1 * cr.y + x2 * cr.x;
                        v[m][2][j] = y1 * cc.x - y2 * cc.y; v[m][3][j] = y1 * cc.y + y2 * cc.x;
                    } else {
#pragma unroll
                        for (int n = 0; n < 4; ++n) v[m][n][j] = acc[m][n][j];
                    }
                }
            u16* dbase; int ldd;
            if (nt < 4) { dbase = WSP_Q + (size_t)row0 * 512 + col0; ldd = 512; }
            else if (nt == 4) { dbase = WSP_Kb + (size_t)row0 * 128 + (col0 - 512); ldd = 128; }
            else { dbase = WSP_U + (size_t)row0 * 512 + (col0 - 768); ldd = 512; }
            wave_store_bf16(v, [&](int row) { return dbase + (size_t)row * ldd; });
        }
    }
}

__device__ __forceinline__ void attn_unit(const Params& p, int u) {
    const int h = u & 7, qb = (u >> 3) & 15, b = u >> 7, kvh = h >> 2;
    const int tid = TIDX, lane = tid & 63, wid = tid >> 6, fr = lane & 15, fq = lane >> 4;
    const int sb = lane * 16, swz = sb ^ (((sb >> 9) & 1) << 5);
    const int r_in = swz >> 6, c_in = (swz & 63) >> 1;
    const int jstart = qb == 0 ? 2 : 0, jend = qb == 15 ? 4 : 6, nb = jend - jstart, ntile = nb + 4;
    const float SC = 0.125f * 1.4426950408889634f;
    bf16x8 qf[2][2];
    const int qrow0 = b * SEQ + qb * 128 + wid * 32;
#pragma unroll
    for (int qt = 0; qt < 2; ++qt)
#pragma unroll
        for (int ks = 0; ks < 2; ++ks)
            qf[qt][ks] = *(const bf16x8*)(WSP_Q + (size_t)(qrow0 + qt * 16 + fr) * 512 + h * 64 + ks * 32 + fq * 8);
    f32x4 o[4][2];
#pragma unroll
    for (int dt = 0; dt < 4; ++dt)
#pragma unroll
        for (int qt = 0; qt < 2; ++qt) o[dt][qt] = (f32x4){0.f, 0.f, 0.f, 0.f};
    float mrun[2], lrun[2];
    const float sinkv = p.attn_sink[h] * 1.4426950408889634f;
    mrun[0] = mrun[1] = sinkv;
    lrun[0] = lrun[1] = (fq == 0) ? 1.f : 0.f;
    __syncthreads();
    auto stage = [&](int i, int s) {
        const u16* kbase; const u16* vbase;
        if (i < nb) {
            const int ks0 = qb * 128 - 128 + 64 * (jstart + i);
            kbase = WSP_Kb + (size_t)(b * SEQ + ks0) * 128 + kvh * 64;
            vbase = WSP_Vt + (size_t)(b * 2 + kvh) * 64 * VT_LD + ks0;
        } else {
            const int c0 = 64 * (i - nb);
            kbase = WSP_Kb + (size_t)(NLAT + b * CTXL + c0) * 128 + kvh * 64;
            vbase = WSP_Vt + (size_t)(b * 2 + kvh) * 64 * VT_LD + SEQ + c0;
        }
        char* sk = smem + s * 16384;
        char* sv = sk + 8192;
#pragma unroll
        for (int it = 0; it < 2; ++it) {
            const int st = wid + 4 * it, R = (st >> 1) * 16 + r_in, C = (st & 1) * 32 + c_in;
            glds16(kbase + (size_t)R * 128 + C, sk + tid * 16 + it * 4096);
            glds16(vbase + (size_t)R * VT_LD + C, sv + tid * 16 + it * 4096);
        }
    };
    stage(0, 0);
    for (int i = 0; i < ntile; ++i) {
        asm volatile("s_waitcnt vmcnt(0)" ::: "memory");
        __syncthreads();
        if (i + 1 < ntile) stage(i + 1, (i + 1) & 1);
        const char* sk = smem + (i & 1) * 16384;
        const char* sv = sk + 8192;
        f32x4 s[4][2];
#pragma unroll
        for (int kt = 0; kt < 4; ++kt)
#pragma unroll
            for (int qt = 0; qt < 2; ++qt) s[kt][qt] = (f32x4){0.f, 0.f, 0.f, 0.f};
#pragma unroll
        for (int ks = 0; ks < 2; ++ks)
#pragma unroll
            for (int kt = 0; kt < 4; ++kt) {
                const bf16x8 kf = *(const bf16x8*)(sk + lds_byte(kt * 16 + fr, ks * 32 + fq * 8));
#pragma unroll
                for (int qt = 0; qt < 2; ++qt) s[kt][qt] = __builtin_amdgcn_mfma_f32_16x16x32_bf16(kf, qf[qt][ks], s[kt][qt], 0, 0, 0);
            }
        const int ks0 = qb * 128 - 128 + 64 * (jstart + i);
        const int qlo = qb * 128 + wid * 32;
        const bool band = (i < nb) && ((qlo + 31 - ks0 > 128) || (ks0 + 63 - qlo > 128));
        bf16x8 pf[2][2];
#pragma unroll
        for (int qt = 0; qt < 2; ++qt) {
            const int qp = qb * 128 + wid * 32 + qt * 16 + fr;
            float mx = -1e30f;
#pragma unroll
            for (int kt = 0; kt < 4; ++kt)
#pragma unroll
                for (int j = 0; j < 4; ++j) {
                    float v = s[kt][qt][j] * SC;
                    if (band) {
                        const int kp = ks0 + kt * 16 + fq * 4 + j, d = qp - kp;
                        if (d > 128 || d < -128) v = -1e30f;
                    }
                    s[kt][qt][j] = v;
                    mx = fmaxf(mx, v);
                }
            mx = fmaxf(mx, __shfl_xor(mx, 16));
            mx = fmaxf(mx, __shfl_xor(mx, 32));
            const float mnew = fmaxf(mrun[qt], mx);
            const float alpha = __builtin_amdgcn_exp2f(mrun[qt] - mnew);
            mrun[qt] = mnew;
            float ls = 0.f;
#pragma unroll
            for (int kt = 0; kt < 4; ++kt)
#pragma unroll
                for (int j = 0; j < 4; ++j) {
                    const float pv = __builtin_amdgcn_exp2f(s[kt][qt][j] - mnew);
                    s[kt][qt][j] = pv;
                    ls += pv;
                }
            lrun[qt] = lrun[qt] * alpha + ls;
#pragma unroll
            for (int dt = 0; dt < 4; ++dt) o[dt][qt] *= alpha;
#pragma unroll
            for (int k2 = 0; k2 < 2; ++k2) {
                bf16x8 t;
#pragma unroll
                for (int j = 0; j < 4; ++j) { t[j] = (short)f2bf(s[2 * k2][qt][j]); t[4 + j] = (short)f2bf(s[2 * k2 + 1][qt][j]); }
                pf[qt][k2] = t;
            }
        }
#pragma unroll
        for (int k2 = 0; k2 < 2; ++k2)
#pragma unroll
            for (int dt = 0; dt < 4; ++dt) {
                const uint2 lo = *(const uint2*)(sv + lds_byte(dt * 16 + fr, k2 * 32 + fq * 4));
                const uint2 hi = *(const uint2*)(sv + lds_byte(dt * 16 + fr, k2 * 32 + 16 + fq * 4));
                union { uint4 u; bf16x8 v; } cv; cv.u = make_uint4(lo.x, lo.y, hi.x, hi.y);
#pragma unroll
                for (int qt = 0; qt < 2; ++qt) o[dt][qt] = __builtin_amdgcn_mfma_f32_16x16x32_bf16(cv.v, pf[qt][k2], o[dt][qt], 0, 0, 0);
            }
    }
#pragma unroll
    for (int qt = 0; qt < 2; ++qt) {
        float l = lrun[qt];
        l += __shfl_xor(l, 16);
        l += __shfl_xor(l, 32);
        const float inv = 1.f / l;
        u16* dst = WSP_AO + (size_t)(qrow0 + qt * 16 + fr) * 512 + h * 64 + fq * 4;
        float sq = 0.f;
#pragma unroll
        for (int dt = 0; dt < 4; ++dt) {
            const unsigned w0 = pack2(o[dt][qt][0] * inv, o[dt][qt][1] * inv), w1 = pack2(o[dt][qt][2] * inv, o[dt][qt][3] * inv);
            *(uint2*)(dst + dt * 16) = make_uint2(w0, w1);
            const float a = bf2f((u16)(w0 & 0xffffu)), b = bf2f((u16)(w0 >> 16)), c = bf2f((u16)(w1 & 0xffffu)), d = bf2f((u16)(w1 >> 16));
            sq += a * a + b * b + c * c + d * d;
        }
        sq += __shfl_xor(sq, 16);
        sq += __shfl_xor(sq, 32);
        if (fq == 0) unsafeAtomicAdd(WSP_rsq + (size_t)(qrow0 + qt * 16 + fr) * 2, sq);
    }
}

__device__ __forceinline__ void ssm_s1_unit(const Params& p, int u) {
    const int ct = u % 9, mh = (u / 9) & 1, g = u / 18;
    const int lane = TIDX & 63, wid = TIDX >> 6, wr = wid >> 1, wc = wid & 1, fr = lane & 15, fq = lane >> 4;
    const u16* A = WSP_TabS + ((size_t)g * 256 + mh * 128) * 256;
    const u16* Ub = WSP_U + (size_t)ct * 128 * 16 * 512 + g * 16;
    f32x4 acc[4][4];
    gemm_tile(4,
        [&](int R, int C, int kt) { return (const void*)(A + (size_t)R * 256 + kt * 64 + C); },
        [&](int R, int C, int kt) { return (const void*)(Ub + (size_t)(R * 16 + kt * 4 + (C >> 4)) * 512 + (C & 15)); }, acc);
#pragma unroll
    for (int m = 0; m < 4; ++m)
#pragma unroll
        for (int n = 0; n < 4; ++n) {
            const int rho = mh * 128 + wr * 64 + m * 16 + fq * 4;
            const int cg = ct * 128 + wc * 64 + n * 16 + fr;
            *(f32x4*)(WSP_S + ((size_t)cg * 32 + g) * 256 + rho) = acc[m][n];
        }
}

__device__ __forceinline__ void phase3(const Params& p) {
    const int NU = 1024 + 576;
    for (int u = blockIdx.x; u < NU; u += gridDim.x) {
        if (u < 1024) attn_unit(p, u); else ssm_s1_unit(p, u - 1024);
    }
}

__device__ __forceinline__ void phase4(const Params& p) {
    if ((int)gridDim.x > 160) { if ((int)blockIdx.x >= 128) { conv_range(p, blockIdx.x - 128, gridDim.x - 128, N_CONV, N_CONV_EARLY); return; } }
    else conv_range(p, blockIdx.x, gridDim.x, N_CONV, N_CONV_EARLY);
    const int gid = blockIdx.x * NTHR + TIDX;
    if (gid >= BATCH * 2 * 32 * 64) return;
    const int n = gid & 63, g = (gid >> 6) & 31, dir = (gid >> 11) & 1, b = gid >> 12;
    const int pidx = dir * 32 + g;
    const float dt = __expf(p.log_dt[pidx]);
    const float are = p.a_re[pidx * 64 + n], aim = p.a_im[pidx * 64 + n];
    const float mag = __expf(16.f * dt * are);
    float rev = 16.f * (dt * aim * 0.15915494309189535f);
    rev -= rintf(rev);
    const float ar = mag * __builtin_amdgcn_cosf(rev), ai = mag * __builtin_amdgcn_sinf(rev);
    float hr = 0.f, hi = 0.f;
    const size_t so = (size_t)g * 256 + dir * 128 + n;
#pragma unroll 8
    for (int i = 0; i < 16; ++i) {
        const int c = dir == 0 ? i : 15 - i;
        const float* sp = WSP_S + (size_t)(NCHUNK_LAT + b * 16 + c) * 8192 + so;
        const float sr = sp[0], si = sp[64];
        const float nr = ar * hr - ai * hi + sr, ni = ar * hi + ai * hr + si;
        hr = nr; hi = ni;
    }
#pragma unroll 8
    for (int i = 0; i < 128; ++i) {
        const int c = dir == 0 ? i : 127 - i;
        const size_t cg = (size_t)b * 128 + c;
        const float* sp = WSP_S + cg * 8192 + so;
        const float sr = sp[0], si = sp[64];
        u16* hp = WSP_Hin + cg * 8192 + so;
        hp[0] = f2bf(hr); hp[64] = f2bf(hi);
        const float nr = ar * hr - ai * hi + sr, ni = ar * hi + ai * hr + si;
        hr = nr; hi = ni;
    }
}

__device__ __forceinline__ void phase5(const Params& p) {
    const int NU = 512;
    const int lane = TIDX & 63, wid = TIDX >> 6, wr = wid >> 1, wc = wid & 1, fr = lane & 15, fq = lane >> 4;
    for (int u = blockIdx.x; u < NU; u += gridDim.x) {
        const int ct = u & 7, mh = (u >> 3) & 1, g = u >> 4;
        const u16* A = WSP_TabY + ((size_t)g * 256 + mh * 128) * 512;
        const u16* Ub = WSP_U + (size_t)ct * 128 * 16 * 512 + g * 16;
        const u16* Hb_ = WSP_Hin + (size_t)ct * 128 * 8192 + g * 256;
        f32x4 acc[4][4];
        gemm_tile(8,
            [&](int R, int C, int kt) { return (const void*)(A + (size_t)R * 512 + kt * 64 + C); },
            [&](int R, int C, int kt) {
                return kt < 4 ? (const void*)(Ub + (size_t)(R * 16 + kt * 4 + (C >> 4)) * 512 + (C & 15))
                              : (const void*)(Hb_ + (size_t)R * 8192 + (kt - 4) * 64 + C);
            }, acc);
#pragma unroll
        for (int m = 0; m < 4; ++m)
#pragma unroll
            for (int n = 0; n < 4; ++n) {
                const int t = mh * 8 + wr * 4 + m;
                const int cg = ct * 128 + wc * 64 + n * 16 + fr;
                u16* dst = WSP_Y + ((size_t)cg * 16 + t) * 512 + g * 16 + fq * 4;
                *(uint2*)dst = make_uint2(pack2(gelu_tanh(acc[m][n][0]), gelu_tanh(acc[m][n][1])),
                                          pack2(gelu_tanh(acc[m][n][2]), gelu_tanh(acc[m][n][3])));
            }
    }
}

__device__ __forceinline__ void phase6(const Params& p) {
    const int NU = 512;
    const int lane = TIDX & 63, wid = TIDX >> 6, wr = wid >> 1, wc = wid & 1, fr = lane & 15, fq = lane >> 4;
    for (int u = blockIdx.x; u < NU; u += gridDim.x) {
        const int mt = u >> 2, nt = u & 3;
        const u16* A = WSP_Y + (size_t)mt * 128 * 512;
        const u16* B = WSP_WgluT + (size_t)nt * 128 * 512;
        f32x4 acc[4][4];
        gemm_tile(8,
            [&](int R, int C, int kt) { return (const void*)(A + (size_t)R * 512 + kt * 64 + C); },
            [&](int R, int C, int kt) { return (const void*)(B + (size_t)R * 512 + kt * 64 + C); }, acc);
        const int row0 = mt * 128 + wr * 64, col0 = nt * 128 + wc * 64;
        char* base = smem + wid * 9216;
        float bg[4];
#pragma unroll
        for (int n = 0; n < 4; ++n) bg[n] = p.b_glu[col0 + n * 16 + fr];
#pragma unroll
        for (int m = 0; m < 4; ++m)
#pragma unroll
            for (int j = 0; j < 4; ++j) {
                const int rl = m * 16 + fq * 4 + j, r = row0 + rl;
                float sq = 0.f;
#pragma unroll
                for (int n = 0; n < 4; ++n) {
                    const int c = col0 + n * 16 + fr;
                    const float yv = bf2f(WSP_Y[(size_t)r * 512 + c]);
                    const u16 ob = f2bf(yv * sigmoidf_(acc[m][n][j] + bg[n]));
                    *(u16*)(base + rl * 144 + (n * 16 + fr) * 2) = ob;
                    const float of = bf2f(ob);
                    sq += of * of;
                }
                sq += __shfl_xor(sq, 1); sq += __shfl_xor(sq, 2); sq += __shfl_xor(sq, 4); sq += __shfl_xor(sq, 8);
                if (fr == 0) unsafeAtomicAdd(WSP_rsq + (size_t)r * 2 + 1, sq);
            }
        asm volatile("s_waitcnt lgkmcnt(0)" ::: "memory");
        __builtin_amdgcn_wave_barrier();
        u16* dbase = WSP_SO + (size_t)row0 * 512 + col0;
#pragma unroll
        for (int i = 0; i < 8; ++i) {
            const int id = i * 64 + lane, row = id >> 3, ch = id & 7;
            *(uint4*)(dbase + (size_t)row * 512 + ch * 8) = *(const uint4*)(base + row * 144 + ch * 16);
        }
        asm volatile("s_waitcnt lgkmcnt(0)" ::: "memory");
        __builtin_amdgcn_wave_barrier();
    }
}

__device__ __forceinline__ void phase7(const Params& p) {
    const int lane = TIDX & 63;
    const int wv = blockIdx.x * 4 + (TIDX >> 6), nwv = gridDim.x * 4;
    for (int it = wv; it < NLAT * 2; it += nwv) {
        const int r = it >> 1, half = it & 1;
        const u16* src = (half ? WSP_SO : WSP_AO) + (size_t)r * 512 + lane * 8;
        const float* gain = (half ? p.norm_ssm_out : p.norm_attn_out) + lane * 8;
        const uint4 d = *(const uint4*)src;
        float f[8];
        f[0] = bf2f((u16)(d.x & 0xffff)); f[1] = bf2f((u16)(d.x >> 16));
        f[2] = bf2f((u16)(d.y & 0xffff)); f[3] = bf2f((u16)(d.y >> 16));
        f[4] = bf2f((u16)(d.z & 0xffff)); f[5] = bf2f((u16)(d.z >> 16));
        f[6] = bf2f((u16)(d.w & 0xffff)); f[7] = bf2f((u16)(d.w >> 16));
        float ss = 0.f;
#pragma unroll
        for (int i = 0; i < 8; ++i) ss += f[i] * f[i];
        ss = wave_sum(ss);
        const float rs = rsqrtf(ss * (1.f / 512.f) + EPS);
        const float4 g0 = *(const float4*)gain, g1 = *(const float4*)(gain + 4);
        *(uint4*)(WSP_CAT + (size_t)r * 1024 + half * 512 + lane * 8) =
            make_uint4(pack2(f[0] * rs * g0.x, f[1] * rs * g0.y), pack2(f[2] * rs * g0.z, f[3] * rs * g0.w),
                       pack2(f[4] * rs * g1.x, f[5] * rs * g1.y), pack2(f[6] * rs * g1.z, f[7] * rs * g1.w));
    }
}

__device__ __forceinline__ void phase8(const Params& p) {
    const int NU = 512;
    for (int u = blockIdx.x; u < NU; u += gridDim.x) {
        const int mt = u >> 2, nt = u & 3;
        const u16* A1 = WSP_AO + (size_t)mt * 128 * 512;
        const u16* A2 = WSP_SO + (size_t)mt * 128 * 512;
        const u16* B = WSP_WoutT + (size_t)nt * 256 * 1024;
        f32x4 acc[4][8];
        {
        const int tid1 = TIDX, fq = (tid1 & 63) >> 4, row0 = mt * 128 + (tid1 >> 7) * 64;
        gemm_tile_w(32,
            [&](int i, int R, int C, int kt) { return (const void*)((kt < 16 ? A1 : A2) + (size_t)R * 512 + (kt & 15) * 32 + C); },
            [&](int i, int R, int C, int kt) { return (const void*)(B + (size_t)R * 1024 + kt * 32 + C); }, acc,
            [&](int kt) {
                if (kt == 16) {
#pragma unroll
                    for (int m = 0; m < 4; ++m) {
                        asm volatile("" ::: "memory");
#pragma unroll
                        for (int j = 0; j < 4; ++j) {
                            const float2 q = *(const float2*)(WSP_rsq + (size_t)(row0 + m * 16 + fq * 4 + j) * 2);
                            const float ratio = rsqrtf(q.x * (1.f / 512.f) + EPS) / rsqrtf(q.y * (1.f / 512.f) + EPS);
#pragma unroll
                            for (int n = 0; n < 8; ++n) acc[m][n][j] *= ratio;
                        }
                    }
                }
            });
        }
        const int tid2 = TIDX, lane = tid2 & 63, wid = tid2 >> 6, fr = lane & 15, fq = lane >> 4;
        const int row0 = mt * 128 + (wid >> 1) * 64, col0 = nt * 256 + (wid & 1) * 128;
        const float* g1 = WSP_mod + (mt >> 4) * 6144 + 2048 + col0;
        float* stg = (float*)(smem + wid * 8448);
#pragma unroll
        for (int m = 0; m < 4; ++m) {
#pragma unroll
            for (int n = 0; n < 8; ++n)
#pragma unroll
                for (int j = 0; j < 4; ++j) stg[(fq * 4 + j) * 132 + n * 16 + fr] = acc[m][n][j];
            asm volatile("s_waitcnt lgkmcnt(0)" ::: "memory");
            __builtin_amdgcn_wave_barrier();
#pragma unroll
            for (int i = 0; i < 8; ++i) {
                const int id = i * 64 + lane, rr = id >> 5, c4 = (id & 31) * 4;
                float4 v = *(const float4*)(stg + rr * 132 + c4);
                const float rsv = rsqrtf(WSP_rsq[(size_t)(row0 + m * 16 + rr) * 2 + 1] * (1.f / 512.f) + EPS);
                v.x *= rsv; v.y *= rsv; v.z *= rsv; v.w *= rsv;
                const float4 g = *(const float4*)(g1 + c4);
                const size_t o = (size_t)(row0 + m * 16 + rr) * 1024 + col0 + c4;
                const float4 xv = *(const float4*)(p.x + o);
                *(float4*)(p.out + o) = make_float4(xv.x + g.x * v.x, xv.y + g.y * v.y, xv.z + g.z * v.z, xv.w + g.w * v.w);
            }
            asm volatile("s_waitcnt lgkmcnt(0)" ::: "memory");
            __builtin_amdgcn_wave_barrier();
        }
    }
}

#define CTR_ECNT 0
#define CTR_Q11 128
#define CTR_Q12 136
#define HALF_TOK 8192
#define HH_HALF_ROWS 73728
#define ELIST_CAP 8192
__device__ __forceinline__ void phase9(const Params& p) {
    const int tid = TIDX, lane = tid & 63, wid = tid >> 6, fr = lane & 15, fq = lane >> 4;
    char* At = smem;
    float* sc = (float*)(smem + 32768);
    int* hist = (int*)(smem + 32768 + 4096);
    int* gbase = hist + 64;
    int* fill = gbase + 64;
    unsigned char* selk = (unsigned char*)(fill + 64);
    float* selw = (float*)(selk + 256);
    for (int chunk = blockIdx.x; chunk < NLAT / 32; chunk += gridDim.x) {
        __syncthreads();
        if (tid < 64) hist[tid] = 0;
        for (int grp = 0; grp < 2; ++grp) {
            const int tok0 = chunk * 32 + grp * 16;
            __syncthreads();
            float4 vall[4][4];
#pragma unroll
            for (int rr = 0; rr < 4; ++rr)
#pragma unroll
                for (int i = 0; i < 4; ++i) vall[rr][i] = *(const float4*)(p.out + (size_t)(tok0 + wid * 4 + rr) * 1024 + i * 256 + lane * 4);
#pragma unroll
            for (int rr = 0; rr < 4; ++rr) {
                const int row = wid * 4 + rr, tok = tok0 + row;
                const float* md = WSP_mod + (tok >> 11) * 6144;
                float4 v[4];
                float ss = 0.f;
#pragma unroll
                for (int i = 0; i < 4; ++i) {
                    v[i] = vall[rr][i];
                    ss += v[i].x * v[i].x + v[i].y * v[i].y + v[i].z * v[i].z + v[i].w * v[i].w;
                }
                ss = wave_sum(ss);
                const float rs = rsqrtf(ss * (1.f / 1024.f) + EPS);
#pragma unroll
                for (int i = 0; i < 4; ++i) {
                    const int c0 = i * 256 + lane * 4;
                    const float4 g = *(const float4*)(p.norm_ffn + c0), s = *(const float4*)(md + 3072 + c0), k = *(const float4*)(md + 4096 + c0);
                    const float a = v[i].x * rs * g.x * (1.f + k.x) + s.x, b = v[i].y * rs * g.y * (1.f + k.y) + s.y;
                    const float c = v[i].z * rs * g.z * (1.f + k.z) + s.z, d = v[i].w * rs * g.w * (1.f + k.w) + s.w;
                    const uint2 pk = make_uint2(pack2(a, b), pack2(c, d));
                    *(uint2*)(WSP_H2 + (size_t)tok * 1024 + c0) = pk;
                    const int ch = c0 >> 3;
                    *(uint2*)(At + row * 2048 + ((ch ^ row) << 4) + ((c0 & 4) << 1)) = pk;
                }
            }
            __syncthreads();
            f32x4 acc = {0.f, 0.f, 0.f, 0.f};
            const u16* bp = WSP_WrT + (size_t)(wid * 16 + fr) * 1024 + fq * 8;
#pragma unroll
            for (int kb = 0; kb < 4; ++kb) {
                bf16x8 bfr[8];
#pragma unroll
                for (int q = 0; q < 8; ++q) bfr[q] = *(const bf16x8*)(bp + (kb * 8 + q) * 32);
#pragma unroll
                for (int q = 0; q < 8; ++q) {
                    const int ch = (kb * 8 + q) * 4 + fq;
                    const bf16x8 a = *(const bf16x8*)(At + fr * 2048 + ((ch ^ fr) << 4));
                    acc = __builtin_amdgcn_mfma_f32_16x16x32_bf16(a, bfr[q], acc, 0, 0, 0);
                }
            }
#pragma unroll
            for (int j = 0; j < 4; ++j) sc[(fq * 4 + j) * 64 + wid * 16 + fr] = sigmoidf_(acc[j]);
            __syncthreads();
            const float bias = p.router_bias[lane];
            const int eg = lane >> 3;
            for (int rr = 0; rr < 4; ++rr) {
                const int row = wid * 4 + rr, tok = tok0 + row;
                const float s = sc[row * 64 + lane];
                const float bz = s + bias;
                float m1 = bz;
                m1 = fmaxf(m1, __shfl_xor(m1, 1)); m1 = fmaxf(m1, __shfl_xor(m1, 2)); m1 = fmaxf(m1, __shfl_xor(m1, 4));
                const unsigned long long eq = __ballot(bz == m1);
                const unsigned gb = (unsigned)((eq >> (eg * 8)) & 0xffull);
                const int first = __ffs(gb) - 1;
                float v2 = ((lane & 7) == first) ? -1e30f : bz;
                v2 = fmaxf(v2, __shfl_xor(v2, 1)); v2 = fmaxf(v2, __shfl_xor(v2, 2)); v2 = fmaxf(v2, __shfl_xor(v2, 4));
                const float gs = m1 + v2;
                int cnt = 0;
#pragma unroll
                for (int j = 0; j < 8; ++j) {
                    const float gj = __int_as_float(__builtin_amdgcn_readlane(__float_as_int(gs), j * 8));
                    cnt += (gj > gs || (gj == gs && j < eg)) ? 1 : 0;
                }
                const bool gsel = cnt < 4;
                const float mv = gsel ? bz : -1e30f;
                int rank = 0;
#pragma unroll
                for (int j = 0; j < 64; ++j) {
                    const float vj = __int_as_float(__builtin_amdgcn_readlane(__float_as_int(mv), j));
                    rank += (vj > mv || (vj == mv && j < lane)) ? 1 : 0;
                }
                const bool sel = gsel && rank < 8;
                const float tot = wave_sum(sel ? s : 0.f);
                if (sel) {
                    selw[(grp * 16 + row) * 8 + rank] = s / tot * 2.5f;
                    selk[(grp * 16 + row) * 8 + rank] = (unsigned char)lane;
                    atomicAdd(&hist[lane], 1);
                }
            }
        }
        __syncthreads();
        const int h = (chunk * 32) >> 13;
        if (tid < 64) {
            gbase[tid] = hist[tid] ? (int)atomicAdd(&WSP_ctr[CTR_ECNT + h * 64 + tid], (unsigned)hist[tid]) : 0;
            fill[tid] = 0;
        }
        __syncthreads();
        {
            const int e = selk[tid];
            const int pos = atomicAdd(&fill[e], 1);
            WSP_elist[(size_t)(h * 64 + e) * ELIST_CAP + gbase[e] + pos] = (chunk * 32 + (tid >> 3)) * 8 + (tid & 7);
            WSP_wsl[(size_t)(h * 64 + e) * ELIST_CAP + gbase[e] + pos] = selw[tid];
        }
    }
}

struct MoeTab { int cnt[16]; int soff[16]; int pre[17]; };

__device__ __forceinline__ void phase11(const Params& p) {
    const int tid = TIDX, lane = tid & 63, wid = tid >> 6, wr = wid >> 1, wc = wid & 1, fr = lane & 15, fq = lane >> 4;
    const int sb = lane * 16, swz = sb ^ (((sb >> 9) & 1) << 5);
    const int r_in = swz >> 6, c_in = (swz & 63) >> 1;
    int* tab = (int*)(smem + 73728);
    int* t_cnt = tab, *t_soff = tab + 16, *t_pre = tab + 32, *t_q = tab + 52;
    const int x = blockIdx.x & 7;
    __syncthreads();
    int* t_all = tab + 64;
    if (tid < 128) t_all[tid] = (int)WSP_ctr[CTR_ECNT + tid];
    if (tid == 0) t_q[0] = (int)atomicAdd(&WSP_ctr[CTR_Q11 + x], 1u);
    __syncthreads();
    if (tid < 16) {
        const int i = tid >> 1, h = tid & 1, e = x + 8 * i;
        t_cnt[tid] = t_all[h * 64 + e];
        int so = 0;
        for (int e2 = 0; e2 < e; ++e2) so += t_all[h * 64 + e2];
        t_soff[tid] = so;
    }
    __syncthreads();
    if (tid == 0) {
        int s = 0;
        for (int j = 0; j < 16; ++j) { t_pre[j] = s; s += (t_cnt[j] + 127) >> 7; }
        t_pre[16] = s;
    }
    __syncthreads();
    const int T_r = t_pre[16], T_all = T_r + 16;
    for (;;) {
        __syncthreads();
        const int u = __builtin_amdgcn_readfirstlane(t_q[0]);
        __syncthreads();
        if (u >= T_all) break;
        if (tid == 0) t_q[0] = (int)atomicAdd(&WSP_ctr[CTR_Q11 + x], 1u);
        int e, h, mt, c, rowbase;
        const int* el = nullptr;
        if (u < T_r) {
            int j = 0;
#pragma unroll
            for (int q = 1; q < 16; ++q) j += (u >= t_pre[q]) ? 1 : 0;
            e = x + 8 * (j >> 1); h = j & 1; mt = u - t_pre[j]; c = t_cnt[j];
            rowbase = h * HH_HALF_ROWS + t_soff[j];
            el = WSP_elist + (size_t)(h * 64 + e) * ELIST_CAP;
        } else {
            const int ms = x * 16 + (u - T_r);
            e = 64; h = ms >> 6; mt = ms & 63; c = HALF_TOK;
            rowbase = h * HH_HALF_ROWS + 65536;
        }
        e = __builtin_amdgcn_readfirstlane(e); h = __builtin_amdgcn_readfirstlane(h); mt = __builtin_amdgcn_readfirstlane(mt);
        c = __builtin_amdgcn_readfirstlane(c); rowbase = __builtin_amdgcn_readfirstlane(rowbase);
        if (e < 64) el = WSP_elist + (size_t)(h * 64 + e) * ELIST_CAP;
        const float* wsl = WSP_wsl + (size_t)(h * 64 + (e & 63)) * ELIST_CAP;
        const u16* aptr[2];
#pragma unroll
        for (int i = 0; i < 2; ++i) {
            int li = mt * 128 + (wid + 4 * i) * 16 + r_in;
            li = li < c ? li : c - 1;
            const int tok = (e < 64) ? (el[li] >> 3) : (h * HALF_TOK + li);
            aptr[i] = WSP_H2 + (size_t)tok * 1024 + c_in;
        }
        const u16* Bw = WSP_WguT + (size_t)e * 262144 + c_in;
        f32x4 acc[4][8];
        gemm_tile_w(32,
            [&](int i, int R, int C, int kt) { return (const void*)(aptr[i] + kt * 32); },
            [&](int i, int R, int C, int kt) { return (const void*)(Bw + (size_t)R * 1024 + kt * 32); }, acc);
        float wgt[4][4];
#pragma unroll
        for (int m = 0; m < 4; ++m)
#pragma unroll
            for (int j = 0; j < 4; ++j) {
                const int li = mt * 128 + wr * 64 + m * 16 + fq * 4 + j;
                float w = 1.f;
                if (e < 64) w = (li < c) ? wsl[li] : 0.f;
                wgt[m][j] = w;
            }
        u16* dbase = WSP_HHs + ((size_t)rowbase + mt * 128 + wr * 64) * 128 + wc * 64;
        const int vrows = c - mt * 128 - wr * 64;
        wave_store_bf16_f([&](int m, int n2, int j) { return siluf_(acc[m][2 * n2][j]) * acc[m][2 * n2 + 1][j] * wgt[m][j]; },
                          [&](int row) { return row < vrows ? dbase + (size_t)row * 128 : (u16*)nullptr; });
    }
}

#define YD_SCALE 8.0f
template <class FV, class FD>
__device__ __forceinline__ void wave_store_fp8_f(FV val, FD dst) {
    const int lane = TIDX & 63, wid = TIDX >> 6, fr = lane & 15, fq = lane >> 4;
    char* base = smem + wid * 9216;
#pragma unroll
    for (int m = 0; m < 4; ++m)
#pragma unroll
        for (int n = 0; n < 8; ++n)
#pragma unroll
            for (int j = 0; j < 4; ++j)
                *(unsigned char*)(base + (m * 16 + fq * 4 + j) * 144 + n * 16 + fr) =
                    (unsigned char)(__builtin_amdgcn_cvt_pk_fp8_f32(val(m, n, j), 0.f, 0, false) & 0xff);
    asm volatile("s_waitcnt lgkmcnt(0)" ::: "memory");
    __builtin_amdgcn_wave_barrier();
#pragma unroll
    for (int i = 0; i < 8; ++i) {
        const int id = i * 64 + lane, row = id >> 3, ch = id & 7;
        const uint4 d = *(const uint4*)(base + row * 144 + ch * 16);
        unsigned char* q = dst(i, row);
        if (q) *(uint4*)(q + ch * 16) = d;
    }
    asm volatile("s_waitcnt lgkmcnt(0)" ::: "memory");
    __builtin_amdgcn_wave_barrier();
}

__device__ __forceinline__ void phase12a(const Params& p) {
    const int tid = TIDX, lane = tid & 63, wid = tid >> 6, wr = wid >> 1, wc = wid & 1;
    const int sb = lane * 16, swz = sb ^ (((sb >> 9) & 1) << 5);
    const int r_in = swz >> 6, c_in = (swz & 63) >> 1;
    int* tab = (int*)(smem + 73728);
    int* t_cnt = tab, *t_soff = tab + 16, *t_pre = tab + 32, *t_q = tab + 52;
    int* t_all = tab + 64;
    const int x = blockIdx.x & 7;
    __syncthreads();
    if (tid < 128) t_all[tid] = (int)WSP_ctr[CTR_ECNT + tid];
    if (tid == 0) t_q[0] = (int)atomicAdd(&WSP_ctr[CTR_Q12 + x], 1u);
    __syncthreads();
    if (tid < 16) {
        const int i = tid >> 1, h = tid & 1, e = x + 8 * i;
        t_cnt[tid] = t_all[h * 64 + e];
        int so = 0;
        for (int e2 = 0; e2 < e; ++e2) so += t_all[h * 64 + e2];
        t_soff[tid] = so;
    }
    __syncthreads();
    if (tid == 0) {
        int s = 0;
        for (int j = 0; j < 16; ++j) { t_pre[j] = s; s += (t_cnt[j] + 127) >> 7; }
        t_pre[16] = s;
    }
    __syncthreads();
    const int T_r = t_pre[16] * 4, T_all = T_r + 64;
    unsigned char* Yd8 = (unsigned char*)(p.ws + OFF_ARENA);
    for (;;) {
        __syncthreads();
        const int u = __builtin_amdgcn_readfirstlane(t_q[0]);
        __syncthreads();
        if (u >= T_all) break;
        if (tid == 0) t_q[0] = (int)atomicAdd(&WSP_ctr[CTR_Q12 + x], 1u);
        int e, h, mt, nt, c, rowbase;
        if (u < T_r) {
            const int um = u >> 2; nt = u & 3;
            int j = 0;
#pragma unroll
            for (int q = 1; q < 16; ++q) j += (um >= t_pre[q]) ? 1 : 0;
            e = x + 8 * (j >> 1); h = j & 1; mt = um - t_pre[j]; c = t_cnt[j];
            rowbase = h * HH_HALF_ROWS + t_soff[j];
        } else {
            const int us = u - T_r; nt = us & 3;
            const int ms = x * 16 + (us >> 2);
            e = 64; h = ms >> 6; mt = ms & 63; c = HALF_TOK; rowbase = h * HH_HALF_ROWS + 65536;
        }
        e = __builtin_amdgcn_readfirstlane(e); h = __builtin_amdgcn_readfirstlane(h); mt = __builtin_amdgcn_readfirstlane(mt);
        nt = __builtin_amdgcn_readfirstlane(nt); c = __builtin_amdgcn_readfirstlane(c); rowbase = __builtin_amdgcn_readfirstlane(rowbase);
        const int* el = WSP_elist + (size_t)(h * 64 + (e & 63)) * ELIST_CAP;
        const u16* aptr[2];
#pragma unroll
        for (int i = 0; i < 2; ++i) {
            int li = mt * 128 + (wid + 4 * i) * 16 + r_in;
            li = li < c ? li : c - 1;
            aptr[i] = WSP_HHs + ((size_t)rowbase + li) * 128 + c_in;
        }
        const u16* Bw = WSP_WdT + ((size_t)e * 1024 + nt * 256) * 128 + c_in;
        const int vrows = c - mt * 128 - wr * 64;
        int slot[8];
        if (e < 64) {
#pragma unroll
            for (int i = 0; i < 8; ++i) {
                int li = mt * 128 + wr * 64 + ((i * 64 + lane) >> 3);
                li = li < c ? li : c - 1;
                slot[i] = el[li];
            }
        } else {
#pragma unroll
            for (int i = 0; i < 8; ++i) slot[i] = (h * HALF_TOK + mt * 128 + wr * 64 + ((i * 64 + lane) >> 3)) * 8;
        }
        f32x4 acc[4][8];
        gemm_tile_w(4,
            [&](int i, int R, int C, int kt) { return (const void*)(aptr[i] + kt * 32); },
            [&](int i, int R, int C, int kt) { return (const void*)(Bw + (size_t)R * 128 + kt * 32); }, acc);
        const int colo = nt * 256 + wc * 128;
        wave_store_fp8_f([&](int m, int n, int j) { return acc[m][n][j] * YD_SCALE; }, [&](int i, int row) {
            if (row >= vrows) return (unsigned char*)nullptr;
            const int s = slot[i];
            const int tok = s >> 3, k = (e == 64) ? 8 : (s & 7);
            return Yd8 + ((size_t)tok * 9 + k) * 1024 + colo;
        });
    }
}

template <bool DUMMY>
__device__ __forceinline__ void phase12b_t(const Params& p) {
    const int lane = TIDX & 63;
    const int wv = blockIdx.x * 4 + (TIDX >> 6), nwv = gridDim.x * 4;
    const unsigned char* Yd8 = (const unsigned char*)(p.ws + OFF_ARENA);
    for (int tok = wv; tok < NLAT; tok += nwv) {
        float* row = p.out + (size_t)tok * 1024 + lane * 16;
        float* orow = DUMMY ? (float*)(p.ws + OFF_HHS) + (size_t)(tok & 8191) * 1024 + lane * 16 : row;
        const float* g2 = WSP_mod + (tok >> 11) * 6144 + 5120 + lane * 16;
        float s[16];
#pragma unroll
        for (int i = 0; i < 16; ++i) s[i] = 0.f;
        const unsigned char* yp = Yd8 + (size_t)tok * 9 * 1024 + lane * 16;
        uint4 yv[9];
#pragma unroll
        for (int k = 0; k < 9; ++k) yv[k] = *(const uint4*)(yp + k * 1024);
#pragma unroll
        for (int k = 0; k < 9; ++k) {
            const unsigned w[4] = {yv[k].x, yv[k].y, yv[k].z, yv[k].w};
#pragma unroll
            for (int i = 0; i < 4; ++i) {
                const auto lo = __builtin_amdgcn_cvt_pk_f32_fp8((int)w[i], false);
                const auto hi = __builtin_amdgcn_cvt_pk_f32_fp8((int)w[i], true);
                s[4 * i] += lo[0]; s[4 * i + 1] += lo[1]; s[4 * i + 2] += hi[0]; s[4 * i + 3] += hi[1];
            }
        }
        float ss = 0.f;
#pragma unroll
        for (int q = 0; q < 4; ++q) {
            const float4 xv = *(const float4*)(row + q * 4), gv = *(const float4*)(g2 + q * 4);
            s[4 * q] = xv.x + gv.x * (1.f / YD_SCALE) * s[4 * q]; s[4 * q + 1] = xv.y + gv.y * (1.f / YD_SCALE) * s[4 * q + 1];
            s[4 * q + 2] = xv.z + gv.z * (1.f / YD_SCALE) * s[4 * q + 2]; s[4 * q + 3] = xv.w + gv.w * (1.f / YD_SCALE) * s[4 * q + 3];
            ss += s[4 * q] * s[4 * q] + s[4 * q + 1] * s[4 * q + 1] + s[4 * q + 2] * s[4 * q + 2] + s[4 * q + 3] * s[4 * q + 3];
        }
        ss = wave_sum(ss);
        const float rs = rsqrtf(ss * (1.f / 1024.f) + EPS);
#pragma unroll
        for (int q = 0; q < 4; ++q) {
            const float4 g = *(const float4*)(p.norm_final + lane * 16 + q * 4);
            *(float4*)(orow + q * 4) = make_float4(s[4 * q] * rs * g.x, s[4 * q + 1] * rs * g.y, s[4 * q + 2] * rs * g.z, s[4 * q + 3] * rs * g.w);
        }
    }
}

#define SMEM_TOTAL (73728 + 1024 + 64)

#if 1
__global__ void __launch_bounds__(NTHR, 2) k_mega(Params p) {
    volatile LAS unsigned* st = (volatile LAS unsigned*)(smem + SMEM_TOTAL - 16);
    if (TIDX == 0) { st[0] = 0u; st[1] = 0u; st[2] = 0u; st[3] = 0u; }
    __syncthreads();
    XcdBarrier bar = xcd_barrier_post(WSP_bar, st);
#define RUNP(N) do { phase##N(p); if (PROBE_DUP == N) phase##N(p); } while (0)
    RUNP(0);  xcd_barrier(bar);
    RUNP(1);  xcd_barrier(bar);
    RUNP(2);  xcd_barrier(bar);
    RUNP(3);  xcd_barrier(bar);
    RUNP(4);  xcd_barrier(bar);
    RUNP(5);  xcd_barrier(bar);
    RUNP(6);  xcd_barrier(bar);
    RUNP(8);  xcd_barrier(bar);
    phase9(p); xcd_barrier(bar);
#if PROBE_DUP == 9
    if (blockIdx.x == 0 && TIDX < 128) WSP_ctr[CTR_ECNT + TIDX] = 0u;
    xcd_barrier(bar); phase9(p); xcd_barrier(bar);
#endif
    phase11(p); xcd_barrier(bar);
#if PROBE_DUP == 11
    if (blockIdx.x == 0 && TIDX < 8) WSP_ctr[CTR_Q11 + TIDX] = 0u;
    xcd_barrier(bar); phase11(p); xcd_barrier(bar);
#endif
    phase12a(p); xcd_barrier(bar);
#if PROBE_DUP == 120
    if (blockIdx.x == 0 && TIDX < 8) WSP_ctr[CTR_Q12 + TIDX] = 0u;
    xcd_barrier(bar); phase12a(p); xcd_barrier(bar);
#endif
#if PROBE_DUP == 121
    phase12b_t<true>(p); xcd_barrier(bar);
#endif
    phase12b_t<false>(p);
}
#endif


extern "C" void kernel_launch(void* const* d_in, const int* in_sizes, int n_in,
                              void* d_out, int out_size, void* d_ws, size_t ws_size,
                              hipStream_t stream) {
    Params p{};
    const float** ip = (const float**)&p.x;
    for (int i = 0; i < 32; ++i) ip[i] = (const float*)d_in[i];
    p.out = (float*)d_out;
    p.ws = (char*)d_ws;
    if (OFF_END > ws_size) { fprintf(stderr, "workspace too small: need %zu have %zu\n", (size_t)OFF_END, ws_size); return; }

    static int grid = 0;
    if (!grid) {
        hipFuncSetAttribute((const void*)k_mega, hipFuncAttributeMaxDynamicSharedMemorySize, SMEM_TOTAL);
        int dev = 0, cus = 0, per_cu = 0;
        hipGetDevice(&dev);
        hipDeviceGetAttribute(&cus, hipDeviceAttributeMultiprocessorCount, dev);
        hipOccupancyMaxActiveBlocksPerMultiprocessor(&per_cu, (const void*)k_mega, NTHR, SMEM_TOTAL);
        if (per_cu < 1) per_cu = 1;
        grid = cus * (per_cu < 2 ? per_cu : 2);
    }
    hipMemsetAsync(p.ws + OFF_BAR, 0, ZERO_BYTES, stream);
    k_mega<<<grid, NTHR, SMEM_TOTAL, stream>>>(p);
}
```

```cpp
#include <hip/hip_runtime.h>
#include <hip/hip_bf16.h>
#include <stdint.h>
#include <stdio.h>

#ifndef MK_MULTI
#define MK_MULTI 0
#endif

typedef __attribute__((ext_vector_type(8))) short bf16x8;
typedef __attribute__((ext_vector_type(4))) short bf16x4;
typedef __attribute__((ext_vector_type(4))) float f32x4;
typedef unsigned short u16;
typedef __attribute__((ext_vector_type(4))) unsigned u32x4;

#ifndef PROBE_DUP
#define PROBE_DUP -1
#endif
#define NTHR 256
__device__ __forceinline__ int opaque_tid() { int t = (int)threadIdx.x; asm volatile("" : "+v"(t)); return t; }
#define TIDX opaque_tid()
#define LDS_BYTES 65536

#define D_MODEL 1024
#define BATCH 8
#define SEQ 2048
#define CTXL 256
#define NLAT (BATCH * SEQ)
#define NCTX (BATCH * CTXL)
#define NROWS (NLAT + NCTX)
#define INW 1280
#define NEXP 64
#define VT_LD (SEQ + CTXL)
#define NCHUNK_LAT 1024
#define NCHUNK_ALL 1152
#define EPS 1e-6f

#define XB_TMO      128
#define XB_XCNT(j)  (256  + 64 * (j))
#define XB_XSUB(j)  (1280 + 64 * (j))
#define XB_XGEN(j)  (2304 + 64 * (j))
#define XB_TOP      3328
#define XB_TOPGEN   3392
#define XCD_BAR_WORDS 3456
#define XB_SPIN_CAP (1u << 20)
#define LAS __attribute__((address_space(3)))

__device__ __forceinline__ unsigned xb_ld(unsigned* p)              { return __hip_atomic_load(p, __ATOMIC_RELAXED, __HIP_MEMORY_SCOPE_AGENT); }
__device__ __forceinline__ unsigned xb_add(unsigned* p, unsigned v) { return __hip_atomic_fetch_add(p, v, __ATOMIC_RELAXED, __HIP_MEMORY_SCOPE_AGENT); }
__device__ __forceinline__ unsigned xb_xcc_id() { return (unsigned)__builtin_amdgcn_s_getreg((3 << 11) | 20) & 0xFu; }
#define XB_SPIN(cond, bar) do { unsigned _sp = 0; while (cond) { __builtin_amdgcn_s_sleep(1); \
    if ((++_sp & 255u) == 0u) { if (xb_ld(&(bar)[XB_TMO])) break; if (_sp > XB_SPIN_CAP) { atomicAdd(&(bar)[XB_TMO], 1u); break; } } } } while (0)

struct XcdBarrier { unsigned* bar; unsigned x; volatile LAS unsigned* st; };

__device__ __forceinline__ XcdBarrier xcd_barrier_post(unsigned* bar, volatile LAS unsigned* st) {
    XcdBarrier b; b.bar = bar; b.x = xb_xcc_id(); b.st = st;
    if (TIDX == 0) (void)xb_add(&bar[XB_XCNT(b.x)], 1u);
    return b;
}
__device__ __forceinline__ void xcd_barrier_complete(unsigned* bar, unsigned x, unsigned& nloc, unsigned& nx) {
    const unsigned G = gridDim.x * gridDim.y * gridDim.z;
    unsigned sum, cnt, mine, sp = 0u;
    for (;;) {
        sum = 0u; cnt = 0u; mine = 0u;
#pragma unroll
        for (unsigned j = 0; j < 16; ++j) { const unsigned c = xb_ld(&bar[XB_XCNT(j)]); sum += c; cnt += (c > 0u) ? 1u : 0u; mine = (j == x) ? c : mine; }
        if (sum == G) break;
        __builtin_amdgcn_s_sleep(1);
        if ((++sp & 255u) == 0u) { if (xb_ld(&bar[XB_TMO])) break; if (sp > XB_SPIN_CAP) { atomicAdd(&bar[XB_TMO], 1u); break; } }
    }
    nloc = mine > 0u ? mine : 1u; nx = cnt > 0u ? cnt : 1u;
}
__device__ __forceinline__ void xcd_barrier(const XcdBarrier& b) {
    asm volatile("s_waitcnt vmcnt(0)" ::: "memory");
    __syncthreads();
    if (TIDX == 0) {
        unsigned* bar = b.bar;
        __builtin_amdgcn_s_waitcnt(0);
        unsigned nloc = b.st[0], nx = b.st[1];
        if (nloc == 0u) { xcd_barrier_complete(bar, b.x, nloc, nx); b.st[0] = nloc; b.st[1] = nx; }
        const unsigned old = xb_add(&bar[XB_XSUB(b.x)], 1u);
        const unsigned gen = old / nloc;
        if (old + 1u == (gen + 1u) * nloc) {
            __builtin_amdgcn_fence(__ATOMIC_RELEASE, "agent");
            asm volatile("s_waitcnt vmcnt(0)" ::: "memory");
            const unsigned og = xb_add(&bar[XB_TOP], 1u);
            const unsigned tg = og / nx;
            if (og + 1u == (tg + 1u) * nx) xb_add(&bar[XB_TOPGEN], 1u);
            else XB_SPIN(xb_ld(&bar[XB_TOPGEN]) == tg, bar);
            __builtin_amdgcn_fence(__ATOMIC_ACQUIRE, "agent");
            xb_add(&bar[XB_XGEN(b.x)], 1u);
            asm volatile("s_waitcnt vmcnt(0)" ::: "memory");
        } else {
            XB_SPIN(xb_ld(&bar[XB_XGEN(b.x)]) == gen, bar);
            __builtin_amdgcn_fence(__ATOMIC_ACQUIRE, "agent");
            asm volatile("s_waitcnt vmcnt(0)" ::: "memory");
        }
    }
    __syncthreads();
}

struct Params {
    const float *x, *c, *ctx, *c_ctx, *w_ada, *b_ada, *norm_mix, *norm_ffn, *w_in, *attn_sink,
        *a_re, *a_im, *log_dt, *b_re, *b_im, *c_re, *c_im, *ssm_d, *w_glu, *b_glu, *norm_attn_out, *norm_ssm_out,
        *w_out, *w_router, *router_bias, *w_gate_e, *w_up_e, *w_down_e, *w_gate_s, *w_up_s, *w_down_s, *norm_final;
    float* out;
    char* ws;
};

constexpr size_t A256(size_t v) { return (v + 255) & ~(size_t)255; }
constexpr size_t OFF_BAR   = 0;
constexpr size_t OFF_RSQ   = A256(OFF_BAR + XCD_BAR_WORDS * 4 + 1024);
constexpr size_t ZERO_BYTES = OFF_RSQ + (size_t)NLAT * 2 * 4;
constexpr size_t OFF_MOD   = A256(ZERO_BYTES);
constexpr size_t OFF_ROPE  = A256(OFF_MOD + 9 * 6144 * 4);
constexpr size_t OFF_KBUF  = A256(OFF_ROPE + 64 * 16 * 8);
constexpr size_t OFF_IDX   = A256(OFF_KBUF + (size_t)32 * 2 * 4096 * 4);
constexpr size_t OFF_WGT   = A256(OFF_IDX + (size_t)NLAT * 8);
constexpr size_t OFF_ELIST = A256(OFF_WGT + (size_t)NLAT * 8 * 4);
constexpr size_t OFF_WSL   = A256(OFF_ELIST + (size_t)2 * 64 * 8192 * 4);
constexpr size_t OFF_WINT  = A256(OFF_WSL + (size_t)2 * 64 * 8192 * 4);
constexpr size_t OFF_WGLUT = A256(OFF_WINT + (size_t)1280 * 1024 * 2);
constexpr size_t OFF_WOUTT = A256(OFF_WGLUT + (size_t)512 * 512 * 2);
constexpr size_t OFF_WRT   = A256(OFF_WOUTT + (size_t)1024 * 1024 * 2);
constexpr size_t OFF_WDT   = A256(OFF_WRT + (size_t)128 * 1024 * 2);
constexpr size_t OFF_HHS   = A256(OFF_WDT + (size_t)65 * 1024 * 128 * 2);
constexpr size_t OFF_ARENA = A256(OFF_HHS + (size_t)2 * 73728 * 128 * 2);
constexpr size_t OFF_WGUT  = OFF_ARENA;
constexpr size_t OFF_TABS  = A256(OFF_WGUT + (size_t)65 * 256 * 1024 * 2);
constexpr size_t OFF_TABY  = A256(OFF_TABS + (size_t)32 * 256 * 256 * 2);
constexpr size_t OFF_R1    = A256(OFF_TABY + (size_t)32 * 256 * 512 * 2);
constexpr size_t OFF_R2    = A256(OFF_R1 + (size_t)NROWS * 1024 * 2);
constexpr size_t OFF_R3    = A256(OFF_R2 + (size_t)NLAT * 1024 * 2);
constexpr size_t OFF_R4    = A256(OFF_R3 + (size_t)NLAT * 1024 * 2);
constexpr size_t OFF_END   = A256(OFF_R4 + (size_t)NLAT * 512 * 2 * 2);
static_assert(OFF_END - OFF_ARENA >= (size_t)8192 * 9 * 1024 * 2, "arena must hold Yd");
#define WSP_bar   ((unsigned*)(p.ws + OFF_BAR))
#define WSP_ctr   ((unsigned*)(p.ws + OFF_BAR) + XCD_BAR_WORDS)
#define WSP_rsq   ((float*)(p.ws + OFF_RSQ))
#define WSP_mod   ((float*)(p.ws + OFF_MOD))
#define WSP_rope  ((float2*)(p.ws + OFF_ROPE))
#define WSP_Kbuf  ((float*)(p.ws + OFF_KBUF))
#define WSP_WGT   ((float*)(p.ws + OFF_WGT))
#define WSP_elist ((int*)(p.ws + OFF_ELIST))
#define WSP_wsl   ((float*)(p.ws + OFF_WSL))
#define WSP_WinT  ((u16*)(p.ws + OFF_WINT))
#define WSP_WgluT ((u16*)(p.ws + OFF_WGLUT))
#define WSP_WoutT ((u16*)(p.ws + OFF_WOUTT))
#define WSP_WrT   ((u16*)(p.ws + OFF_WRT))
#define WSP_WdT   ((u16*)(p.ws + OFF_WDT))
#define WSP_HHs   ((u16*)(p.ws + OFF_HHS))
#define WSP_Yd    ((u16*)(p.ws + OFF_ARENA))
#define WSP_WguT  ((u16*)(p.ws + OFF_WGUT))
#define WSP_TabS  ((u16*)(p.ws + OFF_TABS))
#define WSP_TabY  ((u16*)(p.ws + OFF_TABY))
#define WSP_Hb    ((u16*)(p.ws + OFF_R1))
#define WSP_S     ((float*)(p.ws + OFF_R1))
#define WSP_H2    ((u16*)(p.ws + OFF_R1))
#define WSP_Q     ((u16*)(p.ws + OFF_R2))
#define WSP_Kb    ((u16*)(p.ws + OFF_R2 + (size_t)NLAT * 512 * 2))
#define WSP_Vt    ((u16*)(p.ws + OFF_R2 + (size_t)NLAT * 512 * 2 + (size_t)NROWS * 128 * 2))
#define WSP_Y     ((u16*)(p.ws + OFF_R2))
#define WSP_SO    ((u16*)(p.ws + OFF_R2 + (size_t)NLAT * 512 * 2))
#define WSP_U     ((u16*)(p.ws + OFF_R3))
#define WSP_CAT   ((u16*)(p.ws + OFF_R3))
#define WSP_AO    ((u16*)(p.ws + OFF_R4))
#define WSP_Hin   ((u16*)(p.ws + OFF_R4 + (size_t)NLAT * 512 * 2))

extern __shared__ __attribute__((aligned(16))) char smem[];

typedef __bf16 bf2_t __attribute__((ext_vector_type(2)));
typedef float f2_t __attribute__((ext_vector_type(2)));
__device__ __forceinline__ unsigned pack2(float a, float b) {
    const f2_t v = {a, b};
    return __builtin_bit_cast(unsigned, __builtin_convertvector(v, bf2_t));
}
__device__ __forceinline__ u16 f2bf(float f) { return (u16)(pack2(f, 0.f) & 0xffffu); }
__device__ __forceinline__ float bf2f(u16 h) { return __uint_as_float(((unsigned)h) << 16); }
__device__ __forceinline__ void glds16(const void* g, void* l) {
    __builtin_amdgcn_global_load_lds((const unsigned*)g, (unsigned*)l, 16, 0, 0);
}
__device__ __forceinline__ int lds_byte(int r, int c) {
    int st = (r >> 4) * 2 + (c >> 5), rr = r & 15, cc = c & 31, ob = rr * 64 + cc * 2;
    return st * 1024 + (ob ^ (((ob >> 9) & 1) << 5));
}
__device__ __forceinline__ float wave_sum(float v) {
#pragma unroll
    for (int o = 32; o > 0; o >>= 1) v += __shfl_xor(v, o);
    return v;
}
__device__ __forceinline__ float sigmoidf_(float x) { return __builtin_amdgcn_rcpf(1.f + __expf(-x)); }
__device__ __forceinline__ float siluf_(float x) { return x * __builtin_amdgcn_rcpf(1.f + __expf(-x)); }
__device__ __forceinline__ float gelu_tanh(float x) {
    float u = 0.7978845608028654f * (x + 0.044715f * x * x * x);
    return x * __builtin_amdgcn_rcpf(1.f + __expf(-2.f * u));
}

template <class FA, class FB>
__device__ __forceinline__ void gemm_tile(int nkt, FA fa, FB fb, f32x4 (&acc)[4][4]) {
    const int tid = TIDX, lane = tid & 63, wid = tid >> 6, wr = wid >> 1, wc = wid & 1, fr = lane & 15, fq = lane >> 4;
    const int sb = lane * 16, swz = sb ^ (((sb >> 9) & 1) << 5);
    const int r_in = swz >> 6, c_in = (swz & 63) >> 1;
#pragma unroll
    for (int m = 0; m < 4; ++m)
#pragma unroll
        for (int n = 0; n < 4; ++n) acc[m][n] = (f32x4){0.f, 0.f, 0.f, 0.f};
    __syncthreads();
    auto stage = [&](int kt, int s) {
        char* sa = smem + s * 32768;
        char* sbm = sa + 16384;
#pragma unroll
        for (int i = 0; i < 4; ++i) {
            const int st = wid + 4 * i, R = (st >> 1) * 16 + r_in, C = (st & 1) * 32 + c_in;
            glds16(fa(R, C, kt), sa + tid * 16 + i * 4096);
            glds16(fb(R, C, kt), sbm + tid * 16 + i * 4096);
        }
    };
    stage(0, 0);
    for (int kt = 0; kt < nkt; ++kt) {
        asm volatile("s_waitcnt vmcnt(0)" ::: "memory");
        __syncthreads();
        if (kt + 1 < nkt) stage(kt + 1, (kt + 1) & 1);
        const char* sa = smem + (kt & 1) * 32768;
        const char* sbm = sa + 16384;
#pragma unroll
        for (int ks = 0; ks < 2; ++ks) {
            bf16x8 a[4], b[4];
#pragma unroll
            for (int m = 0; m < 4; ++m) a[m] = *(const bf16x8*)(sa + lds_byte(wr * 64 + m * 16 + fr, ks * 32 + fq * 8));
#pragma unroll
            for (int n = 0; n < 4; ++n) b[n] = *(const bf16x8*)(sbm + lds_byte(wc * 64 + n * 16 + fr, ks * 32 + fq * 8));
#pragma unroll
            for (int m = 0; m < 4; ++m)
#pragma unroll
                for (int n = 0; n < 4; ++n) acc[m][n] = __builtin_amdgcn_mfma_f32_16x16x32_bf16(a[m], b[n], acc[m][n], 0, 0, 0);
        }
    }
    __syncthreads();
}

__device__ __forceinline__ int lds32(int r, int c) {
    const int rr = r & 15;
    return (r >> 4) * 1024 + ((rr * 64 + c * 2) ^ (((rr >> 3) & 1) << 5));
}
struct NoHook { __device__ __forceinline__ void operator()(int) const {} };
template <class FA, class FB, class HK = NoHook>
__device__ __forceinline__ void gemm_tile_w(int nkt, FA fa, FB fb, f32x4 (&acc)[4][8], HK hook = HK()) {
    constexpr bool ZERO = true;
    const int tid = TIDX, lane = tid & 63, wid = tid >> 6, wr = wid >> 1, wc = wid & 1, fr = lane & 15, fq = lane >> 4;
    const int sb = lane * 16, swz = sb ^ (((sb >> 9) & 1) << 5);
    const int r_in = swz >> 6, c_in = (swz & 63) >> 1;
    if (ZERO) {
#pragma unroll
        for (int m = 0; m < 4; ++m)
#pragma unroll
            for (int n = 0; n < 8; ++n) acc[m][n] = (f32x4){0.f, 0.f, 0.f, 0.f};
    }
    __syncthreads();
    auto stage = [&](int kt, int s) {
        char* sa = smem + s * 24576;
#pragma unroll
        for (int i = 0; i < 2; ++i) glds16(fa(i, (wid + 4 * i) * 16 + r_in, c_in, kt), sa + tid * 16 + i * 4096);
#pragma unroll
        for (int i = 0; i < 4; ++i) glds16(fb(i, (wid + 4 * i) * 16 + r_in, c_in, kt), sa + 8192 + tid * 16 + i * 4096);
    };
    stage(0, 0);
    if (nkt > 1) stage(1, 1);
    int s_cur = 0, s_nxt = 2;
    for (int kt = 0; kt < nkt; ++kt) {
        hook(kt);
        if (kt + 1 < nkt) asm volatile("s_waitcnt vmcnt(6) lgkmcnt(0)\n\ts_barrier" ::: "memory");
        else asm volatile("s_waitcnt vmcnt(0) lgkmcnt(0)\n\ts_barrier" ::: "memory");
        if (kt + 2 < nkt) stage(kt + 2, s_nxt);
        const char* sa = smem + s_cur * 24576;
        bf16x8 a[4];
#pragma unroll
        for (int m = 0; m < 4; ++m) a[m] = *(const bf16x8*)(sa + lds32(wr * 64 + m * 16 + fr, fq * 8));
#pragma unroll
        for (int nh = 0; nh < 2; ++nh) {
            bf16x8 b[4];
#pragma unroll
            for (int n = 0; n < 4; ++n) b[n] = *(const bf16x8*)(sa + 8192 + lds32(wc * 128 + (nh * 4 + n) * 16 + fr, fq * 8));
#pragma unroll
            for (int m = 0; m < 4; ++m)
#pragma unroll
                for (int n = 0; n < 4; ++n) acc[m][nh * 4 + n] = __builtin_amdgcn_mfma_f32_16x16x32_bf16(a[m], b[n], acc[m][nh * 4 + n], 0, 0, 0);
        }
        s_cur = (s_cur == 2) ? 0 : s_cur + 1;
        s_nxt = (s_nxt == 2) ? 0 : s_nxt + 1;
    }
    __syncthreads();
}

template <class FV, class FD>
__device__ __forceinline__ void wave_store_bf16_f(FV val, FD dst) {
    const int lane = TIDX & 63, wid = TIDX >> 6, fr = lane & 15, fq = lane >> 4;
    char* base = smem + wid * 9216;
#pragma unroll
    for (int m = 0; m < 4; ++m)
#pragma unroll
        for (int n = 0; n < 4; ++n)
#pragma unroll
            for (int j = 0; j < 4; ++j)
                *(u16*)(base + (m * 16 + fq * 4 + j) * 144 + (n * 16 + fr) * 2) = f2bf(val(m, n, j));
    asm volatile("s_waitcnt lgkmcnt(0)" ::: "memory");
    __builtin_amdgcn_wave_barrier();
#pragma unroll
    for (int i = 0; i < 8; ++i) {
        const int id = i * 64 + lane, row = id >> 3, ch = id & 7;
        const uint4 d = *(const uint4*)(base + row * 144 + ch * 16);
        u16* p = dst(row);
        if (p) *(uint4*)(p + ch * 8) = d;
    }
    asm volatile("s_waitcnt lgkmcnt(0)" ::: "memory");
    __builtin_amdgcn_wave_barrier();
}

template <class FD>
__device__ __forceinline__ void wave_store_bf16(const float (&v)[4][4][4], FD dst) {
    wave_store_bf16_f([&](int m, int n, int j) { return v[m][n][j]; }, dst);
}

struct ConvD { const float* src; u16* dst; int ld, ldd, k0, n0, mode, zr; };
__device__ __forceinline__ void conv_load(const Params& p, const ConvD& d, float (&v)[16]) {
    const int tid = TIDX;
#pragma unroll
    for (int i = 0; i < 16; ++i) v[i] = d.src[(size_t)(d.k0 + i * 4 + (tid >> 6)) * d.ld + d.n0 + (tid & 63)];
    if (d.zr == 2) {
#pragma unroll
        for (int i = 0; i < 16; ++i) {
            const int k = d.k0 + i * 4 + (tid >> 6);
            v[i] *= (k < 512) ? p.norm_attn_out[k] : p.norm_ssm_out[k - 512];
        }
    }
}
__device__ __forceinline__ void conv_store(const Params& p, const ConvD& d, const float (&v)[16]) {
    float* t = (float*)smem;
    const int tid = TIDX;
    __syncthreads();
#pragma unroll
    for (int i = 0; i < 16; ++i) t[(i * 4 + (tid >> 6)) * 65 + (tid & 63)] = v[i];
    __syncthreads();
    const int n = tid >> 2, kq = tid & 3;
    unsigned w[8];
#pragma unroll
    for (int i = 0; i < 8; ++i) w[i] = pack2(t[(kq * 16 + 2 * i) * 65 + n], t[(kq * 16 + 2 * i + 1) * 65 + n]);
    const int gn = d.n0 + n;
    int row = gn;
    if (d.mode == 1) row = (gn >> 4) * 32 + (gn & 15);
    else if (d.mode == 2) row = (gn >> 4) * 32 + 16 + (gn & 15);
    else if (d.mode == 3) row = n;
    uint4* o = (uint4*)(d.dst + (size_t)row * d.ldd + d.k0 + kq * 16);
    o[0] = make_uint4(w[0], w[1], w[2], w[3]);
    o[1] = make_uint4(w[4], w[5], w[6], w[7]);
    if (d.zr == 1) {
        uint4* z = (uint4*)(WSP_WrT + (size_t)(64 + n) * 1024 + d.k0 + kq * 16);
        z[0] = make_uint4(0, 0, 0, 0); z[1] = make_uint4(0, 0, 0, 0);
    }
}

__device__ __forceinline__ void ada_item(const Params& p, int item) {
    float* sc = (float*)smem;
    float* red = sc + 9 * 1024;
    const int tid = TIDX;
    __syncthreads();
    for (int i = tid; i < 9 * 1024; i += NTHR) {
        const int r = i >> 10, k = i & 1023;
        const float cv = (r < 8) ? p.c[r * 1024 + k] : p.c_ctx[k];
        sc[i] = siluf_(cv);
    }
    __syncthreads();
    const int kq = tid >> 6, jl = tid & 63, j = item * 64 + jl;
    float acc[9];
#pragma unroll
    for (int r = 0; r < 9; ++r) acc[r] = 0.f;
#pragma unroll 16
    for (int k = kq; k < 1024; k += 4) {
        const float w = p.w_ada[(size_t)k * 6144 + j];
#pragma unroll
        for (int r = 0; r < 9; ++r) acc[r] += sc[r * 1024 + k] * w;
    }
#pragma unroll
    for (int r = 0; r < 9; ++r) red[(kq * 9 + r) * 64 + jl] = acc[r];
    __syncthreads();
    for (int i = tid; i < 9 * 64; i += NTHR) {
        const int r = i >> 6, l = i & 63;
        const float s = red[(0 * 9 + r) * 64 + l] + red[(1 * 9 + r) * 64 + l] + red[(2 * 9 + r) * 64 + l] + red[(3 * 9 + r) * 64 + l];
        WSP_mod[r * 6144 + item * 64 + l] = s + p.b_ada[item * 64 + l];
    }
}

__device__ __forceinline__ void rope_item(const Params& p) {
    for (int i = TIDX; i < 64 * 16; i += NTHR) {
        const int pos = i >> 4, k = i & 15;
        const float inv = exp2f(-(float)k * (13.287712379549449f / 16.f));
        float s, c;
        sincosf((float)pos * inv, &s, &c);
        WSP_rope[i] = make_float2(c, s);
    }
}

__device__ __forceinline__ void ssm_table_item(const Params& p, int g, int dir) {
    float* pw = (float*)smem;
    float* Bb = pw + 17 * 64 * 2;
    float* Cc = Bb + 64 * 16 * 2;
    const int tid = TIDX;
    u16* tabS = WSP_TabS + (size_t)g * 256 * 256;
    u16* tabY = WSP_TabY + (size_t)g * 256 * 512;
    float* Kf = WSP_Kbuf + (size_t)(g * 2 + dir) * 4096;
    __syncthreads();
    {
        const int pidx = dir * 32 + g;
        const float dt = __expf(p.log_dt[pidx]);
        for (int i = tid; i < 17 * 64; i += NTHR) {
            const int tau = i >> 6, n = i & 63;
            const float are = p.a_re[pidx * 64 + n], aim = p.a_im[pidx * 64 + n];
            const float mag = __expf((float)tau * dt * are);
            float rev = (float)tau * (dt * aim * 0.15915494309189535f);
            rev -= rintf(rev);
            pw[i * 2] = mag * __builtin_amdgcn_cosf(rev);
            pw[i * 2 + 1] = mag * __builtin_amdgcn_sinf(rev);
        }
        __syncthreads();
        for (int i = tid; i < 64 * 16; i += NTHR) {
            const int n = i >> 4;
            const float are = p.a_re[pidx * 64 + n], aim = p.a_im[pidx * 64 + n];
            const float abr = pw[(64 + n) * 2], abi = pw[(64 + n) * 2 + 1];
            const float den = are * are + aim * aim, nre = abr - 1.f;
            const float cre = (nre * are + abi * aim) / den, cim = (abi * are - nre * aim) / den;
            const float br = p.b_re[(size_t)pidx * 1024 + i], bi = p.b_im[(size_t)pidx * 1024 + i];
            Bb[i * 2] = cre * br - cim * bi;
            Bb[i * 2 + 1] = cre * bi + cim * br;
            Cc[i * 2] = p.c_re[(size_t)pidx * 1024 + i];
            Cc[i * 2 + 1] = p.c_im[(size_t)pidx * 1024 + i];
        }
        __syncthreads();
        {
            const int tau = tid >> 4, pp = tid & 15;
            float s[16];
#pragma unroll
            for (int q = 0; q < 16; ++q) s[q] = 0.f;
            for (int n = 0; n < 64; ++n) {
                const float2 cv = *(const float2*)&Cc[(pp * 64 + n) * 2];
                const float2 wv = *(const float2*)&pw[(tau * 64 + n) * 2];
                const float zr = cv.x * wv.x - cv.y * wv.y, zi = cv.x * wv.y + cv.y * wv.x;
#pragma unroll
                for (int q = 0; q < 16; ++q) {
                    const float2 bv = *(const float2*)&Bb[(n * 16 + q) * 2];
                    s[q] += zr * bv.x - zi * bv.y;
                }
            }
#pragma unroll
            for (int q = 0; q < 4; ++q)
                *(float4*)(Kf + tau * 256 + pp * 16 + q * 4) = make_float4(s[4 * q], s[4 * q + 1], s[4 * q + 2], s[4 * q + 3]);
        }
        for (int id = tid; id < 128 * 32; id += NTHR) {
            const int rr = id >> 5, ch = id & 31, cpart = rr >> 6, n = rr & 63, s_ = ch >> 1, q0 = (ch & 1) * 8;
            const int e = dir == 0 ? 15 - s_ : s_;
            const float wr_ = pw[(e * 64 + n) * 2], wi_ = pw[(e * 64 + n) * 2 + 1];
            unsigned w[4];
#pragma unroll
            for (int i = 0; i < 4; ++i) {
                float v[2];
#pragma unroll
                for (int h = 0; h < 2; ++h) {
                    const float br = Bb[(n * 16 + q0 + 2 * i + h) * 2], bi = Bb[(n * 16 + q0 + 2 * i + h) * 2 + 1];
                    v[h] = cpart == 0 ? (wr_ * br - wi_ * bi) : (wr_ * bi + wi_ * br);
                }
                w[i] = pack2(v[0], v[1]);
            }
            *(uint4*)(tabS + (size_t)(dir * 128 + rr) * 256 + s_ * 16 + q0) = make_uint4(w[0], w[1], w[2], w[3]);
        }
        for (int id = tid; id < 256 * 16; id += NTHR) {
            const int m = id >> 4, ch = id & 15, t = m >> 4, pp = m & 15, cpart = ch >> 3, n0 = (ch & 7) * 8;
            const int e = dir == 0 ? t + 1 : 16 - t;
            unsigned w[4];
#pragma unroll
            for (int i = 0; i < 4; ++i) {
                float v[2];
#pragma unroll
                for (int h = 0; h < 2; ++h) {
                    const int n = n0 + 2 * i + h;
                    const float cr = Cc[(pp * 64 + n) * 2], ci = Cc[(pp * 64 + n) * 2 + 1];
                    const float wr_ = pw[(e * 64 + n) * 2], wi_ = pw[(e * 64 + n) * 2 + 1];
                    v[h] = cpart == 0 ? (cr * wr_ - ci * wi_) : -(cr * wi_ + ci * wr_);
                }
                w[i] = pack2(v[0], v[1]);
            }
            *(uint4*)(tabY + (size_t)m * 512 + 256 + dir * 128 + cpart * 64 + n0) = make_uint4(w[0], w[1], w[2], w[3]);
        }
    }
}

__device__ __forceinline__ void ssm_toeplitz_item(const Params& p, int g) {
    float* Kf = (float*)smem;
    const int tid = TIDX;
    u16* tabY = WSP_TabY + (size_t)g * 256 * 512;
    __syncthreads();
    for (int i = tid; i < 2048; i += NTHR) ((float4*)Kf)[i] = ((const float4*)(WSP_Kbuf + (size_t)g * 8192))[i];
    __syncthreads();
    for (int id = tid; id < 256 * 32; id += NTHR) {
        const int m = id >> 5, ch = id & 31, t = m >> 4, pp = m & 15, s_ = ch >> 1, q0 = (ch & 1) * 8;
        unsigned w[4];
#pragma unroll
        for (int i = 0; i < 4; ++i) {
            float v[2];
#pragma unroll
            for (int h = 0; h < 2; ++h) {
                const int q = q0 + 2 * i + h;
                float val;
                if (s_ < t) val = Kf[((t - s_) * 16 + pp) * 16 + q];
                else if (s_ > t) val = Kf[4096 + ((s_ - t) * 16 + pp) * 16 + q];
                else val = Kf[(pp) * 16 + q] + Kf[4096 + pp * 16 + q] + (pp == q ? p.ssm_d[g * 16 + pp] : 0.f);
                v[h] = val;
            }
            w[i] = pack2(v[0], v[1]);
        }
        *(uint4*)(tabY + (size_t)m * 512 + s_ * 16 + q0) = make_uint4(w[0], w[1], w[2], w[3]);
    }
    __syncthreads();
}

#define N_CONV 6896
__device__ __forceinline__ ConvD conv_decode(const Params& p, int t) {
    ConvD d; d.mode = 0; d.zr = 0;
    if (t < 320) { d.src = p.w_in; d.ld = 1280; d.k0 = (t / 20) * 64; d.n0 = (t % 20) * 64; d.dst = WSP_WinT; d.ldd = 1024; return d; }
    t -= 320;
    if (t < 64) { d.src = p.w_glu; d.ld = 512; d.k0 = (t / 8) * 64; d.n0 = (t % 8) * 64; d.dst = WSP_WgluT; d.ldd = 512; return d; }
    t -= 64;
    if (t < 256) { d.src = p.w_out; d.ld = 1024; d.k0 = (t / 16) * 64; d.n0 = (t % 16) * 64; d.dst = WSP_WoutT; d.ldd = 1024; d.zr = 2; return d; }
    t -= 256;
    if (t < 16) { d.src = p.w_router; d.ld = 64; d.k0 = t * 64; d.n0 = 0; d.dst = WSP_WrT; d.ldd = 1024; d.zr = 1; return d; }
    t -= 16;
    if (t < 4096) {
        const int up = t >= 2048; const int tt = t & 2047, e = tt >> 5, r = tt & 31;
        d.src = (up ? p.w_up_e : p.w_gate_e) + (size_t)e * 131072; d.ld = 128; d.k0 = (r >> 1) * 64; d.n0 = (r & 1) * 64;
        d.dst = WSP_WguT + (size_t)e * 262144; d.ldd = 1024; d.mode = 1 + up; return d;
    }
    t -= 4096;
    if (t < 64) {
        const int up = t >= 32; const int r = t & 31;
        d.src = up ? p.w_up_s : p.w_gate_s; d.ld = 128; d.k0 = (r >> 1) * 64; d.n0 = (r & 1) * 64;
        d.dst = WSP_WguT + (size_t)64 * 262144; d.ldd = 1024; d.mode = 1 + up; return d;
    }
    t -= 64;
    if (t < 2048) { const int e = t >> 5, r = t & 31; d.src = p.w_down_e + (size_t)e * 131072; d.ld = 1024; d.k0 = (r >> 4) * 64; d.n0 = (r & 15) * 64; d.dst = WSP_WdT + (size_t)e * 131072; d.ldd = 128; return d; }
    t -= 2048;
    d.src = p.w_down_s; d.ld = 1024; d.k0 = (t >> 4) * 64; d.n0 = (t & 15) * 64; d.dst = WSP_WdT + (size_t)64 * 131072; d.ldd = 128; return d;
}

#define N_CONV_EARLY 3200
__device__ __forceinline__ void conv_range(const Params& p, int t0, int stride, int tend, int tbeg = 0) {
    int t = tbeg + t0;
    if (t < tend) {
        ConvD d = conv_decode(p, t);
        float v[16];
        conv_load(p, d, v);
        while (t < tend) {
            const int tn = t + stride;
            ConvD dn = d;
            float vn[16];
            if (tn < tend) { dn = conv_decode(p, tn); conv_load(p, dn, vn); }
            conv_store(p, d, v);
            d = dn;
#pragma unroll
            for (int i = 0; i < 16; ++i) v[i] = vn[i];
            t = tn;
        }
    }
}
#define P0_CONV_B0 161
__device__ __forceinline__ void phase0(const Params& p) {
    const int b = blockIdx.x, G = gridDim.x;
    if (G > P0_CONV_B0 + 32) {
        if (b < 64) ssm_table_item(p, b >> 1, b & 1);
        else if (b < 160) ada_item(p, b - 64);
        else if (b == 160) rope_item(p);
        else conv_range(p, b - P0_CONV_B0, G - P0_CONV_B0, N_CONV_EARLY);
    } else {
        const int NU = 64 + 96 + 1 + N_CONV_EARLY;
        for (int u = b; u < NU; u += G) {
            if (u < 64) ssm_table_item(p, u >> 1, u & 1);
            else if (u < 160) ada_item(p, u - 64);
            else if (u == 160) rope_item(p);
            else { ConvD d = conv_decode(p, u - 161); float v[16]; conv_load(p, d, v); conv_store(p, d, v); }
        }
    }
}
#if 0
    {
        {
            const int stride = G - P0_CONV_B0;
            int t = b - P0_CONV_B0;
            if (t < N_CONV) {
                ConvD d = conv_decode(p, t);
                float v[16];
                conv_load(p, d, v);
                while (t < N_CONV) {
                    const int tn = t + stride;
                    ConvD dn = d;
                    float vn[16];
                    if (tn < N_CONV) { dn = conv_decode(p, tn); conv_load(p, dn, vn); }
                    conv_store(p, d, v);
                    d = dn;
#pragma unroll
                    for (int i = 0; i < 16; ++i) v[i] = vn[i];
                    t = tn;
                }
            }
        }
    } else {
        const int NU = 64 + 96 + 1 + N_CONV;
        for (int u = b; u < NU; u += G) {
            if (u < 64) ssm_table_item(p, u >> 1, u & 1);
            else if (u < 160) ada_item(p, u - 64);
            else if (u == 160) rope_item(p);
            else { ConvD d = conv_decode(p, u - 161); float v[16]; conv_load(p, d, v); conv_store(p, d, v); }
        }
    }
}

#endif

__device__ __forceinline__ void norm_mod_row(const float* src, const float* gain, const float* sh, const float* scl, u16* dst) {
    const int lane = TIDX & 63;
    float4 v[4];
    float ss = 0.f;
#pragma unroll
    for (int i = 0; i < 4; ++i) {
        v[i] = *(const float4*)(src + i * 256 + lane * 4);
        ss += v[i].x * v[i].x + v[i].y * v[i].y + v[i].z * v[i].z + v[i].w * v[i].w;
    }
    ss = wave_sum(ss);
    const float rs = rsqrtf(ss * (1.f / 1024.f) + EPS);
#pragma unroll
    for (int i = 0; i < 4; ++i) {
        const int c0 = i * 256 + lane * 4;
        const float4 g = *(const float4*)(gain + c0), s = *(const float4*)(sh + c0), k = *(const float4*)(scl + c0);
        const float a = v[i].x * rs * g.x * (1.f + k.x) + s.x, b = v[i].y * rs * g.y * (1.f + k.y) + s.y;
        const float c = v[i].z * rs * g.z * (1.f + k.z) + s.z, d = v[i].w * rs * g.w * (1.f + k.w) + s.w;
        *(uint2*)(dst + c0) = make_uint2(pack2(a, b), pack2(c, d));
    }
}

__device__ __forceinline__ void phase1(const Params& p) {
    for (int g = blockIdx.x; g < 32; g += gridDim.x) ssm_toeplitz_item(p, g);
    const int wv = blockIdx.x * 4 + (TIDX >> 6), nwv = gridDim.x * 4;
    const int lane = TIDX & 63;
    for (int r0 = wv * 4; r0 < NROWS; r0 += nwv * 4) {
        const float* src[4]; const float* md[4];
        float4 v[4][4];
#pragma unroll
        for (int q = 0; q < 4; ++q) {
            const int r = r0 + q;
            if (r < NLAT) { src[q] = p.x + (size_t)r * 1024; md[q] = WSP_mod + (r >> 11) * 6144; }
            else { src[q] = p.ctx + (size_t)(r - NLAT) * 1024; md[q] = WSP_mod + 8 * 6144; }
#pragma unroll
            for (int i = 0; i < 4; ++i) v[q][i] = *(const float4*)(src[q] + i * 256 + lane * 4);
        }
#pragma unroll
        for (int q = 0; q < 4; ++q) {
            float ss = 0.f;
#pragma unroll
            for (int i = 0; i < 4; ++i) ss += v[q][i].x * v[q][i].x + v[q][i].y * v[q][i].y + v[q][i].z * v[q][i].z + v[q][i].w * v[q][i].w;
            ss = wave_sum(ss);
            const float rs = rsqrtf(ss * (1.f / 1024.f) + EPS);
            u16* dst = WSP_Hb + (size_t)(r0 + q) * 1024;
#pragma unroll
            for (int i = 0; i < 4; ++i) {
                const int c0 = i * 256 + lane * 4;
                const float4 g = *(const float4*)(p.norm_mix + c0), s = *(const float4*)(md[q] + c0), k = *(const float4*)(md[q] + 1024 + c0);
                const float a = v[q][i].x * rs * g.x * (1.f + k.x) + s.x, b = v[q][i].y * rs * g.y * (1.f + k.y) + s.y;
                const float c = v[q][i].z * rs * g.z * (1.f + k.z) + s.z, d = v[q][i].w * rs * g.w * (1.f + k.w) + s.w;
                *(uint2*)(dst + c0) = make_uint2(pack2(a, b), pack2(c, d));
            }
        }
    }
}

__device__ __forceinline__ void phase2(const Params& p) {
    const int NU = 128 * 10 + 16 * 6;
    const int lane = TIDX & 63, wid = TIDX >> 6, wr = wid >> 1, wc = wid & 1, fr = lane & 15, fq = lane >> 4;
    for (int u = blockIdx.x; u < NU; u += gridDim.x) {
        int mt, nt;
        if (u < 1280) { mt = u / 10; nt = u % 10; } else { const int v = u - 1280; mt = 128 + v / 6; nt = 4 + v % 6; }
        const u16* A = WSP_Hb + (size_t)mt * 128 * 1024;
        const u16* B = WSP_WinT + (size_t)nt * 128 * 1024;
        f32x4 acc[4][4];
        gemm_tile(16,
            [&](int R, int C, int kt) { return (const void*)(A + (size_t)R * 1024 + kt * 64 + C); },
            [&](int R, int C, int kt) { return (const void*)(B + (size_t)R * 1024 + kt * 64 + C); }, acc);
        const int row0 = mt * 128 + wr * 64;
        const int col0 = nt * 128 + wc * 64;
        const bool is_lat = mt < 128;
        if (nt == 5) {
            const int kvh = wc;
#pragma unroll
            for (int m = 0; m < 4; ++m) {
                const int r = row0 + m * 16 + fq * 4;
                int b, pos;
                if (is_lat) { b = r >> 11; pos = r & 2047; } else { const int rc = r - NLAT; b = rc >> 8; pos = SEQ + (rc & 255); }
#pragma unroll
                for (int n = 0; n < 4; ++n) {
                    const int d = n * 16 + fr;
                    u16* dst = WSP_Vt + ((size_t)(b * 2 + kvh) * 64 + d) * VT_LD + pos;
                    *(uint2*)dst = make_uint2(pack2(acc[m][n][0], acc[m][n][1]), pack2(acc[m][n][2], acc[m][n][3]));
                }
            }
        } else {
            float v[4][4][4];
            const bool do_rope = is_lat && nt <= 4;
#pragma unroll
            for (int m = 0; m < 4; ++m)
#pragma unroll
                for (int j = 0; j < 4; ++j) {
                    if (do_rope) {
                        const int r = row0 + m * 16 + fq * 4 + j, pos = r & 2047;
                        const float2 cr = WSP_rope[(pos >> 6) * 16 + fr], cc = WSP_rope[(pos & 63) * 16 + fr];
                        const float x1 = acc[m][0][j], x2 = acc[m][1][j], y1 = acc[m][2][j], y2 = acc[m][3][j];
                        v[m][0][j] = x1 * cr.x - x2 * cr.y; v[m][1][j] = x1 * cr.y + x2 * cr.x;
                        v[m][2][j] = y1 * cc.x - y2 * cc.y; v[m][3][j] = y1 * cc.y + y2 * cc.x;
                    } else {
#pragma unroll
                        for (int n = 0; n < 4; ++n) v[m][n][j] = acc[m][n][j];
                    }
                }
            u16* dbase; int ldd;
            if (nt < 4) { dbase = WSP_Q + (size_t)row0 * 512 + col0; ldd = 512; }
            else if (nt == 4) { dbase = WSP_Kb + (size_t)row0 * 128 + (col0 - 512); ldd = 128; }
            else { dbase = WSP_U + (size_t)row0 * 512 + (col0 - 768); ldd = 512; }
            wave_store_bf16(v, [&](int row) { return dbase + (size_t)row * ldd; });
        }
    }
}

__device__ __forceinline__ void attn_unit(const Params& p, int u) {
    const int h = u & 7, qb = (u >> 3) & 15, b = u >> 7, kvh = h >> 2;
    const int tid = TIDX, lane = tid & 63, wid = tid >> 6, fr = lane & 15, fq = lane >> 4;
    const int sb = lane * 16, swz = sb ^ (((sb >> 9) & 1) << 5);
    const int r_in = swz >> 6, c_in = (swz & 63) >> 1;
    const int jstart = qb == 0 ? 2 : 0, jend = qb == 15 ? 4 : 6, nb = jend - jstart, ntile = nb + 4;
    const float SC = 0.125f * 1.4426950408889634f;
    bf16x8 qf[2][2];
    const int qrow0 = b * SEQ + qb * 128 + wid * 32;
#pragma unroll
    for (int qt = 0; qt < 2; ++qt)
#pragma unroll
        for (int ks = 0; ks < 2; ++ks)
            qf[qt][ks] = *(const bf16x8*)(WSP_Q + (size_t)(qrow0 + qt * 16 + fr) * 512 + h * 64 + ks * 32 + fq * 8);
    f32x4 o[4][2];
#pragma unroll
    for (int dt = 0; dt < 4; ++dt)
#pragma unroll
        for (int qt = 0; qt < 2; ++qt) o[dt][qt] = (f32x4){0.f, 0.f, 0.f, 0.f};
    float mrun[2], lrun[2];
    const float sinkv = p.attn_sink[h] * 1.4426950408889634f;
    mrun[0] = mrun[1] = sinkv;
    lrun[0] = lrun[1] = (fq == 0) ? 1.f : 0.f;
    __syncthreads();
    auto stage = [&](int i, int s) {
        const u16* kbase; const u16* vbase;
        if (i < nb) {
            const int ks0 = qb * 128 - 128 + 64 * (jstart + i);
            kbase = WSP_Kb + (size_t)(b * SEQ + ks0) * 128 + kvh * 64;
            vbase = WSP_Vt + (size_t)(b * 2 + kvh) * 64 * VT_LD + ks0;
        } else {
            const int c0 = 64 * (i - nb);
            kbase = WSP_Kb + (size_t)(NLAT + b * CTXL + c0) * 128 + kvh * 64;
            vbase = WSP_Vt + (size_t)(b * 2 + kvh) * 64 * VT_LD + SEQ + c0;
        }
        char* sk = smem + s * 16384;
        char* sv = sk + 8192;
#pragma unroll
        for (int it = 0; it < 2; ++it) {
            const int st = wid + 4 * it, R = (st >> 1) * 16 + r_in, C = (st & 1) * 32 + c_in;
            glds16(kbase + (size_t)R * 128 + C, sk + tid * 16 + it * 4096);
            glds16(vbase + (size_t)R * VT_LD + C, sv + tid * 16 + it * 4096);
        }
    };
    stage(0, 0);
    for (int i = 0; i < ntile; ++i) {
        asm volatile("s_waitcnt vmcnt(0)" ::: "memory");
        __syncthreads();
        if (i + 1 < ntile) stage(i + 1, (i + 1) & 1);
        const char* sk = smem + (i & 1) * 16384;
        const char* sv = sk + 8192;
        f32x4 s[4][2];
#pragma unroll
        for (int kt = 0; kt < 4; ++kt)
#pragma unroll
            for (int qt = 0; qt < 2; ++qt) s[kt][qt] = (f32x4){0.f, 0.f, 0.f, 0.f};
#pragma unroll
        for (int ks = 0; ks < 2; ++ks)
#pragma unroll
            for (int kt = 0; kt < 4; ++kt) {
                const bf16x8 kf = *(const bf16x8*)(sk + lds_byte(kt * 16 + fr, ks * 32 + fq * 8));
#pragma unroll
                for (int qt = 0; qt < 2; ++qt) s[kt][qt] = __builtin_amdgcn_mfma_f32_16x16x32_bf16(kf, qf[qt][ks], s[kt][qt], 0, 0, 0);
            }
        const int ks0 = qb * 128 - 128 + 64 * (jstart + i);
        const int qlo = qb * 128 + wid * 32;
        const bool band = (i < nb) && ((qlo + 31 - ks0 > 128) || (ks0 + 63 - qlo > 128));
        bf16x8 pf[2][2];
#pragma unroll
        for (int qt = 0; qt < 2; ++qt) {
            const int qp = qb * 128 + wid * 32 + qt * 16 + fr;
            float mx = -1e30f;
#pragma unroll
            for (int kt = 0; kt < 4; ++kt)
#pragma unroll
                for (int j = 0; j < 4; ++j) {
                    float v = s[kt][qt][j] * SC;
                    if (band) {
                        const int kp = ks0 + kt * 16 + fq * 4 + j, d = qp - kp;
                        if (d > 128 || d < -128) v = -1e30f;
                    }
                    s[kt][qt][j] = v;
                    mx = fmaxf(mx, v);
                }
            mx = fmaxf(mx, __shfl_xor(mx, 16));
            mx = fmaxf(mx, __shfl_xor(mx, 32));
            const float mnew = fmaxf(mrun[qt], mx);
            const float alpha = __builtin_amdgcn_exp2f(mrun[qt] - mnew);
            mrun[qt] = mnew;
            float ls = 0.f;
#pragma unroll
            for (int kt = 0; kt < 4; ++kt)
#pragma unroll
                for (int j = 0; j < 4; ++j) {
                    const float pv = __builtin_amdgcn_exp2f(s[kt][qt][j] - mnew);
                    s[kt][qt][j] = pv;
                    ls += pv;
                }
            lrun[qt] = lrun[qt] * alpha + ls;
#pragma unroll
            for (int dt = 0; dt < 4; ++dt) o[dt][qt] *= alpha;
#pragma unroll
            for (int k2 = 0; k2 < 2; ++k2) {
                bf16x8 t;
#pragma unroll
                for (int j = 0; j < 4; ++j) { t[j] = (short)f2bf(s[2 * k2][qt][j]); t[4 + j] = (short)f2bf(s[2 * k2 + 1][qt][j]); }
                pf[qt][k2] = t;
            }
        }
#pragma unroll
        for (int k2 = 0; k2 < 2; ++k2)
#pragma unroll
            for (int dt = 0; dt < 4; ++dt) {
                const uint2 lo = *(const uint2*)(sv + lds_byte(dt * 16 + fr, k2 * 32 + fq * 4));
                const uint2 hi = *(const uint2*)(sv + lds_byte(dt * 16 + fr, k2 * 32 + 16 + fq * 4));
                union { uint4 u; bf16x8 v; } cv; cv.u = make_uint4(lo.x, lo.y, hi.x, hi.y);
#pragma unroll
                for (int qt = 0; qt < 2; ++qt) o[dt][qt] = __builtin_amdgcn_mfma_f32_16x16x32_bf16(cv.v, pf[qt][k2], o[dt][qt], 0, 0, 0);
            }
    }
#pragma unroll
    for (int qt = 0; qt < 2; ++qt) {
        float l = lrun[qt];
        l += __shfl_xor(l, 16);
        l += __shfl_xor(l, 32);
        const float inv = 1.f / l;
        u16* dst = WSP_AO + (size_t)(qrow0 + qt * 16 + fr) * 512 + h * 64 + fq * 4;
        float sq = 0.f;
#pragma unroll
        for (int dt = 0; dt < 4; ++dt) {
            const unsigned w0 = pack2(o[dt][qt][0] * inv, o[dt][qt][1] * inv), w1 = pack2(o[dt][qt][2] * inv, o[dt][qt][3] * inv);
            *(uint2*)(dst + dt * 16) = make_uint2(w0, w1);
            const float a = bf2f((u16)(w0 & 0xffffu)), b = bf2f((u16)(w0 >> 16)), c = bf2f((u16)(w1 & 0xffffu)), d = bf2f((u16)(w1 >> 16));
            sq += a * a + b * b + c * c + d * d;
        }
        sq += __shfl_xor(sq, 16);
        sq += __shfl_xor(sq, 32);
        if (fq == 0) unsafeAtomicAdd(WSP_rsq + (size_t)(qrow0 + qt * 16 + fr) * 2, sq);
    }
}

__device__ __forceinline__ void ssm_s1_unit(const Params& p, int u) {
    const int ct = u % 9, mh = (u / 9) & 1, g = u / 18;
    const int lane = TIDX & 63, wid = TIDX >> 6, wr = wid >> 1, wc = wid & 1, fr = lane & 15, fq = lane >> 4;
    const u16* A = WSP_TabS + ((size_t)g * 256 + mh * 128) * 256;
    const u16* Ub = WSP_U + (size_t)ct * 128 * 16 * 512 + g * 16;
    f32x4 acc[4][4];
    gemm_tile(4,
        [&](int R, int C, int kt) { return (const void*)(A + (size_t)R * 256 + kt * 64 + C); },
        [&](int R, int C, int kt) { return (const void*)(Ub + (size_t)(R * 16 + kt * 4 + (C >> 4)) * 512 + (C & 15)); }, acc);
#pragma unroll
    for (int m = 0; m < 4; ++m)
#pragma unroll
        for (int n = 0; n < 4; ++n) {
            const int rho = mh * 128 + wr * 64 + m * 16 + fq * 4;
            const int cg = ct * 128 + wc * 64 + n * 16 + fr;
            *(f32x4*)(WSP_S + ((size_t)cg * 32 + g) * 256 + rho) = acc[m][n];
        }
}

__device__ __forceinline__ void phase3(const Params& p) {
    const int NU = 1024 + 576;
    for (int u = blockIdx.x; u < NU; u += gridDim.x) {
        if (u < 1024) attn_unit(p, u); else ssm_s1_unit(p, u - 1024);
    }
}

__device__ __forceinline__ void phase4(const Params& p) {
    if ((int)gridDim.x > 160) { if ((int)blockIdx.x >= 128) { conv_range(p, blockIdx.x - 128, gridDim.x - 128, N_CONV, N_CONV_EARLY); return; } }
    else conv_range(p, blockIdx.x, gridDim.x, N_CONV, N_CONV_EARLY);
    const int gid = blockIdx.x * NTHR + TIDX;
    if (gid >= BATCH * 2 * 32 * 64) return;
    const int n = gid & 63, g = (gid >> 6) & 31, dir = (gid >> 11) & 1, b = gid >> 12;
    const int pidx = dir * 32 + g;
    const float dt = __expf(p.log_dt[pidx]);
    const float are = p.a_re[pidx * 64 + n], aim = p.a_im[pidx * 64 + n];
    const float mag = __expf(16.f * dt * are);
    float rev = 16.f * (dt * aim * 0.15915494309189535f);
    rev -= rintf(rev);
    const float ar = mag * __builtin_amdgcn_cosf(rev), ai = mag * __builtin_amdgcn_sinf(rev);
    float hr = 0.f, hi = 0.f;
    const size_t so = (size_t)g * 256 + dir * 128 + n;
#pragma unroll 8
    for (int i = 0; i < 16; ++i) {
        const int c = dir == 0 ? i : 15 - i;
        const float* sp = WSP_S + (size_t)(NCHUNK_LAT + b * 16 + c) * 8192 + so;
        const float sr = sp[0], si = sp[64];
        const float nr = ar * hr - ai * hi + sr, ni = ar * hi + ai * hr + si;
        hr = nr; hi = ni;
    }
#pragma unroll 8
    for (int i = 0; i < 128; ++i) {
        const int c = dir == 0 ? i : 127 - i;
        const size_t cg = (size_t)b * 128 + c;
        const float* sp = WSP_S + cg * 8192 + so;
        const float sr = sp[0], si = sp[64];
        u16* hp = WSP_Hin + cg * 8192 + so;
        hp[0] = f2bf(hr); hp[64] = f2bf(hi);
        const float nr = ar * hr - ai * hi + sr, ni = ar * hi + ai * hr + si;
        hr = nr; hi = ni;
    }
}

__device__ __forceinline__ void phase5(const Params& p) {
    const int NU = 512;
    const int lane = TIDX & 63, wid = TIDX >> 6, wr = wid >> 1, wc = wid & 1, fr = lane & 15, fq = lane >> 4;
    for (int u = blockIdx.x; u < NU; u += gridDim.x) {
        const int ct = u & 7, mh = (u >> 3) & 1, g = u >> 4;
        const u16* A = WSP_TabY + ((size_t)g * 256 + mh * 128) * 512;
        const u16* Ub = WSP_U + (size_t)ct * 128 * 16 * 512 + g * 16;
        const u16* Hb_ = WSP_Hin + (size_t)ct * 128 * 8192 + g * 256;
        f32x4 acc[4][4];
        gemm_tile(8,
            [&](int R, int C, int kt) { return (const void*)(A + (size_t)R * 512 + kt * 64 + C); },
            [&](int R, int C, int kt) {
                return kt < 4 ? (const void*)(Ub + (size_t)(R * 16 + kt * 4 + (C >> 4)) * 512 + (C & 15))
                              : (const void*)(Hb_ + (size_t)R * 8192 + (kt - 4) * 64 + C);
            }, acc);
#pragma unroll
        for (int m = 0; m < 4; ++m)
#pragma unroll
            for (int n = 0; n < 4; ++n) {
                const int t = mh * 8 + wr * 4 + m;
                const int cg = ct * 128 + wc * 64 + n * 16 + fr;
                u16* dst = WSP_Y + ((size_t)cg * 16 + t) * 512 + g * 16 + fq * 4;
                *(uint2*)dst = make_uint2(pack2(gelu_tanh(acc[m][n][0]), gelu_tanh(acc[m][n][1])),
                                          pack2(gelu_tanh(acc[m][n][2]), gelu_tanh(acc[m][n][3])));
            }
    }
}

__device__ __forceinline__ void phase6(const Params& p) {
    const int NU = 512;
    const int lane = TIDX & 63, wid = TIDX >> 6, wr = wid >> 1, wc = wid & 1, fr = lane & 15, fq = lane >> 4;
    for (int u = blockIdx.x; u < NU; u += gridDim.x) {
        const int mt = u >> 2, nt = u & 3;
        const u16* A = WSP_Y + (size_t)mt * 128 * 512;
        const u16* B = WSP_WgluT + (size_t)nt * 128 * 512;
        f32x4 acc[4][4];
        gemm_tile(8,
            [&](int R, int C, int kt) { return (const void*)(A + (size_t)R * 512 + kt * 64 + C); },
            [&](int R, int C, int kt) { return (const void*)(B + (size_t)R * 512 + kt * 64 + C); }, acc);
        const int row0 = mt * 128 + wr * 64, col0 = nt * 128 + wc * 64;
        char* base = smem + wid * 9216;
        float bg[4];
#pragma unroll
        for (int n = 0; n < 4; ++n) bg[n] = p.b_glu[col0 + n * 16 + fr];
#pragma unroll
        for (int m = 0; m < 4; ++m)
#pragma unroll
            for (int j = 0; j < 4; ++j) {
                const int rl = m * 16 + fq * 4 + j, r = row0 + rl;
                float sq = 0.f;
#pragma unroll
                for (int n = 0; n < 4; ++n) {
                    const int c = col0 + n * 16 + fr;
                    const float yv = bf2f(WSP_Y[(size_t)r * 512 + c]);
                    const u16 ob = f2bf(yv * sigmoidf_(acc[m][n][j] + bg[n]));
                    *(u16*)(base + rl * 144 + (n * 16 + fr) * 2) = ob;
                    const float of = bf2f(ob);
                    sq += of * of;
                }
                sq += __shfl_xor(sq, 1); sq += __shfl_xor(sq, 2); sq += __shfl_xor(sq, 4); sq += __shfl_xor(sq, 8);
                if (fr == 0) unsafeAtomicAdd(WSP_rsq + (size_t)r * 2 + 1, sq);
            }
        asm volatile("s_waitcnt lgkmcnt(0)" ::: "memory");
        __builtin_amdgcn_wave_barrier();
        u16* dbase = WSP_SO + (size_t)row0 * 512 + col0;
#pragma unroll
        for (int i = 0; i < 8; ++i) {
            const int id = i * 64 + lane, row = id >> 3, ch = id & 7;
            *(uint4*)(dbase + (size_t)row * 512 + ch * 8) = *(const uint4*)(base + row * 144 + ch * 16);
        }
        asm volatile("s_waitcnt lgkmcnt(0)" ::: "memory");
        __builtin_amdgcn_wave_barrier();
    }
}

__device__ __forceinline__ void phase7(const Params& p) {
    const int lane = TIDX & 63;
    const int wv = blockIdx.x * 4 + (TIDX >> 6), nwv = gridDim.x * 4;
    for (int it = wv; it < NLAT * 2; it += nwv) {
        const int r = it >> 1, half = it & 1;
        const u16* src = (half ? WSP_SO : WSP_AO) + (size_t)r * 512 + lane * 8;
        const float* gain = (half ? p.norm_ssm_out : p.norm_attn_out) + lane * 8;
        const uint4 d = *(const uint4*)src;
        float f[8];
        f[0] = bf2f((u16)(d.x & 0xffff)); f[1] = bf2f((u16)(d.x >> 16));
        f[2] = bf2f((u16)(d.y & 0xffff)); f[3] = bf2f((u16)(d.y >> 16));
        f[4] = bf2f((u16)(d.z & 0xffff)); f[5] = bf2f((u16)(d.z >> 16));
        f[6] = bf2f((u16)(d.w & 0xffff)); f[7] = bf2f((u16)(d.w >> 16));
        float ss = 0.f;
#pragma unroll
        for (int i = 0; i < 8; ++i) ss += f[i] * f[i];
        ss = wave_sum(ss);
        const float rs = rsqrtf(ss * (1.f / 512.f) + EPS);
        const float4 g0 = *(const float4*)gain, g1 = *(const float4*)(gain + 4);
        *(uint4*)(WSP_CAT + (size_t)r * 1024 + half * 512 + lane * 8) =
            make_uint4(pack2(f[0] * rs * g0.x, f[1] * rs * g0.y), pack2(f[2] * rs * g0.z, f[3] * rs * g0.w),
                       pack2(f[4] * rs * g1.x, f[5] * rs * g1.y), pack2(f[6] * rs * g1.z, f[7] * rs * g1.w));
    }
}

__device__ __forceinline__ void phase8(const Params& p) {
    const int NU = 512;
    for (int u = blockIdx.x; u < NU; u += gridDim.x) {
        const int mt = u >> 2, nt = u & 3;
        const u16* A1 = WSP_AO + (size_t)mt * 128 * 512;
        const u16* A2 = WSP_SO + (size_t)mt * 128 * 512;
        const u16* B = WSP_WoutT + (size_t)nt * 256 * 1024;
        f32x4 acc[4][8];
        {
        const int tid1 = TIDX, fq = (tid1 & 63) >> 4, row0 = mt * 128 + (tid1 >> 7) * 64;
        gemm_tile_w(32,
            [&](int i, int R, int C, int kt) { return (const void*)((kt < 16 ? A1 : A2) + (size_t)R * 512 + (kt & 15) * 32 + C); },
            [&](int i, int R, int C, int kt) { return (const void*)(B + (size_t)R * 1024 + kt * 32 + C); }, acc,
            [&](int kt) {
                if (kt == 16) {
#pragma unroll
                    for (int m = 0; m < 4; ++m) {
                        asm volatile("" ::: "memory");
#pragma unroll
                        for (int j = 0; j < 4; ++j) {
                            const float2 q = *(const float2*)(WSP_rsq + (size_t)(row0 + m * 16 + fq * 4 + j) * 2);
                            const float ratio = rsqrtf(q.x * (1.f / 512.f) + EPS) / rsqrtf(q.y * (1.f / 512.f) + EPS);
#pragma unroll
                            for (int n = 0; n < 8; ++n) acc[m][n][j] *= ratio;
                        }
                    }
                }
            });
        }
        const int tid2 = TIDX, lane = tid2 & 63, wid = tid2 >> 6, fr = lane & 15, fq = lane >> 4;
        const int row0 = mt * 128 + (wid >> 1) * 64, col0 = nt * 256 + (wid & 1) * 128;
        const float* g1 = WSP_mod + (mt >> 4) * 6144 + 2048 + col0;
        float* stg = (float*)(smem + wid * 8448);
#pragma unroll
        for (int m = 0; m < 4; ++m) {
#pragma unroll
            for (int n = 0; n < 8; ++n)
#pragma unroll
                for (int j = 0; j < 4; ++j) stg[(fq * 4 + j) * 132 + n * 16 + fr] = acc[m][n][j];
            asm volatile("s_waitcnt lgkmcnt(0)" ::: "memory");
            __builtin_amdgcn_wave_barrier();
#pragma unroll
            for (int i = 0; i < 8; ++i) {
                const int id = i * 64 + lane, rr = id >> 5, c4 = (id & 31) * 4;
                float4 v = *(const float4*)(stg + rr * 132 + c4);
                const float rsv = rsqrtf(WSP_rsq[(size_t)(row0 + m * 16 + rr) * 2 + 1] * (1.f / 512.f) + EPS);
                v.x *= rsv; v.y *= rsv; v.z *= rsv; v.w *= rsv;
                const float4 g = *(const float4*)(g1 + c4);
                const size_t o = (size_t)(row0 + m * 16 + rr) * 1024 + col0 + c4;
                const float4 xv = *(const float4*)(p.x + o);
                *(float4*)(p.out + o) = make_float4(xv.x + g.x * v.x, xv.y + g.y * v.y, xv.z + g.z * v.z, xv.w + g.w * v.w);
            }
            asm volatile("s_waitcnt lgkmcnt(0)" ::: "memory");
            __builtin_amdgcn_wave_barrier();
        }
    }
}

#define CTR_ECNT 0
#define CTR_Q11 128
#define CTR_Q12 136
#define HALF_TOK 8192
#define HH_HALF_ROWS 73728
#define ELIST_CAP 8192
__device__ __forceinline__ void phase9(const Params& p) {
    const int tid = TIDX, lane = tid & 63, wid = tid >> 6, fr = lane & 15, fq = lane >> 4;
    char* At = smem;
    float* sc = (float*)(smem + 32768);
    int* hist = (int*)(smem + 32768 + 4096);
    int* gbase = hist + 64;
    int* fill = gbase + 64;
    unsigned char* selk = (unsigned char*)(fill + 64);
    float* selw = (float*)(selk + 256);
    for (int chunk = blockIdx.x; chunk < NLAT / 32; chunk += gridDim.x) {
        __syncthreads();
        if (tid < 64) hist[tid] = 0;
        for (int grp = 0; grp < 2; ++grp) {
            const int tok0 = chunk * 32 + grp * 16;
            __syncthreads();
            float4 vall[4][4];
#pragma unroll
            for (int rr = 0; rr < 4; ++rr)
#pragma unroll
                for (int i = 0; i < 4; ++i) vall[rr][i] = *(const float4*)(p.out + (size_t)(tok0 + wid * 4 + rr) * 1024 + i * 256 + lane * 4);
#pragma unroll
            for (int rr = 0; rr < 4; ++rr) {
                const int row = wid * 4 + rr, tok = tok0 + row;
                const float* md = WSP_mod + (tok >> 11) * 6144;
                float4 v[4];
                float ss = 0.f;
#pragma unroll
                for (int i = 0; i < 4; ++i) {
                    v[i] = vall[rr][i];
                    ss += v[i].x * v[i].x + v[i].y * v[i].y + v[i].z * v[i].z + v[i].w * v[i].w;
                }
                ss = wave_sum(ss);
                const float rs = rsqrtf(ss * (1.f / 1024.f) + EPS);
#pragma unroll
                for (int i = 0; i < 4; ++i) {
                    const int c0 = i * 256 + lane * 4;
                    const float4 g = *(const float4*)(p.norm_ffn + c0), s = *(const float4*)(md + 3072 + c0), k = *(const float4*)(md + 4096 + c0);
                    const float a = v[i].x * rs * g.x * (1.f + k.x) + s.x, b = v[i].y * rs * g.y * (1.f + k.y) + s.y;
                    const float c = v[i].z * rs * g.z * (1.f + k.z) + s.z, d = v[i].w * rs * g.w * (1.f + k.w) + s.w;
                    const uint2 pk = make_uint2(pack2(a, b), pack2(c, d));
                    *(uint2*)(WSP_H2 + (size_t)tok * 1024 + c0) = pk;
                    const int ch = c0 >> 3;
                    *(uint2*)(At + row * 2048 + ((ch ^ row) << 4) + ((c0 & 4) << 1)) = pk;
                }
            }
            __syncthreads();
            f32x4 acc = {0.f, 0.f, 0.f, 0.f};
            const u16* bp = WSP_WrT + (size_t)(wid * 16 + fr) * 1024 + fq * 8;
#pragma unroll
            for (int kb = 0; kb < 4; ++kb) {
                bf16x8 bfr[8];
#pragma unroll
                for (int q = 0; q < 8; ++q) bfr[q] = *(const bf16x8*)(bp + (kb * 8 + q) * 32);
#pragma unroll
                for (int q = 0; q < 8; ++q) {
                    const int ch = (kb * 8 + q) * 4 + fq;
                    const bf16x8 a = *(const bf16x8*)(At + fr * 2048 + ((ch ^ fr) << 4));
                    acc = __builtin_amdgcn_mfma_f32_16x16x32_bf16(a, bfr[q], acc, 0, 0, 0);
                }
            }
#pragma unroll
            for (int j = 0; j < 4; ++j) sc[(fq * 4 + j) * 64 + wid * 16 + fr] = sigmoidf_(acc[j]);
            __syncthreads();
            const float bias = p.router_bias[lane];
            const int eg = lane >> 3;
            for (int rr = 0; rr < 4; ++rr) {
                const int row = wid * 4 + rr, tok = tok0 + row;
                const float s = sc[row * 64 + lane];
                const float bz = s + bias;
                float m1 = bz;
                m1 = fmaxf(m1, __shfl_xor(m1, 1)); m1 = fmaxf(m1, __shfl_xor(m1, 2)); m1 = fmaxf(m1, __shfl_xor(m1, 4));
                const unsigned long long eq = __ballot(bz == m1);
                const unsigned gb = (unsigned)((eq >> (eg * 8)) & 0xffull);
                const int first = __ffs(gb) - 1;
                float v2 = ((lane & 7) == first) ? -1e30f : bz;
                v2 = fmaxf(v2, __shfl_xor(v2, 1)); v2 = fmaxf(v2, __shfl_xor(v2, 2)); v2 = fmaxf(v2, __shfl_xor(v2, 4));
                const float gs = m1 + v2;
                int cnt = 0;
#pragma unroll
                for (int j = 0; j < 8; ++j) {
                    const float gj = __int_as_float(__builtin_amdgcn_readlane(__float_as_int(gs), j * 8));
                    cnt += (gj > gs || (gj == gs && j < eg)) ? 1 : 0;
                }
                const bool gsel = cnt < 4;
                const float mv = gsel ? bz : -1e30f;
                int rank = 0;
#pragma unroll
                for (int j = 0; j < 64; ++j) {
                    const float vj = __int_as_float(__builtin_amdgcn_readlane(__float_as_int(mv), j));
                    rank += (vj > mv || (vj == mv && j < lane)) ? 1 : 0;
                }
                const bool sel = gsel && rank < 8;
                const float tot = wave_sum(sel ? s : 0.f);
                if (sel) {
                    selw[(grp * 16 + row) * 8 + rank] = s / tot * 2.5f;
                    selk[(grp * 16 + row) * 8 + rank] = (unsigned char)lane;
                    atomicAdd(&hist[lane], 1);
                }
            }
        }
        __syncthreads();
        const int h = (chunk * 32) >> 13;
        if (tid < 64) {
            gbase[tid] = hist[tid] ? (int)atomicAdd(&WSP_ctr[CTR_ECNT + h * 64 + tid], (unsigned)hist[tid]) : 0;
            fill[tid] = 0;
        }
        __syncthreads();
        {
            const int e = selk[tid];
            const int pos = atomicAdd(&fill[e], 1);
            WSP_elist[(size_t)(h * 64 + e) * ELIST_CAP + gbase[e] + pos] = (chunk * 32 + (tid >> 3)) * 8 + (tid & 7);
            WSP_wsl[(size_t)(h * 64 + e) * ELIST_CAP + gbase[e] + pos] = selw[tid];
        }
    }
}

struct MoeTab { int cnt[16]; int soff[16]; int pre[17]; };

__device__ __forceinline__ void phase11(const Params& p) {
    const int tid = TIDX, lane = tid & 63, wid = tid >> 6, wr = wid >> 1, wc = wid & 1, fr = lane & 15, fq = lane >> 4;
    const int sb = lane * 16, swz = sb ^ (((sb >> 9) & 1) << 5);
    const int r_in = swz >> 6, c_in = (swz & 63) >> 1;
    int* tab = (int*)(smem + 73728);
    int* t_cnt = tab, *t_soff = tab + 16, *t_pre = tab + 32, *t_q = tab + 52;
    const int x = blockIdx.x & 7;
    __syncthreads();
    int* t_all = tab + 64;
    if (tid < 128) t_all[tid] = (int)WSP_ctr[CTR_ECNT + tid];
    if (tid == 0) t_q[0] = (int)atomicAdd(&WSP_ctr[CTR_Q11 + x], 1u);
    __syncthreads();
    if (tid < 16) {
        const int i = tid >> 1, h = tid & 1, e = x + 8 * i;
        t_cnt[tid] = t_all[h * 64 + e];
        int so = 0;
        for (int e2 = 0; e2 < e; ++e2) so += t_all[h * 64 + e2];
        t_soff[tid] = so;
    }
    __syncthreads();
    if (tid == 0) {
        int s = 0;
        for (int j = 0; j < 16; ++j) { t_pre[j] = s; s += (t_cnt[j] + 127) >> 7; }
        t_pre[16] = s;
    }
    __syncthreads();
    const int T_r = t_pre[16], T_all = T_r + 16;
    for (;;) {
        __syncthreads();
        const int u = __builtin_amdgcn_readfirstlane(t_q[0]);
        __syncthreads();
        if (u >= T_all) break;
        if (tid == 0) t_q[0] = (int)atomicAdd(&WSP_ctr[CTR_Q11 + x], 1u);
        int e, h, mt, c, rowbase;
        const int* el = nullptr;
        if (u < T_r) {
            int j = 0;
#pragma unroll
            for (int q = 1; q < 16; ++q) j += (u >= t_pre[q]) ? 1 : 0;
            e = x + 8 * (j >> 1); h = j & 1; mt = u - t_pre[j]; c = t_cnt[j];
            rowbase = h * HH_HALF_ROWS + t_soff[j];
            el = WSP_elist + (size_t)(h * 64 + e) * ELIST_CAP;
        } else {
            const int ms = x * 16 + (u - T_r);
            e = 64; h = ms >> 6; mt = ms & 63; c = HALF_TOK;
            rowbase = h * HH_HALF_ROWS + 65536;
        }
        e = __builtin_amdgcn_readfirstlane(e); h = __builtin_amdgcn_readfirstlane(h); mt = __builtin_amdgcn_readfirstlane(mt);
        c = __builtin_amdgcn_readfirstlane(c); rowbase = __builtin_amdgcn_readfirstlane(rowbase);
        if (e < 64) el = WSP_elist + (size_t)(h * 64 + e) * ELIST_CAP;
        const float* wsl = WSP_wsl + (size_t)(h * 64 + (e & 63)) * ELIST_CAP;
        const u16* aptr[2];
#pragma unroll
        for (int i = 0; i < 2; ++i) {
            int li = mt * 128 + (wid + 4 * i) * 16 + r_in;
            li = li < c ? li : c - 1;
            const int tok = (e < 64) ? (el[li] >> 3) : (h * HALF_TOK + li);
            aptr[i] = WSP_H2 + (size_t)tok * 1024 + c_in;
        }
        const u16* Bw = WSP_WguT + (size_t)e * 262144 + c_in;
        f32x4 acc[4][8];
        gemm_tile_w(32,
            [&](int i, int R, int C, int kt) { return (const void*)(aptr[i] + kt * 32); },
            [&](int i, int R, int C, int kt) { return (const void*)(Bw + (size_t)R * 1024 + kt * 32); }, acc);
        float wgt[4][4];
#pragma unroll
        for (int m = 0; m < 4; ++m)
#pragma unroll
            for (int j = 0; j < 4; ++j) {
                const int li = mt * 128 + wr * 64 + m * 16 + fq * 4 + j;
                float w = 1.f;
                if (e < 64) w = (li < c) ? wsl[li] : 0.f;
                wgt[m][j] = w;
            }
        u16* dbase = WSP_HHs + ((size_t)rowbase + mt * 128 + wr * 64) * 128 + wc * 64;
        const int vrows = c - mt * 128 - wr * 64;
        wave_store_bf16_f([&](int m, int n2, int j) { return siluf_(acc[m][2 * n2][j]) * acc[m][2 * n2 + 1][j] * wgt[m][j]; },
                          [&](int row) { return row < vrows ? dbase + (size_t)row * 128 : (u16*)nullptr; });
    }
}

#define YD_SCALE 8.0f
template <class FV, class FD>
__device__ __forceinline__ void wave_store_fp8_f(FV val, FD dst) {
    const int lane = TIDX & 63, wid = TIDX >> 6, fr = lane & 15, fq = lane >> 4;
    char* base = smem + wid * 9216;
#pragma unroll
    for (int m = 0; m < 4; ++m)
#pragma unroll
        for (int n = 0; n < 8; ++n)
#pragma unroll
            for (int j = 0; j < 4; ++j)
                *(unsigned char*)(base + (m * 16 + fq * 4 + j) * 144 + n * 16 + fr) =
                    (unsigned char)(__builtin_amdgcn_cvt_pk_fp8_f32(val(m, n, j), 0.f, 0, false) & 0xff);
    asm volatile("s_waitcnt lgkmcnt(0)" ::: "memory");
    __builtin_amdgcn_wave_barrier();
#pragma unroll
    for (int i = 0; i < 8; ++i) {
        const int id = i * 64 + lane, row = id >> 3, ch = id & 7;
        const uint4 d = *(const uint4*)(base + row * 144 + ch * 16);
        unsigned char* q = dst(i, row);
        if (q) *(uint4*)(q + ch * 16) = d;
    }
    asm volatile("s_waitcnt lgkmcnt(0)" ::: "memory");
    __builtin_amdgcn_wave_barrier();
}

__device__ __forceinline__ void phase12a(const Params& p) {
    const int tid = TIDX, lane = tid & 63, wid = tid >> 6, wr = wid >> 1, wc = wid & 1;
    const int sb = lane * 16, swz = sb ^ (((sb >> 9) & 1) << 5);
    const int r_in = swz >> 6, c_in = (swz & 63) >> 1;
    int* tab = (int*)(smem + 73728);
    int* t_cnt = tab, *t_soff = tab + 16, *t_pre = tab + 32, *t_q = tab + 52;
    int* t_all = tab + 64;
    const int x = blockIdx.x & 7;
    __syncthreads();
    if (tid < 128) t_all[tid] = (int)WSP_ctr[CTR_ECNT + tid];
    if (tid == 0) t_q[0] = (int)atomicAdd(&WSP_ctr[CTR_Q12 + x], 1u);
    __syncthreads();
    if (tid < 16) {
        const int i = tid >> 1, h = tid & 1, e = x + 8 * i;
        t_cnt[tid] = t_all[h * 64 + e];
        int so = 0;
        for (int e2 = 0; e2 < e; ++e2) so += t_all[h * 64 + e2];
        t_soff[tid] = so;
    }
    __syncthreads();
    if (tid == 0) {
        int s = 0;
        for (int j = 0; j < 16; ++j) { t_pre[j] = s; s += (t_cnt[j] + 127) >> 7; }
        t_pre[16] = s;
    }
    __syncthreads();
    const int T_r = t_pre[16] * 4, T_all = T_r + 64;
    unsigned char* Yd8 = (unsigned char*)(p.ws + OFF_ARENA);
    for (;;) {
        __syncthreads();
        const int u = __builtin_amdgcn_readfirstlane(t_q[0]);
        __syncthreads();
        if (u >= T_all) break;
        if (tid == 0) t_q[0] = (int)atomicAdd(&WSP_ctr[CTR_Q12 + x], 1u);
        int e, h, mt, nt, c, rowbase;
        if (u < T_r) {
            const int um = u >> 2; nt = u & 3;
            int j = 0;
#pragma unroll
            for (int q = 1; q < 16; ++q) j += (um >= t_pre[q]) ? 1 : 0;
            e = x + 8 * (j >> 1); h = j & 1; mt = um - t_pre[j]; c = t_cnt[j];
            rowbase = h * HH_HALF_ROWS + t_soff[j];
        } else {
            const int us = u - T_r; nt = us & 3;
            const int ms = x * 16 + (us >> 2);
            e = 64; h = ms >> 6; mt = ms & 63; c = HALF_TOK; rowbase = h * HH_HALF_ROWS + 65536;
        }
        e = __builtin_amdgcn_readfirstlane(e); h = __builtin_amdgcn_readfirstlane(h); mt = __builtin_amdgcn_readfirstlane(mt);
        nt = __builtin_amdgcn_readfirstlane(nt); c = __builtin_amdgcn_readfirstlane(c); rowbase = __builtin_amdgcn_readfirstlane(rowbase);
        const int* el = WSP_elist + (size_t)(h * 64 + (e & 63)) * ELIST_CAP;
        const u16* aptr[2];
#pragma unroll
        for (int i = 0; i < 2; ++i) {
            int li = mt * 128 + (wid + 4 * i) * 16 + r_in;
            li = li < c ? li : c - 1;
            aptr[i] = WSP_HHs + ((size_t)rowbase + li) * 128 + c_in;
        }
        const u16* Bw = WSP_WdT + ((size_t)e * 1024 + nt * 256) * 128 + c_in;
        const int vrows = c - mt * 128 - wr * 64;
        int slot[8];
        if (e < 64) {
#pragma unroll
            for (int i = 0; i < 8; ++i) {
                int li = mt * 128 + wr * 64 + ((i * 64 + lane) >> 3);
                li = li < c ? li : c - 1;
                slot[i] = el[li];
            }
        } else {
#pragma unroll
            for (int i = 0; i < 8; ++i) slot[i] = (h * HALF_TOK + mt * 128 + wr * 64 + ((i * 64 + lane) >> 3)) * 8;
        }
        f32x4 acc[4][8];
        gemm_tile_w(4,
            [&](int i, int R, int C, int kt) { return (const void*)(aptr[i] + kt * 32); },
            [&](int i, int R, int C, int kt) { return (const void*)(Bw + (size_t)R * 128 + kt * 32); }, acc);
        const int colo = nt * 256 + wc * 128;
        wave_store_fp8_f([&](int m, int n, int j) { return acc[m][n][j] * YD_SCALE; }, [&](int i, int row) {
            if (row >= vrows) return (unsigned char*)nullptr;
            const int s = slot[i];
            const int tok = s >> 3, k = (e == 64) ? 8 : (s & 7);
            return Yd8 + ((size_t)tok * 9 + k) * 1024 + colo;
        });
    }
}

template <bool DUMMY>
__device__ __forceinline__ void phase12b_t(const Params& p) {
    const int lane = TIDX & 63;
    const int wv = blockIdx.x * 4 + (TIDX >> 6), nwv = gridDim.x * 4;
    const unsigned char* Yd8 = (const unsigned char*)(p.ws + OFF_ARENA);
    for (int tok = wv; tok < NLAT; tok += nwv) {
        float* row = p.out + (size_t)tok * 1024 + lane * 16;
        float* orow = DUMMY ? (float*)(p.ws + OFF_HHS) + (size_t)(tok & 8191) * 1024 + lane * 16 : row;
        const float* g2 = WSP_mod + (tok >> 11) * 6144 + 5120 + lane * 16;
        float s[16];
#pragma unroll
        for (int i = 0; i < 16; ++i) s[i] = 0.f;
        const unsigned char* yp = Yd8 + (size_t)tok * 9 * 1024 + lane * 16;
        uint4 yv[9];
#pragma unroll
        for (int k = 0; k < 9; ++k) yv[k] = *(const uint4*)(yp + k * 1024);
#pragma unroll
        for (int k = 0; k < 9; ++k) {
            const unsigned w[4] = {yv[k].x, yv[k].y, yv[k].z, yv[k].w};
#pragma unroll
            for (int i = 0; i < 4; ++i) {
                const auto lo = __builtin_amdgcn_cvt_pk_f32_fp8((int)w[i], false);
                const auto hi = __builtin_amdgcn_cvt_pk_f32_fp8((int)w[i], true);
                s[4 * i] += lo[0]; s[4 * i + 1] += lo[1]; s[4 * i + 2] += hi[0]; s[4 * i + 3] += hi[1];
            }
        }
        float ss = 0.f;
#pragma unroll
        for (int q = 0; q < 4; ++q) {
            const float4 xv = *(const float4*)(row + q * 4), gv = *(const float4*)(g2 + q * 4);
            s[4 * q] = xv.x + gv.x * (1.f / YD_SCALE) * s[4 * q]; s[4 * q + 1] = xv.y + gv.y * (1.f / YD_SCALE) * s[4 * q + 1];
            s[4 * q + 2] = xv.z + gv.z * (1.f / YD_SCALE) * s[4 * q + 2]; s[4 * q + 3] = xv.w + gv.w * (1.f / YD_SCALE) * s[4 * q + 3];
            ss += s[4 * q] * s[4 * q] + s[4 * q + 1] * s[4 * q + 1] + s[4 * q + 2] * s[4 * q + 2] + s[4 * q + 3] * s[4 * q + 3];
        }
        ss = wave_sum(ss);
        const float rs = rsqrtf(ss * (1.f / 1024.f) + EPS);
#pragma unroll
        for (int q = 0; q < 4; ++q) {
            const float4 g = *(const float4*)(p.norm_final + lane * 16 + q * 4);
            *(float4*)(orow + q * 4) = make_float4(s[4 * q] * rs * g.x, s[4 * q + 1] * rs * g.y, s[4 * q + 2] * rs * g.z, s[4 * q + 3] * rs * g.w);
        }
    }
}

#define SMEM_TOTAL (73728 + 1024 + 64)

#if 1
__global__ void __launch_bounds__(NTHR, 2) k_mega(Params p) {
    volatile LAS unsigned* st = (volatile LAS unsigned*)(smem + SMEM_TOTAL - 16);
    if (TIDX == 0) { st[0] = 0u; st[1] = 0u; st[2] = 0u; st[3] = 0u; }
    __syncthreads();
    XcdBarrier bar = xcd_barrier_post(WSP_bar, st);
#define RUNP(N) do { phase##N(p); if (PROBE_DUP == N) phase##N(p); } while (0)
    RUNP(0);  xcd_barrier(bar);
    RUNP(1);  xcd_barrier(bar);
    RUNP(2);  xcd_barrier(bar);
    RUNP(3);  xcd_barrier(bar);
    RUNP(4);  xcd_barrier(bar);
    RUNP(5);  xcd_barrier(bar);
    RUNP(6);  xcd_barrier(bar);
    RUNP(8);  xcd_barrier(bar);
    phase9(p); xcd_barrier(bar);
#if PROBE_DUP == 9
    if (blockIdx.x == 0 && TIDX < 128) WSP_ctr[CTR_ECNT + TIDX] = 0u;
    xcd_barrier(bar); phase9(p); xcd_barrier(bar);
#endif
    phase11(p); xcd_barrier(bar);
#if PROBE_DUP == 11
    if (blockIdx.x == 0 && TIDX < 8) WSP_ctr[CTR_Q11 + TIDX] = 0u;
    xcd_barrier(bar); phase11(p); xcd_barrier(bar);
#endif
    phase12a(p); xcd_barrier(bar);
#if PROBE_DUP == 120
    if (blockIdx.x == 0 && TIDX < 8) WSP_ctr[CTR_Q12 + TIDX] = 0u;
    xcd_barrier(bar); phase12a(p); xcd_barrier(bar);
#endif
#if PROBE_DUP == 121
    phase12b_t<true>(p); xcd_barrier(bar);
#endif
    phase12b_t<false>(p);
}
#endif


extern "C" void kernel_launch(void* const* d_in, const int* in_sizes, int n_in,
                              void* d_out, int out_size, void* d_ws, size_t ws_size,
                              hipStream_t stream) {
    Params p{};
    const float** ip = (const float**)&p.x;
    for (int i = 0; i < 32; ++i) ip[i] = (const float*)d_in[i];
    p.out = (float*)d_out;
    p.ws = (char*)d_ws;
    if (OFF_END > ws_size) { fprintf(stderr, "workspace too small: need %zu have %zu\n", (size_t)OFF_END, ws_size); return; }

    static int grid = 0;
    if (!grid) {
        hipFuncSetAttribute((const void*)k_mega, hipFuncAttributeMaxDynamicSharedMemorySize, SMEM_TOTAL);
        int dev = 0, cus = 0, per_cu = 0;
        hipGetDevice(&dev);
        hipDeviceGetAttribute(&cus, hipDeviceAttributeMultiprocessorCount, dev);
        hipOccupancyMaxActiveBlocksPerMultiprocessor(&per_cu, (const void*)k_mega, NTHR, SMEM_TOTAL);
        if (per_cu < 1) per_cu = 1;
        grid = cus * (per_cu < 2 ? per_cu : 2);
    }
    hipMemsetAsync(p.ws + OFF_BAR, 0, ZERO_BYTES, stream);
    k_mega<<<grid, NTHR, SMEM_TOTAL, stream>>>(p);
}
```

```cpp
#include <hip/hip_runtime.h>
#include <hip/hip_bf16.h>
#include <stdint.h>
#include <stdio.h>

#ifndef MK_MULTI
#define MK_MULTI 0
#endif

typedef __attribute__((ext_vector_type(8))) short bf16x8;
typedef __attribute__((ext_vector_type(4))) short bf16x4;
typedef __attribute__((ext_vector_type(4))) float f32x4;
typedef unsigned short u16;
typedef __attribute__((ext_vector_type(4))) unsigned u32x4;

#ifndef PROBE_DUP
#define PROBE_DUP -1
#endif
#define NTHR 256
__device__ __forceinline__ int opaque_tid() { int t = (int)threadIdx.x; asm volatile("" : "+v"(t)); return t; }
#define TIDX opaque_tid()
#define LDS_BYTES 65536

#define D_MODEL 1024
#define BATCH 8
#define SEQ 2048
#define CTXL 256
#define NLAT (BATCH * SEQ)
#define NCTX (BATCH * CTXL)
#define NROWS (NLAT + NCTX)
#define INW 1280
#define NEXP 64
#define VT_LD (SEQ + CTXL)
#define NCHUNK_LAT 1024
#define NCHUNK_ALL 1152
#define EPS 1e-6f

#define XB_TMO      128
#define XB_XCNT(j)  (256  + 64 * (j))
#define XB_XSUB(j)  (1280 + 64 * (j))
#define XB_XGEN(j)  (2304 + 64 * (j))
#define XB_TOP      3328
#define XB_TOPGEN   3392
#define XCD_BAR_WORDS 3456
#define XB_SPIN_CAP (1u << 20)
#define LAS __attribute__((address_space(3)))

__device__ __forceinline__ unsigned xb_ld(unsigned* p)              { return __hip_atomic_load(p, __ATOMIC_RELAXED, __HIP_MEMORY_SCOPE_AGENT); }
__device__ __forceinline__ unsigned xb_add(unsigned* p, unsigned v) { return __hip_atomic_fetch_add(p, v, __ATOMIC_RELAXED, __HIP_MEMORY_SCOPE_AGENT); }
__device__ __forceinline__ unsigned xb_xcc_id() { return (unsigned)__builtin_amdgcn_s_getreg((3 << 11) | 20) & 0xFu; }
#define XB_SPIN(cond, bar) do { unsigned _sp = 0; while (cond) { __builtin_amdgcn_s_sleep(1); \
    if ((++_sp & 255u) == 0u) { if (xb_ld(&(bar)[XB_TMO])) break; if (_sp > XB_SPIN_CAP) { atomicAdd(&(bar)[XB_TMO], 1u); break; } } } } while (0)

struct XcdBarrier { unsigned* bar; unsigned x; volatile LAS unsigned* st; };

__device__ __forceinline__ XcdBarrier xcd_barrier_post(unsigned* bar, volatile LAS unsigned* st) {
    XcdBarrier b; b.bar = bar; b.x = xb_xcc_id(); b.st = st;
    if (TIDX == 0) (void)xb_add(&bar[XB_XCNT(b.x)], 1u);
    return b;
}
__device__ __forceinline__ void xcd_barrier_complete(unsigned* bar, unsigned x, unsigned& nloc, unsigned& nx) {
    const unsigned G = gridDim.x * gridDim.y * gridDim.z;
    unsigned sum, cnt, mine, sp = 0u;
    for (;;) {
        sum = 0u; cnt = 0u; mine = 0u;
#pragma unroll
        for (unsigned j = 0; j < 16; ++j) { const unsigned c = xb_ld(&bar[XB_XCNT(j)]); sum += c; cnt += (c > 0u) ? 1u : 0u; mine = (j == x) ? c : mine; }
        if (sum == G) break;
        __builtin_amdgcn_s_sleep(1);
        if ((++sp & 255u) == 0u) { if (xb_ld(&bar[XB_TMO])) break; if (sp > XB_SPIN_CAP) { atomicAdd(&bar[XB_TMO], 1u); break; } }
    }
    nloc = mine > 0u ? mine : 1u; nx = cnt > 0u ? cnt : 1u;
}
__device__ __forceinline__ void xcd_barrier(const XcdBarrier& b) {
    asm volatile("s_waitcnt vmcnt(0)" ::: "memory");
    __syncthreads();
    if (TIDX == 0) {
        unsigned* bar = b.bar;
        __builtin_amdgcn_s_waitcnt(0);
        unsigned nloc = b.st[0], nx = b.st[1];
        if (nloc == 0u) { xcd_barrier_complete(bar, b.x, nloc, nx); b.st[0] = nloc; b.st[1] = nx; }
        const unsigned old = xb_add(&bar[XB_XSUB(b.x)], 1u);
        const unsigned gen = old / nloc;
        if (old + 1u == (gen + 1u) * nloc) {
            __builtin_amdgcn_fence(__ATOMIC_RELEASE, "agent");
            asm volatile("s_waitcnt vmcnt(0)" ::: "memory");
            const unsigned og = xb_add(&bar[XB_TOP], 1u);
            const unsigned tg = og / nx;
            if (og + 1u == (tg + 1u) * nx) xb_add(&bar[XB_TOPGEN], 1u);
            else XB_SPIN(xb_ld(&bar[XB_TOPGEN]) == tg, bar);
            __builtin_amdgcn_fence(__ATOMIC_ACQUIRE, "agent");
            xb_add(&bar[XB_XGEN(b.x)], 1u);
            asm volatile("s_waitcnt vmcnt(0)" ::: "memory");
        } else {
            XB_SPIN(xb_ld(&bar[XB_XGEN(b.x)]) == gen, bar);
            __builtin_amdgcn_fence(__ATOMIC_ACQUIRE, "agent");
            asm volatile("s_waitcnt vmcnt(0)" ::: "memory");
        }
    }
    __syncthreads();
}

struct Params {
    const float *x, *c, *ctx, *c_ctx, *w_ada, *b_ada, *norm_mix, *norm_ffn, *w_in, *attn_sink,
        *a_re, *a_im, *log_dt, *b_re, *b_im, *c_re, *c_im, *ssm_d, *w_glu, *b_glu, *norm_attn_out, *norm_ssm_out,
        *w_out, *w_router, *router_bias, *w_gate_e, *w_up_e, *w_down_e, *w_gate_s, *w_up_s, *w_down_s, *norm_final;
    float* out;
    char* ws;
};

constexpr size_t A256(size_t v) { return (v + 255) & ~(size_t)255; }
constexpr size_t OFF_BAR   = 0;
constexpr size_t OFF_RSQ   = A256(OFF_BAR + XCD_BAR_WORDS * 4 + 1024);
#define FLAG_PER_CLASS 1280
constexpr size_t OFF_FLAG  = OFF_RSQ + (size_t)NLAT * 2 * 4;
constexpr size_t ZERO_BYTES = OFF_FLAG + (8 * FLAG_PER_CLASS + 64) * 4;
constexpr size_t OFF_MOD   = A256(ZERO_BYTES);
constexpr size_t OFF_ROPE  = A256(OFF_MOD + 9 * 6144 * 4);
constexpr size_t OFF_KBUF  = A256(OFF_ROPE + 64 * 16 * 8);
constexpr size_t OFF_ELIST = A256(OFF_KBUF + (size_t)32 * 2 * 4096 * 4);
constexpr size_t OFF_WSL   = A256(OFF_ELIST + (size_t)2 * 64 * 8192 * 4);
constexpr size_t OFF_WDT   = A256(OFF_WSL + (size_t)2 * 64 * 8192 * 4);
constexpr size_t OFF_HHS   = A256(OFF_WDT + (size_t)65 * 1024 * 128 * 2);
constexpr size_t OFF_WGUT  = A256(OFF_HHS + (size_t)2 * 73728 * 128 * 2);
constexpr size_t OFF_H2R   = A256(OFF_WGUT + (size_t)65 * 256 * 1024 * 2);
constexpr size_t OFF_ARENA = A256(OFF_H2R + (size_t)NLAT * 1024 * 2);
constexpr size_t OFF_TABS  = OFF_ARENA;
constexpr size_t OFF_TABY  = A256(OFF_TABS + (size_t)32 * 256 * 256 * 2);
constexpr size_t OFF_R1    = A256(OFF_TABY + (size_t)32 * 256 * 512 * 2);
constexpr size_t OFF_R2    = A256(OFF_R1 + (size_t)NROWS * 1024 * 2);
constexpr size_t OFF_R4    = A256(OFF_R2 + (size_t)NLAT * 1024 * 2);
constexpr size_t OFF_WINT  = A256(OFF_R4 + (size_t)NLAT * 512 * 2 * 2);
constexpr size_t OFF_WGLUT = A256(OFF_WINT + (size_t)1280 * 1024 * 2);
constexpr size_t OFF_WOUTT = A256(OFF_WGLUT + (size_t)512 * 512 * 2);
constexpr size_t OFF_WRT   = A256(OFF_WOUTT + (size_t)1024 * 1024 * 2);
constexpr size_t OFF_EARLY_END = A256(OFF_WRT + (size_t)128 * 1024 * 2);
constexpr size_t YD8_BYTES = (size_t)NLAT * 8 * 1024;
constexpr size_t OFF_END   = (OFF_EARLY_END > OFF_ARENA + YD8_BYTES) ? OFF_EARLY_END : A256(OFF_ARENA + YD8_BYTES);
static_assert(OFF_END <= (size_t)256 * 1024 * 1024, "workspace map must fit the guaranteed 256 MiB");
#define WSP_bar   ((unsigned*)(p.ws + OFF_BAR))
#define WSP_ctr   ((unsigned*)(p.ws + OFF_BAR) + XCD_BAR_WORDS)
#define WSP_rsq   ((float*)(p.ws + OFF_RSQ))
#define WSP_flag  ((unsigned*)(p.ws + OFF_FLAG))
#define WSP_mod   ((float*)(p.ws + OFF_MOD))
#define WSP_rope  ((float2*)(p.ws + OFF_ROPE))
#define WSP_Kbuf  ((float*)(p.ws + OFF_KBUF))
#define WSP_elist ((int*)(p.ws + OFF_ELIST))
#define WSP_wsl   ((float*)(p.ws + OFF_WSL))
#define WSP_WinT  ((u16*)(p.ws + OFF_WINT))
#define WSP_WgluT ((u16*)(p.ws + OFF_WGLUT))
#define WSP_WoutT ((u16*)(p.ws + OFF_WOUTT))
#define WSP_WrT   ((u16*)(p.ws + OFF_WRT))
#define WSP_WdT   ((u16*)(p.ws + OFF_WDT))
#define WSP_HHs   ((u16*)(p.ws + OFF_HHS))
#define WSP_WguT  ((u16*)(p.ws + OFF_WGUT))
#define WSP_TabS  ((u16*)(p.ws + OFF_TABS))
#define WSP_TabY  ((u16*)(p.ws + OFF_TABY))
#define WSP_Hb    ((u16*)(p.ws + OFF_R1))
#define WSP_S     ((float*)(p.ws + OFF_R1))
#define WSP_H2    ((u16*)(p.ws + OFF_H2R))
#define WSP_Q     ((u16*)(p.ws + OFF_R2))
#define WSP_Kb    ((u16*)(p.ws + OFF_R2 + (size_t)NLAT * 512 * 2))
#define WSP_Vt    ((u16*)(p.ws + OFF_R2 + (size_t)NLAT * 512 * 2 + (size_t)NROWS * 128 * 2))
#define WSP_Y     ((u16*)(p.ws + OFF_R2))
#define WSP_SO    ((u16*)(p.ws + OFF_R2 + (size_t)NLAT * 512 * 2))
#define WSP_U     ((u16*)(p.ws + OFF_H2R))
#define WSP_AO    ((u16*)(p.ws + OFF_R4))
#define WSP_Hin   ((u16*)(p.ws + OFF_R4 + (size_t)NLAT * 512 * 2))

extern __shared__ __attribute__((aligned(16))) char smem[];

typedef __bf16 bf2_t __attribute__((ext_vector_type(2)));
typedef float f2_t __attribute__((ext_vector_type(2)));
__device__ __forceinline__ unsigned pack2(float a, float b) {
    const f2_t v = {a, b};
    return __builtin_bit_cast(unsigned, __builtin_convertvector(v, bf2_t));
}
__device__ __forceinline__ u16 f2bf(float f) { return (u16)(pack2(f, 0.f) & 0xffffu); }
__device__ __forceinline__ float bf2f(u16 h) { return __uint_as_float(((unsigned)h) << 16); }
__device__ __forceinline__ void glds16(const void* g, void* l) {
    __builtin_amdgcn_global_load_lds((const unsigned*)g, (unsigned*)l, 16, 0, 0);
}
__device__ __forceinline__ void glds16_sc1(const void* g, void* l) {
    __builtin_amdgcn_global_load_lds((const unsigned*)g, (unsigned*)l, 16, 0, 16);
}
__device__ __forceinline__ int lds_byte(int r, int c) {
    int st = (r >> 4) * 2 + (c >> 5), rr = r & 15, cc = c & 31, ob = rr * 64 + cc * 2;
    return st * 1024 + (ob ^ (((ob >> 9) & 1) << 5));
}
__device__ __forceinline__ float wave_sum(float v) {
#pragma unroll
    for (int o = 32; o > 0; o >>= 1) v += __shfl_xor(v, o);
    return v;
}
__device__ __forceinline__ float sigmoidf_(float x) { return __builtin_amdgcn_rcpf(1.f + __expf(-x)); }
__device__ __forceinline__ float siluf_(float x) { return x * __builtin_amdgcn_rcpf(1.f + __expf(-x)); }
__device__ __forceinline__ float gelu_tanh(float x) {
    float u = 0.7978845608028654f * (x + 0.044715f * x * x * x);
    return x * __builtin_amdgcn_rcpf(1.f + __expf(-2.f * u));
}

template <class FA, class FB>
__device__ __forceinline__ void gemm_tile(int nkt, FA fa, FB fb, f32x4 (&acc)[4][4]) {
    const int tid = TIDX, lane = tid & 63, wid = tid >> 6, wr = wid >> 1, wc = wid & 1, fr = lane & 15, fq = lane >> 4;
    const int sb = lane * 16, swz = sb ^ (((sb >> 9) & 1) << 5);
    const int r_in = swz >> 6, c_in = (swz & 63) >> 1;
#pragma unroll
    for (int m = 0; m < 4; ++m)
#pragma unroll
        for (int n = 0; n < 4; ++n) acc[m][n] = (f32x4){0.f, 0.f, 0.f, 0.f};
    __syncthreads();
    auto stage = [&](int kt, int s) {
        char* sa = smem + s * 32768;
        char* sbm = sa + 16384;
#pragma unroll
        for (int i = 0; i < 4; ++i) {
            const int st = wid + 4 * i, R = (st >> 1) * 16 + r_in, C = (st & 1) * 32 + c_in;
            glds16(fa(R, C, kt), sa + tid * 16 + i * 4096);
            glds16(fb(R, C, kt), sbm + tid * 16 + i * 4096);
        }
    };
    stage(0, 0);
    for (int kt = 0; kt < nkt; ++kt) {
        asm volatile("s_waitcnt vmcnt(0)" ::: "memory");
        __syncthreads();
        if (kt + 1 < nkt) stage(kt + 1, (kt + 1) & 1);
        const char* sa = smem + (kt & 1) * 32768;
        const char* sbm = sa + 16384;
#pragma unroll
        for (int ks = 0; ks < 2; ++ks) {
            bf16x8 a[4], b[4];
#pragma unroll
            for (int m = 0; m < 4; ++m) a[m] = *(const bf16x8*)(sa + lds_byte(wr * 64 + m * 16 + fr, ks * 32 + fq * 8));
#pragma unroll
            for (int n = 0; n < 4; ++n) b[n] = *(const bf16x8*)(sbm + lds_byte(wc * 64 + n * 16 + fr, ks * 32 + fq * 8));
#pragma unroll
            for (int m = 0; m < 4; ++m)
#pragma unroll
                for (int n = 0; n < 4; ++n) acc[m][n] = __builtin_amdgcn_mfma_f32_16x16x32_bf16(a[m], b[n], acc[m][n], 0, 0, 0);
        }
    }
    __syncthreads();
}

__device__ __forceinline__ int lds32(int r, int c) {
    const int rr = r & 15;
    return (r >> 4) * 1024 + ((rr * 64 + c * 2) ^ (((rr >> 3) & 1) << 5));
}
struct NoHook { __device__ __forceinline__ void operator()(int) const {} };
template <bool A_SC1 = false, class FA, class FB, class HK = NoHook>
__device__ __forceinline__ void gemm_tile_w(int nkt, FA fa, FB fb, f32x4 (&acc)[4][8], HK hook = HK()) {
    constexpr bool ZERO = true;
    const int tid = TIDX, lane = tid & 63, wid = tid >> 6, wr = wid >> 1, wc = wid & 1, fr = lane & 15, fq = lane >> 4;
    const int sb = lane * 16, swz = sb ^ (((sb >> 9) & 1) << 5);
    const int r_in = swz >> 6, c_in = (swz & 63) >> 1;
    if (ZERO) {
#pragma unroll
        for (int m = 0; m < 4; ++m)
#pragma unroll
            for (int n = 0; n < 8; ++n) acc[m][n] = (f32x4){0.f, 0.f, 0.f, 0.f};
    }
    __syncthreads();
    auto stage = [&](int kt, int s) {
        char* sa = smem + s * 24576;
#pragma unroll
        for (int i = 0; i < 2; ++i) { if (A_SC1) glds16_sc1(fa(i, (wid + 4 * i) * 16 + r_in, c_in, kt), sa + tid * 16 + i * 4096); else glds16(fa(i, (wid + 4 * i) * 16 + r_in, c_in, kt), sa + tid * 16 + i * 4096); }
#pragma unroll
        for (int i = 0; i < 4; ++i) glds16(fb(i, (wid + 4 * i) * 16 + r_in, c_in, kt), sa + 8192 + tid * 16 + i * 4096);
    };
    stage(0, 0);
    if (nkt > 1) stage(1, 1);
    int s_cur = 0, s_nxt = 2;
    for (int kt = 0; kt < nkt; ++kt) {
        hook(kt);
        if (kt + 1 < nkt) asm volatile("s_waitcnt vmcnt(6) lgkmcnt(0)\n\ts_barrier" ::: "memory");
        else asm volatile("s_waitcnt vmcnt(0) lgkmcnt(0)\n\ts_barrier" ::: "memory");
        if (kt + 2 < nkt) stage(kt + 2, s_nxt);
        const char* sa = smem + s_cur * 24576;
        bf16x8 a[4];
#pragma unroll
        for (int m = 0; m < 4; ++m) a[m] = *(const bf16x8*)(sa + lds32(wr * 64 + m * 16 + fr, fq * 8));
#pragma unroll
        for (int nh = 0; nh < 2; ++nh) {
            bf16x8 b[4];
#pragma unroll
            for (int n = 0; n < 4; ++n) b[n] = *(const bf16x8*)(sa + 8192 + lds32(wc * 128 + (nh * 4 + n) * 16 + fr, fq * 8));
#pragma unroll
            for (int m = 0; m < 4; ++m)
#pragma unroll
                for (int n = 0; n < 4; ++n) acc[m][nh * 4 + n] = __builtin_amdgcn_mfma_f32_16x16x32_bf16(a[m], b[n], acc[m][nh * 4 + n], 0, 0, 0);
        }
        s_cur = (s_cur == 2) ? 0 : s_cur + 1;
        s_nxt = (s_nxt == 2) ? 0 : s_nxt + 1;
    }
    __syncthreads();
}

template <class FV, class FD>
__device__ __forceinline__ void wave_store_bf16_f(FV val, FD dst, bool write_through = false, const char* wt_base = nullptr, unsigned wt_bytes = 0) {
    const __amdgpu_buffer_rsrc_t wt_rsrc = __builtin_amdgcn_make_buffer_rsrc((void*)wt_base, 0, (int)wt_bytes, 0x00020000);
    const int lane = TIDX & 63, wid = TIDX >> 6, fr = lane & 15, fq = lane >> 4;
    char* base = smem + wid * 9216;
#pragma unroll
    for (int m = 0; m < 4; ++m)
#pragma unroll
        for (int n = 0; n < 4; ++n)
#pragma unroll
            for (int j = 0; j < 4; ++j)
                *(u16*)(base + (m * 16 + fq * 4 + j) * 144 + (n * 16 + fr) * 2) = f2bf(val(m, n, j));
    asm volatile("s_waitcnt lgkmcnt(0)" ::: "memory");
    __builtin_amdgcn_wave_barrier();
#pragma unroll
    for (int i = 0; i < 8; ++i) {
        const int id = i * 64 + lane, row = id >> 3, ch = id & 7;
        const uint4 d = *(const uint4*)(base + row * 144 + ch * 16);
        u16* p = dst(row);
        if (p) {
            if (write_through) {
                const u32x4 dv = {d.x, d.y, d.z, d.w};
                __builtin_amdgcn_raw_buffer_store_b128(dv, wt_rsrc, (int)((const char*)(p + ch * 8) - wt_base), 0, 16);
            } else *(uint4*)(p + ch * 8) = d;
        }
    }
    asm volatile("s_waitcnt lgkmcnt(0)" ::: "memory");
    __builtin_amdgcn_wave_barrier();
}

template <class FD>
__device__ __forceinline__ void wave_store_bf16(const float (&v)[4][4][4], FD dst) {
    wave_store_bf16_f([&](int m, int n, int j) { return v[m][n][j]; }, dst);
}

struct ConvD { const float* src; u16* dst; int ld, ldd, k0, n0, mode, zr; };
__device__ __forceinline__ void conv_load(const Params& p, const ConvD& d, float (&v)[16]) {
    const int tid = TIDX;
#pragma unroll
    for (int i = 0; i < 16; ++i) v[i] = d.src[(size_t)(d.k0 + i * 4 + (tid >> 6)) * d.ld + d.n0 + (tid & 63)];
    if (d.zr == 2) {
#pragma unroll
        for (int i = 0; i < 16; ++i) {
            const int k = d.k0 + i * 4 + (tid >> 6);
            v[i] *= (k < 512) ? p.norm_attn_out[k] : p.norm_ssm_out[k - 512];
        }
    }
}
__device__ __forceinline__ void conv_store(const Params& p, const ConvD& d, const float (&v)[16]) {
    float* t = (float*)smem;
    const int tid = TIDX;
    __syncthreads();
#pragma unroll
    for (int i = 0; i < 16; ++i) t[(i * 4 + (tid >> 6)) * 65 + (tid & 63)] = v[i];
    __syncthreads();
    const int n = tid >> 2, kq = tid & 3;
    unsigned w[8];
#pragma unroll
    for (int i = 0; i < 8; ++i) w[i] = pack2(t[(kq * 16 + 2 * i) * 65 + n], t[(kq * 16 + 2 * i + 1) * 65 + n]);
    const int gn = d.n0 + n;
    int row = gn;
    if (d.mode == 1) row = (gn >> 4) * 32 + (gn & 15);
    else if (d.mode == 2) row = (gn >> 4) * 32 + 16 + (gn & 15);
    else if (d.mode == 3) row = n;
    uint4* o = (uint4*)(d.dst + (size_t)row * d.ldd + d.k0 + kq * 16);
    o[0] = make_uint4(w[0], w[1], w[2], w[3]);
    o[1] = make_uint4(w[4], w[5], w[6], w[7]);
    if (d.zr == 1) {
        uint4* z = (uint4*)(WSP_WrT + (size_t)(64 + n) * 1024 + d.k0 + kq * 16);
        z[0] = make_uint4(0, 0, 0, 0); z[1] = make_uint4(0, 0, 0, 0);
    }
}

__device__ __forceinline__ void ada_item(const Params& p, int item) {
    float* sc = (float*)smem;
    float* red = sc + 9 * 1024;
    const int tid = TIDX;
    __syncthreads();
    for (int i = tid; i < 9 * 1024; i += NTHR) {
        const int r = i >> 10, k = i & 1023;
        const float cv = (r < 8) ? p.c[r * 1024 + k] : p.c_ctx[k];
        sc[i] = siluf_(cv);
    }
    __syncthreads();
    const int kq = tid >> 6, jl = tid & 63, j = item * 64 + jl;
    float acc[9];
#pragma unroll
    for (int r = 0; r < 9; ++r) acc[r] = 0.f;
#pragma unroll 16
    for (int k = kq; k < 1024; k += 4) {
        const float w = p.w_ada[(size_t)k * 6144 + j];
#pragma unroll
        for (int r = 0; r < 9; ++r) acc[r] += sc[r * 1024 + k] * w;
    }
#pragma unroll
    for (int r = 0; r < 9; ++r) red[(kq * 9 + r) * 64 + jl] = acc[r];
    __syncthreads();
    for (int i = tid; i < 9 * 64; i += NTHR) {
        const int r = i >> 6, l = i & 63;
        const float s = red[(0 * 9 + r) * 64 + l] + red[(1 * 9 + r) * 64 + l] + red[(2 * 9 + r) * 64 + l] + red[(3 * 9 + r) * 64 + l];
        WSP_mod[r * 6144 + item * 64 + l] = s + p.b_ada[item * 64 + l];
    }
}

__device__ __forceinline__ void rope_item(const Params& p) {
    for (int i = TIDX; i < 64 * 16; i += NTHR) {
        const int pos = i >> 4, k = i & 15;
        const float inv = exp2f(-(float)k * (13.287712379549449f / 16.f));
        float s, c;
        sincosf((float)pos * inv, &s, &c);
        WSP_rope[i] = make_float2(c, s);
    }
}

__device__ __forceinline__ void ssm_table_item(const Params& p, int g, int dir) {
    float* pw = (float*)smem;
    float* Bb = pw + 17 * 64 * 2;
    float* Cc = Bb + 64 * 16 * 2;
    const int tid = TIDX;
    u16* tabS = WSP_TabS + (size_t)g * 256 * 256;
    u16* tabY = WSP_TabY + (size_t)g * 256 * 512;
    float* Kf = WSP_Kbuf + (size_t)(g * 2 + dir) * 4096;
    __syncthreads();
    {
        const int pidx = dir * 32 + g;
        const float dt = __expf(p.log_dt[pidx]);
        for (int i = tid; i < 17 * 64; i += NTHR) {
            const int tau = i >> 6, n = i & 63;
            const float are = p.a_re[pidx * 64 + n], aim = p.a_im[pidx * 64 + n];
            const float mag = __expf((float)tau * dt * are);
            float rev = (float)tau * (dt * aim * 0.15915494309189535f);
            rev -= rintf(rev);
            pw[i * 2] = mag * __builtin_amdgcn_cosf(rev);
            pw[i * 2 + 1] = mag * __builtin_amdgcn_sinf(rev);
        }
        __syncthreads();
        for (int i = tid; i < 64 * 16; i += NTHR) {
            const int n = i >> 4;
            const float are = p.a_re[pidx * 64 + n], aim = p.a_im[pidx * 64 + n];
            const float abr = pw[(64 + n) * 2], abi = pw[(64 + n) * 2 + 1];
            const float den = are * are + aim * aim, nre = abr - 1.f;
            const float cre = (nre * are + abi * aim) / den, cim = (abi * are - nre * aim) / den;
            const float br = p.b_re[(size_t)pidx * 1024 + i], bi = p.b_im[(size_t)pidx * 1024 + i];
            Bb[i * 2] = cre * br - cim * bi;
            Bb[i * 2 + 1] = cre * bi + cim * br;
            Cc[i * 2] = p.c_re[(size_t)pidx * 1024 + i];
            Cc[i * 2 + 1] = p.c_im[(size_t)pidx * 1024 + i];
        }
        __syncthreads();
        {
            const int tau = tid >> 4, pp = tid & 15;
            float s[16];
#pragma unroll
            for (int q = 0; q < 16; ++q) s[q] = 0.f;
            for (int n = 0; n < 64; ++n) {
                const float2 cv = *(const float2*)&Cc[(pp * 64 + n) * 2];
                const float2 wv = *(const float2*)&pw[(tau * 64 + n) * 2];
                const float zr = cv.x * wv.x - cv.y * wv.y, zi = cv.x * wv.y + cv.y * wv.x;
#pragma unroll
                for (int q = 0; q < 16; ++q) {
                    const float2 bv = *(const float2*)&Bb[(n * 16 + q) * 2];
                    s[q] += zr * bv.x - zi * bv.y;
                }
            }
#pragma unroll
            for (int q = 0; q < 4; ++q)
                *(float4*)(Kf + tau * 256 + pp * 16 + q * 4) = make_float4(s[4 * q], s[4 * q + 1], s[4 * q + 2], s[4 * q + 3]);
        }
        for (int id = tid; id < 128 * 32; id += NTHR) {
            const int rr = id >> 5, ch = id & 31, cpart = rr >> 6, n = rr & 63, s_ = ch >> 1, q0 = (ch & 1) * 8;
            const int e = dir == 0 ? 15 - s_ : s_;
            const float wr_ = pw[(e * 64 + n) * 2], wi_ = pw[(e * 64 + n) * 2 + 1];
            unsigned w[4];
#pragma unroll
            for (int i = 0; i < 4; ++i) {
                float v[2];
#pragma unroll
                for (int h = 0; h < 2; ++h) {
                    const float br = Bb[(n * 16 + q0 + 2 * i + h) * 2], bi = Bb[(n * 16 + q0 + 2 * i + h) * 2 + 1];
                    v[h] = cpart == 0 ? (wr_ * br - wi_ * bi) : (wr_ * bi + wi_ * br);
                }
                w[i] = pack2(v[0], v[1]);
            }
            *(uint4*)(tabS + (size_t)(dir * 128 + rr) * 256 + s_ * 16 + q0) = make_uint4(w[0], w[1], w[2], w[3]);
        }
        for (int id = tid; id < 256 * 16; id += NTHR) {
            const int m = id >> 4, ch = id & 15, t = m >> 4, pp = m & 15, cpart = ch >> 3, n0 = (ch & 7) * 8;
            const int e = dir == 0 ? t + 1 : 16 - t;
            unsigned w[4];
#pragma unroll
            for (int i = 0; i < 4; ++i) {
                float v[2];
#pragma unroll
                for (int h = 0; h < 2; ++h) {
                    const int n = n0 + 2 * i + h;
                    const float cr = Cc[(pp * 64 + n) * 2], ci = Cc[(pp * 64 + n) * 2 + 1];
                    const float wr_ = pw[(e * 64 + n) * 2], wi_ = pw[(e * 64 + n) * 2 + 1];
                    v[h] = cpart == 0 ? (cr * wr_ - ci * wi_) : -(cr * wi_ + ci * wr_);
                }
                w[i] = pack2(v[0], v[1]);
            }
            *(uint4*)(tabY + (size_t)m * 512 + 256 + dir * 128 + cpart * 64 + n0) = make_uint4(w[0], w[1], w[2], w[3]);
        }
    }
}

__device__ __forceinline__ void ssm_toeplitz_item(const Params& p, int g) {
    float* Kf = (float*)smem;
    const int tid = TIDX;
    u16* tabY = WSP_TabY + (size_t)g * 256 * 512;
    __syncthreads();
    for (int i = tid; i < 2048; i += NTHR) ((float4*)Kf)[i] = ((const float4*)(WSP_Kbuf + (size_t)g * 8192))[i];
    __syncthreads();
    for (int id = tid; id < 256 * 32; id += NTHR) {
        const int m = id >> 5, ch = id & 31, t = m >> 4, pp = m & 15, s_ = ch >> 1, q0 = (ch & 1) * 8;
        unsigned w[4];
#pragma unroll
        for (int i = 0; i < 4; ++i) {
            float v[2];
#pragma unroll
            for (int h = 0; h < 2; ++h) {
                const int q = q0 + 2 * i + h;
                float val;
                if (s_ < t) val = Kf[((t - s_) * 16 + pp) * 16 + q];
                else if (s_ > t) val = Kf[4096 + ((s_ - t) * 16 + pp) * 16 + q];
                else val = Kf[(pp) * 16 + q] + Kf[4096 + pp * 16 + q] + (pp == q ? p.ssm_d[g * 16 + pp] : 0.f);
                v[h] = val;
            }
            w[i] = pack2(v[0], v[1]);
        }
        *(uint4*)(tabY + (size_t)m * 512 + s_ * 16 + q0) = make_uint4(w[0], w[1], w[2], w[3]);
    }
    __syncthreads();
}

#define N_CONV 6896
__device__ __forceinline__ ConvD conv_decode(const Params& p, int t) {
    ConvD d; d.mode = 0; d.zr = 0;
    if (t < 320) { d.src = p.w_in; d.ld = 1280; d.k0 = (t / 20) * 64; d.n0 = (t % 20) * 64; d.dst = WSP_WinT; d.ldd = 1024; return d; }
    t -= 320;
    if (t < 64) { d.src = p.w_glu; d.ld = 512; d.k0 = (t / 8) * 64; d.n0 = (t % 8) * 64; d.dst = WSP_WgluT; d.ldd = 512; return d; }
    t -= 64;
    if (t < 256) { d.src = p.w_out; d.ld = 1024; d.k0 = (t / 16) * 64; d.n0 = (t % 16) * 64; d.dst = WSP_WoutT; d.ldd = 1024; d.zr = 2; return d; }
    t -= 256;
    if (t < 16) { d.src = p.w_router; d.ld = 64; d.k0 = t * 64; d.n0 = 0; d.dst = WSP_WrT; d.ldd = 1024; d.zr = 1; return d; }
    t -= 16;
    if (t < 4096) {
        const int up = t >= 2048; const int tt = t & 2047, e = tt >> 5, r = tt & 31;
        d.src = (up ? p.w_up_e : p.w_gate_e) + (size_t)e * 131072; d.ld = 128; d.k0 = (r >> 1) * 64; d.n0 = (r & 1) * 64;
        d.dst = WSP_WguT + (size_t)e * 262144; d.ldd = 1024; d.mode = 1 + up; return d;
    }
    t -= 4096;
    if (t < 64) {
        const int up = t >= 32; const int r = t & 31;
        d.src = up ? p.w_up_s : p.w_gate_s; d.ld = 128; d.k0 = (r >> 1) * 64; d.n0 = (r & 1) * 64;
        d.dst = WSP_WguT + (size_t)64 * 262144; d.ldd = 1024; d.mode = 1 + up; return d;
    }
    t -= 64;
    if (t < 2048) { const int e = t >> 5, r = t & 31; d.src = p.w_down_e + (size_t)e * 131072; d.ld = 1024; d.k0 = (r >> 4) * 64; d.n0 = (r & 15) * 64; d.dst = WSP_WdT + (size_t)e * 131072; d.ldd = 128; return d; }
    t -= 2048;
    d.src = p.w_down_s; d.ld = 1024; d.k0 = (t >> 4) * 64; d.n0 = (t & 15) * 64; d.dst = WSP_WdT + (size_t)64 * 131072; d.ldd = 128; return d;
}

#define N_CONV_EARLY 3200
__device__ __forceinline__ void conv_range(const Params& p, int t0, int stride, int tend, int tbeg = 0) {
    int t = tbeg + t0;
    if (t < tend) {
        ConvD d = conv_decode(p, t);
        float v[16];
        conv_load(p, d, v);
        while (t < tend) {
            const int tn = t + stride;
            ConvD dn = d;
            float vn[16];
            if (tn < tend) { dn = conv_decode(p, tn); conv_load(p, dn, vn); }
            conv_store(p, d, v);
            d = dn;
#pragma unroll
            for (int i = 0; i < 16; ++i) v[i] = vn[i];
            t = tn;
        }
    }
}
#define P0_CONV_B0 161
__device__ __forceinline__ void phase0(const Params& p) {
    const int b = blockIdx.x, G = gridDim.x;
    if (G > P0_CONV_B0 + 32) {
        if (b < 64) ssm_table_item(p, b >> 1, b & 1);
        else if (b < 160) ada_item(p, b - 64);
        else if (b == 160) rope_item(p);
        else conv_range(p, b - P0_CONV_B0, G - P0_CONV_B0, N_CONV_EARLY);
    } else {
        const int NU = 64 + 96 + 1 + N_CONV_EARLY;
        for (int u = b; u < NU; u += G) {
            if (u < 64) ssm_table_item(p, u >> 1, u & 1);
            else if (u < 160) ada_item(p, u - 64);
            else if (u == 160) rope_item(p);
            else { ConvD d = conv_decode(p, u - 161); float v[16]; conv_load(p, d, v); conv_store(p, d, v); }
        }
    }
}
#if 0
    {
        {
            const int stride = G - P0_CONV_B0;
            int t = b - P0_CONV_B0;
            if (t < N_CONV) {
                ConvD d = conv_decode(p, t);
                float v[16];
                conv_load(p, d, v);
                while (t < N_CONV) {
                    const int tn = t + stride;
                    ConvD dn = d;
                    float vn[16];
                    if (tn < N_CONV) { dn = conv_decode(p, tn); conv_load(p, dn, vn); }
                    conv_store(p, d, v);
                    d = dn;
#pragma unroll
                    for (int i = 0; i < 16; ++i) v[i] = vn[i];
                    t = tn;
                }
            }
        }
    } else {
        const int NU = 64 + 96 + 1 + N_CONV;
        for (int u = b; u < NU; u += G) {
            if (u < 64) ssm_table_item(p, u >> 1, u & 1);
            else if (u < 160) ada_item(p, u - 64);
            else if (u == 160) rope_item(p);
            else { ConvD d = conv_decode(p, u - 161); float v[16]; conv_load(p, d, v); conv_store(p, d, v); }
        }
    }
}

#endif

__device__ __forceinline__ void norm_mod_row(const float* src, const float* gain, const float* sh, const float* scl, u16* dst) {
    const int lane = TIDX & 63;
    float4 v[4];
    float ss = 0.f;
#pragma unroll
    for (int i = 0; i < 4; ++i) {
        v[i] = *(const float4*)(src + i * 256 + lane * 4);
        ss += v[i].x * v[i].x + v[i].y * v[i].y + v[i].z * v[i].z + v[i].w * v[i].w;
    }
    ss = wave_sum(ss);
    const float rs = rsqrtf(ss * (1.f / 1024.f) + EPS);
#pragma unroll
    for (int i = 0; i < 4; ++i) {
        const int c0 = i * 256 + lane * 4;
        const float4 g = *(const float4*)(gain + c0), s = *(const float4*)(sh + c0), k = *(const float4*)(scl + c0);
        const float a = v[i].x * rs * g.x * (1.f + k.x) + s.x, b = v[i].y * rs * g.y * (1.f + k.y) + s.y;
        const float c = v[i].z * rs * g.z * (1.f + k.z) + s.z, d = v[i].w * rs * g.w * (1.f + k.w) + s.w;
        *(uint2*)(dst + c0) = make_uint2(pack2(a, b), pack2(c, d));
    }
}

__device__ __forceinline__ void phase1(const Params& p) {
    const int wv = blockIdx.x * 4 + (TIDX >> 6), nwv = gridDim.x * 4;
    const int lane = TIDX & 63;
    for (int r0 = wv * 4; r0 < NROWS; r0 += nwv * 4) {
        const float* src[4]; const float* md[4];
        float4 v[4][4];
#pragma unroll
        for (int q = 0; q < 4; ++q) {
            const int r = r0 + q;
            if (r < NLAT) { src[q] = p.x + (size_t)r * 1024; md[q] = WSP_mod + (r >> 11) * 6144; }
            else { src[q] = p.ctx + (size_t)(r - NLAT) * 1024; md[q] = WSP_mod + 8 * 6144; }
#pragma unroll
            for (int i = 0; i < 4; ++i) v[q][i] = *(const float4*)(src[q] + i * 256 + lane * 4);
        }
#pragma unroll
        for (int q = 0; q < 4; ++q) {
            float ss = 0.f;
#pragma unroll
            for (int i = 0; i < 4; ++i) ss += v[q][i].x * v[q][i].x + v[q][i].y * v[q][i].y + v[q][i].z * v[q][i].z + v[q][i].w * v[q][i].w;
            ss = wave_sum(ss);
            const float rs = rsqrtf(ss * (1.f / 1024.f) + EPS);
            u16* dst = WSP_Hb + (size_t)(r0 + q) * 1024;
#pragma unroll
            for (int i = 0; i < 4; ++i) {
                const int c0 = i * 256 + lane * 4;
                const float4 g = *(const float4*)(p.norm_mix + c0), s = *(const float4*)(md[q] + c0), k = *(const float4*)(md[q] + 1024 + c0);
                const float a = v[q][i].x * rs * g.x * (1.f + k.x) + s.x, b = v[q][i].y * rs * g.y * (1.f + k.y) + s.y;
                const float c = v[q][i].z * rs * g.z * (1.f + k.z) + s.z, d = v[q][i].w * rs * g.w * (1.f + k.w) + s.w;
                *(uint2*)(dst + c0) = make_uint2(pack2(a, b), pack2(c, d));
            }
        }
    }
}

__device__ __forceinline__ void phase2(const Params& p) {
    const int NU = 128 * 10 + 16 * 6;
    const int lane = TIDX & 63, wid = TIDX >> 6, wr = wid >> 1, wc = wid & 1, fr = lane & 15, fq = lane >> 4;
    for (int u = blockIdx.x; u < NU; u += gridDim.x) {
        int mt, nt;
        {
            const int xc = u & 7, r = u >> 3;
            if (r < 160) { mt = xc + 8 * (r / 10); nt = r % 10; } else { const int v = r - 160; mt = 128 + xc + 8 * (v / 6); nt = 4 + v % 6; }
        }
        const u16* A = WSP_Hb + (size_t)mt * 128 * 1024;
        const u16* B = WSP_WinT + (size_t)nt * 128 * 1024;
        f32x4 acc[4][4];
        gemm_tile(16,
            [&](int R, int C, int kt) { return (const void*)(A + (size_t)R * 1024 + kt * 64 + C); },
            [&](int R, int C, int kt) { return (const void*)(B + (size_t)R * 1024 + kt * 64 + C); }, acc);
        const int row0 = mt * 128 + wr * 64;
        const int col0 = nt * 128 + wc * 64;
        const bool is_lat = mt < 128;
        if (nt == 5) {
            const int kvh = wc;
#pragma unroll
            for (int m = 0; m < 4; ++m) {
                const int r = row0 + m * 16 + fq * 4;
                int b, pos;
                if (is_lat) { b = r >> 11; pos = r & 2047; } else { const int rc = r - NLAT; b = rc >> 8; pos = SEQ + (rc & 255); }
#pragma unroll
                for (int n = 0; n < 4; ++n) {
                    const int d = n * 16 + fr;
                    u16* dst = WSP_Vt + ((size_t)(b * 2 + kvh) * 64 + d) * VT_LD + pos;
                    *(uint2*)dst = make_uint2(pack2(acc[m][n][0], acc[m][n][1]), pack2(acc[m][n][2], acc[m][n][3]));
                }
            }
        } else {
            float v[4][4][4];
            const bool do_rope = is_lat && nt <= 4;
#pragma unroll
            for (int m = 0; m < 4; ++m)
#pragma unroll
                for (int j = 0; j < 4; ++j) {
                    if (do_rope) {
                        const int r = row0 + m * 16 + fq * 4 + j, pos = r & 2047;
                        const float2 cr = WSP_rope[(pos >> 6) * 16 + fr], cc = WSP_rope[(pos & 63) * 16 + fr];
                        const float x1 = acc[m][0][j], x2 = acc[m][1][j], y1 = acc[m][2][j], y2 = acc[m][3][j];
                        v[m][0][j] = x1 * cr.x - x2 * cr.y; v[m][1][j] = x1 * cr.y + x2 * cr.x;
                        v[m][2][j] = y1 * cc.x - y2 * cc.y; v[m][3][j] = y1 * cc.y + y2 * cc.x;
                    } else {
#pragma unroll
                        for (int n = 0; n < 4; ++n) v[m][n][j] = acc[m][n][j];
                    }
                }
            u16* dbase; int ldd;
            if (nt < 4) { dbase = WSP_Q + (size_t)row0 * 512 + col0; ldd = 512; }
            else if (nt == 4) { dbase = WSP_Kb + (size_t)row0 * 128 + (col0 - 512); ldd = 128; }
            else { dbase = WSP_U + (size_t)row0 * 512 + (col0 - 768); ldd = 512; }
            wave_store_bf16(v, [&](int row) { return dbase + (size_t)row * ldd; });
        }
    }
}

__device__ __forceinline__ void attn_unit(const Params& p, int u) {
    const int h = u & 7, qb = (u >> 3) & 15, b = u >> 7, kvh = h >> 2;
    const int tid = TIDX, lane = tid & 63, wid = tid >> 6, fr = lane & 15, fq = lane >> 4;
    const int sb = lane * 16, swz = sb ^ (((sb >> 9) & 1) << 5);
    const int r_in = swz >> 6, c_in = (swz & 63) >> 1;
    const int jstart = qb == 0 ? 2 : 0, jend = qb == 15 ? 4 : 6, nb = jend - jstart, ntile = nb + 4;
    const float SC = 0.125f * 1.4426950408889634f;
    bf16x8 qf[2][2];
    const int qrow0 = b * SEQ + qb * 128 + wid * 32;
#pragma unroll
    for (int qt = 0; qt < 2; ++qt)
#pragma unroll
        for (int ks = 0; ks < 2; ++ks)
            qf[qt][ks] = *(const bf16x8*)(WSP_Q + (size_t)(qrow0 + qt * 16 + fr) * 512 + h * 64 + ks * 32 + fq * 8);
    f32x4 o[4][2];
#pragma unroll
    for (int dt = 0; dt < 4; ++dt)
#pragma unroll
        for (int qt = 0; qt < 2; ++qt) o[dt][qt] = (f32x4){0.f, 0.f, 0.f, 0.f};
    float mrun[2], lrun[2];
    const float sinkv = p.attn_sink[h] * 1.4426950408889634f;
    mrun[0] = mrun[1] = sinkv;
    lrun[0] = lrun[1] = (fq == 0) ? 1.f : 0.f;
    __syncthreads();
    auto stage = [&](int i, int s) {
        const u16* kbase; const u16* vbase;
        if (i < nb) {
            const int ks0 = qb * 128 - 128 + 64 * (jstart + i);
            kbase = WSP_Kb + (size_t)(b * SEQ + ks0) * 128 + kvh * 64;
            vbase = WSP_Vt + (size_t)(b * 2 + kvh) * 64 * VT_LD + ks0;
        } else {
            const int c0 = 64 * (i - nb);
            kbase = WSP_Kb + (size_t)(NLAT + b * CTXL + c0) * 128 + kvh * 64;
            vbase = WSP_Vt + (size_t)(b * 2 + kvh) * 64 * VT_LD + SEQ + c0;
        }
        char* sk = smem + s * 16384;
        char* sv = sk + 8192;
#pragma unroll
        for (int it = 0; it < 2; ++it) {
            const int st = wid + 4 * it, R = (st >> 1) * 16 + r_in, C = (st & 1) * 32 + c_in;
            glds16(kbase + (size_t)R * 128 + C, sk + tid * 16 + it * 4096);
            glds16(vbase + (size_t)R * VT_LD + C, sv + tid * 16 + it * 4096);
        }
    };
    stage(0, 0);
    for (int i = 0; i < ntile; ++i) {
        asm volatile("s_waitcnt vmcnt(0)" ::: "memory");
        __syncthreads();
        if (i + 1 < ntile) stage(i + 1, (i + 1) & 1);
        const char* sk = smem + (i & 1) * 16384;
        const char* sv = sk + 8192;
        f32x4 s[4][2];
#pragma unroll
        for (int kt = 0; kt < 4; ++kt)
#pragma unroll
            for (int qt = 0; qt < 2; ++qt) s[kt][qt] = (f32x4){0.f, 0.f, 0.f, 0.f};
#pragma unroll
        for (int ks = 0; ks < 2; ++ks)
#pragma unroll
            for (int kt = 0; kt < 4; ++kt) {
                const bf16x8 kf = *(const bf16x8*)(sk + lds_byte(kt * 16 + fr, ks * 32 + fq * 8));
#pragma unroll
                for (int qt = 0; qt < 2; ++qt) s[kt][qt] = __builtin_amdgcn_mfma_f32_16x16x32_bf16(kf, qf[qt][ks], s[kt][qt], 0, 0, 0);
            }
        const int ks0 = qb * 128 - 128 + 64 * (jstart + i);
        const int qlo = qb * 128 + wid * 32;
        const bool band = (i < nb) && ((qlo + 31 - ks0 > 128) || (ks0 + 63 - qlo > 128));
        bf16x8 pf[2][2];
#pragma unroll
        for (int qt = 0; qt < 2; ++qt) {
            const int qp = qb * 128 + wid * 32 + qt * 16 + fr;
            float mx = -1e30f;
#pragma unroll
            for (int kt = 0; kt < 4; ++kt)
#pragma unroll
                for (int j = 0; j < 4; ++j) {
                    float v = s[kt][qt][j] * SC;
                    if (band) {
                        const int kp = ks0 + kt * 16 + fq * 4 + j, d = qp - kp;
                        if (d > 128 || d < -128) v = -1e30f;
                    }
                    s[kt][qt][j] = v;
                    mx = fmaxf(mx, v);
                }
            mx = fmaxf(mx, __shfl_xor(mx, 16));
            mx = fmaxf(mx, __shfl_xor(mx, 32));
            const float mnew = fmaxf(mrun[qt], mx);
            const float alpha = __builtin_amdgcn_exp2f(mrun[qt] - mnew);
            mrun[qt] = mnew;
            float ls = 0.f;
#pragma unroll
            for (int kt = 0; kt < 4; ++kt)
#pragma unroll
                for (int j = 0; j < 4; ++j) {
                    const float pv = __builtin_amdgcn_exp2f(s[kt][qt][j] - mnew);
                    s[kt][qt][j] = pv;
                    ls += pv;
                }
            lrun[qt] = lrun[qt] * alpha + ls;
#pragma unroll
            for (int dt = 0; dt < 4; ++dt) o[dt][qt] *= alpha;
#pragma unroll
            for (int k2 = 0; k2 < 2; ++k2) {
                bf16x8 t;
#pragma unroll
                for (int j = 0; j < 4; ++j) { t[j] = (short)f2bf(s[2 * k2][qt][j]); t[4 + j] = (short)f2bf(s[2 * k2 + 1][qt][j]); }
                pf[qt][k2] = t;
            }
        }
#pragma unroll
        for (int k2 = 0; k2 < 2; ++k2)
#pragma unroll
            for (int dt = 0; dt < 4; ++dt) {
                const uint2 lo = *(const uint2*)(sv + lds_byte(dt * 16 + fr, k2 * 32 + fq * 4));
                const uint2 hi = *(const uint2*)(sv + lds_byte(dt * 16 + fr, k2 * 32 + 16 + fq * 4));
                union { uint4 u; bf16x8 v; } cv; cv.u = make_uint4(lo.x, lo.y, hi.x, hi.y);
#pragma unroll
                for (int qt = 0; qt < 2; ++qt) o[dt][qt] = __builtin_amdgcn_mfma_f32_16x16x32_bf16(cv.v, pf[qt][k2], o[dt][qt], 0, 0, 0);
            }
    }
#pragma unroll
    for (int qt = 0; qt < 2; ++qt) {
        float l = lrun[qt];
        l += __shfl_xor(l, 16);
        l += __shfl_xor(l, 32);
        const float inv = 1.f / l;
        u16* dst = WSP_AO + (size_t)(qrow0 + qt * 16 + fr) * 512 + h * 64 + fq * 4;
        float sq = 0.f;
#pragma unroll
        for (int dt = 0; dt < 4; ++dt) {
            const unsigned w0 = pack2(o[dt][qt][0] * inv, o[dt][qt][1] * inv), w1 = pack2(o[dt][qt][2] * inv, o[dt][qt][3] * inv);
            *(uint2*)(dst + dt * 16) = make_uint2(w0, w1);
            const float a = bf2f((u16)(w0 & 0xffffu)), b = bf2f((u16)(w0 >> 16)), c = bf2f((u16)(w1 & 0xffffu)), d = bf2f((u16)(w1 >> 16));
            sq += a * a + b * b + c * c + d * d;
        }
        sq += __shfl_xor(sq, 16);
        sq += __shfl_xor(sq, 32);
        if (fq == 0) unsafeAtomicAdd(WSP_rsq + (size_t)(qrow0 + qt * 16 + fr) * 2, sq);
    }
}

__device__ __forceinline__ void ssm_s1_unit(const Params& p, int u) {
    const int ct = u % 9, mh = (u / 9) & 1, g = u / 18;
    const int lane = TIDX & 63, wid = TIDX >> 6, wr = wid >> 1, wc = wid & 1, fr = lane & 15, fq = lane >> 4;
    const u16* A = WSP_TabS + ((size_t)g * 256 + mh * 128) * 256;
    const u16* Ub = WSP_U + (size_t)ct * 128 * 16 * 512 + g * 16;
    f32x4 acc[4][4];
    gemm_tile(4,
        [&](int R, int C, int kt) { return (const void*)(A + (size_t)R * 256 + kt * 64 + C); },
        [&](int R, int C, int kt) { return (const void*)(Ub + (size_t)(R * 16 + kt * 4 + (C >> 4)) * 512 + (C & 15)); }, acc);
#pragma unroll
    for (int m = 0; m < 4; ++m)
#pragma unroll
        for (int n = 0; n < 4; ++n) {
            const int rho = mh * 128 + wr * 64 + m * 16 + fq * 4;
            const int cg = ct * 128 + wc * 64 + n * 16 + fr;
            *(f32x4*)(WSP_S + ((size_t)cg * 32 + g) * 256 + rho) = acc[m][n];
        }
}

__device__ __forceinline__ void phase3(const Params& p) {
    const int NU = 1024 + 576;
    for (int u = blockIdx.x; u < NU; u += gridDim.x) {
        if (u < 1024) attn_unit(p, u); else ssm_s1_unit(p, u - 1024);
    }
}

__device__ __forceinline__ void phase4(const Params& p) {
    if ((int)gridDim.x > 192) {
        if ((int)blockIdx.x >= 160) { conv_range(p, blockIdx.x - 160, gridDim.x - 160, N_CONV, N_CONV_EARLY); return; }
        if ((int)blockIdx.x >= 128) { ssm_toeplitz_item(p, blockIdx.x - 128); return; }
    } else {
        for (int g = blockIdx.x; g < 32; g += gridDim.x) ssm_toeplitz_item(p, g);
        conv_range(p, blockIdx.x, gridDim.x, N_CONV, N_CONV_EARLY);
    }
    const int gid = blockIdx.x * NTHR + TIDX;
    if (gid >= BATCH * 2 * 32 * 64) return;
    const int n = gid & 63, g = (gid >> 6) & 31, dir = (gid >> 11) & 1, b = gid >> 12;
    const int pidx = dir * 32 + g;
    const float dt = __expf(p.log_dt[pidx]);
    const float are = p.a_re[pidx * 64 + n], aim = p.a_im[pidx * 64 + n];
    const float mag = __expf(16.f * dt * are);
    float rev = 16.f * (dt * aim * 0.15915494309189535f);
    rev -= rintf(rev);
    const float ar = mag * __builtin_amdgcn_cosf(rev), ai = mag * __builtin_amdgcn_sinf(rev);
    float hr = 0.f, hi = 0.f;
    const size_t so = (size_t)g * 256 + dir * 128 + n;
#pragma unroll 8
    for (int i = 0; i < 16; ++i) {
        const int c = dir == 0 ? i : 15 - i;
        const float* sp = WSP_S + (size_t)(NCHUNK_LAT + b * 16 + c) * 8192 + so;
        const float sr = sp[0], si = sp[64];
        const float nr = ar * hr - ai * hi + sr, ni = ar * hi + ai * hr + si;
        hr = nr; hi = ni;
    }
#pragma unroll 8
    for (int i = 0; i < 128; ++i) {
        const int c = dir == 0 ? i : 127 - i;
        const size_t cg = (size_t)b * 128 + c;
        const float* sp = WSP_S + cg * 8192 + so;
        const float sr = sp[0], si = sp[64];
        u16* hp = WSP_Hin + cg * 8192 + so;
        hp[0] = f2bf(hr); hp[64] = f2bf(hi);
        const float nr = ar * hr - ai * hi + sr, ni = ar * hi + ai * hr + si;
        hr = nr; hi = ni;
    }
}

__device__ __forceinline__ void phase5(const Params& p) {
    const int NU = 512;
    const int lane = TIDX & 63, wid = TIDX >> 6, wr = wid >> 1, wc = wid & 1, fr = lane & 15, fq = lane >> 4;
    for (int u = blockIdx.x; u < NU; u += gridDim.x) {
        const int ct = u & 7, mh = (u >> 3) & 1, g = u >> 4;
        const u16* A = WSP_TabY + ((size_t)g * 256 + mh * 128) * 512;
        const u16* Ub = WSP_U + (size_t)ct * 128 * 16 * 512 + g * 16;
        const u16* Hb_ = WSP_Hin + (size_t)ct * 128 * 8192 + g * 256;
        f32x4 acc[4][4];
        gemm_tile(8,
            [&](int R, int C, int kt) { return (const void*)(A + (size_t)R * 512 + kt * 64 + C); },
            [&](int R, int C, int kt) {
                return kt < 4 ? (const void*)(Ub + (size_t)(R * 16 + kt * 4 + (C >> 4)) * 512 + (C & 15))
                              : (const void*)(Hb_ + (size_t)R * 8192 + (kt - 4) * 64 + C);
            }, acc);
#pragma unroll
        for (int m = 0; m < 4; ++m)
#pragma unroll
            for (int n = 0; n < 4; ++n) {
                const int t = mh * 8 + wr * 4 + m;
                const int cg = ct * 128 + wc * 64 + n * 16 + fr;
                u16* dst = WSP_Y + ((size_t)cg * 16 + t) * 512 + g * 16 + fq * 4;
                *(uint2*)dst = make_uint2(pack2(gelu_tanh(acc[m][n][0]), gelu_tanh(acc[m][n][1])),
                                          pack2(gelu_tanh(acc[m][n][2]), gelu_tanh(acc[m][n][3])));
            }
    }
}

__device__ __forceinline__ void phase6(const Params& p) {
    const int NU = 512;
    const int lane = TIDX & 63, wid = TIDX >> 6, wr = wid >> 1, wc = wid & 1, fr = lane & 15, fq = lane >> 4;
    for (int u = blockIdx.x; u < NU; u += gridDim.x) {
        const int mt = u >> 2, nt = u & 3;
        const u16* A = WSP_Y + (size_t)mt * 128 * 512;
        const u16* B = WSP_WgluT + (size_t)nt * 128 * 512;
        f32x4 acc[4][4];
        gemm_tile(8,
            [&](int R, int C, int kt) { return (const void*)(A + (size_t)R * 512 + kt * 64 + C); },
            [&](int R, int C, int kt) { return (const void*)(B + (size_t)R * 512 + kt * 64 + C); }, acc);
        const int row0 = mt * 128 + wr * 64, col0 = nt * 128 + wc * 64;
        char* base = smem + wid * 9216;
        float bg[4];
#pragma unroll
        for (int n = 0; n < 4; ++n) bg[n] = p.b_glu[col0 + n * 16 + fr];
#pragma unroll
        for (int m = 0; m < 4; ++m)
#pragma unroll
            for (int j = 0; j < 4; ++j) {
                const int rl = m * 16 + fq * 4 + j, r = row0 + rl;
                float sq = 0.f;
#pragma unroll
                for (int n = 0; n < 4; ++n) {
                    const int c = col0 + n * 16 + fr;
                    const float yv = bf2f(WSP_Y[(size_t)r * 512 + c]);
                    const u16 ob = f2bf(yv * sigmoidf_(acc[m][n][j] + bg[n]));
                    *(u16*)(base + rl * 144 + (n * 16 + fr) * 2) = ob;
                    const float of = bf2f(ob);
                    sq += of * of;
                }
                sq += __shfl_xor(sq, 1); sq += __shfl_xor(sq, 2); sq += __shfl_xor(sq, 4); sq += __shfl_xor(sq, 8);
                if (fr == 0) unsafeAtomicAdd(WSP_rsq + (size_t)r * 2 + 1, sq);
            }
        asm volatile("s_waitcnt lgkmcnt(0)" ::: "memory");
        __builtin_amdgcn_wave_barrier();
        u16* dbase = WSP_SO + (size_t)row0 * 512 + col0;
#pragma unroll
        for (int i = 0; i < 8; ++i) {
            const int id = i * 64 + lane, row = id >> 3, ch = id & 7;
            *(uint4*)(dbase + (size_t)row * 512 + ch * 8) = *(const uint4*)(base + row * 144 + ch * 16);
        }
        asm volatile("s_waitcnt lgkmcnt(0)" ::: "memory");
        __builtin_amdgcn_wave_barrier();
    }
}

__device__ __forceinline__ void phase8(const Params& p) {
    const int NU = 512;
    for (int u = blockIdx.x; u < NU; u += gridDim.x) {
        const int mt = (u & 7) + 8 * (u >> 5), nt = (u >> 3) & 3;
        const u16* A1 = WSP_AO + (size_t)mt * 128 * 512;
        const u16* A2 = WSP_SO + (size_t)mt * 128 * 512;
        const u16* B = WSP_WoutT + (size_t)nt * 256 * 1024;
        f32x4 acc[4][8];
        {
        const int tid1 = TIDX, fq = (tid1 & 63) >> 4, row0 = mt * 128 + (tid1 >> 7) * 64;
        gemm_tile_w(32,
            [&](int i, int R, int C, int kt) { return (const void*)((kt < 16 ? A1 : A2) + (size_t)R * 512 + (kt & 15) * 32 + C); },
            [&](int i, int R, int C, int kt) { return (const void*)(B + (size_t)R * 1024 + kt * 32 + C); }, acc,
            [&](int kt) {
                if (kt == 16) {
#pragma unroll
                    for (int m = 0; m < 4; ++m) {
                        asm volatile("" ::: "memory");
#pragma unroll
                        for (int j = 0; j < 4; ++j) {
                            const float2 q = *(const float2*)(WSP_rsq + (size_t)(row0 + m * 16 + fq * 4 + j) * 2);
                            const float ratio = rsqrtf(q.x * (1.f / 512.f) + EPS) / rsqrtf(q.y * (1.f / 512.f) + EPS);
#pragma unroll
                            for (int n = 0; n < 8; ++n) acc[m][n][j] *= ratio;
                        }
                    }
                }
            });
        }
        const int tid2 = TIDX, lane = tid2 & 63, wid = tid2 >> 6, fr = lane & 15, fq = lane >> 4;
        const int row0 = mt * 128 + (wid >> 1) * 64, col0 = nt * 256 + (wid & 1) * 128;
        const float* g1 = WSP_mod + (mt >> 4) * 6144 + 2048 + col0;
        float* stg = (float*)(smem + wid * 8448);
#pragma unroll
        for (int m = 0; m < 4; ++m) {
#pragma unroll
            for (int n = 0; n < 8; ++n)
#pragma unroll
                for (int j = 0; j < 4; ++j) stg[(fq * 4 + j) * 132 + n * 16 + fr] = acc[m][n][j];
            asm volatile("s_waitcnt lgkmcnt(0)" ::: "memory");
            __builtin_amdgcn_wave_barrier();
#pragma unroll
            for (int i = 0; i < 8; ++i) {
                const int id = i * 64 + lane, rr = id >> 5, c4 = (id & 31) * 4;
                float4 v = *(const float4*)(stg + rr * 132 + c4);
                const float rsv = rsqrtf(WSP_rsq[(size_t)(row0 + m * 16 + rr) * 2 + 1] * (1.f / 512.f) + EPS);
                v.x *= rsv; v.y *= rsv; v.z *= rsv; v.w *= rsv;
                const float4 g = *(const float4*)(g1 + c4);
                const size_t o = (size_t)(row0 + m * 16 + rr) * 1024 + col0 + c4;
                const float4 xv = *(const float4*)(p.x + o);
                *(float4*)(p.out + o) = make_float4(xv.x + g.x * v.x, xv.y + g.y * v.y, xv.z + g.z * v.z, xv.w + g.w * v.w);
            }
            asm volatile("s_waitcnt lgkmcnt(0)" ::: "memory");
            __builtin_amdgcn_wave_barrier();
        }
    }
}

#define CTR_ECNT 0
#define CTR_Q11 128
#define CTR_Q12 136
#define HALF_TOK 8192
#define HH_HALF_ROWS 73728
#define ELIST_CAP 8192
__device__ __forceinline__ void phase9(const Params& p) {
    const int tid = TIDX, lane = tid & 63, wid = tid >> 6, fr = lane & 15, fq = lane >> 4;
    char* At = smem;
    float* sc = (float*)(smem + 32768);
    int* hist = (int*)(smem + 32768 + 4096);
    int* gbase = hist + 64;
    int* fill = gbase + 64;
    unsigned char* selk = (unsigned char*)(fill + 64);
    float* selw = (float*)(selk + 256);
    for (int chunk = blockIdx.x; chunk < NLAT / 32; chunk += gridDim.x) {
        __syncthreads();
        if (tid < 64) hist[tid] = 0;
        for (int grp = 0; grp < 2; ++grp) {
            const int tok0 = chunk * 32 + grp * 16;
            __syncthreads();
            float4 vall[4][4];
#pragma unroll
            for (int rr = 0; rr < 4; ++rr)
#pragma unroll
                for (int i = 0; i < 4; ++i) vall[rr][i] = *(const float4*)(p.out + (size_t)(tok0 + wid * 4 + rr) * 1024 + i * 256 + lane * 4);
#pragma unroll
            for (int rr = 0; rr < 4; ++rr) {
                const int row = wid * 4 + rr, tok = tok0 + row;
                const float* md = WSP_mod + (tok >> 11) * 6144;
                float4 v[4];
                float ss = 0.f;
#pragma unroll
                for (int i = 0; i < 4; ++i) {
                    v[i] = vall[rr][i];
                    ss += v[i].x * v[i].x + v[i].y * v[i].y + v[i].z * v[i].z + v[i].w * v[i].w;
                }
                ss = wave_sum(ss);
                const float rs = rsqrtf(ss * (1.f / 1024.f) + EPS);
#pragma unroll
                for (int i = 0; i < 4; ++i) {
                    const int c0 = i * 256 + lane * 4;
                    const float4 g = *(const float4*)(p.norm_ffn + c0), s = *(const float4*)(md + 3072 + c0), k = *(const float4*)(md + 4096 + c0);
                    const float a = v[i].x * rs * g.x * (1.f + k.x) + s.x, b = v[i].y * rs * g.y * (1.f + k.y) + s.y;
                    const float c = v[i].z * rs * g.z * (1.f + k.z) + s.z, d = v[i].w * rs * g.w * (1.f + k.w) + s.w;
                    const uint2 pk = make_uint2(pack2(a, b), pack2(c, d));
                    *(uint2*)(WSP_H2 + (size_t)tok * 1024 + c0) = pk;
                    const int ch = c0 >> 3;
                    *(uint2*)(At + row * 2048 + ((ch ^ row) << 4) + ((c0 & 4) << 1)) = pk;
                }
            }
            __syncthreads();
            f32x4 acc = {0.f, 0.f, 0.f, 0.f};
            const u16* bp = WSP_WrT + (size_t)(wid * 16 + fr) * 1024 + fq * 8;
#pragma unroll
            for (int kb = 0; kb < 4; ++kb) {
                bf16x8 bfr[8];
#pragma unroll
                for (int q = 0; q < 8; ++q) bfr[q] = *(const bf16x8*)(bp + (kb * 8 + q) * 32);
#pragma unroll
                for (int q = 0; q < 8; ++q) {
                    const int ch = (kb * 8 + q) * 4 + fq;
                    const bf16x8 a = *(const bf16x8*)(At + fr * 2048 + ((ch ^ fr) << 4));
                    acc = __builtin_amdgcn_mfma_f32_16x16x32_bf16(a, bfr[q], acc, 0, 0, 0);
                }
            }
#pragma unroll
            for (int j = 0; j < 4; ++j) sc[(fq * 4 + j) * 64 + wid * 16 + fr] = sigmoidf_(acc[j]);
            __syncthreads();
            const float bias = p.router_bias[lane];
            const int eg = lane >> 3;
            for (int rr = 0; rr < 4; ++rr) {
                const int row = wid * 4 + rr, tok = tok0 + row;
                const float s = sc[row * 64 + lane];
                const float bz = s + bias;
                float m1 = bz;
                m1 = fmaxf(m1, __shfl_xor(m1, 1)); m1 = fmaxf(m1, __shfl_xor(m1, 2)); m1 = fmaxf(m1, __shfl_xor(m1, 4));
                const unsigned long long eq = __ballot(bz == m1);
                const unsigned gb = (unsigned)((eq >> (eg * 8)) & 0xffull);
                const int first = __ffs(gb) - 1;
                float v2 = ((lane & 7) == first) ? -1e30f : bz;
                v2 = fmaxf(v2, __shfl_xor(v2, 1)); v2 = fmaxf(v2, __shfl_xor(v2, 2)); v2 = fmaxf(v2, __shfl_xor(v2, 4));
                const float gs = m1 + v2;
                int cnt = 0;
#pragma unroll
                for (int j = 0; j < 8; ++j) {
                    const float gj = __int_as_float(__builtin_amdgcn_readlane(__float_as_int(gs), j * 8));
                    cnt += (gj > gs || (gj == gs && j < eg)) ? 1 : 0;
                }
                const bool gsel = cnt < 4;
                const float mv = gsel ? bz : -1e30f;
                int rank = 0;
#pragma unroll
                for (int j = 0; j < 64; ++j) {
                    const float vj = __int_as_float(__builtin_amdgcn_readlane(__float_as_int(mv), j));
                    rank += (vj > mv || (vj == mv && j < lane)) ? 1 : 0;
                }
                const bool sel = gsel && rank < 8;
                const float tot = wave_sum(sel ? s : 0.f);
                if (sel) {
                    selw[(grp * 16 + row) * 8 + rank] = s / tot * 2.5f;
                    selk[(grp * 16 + row) * 8 + rank] = (unsigned char)lane;
                    atomicAdd(&hist[lane], 1);
                }
            }
        }
        __syncthreads();
        const int h = (chunk * 32) >> 13;
        if (tid < 64) {
            gbase[tid] = hist[tid] ? (int)atomicAdd(&WSP_ctr[CTR_ECNT + h * 64 + tid], (unsigned)hist[tid]) : 0;
            fill[tid] = 0;
        }
        __syncthreads();
        {
            const int e = selk[tid];
            const int pos = atomicAdd(&fill[e], 1);
            WSP_elist[(size_t)(h * 64 + e) * ELIST_CAP + gbase[e] + pos] = (chunk * 32 + (tid >> 3)) * 8 + (tid & 7);
            WSP_wsl[(size_t)(h * 64 + e) * ELIST_CAP + gbase[e] + pos] = selw[tid];
        }
    }
}

struct MoeTab { int cnt[16]; int soff[16]; int pre[17]; };

template <class FV, class FD>
__device__ __forceinline__ void wave_store_fp8_f(FV val, FD dst) {
    const int lane = TIDX & 63, wid = TIDX >> 6, fr = lane & 15, fq = lane >> 4;
    char* base = smem + wid * 9216;
#pragma unroll
    for (int m = 0; m < 4; ++m)
#pragma unroll
        for (int n = 0; n < 8; ++n)
#pragma unroll
            for (int j = 0; j < 4; ++j)
                *(unsigned char*)(base + (m * 16 + fq * 4 + j) * 144 + n * 16 + fr) =
                    (unsigned char)(__builtin_amdgcn_cvt_pk_fp8_f32(val(m, n, j), 0.f, 0, false) & 0xff);
    asm volatile("s_waitcnt lgkmcnt(0)" ::: "memory");
    __builtin_amdgcn_wave_barrier();
#pragma unroll
    for (int i = 0; i < 8; ++i) {
        const int id = i * 64 + lane, row = id >> 3, ch = id & 7;
        const uint4 d = *(const uint4*)(base + row * 144 + ch * 16);
        unsigned char* q = dst(i, row);
        if (q) *(uint4*)(q + ch * 16) = d;
    }
    asm volatile("s_waitcnt lgkmcnt(0)" ::: "memory");
    __builtin_amdgcn_wave_barrier();
}

#define YD_SCALE 8.0f
template <int MODE>
__device__ __forceinline__ void phase11f(const Params& p) {
    const int tid = TIDX;
    int* tab = (int*)(smem + 73728);
    int* t_cnt = tab, *t_soff = tab + 16, *t_pre = tab + 32, *t_q = tab + 52;
    int* t_all = tab + 64;
    const int x = blockIdx.x & 7;
    unsigned* flags = WSP_flag + x * FLAG_PER_CLASS;
    unsigned* tmo = WSP_flag + 8 * FLAG_PER_CLASS;
    unsigned char* Yd8 = (unsigned char*)(p.ws + OFF_ARENA);
    __syncthreads();
    if (tid < 128) t_all[tid] = (int)WSP_ctr[CTR_ECNT + tid];
    unsigned* qhead = &WSP_ctr[(MODE == 2 ? CTR_Q12 : CTR_Q11) + x];
    if (tid == 0) t_q[0] = (int)atomicAdd(qhead, 1u);
    __syncthreads();
    if (tid < 16) {
        const int i = tid >> 1, h = tid & 1, e = x + 8 * i;
        t_cnt[tid] = t_all[h * 64 + e];
        int so = 0;
        for (int e2 = 0; e2 < e; ++e2) so += t_all[h * 64 + e2];
        t_soff[tid] = so;
    }
    __syncthreads();
    if (tid == 0) {
        int s = 0;
        for (int j = 0; j < 16; ++j) { t_pre[j] = s; s += (t_cnt[j] + 127) >> 7; }
        t_pre[16] = s;
    }
    __syncthreads();
    const int T_r = t_pre[16], T11 = T_r + 16, T_all = (MODE == 1) ? T11 : T11 + T11 * 4;
    for (;;) {
        __syncthreads();
        const int q = __builtin_amdgcn_readfirstlane(t_q[0]) + (MODE == 2 ? T11 : 0);
        __syncthreads();
        if (q >= T_all) break;
        if (tid == 0) t_q[0] = (int)atomicAdd(qhead, 1u);
        const bool is_down = q >= T11;
        const int u = is_down ? (q - T11) >> 2 : q;
        int nt = is_down ? (q - T11) & 3 : 0;
        int e, h, mt, c, rowbase;
        if (u < T_r) {
            int j = 0;
#pragma unroll
            for (int qq = 1; qq < 16; ++qq) j += (u >= t_pre[qq]) ? 1 : 0;
            e = x + 8 * (j >> 1); h = j & 1; mt = u - t_pre[j]; c = t_cnt[j];
            rowbase = h * HH_HALF_ROWS + t_soff[j];
        } else {
            const int ms = x * 16 + (u - T_r);
            e = 64; h = ms >> 6; mt = ms & 63; c = HALF_TOK;
            rowbase = h * HH_HALF_ROWS + 65536;
        }
        e = __builtin_amdgcn_readfirstlane(e); h = __builtin_amdgcn_readfirstlane(h); mt = __builtin_amdgcn_readfirstlane(mt);
        nt = __builtin_amdgcn_readfirstlane(nt); c = __builtin_amdgcn_readfirstlane(c); rowbase = __builtin_amdgcn_readfirstlane(rowbase);
        const int* el = WSP_elist + (size_t)(h * 64 + (e & 63)) * ELIST_CAP;
        if (!is_down) {
            const int t2 = TIDX, lane = t2 & 63, wid = t2 >> 6, wr = wid >> 1, wc = wid & 1, fr = lane & 15, fq = lane >> 4;
            const int sb = lane * 16, swz = sb ^ (((sb >> 9) & 1) << 5);
            const int r_in = swz >> 6, c_in = (swz & 63) >> 1;
            const int vrows = c - mt * 128 - wr * 64;
            const float* wsl = WSP_wsl + (size_t)(h * 64 + (e & 63)) * ELIST_CAP;
            const u16* aptr[2];
#pragma unroll
            for (int i = 0; i < 2; ++i) {
                int li = mt * 128 + (wid + 4 * i) * 16 + r_in;
                li = li < c ? li : c - 1;
                const int tok = (e < 64) ? (el[li] >> 3) : (h * HALF_TOK + li);
                aptr[i] = WSP_H2 + (size_t)tok * 1024 + c_in;
            }
            const u16* Bw = WSP_WguT + (size_t)e * 262144 + c_in;
            f32x4 acc[4][8];
            gemm_tile_w(32,
                [&](int i, int R, int C, int kt) { return (const void*)(aptr[i] + kt * 32); },
                [&](int i, int R, int C, int kt) { return (const void*)(Bw + (size_t)R * 1024 + kt * 32); }, acc);
            float wgt[4][4];
#pragma unroll
            for (int m = 0; m < 4; ++m)
#pragma unroll
                for (int j = 0; j < 4; ++j) {
                    const int li = mt * 128 + wr * 64 + m * 16 + fq * 4 + j;
                    float w = 1.f;
                    if (e < 64) w = (li < c) ? wsl[li] : 0.f;
                    wgt[m][j] = w;
                }
            u16* dbase = WSP_HHs + ((size_t)rowbase + mt * 128 + wr * 64) * 128 + wc * 64;
            wave_store_bf16_f([&](int m, int n2, int j) { return siluf_(acc[m][2 * n2][j]) * acc[m][2 * n2 + 1][j] * wgt[m][j]; },
                              [&](int row) { return row < vrows ? dbase + (size_t)row * 128 : (u16*)nullptr; }, true, (const char*)WSP_HHs, (unsigned)((size_t)2 * HH_HALF_ROWS * 128 * 2));
            asm volatile("s_waitcnt vmcnt(0)" ::: "memory");
            __syncthreads();
            if (tid == 0) __hip_atomic_store(&flags[u], 1u, __ATOMIC_RELAXED, __HIP_MEMORY_SCOPE_AGENT);
        } else {
            const int t2 = TIDX, lane = t2 & 63, wid = t2 >> 6, wr = wid >> 1, wc = wid & 1, fr = lane & 15, fq = lane >> 4;
            const int sb = lane * 16, swz = sb ^ (((sb >> 9) & 1) << 5);
            const int r_in = swz >> 6, c_in = (swz & 63) >> 1;
            const int vrows = c - mt * 128 - wr * 64;
            if (MODE == 0 && tid == 0) {
                unsigned sp = 0;
                while (__hip_atomic_load(&flags[u], __ATOMIC_RELAXED, __HIP_MEMORY_SCOPE_AGENT) == 0u) {
                    __builtin_amdgcn_s_sleep(2);
                    if ((++sp & 255u) == 0u) {
                        if (__hip_atomic_load(tmo, __ATOMIC_RELAXED, __HIP_MEMORY_SCOPE_AGENT)) break;
                        if (sp > (1u << 20)) { atomicAdd(tmo, 1u); break; }
                    }
                }
            }
            __syncthreads();
            const u16* aptr[2];
#pragma unroll
            for (int i = 0; i < 2; ++i) {
                int li = mt * 128 + (wid + 4 * i) * 16 + r_in;
                li = li < c ? li : c - 1;
                aptr[i] = WSP_HHs + ((size_t)rowbase + li) * 128 + c_in;
            }
            const u16* Bw = WSP_WdT + ((size_t)e * 1024 + nt * 256) * 128 + c_in;
            int slot[8];
            if (e < 64) {
#pragma unroll
                for (int i = 0; i < 8; ++i) {
                    int li = mt * 128 + wr * 64 + ((i * 64 + lane) >> 3);
                    li = li < c ? li : c - 1;
                    slot[i] = el[li];
                }
            } else {
#pragma unroll
                for (int i = 0; i < 8; ++i) slot[i] = (h * HALF_TOK + mt * 128 + wr * 64 + ((i * 64 + lane) >> 3)) * 8;
            }
            f32x4 acc[4][8];
            gemm_tile_w<true>(4,
                [&](int i, int R, int C, int kt) { return (const void*)(aptr[i] + kt * 32); },
                [&](int i, int R, int C, int kt) { return (const void*)(Bw + (size_t)R * 128 + kt * 32); }, acc);
            const int colo = nt * 256 + wc * 128;
            if (e < 64) {
                wave_store_fp8_f([&](int m, int n, int j) { return acc[m][n][j] * YD_SCALE; }, [&](int i, int row) {
                    if (row >= vrows) return (unsigned char*)nullptr;
                    const int s = slot[i];
                    return Yd8 + ((size_t)(s >> 3) * 8 + (s & 7)) * 1024 + colo;
                });
            } else {
                const int tok0 = h * HALF_TOK + mt * 128 + wr * 64;
                const float* g2 = WSP_mod + (tok0 >> 11) * 6144 + 5120 + colo;
                float* stg = (float*)(smem + wid * 8448);
#pragma unroll
                for (int m = 0; m < 4; ++m) {
#pragma unroll
                    for (int n = 0; n < 8; ++n)
#pragma unroll
                        for (int j = 0; j < 4; ++j) stg[(fq * 4 + j) * 132 + n * 16 + fr] = acc[m][n][j];
                    asm volatile("s_waitcnt lgkmcnt(0)" ::: "memory");
                    __builtin_amdgcn_wave_barrier();
#pragma unroll
                    for (int i = 0; i < 8; ++i) {
                        const int id = i * 64 + lane, rr = id >> 5, c4 = (id & 31) * 4;
                        const float4 v = *(const float4*)(stg + rr * 132 + c4);
                        const float4 g = *(const float4*)(g2 + c4);
                        float* op = p.out + (size_t)(tok0 + m * 16 + rr) * 1024 + colo + c4;
                        const float4 xv = *(const float4*)op;
                        *(float4*)op = make_float4(xv.x + g.x * v.x, xv.y + g.y * v.y, xv.z + g.z * v.z, xv.w + g.w * v.w);
                    }
                    asm volatile("s_waitcnt lgkmcnt(0)" ::: "memory");
                    __builtin_amdgcn_wave_barrier();
                }
            }
        }
    }
}

template <bool DUMMY>
__device__ __forceinline__ void phase12b_t(const Params& p) {
    const int lane = TIDX & 63;
    const int wv = blockIdx.x * 4 + (TIDX >> 6), nwv = gridDim.x * 4;
    const unsigned char* Yd8 = (const unsigned char*)(p.ws + OFF_ARENA);
    for (int tok = wv; tok < NLAT; tok += nwv) {
        float* row = p.out + (size_t)tok * 1024 + lane * 16;
        float* orow = DUMMY ? (float*)(p.ws + OFF_HHS) + (size_t)(tok & 8191) * 1024 + lane * 16 : row;
        const float* g2 = WSP_mod + (tok >> 11) * 6144 + 5120 + lane * 16;
        float s[16];
#pragma unroll
        for (int i = 0; i < 16; ++i) s[i] = 0.f;
        const unsigned char* yp = Yd8 + (size_t)tok * 8 * 1024 + lane * 16;
        uint4 yv[8];
#pragma unroll
        for (int k = 0; k < 8; ++k) yv[k] = *(const uint4*)(yp + k * 1024);
#pragma unroll
        for (int k = 0; k < 8; ++k) {
            const unsigned w[4] = {yv[k].x, yv[k].y, yv[k].z, yv[k].w};
#pragma unroll
            for (int i = 0; i < 4; ++i) {
                const auto lo = __builtin_amdgcn_cvt_pk_f32_fp8((int)w[i], false);
                const auto hi = __builtin_amdgcn_cvt_pk_f32_fp8((int)w[i], true);
                s[4 * i] += lo[0]; s[4 * i + 1] += lo[1]; s[4 * i + 2] += hi[0]; s[4 * i + 3] += hi[1];
            }
        }
        float ss = 0.f;
#pragma unroll
        for (int q = 0; q < 4; ++q) {
            const float4 xv = *(const float4*)(row + q * 4), gv = *(const float4*)(g2 + q * 4);
            s[4 * q] = xv.x + gv.x * (1.f / YD_SCALE) * s[4 * q]; s[4 * q + 1] = xv.y + gv.y * (1.f / YD_SCALE) * s[4 * q + 1];
            s[4 * q + 2] = xv.z + gv.z * (1.f / YD_SCALE) * s[4 * q + 2]; s[4 * q + 3] = xv.w + gv.w * (1.f / YD_SCALE) * s[4 * q + 3];
            ss += s[4 * q] * s[4 * q] + s[4 * q + 1] * s[4 * q + 1] + s[4 * q + 2] * s[4 * q + 2] + s[4 * q + 3] * s[4 * q + 3];
        }
        ss = wave_sum(ss);
        const float rs = rsqrtf(ss * (1.f / 1024.f) + EPS);
#pragma unroll
        for (int q = 0; q < 4; ++q) {
            const float4 g = *(const float4*)(p.norm_final + lane * 16 + q * 4);
            *(float4*)(orow + q * 4) = make_float4(s[4 * q] * rs * g.x, s[4 * q + 1] * rs * g.y, s[4 * q + 2] * rs * g.z, s[4 * q + 3] * rs * g.w);
        }
    }
}

#define SMEM_TOTAL (73728 + 1024 + 64)

#if 1
__global__ void __launch_bounds__(NTHR, 2) k_mega(Params p) {
    volatile LAS unsigned* st = (volatile LAS unsigned*)(smem + SMEM_TOTAL - 16);
    if (TIDX == 0) { st[0] = 0u; st[1] = 0u; st[2] = 0u; st[3] = 0u; }
    __syncthreads();
    XcdBarrier bar = xcd_barrier_post(WSP_bar, st);
#define RUNP(N) do { phase##N(p); if (PROBE_DUP == N) phase##N(p); } while (0)
    RUNP(0);  xcd_barrier(bar);
    RUNP(1);  xcd_barrier(bar);
    RUNP(2);  xcd_barrier(bar);
    RUNP(3);  xcd_barrier(bar);
    RUNP(4);  xcd_barrier(bar);
    RUNP(5);  xcd_barrier(bar);
    RUNP(6);  xcd_barrier(bar);
    RUNP(8);  xcd_barrier(bar);
    phase9(p); xcd_barrier(bar);
#if PROBE_DUP == 9
    if (blockIdx.x == 0 && TIDX < 128) WSP_ctr[CTR_ECNT + TIDX] = 0u;
    xcd_barrier(bar); phase9(p); xcd_barrier(bar);
#endif
#ifndef MOE_FUSED
#define MOE_FUSED 1
#endif
#if MOE_FUSED
    phase11f<0>(p); xcd_barrier(bar);
#else
    phase11f<1>(p); xcd_barrier(bar);
    phase11f<2>(p); xcd_barrier(bar);
#endif
#if PROBE_DUP == 11
    if (blockIdx.x == 0 && TIDX < 8) WSP_ctr[CTR_Q11 + TIDX] = 0u;
    if (blockIdx.x == 1) for (int i = TIDX; i < 8 * FLAG_PER_CLASS; i += NTHR) WSP_flag[i] = 0u;
    xcd_barrier(bar); phase11f<1>(p); xcd_barrier(bar);
#endif
#if PROBE_DUP == 121
    phase12b_t<true>(p); xcd_barrier(bar);
#endif
    phase12b_t<false>(p);
}
#endif


extern "C" void kernel_launch(void* const* d_in, const int* in_sizes, int n_in,
                              void* d_out, int out_size, void* d_ws, size_t ws_size,
                              hipStream_t stream) {
    Params p{};
    const float** ip = (const float**)&p.x;
    for (int i = 0; i < 32; ++i) ip[i] = (const float*)d_in[i];
    p.out = (float*)d_out;
    p.ws = (char*)d_ws;
    if (OFF_END > ws_size) { fprintf(stderr, "workspace too small: need %zu have %zu\n", (size_t)OFF_END, ws_size); return; }

    static int grid = 0;
    if (!grid) {
        hipFuncSetAttribute((const void*)k_mega, hipFuncAttributeMaxDynamicSharedMemorySize, SMEM_TOTAL);
        int dev = 0, cus = 0, per_cu = 0;
        hipGetDevice(&dev);
        hipDeviceGetAttribute(&cus, hipDeviceAttributeMultiprocessorCount, dev);
        hipOccupancyMaxActiveBlocksPerMultiprocessor(&per_cu, (const void*)k_mega, NTHR, SMEM_TOTAL);
        if (per_cu < 1) per_cu = 1;
        grid = cus * (per_cu < 2 ? per_cu : 2);
    }
    hipMemsetAsync(p.ws + OFF_BAR, 0, ZERO_BYTES, stream);
    k_mega<<<grid, NTHR, SMEM_TOTAL, stream>>>(p);
}
```

```cpp
#include <hip/hip_runtime.h>
#include <hip/hip_bf16.h>
#include <stdint.h>
#include <stdio.h>

#ifndef MK_MULTI
#define MK_MULTI 0
#endif

typedef __attribute__((ext_vector_type(8))) short bf16x8;
typedef __attribute__((ext_vector_type(4))) short bf16x4;
typedef __attribute__((ext_vector_type(4))) float f32x4;
typedef unsigned short u16;
typedef __attribute__((ext_vector_type(4))) unsigned u32x4;

#ifndef PROBE_DUP
#define PROBE_DUP -1
#endif
#define NTHR 256
__device__ __forceinline__ int opaque_tid() { int t = (int)threadIdx.x; asm volatile("" : "+v"(t)); return t; }
#define TIDX opaque_tid()
#define LDS_BYTES 65536

#define D_MODEL 1024
#define BATCH 8
#define SEQ 2048
#define CTXL 256
#define NLAT (BATCH * SEQ)
#define NCTX (BATCH * CTXL)
#define NROWS (NLAT + NCTX)
#define INW 1280
#define NEXP 64
#define VT_LD (SEQ + CTXL)
#define NCHUNK_LAT 1024
#define NCHUNK_ALL 1152
#define EPS 1e-6f

#define XB_TMO      128
#define XB_XCNT(j)  (256  + 64 * (j))
#define XB_XSUB(j)  (1280 + 64 * (j))
#define XB_XGEN(j)  (2304 + 64 * (j))
#define XB_TOP      3328
#define XB_TOPGEN   3392
#define XCD_BAR_WORDS 3456
#define XB_SPIN_CAP (1u << 20)
#define LAS __attribute__((address_space(3)))

__device__ __forceinline__ unsigned xb_ld(unsigned* p)              { return __hip_atomic_load(p, __ATOMIC_RELAXED, __HIP_MEMORY_SCOPE_AGENT); }
__device__ __forceinline__ unsigned xb_add(unsigned* p, unsigned v) { return __hip_atomic_fetch_add(p, v, __ATOMIC_RELAXED, __HIP_MEMORY_SCOPE_AGENT); }
__device__ __forceinline__ unsigned xb_xcc_id() { return (unsigned)__builtin_amdgcn_s_getreg((3 << 11) | 20) & 0xFu; }
#define XB_SPIN(cond, bar) do { unsigned _sp = 0; while (cond) { __builtin_amdgcn_s_sleep(1); \
    if ((++_sp & 255u) == 0u) { if (xb_ld(&(bar)[XB_TMO])) break; if (_sp > XB_SPIN_CAP) { atomicAdd(&(bar)[XB_TMO], 1u); break; } } } } while (0)

struct XcdBarrier { unsigned* bar; unsigned x; volatile LAS unsigned* st; };

__device__ __forceinline__ XcdBarrier xcd_barrier_post(unsigned* bar, volatile LAS unsigned* st) {
    XcdBarrier b; b.bar = bar; b.x = xb_xcc_id(); b.st = st;
    if (TIDX == 0) (void)xb_add(&bar[XB_XCNT(b.x)], 1u);
    return b;
}
__device__ __forceinline__ void xcd_barrier_complete(unsigned* bar, unsigned x, unsigned& nloc, unsigned& nx) {
    const unsigned G = gridDim.x * gridDim.y * gridDim.z;
    unsigned sum, cnt, mine, sp = 0u;
    for (;;) {
        sum = 0u; cnt = 0u; mine = 0u;
#pragma unroll
        for (unsigned j = 0; j < 16; ++j) { const unsigned c = xb_ld(&bar[XB_XCNT(j)]); sum += c; cnt += (c > 0u) ? 1u : 0u; mine = (j == x) ? c : mine; }
        if (sum == G) break;
        __builtin_amdgcn_s_sleep(1);
        if ((++sp & 255u) == 0u) { if (xb_ld(&bar[XB_TMO])) break; if (sp > XB_SPIN_CAP) { atomicAdd(&bar[XB_TMO], 1u); break; } }
    }
    nloc = mine > 0u ? mine : 1u; nx = cnt > 0u ? cnt : 1u;
}
__device__ __forceinline__ void xcd_barrier(const XcdBarrier& b) {
    asm volatile("s_waitcnt vmcnt(0)" ::: "memory");
    __syncthreads();
    if (TIDX == 0) {
        unsigned* bar = b.bar;
        __builtin_amdgcn_s_waitcnt(0);
        unsigned nloc = b.st[0], nx = b.st[1];
        if (nloc == 0u) { xcd_barrier_complete(bar, b.x, nloc, nx); b.st[0] = nloc; b.st[1] = nx; }
        const unsigned old = xb_add(&bar[XB_XSUB(b.x)], 1u);
        const unsigned gen = old / nloc;
        if (old + 1u == (gen + 1u) * nloc) {
            __builtin_amdgcn_fence(__ATOMIC_RELEASE, "agent");
            asm volatile("s_waitcnt vmcnt(0)" ::: "memory");
            const unsigned og = xb_add(&bar[XB_TOP], 1u);
            const unsigned tg = og / nx;
            if (og + 1u == (tg + 1u) * nx) xb_add(&bar[XB_TOPGEN], 1u);
            else XB_SPIN(xb_ld(&bar[XB_TOPGEN]) == tg, bar);
            __builtin_amdgcn_fence(__ATOMIC_ACQUIRE, "agent");
            xb_add(&bar[XB_XGEN(b.x)], 1u);
            asm volatile("s_waitcnt vmcnt(0)" ::: "memory");
        } else {
            XB_SPIN(xb_ld(&bar[XB_XGEN(b.x)]) == gen, bar);
            __builtin_amdgcn_fence(__ATOMIC_ACQUIRE, "agent");
            asm volatile("s_waitcnt vmcnt(0)" ::: "memory");
        }
    }
    __syncthreads();
}

struct Params {
    const float *x, *c, *ctx, *c_ctx, *w_ada, *b_ada, *norm_mix, *norm_ffn, *w_in, *attn_sink,
        *a_re, *a_im, *log_dt, *b_re, *b_im, *c_re, *c_im, *ssm_d, *w_glu, *b_glu, *norm_attn_out, *norm_ssm_out,
        *w_out, *w_router, *router_bias, *w_gate_e, *w_up_e, *w_down_e, *w_gate_s, *w_up_s, *w_down_s, *norm_final;
    float* out;
    char* ws;
};

constexpr size_t A256(size_t v) { return (v + 255) & ~(size_t)255; }
constexpr size_t OFF_BAR   = 0;
constexpr size_t OFF_RSQ   = A256(OFF_BAR + XCD_BAR_WORDS * 4 + 1024);
#define FLAG_PER_CLASS 1280
constexpr size_t OFF_FLAG  = OFF_RSQ + (size_t)NLAT * 2 * 4;
constexpr size_t ZERO_BYTES = OFF_FLAG + (8 * FLAG_PER_CLASS + 64) * 4;
constexpr size_t OFF_MOD   = A256(ZERO_BYTES);
constexpr size_t OFF_ROPE  = A256(OFF_MOD + 9 * 6144 * 4);
constexpr size_t OFF_KBUF  = A256(OFF_ROPE + 64 * 16 * 8);
constexpr size_t OFF_ELIST = A256(OFF_KBUF + (size_t)32 * 2 * 4096 * 4);
constexpr size_t OFF_WSL   = A256(OFF_ELIST + (size_t)2 * 64 * 8192 * 4);
constexpr size_t OFF_WDT   = A256(OFF_WSL + (size_t)2 * 64 * 8192 * 4);
constexpr size_t OFF_HHS   = A256(OFF_WDT + (size_t)65 * 1024 * 128 * 2);
constexpr size_t OFF_WGUT  = A256(OFF_HHS + (size_t)2 * 73728 * 128 * 2);
constexpr size_t OFF_H2R   = A256(OFF_WGUT + (size_t)65 * 256 * 1024 * 2);
constexpr size_t OFF_ARENA = A256(OFF_H2R + (size_t)NLAT * 1024 * 2);
constexpr size_t OFF_TABS  = OFF_ARENA;
constexpr size_t OFF_TABY  = A256(OFF_TABS + (size_t)32 * 256 * 256 * 2);
constexpr size_t OFF_R1    = A256(OFF_TABY + (size_t)32 * 256 * 512 * 2);
constexpr size_t OFF_R2    = A256(OFF_R1 + (size_t)NROWS * 1024 * 2);
constexpr size_t OFF_R4    = A256(OFF_R2 + (size_t)NLAT * 1024 * 2);
constexpr size_t OFF_WINT  = A256(OFF_R4 + (size_t)NLAT * 512 * 2 * 2);
constexpr size_t OFF_WGLUT = A256(OFF_WINT + (size_t)1280 * 1024 * 2);
constexpr size_t OFF_WOUTT = A256(OFF_WGLUT + (size_t)512 * 512 * 2);
constexpr size_t OFF_WRT   = A256(OFF_WOUTT + (size_t)1024 * 1024 * 2);
constexpr size_t OFF_EARLY_END = A256(OFF_WRT + (size_t)128 * 1024 * 2);
constexpr size_t YD8_BYTES = (size_t)NLAT * 8 * 1024;
constexpr size_t OFF_END   = (OFF_EARLY_END > OFF_ARENA + YD8_BYTES) ? OFF_EARLY_END : A256(OFF_ARENA + YD8_BYTES);
static_assert(OFF_END <= (size_t)256 * 1024 * 1024, "workspace map must fit the guaranteed 256 MiB");
#define WSP_bar   ((unsigned*)(p.ws + OFF_BAR))
#define WSP_ctr   ((unsigned*)(p.ws + OFF_BAR) + XCD_BAR_WORDS)
#define WSP_rsq   ((float*)(p.ws + OFF_RSQ))
#define WSP_flag  ((unsigned*)(p.ws + OFF_FLAG))
#define WSP_mod   ((float*)(p.ws + OFF_MOD))
#define WSP_rope  ((float2*)(p.ws + OFF_ROPE))
#define WSP_Kbuf  ((float*)(p.ws + OFF_KBUF))
#define WSP_elist ((int*)(p.ws + OFF_ELIST))
#define WSP_wsl   ((float*)(p.ws + OFF_WSL))
#define WSP_WinT  ((u16*)(p.ws + OFF_WINT))
#define WSP_WgluT ((u16*)(p.ws + OFF_WGLUT))
#define WSP_WoutT ((u16*)(p.ws + OFF_WOUTT))
#define WSP_WrT   ((u16*)(p.ws + OFF_WRT))
#define WSP_WdT   ((u16*)(p.ws + OFF_WDT))
#define WSP_HHs   ((u16*)(p.ws + OFF_HHS))
#define WSP_WguT  ((u16*)(p.ws + OFF_WGUT))
#define WSP_TabS  ((u16*)(p.ws + OFF_TABS))
#define WSP_TabY  ((u16*)(p.ws + OFF_TABY))
#define WSP_Hb    ((u16*)(p.ws + OFF_R1))
#define WSP_S     ((float*)(p.ws + OFF_R1))
#define WSP_H2    ((u16*)(p.ws + OFF_H2R))
#define WSP_Q     ((u16*)(p.ws + OFF_R2))
#define WSP_Kb    ((u16*)(p.ws + OFF_R2 + (size_t)NLAT * 512 * 2))
#define WSP_Vt    ((u16*)(p.ws + OFF_R2 + (size_t)NLAT * 512 * 2 + (size_t)NROWS * 128 * 2))
#define WSP_Y     ((u16*)(p.ws + OFF_R2))
#define WSP_SO    ((u16*)(p.ws + OFF_R2 + (size_t)NLAT * 512 * 2))
#define WSP_U     ((u16*)(p.ws + OFF_H2R))
#define WSP_AO    ((u16*)(p.ws + OFF_R4))
#define WSP_Hin   ((u16*)(p.ws + OFF_R4 + (size_t)NLAT * 512 * 2))

extern __shared__ __attribute__((aligned(16))) char smem[];

typedef __bf16 bf2_t __attribute__((ext_vector_type(2)));
typedef float f2_t __attribute__((ext_vector_type(2)));
__device__ __forceinline__ unsigned pack2(float a, float b) {
    const f2_t v = {a, b};
    return __builtin_bit_cast(unsigned, __builtin_convertvector(v, bf2_t));
}
__device__ __forceinline__ u16 f2bf(float f) { return (u16)(pack2(f, 0.f) & 0xffffu); }
__device__ __forceinline__ float bf2f(u16 h) { return __uint_as_float(((unsigned)h) << 16); }
__device__ __forceinline__ void glds16(const void* g, void* l) {
    __builtin_amdgcn_global_load_lds((const unsigned*)g, (unsigned*)l, 16, 0, 0);
}
__device__ __forceinline__ void glds16_sc1(const void* g, void* l) {
    __builtin_amdgcn_global_load_lds((const unsigned*)g, (unsigned*)l, 16, 0, 16);
}
__device__ __forceinline__ int lds_byte(int r, int c) {
    int st = (r >> 4) * 2 + (c >> 5), rr = r & 15, cc = c & 31, ob = rr * 64 + cc * 2;
    return st * 1024 + (ob ^ (((ob >> 9) & 1) << 5));
}
__device__ __forceinline__ float wave_sum(float v) {
#pragma unroll
    for (int o = 32; o > 0; o >>= 1) v += __shfl_xor(v, o);
    return v;
}
__device__ __forceinline__ float sigmoidf_(float x) { return __builtin_amdgcn_rcpf(1.f + __expf(-x)); }
__device__ __forceinline__ float siluf_(float x) { return x * __builtin_amdgcn_rcpf(1.f + __expf(-x)); }
__device__ __forceinline__ float gelu_tanh(float x) {
    float u = 0.7978845608028654f * (x + 0.044715f * x * x * x);
    return x * __builtin_amdgcn_rcpf(1.f + __expf(-2.f * u));
}

template <class FA, class FB>
__device__ __forceinline__ void gemm_tile(int nkt, FA fa, FB fb, f32x4 (&acc)[4][4]) {
    const int tid = TIDX, lane = tid & 63, wid = tid >> 6, wr = wid >> 1, wc = wid & 1, fr = lane & 15, fq = lane >> 4;
    const int sb = lane * 16, swz = sb ^ (((sb >> 9) & 1) << 5);
    const int r_in = swz >> 6, c_in = (swz & 63) >> 1;
#pragma unroll
    for (int m = 0; m < 4; ++m)
#pragma unroll
        for (int n = 0; n < 4; ++n) acc[m][n] = (f32x4){0.f, 0.f, 0.f, 0.f};
    __syncthreads();
    auto stage = [&](int kt, int s) {
        char* sa = smem + s * 32768;
        char* sbm = sa + 16384;
#pragma unroll
        for (int i = 0; i < 4; ++i) {
            const int st = wid + 4 * i, R = (st >> 1) * 16 + r_in, C = (st & 1) * 32 + c_in;
            glds16(fa(R, C, kt), sa + tid * 16 + i * 4096);
            glds16(fb(R, C, kt), sbm + tid * 16 + i * 4096);
        }
    };
    stage(0, 0);
    for (int kt = 0; kt < nkt; ++kt) {
        asm volatile("s_waitcnt vmcnt(0)" ::: "memory");
        __syncthreads();
        if (kt + 1 < nkt) stage(kt + 1, (kt + 1) & 1);
        const char* sa = smem + (kt & 1) * 32768;
        const char* sbm = sa + 16384;
#pragma unroll
        for (int ks = 0; ks < 2; ++ks) {
            bf16x8 a[4], b[4];
#pragma unroll
            for (int m = 0; m < 4; ++m) a[m] = *(const bf16x8*)(sa + lds_byte(wr * 64 + m * 16 + fr, ks * 32 + fq * 8));
#pragma unroll
            for (int n = 0; n < 4; ++n) b[n] = *(const bf16x8*)(sbm + lds_byte(wc * 64 + n * 16 + fr, ks * 32 + fq * 8));
#pragma unroll
            for (int m = 0; m < 4; ++m)
#pragma unroll
                for (int n = 0; n < 4; ++n) acc[m][n] = __builtin_amdgcn_mfma_f32_16x16x32_bf16(a[m], b[n], acc[m][n], 0, 0, 0);
        }
    }
    __syncthreads();
}

__device__ __forceinline__ int lds32(int r, int c) {
    const int rr = r & 15;
    return (r >> 4) * 1024 + ((rr * 64 + c * 2) ^ (((rr >> 3) & 1) << 5));
}
struct NoHook { __device__ __forceinline__ void operator()(int) const {} };
template <bool A_SC1 = false, class FA, class FB, class HK = NoHook>
__device__ __forceinline__ void gemm_tile_w(int nkt, FA fa, FB fb, f32x4 (&acc)[4][8], HK hook = HK()) {
    constexpr bool ZERO = true;
    const int tid = TIDX, lane = tid & 63, wid = tid >> 6, wr = wid >> 1, wc = wid & 1, fr = lane & 15, fq = lane >> 4;
    const int sb = lane * 16, swz = sb ^ (((sb >> 9) & 1) << 5);
    const int r_in = swz >> 6, c_in = (swz & 63) >> 1;
    if (ZERO) {
#pragma unroll
        for (int m = 0; m < 4; ++m)
#pragma unroll
            for (int n = 0; n < 8; ++n) acc[m][n] = (f32x4){0.f, 0.f, 0.f, 0.f};
    }
    __syncthreads();
    auto stage = [&](int kt, int s) {
        char* sa = smem + s * 24576;
#pragma unroll
        for (int i = 0; i < 2; ++i) { if (A_SC1) glds16_sc1(fa(i, (wid + 4 * i) * 16 + r_in, c_in, kt), sa + tid * 16 + i * 4096); else glds16(fa(i, (wid + 4 * i) * 16 + r_in, c_in, kt), sa + tid * 16 + i * 4096); }
#pragma unroll
        for (int i = 0; i < 4; ++i) glds16(fb(i, (wid + 4 * i) * 16 + r_in, c_in, kt), sa + 8192 + tid * 16 + i * 4096);
    };
    stage(0, 0);
    if (nkt > 1) stage(1, 1);
    int s_cur = 0, s_nxt = 2;
    for (int kt = 0; kt < nkt; ++kt) {
        hook(kt);
        if (kt + 1 < nkt) asm volatile("s_waitcnt vmcnt(6) lgkmcnt(0)\n\ts_barrier" ::: "memory");
        else asm volatile("s_waitcnt vmcnt(0) lgkmcnt(0)\n\ts_barrier" ::: "memory");
        if (kt + 2 < nkt) stage(kt + 2, s_nxt);
        const char* sa = smem + s_cur * 24576;
        bf16x8 a[4];
#pragma unroll
        for (int m = 0; m < 4; ++m) a[m] = *(const bf16x8*)(sa + lds32(wr * 64 + m * 16 + fr, fq * 8));
#pragma unroll
        for (int nh = 0; nh < 2; ++nh) {
            bf16x8 b[4];
#pragma unroll
            for (int n = 0; n < 4; ++n) b[n] = *(const bf16x8*)(sa + 8192 + lds32(wc * 128 + (nh * 4 + n) * 16 + fr, fq * 8));
#pragma unroll
            for (int m = 0; m < 4; ++m)
#pragma unroll
                for (int n = 0; n < 4; ++n) acc[m][nh * 4 + n] = __builtin_amdgcn_mfma_f32_16x16x32_bf16(a[m], b[n], acc[m][nh * 4 + n], 0, 0, 0);
        }
        s_cur = (s_cur == 2) ? 0 : s_cur + 1;
        s_nxt = (s_nxt == 2) ? 0 : s_nxt + 1;
    }
    __syncthreads();
}

template <class FV, class FD>
__device__ __forceinline__ void wave_store_bf16_f(FV val, FD dst, bool write_through = false, const char* wt_base = nullptr, unsigned wt_bytes = 0) {
    const __amdgpu_buffer_rsrc_t wt_rsrc = __builtin_amdgcn_make_buffer_rsrc((void*)wt_base, 0, (int)wt_bytes, 0x00020000);
    const int lane = TIDX & 63, wid = TIDX >> 6, fr = lane & 15, fq = lane >> 4;
    char* base = smem + wid * 9216;
#pragma unroll
    for (int m = 0; m < 4; ++m)
#pragma unroll
        for (int n = 0; n < 4; ++n)
#pragma unroll
            for (int j = 0; j < 4; ++j)
                *(u16*)(base + (m * 16 + fq * 4 + j) * 144 + (n * 16 + fr) * 2) = f2bf(val(m, n, j));
    asm volatile("s_waitcnt lgkmcnt(0)" ::: "memory");
    __builtin_amdgcn_wave_barrier();
#pragma unroll
    for (int i = 0; i < 8; ++i) {
        const int id = i * 64 + lane, row = id >> 3, ch = id & 7;
        const uint4 d = *(const uint4*)(base + row * 144 + ch * 16);
        u16* p = dst(row);
        if (p) {
            if (write_through) {
                const u32x4 dv = {d.x, d.y, d.z, d.w};
                __builtin_amdgcn_raw_buffer_store_b128(dv, wt_rsrc, (int)((const char*)(p + ch * 8) - wt_base), 0, 16);
            } else *(uint4*)(p + ch * 8) = d;
        }
    }
    asm volatile("s_waitcnt lgkmcnt(0)" ::: "memory");
    __builtin_amdgcn_wave_barrier();
}

template <class FD>
__device__ __forceinline__ void wave_store_bf16(const float (&v)[4][4][4], FD dst) {
    wave_store_bf16_f([&](int m, int n, int j) { return v[m][n][j]; }, dst);
}

struct ConvD { const float* src; u16* dst; int ld, ldd, k0, n0, mode, zr; };
__device__ __forceinline__ void conv_load(const Params& p, const ConvD& d, float (&v)[16]) {
    const int tid = TIDX;
#pragma unroll
    for (int i = 0; i < 16; ++i) v[i] = d.src[(size_t)(d.k0 + i * 4 + (tid >> 6)) * d.ld + d.n0 + (tid & 63)];
    if (d.zr == 2) {
#pragma unroll
        for (int i = 0; i < 16; ++i) {
            const int k = d.k0 + i * 4 + (tid >> 6);
            v[i] *= (k < 512) ? p.norm_attn_out[k] : p.norm_ssm_out[k - 512];
        }
    }
}
__device__ __forceinline__ void conv_store(const Params& p, const ConvD& d, const float (&v)[16]) {
    float* t = (float*)smem;
    const int tid = TIDX;
    __syncthreads();
#pragma unroll
    for (int i = 0; i < 16; ++i) t[(i * 4 + (tid >> 6)) * 65 + (tid & 63)] = v[i];
    __syncthreads();
    const int n = tid >> 2, kq = tid & 3;
    unsigned w[8];
#pragma unroll
    for (int i = 0; i < 8; ++i) w[i] = pack2(t[(kq * 16 + 2 * i) * 65 + n], t[(kq * 16 + 2 * i + 1) * 65 + n]);
    const int gn = d.n0 + n;
    int row = gn;
    if (d.mode == 1) row = (gn >> 4) * 32 + (gn & 15);
    else if (d.mode == 2) row = (gn >> 4) * 32 + 16 + (gn & 15);
    else if (d.mode == 3) row = n;
    uint4* o = (uint4*)(d.dst + (size_t)row * d.ldd + d.k0 + kq * 16);
    o[0] = make_uint4(w[0], w[1], w[2], w[3]);
    o[1] = make_uint4(w[4], w[5], w[6], w[7]);
    if (d.zr == 1) {
        uint4* z = (uint4*)(WSP_WrT + (size_t)(64 + n) * 1024 + d.k0 + kq * 16);
        z[0] = make_uint4(0, 0, 0, 0); z[1] = make_uint4(0, 0, 0, 0);
    }
}

__device__ __forceinline__ void ada_item(const Params& p, int item) {
    float* sc = (float*)smem;
    float* red = sc + 9 * 1024;
    const int tid = TIDX;
    __syncthreads();
    for (int i = tid; i < 9 * 1024; i += NTHR) {
        const int r = i >> 10, k = i & 1023;
        const float cv = (r < 8) ? p.c[r * 1024 + k] : p.c_ctx[k];
        sc[i] = siluf_(cv);
    }
    __syncthreads();
    const int kq = tid >> 6, jl = tid & 63, j = item * 64 + jl;
    float acc[9];
#pragma unroll
    for (int r = 0; r < 9; ++r) acc[r] = 0.f;
#pragma unroll 16
    for (int k = kq; k < 1024; k += 4) {
        const float w = p.w_ada[(size_t)k * 6144 + j];
#pragma unroll
        for (int r = 0; r < 9; ++r) acc[r] += sc[r * 1024 + k] * w;
    }
#pragma unroll
    for (int r = 0; r < 9; ++r) red[(kq * 9 + r) * 64 + jl] = acc[r];
    __syncthreads();
    for (int i = tid; i < 9 * 64; i += NTHR) {
        const int r = i >> 6, l = i & 63;
        const float s = red[(0 * 9 + r) * 64 + l] + red[(1 * 9 + r) * 64 + l] + red[(2 * 9 + r) * 64 + l] + red[(3 * 9 + r) * 64 + l];
        WSP_mod[r * 6144 + item * 64 + l] = s + p.b_ada[item * 64 + l];
    }
}

__device__ __forceinline__ void rope_item(const Params& p) {
    for (int i = TIDX; i < 64 * 16; i += NTHR) {
        const int pos = i >> 4, k = i & 15;
        const float inv = exp2f(-(float)k * (13.287712379549449f / 16.f));
        float s, c;
        sincosf((float)pos * inv, &s, &c);
        WSP_rope[i] = make_float2(c, s);
    }
}

__device__ __forceinline__ void ssm_table_item(const Params& p, int g, int dir) {
    float* pw = (float*)smem;
    float* Bb = pw + 17 * 64 * 2;
    float* Cc = Bb + 64 * 16 * 2;
    const int tid = TIDX;
    u16* tabS = WSP_TabS + (size_t)g * 256 * 256;
    u16* tabY = WSP_TabY + (size_t)g * 256 * 512;
    float* Kf = WSP_Kbuf + (size_t)(g * 2 + dir) * 4096;
    __syncthreads();
    {
        const int pidx = dir * 32 + g;
        const float dt = __expf(p.log_dt[pidx]);
        for (int i = tid; i < 17 * 64; i += NTHR) {
            const int tau = i >> 6, n = i & 63;
            const float are = p.a_re[pidx * 64 + n], aim = p.a_im[pidx * 64 + n];
            const float mag = __expf((float)tau * dt * are);
            float rev = (float)tau * (dt * aim * 0.15915494309189535f);
            rev -= rintf(rev);
            pw[i * 2] = mag * __builtin_amdgcn_cosf(rev);
            pw[i * 2 + 1] = mag * __builtin_amdgcn_sinf(rev);
        }
        __syncthreads();
        for (int i = tid; i < 64 * 16; i += NTHR) {
            const int n = i >> 4;
            const float are = p.a_re[pidx * 64 + n], aim = p.a_im[pidx * 64 + n];
            const float abr = pw[(64 + n) * 2], abi = pw[(64 + n) * 2 + 1];
            const float den = are * are + aim * aim, nre = abr - 1.f;
            const float cre = (nre * are + abi * aim) / den, cim = (abi * are - nre * aim) / den;
            const float br = p.b_re[(size_t)pidx * 1024 + i], bi = p.b_im[(size_t)pidx * 1024 + i];
            Bb[i * 2] = cre * br - cim * bi;
            Bb[i * 2 + 1] = cre * bi + cim * br;
            Cc[i * 2] = p.c_re[(size_t)pidx * 1024 + i];
            Cc[i * 2 + 1] = p.c_im[(size_t)pidx * 1024 + i];
        }
        __syncthreads();
        {
            const int tau = tid >> 4, pp = tid & 15;
            float s[16];
#pragma unroll
            for (int q = 0; q < 16; ++q) s[q] = 0.f;
            for (int n = 0; n < 64; ++n) {
                const float2 cv = *(const float2*)&Cc[(pp * 64 + n) * 2];
                const float2 wv = *(const float2*)&pw[(tau * 64 + n) * 2];
                const float zr = cv.x * wv.x - cv.y * wv.y, zi = cv.x * wv.y + cv.y * wv.x;
#pragma unroll
                for (int q = 0; q < 16; ++q) {
                    const float2 bv = *(const float2*)&Bb[(n * 16 + q) * 2];
                    s[q] += zr * bv.x - zi * bv.y;
                }
            }
#pragma unroll
            for (int q = 0; q < 4; ++q)
                *(float4*)(Kf + tau * 256 + pp * 16 + q * 4) = make_float4(s[4 * q], s[4 * q + 1], s[4 * q + 2], s[4 * q + 3]);
        }
        for (int id = tid; id < 128 * 32; id += NTHR) {
            const int rr = id >> 5, ch = id & 31, cpart = rr >> 6, n = rr & 63, s_ = ch >> 1, q0 = (ch & 1) * 8;
            const int e = dir == 0 ? 15 - s_ : s_;
            const float wr_ = pw[(e * 64 + n) * 2], wi_ = pw[(e * 64 + n) * 2 + 1];
            unsigned w[4];
#pragma unroll
            for (int i = 0; i < 4; ++i) {
                float v[2];
#pragma unroll
                for (int h = 0; h < 2; ++h) {
                    const float br = Bb[(n * 16 + q0 + 2 * i + h) * 2], bi = Bb[(n * 16 + q0 + 2 * i + h) * 2 + 1];
                    v[h] = cpart == 0 ? (wr_ * br - wi_ * bi) : (wr_ * bi + wi_ * br);
                }
                w[i] = pack2(v[0], v[1]);
            }
            *(uint4*)(tabS + (size_t)(dir * 128 + rr) * 256 + s_ * 16 + q0) = make_uint4(w[0], w[1], w[2], w[3]);
        }
        for (int id = tid; id < 256 * 16; id += NTHR) {
            const int m = id >> 4, ch = id & 15, t = m >> 4, pp = m & 15, cpart = ch >> 3, n0 = (ch & 7) * 8;
            const int e = dir == 0 ? t + 1 : 16 - t;
            unsigned w[4];
#pragma unroll
            for (int i = 0; i < 4; ++i) {
                float v[2];
#pragma unroll
                for (int h = 0; h < 2; ++h) {
                    const int n = n0 + 2 * i + h;
                    const float cr = Cc[(pp * 64 + n) * 2], ci = Cc[(pp * 64 + n) * 2 + 1];
                    const float wr_ = pw[(e * 64 + n) * 2], wi_ = pw[(e * 64 + n) * 2 + 1];
                    v[h] = cpart == 0 ? (cr * wr_ - ci * wi_) : -(cr * wi_ + ci * wr_);
                }
                w[i] = pack2(v[0], v[1]);
            }
            *(uint4*)(tabY + (size_t)m * 512 + 256 + dir * 128 + cpart * 64 + n0) = make_uint4(w[0], w[1], w[2], w[3]);
        }
    }
}

__device__ __forceinline__ void ssm_toeplitz_item(const Params& p, int g) {
    float* Kf = (float*)smem;
    const int tid = TIDX;
    u16* tabY = WSP_TabY + (size_t)g * 256 * 512;
    __syncthreads();
    for (int i = tid; i < 2048; i += NTHR) ((float4*)Kf)[i] = ((const float4*)(WSP_Kbuf + (size_t)g * 8192))[i];
    __syncthreads();
    for (int id = tid; id < 256 * 32; id += NTHR) {
        const int m = id >> 5, ch = id & 31, t = m >> 4, pp = m & 15, s_ = ch >> 1, q0 = (ch & 1) * 8;
        unsigned w[4];
#pragma unroll
        for (int i = 0; i < 4; ++i) {
            float v[2];
#pragma unroll
            for (int h = 0; h < 2; ++h) {
                const int q = q0 + 2 * i + h;
                float val;
                if (s_ < t) val = Kf[((t - s_) * 16 + pp) * 16 + q];
                else if (s_ > t) val = Kf[4096 + ((s_ - t) * 16 + pp) * 16 + q];
                else val = Kf[(pp) * 16 + q] + Kf[4096 + pp * 16 + q] + (pp == q ? p.ssm_d[g * 16 + pp] : 0.f);
                v[h] = val;
            }
            w[i] = pack2(v[0], v[1]);
        }
        *(uint4*)(tabY + (size_t)m * 512 + s_ * 16 + q0) = make_uint4(w[0], w[1], w[2], w[3]);
    }
    __syncthreads();
}

#define N_CONV 6896
__device__ __forceinline__ ConvD conv_decode(const Params& p, int t) {
    ConvD d; d.mode = 0; d.zr = 0;
    if (t < 320) { d.src = p.w_in; d.ld = 1280; d.k0 = (t / 20) * 64; d.n0 = (t % 20) * 64; d.dst = WSP_WinT; d.ldd = 1024; return d; }
    t -= 320;
    if (t < 64) { d.src = p.w_glu; d.ld = 512; d.k0 = (t / 8) * 64; d.n0 = (t % 8) * 64; d.dst = WSP_WgluT; d.ldd = 512; return d; }
    t -= 64;
    if (t < 256) { d.src = p.w_out; d.ld = 1024; d.k0 = (t / 16) * 64; d.n0 = (t % 16) * 64; d.dst = WSP_WoutT; d.ldd = 1024; d.zr = 2; return d; }
    t -= 256;
    if (t < 16) { d.src = p.w_router; d.ld = 64; d.k0 = t * 64; d.n0 = 0; d.dst = WSP_WrT; d.ldd = 1024; d.zr = 1; return d; }
    t -= 16;
    if (t < 4096) {
        const int up = t >= 2048; const int tt = t & 2047, e = tt >> 5, r = tt & 31;
        d.src = (up ? p.w_up_e : p.w_gate_e) + (size_t)e * 131072; d.ld = 128; d.k0 = (r >> 1) * 64; d.n0 = (r & 1) * 64;
        d.dst = WSP_WguT + (size_t)e * 262144; d.ldd = 1024; d.mode = 1 + up; return d;
    }
    t -= 4096;
    if (t < 64) {
        const int up = t >= 32; const int r = t & 31;
        d.src = up ? p.w_up_s : p.w_gate_s; d.ld = 128; d.k0 = (r >> 1) * 64; d.n0 = (r & 1) * 64;
        d.dst = WSP_WguT + (size_t)64 * 262144; d.ldd = 1024; d.mode = 1 + up; return d;
    }
    t -= 64;
    if (t < 2048) { const int e = t >> 5, r = t & 31; d.src = p.w_down_e + (size_t)e * 131072; d.ld = 1024; d.k0 = (r >> 4) * 64; d.n0 = (r & 15) * 64; d.dst = WSP_WdT + (size_t)e * 131072; d.ldd = 128; return d; }
    t -= 2048;
    d.src = p.w_down_s; d.ld = 1024; d.k0 = (t >> 4) * 64; d.n0 = (t & 15) * 64; d.dst = WSP_WdT + (size_t)64 * 131072; d.ldd = 128; return d;
}

#define N_CONV_EARLY 4000
__device__ __forceinline__ void conv_range(const Params& p, int t0, int stride, int tend, int tbeg = 0) {
    int t = tbeg + t0;
    if (t < tend) {
        ConvD d = conv_decode(p, t);
        float v[16];
        conv_load(p, d, v);
        while (t < tend) {
            const int tn = t + stride;
            ConvD dn = d;
            float vn[16];
            if (tn < tend) { dn = conv_decode(p, tn); conv_load(p, dn, vn); }
            conv_store(p, d, v);
            d = dn;
#pragma unroll
            for (int i = 0; i < 16; ++i) v[i] = vn[i];
            t = tn;
        }
    }
}
#define P0_CONV_B0 161
__device__ __forceinline__ void phase0(const Params& p) {
    const int b = blockIdx.x, G = gridDim.x;
    if (G > P0_CONV_B0 + 32) {
        if (b < 64) ssm_table_item(p, b >> 1, b & 1);
        else if (b < 160) ada_item(p, b - 64);
        else if (b == 160) rope_item(p);
        else conv_range(p, b - P0_CONV_B0, G - P0_CONV_B0, N_CONV_EARLY);
    } else {
        const int NU = 64 + 96 + 1 + N_CONV_EARLY;
        for (int u = b; u < NU; u += G) {
            if (u < 64) ssm_table_item(p, u >> 1, u & 1);
            else if (u < 160) ada_item(p, u - 64);
            else if (u == 160) rope_item(p);
            else { ConvD d = conv_decode(p, u - 161); float v[16]; conv_load(p, d, v); conv_store(p, d, v); }
        }
    }
}
#if 0
    {
        {
            const int stride = G - P0_CONV_B0;
            int t = b - P0_CONV_B0;
            if (t < N_CONV) {
                ConvD d = conv_decode(p, t);
                float v[16];
                conv_load(p, d, v);
                while (t < N_CONV) {
                    const int tn = t + stride;
                    ConvD dn = d;
                    float vn[16];
                    if (tn < N_CONV) { dn = conv_decode(p, tn); conv_load(p, dn, vn); }
                    conv_store(p, d, v);
                    d = dn;
#pragma unroll
                    for (int i = 0; i < 16; ++i) v[i] = vn[i];
                    t = tn;
                }
            }
        }
    } else {
        const int NU = 64 + 96 + 1 + N_CONV;
        for (int u = b; u < NU; u += G) {
            if (u < 64) ssm_table_item(p, u >> 1, u & 1);
            else if (u < 160) ada_item(p, u - 64);
            else if (u == 160) rope_item(p);
            else { ConvD d = conv_decode(p, u - 161); float v[16]; conv_load(p, d, v); conv_store(p, d, v); }
        }
    }
}

#endif

__device__ __forceinline__ void norm_mod_row(const float* src, const float* gain, const float* sh, const float* scl, u16* dst) {
    const int lane = TIDX & 63;
    float4 v[4];
    float ss = 0.f;
#pragma unroll
    for (int i = 0; i < 4; ++i) {
        v[i] = *(const float4*)(src + i * 256 + lane * 4);
        ss += v[i].x * v[i].x + v[i].y * v[i].y + v[i].z * v[i].z + v[i].w * v[i].w;
    }
    ss = wave_sum(ss);
    const float rs = rsqrtf(ss * (1.f / 1024.f) + EPS);
#pragma unroll
    for (int i = 0; i < 4; ++i) {
        const int c0 = i * 256 + lane * 4;
        const float4 g = *(const float4*)(gain + c0), s = *(const float4*)(sh + c0), k = *(const float4*)(scl + c0);
        const float a = v[i].x * rs * g.x * (1.f + k.x) + s.x, b = v[i].y * rs * g.y * (1.f + k.y) + s.y;
        const float c = v[i].z * rs * g.z * (1.f + k.z) + s.z, d = v[i].w * rs * g.w * (1.f + k.w) + s.w;
        *(uint2*)(dst + c0) = make_uint2(pack2(a, b), pack2(c, d));
    }
}

__device__ __forceinline__ void phase1(const Params& p) {
    const int wv = blockIdx.x * 4 + (TIDX >> 6), nwv = gridDim.x * 4;
    const int lane = TIDX & 63;
    for (int r0 = wv * 4; r0 < NROWS; r0 += nwv * 4) {
        const float* src[4]; const float* md[4];
        float4 v[4][4];
#pragma unroll
        for (int q = 0; q < 4; ++q) {
            const int r = r0 + q;
            if (r < NLAT) { src[q] = p.x + (size_t)r * 1024; md[q] = WSP_mod + (r >> 11) * 6144; }
            else { src[q] = p.ctx + (size_t)(r - NLAT) * 1024; md[q] = WSP_mod + 8 * 6144; }
#pragma unroll
            for (int i = 0; i < 4; ++i) v[q][i] = *(const float4*)(src[q] + i * 256 + lane * 4);
        }
#pragma unroll
        for (int q = 0; q < 4; ++q) {
            float ss = 0.f;
#pragma unroll
            for (int i = 0; i < 4; ++i) ss += v[q][i].x * v[q][i].x + v[q][i].y * v[q][i].y + v[q][i].z * v[q][i].z + v[q][i].w * v[q][i].w;
            ss = wave_sum(ss);
            const float rs = rsqrtf(ss * (1.f / 1024.f) + EPS);
            u16* dst = WSP_Hb + (size_t)(r0 + q) * 1024;
#pragma unroll
            for (int i = 0; i < 4; ++i) {
                const int c0 = i * 256 + lane * 4;
                const float4 g = *(const float4*)(p.norm_mix + c0), s = *(const float4*)(md[q] + c0), k = *(const float4*)(md[q] + 1024 + c0);
                const float a = v[q][i].x * rs * g.x * (1.f + k.x) + s.x, b = v[q][i].y * rs * g.y * (1.f + k.y) + s.y;
                const float c = v[q][i].z * rs * g.z * (1.f + k.z) + s.z, d = v[q][i].w * rs * g.w * (1.f + k.w) + s.w;
                *(uint2*)(dst + c0) = make_uint2(pack2(a, b), pack2(c, d));
            }
        }
    }
}

__device__ __forceinline__ void phase2(const Params& p) {
    const int NU = 128 * 10 + 16 * 6;
    const int lane = TIDX & 63, wid = TIDX >> 6, wr = wid >> 1, wc = wid & 1, fr = lane & 15, fq = lane >> 4;
    for (int u = blockIdx.x; u < NU; u += gridDim.x) {
        int mt, nt;
        {
            const int xc = u & 7, r = u >> 3;
            if (r < 160) { mt = xc + 8 * (r / 10); nt = r % 10; } else { const int v = r - 160; mt = 128 + xc + 8 * (v / 6); nt = 4 + v % 6; }
        }
        const u16* A = WSP_Hb + (size_t)mt * 128 * 1024;
        const u16* B = WSP_WinT + (size_t)nt * 128 * 1024;
        f32x4 acc[4][4];
        gemm_tile(16,
            [&](int R, int C, int kt) { return (const void*)(A + (size_t)R * 1024 + kt * 64 + C); },
            [&](int R, int C, int kt) { return (const void*)(B + (size_t)R * 1024 + kt * 64 + C); }, acc);
        const int row0 = mt * 128 + wr * 64;
        const int col0 = nt * 128 + wc * 64;
        const bool is_lat = mt < 128;
        if (nt == 5) {
            const int kvh = wc;
#pragma unroll
            for (int m = 0; m < 4; ++m) {
                const int r = row0 + m * 16 + fq * 4;
                int b, pos;
                if (is_lat) { b = r >> 11; pos = r & 2047; } else { const int rc = r - NLAT; b = rc >> 8; pos = SEQ + (rc & 255); }
#pragma unroll
                for (int n = 0; n < 4; ++n) {
                    const int d = n * 16 + fr;
                    u16* dst = WSP_Vt + ((size_t)(b * 2 + kvh) * 64 + d) * VT_LD + pos;
                    *(uint2*)dst = make_uint2(pack2(acc[m][n][0], acc[m][n][1]), pack2(acc[m][n][2], acc[m][n][3]));
                }
            }
        } else {
            float v[4][4][4];
            const bool do_rope = is_lat && nt <= 4;
#pragma unroll
            for (int m = 0; m < 4; ++m)
#pragma unroll
                for (int j = 0; j < 4; ++j) {
                    if (do_rope) {
                        const int r = row0 + m * 16 + fq * 4 + j, pos = r & 2047;
                        const float2 cr = WSP_rope[(pos >> 6) * 16 + fr], cc = WSP_rope[(pos & 63) * 16 + fr];
                        const float x1 = acc[m][0][j], x2 = acc[m][1][j], y1 = acc[m][2][j], y2 = acc[m][3][j];
                        v[m][0][j] = x1 * cr.x - x2 * cr.y; v[m][1][j] = x1 * cr.y + x2 * cr.x;
                        v[m][2][j] = y1 * cc.x - y2 * cc.y; v[m][3][j] = y1 * cc.y + y2 * cc.x;
                    } else {
#pragma unroll
                        for (int n = 0; n < 4; ++n) v[m][n][j] = acc[m][n][j];
                    }
                }
            u16* dbase; int ldd;
            if (nt < 4) { dbase = WSP_Q + (size_t)row0 * 512 + col0; ldd = 512; }
            else if (nt == 4) { dbase = WSP_Kb + (size_t)row0 * 128 + (col0 - 512); ldd = 128; }
            else { dbase = WSP_U + (size_t)row0 * 512 + (col0 - 768); ldd = 512; }
            wave_store_bf16(v, [&](int row) { return dbase + (size_t)row * ldd; });
        }
    }
}

__device__ __forceinline__ void attn_unit(const Params& p, int u) {
    const int h = u & 7, qb = (u >> 3) & 15, b = u >> 7, kvh = h >> 2;
    const int tid = TIDX, lane = tid & 63, wid = tid >> 6, fr = lane & 15, fq = lane >> 4;
    const int sb = lane * 16, swz = sb ^ (((sb >> 9) & 1) << 5);
    const int r_in = swz >> 6, c_in = (swz & 63) >> 1;
    const int jstart = qb == 0 ? 2 : 0, jend = qb == 15 ? 4 : 6, nb = jend - jstart, ntile = nb + 4;
    const float SC = 0.125f * 1.4426950408889634f;
    bf16x8 qf[2][2];
    const int qrow0 = b * SEQ + qb * 128 + wid * 32;
#pragma unroll
    for (int qt = 0; qt < 2; ++qt)
#pragma unroll
        for (int ks = 0; ks < 2; ++ks)
            qf[qt][ks] = *(const bf16x8*)(WSP_Q + (size_t)(qrow0 + qt * 16 + fr) * 512 + h * 64 + ks * 32 + fq * 8);
    f32x4 o[4][2];
#pragma unroll
    for (int dt = 0; dt < 4; ++dt)
#pragma unroll
        for (int qt = 0; qt < 2; ++qt) o[dt][qt] = (f32x4){0.f, 0.f, 0.f, 0.f};
    float mrun[2], lrun[2];
    const float sinkv = p.attn_sink[h] * 1.4426950408889634f;
    mrun[0] = mrun[1] = sinkv;
    lrun[0] = lrun[1] = (fq == 0) ? 1.f : 0.f;
    __syncthreads();
    auto stage = [&](int i, int s) {
        const u16* kbase; const u16* vbase;
        if (i < nb) {
            const int ks0 = qb * 128 - 128 + 64 * (jstart + i);
            kbase = WSP_Kb + (size_t)(b * SEQ + ks0) * 128 + kvh * 64;
            vbase = WSP_Vt + (size_t)(b * 2 + kvh) * 64 * VT_LD + ks0;
        } else {
            const int c0 = 64 * (i - nb);
            kbase = WSP_Kb + (size_t)(NLAT + b * CTXL + c0) * 128 + kvh * 64;
            vbase = WSP_Vt + (size_t)(b * 2 + kvh) * 64 * VT_LD + SEQ + c0;
        }
        char* sk = smem + s * 16384;
        char* sv = sk + 8192;
#pragma unroll
        for (int it = 0; it < 2; ++it) {
            const int st = wid + 4 * it, R = (st >> 1) * 16 + r_in, C = (st & 1) * 32 + c_in;
            glds16(kbase + (size_t)R * 128 + C, sk + tid * 16 + it * 4096);
            glds16(vbase + (size_t)R * VT_LD + C, sv + tid * 16 + it * 4096);
        }
    };
    stage(0, 0);
    for (int i = 0; i < ntile; ++i) {
        asm volatile("s_waitcnt vmcnt(0)" ::: "memory");
        __syncthreads();
        if (i + 1 < ntile) stage(i + 1, (i + 1) & 1);
        const char* sk = smem + (i & 1) * 16384;
        const char* sv = sk + 8192;
        f32x4 s[4][2];
#pragma unroll
        for (int kt = 0; kt < 4; ++kt)
#pragma unroll
            for (int qt = 0; qt < 2; ++qt) s[kt][qt] = (f32x4){0.f, 0.f, 0.f, 0.f};
#pragma unroll
        for (int ks = 0; ks < 2; ++ks)
#pragma unroll
            for (int kt = 0; kt < 4; ++kt) {
                const bf16x8 kf = *(const bf16x8*)(sk + lds_byte(kt * 16 + fr, ks * 32 + fq * 8));
#pragma unroll
                for (int qt = 0; qt < 2; ++qt) s[kt][qt] = __builtin_amdgcn_mfma_f32_16x16x32_bf16(kf, qf[qt][ks], s[kt][qt], 0, 0, 0);
            }
        const int ks0 = qb * 128 - 128 + 64 * (jstart + i);
        const int qlo = qb * 128 + wid * 32;
        const bool band = (i < nb) && ((qlo + 31 - ks0 > 128) || (ks0 + 63 - qlo > 128));
        bf16x8 pf[2][2];
#pragma unroll
        for (int qt = 0; qt < 2; ++qt) {
            const int qp = qb * 128 + wid * 32 + qt * 16 + fr;
            float mx = -1e30f;
#pragma unroll
            for (int kt = 0; kt < 4; ++kt)
#pragma unroll
                for (int j = 0; j < 4; ++j) {
                    float v = s[kt][qt][j] * SC;
                    if (band) {
                        const int kp = ks0 + kt * 16 + fq * 4 + j, d = qp - kp;
                        if (d > 128 || d < -128) v = -1e30f;
                    }
                    s[kt][qt][j] = v;
                    mx = fmaxf(mx, v);
                }
            mx = fmaxf(mx, __shfl_xor(mx, 16));
            mx = fmaxf(mx, __shfl_xor(mx, 32));
            const float mnew = fmaxf(mrun[qt], mx);
            const float alpha = __builtin_amdgcn_exp2f(mrun[qt] - mnew);
            mrun[qt] = mnew;
            float ls = 0.f;
#pragma unroll
            for (int kt = 0; kt < 4; ++kt)
#pragma unroll
                for (int j = 0; j < 4; ++j) {
                    const float pv = __builtin_amdgcn_exp2f(s[kt][qt][j] - mnew);
                    s[kt][qt][j] = pv;
                    ls += pv;
                }
            lrun[qt] = lrun[qt] * alpha + ls;
#pragma unroll
            for (int dt = 0; dt < 4; ++dt) o[dt][qt] *= alpha;
#pragma unroll
            for (int k2 = 0; k2 < 2; ++k2) {
                bf16x8 t;
#pragma unroll
                for (int j = 0; j < 4; ++j) { t[j] = (short)f2bf(s[2 * k2][qt][j]); t[4 + j] = (short)f2bf(s[2 * k2 + 1][qt][j]); }
                pf[qt][k2] = t;
            }
        }
#pragma unroll
        for (int k2 = 0; k2 < 2; ++k2)
#pragma unroll
            for (int dt = 0; dt < 4; ++dt) {
                const uint2 lo = *(const uint2*)(sv + lds_byte(dt * 16 + fr, k2 * 32 + fq * 4));
                const uint2 hi = *(const uint2*)(sv + lds_byte(dt * 16 + fr, k2 * 32 + 16 + fq * 4));
                union { uint4 u; bf16x8 v; } cv; cv.u = make_uint4(lo.x, lo.y, hi.x, hi.y);
#pragma unroll
                for (int qt = 0; qt < 2; ++qt) o[dt][qt] = __builtin_amdgcn_mfma_f32_16x16x32_bf16(cv.v, pf[qt][k2], o[dt][qt], 0, 0, 0);
            }
    }
#pragma unroll
    for (int qt = 0; qt < 2; ++qt) {
        float l = lrun[qt];
        l += __shfl_xor(l, 16);
        l += __shfl_xor(l, 32);
        const float inv = 1.f / l;
        u16* dst = WSP_AO + (size_t)(qrow0 + qt * 16 + fr) * 512 + h * 64 + fq * 4;
        float sq = 0.f;
#pragma unroll
        for (int dt = 0; dt < 4; ++dt) {
            const unsigned w0 = pack2(o[dt][qt][0] * inv, o[dt][qt][1] * inv), w1 = pack2(o[dt][qt][2] * inv, o[dt][qt][3] * inv);
            *(uint2*)(dst + dt * 16) = make_uint2(w0, w1);
            const float a = bf2f((u16)(w0 & 0xffffu)), b = bf2f((u16)(w0 >> 16)), c = bf2f((u16)(w1 & 0xffffu)), d = bf2f((u16)(w1 >> 16));
            sq += a * a + b * b + c * c + d * d;
        }
        sq += __shfl_xor(sq, 16);
        sq += __shfl_xor(sq, 32);
        if (fq == 0) unsafeAtomicAdd(WSP_rsq + (size_t)(qrow0 + qt * 16 + fr) * 2, sq);
    }
}

__device__ __forceinline__ void ssm_s1_unit(const Params& p, int u) {
    const int ct = u % 9, mh = (u / 9) & 1, g = u / 18;
    const int lane = TIDX & 63, wid = TIDX >> 6, wr = wid >> 1, wc = wid & 1, fr = lane & 15, fq = lane >> 4;
    const u16* A = WSP_TabS + ((size_t)g * 256 + mh * 128) * 256;
    const u16* Ub = WSP_U + (size_t)ct * 128 * 16 * 512 + g * 16;
    f32x4 acc[4][4];
    gemm_tile(4,
        [&](int R, int C, int kt) { return (const void*)(A + (size_t)R * 256 + kt * 64 + C); },
        [&](int R, int C, int kt) { return (const void*)(Ub + (size_t)(R * 16 + kt * 4 + (C >> 4)) * 512 + (C & 15)); }, acc);
#pragma unroll
    for (int m = 0; m < 4; ++m)
#pragma unroll
        for (int n = 0; n < 4; ++n) {
            const int rho = mh * 128 + wr * 64 + m * 16 + fq * 4;
            const int cg = ct * 128 + wc * 64 + n * 16 + fr;
            *(f32x4*)(WSP_S + ((size_t)cg * 32 + g) * 256 + rho) = acc[m][n];
        }
}

__device__ __forceinline__ void phase3(const Params& p) {
    const int NU = 1024 + 576;
    for (int u = blockIdx.x; u < NU; u += gridDim.x) {
        if (u < 1024) attn_unit(p, u); else ssm_s1_unit(p, u - 1024);
    }
}

__device__ __forceinline__ void phase4(const Params& p) {
    if ((int)gridDim.x > 192) {
        if ((int)blockIdx.x >= 160) { conv_range(p, blockIdx.x - 160, gridDim.x - 160, N_CONV, N_CONV_EARLY); return; }
        if ((int)blockIdx.x >= 128) { ssm_toeplitz_item(p, blockIdx.x - 128); return; }
    } else {
        for (int g = blockIdx.x; g < 32; g += gridDim.x) ssm_toeplitz_item(p, g);
        conv_range(p, blockIdx.x, gridDim.x, N_CONV, N_CONV_EARLY);
    }
    const int gid = blockIdx.x * NTHR + TIDX;
    if (gid >= BATCH * 2 * 32 * 64) return;
    const int n = gid & 63, g = (gid >> 6) & 31, dir = (gid >> 11) & 1, b = gid >> 12;
    const int pidx = dir * 32 + g;
    const float dt = __expf(p.log_dt[pidx]);
    const float are = p.a_re[pidx * 64 + n], aim = p.a_im[pidx * 64 + n];
    const float mag = __expf(16.f * dt * are);
    float rev = 16.f * (dt * aim * 0.15915494309189535f);
    rev -= rintf(rev);
    const float ar = mag * __builtin_amdgcn_cosf(rev), ai = mag * __builtin_amdgcn_sinf(rev);
    float hr = 0.f, hi = 0.f;
    const size_t so = (size_t)g * 256 + dir * 128 + n;
#pragma unroll 8
    for (int i = 0; i < 16; ++i) {
        const int c = dir == 0 ? i : 15 - i;
        const float* sp = WSP_S + (size_t)(NCHUNK_LAT + b * 16 + c) * 8192 + so;
        const float sr = sp[0], si = sp[64];
        const float nr = ar * hr - ai * hi + sr, ni = ar * hi + ai * hr + si;
        hr = nr; hi = ni;
    }
#pragma unroll 8
    for (int i = 0; i < 128; ++i) {
        const int c = dir == 0 ? i : 127 - i;
        const size_t cg = (size_t)b * 128 + c;
        const float* sp = WSP_S + cg * 8192 + so;
        const float sr = sp[0], si = sp[64];
        u16* hp = WSP_Hin + cg * 8192 + so;
        hp[0] = f2bf(hr); hp[64] = f2bf(hi);
        const float nr = ar * hr - ai * hi + sr, ni = ar * hi + ai * hr + si;
        hr = nr; hi = ni;
    }
}

__device__ __forceinline__ void phase5(const Params& p) {
    const int NU = 512;
    const int lane = TIDX & 63, wid = TIDX >> 6, wr = wid >> 1, wc = wid & 1, fr = lane & 15, fq = lane >> 4;
    for (int u = blockIdx.x; u < NU; u += gridDim.x) {
        const int ct = u & 7, mh = (u >> 3) & 1, g = u >> 4;
        const u16* A = WSP_TabY + ((size_t)g * 256 + mh * 128) * 512;
        const u16* Ub = WSP_U + (size_t)ct * 128 * 16 * 512 + g * 16;
        const u16* Hb_ = WSP_Hin + (size_t)ct * 128 * 8192 + g * 256;
        f32x4 acc[4][4];
        gemm_tile(8,
            [&](int R, int C, int kt) { return (const void*)(A + (size_t)R * 512 + kt * 64 + C); },
            [&](int R, int C, int kt) {
                return kt < 4 ? (const void*)(Ub + (size_t)(R * 16 + kt * 4 + (C >> 4)) * 512 + (C & 15))
                              : (const void*)(Hb_ + (size_t)R * 8192 + (kt - 4) * 64 + C);
            }, acc);
#pragma unroll
        for (int m = 0; m < 4; ++m)
#pragma unroll
            for (int n = 0; n < 4; ++n) {
                const int t = mh * 8 + wr * 4 + m;
                const int cg = ct * 128 + wc * 64 + n * 16 + fr;
                u16* dst = WSP_Y + ((size_t)cg * 16 + t) * 512 + g * 16 + fq * 4;
                *(uint2*)dst = make_uint2(pack2(gelu_tanh(acc[m][n][0]), gelu_tanh(acc[m][n][1])),
                                          pack2(gelu_tanh(acc[m][n][2]), gelu_tanh(acc[m][n][3])));
            }
    }
}

__device__ __forceinline__ void phase6(const Params& p) {
    const int NU = 512;
    const int lane = TIDX & 63, wid = TIDX >> 6, wr = wid >> 1, wc = wid & 1, fr = lane & 15, fq = lane >> 4;
    for (int u = blockIdx.x; u < NU; u += gridDim.x) {
        const int mt = u >> 2, nt = u & 3;
        const u16* A = WSP_Y + (size_t)mt * 128 * 512;
        const u16* B = WSP_WgluT + (size_t)nt * 128 * 512;
        f32x4 acc[4][4];
        gemm_tile(8,
            [&](int R, int C, int kt) { return (const void*)(A + (size_t)R * 512 + kt * 64 + C); },
            [&](int R, int C, int kt) { return (const void*)(B + (size_t)R * 512 + kt * 64 + C); }, acc);
        const int row0 = mt * 128 + wr * 64, col0 = nt * 128 + wc * 64;
        char* base = smem + wid * 9216;
        float bg[4];
#pragma unroll
        for (int n = 0; n < 4; ++n) bg[n] = p.b_glu[col0 + n * 16 + fr];
#pragma unroll
        for (int m = 0; m < 4; ++m)
#pragma unroll
            for (int j = 0; j < 4; ++j) {
                const int rl = m * 16 + fq * 4 + j, r = row0 + rl;
                float sq = 0.f;
#pragma unroll
                for (int n = 0; n < 4; ++n) {
                    const int c = col0 + n * 16 + fr;
                    const float yv = bf2f(WSP_Y[(size_t)r * 512 + c]);
                    const u16 ob = f2bf(yv * sigmoidf_(acc[m][n][j] + bg[n]));
                    *(u16*)(base + rl * 144 + (n * 16 + fr) * 2) = ob;
                    const float of = bf2f(ob);
                    sq += of * of;
                }
                sq += __shfl_xor(sq, 1); sq += __shfl_xor(sq, 2); sq += __shfl_xor(sq, 4); sq += __shfl_xor(sq, 8);
                if (fr == 0) unsafeAtomicAdd(WSP_rsq + (size_t)r * 2 + 1, sq);
            }
        asm volatile("s_waitcnt lgkmcnt(0)" ::: "memory");
        __builtin_amdgcn_wave_barrier();
        u16* dbase = WSP_SO + (size_t)row0 * 512 + col0;
#pragma unroll
        for (int i = 0; i < 8; ++i) {
            const int id = i * 64 + lane, row = id >> 3, ch = id & 7;
            *(uint4*)(dbase + (size_t)row * 512 + ch * 8) = *(const uint4*)(base + row * 144 + ch * 16);
        }
        asm volatile("s_waitcnt lgkmcnt(0)" ::: "memory");
        __builtin_amdgcn_wave_barrier();
    }
}

__device__ __forceinline__ void phase8(const Params& p) {
    const int NU = 512;
    for (int u = blockIdx.x; u < NU; u += gridDim.x) {
        const int mt = (u & 7) + 8 * (u >> 5), nt = (u >> 3) & 3;
        const u16* A1 = WSP_AO + (size_t)mt * 128 * 512;
        const u16* A2 = WSP_SO + (size_t)mt * 128 * 512;
        const u16* B = WSP_WoutT + (size_t)nt * 256 * 1024;
        f32x4 acc[4][8];
        {
        const int tid1 = TIDX, fq = (tid1 & 63) >> 4, row0 = mt * 128 + (tid1 >> 7) * 64;
        gemm_tile_w(32,
            [&](int i, int R, int C, int kt) { return (const void*)((kt < 16 ? A1 : A2) + (size_t)R * 512 + (kt & 15) * 32 + C); },
            [&](int i, int R, int C, int kt) { return (const void*)(B + (size_t)R * 1024 + kt * 32 + C); }, acc,
            [&](int kt) {
                if (kt == 16) {
#pragma unroll
                    for (int m = 0; m < 4; ++m) {
                        asm volatile("" ::: "memory");
#pragma unroll
                        for (int j = 0; j < 4; ++j) {
                            const float2 q = *(const float2*)(WSP_rsq + (size_t)(row0 + m * 16 + fq * 4 + j) * 2);
                            const float ratio = rsqrtf(q.x * (1.f / 512.f) + EPS) / rsqrtf(q.y * (1.f / 512.f) + EPS);
#pragma unroll
                            for (int n = 0; n < 8; ++n) acc[m][n][j] *= ratio;
                        }
                    }
                }
            });
        }
        const int tid2 = TIDX, lane = tid2 & 63, wid = tid2 >> 6, fr = lane & 15, fq = lane >> 4;
        const int row0 = mt * 128 + (wid >> 1) * 64, col0 = nt * 256 + (wid & 1) * 128;
        const float* g1 = WSP_mod + (mt >> 4) * 6144 + 2048 + col0;
        float* stg = (float*)(smem + wid * 8448);
#pragma unroll
        for (int m = 0; m < 4; ++m) {
#pragma unroll
            for (int n = 0; n < 8; ++n)
#pragma unroll
                for (int j = 0; j < 4; ++j) stg[(fq * 4 + j) * 132 + n * 16 + fr] = acc[m][n][j];
            asm volatile("s_waitcnt lgkmcnt(0)" ::: "memory");
            __builtin_amdgcn_wave_barrier();
#pragma unroll
            for (int i = 0; i < 8; ++i) {
                const int id = i * 64 + lane, rr = id >> 5, c4 = (id & 31) * 4;
                float4 v = *(const float4*)(stg + rr * 132 + c4);
                const float rsv = rsqrtf(WSP_rsq[(size_t)(row0 + m * 16 + rr) * 2 + 1] * (1.f / 512.f) + EPS);
                v.x *= rsv; v.y *= rsv; v.z *= rsv; v.w *= rsv;
                const float4 g = *(const float4*)(g1 + c4);
                const size_t o = (size_t)(row0 + m * 16 + rr) * 1024 + col0 + c4;
                const float4 xv = *(const float4*)(p.x + o);
                *(float4*)(p.out + o) = make_float4(xv.x + g.x * v.x, xv.y + g.y * v.y, xv.z + g.z * v.z, xv.w + g.w * v.w);
            }
            asm volatile("s_waitcnt lgkmcnt(0)" ::: "memory");
            __builtin_amdgcn_wave_barrier();
        }
    }
}

#define CTR_ECNT 0
#define CTR_Q11 128
#define CTR_Q12 136
#define HALF_TOK 8192
#define HH_HALF_ROWS 73728
#define ELIST_CAP 8192
template <int LEVEL>
__device__ __forceinline__ void phase9_t(const Params& p) {
    const int tid = TIDX, lane = tid & 63, wid = tid >> 6, fr = lane & 15, fq = lane >> 4;
    char* At = smem;
    float* sc = (float*)(smem + 65536);
    int* hist = (int*)(smem + 65536 + 8192);
    int* gbase = hist + 64;
    int* fill = gbase + 64;
    unsigned char* selk = (unsigned char*)(fill + 64);
    float* selw = (float*)(selk + 256);
    for (int chunk = blockIdx.x; chunk < NLAT / 32; chunk += gridDim.x) {
        const int tok0 = chunk * 32;
        __syncthreads();
        if (tid < 64) hist[tid] = 0;
#pragma unroll 1
        for (int hb = 0; hb < 2; ++hb) {
            float4 vall[4][4];
#pragma unroll
            for (int rr = 0; rr < 4; ++rr)
#pragma unroll
                for (int i = 0; i < 4; ++i) vall[rr][i] = *(const float4*)(p.out + (size_t)(tok0 + wid * 8 + hb * 4 + rr) * 1024 + i * 256 + lane * 4);
#pragma unroll
            for (int rr = 0; rr < 4; ++rr) {
                const int row = wid * 8 + hb * 4 + rr, tok = tok0 + row;
                const float* md = WSP_mod + (tok >> 11) * 6144;
                float ss = 0.f;
#pragma unroll
                for (int i = 0; i < 4; ++i) ss += vall[rr][i].x * vall[rr][i].x + vall[rr][i].y * vall[rr][i].y + vall[rr][i].z * vall[rr][i].z + vall[rr][i].w * vall[rr][i].w;
                ss = wave_sum(ss);
                const float rs = rsqrtf(ss * (1.f / 1024.f) + EPS);
#pragma unroll
                for (int i = 0; i < 4; ++i) {
                    const int c0 = i * 256 + lane * 4;
                    const float4 v = vall[rr][i];
                    const float4 g = *(const float4*)(p.norm_ffn + c0), s = *(const float4*)(md + 3072 + c0), k = *(const float4*)(md + 4096 + c0);
                    const float a = v.x * rs * g.x * (1.f + k.x) + s.x, b = v.y * rs * g.y * (1.f + k.y) + s.y;
                    const float c = v.z * rs * g.z * (1.f + k.z) + s.z, d = v.w * rs * g.w * (1.f + k.w) + s.w;
                    const uint2 pk = make_uint2(pack2(a, b), pack2(c, d));
                    *(uint2*)(WSP_H2 + (size_t)tok * 1024 + c0) = pk;
                    const int ch = c0 >> 3;
                    *(uint2*)(At + row * 2048 + ((ch ^ (row & 15)) << 4) + ((c0 & 4) << 1)) = pk;
                }
            }
        }
        __syncthreads();
        if (LEVEL == 1) continue;
        {
            f32x4 acc0 = {0.f, 0.f, 0.f, 0.f}, acc1 = {0.f, 0.f, 0.f, 0.f};
            const u16* bp = WSP_WrT + (size_t)(wid * 16 + fr) * 1024 + fq * 8;
#pragma unroll
            for (int kb = 0; kb < 4; ++kb) {
                bf16x8 bfr[8];
#pragma unroll
                for (int q = 0; q < 8; ++q) bfr[q] = *(const bf16x8*)(bp + (kb * 8 + q) * 32);
#pragma unroll
                for (int q = 0; q < 8; ++q) {
                    const int ch = (kb * 8 + q) * 4 + fq;
                    const bf16x8 a0 = *(const bf16x8*)(At + fr * 2048 + ((ch ^ fr) << 4));
                    const bf16x8 a1 = *(const bf16x8*)(At + (16 + fr) * 2048 + ((ch ^ fr) << 4));
                    acc0 = __builtin_amdgcn_mfma_f32_16x16x32_bf16(a0, bfr[q], acc0, 0, 0, 0);
                    acc1 = __builtin_amdgcn_mfma_f32_16x16x32_bf16(a1, bfr[q], acc1, 0, 0, 0);
                }
            }
#pragma unroll
            for (int j = 0; j < 4; ++j) {
                sc[(fq * 4 + j) * 64 + wid * 16 + fr] = sigmoidf_(acc0[j]);
                sc[(16 + fq * 4 + j) * 64 + wid * 16 + fr] = sigmoidf_(acc1[j]);
            }
        }
        __syncthreads();
        const float bias = p.router_bias[lane];
        const int eg = lane >> 3;
        for (int rr = 0; rr < 8; ++rr) {
            const int row = wid * 8 + rr;
            const float s = sc[row * 64 + lane];
            const float bz = s + bias;
            float m1 = bz;
            m1 = fmaxf(m1, __shfl_xor(m1, 1)); m1 = fmaxf(m1, __shfl_xor(m1, 2)); m1 = fmaxf(m1, __shfl_xor(m1, 4));
            const unsigned long long eq = __ballot(bz == m1);
            const unsigned gb = (unsigned)((eq >> (eg * 8)) & 0xffull);
            const int first = __ffs(gb) - 1;
            float v2 = ((lane & 7) == first) ? -1e30f : bz;
            v2 = fmaxf(v2, __shfl_xor(v2, 1)); v2 = fmaxf(v2, __shfl_xor(v2, 2)); v2 = fmaxf(v2, __shfl_xor(v2, 4));
            const float gs = m1 + v2;
            int cnt = 0;
#pragma unroll
            for (int j = 0; j < 8; ++j) {
                const float gj = __int_as_float(__builtin_amdgcn_readlane(__float_as_int(gs), j * 8));
                cnt += (gj > gs || (gj == gs && j < eg)) ? 1 : 0;
            }
            const bool gsel = cnt < 4;
            const float mv = gsel ? bz : -1e30f;
            int rank = 0;
#pragma unroll
            for (int j = 0; j < 64; ++j) {
                const float vj = __int_as_float(__builtin_amdgcn_readlane(__float_as_int(mv), j));
                rank += (vj > mv || (vj == mv && j < lane)) ? 1 : 0;
            }
            const bool sel = gsel && rank < 8;
            const float tot = wave_sum(sel ? s : 0.f);
            if (sel) {
                selw[row * 8 + rank] = s / tot * 2.5f;
                selk[row * 8 + rank] = (unsigned char)lane;
                atomicAdd(&hist[lane], 1);
            }
        }
        __syncthreads();
        const int h = tok0 >> 13;
        if (tid < 64) {
            gbase[tid] = hist[tid] ? (int)atomicAdd(&WSP_ctr[CTR_ECNT + h * 64 + tid], (unsigned)hist[tid]) : 0;
            fill[tid] = 0;
        }
        __syncthreads();
        {
            const int e = selk[tid];
            const int pos = atomicAdd(&fill[e], 1);
            WSP_elist[(size_t)(h * 64 + e) * ELIST_CAP + gbase[e] + pos] = (tok0 + (tid >> 3)) * 8 + (tid & 7);
            WSP_wsl[(size_t)(h * 64 + e) * ELIST_CAP + gbase[e] + pos] = selw[tid];
        }
    }
}

struct MoeTab { int cnt[16]; int soff[16]; int pre[17]; };

template <class FV, class FD>
__device__ __forceinline__ void wave_store_fp8_f(FV val, FD dst) {
    const int lane = TIDX & 63, wid = TIDX >> 6, fr = lane & 15, fq = lane >> 4;
    char* base = smem + wid * 9216;
#pragma unroll
    for (int m = 0; m < 4; ++m)
#pragma unroll
        for (int n = 0; n < 8; ++n)
#pragma unroll
            for (int j = 0; j < 4; ++j)
                *(unsigned char*)(base + (m * 16 + fq * 4 + j) * 144 + n * 16 + fr) =
                    (unsigned char)(__builtin_amdgcn_cvt_pk_fp8_f32(val(m, n, j), 0.f, 0, false) & 0xff);
    asm volatile("s_waitcnt lgkmcnt(0)" ::: "memory");
    __builtin_amdgcn_wave_barrier();
#pragma unroll
    for (int i = 0; i < 8; ++i) {
        const int id = i * 64 + lane, row = id >> 3, ch = id & 7;
        const uint4 d = *(const uint4*)(base + row * 144 + ch * 16);
        unsigned char* q = dst(i, row);
        if (q) *(uint4*)(q + ch * 16) = d;
    }
    asm volatile("s_waitcnt lgkmcnt(0)" ::: "memory");
    __builtin_amdgcn_wave_barrier();
}

#define YD_SCALE 8.0f
template <int MODE>
__device__ __forceinline__ void phase11f(const Params& p) {
    const int tid = TIDX;
    int* tab = (int*)(smem + 73728);
    int* t_cnt = tab, *t_soff = tab + 16, *t_pre = tab + 32, *t_q = tab + 52;
    int* t_all = tab + 64;
    const int x = blockIdx.x & 7;
    unsigned* flags = WSP_flag + x * FLAG_PER_CLASS;
    unsigned* tmo = WSP_flag + 8 * FLAG_PER_CLASS;
    unsigned char* Yd8 = (unsigned char*)(p.ws + OFF_ARENA);
    __syncthreads();
    if (tid < 128) t_all[tid] = (int)WSP_ctr[CTR_ECNT + tid];
    unsigned* qhead = &WSP_ctr[(MODE == 2 ? CTR_Q12 : CTR_Q11) + x];
    if (tid == 0) t_q[0] = (int)atomicAdd(qhead, 1u);
    __syncthreads();
    if (tid < 16) {
        const int i = tid >> 1, h = tid & 1, e = x + 8 * i;
        t_cnt[tid] = t_all[h * 64 + e];
        int so = 0;
        for (int e2 = 0; e2 < e; ++e2) so += t_all[h * 64 + e2];
        t_soff[tid] = so;
    }
    __syncthreads();
    if (tid == 0) {
        int s = 0;
        for (int j = 0; j < 16; ++j) { t_pre[j] = s; s += (t_cnt[j] + 127) >> 7; }
        t_pre[16] = s;
    }
    __syncthreads();
    const int T_r = t_pre[16], T11 = T_r + 16, T_all = (MODE == 1) ? T11 : T11 + T_r * 4;
    for (;;) {
        __syncthreads();
        const int q = __builtin_amdgcn_readfirstlane(t_q[0]) + (MODE == 2 ? T11 : 0);
        __syncthreads();
        if (q >= T_all) break;
        if (tid == 0) t_q[0] = (int)atomicAdd(qhead, 1u);
        const bool is_down = q >= T11;
        const int u = is_down ? (q - T11) >> 2 : q;
        int nt = is_down ? (q - T11) & 3 : 0;
        int e, h, mt, c, rowbase;
        if (u < T_r) {
            int j = 0;
#pragma unroll
            for (int qq = 1; qq < 16; ++qq) j += (u >= t_pre[qq]) ? 1 : 0;
            e = x + 8 * (j >> 1); h = j & 1; mt = u - t_pre[j]; c = t_cnt[j];
            rowbase = h * HH_HALF_ROWS + t_soff[j];
        } else {
            const int ms = x * 16 + (u - T_r);
            e = 64; h = ms >> 6; mt = ms & 63; c = HALF_TOK;
            rowbase = h * HH_HALF_ROWS + 65536;
        }
        e = __builtin_amdgcn_readfirstlane(e); h = __builtin_amdgcn_readfirstlane(h); mt = __builtin_amdgcn_readfirstlane(mt);
        nt = __builtin_amdgcn_readfirstlane(nt); c = __builtin_amdgcn_readfirstlane(c); rowbase = __builtin_amdgcn_readfirstlane(rowbase);
        const int* el = WSP_elist + (size_t)(h * 64 + (e & 63)) * ELIST_CAP;
        if (!is_down) {
            const int t2 = TIDX, lane = t2 & 63, wid = t2 >> 6, wr = wid >> 1, wc = wid & 1, fr = lane & 15, fq = lane >> 4;
            const int sb = lane * 16, swz = sb ^ (((sb >> 9) & 1) << 5);
            const int r_in = swz >> 6, c_in = (swz & 63) >> 1;
            const int vrows = c - mt * 128 - wr * 64;
            const float* wsl = WSP_wsl + (size_t)(h * 64 + (e & 63)) * ELIST_CAP;
            const u16* aptr[2];
#pragma unroll
            for (int i = 0; i < 2; ++i) {
                int li = mt * 128 + (wid + 4 * i) * 16 + r_in;
                li = li < c ? li : c - 1;
                const int tok = (e < 64) ? (el[li] >> 3) : (h * HALF_TOK + li);
                aptr[i] = WSP_H2 + (size_t)tok * 1024 + c_in;
            }
            const u16* Bw = WSP_WguT + (size_t)e * 262144 + c_in;
            f32x4 acc[4][8];
            gemm_tile_w(32,
                [&](int i, int R, int C, int kt) { return (const void*)(aptr[i] + kt * 32); },
                [&](int i, int R, int C, int kt) { return (const void*)(Bw + (size_t)R * 1024 + kt * 32); }, acc);
            float wgt[4][4];
#pragma unroll
            for (int m = 0; m < 4; ++m)
#pragma unroll
                for (int j = 0; j < 4; ++j) {
                    const int li = mt * 128 + wr * 64 + m * 16 + fq * 4 + j;
                    float w = 1.f;
                    if (e < 64) w = (li < c) ? wsl[li] : 0.f;
                    wgt[m][j] = w;
                }
            u16* dbase = WSP_HHs + ((size_t)rowbase + mt * 128 + wr * 64) * 128 + wc * 64;
            wave_store_bf16_f([&](int m, int n2, int j) { return siluf_(acc[m][2 * n2][j]) * acc[m][2 * n2 + 1][j] * wgt[m][j]; },
                              [&](int row) { return row < vrows ? dbase + (size_t)row * 128 : (u16*)nullptr; }, true, (const char*)WSP_HHs, (unsigned)((size_t)2 * HH_HALF_ROWS * 128 * 2));
            asm volatile("s_waitcnt vmcnt(0)" ::: "memory");
            __syncthreads();
            if (tid == 0) __hip_atomic_store(&flags[u], 1u, __ATOMIC_RELAXED, __HIP_MEMORY_SCOPE_AGENT);
        } else {
            const int t2 = TIDX, lane = t2 & 63, wid = t2 >> 6, wr = wid >> 1, wc = wid & 1, fr = lane & 15, fq = lane >> 4;
            const int sb = lane * 16, swz = sb ^ (((sb >> 9) & 1) << 5);
            const int r_in = swz >> 6, c_in = (swz & 63) >> 1;
            const int vrows = c - mt * 128 - wr * 64;
            if (MODE == 0 && tid == 0) {
                unsigned sp = 0;
                while (__hip_atomic_load(&flags[u], __ATOMIC_RELAXED, __HIP_MEMORY_SCOPE_AGENT) == 0u) {
                    __builtin_amdgcn_s_sleep(2);
                    if ((++sp & 255u) == 0u) {
                        if (__hip_atomic_load(tmo, __ATOMIC_RELAXED, __HIP_MEMORY_SCOPE_AGENT)) break;
                        if (sp > (1u << 20)) { atomicAdd(tmo, 1u); break; }
                    }
                }
            }
            __syncthreads();
            const u16* aptr[2];
#pragma unroll
            for (int i = 0; i < 2; ++i) {
                int li = mt * 128 + (wid + 4 * i) * 16 + r_in;
                li = li < c ? li : c - 1;
                aptr[i] = WSP_HHs + ((size_t)rowbase + li) * 128 + c_in;
            }
            const u16* Bw = WSP_WdT + ((size_t)e * 1024 + nt * 256) * 128 + c_in;
            int slot[8];
            if (e < 64) {
#pragma unroll
                for (int i = 0; i < 8; ++i) {
                    int li = mt * 128 + wr * 64 + ((i * 64 + lane) >> 3);
                    li = li < c ? li : c - 1;
                    slot[i] = el[li];
                }
            } else {
#pragma unroll
                for (int i = 0; i < 8; ++i) slot[i] = (h * HALF_TOK + mt * 128 + wr * 64 + ((i * 64 + lane) >> 3)) * 8;
            }
            f32x4 acc[4][8];
            gemm_tile_w<true>(4,
                [&](int i, int R, int C, int kt) { return (const void*)(aptr[i] + kt * 32); },
                [&](int i, int R, int C, int kt) { return (const void*)(Bw + (size_t)R * 128 + kt * 32); }, acc);
            const int colo = nt * 256 + wc * 128;
            if (e < 64) {
                wave_store_fp8_f([&](int m, int n, int j) { return acc[m][n][j] * YD_SCALE; }, [&](int i, int row) {
                    if (row >= vrows) return (unsigned char*)nullptr;
                    const int s = slot[i];
                    return Yd8 + ((size_t)(s >> 3) * 8 + (s & 7)) * 1024 + colo;
                });
            } else {
                const int tok0 = h * HALF_TOK + mt * 128 + wr * 64;
                const float* g2 = WSP_mod + (tok0 >> 11) * 6144 + 5120 + colo;
                float* stg = (float*)(smem + wid * 8448);
#pragma unroll
                for (int m = 0; m < 4; ++m) {
#pragma unroll
                    for (int n = 0; n < 8; ++n)
#pragma unroll
                        for (int j = 0; j < 4; ++j) stg[(fq * 4 + j) * 132 + n * 16 + fr] = acc[m][n][j];
                    asm volatile("s_waitcnt lgkmcnt(0)" ::: "memory");
                    __builtin_amdgcn_wave_barrier();
#pragma unroll
                    for (int i = 0; i < 8; ++i) {
                        const int id = i * 64 + lane, rr = id >> 5, c4 = (id & 31) * 4;
                        const float4 v = *(const float4*)(stg + rr * 132 + c4);
                        const float4 g = *(const float4*)(g2 + c4);
                        float* op = p.out + (size_t)(tok0 + m * 16 + rr) * 1024 + colo + c4;
                        const float4 xv = *(const float4*)op;
                        *(float4*)op = make_float4(xv.x + g.x * v.x, xv.y + g.y * v.y, xv.z + g.z * v.z, xv.w + g.w * v.w);
                    }
                    asm volatile("s_waitcnt lgkmcnt(0)" ::: "memory");
                    __builtin_amdgcn_wave_barrier();
                }
            }
        }
    }
}

#define P12_SLD 2064
template <bool DUMMY>
__device__ __forceinline__ void phase12b_t(const Params& p) {
    const int tid = TIDX, lane = tid & 63, wid = tid >> 6, fr = lane & 15, fq = lane >> 4;
    const unsigned char* Yd8 = (const unsigned char*)(p.ws + OFF_ARENA);
    const u16* Wb = WSP_WdT + (size_t)64 * 131072 + (size_t)(wid * 256 + fr) * 128 + fq * 8;
    for (int tile = blockIdx.x; tile < NLAT / 32; tile += gridDim.x) {
        const int tok0 = tile * 32;
        const int hh = tok0 >> 13;
        const u16* Ab = WSP_HHs + ((size_t)hh * HH_HALF_ROWS + 65536 + (tok0 & 8191) + fr) * 128 + fq * 8;
        __syncthreads();
        bf16x8 af[2][4];
#pragma unroll
        for (int m = 0; m < 2; ++m)
#pragma unroll
            for (int ks = 0; ks < 4; ++ks) af[m][ks] = *(const bf16x8*)(Ab + (size_t)m * 16 * 128 + ks * 32);
#pragma unroll 1
        for (int nb = 0; nb < 4; ++nb) {
            bf16x8 bfr[4][4];
#pragma unroll
            for (int n = 0; n < 4; ++n)
#pragma unroll
                for (int ks = 0; ks < 4; ++ks) bfr[n][ks] = *(const bf16x8*)(Wb + (size_t)((nb * 4 + n) * 16) * 128 + ks * 32);
#pragma unroll
            for (int m = 0; m < 2; ++m)
#pragma unroll
                for (int n = 0; n < 4; ++n) {
                    f32x4 d = {0.f, 0.f, 0.f, 0.f};
#pragma unroll
                    for (int ks = 0; ks < 4; ++ks) d = __builtin_amdgcn_mfma_f32_16x16x32_bf16(af[m][ks], bfr[n][ks], d, 0, 0, 0);
                    const int col = wid * 256 + (nb * 4 + n) * 16 + fr;
#pragma unroll
                    for (int j = 0; j < 4; ++j) *(u16*)(smem + (m * 16 + fq * 4 + j) * P12_SLD + col * 2) = f2bf(d[j]);
                }
        }
        __syncthreads();
        for (int rr = 0; rr < 8; ++rr) {
            const int row = wid * 8 + rr, tok = tok0 + row;
            float* xrow = p.out + (size_t)tok * 1024 + lane * 16;
            float* orow = DUMMY ? (float*)(p.ws + OFF_HHS) + (size_t)(tok & 8191) * 1024 + lane * 16 : xrow;
            const float* g2 = WSP_mod + (tok >> 11) * 6144 + 5120 + lane * 16;
            float s[16];
#pragma unroll
            for (int i = 0; i < 16; ++i) s[i] = 0.f;
            const unsigned char* yp = Yd8 + (size_t)tok * 8 * 1024 + lane * 16;
            uint4 yv[8];
#pragma unroll
            for (int k = 0; k < 8; ++k) yv[k] = *(const uint4*)(yp + k * 1024);
#pragma unroll
            for (int k = 0; k < 8; ++k) {
                const unsigned w[4] = {yv[k].x, yv[k].y, yv[k].z, yv[k].w};
#pragma unroll
                for (int i = 0; i < 4; ++i) {
                    const auto lo = __builtin_amdgcn_cvt_pk_f32_fp8((int)w[i], false);
                    const auto hi = __builtin_amdgcn_cvt_pk_f32_fp8((int)w[i], true);
                    s[4 * i] += lo[0]; s[4 * i + 1] += lo[1]; s[4 * i + 2] += hi[0]; s[4 * i + 3] += hi[1];
                }
            }
            const uint4 sa = *(const uint4*)(smem + row * P12_SLD + lane * 32), sbv = *(const uint4*)(smem + row * P12_SLD + lane * 32 + 16);
            const unsigned sw[8] = {sa.x, sa.y, sa.z, sa.w, sbv.x, sbv.y, sbv.z, sbv.w};
#pragma unroll
            for (int i = 0; i < 8; ++i) {
                s[2 * i] = s[2 * i] * (1.f / YD_SCALE) + bf2f((u16)(sw[i] & 0xffffu));
                s[2 * i + 1] = s[2 * i + 1] * (1.f / YD_SCALE) + bf2f((u16)(sw[i] >> 16));
            }
            float ss = 0.f;
#pragma unroll
            for (int q = 0; q < 4; ++q) {
                const float4 xv = *(const float4*)(xrow + q * 4), gv = *(const float4*)(g2 + q * 4);
                s[4 * q] = xv.x + gv.x * s[4 * q]; s[4 * q + 1] = xv.y + gv.y * s[4 * q + 1];
                s[4 * q + 2] = xv.z + gv.z * s[4 * q + 2]; s[4 * q + 3] = xv.w + gv.w * s[4 * q + 3];
                ss += s[4 * q] * s[4 * q] + s[4 * q + 1] * s[4 * q + 1] + s[4 * q + 2] * s[4 * q + 2] + s[4 * q + 3] * s[4 * q + 3];
            }
            ss = wave_sum(ss);
            const float rs = rsqrtf(ss * (1.f / 1024.f) + EPS);
#pragma unroll
            for (int q = 0; q < 4; ++q) {
                const float4 g = *(const float4*)(p.norm_final + lane * 16 + q * 4);
                *(float4*)(orow + q * 4) = make_float4(s[4 * q] * rs * g.x, s[4 * q + 1] * rs * g.y, s[4 * q + 2] * rs * g.z, s[4 * q + 3] * rs * g.w);
            }
        }
    }
}

#define SMEM_TOTAL (73728 + 3072 + 64)

#if 1
__global__ void __launch_bounds__(NTHR, 2) k_mega(Params p) {
    volatile LAS unsigned* st = (volatile LAS unsigned*)(smem + SMEM_TOTAL - 16);
    if (TIDX == 0) { st[0] = 0u; st[1] = 0u; st[2] = 0u; st[3] = 0u; }
    __syncthreads();
    XcdBarrier bar = xcd_barrier_post(WSP_bar, st);
#define RUNP(N) do { phase##N(p); if (PROBE_DUP == N) phase##N(p); } while (0)
    RUNP(0);  xcd_barrier(bar);
    RUNP(1);  xcd_barrier(bar);
    RUNP(2);  xcd_barrier(bar);
    RUNP(3);  xcd_barrier(bar);
    RUNP(4);  xcd_barrier(bar);
    RUNP(5);  xcd_barrier(bar);
    RUNP(6);  xcd_barrier(bar);
    RUNP(8);  xcd_barrier(bar);
#if PROBE_DUP == 91
    phase9_t<1>(p); xcd_barrier(bar);
#endif
    phase9_t<0>(p); xcd_barrier(bar);
#if PROBE_DUP == 9
    if (blockIdx.x == 0 && TIDX < 128) WSP_ctr[CTR_ECNT + TIDX] = 0u;
    xcd_barrier(bar); phase9_t<0>(p); xcd_barrier(bar);
#endif
#ifndef MOE_FUSED
#define MOE_FUSED 1
#endif
#if MOE_FUSED
    phase11f<0>(p); xcd_barrier(bar);
#else
    phase11f<1>(p); xcd_barrier(bar);
    phase11f<2>(p); xcd_barrier(bar);
#endif
#if PROBE_DUP == 11
    if (blockIdx.x == 0 && TIDX < 8) WSP_ctr[CTR_Q11 + TIDX] = 0u;
    if (blockIdx.x == 1) for (int i = TIDX; i < 8 * FLAG_PER_CLASS; i += NTHR) WSP_flag[i] = 0u;
    xcd_barrier(bar); phase11f<0>(p); xcd_barrier(bar);
#endif
#if PROBE_DUP == 121
    phase12b_t<true>(p); xcd_barrier(bar);
#endif
    phase12b_t<false>(p);
}
#endif


extern "C" void kernel_launch(void* const* d_in, const int* in_sizes, int n_in,
                              void* d_out, int out_size, void* d_ws, size_t ws_size,
                              hipStream_t stream) {
    Params p{};
    const float** ip = (const float**)&p.x;
    for (int i = 0; i < 32; ++i) ip[i] = (const float*)d_in[i];
    p.out = (float*)d_out;
    p.ws = (char*)d_ws;
    if (OFF_END > ws_size) { fprintf(stderr, "workspace too small: need %zu have %zu\n", (size_t)OFF_END, ws_size); return; }

    static int grid = 0;
    if (!grid) {
        hipFuncSetAttribute((const void*)k_mega, hipFuncAttributeMaxDynamicSharedMemorySize, SMEM_TOTAL);
        int dev = 0, cus = 0, per_cu = 0;
        hipGetDevice(&dev);
        hipDeviceGetAttribute(&cus, hipDeviceAttributeMultiprocessorCount, dev);
        hipOccupancyMaxActiveBlocksPerMultiprocessor(&per_cu, (const void*)k_mega, NTHR, SMEM_TOTAL);
        if (per_cu < 1) per_cu = 1;
        grid = cus * (per_cu < 2 ? per_cu : 2);
    }
    hipMemsetAsync(p.ws + OFF_BAR, 0, ZERO_BYTES, stream);
    k_mega<<<grid, NTHR, SMEM_TOTAL, stream>>>(p);
}
```

```cpp
#include <hip/hip_runtime.h>
#include <hip/hip_bf16.h>
#include <stdint.h>
#include <stdio.h>

#ifndef MK_MULTI
#define MK_MULTI 0
#endif

typedef __attribute__((ext_vector_type(8))) short bf16x8;
typedef __attribute__((ext_vector_type(4))) short bf16x4;
typedef __attribute__((ext_vector_type(4))) float f32x4;
typedef unsigned short u16;
typedef __attribute__((ext_vector_type(4))) unsigned u32x4;

#ifndef PROBE_DUP
#define PROBE_DUP -1
#endif
#define NTHR 256
__device__ __forceinline__ int opaque_tid() { int t = (int)threadIdx.x; asm volatile("" : "+v"(t)); return t; }
#define TIDX opaque_tid()
#define LDS_BYTES 65536

#define D_MODEL 1024
#define BATCH 8
#define SEQ 2048
#define CTXL 256
#define NLAT (BATCH * SEQ)
#define NCTX (BATCH * CTXL)
#define NROWS (NLAT + NCTX)
#define INW 1280
#define NEXP 64
#define VT_LD (SEQ + CTXL)
#define NCHUNK_LAT 1024
#define NCHUNK_ALL 1152
#define EPS 1e-6f

#define XB_TMO      128
#define XB_XCNT(j)  (256  + 64 * (j))
#define XB_XSUB(j)  (1280 + 64 * (j))
#define XB_XGEN(j)  (2304 + 64 * (j))
#define XB_TOP      3328
#define XB_TOPGEN   3392
#define XCD_BAR_WORDS 3456
#define XB_SPIN_CAP (1u << 20)
#define LAS __attribute__((address_space(3)))

__device__ __forceinline__ unsigned xb_ld(unsigned* p)              { return __hip_atomic_load(p, __ATOMIC_RELAXED, __HIP_MEMORY_SCOPE_AGENT); }
__device__ __forceinline__ unsigned xb_add(unsigned* p, unsigned v) { return __hip_atomic_fetch_add(p, v, __ATOMIC_RELAXED, __HIP_MEMORY_SCOPE_AGENT); }
__device__ __forceinline__ unsigned xb_xcc_id() { return (unsigned)__builtin_amdgcn_s_getreg((3 << 11) | 20) & 0xFu; }
#define XB_SPIN(cond, bar) do { unsigned _sp = 0; while (cond) { __builtin_amdgcn_s_sleep(1); \
    if ((++_sp & 255u) == 0u) { if (xb_ld(&(bar)[XB_TMO])) break; if (_sp > XB_SPIN_CAP) { atomicAdd(&(bar)[XB_TMO], 1u); break; } } } } while (0)

struct XcdBarrier { unsigned* bar; unsigned x; volatile LAS unsigned* st; };

__device__ __forceinline__ XcdBarrier xcd_barrier_post(unsigned* bar, volatile LAS unsigned* st) {
    XcdBarrier b; b.bar = bar; b.x = xb_xcc_id(); b.st = st;
    if (TIDX == 0) (void)xb_add(&bar[XB_XCNT(b.x)], 1u);
    return b;
}
__device__ __forceinline__ void xcd_barrier_complete(unsigned* bar, unsigned x, unsigned& nloc, unsigned& nx) {
    const unsigned G = gridDim.x * gridDim.y * gridDim.z;
    unsigned sum, cnt, mine, sp = 0u;
    for (;;) {
        sum = 0u; cnt = 0u; mine = 0u;
#pragma unroll
        for (unsigned j = 0; j < 16; ++j) { const unsigned c = xb_ld(&bar[XB_XCNT(j)]); sum += c; cnt += (c > 0u) ? 1u : 0u; mine = (j == x) ? c : mine; }
        if (sum == G) break;
        __builtin_amdgcn_s_sleep(1);
        if ((++sp & 255u) == 0u) { if (xb_ld(&bar[XB_TMO])) break; if (sp > XB_SPIN_CAP) { atomicAdd(&bar[XB_TMO], 1u); break; } }
    }
    nloc = mine > 0u ? mine : 1u; nx = cnt > 0u ? cnt : 1u;
}
__device__ __forceinline__ void xcd_barrier(const XcdBarrier& b) {
    asm volatile("s_waitcnt vmcnt(0)" ::: "memory");
    __syncthreads();
    if (TIDX == 0) {
        unsigned* bar = b.bar;
        __builtin_amdgcn_s_waitcnt(0);
        unsigned nloc = b.st[0], nx = b.st[1];
        if (nloc == 0u) { xcd_barrier_complete(bar, b.x, nloc, nx); b.st[0] = nloc; b.st[1] = nx; }
        const unsigned old = xb_add(&bar[XB_XSUB(b.x)], 1u);
        const unsigned gen = old / nloc;
        if (old + 1u == (gen + 1u) * nloc) {
            __builtin_amdgcn_fence(__ATOMIC_RELEASE, "agent");
            asm volatile("s_waitcnt vmcnt(0)" ::: "memory");
            const unsigned og = xb_add(&bar[XB_TOP], 1u);
            const unsigned tg = og / nx;
            if (og + 1u == (tg + 1u) * nx) xb_add(&bar[XB_TOPGEN], 1u);
            else XB_SPIN(xb_ld(&bar[XB_TOPGEN]) == tg, bar);
            __builtin_amdgcn_fence(__ATOMIC_ACQUIRE, "agent");
            xb_add(&bar[XB_XGEN(b.x)], 1u);
            asm volatile("s_waitcnt vmcnt(0)" ::: "memory");
        } else {
            XB_SPIN(xb_ld(&bar[XB_XGEN(b.x)]) == gen, bar);
            __builtin_amdgcn_fence(__ATOMIC_ACQUIRE, "agent");
            asm volatile("s_waitcnt vmcnt(0)" ::: "memory");
        }
    }
    __syncthreads();
}

struct Params {
    const float *x, *c, *ctx, *c_ctx, *w_ada, *b_ada, *norm_mix, *norm_ffn, *w_in, *attn_sink,
        *a_re, *a_im, *log_dt, *b_re, *b_im, *c_re, *c_im, *ssm_d, *w_glu, *b_glu, *norm_attn_out, *norm_ssm_out,
        *w_out, *w_router, *router_bias, *w_gate_e, *w_up_e, *w_down_e, *w_gate_s, *w_up_s, *w_down_s, *norm_final;
    float* out;
    char* ws;
};

constexpr size_t A256(size_t v) { return (v + 255) & ~(size_t)255; }
constexpr size_t OFF_BAR   = 0;
constexpr size_t OFF_RSQ   = A256(OFF_BAR + XCD_BAR_WORDS * 4 + 1024);
#define FLAG_PER_CLASS 1280
constexpr size_t OFF_FLAG  = OFF_RSQ + (size_t)NLAT * 2 * 4;
constexpr size_t ZERO_BYTES = OFF_FLAG + (8 * FLAG_PER_CLASS + 64) * 4;
constexpr size_t OFF_MOD   = A256(ZERO_BYTES);
constexpr size_t OFF_ROPE  = A256(OFF_MOD + 9 * 6144 * 4);
constexpr size_t OFF_KBUF  = A256(OFF_ROPE + 64 * 16 * 8);
constexpr size_t OFF_ELIST = A256(OFF_KBUF + (size_t)32 * 2 * 4096 * 4);
constexpr size_t OFF_WSL   = A256(OFF_ELIST + (size_t)2 * 64 * 8192 * 4);
constexpr size_t OFF_WDT   = A256(OFF_WSL + (size_t)2 * 64 * 8192 * 4);
constexpr size_t OFF_HHS   = A256(OFF_WDT + (size_t)65 * 1024 * 128 * 2);
constexpr size_t OFF_WGUT  = A256(OFF_HHS + (size_t)2 * 73728 * 128 * 2);
constexpr size_t OFF_H2R   = A256(OFF_WGUT + (size_t)65 * 256 * 1024 * 2);
constexpr size_t OFF_ARENA = A256(OFF_H2R + (size_t)NLAT * 1024 * 2);
constexpr size_t OFF_TABS  = OFF_ARENA;
constexpr size_t OFF_TABY  = A256(OFF_TABS + (size_t)32 * 256 * 256 * 2);
constexpr size_t OFF_R1    = A256(OFF_TABY + (size_t)32 * 256 * 512 * 2);
constexpr size_t OFF_R2    = A256(OFF_R1 + (size_t)NROWS * 1024 * 2);
constexpr size_t OFF_R4    = A256(OFF_R2 + (size_t)NLAT * 1024 * 2);
constexpr size_t OFF_WINT  = A256(OFF_R4 + (size_t)NLAT * 512 * 2 * 2);
constexpr size_t OFF_WGLUT = A256(OFF_WINT + (size_t)1280 * 1024 * 2);
constexpr size_t OFF_WOUTT = A256(OFF_WGLUT + (size_t)512 * 512 * 2);
constexpr size_t OFF_WRT   = A256(OFF_WOUTT + (size_t)1024 * 1024 * 2);
constexpr size_t OFF_EARLY_END = A256(OFF_WRT + (size_t)128 * 1024 * 2);
constexpr size_t YD8_BYTES = (size_t)NLAT * 8 * 1024;
constexpr size_t OFF_END   = (OFF_EARLY_END > OFF_ARENA + YD8_BYTES) ? OFF_EARLY_END : A256(OFF_ARENA + YD8_BYTES);
static_assert(OFF_END <= (size_t)256 * 1024 * 1024, "workspace map must fit the guaranteed 256 MiB");
#define WSP_bar   ((unsigned*)(p.ws + OFF_BAR))
#define WSP_ctr   ((unsigned*)(p.ws + OFF_BAR) + XCD_BAR_WORDS)
#define WSP_rsq   ((float*)(p.ws + OFF_RSQ))
#define WSP_flag  ((unsigned*)(p.ws + OFF_FLAG))
#define WSP_mod   ((float*)(p.ws + OFF_MOD))
#define WSP_rope  ((float2*)(p.ws + OFF_ROPE))
#define WSP_Kbuf  ((float*)(p.ws + OFF_KBUF))
#define WSP_elist ((int*)(p.ws + OFF_ELIST))
#define WSP_wsl   ((float*)(p.ws + OFF_WSL))
#define WSP_WinT  ((u16*)(p.ws + OFF_WINT))
#define WSP_WgluT ((u16*)(p.ws + OFF_WGLUT))
#define WSP_WoutT ((u16*)(p.ws + OFF_WOUTT))
#define WSP_WrT   ((u16*)(p.ws + OFF_WRT))
#define WSP_WdT   ((u16*)(p.ws + OFF_WDT))
#define WSP_HHs   ((u16*)(p.ws + OFF_HHS))
#define WSP_WguT  ((u16*)(p.ws + OFF_WGUT))
#define WSP_TabS  ((u16*)(p.ws + OFF_TABS))
#define WSP_TabY  ((u16*)(p.ws + OFF_TABY))
#define WSP_Hb    ((u16*)(p.ws + OFF_R1))
#define WSP_S     ((float*)(p.ws + OFF_R1))
#define WSP_H2    ((u16*)(p.ws + OFF_H2R))
#define WSP_Q     ((u16*)(p.ws + OFF_R2))
#define WSP_Kb    ((u16*)(p.ws + OFF_R2 + (size_t)NLAT * 512 * 2))
#define WSP_Vt    ((u16*)(p.ws + OFF_R2 + (size_t)NLAT * 512 * 2 + (size_t)NROWS * 128 * 2))
#define WSP_Y     ((u16*)(p.ws + OFF_R2))
#define WSP_SO    ((u16*)(p.ws + OFF_R2 + (size_t)NLAT * 512 * 2))
#define WSP_U     ((u16*)(p.ws + OFF_H2R))
#define WSP_AO    ((u16*)(p.ws + OFF_R4))
#define WSP_Hin   ((u16*)(p.ws + OFF_R4 + (size_t)NLAT * 512 * 2))

extern __shared__ __attribute__((aligned(16))) char smem[];

typedef __bf16 bf2_t __attribute__((ext_vector_type(2)));
typedef float f2_t __attribute__((ext_vector_type(2)));
__device__ __forceinline__ unsigned pack2(float a, float b) {
    const f2_t v = {a, b};
    return __builtin_bit_cast(unsigned, __builtin_convertvector(v, bf2_t));
}
__device__ __forceinline__ u16 f2bf(float f) { return (u16)(pack2(f, 0.f) & 0xffffu); }
__device__ __forceinline__ float bf2f(u16 h) { return __uint_as_float(((unsigned)h) << 16); }
__device__ __forceinline__ void glds16(const void* g, void* l) {
    __builtin_amdgcn_global_load_lds((const unsigned*)g, (unsigned*)l, 16, 0, 0);
}
__device__ __forceinline__ void glds16_sc1(const void* g, void* l) {
    __builtin_amdgcn_global_load_lds((const unsigned*)g, (unsigned*)l, 16, 0, 16);
}
__device__ __forceinline__ int lds_byte(int r, int c) {
    int st = (r >> 4) * 2 + (c >> 5), rr = r & 15, cc = c & 31, ob = rr * 64 + cc * 2;
    return st * 1024 + (ob ^ (((ob >> 9) & 1) << 5));
}
template <int CTRL> __device__ __forceinline__ float dppf(float v) {
    return __int_as_float(__builtin_amdgcn_update_dpp(0, __float_as_int(v), CTRL, 0xf, 0xf, true));
}
__device__ __forceinline__ float sum_x16(float v) {
    const unsigned u = __float_as_uint(v);
    const auto r = __builtin_amdgcn_permlane16_swap(u, u, false, false);
    return __uint_as_float(r[0]) + __uint_as_float(r[1]);
}
__device__ __forceinline__ float sum_x32(float v) {
    const unsigned u = __float_as_uint(v);
    const auto r = __builtin_amdgcn_permlane32_swap(u, u, false, false);
    return __uint_as_float(r[0]) + __uint_as_float(r[1]);
}
__device__ __forceinline__ float max_x16(float v) {
    const unsigned u = __float_as_uint(v);
    const auto r = __builtin_amdgcn_permlane16_swap(u, u, false, false);
    return fmaxf(__uint_as_float(r[0]), __uint_as_float(r[1]));
}
__device__ __forceinline__ float max_x32(float v) {
    const unsigned u = __float_as_uint(v);
    const auto r = __builtin_amdgcn_permlane32_swap(u, u, false, false);
    return fmaxf(__uint_as_float(r[0]), __uint_as_float(r[1]));
}
__device__ __forceinline__ float sum16(float v) {
    v += dppf<0xB1>(v);
    v += dppf<0x4E>(v);
    v += dppf<0x141>(v);
    v += dppf<0x140>(v);
    return v;
}
__device__ __forceinline__ float wave_sum(float v) { return sum_x32(sum_x16(sum16(v))); }
template <int CTRL> __device__ __forceinline__ float dpp_f(float v) {
    return __int_as_float(__builtin_amdgcn_update_dpp(0, __float_as_int(v), CTRL, 0xf, 0xf, true));
}
__device__ __forceinline__ float max8(float v) {
    v = fmaxf(v, dpp_f<0xB1>(v));
    v = fmaxf(v, dpp_f<0x4E>(v));
    v = fmaxf(v, dpp_f<0x141>(v));
    return v;
}
__device__ __forceinline__ float sigmoidf_(float x) { return __builtin_amdgcn_rcpf(1.f + __expf(-x)); }
__device__ __forceinline__ float siluf_(float x) { return x * __builtin_amdgcn_rcpf(1.f + __expf(-x)); }
__device__ __forceinline__ float gelu_tanh(float x) {
    float u = 0.7978845608028654f * (x + 0.044715f * x * x * x);
    return x * __builtin_amdgcn_rcpf(1.f + __expf(-2.f * u));
}

template <class FA, class FB>
__device__ __forceinline__ void gemm_tile(int nkt, FA fa, FB fb, f32x4 (&acc)[4][4]) {
    const int tid = TIDX, lane = tid & 63, wid = tid >> 6, wr = wid >> 1, wc = wid & 1, fr = lane & 15, fq = lane >> 4;
    const int sb = lane * 16, swz = sb ^ (((sb >> 9) & 1) << 5);
    const int r_in = swz >> 6, c_in = (swz & 63) >> 1;
#pragma unroll
    for (int m = 0; m < 4; ++m)
#pragma unroll
        for (int n = 0; n < 4; ++n) acc[m][n] = (f32x4){0.f, 0.f, 0.f, 0.f};
    __syncthreads();
    auto stage = [&](int kt, int s) {
        char* sa = smem + s * 32768;
        char* sbm = sa + 16384;
#pragma unroll
        for (int i = 0; i < 4; ++i) {
            const int st = wid + 4 * i, R = (st >> 1) * 16 + r_in, C = (st & 1) * 32 + c_in;
            glds16(fa(R, C, kt), sa + tid * 16 + i * 4096);
            glds16(fb(R, C, kt), sbm + tid * 16 + i * 4096);
        }
    };
    stage(0, 0);
    for (int kt = 0; kt < nkt; ++kt) {
        asm volatile("s_waitcnt vmcnt(0)" ::: "memory");
        __syncthreads();
        if (kt + 1 < nkt) stage(kt + 1, (kt + 1) & 1);
        const char* sa = smem + (kt & 1) * 32768;
        const char* sbm = sa + 16384;
#pragma unroll
        for (int ks = 0; ks < 2; ++ks) {
            bf16x8 a[4], b[4];
#pragma unroll
            for (int m = 0; m < 4; ++m) a[m] = *(const bf16x8*)(sa + lds_byte(wr * 64 + m * 16 + fr, ks * 32 + fq * 8));
#pragma unroll
            for (int n = 0; n < 4; ++n) b[n] = *(const bf16x8*)(sbm + lds_byte(wc * 64 + n * 16 + fr, ks * 32 + fq * 8));
#pragma unroll
            for (int m = 0; m < 4; ++m)
#pragma unroll
                for (int n = 0; n < 4; ++n) acc[m][n] = __builtin_amdgcn_mfma_f32_16x16x32_bf16(a[m], b[n], acc[m][n], 0, 0, 0);
        }
    }
    __syncthreads();
}

__device__ __forceinline__ int lds32(int r, int c) {
    const int rr = r & 15;
    return (r >> 4) * 1024 + ((rr * 64 + c * 2) ^ (((rr >> 3) & 1) << 5));
}
struct NoHook { __device__ __forceinline__ void operator()(int) const {} };
template <bool A_SC1 = false, class FA, class FB, class HK = NoHook>
__device__ __forceinline__ void gemm_tile_w(int nkt, FA fa, FB fb, f32x4 (&acc)[4][8], HK hook = HK()) {
    constexpr bool ZERO = true;
    const int tid = TIDX, lane = tid & 63, wid = tid >> 6, wr = wid >> 1, wc = wid & 1, fr = lane & 15, fq = lane >> 4;
    const int sb = lane * 16, swz = sb ^ (((sb >> 9) & 1) << 5);
    const int r_in = swz >> 6, c_in = (swz & 63) >> 1;
    if (ZERO) {
#pragma unroll
        for (int m = 0; m < 4; ++m)
#pragma unroll
            for (int n = 0; n < 8; ++n) acc[m][n] = (f32x4){0.f, 0.f, 0.f, 0.f};
    }
    __syncthreads();
    auto stage = [&](int kt, int s) {
        char* sa = smem + s * 24576;
#pragma unroll
        for (int i = 0; i < 2; ++i) { if (A_SC1) glds16_sc1(fa(i, (wid + 4 * i) * 16 + r_in, c_in, kt), sa + tid * 16 + i * 4096); else glds16(fa(i, (wid + 4 * i) * 16 + r_in, c_in, kt), sa + tid * 16 + i * 4096); }
#pragma unroll
        for (int i = 0; i < 4; ++i) glds16(fb(i, (wid + 4 * i) * 16 + r_in, c_in, kt), sa + 8192 + tid * 16 + i * 4096);
    };
    stage(0, 0);
    if (nkt > 1) stage(1, 1);
    int s_cur = 0, s_nxt = 2;
    for (int kt = 0; kt < nkt; ++kt) {
        hook(kt);
        if (kt + 1 < nkt) asm volatile("s_waitcnt vmcnt(6) lgkmcnt(0)\n\ts_barrier" ::: "memory");
        else asm volatile("s_waitcnt vmcnt(0) lgkmcnt(0)\n\ts_barrier" ::: "memory");
        if (kt + 2 < nkt) stage(kt + 2, s_nxt);
        const char* sa = smem + s_cur * 24576;
        bf16x8 a[4];
#pragma unroll
        for (int m = 0; m < 4; ++m) a[m] = *(const bf16x8*)(sa + lds32(wr * 64 + m * 16 + fr, fq * 8));
#pragma unroll
        for (int nh = 0; nh < 2; ++nh) {
            bf16x8 b[4];
#pragma unroll
            for (int n = 0; n < 4; ++n) b[n] = *(const bf16x8*)(sa + 8192 + lds32(wc * 128 + (nh * 4 + n) * 16 + fr, fq * 8));
#pragma unroll
            for (int m = 0; m < 4; ++m)
#pragma unroll
                for (int n = 0; n < 4; ++n) acc[m][nh * 4 + n] = __builtin_amdgcn_mfma_f32_16x16x32_bf16(a[m], b[n], acc[m][nh * 4 + n], 0, 0, 0);
        }
        s_cur = (s_cur == 2) ? 0 : s_cur + 1;
        s_nxt = (s_nxt == 2) ? 0 : s_nxt + 1;
    }
    __syncthreads();
}

template <class FV, class FD>
__device__ __forceinline__ void wave_store_bf16_f(FV val, FD dst, bool write_through = false, const char* wt_base = nullptr, unsigned wt_bytes = 0) {
    const __amdgpu_buffer_rsrc_t wt_rsrc = __builtin_amdgcn_make_buffer_rsrc((void*)wt_base, 0, (int)wt_bytes, 0x00020000);
    const int lane = TIDX & 63, wid = TIDX >> 6, fr = lane & 15, fq = lane >> 4;
    char* base = smem + wid * 9216;
#pragma unroll
    for (int m = 0; m < 4; ++m)
#pragma unroll
        for (int n = 0; n < 4; ++n)
#pragma unroll
            for (int j = 0; j < 4; ++j)
                *(u16*)(base + (m * 16 + fq * 4 + j) * 144 + (n * 16 + fr) * 2) = f2bf(val(m, n, j));
    asm volatile("s_waitcnt lgkmcnt(0)" ::: "memory");
    __builtin_amdgcn_wave_barrier();
#pragma unroll
    for (int i = 0; i < 8; ++i) {
        const int id = i * 64 + lane, row = id >> 3, ch = id & 7;
        const uint4 d = *(const uint4*)(base + row * 144 + ch * 16);
        u16* p = dst(row);
        if (p) {
            if (write_through) {
                const u32x4 dv = {d.x, d.y, d.z, d.w};
                __builtin_amdgcn_raw_buffer_store_b128(dv, wt_rsrc, (int)((const char*)(p + ch * 8) - wt_base), 0, 16);
            } else *(uint4*)(p + ch * 8) = d;
        }
    }
    asm volatile("s_waitcnt lgkmcnt(0)" ::: "memory");
    __builtin_amdgcn_wave_barrier();
}

template <class FD>
__device__ __forceinline__ void wave_store_bf16(const float (&v)[4][4][4], FD dst) {
    wave_store_bf16_f([&](int m, int n, int j) { return v[m][n][j]; }, dst);
}

struct ConvD { const float* src; u16* dst; int ld, ldd, k0, n0, mode, zr; };
__device__ __forceinline__ void conv_load(const Params& p, const ConvD& d, float (&v)[16]) {
    const int tid = TIDX;
#pragma unroll
    for (int i = 0; i < 16; ++i) v[i] = d.src[(size_t)(d.k0 + i * 4 + (tid >> 6)) * d.ld + d.n0 + (tid & 63)];
    if (d.zr == 2) {
#pragma unroll
        for (int i = 0; i < 16; ++i) {
            const int k = d.k0 + i * 4 + (tid >> 6);
            v[i] *= (k < 512) ? p.norm_attn_out[k] : p.norm_ssm_out[k - 512];
        }
    }
}
__device__ __forceinline__ void conv_store(const Params& p, const ConvD& d, const float (&v)[16]) {
    float* t = (float*)smem;
    const int tid = TIDX;
    __syncthreads();
#pragma unroll
    for (int i = 0; i < 16; ++i) t[(i * 4 + (tid >> 6)) * 65 + (tid & 63)] = v[i];
    __syncthreads();
    const int n = tid >> 2, kq = tid & 3;
    unsigned w[8];
#pragma unroll
    for (int i = 0; i < 8; ++i) w[i] = pack2(t[(kq * 16 + 2 * i) * 65 + n], t[(kq * 16 + 2 * i + 1) * 65 + n]);
    const int gn = d.n0 + n;
    int row = gn;
    if (d.mode == 1) row = (gn >> 4) * 32 + (gn & 15);
    else if (d.mode == 2) row = (gn >> 4) * 32 + 16 + (gn & 15);
    else if (d.mode == 3) row = n;
    uint4* o = (uint4*)(d.dst + (size_t)row * d.ldd + d.k0 + kq * 16);
    o[0] = make_uint4(w[0], w[1], w[2], w[3]);
    o[1] = make_uint4(w[4], w[5], w[6], w[7]);
    if (d.zr == 1) {
        uint4* z = (uint4*)(WSP_WrT + (size_t)(64 + n) * 1024 + d.k0 + kq * 16);
        z[0] = make_uint4(0, 0, 0, 0); z[1] = make_uint4(0, 0, 0, 0);
    }
}

__device__ __forceinline__ void ada_item(const Params& p, int item) {
    float* sc = (float*)smem;
    float* red = sc + 9 * 1024;
    const int tid = TIDX;
    __syncthreads();
    for (int i = tid; i < 9 * 1024; i += NTHR) {
        const int r = i >> 10, k = i & 1023;
        const float cv = (r < 8) ? p.c[r * 1024 + k] : p.c_ctx[k];
        sc[i] = siluf_(cv);
    }
    __syncthreads();
    const int kq = tid >> 6, jl = tid & 63, j = item * 64 + jl;
    float acc[9];
#pragma unroll
    for (int r = 0; r < 9; ++r) acc[r] = 0.f;
#pragma unroll 16
    for (int k = kq; k < 1024; k += 4) {
        const float w = p.w_ada[(size_t)k * 6144 + j];
#pragma unroll
        for (int r = 0; r < 9; ++r) acc[r] += sc[r * 1024 + k] * w;
    }
#pragma unroll
    for (int r = 0; r < 9; ++r) red[(kq * 9 + r) * 64 + jl] = acc[r];
    __syncthreads();
    for (int i = tid; i < 9 * 64; i += NTHR) {
        const int r = i >> 6, l = i & 63;
        const float s = red[(0 * 9 + r) * 64 + l] + red[(1 * 9 + r) * 64 + l] + red[(2 * 9 + r) * 64 + l] + red[(3 * 9 + r) * 64 + l];
        WSP_mod[r * 6144 + item * 64 + l] = s + p.b_ada[item * 64 + l];
    }
}

__device__ __forceinline__ void rope_item(const Params& p) {
    for (int i = TIDX; i < 64 * 16; i += NTHR) {
        const int pos = i >> 4, k = i & 15;
        const float inv = exp2f(-(float)k * (13.287712379549449f / 16.f));
        float s, c;
        sincosf((float)pos * inv, &s, &c);
        WSP_rope[i] = make_float2(c, s);
    }
}

__device__ __forceinline__ void ssm_table_item(const Params& p, int g, int dir) {
    float* pw = (float*)smem;
    float* Bb = pw + 17 * 64 * 2;
    float* Cc = Bb + 64 * 16 * 2;
    const int tid = TIDX;
    u16* tabS = WSP_TabS + (size_t)g * 256 * 256;
    u16* tabY = WSP_TabY + (size_t)g * 256 * 512;
    float* Kf = WSP_Kbuf + (size_t)(g * 2 + dir) * 4096;
    __syncthreads();
    {
        const int pidx = dir * 32 + g;
        const float dt = __expf(p.log_dt[pidx]);
        for (int i = tid; i < 17 * 64; i += NTHR) {
            const int tau = i >> 6, n = i & 63;
            const float are = p.a_re[pidx * 64 + n], aim = p.a_im[pidx * 64 + n];
            const float mag = __expf((float)tau * dt * are);
            float rev = (float)tau * (dt * aim * 0.15915494309189535f);
            rev -= rintf(rev);
            pw[i * 2] = mag * __builtin_amdgcn_cosf(rev);
            pw[i * 2 + 1] = mag * __builtin_amdgcn_sinf(rev);
        }
        __syncthreads();
        for (int i = tid; i < 64 * 16; i += NTHR) {
            const int n = i >> 4;
            const float are = p.a_re[pidx * 64 + n], aim = p.a_im[pidx * 64 + n];
            const float abr = pw[(64 + n) * 2], abi = pw[(64 + n) * 2 + 1];
            const float den = are * are + aim * aim, nre = abr - 1.f;
            const float cre = (nre * are + abi * aim) / den, cim = (abi * are - nre * aim) / den;
            const float br = p.b_re[(size_t)pidx * 1024 + i], bi = p.b_im[(size_t)pidx * 1024 + i];
            Bb[i * 2] = cre * br - cim * bi;
            Bb[i * 2 + 1] = cre * bi + cim * br;
            Cc[i * 2] = p.c_re[(size_t)pidx * 1024 + i];
            Cc[i * 2 + 1] = p.c_im[(size_t)pidx * 1024 + i];
        }
        __syncthreads();
        {
            const int tau = tid >> 4, pp = tid & 15;
            float s[16];
#pragma unroll
            for (int q = 0; q < 16; ++q) s[q] = 0.f;
            for (int n = 0; n < 64; ++n) {
                const float2 cv = *(const float2*)&Cc[(pp * 64 + n) * 2];
                const float2 wv = *(const float2*)&pw[(tau * 64 + n) * 2];
                const float zr = cv.x * wv.x - cv.y * wv.y, zi = cv.x * wv.y + cv.y * wv.x;
#pragma unroll
                for (int q = 0; q < 16; ++q) {
                    const float2 bv = *(const float2*)&Bb[(n * 16 + q) * 2];
                    s[q] += zr * bv.x - zi * bv.y;
                }
            }
#pragma unroll
            for (int q = 0; q < 4; ++q)
                *(float4*)(Kf + tau * 256 + pp * 16 + q * 4) = make_float4(s[4 * q], s[4 * q + 1], s[4 * q + 2], s[4 * q + 3]);
        }
        for (int id = tid; id < 128 * 32; id += NTHR) {
            const int rr = id >> 5, ch = id & 31, cpart = rr >> 6, n = rr & 63, s_ = ch >> 1, q0 = (ch & 1) * 8;
            const int e = dir == 0 ? 15 - s_ : s_;
            const float wr_ = pw[(e * 64 + n) * 2], wi_ = pw[(e * 64 + n) * 2 + 1];
            unsigned w[4];
#pragma unroll
            for (int i = 0; i < 4; ++i) {
                float v[2];
#pragma unroll
                for (int h = 0; h < 2; ++h) {
                    const float br = Bb[(n * 16 + q0 + 2 * i + h) * 2], bi = Bb[(n * 16 + q0 + 2 * i + h) * 2 + 1];
                    v[h] = cpart == 0 ? (wr_ * br - wi_ * bi) : (wr_ * bi + wi_ * br);
                }
                w[i] = pack2(v[0], v[1]);
            }
            *(uint4*)(tabS + (size_t)(dir * 128 + rr) * 256 + s_ * 16 + q0) = make_uint4(w[0], w[1], w[2], w[3]);
        }
        for (int id = tid; id < 256 * 16; id += NTHR) {
            const int m = id >> 4, ch = id & 15, t = m >> 4, pp = m & 15, cpart = ch >> 3, n0 = (ch & 7) * 8;
            const int e = dir == 0 ? t + 1 : 16 - t;
            unsigned w[4];
#pragma unroll
            for (int i = 0; i < 4; ++i) {
                float v[2];
#pragma unroll
                for (int h = 0; h < 2; ++h) {
                    const int n = n0 + 2 * i + h;
                    const float cr = Cc[(pp * 64 + n) * 2], ci = Cc[(pp * 64 + n) * 2 + 1];
                    const float wr_ = pw[(e * 64 + n) * 2], wi_ = pw[(e * 64 + n) * 2 + 1];
                    v[h] = cpart == 0 ? (cr * wr_ - ci * wi_) : -(cr * wi_ + ci * wr_);
                }
                w[i] = pack2(v[0], v[1]);
            }
            *(uint4*)(tabY + (size_t)m * 512 + 256 + dir * 128 + cpart * 64 + n0) = make_uint4(w[0], w[1], w[2], w[3]);
        }
    }
}

__device__ __forceinline__ void ssm_toeplitz_item(const Params& p, int g) {
    float* Kf = (float*)smem;
    const int tid = TIDX;
    u16* tabY = WSP_TabY + (size_t)g * 256 * 512;
    __syncthreads();
    for (int i = tid; i < 2048; i += NTHR) ((float4*)Kf)[i] = ((const float4*)(WSP_Kbuf + (size_t)g * 8192))[i];
    __syncthreads();
    for (int id = tid; id < 256 * 32; id += NTHR) {
        const int m = id >> 5, ch = id & 31, t = m >> 4, pp = m & 15, s_ = ch >> 1, q0 = (ch & 1) * 8;
        unsigned w[4];
#pragma unroll
        for (int i = 0; i < 4; ++i) {
            float v[2];
#pragma unroll
            for (int h = 0; h < 2; ++h) {
                const int q = q0 + 2 * i + h;
                float val;
                if (s_ < t) val = Kf[((t - s_) * 16 + pp) * 16 + q];
                else if (s_ > t) val = Kf[4096 + ((s_ - t) * 16 + pp) * 16 + q];
                else val = Kf[(pp) * 16 + q] + Kf[4096 + pp * 16 + q] + (pp == q ? p.ssm_d[g * 16 + pp] : 0.f);
                v[h] = val;
            }
            w[i] = pack2(v[0], v[1]);
        }
        *(uint4*)(tabY + (size_t)m * 512 + s_ * 16 + q0) = make_uint4(w[0], w[1], w[2], w[3]);
    }
    __syncthreads();
}

#define N_CONV 6896
__device__ __forceinline__ ConvD conv_decode(const Params& p, int t) {
    ConvD d; d.mode = 0; d.zr = 0;
    if (t < 320) { d.src = p.w_in; d.ld = 1280; d.k0 = (t / 20) * 64; d.n0 = (t % 20) * 64; d.dst = WSP_WinT; d.ldd = 1024; return d; }
    t -= 320;
    if (t < 64) { d.src = p.w_glu; d.ld = 512; d.k0 = (t / 8) * 64; d.n0 = (t % 8) * 64; d.dst = WSP_WgluT; d.ldd = 512; return d; }
    t -= 64;
    if (t < 256) { d.src = p.w_out; d.ld = 1024; d.k0 = (t / 16) * 64; d.n0 = (t % 16) * 64; d.dst = WSP_WoutT; d.ldd = 1024; d.zr = 2; return d; }
    t -= 256;
    if (t < 16) { d.src = p.w_router; d.ld = 64; d.k0 = t * 64; d.n0 = 0; d.dst = WSP_WrT; d.ldd = 1024; d.zr = 1; return d; }
    t -= 16;
    if (t < 4096) {
        const int up = t >= 2048; const int tt = t & 2047, e = tt >> 5, r = tt & 31;
        d.src = (up ? p.w_up_e : p.w_gate_e) + (size_t)e * 131072; d.ld = 128; d.k0 = (r >> 1) * 64; d.n0 = (r & 1) * 64;
        d.dst = WSP_WguT + (size_t)e * 262144; d.ldd = 1024; d.mode = 1 + up; return d;
    }
    t -= 4096;
    if (t < 64) {
        const int up = t >= 32; const int r = t & 31;
        d.src = up ? p.w_up_s : p.w_gate_s; d.ld = 128; d.k0 = (r >> 1) * 64; d.n0 = (r & 1) * 64;
        d.dst = WSP_WguT + (size_t)64 * 262144; d.ldd = 1024; d.mode = 1 + up; return d;
    }
    t -= 64;
    if (t < 2048) { const int e = t >> 5, r = t & 31; d.src = p.w_down_e + (size_t)e * 131072; d.ld = 1024; d.k0 = (r >> 4) * 64; d.n0 = (r & 15) * 64; d.dst = WSP_WdT + (size_t)e * 131072; d.ldd = 128; return d; }
    t -= 2048;
    d.src = p.w_down_s; d.ld = 1024; d.k0 = (t >> 4) * 64; d.n0 = (t & 15) * 64; d.dst = WSP_WdT + (size_t)64 * 131072; d.ldd = 128; return d;
}

#define N_CONV_EARLY 4000
__device__ __forceinline__ void conv_range(const Params& p, int t0, int stride, int tend, int tbeg = 0) {
    int t = tbeg + t0;
    if (t < tend) {
        ConvD d = conv_decode(p, t);
        float v[16];
        conv_load(p, d, v);
        while (t < tend) {
            const int tn = t + stride;
            ConvD dn = d;
            float vn[16];
            if (tn < tend) { dn = conv_decode(p, tn); conv_load(p, dn, vn); }
            conv_store(p, d, v);
            d = dn;
#pragma unroll
            for (int i = 0; i < 16; ++i) v[i] = vn[i];
            t = tn;
        }
    }
}
#define P0_CONV_B0 161
__device__ __forceinline__ void phase0(const Params& p) {
    const int b = blockIdx.x, G = gridDim.x;
    if (G > P0_CONV_B0 + 32) {
        if (b < 64) ssm_table_item(p, b >> 1, b & 1);
        else if (b < 160) ada_item(p, b - 64);
        else if (b == 160) rope_item(p);
        else conv_range(p, b - P0_CONV_B0, G - P0_CONV_B0, N_CONV_EARLY);
    } else {
        const int NU = 64 + 96 + 1 + N_CONV_EARLY;
        for (int u = b; u < NU; u += G) {
            if (u < 64) ssm_table_item(p, u >> 1, u & 1);
            else if (u < 160) ada_item(p, u - 64);
            else if (u == 160) rope_item(p);
            else { ConvD d = conv_decode(p, u - 161); float v[16]; conv_load(p, d, v); conv_store(p, d, v); }
        }
    }
}
#if 0
    {
        {
            const int stride = G - P0_CONV_B0;
            int t = b - P0_CONV_B0;
            if (t < N_CONV) {
                ConvD d = conv_decode(p, t);
                float v[16];
                conv_load(p, d, v);
                while (t < N_CONV) {
                    const int tn = t + stride;
                    ConvD dn = d;
                    float vn[16];
                    if (tn < N_CONV) { dn = conv_decode(p, tn); conv_load(p, dn, vn); }
                    conv_store(p, d, v);
                    d = dn;
#pragma unroll
                    for (int i = 0; i < 16; ++i) v[i] = vn[i];
                    t = tn;
                }
            }
        }
    } else {
        const int NU = 64 + 96 + 1 + N_CONV;
        for (int u = b; u < NU; u += G) {
            if (u < 64) ssm_table_item(p, u >> 1, u & 1);
            else if (u < 160) ada_item(p, u - 64);
            else if (u == 160) rope_item(p);
            else { ConvD d = conv_decode(p, u - 161); float v[16]; conv_load(p, d, v); conv_store(p, d, v); }
        }
    }
}

#endif

__device__ __forceinline__ void norm_mod_row(const float* src, const float* gain, const float* sh, const float* scl, u16* dst) {
    const int lane = TIDX & 63;
    float4 v[4];
    float ss = 0.f;
#pragma unroll
    for (int i = 0; i < 4; ++i) {
        v[i] = *(const float4*)(src + i * 256 + lane * 4);
        ss += v[i].x * v[i].x + v[i].y * v[i].y + v[i].z * v[i].z + v[i].w * v[i].w;
    }
    ss = wave_sum(ss);
    const float rs = rsqrtf(ss * (1.f / 1024.f) + EPS);
#pragma unroll
    for (int i = 0; i < 4; ++i) {
        const int c0 = i * 256 + lane * 4;
        const float4 g = *(const float4*)(gain + c0), s = *(const float4*)(sh + c0), k = *(const float4*)(scl + c0);
        const float a = v[i].x * rs * g.x * (1.f + k.x) + s.x, b = v[i].y * rs * g.y * (1.f + k.y) + s.y;
        const float c = v[i].z * rs * g.z * (1.f + k.z) + s.z, d = v[i].w * rs * g.w * (1.f + k.w) + s.w;
        *(uint2*)(dst + c0) = make_uint2(pack2(a, b), pack2(c, d));
    }
}

__device__ __forceinline__ void phase1(const Params& p) {
    const int wv = blockIdx.x * 4 + (TIDX >> 6), nwv = gridDim.x * 4;
    const int lane = TIDX & 63;
    for (int r0 = wv * 4; r0 < NROWS; r0 += nwv * 4) {
        const float* src[4]; const float* md[4];
        float4 v[4][4];
#pragma unroll
        for (int q = 0; q < 4; ++q) {
            const int r = r0 + q;
            if (r < NLAT) { src[q] = p.x + (size_t)r * 1024; md[q] = WSP_mod + (r >> 11) * 6144; }
            else { src[q] = p.ctx + (size_t)(r - NLAT) * 1024; md[q] = WSP_mod + 8 * 6144; }
#pragma unroll
            for (int i = 0; i < 4; ++i) v[q][i] = *(const float4*)(src[q] + i * 256 + lane * 4);
        }
#pragma unroll
        for (int q = 0; q < 4; ++q) {
            float ss = 0.f;
#pragma unroll
            for (int i = 0; i < 4; ++i) ss += v[q][i].x * v[q][i].x + v[q][i].y * v[q][i].y + v[q][i].z * v[q][i].z + v[q][i].w * v[q][i].w;
            ss = wave_sum(ss);
            const float rs = rsqrtf(ss * (1.f / 1024.f) + EPS);
            u16* dst = WSP_Hb + (size_t)(r0 + q) * 1024;
#pragma unroll
            for (int i = 0; i < 4; ++i) {
                const int c0 = i * 256 + lane * 4;
                const float4 g = *(const float4*)(p.norm_mix + c0), s = *(const float4*)(md[q] + c0), k = *(const float4*)(md[q] + 1024 + c0);
                const float a = v[q][i].x * rs * g.x * (1.f + k.x) + s.x, b = v[q][i].y * rs * g.y * (1.f + k.y) + s.y;
                const float c = v[q][i].z * rs * g.z * (1.f + k.z) + s.z, d = v[q][i].w * rs * g.w * (1.f + k.w) + s.w;
                *(uint2*)(dst + c0) = make_uint2(pack2(a, b), pack2(c, d));
            }
        }
    }
}

__device__ __forceinline__ void phase2(const Params& p) {
    const int NU = 128 * 10 + 16 * 6;
    const int lane = TIDX & 63, wid = TIDX >> 6, wr = wid >> 1, wc = wid & 1, fr = lane & 15, fq = lane >> 4;
    for (int u = blockIdx.x; u < NU; u += gridDim.x) {
        int mt, nt;
        {
            const int xc = u & 7, r = u >> 3;
            if (r < 160) { mt = xc + 8 * (r / 10); nt = r % 10; } else { const int v = r - 160; mt = 128 + xc + 8 * (v / 6); nt = 4 + v % 6; }
        }
        const u16* A = WSP_Hb + (size_t)mt * 128 * 1024;
        const u16* B = WSP_WinT + (size_t)nt * 128 * 1024;
        f32x4 acc[4][4];
        gemm_tile(16,
            [&](int R, int C, int kt) { return (const void*)(A + (size_t)R * 1024 + kt * 64 + C); },
            [&](int R, int C, int kt) { return (const void*)(B + (size_t)R * 1024 + kt * 64 + C); }, acc);
        const int row0 = mt * 128 + wr * 64;
        const int col0 = nt * 128 + wc * 64;
        const bool is_lat = mt < 128;
        if (nt == 5) {
            const int kvh = wc;
#pragma unroll
            for (int m = 0; m < 4; ++m) {
                const int r = row0 + m * 16 + fq * 4;
                int b, pos;
                if (is_lat) { b = r >> 11; pos = r & 2047; } else { const int rc = r - NLAT; b = rc >> 8; pos = SEQ + (rc & 255); }
#pragma unroll
                for (int n = 0; n < 4; ++n) {
                    const int d = n * 16 + fr;
                    u16* dst = WSP_Vt + ((size_t)(b * 2 + kvh) * 64 + d) * VT_LD + pos;
                    *(uint2*)dst = make_uint2(pack2(acc[m][n][0], acc[m][n][1]), pack2(acc[m][n][2], acc[m][n][3]));
                }
            }
        } else {
            float v[4][4][4];
            const bool do_rope = is_lat && nt <= 4;
#pragma unroll
            for (int m = 0; m < 4; ++m)
#pragma unroll
                for (int j = 0; j < 4; ++j) {
                    if (do_rope) {
                        const int r = row0 + m * 16 + fq * 4 + j, pos = r & 2047;
                        const float2 cr = WSP_rope[(pos >> 6) * 16 + fr], cc = WSP_rope[(pos & 63) * 16 + fr];
                        const float x1 = acc[m][0][j], x2 = acc[m][1][j], y1 = acc[m][2][j], y2 = acc[m][3][j];
                        v[m][0][j] = x1 * cr.x - x2 * cr.y; v[m][1][j] = x1 * cr.y + x2 * cr.x;
                        v[m][2][j] = y1 * cc.x - y2 * cc.y; v[m][3][j] = y1 * cc.y + y2 * cc.x;
                    } else {
#pragma unroll
                        for (int n = 0; n < 4; ++n) v[m][n][j] = acc[m][n][j];
                    }
                }
            u16* dbase; int ldd;
            if (nt < 4) { dbase = WSP_Q + (size_t)row0 * 512 + col0; ldd = 512; }
            else if (nt == 4) { dbase = WSP_Kb + (size_t)row0 * 128 + (col0 - 512); ldd = 128; }
            else { dbase = WSP_U + (size_t)row0 * 512 + (col0 - 768); ldd = 512; }
            wave_store_bf16(v, [&](int row) { return dbase + (size_t)row * ldd; });
        }
    }
}

__device__ __forceinline__ void attn_unit(const Params& p, int u) {
    const int h = u & 7, qb = (u >> 3) & 15, b = u >> 7, kvh = h >> 2;
    const int tid = TIDX, lane = tid & 63, wid = tid >> 6, fr = lane & 15, fq = lane >> 4;
    const int sb = lane * 16, swz = sb ^ (((sb >> 9) & 1) << 5);
    const int r_in = swz >> 6, c_in = (swz & 63) >> 1;
    const int jstart = qb == 0 ? 2 : 0, jend = qb == 15 ? 4 : 6, nb = jend - jstart, ntile = nb + 4;
    const float SC = 0.125f * 1.4426950408889634f;
    bf16x8 qf[2][2];
    const int qrow0 = b * SEQ + qb * 128 + wid * 32;
#pragma unroll
    for (int qt = 0; qt < 2; ++qt)
#pragma unroll
        for (int ks = 0; ks < 2; ++ks)
            qf[qt][ks] = *(const bf16x8*)(WSP_Q + (size_t)(qrow0 + qt * 16 + fr) * 512 + h * 64 + ks * 32 + fq * 8);
    f32x4 o[4][2];
#pragma unroll
    for (int dt = 0; dt < 4; ++dt)
#pragma unroll
        for (int qt = 0; qt < 2; ++qt) o[dt][qt] = (f32x4){0.f, 0.f, 0.f, 0.f};
    float mrun[2], lrun[2];
    const float sinkv = p.attn_sink[h] * 1.4426950408889634f;
    mrun[0] = mrun[1] = sinkv;
    lrun[0] = lrun[1] = (fq == 0) ? 1.f : 0.f;
    __syncthreads();
    const u16* kp[2]; const u16* vp[2];
    {
        const int ks0 = qb * 128 - 128 + 64 * jstart;
#pragma unroll
        for (int it = 0; it < 2; ++it) {
            const int st = wid + 4 * it, R = (st >> 1) * 16 + r_in, C = (st & 1) * 32 + c_in;
            kp[it] = WSP_Kb + (size_t)(b * SEQ + ks0 + R) * 128 + kvh * 64 + C;
            vp[it] = WSP_Vt + ((size_t)(b * 2 + kvh) * 64 + R) * VT_LD + ks0 + C;
        }
    }
    auto stage = [&](int i, int s) {
        char* sk = smem + s * 16384;
        char* sv = sk + 8192;
#pragma unroll
        for (int it = 0; it < 2; ++it) {
            glds16(kp[it], sk + tid * 16 + it * 4096);
            glds16(vp[it], sv + tid * 16 + it * 4096);
        }
        if (i + 1 == nb) {
            const int ks0 = qb * 128 - 128 + 64 * (jstart + i);
#pragma unroll
            for (int it = 0; it < 2; ++it) {
                kp[it] += (size_t)(NLAT + b * CTXL - (b * SEQ + ks0)) * 128;
                vp[it] += SEQ - ks0;
            }
        } else {
#pragma unroll
            for (int it = 0; it < 2; ++it) { kp[it] += 64 * 128; vp[it] += 64; }
        }
    };
    stage(0, 0);
    for (int i = 0; i < ntile; ++i) {
        asm volatile("s_waitcnt vmcnt(0)" ::: "memory");
        __syncthreads();
        if (i + 1 < ntile) stage(i + 1, (i + 1) & 1);
        const char* sk = smem + (i & 1) * 16384;
        const char* sv = sk + 8192;
        f32x4 s[4][2];
#pragma unroll
        for (int kt = 0; kt < 4; ++kt)
#pragma unroll
            for (int qt = 0; qt < 2; ++qt) s[kt][qt] = (f32x4){0.f, 0.f, 0.f, 0.f};
#pragma unroll
        for (int ks = 0; ks < 2; ++ks)
#pragma unroll
            for (int kt = 0; kt < 4; ++kt) {
                const bf16x8 kf = *(const bf16x8*)(sk + lds_byte(32 * (kt >> 1) + 8 * (fr >> 2) + 4 * (kt & 1) + (fr & 3), ks * 32 + fq * 8));
#pragma unroll
                for (int qt = 0; qt < 2; ++qt) s[kt][qt] = __builtin_amdgcn_mfma_f32_16x16x32_bf16(kf, qf[qt][ks], s[kt][qt], 0, 0, 0);
            }
        const int ks0 = qb * 128 - 128 + 64 * (jstart + i);
        const int qlo = qb * 128 + wid * 32;
        const bool band = (i < nb) && ((qlo + 31 - ks0 > 128) || (ks0 + 63 - qlo > 128));
        bf16x8 pf[2][2];
#pragma unroll
        for (int qt = 0; qt < 2; ++qt) {
            const int qp = qb * 128 + wid * 32 + qt * 16 + fr;
            float mx = -1e30f;
            if (band) {
#pragma unroll
                for (int kt = 0; kt < 4; ++kt)
#pragma unroll
                    for (int j = 0; j < 4; ++j) {
                        const int kp = ks0 + 32 * (kt >> 1) + 8 * fq + 4 * (kt & 1) + j, d = qp - kp;
                        const float v = (d > 128 || d < -128) ? -1e30f : s[kt][qt][j];
                        s[kt][qt][j] = v;
                        mx = fmaxf(mx, v);
                    }
                asm volatile("" ::: "memory");
            } else {
#pragma unroll
                for (int kt = 0; kt < 4; ++kt)
#pragma unroll
                    for (int j = 0; j < 4; ++j) mx = fmaxf(mx, s[kt][qt][j]);
            }
            mx = max_x32(max_x16(mx));
            const float mnew = fmaxf(mrun[qt], mx * SC);
            const float alpha = __builtin_amdgcn_exp2f(mrun[qt] - mnew);
            mrun[qt] = mnew;
            float ls = 0.f;
#pragma unroll
            for (int kt = 0; kt < 4; ++kt)
#pragma unroll
                for (int j = 0; j < 4; ++j) {
                    const float pv = __builtin_amdgcn_exp2f(fmaf(s[kt][qt][j], SC, -mnew));
                    s[kt][qt][j] = pv;
                    ls += pv;
                }
            lrun[qt] = lrun[qt] * alpha + ls;
            if (!__all(alpha == 1.f)) {
#pragma unroll
                for (int dt = 0; dt < 4; ++dt) o[dt][qt] *= alpha;
            }
#pragma unroll
            for (int k2 = 0; k2 < 2; ++k2) {
                bf16x8 t;
#pragma unroll
                for (int j = 0; j < 4; ++j) { t[j] = (short)f2bf(s[2 * k2][qt][j]); t[4 + j] = (short)f2bf(s[2 * k2 + 1][qt][j]); }
                pf[qt][k2] = t;
            }
        }
#pragma unroll
        for (int k2 = 0; k2 < 2; ++k2)
#pragma unroll
            for (int dt = 0; dt < 4; ++dt) {
                const bf16x8 vf = *(const bf16x8*)(sv + lds_byte(dt * 16 + fr, k2 * 32 + fq * 8));
#pragma unroll
                for (int qt = 0; qt < 2; ++qt) o[dt][qt] = __builtin_amdgcn_mfma_f32_16x16x32_bf16(vf, pf[qt][k2], o[dt][qt], 0, 0, 0);
            }
    }
#pragma unroll
    for (int qt = 0; qt < 2; ++qt) {
        const float l = sum_x32(sum_x16(lrun[qt]));
        const float inv = 1.f / l;
        u16* dst = WSP_AO + (size_t)(qrow0 + qt * 16 + fr) * 512 + h * 64 + fq * 4;
        float sq = 0.f;
#pragma unroll
        for (int dt = 0; dt < 4; ++dt) {
            const unsigned w0 = pack2(o[dt][qt][0] * inv, o[dt][qt][1] * inv), w1 = pack2(o[dt][qt][2] * inv, o[dt][qt][3] * inv);
            *(uint2*)(dst + dt * 16) = make_uint2(w0, w1);
            const float a = bf2f((u16)(w0 & 0xffffu)), b = bf2f((u16)(w0 >> 16)), c = bf2f((u16)(w1 & 0xffffu)), d = bf2f((u16)(w1 >> 16));
            sq += a * a + b * b + c * c + d * d;
        }
        sq = sum_x32(sum_x16(sq));
        if (fq == 0) unsafeAtomicAdd(WSP_rsq + (size_t)(qrow0 + qt * 16 + fr) * 2, sq);
    }
}

__device__ __forceinline__ void ssm_s1_unit(const Params& p, int u) {
    const int ct = u % 9, mh = (u / 9) & 1, g = u / 18;
    const int lane = TIDX & 63, wid = TIDX >> 6, wr = wid >> 1, wc = wid & 1, fr = lane & 15, fq = lane >> 4;
    const u16* A = WSP_TabS + ((size_t)g * 256 + mh * 128) * 256;
    const u16* Ub = WSP_U + (size_t)ct * 128 * 16 * 512 + g * 16;
    f32x4 acc[4][4];
    gemm_tile(4,
        [&](int R, int C, int kt) { return (const void*)(A + (size_t)R * 256 + kt * 64 + C); },
        [&](int R, int C, int kt) { return (const void*)(Ub + (size_t)(R * 16 + kt * 4 + (C >> 4)) * 512 + (C & 15)); }, acc);
#pragma unroll
    for (int m = 0; m < 4; ++m)
#pragma unroll
        for (int n = 0; n < 4; ++n) {
            const int rho = mh * 128 + wr * 64 + m * 16 + fq * 4;
            const int cg = ct * 128 + wc * 64 + n * 16 + fr;
            *(f32x4*)(WSP_S + ((size_t)cg * 32 + g) * 256 + rho) = acc[m][n];
        }
}

__device__ __forceinline__ void phase3(const Params& p) {
    const int NU = 1024 + 576;
    for (int u = blockIdx.x; u < NU; u += gridDim.x) {
        if (u < 1024) attn_unit(p, u); else ssm_s1_unit(p, u - 1024);
    }
}

__device__ __forceinline__ void phase4(const Params& p) {
    if ((int)gridDim.x > 192) {
        if ((int)blockIdx.x >= 160) { conv_range(p, blockIdx.x - 160, gridDim.x - 160, N_CONV, N_CONV_EARLY); return; }
        if ((int)blockIdx.x >= 128) { ssm_toeplitz_item(p, blockIdx.x - 128); return; }
    } else {
        for (int g = blockIdx.x; g < 32; g += gridDim.x) ssm_toeplitz_item(p, g);
        conv_range(p, blockIdx.x, gridDim.x, N_CONV, N_CONV_EARLY);
    }
    const int gid = blockIdx.x * NTHR + TIDX;
    if (gid >= BATCH * 2 * 32 * 64) return;
    const int n = gid & 63, g = (gid >> 6) & 31, dir = (gid >> 11) & 1, b = gid >> 12;
    const int pidx = dir * 32 + g;
    const float dt = __expf(p.log_dt[pidx]);
    const float are = p.a_re[pidx * 64 + n], aim = p.a_im[pidx * 64 + n];
    const float mag = __expf(16.f * dt * are);
    float rev = 16.f * (dt * aim * 0.15915494309189535f);
    rev -= rintf(rev);
    const float ar = mag * __builtin_amdgcn_cosf(rev), ai = mag * __builtin_amdgcn_sinf(rev);
    float hr = 0.f, hi = 0.f;
    const size_t so = (size_t)g * 256 + dir * 128 + n;
#pragma unroll 8
    for (int i = 0; i < 16; ++i) {
        const int c = dir == 0 ? i : 15 - i;
        const float* sp = WSP_S + (size_t)(NCHUNK_LAT + b * 16 + c) * 8192 + so;
        const float sr = sp[0], si = sp[64];
        const float nr = ar * hr - ai * hi + sr, ni = ar * hi + ai * hr + si;
        hr = nr; hi = ni;
    }
#pragma unroll 8
    for (int i = 0; i < 128; ++i) {
        const int c = dir == 0 ? i : 127 - i;
        const size_t cg = (size_t)b * 128 + c;
        const float* sp = WSP_S + cg * 8192 + so;
        const float sr = sp[0], si = sp[64];
        u16* hp = WSP_Hin + cg * 8192 + so;
        hp[0] = f2bf(hr); hp[64] = f2bf(hi);
        const float nr = ar * hr - ai * hi + sr, ni = ar * hi + ai * hr + si;
        hr = nr; hi = ni;
    }
}

__device__ __forceinline__ void phase5(const Params& p) {
    const int NU = 512;
    const int lane = TIDX & 63, wid = TIDX >> 6, wr = wid >> 1, wc = wid & 1, fr = lane & 15, fq = lane >> 4;
    for (int u = blockIdx.x; u < NU; u += gridDim.x) {
        const int ct = u & 7, mh = (u >> 3) & 1, g = u >> 4;
        const u16* A = WSP_TabY + ((size_t)g * 256 + mh * 128) * 512;
        const u16* Ub = WSP_U + (size_t)ct * 128 * 16 * 512 + g * 16;
        const u16* Hb_ = WSP_Hin + (size_t)ct * 128 * 8192 + g * 256;
        f32x4 acc[4][4];
        gemm_tile(8,
            [&](int R, int C, int kt) { return (const void*)(A + (size_t)R * 512 + kt * 64 + C); },
            [&](int R, int C, int kt) {
                return kt < 4 ? (const void*)(Ub + (size_t)(R * 16 + kt * 4 + (C >> 4)) * 512 + (C & 15))
                              : (const void*)(Hb_ + (size_t)R * 8192 + (kt - 4) * 64 + C);
            }, acc);
#pragma unroll
        for (int m = 0; m < 4; ++m)
#pragma unroll
            for (int n = 0; n < 4; ++n) {
                const int t = mh * 8 + wr * 4 + m;
                const int cg = ct * 128 + wc * 64 + n * 16 + fr;
                u16* dst = WSP_Y + ((size_t)cg * 16 + t) * 512 + g * 16 + fq * 4;
                *(uint2*)dst = make_uint2(pack2(gelu_tanh(acc[m][n][0]), gelu_tanh(acc[m][n][1])),
                                          pack2(gelu_tanh(acc[m][n][2]), gelu_tanh(acc[m][n][3])));
            }
    }
}

__device__ __forceinline__ void phase6(const Params& p) {
    const int NU = 512;
    const int lane = TIDX & 63, wid = TIDX >> 6, wr = wid >> 1, wc = wid & 1, fr = lane & 15, fq = lane >> 4;
    for (int u = blockIdx.x; u < NU; u += gridDim.x) {
        const int mt = u >> 2, nt = u & 3;
        const u16* A = WSP_Y + (size_t)mt * 128 * 512;
        const u16* B = WSP_WgluT + (size_t)nt * 128 * 512;
        f32x4 acc[4][4];
        gemm_tile(8,
            [&](int R, int C, int kt) { return (const void*)(A + (size_t)R * 512 + kt * 64 + C); },
            [&](int R, int C, int kt) { return (const void*)(B + (size_t)R * 512 + kt * 64 + C); }, acc);
        const int row0 = mt * 128 + wr * 64, col0 = nt * 128 + wc * 64;
        char* base = smem + wid * 9216;
        float bg[4];
#pragma unroll
        for (int n = 0; n < 4; ++n) bg[n] = p.b_glu[col0 + n * 16 + fr];
#pragma unroll
        for (int m = 0; m < 4; ++m)
#pragma unroll
            for (int j = 0; j < 4; ++j) {
                const int rl = m * 16 + fq * 4 + j, r = row0 + rl;
                float sq = 0.f;
#pragma unroll
                for (int n = 0; n < 4; ++n) {
                    const int c = col0 + n * 16 + fr;
                    const float yv = bf2f(WSP_Y[(size_t)r * 512 + c]);
                    const u16 ob = f2bf(yv * sigmoidf_(acc[m][n][j] + bg[n]));
                    *(u16*)(base + rl * 144 + (n * 16 + fr) * 2) = ob;
                    const float of = bf2f(ob);
                    sq += of * of;
                }
                sq = sum16(sq);
                if (fr == 0) unsafeAtomicAdd(WSP_rsq + (size_t)r * 2 + 1, sq);
            }
        asm volatile("s_waitcnt lgkmcnt(0)" ::: "memory");
        __builtin_amdgcn_wave_barrier();
        u16* dbase = WSP_SO + (size_t)row0 * 512 + col0;
#pragma unroll
        for (int i = 0; i < 8; ++i) {
            const int id = i * 64 + lane, row = id >> 3, ch = id & 7;
            *(uint4*)(dbase + (size_t)row * 512 + ch * 8) = *(const uint4*)(base + row * 144 + ch * 16);
        }
        asm volatile("s_waitcnt lgkmcnt(0)" ::: "memory");
        __builtin_amdgcn_wave_barrier();
    }
}

__device__ __forceinline__ void phase8(const Params& p) {
    const int NU = 512;
    for (int u = blockIdx.x; u < NU; u += gridDim.x) {
        const int mt = (u & 7) + 8 * (u >> 5), nt = (u >> 3) & 3;
        const u16* A1 = WSP_AO + (size_t)mt * 128 * 512;
        const u16* A2 = WSP_SO + (size_t)mt * 128 * 512;
        const u16* B = WSP_WoutT + (size_t)nt * 256 * 1024;
        f32x4 acc[4][8];
        {
        const int tid1 = TIDX, fq = (tid1 & 63) >> 4, row0 = mt * 128 + (tid1 >> 7) * 64;
        gemm_tile_w(32,
            [&](int i, int R, int C, int kt) { return (const void*)((kt < 16 ? A1 : A2) + (size_t)R * 512 + (kt & 15) * 32 + C); },
            [&](int i, int R, int C, int kt) { return (const void*)(B + (size_t)R * 1024 + kt * 32 + C); }, acc,
            [&](int kt) {
                if (kt == 16) {
#pragma unroll
                    for (int m = 0; m < 4; ++m) {
                        asm volatile("" ::: "memory");
#pragma unroll
                        for (int j = 0; j < 4; ++j) {
                            const float2 q = *(const float2*)(WSP_rsq + (size_t)(row0 + m * 16 + fq * 4 + j) * 2);
                            const float ratio = rsqrtf(q.x * (1.f / 512.f) + EPS) / rsqrtf(q.y * (1.f / 512.f) + EPS);
#pragma unroll
                            for (int n = 0; n < 8; ++n) acc[m][n][j] *= ratio;
                        }
                    }
                }
            });
        }
        const int tid2 = TIDX, lane = tid2 & 63, wid = tid2 >> 6, fr = lane & 15, fq = lane >> 4;
        const int row0 = mt * 128 + (wid >> 1) * 64, col0 = nt * 256 + (wid & 1) * 128;
        const float* g1 = WSP_mod + (mt >> 4) * 6144 + 2048 + col0;
        float* stg = (float*)(smem + wid * 8448);
#pragma unroll
        for (int m = 0; m < 4; ++m) {
#pragma unroll
            for (int n = 0; n < 8; ++n)
#pragma unroll
                for (int j = 0; j < 4; ++j) stg[(fq * 4 + j) * 132 + n * 16 + fr] = acc[m][n][j];
            asm volatile("s_waitcnt lgkmcnt(0)" ::: "memory");
            __builtin_amdgcn_wave_barrier();
#pragma unroll
            for (int i = 0; i < 8; ++i) {
                const int id = i * 64 + lane, rr = id >> 5, c4 = (id & 31) * 4;
                float4 v = *(const float4*)(stg + rr * 132 + c4);
                const float rsv = rsqrtf(WSP_rsq[(size_t)(row0 + m * 16 + rr) * 2 + 1] * (1.f / 512.f) + EPS);
                v.x *= rsv; v.y *= rsv; v.z *= rsv; v.w *= rsv;
                const float4 g = *(const float4*)(g1 + c4);
                const size_t o = (size_t)(row0 + m * 16 + rr) * 1024 + col0 + c4;
                const float4 xv = *(const float4*)(p.x + o);
                *(float4*)(p.out + o) = make_float4(xv.x + g.x * v.x, xv.y + g.y * v.y, xv.z + g.z * v.z, xv.w + g.w * v.w);
            }
            asm volatile("s_waitcnt lgkmcnt(0)" ::: "memory");
            __builtin_amdgcn_wave_barrier();
        }
    }
}

#define CTR_ECNT 0
#define CTR_Q11 128
#define CTR_Q12 136
#define HALF_TOK 8192
#define HH_HALF_ROWS 73728
#define ELIST_CAP 8192
template <int LEVEL>
__device__ __forceinline__ void phase9_t(const Params& p) {
    const int tid = TIDX, lane = tid & 63, wid = tid >> 6, fr = lane & 15, fq = lane >> 4;
    char* At = smem;
    float* sc = (float*)(smem + 65536);
    int* hist = (int*)(smem + 65536 + 8192);
    int* gbase = hist + 64;
    int* fill = gbase + 64;
    unsigned char* selk = (unsigned char*)(fill + 64);
    float* selw = (float*)(selk + 256);
    for (int chunk = blockIdx.x; chunk < NLAT / 32; chunk += gridDim.x) {
        const int tok0 = chunk * 32;
        __syncthreads();
        if (tid < 64) hist[tid] = 0;
#pragma unroll 1
        for (int hb = 0; hb < 2; ++hb) {
            float4 vall[4][4];
#pragma unroll
            for (int rr = 0; rr < 4; ++rr)
#pragma unroll
                for (int i = 0; i < 4; ++i) vall[rr][i] = *(const float4*)(p.out + (size_t)(tok0 + wid * 8 + hb * 4 + rr) * 1024 + i * 256 + lane * 4);
#pragma unroll
            for (int rr = 0; rr < 4; ++rr) {
                const int row = wid * 8 + hb * 4 + rr, tok = tok0 + row;
                const float* md = WSP_mod + (tok >> 11) * 6144;
                float ss = 0.f;
#pragma unroll
                for (int i = 0; i < 4; ++i) ss += vall[rr][i].x * vall[rr][i].x + vall[rr][i].y * vall[rr][i].y + vall[rr][i].z * vall[rr][i].z + vall[rr][i].w * vall[rr][i].w;
                ss = wave_sum(ss);
                const float rs = rsqrtf(ss * (1.f / 1024.f) + EPS);
#pragma unroll
                for (int i = 0; i < 4; ++i) {
                    const int c0 = i * 256 + lane * 4;
                    const float4 v = vall[rr][i];
                    const float4 g = *(const float4*)(p.norm_ffn + c0), s = *(const float4*)(md + 3072 + c0), k = *(const float4*)(md + 4096 + c0);
                    const float a = v.x * rs * g.x * (1.f + k.x) + s.x, b = v.y * rs * g.y * (1.f + k.y) + s.y;
                    const float c = v.z * rs * g.z * (1.f + k.z) + s.z, d = v.w * rs * g.w * (1.f + k.w) + s.w;
                    const uint2 pk = make_uint2(pack2(a, b), pack2(c, d));
                    *(uint2*)(WSP_H2 + (size_t)tok * 1024 + c0) = pk;
                    const int ch = c0 >> 3;
                    *(uint2*)(At + row * 2048 + ((ch ^ (row & 15)) << 4) + ((c0 & 4) << 1)) = pk;
                }
            }
        }
        __syncthreads();
        if (LEVEL == 1) continue;
        {
            f32x4 acc0 = {0.f, 0.f, 0.f, 0.f}, acc1 = {0.f, 0.f, 0.f, 0.f};
            const u16* bp = WSP_WrT + (size_t)(wid * 16 + fr) * 1024 + fq * 8;
#pragma unroll
            for (int kb = 0; kb < 4; ++kb) {
                bf16x8 bfr[8];
#pragma unroll
                for (int q = 0; q < 8; ++q) bfr[q] = *(const bf16x8*)(bp + (kb * 8 + q) * 32);
#pragma unroll
                for (int q = 0; q < 8; ++q) {
                    const int ch = (kb * 8 + q) * 4 + fq;
                    const bf16x8 a0 = *(const bf16x8*)(At + fr * 2048 + ((ch ^ fr) << 4));
                    const bf16x8 a1 = *(const bf16x8*)(At + (16 + fr) * 2048 + ((ch ^ fr) << 4));
                    acc0 = __builtin_amdgcn_mfma_f32_16x16x32_bf16(a0, bfr[q], acc0, 0, 0, 0);
                    acc1 = __builtin_amdgcn_mfma_f32_16x16x32_bf16(a1, bfr[q], acc1, 0, 0, 0);
                }
            }
#pragma unroll
            for (int j = 0; j < 4; ++j) {
                sc[(fq * 4 + j) * 64 + wid * 16 + fr] = sigmoidf_(acc0[j]);
                sc[(16 + fq * 4 + j) * 64 + wid * 16 + fr] = sigmoidf_(acc1[j]);
            }
        }
        __syncthreads();
        if (LEVEL == 2) continue;
        const float bias = p.router_bias[lane];
        const int eg = lane >> 3;
        for (int rr = 0; rr < 8; ++rr) {
            const int row = wid * 8 + rr;
            const float s = sc[row * 64 + lane];
            const float bz = s + bias;
            const float m1 = max8(bz);
            const unsigned long long eq = __ballot(bz == m1);
            const unsigned gb = (unsigned)((eq >> (eg * 8)) & 0xffull);
            const int first = __ffs(gb) - 1;
            const float v2 = max8(((lane & 7) == first) ? -1e30f : bz);
            const float gs = m1 + v2;
            int cnt = 0;
#pragma unroll
            for (int j = 0; j < 8; ++j) {
                const float gj = __int_as_float(__builtin_amdgcn_readlane(__float_as_int(gs), j * 8));
                cnt += (gj > gs || (gj == gs && j < eg)) ? 1 : 0;
            }
            const bool gsel = cnt < 4;
            const float mv = gsel ? bz : -1e30f;
            unsigned long long gm = __ballot(gsel);
            int rank = 0;
#pragma unroll 1
            for (int it = 0; it < 4; ++it) {
                const int jb = __builtin_amdgcn_readfirstlane(__ffsll((long long)gm) - 1);
                gm &= ~(0xffull << jb);
#pragma unroll
                for (int j = 0; j < 8; ++j) {
                    const float vj = __int_as_float(__builtin_amdgcn_readlane(__float_as_int(mv), jb + j));
                    rank += (vj > mv || (vj == mv && (jb + j) < lane)) ? 1 : 0;
                }
            }
            const bool sel = gsel && rank < 8;
            unsigned long long sm = __ballot(sel);
            float tot = 0.f;
#pragma unroll 1
            for (int it = 0; it < 8; ++it) {
                const int l = __builtin_amdgcn_readfirstlane(__ffsll((long long)sm) - 1);
                sm &= sm - 1;
                tot += __int_as_float(__builtin_amdgcn_readlane(__float_as_int(s), l));
            }
            if (sel) {
                selw[row * 8 + rank] = s / tot * 2.5f;
                selk[row * 8 + rank] = (unsigned char)lane;
                atomicAdd(&hist[lane], 1);
            }
        }
        __syncthreads();
        const int h = tok0 >> 13;
        if (tid < 64) {
            gbase[tid] = hist[tid] ? (int)atomicAdd(&WSP_ctr[CTR_ECNT + h * 64 + tid], (unsigned)hist[tid]) : 0;
            fill[tid] = 0;
        }
        __syncthreads();
        {
            const int e = selk[tid];
            const int pos = atomicAdd(&fill[e], 1);
            WSP_elist[(size_t)(h * 64 + e) * ELIST_CAP + gbase[e] + pos] = (tok0 + (tid >> 3)) * 8 + (tid & 7);
            WSP_wsl[(size_t)(h * 64 + e) * ELIST_CAP + gbase[e] + pos] = selw[tid];
        }
    }
}

struct MoeTab { int cnt[16]; int soff[16]; int pre[17]; };

template <class FV, class FD>
__device__ __forceinline__ void wave_store_fp8_f(FV val, FD dst) {
    const int lane = TIDX & 63, wid = TIDX >> 6, fr = lane & 15, fq = lane >> 4;
    char* base = smem + wid * 9216;
#pragma unroll
    for (int m = 0; m < 4; ++m)
#pragma unroll
        for (int n = 0; n < 8; ++n)
#pragma unroll
            for (int j = 0; j < 4; ++j)
                *(unsigned char*)(base + (m * 16 + fq * 4 + j) * 144 + n * 16 + fr) =
                    (unsigned char)(__builtin_amdgcn_cvt_pk_fp8_f32(val(m, n, j), 0.f, 0, false) & 0xff);
    asm volatile("s_waitcnt lgkmcnt(0)" ::: "memory");
    __builtin_amdgcn_wave_barrier();
#pragma unroll
    for (int i = 0; i < 8; ++i) {
        const int id = i * 64 + lane, row = id >> 3, ch = id & 7;
        const uint4 d = *(const uint4*)(base + row * 144 + ch * 16);
        unsigned char* q = dst(i, row);
        if (q) *(uint4*)(q + ch * 16) = d;
    }
    asm volatile("s_waitcnt lgkmcnt(0)" ::: "memory");
    __builtin_amdgcn_wave_barrier();
}

#define YD_SCALE 8.0f
template <int MODE>
__device__ __forceinline__ void phase11f(const Params& p) {
    const int tid = TIDX;
    int* tab = (int*)(smem + 73728);
    int* t_cnt = tab, *t_soff = tab + 16, *t_pre = tab + 32, *t_q = tab + 52;
    int* t_all = tab + 64;
    const int x = blockIdx.x & 7;
    unsigned* flags = WSP_flag + x * FLAG_PER_CLASS;
    unsigned* tmo = WSP_flag + 8 * FLAG_PER_CLASS;
    unsigned char* Yd8 = (unsigned char*)(p.ws + OFF_ARENA);
    __syncthreads();
    if (tid < 128) t_all[tid] = (int)WSP_ctr[CTR_ECNT + tid];
    unsigned* qhead = &WSP_ctr[(MODE == 2 ? CTR_Q12 : CTR_Q11) + x];
    if (tid == 0) t_q[0] = (int)atomicAdd(qhead, 1u);
    __syncthreads();
    if (tid < 16) {
        const int i = tid >> 1, h = tid & 1, e = x + 8 * i;
        t_cnt[tid] = t_all[h * 64 + e];
        int so = 0;
        for (int e2 = 0; e2 < e; ++e2) so += t_all[h * 64 + e2];
        t_soff[tid] = so;
    }
    __syncthreads();
    if (tid == 0) {
        int s = 0;
        for (int j = 0; j < 16; ++j) { t_pre[j] = s; s += (t_cnt[j] + 127) >> 7; }
        t_pre[16] = s;
    }
    __syncthreads();
    const int T_r = t_pre[16], T11 = T_r + 16, T_all = (MODE == 1) ? T11 : T11 + T_r * 4;
    for (;;) {
        __syncthreads();
        const int q = __builtin_amdgcn_readfirstlane(t_q[0]) + (MODE == 2 ? T11 : 0);
        __syncthreads();
        if (q >= T_all) break;
        if (tid == 0) t_q[0] = (int)atomicAdd(qhead, 1u);
        const bool is_down = q >= T11;
        const int u = is_down ? (q - T11) >> 2 : q;
        int nt = is_down ? (q - T11) & 3 : 0;
        int e, h, mt, c, rowbase;
        if (u < T_r) {
            int j = 0;
#pragma unroll
            for (int qq = 1; qq < 16; ++qq) j += (u >= t_pre[qq]) ? 1 : 0;
            e = x + 8 * (j >> 1); h = j & 1; mt = u - t_pre[j]; c = t_cnt[j];
            rowbase = h * HH_HALF_ROWS + t_soff[j];
        } else {
            const int ms = x * 16 + (u - T_r);
            e = 64; h = ms >> 6; mt = ms & 63; c = HALF_TOK;
            rowbase = h * HH_HALF_ROWS + 65536;
        }
        e = __builtin_amdgcn_readfirstlane(e); h = __builtin_amdgcn_readfirstlane(h); mt = __builtin_amdgcn_readfirstlane(mt);
        nt = __builtin_amdgcn_readfirstlane(nt); c = __builtin_amdgcn_readfirstlane(c); rowbase = __builtin_amdgcn_readfirstlane(rowbase);
        const int* el = WSP_elist + (size_t)(h * 64 + (e & 63)) * ELIST_CAP;
        if (!is_down) {
            const int t2 = TIDX, lane = t2 & 63, wid = t2 >> 6, wr = wid >> 1, wc = wid & 1, fr = lane & 15, fq = lane >> 4;
            const int sb = lane * 16, swz = sb ^ (((sb >> 9) & 1) << 5);
            const int r_in = swz >> 6, c_in = (swz & 63) >> 1;
            const int vrows = c - mt * 128 - wr * 64;
            const float* wsl = WSP_wsl + (size_t)(h * 64 + (e & 63)) * ELIST_CAP;
            const u16* aptr[2];
#pragma unroll
            for (int i = 0; i < 2; ++i) {
                int li = mt * 128 + (wid + 4 * i) * 16 + r_in;
                li = li < c ? li : c - 1;
                const int tok = (e < 64) ? (el[li] >> 3) : (h * HALF_TOK + li);
                aptr[i] = WSP_H2 + (size_t)tok * 1024 + c_in;
            }
            const u16* Bw = WSP_WguT + (size_t)e * 262144 + c_in;
            f32x4 acc[4][8];
            gemm_tile_w(32,
                [&](int i, int R, int C, int kt) { return (const void*)(aptr[i] + kt * 32); },
                [&](int i, int R, int C, int kt) { return (const void*)(Bw + (size_t)R * 1024 + kt * 32); }, acc);
            float wgt[4][4];
#pragma unroll
            for (int m = 0; m < 4; ++m)
#pragma unroll
                for (int j = 0; j < 4; ++j) {
                    const int li = mt * 128 + wr * 64 + m * 16 + fq * 4 + j;
                    float w = 1.f;
                    if (e < 64) w = (li < c) ? wsl[li] : 0.f;
                    wgt[m][j] = w;
                }
            u16* dbase = WSP_HHs + ((size_t)rowbase + mt * 128 + wr * 64) * 128 + wc * 64;
            wave_store_bf16_f([&](int m, int n2, int j) { return siluf_(acc[m][2 * n2][j]) * acc[m][2 * n2 + 1][j] * wgt[m][j]; },
                              [&](int row) { return row < vrows ? dbase + (size_t)row * 128 : (u16*)nullptr; }, true, (const char*)WSP_HHs, (unsigned)((size_t)2 * HH_HALF_ROWS * 128 * 2));
            asm volatile("s_waitcnt vmcnt(0)" ::: "memory");
            __syncthreads();
            if (tid == 0) __hip_atomic_store(&flags[u], 1u, __ATOMIC_RELAXED, __HIP_MEMORY_SCOPE_AGENT);
        } else {
            const int t2 = TIDX, lane = t2 & 63, wid = t2 >> 6, wr = wid >> 1, wc = wid & 1, fr = lane & 15, fq = lane >> 4;
            const int sb = lane * 16, swz = sb ^ (((sb >> 9) & 1) << 5);
            const int r_in = swz >> 6, c_in = (swz & 63) >> 1;
            const int vrows = c - mt * 128 - wr * 64;
            if (MODE == 0 && tid == 0) {
                unsigned sp = 0;
                while (__hip_atomic_load(&flags[u], __ATOMIC_RELAXED, __HIP_MEMORY_SCOPE_AGENT) == 0u) {
                    __builtin_amdgcn_s_sleep(2);
                    if ((++sp & 255u) == 0u) {
                        if (__hip_atomic_load(tmo, __ATOMIC_RELAXED, __HIP_MEMORY_SCOPE_AGENT)) break;
                        if (sp > (1u << 20)) { atomicAdd(tmo, 1u); break; }
                    }
                }
            }
            __syncthreads();
            const u16* aptr[2];
#pragma unroll
            for (int i = 0; i < 2; ++i) {
                int li = mt * 128 + (wid + 4 * i) * 16 + r_in;
                li = li < c ? li : c - 1;
                aptr[i] = WSP_HHs + ((size_t)rowbase + li) * 128 + c_in;
            }
            const u16* Bw = WSP_WdT + ((size_t)e * 1024 + nt * 256) * 128 + c_in;
            int slot[8];
            if (e < 64) {
#pragma unroll
                for (int i = 0; i < 8; ++i) {
                    int li = mt * 128 + wr * 64 + ((i * 64 + lane) >> 3);
                    li = li < c ? li : c - 1;
                    slot[i] = el[li];
                }
            } else {
#pragma unroll
                for (int i = 0; i < 8; ++i) slot[i] = (h * HALF_TOK + mt * 128 + wr * 64 + ((i * 64 + lane) >> 3)) * 8;
            }
            f32x4 acc[4][8];
            gemm_tile_w<true>(4,
                [&](int i, int R, int C, int kt) { return (const void*)(aptr[i] + kt * 32); },
                [&](int i, int R, int C, int kt) { return (const void*)(Bw + (size_t)R * 128 + kt * 32); }, acc);
            const int colo = nt * 256 + wc * 128;
            if (e < 64) {
                wave_store_fp8_f([&](int m, int n, int j) { return acc[m][n][j] * YD_SCALE; }, [&](int i, int row) {
                    if (row >= vrows) return (unsigned char*)nullptr;
                    const int s = slot[i];
                    return Yd8 + ((size_t)(s >> 3) * 8 + (s & 7)) * 1024 + colo;
                });
            } else {
                const int tok0 = h * HALF_TOK + mt * 128 + wr * 64;
                const float* g2 = WSP_mod + (tok0 >> 11) * 6144 + 5120 + colo;
                float* stg = (float*)(smem + wid * 8448);
#pragma unroll
                for (int m = 0; m < 4; ++m) {
#pragma unroll
                    for (int n = 0; n < 8; ++n)
#pragma unroll
                        for (int j = 0; j < 4; ++j) stg[(fq * 4 + j) * 132 + n * 16 + fr] = acc[m][n][j];
                    asm volatile("s_waitcnt lgkmcnt(0)" ::: "memory");
                    __builtin_amdgcn_wave_barrier();
#pragma unroll
                    for (int i = 0; i < 8; ++i) {
                        const int id = i * 64 + lane, rr = id >> 5, c4 = (id & 31) * 4;
                        const float4 v = *(const float4*)(stg + rr * 132 + c4);
                        const float4 g = *(const float4*)(g2 + c4);
                        float* op = p.out + (size_t)(tok0 + m * 16 + rr) * 1024 + colo + c4;
                        const float4 xv = *(const float4*)op;
                        *(float4*)op = make_float4(xv.x + g.x * v.x, xv.y + g.y * v.y, xv.z + g.z * v.z, xv.w + g.w * v.w);
                    }
                    asm volatile("s_waitcnt lgkmcnt(0)" ::: "memory");
                    __builtin_amdgcn_wave_barrier();
                }
            }
        }
    }
}

#define P12_SLD 2064
template <bool DUMMY>
__device__ __forceinline__ void phase12b_t(const Params& p) {
    const int tid = TIDX, lane = tid & 63, wid = tid >> 6, fr = lane & 15, fq = lane >> 4;
    const unsigned char* Yd8 = (const unsigned char*)(p.ws + OFF_ARENA);
    const u16* Wb = WSP_WdT + (size_t)64 * 131072 + (size_t)(wid * 256 + fr) * 128 + fq * 8;
    for (int tile = blockIdx.x; tile < NLAT / 32; tile += gridDim.x) {
        const int tok0 = tile * 32;
        const int hh = tok0 >> 13;
        const u16* Ab = WSP_HHs + ((size_t)hh * HH_HALF_ROWS + 65536 + (tok0 & 8191) + fr) * 128 + fq * 8;
        __syncthreads();
        bf16x8 af[2][4];
#pragma unroll
        for (int m = 0; m < 2; ++m)
#pragma unroll
            for (int ks = 0; ks < 4; ++ks) af[m][ks] = *(const bf16x8*)(Ab + (size_t)m * 16 * 128 + ks * 32);
#pragma unroll 1
        for (int nb = 0; nb < 4; ++nb) {
            bf16x8 bfr[4][4];
#pragma unroll
            for (int n = 0; n < 4; ++n)
#pragma unroll
                for (int ks = 0; ks < 4; ++ks) bfr[n][ks] = *(const bf16x8*)(Wb + (size_t)((nb * 4 + n) * 16) * 128 + ks * 32);
#pragma unroll
            for (int m = 0; m < 2; ++m)
#pragma unroll
                for (int n = 0; n < 4; ++n) {
                    f32x4 d = {0.f, 0.f, 0.f, 0.f};
#pragma unroll
                    for (int ks = 0; ks < 4; ++ks) d = __builtin_amdgcn_mfma_f32_16x16x32_bf16(af[m][ks], bfr[n][ks], d, 0, 0, 0);
                    const int col = wid * 256 + (nb * 4 + n) * 16 + fr;
#pragma unroll
                    for (int j = 0; j < 4; ++j) *(u16*)(smem + (m * 16 + fq * 4 + j) * P12_SLD + col * 2) = f2bf(d[j]);
                }
        }
        __syncthreads();
        for (int rr = 0; rr < 8; ++rr) {
            const int row = wid * 8 + rr, tok = tok0 + row;
            float* xrow = p.out + (size_t)tok * 1024 + lane * 16;
            float* orow = DUMMY ? (float*)(p.ws + OFF_HHS) + (size_t)(tok & 8191) * 1024 + lane * 16 : xrow;
            const float* g2 = WSP_mod + (tok >> 11) * 6144 + 5120 + lane * 16;
            float s[16];
#pragma unroll
            for (int i = 0; i < 16; ++i) s[i] = 0.f;
            const unsigned char* yp = Yd8 + (size_t)tok * 8 * 1024 + lane * 16;
            uint4 yv[8];
#pragma unroll
            for (int k = 0; k < 8; ++k) yv[k] = *(const uint4*)(yp + k * 1024);
#pragma unroll
            for (int k = 0; k < 8; ++k) {
                const unsigned w[4] = {yv[k].x, yv[k].y, yv[k].z, yv[k].w};
#pragma unroll
                for (int i = 0; i < 4; ++i) {
                    const auto lo = __builtin_amdgcn_cvt_pk_f32_fp8((int)w[i], false);
                    const auto hi = __builtin_amdgcn_cvt_pk_f32_fp8((int)w[i], true);
                    s[4 * i] += lo[0]; s[4 * i + 1] += lo[1]; s[4 * i + 2] += hi[0]; s[4 * i + 3] += hi[1];
                }
            }
            const uint4 sa = *(const uint4*)(smem + row * P12_SLD + lane * 32), sbv = *(const uint4*)(smem + row * P12_SLD + lane * 32 + 16);
            const unsigned sw[8] = {sa.x, sa.y, sa.z, sa.w, sbv.x, sbv.y, sbv.z, sbv.w};
#pragma unroll
            for (int i = 0; i < 8; ++i) {
                s[2 * i] = s[2 * i] * (1.f / YD_SCALE) + bf2f((u16)(sw[i] & 0xffffu));
                s[2 * i + 1] = s[2 * i + 1] * (1.f / YD_SCALE) + bf2f((u16)(sw[i] >> 16));
            }
            float ss = 0.f;
#pragma unroll
            for (int q = 0; q < 4; ++q) {
                const float4 xv = *(const float4*)(xrow + q * 4), gv = *(const float4*)(g2 + q * 4);
                s[4 * q] = xv.x + gv.x * s[4 * q]; s[4 * q + 1] = xv.y + gv.y * s[4 * q + 1];
                s[4 * q + 2] = xv.z + gv.z * s[4 * q + 2]; s[4 * q + 3] = xv.w + gv.w * s[4 * q + 3];
                ss += s[4 * q] * s[4 * q] + s[4 * q + 1] * s[4 * q + 1] + s[4 * q + 2] * s[4 * q + 2] + s[4 * q + 3] * s[4 * q + 3];
            }
            ss = wave_sum(ss);
            const float rs = rsqrtf(ss * (1.f / 1024.f) + EPS);
#pragma unroll
            for (int q = 0; q < 4; ++q) {
                const float4 g = *(const float4*)(p.norm_final + lane * 16 + q * 4);
                *(float4*)(orow + q * 4) = make_float4(s[4 * q] * rs * g.x, s[4 * q + 1] * rs * g.y, s[4 * q + 2] * rs * g.z, s[4 * q + 3] * rs * g.w);
            }
        }
    }
}

#define SMEM_TOTAL (73728 + 3072 + 64)

#if 1
__global__ void __launch_bounds__(NTHR, 2) k_mega(Params p) {
    volatile LAS unsigned* st = (volatile LAS unsigned*)(smem + SMEM_TOTAL - 16);
    if (TIDX == 0) { st[0] = 0u; st[1] = 0u; st[2] = 0u; st[3] = 0u; }
    __syncthreads();
    XcdBarrier bar = xcd_barrier_post(WSP_bar, st);
#define RUNP(N) do { phase##N(p); if (PROBE_DUP == N) phase##N(p); } while (0)
    RUNP(0);  xcd_barrier(bar);
    RUNP(1);  xcd_barrier(bar);
    RUNP(2);  xcd_barrier(bar);
    RUNP(3);  xcd_barrier(bar);
    RUNP(4);  xcd_barrier(bar);
    RUNP(5);  xcd_barrier(bar);
    RUNP(6);  xcd_barrier(bar);
    RUNP(8);  xcd_barrier(bar);
#if PROBE_DUP == 91
    phase9_t<1>(p); xcd_barrier(bar);
#endif
#if PROBE_DUP == 92
    phase9_t<2>(p); xcd_barrier(bar);
#endif
    phase9_t<0>(p); xcd_barrier(bar);
#if PROBE_DUP == 9
    if (blockIdx.x == 0 && TIDX < 128) WSP_ctr[CTR_ECNT + TIDX] = 0u;
    xcd_barrier(bar); phase9_t<0>(p); xcd_barrier(bar);
#endif
#ifndef MOE_FUSED
#define MOE_FUSED 1
#endif
#if MOE_FUSED
    phase11f<0>(p); xcd_barrier(bar);
#else
    phase11f<1>(p); xcd_barrier(bar);
    phase11f<2>(p); xcd_barrier(bar);
#endif
#if PROBE_DUP == 11
    if (blockIdx.x == 0 && TIDX < 8) WSP_ctr[CTR_Q11 + TIDX] = 0u;
    if (blockIdx.x == 1) for (int i = TIDX; i < 8 * FLAG_PER_CLASS; i += NTHR) WSP_flag[i] = 0u;
    xcd_barrier(bar); phase11f<0>(p); xcd_barrier(bar);
#endif
#if PROBE_DUP == 121
    phase12b_t<true>(p); xcd_barrier(bar);
#endif
    phase12b_t<false>(p);
}
#endif


extern "C" void kernel_launch(void* const* d_in, const int* in_sizes, int n_in,
                              void* d_out, int out_size, void* d_ws, size_t ws_size,
                              hipStream_t stream) {
    Params p{};
    const float** ip = (const float**)&p.x;
    for (int i = 0; i < 32; ++i) ip[i] = (const float*)d_in[i];
    p.out = (float*)d_out;
    p.ws = (char*)d_ws;
    if (OFF_END > ws_size) { fprintf(stderr, "workspace too small: need %zu have %zu\n", (size_t)OFF_END, ws_size); return; }

    static int grid = 0;
    if (!grid) {
        hipFuncSetAttribute((const void*)k_mega, hipFuncAttributeMaxDynamicSharedMemorySize, SMEM_TOTAL);
        int dev = 0, cus = 0, per_cu = 0;
        hipGetDevice(&dev);
        hipDeviceGetAttribute(&cus, hipDeviceAttributeMultiprocessorCount, dev);
        hipOccupancyMaxActiveBlocksPerMultiprocessor(&per_cu, (const void*)k_mega, NTHR, SMEM_TOTAL);
        if (per_cu < 1) per_cu = 1;
        grid = cus * (per_cu < 2 ? per_cu : 2);
    }
    hipMemsetAsync(p.ws + OFF_BAR, 0, ZERO_BYTES, stream);
    k_mega<<<grid, NTHR, SMEM_TOTAL, stream>>>(p);
}
```

```cpp
#include <hip/hip_runtime.h>
#include <hip/hip_bf16.h>
#include <stdint.h>
#include <stdio.h>

#ifndef MK_MULTI
#define MK_MULTI 0
#endif

typedef __attribute__((ext_vector_type(8))) short bf16x8;
typedef __attribute__((ext_vector_type(4))) short bf16x4;
typedef __attribute__((ext_vector_type(4))) float f32x4;
typedef unsigned short u16;
typedef __attribute__((ext_vector_type(4))) unsigned u32x4;

#ifndef PROBE_DUP
#define PROBE_DUP -1
#endif
#define NTHR 256
__device__ __forceinline__ int opaque_tid() { int t = (int)threadIdx.x; asm volatile("" : "+v"(t)); return t; }
#define TIDX opaque_tid()
#define LDS_BYTES 65536

#define D_MODEL 1024
#define BATCH 8
#define SEQ 2048
#define CTXL 256
#define NLAT (BATCH * SEQ)
#define NCTX (BATCH * CTXL)
#define NROWS (NLAT + NCTX)
#define INW 1280
#define NEXP 64
#define VT_LD (SEQ + CTXL)
#define NCHUNK_LAT 1024
#define NCHUNK_ALL 1152
#define EPS 1e-6f

#define XB_TMO      128
#define XB_XCNT(j)  (256  + 64 * (j))
#define XB_XSUB(j)  (1280 + 64 * (j))
#define XB_XGEN(j)  (2304 + 64 * (j))
#define XB_TOP      3328
#define XB_TOPGEN   3392
#define XCD_BAR_WORDS 3456
#define XB_SPIN_CAP (1u << 20)
#define LAS __attribute__((address_space(3)))

__device__ __forceinline__ unsigned xb_ld(unsigned* p)              { return __hip_atomic_load(p, __ATOMIC_RELAXED, __HIP_MEMORY_SCOPE_AGENT); }
__device__ __forceinline__ unsigned xb_add(unsigned* p, unsigned v) { return __hip_atomic_fetch_add(p, v, __ATOMIC_RELAXED, __HIP_MEMORY_SCOPE_AGENT); }
__device__ __forceinline__ unsigned xb_xcc_id() { return (unsigned)__builtin_amdgcn_s_getreg((3 << 11) | 20) & 0xFu; }
#define XB_SPIN(cond, bar) do { unsigned _sp = 0; while (cond) { __builtin_amdgcn_s_sleep(1); \
    if ((++_sp & 255u) == 0u) { if (xb_ld(&(bar)[XB_TMO])) break; if (_sp > XB_SPIN_CAP) { atomicAdd(&(bar)[XB_TMO], 1u); break; } } } } while (0)

struct XcdBarrier { unsigned* bar; unsigned x; volatile LAS unsigned* st; };

__device__ __forceinline__ XcdBarrier xcd_barrier_post(unsigned* bar, volatile LAS unsigned* st) {
    XcdBarrier b; b.bar = bar; b.x = xb_xcc_id(); b.st = st;
    if (TIDX == 0) (void)xb_add(&bar[XB_XCNT(b.x)], 1u);
    return b;
}
__device__ __forceinline__ void xcd_barrier_complete(unsigned* bar, unsigned x, unsigned& nloc, unsigned& nx) {
    const unsigned G = gridDim.x * gridDim.y * gridDim.z;
    unsigned sum, cnt, mine, sp = 0u;
    for (;;) {
        sum = 0u; cnt = 0u; mine = 0u;
#pragma unroll
        for (unsigned j = 0; j < 16; ++j) { const unsigned c = xb_ld(&bar[XB_XCNT(j)]); sum += c; cnt += (c > 0u) ? 1u : 0u; mine = (j == x) ? c : mine; }
        if (sum == G) break;
        __builtin_amdgcn_s_sleep(1);
        if ((++sp & 255u) == 0u) { if (xb_ld(&bar[XB_TMO])) break; if (sp > XB_SPIN_CAP) { atomicAdd(&bar[XB_TMO], 1u); break; } }
    }
    nloc = mine > 0u ? mine : 1u; nx = cnt > 0u ? cnt : 1u;
}
__device__ __forceinline__ void xcd_barrier(const XcdBarrier& b) {
    asm volatile("s_waitcnt vmcnt(0)" ::: "memory");
    __syncthreads();
    if (TIDX == 0) {
        unsigned* bar = b.bar;
        __builtin_amdgcn_s_waitcnt(0);
        unsigned nloc = b.st[0], nx = b.st[1];
        if (nloc == 0u) { xcd_barrier_complete(bar, b.x, nloc, nx); b.st[0] = nloc; b.st[1] = nx; }
        const unsigned old = xb_add(&bar[XB_XSUB(b.x)], 1u);
        const unsigned gen = old / nloc;
        if (old + 1u == (gen + 1u) * nloc) {
            __builtin_amdgcn_fence(__ATOMIC_RELEASE, "agent");
            asm volatile("s_waitcnt vmcnt(0)" ::: "memory");
            const unsigned og = xb_add(&bar[XB_TOP], 1u);
            const unsigned tg = og / nx;
            if (og + 1u == (tg + 1u) * nx) xb_add(&bar[XB_TOPGEN], 1u);
            else XB_SPIN(xb_ld(&bar[XB_TOPGEN]) == tg, bar);
            __builtin_amdgcn_fence(__ATOMIC_ACQUIRE, "agent");
            xb_add(&bar[XB_XGEN(b.x)], 1u);
            asm volatile("s_waitcnt vmcnt(0)" ::: "memory");
        } else {
            XB_SPIN(xb_ld(&bar[XB_XGEN(b.x)]) == gen, bar);
            __builtin_amdgcn_fence(__ATOMIC_ACQUIRE, "agent");
            asm volatile("s_waitcnt vmcnt(0)" ::: "memory");
        }
    }
    __syncthreads();
}

struct Params {
    const float *x, *c, *ctx, *c_ctx, *w_ada, *b_ada, *norm_mix, *norm_ffn, *w_in, *attn_sink,
        *a_re, *a_im, *log_dt, *b_re, *b_im, *c_re, *c_im, *ssm_d, *w_glu, *b_glu, *norm_attn_out, *norm_ssm_out,
        *w_out, *w_router, *router_bias, *w_gate_e, *w_up_e, *w_down_e, *w_gate_s, *w_up_s, *w_down_s, *norm_final;
    float* out;
    char* ws;
};

constexpr size_t A256(size_t v) { return (v + 255) & ~(size_t)255; }
constexpr size_t OFF_BAR   = 0;
constexpr size_t OFF_RSQ   = A256(OFF_BAR + XCD_BAR_WORDS * 4 + 1024);
#define FLAG_PER_CLASS 1280
constexpr size_t OFF_FLAG  = OFF_RSQ + (size_t)NLAT * 2 * 4;
constexpr size_t ZERO_BYTES = OFF_FLAG + (8 * FLAG_PER_CLASS + 64) * 4;
constexpr size_t OFF_MOD   = A256(ZERO_BYTES);
constexpr size_t OFF_ROPE  = A256(OFF_MOD + 9 * 6144 * 4);
constexpr size_t OFF_KBUF  = A256(OFF_ROPE + 64 * 16 * 8);
constexpr size_t OFF_ELIST = A256(OFF_KBUF + (size_t)32 * 2 * 4096 * 4);
constexpr size_t OFF_WSL   = A256(OFF_ELIST + (size_t)2 * 64 * 8192 * 4);
constexpr size_t OFF_WDT   = A256(OFF_WSL + (size_t)2 * 64 * 8192 * 4);
constexpr size_t OFF_HHS   = A256(OFF_WDT + (size_t)65 * 1024 * 128 * 2);
constexpr size_t OFF_WGUT  = A256(OFF_HHS + (size_t)2 * 73728 * 128 * 2);
constexpr size_t OFF_H2R   = A256(OFF_WGUT + (size_t)65 * 256 * 1024 * 2);
constexpr size_t OFF_ARENA = A256(OFF_H2R + (size_t)NLAT * 1024 * 2);
constexpr size_t OFF_TABS  = OFF_ARENA;
constexpr size_t OFF_TABY  = A256(OFF_TABS + (size_t)32 * 256 * 256 * 2);
constexpr size_t OFF_R1    = A256(OFF_TABY + (size_t)32 * 256 * 512 * 2);
constexpr size_t OFF_R2    = A256(OFF_R1 + (size_t)NROWS * 1024 * 2);
constexpr size_t OFF_R4    = A256(OFF_R2 + (size_t)NLAT * 1024 * 2);
constexpr size_t OFF_WINT  = A256(OFF_R4 + (size_t)NLAT * 512 * 2 * 2);
constexpr size_t OFF_WGLUT = A256(OFF_WINT + (size_t)1280 * 1024 * 2);
constexpr size_t OFF_WOUTT = A256(OFF_WGLUT + (size_t)512 * 512 * 2);
constexpr size_t OFF_WRT   = A256(OFF_WOUTT + (size_t)1024 * 1024 * 2);
constexpr size_t OFF_EARLY_END = A256(OFF_WRT + (size_t)128 * 1024 * 2);
constexpr size_t YD8_BYTES = (size_t)NLAT * 8 * 1024;
constexpr size_t OFF_END   = (OFF_EARLY_END > OFF_ARENA + YD8_BYTES) ? OFF_EARLY_END : A256(OFF_ARENA + YD8_BYTES);
static_assert(OFF_END <= (size_t)256 * 1024 * 1024, "workspace map must fit the guaranteed 256 MiB");
#define CTR_QS1 160
#define WSP_bar   ((unsigned*)(p.ws + OFF_BAR))
#define WSP_ctr   ((unsigned*)(p.ws + OFF_BAR) + XCD_BAR_WORDS)
#define WSP_rsq   ((float*)(p.ws + OFF_RSQ))
#define WSP_flag  ((unsigned*)(p.ws + OFF_FLAG))
#define WSP_mod   ((float*)(p.ws + OFF_MOD))
#define WSP_rope  ((float2*)(p.ws + OFF_ROPE))
#define WSP_Kbuf  ((float*)(p.ws + OFF_KBUF))
#define WSP_elist ((int*)(p.ws + OFF_ELIST))
#define WSP_wsl   ((float*)(p.ws + OFF_WSL))
#define WSP_WinT  ((u16*)(p.ws + OFF_WINT))
#define WSP_WgluT ((u16*)(p.ws + OFF_WGLUT))
#define WSP_WoutT ((u16*)(p.ws + OFF_WOUTT))
#define WSP_WrT   ((u16*)(p.ws + OFF_WRT))
#define WSP_WdT   ((u16*)(p.ws + OFF_WDT))
#define WSP_HHs   ((u16*)(p.ws + OFF_HHS))
#define WSP_WguT  ((u16*)(p.ws + OFF_WGUT))
#define WSP_TabS  ((u16*)(p.ws + OFF_TABS))
#define WSP_TabY  ((u16*)(p.ws + OFF_TABY))
#define WSP_Hb    ((u16*)(p.ws + OFF_R1))
#define WSP_S     ((float*)(p.ws + OFF_R1))
#define WSP_H2    ((u16*)(p.ws + OFF_H2R))
#define WSP_Q     ((u16*)(p.ws + OFF_R2))
#define WSP_Kb    ((u16*)(p.ws + OFF_R2 + (size_t)NLAT * 512 * 2))
#define WSP_Vt    ((u16*)(p.ws + OFF_R2 + (size_t)NLAT * 512 * 2 + (size_t)NROWS * 128 * 2))
#define WSP_Y     ((u16*)(p.ws + OFF_R2))
#define WSP_SO    ((u16*)(p.ws + OFF_R2 + (size_t)NLAT * 512 * 2))
#define WSP_U     ((u16*)(p.ws + OFF_H2R))
#define WSP_AO    ((u16*)(p.ws + OFF_R4))
#define WSP_Hin   ((u16*)(p.ws + OFF_R4 + (size_t)NLAT * 512 * 2))

extern __shared__ __attribute__((aligned(16))) char smem[];

typedef __bf16 bf2_t __attribute__((ext_vector_type(2)));
typedef float f2_t __attribute__((ext_vector_type(2)));
__device__ __forceinline__ unsigned pack2(float a, float b) {
    const f2_t v = {a, b};
    return __builtin_bit_cast(unsigned, __builtin_convertvector(v, bf2_t));
}
__device__ __forceinline__ u16 f2bf(float f) { return (u16)(pack2(f, 0.f) & 0xffffu); }
__device__ __forceinline__ float bf2f(u16 h) { return __uint_as_float(((unsigned)h) << 16); }
__device__ __forceinline__ void glds16(const void* g, void* l) {
    __builtin_amdgcn_global_load_lds((const unsigned*)g, (unsigned*)l, 16, 0, 0);
}
__device__ __forceinline__ void glds16_sc1(const void* g, void* l) {
    __builtin_amdgcn_global_load_lds((const unsigned*)g, (unsigned*)l, 16, 0, 16);
}
__device__ __forceinline__ int lds_byte(int r, int c) {
    int st = (r >> 4) * 2 + (c >> 5), rr = r & 15, cc = c & 31, ob = rr * 64 + cc * 2;
    return st * 1024 + (ob ^ (((ob >> 9) & 1) << 5));
}
template <int CTRL> __device__ __forceinline__ float dppf(float v) {
    return __int_as_float(__builtin_amdgcn_update_dpp(0, __float_as_int(v), CTRL, 0xf, 0xf, true));
}
__device__ __forceinline__ float sum_x16(float v) {
    const unsigned u = __float_as_uint(v);
    const auto r = __builtin_amdgcn_permlane16_swap(u, u, false, false);
    return __uint_as_float(r[0]) + __uint_as_float(r[1]);
}
__device__ __forceinline__ float sum_x32(float v) {
    const unsigned u = __float_as_uint(v);
    const auto r = __builtin_amdgcn_permlane32_swap(u, u, false, false);
    return __uint_as_float(r[0]) + __uint_as_float(r[1]);
}
__device__ __forceinline__ float max_x16(float v) {
    const unsigned u = __float_as_uint(v);
    const auto r = __builtin_amdgcn_permlane16_swap(u, u, false, false);
    return fmaxf(__uint_as_float(r[0]), __uint_as_float(r[1]));
}
__device__ __forceinline__ float max_x32(float v) {
    const unsigned u = __float_as_uint(v);
    const auto r = __builtin_amdgcn_permlane32_swap(u, u, false, false);
    return fmaxf(__uint_as_float(r[0]), __uint_as_float(r[1]));
}
__device__ __forceinline__ float sum16(float v) {
    v += dppf<0xB1>(v);
    v += dppf<0x4E>(v);
    v += dppf<0x141>(v);
    v += dppf<0x140>(v);
    return v;
}
__device__ __forceinline__ float wave_sum(float v) { return sum_x32(sum_x16(sum16(v))); }
template <int CTRL> __device__ __forceinline__ float dpp_f(float v) {
    return __int_as_float(__builtin_amdgcn_update_dpp(0, __float_as_int(v), CTRL, 0xf, 0xf, true));
}
__device__ __forceinline__ float max8(float v) {
    v = fmaxf(v, dpp_f<0xB1>(v));
    v = fmaxf(v, dpp_f<0x4E>(v));
    v = fmaxf(v, dpp_f<0x141>(v));
    return v;
}
__device__ __forceinline__ float sigmoidf_(float x) { return __builtin_amdgcn_rcpf(1.f + __expf(-x)); }
__device__ __forceinline__ float siluf_(float x) { return x * __builtin_amdgcn_rcpf(1.f + __expf(-x)); }
__device__ __forceinline__ float gelu_tanh(float x) {
    float u = 0.7978845608028654f * (x + 0.044715f * x * x * x);
    return x * __builtin_amdgcn_rcpf(1.f + __expf(-2.f * u));
}

template <class FA, class FB>
__device__ __forceinline__ void gemm_tile(int nkt, FA fa, FB fb, f32x4 (&acc)[4][4]) {
    const int tid = TIDX, lane = tid & 63, wid = tid >> 6, wr = wid >> 1, wc = wid & 1, fr = lane & 15, fq = lane >> 4;
    const int sb = lane * 16, swz = sb ^ (((sb >> 9) & 1) << 5);
    const int r_in = swz >> 6, c_in = (swz & 63) >> 1;
#pragma unroll
    for (int m = 0; m < 4; ++m)
#pragma unroll
        for (int n = 0; n < 4; ++n) acc[m][n] = (f32x4){0.f, 0.f, 0.f, 0.f};
    __syncthreads();
    auto stage = [&](int kt, int s) {
        char* sa = smem + s * 32768;
        char* sbm = sa + 16384;
#pragma unroll
        for (int i = 0; i < 4; ++i) {
            const int st = wid + 4 * i, R = (st >> 1) * 16 + r_in, C = (st & 1) * 32 + c_in;
            glds16(fa(R, C, kt), sa + tid * 16 + i * 4096);
            glds16(fb(R, C, kt), sbm + tid * 16 + i * 4096);
        }
    };
    stage(0, 0);
    for (int kt = 0; kt < nkt; ++kt) {
        asm volatile("s_waitcnt vmcnt(0)" ::: "memory");
        __syncthreads();
        if (kt + 1 < nkt) stage(kt + 1, (kt + 1) & 1);
        const char* sa = smem + (kt & 1) * 32768;
        const char* sbm = sa + 16384;
#pragma unroll
        for (int ks = 0; ks < 2; ++ks) {
            bf16x8 a[4], b[4];
#pragma unroll
            for (int m = 0; m < 4; ++m) a[m] = *(const bf16x8*)(sa + lds_byte(wr * 64 + m * 16 + fr, ks * 32 + fq * 8));
#pragma unroll
            for (int n = 0; n < 4; ++n) b[n] = *(const bf16x8*)(sbm + lds_byte(wc * 64 + n * 16 + fr, ks * 32 + fq * 8));
#pragma unroll
            for (int m = 0; m < 4; ++m)
#pragma unroll
                for (int n = 0; n < 4; ++n) acc[m][n] = __builtin_amdgcn_mfma_f32_16x16x32_bf16(a[m], b[n], acc[m][n], 0, 0, 0);
        }
    }
    __syncthreads();
}

__device__ __forceinline__ int lds32(int r, int c) {
    const int rr = r & 15;
    return (r >> 4) * 1024 + ((rr * 64 + c * 2) ^ (((rr >> 3) & 1) << 5));
}
struct NoHook { __device__ __forceinline__ void operator()(int) const {} };
template <bool A_SC1 = false, class FA, class FB, class HK = NoHook>
__device__ __forceinline__ void gemm_tile_w(int nkt, FA fa, FB fb, f32x4 (&acc)[4][8], HK hook = HK()) {
    constexpr bool ZERO = true;
    const int tid = TIDX, lane = tid & 63, wid = tid >> 6, wr = wid >> 1, wc = wid & 1, fr = lane & 15, fq = lane >> 4;
    const int sb = lane * 16, swz = sb ^ (((sb >> 9) & 1) << 5);
    const int r_in = swz >> 6, c_in = (swz & 63) >> 1;
    if (ZERO) {
#pragma unroll
        for (int m = 0; m < 4; ++m)
#pragma unroll
            for (int n = 0; n < 8; ++n) acc[m][n] = (f32x4){0.f, 0.f, 0.f, 0.f};
    }
    __syncthreads();
    auto stage = [&](int kt, int s) {
        char* sa = smem + s * 24576;
#pragma unroll
        for (int i = 0; i < 2; ++i) { if (A_SC1) glds16_sc1(fa(i, (wid + 4 * i) * 16 + r_in, c_in, kt), sa + tid * 16 + i * 4096); else glds16(fa(i, (wid + 4 * i) * 16 + r_in, c_in, kt), sa + tid * 16 + i * 4096); }
#pragma unroll
        for (int i = 0; i < 4; ++i) glds16(fb(i, (wid + 4 * i) * 16 + r_in, c_in, kt), sa + 8192 + tid * 16 + i * 4096);
    };
    stage(0, 0);
    if (nkt > 1) stage(1, 1);
    int s_cur = 0, s_nxt = 2;
    for (int kt = 0; kt < nkt; ++kt) {
        hook(kt);
        if (kt + 1 < nkt) asm volatile("s_waitcnt vmcnt(6) lgkmcnt(0)\n\ts_barrier" ::: "memory");
        else asm volatile("s_waitcnt vmcnt(0) lgkmcnt(0)\n\ts_barrier" ::: "memory");
        if (kt + 2 < nkt) stage(kt + 2, s_nxt);
        const char* sa = smem + s_cur * 24576;
        bf16x8 a[4];
#pragma unroll
        for (int m = 0; m < 4; ++m) a[m] = *(const bf16x8*)(sa + lds32(wr * 64 + m * 16 + fr, fq * 8));
#pragma unroll
        for (int nh = 0; nh < 2; ++nh) {
            bf16x8 b[4];
#pragma unroll
            for (int n = 0; n < 4; ++n) b[n] = *(const bf16x8*)(sa + 8192 + lds32(wc * 128 + (nh * 4 + n) * 16 + fr, fq * 8));
#pragma unroll
            for (int m = 0; m < 4; ++m)
#pragma unroll
                for (int n = 0; n < 4; ++n) acc[m][nh * 4 + n] = __builtin_amdgcn_mfma_f32_16x16x32_bf16(a[m], b[n], acc[m][nh * 4 + n], 0, 0, 0);
        }
        s_cur = (s_cur == 2) ? 0 : s_cur + 1;
        s_nxt = (s_nxt == 2) ? 0 : s_nxt + 1;
    }
    __syncthreads();
}

template <class FV, class FD>
__device__ __forceinline__ void wave_store_bf16_f(FV val, FD dst, bool write_through = false, const char* wt_base = nullptr, unsigned wt_bytes = 0) {
    const __amdgpu_buffer_rsrc_t wt_rsrc = __builtin_amdgcn_make_buffer_rsrc((void*)wt_base, 0, (int)wt_bytes, 0x00020000);
    const int lane = TIDX & 63, wid = TIDX >> 6, fr = lane & 15, fq = lane >> 4;
    char* base = smem + wid * 9216;
#pragma unroll
    for (int m = 0; m < 4; ++m)
#pragma unroll
        for (int n = 0; n < 4; ++n)
#pragma unroll
            for (int j = 0; j < 4; ++j)
                *(u16*)(base + (m * 16 + fq * 4 + j) * 144 + (n * 16 + fr) * 2) = f2bf(val(m, n, j));
    asm volatile("s_waitcnt lgkmcnt(0)" ::: "memory");
    __builtin_amdgcn_wave_barrier();
#pragma unroll
    for (int i = 0; i < 8; ++i) {
        const int id = i * 64 + lane, row = id >> 3, ch = id & 7;
        const uint4 d = *(const uint4*)(base + row * 144 + ch * 16);
        u16* p = dst(row);
        if (p) {
            if (write_through) {
                const u32x4 dv = {d.x, d.y, d.z, d.w};
                __builtin_amdgcn_raw_buffer_store_b128(dv, wt_rsrc, (int)((const char*)(p + ch * 8) - wt_base), 0, 16);
            } else *(uint4*)(p + ch * 8) = d;
        }
    }
    asm volatile("s_waitcnt lgkmcnt(0)" ::: "memory");
    __builtin_amdgcn_wave_barrier();
}

template <class FD>
__device__ __forceinline__ void wave_store_bf16(const float (&v)[4][4][4], FD dst) {
    wave_store_bf16_f([&](int m, int n, int j) { return v[m][n][j]; }, dst);
}

struct ConvD { const float* src; u16* dst; int ld, ldd, k0, n0, mode, zr; };
__device__ __forceinline__ void conv_load(const Params& p, const ConvD& d, float (&v)[16]) {
    const int tid = TIDX;
#pragma unroll
    for (int i = 0; i < 16; ++i) v[i] = d.src[(size_t)(d.k0 + i * 4 + (tid >> 6)) * d.ld + d.n0 + (tid & 63)];
    if (d.zr == 2) {
#pragma unroll
        for (int i = 0; i < 16; ++i) {
            const int k = d.k0 + i * 4 + (tid >> 6);
            v[i] *= (k < 512) ? p.norm_attn_out[k] : p.norm_ssm_out[k - 512];
        }
    }
}
__device__ __forceinline__ void conv_store(const Params& p, const ConvD& d, const float (&v)[16]) {
    float* t = (float*)smem;
    const int tid = TIDX;
    __syncthreads();
#pragma unroll
    for (int i = 0; i < 16; ++i) t[(i * 4 + (tid >> 6)) * 65 + (tid & 63)] = v[i];
    __syncthreads();
    const int n = tid >> 2, kq = tid & 3;
    unsigned w[8];
#pragma unroll
    for (int i = 0; i < 8; ++i) w[i] = pack2(t[(kq * 16 + 2 * i) * 65 + n], t[(kq * 16 + 2 * i + 1) * 65 + n]);
    const int gn = d.n0 + n;
    int row = gn;
    if (d.mode == 1) row = (gn >> 4) * 32 + (gn & 15);
    else if (d.mode == 2) row = (gn >> 4) * 32 + 16 + (gn & 15);
    else if (d.mode == 3) row = n;
    uint4* o = (uint4*)(d.dst + (size_t)row * d.ldd + d.k0 + kq * 16);
    o[0] = make_uint4(w[0], w[1], w[2], w[3]);
    o[1] = make_uint4(w[4], w[5], w[6], w[7]);
    if (d.zr == 1) {
        uint4* z = (uint4*)(WSP_WrT + (size_t)(64 + n) * 1024 + d.k0 + kq * 16);
        z[0] = make_uint4(0, 0, 0, 0); z[1] = make_uint4(0, 0, 0, 0);
    }
}

__device__ __forceinline__ void ada_item(const Params& p, int item) {
    float* sc = (float*)smem;
    float* red = sc + 9 * 1024;
    const int tid = TIDX;
    __syncthreads();
    for (int i = tid; i < 9 * 1024; i += NTHR) {
        const int r = i >> 10, k = i & 1023;
        const float cv = (r < 8) ? p.c[r * 1024 + k] : p.c_ctx[k];
        sc[i] = siluf_(cv);
    }
    __syncthreads();
    const int kq = tid >> 6, jl = tid & 63, j = item * 64 + jl;
    float acc[9];
#pragma unroll
    for (int r = 0; r < 9; ++r) acc[r] = 0.f;
#pragma unroll 16
    for (int k = kq; k < 1024; k += 4) {
        const float w = p.w_ada[(size_t)k * 6144 + j];
#pragma unroll
        for (int r = 0; r < 9; ++r) acc[r] += sc[r * 1024 + k] * w;
    }
#pragma unroll
    for (int r = 0; r < 9; ++r) red[(kq * 9 + r) * 64 + jl] = acc[r];
    __syncthreads();
    for (int i = tid; i < 9 * 64; i += NTHR) {
        const int r = i >> 6, l = i & 63;
        const float s = red[(0 * 9 + r) * 64 + l] + red[(1 * 9 + r) * 64 + l] + red[(2 * 9 + r) * 64 + l] + red[(3 * 9 + r) * 64 + l];
        WSP_mod[r * 6144 + item * 64 + l] = s + p.b_ada[item * 64 + l];
    }
}

__device__ __forceinline__ void rope_item(const Params& p) {
    for (int i = TIDX; i < 64 * 16; i += NTHR) {
        const int pos = i >> 4, k = i & 15;
        const float inv = exp2f(-(float)k * (13.287712379549449f / 16.f));
        float s, c;
        sincosf((float)pos * inv, &s, &c);
        WSP_rope[i] = make_float2(c, s);
    }
}

__device__ __forceinline__ void ssm_table_item(const Params& p, int g, int dir) {
    float* pw = (float*)smem;
    float* Bb = pw + 17 * 64 * 2;
    float* Cc = Bb + 64 * 16 * 2;
    const int tid = TIDX;
    u16* tabS = WSP_TabS + (size_t)g * 256 * 256;
    u16* tabY = WSP_TabY + (size_t)g * 256 * 512;
    float* Kf = WSP_Kbuf + (size_t)(g * 2 + dir) * 4096;
    __syncthreads();
    {
        const int pidx = dir * 32 + g;
        const float dt = __expf(p.log_dt[pidx]);
        for (int i = tid; i < 17 * 64; i += NTHR) {
            const int tau = i >> 6, n = i & 63;
            const float are = p.a_re[pidx * 64 + n], aim = p.a_im[pidx * 64 + n];
            const float mag = __expf((float)tau * dt * are);
            float rev = (float)tau * (dt * aim * 0.15915494309189535f);
            rev -= rintf(rev);
            pw[i * 2] = mag * __builtin_amdgcn_cosf(rev);
            pw[i * 2 + 1] = mag * __builtin_amdgcn_sinf(rev);
        }
        __syncthreads();
        for (int i = tid; i < 64 * 16; i += NTHR) {
            const int n = i >> 4;
            const float are = p.a_re[pidx * 64 + n], aim = p.a_im[pidx * 64 + n];
            const float abr = pw[(64 + n) * 2], abi = pw[(64 + n) * 2 + 1];
            const float den = are * are + aim * aim, nre = abr - 1.f;
            const float cre = (nre * are + abi * aim) / den, cim = (abi * are - nre * aim) / den;
            const float br = p.b_re[(size_t)pidx * 1024 + i], bi = p.b_im[(size_t)pidx * 1024 + i];
            Bb[i * 2] = cre * br - cim * bi;
            Bb[i * 2 + 1] = cre * bi + cim * br;
            Cc[i * 2] = p.c_re[(size_t)pidx * 1024 + i];
            Cc[i * 2 + 1] = p.c_im[(size_t)pidx * 1024 + i];
        }
        __syncthreads();
        {
            const int tau = tid >> 4, pp = tid & 15;
            float s[16];
#pragma unroll
            for (int q = 0; q < 16; ++q) s[q] = 0.f;
            for (int n = 0; n < 64; ++n) {
                const float2 cv = *(const float2*)&Cc[(pp * 64 + n) * 2];
                const float2 wv = *(const float2*)&pw[(tau * 64 + n) * 2];
                const float zr = cv.x * wv.x - cv.y * wv.y, zi = cv.x * wv.y + cv.y * wv.x;
#pragma unroll
                for (int q = 0; q < 16; ++q) {
                    const float2 bv = *(const float2*)&Bb[(n * 16 + q) * 2];
                    s[q] += zr * bv.x - zi * bv.y;
                }
            }
#pragma unroll
            for (int q = 0; q < 4; ++q)
                *(float4*)(Kf + tau * 256 + pp * 16 + q * 4) = make_float4(s[4 * q], s[4 * q + 1], s[4 * q + 2], s[4 * q + 3]);
        }
        for (int id = tid; id < 128 * 32; id += NTHR) {
            const int rr = id >> 5, ch = id & 31, cpart = rr >> 6, n = rr & 63, s_ = ch >> 1, q0 = (ch & 1) * 8;
            const int e = dir == 0 ? 15 - s_ : s_;
            const float wr_ = pw[(e * 64 + n) * 2], wi_ = pw[(e * 64 + n) * 2 + 1];
            unsigned w[4];
#pragma unroll
            for (int i = 0; i < 4; ++i) {
                float v[2];
#pragma unroll
                for (int h = 0; h < 2; ++h) {
                    const float br = Bb[(n * 16 + q0 + 2 * i + h) * 2], bi = Bb[(n * 16 + q0 + 2 * i + h) * 2 + 1];
                    v[h] = cpart == 0 ? (wr_ * br - wi_ * bi) : (wr_ * bi + wi_ * br);
                }
                w[i] = pack2(v[0], v[1]);
            }
            *(uint4*)(tabS + (size_t)(dir * 128 + rr) * 256 + s_ * 16 + q0) = make_uint4(w[0], w[1], w[2], w[3]);
        }
        for (int id = tid; id < 256 * 16; id += NTHR) {
            const int m = id >> 4, ch = id & 15, t = m >> 4, pp = m & 15, cpart = ch >> 3, n0 = (ch & 7) * 8;
            const int e = dir == 0 ? t + 1 : 16 - t;
            unsigned w[4];
#pragma unroll
            for (int i = 0; i < 4; ++i) {
                float v[2];
#pragma unroll
                for (int h = 0; h < 2; ++h) {
                    const int n = n0 + 2 * i + h;
                    const float cr = Cc[(pp * 64 + n) * 2], ci = Cc[(pp * 64 + n) * 2 + 1];
                    const float wr_ = pw[(e * 64 + n) * 2], wi_ = pw[(e * 64 + n) * 2 + 1];
                    v[h] = cpart == 0 ? (cr * wr_ - ci * wi_) : -(cr * wi_ + ci * wr_);
                }
                w[i] = pack2(v[0], v[1]);
            }
            *(uint4*)(tabY + (size_t)m * 512 + 256 + dir * 128 + cpart * 64 + n0) = make_uint4(w[0], w[1], w[2], w[3]);
        }
    }
}

__device__ __forceinline__ void ssm_toeplitz_item(const Params& p, int g) {
    float* Kf = (float*)smem;
    const int tid = TIDX;
    u16* tabY = WSP_TabY + (size_t)g * 256 * 512;
    __syncthreads();
    for (int i = tid; i < 2048; i += NTHR) ((float4*)Kf)[i] = ((const float4*)(WSP_Kbuf + (size_t)g * 8192))[i];
    __syncthreads();
    for (int id = tid; id < 256 * 32; id += NTHR) {
        const int m = id >> 5, ch = id & 31, t = m >> 4, pp = m & 15, s_ = ch >> 1, q0 = (ch & 1) * 8;
        unsigned w[4];
#pragma unroll
        for (int i = 0; i < 4; ++i) {
            float v[2];
#pragma unroll
            for (int h = 0; h < 2; ++h) {
                const int q = q0 + 2 * i + h;
                float val;
                if (s_ < t) val = Kf[((t - s_) * 16 + pp) * 16 + q];
                else if (s_ > t) val = Kf[4096 + ((s_ - t) * 16 + pp) * 16 + q];
                else val = Kf[(pp) * 16 + q] + Kf[4096 + pp * 16 + q] + (pp == q ? p.ssm_d[g * 16 + pp] : 0.f);
                v[h] = val;
            }
            w[i] = pack2(v[0], v[1]);
        }
        *(uint4*)(tabY + (size_t)m * 512 + s_ * 16 + q0) = make_uint4(w[0], w[1], w[2], w[3]);
    }
    __syncthreads();
}

#define N_CONV 6896
__device__ __forceinline__ ConvD conv_decode(const Params& p, int t) {
    ConvD d; d.mode = 0; d.zr = 0;
    if (t < 320) { d.src = p.w_in; d.ld = 1280; d.k0 = (t / 20) * 64; d.n0 = (t % 20) * 64; d.dst = WSP_WinT; d.ldd = 1024; return d; }
    t -= 320;
    if (t < 64) { d.src = p.w_glu; d.ld = 512; d.k0 = (t / 8) * 64; d.n0 = (t % 8) * 64; d.dst = WSP_WgluT; d.ldd = 512; return d; }
    t -= 64;
    if (t < 256) { d.src = p.w_out; d.ld = 1024; d.k0 = (t / 16) * 64; d.n0 = (t % 16) * 64; d.dst = WSP_WoutT; d.ldd = 1024; d.zr = 2; return d; }
    t -= 256;
    if (t < 16) { d.src = p.w_router; d.ld = 64; d.k0 = t * 64; d.n0 = 0; d.dst = WSP_WrT; d.ldd = 1024; d.zr = 1; return d; }
    t -= 16;
    if (t < 4096) {
        const int up = t >= 2048; const int tt = t & 2047, e = tt >> 5, r = tt & 31;
        d.src = (up ? p.w_up_e : p.w_gate_e) + (size_t)e * 131072; d.ld = 128; d.k0 = (r >> 1) * 64; d.n0 = (r & 1) * 64;
        d.dst = WSP_WguT + (size_t)e * 262144; d.ldd = 1024; d.mode = 1 + up; return d;
    }
    t -= 4096;
    if (t < 64) {
        const int up = t >= 32; const int r = t & 31;
        d.src = up ? p.w_up_s : p.w_gate_s; d.ld = 128; d.k0 = (r >> 1) * 64; d.n0 = (r & 1) * 64;
        d.dst = WSP_WguT + (size_t)64 * 262144; d.ldd = 1024; d.mode = 1 + up; return d;
    }
    t -= 64;
    if (t < 2048) { const int e = t >> 5, r = t & 31; d.src = p.w_down_e + (size_t)e * 131072; d.ld = 1024; d.k0 = (r >> 4) * 64; d.n0 = (r & 15) * 64; d.dst = WSP_WdT + (size_t)e * 131072; d.ldd = 128; return d; }
    t -= 2048;
    d.src = p.w_down_s; d.ld = 1024; d.k0 = (t >> 4) * 64; d.n0 = (t & 15) * 64; d.dst = WSP_WdT + (size_t)64 * 131072; d.ldd = 128; return d;
}

#define N_CONV_EARLY 4000
__device__ __forceinline__ void conv_range(const Params& p, int t0, int stride, int tend, int tbeg = 0) {
    int t = tbeg + t0;
    if (t < tend) {
        ConvD d = conv_decode(p, t);
        float v[16];
        conv_load(p, d, v);
        while (t < tend) {
            const int tn = t + stride;
            ConvD dn = d;
            float vn[16];
            if (tn < tend) { dn = conv_decode(p, tn); conv_load(p, dn, vn); }
            conv_store(p, d, v);
            d = dn;
#pragma unroll
            for (int i = 0; i < 16; ++i) v[i] = vn[i];
            t = tn;
        }
    }
}
#define P0_CONV_B0 161
__device__ __forceinline__ void phase0(const Params& p) {
    const int b = blockIdx.x, G = gridDim.x;
    if (G > P0_CONV_B0 + 32) {
        if (b < 64) ssm_table_item(p, b >> 1, b & 1);
        else if (b < 160) ada_item(p, b - 64);
        else if (b == 160) rope_item(p);
        else conv_range(p, b - P0_CONV_B0, G - P0_CONV_B0, N_CONV_EARLY);
    } else {
        const int NU = 64 + 96 + 1 + N_CONV_EARLY;
        for (int u = b; u < NU; u += G) {
            if (u < 64) ssm_table_item(p, u >> 1, u & 1);
            else if (u < 160) ada_item(p, u - 64);
            else if (u == 160) rope_item(p);
            else { ConvD d = conv_decode(p, u - 161); float v[16]; conv_load(p, d, v); conv_store(p, d, v); }
        }
    }
}
#if 0
    {
        {
            const int stride = G - P0_CONV_B0;
            int t = b - P0_CONV_B0;
            if (t < N_CONV) {
                ConvD d = conv_decode(p, t);
                float v[16];
                conv_load(p, d, v);
                while (t < N_CONV) {
                    const int tn = t + stride;
                    ConvD dn = d;
                    float vn[16];
                    if (tn < N_CONV) { dn = conv_decode(p, tn); conv_load(p, dn, vn); }
                    conv_store(p, d, v);
                    d = dn;
#pragma unroll
                    for (int i = 0; i < 16; ++i) v[i] = vn[i];
                    t = tn;
                }
            }
        }
    } else {
        const int NU = 64 + 96 + 1 + N_CONV;
        for (int u = b; u < NU; u += G) {
            if (u < 64) ssm_table_item(p, u >> 1, u & 1);
            else if (u < 160) ada_item(p, u - 64);
            else if (u == 160) rope_item(p);
            else { ConvD d = conv_decode(p, u - 161); float v[16]; conv_load(p, d, v); conv_store(p, d, v); }
        }
    }
}

#endif

__device__ __forceinline__ void norm_mod_row(const float* src, const float* gain, const float* sh, const float* scl, u16* dst) {
    const int lane = TIDX & 63;
    float4 v[4];
    float ss = 0.f;
#pragma unroll
    for (int i = 0; i < 4; ++i) {
        v[i] = *(const float4*)(src + i * 256 + lane * 4);
        ss += v[i].x * v[i].x + v[i].y * v[i].y + v[i].z * v[i].z + v[i].w * v[i].w;
    }
    ss = wave_sum(ss);
    const float rs = rsqrtf(ss * (1.f / 1024.f) + EPS);
#pragma unroll
    for (int i = 0; i < 4; ++i) {
        const int c0 = i * 256 + lane * 4;
        const float4 g = *(const float4*)(gain + c0), s = *(const float4*)(sh + c0), k = *(const float4*)(scl + c0);
        const float a = v[i].x * rs * g.x * (1.f + k.x) + s.x, b = v[i].y * rs * g.y * (1.f + k.y) + s.y;
        const float c = v[i].z * rs * g.z * (1.f + k.z) + s.z, d = v[i].w * rs * g.w * (1.f + k.w) + s.w;
        *(uint2*)(dst + c0) = make_uint2(pack2(a, b), pack2(c, d));
    }
}

__device__ __forceinline__ void phase1(const Params& p) {
    const int wv = blockIdx.x * 4 + (TIDX >> 6), nwv = gridDim.x * 4;
    const int lane = TIDX & 63;
    for (int r0 = wv * 4; r0 < NROWS; r0 += nwv * 4) {
        const float* src[4]; const float* md[4];
        float4 v[4][4];
#pragma unroll
        for (int q = 0; q < 4; ++q) {
            const int r = r0 + q;
            if (r < NLAT) { src[q] = p.x + (size_t)r * 1024; md[q] = WSP_mod + (r >> 11) * 6144; }
            else { src[q] = p.ctx + (size_t)(r - NLAT) * 1024; md[q] = WSP_mod + 8 * 6144; }
#pragma unroll
            for (int i = 0; i < 4; ++i) v[q][i] = *(const float4*)(src[q] + i * 256 + lane * 4);
        }
#pragma unroll
        for (int q = 0; q < 4; ++q) {
            float ss = 0.f;
#pragma unroll
            for (int i = 0; i < 4; ++i) ss += v[q][i].x * v[q][i].x + v[q][i].y * v[q][i].y + v[q][i].z * v[q][i].z + v[q][i].w * v[q][i].w;
            ss = wave_sum(ss);
            const float rs = rsqrtf(ss * (1.f / 1024.f) + EPS);
            u16* dst = WSP_Hb + (size_t)(r0 + q) * 1024;
#pragma unroll
            for (int i = 0; i < 4; ++i) {
                const int c0 = i * 256 + lane * 4;
                const float4 g = *(const float4*)(p.norm_mix + c0), s = *(const float4*)(md[q] + c0), k = *(const float4*)(md[q] + 1024 + c0);
                const float a = v[q][i].x * rs * g.x * (1.f + k.x) + s.x, b = v[q][i].y * rs * g.y * (1.f + k.y) + s.y;
                const float c = v[q][i].z * rs * g.z * (1.f + k.z) + s.z, d = v[q][i].w * rs * g.w * (1.f + k.w) + s.w;
                *(uint2*)(dst + c0) = make_uint2(pack2(a, b), pack2(c, d));
            }
        }
    }
}

__device__ __forceinline__ void phase2(const Params& p) {
    const int NU = 128 * 10 + 16 * 6;
    const int lane = TIDX & 63, wid = TIDX >> 6, wr = wid >> 1, wc = wid & 1, fr = lane & 15, fq = lane >> 4;
    for (int u = blockIdx.x; u < NU; u += gridDim.x) {
        int mt, nt;
        {
            const int xc = u & 7, r = u >> 3;
            if (r < 160) { mt = xc + 8 * (r / 10); nt = r % 10; } else { const int v = r - 160; mt = 128 + xc + 8 * (v / 6); nt = 4 + v % 6; }
        }
        const u16* A = WSP_Hb + (size_t)mt * 128 * 1024;
        const u16* B = WSP_WinT + (size_t)nt * 128 * 1024;
        f32x4 acc[4][4];
        gemm_tile(16,
            [&](int R, int C, int kt) { return (const void*)(A + (size_t)R * 1024 + kt * 64 + C); },
            [&](int R, int C, int kt) { return (const void*)(B + (size_t)R * 1024 + kt * 64 + C); }, acc);
        const int row0 = mt * 128 + wr * 64;
        const int col0 = nt * 128 + wc * 64;
        const bool is_lat = mt < 128;
        if (nt == 5) {
            const int kvh = wc;
#pragma unroll
            for (int m = 0; m < 4; ++m) {
                const int r = row0 + m * 16 + fq * 4;
                int b, pos;
                if (is_lat) { b = r >> 11; pos = r & 2047; } else { const int rc = r - NLAT; b = rc >> 8; pos = SEQ + (rc & 255); }
#pragma unroll
                for (int n = 0; n < 4; ++n) {
                    const int d = n * 16 + fr;
                    u16* dst = WSP_Vt + ((size_t)(b * 2 + kvh) * 64 + d) * VT_LD + pos;
                    *(uint2*)dst = make_uint2(pack2(acc[m][n][0], acc[m][n][1]), pack2(acc[m][n][2], acc[m][n][3]));
                }
            }
        } else {
            float v[4][4][4];
            const bool do_rope = is_lat && nt <= 4;
#pragma unroll
            for (int m = 0; m < 4; ++m)
#pragma unroll
                for (int j = 0; j < 4; ++j) {
                    if (do_rope) {
                        const int r = row0 + m * 16 + fq * 4 + j, pos = r & 2047;
                        const float2 cr = WSP_rope[(pos >> 6) * 16 + fr], cc = WSP_rope[(pos & 63) * 16 + fr];
                        const float x1 = acc[m][0][j], x2 = acc[m][1][j], y1 = acc[m][2][j], y2 = acc[m][3][j];
                        v[m][0][j] = x1 * cr.x - x2 * cr.y; v[m][1][j] = x1 * cr.y + x2 * cr.x;
                        v[m][2][j] = y1 * cc.x - y2 * cc.y; v[m][3][j] = y1 * cc.y + y2 * cc.x;
                    } else {
#pragma unroll
                        for (int n = 0; n < 4; ++n) v[m][n][j] = acc[m][n][j];
                    }
                }
            u16* dbase; int ldd;
            if (nt < 4) { dbase = WSP_Q + (size_t)row0 * 512 + col0; ldd = 512; }
            else if (nt == 4) { dbase = WSP_Kb + (size_t)row0 * 128 + (col0 - 512); ldd = 128; }
            else { dbase = WSP_U + (size_t)row0 * 512 + (col0 - 768); ldd = 512; }
            wave_store_bf16(v, [&](int row) { return dbase + (size_t)row * ldd; });
        }
    }
}

__device__ __forceinline__ void attn_unit(const Params& p, int u) {
    const int h = u & 7, qb = (u >> 3) & 15, b = u >> 7, kvh = h >> 2;
    const int tid = TIDX, lane = tid & 63, wid = tid >> 6, fr = lane & 15, fq = lane >> 4;
    const int sb = lane * 16, swz = sb ^ (((sb >> 9) & 1) << 5);
    const int r_in = swz >> 6, c_in = (swz & 63) >> 1;
    const int jstart = qb == 0 ? 2 : 0, jend = qb == 15 ? 4 : 6, nb = jend - jstart, ntile = nb + 4;
    const float SC = 0.125f * 1.4426950408889634f;
    bf16x8 qf[2][2];
    const int qrow0 = b * SEQ + qb * 128 + wid * 32;
#pragma unroll
    for (int qt = 0; qt < 2; ++qt)
#pragma unroll
        for (int ks = 0; ks < 2; ++ks)
            qf[qt][ks] = *(const bf16x8*)(WSP_Q + (size_t)(qrow0 + qt * 16 + fr) * 512 + h * 64 + ks * 32 + fq * 8);
    f32x4 o[4][2];
#pragma unroll
    for (int dt = 0; dt < 4; ++dt)
#pragma unroll
        for (int qt = 0; qt < 2; ++qt) o[dt][qt] = (f32x4){0.f, 0.f, 0.f, 0.f};
    float mrun[2], lrun[2];
    const float sinkv = p.attn_sink[h] * 1.4426950408889634f;
    mrun[0] = mrun[1] = sinkv;
    lrun[0] = lrun[1] = (fq == 0) ? 1.f : 0.f;
    __syncthreads();
    const u16* kp[2]; const u16* vp[2];
    {
        const int ks0 = qb * 128 - 128 + 64 * jstart;
#pragma unroll
        for (int it = 0; it < 2; ++it) {
            const int st = wid + 4 * it, R = (st >> 1) * 16 + r_in, C = (st & 1) * 32 + c_in;
            kp[it] = WSP_Kb + (size_t)(b * SEQ + ks0 + R) * 128 + kvh * 64 + C;
            vp[it] = WSP_Vt + ((size_t)(b * 2 + kvh) * 64 + R) * VT_LD + ks0 + C;
        }
    }
    auto stage = [&](int i, int s) {
        char* sk = smem + s * 16384;
        char* sv = sk + 8192;
#pragma unroll
        for (int it = 0; it < 2; ++it) {
            glds16(kp[it], sk + tid * 16 + it * 4096);
            glds16(vp[it], sv + tid * 16 + it * 4096);
        }
        if (i + 1 == nb) {
            const int ks0 = qb * 128 - 128 + 64 * (jstart + i);
#pragma unroll
            for (int it = 0; it < 2; ++it) {
                kp[it] += (size_t)(NLAT + b * CTXL - (b * SEQ + ks0)) * 128;
                vp[it] += SEQ - ks0;
            }
        } else {
#pragma unroll
            for (int it = 0; it < 2; ++it) { kp[it] += 64 * 128; vp[it] += 64; }
        }
    };
    stage(0, 0);
    for (int i = 0; i < ntile; ++i) {
        asm volatile("s_waitcnt vmcnt(0)" ::: "memory");
        __syncthreads();
        if (i + 1 < ntile) stage(i + 1, (i + 1) & 1);
        const char* sk = smem + (i & 1) * 16384;
        const char* sv = sk + 8192;
        f32x4 s[4][2];
#pragma unroll
        for (int kt = 0; kt < 4; ++kt)
#pragma unroll
            for (int qt = 0; qt < 2; ++qt) s[kt][qt] = (f32x4){0.f, 0.f, 0.f, 0.f};
#pragma unroll
        for (int ks = 0; ks < 2; ++ks)
#pragma unroll
            for (int kt = 0; kt < 4; ++kt) {
                const bf16x8 kf = *(const bf16x8*)(sk + lds_byte(32 * (kt >> 1) + 8 * (fr >> 2) + 4 * (kt & 1) + (fr & 3), ks * 32 + fq * 8));
#pragma unroll
                for (int qt = 0; qt < 2; ++qt) s[kt][qt] = __builtin_amdgcn_mfma_f32_16x16x32_bf16(kf, qf[qt][ks], s[kt][qt], 0, 0, 0);
            }
        const int ks0 = qb * 128 - 128 + 64 * (jstart + i);
        const int qlo = qb * 128 + wid * 32;
        const bool band = (i < nb) && ((qlo + 31 - ks0 > 128) || (ks0 + 63 - qlo > 128));
        bf16x8 pf[2][2];
#pragma unroll
        for (int qt = 0; qt < 2; ++qt) {
            const int qp = qb * 128 + wid * 32 + qt * 16 + fr;
            float mx = -1e30f;
            if (band) {
#pragma unroll
                for (int kt = 0; kt < 4; ++kt)
#pragma unroll
                    for (int j = 0; j < 4; ++j) {
                        const int kp = ks0 + 32 * (kt >> 1) + 8 * fq + 4 * (kt & 1) + j, d = qp - kp;
                        const float v = (d > 128 || d < -128) ? -1e30f : s[kt][qt][j];
                        s[kt][qt][j] = v;
                        mx = fmaxf(mx, v);
                    }
                asm volatile("" ::: "memory");
            } else {
#pragma unroll
                for (int kt = 0; kt < 4; ++kt)
#pragma unroll
                    for (int j = 0; j < 4; ++j) mx = fmaxf(mx, s[kt][qt][j]);
            }
            mx = max_x32(max_x16(mx));
            const float mnew = fmaxf(mrun[qt], mx * SC);
            const float alpha = __builtin_amdgcn_exp2f(mrun[qt] - mnew);
            mrun[qt] = mnew;
            float ls = 0.f;
#pragma unroll
            for (int kt = 0; kt < 4; ++kt)
#pragma unroll
                for (int j = 0; j < 4; ++j) {
                    const float pv = __builtin_amdgcn_exp2f(fmaf(s[kt][qt][j], SC, -mnew));
                    s[kt][qt][j] = pv;
                    ls += pv;
                }
            lrun[qt] = lrun[qt] * alpha + ls;
            if (!__all(alpha == 1.f)) {
#pragma unroll
                for (int dt = 0; dt < 4; ++dt) o[dt][qt] *= alpha;
            }
#pragma unroll
            for (int k2 = 0; k2 < 2; ++k2) {
                bf16x8 t;
#pragma unroll
                for (int j = 0; j < 4; ++j) { t[j] = (short)f2bf(s[2 * k2][qt][j]); t[4 + j] = (short)f2bf(s[2 * k2 + 1][qt][j]); }
                pf[qt][k2] = t;
            }
        }
#pragma unroll
        for (int k2 = 0; k2 < 2; ++k2)
#pragma unroll
            for (int dt = 0; dt < 4; ++dt) {
                const bf16x8 vf = *(const bf16x8*)(sv + lds_byte(dt * 16 + fr, k2 * 32 + fq * 8));
#pragma unroll
                for (int qt = 0; qt < 2; ++qt) o[dt][qt] = __builtin_amdgcn_mfma_f32_16x16x32_bf16(vf, pf[qt][k2], o[dt][qt], 0, 0, 0);
            }
    }
#pragma unroll
    for (int qt = 0; qt < 2; ++qt) {
        const float l = sum_x32(sum_x16(lrun[qt]));
        const float inv = 1.f / l;
        u16* dst = WSP_AO + (size_t)(qrow0 + qt * 16 + fr) * 512 + h * 64 + fq * 4;
        float sq = 0.f;
#pragma unroll
        for (int dt = 0; dt < 4; ++dt) {
            const unsigned w0 = pack2(o[dt][qt][0] * inv, o[dt][qt][1] * inv), w1 = pack2(o[dt][qt][2] * inv, o[dt][qt][3] * inv);
            *(uint2*)(dst + dt * 16) = make_uint2(w0, w1);
            const float a = bf2f((u16)(w0 & 0xffffu)), b = bf2f((u16)(w0 >> 16)), c = bf2f((u16)(w1 & 0xffffu)), d = bf2f((u16)(w1 >> 16));
            sq += a * a + b * b + c * c + d * d;
        }
        sq = sum_x32(sum_x16(sq));
        if (fq == 0) unsafeAtomicAdd(WSP_rsq + (size_t)(qrow0 + qt * 16 + fr) * 2, sq);
    }
}

__device__ __forceinline__ void ssm_s1_unit(const Params& p, int u) {
    const int ct = u % 9, mh = (u / 9) & 1, g = u / 18;
    const int lane = TIDX & 63, wid = TIDX >> 6, wr = wid >> 1, wc = wid & 1, fr = lane & 15, fq = lane >> 4;
    const u16* A = WSP_TabS + ((size_t)g * 256 + mh * 128) * 256;
    const u16* Ub = WSP_U + (size_t)ct * 128 * 16 * 512 + g * 16;
    f32x4 acc[4][4];
    gemm_tile(4,
        [&](int R, int C, int kt) { return (const void*)(A + (size_t)R * 256 + kt * 64 + C); },
        [&](int R, int C, int kt) { return (const void*)(Ub + (size_t)(R * 16 + kt * 4 + (C >> 4)) * 512 + (C & 15)); }, acc);
#pragma unroll
    for (int m = 0; m < 4; ++m)
#pragma unroll
        for (int n = 0; n < 4; ++n) {
            const int rho = mh * 128 + wr * 64 + m * 16 + fq * 4;
            const int cg = ct * 128 + wc * 64 + n * 16 + fr;
            *(f32x4*)(WSP_S + ((size_t)cg * 32 + g) * 256 + rho) = acc[m][n];
        }
}

__device__ __forceinline__ void phase3(const Params& p) {
    for (int u = blockIdx.x; u < 1024; u += gridDim.x) attn_unit(p, u);
    int* qv = (int*)(smem + 73728);
    for (;;) {
        __syncthreads();
        if (TIDX == 0) qv[0] = (int)atomicAdd(&WSP_ctr[CTR_QS1], 1u);
        __syncthreads();
        const int u = __builtin_amdgcn_readfirstlane(qv[0]);
        if (u >= 576) break;
        ssm_s1_unit(p, u);
    }
}

__device__ __forceinline__ void phase4(const Params& p) {
    if ((int)gridDim.x > 192) {
        if ((int)blockIdx.x >= 160) { conv_range(p, blockIdx.x - 160, gridDim.x - 160, N_CONV, N_CONV_EARLY); return; }
        if ((int)blockIdx.x >= 128) { ssm_toeplitz_item(p, blockIdx.x - 128); return; }
    } else {
        for (int g = blockIdx.x; g < 32; g += gridDim.x) ssm_toeplitz_item(p, g);
        conv_range(p, blockIdx.x, gridDim.x, N_CONV, N_CONV_EARLY);
    }
    const int gid = blockIdx.x * NTHR + TIDX;
    if (gid >= BATCH * 2 * 32 * 64) return;
    const int n = gid & 63, g = (gid >> 6) & 31, dir = (gid >> 11) & 1, b = gid >> 12;
    const int pidx = dir * 32 + g;
    const float dt = __expf(p.log_dt[pidx]);
    const float are = p.a_re[pidx * 64 + n], aim = p.a_im[pidx * 64 + n];
    const float mag = __expf(16.f * dt * are);
    float rev = 16.f * (dt * aim * 0.15915494309189535f);
    rev -= rintf(rev);
    const float ar = mag * __builtin_amdgcn_cosf(rev), ai = mag * __builtin_amdgcn_sinf(rev);
    float hr = 0.f, hi = 0.f;
    const size_t so = (size_t)g * 256 + dir * 128 + n;
#pragma unroll 8
    for (int i = 0; i < 16; ++i) {
        const int c = dir == 0 ? i : 15 - i;
        const float* sp = WSP_S + (size_t)(NCHUNK_LAT + b * 16 + c) * 8192 + so;
        const float sr = sp[0], si = sp[64];
        const float nr = ar * hr - ai * hi + sr, ni = ar * hi + ai * hr + si;
        hr = nr; hi = ni;
    }
#pragma unroll 8
    for (int i = 0; i < 128; ++i) {
        const int c = dir == 0 ? i : 127 - i;
        const size_t cg = (size_t)b * 128 + c;
        const float* sp = WSP_S + cg * 8192 + so;
        const float sr = sp[0], si = sp[64];
        u16* hp = WSP_Hin + cg * 8192 + so;
        hp[0] = f2bf(hr); hp[64] = f2bf(hi);
        const float nr = ar * hr - ai * hi + sr, ni = ar * hi + ai * hr + si;
        hr = nr; hi = ni;
    }
}

__device__ __forceinline__ void phase5(const Params& p) {
    const int NU = 512;
    const int lane = TIDX & 63, wid = TIDX >> 6, wr = wid >> 1, wc = wid & 1, fr = lane & 15, fq = lane >> 4;
    for (int u = blockIdx.x; u < NU; u += gridDim.x) {
        const int ct = u & 7, mh = (u >> 3) & 1, g = u >> 4;
        const u16* A = WSP_TabY + ((size_t)g * 256 + mh * 128) * 512;
        const u16* Ub = WSP_U + (size_t)ct * 128 * 16 * 512 + g * 16;
        const u16* Hb_ = WSP_Hin + (size_t)ct * 128 * 8192 + g * 256;
        f32x4 acc[4][4];
        gemm_tile(8,
            [&](int R, int C, int kt) { return (const void*)(A + (size_t)R * 512 + kt * 64 + C); },
            [&](int R, int C, int kt) {
                return kt < 4 ? (const void*)(Ub + (size_t)(R * 16 + kt * 4 + (C >> 4)) * 512 + (C & 15))
                              : (const void*)(Hb_ + (size_t)R * 8192 + (kt - 4) * 64 + C);
            }, acc);
#pragma unroll
        for (int m = 0; m < 4; ++m)
#pragma unroll
            for (int n = 0; n < 4; ++n) {
                const int t = mh * 8 + wr * 4 + m;
                const int cg = ct * 128 + wc * 64 + n * 16 + fr;
                u16* dst = WSP_Y + ((size_t)cg * 16 + t) * 512 + g * 16 + fq * 4;
                *(uint2*)dst = make_uint2(pack2(gelu_tanh(acc[m][n][0]), gelu_tanh(acc[m][n][1])),
                                          pack2(gelu_tanh(acc[m][n][2]), gelu_tanh(acc[m][n][3])));
            }
    }
}

__device__ __forceinline__ void phase6(const Params& p) {
    const int NU = 512;
    const int lane = TIDX & 63, wid = TIDX >> 6, wr = wid >> 1, wc = wid & 1, fr = lane & 15, fq = lane >> 4;
    for (int u = blockIdx.x; u < NU; u += gridDim.x) {
        const int mt = u >> 2, nt = u & 3;
        const u16* A = WSP_Y + (size_t)mt * 128 * 512;
        const u16* B = WSP_WgluT + (size_t)nt * 128 * 512;
        f32x4 acc[4][4];
        gemm_tile(8,
            [&](int R, int C, int kt) { return (const void*)(A + (size_t)R * 512 + kt * 64 + C); },
            [&](int R, int C, int kt) { return (const void*)(B + (size_t)R * 512 + kt * 64 + C); }, acc);
        const int row0 = mt * 128 + wr * 64, col0 = nt * 128 + wc * 64;
        char* base = smem + wid * 9216;
        float bg[4];
#pragma unroll
        for (int n = 0; n < 4; ++n) bg[n] = p.b_glu[col0 + n * 16 + fr];
#pragma unroll
        for (int i = 0; i < 8; ++i) {
            const int id = i * 64 + lane, row = id >> 3, ch = id & 7;
            *(uint4*)(base + row * 144 + ch * 16) = *(const uint4*)(WSP_Y + (size_t)(row0 + row) * 512 + col0 + ch * 8);
        }
        asm volatile("s_waitcnt lgkmcnt(0)" ::: "memory");
        __builtin_amdgcn_wave_barrier();
#pragma unroll
        for (int m = 0; m < 4; ++m)
#pragma unroll
            for (int j = 0; j < 4; ++j) {
                const int rl = m * 16 + fq * 4 + j, r = row0 + rl;
                float sq = 0.f;
#pragma unroll
                for (int n = 0; n < 4; ++n) {
                    const int c = col0 + n * 16 + fr;
                    const float yv = bf2f(*(const u16*)(base + rl * 144 + (n * 16 + fr) * 2));
                    const u16 ob = f2bf(yv * sigmoidf_(acc[m][n][j] + bg[n]));
                    *(u16*)(base + rl * 144 + (n * 16 + fr) * 2) = ob;
                    const float of = bf2f(ob);
                    sq += of * of;
                }
                sq = sum16(sq);
                if (fr == 0) unsafeAtomicAdd(WSP_rsq + (size_t)r * 2 + 1, sq);
            }
        asm volatile("s_waitcnt lgkmcnt(0)" ::: "memory");
        __builtin_amdgcn_wave_barrier();
        u16* dbase = WSP_SO + (size_t)row0 * 512 + col0;
#pragma unroll
        for (int i = 0; i < 8; ++i) {
            const int id = i * 64 + lane, row = id >> 3, ch = id & 7;
            *(uint4*)(dbase + (size_t)row * 512 + ch * 8) = *(const uint4*)(base + row * 144 + ch * 16);
        }
        asm volatile("s_waitcnt lgkmcnt(0)" ::: "memory");
        __builtin_amdgcn_wave_barrier();
    }
}

__device__ __forceinline__ void phase8(const Params& p) {
    const int NU = 512;
    for (int u = blockIdx.x; u < NU; u += gridDim.x) {
        const int mt = (u & 7) + 8 * (u >> 5), nt = (u >> 3) & 3;
        const u16* A1 = WSP_AO + (size_t)mt * 128 * 512;
        const u16* A2 = WSP_SO + (size_t)mt * 128 * 512;
        const u16* B = WSP_WoutT + (size_t)nt * 256 * 1024;
        f32x4 acc[4][8];
        {
        const int tid1 = TIDX, fq = (tid1 & 63) >> 4, row0 = mt * 128 + (tid1 >> 7) * 64;
        gemm_tile_w(32,
            [&](int i, int R, int C, int kt) { return (const void*)((kt < 16 ? A1 : A2) + (size_t)R * 512 + (kt & 15) * 32 + C); },
            [&](int i, int R, int C, int kt) { return (const void*)(B + (size_t)R * 1024 + kt * 32 + C); }, acc,
            [&](int kt) {
                if (kt == 16) {
#pragma unroll
                    for (int m = 0; m < 4; ++m) {
                        asm volatile("" ::: "memory");
#pragma unroll
                        for (int j = 0; j < 4; ++j) {
                            const float2 q = *(const float2*)(WSP_rsq + (size_t)(row0 + m * 16 + fq * 4 + j) * 2);
                            const float ratio = rsqrtf(q.x * (1.f / 512.f) + EPS) / rsqrtf(q.y * (1.f / 512.f) + EPS);
#pragma unroll
                            for (int n = 0; n < 8; ++n) acc[m][n][j] *= ratio;
                        }
                    }
                }
            });
        }
        const int tid2 = TIDX, lane = tid2 & 63, wid = tid2 >> 6, fr = lane & 15, fq = lane >> 4;
        const int row0 = mt * 128 + (wid >> 1) * 64, col0 = nt * 256 + (wid & 1) * 128;
        const float* g1 = WSP_mod + (mt >> 4) * 6144 + 2048 + col0;
        float* stg = (float*)(smem + wid * 8448);
#pragma unroll
        for (int m = 0; m < 4; ++m) {
#pragma unroll
            for (int n = 0; n < 8; ++n)
#pragma unroll
                for (int j = 0; j < 4; ++j) stg[(fq * 4 + j) * 132 + n * 16 + fr] = acc[m][n][j];
            asm volatile("s_waitcnt lgkmcnt(0)" ::: "memory");
            __builtin_amdgcn_wave_barrier();
#pragma unroll
            for (int i = 0; i < 8; ++i) {
                const int id = i * 64 + lane, rr = id >> 5, c4 = (id & 31) * 4;
                float4 v = *(const float4*)(stg + rr * 132 + c4);
                const float rsv = rsqrtf(WSP_rsq[(size_t)(row0 + m * 16 + rr) * 2 + 1] * (1.f / 512.f) + EPS);
                v.x *= rsv; v.y *= rsv; v.z *= rsv; v.w *= rsv;
                const float4 g = *(const float4*)(g1 + c4);
                const size_t o = (size_t)(row0 + m * 16 + rr) * 1024 + col0 + c4;
                const float4 xv = *(const float4*)(p.x + o);
                *(float4*)(p.out + o) = make_float4(xv.x + g.x * v.x, xv.y + g.y * v.y, xv.z + g.z * v.z, xv.w + g.w * v.w);
            }
            asm volatile("s_waitcnt lgkmcnt(0)" ::: "memory");
            __builtin_amdgcn_wave_barrier();
        }
    }
}

#define CTR_ECNT 0
#define CTR_Q11 128
#define CTR_Q12 136
#define HALF_TOK 8192
#define HH_HALF_ROWS 73728
#define ELIST_CAP 8192
template <int LEVEL>
__device__ __forceinline__ void phase9_t(const Params& p) {
    const int tid = TIDX, lane = tid & 63, wid = tid >> 6, fr = lane & 15, fq = lane >> 4;
    char* At = smem;
    float* sc = (float*)(smem + 65536);
    int* hist = (int*)(smem + 65536 + 8192);
    int* gbase = hist + 64;
    int* fill = gbase + 64;
    unsigned char* selk = (unsigned char*)(fill + 64);
    float* selw = (float*)(selk + 256);
    for (int chunk = blockIdx.x; chunk < NLAT / 32; chunk += gridDim.x) {
        const int tok0 = chunk * 32;
        __syncthreads();
        if (tid < 64) hist[tid] = 0;
#pragma unroll 1
        for (int hb = 0; hb < 2; ++hb) {
            float4 vall[4][4];
#pragma unroll
            for (int rr = 0; rr < 4; ++rr)
#pragma unroll
                for (int i = 0; i < 4; ++i) vall[rr][i] = *(const float4*)(p.out + (size_t)(tok0 + wid * 8 + hb * 4 + rr) * 1024 + i * 256 + lane * 4);
#pragma unroll
            for (int rr = 0; rr < 4; ++rr) {
                const int row = wid * 8 + hb * 4 + rr, tok = tok0 + row;
                const float* md = WSP_mod + (tok >> 11) * 6144;
                float ss = 0.f;
#pragma unroll
                for (int i = 0; i < 4; ++i) ss += vall[rr][i].x * vall[rr][i].x + vall[rr][i].y * vall[rr][i].y + vall[rr][i].z * vall[rr][i].z + vall[rr][i].w * vall[rr][i].w;
                ss = wave_sum(ss);
                const float rs = rsqrtf(ss * (1.f / 1024.f) + EPS);
#pragma unroll
                for (int i = 0; i < 4; ++i) {
                    const int c0 = i * 256 + lane * 4;
                    const float4 v = vall[rr][i];
                    const float4 g = *(const float4*)(p.norm_ffn + c0), s = *(const float4*)(md + 3072 + c0), k = *(const float4*)(md + 4096 + c0);
                    const float a = v.x * rs * g.x * (1.f + k.x) + s.x, b = v.y * rs * g.y * (1.f + k.y) + s.y;
                    const float c = v.z * rs * g.z * (1.f + k.z) + s.z, d = v.w * rs * g.w * (1.f + k.w) + s.w;
                    const uint2 pk = make_uint2(pack2(a, b), pack2(c, d));
                    *(uint2*)(WSP_H2 + (size_t)tok * 1024 + c0) = pk;
                    const int ch = c0 >> 3;
                    *(uint2*)(At + row * 2048 + ((ch ^ (row & 15)) << 4) + ((c0 & 4) << 1)) = pk;
                }
            }
        }
        __syncthreads();
        if (LEVEL == 1) continue;
        {
            f32x4 acc0 = {0.f, 0.f, 0.f, 0.f}, acc1 = {0.f, 0.f, 0.f, 0.f};
            const u16* bp = WSP_WrT + (size_t)(wid * 16 + fr) * 1024 + fq * 8;
#pragma unroll
            for (int kb = 0; kb < 4; ++kb) {
                bf16x8 bfr[8];
#pragma unroll
                for (int q = 0; q < 8; ++q) bfr[q] = *(const bf16x8*)(bp + (kb * 8 + q) * 32);
#pragma unroll
                for (int q = 0; q < 8; ++q) {
                    const int ch = (kb * 8 + q) * 4 + fq;
                    const bf16x8 a0 = *(const bf16x8*)(At + fr * 2048 + ((ch ^ fr) << 4));
                    const bf16x8 a1 = *(const bf16x8*)(At + (16 + fr) * 2048 + ((ch ^ fr) << 4));
                    acc0 = __builtin_amdgcn_mfma_f32_16x16x32_bf16(a0, bfr[q], acc0, 0, 0, 0);
                    acc1 = __builtin_amdgcn_mfma_f32_16x16x32_bf16(a1, bfr[q], acc1, 0, 0, 0);
                }
            }
#pragma unroll
            for (int j = 0; j < 4; ++j) {
                sc[(fq * 4 + j) * 64 + wid * 16 + fr] = sigmoidf_(acc0[j]);
                sc[(16 + fq * 4 + j) * 64 + wid * 16 + fr] = sigmoidf_(acc1[j]);
            }
        }
        __syncthreads();
        if (LEVEL == 2) continue;
        const float bias = p.router_bias[lane];
        const int eg = lane >> 3;
#pragma unroll 2
        for (int rr = 0; rr < 8; ++rr) {
            const int row = wid * 8 + rr;
            const float s = sc[row * 64 + lane];
            const float bz = s + bias;
            const float m1 = max8(bz);
            const unsigned long long eq = __ballot(bz == m1);
            const unsigned gb = (unsigned)((eq >> (eg * 8)) & 0xffull);
            const int first = __ffs(gb) - 1;
            const float v2 = max8(((lane & 7) == first) ? -1e30f : bz);
            const float gs = m1 + v2;
            int cnt = 0;
#pragma unroll
            for (int j = 0; j < 8; ++j) {
                const float gj = __int_as_float(__builtin_amdgcn_readlane(__float_as_int(gs), j * 8));
                cnt += (gj > gs || (gj == gs && j < eg)) ? 1 : 0;
            }
            const bool gsel = cnt < 4;
            const float mv = gsel ? bz : -1e30f;
            unsigned long long gm = __ballot(gsel);
            int rank = 0;
#pragma unroll 1
            for (int it = 0; it < 4; ++it) {
                const int jb = __builtin_amdgcn_readfirstlane(__ffsll((long long)gm) - 1);
                gm &= ~(0xffull << jb);
#pragma unroll
                for (int j = 0; j < 8; ++j) {
                    const float vj = __int_as_float(__builtin_amdgcn_readlane(__float_as_int(mv), jb + j));
                    rank += (vj > mv || (vj == mv && (jb + j) < lane)) ? 1 : 0;
                }
            }
            const bool sel = gsel && rank < 8;
            unsigned long long sm = __ballot(sel);
            float tot = 0.f;
#pragma unroll 1
            for (int it = 0; it < 8; ++it) {
                const int l = __builtin_amdgcn_readfirstlane(__ffsll((long long)sm) - 1);
                sm &= sm - 1;
                tot += __int_as_float(__builtin_amdgcn_readlane(__float_as_int(s), l));
            }
            if (sel) {
                selw[row * 8 + rank] = s / tot * 2.5f;
                selk[row * 8 + rank] = (unsigned char)lane;
                atomicAdd(&hist[lane], 1);
            }
        }
        __syncthreads();
        const int h = tok0 >> 13;
        if (tid < 64) {
            gbase[tid] = hist[tid] ? (int)atomicAdd(&WSP_ctr[CTR_ECNT + h * 64 + tid], (unsigned)hist[tid]) : 0;
            fill[tid] = 0;
        }
        __syncthreads();
        {
            const int e = selk[tid];
            const int pos = atomicAdd(&fill[e], 1);
            WSP_elist[(size_t)(h * 64 + e) * ELIST_CAP + gbase[e] + pos] = (tok0 + (tid >> 3)) * 8 + (tid & 7);
            WSP_wsl[(size_t)(h * 64 + e) * ELIST_CAP + gbase[e] + pos] = selw[tid];
        }
    }
}

struct MoeTab { int cnt[16]; int soff[16]; int pre[17]; };

template <class FV, class FD>
__device__ __forceinline__ void wave_store_fp8_f(FV val, FD dst) {
    const int lane = TIDX & 63, wid = TIDX >> 6, fr = lane & 15, fq = lane >> 4;
    char* base = smem + wid * 9216;
#pragma unroll
    for (int m = 0; m < 4; ++m)
#pragma unroll
        for (int n = 0; n < 8; ++n)
#pragma unroll
            for (int j = 0; j < 4; ++j)
                *(unsigned char*)(base + (m * 16 + fq * 4 + j) * 144 + n * 16 + fr) =
                    (unsigned char)(__builtin_amdgcn_cvt_pk_fp8_f32(val(m, n, j), 0.f, 0, false) & 0xff);
    asm volatile("s_waitcnt lgkmcnt(0)" ::: "memory");
    __builtin_amdgcn_wave_barrier();
#pragma unroll
    for (int i = 0; i < 8; ++i) {
        const int id = i * 64 + lane, row = id >> 3, ch = id & 7;
        const uint4 d = *(const uint4*)(base + row * 144 + ch * 16);
        unsigned char* q = dst(i, row);
        if (q) *(uint4*)(q + ch * 16) = d;
    }
    asm volatile("s_waitcnt lgkmcnt(0)" ::: "memory");
    __builtin_amdgcn_wave_barrier();
}

#define YD_SCALE 8.0f
template <int MODE>
__device__ __forceinline__ void phase11f(const Params& p) {
    const int tid = TIDX;
    int* tab = (int*)(smem + 73728);
    int* t_cnt = tab, *t_soff = tab + 16, *t_pre = tab + 32, *t_q = tab + 52;
    int* t_all = tab + 64;
    const int x = blockIdx.x & 7;
    unsigned* flags = WSP_flag + x * FLAG_PER_CLASS;
    unsigned* tmo = WSP_flag + 8 * FLAG_PER_CLASS;
    unsigned char* Yd8 = (unsigned char*)(p.ws + OFF_ARENA);
    __syncthreads();
    if (tid < 128) t_all[tid] = (int)WSP_ctr[CTR_ECNT + tid];
    unsigned* qhead = &WSP_ctr[(MODE == 2 ? CTR_Q12 : CTR_Q11) + x];
    if (tid == 0) t_q[0] = (int)atomicAdd(qhead, 1u);
    __syncthreads();
    if (tid < 16) {
        const int i = tid >> 1, h = tid & 1, e = x + 8 * i;
        t_cnt[tid] = t_all[h * 64 + e];
        int so = 0;
        for (int e2 = 0; e2 < e; ++e2) so += t_all[h * 64 + e2];
        t_soff[tid] = so;
    }
    __syncthreads();
    if (tid == 0) {
        int s = 0;
        for (int j = 0; j < 16; ++j) { t_pre[j] = s; s += (t_cnt[j] + 127) >> 7; }
        t_pre[16] = s;
    }
    __syncthreads();
    const int T_r = t_pre[16], T11 = T_r + 16, T_all = (MODE == 1) ? T11 : T11 + T_r * 4;
    for (;;) {
        __syncthreads();
        const int q = __builtin_amdgcn_readfirstlane(t_q[0]) + (MODE == 2 ? T11 : 0);
        __syncthreads();
        if (q >= T_all) break;
        if (tid == 0) t_q[0] = (int)atomicAdd(qhead, 1u);
        const bool is_down = q >= T11;
        const int u = is_down ? (q - T11) >> 2 : q;
        int nt = is_down ? (q - T11) & 3 : 0;
        int e, h, mt, c, rowbase;
        if (u < T_r) {
            int j = 0;
#pragma unroll
            for (int qq = 1; qq < 16; ++qq) j += (u >= t_pre[qq]) ? 1 : 0;
            e = x + 8 * (j >> 1); h = j & 1; mt = u - t_pre[j]; c = t_cnt[j];
            rowbase = h * HH_HALF_ROWS + t_soff[j];
        } else {
            const int ms = x * 16 + (u - T_r);
            e = 64; h = ms >> 6; mt = ms & 63; c = HALF_TOK;
            rowbase = h * HH_HALF_ROWS + 65536;
        }
        e = __builtin_amdgcn_readfirstlane(e); h = __builtin_amdgcn_readfirstlane(h); mt = __builtin_amdgcn_readfirstlane(mt);
        nt = __builtin_amdgcn_readfirstlane(nt); c = __builtin_amdgcn_readfirstlane(c); rowbase = __builtin_amdgcn_readfirstlane(rowbase);
        const int* el = WSP_elist + (size_t)(h * 64 + (e & 63)) * ELIST_CAP;
        if (!is_down) {
            const int t2 = TIDX, lane = t2 & 63, wid = t2 >> 6, wr = wid >> 1, wc = wid & 1, fr = lane & 15, fq = lane >> 4;
            const int sb = lane * 16, swz = sb ^ (((sb >> 9) & 1) << 5);
            const int r_in = swz >> 6, c_in = (swz & 63) >> 1;
            const int vrows = c - mt * 128 - wr * 64;
            const float* wsl = WSP_wsl + (size_t)(h * 64 + (e & 63)) * ELIST_CAP;
            const u16* aptr[2];
#pragma unroll
            for (int i = 0; i < 2; ++i) {
                int li = mt * 128 + (wid + 4 * i) * 16 + r_in;
                li = li < c ? li : c - 1;
                const int tok = (e < 64) ? (el[li] >> 3) : (h * HALF_TOK + li);
                aptr[i] = WSP_H2 + (size_t)tok * 1024 + c_in;
            }
            const u16* Bw = WSP_WguT + (size_t)e * 262144 + c_in;
            f32x4 acc[4][8];
            gemm_tile_w(32,
                [&](int i, int R, int C, int kt) { return (const void*)(aptr[i] + kt * 32); },
                [&](int i, int R, int C, int kt) { return (const void*)(Bw + (size_t)R * 1024 + kt * 32); }, acc);
            float wgt[4][4];
#pragma unroll
            for (int m = 0; m < 4; ++m)
#pragma unroll
                for (int j = 0; j < 4; ++j) {
                    const int li = mt * 128 + wr * 64 + m * 16 + fq * 4 + j;
                    float w = 1.f;
                    if (e < 64) w = (li < c) ? wsl[li] : 0.f;
                    wgt[m][j] = w;
                }
            u16* dbase = WSP_HHs + ((size_t)rowbase + mt * 128 + wr * 64) * 128 + wc * 64;
            wave_store_bf16_f([&](int m, int n2, int j) { return siluf_(acc[m][2 * n2][j]) * acc[m][2 * n2 + 1][j] * wgt[m][j]; },
                              [&](int row) { return row < vrows ? dbase + (size_t)row * 128 : (u16*)nullptr; }, true, (const char*)WSP_HHs, (unsigned)((size_t)2 * HH_HALF_ROWS * 128 * 2));
            asm volatile("s_waitcnt vmcnt(0)" ::: "memory");
            __syncthreads();
            if (tid == 0) __hip_atomic_store(&flags[u], 1u, __ATOMIC_RELAXED, __HIP_MEMORY_SCOPE_AGENT);
        } else {
            const int t2 = TIDX, lane = t2 & 63, wid = t2 >> 6, wr = wid >> 1, wc = wid & 1, fr = lane & 15, fq = lane >> 4;
            const int sb = lane * 16, swz = sb ^ (((sb >> 9) & 1) << 5);
            const int r_in = swz >> 6, c_in = (swz & 63) >> 1;
            const int vrows = c - mt * 128 - wr * 64;
            if (MODE == 0 && tid == 0) {
                unsigned sp = 0;
                while (__hip_atomic_load(&flags[u], __ATOMIC_RELAXED, __HIP_MEMORY_SCOPE_AGENT) == 0u) {
                    __builtin_amdgcn_s_sleep(2);
                    if ((++sp & 255u) == 0u) {
                        if (__hip_atomic_load(tmo, __ATOMIC_RELAXED, __HIP_MEMORY_SCOPE_AGENT)) break;
                        if (sp > (1u << 20)) { atomicAdd(tmo, 1u); break; }
                    }
                }
            }
            __syncthreads();
            const u16* aptr[2];
#pragma unroll
            for (int i = 0; i < 2; ++i) {
                int li = mt * 128 + (wid + 4 * i) * 16 + r_in;
                li = li < c ? li : c - 1;
                aptr[i] = WSP_HHs + ((size_t)rowbase + li) * 128 + c_in;
            }
            const u16* Bw = WSP_WdT + ((size_t)e * 1024 + nt * 256) * 128 + c_in;
            int slot[8];
            if (e < 64) {
#pragma unroll
                for (int i = 0; i < 8; ++i) {
                    int li = mt * 128 + wr * 64 + ((i * 64 + lane) >> 3);
                    li = li < c ? li : c - 1;
                    slot[i] = el[li];
                }
            } else {
#pragma unroll
                for (int i = 0; i < 8; ++i) slot[i] = (h * HALF_TOK + mt * 128 + wr * 64 + ((i * 64 + lane) >> 3)) * 8;
            }
            f32x4 acc[4][8];
            gemm_tile_w<true>(4,
                [&](int i, int R, int C, int kt) { return (const void*)(aptr[i] + kt * 32); },
                [&](int i, int R, int C, int kt) { return (const void*)(Bw + (size_t)R * 128 + kt * 32); }, acc);
            const int colo = nt * 256 + wc * 128;
            if (e < 64) {
                wave_store_fp8_f([&](int m, int n, int j) { return acc[m][n][j] * YD_SCALE; }, [&](int i, int row) {
                    if (row >= vrows) return (unsigned char*)nullptr;
                    const int s = slot[i];
                    return Yd8 + ((size_t)(s >> 3) * 8 + (s & 7)) * 1024 + colo;
                });
            } else {
                const int tok0 = h * HALF_TOK + mt * 128 + wr * 64;
                const float* g2 = WSP_mod + (tok0 >> 11) * 6144 + 5120 + colo;
                float* stg = (float*)(smem + wid * 8448);
#pragma unroll
                for (int m = 0; m < 4; ++m) {
#pragma unroll
                    for (int n = 0; n < 8; ++n)
#pragma unroll
                        for (int j = 0; j < 4; ++j) stg[(fq * 4 + j) * 132 + n * 16 + fr] = acc[m][n][j];
                    asm volatile("s_waitcnt lgkmcnt(0)" ::: "memory");
                    __builtin_amdgcn_wave_barrier();
#pragma unroll
                    for (int i = 0; i < 8; ++i) {
                        const int id = i * 64 + lane, rr = id >> 5, c4 = (id & 31) * 4;
                        const float4 v = *(const float4*)(stg + rr * 132 + c4);
                        const float4 g = *(const float4*)(g2 + c4);
                        float* op = p.out + (size_t)(tok0 + m * 16 + rr) * 1024 + colo + c4;
                        const float4 xv = *(const float4*)op;
                        *(float4*)op = make_float4(xv.x + g.x * v.x, xv.y + g.y * v.y, xv.z + g.z * v.z, xv.w + g.w * v.w);
                    }
                    asm volatile("s_waitcnt lgkmcnt(0)" ::: "memory");
                    __builtin_amdgcn_wave_barrier();
                }
            }
        }
    }
}

#define P12_SLD 2064
template <bool DUMMY>
__device__ __forceinline__ void phase12b_t(const Params& p) {
    const int tid = TIDX, lane = tid & 63, wid = tid >> 6, fr = lane & 15, fq = lane >> 4;
    const unsigned char* Yd8 = (const unsigned char*)(p.ws + OFF_ARENA);
    const u16* Wb = WSP_WdT + (size_t)64 * 131072 + (size_t)(wid * 256 + fr) * 128 + fq * 8;
    for (int tile = blockIdx.x; tile < NLAT / 32; tile += gridDim.x) {
        const int tok0 = tile * 32;
        const int hh = tok0 >> 13;
        const u16* Ab = WSP_HHs + ((size_t)hh * HH_HALF_ROWS + 65536 + (tok0 & 8191) + fr) * 128 + fq * 8;
        __syncthreads();
        bf16x8 af[2][4];
#pragma unroll
        for (int m = 0; m < 2; ++m)
#pragma unroll
            for (int ks = 0; ks < 4; ++ks) af[m][ks] = *(const bf16x8*)(Ab + (size_t)m * 16 * 128 + ks * 32);
#pragma unroll 1
        for (int nb = 0; nb < 4; ++nb) {
            bf16x8 bfr[4][4];
#pragma unroll
            for (int n = 0; n < 4; ++n)
#pragma unroll
                for (int ks = 0; ks < 4; ++ks) bfr[n][ks] = *(const bf16x8*)(Wb + (size_t)((nb * 4 + n) * 16) * 128 + ks * 32);
#pragma unroll
            for (int m = 0; m < 2; ++m)
#pragma unroll
                for (int n = 0; n < 4; ++n) {
                    f32x4 d = {0.f, 0.f, 0.f, 0.f};
#pragma unroll
                    for (int ks = 0; ks < 4; ++ks) d = __builtin_amdgcn_mfma_f32_16x16x32_bf16(af[m][ks], bfr[n][ks], d, 0, 0, 0);
                    const int col = wid * 256 + (nb * 4 + n) * 16 + fr;
#pragma unroll
                    for (int j = 0; j < 4; ++j) *(u16*)(smem + (m * 16 + fq * 4 + j) * P12_SLD + col * 2) = f2bf(d[j]);
                }
        }
        __syncthreads();
        for (int rr = 0; rr < 8; ++rr) {
            const int row = wid * 8 + rr, tok = tok0 + row;
            float* xrow = p.out + (size_t)tok * 1024 + lane * 16;
            float* orow = DUMMY ? (float*)(p.ws + OFF_HHS) + (size_t)(tok & 8191) * 1024 + lane * 16 : xrow;
            const float* g2 = WSP_mod + (tok >> 11) * 6144 + 5120 + lane * 16;
            float s[16];
#pragma unroll
            for (int i = 0; i < 16; ++i) s[i] = 0.f;
            const unsigned char* yp = Yd8 + (size_t)tok * 8 * 1024 + lane * 16;
            uint4 yv[8];
#pragma unroll
            for (int k = 0; k < 8; ++k) yv[k] = *(const uint4*)(yp + k * 1024);
#pragma unroll
            for (int k = 0; k < 8; ++k) {
                const unsigned w[4] = {yv[k].x, yv[k].y, yv[k].z, yv[k].w};
#pragma unroll
                for (int i = 0; i < 4; ++i) {
                    const auto lo = __builtin_amdgcn_cvt_pk_f32_fp8((int)w[i], false);
                    const auto hi = __builtin_amdgcn_cvt_pk_f32_fp8((int)w[i], true);
                    s[4 * i] += lo[0]; s[4 * i + 1] += lo[1]; s[4 * i + 2] += hi[0]; s[4 * i + 3] += hi[1];
                }
            }
            const uint4 sa = *(const uint4*)(smem + row * P12_SLD + lane * 32), sbv = *(const uint4*)(smem + row * P12_SLD + lane * 32 + 16);
            const unsigned sw[8] = {sa.x, sa.y, sa.z, sa.w, sbv.x, sbv.y, sbv.z, sbv.w};
#pragma unroll
            for (int i = 0; i < 8; ++i) {
                s[2 * i] = s[2 * i] * (1.f / YD_SCALE) + bf2f((u16)(sw[i] & 0xffffu));
                s[2 * i + 1] = s[2 * i + 1] * (1.f / YD_SCALE) + bf2f((u16)(sw[i] >> 16));
            }
            float ss = 0.f;
#pragma unroll
            for (int q = 0; q < 4; ++q) {
                const float4 xv = *(const float4*)(xrow + q * 4), gv = *(const float4*)(g2 + q * 4);
                s[4 * q] = xv.x + gv.x * s[4 * q]; s[4 * q + 1] = xv.y + gv.y * s[4 * q + 1];
                s[4 * q + 2] = xv.z + gv.z * s[4 * q + 2]; s[4 * q + 3] = xv.w + gv.w * s[4 * q + 3];
                ss += s[4 * q] * s[4 * q] + s[4 * q + 1] * s[4 * q + 1] + s[4 * q + 2] * s[4 * q + 2] + s[4 * q + 3] * s[4 * q + 3];
            }
            ss = wave_sum(ss);
            const float rs = rsqrtf(ss * (1.f / 1024.f) + EPS);
#pragma unroll
            for (int q = 0; q < 4; ++q) {
                const float4 g = *(const float4*)(p.norm_final + lane * 16 + q * 4);
                *(float4*)(orow + q * 4) = make_float4(s[4 * q] * rs * g.x, s[4 * q + 1] * rs * g.y, s[4 * q + 2] * rs * g.z, s[4 * q + 3] * rs * g.w);
            }
        }
    }
}

#define SMEM_TOTAL (73728 + 3072 + 64)

#if 1
__global__ void __launch_bounds__(NTHR, 2) k_mega(Params p) {
    volatile LAS unsigned* st = (volatile LAS unsigned*)(smem + SMEM_TOTAL - 16);
    if (TIDX == 0) { st[0] = 0u; st[1] = 0u; st[2] = 0u; st[3] = 0u; }
    __syncthreads();
    XcdBarrier bar = xcd_barrier_post(WSP_bar, st);
#define RUNP(N) do { phase##N(p); if (PROBE_DUP == N) phase##N(p); } while (0)
    RUNP(0);  xcd_barrier(bar);
    RUNP(1);  xcd_barrier(bar);
    RUNP(2);  xcd_barrier(bar);
    RUNP(3);  xcd_barrier(bar);
    RUNP(4);  xcd_barrier(bar);
    RUNP(5);  xcd_barrier(bar);
    RUNP(6);  xcd_barrier(bar);
    RUNP(8);  xcd_barrier(bar);
#if PROBE_DUP == 91
    phase9_t<1>(p); xcd_barrier(bar);
#endif
#if PROBE_DUP == 92
    phase9_t<2>(p); xcd_barrier(bar);
#endif
    phase9_t<0>(p); xcd_barrier(bar);
#if PROBE_DUP == 9
    if (blockIdx.x == 0 && TIDX < 128) WSP_ctr[CTR_ECNT + TIDX] = 0u;
    xcd_barrier(bar); phase9_t<0>(p); xcd_barrier(bar);
#endif
#ifndef MOE_FUSED
#define MOE_FUSED 1
#endif
#if MOE_FUSED
    phase11f<0>(p); xcd_barrier(bar);
#else
    phase11f<1>(p); xcd_barrier(bar);
    phase11f<2>(p); xcd_barrier(bar);
#endif
#if PROBE_DUP == 11
    if (blockIdx.x == 0 && TIDX < 8) WSP_ctr[CTR_Q11 + TIDX] = 0u;
    if (blockIdx.x == 1) for (int i = TIDX; i < 8 * FLAG_PER_CLASS; i += NTHR) WSP_flag[i] = 0u;
    xcd_barrier(bar); phase11f<0>(p); xcd_barrier(bar);
#endif
#if PROBE_DUP == 121
    phase12b_t<true>(p); xcd_barrier(bar);
#endif
    phase12b_t<false>(p);
}
#endif


extern "C" void kernel_launch(void* const* d_in, const int* in_sizes, int n_in,
                              void* d_out, int out_size, void* d_ws, size_t ws_size,
                              hipStream_t stream) {
    Params p{};
    const float** ip = (const float**)&p.x;
    for (int i = 0; i < 32; ++i) ip[i] = (const float*)d_in[i];
    p.out = (float*)d_out;
    p.ws = (char*)d_ws;
    if (OFF_END > ws_size) { fprintf(stderr, "workspace too small: need %zu have %zu\n", (size_t)OFF_END, ws_size); return; }

    static int grid = 0;
    if (!grid) {
        hipFuncSetAttribute((const void*)k_mega, hipFuncAttributeMaxDynamicSharedMemorySize, SMEM_TOTAL);
        int dev = 0, cus = 0, per_cu = 0;
        hipGetDevice(&dev);
        hipDeviceGetAttribute(&cus, hipDeviceAttributeMultiprocessorCount, dev);
        hipOccupancyMaxActiveBlocksPerMultiprocessor(&per_cu, (const void*)k_mega, NTHR, SMEM_TOTAL);
        if (per_cu < 1) per_cu = 1;
        grid = cus * (per_cu < 2 ? per_cu : 2);
    }
    hipMemsetAsync(p.ws + OFF_BAR, 0, ZERO_BYTES, stream);
    k_mega<<<grid, NTHR, SMEM_TOTAL, stream>>>(p);
}
```

```cpp
#include <hip/hip_runtime.h>
#include <hip/hip_bf16.h>
#include <stdint.h>
#include <stdio.h>

#ifndef MK_MULTI
#define MK_MULTI 0
#endif

typedef __attribute__((ext_vector_type(8))) short bf16x8;
typedef __attribute__((ext_vector_type(4))) short bf16x4;
typedef __attribute__((ext_vector_type(4))) float f32x4;
typedef unsigned short u16;
typedef __attribute__((ext_vector_type(4))) unsigned u32x4;

#ifndef PROBE_DUP
#define PROBE_DUP -1
#endif
#define NTHR 256
__device__ __forceinline__ int opaque_tid() { int t = (int)threadIdx.x; asm volatile("" : "+v"(t)); return t; }
#define TIDX opaque_tid()
#define LDS_BYTES 65536

#define D_MODEL 1024
#define BATCH 8
#define SEQ 2048
#define CTXL 256
#define NLAT (BATCH * SEQ)
#define NCTX (BATCH * CTXL)
#define NROWS (NLAT + NCTX)
#define INW 1280
#define NEXP 64
#define VT_LD (SEQ + CTXL)
#define NCHUNK_LAT 1024
#define NCHUNK_ALL 1152
#define EPS 1e-6f

#define XB_TMO      128
#define XB_XCNT(j)  (256  + 64 * (j))
#define XB_XSUB(j)  (1280 + 64 * (j))
#define XB_XGEN(j)  (2304 + 64 * (j))
#define XB_TOP      3328
#define XB_TOPGEN   3392
#define XCD_BAR_WORDS 3456
#define XB_SPIN_CAP (1u << 20)
#define LAS __attribute__((address_space(3)))

__device__ __forceinline__ unsigned xb_ld(unsigned* p)              { return __hip_atomic_load(p, __ATOMIC_RELAXED, __HIP_MEMORY_SCOPE_AGENT); }
__device__ __forceinline__ unsigned xb_add(unsigned* p, unsigned v) { return __hip_atomic_fetch_add(p, v, __ATOMIC_RELAXED, __HIP_MEMORY_SCOPE_AGENT); }
__device__ __forceinline__ unsigned xb_xcc_id() { return (unsigned)__builtin_amdgcn_s_getreg((3 << 11) | 20) & 0xFu; }
#define XB_SPIN(cond, bar) do { unsigned _sp = 0; while (cond) { __builtin_amdgcn_s_sleep(1); \
    if ((++_sp & 255u) == 0u) { if (xb_ld(&(bar)[XB_TMO])) break; if (_sp > XB_SPIN_CAP) { atomicAdd(&(bar)[XB_TMO], 1u); break; } } } } while (0)

struct XcdBarrier { unsigned* bar; unsigned x; volatile LAS unsigned* st; };

__device__ __forceinline__ XcdBarrier xcd_barrier_post(unsigned* bar, volatile LAS unsigned* st) {
    XcdBarrier b; b.bar = bar; b.x = xb_xcc_id(); b.st = st;
    if (TIDX == 0) (void)xb_add(&bar[XB_XCNT(b.x)], 1u);
    return b;
}
__device__ __forceinline__ void xcd_barrier_complete(unsigned* bar, unsigned x, unsigned& nloc, unsigned& nx) {
    const unsigned G = gridDim.x * gridDim.y * gridDim.z;
    unsigned sum, cnt, mine, sp = 0u;
    for (;;) {
        sum = 0u; cnt = 0u; mine = 0u;
#pragma unroll
        for (unsigned j = 0; j < 16; ++j) { const unsigned c = xb_ld(&bar[XB_XCNT(j)]); sum += c; cnt += (c > 0u) ? 1u : 0u; mine = (j == x) ? c : mine; }
        if (sum == G) break;
        __builtin_amdgcn_s_sleep(1);
        if ((++sp & 255u) == 0u) { if (xb_ld(&bar[XB_TMO])) break; if (sp > XB_SPIN_CAP) { atomicAdd(&bar[XB_TMO], 1u); break; } }
    }
    nloc = mine > 0u ? mine : 1u; nx = cnt > 0u ? cnt : 1u;
}
__device__ __forceinline__ void xcd_barrier(const XcdBarrier& b) {
    asm volatile("s_waitcnt vmcnt(0)" ::: "memory");
    __syncthreads();
    if (TIDX == 0) {
        unsigned* bar = b.bar;
        __builtin_amdgcn_s_waitcnt(0);
        unsigned nloc = b.st[0], nx = b.st[1];
        if (nloc == 0u) { xcd_barrier_complete(bar, b.x, nloc, nx); b.st[0] = nloc; b.st[1] = nx; }
        const unsigned old = xb_add(&bar[XB_XSUB(b.x)], 1u);
        const unsigned gen = old / nloc;
        if (old + 1u == (gen + 1u) * nloc) {
            __builtin_amdgcn_fence(__ATOMIC_RELEASE, "agent");
            asm volatile("s_waitcnt vmcnt(0)" ::: "memory");
            const unsigned og = xb_add(&bar[XB_TOP], 1u);
            const unsigned tg = og / nx;
            if (og + 1u == (tg + 1u) * nx) xb_add(&bar[XB_TOPGEN], 1u);
            else XB_SPIN(xb_ld(&bar[XB_TOPGEN]) == tg, bar);
            __builtin_amdgcn_fence(__ATOMIC_ACQUIRE, "agent");
            xb_add(&bar[XB_XGEN(b.x)], 1u);
            asm volatile("s_waitcnt vmcnt(0)" ::: "memory");
        } else {
            XB_SPIN(xb_ld(&bar[XB_XGEN(b.x)]) == gen, bar);
            __builtin_amdgcn_fence(__ATOMIC_ACQUIRE, "agent");
            asm volatile("s_waitcnt vmcnt(0)" ::: "memory");
        }
    }
    __syncthreads();
}

struct Params {
    const float *x, *c, *ctx, *c_ctx, *w_ada, *b_ada, *norm_mix, *norm_ffn, *w_in, *attn_sink,
        *a_re, *a_im, *log_dt, *b_re, *b_im, *c_re, *c_im, *ssm_d, *w_glu, *b_glu, *norm_attn_out, *norm_ssm_out,
        *w_out, *w_router, *router_bias, *w_gate_e, *w_up_e, *w_down_e, *w_gate_s, *w_up_s, *w_down_s, *norm_final;
    float* out;
    char* ws;
};

constexpr size_t A256(size_t v) { return (v + 255) & ~(size_t)255; }
constexpr size_t OFF_BAR   = 0;
constexpr size_t OFF_RSQ   = A256(OFF_BAR + XCD_BAR_WORDS * 4 + 1024);
#define FLAG_PER_CLASS 1280
constexpr size_t OFF_FLAG  = OFF_RSQ + (size_t)NLAT * 2 * 4;
constexpr size_t ZERO_BYTES = OFF_FLAG + (8 * FLAG_PER_CLASS + 64) * 4;
constexpr size_t OFF_MOD   = A256(ZERO_BYTES);
constexpr size_t OFF_ROPE  = A256(OFF_MOD + 9 * 6144 * 4);
constexpr size_t OFF_KBUF  = A256(OFF_ROPE + 64 * 16 * 8);
constexpr size_t OFF_ELIST = A256(OFF_KBUF + (size_t)32 * 2 * 4096 * 4);
constexpr size_t OFF_WSL   = A256(OFF_ELIST + (size_t)2 * 64 * 8192 * 4);
constexpr size_t OFF_WDT   = A256(OFF_WSL + (size_t)2 * 64 * 8192 * 4);
constexpr size_t OFF_HHS   = A256(OFF_WDT + (size_t)65 * 1024 * 128 * 2);
constexpr size_t OFF_WGUT  = A256(OFF_HHS + (size_t)2 * 73728 * 128 * 2);
constexpr size_t OFF_H2R   = A256(OFF_WGUT + (size_t)65 * 256 * 1024 * 2);
constexpr size_t OFF_ARENA = A256(OFF_H2R + (size_t)NLAT * 1024 * 2);
constexpr size_t OFF_TABS  = OFF_ARENA;
constexpr size_t OFF_TABY  = A256(OFF_TABS + (size_t)32 * 256 * 256 * 2);
constexpr size_t OFF_R1    = A256(OFF_TABY + (size_t)32 * 256 * 512 * 2);
constexpr size_t OFF_R2    = A256(OFF_R1 + (size_t)NROWS * 1024 * 2);
constexpr size_t OFF_R4    = A256(OFF_R2 + (size_t)NLAT * 1024 * 2);
constexpr size_t OFF_WINT  = A256(OFF_R4 + (size_t)NLAT * 512 * 2 * 2);
constexpr size_t OFF_WGLUT = A256(OFF_WINT + (size_t)1280 * 1024 * 2);
constexpr size_t OFF_WOUTT = A256(OFF_WGLUT + (size_t)512 * 512 * 2);
constexpr size_t OFF_WRT   = A256(OFF_WOUTT + (size_t)1024 * 1024 * 2);
constexpr size_t OFF_EARLY_END = A256(OFF_WRT + (size_t)128 * 1024 * 2);
constexpr size_t YD8_BYTES = (size_t)NLAT * 8 * 1024;
constexpr size_t OFF_END   = (OFF_EARLY_END > OFF_ARENA + YD8_BYTES) ? OFF_EARLY_END : A256(OFF_ARENA + YD8_BYTES);
static_assert(OFF_END <= (size_t)256 * 1024 * 1024, "workspace map must fit the guaranteed 256 MiB");
#define CTR_QS1 160
#define WSP_bar   ((unsigned*)(p.ws + OFF_BAR))
#define WSP_ctr   ((unsigned*)(p.ws + OFF_BAR) + XCD_BAR_WORDS)
#define WSP_rsq   ((float*)(p.ws + OFF_RSQ))
#define WSP_flag  ((unsigned*)(p.ws + OFF_FLAG))
#define WSP_mod   ((float*)(p.ws + OFF_MOD))
#define WSP_rope  ((float2*)(p.ws + OFF_ROPE))
#define WSP_Kbuf  ((float*)(p.ws + OFF_KBUF))
#define WSP_elist ((int*)(p.ws + OFF_ELIST))
#define WSP_wsl   ((float*)(p.ws + OFF_WSL))
#define WSP_WinT  ((u16*)(p.ws + OFF_WINT))
#define WSP_WgluT ((u16*)(p.ws + OFF_WGLUT))
#define WSP_WoutT ((u16*)(p.ws + OFF_WOUTT))
#define WSP_WrT   ((u16*)(p.ws + OFF_WRT))
#define WSP_WdT   ((u16*)(p.ws + OFF_WDT))
#define WSP_HHs   ((u16*)(p.ws + OFF_HHS))
#define WSP_WguT  ((u16*)(p.ws + OFF_WGUT))
#define WSP_TabS  ((u16*)(p.ws + OFF_TABS))
#define WSP_TabY  ((u16*)(p.ws + OFF_TABY))
#define WSP_Hb    ((u16*)(p.ws + OFF_R1))
#define WSP_S     ((float*)(p.ws + OFF_R1))
#define WSP_H2    ((u16*)(p.ws + OFF_H2R))
#define WSP_Q     ((u16*)(p.ws + OFF_R2))
#define WSP_Kb    ((u16*)(p.ws + OFF_R2 + (size_t)NLAT * 512 * 2))
#define WSP_Vt    ((u16*)(p.ws + OFF_R2 + (size_t)NLAT * 512 * 2 + (size_t)NROWS * 128 * 2))
#define WSP_Y     ((u16*)(p.ws + OFF_R2))
#define WSP_SO    ((u16*)(p.ws + OFF_R2 + (size_t)NLAT * 512 * 2))
#define WSP_U     ((u16*)(p.ws + OFF_H2R))
#define WSP_AO    ((u16*)(p.ws + OFF_R4))
#define WSP_Hin   ((u16*)(p.ws + OFF_R4 + (size_t)NLAT * 512 * 2))

extern __shared__ __attribute__((aligned(16))) char smem[];

typedef __bf16 bf2_t __attribute__((ext_vector_type(2)));
typedef float f2_t __attribute__((ext_vector_type(2)));
__device__ __forceinline__ unsigned pack2(float a, float b) {
    const f2_t v = {a, b};
    return __builtin_bit_cast(unsigned, __builtin_convertvector(v, bf2_t));
}
__device__ __forceinline__ u16 f2bf(float f) { return (u16)(pack2(f, 0.f) & 0xffffu); }
__device__ __forceinline__ float bf2f(u16 h) { return __uint_as_float(((unsigned)h) << 16); }
__device__ __forceinline__ void glds16(const void* g, void* l) {
    __builtin_amdgcn_global_load_lds((const unsigned*)g, (unsigned*)l, 16, 0, 0);
}
__device__ __forceinline__ void glds16_sc1(const void* g, void* l) {
    __builtin_amdgcn_global_load_lds((const unsigned*)g, (unsigned*)l, 16, 0, 16);
}
__device__ __forceinline__ int lds_byte(int r, int c) {
    int st = (r >> 4) * 2 + (c >> 5), rr = r & 15, cc = c & 31, ob = rr * 64 + cc * 2;
    return st * 1024 + (ob ^ (((ob >> 9) & 1) << 5));
}
template <int CTRL> __device__ __forceinline__ float dppf(float v) {
    return __int_as_float(__builtin_amdgcn_update_dpp(0, __float_as_int(v), CTRL, 0xf, 0xf, true));
}
__device__ __forceinline__ float sum_x16(float v) {
    const unsigned u = __float_as_uint(v);
    const auto r = __builtin_amdgcn_permlane16_swap(u, u, false, false);
    return __uint_as_float(r[0]) + __uint_as_float(r[1]);
}
__device__ __forceinline__ float sum_x32(float v) {
    const unsigned u = __float_as_uint(v);
    const auto r = __builtin_amdgcn_permlane32_swap(u, u, false, false);
    return __uint_as_float(r[0]) + __uint_as_float(r[1]);
}
__device__ __forceinline__ float max_x16(float v) {
    const unsigned u = __float_as_uint(v);
    const auto r = __builtin_amdgcn_permlane16_swap(u, u, false, false);
    return fmaxf(__uint_as_float(r[0]), __uint_as_float(r[1]));
}
__device__ __forceinline__ float max_x32(float v) {
    const unsigned u = __float_as_uint(v);
    const auto r = __builtin_amdgcn_permlane32_swap(u, u, false, false);
    return fmaxf(__uint_as_float(r[0]), __uint_as_float(r[1]));
}
__device__ __forceinline__ float sum16(float v) {
    v += dppf<0xB1>(v);
    v += dppf<0x4E>(v);
    v += dppf<0x141>(v);
    v += dppf<0x140>(v);
    return v;
}
__device__ __forceinline__ float wave_sum(float v) { return sum_x32(sum_x16(sum16(v))); }
template <int CTRL> __device__ __forceinline__ float dpp_f(float v) {
    return __int_as_float(__builtin_amdgcn_update_dpp(0, __float_as_int(v), CTRL, 0xf, 0xf, true));
}
__device__ __forceinline__ float max8(float v) {
    v = fmaxf(v, dpp_f<0xB1>(v));
    v = fmaxf(v, dpp_f<0x4E>(v));
    v = fmaxf(v, dpp_f<0x141>(v));
    return v;
}
__device__ __forceinline__ float sigmoidf_(float x) { return __builtin_amdgcn_rcpf(1.f + __expf(-x)); }
__device__ __forceinline__ float siluf_(float x) { return x * __builtin_amdgcn_rcpf(1.f + __expf(-x)); }
__device__ __forceinline__ float gelu_tanh(float x) {
    float u = 0.7978845608028654f * (x + 0.044715f * x * x * x);
    return x * __builtin_amdgcn_rcpf(1.f + __expf(-2.f * u));
}

template <class FA, class FB>
__device__ __forceinline__ void gemm_tile(int nkt, FA fa, FB fb, f32x4 (&acc)[4][4]) {
    const int tid = TIDX, lane = tid & 63, wid = tid >> 6, wr = wid >> 1, wc = wid & 1, fr = lane & 15, fq = lane >> 4;
    const int sb = lane * 16, swz = sb ^ (((sb >> 9) & 1) << 5);
    const int r_in = swz >> 6, c_in = (swz & 63) >> 1;
#pragma unroll
    for (int m = 0; m < 4; ++m)
#pragma unroll
        for (int n = 0; n < 4; ++n) acc[m][n] = (f32x4){0.f, 0.f, 0.f, 0.f};
    __syncthreads();
    auto stage = [&](int kt, int s) {
        char* sa = smem + s * 32768;
        char* sbm = sa + 16384;
#pragma unroll
        for (int i = 0; i < 4; ++i) {
            const int st = wid + 4 * i, R = (st >> 1) * 16 + r_in, C = (st & 1) * 32 + c_in;
            glds16(fa(R, C, kt), sa + tid * 16 + i * 4096);
            glds16(fb(R, C, kt), sbm + tid * 16 + i * 4096);
        }
    };
    stage(0, 0);
    for (int kt = 0; kt < nkt; ++kt) {
        asm volatile("s_waitcnt vmcnt(0)" ::: "memory");
        __syncthreads();
        if (kt + 1 < nkt) stage(kt + 1, (kt + 1) & 1);
        const char* sa = smem + (kt & 1) * 32768;
        const char* sbm = sa + 16384;
#pragma unroll
        for (int ks = 0; ks < 2; ++ks) {
            bf16x8 a[4], b[4];
#pragma unroll
            for (int m = 0; m < 4; ++m) a[m] = *(const bf16x8*)(sa + lds_byte(wr * 64 + m * 16 + fr, ks * 32 + fq * 8));
#pragma unroll
            for (int n = 0; n < 4; ++n) b[n] = *(const bf16x8*)(sbm + lds_byte(wc * 64 + n * 16 + fr, ks * 32 + fq * 8));
#pragma unroll
            for (int m = 0; m < 4; ++m)
#pragma unroll
                for (int n = 0; n < 4; ++n) acc[m][n] = __builtin_amdgcn_mfma_f32_16x16x32_bf16(a[m], b[n], acc[m][n], 0, 0, 0);
        }
    }
    __syncthreads();
}

__device__ __forceinline__ int lds32(int r, int c) {
    const int rr = r & 15;
    return (r >> 4) * 1024 + ((rr * 64 + c * 2) ^ (((rr >> 3) & 1) << 5));
}
struct NoHook { __device__ __forceinline__ void operator()(int) const {} };
template <bool A_SC1 = false, class FA, class FB, class HK = NoHook>
__device__ __forceinline__ void gemm_tile_w(int nkt, FA fa, FB fb, f32x4 (&acc)[4][8], HK hook = HK()) {
    constexpr bool ZERO = true;
    const int tid = TIDX, lane = tid & 63, wid = tid >> 6, wr = wid >> 1, wc = wid & 1, fr = lane & 15, fq = lane >> 4;
    const int sb = lane * 16, swz = sb ^ (((sb >> 9) & 1) << 5);
    const int r_in = swz >> 6, c_in = (swz & 63) >> 1;
    if (ZERO) {
#pragma unroll
        for (int m = 0; m < 4; ++m)
#pragma unroll
            for (int n = 0; n < 8; ++n) acc[m][n] = (f32x4){0.f, 0.f, 0.f, 0.f};
    }
    __syncthreads();
    auto stage = [&](int kt, int s) {
        char* sa = smem + s * 24576;
#pragma unroll
        for (int i = 0; i < 2; ++i) { if (A_SC1) glds16_sc1(fa(i, (wid + 4 * i) * 16 + r_in, c_in, kt), sa + tid * 16 + i * 4096); else glds16(fa(i, (wid + 4 * i) * 16 + r_in, c_in, kt), sa + tid * 16 + i * 4096); }
#pragma unroll
        for (int i = 0; i < 4; ++i) glds16(fb(i, (wid + 4 * i) * 16 + r_in, c_in, kt), sa + 8192 + tid * 16 + i * 4096);
    };
    stage(0, 0);
    if (nkt > 1) stage(1, 1);
    int s_cur = 0, s_nxt = 2;
    for (int kt = 0; kt < nkt; ++kt) {
        hook(kt);
        if (kt + 1 < nkt) asm volatile("s_waitcnt vmcnt(6) lgkmcnt(0)\n\ts_barrier" ::: "memory");
        else asm volatile("s_waitcnt vmcnt(0) lgkmcnt(0)\n\ts_barrier" ::: "memory");
        if (kt + 2 < nkt) stage(kt + 2, s_nxt);
        const char* sa = smem + s_cur * 24576;
        bf16x8 a[4];
#pragma unroll
        for (int m = 0; m < 4; ++m) a[m] = *(const bf16x8*)(sa + lds32(wr * 64 + m * 16 + fr, fq * 8));
#pragma unroll
        for (int nh = 0; nh < 2; ++nh) {
            bf16x8 b[4];
#pragma unroll
            for (int n = 0; n < 4; ++n) b[n] = *(const bf16x8*)(sa + 8192 + lds32(wc * 128 + (nh * 4 + n) * 16 + fr, fq * 8));
#pragma unroll
            for (int m = 0; m < 4; ++m)
#pragma unroll
                for (int n = 0; n < 4; ++n) acc[m][nh * 4 + n] = __builtin_amdgcn_mfma_f32_16x16x32_bf16(a[m], b[n], acc[m][nh * 4 + n], 0, 0, 0);
        }
        s_cur = (s_cur == 2) ? 0 : s_cur + 1;
        s_nxt = (s_nxt == 2) ? 0 : s_nxt + 1;
    }
    __syncthreads();
}

template <class FV, class FD>
__device__ __forceinline__ void wave_store_bf16_f(FV val, FD dst, bool write_through = false, const char* wt_base = nullptr, unsigned wt_bytes = 0) {
    const __amdgpu_buffer_rsrc_t wt_rsrc = __builtin_amdgcn_make_buffer_rsrc((void*)wt_base, 0, (int)wt_bytes, 0x00020000);
    const int lane = TIDX & 63, wid = TIDX >> 6, fr = lane & 15, fq = lane >> 4;
    char* base = smem + wid * 9216;
#pragma unroll
    for (int m = 0; m < 4; ++m)
#pragma unroll
        for (int n = 0; n < 4; ++n)
#pragma unroll
            for (int j = 0; j < 4; ++j)
                *(u16*)(base + (m * 16 + fq * 4 + j) * 144 + (n * 16 + fr) * 2) = f2bf(val(m, n, j));
    asm volatile("s_waitcnt lgkmcnt(0)" ::: "memory");
    __builtin_amdgcn_wave_barrier();
#pragma unroll
    for (int i = 0; i < 8; ++i) {
        const int id = i * 64 + lane, row = id >> 3, ch = id & 7;
        const uint4 d = *(const uint4*)(base + row * 144 + ch * 16);
        u16* p = dst(row);
        if (p) {
            if (write_through) {
                const u32x4 dv = {d.x, d.y, d.z, d.w};
                __builtin_amdgcn_raw_buffer_store_b128(dv, wt_rsrc, (int)((const char*)(p + ch * 8) - wt_base), 0, 16);
            } else *(uint4*)(p + ch * 8) = d;
        }
    }
    asm volatile("s_waitcnt lgkmcnt(0)" ::: "memory");
    __builtin_amdgcn_wave_barrier();
}

template <class FD>
__device__ __forceinline__ void wave_store_bf16(const float (&v)[4][4][4], FD dst) {
    wave_store_bf16_f([&](int m, int n, int j) { return v[m][n][j]; }, dst);
}

struct ConvD { const float* src; u16* dst; int ld, ldd, k0, n0, mode, zr; };
__device__ __forceinline__ void conv_load(const Params& p, const ConvD& d, float (&v)[16]) {
    const int tid = TIDX;
#pragma unroll
    for (int i = 0; i < 16; ++i) v[i] = d.src[(size_t)(d.k0 + i * 4 + (tid >> 6)) * d.ld + d.n0 + (tid & 63)];
    if (d.zr == 2) {
#pragma unroll
        for (int i = 0; i < 16; ++i) {
            const int k = d.k0 + i * 4 + (tid >> 6);
            v[i] *= (k < 512) ? p.norm_attn_out[k] : p.norm_ssm_out[k - 512];
        }
    }
}
__device__ __forceinline__ void conv_store(const Params& p, const ConvD& d, const float (&v)[16]) {
    float* t = (float*)smem;
    const int tid = TIDX;
    __syncthreads();
#pragma unroll
    for (int i = 0; i < 16; ++i) t[(i * 4 + (tid >> 6)) * 65 + (tid & 63)] = v[i];
    __syncthreads();
    const int n = tid >> 2, kq = tid & 3;
    unsigned w[8];
#pragma unroll
    for (int i = 0; i < 8; ++i) w[i] = pack2(t[(kq * 16 + 2 * i) * 65 + n], t[(kq * 16 + 2 * i + 1) * 65 + n]);
    const int gn = d.n0 + n;
    int row = gn;
    if (d.mode == 1) row = (gn >> 4) * 32 + (gn & 15);
    else if (d.mode == 2) row = (gn >> 4) * 32 + 16 + (gn & 15);
    else if (d.mode == 3) row = n;
    uint4* o = (uint4*)(d.dst + (size_t)row * d.ldd + d.k0 + kq * 16);
    o[0] = make_uint4(w[0], w[1], w[2], w[3]);
    o[1] = make_uint4(w[4], w[5], w[6], w[7]);
    if (d.zr == 1) {
        uint4* z = (uint4*)(WSP_WrT + (size_t)(64 + n) * 1024 + d.k0 + kq * 16);
        z[0] = make_uint4(0, 0, 0, 0); z[1] = make_uint4(0, 0, 0, 0);
    }
}

__device__ __forceinline__ void ada_item(const Params& p, int item) {
    float* sc = (float*)smem;
    float* red = sc + 9 * 1024;
    const int tid = TIDX;
    __syncthreads();
    for (int i = tid; i < 9 * 1024; i += NTHR) {
        const int r = i >> 10, k = i & 1023;
        const float cv = (r < 8) ? p.c[r * 1024 + k] : p.c_ctx[k];
        sc[i] = siluf_(cv);
    }
    __syncthreads();
    const int kq = tid >> 6, jl = tid & 63, j = item * 64 + jl;
    float acc[9];
#pragma unroll
    for (int r = 0; r < 9; ++r) acc[r] = 0.f;
#pragma unroll 16
    for (int k = kq; k < 1024; k += 4) {
        const float w = p.w_ada[(size_t)k * 6144 + j];
#pragma unroll
        for (int r = 0; r < 9; ++r) acc[r] += sc[r * 1024 + k] * w;
    }
#pragma unroll
    for (int r = 0; r < 9; ++r) red[(kq * 9 + r) * 64 + jl] = acc[r];
    __syncthreads();
    for (int i = tid; i < 9 * 64; i += NTHR) {
        const int r = i >> 6, l = i & 63;
        const float s = red[(0 * 9 + r) * 64 + l] + red[(1 * 9 + r) * 64 + l] + red[(2 * 9 + r) * 64 + l] + red[(3 * 9 + r) * 64 + l];
        WSP_mod[r * 6144 + item * 64 + l] = s + p.b_ada[item * 64 + l];
    }
}

__device__ __forceinline__ void rope_item(const Params& p) {
    for (int i = TIDX; i < 64 * 16; i += NTHR) {
        const int pos = i >> 4, k = i & 15;
        const float inv = exp2f(-(float)k * (13.287712379549449f / 16.f));
        float s, c;
        sincosf((float)pos * inv, &s, &c);
        WSP_rope[i] = make_float2(c, s);
    }
}

__device__ __forceinline__ void ssm_table_item(const Params& p, int g, int dir) {
    float* pw = (float*)smem;
    float* Bb = pw + 17 * 64 * 2;
    float* Cc = Bb + 64 * 16 * 2;
    const int tid = TIDX;
    u16* tabS = WSP_TabS + (size_t)g * 256 * 256;
    u16* tabY = WSP_TabY + (size_t)g * 256 * 512;
    float* Kf = WSP_Kbuf + (size_t)(g * 2 + dir) * 4096;
    __syncthreads();
    {
        const int pidx = dir * 32 + g;
        const float dt = __expf(p.log_dt[pidx]);
        for (int i = tid; i < 17 * 64; i += NTHR) {
            const int tau = i >> 6, n = i & 63;
            const float are = p.a_re[pidx * 64 + n], aim = p.a_im[pidx * 64 + n];
            const float mag = __expf((float)tau * dt * are);
            float rev = (float)tau * (dt * aim * 0.15915494309189535f);
            rev -= rintf(rev);
            pw[i * 2] = mag * __builtin_amdgcn_cosf(rev);
            pw[i * 2 + 1] = mag * __builtin_amdgcn_sinf(rev);
        }
        __syncthreads();
        for (int i = tid; i < 64 * 16; i += NTHR) {
            const int n = i >> 4;
            const float are = p.a_re[pidx * 64 + n], aim = p.a_im[pidx * 64 + n];
            const float abr = pw[(64 + n) * 2], abi = pw[(64 + n) * 2 + 1];
            const float den = are * are + aim * aim, nre = abr - 1.f;
            const float cre = (nre * are + abi * aim) / den, cim = (abi * are - nre * aim) / den;
            const float br = p.b_re[(size_t)pidx * 1024 + i], bi = p.b_im[(size_t)pidx * 1024 + i];
            Bb[i * 2] = cre * br - cim * bi;
            Bb[i * 2 + 1] = cre * bi + cim * br;
            Cc[i * 2] = p.c_re[(size_t)pidx * 1024 + i];
            Cc[i * 2 + 1] = p.c_im[(size_t)pidx * 1024 + i];
        }
        __syncthreads();
        {
            const int tau = tid >> 4, pp = tid & 15;
            float s[16];
#pragma unroll
            for (int q = 0; q < 16; ++q) s[q] = 0.f;
            for (int n = 0; n < 64; ++n) {
                const float2 cv = *(const float2*)&Cc[(pp * 64 + n) * 2];
                const float2 wv = *(const float2*)&pw[(tau * 64 + n) * 2];
                const float zr = cv.x * wv.x - cv.y * wv.y, zi = cv.x * wv.y + cv.y * wv.x;
#pragma unroll
                for (int q = 0; q < 16; ++q) {
                    const float2 bv = *(const float2*)&Bb[(n * 16 + q) * 2];
                    s[q] += zr * bv.x - zi * bv.y;
                }
            }
#pragma unroll
            for (int q = 0; q < 4; ++q)
                *(float4*)(Kf + tau * 256 + pp * 16 + q * 4) = make_float4(s[4 * q], s[4 * q + 1], s[4 * q + 2], s[4 * q + 3]);
        }
        for (int id = tid; id < 128 * 32; id += NTHR) {
            const int rr = id >> 5, ch = id & 31, cpart = rr >> 6, n = rr & 63, s_ = ch >> 1, q0 = (ch & 1) * 8;
            const int e = dir == 0 ? 15 - s_ : s_;
            const float wr_ = pw[(e * 64 + n) * 2], wi_ = pw[(e * 64 + n) * 2 + 1];
            unsigned w[4];
#pragma unroll
            for (int i = 0; i < 4; ++i) {
                float v[2];
#pragma unroll
                for (int h = 0; h < 2; ++h) {
                    const float br = Bb[(n * 16 + q0 + 2 * i + h) * 2], bi = Bb[(n * 16 + q0 + 2 * i + h) * 2 + 1];
                    v[h] = cpart == 0 ? (wr_ * br - wi_ * bi) : (wr_ * bi + wi_ * br);
                }
                w[i] = pack2(v[0], v[1]);
            }
            *(uint4*)(tabS + (size_t)(dir * 128 + rr) * 256 + s_ * 16 + q0) = make_uint4(w[0], w[1], w[2], w[3]);
        }
        for (int id = tid; id < 256 * 16; id += NTHR) {
            const int m = id >> 4, ch = id & 15, t = m >> 4, pp = m & 15, cpart = ch >> 3, n0 = (ch & 7) * 8;
            const int e = dir == 0 ? t + 1 : 16 - t;
            unsigned w[4];
#pragma unroll
            for (int i = 0; i < 4; ++i) {
                float v[2];
#pragma unroll
                for (int h = 0; h < 2; ++h) {
                    const int n = n0 + 2 * i + h;
                    const float cr = Cc[(pp * 64 + n) * 2], ci = Cc[(pp * 64 + n) * 2 + 1];
                    const float wr_ = pw[(e * 64 + n) * 2], wi_ = pw[(e * 64 + n) * 2 + 1];
                    v[h] = cpart == 0 ? (cr * wr_ - ci * wi_) : -(cr * wi_ + ci * wr_);
                }
                w[i] = pack2(v[0], v[1]);
            }
            *(uint4*)(tabY + (size_t)m * 512 + 256 + dir * 128 + cpart * 64 + n0) = make_uint4(w[0], w[1], w[2], w[3]);
        }
    }
}

__device__ __forceinline__ void ssm_toeplitz_item(const Params& p, int g) {
    float* Kf = (float*)smem;
    const int tid = TIDX;
    u16* tabY = WSP_TabY + (size_t)g * 256 * 512;
    __syncthreads();
    for (int i = tid; i < 2048; i += NTHR) ((float4*)Kf)[i] = ((const float4*)(WSP_Kbuf + (size_t)g * 8192))[i];
    __syncthreads();
    for (int id = tid; id < 256 * 32; id += NTHR) {
        const int m = id >> 5, ch = id & 31, t = m >> 4, pp = m & 15, s_ = ch >> 1, q0 = (ch & 1) * 8;
        unsigned w[4];
#pragma unroll
        for (int i = 0; i < 4; ++i) {
            float v[2];
#pragma unroll
            for (int h = 0; h < 2; ++h) {
                const int q = q0 + 2 * i + h;
                float val;
                if (s_ < t) val = Kf[((t - s_) * 16 + pp) * 16 + q];
                else if (s_ > t) val = Kf[4096 + ((s_ - t) * 16 + pp) * 16 + q];
                else val = Kf[(pp) * 16 + q] + Kf[4096 + pp * 16 + q] + (pp == q ? p.ssm_d[g * 16 + pp] : 0.f);
                v[h] = val;
            }
            w[i] = pack2(v[0], v[1]);
        }
        *(uint4*)(tabY + (size_t)m * 512 + s_ * 16 + q0) = make_uint4(w[0], w[1], w[2], w[3]);
    }
    __syncthreads();
}

#define N_CONV 6896
__device__ __forceinline__ ConvD conv_decode(const Params& p, int t) {
    ConvD d; d.mode = 0; d.zr = 0;
    if (t < 320) { d.src = p.w_in; d.ld = 1280; d.k0 = (t / 20) * 64; d.n0 = (t % 20) * 64; d.dst = WSP_WinT; d.ldd = 1024; return d; }
    t -= 320;
    if (t < 64) { d.src = p.w_glu; d.ld = 512; d.k0 = (t / 8) * 64; d.n0 = (t % 8) * 64; d.dst = WSP_WgluT; d.ldd = 512; return d; }
    t -= 64;
    if (t < 256) { d.src = p.w_out; d.ld = 1024; d.k0 = (t / 16) * 64; d.n0 = (t % 16) * 64; d.dst = WSP_WoutT; d.ldd = 1024; d.zr = 2; return d; }
    t -= 256;
    if (t < 16) { d.src = p.w_router; d.ld = 64; d.k0 = t * 64; d.n0 = 0; d.dst = WSP_WrT; d.ldd = 1024; d.zr = 1; return d; }
    t -= 16;
    if (t < 4096) {
        const int up = t >= 2048; const int tt = t & 2047, e = tt >> 5, r = tt & 31;
        d.src = (up ? p.w_up_e : p.w_gate_e) + (size_t)e * 131072; d.ld = 128; d.k0 = (r >> 1) * 64; d.n0 = (r & 1) * 64;
        d.dst = WSP_WguT + (size_t)e * 262144; d.ldd = 1024; d.mode = 1 + up; return d;
    }
    t -= 4096;
    if (t < 64) {
        const int up = t >= 32; const int r = t & 31;
        d.src = up ? p.w_up_s : p.w_gate_s; d.ld = 128; d.k0 = (r >> 1) * 64; d.n0 = (r & 1) * 64;
        d.dst = WSP_WguT + (size_t)64 * 262144; d.ldd = 1024; d.mode = 1 + up; return d;
    }
    t -= 64;
    if (t < 2048) { const int e = t >> 5, r = t & 31; d.src = p.w_down_e + (size_t)e * 131072; d.ld = 1024; d.k0 = (r >> 4) * 64; d.n0 = (r & 15) * 64; d.dst = WSP_WdT + (size_t)e * 131072; d.ldd = 128; return d; }
    t -= 2048;
    d.src = p.w_down_s; d.ld = 1024; d.k0 = (t >> 4) * 64; d.n0 = (t & 15) * 64; d.dst = WSP_WdT + (size_t)64 * 131072; d.ldd = 128; return d;
}

#define N_CONV_EARLY 4000
__device__ __forceinline__ void conv_range(const Params& p, int t0, int stride, int tend, int tbeg = 0) {
    int t = tbeg + t0;
    if (t < tend) {
        ConvD d = conv_decode(p, t);
        float v[16];
        conv_load(p, d, v);
        while (t < tend) {
            const int tn = t + stride;
            ConvD dn = d;
            float vn[16];
            if (tn < tend) { dn = conv_decode(p, tn); conv_load(p, dn, vn); }
            conv_store(p, d, v);
            d = dn;
#pragma unroll
            for (int i = 0; i < 16; ++i) v[i] = vn[i];
            t = tn;
        }
    }
}
#define P0_CONV_B0 161
__device__ __forceinline__ void phase0(const Params& p) {
    const int b = blockIdx.x, G = gridDim.x;
    if (G > P0_CONV_B0 + 32) {
        if (b < 64) ssm_table_item(p, b >> 1, b & 1);
        else if (b < 160) ada_item(p, b - 64);
        else if (b == 160) rope_item(p);
        else conv_range(p, b - P0_CONV_B0, G - P0_CONV_B0, N_CONV_EARLY);
    } else {
        const int NU = 64 + 96 + 1 + N_CONV_EARLY;
        for (int u = b; u < NU; u += G) {
            if (u < 64) ssm_table_item(p, u >> 1, u & 1);
            else if (u < 160) ada_item(p, u - 64);
            else if (u == 160) rope_item(p);
            else { ConvD d = conv_decode(p, u - 161); float v[16]; conv_load(p, d, v); conv_store(p, d, v); }
        }
    }
}
#if 0
    {
        {
            const int stride = G - P0_CONV_B0;
            int t = b - P0_CONV_B0;
            if (t < N_CONV) {
                ConvD d = conv_decode(p, t);
                float v[16];
                conv_load(p, d, v);
                while (t < N_CONV) {
                    const int tn = t + stride;
                    ConvD dn = d;
                    float vn[16];
                    if (tn < N_CONV) { dn = conv_decode(p, tn); conv_load(p, dn, vn); }
                    conv_store(p, d, v);
                    d = dn;
#pragma unroll
                    for (int i = 0; i < 16; ++i) v[i] = vn[i];
                    t = tn;
                }
            }
        }
    } else {
        const int NU = 64 + 96 + 1 + N_CONV;
        for (int u = b; u < NU; u += G) {
            if (u < 64) ssm_table_item(p, u >> 1, u & 1);
            else if (u < 160) ada_item(p, u - 64);
            else if (u == 160) rope_item(p);
            else { ConvD d = conv_decode(p, u - 161); float v[16]; conv_load(p, d, v); conv_store(p, d, v); }
        }
    }
}

#endif

__device__ __forceinline__ void norm_mod_row(const float* src, const float* gain, const float* sh, const float* scl, u16* dst) {
    const int lane = TIDX & 63;
    float4 v[4];
    float ss = 0.f;
#pragma unroll
    for (int i = 0; i < 4; ++i) {
        v[i] = *(const float4*)(src + i * 256 + lane * 4);
        ss += v[i].x * v[i].x + v[i].y * v[i].y + v[i].z * v[i].z + v[i].w * v[i].w;
    }
    ss = wave_sum(ss);
    const float rs = rsqrtf(ss * (1.f / 1024.f) + EPS);
#pragma unroll
    for (int i = 0; i < 4; ++i) {
        const int c0 = i * 256 + lane * 4;
        const float4 g = *(const float4*)(gain + c0), s = *(const float4*)(sh + c0), k = *(const float4*)(scl + c0);
        const float a = v[i].x * rs * g.x * (1.f + k.x) + s.x, b = v[i].y * rs * g.y * (1.f + k.y) + s.y;
        const float c = v[i].z * rs * g.z * (1.f + k.z) + s.z, d = v[i].w * rs * g.w * (1.f + k.w) + s.w;
        *(uint2*)(dst + c0) = make_uint2(pack2(a, b), pack2(c, d));
    }
}

__device__ __forceinline__ void phase1(const Params& p) {
    const int wv = blockIdx.x * 4 + (TIDX >> 6), nwv = gridDim.x * 4;
    const int lane = TIDX & 63;
    for (int r0 = wv * 4; r0 < NROWS; r0 += nwv * 4) {
        const float* src[4]; const float* md[4];
        float4 v[4][4];
#pragma unroll
        for (int q = 0; q < 4; ++q) {
            const int r = r0 + q;
            if (r < NLAT) { src[q] = p.x + (size_t)r * 1024; md[q] = WSP_mod + (r >> 11) * 6144; }
            else { src[q] = p.ctx + (size_t)(r - NLAT) * 1024; md[q] = WSP_mod + 8 * 6144; }
#pragma unroll
            for (int i = 0; i < 4; ++i) v[q][i] = *(const float4*)(src[q] + i * 256 + lane * 4);
        }
#pragma unroll
        for (int q = 0; q < 4; ++q) {
            float ss = 0.f;
#pragma unroll
            for (int i = 0; i < 4; ++i) ss += v[q][i].x * v[q][i].x + v[q][i].y * v[q][i].y + v[q][i].z * v[q][i].z + v[q][i].w * v[q][i].w;
            ss = wave_sum(ss);
            const float rs = rsqrtf(ss * (1.f / 1024.f) + EPS);
            u16* dst = WSP_Hb + (size_t)(r0 + q) * 1024;
#pragma unroll
            for (int i = 0; i < 4; ++i) {
                const int c0 = i * 256 + lane * 4;
                const float4 g = *(const float4*)(p.norm_mix + c0), s = *(const float4*)(md[q] + c0), k = *(const float4*)(md[q] + 1024 + c0);
                const float a = v[q][i].x * rs * g.x * (1.f + k.x) + s.x, b = v[q][i].y * rs * g.y * (1.f + k.y) + s.y;
                const float c = v[q][i].z * rs * g.z * (1.f + k.z) + s.z, d = v[q][i].w * rs * g.w * (1.f + k.w) + s.w;
                *(uint2*)(dst + c0) = make_uint2(pack2(a, b), pack2(c, d));
            }
        }
    }
}

__device__ __forceinline__ void phase2(const Params& p) {
    const int NU = 128 * 10 + 16 * 6;
    const int lane = TIDX & 63, wid = TIDX >> 6, wr = wid >> 1, wc = wid & 1, fr = lane & 15, fq = lane >> 4;
    for (int u = blockIdx.x; u < NU; u += gridDim.x) {
        int mt, nt;
        {
            const int xc = u & 7, r = u >> 3;
            if (r < 160) { mt = xc + 8 * (r / 10); nt = r % 10; } else { const int v = r - 160; mt = 128 + xc + 8 * (v / 6); nt = 4 + v % 6; }
        }
        const u16* A = WSP_Hb + (size_t)mt * 128 * 1024;
        const u16* B = WSP_WinT + (size_t)nt * 128 * 1024;
        f32x4 acc[4][4];
        gemm_tile(16,
            [&](int R, int C, int kt) { return (const void*)(A + (size_t)R * 1024 + kt * 64 + C); },
            [&](int R, int C, int kt) { return (const void*)(B + (size_t)R * 1024 + kt * 64 + C); }, acc);
        const int row0 = mt * 128 + wr * 64;
        const int col0 = nt * 128 + wc * 64;
        const bool is_lat = mt < 128;
        if (nt == 5) {
            const int kvh = wc;
#pragma unroll
            for (int m = 0; m < 4; ++m) {
                const int r = row0 + m * 16 + fq * 4;
                int b, pos;
                if (is_lat) { b = r >> 11; pos = r & 2047; } else { const int rc = r - NLAT; b = rc >> 8; pos = SEQ + (rc & 255); }
#pragma unroll
                for (int n = 0; n < 4; ++n) {
                    const int d = n * 16 + fr;
                    u16* dst = WSP_Vt + ((size_t)(b * 2 + kvh) * 64 + d) * VT_LD + pos;
                    *(uint2*)dst = make_uint2(pack2(acc[m][n][0], acc[m][n][1]), pack2(acc[m][n][2], acc[m][n][3]));
                }
            }
        } else {
            float v[4][4][4];
            const bool do_rope = is_lat && nt <= 4;
#pragma unroll
            for (int m = 0; m < 4; ++m)
#pragma unroll
                for (int j = 0; j < 4; ++j) {
                    if (do_rope) {
                        const int r = row0 + m * 16 + fq * 4 + j, pos = r & 2047;
                        const float2 cr = WSP_rope[(pos >> 6) * 16 + fr], cc = WSP_rope[(pos & 63) * 16 + fr];
                        const float x1 = acc[m][0][j], x2 = acc[m][1][j], y1 = acc[m][2][j], y2 = acc[m][3][j];
                        v[m][0][j] = x1 * cr.x - x2 * cr.y; v[m][1][j] = x1 * cr.y + x2 * cr.x;
                        v[m][2][j] = y1 * cc.x - y2 * cc.y; v[m][3][j] = y1 * cc.y + y2 * cc.x;
                    } else {
#pragma unroll
                        for (int n = 0; n < 4; ++n) v[m][n][j] = acc[m][n][j];
                    }
                }
            u16* dbase; int ldd;
            if (nt < 4) { dbase = WSP_Q + (size_t)row0 * 512 + col0; ldd = 512; }
            else if (nt == 4) { dbase = WSP_Kb + (size_t)row0 * 128 + (col0 - 512); ldd = 128; }
            else { dbase = WSP_U + (size_t)row0 * 512 + (col0 - 768); ldd = 512; }
            wave_store_bf16(v, [&](int row) { return dbase + (size_t)row * ldd; });
        }
    }
}

__device__ __forceinline__ void attn_unit(const Params& p, int u) {
    const int h = u & 7, qb = (u >> 3) & 15, b = u >> 7, kvh = h >> 2;
    const int tid = TIDX, lane = tid & 63, wid = tid >> 6, fr = lane & 15, fq = lane >> 4;
    const int sb = lane * 16, swz = sb ^ (((sb >> 9) & 1) << 5);
    const int r_in = swz >> 6, c_in = (swz & 63) >> 1;
    const int jstart = qb == 0 ? 2 : 0, jend = qb == 15 ? 4 : 6, nb = jend - jstart, ntile = nb + 4;
    const float SC = 0.125f * 1.4426950408889634f;
    bf16x8 qf[2][2];
    const int qrow0 = b * SEQ + qb * 128 + wid * 32;
#pragma unroll
    for (int qt = 0; qt < 2; ++qt)
#pragma unroll
        for (int ks = 0; ks < 2; ++ks)
            qf[qt][ks] = *(const bf16x8*)(WSP_Q + (size_t)(qrow0 + qt * 16 + fr) * 512 + h * 64 + ks * 32 + fq * 8);
    f32x4 o[4][2];
#pragma unroll
    for (int dt = 0; dt < 4; ++dt)
#pragma unroll
        for (int qt = 0; qt < 2; ++qt) o[dt][qt] = (f32x4){0.f, 0.f, 0.f, 0.f};
    float mrun[2], lrun[2];
    const float sinkv = p.attn_sink[h] * 1.4426950408889634f;
    mrun[0] = mrun[1] = sinkv;
    lrun[0] = lrun[1] = (fq == 0) ? 1.f : 0.f;
    __syncthreads();
    const u16* kp[2]; const u16* vp[2];
    {
        const int ks0 = qb * 128 - 128 + 64 * jstart;
#pragma unroll
        for (int it = 0; it < 2; ++it) {
            const int st = wid + 4 * it, R = (st >> 1) * 16 + r_in, C = (st & 1) * 32 + c_in;
            kp[it] = WSP_Kb + (size_t)(b * SEQ + ks0 + R) * 128 + kvh * 64 + C;
            vp[it] = WSP_Vt + ((size_t)(b * 2 + kvh) * 64 + R) * VT_LD + ks0 + C;
        }
    }
    auto stage = [&](int i, int s) {
        char* sk = smem + s * 16384;
        char* sv = sk + 8192;
#pragma unroll
        for (int it = 0; it < 2; ++it) {
            glds16(kp[it], sk + tid * 16 + it * 4096);
            glds16(vp[it], sv + tid * 16 + it * 4096);
        }
        if (i + 1 == nb) {
            const int ks0 = qb * 128 - 128 + 64 * (jstart + i);
#pragma unroll
            for (int it = 0; it < 2; ++it) {
                kp[it] += (size_t)(NLAT + b * CTXL - (b * SEQ + ks0)) * 128;
                vp[it] += SEQ - ks0;
            }
        } else {
#pragma unroll
            for (int it = 0; it < 2; ++it) { kp[it] += 64 * 128; vp[it] += 64; }
        }
    };
    stage(0, 0);
    for (int i = 0; i < ntile; ++i) {
        asm volatile("s_waitcnt vmcnt(0)" ::: "memory");
        __syncthreads();
        if (i + 1 < ntile) stage(i + 1, (i + 1) & 1);
        const char* sk = smem + (i & 1) * 16384;
        const char* sv = sk + 8192;
        f32x4 s[4][2];
#pragma unroll
        for (int kt = 0; kt < 4; ++kt)
#pragma unroll
            for (int qt = 0; qt < 2; ++qt) s[kt][qt] = (f32x4){0.f, 0.f, 0.f, 0.f};
#pragma unroll
        for (int ks = 0; ks < 2; ++ks)
#pragma unroll
            for (int kt = 0; kt < 4; ++kt) {
                const bf16x8 kf = *(const bf16x8*)(sk + lds_byte(32 * (kt >> 1) + 8 * (fr >> 2) + 4 * (kt & 1) + (fr & 3), ks * 32 + fq * 8));
#pragma unroll
                for (int qt = 0; qt < 2; ++qt) s[kt][qt] = __builtin_amdgcn_mfma_f32_16x16x32_bf16(kf, qf[qt][ks], s[kt][qt], 0, 0, 0);
            }
        const int ks0 = qb * 128 - 128 + 64 * (jstart + i);
        const int qlo = qb * 128 + wid * 32;
        const bool band = (i < nb) && ((qlo + 31 - ks0 > 128) || (ks0 + 63 - qlo > 128));
        bf16x8 pf[2][2];
#pragma unroll
        for (int qt = 0; qt < 2; ++qt) {
            const int qp = qb * 128 + wid * 32 + qt * 16 + fr;
            float mx = -1e30f;
            if (band) {
#pragma unroll
                for (int kt = 0; kt < 4; ++kt)
#pragma unroll
                    for (int j = 0; j < 4; ++j) {
                        const int kp = ks0 + 32 * (kt >> 1) + 8 * fq + 4 * (kt & 1) + j, d = qp - kp;
                        const float v = (d > 128 || d < -128) ? -1e30f : s[kt][qt][j];
                        s[kt][qt][j] = v;
                        mx = fmaxf(mx, v);
                    }
                asm volatile("" ::: "memory");
            } else {
#pragma unroll
                for (int kt = 0; kt < 4; ++kt)
#pragma unroll
                    for (int j = 0; j < 4; ++j) mx = fmaxf(mx, s[kt][qt][j]);
            }
            mx = max_x32(max_x16(mx));
            const float mnew = fmaxf(mrun[qt], mx * SC);
            const float alpha = __builtin_amdgcn_exp2f(mrun[qt] - mnew);
            mrun[qt] = mnew;
            float ls = 0.f;
#pragma unroll
            for (int kt = 0; kt < 4; ++kt)
#pragma unroll
                for (int j = 0; j < 4; ++j) {
                    const float pv = __builtin_amdgcn_exp2f(fmaf(s[kt][qt][j], SC, -mnew));
                    s[kt][qt][j] = pv;
                    ls += pv;
                }
            lrun[qt] = lrun[qt] * alpha + ls;
            if (!__all(alpha == 1.f)) {
#pragma unroll
                for (int dt = 0; dt < 4; ++dt) o[dt][qt] *= alpha;
            }
#pragma unroll
            for (int k2 = 0; k2 < 2; ++k2) {
                bf16x8 t;
#pragma unroll
                for (int j = 0; j < 4; ++j) { t[j] = (short)f2bf(s[2 * k2][qt][j]); t[4 + j] = (short)f2bf(s[2 * k2 + 1][qt][j]); }
                pf[qt][k2] = t;
            }
        }
#pragma unroll
        for (int k2 = 0; k2 < 2; ++k2)
#pragma unroll
            for (int dt = 0; dt < 4; ++dt) {
                const bf16x8 vf = *(const bf16x8*)(sv + lds_byte(dt * 16 + fr, k2 * 32 + fq * 8));
#pragma unroll
                for (int qt = 0; qt < 2; ++qt) o[dt][qt] = __builtin_amdgcn_mfma_f32_16x16x32_bf16(vf, pf[qt][k2], o[dt][qt], 0, 0, 0);
            }
    }
#pragma unroll
    for (int qt = 0; qt < 2; ++qt) {
        const float l = sum_x32(sum_x16(lrun[qt]));
        const float inv = 1.f / l;
        u16* dst = WSP_AO + (size_t)(qrow0 + qt * 16 + fr) * 512 + h * 64 + fq * 4;
        float sq = 0.f;
#pragma unroll
        for (int dt = 0; dt < 4; ++dt) {
            const unsigned w0 = pack2(o[dt][qt][0] * inv, o[dt][qt][1] * inv), w1 = pack2(o[dt][qt][2] * inv, o[dt][qt][3] * inv);
            *(uint2*)(dst + dt * 16) = make_uint2(w0, w1);
            const float a = bf2f((u16)(w0 & 0xffffu)), b = bf2f((u16)(w0 >> 16)), c = bf2f((u16)(w1 & 0xffffu)), d = bf2f((u16)(w1 >> 16));
            sq += a * a + b * b + c * c + d * d;
        }
        sq = sum_x32(sum_x16(sq));
        if (fq == 0) unsafeAtomicAdd(WSP_rsq + (size_t)(qrow0 + qt * 16 + fr) * 2, sq);
    }
}

__device__ __forceinline__ void ssm_s1_unit(const Params& p, int u) {
    const int ct = u % 9, mh = (u / 9) & 1, g = u / 18;
    const int lane = TIDX & 63, wid = TIDX >> 6, wr = wid >> 1, wc = wid & 1, fr = lane & 15, fq = lane >> 4;
    const u16* A = WSP_TabS + ((size_t)g * 256 + mh * 128) * 256;
    const u16* Ub = WSP_U + (size_t)ct * 128 * 16 * 512 + g * 16;
    f32x4 acc[4][4];
    gemm_tile(4,
        [&](int R, int C, int kt) { return (const void*)(A + (size_t)R * 256 + kt * 64 + C); },
        [&](int R, int C, int kt) { return (const void*)(Ub + (size_t)(R * 16 + kt * 4 + (C >> 4)) * 512 + (C & 15)); }, acc);
#pragma unroll
    for (int m = 0; m < 4; ++m)
#pragma unroll
        for (int n = 0; n < 4; ++n) {
            const int rho = mh * 128 + wr * 64 + m * 16 + fq * 4;
            const int cg = ct * 128 + wc * 64 + n * 16 + fr;
            *(f32x4*)(WSP_S + ((size_t)cg * 32 + g) * 256 + rho) = acc[m][n];
        }
}

__device__ __forceinline__ void phase3(const Params& p) {
    for (int u = blockIdx.x; u < 1024; u += gridDim.x) attn_unit(p, u);
    int* qv = (int*)(smem + 73728);
    for (;;) {
        __syncthreads();
        if (TIDX == 0) qv[0] = (int)atomicAdd(&WSP_ctr[CTR_QS1], 1u);
        __syncthreads();
        const int u = __builtin_amdgcn_readfirstlane(qv[0]);
        if (u >= 576) break;
        ssm_s1_unit(p, u);
    }
}

__device__ __forceinline__ void phase4(const Params& p) {
    if ((int)gridDim.x > 192) {
        if ((int)blockIdx.x >= 160) { conv_range(p, blockIdx.x - 160, gridDim.x - 160, N_CONV, N_CONV_EARLY); return; }
        if ((int)blockIdx.x >= 128) { ssm_toeplitz_item(p, blockIdx.x - 128); return; }
    } else {
        for (int g = blockIdx.x; g < 32; g += gridDim.x) ssm_toeplitz_item(p, g);
        conv_range(p, blockIdx.x, gridDim.x, N_CONV, N_CONV_EARLY);
    }
    const int gid = blockIdx.x * NTHR + TIDX;
    if (gid >= BATCH * 2 * 32 * 64) return;
    const int n = gid & 63, g = (gid >> 6) & 31, dir = (gid >> 11) & 1, b = gid >> 12;
    const int pidx = dir * 32 + g;
    const float dt = __expf(p.log_dt[pidx]);
    const float are = p.a_re[pidx * 64 + n], aim = p.a_im[pidx * 64 + n];
    const float mag = __expf(16.f * dt * are);
    float rev = 16.f * (dt * aim * 0.15915494309189535f);
    rev -= rintf(rev);
    const float ar = mag * __builtin_amdgcn_cosf(rev), ai = mag * __builtin_amdgcn_sinf(rev);
    float hr = 0.f, hi = 0.f;
    const size_t so = (size_t)g * 256 + dir * 128 + n;
#pragma unroll 8
    for (int i = 0; i < 16; ++i) {
        const int c = dir == 0 ? i : 15 - i;
        const float* sp = WSP_S + (size_t)(NCHUNK_LAT + b * 16 + c) * 8192 + so;
        const float sr = sp[0], si = sp[64];
        const float nr = ar * hr - ai * hi + sr, ni = ar * hi + ai * hr + si;
        hr = nr; hi = ni;
    }
#pragma unroll 8
    for (int i = 0; i < 128; ++i) {
        const int c = dir == 0 ? i : 127 - i;
        const size_t cg = (size_t)b * 128 + c;
        const float* sp = WSP_S + cg * 8192 + so;
        const float sr = sp[0], si = sp[64];
        u16* hp = WSP_Hin + cg * 8192 + so;
        hp[0] = f2bf(hr); hp[64] = f2bf(hi);
        const float nr = ar * hr - ai * hi + sr, ni = ar * hi + ai * hr + si;
        hr = nr; hi = ni;
    }
}

__device__ __forceinline__ void phase5(const Params& p) {
    const int NU = 512;
    const int lane = TIDX & 63, wid = TIDX >> 6, wr = wid >> 1, wc = wid & 1, fr = lane & 15, fq = lane >> 4;
    for (int u = blockIdx.x; u < NU; u += gridDim.x) {
        const int ct = u & 7, mh = (u >> 3) & 1, g = u >> 4;
        const u16* A = WSP_TabY + ((size_t)g * 256 + mh * 128) * 512;
        const u16* Ub = WSP_U + (size_t)ct * 128 * 16 * 512 + g * 16;
        const u16* Hb_ = WSP_Hin + (size_t)ct * 128 * 8192 + g * 256;
        f32x4 acc[4][4];
        gemm_tile(8,
            [&](int R, int C, int kt) { return (const void*)(A + (size_t)R * 512 + kt * 64 + C); },
            [&](int R, int C, int kt) {
                return kt < 4 ? (const void*)(Ub + (size_t)(R * 16 + kt * 4 + (C >> 4)) * 512 + (C & 15))
                              : (const void*)(Hb_ + (size_t)R * 8192 + (kt - 4) * 64 + C);
            }, acc);
#pragma unroll
        for (int m = 0; m < 4; ++m)
#pragma unroll
            for (int n = 0; n < 4; ++n) {
                const int t = mh * 8 + wr * 4 + m;
                const int cg = ct * 128 + wc * 64 + n * 16 + fr;
                u16* dst = WSP_Y + ((size_t)cg * 16 + t) * 512 + g * 16 + fq * 4;
                *(uint2*)dst = make_uint2(pack2(gelu_tanh(acc[m][n][0]), gelu_tanh(acc[m][n][1])),
                                          pack2(gelu_tanh(acc[m][n][2]), gelu_tanh(acc[m][n][3])));
            }
    }
}

__device__ __forceinline__ void phase6(const Params& p) {
    const int NU = 512;
    const int lane = TIDX & 63, wid = TIDX >> 6, wr = wid >> 1, wc = wid & 1, fr = lane & 15, fq = lane >> 4;
    for (int u = blockIdx.x; u < NU; u += gridDim.x) {
        const int mt = u >> 2, nt = u & 3;
        const u16* A = WSP_Y + (size_t)mt * 128 * 512;
        const u16* B = WSP_WgluT + (size_t)nt * 128 * 512;
        f32x4 acc[4][4];
        gemm_tile(8,
            [&](int R, int C, int kt) { return (const void*)(A + (size_t)R * 512 + kt * 64 + C); },
            [&](int R, int C, int kt) { return (const void*)(B + (size_t)R * 512 + kt * 64 + C); }, acc);
        const int row0 = mt * 128 + wr * 64, col0 = nt * 128 + wc * 64;
        char* base = smem + wid * 9216;
        float bg[4];
#pragma unroll
        for (int n = 0; n < 4; ++n) bg[n] = p.b_glu[col0 + n * 16 + fr];
#pragma unroll
        for (int i = 0; i < 8; ++i) {
            const int id = i * 64 + lane, row = id >> 3, ch = id & 7;
            *(uint4*)(base + row * 144 + ch * 16) = *(const uint4*)(WSP_Y + (size_t)(row0 + row) * 512 + col0 + ch * 8);
        }
        asm volatile("s_waitcnt lgkmcnt(0)" ::: "memory");
        __builtin_amdgcn_wave_barrier();
#pragma unroll
        for (int m = 0; m < 4; ++m)
#pragma unroll
            for (int j = 0; j < 4; ++j) {
                const int rl = m * 16 + fq * 4 + j, r = row0 + rl;
                float sq = 0.f;
#pragma unroll
                for (int n = 0; n < 4; ++n) {
                    const int c = col0 + n * 16 + fr;
                    const float yv = bf2f(*(const u16*)(base + rl * 144 + (n * 16 + fr) * 2));
                    const u16 ob = f2bf(yv * sigmoidf_(acc[m][n][j] + bg[n]));
                    *(u16*)(base + rl * 144 + (n * 16 + fr) * 2) = ob;
                    const float of = bf2f(ob);
                    sq += of * of;
                }
                sq = sum16(sq);
                if (fr == 0) unsafeAtomicAdd(WSP_rsq + (size_t)r * 2 + 1, sq);
            }
        asm volatile("s_waitcnt lgkmcnt(0)" ::: "memory");
        __builtin_amdgcn_wave_barrier();
        u16* dbase = WSP_SO + (size_t)row0 * 512 + col0;
#pragma unroll
        for (int i = 0; i < 8; ++i) {
            const int id = i * 64 + lane, row = id >> 3, ch = id & 7;
            *(uint4*)(dbase + (size_t)row * 512 + ch * 8) = *(const uint4*)(base + row * 144 + ch * 16);
        }
        asm volatile("s_waitcnt lgkmcnt(0)" ::: "memory");
        __builtin_amdgcn_wave_barrier();
    }
}

__device__ __forceinline__ void phase8(const Params& p) {
    const int NU = 512;
    for (int u = blockIdx.x; u < NU; u += gridDim.x) {
        const int mt = (u & 7) + 8 * (u >> 5), nt = (u >> 3) & 3;
        const u16* A1 = WSP_AO + (size_t)mt * 128 * 512;
        const u16* A2 = WSP_SO + (size_t)mt * 128 * 512;
        const u16* B = WSP_WoutT + (size_t)nt * 256 * 1024;
        f32x4 acc[4][8];
        {
        const int tid1 = TIDX, fq = (tid1 & 63) >> 4, row0 = mt * 128 + (tid1 >> 7) * 64;
        gemm_tile_w(32,
            [&](int i, int R, int C, int kt) { return (const void*)((kt < 16 ? A1 : A2) + (size_t)R * 512 + (kt & 15) * 32 + C); },
            [&](int i, int R, int C, int kt) { return (const void*)(B + (size_t)R * 1024 + kt * 32 + C); }, acc,
            [&](int kt) {
                if (kt == 16) {
#pragma unroll
                    for (int m = 0; m < 4; ++m) {
                        asm volatile("" ::: "memory");
#pragma unroll
                        for (int j = 0; j < 4; ++j) {
                            const float2 q = *(const float2*)(WSP_rsq + (size_t)(row0 + m * 16 + fq * 4 + j) * 2);
                            const float ratio = rsqrtf(q.x * (1.f / 512.f) + EPS) / rsqrtf(q.y * (1.f / 512.f) + EPS);
#pragma unroll
                            for (int n = 0; n < 8; ++n) acc[m][n][j] *= ratio;
                        }
                    }
                }
            });
        }
        const int tid2 = TIDX, lane = tid2 & 63, wid = tid2 >> 6, fr = lane & 15, fq = lane >> 4;
        const int row0 = mt * 128 + (wid >> 1) * 64, col0 = nt * 256 + (wid & 1) * 128;
        const float* g1 = WSP_mod + (mt >> 4) * 6144 + 2048 + col0;
        float* stg = (float*)(smem + wid * 8448);
#pragma unroll
        for (int m = 0; m < 4; ++m) {
#pragma unroll
            for (int n = 0; n < 8; ++n)
#pragma unroll
                for (int j = 0; j < 4; ++j) stg[(fq * 4 + j) * 132 + n * 16 + fr] = acc[m][n][j];
            asm volatile("s_waitcnt lgkmcnt(0)" ::: "memory");
            __builtin_amdgcn_wave_barrier();
#pragma unroll
            for (int i = 0; i < 8; ++i) {
                const int id = i * 64 + lane, rr = id >> 5, c4 = (id & 31) * 4;
                float4 v = *(const float4*)(stg + rr * 132 + c4);
                const float rsv = rsqrtf(WSP_rsq[(size_t)(row0 + m * 16 + rr) * 2 + 1] * (1.f / 512.f) + EPS);
                v.x *= rsv; v.y *= rsv; v.z *= rsv; v.w *= rsv;
                const float4 g = *(const float4*)(g1 + c4);
                const size_t o = (size_t)(row0 + m * 16 + rr) * 1024 + col0 + c4;
                const float4 xv = *(const float4*)(p.x + o);
                *(float4*)(p.out + o) = make_float4(xv.x + g.x * v.x, xv.y + g.y * v.y, xv.z + g.z * v.z, xv.w + g.w * v.w);
            }
            asm volatile("s_waitcnt lgkmcnt(0)" ::: "memory");
            __builtin_amdgcn_wave_barrier();
        }
    }
}

#define CTR_ECNT 0
#define CTR_Q11 128
#define CTR_Q12 136
#define HALF_TOK 8192
#define HH_HALF_ROWS 73728
#define ELIST_CAP 8192
template <int LEVEL>
__device__ __forceinline__ void phase9_t(const Params& p) {
    const int tid = TIDX, lane = tid & 63, wid = tid >> 6, fr = lane & 15, fq = lane >> 4;
    char* At = smem;
    float* sc = (float*)(smem + 65536);
    int* hist = (int*)(smem + 65536 + 8192);
    int* gbase = hist + 64;
    int* fill = gbase + 64;
    unsigned char* selk = (unsigned char*)(fill + 64);
    float* selw = (float*)(selk + 256);
    for (int chunk = blockIdx.x; chunk < NLAT / 32; chunk += gridDim.x) {
        const int tok0 = chunk * 32;
        __syncthreads();
        if (tid < 64) hist[tid] = 0;
#pragma unroll 1
        for (int hb = 0; hb < 2; ++hb) {
            float4 vall[4][4];
#pragma unroll
            for (int rr = 0; rr < 4; ++rr)
#pragma unroll
                for (int i = 0; i < 4; ++i) vall[rr][i] = *(const float4*)(p.out + (size_t)(tok0 + wid * 8 + hb * 4 + rr) * 1024 + i * 256 + lane * 4);
#pragma unroll
            for (int rr = 0; rr < 4; ++rr) {
                const int row = wid * 8 + hb * 4 + rr, tok = tok0 + row;
                const float* md = WSP_mod + (tok >> 11) * 6144;
                float ss = 0.f;
#pragma unroll
                for (int i = 0; i < 4; ++i) ss += vall[rr][i].x * vall[rr][i].x + vall[rr][i].y * vall[rr][i].y + vall[rr][i].z * vall[rr][i].z + vall[rr][i].w * vall[rr][i].w;
                ss = wave_sum(ss);
                const float rs = rsqrtf(ss * (1.f / 1024.f) + EPS);
#pragma unroll
                for (int i = 0; i < 4; ++i) {
                    const int c0 = i * 256 + lane * 4;
                    const float4 v = vall[rr][i];
                    const float4 g = *(const float4*)(p.norm_ffn + c0), s = *(const float4*)(md + 3072 + c0), k = *(const float4*)(md + 4096 + c0);
                    const float a = v.x * rs * g.x * (1.f + k.x) + s.x, b = v.y * rs * g.y * (1.f + k.y) + s.y;
                    const float c = v.z * rs * g.z * (1.f + k.z) + s.z, d = v.w * rs * g.w * (1.f + k.w) + s.w;
                    const uint2 pk = make_uint2(pack2(a, b), pack2(c, d));
                    *(uint2*)(WSP_H2 + (size_t)tok * 1024 + c0) = pk;
                    const int ch = c0 >> 3;
                    *(uint2*)(At + row * 2048 + ((ch ^ (row & 15)) << 4) + ((c0 & 4) << 1)) = pk;
                }
            }
        }
        __syncthreads();
        if (LEVEL == 1) continue;
        {
            f32x4 acc0 = {0.f, 0.f, 0.f, 0.f}, acc1 = {0.f, 0.f, 0.f, 0.f};
            const u16* bp = WSP_WrT + (size_t)(wid * 16 + fr) * 1024 + fq * 8;
#pragma unroll
            for (int kb = 0; kb < 4; ++kb) {
                bf16x8 bfr[8];
#pragma unroll
                for (int q = 0; q < 8; ++q) bfr[q] = *(const bf16x8*)(bp + (kb * 8 + q) * 32);
#pragma unroll
                for (int q = 0; q < 8; ++q) {
                    const int ch = (kb * 8 + q) * 4 + fq;
                    const bf16x8 a0 = *(const bf16x8*)(At + fr * 2048 + ((ch ^ fr) << 4));
                    const bf16x8 a1 = *(const bf16x8*)(At + (16 + fr) * 2048 + ((ch ^ fr) << 4));
                    acc0 = __builtin_amdgcn_mfma_f32_16x16x32_bf16(a0, bfr[q], acc0, 0, 0, 0);
                    acc1 = __builtin_amdgcn_mfma_f32_16x16x32_bf16(a1, bfr[q], acc1, 0, 0, 0);
                }
            }
#pragma unroll
            for (int j = 0; j < 4; ++j) {
                sc[(fq * 4 + j) * 64 + wid * 16 + fr] = sigmoidf_(acc0[j]);
                sc[(16 + fq * 4 + j) * 64 + wid * 16 + fr] = sigmoidf_(acc1[j]);
            }
        }
        __syncthreads();
        if (LEVEL == 2) continue;
        const float bias = p.router_bias[lane];
        const int eg = lane >> 3;
#pragma unroll 2
        for (int rr = 0; rr < 8; ++rr) {
            const int row = wid * 8 + rr;
            const float s = sc[row * 64 + lane];
            const float bz = s + bias;
            const float m1 = max8(bz);
            const unsigned long long eq = __ballot(bz == m1);
            const unsigned gb = (unsigned)((eq >> (eg * 8)) & 0xffull);
            const int first = __ffs(gb) - 1;
            const float v2 = max8(((lane & 7) == first) ? -1e30f : bz);
            const float gs = m1 + v2;
            int cnt = 0;
#pragma unroll
            for (int j = 0; j < 8; ++j) {
                const float gj = __int_as_float(__builtin_amdgcn_readlane(__float_as_int(gs), j * 8));
                cnt += (gj > gs || (gj == gs && j < eg)) ? 1 : 0;
            }
            const bool gsel = cnt < 4;
            const float mv = gsel ? bz : -1e30f;
            unsigned long long gm = __ballot(gsel);
            int rank = 0;
#pragma unroll 1
            for (int it = 0; it < 4; ++it) {
                const int jb = __builtin_amdgcn_readfirstlane(__ffsll((long long)gm) - 1);
                gm &= ~(0xffull << jb);
#pragma unroll
                for (int j = 0; j < 8; ++j) {
                    const float vj = __int_as_float(__builtin_amdgcn_readlane(__float_as_int(mv), jb + j));
                    rank += (vj > mv || (vj == mv && (jb + j) < lane)) ? 1 : 0;
                }
            }
            const bool sel = gsel && rank < 8;
            unsigned long long sm = __ballot(sel);
            float tot = 0.f;
#pragma unroll 1
            for (int it = 0; it < 8; ++it) {
                const int l = __builtin_amdgcn_readfirstlane(__ffsll((long long)sm) - 1);
                sm &= sm - 1;
                tot += __int_as_float(__builtin_amdgcn_readlane(__float_as_int(s), l));
            }
            if (sel) {
                selw[row * 8 + rank] = s / tot * 2.5f;
                selk[row * 8 + rank] = (unsigned char)lane;
                atomicAdd(&hist[lane], 1);
            }
        }
        __syncthreads();
        const int h = tok0 >> 13;
        if (tid < 64) {
            gbase[tid] = hist[tid] ? (int)atomicAdd(&WSP_ctr[CTR_ECNT + h * 64 + tid], (unsigned)hist[tid]) : 0;
            fill[tid] = 0;
        }
        __syncthreads();
        {
            const int e = selk[tid];
            const int pos = atomicAdd(&fill[e], 1);
            WSP_elist[(size_t)(h * 64 + e) * ELIST_CAP + gbase[e] + pos] = (tok0 + (tid >> 3)) * 8 + (tid & 7);
            WSP_wsl[(size_t)(h * 64 + e) * ELIST_CAP + gbase[e] + pos] = selw[tid];
        }
    }
}

struct MoeTab { int cnt[16]; int soff[16]; int pre[17]; };

template <class FV, class FD>
__device__ __forceinline__ void wave_store_fp8_f(FV val, FD dst) {
    const int lane = TIDX & 63, wid = TIDX >> 6, fr = lane & 15, fq = lane >> 4;
    char* base = smem + wid * 9216;
#pragma unroll
    for (int m = 0; m < 4; ++m)
#pragma unroll
        for (int n = 0; n < 8; ++n)
#pragma unroll
            for (int j = 0; j < 4; ++j)
                *(unsigned char*)(base + (m * 16 + fq * 4 + j) * 144 + n * 16 + fr) =
                    (unsigned char)(__builtin_amdgcn_cvt_pk_fp8_f32(val(m, n, j), 0.f, 0, false) & 0xff);
    asm volatile("s_waitcnt lgkmcnt(0)" ::: "memory");
    __builtin_amdgcn_wave_barrier();
#pragma unroll
    for (int i = 0; i < 8; ++i) {
        const int id = i * 64 + lane, row = id >> 3, ch = id & 7;
        const uint4 d = *(const uint4*)(base + row * 144 + ch * 16);
        unsigned char* q = dst(i, row);
        if (q) { const u32x4 t = {d.x, d.y, d.z, d.w}; __builtin_nontemporal_store(t, (u32x4*)(q + ch * 16)); }
    }
    asm volatile("s_waitcnt lgkmcnt(0)" ::: "memory");
    __builtin_amdgcn_wave_barrier();
}

#define YD_SCALE 8.0f
template <int MODE>
__device__ __forceinline__ void phase11f(const Params& p) {
    const int tid = TIDX;
    int* tab = (int*)(smem + 73728);
    int* t_cnt = tab, *t_soff = tab + 16, *t_pre = tab + 32, *t_q = tab + 52;
    int* t_all = tab + 64;
    const int x = blockIdx.x & 7;
    unsigned* flags = WSP_flag + x * FLAG_PER_CLASS;
    unsigned* tmo = WSP_flag + 8 * FLAG_PER_CLASS;
    unsigned char* Yd8 = (unsigned char*)(p.ws + OFF_ARENA);
    __syncthreads();
    if (tid < 128) t_all[tid] = (int)WSP_ctr[CTR_ECNT + tid];
    unsigned* qhead = &WSP_ctr[(MODE == 2 ? CTR_Q12 : CTR_Q11) + x];
    if (tid == 0) t_q[0] = (int)atomicAdd(qhead, 1u);
    __syncthreads();
    if (tid < 16) {
        const int i = tid >> 1, h = tid & 1, e = x + 8 * i;
        t_cnt[tid] = t_all[h * 64 + e];
        int so = 0;
        for (int e2 = 0; e2 < e; ++e2) so += t_all[h * 64 + e2];
        t_soff[tid] = so;
    }
    __syncthreads();
    if (tid == 0) {
        int s = 0;
        for (int j = 0; j < 16; ++j) { t_pre[j] = s; s += (t_cnt[j] + 127) >> 7; }
        t_pre[16] = s;
    }
    __syncthreads();
    const int T_r = t_pre[16], T11 = T_r + 16, T_all = (MODE == 1) ? T11 : T11 + T_r * 4;
    for (;;) {
        __syncthreads();
        const int q = __builtin_amdgcn_readfirstlane(t_q[0]) + (MODE == 2 ? T11 : 0);
        __syncthreads();
        if (q >= T_all) break;
        if (tid == 0) t_q[0] = (int)atomicAdd(qhead, 1u);
        const bool is_down = q >= T11;
        const int u = is_down ? (q - T11) >> 2 : q;
        int nt = is_down ? (q - T11) & 3 : 0;
        int e, h, mt, c, rowbase;
        if (u < T_r) {
            int j = 0;
#pragma unroll
            for (int qq = 1; qq < 16; ++qq) j += (u >= t_pre[qq]) ? 1 : 0;
            e = x + 8 * (j >> 1); h = j & 1; mt = u - t_pre[j]; c = t_cnt[j];
            rowbase = h * HH_HALF_ROWS + t_soff[j];
        } else {
            const int ms = x * 16 + (u - T_r);
            e = 64; h = ms >> 6; mt = ms & 63; c = HALF_TOK;
            rowbase = h * HH_HALF_ROWS + 65536;
        }
        e = __builtin_amdgcn_readfirstlane(e); h = __builtin_amdgcn_readfirstlane(h); mt = __builtin_amdgcn_readfirstlane(mt);
        nt = __builtin_amdgcn_readfirstlane(nt); c = __builtin_amdgcn_readfirstlane(c); rowbase = __builtin_amdgcn_readfirstlane(rowbase);
        const int* el = WSP_elist + (size_t)(h * 64 + (e & 63)) * ELIST_CAP;
        if (!is_down) {
            const int t2 = TIDX, lane = t2 & 63, wid = t2 >> 6, wr = wid >> 1, wc = wid & 1, fr = lane & 15, fq = lane >> 4;
            const int sb = lane * 16, swz = sb ^ (((sb >> 9) & 1) << 5);
            const int r_in = swz >> 6, c_in = (swz & 63) >> 1;
            const int vrows = c - mt * 128 - wr * 64;
            const float* wsl = WSP_wsl + (size_t)(h * 64 + (e & 63)) * ELIST_CAP;
            const u16* aptr[2];
#pragma unroll
            for (int i = 0; i < 2; ++i) {
                int li = mt * 128 + (wid + 4 * i) * 16 + r_in;
                li = li < c ? li : c - 1;
                const int tok = (e < 64) ? (el[li] >> 3) : (h * HALF_TOK + li);
                aptr[i] = WSP_H2 + (size_t)tok * 1024 + c_in;
            }
            const u16* Bw = WSP_WguT + (size_t)e * 262144 + c_in;
            f32x4 acc[4][8];
            gemm_tile_w(32,
                [&](int i, int R, int C, int kt) { return (const void*)(aptr[i] + kt * 32); },
                [&](int i, int R, int C, int kt) { return (const void*)(Bw + (size_t)R * 1024 + kt * 32); }, acc);
            float wgt[4][4];
#pragma unroll
            for (int m = 0; m < 4; ++m)
#pragma unroll
                for (int j = 0; j < 4; ++j) {
                    const int li = mt * 128 + wr * 64 + m * 16 + fq * 4 + j;
                    float w = 1.f;
                    if (e < 64) w = (li < c) ? wsl[li] : 0.f;
                    wgt[m][j] = w;
                }
            u16* dbase = WSP_HHs + ((size_t)rowbase + mt * 128 + wr * 64) * 128 + wc * 64;
            wave_store_bf16_f([&](int m, int n2, int j) { return siluf_(acc[m][2 * n2][j]) * acc[m][2 * n2 + 1][j] * wgt[m][j]; },
                              [&](int row) { return row < vrows ? dbase + (size_t)row * 128 : (u16*)nullptr; }, true, (const char*)WSP_HHs, (unsigned)((size_t)2 * HH_HALF_ROWS * 128 * 2));
            asm volatile("s_waitcnt vmcnt(0)" ::: "memory");
            __syncthreads();
            if (tid == 0) __hip_atomic_store(&flags[u], 1u, __ATOMIC_RELAXED, __HIP_MEMORY_SCOPE_AGENT);
        } else {
            const int t2 = TIDX, lane = t2 & 63, wid = t2 >> 6, wr = wid >> 1, wc = wid & 1, fr = lane & 15, fq = lane >> 4;
            const int sb = lane * 16, swz = sb ^ (((sb >> 9) & 1) << 5);
            const int r_in = swz >> 6, c_in = (swz & 63) >> 1;
            const int vrows = c - mt * 128 - wr * 64;
            if (MODE == 0 && tid == 0) {
                unsigned sp = 0;
                while (__hip_atomic_load(&flags[u], __ATOMIC_RELAXED, __HIP_MEMORY_SCOPE_AGENT) == 0u) {
                    __builtin_amdgcn_s_sleep(2);
                    if ((++sp & 255u) == 0u) {
                        if (__hip_atomic_load(tmo, __ATOMIC_RELAXED, __HIP_MEMORY_SCOPE_AGENT)) break;
                        if (sp > (1u << 20)) { atomicAdd(tmo, 1u); break; }
                    }
                }
            }
            __syncthreads();
            const u16* aptr[2];
#pragma unroll
            for (int i = 0; i < 2; ++i) {
                int li = mt * 128 + (wid + 4 * i) * 16 + r_in;
                li = li < c ? li : c - 1;
                aptr[i] = WSP_HHs + ((size_t)rowbase + li) * 128 + c_in;
            }
            const u16* Bw = WSP_WdT + ((size_t)e * 1024 + nt * 256) * 128 + c_in;
            int slot[8];
            if (e < 64) {
#pragma unroll
                for (int i = 0; i < 8; ++i) {
                    int li = mt * 128 + wr * 64 + ((i * 64 + lane) >> 3);
                    li = li < c ? li : c - 1;
                    slot[i] = el[li];
                }
            } else {
#pragma unroll
                for (int i = 0; i < 8; ++i) slot[i] = (h * HALF_TOK + mt * 128 + wr * 64 + ((i * 64 + lane) >> 3)) * 8;
            }
            f32x4 acc[4][8];
            gemm_tile_w<true>(4,
                [&](int i, int R, int C, int kt) { return (const void*)(aptr[i] + kt * 32); },
                [&](int i, int R, int C, int kt) { return (const void*)(Bw + (size_t)R * 128 + kt * 32); }, acc);
            const int colo = nt * 256 + wc * 128;
            if (e < 64) {
                wave_store_fp8_f([&](int m, int n, int j) { return acc[m][n][j] * YD_SCALE; }, [&](int i, int row) {
                    if (row >= vrows) return (unsigned char*)nullptr;
                    const int s = slot[i];
                    return Yd8 + ((size_t)(s >> 3) * 8 + (s & 7)) * 1024 + colo;
                });
            } else {
                const int tok0 = h * HALF_TOK + mt * 128 + wr * 64;
                const float* g2 = WSP_mod + (tok0 >> 11) * 6144 + 5120 + colo;
                float* stg = (float*)(smem + wid * 8448);
#pragma unroll
                for (int m = 0; m < 4; ++m) {
#pragma unroll
                    for (int n = 0; n < 8; ++n)
#pragma unroll
                        for (int j = 0; j < 4; ++j) stg[(fq * 4 + j) * 132 + n * 16 + fr] = acc[m][n][j];
                    asm volatile("s_waitcnt lgkmcnt(0)" ::: "memory");
                    __builtin_amdgcn_wave_barrier();
#pragma unroll
                    for (int i = 0; i < 8; ++i) {
                        const int id = i * 64 + lane, rr = id >> 5, c4 = (id & 31) * 4;
                        const float4 v = *(const float4*)(stg + rr * 132 + c4);
                        const float4 g = *(const float4*)(g2 + c4);
                        float* op = p.out + (size_t)(tok0 + m * 16 + rr) * 1024 + colo + c4;
                        const float4 xv = *(const float4*)op;
                        *(float4*)op = make_float4(xv.x + g.x * v.x, xv.y + g.y * v.y, xv.z + g.z * v.z, xv.w + g.w * v.w);
                    }
                    asm volatile("s_waitcnt lgkmcnt(0)" ::: "memory");
                    __builtin_amdgcn_wave_barrier();
                }
            }
        }
    }
}

#define P12_SLD 2064
template <bool DUMMY>
__device__ __forceinline__ void phase12b_t(const Params& p) {
    const int tid = TIDX, lane = tid & 63, wid = tid >> 6, fr = lane & 15, fq = lane >> 4;
    const unsigned char* Yd8 = (const unsigned char*)(p.ws + OFF_ARENA);
    const u16* Wb = WSP_WdT + (size_t)64 * 131072 + (size_t)(wid * 256 + fr) * 128 + fq * 8;
    for (int tile = blockIdx.x; tile < NLAT / 32; tile += gridDim.x) {
        const int tok0 = tile * 32;
        const int hh = tok0 >> 13;
        const u16* Ab = WSP_HHs + ((size_t)hh * HH_HALF_ROWS + 65536 + (tok0 & 8191) + fr) * 128 + fq * 8;
        __syncthreads();
        bf16x8 af[2][4];
#pragma unroll
        for (int m = 0; m < 2; ++m)
#pragma unroll
            for (int ks = 0; ks < 4; ++ks) af[m][ks] = *(const bf16x8*)(Ab + (size_t)m * 16 * 128 + ks * 32);
#pragma unroll 1
        for (int nb = 0; nb < 4; ++nb) {
            bf16x8 bfr[4][4];
#pragma unroll
            for (int n = 0; n < 4; ++n)
#pragma unroll
                for (int ks = 0; ks < 4; ++ks) bfr[n][ks] = *(const bf16x8*)(Wb + (size_t)((nb * 4 + n) * 16) * 128 + ks * 32);
#pragma unroll
            for (int m = 0; m < 2; ++m)
#pragma unroll
                for (int n = 0; n < 4; ++n) {
                    f32x4 d = {0.f, 0.f, 0.f, 0.f};
#pragma unroll
                    for (int ks = 0; ks < 4; ++ks) d = __builtin_amdgcn_mfma_f32_16x16x32_bf16(af[m][ks], bfr[n][ks], d, 0, 0, 0);
                    const int col = wid * 256 + (nb * 4 + n) * 16 + fr;
#pragma unroll
                    for (int j = 0; j < 4; ++j) *(u16*)(smem + (m * 16 + fq * 4 + j) * P12_SLD + col * 2) = f2bf(d[j]);
                }
        }
        __syncthreads();
        for (int rr = 0; rr < 8; ++rr) {
            const int row = wid * 8 + rr, tok = tok0 + row;
            float* xrow = p.out + (size_t)tok * 1024 + lane * 16;
            float* orow = DUMMY ? (float*)(p.ws + OFF_HHS) + (size_t)(tok & 8191) * 1024 + lane * 16 : xrow;
            const float* g2 = WSP_mod + (tok >> 11) * 6144 + 5120 + lane * 16;
            float s[16];
#pragma unroll
            for (int i = 0; i < 16; ++i) s[i] = 0.f;
            const unsigned char* yp = Yd8 + (size_t)tok * 8 * 1024 + lane * 16;
            uint4 yv[8];
#pragma unroll
            for (int k = 0; k < 8; ++k) { const u32x4 t = __builtin_nontemporal_load((const u32x4*)(yp + k * 1024)); yv[k] = make_uint4(t[0], t[1], t[2], t[3]); }
#pragma unroll
            for (int k = 0; k < 8; ++k) {
                const unsigned w[4] = {yv[k].x, yv[k].y, yv[k].z, yv[k].w};
#pragma unroll
                for (int i = 0; i < 4; ++i) {
                    const auto lo = __builtin_amdgcn_cvt_pk_f32_fp8((int)w[i], false);
                    const auto hi = __builtin_amdgcn_cvt_pk_f32_fp8((int)w[i], true);
                    s[4 * i] += lo[0]; s[4 * i + 1] += lo[1]; s[4 * i + 2] += hi[0]; s[4 * i + 3] += hi[1];
                }
            }
            const uint4 sa = *(const uint4*)(smem + row * P12_SLD + lane * 32), sbv = *(const uint4*)(smem + row * P12_SLD + lane * 32 + 16);
            const unsigned sw[8] = {sa.x, sa.y, sa.z, sa.w, sbv.x, sbv.y, sbv.z, sbv.w};
#pragma unroll
            for (int i = 0; i < 8; ++i) {
                s[2 * i] = s[2 * i] * (1.f / YD_SCALE) + bf2f((u16)(sw[i] & 0xffffu));
                s[2 * i + 1] = s[2 * i + 1] * (1.f / YD_SCALE) + bf2f((u16)(sw[i] >> 16));
            }
            float ss = 0.f;
#pragma unroll
            for (int q = 0; q < 4; ++q) {
                const float4 xv = *(const float4*)(xrow + q * 4), gv = *(const float4*)(g2 + q * 4);
                s[4 * q] = xv.x + gv.x * s[4 * q]; s[4 * q + 1] = xv.y + gv.y * s[4 * q + 1];
                s[4 * q + 2] = xv.z + gv.z * s[4 * q + 2]; s[4 * q + 3] = xv.w + gv.w * s[4 * q + 3];
                ss += s[4 * q] * s[4 * q] + s[4 * q + 1] * s[4 * q + 1] + s[4 * q + 2] * s[4 * q + 2] + s[4 * q + 3] * s[4 * q + 3];
            }
            ss = wave_sum(ss);
            const float rs = rsqrtf(ss * (1.f / 1024.f) + EPS);
#pragma unroll
            for (int q = 0; q < 4; ++q) {
                const float4 g = *(const float4*)(p.norm_final + lane * 16 + q * 4);
                *(float4*)(orow + q * 4) = make_float4(s[4 * q] * rs * g.x, s[4 * q + 1] * rs * g.y, s[4 * q + 2] * rs * g.z, s[4 * q + 3] * rs * g.w);
            }
        }
    }
}

#define SMEM_TOTAL (73728 + 3072 + 64)

#if 1
__global__ void __launch_bounds__(NTHR, 2) k_mega(Params p) {
    volatile LAS unsigned* st = (volatile LAS unsigned*)(smem + SMEM_TOTAL - 16);
    if (TIDX == 0) { st[0] = 0u; st[1] = 0u; st[2] = 0u; st[3] = 0u; }
    __syncthreads();
    XcdBarrier bar = xcd_barrier_post(WSP_bar, st);
#define RUNP(N) do { phase##N(p); if (PROBE_DUP == N) phase##N(p); } while (0)
    RUNP(0);  xcd_barrier(bar);
    RUNP(1);  xcd_barrier(bar);
    RUNP(2);  xcd_barrier(bar);
    RUNP(3);  xcd_barrier(bar);
    RUNP(4);  xcd_barrier(bar);
    RUNP(5);  xcd_barrier(bar);
    RUNP(6);  xcd_barrier(bar);
    RUNP(8);  xcd_barrier(bar);
#if PROBE_DUP == 91
    phase9_t<1>(p); xcd_barrier(bar);
#endif
#if PROBE_DUP == 92
    phase9_t<2>(p); xcd_barrier(bar);
#endif
    phase9_t<0>(p); xcd_barrier(bar);
#if PROBE_DUP == 9
    if (blockIdx.x == 0 && TIDX < 128) WSP_ctr[CTR_ECNT + TIDX] = 0u;
    xcd_barrier(bar); phase9_t<0>(p); xcd_barrier(bar);
#endif
#ifndef MOE_FUSED
#define MOE_FUSED 1
#endif
#if MOE_FUSED
    phase11f<0>(p); xcd_barrier(bar);
#else
    phase11f<1>(p); xcd_barrier(bar);
    phase11f<2>(p); xcd_barrier(bar);
#endif
#if PROBE_DUP == 11
    if (blockIdx.x == 0 && TIDX < 8) WSP_ctr[CTR_Q11 + TIDX] = 0u;
    if (blockIdx.x == 1) for (int i = TIDX; i < 8 * FLAG_PER_CLASS; i += NTHR) WSP_flag[i] = 0u;
    xcd_barrier(bar); phase11f<0>(p); xcd_barrier(bar);
#endif
#if PROBE_DUP == 121
    phase12b_t<true>(p); xcd_barrier(bar);
#endif
    phase12b_t<false>(p);
}
#endif


extern "C" void kernel_launch(void* const* d_in, const int* in_sizes, int n_in,
                              void* d_out, int out_size, void* d_ws, size_t ws_size,
                              hipStream_t stream) {
    Params p{};
    const float** ip = (const float**)&p.x;
    for (int i = 0; i < 32; ++i) ip[i] = (const float*)d_in[i];
    p.out = (float*)d_out;
    p.ws = (char*)d_ws;
    if (OFF_END > ws_size) { fprintf(stderr, "workspace too small: need %zu have %zu\n", (size_t)OFF_END, ws_size); return; }

    static int grid = 0;
    if (!grid) {
        hipFuncSetAttribute((const void*)k_mega, hipFuncAttributeMaxDynamicSharedMemorySize, SMEM_TOTAL);
        int dev = 0, cus = 0, per_cu = 0;
        hipGetDevice(&dev);
        hipDeviceGetAttribute(&cus, hipDeviceAttributeMultiprocessorCount, dev);
        hipOccupancyMaxActiveBlocksPerMultiprocessor(&per_cu, (const void*)k_mega, NTHR, SMEM_TOTAL);
        if (per_cu < 1) per_cu = 1;
        grid = cus * (per_cu < 2 ? per_cu : 2);
    }
    hipMemsetAsync(p.ws + OFF_BAR, 0, ZERO_BYTES, stream);
    k_mega<<<grid, NTHR, SMEM_TOTAL, stream>>>(p);
}
```

```cpp
#include <hip/hip_runtime.h>
#include <hip/hip_bf16.h>
#include <stdint.h>
#include <stdio.h>

#ifndef MK_MULTI
#define MK_MULTI 0
#endif

typedef __attribute__((ext_vector_type(8))) short bf16x8;
typedef __attribute__((ext_vector_type(4))) short bf16x4;
typedef __attribute__((ext_vector_type(4))) float f32x4;
typedef unsigned short u16;
typedef __attribute__((ext_vector_type(4))) unsigned u32x4;

#ifndef PROBE_DUP
#define PROBE_DUP -1
#endif
#define NTHR 256
__device__ __forceinline__ int opaque_tid() { int t = (int)threadIdx.x; asm volatile("" : "+v"(t)); return t; }
#define TIDX opaque_tid()
#define LDS_BYTES 65536

#define D_MODEL 1024
#define BATCH 8
#define SEQ 2048
#define CTXL 256
#define NLAT (BATCH * SEQ)
#define NCTX (BATCH * CTXL)
#define NROWS (NLAT + NCTX)
#define INW 1280
#define NEXP 64
#define VT_LD (SEQ + CTXL)
#define NCHUNK_LAT 1024
#define NCHUNK_ALL 1152
#define EPS 1e-6f

#define XB_TMO      128
#define XB_XCNT(j)  (256  + 64 * (j))
#define XB_XSUB(j)  (1280 + 64 * (j))
#define XB_XGEN(j)  (2304 + 64 * (j))
#define XB_TOP      3328
#define XB_TOPGEN   3392
#define XCD_BAR_WORDS 3456
#define XB_SPIN_CAP (1u << 20)
#define LAS __attribute__((address_space(3)))

__device__ __forceinline__ unsigned xb_ld(unsigned* p)              { return __hip_atomic_load(p, __ATOMIC_RELAXED, __HIP_MEMORY_SCOPE_AGENT); }
__device__ __forceinline__ unsigned xb_add(unsigned* p, unsigned v) { return __hip_atomic_fetch_add(p, v, __ATOMIC_RELAXED, __HIP_MEMORY_SCOPE_AGENT); }
__device__ __forceinline__ unsigned xb_xcc_id() { return (unsigned)__builtin_amdgcn_s_getreg((3 << 11) | 20) & 0xFu; }
#define XB_SPIN(cond, bar) do { unsigned _sp = 0; while (cond) { __builtin_amdgcn_s_sleep(1); \
    if ((++_sp & 255u) == 0u) { if (xb_ld(&(bar)[XB_TMO])) break; if (_sp > XB_SPIN_CAP) { atomicAdd(&(bar)[XB_TMO], 1u); break; } } } } while (0)

struct XcdBarrier { unsigned* bar; unsigned x; volatile LAS unsigned* st; };

__device__ __forceinline__ XcdBarrier xcd_barrier_post(unsigned* bar, volatile LAS unsigned* st) {
    XcdBarrier b; b.bar = bar; b.x = xb_xcc_id(); b.st = st;
    if (TIDX == 0) (void)xb_add(&bar[XB_XCNT(b.x)], 1u);
    return b;
}
__device__ __forceinline__ void xcd_barrier_complete(unsigned* bar, unsigned x, unsigned& nloc, unsigned& nx) {
    const unsigned G = gridDim.x * gridDim.y * gridDim.z;
    unsigned sum, cnt, mine, sp = 0u;
    for (;;) {
        sum = 0u; cnt = 0u; mine = 0u;
#pragma unroll
        for (unsigned j = 0; j < 16; ++j) { const unsigned c = xb_ld(&bar[XB_XCNT(j)]); sum += c; cnt += (c > 0u) ? 1u : 0u; mine = (j == x) ? c : mine; }
        if (sum == G) break;
        __builtin_amdgcn_s_sleep(1);
        if ((++sp & 255u) == 0u) { if (xb_ld(&bar[XB_TMO])) break; if (sp > XB_SPIN_CAP) { atomicAdd(&bar[XB_TMO], 1u); break; } }
    }
    nloc = mine > 0u ? mine : 1u; nx = cnt > 0u ? cnt : 1u;
}
__device__ __forceinline__ void xcd_barrier(const XcdBarrier& b) {
    asm volatile("s_waitcnt vmcnt(0)" ::: "memory");
    __syncthreads();
    if (TIDX == 0) {
        unsigned* bar = b.bar;
        __builtin_amdgcn_s_waitcnt(0);
        unsigned nloc = b.st[0], nx = b.st[1];
        if (nloc == 0u) { xcd_barrier_complete(bar, b.x, nloc, nx); b.st[0] = nloc; b.st[1] = nx; }
        const unsigned old = xb_add(&bar[XB_XSUB(b.x)], 1u);
        const unsigned gen = old / nloc;
        if (old + 1u == (gen + 1u) * nloc) {
            __builtin_amdgcn_fence(__ATOMIC_RELEASE, "agent");
            asm volatile("s_waitcnt vmcnt(0)" ::: "memory");
            const unsigned og = xb_add(&bar[XB_TOP], 1u);
            const unsigned tg = og / nx;
            if (og + 1u == (tg + 1u) * nx) xb_add(&bar[XB_TOPGEN], 1u);
            else XB_SPIN(xb_ld(&bar[XB_TOPGEN]) == tg, bar);
            __builtin_amdgcn_fence(__ATOMIC_ACQUIRE, "agent");
            xb_add(&bar[XB_XGEN(b.x)], 1u);
            asm volatile("s_waitcnt vmcnt(0)" ::: "memory");
        } else {
            XB_SPIN(xb_ld(&bar[XB_XGEN(b.x)]) == gen, bar);
            __builtin_amdgcn_fence(__ATOMIC_ACQUIRE, "agent");
            asm volatile("s_waitcnt vmcnt(0)" ::: "memory");
        }
    }
    __syncthreads();
}

struct Params {
    const float *x, *c, *ctx, *c_ctx, *w_ada, *b_ada, *norm_mix, *norm_ffn, *w_in, *attn_sink,
        *a_re, *a_im, *log_dt, *b_re, *b_im, *c_re, *c_im, *ssm_d, *w_glu, *b_glu, *norm_attn_out, *norm_ssm_out,
        *w_out, *w_router, *router_bias, *w_gate_e, *w_up_e, *w_down_e, *w_gate_s, *w_up_s, *w_down_s, *norm_final;
    float* out;
    char* ws;
};

constexpr size_t A256(size_t v) { return (v + 255) & ~(size_t)255; }
constexpr size_t OFF_BAR   = 0;
constexpr size_t OFF_RSQ   = A256(OFF_BAR + XCD_BAR_WORDS * 4 + 1024);
#define FLAG_PER_CLASS 1280
constexpr size_t OFF_FLAG  = OFF_RSQ + (size_t)NLAT * 2 * 4;
constexpr size_t ZERO_BYTES = OFF_FLAG + (8 * FLAG_PER_CLASS + 64) * 4;
constexpr size_t OFF_MOD   = A256(ZERO_BYTES);
constexpr size_t OFF_ROPE  = A256(OFF_MOD + 9 * 6144 * 4);
constexpr size_t OFF_KBUF  = A256(OFF_ROPE + 64 * 16 * 8);
constexpr size_t OFF_ELIST = A256(OFF_KBUF + (size_t)32 * 2 * 4096 * 4);
constexpr size_t OFF_WSL   = A256(OFF_ELIST + (size_t)2 * 64 * 8192 * 4);
constexpr size_t OFF_WDT   = A256(OFF_WSL + (size_t)2 * 64 * 8192 * 4);
constexpr size_t OFF_HHS   = A256(OFF_WDT + (size_t)65 * 1024 * 128 * 2);
constexpr size_t OFF_WGUT  = A256(OFF_HHS + (size_t)2 * 73728 * 128 * 2);
constexpr size_t OFF_H2R   = A256(OFF_WGUT + (size_t)65 * 256 * 1024 * 2);
constexpr size_t OFF_ARENA = A256(OFF_H2R + (size_t)NLAT * 1024 * 2);
constexpr size_t OFF_TABS  = OFF_ARENA;
constexpr size_t OFF_TABY  = A256(OFF_TABS + (size_t)32 * 256 * 256 * 2);
constexpr size_t OFF_R1    = A256(OFF_TABY + (size_t)32 * 256 * 512 * 2);
constexpr size_t OFF_R2    = A256(OFF_R1 + (size_t)NROWS * 1024 * 2);
constexpr size_t OFF_R4    = A256(OFF_R2 + (size_t)NLAT * 1024 * 2);
constexpr size_t OFF_WINT  = A256(OFF_R4 + (size_t)NLAT * 512 * 2 * 2);
constexpr size_t OFF_WGLUT = A256(OFF_WINT + (size_t)1280 * 1024 * 2);
constexpr size_t OFF_WOUTT = A256(OFF_WGLUT + (size_t)512 * 512 * 2);
constexpr size_t OFF_WRT   = A256(OFF_WOUTT + (size_t)1024 * 1024 * 2);
constexpr size_t OFF_EARLY_END = A256(OFF_WRT + (size_t)128 * 1024 * 2);
constexpr size_t YD8_BYTES = (size_t)NLAT * 8 * 1024;
constexpr size_t OFF_END   = (OFF_EARLY_END > OFF_ARENA + YD8_BYTES) ? OFF_EARLY_END : A256(OFF_ARENA + YD8_BYTES);
static_assert(OFF_END <= (size_t)256 * 1024 * 1024, "workspace map must fit the guaranteed 256 MiB");
#define CTR_QS1 160
#define WSP_bar   ((unsigned*)(p.ws + OFF_BAR))
#define WSP_ctr   ((unsigned*)(p.ws + OFF_BAR) + XCD_BAR_WORDS)
#define WSP_rsq   ((float*)(p.ws + OFF_RSQ))
#define WSP_flag  ((unsigned*)(p.ws + OFF_FLAG))
#define WSP_mod   ((float*)(p.ws + OFF_MOD))
#define WSP_rope  ((float2*)(p.ws + OFF_ROPE))
#define WSP_Kbuf  ((float*)(p.ws + OFF_KBUF))
#define WSP_elist ((int*)(p.ws + OFF_ELIST))
#define WSP_wsl   ((float*)(p.ws + OFF_WSL))
#define WSP_WinT  ((u16*)(p.ws + OFF_WINT))
#define WSP_WgluT ((u16*)(p.ws + OFF_WGLUT))
#define WSP_WoutT ((u16*)(p.ws + OFF_WOUTT))
#define WSP_WrT   ((u16*)(p.ws + OFF_WRT))
#define WSP_WdT   ((u16*)(p.ws + OFF_WDT))
#define WSP_HHs   ((u16*)(p.ws + OFF_HHS))
#define WSP_WguT  ((u16*)(p.ws + OFF_WGUT))
#define WSP_TabS  ((u16*)(p.ws + OFF_TABS))
#define WSP_TabY  ((u16*)(p.ws + OFF_TABY))
#define WSP_Hb    ((u16*)(p.ws + OFF_R1))
#define WSP_S     ((float*)(p.ws + OFF_R1))
#define WSP_H2    ((u16*)(p.ws + OFF_H2R))
#define WSP_Q     ((u16*)(p.ws + OFF_R2))
#define WSP_Kb    ((u16*)(p.ws + OFF_R2 + (size_t)NLAT * 512 * 2))
#define WSP_Vt    ((u16*)(p.ws + OFF_R2 + (size_t)NLAT * 512 * 2 + (size_t)NROWS * 128 * 2))
#define WSP_Y     ((u16*)(p.ws + OFF_R2))
#define WSP_SO    ((u16*)(p.ws + OFF_R2 + (size_t)NLAT * 512 * 2))
#define WSP_U     ((u16*)(p.ws + OFF_H2R))
#define WSP_AO    ((u16*)(p.ws + OFF_R4))
#define WSP_Hin   ((u16*)(p.ws + OFF_R4 + (size_t)NLAT * 512 * 2))

extern __shared__ __attribute__((aligned(16))) char smem[];

typedef __bf16 bf2_t __attribute__((ext_vector_type(2)));
typedef float f2_t __attribute__((ext_vector_type(2)));
__device__ __forceinline__ unsigned pack2(float a, float b) {
    const f2_t v = {a, b};
    return __builtin_bit_cast(unsigned, __builtin_convertvector(v, bf2_t));
}
__device__ __forceinline__ u16 f2bf(float f) { return (u16)(pack2(f, 0.f) & 0xffffu); }
__device__ __forceinline__ float bf2f(u16 h) { return __uint_as_float(((unsigned)h) << 16); }
__device__ __forceinline__ void glds16(const void* g, void* l) {
    __builtin_amdgcn_global_load_lds((const unsigned*)g, (unsigned*)l, 16, 0, 0);
}
__device__ __forceinline__ void glds16_sc1(const void* g, void* l) {
    __builtin_amdgcn_global_load_lds((const unsigned*)g, (unsigned*)l, 16, 0, 16);
}
__device__ __forceinline__ int lds_byte(int r, int c) {
    int st = (r >> 4) * 2 + (c >> 5), rr = r & 15, cc = c & 31, ob = rr * 64 + cc * 2;
    return st * 1024 + (ob ^ (((ob >> 9) & 1) << 5));
}
template <int CTRL> __device__ __forceinline__ float dppf(float v) {
    return __int_as_float(__builtin_amdgcn_update_dpp(0, __float_as_int(v), CTRL, 0xf, 0xf, true));
}
__device__ __forceinline__ float sum_x16(float v) {
    const unsigned u = __float_as_uint(v);
    const auto r = __builtin_amdgcn_permlane16_swap(u, u, false, false);
    return __uint_as_float(r[0]) + __uint_as_float(r[1]);
}
__device__ __forceinline__ float sum_x32(float v) {
    const unsigned u = __float_as_uint(v);
    const auto r = __builtin_amdgcn_permlane32_swap(u, u, false, false);
    return __uint_as_float(r[0]) + __uint_as_float(r[1]);
}
__device__ __forceinline__ float max_x16(float v) {
    const unsigned u = __float_as_uint(v);
    const auto r = __builtin_amdgcn_permlane16_swap(u, u, false, false);
    return fmaxf(__uint_as_float(r[0]), __uint_as_float(r[1]));
}
__device__ __forceinline__ float max_x32(float v) {
    const unsigned u = __float_as_uint(v);
    const auto r = __builtin_amdgcn_permlane32_swap(u, u, false, false);
    return fmaxf(__uint_as_float(r[0]), __uint_as_float(r[1]));
}
__device__ __forceinline__ float sum16(float v) {
    v += dppf<0xB1>(v);
    v += dppf<0x4E>(v);
    v += dppf<0x141>(v);
    v += dppf<0x140>(v);
    return v;
}
__device__ __forceinline__ float wave_sum(float v) { return sum_x32(sum_x16(sum16(v))); }
template <int CTRL> __device__ __forceinline__ float dpp_f(float v) {
    return __int_as_float(__builtin_amdgcn_update_dpp(0, __float_as_int(v), CTRL, 0xf, 0xf, true));
}
__device__ __forceinline__ float max8(float v) {
    v = fmaxf(v, dpp_f<0xB1>(v));
    v = fmaxf(v, dpp_f<0x4E>(v));
    v = fmaxf(v, dpp_f<0x141>(v));
    return v;
}
__device__ __forceinline__ float sigmoidf_(float x) { return __builtin_amdgcn_rcpf(1.f + __expf(-x)); }
__device__ __forceinline__ float siluf_(float x) { return x * __builtin_amdgcn_rcpf(1.f + __expf(-x)); }
__device__ __forceinline__ float gelu_tanh(float x) {
    float u = 0.7978845608028654f * (x + 0.044715f * x * x * x);
    return x * __builtin_amdgcn_rcpf(1.f + __expf(-2.f * u));
}

template <class FA, class FB>
__device__ __forceinline__ void gemm_tile(int nkt, FA fa, FB fb, f32x4 (&acc)[4][4]) {
    const int tid = TIDX, lane = tid & 63, wid = tid >> 6, wr = wid >> 1, wc = wid & 1, fr = lane & 15, fq = lane >> 4;
    const int sb = lane * 16, swz = sb ^ (((sb >> 9) & 1) << 5);
    const int r_in = swz >> 6, c_in = (swz & 63) >> 1;
#pragma unroll
    for (int m = 0; m < 4; ++m)
#pragma unroll
        for (int n = 0; n < 4; ++n) acc[m][n] = (f32x4){0.f, 0.f, 0.f, 0.f};
    __syncthreads();
    auto stage = [&](int kt, int s) {
        char* sa = smem + s * 32768;
        char* sbm = sa + 16384;
#pragma unroll
        for (int i = 0; i < 4; ++i) {
            const int st = wid + 4 * i, R = (st >> 1) * 16 + r_in, C = (st & 1) * 32 + c_in;
            glds16(fa(R, C, kt), sa + tid * 16 + i * 4096);
            glds16(fb(R, C, kt), sbm + tid * 16 + i * 4096);
        }
    };
    stage(0, 0);
    for (int kt = 0; kt < nkt; ++kt) {
        asm volatile("s_waitcnt vmcnt(0)" ::: "memory");
        __syncthreads();
        if (kt + 1 < nkt) stage(kt + 1, (kt + 1) & 1);
        const char* sa = smem + (kt & 1) * 32768;
        const char* sbm = sa + 16384;
#pragma unroll
        for (int ks = 0; ks < 2; ++ks) {
            bf16x8 a[4], b[4];
#pragma unroll
            for (int m = 0; m < 4; ++m) a[m] = *(const bf16x8*)(sa + lds_byte(wr * 64 + m * 16 + fr, ks * 32 + fq * 8));
#pragma unroll
            for (int n = 0; n < 4; ++n) b[n] = *(const bf16x8*)(sbm + lds_byte(wc * 64 + n * 16 + fr, ks * 32 + fq * 8));
#pragma unroll
            for (int m = 0; m < 4; ++m)
#pragma unroll
                for (int n = 0; n < 4; ++n) acc[m][n] = __builtin_amdgcn_mfma_f32_16x16x32_bf16(a[m], b[n], acc[m][n], 0, 0, 0);
        }
    }
    __syncthreads();
}

__device__ __forceinline__ int lds32(int r, int c) {
    const int rr = r & 15;
    return (r >> 4) * 1024 + ((rr * 64 + c * 2) ^ (((rr >> 3) & 1) << 5));
}
struct NoHook { __device__ __forceinline__ void operator()(int) const {} };
template <bool A_SC1 = false, class FA, class FB, class HK = NoHook>
__device__ __forceinline__ void gemm_tile_w(int nkt, FA fa, FB fb, f32x4 (&acc)[4][8], HK hook = HK()) {
    constexpr bool ZERO = true;
    const int tid = TIDX, lane = tid & 63, wid = tid >> 6, wr = wid >> 1, wc = wid & 1, fr = lane & 15, fq = lane >> 4;
    const int sb = lane * 16, swz = sb ^ (((sb >> 9) & 1) << 5);
    const int r_in = swz >> 6, c_in = (swz & 63) >> 1;
    if (ZERO) {
#pragma unroll
        for (int m = 0; m < 4; ++m)
#pragma unroll
            for (int n = 0; n < 8; ++n) acc[m][n] = (f32x4){0.f, 0.f, 0.f, 0.f};
    }
    __syncthreads();
    auto stage = [&](int kt, int s) {
        char* sa = smem + s * 24576;
#pragma unroll
        for (int i = 0; i < 2; ++i) { if (A_SC1) glds16_sc1(fa(i, (wid + 4 * i) * 16 + r_in, c_in, kt), sa + tid * 16 + i * 4096); else glds16(fa(i, (wid + 4 * i) * 16 + r_in, c_in, kt), sa + tid * 16 + i * 4096); }
#pragma unroll
        for (int i = 0; i < 4; ++i) glds16(fb(i, (wid + 4 * i) * 16 + r_in, c_in, kt), sa + 8192 + tid * 16 + i * 4096);
    };
    stage(0, 0);
    if (nkt > 1) stage(1, 1);
    int s_cur = 0, s_nxt = 2;
    for (int kt = 0; kt < nkt; ++kt) {
        hook(kt);
        if (kt + 1 < nkt) asm volatile("s_waitcnt vmcnt(6) lgkmcnt(0)\n\ts_barrier" ::: "memory");
        else asm volatile("s_waitcnt vmcnt(0) lgkmcnt(0)\n\ts_barrier" ::: "memory");
        if (kt + 2 < nkt) stage(kt + 2, s_nxt);
        const char* sa = smem + s_cur * 24576;
        bf16x8 a[4];
#pragma unroll
        for (int m = 0; m < 4; ++m) a[m] = *(const bf16x8*)(sa + lds32(wr * 64 + m * 16 + fr, fq * 8));
#pragma unroll
        for (int nh = 0; nh < 2; ++nh) {
            bf16x8 b[4];
#pragma unroll
            for (int n = 0; n < 4; ++n) b[n] = *(const bf16x8*)(sa + 8192 + lds32(wc * 128 + (nh * 4 + n) * 16 + fr, fq * 8));
#pragma unroll
            for (int m = 0; m < 4; ++m)
#pragma unroll
                for (int n = 0; n < 4; ++n) acc[m][nh * 4 + n] = __builtin_amdgcn_mfma_f32_16x16x32_bf16(a[m], b[n], acc[m][nh * 4 + n], 0, 0, 0);
        }
        s_cur = (s_cur == 2) ? 0 : s_cur + 1;
        s_nxt = (s_nxt == 2) ? 0 : s_nxt + 1;
    }
    __syncthreads();
}

template <class FV, class FD>
__device__ __forceinline__ void wave_store_bf16_f(FV val, FD dst, bool write_through = false, const char* wt_base = nullptr, unsigned wt_bytes = 0) {
    const __amdgpu_buffer_rsrc_t wt_rsrc = __builtin_amdgcn_make_buffer_rsrc((void*)wt_base, 0, (int)wt_bytes, 0x00020000);
    const int lane = TIDX & 63, wid = TIDX >> 6, fr = lane & 15, fq = lane >> 4;
    char* base = smem + wid * 9216;
#pragma unroll
    for (int m = 0; m < 4; ++m)
#pragma unroll
        for (int n = 0; n < 4; ++n)
#pragma unroll
            for (int j = 0; j < 4; ++j)
                *(u16*)(base + (m * 16 + fq * 4 + j) * 144 + (n * 16 + fr) * 2) = f2bf(val(m, n, j));
    asm volatile("s_waitcnt lgkmcnt(0)" ::: "memory");
    __builtin_amdgcn_wave_barrier();
#pragma unroll
    for (int i = 0; i < 8; ++i) {
        const int id = i * 64 + lane, row = id >> 3, ch = id & 7;
        const uint4 d = *(const uint4*)(base + row * 144 + ch * 16);
        u16* p = dst(row);
        if (p) {
            if (write_through) {
                const u32x4 dv = {d.x, d.y, d.z, d.w};
                __builtin_amdgcn_raw_buffer_store_b128(dv, wt_rsrc, (int)((const char*)(p + ch * 8) - wt_base), 0, 16);
            } else *(uint4*)(p + ch * 8) = d;
        }
    }
    asm volatile("s_waitcnt lgkmcnt(0)" ::: "memory");
    __builtin_amdgcn_wave_barrier();
}

template <class FD>
__device__ __forceinline__ void wave_store_bf16(const float (&v)[4][4][4], FD dst) {
    wave_store_bf16_f([&](int m, int n, int j) { return v[m][n][j]; }, dst);
}

struct ConvD { const float* src; u16* dst; int ld, ldd, k0, n0, mode, zr; };
__device__ __forceinline__ void conv_load(const Params& p, const ConvD& d, float (&v)[16]) {
    const int tid = TIDX;
#pragma unroll
    for (int i = 0; i < 16; ++i) v[i] = d.src[(size_t)(d.k0 + i * 4 + (tid >> 6)) * d.ld + d.n0 + (tid & 63)];
    if (d.zr == 2) {
#pragma unroll
        for (int i = 0; i < 16; ++i) {
            const int k = d.k0 + i * 4 + (tid >> 6);
            v[i] *= (k < 512) ? p.norm_attn_out[k] : p.norm_ssm_out[k - 512];
        }
    }
}
__device__ __forceinline__ void conv_store(const Params& p, const ConvD& d, const float (&v)[16]) {
    float* t = (float*)smem;
    const int tid = TIDX;
    __syncthreads();
#pragma unroll
    for (int i = 0; i < 16; ++i) t[(i * 4 + (tid >> 6)) * 65 + (tid & 63)] = v[i];
    __syncthreads();
    const int n = tid >> 2, kq = tid & 3;
    unsigned w[8];
#pragma unroll
    for (int i = 0; i < 8; ++i) w[i] = pack2(t[(kq * 16 + 2 * i) * 65 + n], t[(kq * 16 + 2 * i + 1) * 65 + n]);
    const int gn = d.n0 + n;
    int row = gn;
    if (d.mode == 1) row = (gn >> 4) * 32 + (gn & 15);
    else if (d.mode == 2) row = (gn >> 4) * 32 + 16 + (gn & 15);
    else if (d.mode == 3) row = n;
    uint4* o = (uint4*)(d.dst + (size_t)row * d.ldd + d.k0 + kq * 16);
    o[0] = make_uint4(w[0], w[1], w[2], w[3]);
    o[1] = make_uint4(w[4], w[5], w[6], w[7]);
    if (d.zr == 1) {
        uint4* z = (uint4*)(WSP_WrT + (size_t)(64 + n) * 1024 + d.k0 + kq * 16);
        z[0] = make_uint4(0, 0, 0, 0); z[1] = make_uint4(0, 0, 0, 0);
    }
}

__device__ __forceinline__ void ada_item(const Params& p, int item) {
    float* sc = (float*)smem;
    float* red = sc + 9 * 1024;
    const int tid = TIDX;
    __syncthreads();
    for (int i = tid; i < 9 * 1024; i += NTHR) {
        const int r = i >> 10, k = i & 1023;
        const float cv = (r < 8) ? p.c[r * 1024 + k] : p.c_ctx[k];
        sc[i] = siluf_(cv);
    }
    __syncthreads();
    const int kq = tid >> 6, jl = tid & 63, j = item * 64 + jl;
    float acc[9];
#pragma unroll
    for (int r = 0; r < 9; ++r) acc[r] = 0.f;
#pragma unroll 16
    for (int k = kq; k < 1024; k += 4) {
        const float w = p.w_ada[(size_t)k * 6144 + j];
#pragma unroll
        for (int r = 0; r < 9; ++r) acc[r] += sc[r * 1024 + k] * w;
    }
#pragma unroll
    for (int r = 0; r < 9; ++r) red[(kq * 9 + r) * 64 + jl] = acc[r];
    __syncthreads();
    for (int i = tid; i < 9 * 64; i += NTHR) {
        const int r = i >> 6, l = i & 63;
        const float s = red[(0 * 9 + r) * 64 + l] + red[(1 * 9 + r) * 64 + l] + red[(2 * 9 + r) * 64 + l] + red[(3 * 9 + r) * 64 + l];
        WSP_mod[r * 6144 + item * 64 + l] = s + p.b_ada[item * 64 + l];
    }
}

__device__ __forceinline__ void rope_item(const Params& p) {
    for (int i = TIDX; i < 64 * 16; i += NTHR) {
        const int pos = i >> 4, k = i & 15;
        const float inv = exp2f(-(float)k * (13.287712379549449f / 16.f));
        float s, c;
        sincosf((float)pos * inv, &s, &c);
        WSP_rope[i] = make_float2(c, s);
    }
}

__device__ __forceinline__ void ssm_table_item(const Params& p, int g, int dir) {
    float* pw = (float*)smem;
    float* Bb = pw + 17 * 64 * 2;
    float* Cc = Bb + 64 * 16 * 2;
    const int tid = TIDX;
    u16* tabS = WSP_TabS + (size_t)g * 256 * 256;
    u16* tabY = WSP_TabY + (size_t)g * 256 * 512;
    float* Kf = WSP_Kbuf + (size_t)(g * 2 + dir) * 4096;
    __syncthreads();
    {
        const int pidx = dir * 32 + g;
        const float dt = __expf(p.log_dt[pidx]);
        for (int i = tid; i < 17 * 64; i += NTHR) {
            const int tau = i >> 6, n = i & 63;
            const float are = p.a_re[pidx * 64 + n], aim = p.a_im[pidx * 64 + n];
            const float mag = __expf((float)tau * dt * are);
            float rev = (float)tau * (dt * aim * 0.15915494309189535f);
            rev -= rintf(rev);
            pw[i * 2] = mag * __builtin_amdgcn_cosf(rev);
            pw[i * 2 + 1] = mag * __builtin_amdgcn_sinf(rev);
        }
        __syncthreads();
        for (int i = tid; i < 64 * 16; i += NTHR) {
            const int n = i >> 4;
            const float are = p.a_re[pidx * 64 + n], aim = p.a_im[pidx * 64 + n];
            const float abr = pw[(64 + n) * 2], abi = pw[(64 + n) * 2 + 1];
            const float den = are * are + aim * aim, nre = abr - 1.f;
            const float cre = (nre * are + abi * aim) / den, cim = (abi * are - nre * aim) / den;
            const float br = p.b_re[(size_t)pidx * 1024 + i], bi = p.b_im[(size_t)pidx * 1024 + i];
            Bb[i * 2] = cre * br - cim * bi;
            Bb[i * 2 + 1] = cre * bi + cim * br;
            Cc[i * 2] = p.c_re[(size_t)pidx * 1024 + i];
            Cc[i * 2 + 1] = p.c_im[(size_t)pidx * 1024 + i];
        }
        __syncthreads();
        {
            const int tau = tid >> 4, pp = tid & 15;
            float s[16];
#pragma unroll
            for (int q = 0; q < 16; ++q) s[q] = 0.f;
            for (int n = 0; n < 64; ++n) {
                const float2 cv = *(const float2*)&Cc[(pp * 64 + n) * 2];
                const float2 wv = *(const float2*)&pw[(tau * 64 + n) * 2];
                const float zr = cv.x * wv.x - cv.y * wv.y, zi = cv.x * wv.y + cv.y * wv.x;
#pragma unroll
                for (int q = 0; q < 16; ++q) {
                    const float2 bv = *(const float2*)&Bb[(n * 16 + q) * 2];
                    s[q] += zr * bv.x - zi * bv.y;
                }
            }
#pragma unroll
            for (int q = 0; q < 4; ++q)
                *(float4*)(Kf + tau * 256 + pp * 16 + q * 4) = make_float4(s[4 * q], s[4 * q + 1], s[4 * q + 2], s[4 * q + 3]);
        }
        for (int id = tid; id < 128 * 32; id += NTHR) {
            const int rr = id >> 5, ch = id & 31, cpart = rr >> 6, n = rr & 63, s_ = ch >> 1, q0 = (ch & 1) * 8;
            const int e = dir == 0 ? 15 - s_ : s_;
            const float wr_ = pw[(e * 64 + n) * 2], wi_ = pw[(e * 64 + n) * 2 + 1];
            unsigned w[4];
#pragma unroll
            for (int i = 0; i < 4; ++i) {
                float v[2];
#pragma unroll
                for (int h = 0; h < 2; ++h) {
                    const float br = Bb[(n * 16 + q0 + 2 * i + h) * 2], bi = Bb[(n * 16 + q0 + 2 * i + h) * 2 + 1];
                    v[h] = cpart == 0 ? (wr_ * br - wi_ * bi) : (wr_ * bi + wi_ * br);
                }
                w[i] = pack2(v[0], v[1]);
            }
            *(uint4*)(tabS + (size_t)(dir * 128 + rr) * 256 + s_ * 16 + q0) = make_uint4(w[0], w[1], w[2], w[3]);
        }
        for (int id = tid; id < 256 * 16; id += NTHR) {
            const int m = id >> 4, ch = id & 15, t = m >> 4, pp = m & 15, cpart = ch >> 3, n0 = (ch & 7) * 8;
            const int e = dir == 0 ? t + 1 : 16 - t;
            unsigned w[4];
#pragma unroll
            for (int i = 0; i < 4; ++i) {
                float v[2];
#pragma unroll
                for (int h = 0; h < 2; ++h) {
                    const int n = n0 + 2 * i + h;
                    const float cr = Cc[(pp * 64 + n) * 2], ci = Cc[(pp * 64 + n) * 2 + 1];
                    const float wr_ = pw[(e * 64 + n) * 2], wi_ = pw[(e * 64 + n) * 2 + 1];
                    v[h] = cpart == 0 ? (cr * wr_ - ci * wi_) : -(cr * wi_ + ci * wr_);
                }
                w[i] = pack2(v[0], v[1]);
            }
            *(uint4*)(tabY + (size_t)m * 512 + 256 + dir * 128 + cpart * 64 + n0) = make_uint4(w[0], w[1], w[2], w[3]);
        }
    }
}

__device__ __forceinline__ void ssm_toeplitz_item(const Params& p, int g) {
    float* Kf = (float*)smem;
    const int tid = TIDX;
    u16* tabY = WSP_TabY + (size_t)g * 256 * 512;
    __syncthreads();
    for (int i = tid; i < 2048; i += NTHR) ((float4*)Kf)[i] = ((const float4*)(WSP_Kbuf + (size_t)g * 8192))[i];
    __syncthreads();
    for (int id = tid; id < 256 * 32; id += NTHR) {
        const int m = id >> 5, ch = id & 31, t = m >> 4, pp = m & 15, s_ = ch >> 1, q0 = (ch & 1) * 8;
        unsigned w[4];
#pragma unroll
        for (int i = 0; i < 4; ++i) {
            float v[2];
#pragma unroll
            for (int h = 0; h < 2; ++h) {
                const int q = q0 + 2 * i + h;
                float val;
                if (s_ < t) val = Kf[((t - s_) * 16 + pp) * 16 + q];
                else if (s_ > t) val = Kf[4096 + ((s_ - t) * 16 + pp) * 16 + q];
                else val = Kf[(pp) * 16 + q] + Kf[4096 + pp * 16 + q] + (pp == q ? p.ssm_d[g * 16 + pp] : 0.f);
                v[h] = val;
            }
            w[i] = pack2(v[0], v[1]);
        }
        *(uint4*)(tabY + (size_t)m * 512 + s_ * 16 + q0) = make_uint4(w[0], w[1], w[2], w[3]);
    }
    __syncthreads();
}

#define N_CONV 6896
__device__ __forceinline__ ConvD conv_decode(const Params& p, int t) {
    ConvD d; d.mode = 0; d.zr = 0;
    if (t < 320) { d.src = p.w_in; d.ld = 1280; d.k0 = (t / 20) * 64; d.n0 = (t % 20) * 64; d.dst = WSP_WinT; d.ldd = 1024; return d; }
    t -= 320;
    if (t < 64) { d.src = p.w_glu; d.ld = 512; d.k0 = (t / 8) * 64; d.n0 = (t % 8) * 64; d.dst = WSP_WgluT; d.ldd = 512; return d; }
    t -= 64;
    if (t < 256) { d.src = p.w_out; d.ld = 1024; d.k0 = (t / 16) * 64; d.n0 = (t % 16) * 64; d.dst = WSP_WoutT; d.ldd = 1024; d.zr = 2; return d; }
    t -= 256;
    if (t < 16) { d.src = p.w_router; d.ld = 64; d.k0 = t * 64; d.n0 = 0; d.dst = WSP_WrT; d.ldd = 1024; d.zr = 1; return d; }
    t -= 16;
    if (t < 4096) {
        const int up = t >= 2048; const int tt = t & 2047, e = tt >> 5, r = tt & 31;
        d.src = (up ? p.w_up_e : p.w_gate_e) + (size_t)e * 131072; d.ld = 128; d.k0 = (r >> 1) * 64; d.n0 = (r & 1) * 64;
        d.dst = WSP_WguT + (size_t)e * 262144; d.ldd = 1024; d.mode = 1 + up; return d;
    }
    t -= 4096;
    if (t < 64) {
        const int up = t >= 32; const int r = t & 31;
        d.src = up ? p.w_up_s : p.w_gate_s; d.ld = 128; d.k0 = (r >> 1) * 64; d.n0 = (r & 1) * 64;
        d.dst = WSP_WguT + (size_t)64 * 262144; d.ldd = 1024; d.mode = 1 + up; return d;
    }
    t -= 64;
    if (t < 2048) { const int e = t >> 5, r = t & 31; d.src = p.w_down_e + (size_t)e * 131072; d.ld = 1024; d.k0 = (r >> 4) * 64; d.n0 = (r & 15) * 64; d.dst = WSP_WdT + (size_t)e * 131072; d.ldd = 128; return d; }
    t -= 2048;
    d.src = p.w_down_s; d.ld = 1024; d.k0 = (t >> 4) * 64; d.n0 = (t & 15) * 64; d.dst = WSP_WdT + (size_t)64 * 131072; d.ldd = 128; return d;
}

#define N_CONV_EARLY 4000
__device__ __forceinline__ void conv_range(const Params& p, int t0, int stride, int tend, int tbeg = 0) {
    int t = tbeg + t0;
    if (t < tend) {
        ConvD d = conv_decode(p, t);
        float v[16];
        conv_load(p, d, v);
        while (t < tend) {
            const int tn = t + stride;
            ConvD dn = d;
            float vn[16];
            if (tn < tend) { dn = conv_decode(p, tn); conv_load(p, dn, vn); }
            conv_store(p, d, v);
            d = dn;
#pragma unroll
            for (int i = 0; i < 16; ++i) v[i] = vn[i];
            t = tn;
        }
    }
}
#define P0_CONV_B0 161
__device__ __forceinline__ void phase0(const Params& p) {
    const int b = blockIdx.x, G = gridDim.x;
    if (G > P0_CONV_B0 + 32) {
        if (b < 64) ssm_table_item(p, b >> 1, b & 1);
        else if (b < 160) ada_item(p, b - 64);
        else if (b == 160) rope_item(p);
        else conv_range(p, b - P0_CONV_B0, G - P0_CONV_B0, N_CONV_EARLY);
    } else {
        const int NU = 64 + 96 + 1 + N_CONV_EARLY;
        for (int u = b; u < NU; u += G) {
            if (u < 64) ssm_table_item(p, u >> 1, u & 1);
            else if (u < 160) ada_item(p, u - 64);
            else if (u == 160) rope_item(p);
            else { ConvD d = conv_decode(p, u - 161); float v[16]; conv_load(p, d, v); conv_store(p, d, v); }
        }
    }
}
#if 0
    {
        {
            const int stride = G - P0_CONV_B0;
            int t = b - P0_CONV_B0;
            if (t < N_CONV) {
                ConvD d = conv_decode(p, t);
                float v[16];
                conv_load(p, d, v);
                while (t < N_CONV) {
                    const int tn = t + stride;
                    ConvD dn = d;
                    float vn[16];
                    if (tn < N_CONV) { dn = conv_decode(p, tn); conv_load(p, dn, vn); }
                    conv_store(p, d, v);
                    d = dn;
#pragma unroll
                    for (int i = 0; i < 16; ++i) v[i] = vn[i];
                    t = tn;
                }
            }
        }
    } else {
        const int NU = 64 + 96 + 1 + N_CONV;
        for (int u = b; u < NU; u += G) {
            if (u < 64) ssm_table_item(p, u >> 1, u & 1);
            else if (u < 160) ada_item(p, u - 64);
            else if (u == 160) rope_item(p);
            else { ConvD d = conv_decode(p, u - 161); float v[16]; conv_load(p, d, v); conv_store(p, d, v); }
        }
    }
}

#endif

__device__ __forceinline__ void norm_mod_row(const float* src, const float* gain, const float* sh, const float* scl, u16* dst) {
    const int lane = TIDX & 63;
    float4 v[4];
    float ss = 0.f;
#pragma unroll
    for (int i = 0; i < 4; ++i) {
        v[i] = *(const float4*)(src + i * 256 + lane * 4);
        ss += v[i].x * v[i].x + v[i].y * v[i].y + v[i].z * v[i].z + v[i].w * v[i].w;
    }
    ss = wave_sum(ss);
    const float rs = rsqrtf(ss * (1.f / 1024.f) + EPS);
#pragma unroll
    for (int i = 0; i < 4; ++i) {
        const int c0 = i * 256 + lane * 4;
        const float4 g = *(const float4*)(gain + c0), s = *(const float4*)(sh + c0), k = *(const float4*)(scl + c0);
        const float a = v[i].x * rs * g.x * (1.f + k.x) + s.x, b = v[i].y * rs * g.y * (1.f + k.y) + s.y;
        const float c = v[i].z * rs * g.z * (1.f + k.z) + s.z, d = v[i].w * rs * g.w * (1.f + k.w) + s.w;
        *(uint2*)(dst + c0) = make_uint2(pack2(a, b), pack2(c, d));
    }
}

__device__ __forceinline__ void phase1(const Params& p) {
    const int wv = blockIdx.x * 4 + (TIDX >> 6), nwv = gridDim.x * 4;
    const int lane = TIDX & 63;
    for (int r0 = wv * 4; r0 < NROWS; r0 += nwv * 4) {
        const float* src[4]; const float* md[4];
        float4 v[4][4];
#pragma unroll
        for (int q = 0; q < 4; ++q) {
            const int r = r0 + q;
            if (r < NLAT) { src[q] = p.x + (size_t)r * 1024; md[q] = WSP_mod + (r >> 11) * 6144; }
            else { src[q] = p.ctx + (size_t)(r - NLAT) * 1024; md[q] = WSP_mod + 8 * 6144; }
#pragma unroll
            for (int i = 0; i < 4; ++i) v[q][i] = *(const float4*)(src[q] + i * 256 + lane * 4);
        }
#pragma unroll
        for (int q = 0; q < 4; ++q) {
            float ss = 0.f;
#pragma unroll
            for (int i = 0; i < 4; ++i) ss += v[q][i].x * v[q][i].x + v[q][i].y * v[q][i].y + v[q][i].z * v[q][i].z + v[q][i].w * v[q][i].w;
            ss = wave_sum(ss);
            const float rs = rsqrtf(ss * (1.f / 1024.f) + EPS);
            u16* dst = WSP_Hb + (size_t)(r0 + q) * 1024;
#pragma unroll
            for (int i = 0; i < 4; ++i) {
                const int c0 = i * 256 + lane * 4;
                const float4 g = *(const float4*)(p.norm_mix + c0), s = *(const float4*)(md[q] + c0), k = *(const float4*)(md[q] + 1024 + c0);
                const float a = v[q][i].x * rs * g.x * (1.f + k.x) + s.x, b = v[q][i].y * rs * g.y * (1.f + k.y) + s.y;
                const float c = v[q][i].z * rs * g.z * (1.f + k.z) + s.z, d = v[q][i].w * rs * g.w * (1.f + k.w) + s.w;
                *(uint2*)(dst + c0) = make_uint2(pack2(a, b), pack2(c, d));
            }
        }
    }
}

__device__ __forceinline__ void phase2(const Params& p) {
    const int NU = 128 * 10 + 16 * 6;
    const int lane = TIDX & 63, wid = TIDX >> 6, wr = wid >> 1, wc = wid & 1, fr = lane & 15, fq = lane >> 4;
    for (int u = blockIdx.x; u < NU; u += gridDim.x) {
        int mt, nt;
        {
            const int xc = u & 7, r = u >> 3;
            if (r < 160) { mt = xc + 8 * (r / 10); nt = r % 10; } else { const int v = r - 160; mt = 128 + xc + 8 * (v / 6); nt = 4 + v % 6; }
        }
        const u16* A = WSP_Hb + (size_t)mt * 128 * 1024;
        const u16* B = WSP_WinT + (size_t)nt * 128 * 1024;
        f32x4 acc[4][4];
        gemm_tile(16,
            [&](int R, int C, int kt) { return (const void*)(A + (size_t)R * 1024 + kt * 64 + C); },
            [&](int R, int C, int kt) { return (const void*)(B + (size_t)R * 1024 + kt * 64 + C); }, acc);
        const int row0 = mt * 128 + wr * 64;
        const int col0 = nt * 128 + wc * 64;
        const bool is_lat = mt < 128;
        if (nt == 5) {
            const int kvh = wc;
#pragma unroll
            for (int m = 0; m < 4; ++m) {
                const int r = row0 + m * 16 + fq * 4;
                int b, pos;
                if (is_lat) { b = r >> 11; pos = r & 2047; } else { const int rc = r - NLAT; b = rc >> 8; pos = SEQ + (rc & 255); }
#pragma unroll
                for (int n = 0; n < 4; ++n) {
                    const int d = n * 16 + fr;
                    u16* dst = WSP_Vt + ((size_t)(b * 2 + kvh) * 64 + d) * VT_LD + pos;
                    *(uint2*)dst = make_uint2(pack2(acc[m][n][0], acc[m][n][1]), pack2(acc[m][n][2], acc[m][n][3]));
                }
            }
        } else {
            float v[4][4][4];
            const bool do_rope = is_lat && nt <= 4;
#pragma unroll
            for (int m = 0; m < 4; ++m)
#pragma unroll
                for (int j = 0; j < 4; ++j) {
                    if (do_rope) {
                        const int r = row0 + m * 16 + fq * 4 + j, pos = r & 2047;
                        const float2 cr = WSP_rope[(pos >> 6) * 16 + fr], cc = WSP_rope[(pos & 63) * 16 + fr];
                        const float x1 = acc[m][0][j], x2 = acc[m][1][j], y1 = acc[m][2][j], y2 = acc[m][3][j];
                        v[m][0][j] = x1 * cr.x - x2 * cr.y; v[m][1][j] = x1 * cr.y + x2 * cr.x;
                        v[m][2][j] = y1 * cc.x - y2 * cc.y; v[m][3][j] = y1 * cc.y + y2 * cc.x;
                    } else {
#pragma unroll
                        for (int n = 0; n < 4; ++n) v[m][n][j] = acc[m][n][j];
                    }
                }
            u16* dbase; int ldd;
            if (nt < 4) { dbase = WSP_Q + (size_t)row0 * 512 + col0; ldd = 512; }
            else if (nt == 4) { dbase = WSP_Kb + (size_t)row0 * 128 + (col0 - 512); ldd = 128; }
            else { dbase = WSP_U + (size_t)row0 * 512 + (col0 - 768); ldd = 512; }
            wave_store_bf16(v, [&](int row) { return dbase + (size_t)row * ldd; });
        }
    }
}

__device__ __forceinline__ void attn_unit(const Params& p, int u) {
    const int h = u & 7, qb = (u >> 3) & 15, b = u >> 7, kvh = h >> 2;
    const int tid = TIDX, lane = tid & 63, wid = tid >> 6, fr = lane & 15, fq = lane >> 4;
    const int sb = lane * 16, swz = sb ^ (((sb >> 9) & 1) << 5);
    const int r_in = swz >> 6, c_in = (swz & 63) >> 1;
    const int jstart = qb == 0 ? 2 : 0, jend = qb == 15 ? 4 : 6, nb = jend - jstart, ntile = nb + 4;
    const float SC = 0.125f * 1.4426950408889634f;
    bf16x8 qf[2][2];
    const int qrow0 = b * SEQ + qb * 128 + wid * 32;
#pragma unroll
    for (int qt = 0; qt < 2; ++qt)
#pragma unroll
        for (int ks = 0; ks < 2; ++ks)
            qf[qt][ks] = *(const bf16x8*)(WSP_Q + (size_t)(qrow0 + qt * 16 + fr) * 512 + h * 64 + ks * 32 + fq * 8);
    f32x4 o[4][2];
#pragma unroll
    for (int dt = 0; dt < 4; ++dt)
#pragma unroll
        for (int qt = 0; qt < 2; ++qt) o[dt][qt] = (f32x4){0.f, 0.f, 0.f, 0.f};
    float mrun[2], lrun[2];
    const float sinkv = p.attn_sink[h] * 1.4426950408889634f;
    mrun[0] = mrun[1] = sinkv;
    lrun[0] = lrun[1] = (fq == 0) ? 1.f : 0.f;
    __syncthreads();
    const u16* kp[2]; const u16* vp[2];
    {
        const int ks0 = qb * 128 - 128 + 64 * jstart;
#pragma unroll
        for (int it = 0; it < 2; ++it) {
            const int st = wid + 4 * it, R = (st >> 1) * 16 + r_in, C = (st & 1) * 32 + c_in;
            kp[it] = WSP_Kb + (size_t)(b * SEQ + ks0 + R) * 128 + kvh * 64 + C;
            vp[it] = WSP_Vt + ((size_t)(b * 2 + kvh) * 64 + R) * VT_LD + ks0 + C;
        }
    }
    auto stage = [&](int i, int s) {
        char* sk = smem + s * 16384;
        char* sv = sk + 8192;
#pragma unroll
        for (int it = 0; it < 2; ++it) {
            glds16(kp[it], sk + tid * 16 + it * 4096);
            glds16(vp[it], sv + tid * 16 + it * 4096);
        }
        if (i + 1 == nb) {
            const int ks0 = qb * 128 - 128 + 64 * (jstart + i);
#pragma unroll
            for (int it = 0; it < 2; ++it) {
                kp[it] += (size_t)(NLAT + b * CTXL - (b * SEQ + ks0)) * 128;
                vp[it] += SEQ - ks0;
            }
        } else {
#pragma unroll
            for (int it = 0; it < 2; ++it) { kp[it] += 64 * 128; vp[it] += 64; }
        }
    };
    stage(0, 0);
    for (int i = 0; i < ntile; ++i) {
        asm volatile("s_waitcnt vmcnt(0)" ::: "memory");
        __syncthreads();
        if (i + 1 < ntile) stage(i + 1, (i + 1) & 1);
        const char* sk = smem + (i & 1) * 16384;
        const char* sv = sk + 8192;
        f32x4 s[4][2];
#pragma unroll
        for (int kt = 0; kt < 4; ++kt)
#pragma unroll
            for (int qt = 0; qt < 2; ++qt) s[kt][qt] = (f32x4){0.f, 0.f, 0.f, 0.f};
#pragma unroll
        for (int ks = 0; ks < 2; ++ks)
#pragma unroll
            for (int kt = 0; kt < 4; ++kt) {
                const bf16x8 kf = *(const bf16x8*)(sk + lds_byte(32 * (kt >> 1) + 8 * (fr >> 2) + 4 * (kt & 1) + (fr & 3), ks * 32 + fq * 8));
#pragma unroll
                for (int qt = 0; qt < 2; ++qt) s[kt][qt] = __builtin_amdgcn_mfma_f32_16x16x32_bf16(kf, qf[qt][ks], s[kt][qt], 0, 0, 0);
            }
        const int ks0 = qb * 128 - 128 + 64 * (jstart + i);
        const int qlo = qb * 128 + wid * 32;
        const bool band = (i < nb) && ((qlo + 31 - ks0 > 128) || (ks0 + 63 - qlo > 128));
        bf16x8 pf[2][2];
#pragma unroll
        for (int qt = 0; qt < 2; ++qt) {
            const int qp = qb * 128 + wid * 32 + qt * 16 + fr;
            float mx = -1e30f;
            if (band) {
#pragma unroll
                for (int kt = 0; kt < 4; ++kt)
#pragma unroll
                    for (int j = 0; j < 4; ++j) {
                        const int kp = ks0 + 32 * (kt >> 1) + 8 * fq + 4 * (kt & 1) + j, d = qp - kp;
                        const float v = (d > 128 || d < -128) ? -1e30f : s[kt][qt][j];
                        s[kt][qt][j] = v;
                        mx = fmaxf(mx, v);
                    }
                asm volatile("" ::: "memory");
            } else {
#pragma unroll
                for (int kt = 0; kt < 4; ++kt)
#pragma unroll
                    for (int j = 0; j < 4; ++j) mx = fmaxf(mx, s[kt][qt][j]);
            }
            mx = max_x32(max_x16(mx));
            const float mnew = fmaxf(mrun[qt], mx * SC);
            const float alpha = __builtin_amdgcn_exp2f(mrun[qt] - mnew);
            mrun[qt] = mnew;
            float ls = 0.f;
#pragma unroll
            for (int kt = 0; kt < 4; ++kt)
#pragma unroll
                for (int j = 0; j < 4; ++j) {
                    const float pv = __builtin_amdgcn_exp2f(fmaf(s[kt][qt][j], SC, -mnew));
                    s[kt][qt][j] = pv;
                    ls += pv;
                }
            lrun[qt] = lrun[qt] * alpha + ls;
            if (!__all(alpha == 1.f)) {
#pragma unroll
                for (int dt = 0; dt < 4; ++dt) o[dt][qt] *= alpha;
            }
#pragma unroll
            for (int k2 = 0; k2 < 2; ++k2) {
                bf16x8 t;
#pragma unroll
                for (int j = 0; j < 4; ++j) { t[j] = (short)f2bf(s[2 * k2][qt][j]); t[4 + j] = (short)f2bf(s[2 * k2 + 1][qt][j]); }
                pf[qt][k2] = t;
            }
        }
#pragma unroll
        for (int k2 = 0; k2 < 2; ++k2)
#pragma unroll
            for (int dt = 0; dt < 4; ++dt) {
                const bf16x8 vf = *(const bf16x8*)(sv + lds_byte(dt * 16 + fr, k2 * 32 + fq * 8));
#pragma unroll
                for (int qt = 0; qt < 2; ++qt) o[dt][qt] = __builtin_amdgcn_mfma_f32_16x16x32_bf16(vf, pf[qt][k2], o[dt][qt], 0, 0, 0);
            }
    }
#pragma unroll
    for (int qt = 0; qt < 2; ++qt) {
        const float l = sum_x32(sum_x16(lrun[qt]));
        const float inv = 1.f / l;
        u16* dst = WSP_AO + (size_t)(qrow0 + qt * 16 + fr) * 512 + h * 64 + fq * 4;
        float sq = 0.f;
#pragma unroll
        for (int dt = 0; dt < 4; ++dt) {
            const unsigned w0 = pack2(o[dt][qt][0] * inv, o[dt][qt][1] * inv), w1 = pack2(o[dt][qt][2] * inv, o[dt][qt][3] * inv);
            *(uint2*)(dst + dt * 16) = make_uint2(w0, w1);
            const float a = bf2f((u16)(w0 & 0xffffu)), b = bf2f((u16)(w0 >> 16)), c = bf2f((u16)(w1 & 0xffffu)), d = bf2f((u16)(w1 >> 16));
            sq += a * a + b * b + c * c + d * d;
        }
        sq = sum_x32(sum_x16(sq));
        if (fq == 0) unsafeAtomicAdd(WSP_rsq + (size_t)(qrow0 + qt * 16 + fr) * 2, sq);
    }
}

__device__ __forceinline__ void ssm_s1_unit(const Params& p, int u) {
    const int ct = u % 9, mh = (u / 9) & 1, g = u / 18;
    const int lane = TIDX & 63, wid = TIDX >> 6, wr = wid >> 1, wc = wid & 1, fr = lane & 15, fq = lane >> 4;
    const u16* A = WSP_TabS + ((size_t)g * 256 + mh * 128) * 256;
    const u16* Ub = WSP_U + (size_t)ct * 128 * 16 * 512 + g * 16;
    f32x4 acc[4][4];
    gemm_tile(4,
        [&](int R, int C, int kt) { return (const void*)(A + (size_t)R * 256 + kt * 64 + C); },
        [&](int R, int C, int kt) { return (const void*)(Ub + (size_t)(R * 16 + kt * 4 + (C >> 4)) * 512 + (C & 15)); }, acc);
#pragma unroll
    for (int m = 0; m < 4; ++m)
#pragma unroll
        for (int n = 0; n < 4; ++n) {
            const int rho = mh * 128 + wr * 64 + m * 16 + fq * 4;
            const int cg = ct * 128 + wc * 64 + n * 16 + fr;
            *(f32x4*)(WSP_S + ((size_t)cg * 32 + g) * 256 + rho) = acc[m][n];
        }
}

__device__ __forceinline__ void phase3(const Params& p) {
    for (int u = blockIdx.x; u < 1024; u += gridDim.x) attn_unit(p, u);
    int* qv = (int*)(smem + 73728);
    for (;;) {
        __syncthreads();
        if (TIDX == 0) qv[0] = (int)atomicAdd(&WSP_ctr[CTR_QS1], 1u);
        __syncthreads();
        const int u = __builtin_amdgcn_readfirstlane(qv[0]);
        if (u >= 576) break;
        ssm_s1_unit(p, u);
    }
}

__device__ __forceinline__ void phase4(const Params& p) {
    if ((int)gridDim.x > 192) {
        if ((int)blockIdx.x >= 160) { conv_range(p, blockIdx.x - 160, gridDim.x - 160, N_CONV, N_CONV_EARLY); return; }
        if ((int)blockIdx.x >= 128) { ssm_toeplitz_item(p, blockIdx.x - 128); return; }
    } else {
        for (int g = blockIdx.x; g < 32; g += gridDim.x) ssm_toeplitz_item(p, g);
        conv_range(p, blockIdx.x, gridDim.x, N_CONV, N_CONV_EARLY);
    }
    const int gid = blockIdx.x * NTHR + TIDX;
    if (gid >= BATCH * 2 * 32 * 64) return;
    const int n = gid & 63, g = (gid >> 6) & 31, dir = (gid >> 11) & 1, b = gid >> 12;
    const int pidx = dir * 32 + g;
    const float dt = __expf(p.log_dt[pidx]);
    const float are = p.a_re[pidx * 64 + n], aim = p.a_im[pidx * 64 + n];
    const float mag = __expf(16.f * dt * are);
    float rev = 16.f * (dt * aim * 0.15915494309189535f);
    rev -= rintf(rev);
    const float ar = mag * __builtin_amdgcn_cosf(rev), ai = mag * __builtin_amdgcn_sinf(rev);
    float hr = 0.f, hi = 0.f;
    const size_t so = (size_t)g * 256 + dir * 128 + n;
#pragma unroll 8
    for (int i = 0; i < 16; ++i) {
        const int c = dir == 0 ? i : 15 - i;
        const float* sp = WSP_S + (size_t)(NCHUNK_LAT + b * 16 + c) * 8192 + so;
        const float sr = sp[0], si = sp[64];
        const float nr = ar * hr - ai * hi + sr, ni = ar * hi + ai * hr + si;
        hr = nr; hi = ni;
    }
#pragma unroll 8
    for (int i = 0; i < 128; ++i) {
        const int c = dir == 0 ? i : 127 - i;
        const size_t cg = (size_t)b * 128 + c;
        const float* sp = WSP_S + cg * 8192 + so;
        const float sr = sp[0], si = sp[64];
        u16* hp = WSP_Hin + cg * 8192 + so;
        hp[0] = f2bf(hr); hp[64] = f2bf(hi);
        const float nr = ar * hr - ai * hi + sr, ni = ar * hi + ai * hr + si;
        hr = nr; hi = ni;
    }
}

__device__ __forceinline__ void phase5(const Params& p) {
    const int NU = 512;
    const int lane = TIDX & 63, wid = TIDX >> 6, wr = wid >> 1, wc = wid & 1, fr = lane & 15, fq = lane >> 4;
    for (int u = blockIdx.x; u < NU; u += gridDim.x) {
        const int ct = u & 7, mh = (u >> 3) & 1, g = u >> 4;
        const u16* A = WSP_TabY + ((size_t)g * 256 + mh * 128) * 512;
        const u16* Ub = WSP_U + (size_t)ct * 128 * 16 * 512 + g * 16;
        const u16* Hb_ = WSP_Hin + (size_t)ct * 128 * 8192 + g * 256;
        f32x4 acc[4][4];
        gemm_tile(8,
            [&](int R, int C, int kt) { return (const void*)(A + (size_t)R * 512 + kt * 64 + C); },
            [&](int R, int C, int kt) {
                return kt < 4 ? (const void*)(Ub + (size_t)(R * 16 + kt * 4 + (C >> 4)) * 512 + (C & 15))
                              : (const void*)(Hb_ + (size_t)R * 8192 + (kt - 4) * 64 + C);
            }, acc);
#pragma unroll
        for (int m = 0; m < 4; ++m)
#pragma unroll
            for (int n = 0; n < 4; ++n) {
                const int t = mh * 8 + wr * 4 + m;
                const int cg = ct * 128 + wc * 64 + n * 16 + fr;
                u16* dst = WSP_Y + ((size_t)cg * 16 + t) * 512 + g * 16 + fq * 4;
                *(uint2*)dst = make_uint2(pack2(gelu_tanh(acc[m][n][0]), gelu_tanh(acc[m][n][1])),
                                          pack2(gelu_tanh(acc[m][n][2]), gelu_tanh(acc[m][n][3])));
            }
    }
}

__device__ __forceinline__ void phase6(const Params& p) {
    const int NU = 512;
    const int lane = TIDX & 63, wid = TIDX >> 6, wr = wid >> 1, wc = wid & 1, fr = lane & 15, fq = lane >> 4;
    for (int u = blockIdx.x; u < NU; u += gridDim.x) {
        const int mt = u >> 2, nt = u & 3;
        const u16* A = WSP_Y + (size_t)mt * 128 * 512;
        const u16* B = WSP_WgluT + (size_t)nt * 128 * 512;
        f32x4 acc[4][4];
        gemm_tile(8,
            [&](int R, int C, int kt) { return (const void*)(A + (size_t)R * 512 + kt * 64 + C); },
            [&](int R, int C, int kt) { return (const void*)(B + (size_t)R * 512 + kt * 64 + C); }, acc);
        const int row0 = mt * 128 + wr * 64, col0 = nt * 128 + wc * 64;
        char* base = smem + wid * 9216;
        float bg[4];
#pragma unroll
        for (int n = 0; n < 4; ++n) bg[n] = p.b_glu[col0 + n * 16 + fr];
#pragma unroll
        for (int i = 0; i < 8; ++i) {
            const int id = i * 64 + lane, row = id >> 3, ch = id & 7;
            *(uint4*)(base + row * 144 + ch * 16) = *(const uint4*)(WSP_Y + (size_t)(row0 + row) * 512 + col0 + ch * 8);
        }
        asm volatile("s_waitcnt lgkmcnt(0)" ::: "memory");
        __builtin_amdgcn_wave_barrier();
#pragma unroll
        for (int m = 0; m < 4; ++m)
#pragma unroll
            for (int j = 0; j < 4; ++j) {
                const int rl = m * 16 + fq * 4 + j, r = row0 + rl;
                float sq = 0.f;
#pragma unroll
                for (int n = 0; n < 4; ++n) {
                    const int c = col0 + n * 16 + fr;
                    const float yv = bf2f(*(const u16*)(base + rl * 144 + (n * 16 + fr) * 2));
                    const u16 ob = f2bf(yv * sigmoidf_(acc[m][n][j] + bg[n]));
                    *(u16*)(base + rl * 144 + (n * 16 + fr) * 2) = ob;
                    const float of = bf2f(ob);
                    sq += of * of;
                }
                sq = sum16(sq);
                if (fr == 0) unsafeAtomicAdd(WSP_rsq + (size_t)r * 2 + 1, sq);
            }
        asm volatile("s_waitcnt lgkmcnt(0)" ::: "memory");
        __builtin_amdgcn_wave_barrier();
        u16* dbase = WSP_SO + (size_t)row0 * 512 + col0;
#pragma unroll
        for (int i = 0; i < 8; ++i) {
            const int id = i * 64 + lane, row = id >> 3, ch = id & 7;
            *(uint4*)(dbase + (size_t)row * 512 + ch * 8) = *(const uint4*)(base + row * 144 + ch * 16);
        }
        asm volatile("s_waitcnt lgkmcnt(0)" ::: "memory");
        __builtin_amdgcn_wave_barrier();
    }
}

__device__ __forceinline__ void phase8(const Params& p) {
    const int NU = 512;
    for (int u = blockIdx.x; u < NU; u += gridDim.x) {
        const int mt = (u & 7) + 8 * (u >> 5), nt = (u >> 3) & 3;
        const u16* A1 = WSP_AO + (size_t)mt * 128 * 512;
        const u16* A2 = WSP_SO + (size_t)mt * 128 * 512;
        const u16* B = WSP_WoutT + (size_t)nt * 256 * 1024;
        f32x4 acc[4][8];
        {
        const int tid1 = TIDX, fq = (tid1 & 63) >> 4, row0 = mt * 128 + (tid1 >> 7) * 64;
        gemm_tile_w(32,
            [&](int i, int R, int C, int kt) { return (const void*)((kt < 16 ? A1 : A2) + (size_t)R * 512 + (kt & 15) * 32 + C); },
            [&](int i, int R, int C, int kt) { return (const void*)(B + (size_t)R * 1024 + kt * 32 + C); }, acc,
            [&](int kt) {
                if (kt == 16) {
#pragma unroll
                    for (int m = 0; m < 4; ++m) {
                        asm volatile("" ::: "memory");
#pragma unroll
                        for (int j = 0; j < 4; ++j) {
                            const float2 q = *(const float2*)(WSP_rsq + (size_t)(row0 + m * 16 + fq * 4 + j) * 2);
                            const float ratio = rsqrtf(q.x * (1.f / 512.f) + EPS) / rsqrtf(q.y * (1.f / 512.f) + EPS);
#pragma unroll
                            for (int n = 0; n < 8; ++n) acc[m][n][j] *= ratio;
                        }
                    }
                }
            });
        }
        const int tid2 = TIDX, lane = tid2 & 63, wid = tid2 >> 6, fr = lane & 15, fq = lane >> 4;
        const int row0 = mt * 128 + (wid >> 1) * 64, col0 = nt * 256 + (wid & 1) * 128;
        const float* g1 = WSP_mod + (mt >> 4) * 6144 + 2048 + col0;
        float* stg = (float*)(smem + wid * 8448);
#pragma unroll
        for (int m = 0; m < 4; ++m) {
#pragma unroll
            for (int n = 0; n < 8; ++n)
#pragma unroll
                for (int j = 0; j < 4; ++j) stg[(fq * 4 + j) * 132 + n * 16 + fr] = acc[m][n][j];
            asm volatile("s_waitcnt lgkmcnt(0)" ::: "memory");
            __builtin_amdgcn_wave_barrier();
#pragma unroll
            for (int i = 0; i < 8; ++i) {
                const int id = i * 64 + lane, rr = id >> 5, c4 = (id & 31) * 4;
                float4 v = *(const float4*)(stg + rr * 132 + c4);
                const float rsv = rsqrtf(WSP_rsq[(size_t)(row0 + m * 16 + rr) * 2 + 1] * (1.f / 512.f) + EPS);
                v.x *= rsv; v.y *= rsv; v.z *= rsv; v.w *= rsv;
                const float4 g = *(const float4*)(g1 + c4);
                const size_t o = (size_t)(row0 + m * 16 + rr) * 1024 + col0 + c4;
                const float4 xv = *(const float4*)(p.x + o);
                *(float4*)(p.out + o) = make_float4(xv.x + g.x * v.x, xv.y + g.y * v.y, xv.z + g.z * v.z, xv.w + g.w * v.w);
            }
            asm volatile("s_waitcnt lgkmcnt(0)" ::: "memory");
            __builtin_amdgcn_wave_barrier();
        }
    }
}

#define CTR_ECNT 0
#define CTR_Q11 128
#define CTR_Q12 136
#define HALF_TOK 8192
#define HH_HALF_ROWS 73728
#define ELIST_CAP 8192
template <int LEVEL>
__device__ __forceinline__ void phase9_t(const Params& p) {
    const int tid = TIDX, lane = tid & 63, wid = tid >> 6, fr = lane & 15, fq = lane >> 4;
    char* At = smem;
    float* sc = (float*)(smem + 65536);
    int* hist = (int*)(smem + 65536 + 8192);
    int* gbase = hist + 64;
    int* fill = gbase + 64;
    unsigned char* selk = (unsigned char*)(fill + 64);
    float* selw = (float*)(selk + 256);
    for (int chunk = blockIdx.x; chunk < NLAT / 32; chunk += gridDim.x) {
        const int tok0 = chunk * 32;
        __syncthreads();
        if (tid < 64) hist[tid] = 0;
#pragma unroll 1
        for (int hb = 0; hb < 2; ++hb) {
            float4 vall[4][4];
#pragma unroll
            for (int rr = 0; rr < 4; ++rr)
#pragma unroll
                for (int i = 0; i < 4; ++i) vall[rr][i] = *(const float4*)(p.out + (size_t)(tok0 + wid * 8 + hb * 4 + rr) * 1024 + i * 256 + lane * 4);
#pragma unroll
            for (int rr = 0; rr < 4; ++rr) {
                const int row = wid * 8 + hb * 4 + rr, tok = tok0 + row;
                const float* md = WSP_mod + (tok >> 11) * 6144;
                float ss = 0.f;
#pragma unroll
                for (int i = 0; i < 4; ++i) ss += vall[rr][i].x * vall[rr][i].x + vall[rr][i].y * vall[rr][i].y + vall[rr][i].z * vall[rr][i].z + vall[rr][i].w * vall[rr][i].w;
                ss = wave_sum(ss);
                const float rs = rsqrtf(ss * (1.f / 1024.f) + EPS);
#pragma unroll
                for (int i = 0; i < 4; ++i) {
                    const int c0 = i * 256 + lane * 4;
                    const float4 v = vall[rr][i];
                    const float4 g = *(const float4*)(p.norm_ffn + c0), s = *(const float4*)(md + 3072 + c0), k = *(const float4*)(md + 4096 + c0);
                    const float a = v.x * rs * g.x * (1.f + k.x) + s.x, b = v.y * rs * g.y * (1.f + k.y) + s.y;
                    const float c = v.z * rs * g.z * (1.f + k.z) + s.z, d = v.w * rs * g.w * (1.f + k.w) + s.w;
                    const uint2 pk = make_uint2(pack2(a, b), pack2(c, d));
                    *(uint2*)(WSP_H2 + (size_t)tok * 1024 + c0) = pk;
                    const int ch = c0 >> 3;
                    *(uint2*)(At + row * 2048 + ((ch ^ (row & 15)) << 4) + ((c0 & 4) << 1)) = pk;
                }
            }
        }
        __syncthreads();
        if (LEVEL == 1) continue;
        {
            f32x4 acc0 = {0.f, 0.f, 0.f, 0.f}, acc1 = {0.f, 0.f, 0.f, 0.f};
            const u16* bp = WSP_WrT + (size_t)(wid * 16 + fr) * 1024 + fq * 8;
#pragma unroll
            for (int kb = 0; kb < 4; ++kb) {
                bf16x8 bfr[8];
#pragma unroll
                for (int q = 0; q < 8; ++q) bfr[q] = *(const bf16x8*)(bp + (kb * 8 + q) * 32);
#pragma unroll
                for (int q = 0; q < 8; ++q) {
                    const int ch = (kb * 8 + q) * 4 + fq;
                    const bf16x8 a0 = *(const bf16x8*)(At + fr * 2048 + ((ch ^ fr) << 4));
                    const bf16x8 a1 = *(const bf16x8*)(At + (16 + fr) * 2048 + ((ch ^ fr) << 4));
                    acc0 = __builtin_amdgcn_mfma_f32_16x16x32_bf16(a0, bfr[q], acc0, 0, 0, 0);
                    acc1 = __builtin_amdgcn_mfma_f32_16x16x32_bf16(a1, bfr[q], acc1, 0, 0, 0);
                }
            }
#pragma unroll
            for (int j = 0; j < 4; ++j) {
                sc[(fq * 4 + j) * 64 + wid * 16 + fr] = sigmoidf_(acc0[j]);
                sc[(16 + fq * 4 + j) * 64 + wid * 16 + fr] = sigmoidf_(acc1[j]);
            }
        }
        __syncthreads();
        if (LEVEL == 2) continue;
        const float bias = p.router_bias[lane];
        const int eg = lane >> 3;
#pragma unroll 2
        for (int rr = 0; rr < 8; ++rr) {
            const int row = wid * 8 + rr;
            const float s = sc[row * 64 + lane];
            const float bz = s + bias;
            const float m1 = max8(bz);
            const unsigned long long eq = __ballot(bz == m1);
            const unsigned gb = (unsigned)((eq >> (eg * 8)) & 0xffull);
            const int first = __ffs(gb) - 1;
            const float v2 = max8(((lane & 7) == first) ? -1e30f : bz);
            const float gs = m1 + v2;
            int cnt = 0;
#pragma unroll
            for (int j = 0; j < 8; ++j) {
                const float gj = __int_as_float(__builtin_amdgcn_readlane(__float_as_int(gs), j * 8));
                cnt += (gj > gs || (gj == gs && j < eg)) ? 1 : 0;
            }
            const bool gsel = cnt < 4;
            const float mv = gsel ? bz : -1e30f;
            unsigned long long gm = __ballot(gsel);
            int rank = 0;
#pragma unroll 1
            for (int it = 0; it < 4; ++it) {
                const int jb = __builtin_amdgcn_readfirstlane(__ffsll((long long)gm) - 1);
                gm &= ~(0xffull << jb);
#pragma unroll
                for (int j = 0; j < 8; ++j) {
                    const float vj = __int_as_float(__builtin_amdgcn_readlane(__float_as_int(mv), jb + j));
                    rank += (vj > mv || (vj == mv && (jb + j) < lane)) ? 1 : 0;
                }
            }
            const bool sel = gsel && rank < 8;
            unsigned long long sm = __ballot(sel);
            float tot = 0.f;
#pragma unroll 1
            for (int it = 0; it < 8; ++it) {
                const int l = __builtin_amdgcn_readfirstlane(__ffsll((long long)sm) - 1);
                sm &= sm - 1;
                tot += __int_as_float(__builtin_amdgcn_readlane(__float_as_int(s), l));
            }
            if (sel) {
                selw[row * 8 + rank] = s / tot * 2.5f;
                selk[row * 8 + rank] = (unsigned char)lane;
                atomicAdd(&hist[lane], 1);
            }
        }
        __syncthreads();
        const int h = tok0 >> 13;
        if (tid < 64) {
            gbase[tid] = hist[tid] ? (int)atomicAdd(&WSP_ctr[CTR_ECNT + h * 64 + tid], (unsigned)hist[tid]) : 0;
            fill[tid] = 0;
        }
        __syncthreads();
        {
            const int e = selk[tid];
            const int pos = atomicAdd(&fill[e], 1);
            WSP_elist[(size_t)(h * 64 + e) * ELIST_CAP + gbase[e] + pos] = (tok0 + (tid >> 3)) * 8 + (tid & 7);
            WSP_wsl[(size_t)(h * 64 + e) * ELIST_CAP + gbase[e] + pos] = selw[tid];
        }
    }
}

struct MoeTab { int cnt[16]; int soff[16]; int pre[17]; };

template <class FV, class FD>
__device__ __forceinline__ void wave_store_fp8_f(FV val, FD dst) {
    const int lane = TIDX & 63, wid = TIDX >> 6, fr = lane & 15, fq = lane >> 4;
    char* base = smem + wid * 9216;
#pragma unroll
    for (int m = 0; m < 4; ++m)
#pragma unroll
        for (int n = 0; n < 8; ++n)
#pragma unroll
            for (int j = 0; j < 4; ++j)
                *(unsigned char*)(base + (m * 16 + fq * 4 + j) * 144 + n * 16 + fr) =
                    (unsigned char)(__builtin_amdgcn_cvt_pk_fp8_f32(val(m, n, j), 0.f, 0, false) & 0xff);
    asm volatile("s_waitcnt lgkmcnt(0)" ::: "memory");
    __builtin_amdgcn_wave_barrier();
#pragma unroll
    for (int i = 0; i < 8; ++i) {
        const int id = i * 64 + lane, row = id >> 3, ch = id & 7;
        const uint4 d = *(const uint4*)(base + row * 144 + ch * 16);
        unsigned char* q = dst(i, row);
        if (q) { const u32x4 t = {d.x, d.y, d.z, d.w}; __builtin_nontemporal_store(t, (u32x4*)(q + ch * 16)); }
    }
    asm volatile("s_waitcnt lgkmcnt(0)" ::: "memory");
    __builtin_amdgcn_wave_barrier();
}

#define YD_SCALE 8.0f
template <int MODE>
__device__ __forceinline__ void phase11f(const Params& p) {
    const int tid = TIDX;
    int* tab = (int*)(smem + 73728);
    int* t_cnt = tab, *t_soff = tab + 16, *t_pre = tab + 32, *t_q = tab + 52;
    int* t_all = tab + 64;
    const int x = blockIdx.x & 7;
    unsigned* flags = WSP_flag + x * FLAG_PER_CLASS;
    unsigned* tmo = WSP_flag + 8 * FLAG_PER_CLASS;
    unsigned char* Yd8 = (unsigned char*)(p.ws + OFF_ARENA);
    __syncthreads();
    if (tid < 128) t_all[tid] = (int)WSP_ctr[CTR_ECNT + tid];
    unsigned* qhead = &WSP_ctr[(MODE == 2 ? CTR_Q12 : CTR_Q11) + x];
    if (tid == 0) { t_q[0] = (int)atomicAdd(qhead, 1u); t_q[2] = 0; }
    __syncthreads();
    if (tid < 16) {
        const int i = tid >> 1, h = tid & 1, e = x + 8 * i;
        t_cnt[tid] = t_all[h * 64 + e];
        int so = 0;
        for (int e2 = 0; e2 < e; ++e2) so += t_all[h * 64 + e2];
        t_soff[tid] = so;
    }
    __syncthreads();
    if (tid == 0) {
        int s = 0;
        for (int j = 0; j < 16; ++j) { t_pre[j] = s; s += (t_cnt[j] + 127) >> 7; }
        t_pre[16] = s;
    }
    __syncthreads();
    const int T_r = t_pre[16], T11 = T_r + 16, T_all = (MODE == 1) ? T11 : T11 + T_r * 4;
    for (;;) {
        __syncthreads();
        const int q = __builtin_amdgcn_readfirstlane(t_q[0]) + (MODE == 2 ? T11 : 0);
        const int pre_flag = __builtin_amdgcn_readfirstlane(t_q[2]);
        __syncthreads();
        if (q >= T_all) break;
        int qn = 0; unsigned fl = 0u;
        if (tid == 0) qn = (int)atomicAdd(qhead, 1u) + (MODE == 2 ? T11 : 0);
        const bool is_down = q >= T11;
        const int u = is_down ? (q - T11) >> 2 : q;
        int nt = is_down ? (q - T11) & 3 : 0;
        int e, h, mt, c, rowbase;
        if (u < T_r) {
            int j = 0;
#pragma unroll
            for (int qq = 1; qq < 16; ++qq) j += (u >= t_pre[qq]) ? 1 : 0;
            e = x + 8 * (j >> 1); h = j & 1; mt = u - t_pre[j]; c = t_cnt[j];
            rowbase = h * HH_HALF_ROWS + t_soff[j];
        } else {
            const int ms = x * 16 + (u - T_r);
            e = 64; h = ms >> 6; mt = ms & 63; c = HALF_TOK;
            rowbase = h * HH_HALF_ROWS + 65536;
        }
        e = __builtin_amdgcn_readfirstlane(e); h = __builtin_amdgcn_readfirstlane(h); mt = __builtin_amdgcn_readfirstlane(mt);
        nt = __builtin_amdgcn_readfirstlane(nt); c = __builtin_amdgcn_readfirstlane(c); rowbase = __builtin_amdgcn_readfirstlane(rowbase);
        const int* el = WSP_elist + (size_t)(h * 64 + (e & 63)) * ELIST_CAP;
        if (!is_down) {
            const int t2 = TIDX, lane = t2 & 63, wid = t2 >> 6, wr = wid >> 1, wc = wid & 1, fr = lane & 15, fq = lane >> 4;
            const int sb = lane * 16, swz = sb ^ (((sb >> 9) & 1) << 5);
            const int r_in = swz >> 6, c_in = (swz & 63) >> 1;
            const int vrows = c - mt * 128 - wr * 64;
            const float* wsl = WSP_wsl + (size_t)(h * 64 + (e & 63)) * ELIST_CAP;
            const u16* aptr[2];
#pragma unroll
            for (int i = 0; i < 2; ++i) {
                int li = mt * 128 + (wid + 4 * i) * 16 + r_in;
                li = li < c ? li : c - 1;
                const int tok = (e < 64) ? (el[li] >> 3) : (h * HALF_TOK + li);
                aptr[i] = WSP_H2 + (size_t)tok * 1024 + c_in;
            }
            const u16* Bw = WSP_WguT + (size_t)e * 262144 + c_in;
            f32x4 acc[4][8];
            gemm_tile_w(32,
                [&](int i, int R, int C, int kt) { return (const void*)(aptr[i] + kt * 32); },
                [&](int i, int R, int C, int kt) { return (const void*)(Bw + (size_t)R * 1024 + kt * 32); }, acc);
            if (MODE == 0 && tid == 0 && qn >= T11 && qn < T_all) fl = __hip_atomic_load(&flags[(qn - T11) >> 2], __ATOMIC_RELAXED, __HIP_MEMORY_SCOPE_AGENT);
            float wgt[4][4];
#pragma unroll
            for (int m = 0; m < 4; ++m)
#pragma unroll
                for (int j = 0; j < 4; ++j) {
                    const int li = mt * 128 + wr * 64 + m * 16 + fq * 4 + j;
                    float w = 1.f;
                    if (e < 64) w = (li < c) ? wsl[li] : 0.f;
                    wgt[m][j] = w;
                }
            u16* dbase = WSP_HHs + ((size_t)rowbase + mt * 128 + wr * 64) * 128 + wc * 64;
            wave_store_bf16_f([&](int m, int n2, int j) { return siluf_(acc[m][2 * n2][j]) * acc[m][2 * n2 + 1][j] * wgt[m][j]; },
                              [&](int row) { return row < vrows ? dbase + (size_t)row * 128 : (u16*)nullptr; }, true, (const char*)WSP_HHs, (unsigned)((size_t)2 * HH_HALF_ROWS * 128 * 2));
            asm volatile("s_waitcnt vmcnt(0)" ::: "memory");
            __syncthreads();
            if (tid == 0) __hip_atomic_store(&flags[u], 1u, __ATOMIC_RELAXED, __HIP_MEMORY_SCOPE_AGENT);
        } else {
            const int t2 = TIDX, lane = t2 & 63, wid = t2 >> 6, wr = wid >> 1, wc = wid & 1, fr = lane & 15, fq = lane >> 4;
            const int sb = lane * 16, swz = sb ^ (((sb >> 9) & 1) << 5);
            const int r_in = swz >> 6, c_in = (swz & 63) >> 1;
            const int vrows = c - mt * 128 - wr * 64;
            if (MODE == 0 && tid == 0 && pre_flag == 0) {
                unsigned sp = 0;
                while (__hip_atomic_load(&flags[u], __ATOMIC_RELAXED, __HIP_MEMORY_SCOPE_AGENT) == 0u) {
                    __builtin_amdgcn_s_sleep(2);
                    if ((++sp & 255u) == 0u) {
                        if (__hip_atomic_load(tmo, __ATOMIC_RELAXED, __HIP_MEMORY_SCOPE_AGENT)) break;
                        if (sp > (1u << 20)) { atomicAdd(tmo, 1u); break; }
                    }
                }
            }
            __syncthreads();
            const u16* aptr[2];
#pragma unroll
            for (int i = 0; i < 2; ++i) {
                int li = mt * 128 + (wid + 4 * i) * 16 + r_in;
                li = li < c ? li : c - 1;
                aptr[i] = WSP_HHs + ((size_t)rowbase + li) * 128 + c_in;
            }
            const u16* Bw = WSP_WdT + ((size_t)e * 1024 + nt * 256) * 128 + c_in;
            int slot[8];
            if (e < 64) {
#pragma unroll
                for (int i = 0; i < 8; ++i) {
                    int li = mt * 128 + wr * 64 + ((i * 64 + lane) >> 3);
                    li = li < c ? li : c - 1;
                    slot[i] = el[li];
                }
            } else {
#pragma unroll
                for (int i = 0; i < 8; ++i) slot[i] = (h * HALF_TOK + mt * 128 + wr * 64 + ((i * 64 + lane) >> 3)) * 8;
            }
            f32x4 acc[4][8];
            gemm_tile_w<true>(4,
                [&](int i, int R, int C, int kt) { return (const void*)(aptr[i] + kt * 32); },
                [&](int i, int R, int C, int kt) { return (const void*)(Bw + (size_t)R * 128 + kt * 32); }, acc);
            if (MODE == 0 && tid == 0 && qn >= T11 && qn < T_all) fl = __hip_atomic_load(&flags[(qn - T11) >> 2], __ATOMIC_RELAXED, __HIP_MEMORY_SCOPE_AGENT);
            const int colo = nt * 256 + wc * 128;
            if (e < 64) {
                wave_store_fp8_f([&](int m, int n, int j) { return acc[m][n][j] * YD_SCALE; }, [&](int i, int row) {
                    if (row >= vrows) return (unsigned char*)nullptr;
                    const int s = slot[i];
                    return Yd8 + ((size_t)(s >> 3) * 8 + (s & 7)) * 1024 + colo;
                });
            } else {
                const int tok0 = h * HALF_TOK + mt * 128 + wr * 64;
                const float* g2 = WSP_mod + (tok0 >> 11) * 6144 + 5120 + colo;
                float* stg = (float*)(smem + wid * 8448);
#pragma unroll
                for (int m = 0; m < 4; ++m) {
#pragma unroll
                    for (int n = 0; n < 8; ++n)
#pragma unroll
                        for (int j = 0; j < 4; ++j) stg[(fq * 4 + j) * 132 + n * 16 + fr] = acc[m][n][j];
                    asm volatile("s_waitcnt lgkmcnt(0)" ::: "memory");
                    __builtin_amdgcn_wave_barrier();
#pragma unroll
                    for (int i = 0; i < 8; ++i) {
                        const int id = i * 64 + lane, rr = id >> 5, c4 = (id & 31) * 4;
                        const float4 v = *(const float4*)(stg + rr * 132 + c4);
                        const float4 g = *(const float4*)(g2 + c4);
                        float* op = p.out + (size_t)(tok0 + m * 16 + rr) * 1024 + colo + c4;
                        const float4 xv = *(const float4*)op;
                        *(float4*)op = make_float4(xv.x + g.x * v.x, xv.y + g.y * v.y, xv.z + g.z * v.z, xv.w + g.w * v.w);
                    }
                    asm volatile("s_waitcnt lgkmcnt(0)" ::: "memory");
                    __builtin_amdgcn_wave_barrier();
                }
            }
        }
        if (tid == 0) { t_q[0] = qn - (MODE == 2 ? T11 : 0); t_q[2] = (int)fl; }
    }
}

#define P12_SLD 2064
template <bool DUMMY>
__device__ __forceinline__ void phase12b_t(const Params& p) {
    const int tid = TIDX, lane = tid & 63, wid = tid >> 6, fr = lane & 15, fq = lane >> 4;
    const unsigned char* Yd8 = (const unsigned char*)(p.ws + OFF_ARENA);
    const u16* Wb = WSP_WdT + (size_t)64 * 131072 + (size_t)(wid * 256 + fr) * 128 + fq * 8;
    for (int tile = blockIdx.x; tile < NLAT / 32; tile += gridDim.x) {
        const int tok0 = tile * 32;
        const int hh = tok0 >> 13;
        const u16* Ab = WSP_HHs + ((size_t)hh * HH_HALF_ROWS + 65536 + (tok0 & 8191) + fr) * 128 + fq * 8;
        __syncthreads();
        bf16x8 af[2][4];
#pragma unroll
        for (int m = 0; m < 2; ++m)
#pragma unroll
            for (int ks = 0; ks < 4; ++ks) af[m][ks] = *(const bf16x8*)(Ab + (size_t)m * 16 * 128 + ks * 32);
#pragma unroll 1
        for (int nb = 0; nb < 4; ++nb) {
            bf16x8 bfr[4][4];
#pragma unroll
            for (int n = 0; n < 4; ++n)
#pragma unroll
                for (int ks = 0; ks < 4; ++ks) bfr[n][ks] = *(const bf16x8*)(Wb + (size_t)((nb * 4 + n) * 16) * 128 + ks * 32);
#pragma unroll
            for (int m = 0; m < 2; ++m)
#pragma unroll
                for (int n = 0; n < 4; ++n) {
                    f32x4 d = {0.f, 0.f, 0.f, 0.f};
#pragma unroll
                    for (int ks = 0; ks < 4; ++ks) d = __builtin_amdgcn_mfma_f32_16x16x32_bf16(af[m][ks], bfr[n][ks], d, 0, 0, 0);
                    const int col = wid * 256 + (nb * 4 + n) * 16 + fr;
#pragma unroll
                    for (int j = 0; j < 4; ++j) *(u16*)(smem + (m * 16 + fq * 4 + j) * P12_SLD + col * 2) = f2bf(d[j]);
                }
        }
        __syncthreads();
        for (int rr = 0; rr < 8; ++rr) {
            const int row = wid * 8 + rr, tok = tok0 + row;
            float* xrow = p.out + (size_t)tok * 1024 + lane * 16;
            float* orow = DUMMY ? (float*)(p.ws + OFF_HHS) + (size_t)(tok & 8191) * 1024 + lane * 16 : xrow;
            const float* g2 = WSP_mod + (tok >> 11) * 6144 + 5120 + lane * 16;
            float s[16];
#pragma unroll
            for (int i = 0; i < 16; ++i) s[i] = 0.f;
            const unsigned char* yp = Yd8 + (size_t)tok * 8 * 1024 + lane * 16;
            uint4 yv[8];
#pragma unroll
            for (int k = 0; k < 8; ++k) { const u32x4 t = __builtin_nontemporal_load((const u32x4*)(yp + k * 1024)); yv[k] = make_uint4(t[0], t[1], t[2], t[3]); }
#pragma unroll
            for (int k = 0; k < 8; ++k) {
                const unsigned w[4] = {yv[k].x, yv[k].y, yv[k].z, yv[k].w};
#pragma unroll
                for (int i = 0; i < 4; ++i) {
                    const auto lo = __builtin_amdgcn_cvt_pk_f32_fp8((int)w[i], false);
                    const auto hi = __builtin_amdgcn_cvt_pk_f32_fp8((int)w[i], true);
                    s[4 * i] += lo[0]; s[4 * i + 1] += lo[1]; s[4 * i + 2] += hi[0]; s[4 * i + 3] += hi[1];
                }
            }
            const uint4 sa = *(const uint4*)(smem + row * P12_SLD + lane * 32), sbv = *(const uint4*)(smem + row * P12_SLD + lane * 32 + 16);
            const unsigned sw[8] = {sa.x, sa.y, sa.z, sa.w, sbv.x, sbv.y, sbv.z, sbv.w};
#pragma unroll
            for (int i = 0; i < 8; ++i) {
                s[2 * i] = s[2 * i] * (1.f / YD_SCALE) + bf2f((u16)(sw[i] & 0xffffu));
                s[2 * i + 1] = s[2 * i + 1] * (1.f / YD_SCALE) + bf2f((u16)(sw[i] >> 16));
            }
            float ss = 0.f;
#pragma unroll
            for (int q = 0; q < 4; ++q) {
                const float4 xv = *(const float4*)(xrow + q * 4), gv = *(const float4*)(g2 + q * 4);
                s[4 * q] = xv.x + gv.x * s[4 * q]; s[4 * q + 1] = xv.y + gv.y * s[4 * q + 1];
                s[4 * q + 2] = xv.z + gv.z * s[4 * q + 2]; s[4 * q + 3] = xv.w + gv.w * s[4 * q + 3];
                ss += s[4 * q] * s[4 * q] + s[4 * q + 1] * s[4 * q + 1] + s[4 * q + 2] * s[4 * q + 2] + s[4 * q + 3] * s[4 * q + 3];
            }
            ss = wave_sum(ss);
            const float rs = rsqrtf(ss * (1.f / 1024.f) + EPS);
#pragma unroll
            for (int q = 0; q < 4; ++q) {
                const float4 g = *(const float4*)(p.norm_final + lane * 16 + q * 4);
                *(float4*)(orow + q * 4) = make_float4(s[4 * q] * rs * g.x, s[4 * q + 1] * rs * g.y, s[4 * q + 2] * rs * g.z, s[4 * q + 3] * rs * g.w);
            }
        }
    }
}

#define SMEM_TOTAL (73728 + 3072 + 64)

#if 1
__global__ void __launch_bounds__(NTHR, 2) k_mega(Params p) {
    volatile LAS unsigned* st = (volatile LAS unsigned*)(smem + SMEM_TOTAL - 16);
    if (TIDX == 0) { st[0] = 0u; st[1] = 0u; st[2] = 0u; st[3] = 0u; }
    __syncthreads();
    XcdBarrier bar = xcd_barrier_post(WSP_bar, st);
#define RUNP(N) do { phase##N(p); if (PROBE_DUP == N) phase##N(p); } while (0)
    RUNP(0);  xcd_barrier(bar);
    RUNP(1);  xcd_barrier(bar);
    RUNP(2);  xcd_barrier(bar);
    RUNP(3);  xcd_barrier(bar);
    RUNP(4);  xcd_barrier(bar);
    RUNP(5);  xcd_barrier(bar);
    RUNP(6);  xcd_barrier(bar);
    RUNP(8);  xcd_barrier(bar);
#if PROBE_DUP == 91
    phase9_t<1>(p); xcd_barrier(bar);
#endif
#if PROBE_DUP == 92
    phase9_t<2>(p); xcd_barrier(bar);
#endif
    phase9_t<0>(p); xcd_barrier(bar);
#if PROBE_DUP == 9
    if (blockIdx.x == 0 && TIDX < 128) WSP_ctr[CTR_ECNT + TIDX] = 0u;
    xcd_barrier(bar); phase9_t<0>(p); xcd_barrier(bar);
#endif
#ifndef MOE_FUSED
#define MOE_FUSED 1
#endif
#if MOE_FUSED
    phase11f<0>(p); xcd_barrier(bar);
#else
    phase11f<1>(p); xcd_barrier(bar);
    phase11f<2>(p); xcd_barrier(bar);
#endif
#if PROBE_DUP == 11
    if (blockIdx.x == 0 && TIDX < 8) WSP_ctr[CTR_Q11 + TIDX] = 0u;
    if (blockIdx.x == 1) for (int i = TIDX; i < 8 * FLAG_PER_CLASS; i += NTHR) WSP_flag[i] = 0u;
    xcd_barrier(bar); phase11f<0>(p); xcd_barrier(bar);
#endif
#if PROBE_DUP == 121
    phase12b_t<true>(p); xcd_barrier(bar);
#endif
    phase12b_t<false>(p);
}
#endif


extern "C" void kernel_launch(void* const* d_in, const int* in_sizes, int n_in,
                              void* d_out, int out_size, void* d_ws, size_t ws_size,
                              hipStream_t stream) {
    Params p{};
    const float** ip = (const float**)&p.x;
    for (int i = 0; i < 32; ++i) ip[i] = (const float*)d_in[i];
    p.out = (float*)d_out;
    p.ws = (char*)d_ws;
    if (OFF_END > ws_size) { fprintf(stderr, "workspace too small: need %zu have %zu\n", (size_t)OFF_END, ws_size); return; }

    static int grid = 0;
    if (!grid) {
        hipFuncSetAttribute((const void*)k_mega, hipFuncAttributeMaxDynamicSharedMemorySize, SMEM_TOTAL);
        int dev = 0, cus = 0, per_cu = 0;
        hipGetDevice(&dev);
        hipDeviceGetAttribute(&cus, hipDeviceAttributeMultiprocessorCount, dev);
        hipOccupancyMaxActiveBlocksPerMultiprocessor(&per_cu, (const void*)k_mega, NTHR, SMEM_TOTAL);
        if (per_cu < 1) per_cu = 1;
        grid = cus * (per_cu < 2 ? per_cu : 2);
    }
    hipMemsetAsync(p.ws + OFF_BAR, 0, ZERO_BYTES, stream);
    k_mega<<<grid, NTHR, SMEM_TOTAL, stream>>>(p);
}
```

```cpp
#include <hip/hip_runtime.h>
#include <hip/hip_bf16.h>
#include <stdint.h>
#include <stdio.h>

#ifndef MK_MULTI
#define MK_MULTI 0
#endif

typedef __attribute__((ext_vector_type(8))) short bf16x8;
typedef __attribute__((ext_vector_type(4))) short bf16x4;
typedef __attribute__((ext_vector_type(4))) float f32x4;
typedef unsigned short u16;
typedef __attribute__((ext_vector_type(4))) unsigned u32x4;

#ifndef PROBE_DUP
#define PROBE_DUP -1
#endif
#define NTHR 256
__device__ __forceinline__ int opaque_tid() { int t = (int)threadIdx.x; asm volatile("" : "+v"(t)); return t; }
#define TIDX opaque_tid()
#define LDS_BYTES 65536

#define D_MODEL 1024
#define BATCH 8
#define SEQ 2048
#define CTXL 256
#define NLAT (BATCH * SEQ)
#define NCTX (BATCH * CTXL)
#define NROWS (NLAT + NCTX)
#define INW 1280
#define NEXP 64
#define VT_LD (SEQ + CTXL)
#define NCHUNK_LAT 1024
#define NCHUNK_ALL 1152
#define EPS 1e-6f

#define XB_TMO      128
#define XB_XCNT(j)  (256  + 64 * (j))
#define XB_XSUB(j)  (1280 + 64 * (j))
#define XB_XGEN(j)  (2304 + 64 * (j))
#define XB_TOP      3328
#define XB_TOPGEN   3392
#define XCD_BAR_WORDS 3456
#define XB_SPIN_CAP (1u << 20)
#define LAS __attribute__((address_space(3)))

__device__ __forceinline__ unsigned xb_ld(unsigned* p)              { return __hip_atomic_load(p, __ATOMIC_RELAXED, __HIP_MEMORY_SCOPE_AGENT); }
__device__ __forceinline__ unsigned xb_add(unsigned* p, unsigned v) { return __hip_atomic_fetch_add(p, v, __ATOMIC_RELAXED, __HIP_MEMORY_SCOPE_AGENT); }
__device__ __forceinline__ unsigned xb_xcc_id() { return (unsigned)__builtin_amdgcn_s_getreg((3 << 11) | 20) & 0xFu; }
#define XB_SPIN(cond, bar) do { unsigned _sp = 0; while (cond) { __builtin_amdgcn_s_sleep(1); \
    if ((++_sp & 255u) == 0u) { if (xb_ld(&(bar)[XB_TMO])) break; if (_sp > XB_SPIN_CAP) { atomicAdd(&(bar)[XB_TMO], 1u); break; } } } } while (0)

struct XcdBarrier { unsigned* bar; unsigned x; volatile LAS unsigned* st; };

__device__ __forceinline__ XcdBarrier xcd_barrier_post(unsigned* bar, volatile LAS unsigned* st) {
    XcdBarrier b; b.bar = bar; b.x = xb_xcc_id(); b.st = st;
    if (TIDX == 0) (void)xb_add(&bar[XB_XCNT(b.x)], 1u);
    return b;
}
__device__ __forceinline__ void xcd_barrier_complete(unsigned* bar, unsigned x, unsigned& nloc, unsigned& nx) {
    const unsigned G = gridDim.x * gridDim.y * gridDim.z;
    unsigned sum, cnt, mine, sp = 0u;
    for (;;) {
        sum = 0u; cnt = 0u; mine = 0u;
#pragma unroll
        for (unsigned j = 0; j < 16; ++j) { const unsigned c = xb_ld(&bar[XB_XCNT(j)]); sum += c; cnt += (c > 0u) ? 1u : 0u; mine = (j == x) ? c : mine; }
        if (sum == G) break;
        __builtin_amdgcn_s_sleep(1);
        if ((++sp & 255u) == 0u) { if (xb_ld(&bar[XB_TMO])) break; if (sp > XB_SPIN_CAP) { atomicAdd(&bar[XB_TMO], 1u); break; } }
    }
    nloc = mine > 0u ? mine : 1u; nx = cnt > 0u ? cnt : 1u;
}
__device__ __forceinline__ void xcd_barrier(const XcdBarrier& b) {
    asm volatile("s_waitcnt vmcnt(0)" ::: "memory");
    __syncthreads();
    if (TIDX == 0) {
        unsigned* bar = b.bar;
        __builtin_amdgcn_s_waitcnt(0);
        unsigned nloc = b.st[0], nx = b.st[1];
        if (nloc == 0u) { xcd_barrier_complete(bar, b.x, nloc, nx); b.st[0] = nloc; b.st[1] = nx; }
        const unsigned old = xb_add(&bar[XB_XSUB(b.x)], 1u);
        const unsigned gen = old / nloc;
        if (old + 1u == (gen + 1u) * nloc) {
            __builtin_amdgcn_fence(__ATOMIC_RELEASE, "agent");
            asm volatile("s_waitcnt vmcnt(0)" ::: "memory");
            const unsigned og = xb_add(&bar[XB_TOP], 1u);
            const unsigned tg = og / nx;
            if (og + 1u == (tg + 1u) * nx) xb_add(&bar[XB_TOPGEN], 1u);
            else XB_SPIN(xb_ld(&bar[XB_TOPGEN]) == tg, bar);
            __builtin_amdgcn_fence(__ATOMIC_ACQUIRE, "agent");
            xb_add(&bar[XB_XGEN(b.x)], 1u);
            asm volatile("s_waitcnt vmcnt(0)" ::: "memory");
        } else {
            XB_SPIN(xb_ld(&bar[XB_XGEN(b.x)]) == gen, bar);
            __builtin_amdgcn_fence(__ATOMIC_ACQUIRE, "agent");
            asm volatile("s_waitcnt vmcnt(0)" ::: "memory");
        }
    }
    __syncthreads();
}

struct Params {
    const float *x, *c, *ctx, *c_ctx, *w_ada, *b_ada, *norm_mix, *norm_ffn, *w_in, *attn_sink,
        *a_re, *a_im, *log_dt, *b_re, *b_im, *c_re, *c_im, *ssm_d, *w_glu, *b_glu, *norm_attn_out, *norm_ssm_out,
        *w_out, *w_router, *router_bias, *w_gate_e, *w_up_e, *w_down_e, *w_gate_s, *w_up_s, *w_down_s, *norm_final;
    float* out;
    char* ws;
};

constexpr size_t A256(size_t v) { return (v + 255) & ~(size_t)255; }
constexpr size_t OFF_BAR   = 0;
constexpr size_t OFF_RSQ   = A256(OFF_BAR + XCD_BAR_WORDS * 4 + 1024);
#define FLAG_PER_CLASS 1280
constexpr size_t OFF_FLAG  = OFF_RSQ + (size_t)NLAT * 2 * 4;
constexpr size_t ZERO_BYTES = OFF_FLAG + (8 * FLAG_PER_CLASS + 64) * 4;
constexpr size_t OFF_MOD   = A256(ZERO_BYTES);
constexpr size_t OFF_ROPE  = A256(OFF_MOD + 9 * 6144 * 4);
constexpr size_t OFF_KBUF  = A256(OFF_ROPE + 64 * 16 * 8);
constexpr size_t OFF_ELIST = A256(OFF_KBUF + (size_t)32 * 2 * 4096 * 4);
constexpr size_t OFF_WSL   = A256(OFF_ELIST + (size_t)2 * 64 * 8192 * 4);
constexpr size_t OFF_WDT   = A256(OFF_WSL + (size_t)2 * 64 * 8192 * 4);
constexpr size_t OFF_HHS   = A256(OFF_WDT + (size_t)65 * 1024 * 128 * 2);
constexpr size_t OFF_WGUT  = A256(OFF_HHS + (size_t)2 * 73728 * 128 * 2);
constexpr size_t OFF_H2R   = A256(OFF_WGUT + (size_t)65 * 256 * 1024 * 2);
constexpr size_t OFF_ARENA = A256(OFF_H2R + (size_t)NLAT * 1024 * 2);
constexpr size_t OFF_TABS  = OFF_ARENA;
constexpr size_t OFF_TABY  = A256(OFF_TABS + (size_t)32 * 256 * 256 * 2);
constexpr size_t OFF_R1    = A256(OFF_TABY + (size_t)32 * 256 * 512 * 2);
constexpr size_t OFF_R2    = A256(OFF_R1 + (size_t)NROWS * 1024 * 2);
constexpr size_t OFF_R4    = A256(OFF_R2 + (size_t)NLAT * 1024 * 2);
constexpr size_t OFF_WINT  = A256(OFF_R4 + (size_t)NLAT * 512 * 2 * 2);
constexpr size_t OFF_WGLUT = A256(OFF_WINT + (size_t)1280 * 1024 * 2);
constexpr size_t OFF_WOUTT = A256(OFF_WGLUT + (size_t)512 * 512 * 2);
constexpr size_t OFF_WRT   = A256(OFF_WOUTT + (size_t)1024 * 1024 * 2);
constexpr size_t OFF_EARLY_END = A256(OFF_WRT + (size_t)128 * 1024 * 2);
constexpr size_t YD8_BYTES = (size_t)NLAT * 8 * 1024;
constexpr size_t OFF_END   = (OFF_EARLY_END > OFF_ARENA + YD8_BYTES) ? OFF_EARLY_END : A256(OFF_ARENA + YD8_BYTES);
static_assert(OFF_END <= (size_t)256 * 1024 * 1024, "workspace map must fit the guaranteed 256 MiB");
#define CTR_QS1 160
#define WSP_bar   ((unsigned*)(p.ws + OFF_BAR))
#define WSP_ctr   ((unsigned*)(p.ws + OFF_BAR) + XCD_BAR_WORDS)
#define WSP_rsq   ((float*)(p.ws + OFF_RSQ))
#define WSP_flag  ((unsigned*)(p.ws + OFF_FLAG))
#define WSP_mod   ((float*)(p.ws + OFF_MOD))
#define WSP_rope  ((float2*)(p.ws + OFF_ROPE))
#define WSP_Kbuf  ((float*)(p.ws + OFF_KBUF))
#define WSP_elist ((int*)(p.ws + OFF_ELIST))
#define WSP_wsl   ((float*)(p.ws + OFF_WSL))
#define WSP_WinT  ((u16*)(p.ws + OFF_WINT))
#define WSP_WgluT ((u16*)(p.ws + OFF_WGLUT))
#define WSP_WoutT ((u16*)(p.ws + OFF_WOUTT))
#define WSP_WrT   ((u16*)(p.ws + OFF_WRT))
#define WSP_WdT   ((u16*)(p.ws + OFF_WDT))
#define WSP_HHs   ((u16*)(p.ws + OFF_HHS))
#define WSP_WguT  ((u16*)(p.ws + OFF_WGUT))
#define WSP_TabS  ((u16*)(p.ws + OFF_TABS))
#define WSP_TabY  ((u16*)(p.ws + OFF_TABY))
#define WSP_Hb    ((u16*)(p.ws + OFF_R1))
#define WSP_S     ((float*)(p.ws + OFF_R1))
#define WSP_H2    ((u16*)(p.ws + OFF_H2R))
#define WSP_Q     ((u16*)(p.ws + OFF_R2))
#define WSP_Kb    ((u16*)(p.ws + OFF_R2 + (size_t)NLAT * 512 * 2))
#define WSP_Vt    ((u16*)(p.ws + OFF_R2 + (size_t)NLAT * 512 * 2 + (size_t)NROWS * 128 * 2))
#define WSP_Y     ((u16*)(p.ws + OFF_R2))
#define WSP_SO    ((u16*)(p.ws + OFF_R2 + (size_t)NLAT * 512 * 2))
#define WSP_U     ((u16*)(p.ws + OFF_H2R))
#define WSP_AO    ((u16*)(p.ws + OFF_R4))
#define WSP_Hin   ((u16*)(p.ws + OFF_R4 + (size_t)NLAT * 512 * 2))

extern __shared__ __attribute__((aligned(16))) char smem[];

typedef __bf16 bf2_t __attribute__((ext_vector_type(2)));
typedef float f2_t __attribute__((ext_vector_type(2)));
__device__ __forceinline__ unsigned pack2(float a, float b) {
    const f2_t v = {a, b};
    return __builtin_bit_cast(unsigned, __builtin_convertvector(v, bf2_t));
}
__device__ __forceinline__ u16 f2bf(float f) { return (u16)(pack2(f, 0.f) & 0xffffu); }
__device__ __forceinline__ float bf2f(u16 h) { return __uint_as_float(((unsigned)h) << 16); }
__device__ __forceinline__ void glds16(const void* g, void* l) {
    __builtin_amdgcn_global_load_lds((const unsigned*)g, (unsigned*)l, 16, 0, 0);
}
__device__ __forceinline__ void glds16_sc1(const void* g, void* l) {
    __builtin_amdgcn_global_load_lds((const unsigned*)g, (unsigned*)l, 16, 0, 16);
}
__device__ __forceinline__ int lds_byte(int r, int c) {
    int st = (r >> 4) * 2 + (c >> 5), rr = r & 15, cc = c & 31, ob = rr * 64 + cc * 2;
    return st * 1024 + (ob ^ (((ob >> 9) & 1) << 5));
}
template <int CTRL> __device__ __forceinline__ float dppf(float v) {
    return __int_as_float(__builtin_amdgcn_update_dpp(0, __float_as_int(v), CTRL, 0xf, 0xf, true));
}
__device__ __forceinline__ float sum_x16(float v) {
    const unsigned u = __float_as_uint(v);
    const auto r = __builtin_amdgcn_permlane16_swap(u, u, false, false);
    return __uint_as_float(r[0]) + __uint_as_float(r[1]);
}
__device__ __forceinline__ float sum_x32(float v) {
    const unsigned u = __float_as_uint(v);
    const auto r = __builtin_amdgcn_permlane32_swap(u, u, false, false);
    return __uint_as_float(r[0]) + __uint_as_float(r[1]);
}
__device__ __forceinline__ float max_x16(float v) {
    const unsigned u = __float_as_uint(v);
    const auto r = __builtin_amdgcn_permlane16_swap(u, u, false, false);
    return fmaxf(__uint_as_float(r[0]), __uint_as_float(r[1]));
}
__device__ __forceinline__ float max_x32(float v) {
    const unsigned u = __float_as_uint(v);
    const auto r = __builtin_amdgcn_permlane32_swap(u, u, false, false);
    return fmaxf(__uint_as_float(r[0]), __uint_as_float(r[1]));
}
__device__ __forceinline__ float sum16(float v) {
    v += dppf<0xB1>(v);
    v += dppf<0x4E>(v);
    v += dppf<0x141>(v);
    v += dppf<0x140>(v);
    return v;
}
__device__ __forceinline__ float wave_sum(float v) { return sum_x32(sum_x16(sum16(v))); }
template <int CTRL> __device__ __forceinline__ float dpp_f(float v) {
    return __int_as_float(__builtin_amdgcn_update_dpp(0, __float_as_int(v), CTRL, 0xf, 0xf, true));
}
__device__ __forceinline__ float max8(float v) {
    v = fmaxf(v, dpp_f<0xB1>(v));
    v = fmaxf(v, dpp_f<0x4E>(v));
    v = fmaxf(v, dpp_f<0x141>(v));
    return v;
}
__device__ __forceinline__ float sigmoidf_(float x) { return __builtin_amdgcn_rcpf(1.f + __expf(-x)); }
__device__ __forceinline__ float siluf_(float x) { return x * __builtin_amdgcn_rcpf(1.f + __expf(-x)); }
__device__ __forceinline__ float gelu_tanh(float x) {
    float u = 0.7978845608028654f * (x + 0.044715f * x * x * x);
    return x * __builtin_amdgcn_rcpf(1.f + __expf(-2.f * u));
}

template <class FA, class FB>
__device__ __forceinline__ void gemm_tile(int nkt, FA fa, FB fb, f32x4 (&acc)[4][4]) {
    const int tid = TIDX, lane = tid & 63, wid = tid >> 6, wr = wid >> 1, wc = wid & 1, fr = lane & 15, fq = lane >> 4;
    const int sb = lane * 16, swz = sb ^ (((sb >> 9) & 1) << 5);
    const int r_in = swz >> 6, c_in = (swz & 63) >> 1;
#pragma unroll
    for (int m = 0; m < 4; ++m)
#pragma unroll
        for (int n = 0; n < 4; ++n) acc[m][n] = (f32x4){0.f, 0.f, 0.f, 0.f};
    __syncthreads();
    auto stage = [&](int kt, int s) {
        char* sa = smem + s * 32768;
        char* sbm = sa + 16384;
#pragma unroll
        for (int i = 0; i < 4; ++i) {
            const int st = wid + 4 * i, R = (st >> 1) * 16 + r_in, C = (st & 1) * 32 + c_in;
            glds16(fa(R, C, kt), sa + tid * 16 + i * 4096);
            glds16(fb(R, C, kt), sbm + tid * 16 + i * 4096);
        }
    };
    stage(0, 0);
    for (int kt = 0; kt < nkt; ++kt) {
        asm volatile("s_waitcnt vmcnt(0)" ::: "memory");
        __syncthreads();
        if (kt + 1 < nkt) stage(kt + 1, (kt + 1) & 1);
        const char* sa = smem + (kt & 1) * 32768;
        const char* sbm = sa + 16384;
#pragma unroll
        for (int ks = 0; ks < 2; ++ks) {
            bf16x8 a[4], b[4];
#pragma unroll
            for (int m = 0; m < 4; ++m) a[m] = *(const bf16x8*)(sa + lds_byte(wr * 64 + m * 16 + fr, ks * 32 + fq * 8));
#pragma unroll
            for (int n = 0; n < 4; ++n) b[n] = *(const bf16x8*)(sbm + lds_byte(wc * 64 + n * 16 + fr, ks * 32 + fq * 8));
            __builtin_amdgcn_s_setprio(1);
#pragma unroll
            for (int m = 0; m < 4; ++m)
#pragma unroll
                for (int n = 0; n < 4; ++n) acc[m][n] = __builtin_amdgcn_mfma_f32_16x16x32_bf16(a[m], b[n], acc[m][n], 0, 0, 0);
            __builtin_amdgcn_s_setprio(0);
        }
    }
    __syncthreads();
}

__device__ __forceinline__ int lds32(int r, int c) {
    const int rr = r & 15;
    return (r >> 4) * 1024 + ((rr * 64 + c * 2) ^ (((rr >> 3) & 1) << 5));
}
struct NoHook { __device__ __forceinline__ void operator()(int) const {} };
template <bool A_SC1 = false, class FA, class FB, class HK = NoHook>
__device__ __forceinline__ void gemm_tile_w(int nkt, FA fa, FB fb, f32x4 (&acc)[4][8], HK hook = HK()) {
    constexpr bool ZERO = true;
    const int tid = TIDX, lane = tid & 63, wid = tid >> 6, wr = wid >> 1, wc = wid & 1, fr = lane & 15, fq = lane >> 4;
    const int sb = lane * 16, swz = sb ^ (((sb >> 9) & 1) << 5);
    const int r_in = swz >> 6, c_in = (swz & 63) >> 1;
    if (ZERO) {
#pragma unroll
        for (int m = 0; m < 4; ++m)
#pragma unroll
            for (int n = 0; n < 8; ++n) acc[m][n] = (f32x4){0.f, 0.f, 0.f, 0.f};
    }
    __syncthreads();
    auto stage = [&](int kt, int s) {
        char* sa = smem + s * 24576;
#pragma unroll
        for (int i = 0; i < 2; ++i) { if (A_SC1) glds16_sc1(fa(i, (wid + 4 * i) * 16 + r_in, c_in, kt), sa + tid * 16 + i * 4096); else glds16(fa(i, (wid + 4 * i) * 16 + r_in, c_in, kt), sa + tid * 16 + i * 4096); }
#pragma unroll
        for (int i = 0; i < 4; ++i) glds16(fb(i, (wid + 4 * i) * 16 + r_in, c_in, kt), sa + 8192 + tid * 16 + i * 4096);
    };
    stage(0, 0);
    if (nkt > 1) stage(1, 1);
    int s_cur = 0, s_nxt = 2;
    for (int kt = 0; kt < nkt; ++kt) {
        hook(kt);
        if (kt + 1 < nkt) asm volatile("s_waitcnt vmcnt(6) lgkmcnt(0)\n\ts_barrier" ::: "memory");
        else asm volatile("s_waitcnt vmcnt(0) lgkmcnt(0)\n\ts_barrier" ::: "memory");
        if (kt + 2 < nkt) stage(kt + 2, s_nxt);
        const char* sa = smem + s_cur * 24576;
        bf16x8 a[4];
#pragma unroll
        for (int m = 0; m < 4; ++m) a[m] = *(const bf16x8*)(sa + lds32(wr * 64 + m * 16 + fr, fq * 8));
#pragma unroll
        for (int nh = 0; nh < 2; ++nh) {
            bf16x8 b[4];
#pragma unroll
            for (int n = 0; n < 4; ++n) b[n] = *(const bf16x8*)(sa + 8192 + lds32(wc * 128 + (nh * 4 + n) * 16 + fr, fq * 8));
            __builtin_amdgcn_s_setprio(1);
#pragma unroll
            for (int m = 0; m < 4; ++m)
#pragma unroll
                for (int n = 0; n < 4; ++n) acc[m][nh * 4 + n] = __builtin_amdgcn_mfma_f32_16x16x32_bf16(a[m], b[n], acc[m][nh * 4 + n], 0, 0, 0);
            __builtin_amdgcn_s_setprio(0);
        }
        s_cur = (s_cur == 2) ? 0 : s_cur + 1;
        s_nxt = (s_nxt == 2) ? 0 : s_nxt + 1;
    }
    __syncthreads();
}

template <class FV, class FD>
__device__ __forceinline__ void wave_store_bf16_f(FV val, FD dst, bool write_through = false, const char* wt_base = nullptr, unsigned wt_bytes = 0) {
    const __amdgpu_buffer_rsrc_t wt_rsrc = __builtin_amdgcn_make_buffer_rsrc((void*)wt_base, 0, (int)wt_bytes, 0x00020000);
    const int lane = TIDX & 63, wid = TIDX >> 6, fr = lane & 15, fq = lane >> 4;
    char* base = smem + wid * 9216;
#pragma unroll
    for (int m = 0; m < 4; ++m)
#pragma unroll
        for (int n = 0; n < 4; ++n)
#pragma unroll
            for (int j = 0; j < 4; ++j)
                *(u16*)(base + (m * 16 + fq * 4 + j) * 144 + (n * 16 + fr) * 2) = f2bf(val(m, n, j));
    asm volatile("s_waitcnt lgkmcnt(0)" ::: "memory");
    __builtin_amdgcn_wave_barrier();
#pragma unroll
    for (int i = 0; i < 8; ++i) {
        const int id = i * 64 + lane, row = id >> 3, ch = id & 7;
        const uint4 d = *(const uint4*)(base + row * 144 + ch * 16);
        u16* p = dst(row);
        if (p) {
            if (write_through) {
                const u32x4 dv = {d.x, d.y, d.z, d.w};
                __builtin_amdgcn_raw_buffer_store_b128(dv, wt_rsrc, (int)((const char*)(p + ch * 8) - wt_base), 0, 16);
            } else *(uint4*)(p + ch * 8) = d;
        }
    }
    asm volatile("s_waitcnt lgkmcnt(0)" ::: "memory");
    __builtin_amdgcn_wave_barrier();
}

template <class FD>
__device__ __forceinline__ void wave_store_bf16(const float (&v)[4][4][4], FD dst) {
    wave_store_bf16_f([&](int m, int n, int j) { return v[m][n][j]; }, dst);
}

struct ConvD { const float* src; u16* dst; int ld, ldd, k0, n0, mode, zr; };
__device__ __forceinline__ void conv_load(const Params& p, const ConvD& d, float (&v)[16]) {
    const int tid = TIDX;
#pragma unroll
    for (int i = 0; i < 16; ++i) v[i] = d.src[(size_t)(d.k0 + i * 4 + (tid >> 6)) * d.ld + d.n0 + (tid & 63)];
    if (d.zr == 2) {
#pragma unroll
        for (int i = 0; i < 16; ++i) {
            const int k = d.k0 + i * 4 + (tid >> 6);
            v[i] *= (k < 512) ? p.norm_attn_out[k] : p.norm_ssm_out[k - 512];
        }
    }
}
__device__ __forceinline__ void conv_store(const Params& p, const ConvD& d, const float (&v)[16]) {
    float* t = (float*)smem;
    const int tid = TIDX;
    __syncthreads();
#pragma unroll
    for (int i = 0; i < 16; ++i) t[(i * 4 + (tid >> 6)) * 65 + (tid & 63)] = v[i];
    __syncthreads();
    const int n = tid >> 2, kq = tid & 3;
    unsigned w[8];
#pragma unroll
    for (int i = 0; i < 8; ++i) w[i] = pack2(t[(kq * 16 + 2 * i) * 65 + n], t[(kq * 16 + 2 * i + 1) * 65 + n]);
    const int gn = d.n0 + n;
    int row = gn;
    if (d.mode == 1) row = (gn >> 4) * 32 + (gn & 15);
    else if (d.mode == 2) row = (gn >> 4) * 32 + 16 + (gn & 15);
    else if (d.mode == 3) row = n;
    uint4* o = (uint4*)(d.dst + (size_t)row * d.ldd + d.k0 + kq * 16);
    o[0] = make_uint4(w[0], w[1], w[2], w[3]);
    o[1] = make_uint4(w[4], w[5], w[6], w[7]);
    if (d.zr == 1) {
        uint4* z = (uint4*)(WSP_WrT + (size_t)(64 + n) * 1024 + d.k0 + kq * 16);
        z[0] = make_uint4(0, 0, 0, 0); z[1] = make_uint4(0, 0, 0, 0);
    }
}

__device__ __forceinline__ void ada_item(const Params& p, int item) {
    float* sc = (float*)smem;
    float* red = sc + 9 * 1024;
    const int tid = TIDX;
    __syncthreads();
    for (int i = tid; i < 9 * 1024; i += NTHR) {
        const int r = i >> 10, k = i & 1023;
        const float cv = (r < 8) ? p.c[r * 1024 + k] : p.c_ctx[k];
        sc[i] = siluf_(cv);
    }
    __syncthreads();
    const int kq = tid >> 6, jl = tid & 63, j = item * 64 + jl;
    float acc[9];
#pragma unroll
    for (int r = 0; r < 9; ++r) acc[r] = 0.f;
#pragma unroll 16
    for (int k = kq; k < 1024; k += 4) {
        const float w = p.w_ada[(size_t)k * 6144 + j];
#pragma unroll
        for (int r = 0; r < 9; ++r) acc[r] += sc[r * 1024 + k] * w;
    }
#pragma unroll
    for (int r = 0; r < 9; ++r) red[(kq * 9 + r) * 64 + jl] = acc[r];
    __syncthreads();
    for (int i = tid; i < 9 * 64; i += NTHR) {
        const int r = i >> 6, l = i & 63;
        const float s = red[(0 * 9 + r) * 64 + l] + red[(1 * 9 + r) * 64 + l] + red[(2 * 9 + r) * 64 + l] + red[(3 * 9 + r) * 64 + l];
        WSP_mod[r * 6144 + item * 64 + l] = s + p.b_ada[item * 64 + l];
    }
}

__device__ __forceinline__ void rope_item(const Params& p) {
    for (int i = TIDX; i < 64 * 16; i += NTHR) {
        const int pos = i >> 4, k = i & 15;
        const float inv = exp2f(-(float)k * (13.287712379549449f / 16.f));
        float s, c;
        sincosf((float)pos * inv, &s, &c);
        WSP_rope[i] = make_float2(c, s);
    }
}

__device__ __forceinline__ void ssm_table_item(const Params& p, int g, int dir) {
    float* pw = (float*)smem;
    float* Bb = pw + 17 * 64 * 2;
    float* Cc = Bb + 64 * 16 * 2;
    const int tid = TIDX;
    u16* tabS = WSP_TabS + (size_t)g * 256 * 256;
    u16* tabY = WSP_TabY + (size_t)g * 256 * 512;
    float* Kf = WSP_Kbuf + (size_t)(g * 2 + dir) * 4096;
    __syncthreads();
    {
        const int pidx = dir * 32 + g;
        const float dt = __expf(p.log_dt[pidx]);
        for (int i = tid; i < 17 * 64; i += NTHR) {
            const int tau = i >> 6, n = i & 63;
            const float are = p.a_re[pidx * 64 + n], aim = p.a_im[pidx * 64 + n];
            const float mag = __expf((float)tau * dt * are);
            float rev = (float)tau * (dt * aim * 0.15915494309189535f);
            rev -= rintf(rev);
            pw[i * 2] = mag * __builtin_amdgcn_cosf(rev);
            pw[i * 2 + 1] = mag * __builtin_amdgcn_sinf(rev);
        }
        __syncthreads();
        for (int i = tid; i < 64 * 16; i += NTHR) {
            const int n = i >> 4;
            const float are = p.a_re[pidx * 64 + n], aim = p.a_im[pidx * 64 + n];
            const float abr = pw[(64 + n) * 2], abi = pw[(64 + n) * 2 + 1];
            const float den = are * are + aim * aim, nre = abr - 1.f;
            const float cre = (nre * are + abi * aim) / den, cim = (abi * are - nre * aim) / den;
            const float br = p.b_re[(size_t)pidx * 1024 + i], bi = p.b_im[(size_t)pidx * 1024 + i];
            Bb[i * 2] = cre * br - cim * bi;
            Bb[i * 2 + 1] = cre * bi + cim * br;
            Cc[i * 2] = p.c_re[(size_t)pidx * 1024 + i];
            Cc[i * 2 + 1] = p.c_im[(size_t)pidx * 1024 + i];
        }
        __syncthreads();
        {
            const int tau = tid >> 4, pp = tid & 15;
            float s[16];
#pragma unroll
            for (int q = 0; q < 16; ++q) s[q] = 0.f;
            for (int n = 0; n < 64; ++n) {
                const float2 cv = *(const float2*)&Cc[(pp * 64 + n) * 2];
                const float2 wv = *(const float2*)&pw[(tau * 64 + n) * 2];
                const float zr = cv.x * wv.x - cv.y * wv.y, zi = cv.x * wv.y + cv.y * wv.x;
#pragma unroll
                for (int q = 0; q < 16; ++q) {
                    const float2 bv = *(const float2*)&Bb[(n * 16 + q) * 2];
                    s[q] += zr * bv.x - zi * bv.y;
                }
            }
#pragma unroll
            for (int q = 0; q < 4; ++q)
                *(float4*)(Kf + tau * 256 + pp * 16 + q * 4) = make_float4(s[4 * q], s[4 * q + 1], s[4 * q + 2], s[4 * q + 3]);
        }
        for (int id = tid; id < 128 * 32; id += NTHR) {
            const int rr = id >> 5, ch = id & 31, cpart = rr >> 6, n = rr & 63, s_ = ch >> 1, q0 = (ch & 1) * 8;
            const int e = dir == 0 ? 15 - s_ : s_;
            const float wr_ = pw[(e * 64 + n) * 2], wi_ = pw[(e * 64 + n) * 2 + 1];
            unsigned w[4];
#pragma unroll
            for (int i = 0; i < 4; ++i) {
                float v[2];
#pragma unroll
                for (int h = 0; h < 2; ++h) {
                    const float br = Bb[(n * 16 + q0 + 2 * i + h) * 2], bi = Bb[(n * 16 + q0 + 2 * i + h) * 2 + 1];
                    v[h] = cpart == 0 ? (wr_ * br - wi_ * bi) : (wr_ * bi + wi_ * br);
                }
                w[i] = pack2(v[0], v[1]);
            }
            *(uint4*)(tabS + (size_t)(dir * 128 + rr) * 256 + s_ * 16 + q0) = make_uint4(w[0], w[1], w[2], w[3]);
        }
        for (int id = tid; id < 256 * 16; id += NTHR) {
            const int m = id >> 4, ch = id & 15, t = m >> 4, pp = m & 15, cpart = ch >> 3, n0 = (ch & 7) * 8;
            const int e = dir == 0 ? t + 1 : 16 - t;
            unsigned w[4];
#pragma unroll
            for (int i = 0; i < 4; ++i) {
                float v[2];
#pragma unroll
                for (int h = 0; h < 2; ++h) {
                    const int n = n0 + 2 * i + h;
                    const float cr = Cc[(pp * 64 + n) * 2], ci = Cc[(pp * 64 + n) * 2 + 1];
                    const float wr_ = pw[(e * 64 + n) * 2], wi_ = pw[(e * 64 + n) * 2 + 1];
                    v[h] = cpart == 0 ? (cr * wr_ - ci * wi_) : -(cr * wi_ + ci * wr_);
                }
                w[i] = pack2(v[0], v[1]);
            }
            *(uint4*)(tabY + (size_t)m * 512 + 256 + dir * 128 + cpart * 64 + n0) = make_uint4(w[0], w[1], w[2], w[3]);
        }
    }
}

__device__ __forceinline__ void ssm_toeplitz_item(const Params& p, int g) {
    float* Kf = (float*)smem;
    const int tid = TIDX;
    u16* tabY = WSP_TabY + (size_t)g * 256 * 512;
    __syncthreads();
    for (int i = tid; i < 2048; i += NTHR) ((float4*)Kf)[i] = ((const float4*)(WSP_Kbuf + (size_t)g * 8192))[i];
    __syncthreads();
    for (int id = tid; id < 256 * 32; id += NTHR) {
        const int m = id >> 5, ch = id & 31, t = m >> 4, pp = m & 15, s_ = ch >> 1, q0 = (ch & 1) * 8;
        unsigned w[4];
#pragma unroll
        for (int i = 0; i < 4; ++i) {
            float v[2];
#pragma unroll
            for (int h = 0; h < 2; ++h) {
                const int q = q0 + 2 * i + h;
                float val;
                if (s_ < t) val = Kf[((t - s_) * 16 + pp) * 16 + q];
                else if (s_ > t) val = Kf[4096 + ((s_ - t) * 16 + pp) * 16 + q];
                else val = Kf[(pp) * 16 + q] + Kf[4096 + pp * 16 + q] + (pp == q ? p.ssm_d[g * 16 + pp] : 0.f);
                v[h] = val;
            }
            w[i] = pack2(v[0], v[1]);
        }
        *(uint4*)(tabY + (size_t)m * 512 + s_ * 16 + q0) = make_uint4(w[0], w[1], w[2], w[3]);
    }
    __syncthreads();
}

#define N_CONV 6896
__device__ __forceinline__ ConvD conv_decode(const Params& p, int t) {
    ConvD d; d.mode = 0; d.zr = 0;
    if (t < 320) { d.src = p.w_in; d.ld = 1280; d.k0 = (t / 20) * 64; d.n0 = (t % 20) * 64; d.dst = WSP_WinT; d.ldd = 1024; return d; }
    t -= 320;
    if (t < 64) { d.src = p.w_glu; d.ld = 512; d.k0 = (t / 8) * 64; d.n0 = (t % 8) * 64; d.dst = WSP_WgluT; d.ldd = 512; return d; }
    t -= 64;
    if (t < 256) { d.src = p.w_out; d.ld = 1024; d.k0 = (t / 16) * 64; d.n0 = (t % 16) * 64; d.dst = WSP_WoutT; d.ldd = 1024; d.zr = 2; return d; }
    t -= 256;
    if (t < 16) { d.src = p.w_router; d.ld = 64; d.k0 = t * 64; d.n0 = 0; d.dst = WSP_WrT; d.ldd = 1024; d.zr = 1; return d; }
    t -= 16;
    if (t < 4096) {
        const int up = t >= 2048; const int tt = t & 2047, e = tt >> 5, r = tt & 31;
        d.src = (up ? p.w_up_e : p.w_gate_e) + (size_t)e * 131072; d.ld = 128; d.k0 = (r >> 1) * 64; d.n0 = (r & 1) * 64;
        d.dst = WSP_WguT + (size_t)e * 262144; d.ldd = 1024; d.mode = 1 + up; return d;
    }
    t -= 4096;
    if (t < 64) {
        const int up = t >= 32; const int r = t & 31;
        d.src = up ? p.w_up_s : p.w_gate_s; d.ld = 128; d.k0 = (r >> 1) * 64; d.n0 = (r & 1) * 64;
        d.dst = WSP_WguT + (size_t)64 * 262144; d.ldd = 1024; d.mode = 1 + up; return d;
    }
    t -= 64;
    if (t < 2048) { const int e = t >> 5, r = t & 31; d.src = p.w_down_e + (size_t)e * 131072; d.ld = 1024; d.k0 = (r >> 4) * 64; d.n0 = (r & 15) * 64; d.dst = WSP_WdT + (size_t)e * 131072; d.ldd = 128; return d; }
    t -= 2048;
    d.src = p.w_down_s; d.ld = 1024; d.k0 = (t >> 4) * 64; d.n0 = (t & 15) * 64; d.dst = WSP_WdT + (size_t)64 * 131072; d.ldd = 128; return d;
}

#define N_CONV_EARLY 4000
__device__ __forceinline__ void conv_range(const Params& p, int t0, int stride, int tend, int tbeg = 0) {
    int t = tbeg + t0;
    if (t < tend) {
        ConvD d = conv_decode(p, t);
        float v[16];
        conv_load(p, d, v);
        while (t < tend) {
            const int tn = t + stride;
            ConvD dn = d;
            float vn[16];
            if (tn < tend) { dn = conv_decode(p, tn); conv_load(p, dn, vn); }
            conv_store(p, d, v);
            d = dn;
#pragma unroll
            for (int i = 0; i < 16; ++i) v[i] = vn[i];
            t = tn;
        }
    }
}
#define P0_CONV_B0 161
__device__ __forceinline__ void phase0(const Params& p) {
    const int b = blockIdx.x, G = gridDim.x;
    if (G > P0_CONV_B0 + 32) {
        if (b < 64) ssm_table_item(p, b >> 1, b & 1);
        else if (b < 160) ada_item(p, b - 64);
        else if (b == 160) rope_item(p);
        else conv_range(p, b - P0_CONV_B0, G - P0_CONV_B0, N_CONV_EARLY);
    } else {
        const int NU = 64 + 96 + 1 + N_CONV_EARLY;
        for (int u = b; u < NU; u += G) {
            if (u < 64) ssm_table_item(p, u >> 1, u & 1);
            else if (u < 160) ada_item(p, u - 64);
            else if (u == 160) rope_item(p);
            else { ConvD d = conv_decode(p, u - 161); float v[16]; conv_load(p, d, v); conv_store(p, d, v); }
        }
    }
}
#if 0
    {
        {
            const int stride = G - P0_CONV_B0;
            int t = b - P0_CONV_B0;
            if (t < N_CONV) {
                ConvD d = conv_decode(p, t);
                float v[16];
                conv_load(p, d, v);
                while (t < N_CONV) {
                    const int tn = t + stride;
                    ConvD dn = d;
                    float vn[16];
                    if (tn < N_CONV) { dn = conv_decode(p, tn); conv_load(p, dn, vn); }
                    conv_store(p, d, v);
                    d = dn;
#pragma unroll
                    for (int i = 0; i < 16; ++i) v[i] = vn[i];
                    t = tn;
                }
            }
        }
    } else {
        const int NU = 64 + 96 + 1 + N_CONV;
        for (int u = b; u < NU; u += G) {
            if (u < 64) ssm_table_item(p, u >> 1, u & 1);
            else if (u < 160) ada_item(p, u - 64);
            else if (u == 160) rope_item(p);
            else { ConvD d = conv_decode(p, u - 161); float v[16]; conv_load(p, d, v); conv_store(p, d, v); }
        }
    }
}

#endif

__device__ __forceinline__ void norm_mod_row(const float* src, const float* gain, const float* sh, const float* scl, u16* dst) {
    const int lane = TIDX & 63;
    float4 v[4];
    float ss = 0.f;
#pragma unroll
    for (int i = 0; i < 4; ++i) {
        v[i] = *(const float4*)(src + i * 256 + lane * 4);
        ss += v[i].x * v[i].x + v[i].y * v[i].y + v[i].z * v[i].z + v[i].w * v[i].w;
    }
    ss = wave_sum(ss);
    const float rs = rsqrtf(ss * (1.f / 1024.f) + EPS);
#pragma unroll
    for (int i = 0; i < 4; ++i) {
        const int c0 = i * 256 + lane * 4;
        const float4 g = *(const float4*)(gain + c0), s = *(const float4*)(sh + c0), k = *(const float4*)(scl + c0);
        const float a = v[i].x * rs * g.x * (1.f + k.x) + s.x, b = v[i].y * rs * g.y * (1.f + k.y) + s.y;
        const float c = v[i].z * rs * g.z * (1.f + k.z) + s.z, d = v[i].w * rs * g.w * (1.f + k.w) + s.w;
        *(uint2*)(dst + c0) = make_uint2(pack2(a, b), pack2(c, d));
    }
}

__device__ __forceinline__ void phase1(const Params& p) {
    const int wv = blockIdx.x * 4 + (TIDX >> 6), nwv = gridDim.x * 4;
    const int lane = TIDX & 63;
    for (int r0 = wv * 4; r0 < NROWS; r0 += nwv * 4) {
        const float* src[4]; const float* md[4];
        float4 v[4][4];
#pragma unroll
        for (int q = 0; q < 4; ++q) {
            const int r = r0 + q;
            if (r < NLAT) { src[q] = p.x + (size_t)r * 1024; md[q] = WSP_mod + (r >> 11) * 6144; }
            else { src[q] = p.ctx + (size_t)(r - NLAT) * 1024; md[q] = WSP_mod + 8 * 6144; }
#pragma unroll
            for (int i = 0; i < 4; ++i) v[q][i] = *(const float4*)(src[q] + i * 256 + lane * 4);
        }
#pragma unroll
        for (int q = 0; q < 4; ++q) {
            float ss = 0.f;
#pragma unroll
            for (int i = 0; i < 4; ++i) ss += v[q][i].x * v[q][i].x + v[q][i].y * v[q][i].y + v[q][i].z * v[q][i].z + v[q][i].w * v[q][i].w;
            ss = wave_sum(ss);
            const float rs = rsqrtf(ss * (1.f / 1024.f) + EPS);
            u16* dst = WSP_Hb + (size_t)(r0 + q) * 1024;
#pragma unroll
            for (int i = 0; i < 4; ++i) {
                const int c0 = i * 256 + lane * 4;
                const float4 g = *(const float4*)(p.norm_mix + c0), s = *(const float4*)(md[q] + c0), k = *(const float4*)(md[q] + 1024 + c0);
                const float a = v[q][i].x * rs * g.x * (1.f + k.x) + s.x, b = v[q][i].y * rs * g.y * (1.f + k.y) + s.y;
                const float c = v[q][i].z * rs * g.z * (1.f + k.z) + s.z, d = v[q][i].w * rs * g.w * (1.f + k.w) + s.w;
                *(uint2*)(dst + c0) = make_uint2(pack2(a, b), pack2(c, d));
            }
        }
    }
}

__device__ __forceinline__ void phase2(const Params& p) {
    const int NU = 128 * 10 + 16 * 6;
    const int lane = TIDX & 63, wid = TIDX >> 6, wr = wid >> 1, wc = wid & 1, fr = lane & 15, fq = lane >> 4;
    for (int u = blockIdx.x; u < NU; u += gridDim.x) {
        int mt, nt;
        {
            const int xc = u & 7, r = u >> 3;
            if (r < 160) { mt = xc + 8 * (r / 10); nt = r % 10; } else { const int v = r - 160; mt = 128 + xc + 8 * (v / 6); nt = 4 + v % 6; }
        }
        const u16* A = WSP_Hb + (size_t)mt * 128 * 1024;
        const u16* B = WSP_WinT + (size_t)nt * 128 * 1024;
        f32x4 acc[4][4];
        gemm_tile(16,
            [&](int R, int C, int kt) { return (const void*)(A + (size_t)R * 1024 + kt * 64 + C); },
            [&](int R, int C, int kt) { return (const void*)(B + (size_t)R * 1024 + kt * 64 + C); }, acc);
        const int row0 = mt * 128 + wr * 64;
        const int col0 = nt * 128 + wc * 64;
        const bool is_lat = mt < 128;
        if (nt == 5) {
            const int kvh = wc;
#pragma unroll
            for (int m = 0; m < 4; ++m) {
                const int r = row0 + m * 16 + fq * 4;
                int b, pos;
                if (is_lat) { b = r >> 11; pos = r & 2047; } else { const int rc = r - NLAT; b = rc >> 8; pos = SEQ + (rc & 255); }
#pragma unroll
                for (int n = 0; n < 4; ++n) {
                    const int d = n * 16 + fr;
                    u16* dst = WSP_Vt + ((size_t)(b * 2 + kvh) * 64 + d) * VT_LD + pos;
                    *(uint2*)dst = make_uint2(pack2(acc[m][n][0], acc[m][n][1]), pack2(acc[m][n][2], acc[m][n][3]));
                }
            }
        } else {
            float v[4][4][4];
            const bool do_rope = is_lat && nt <= 4;
#pragma unroll
            for (int m = 0; m < 4; ++m)
#pragma unroll
                for (int j = 0; j < 4; ++j) {
                    if (do_rope) {
                        const int r = row0 + m * 16 + fq * 4 + j, pos = r & 2047;
                        const float2 cr = WSP_rope[(pos >> 6) * 16 + fr], cc = WSP_rope[(pos & 63) * 16 + fr];
                        const float x1 = acc[m][0][j], x2 = acc[m][1][j], y1 = acc[m][2][j], y2 = acc[m][3][j];
                        v[m][0][j] = x1 * cr.x - x2 * cr.y; v[m][1][j] = x1 * cr.y + x2 * cr.x;
                        v[m][2][j] = y1 * cc.x - y2 * cc.y; v[m][3][j] = y1 * cc.y + y2 * cc.x;
                    } else {
#pragma unroll
                        for (int n = 0; n < 4; ++n) v[m][n][j] = acc[m][n][j];
                    }
                }
            u16* dbase; int ldd;
            if (nt < 4) { dbase = WSP_Q + (size_t)row0 * 512 + col0; ldd = 512; }
            else if (nt == 4) { dbase = WSP_Kb + (size_t)row0 * 128 + (col0 - 512); ldd = 128; }
            else { dbase = WSP_U + (size_t)row0 * 512 + (col0 - 768); ldd = 512; }
            wave_store_bf16(v, [&](int row) { return dbase + (size_t)row * ldd; });
        }
    }
}

__device__ __forceinline__ void attn_unit(const Params& p, int u) {
    const int h = u & 7, qb = (u >> 3) & 15, b = u >> 7, kvh = h >> 2;
    const int tid = TIDX, lane = tid & 63, wid = tid >> 6, fr = lane & 15, fq = lane >> 4;
    const int sb = lane * 16, swz = sb ^ (((sb >> 9) & 1) << 5);
    const int r_in = swz >> 6, c_in = (swz & 63) >> 1;
    const int jstart = qb == 0 ? 2 : 0, jend = qb == 15 ? 4 : 6, nb = jend - jstart, ntile = nb + 4;
    const float SC = 0.125f * 1.4426950408889634f;
    bf16x8 qf[2][2];
    const int qrow0 = b * SEQ + qb * 128 + wid * 32;
#pragma unroll
    for (int qt = 0; qt < 2; ++qt)
#pragma unroll
        for (int ks = 0; ks < 2; ++ks)
            qf[qt][ks] = *(const bf16x8*)(WSP_Q + (size_t)(qrow0 + qt * 16 + fr) * 512 + h * 64 + ks * 32 + fq * 8);
    f32x4 o[4][2];
#pragma unroll
    for (int dt = 0; dt < 4; ++dt)
#pragma unroll
        for (int qt = 0; qt < 2; ++qt) o[dt][qt] = (f32x4){0.f, 0.f, 0.f, 0.f};
    float mrun[2], lrun[2];
    const float sinkv = p.attn_sink[h] * 1.4426950408889634f;
    mrun[0] = mrun[1] = sinkv;
    lrun[0] = lrun[1] = (fq == 0) ? 1.f : 0.f;
    __syncthreads();
    const u16* kp[2]; const u16* vp[2];
    {
        const int ks0 = qb * 128 - 128 + 64 * jstart;
#pragma unroll
        for (int it = 0; it < 2; ++it) {
            const int st = wid + 4 * it, R = (st >> 1) * 16 + r_in, C = (st & 1) * 32 + c_in;
            kp[it] = WSP_Kb + (size_t)(b * SEQ + ks0 + R) * 128 + kvh * 64 + C;
            vp[it] = WSP_Vt + ((size_t)(b * 2 + kvh) * 64 + R) * VT_LD + ks0 + C;
        }
    }
    auto stage = [&](int i, int s) {
        char* sk = smem + s * 16384;
        char* sv = sk + 8192;
#pragma unroll
        for (int it = 0; it < 2; ++it) {
            glds16(kp[it], sk + tid * 16 + it * 4096);
            glds16(vp[it], sv + tid * 16 + it * 4096);
        }
        if (i + 1 == nb) {
            const int ks0 = qb * 128 - 128 + 64 * (jstart + i);
#pragma unroll
            for (int it = 0; it < 2; ++it) {
                kp[it] += (size_t)(NLAT + b * CTXL - (b * SEQ + ks0)) * 128;
                vp[it] += SEQ - ks0;
            }
        } else {
#pragma unroll
            for (int it = 0; it < 2; ++it) { kp[it] += 64 * 128; vp[it] += 64; }
        }
    };
    stage(0, 0);
    for (int i = 0; i < ntile; ++i) {
        asm volatile("s_waitcnt vmcnt(0)" ::: "memory");
        __syncthreads();
        if (i + 1 < ntile) stage(i + 1, (i + 1) & 1);
        const char* sk = smem + (i & 1) * 16384;
        const char* sv = sk + 8192;
        f32x4 s[4][2];
#pragma unroll
        for (int kt = 0; kt < 4; ++kt)
#pragma unroll
            for (int qt = 0; qt < 2; ++qt) s[kt][qt] = (f32x4){0.f, 0.f, 0.f, 0.f};
#pragma unroll
        for (int ks = 0; ks < 2; ++ks)
#pragma unroll
            for (int kt = 0; kt < 4; ++kt) {
                const bf16x8 kf = *(const bf16x8*)(sk + lds_byte(32 * (kt >> 1) + 8 * (fr >> 2) + 4 * (kt & 1) + (fr & 3), ks * 32 + fq * 8));
#pragma unroll
                for (int qt = 0; qt < 2; ++qt) s[kt][qt] = __builtin_amdgcn_mfma_f32_16x16x32_bf16(kf, qf[qt][ks], s[kt][qt], 0, 0, 0);
            }
        const int ks0 = qb * 128 - 128 + 64 * (jstart + i);
        const int qlo = qb * 128 + wid * 32;
        const bool band = (i < nb) && ((qlo + 31 - ks0 > 128) || (ks0 + 63 - qlo > 128));
        bf16x8 pf[2][2];
#pragma unroll
        for (int qt = 0; qt < 2; ++qt) {
            const int qp = qb * 128 + wid * 32 + qt * 16 + fr;
            float mx = -1e30f;
            if (band) {
#pragma unroll
                for (int kt = 0; kt < 4; ++kt)
#pragma unroll
                    for (int j = 0; j < 4; ++j) {
                        const int kp = ks0 + 32 * (kt >> 1) + 8 * fq + 4 * (kt & 1) + j, d = qp - kp;
                        const float v = (d > 128 || d < -128) ? -1e30f : s[kt][qt][j];
                        s[kt][qt][j] = v;
                        mx = fmaxf(mx, v);
                    }
                asm volatile("" ::: "memory");
            } else {
#pragma unroll
                for (int kt = 0; kt < 4; ++kt)
#pragma unroll
                    for (int j = 0; j < 4; ++j) mx = fmaxf(mx, s[kt][qt][j]);
            }
            mx = max_x32(max_x16(mx));
            const float mnew = fmaxf(mrun[qt], mx * SC);
            const float alpha = __builtin_amdgcn_exp2f(mrun[qt] - mnew);
            mrun[qt] = mnew;
            float ls = 0.f;
#pragma unroll
            for (int kt = 0; kt < 4; ++kt)
#pragma unroll
                for (int j = 0; j < 4; ++j) {
                    const float pv = __builtin_amdgcn_exp2f(fmaf(s[kt][qt][j], SC, -mnew));
                    s[kt][qt][j] = pv;
                    ls += pv;
                }
            lrun[qt] = lrun[qt] * alpha + ls;
            if (!__all(alpha == 1.f)) {
#pragma unroll
                for (int dt = 0; dt < 4; ++dt) o[dt][qt] *= alpha;
            }
#pragma unroll
            for (int k2 = 0; k2 < 2; ++k2) {
                bf16x8 t;
#pragma unroll
                for (int j = 0; j < 4; ++j) { t[j] = (short)f2bf(s[2 * k2][qt][j]); t[4 + j] = (short)f2bf(s[2 * k2 + 1][qt][j]); }
                pf[qt][k2] = t;
            }
        }
#pragma unroll
        for (int k2 = 0; k2 < 2; ++k2)
#pragma unroll
            for (int dt = 0; dt < 4; ++dt) {
                const bf16x8 vf = *(const bf16x8*)(sv + lds_byte(dt * 16 + fr, k2 * 32 + fq * 8));
#pragma unroll
                for (int qt = 0; qt < 2; ++qt) o[dt][qt] = __builtin_amdgcn_mfma_f32_16x16x32_bf16(vf, pf[qt][k2], o[dt][qt], 0, 0, 0);
            }
    }
#pragma unroll
    for (int qt = 0; qt < 2; ++qt) {
        const float l = sum_x32(sum_x16(lrun[qt]));
        const float inv = 1.f / l;
        u16* dst = WSP_AO + (size_t)(qrow0 + qt * 16 + fr) * 512 + h * 64 + fq * 4;
        float sq = 0.f;
#pragma unroll
        for (int dt = 0; dt < 4; ++dt) {
            const unsigned w0 = pack2(o[dt][qt][0] * inv, o[dt][qt][1] * inv), w1 = pack2(o[dt][qt][2] * inv, o[dt][qt][3] * inv);
            *(uint2*)(dst + dt * 16) = make_uint2(w0, w1);
            const float a = bf2f((u16)(w0 & 0xffffu)), b = bf2f((u16)(w0 >> 16)), c = bf2f((u16)(w1 & 0xffffu)), d = bf2f((u16)(w1 >> 16));
            sq += a * a + b * b + c * c + d * d;
        }
        sq = sum_x32(sum_x16(sq));
        if (fq == 0) unsafeAtomicAdd(WSP_rsq + (size_t)(qrow0 + qt * 16 + fr) * 2, sq);
    }
}

__device__ __forceinline__ void ssm_s1_unit(const Params& p, int u) {
    const int ct = u % 9, mh = (u / 9) & 1, g = u / 18;
    const int lane = TIDX & 63, wid = TIDX >> 6, wr = wid >> 1, wc = wid & 1, fr = lane & 15, fq = lane >> 4;
    const u16* A = WSP_TabS + ((size_t)g * 256 + mh * 128) * 256;
    const u16* Ub = WSP_U + (size_t)ct * 128 * 16 * 512 + g * 16;
    f32x4 acc[4][4];
    gemm_tile(4,
        [&](int R, int C, int kt) { return (const void*)(A + (size_t)R * 256 + kt * 64 + C); },
        [&](int R, int C, int kt) { return (const void*)(Ub + (size_t)(R * 16 + kt * 4 + (C >> 4)) * 512 + (C & 15)); }, acc);
#pragma unroll
    for (int m = 0; m < 4; ++m)
#pragma unroll
        for (int n = 0; n < 4; ++n) {
            const int rho = mh * 128 + wr * 64 + m * 16 + fq * 4;
            const int cg = ct * 128 + wc * 64 + n * 16 + fr;
            *(f32x4*)(WSP_S + ((size_t)cg * 32 + g) * 256 + rho) = acc[m][n];
        }
}

__device__ __forceinline__ void phase3(const Params& p) {
    for (int u = blockIdx.x; u < 1024; u += gridDim.x) attn_unit(p, u);
    int* qv = (int*)(smem + 73728);
    for (;;) {
        __syncthreads();
        if (TIDX == 0) qv[0] = (int)atomicAdd(&WSP_ctr[CTR_QS1], 1u);
        __syncthreads();
        const int u = __builtin_amdgcn_readfirstlane(qv[0]);
        if (u >= 576) break;
        ssm_s1_unit(p, u);
    }
}

__device__ __forceinline__ void phase4(const Params& p) {
    if ((int)gridDim.x > 192) {
        if ((int)blockIdx.x >= 160) { conv_range(p, blockIdx.x - 160, gridDim.x - 160, N_CONV, N_CONV_EARLY); return; }
        if ((int)blockIdx.x >= 128) { ssm_toeplitz_item(p, blockIdx.x - 128); return; }
    } else {
        for (int g = blockIdx.x; g < 32; g += gridDim.x) ssm_toeplitz_item(p, g);
        conv_range(p, blockIdx.x, gridDim.x, N_CONV, N_CONV_EARLY);
    }
    const int gid = blockIdx.x * NTHR + TIDX;
    if (gid >= BATCH * 2 * 32 * 64) return;
    const int n = gid & 63, g = (gid >> 6) & 31, dir = (gid >> 11) & 1, b = gid >> 12;
    const int pidx = dir * 32 + g;
    const float dt = __expf(p.log_dt[pidx]);
    const float are = p.a_re[pidx * 64 + n], aim = p.a_im[pidx * 64 + n];
    const float mag = __expf(16.f * dt * are);
    float rev = 16.f * (dt * aim * 0.15915494309189535f);
    rev -= rintf(rev);
    const float ar = mag * __builtin_amdgcn_cosf(rev), ai = mag * __builtin_amdgcn_sinf(rev);
    float hr = 0.f, hi = 0.f;
    const size_t so = (size_t)g * 256 + dir * 128 + n;
#pragma unroll 8
    for (int i = 0; i < 16; ++i) {
        const int c = dir == 0 ? i : 15 - i;
        const float* sp = WSP_S + (size_t)(NCHUNK_LAT + b * 16 + c) * 8192 + so;
        const float sr = sp[0], si = sp[64];
        const float nr = ar * hr - ai * hi + sr, ni = ar * hi + ai * hr + si;
        hr = nr; hi = ni;
    }
#pragma unroll 8
    for (int i = 0; i < 128; ++i) {
        const int c = dir == 0 ? i : 127 - i;
        const size_t cg = (size_t)b * 128 + c;
        const float* sp = WSP_S + cg * 8192 + so;
        const float sr = sp[0], si = sp[64];
        u16* hp = WSP_Hin + cg * 8192 + so;
        hp[0] = f2bf(hr); hp[64] = f2bf(hi);
        const float nr = ar * hr - ai * hi + sr, ni = ar * hi + ai * hr + si;
        hr = nr; hi = ni;
    }
}

__device__ __forceinline__ void phase5(const Params& p) {
    const int NU = 512;
    const int lane = TIDX & 63, wid = TIDX >> 6, wr = wid >> 1, wc = wid & 1, fr = lane & 15, fq = lane >> 4;
    for (int u = blockIdx.x; u < NU; u += gridDim.x) {
        const int ct = u & 7, mh = (u >> 3) & 1, g = u >> 4;
        const u16* A = WSP_TabY + ((size_t)g * 256 + mh * 128) * 512;
        const u16* Ub = WSP_U + (size_t)ct * 128 * 16 * 512 + g * 16;
        const u16* Hb_ = WSP_Hin + (size_t)ct * 128 * 8192 + g * 256;
        f32x4 acc[4][4];
        gemm_tile(8,
            [&](int R, int C, int kt) { return (const void*)(A + (size_t)R * 512 + kt * 64 + C); },
            [&](int R, int C, int kt) {
                return kt < 4 ? (const void*)(Ub + (size_t)(R * 16 + kt * 4 + (C >> 4)) * 512 + (C & 15))
                              : (const void*)(Hb_ + (size_t)R * 8192 + (kt - 4) * 64 + C);
            }, acc);
#pragma unroll
        for (int m = 0; m < 4; ++m)
#pragma unroll
            for (int n = 0; n < 4; ++n) {
                const int t = mh * 8 + wr * 4 + m;
                const int cg = ct * 128 + wc * 64 + n * 16 + fr;
                u16* dst = WSP_Y + ((size_t)cg * 16 + t) * 512 + g * 16 + fq * 4;
                *(uint2*)dst = make_uint2(pack2(gelu_tanh(acc[m][n][0]), gelu_tanh(acc[m][n][1])),
                                          pack2(gelu_tanh(acc[m][n][2]), gelu_tanh(acc[m][n][3])));
            }
    }
}

__device__ __forceinline__ void phase6(const Params& p) {
    const int NU = 512;
    const int lane = TIDX & 63, wid = TIDX >> 6, wr = wid >> 1, wc = wid & 1, fr = lane & 15, fq = lane >> 4;
    for (int u = blockIdx.x; u < NU; u += gridDim.x) {
        const int mt = u >> 2, nt = u & 3;
        const u16* A = WSP_Y + (size_t)mt * 128 * 512;
        const u16* B = WSP_WgluT + (size_t)nt * 128 * 512;
        f32x4 acc[4][4];
        gemm_tile(8,
            [&](int R, int C, int kt) { return (const void*)(A + (size_t)R * 512 + kt * 64 + C); },
            [&](int R, int C, int kt) { return (const void*)(B + (size_t)R * 512 + kt * 64 + C); }, acc);
        const int row0 = mt * 128 + wr * 64, col0 = nt * 128 + wc * 64;
        char* base = smem + wid * 9216;
        float bg[4];
#pragma unroll
        for (int n = 0; n < 4; ++n) bg[n] = p.b_glu[col0 + n * 16 + fr];
#pragma unroll
        for (int i = 0; i < 8; ++i) {
            const int id = i * 64 + lane, row = id >> 3, ch = id & 7;
            *(uint4*)(base + row * 144 + ch * 16) = *(const uint4*)(WSP_Y + (size_t)(row0 + row) * 512 + col0 + ch * 8);
        }
        asm volatile("s_waitcnt lgkmcnt(0)" ::: "memory");
        __builtin_amdgcn_wave_barrier();
#pragma unroll
        for (int m = 0; m < 4; ++m)
#pragma unroll
            for (int j = 0; j < 4; ++j) {
                const int rl = m * 16 + fq * 4 + j, r = row0 + rl;
                float sq = 0.f;
#pragma unroll
                for (int n = 0; n < 4; ++n) {
                    const int c = col0 + n * 16 + fr;
                    const float yv = bf2f(*(const u16*)(base + rl * 144 + (n * 16 + fr) * 2));
                    const u16 ob = f2bf(yv * sigmoidf_(acc[m][n][j] + bg[n]));
                    *(u16*)(base + rl * 144 + (n * 16 + fr) * 2) = ob;
                    const float of = bf2f(ob);
                    sq += of * of;
                }
                sq = sum16(sq);
                if (fr == 0) unsafeAtomicAdd(WSP_rsq + (size_t)r * 2 + 1, sq);
            }
        asm volatile("s_waitcnt lgkmcnt(0)" ::: "memory");
        __builtin_amdgcn_wave_barrier();
        u16* dbase = WSP_SO + (size_t)row0 * 512 + col0;
#pragma unroll
        for (int i = 0; i < 8; ++i) {
            const int id = i * 64 + lane, row = id >> 3, ch = id & 7;
            *(uint4*)(dbase + (size_t)row * 512 + ch * 8) = *(const uint4*)(base + row * 144 + ch * 16);
        }
        asm volatile("s_waitcnt lgkmcnt(0)" ::: "memory");
        __builtin_amdgcn_wave_barrier();
    }
}

__device__ __forceinline__ void phase8(const Params& p) {
    const int NU = 512;
    for (int u = blockIdx.x; u < NU; u += gridDim.x) {
        const int mt = (u & 7) + 8 * (u >> 5), nt = (u >> 3) & 3;
        const u16* A1 = WSP_AO + (size_t)mt * 128 * 512;
        const u16* A2 = WSP_SO + (size_t)mt * 128 * 512;
        const u16* B = WSP_WoutT + (size_t)nt * 256 * 1024;
        f32x4 acc[4][8];
        {
        const int tid1 = TIDX, fq = (tid1 & 63) >> 4, row0 = mt * 128 + (tid1 >> 7) * 64;
        gemm_tile_w(32,
            [&](int i, int R, int C, int kt) { return (const void*)((kt < 16 ? A1 : A2) + (size_t)R * 512 + (kt & 15) * 32 + C); },
            [&](int i, int R, int C, int kt) { return (const void*)(B + (size_t)R * 1024 + kt * 32 + C); }, acc,
            [&](int kt) {
                if (kt == 16) {
#pragma unroll
                    for (int m = 0; m < 4; ++m) {
                        asm volatile("" ::: "memory");
#pragma unroll
                        for (int j = 0; j < 4; ++j) {
                            const float2 q = *(const float2*)(WSP_rsq + (size_t)(row0 + m * 16 + fq * 4 + j) * 2);
                            const float ratio = rsqrtf(q.x * (1.f / 512.f) + EPS) / rsqrtf(q.y * (1.f / 512.f) + EPS);
#pragma unroll
                            for (int n = 0; n < 8; ++n) acc[m][n][j] *= ratio;
                        }
                    }
                }
            });
        }
        const int tid2 = TIDX, lane = tid2 & 63, wid = tid2 >> 6, fr = lane & 15, fq = lane >> 4;
        const int row0 = mt * 128 + (wid >> 1) * 64, col0 = nt * 256 + (wid & 1) * 128;
        const float* g1 = WSP_mod + (mt >> 4) * 6144 + 2048 + col0;
        float* stg = (float*)(smem + wid * 8448);
#pragma unroll
        for (int m = 0; m < 4; ++m) {
#pragma unroll
            for (int n = 0; n < 8; ++n)
#pragma unroll
                for (int j = 0; j < 4; ++j) stg[(fq * 4 + j) * 132 + n * 16 + fr] = acc[m][n][j];
            asm volatile("s_waitcnt lgkmcnt(0)" ::: "memory");
            __builtin_amdgcn_wave_barrier();
#pragma unroll
            for (int i = 0; i < 8; ++i) {
                const int id = i * 64 + lane, rr = id >> 5, c4 = (id & 31) * 4;
                float4 v = *(const float4*)(stg + rr * 132 + c4);
                const float rsv = rsqrtf(WSP_rsq[(size_t)(row0 + m * 16 + rr) * 2 + 1] * (1.f / 512.f) + EPS);
                v.x *= rsv; v.y *= rsv; v.z *= rsv; v.w *= rsv;
                const float4 g = *(const float4*)(g1 + c4);
                const size_t o = (size_t)(row0 + m * 16 + rr) * 1024 + col0 + c4;
                const float4 xv = *(const float4*)(p.x + o);
                *(float4*)(p.out + o) = make_float4(xv.x + g.x * v.x, xv.y + g.y * v.y, xv.z + g.z * v.z, xv.w + g.w * v.w);
            }
            asm volatile("s_waitcnt lgkmcnt(0)" ::: "memory");
            __builtin_amdgcn_wave_barrier();
        }
    }
}

#define CTR_ECNT 0
#define CTR_Q11 128
#define CTR_Q12 136
#define HALF_TOK 8192
#define HH_HALF_ROWS 73728
#define ELIST_CAP 8192
template <int LEVEL>
__device__ __forceinline__ void phase9_t(const Params& p) {
    const int tid = TIDX, lane = tid & 63, wid = tid >> 6, fr = lane & 15, fq = lane >> 4;
    char* At = smem;
    float* sc = (float*)(smem + 65536);
    int* hist = (int*)(smem + 65536 + 8192);
    int* gbase = hist + 64;
    int* fill = gbase + 64;
    unsigned char* selk = (unsigned char*)(fill + 64);
    float* selw = (float*)(selk + 256);
    for (int chunk = blockIdx.x; chunk < NLAT / 32; chunk += gridDim.x) {
        const int tok0 = chunk * 32;
        __syncthreads();
        if (tid < 64) hist[tid] = 0;
#pragma unroll 1
        for (int hb = 0; hb < 2; ++hb) {
            float4 vall[4][4];
#pragma unroll
            for (int rr = 0; rr < 4; ++rr)
#pragma unroll
                for (int i = 0; i < 4; ++i) vall[rr][i] = *(const float4*)(p.out + (size_t)(tok0 + wid * 8 + hb * 4 + rr) * 1024 + i * 256 + lane * 4);
#pragma unroll
            for (int rr = 0; rr < 4; ++rr) {
                const int row = wid * 8 + hb * 4 + rr, tok = tok0 + row;
                const float* md = WSP_mod + (tok >> 11) * 6144;
                float ss = 0.f;
#pragma unroll
                for (int i = 0; i < 4; ++i) ss += vall[rr][i].x * vall[rr][i].x + vall[rr][i].y * vall[rr][i].y + vall[rr][i].z * vall[rr][i].z + vall[rr][i].w * vall[rr][i].w;
                ss = wave_sum(ss);
                const float rs = rsqrtf(ss * (1.f / 1024.f) + EPS);
#pragma unroll
                for (int i = 0; i < 4; ++i) {
                    const int c0 = i * 256 + lane * 4;
                    const float4 v = vall[rr][i];
                    const float4 g = *(const float4*)(p.norm_ffn + c0), s = *(const float4*)(md + 3072 + c0), k = *(const float4*)(md + 4096 + c0);
                    const float a = v.x * rs * g.x * (1.f + k.x) + s.x, b = v.y * rs * g.y * (1.f + k.y) + s.y;
                    const float c = v.z * rs * g.z * (1.f + k.z) + s.z, d = v.w * rs * g.w * (1.f + k.w) + s.w;
                    const uint2 pk = make_uint2(pack2(a, b), pack2(c, d));
                    *(uint2*)(WSP_H2 + (size_t)tok * 1024 + c0) = pk;
                    const int ch = c0 >> 3;
                    *(uint2*)(At + row * 2048 + ((ch ^ (row & 15)) << 4) + ((c0 & 4) << 1)) = pk;
                }
            }
        }
        __syncthreads();
        if (LEVEL == 1) continue;
        {
            f32x4 acc0 = {0.f, 0.f, 0.f, 0.f}, acc1 = {0.f, 0.f, 0.f, 0.f};
            const u16* bp = WSP_WrT + (size_t)(wid * 16 + fr) * 1024 + fq * 8;
#pragma unroll
            for (int kb = 0; kb < 4; ++kb) {
                bf16x8 bfr[8];
#pragma unroll
                for (int q = 0; q < 8; ++q) bfr[q] = *(const bf16x8*)(bp + (kb * 8 + q) * 32);
#pragma unroll
                for (int q = 0; q < 8; ++q) {
                    const int ch = (kb * 8 + q) * 4 + fq;
                    const bf16x8 a0 = *(const bf16x8*)(At + fr * 2048 + ((ch ^ fr) << 4));
                    const bf16x8 a1 = *(const bf16x8*)(At + (16 + fr) * 2048 + ((ch ^ fr) << 4));
                    acc0 = __builtin_amdgcn_mfma_f32_16x16x32_bf16(a0, bfr[q], acc0, 0, 0, 0);
                    acc1 = __builtin_amdgcn_mfma_f32_16x16x32_bf16(a1, bfr[q], acc1, 0, 0, 0);
                }
            }
#pragma unroll
            for (int j = 0; j < 4; ++j) {
                sc[(fq * 4 + j) * 64 + wid * 16 + fr] = sigmoidf_(acc0[j]);
                sc[(16 + fq * 4 + j) * 64 + wid * 16 + fr] = sigmoidf_(acc1[j]);
            }
        }
        __syncthreads();
        if (LEVEL == 2) continue;
        const float bias = p.router_bias[lane];
        const int eg = lane >> 3;
#pragma unroll 2
        for (int rr = 0; rr < 8; ++rr) {
            const int row = wid * 8 + rr;
            const float s = sc[row * 64 + lane];
            const float bz = s + bias;
            const float m1 = max8(bz);
            const unsigned long long eq = __ballot(bz == m1);
            const unsigned gb = (unsigned)((eq >> (eg * 8)) & 0xffull);
            const int first = __ffs(gb) - 1;
            const float v2 = max8(((lane & 7) == first) ? -1e30f : bz);
            const float gs = m1 + v2;
            int cnt = 0;
#pragma unroll
            for (int j = 0; j < 8; ++j) {
                const float gj = __int_as_float(__builtin_amdgcn_readlane(__float_as_int(gs), j * 8));
                cnt += (gj > gs || (gj == gs && j < eg)) ? 1 : 0;
            }
            const bool gsel = cnt < 4;
            const float mv = gsel ? bz : -1e30f;
            unsigned long long gm = __ballot(gsel);
            int rank = 0;
#pragma unroll 1
            for (int it = 0; it < 4; ++it) {
                const int jb = __builtin_amdgcn_readfirstlane(__ffsll((long long)gm) - 1);
                gm &= ~(0xffull << jb);
#pragma unroll
                for (int j = 0; j < 8; ++j) {
                    const float vj = __int_as_float(__builtin_amdgcn_readlane(__float_as_int(mv), jb + j));
                    rank += (vj > mv || (vj == mv && (jb + j) < lane)) ? 1 : 0;
                }
            }
            const bool sel = gsel && rank < 8;
            unsigned long long sm = __ballot(sel);
            float tot = 0.f;
#pragma unroll 1
            for (int it = 0; it < 8; ++it) {
                const int l = __builtin_amdgcn_readfirstlane(__ffsll((long long)sm) - 1);
                sm &= sm - 1;
                tot += __int_as_float(__builtin_amdgcn_readlane(__float_as_int(s), l));
            }
            if (sel) {
                selw[row * 8 + rank] = s / tot * 2.5f;
                selk[row * 8 + rank] = (unsigned char)lane;
                atomicAdd(&hist[lane], 1);
            }
        }
        __syncthreads();
        const int h = tok0 >> 13;
        if (tid < 64) {
            gbase[tid] = hist[tid] ? (int)atomicAdd(&WSP_ctr[CTR_ECNT + h * 64 + tid], (unsigned)hist[tid]) : 0;
            fill[tid] = 0;
        }
        __syncthreads();
        {
            const int e = selk[tid];
            const int pos = atomicAdd(&fill[e], 1);
            WSP_elist[(size_t)(h * 64 + e) * ELIST_CAP + gbase[e] + pos] = (tok0 + (tid >> 3)) * 8 + (tid & 7);
            WSP_wsl[(size_t)(h * 64 + e) * ELIST_CAP + gbase[e] + pos] = selw[tid];
        }
    }
}

struct MoeTab { int cnt[16]; int soff[16]; int pre[17]; };

template <class FV, class FD>
__device__ __forceinline__ void wave_store_fp8_f(FV val, FD dst) {
    const int lane = TIDX & 63, wid = TIDX >> 6, fr = lane & 15, fq = lane >> 4;
    char* base = smem + wid * 9216;
#pragma unroll
    for (int m = 0; m < 4; ++m)
#pragma unroll
        for (int n = 0; n < 8; ++n)
#pragma unroll
            for (int j = 0; j < 4; ++j)
                *(unsigned char*)(base + (m * 16 + fq * 4 + j) * 144 + n * 16 + fr) =
                    (unsigned char)(__builtin_amdgcn_cvt_pk_fp8_f32(val(m, n, j), 0.f, 0, false) & 0xff);
    asm volatile("s_waitcnt lgkmcnt(0)" ::: "memory");
    __builtin_amdgcn_wave_barrier();
#pragma unroll
    for (int i = 0; i < 8; ++i) {
        const int id = i * 64 + lane, row = id >> 3, ch = id & 7;
        const uint4 d = *(const uint4*)(base + row * 144 + ch * 16);
        unsigned char* q = dst(i, row);
        if (q) { const u32x4 t = {d.x, d.y, d.z, d.w}; __builtin_nontemporal_store(t, (u32x4*)(q + ch * 16)); }
    }
    asm volatile("s_waitcnt lgkmcnt(0)" ::: "memory");
    __builtin_amdgcn_wave_barrier();
}

#define YD_SCALE 8.0f
template <int MODE>
__device__ __forceinline__ void phase11f(const Params& p) {
    const int tid = TIDX;
    int* tab = (int*)(smem + 73728);
    int* t_cnt = tab, *t_soff = tab + 16, *t_pre = tab + 32, *t_q = tab + 52;
    int* t_all = tab + 64;
    const int x = blockIdx.x & 7;
    unsigned* flags = WSP_flag + x * FLAG_PER_CLASS;
    unsigned* tmo = WSP_flag + 8 * FLAG_PER_CLASS;
    unsigned char* Yd8 = (unsigned char*)(p.ws + OFF_ARENA);
    __syncthreads();
    if (tid < 128) t_all[tid] = (int)WSP_ctr[CTR_ECNT + tid];
    unsigned* qhead = &WSP_ctr[(MODE == 2 ? CTR_Q12 : CTR_Q11) + x];
    if (tid == 0) t_q[0] = (int)atomicAdd(qhead, 1u);
    __syncthreads();
    if (tid < 16) {
        const int i = tid >> 1, h = tid & 1, e = x + 8 * i;
        t_cnt[tid] = t_all[h * 64 + e];
        int so = 0;
        for (int e2 = 0; e2 < e; ++e2) so += t_all[h * 64 + e2];
        t_soff[tid] = so;
    }
    __syncthreads();
    if (tid == 0) {
        int s = 0;
        for (int j = 0; j < 16; ++j) { t_pre[j] = s; s += (t_cnt[j] + 127) >> 7; }
        t_pre[16] = s;
    }
    __syncthreads();
    const int T_r = t_pre[16], T11 = T_r + 16, T_all = (MODE == 1) ? T11 : T11 + T_r * 4;
    for (;;) {
        __syncthreads();
        const int q = __builtin_amdgcn_readfirstlane(t_q[0]) + (MODE == 2 ? T11 : 0);
        __syncthreads();
        if (q >= T_all) break;
        if (tid == 0) t_q[0] = (int)atomicAdd(qhead, 1u);
        const bool is_down = q >= T11;
        const int u = is_down ? (q - T11) >> 2 : q;
        int nt = is_down ? (q - T11) & 3 : 0;
        int e, h, mt, c, rowbase;
        if (u < T_r) {
            int j = 0;
#pragma unroll
            for (int qq = 1; qq < 16; ++qq) j += (u >= t_pre[qq]) ? 1 : 0;
            e = x + 8 * (j >> 1); h = j & 1; mt = u - t_pre[j]; c = t_cnt[j];
            rowbase = h * HH_HALF_ROWS + t_soff[j];
        } else {
            const int ms = x * 16 + (u - T_r);
            e = 64; h = ms >> 6; mt = ms & 63; c = HALF_TOK;
            rowbase = h * HH_HALF_ROWS + 65536;
        }
        e = __builtin_amdgcn_readfirstlane(e); h = __builtin_amdgcn_readfirstlane(h); mt = __builtin_amdgcn_readfirstlane(mt);
        nt = __builtin_amdgcn_readfirstlane(nt); c = __builtin_amdgcn_readfirstlane(c); rowbase = __builtin_amdgcn_readfirstlane(rowbase);
        const int* el = WSP_elist + (size_t)(h * 64 + (e & 63)) * ELIST_CAP;
        if (!is_down) {
            const int t2 = TIDX, lane = t2 & 63, wid = t2 >> 6, wr = wid >> 1, wc = wid & 1, fr = lane & 15, fq = lane >> 4;
            const int sb = lane * 16, swz = sb ^ (((sb >> 9) & 1) << 5);
            const int r_in = swz >> 6, c_in = (swz & 63) >> 1;
            const int vrows = c - mt * 128 - wr * 64;
            const float* wsl = WSP_wsl + (size_t)(h * 64 + (e & 63)) * ELIST_CAP;
            const u16* aptr[2];
#pragma unroll
            for (int i = 0; i < 2; ++i) {
                int li = mt * 128 + (wid + 4 * i) * 16 + r_in;
                li = li < c ? li : c - 1;
                const int tok = (e < 64) ? (el[li] >> 3) : (h * HALF_TOK + li);
                aptr[i] = WSP_H2 + (size_t)tok * 1024 + c_in;
            }
            const u16* Bw = WSP_WguT + (size_t)e * 262144 + c_in;
            f32x4 acc[4][8];
            gemm_tile_w(32,
                [&](int i, int R, int C, int kt) { return (const void*)(aptr[i] + kt * 32); },
                [&](int i, int R, int C, int kt) { return (const void*)(Bw + (size_t)R * 1024 + kt * 32); }, acc);
            float wgt[4][4];
#pragma unroll
            for (int m = 0; m < 4; ++m)
#pragma unroll
                for (int j = 0; j < 4; ++j) {
                    const int li = mt * 128 + wr * 64 + m * 16 + fq * 4 + j;
                    float w = 1.f;
                    if (e < 64) w = (li < c) ? wsl[li] : 0.f;
                    wgt[m][j] = w;
                }
            u16* dbase = WSP_HHs + ((size_t)rowbase + mt * 128 + wr * 64) * 128 + wc * 64;
            wave_store_bf16_f([&](int m, int n2, int j) { return siluf_(acc[m][2 * n2][j]) * acc[m][2 * n2 + 1][j] * wgt[m][j]; },
                              [&](int row) { return row < vrows ? dbase + (size_t)row * 128 : (u16*)nullptr; }, true, (const char*)WSP_HHs, (unsigned)((size_t)2 * HH_HALF_ROWS * 128 * 2));
            asm volatile("s_waitcnt vmcnt(0)" ::: "memory");
            __syncthreads();
            if (tid == 0) __hip_atomic_store(&flags[u], 1u, __ATOMIC_RELAXED, __HIP_MEMORY_SCOPE_AGENT);
        } else {
            const int t2 = TIDX, lane = t2 & 63, wid = t2 >> 6, wr = wid >> 1, wc = wid & 1, fr = lane & 15, fq = lane >> 4;
            const int sb = lane * 16, swz = sb ^ (((sb >> 9) & 1) << 5);
            const int r_in = swz >> 6, c_in = (swz & 63) >> 1;
            const int vrows = c - mt * 128 - wr * 64;
            if (MODE == 0 && tid == 0) {
                unsigned sp = 0;
                while (__hip_atomic_load(&flags[u], __ATOMIC_RELAXED, __HIP_MEMORY_SCOPE_AGENT) == 0u) {
                    __builtin_amdgcn_s_sleep(2);
                    if ((++sp & 255u) == 0u) {
                        if (__hip_atomic_load(tmo, __ATOMIC_RELAXED, __HIP_MEMORY_SCOPE_AGENT)) break;
                        if (sp > (1u << 20)) { atomicAdd(tmo, 1u); break; }
                    }
                }
            }
            __syncthreads();
            const u16* aptr[2];
#pragma unroll
            for (int i = 0; i < 2; ++i) {
                int li = mt * 128 + (wid + 4 * i) * 16 + r_in;
                li = li < c ? li : c - 1;
                aptr[i] = WSP_HHs + ((size_t)rowbase + li) * 128 + c_in;
            }
            const u16* Bw = WSP_WdT + ((size_t)e * 1024 + nt * 256) * 128 + c_in;
            int slot[8];
            if (e < 64) {
#pragma unroll
                for (int i = 0; i < 8; ++i) {
                    int li = mt * 128 + wr * 64 + ((i * 64 + lane) >> 3);
                    li = li < c ? li : c - 1;
                    slot[i] = el[li];
                }
            } else {
#pragma unroll
                for (int i = 0; i < 8; ++i) slot[i] = (h * HALF_TOK + mt * 128 + wr * 64 + ((i * 64 + lane) >> 3)) * 8;
            }
            f32x4 acc[4][8];
            gemm_tile_w<true>(4,
                [&](int i, int R, int C, int kt) { return (const void*)(aptr[i] + kt * 32); },
                [&](int i, int R, int C, int kt) { return (const void*)(Bw + (size_t)R * 128 + kt * 32); }, acc);
            const int colo = nt * 256 + wc * 128;
            if (e < 64) {
                wave_store_fp8_f([&](int m, int n, int j) { return acc[m][n][j] * YD_SCALE; }, [&](int i, int row) {
                    if (row >= vrows) return (unsigned char*)nullptr;
                    const int s = slot[i];
                    return Yd8 + ((size_t)(s >> 3) * 8 + (s & 7)) * 1024 + colo;
                });
            } else {
                const int tok0 = h * HALF_TOK + mt * 128 + wr * 64;
                const float* g2 = WSP_mod + (tok0 >> 11) * 6144 + 5120 + colo;
                float* stg = (float*)(smem + wid * 8448);
#pragma unroll
                for (int m = 0; m < 4; ++m) {
#pragma unroll
                    for (int n = 0; n < 8; ++n)
#pragma unroll
                        for (int j = 0; j < 4; ++j) stg[(fq * 4 + j) * 132 + n * 16 + fr] = acc[m][n][j];
                    asm volatile("s_waitcnt lgkmcnt(0)" ::: "memory");
                    __builtin_amdgcn_wave_barrier();
#pragma unroll
                    for (int i = 0; i < 8; ++i) {
                        const int id = i * 64 + lane, rr = id >> 5, c4 = (id & 31) * 4;
                        const float4 v = *(const float4*)(stg + rr * 132 + c4);
                        const float4 g = *(const float4*)(g2 + c4);
                        float* op = p.out + (size_t)(tok0 + m * 16 + rr) * 1024 + colo + c4;
                        const float4 xv = *(const float4*)op;
                        *(float4*)op = make_float4(xv.x + g.x * v.x, xv.y + g.y * v.y, xv.z + g.z * v.z, xv.w + g.w * v.w);
                    }
                    asm volatile("s_waitcnt lgkmcnt(0)" ::: "memory");
                    __builtin_amdgcn_wave_barrier();
                }
            }
        }
    }
}

#define P12_SLD 2064
template <bool DUMMY>
__device__ __forceinline__ void phase12b_t(const Params& p) {
    const int tid = TIDX, lane = tid & 63, wid = tid >> 6, fr = lane & 15, fq = lane >> 4;
    const unsigned char* Yd8 = (const unsigned char*)(p.ws + OFF_ARENA);
    const u16* Wb = WSP_WdT + (size_t)64 * 131072 + (size_t)(wid * 256 + fr) * 128 + fq * 8;
    for (int tile = blockIdx.x; tile < NLAT / 32; tile += gridDim.x) {
        const int tok0 = tile * 32;
        const int hh = tok0 >> 13;
        const u16* Ab = WSP_HHs + ((size_t)hh * HH_HALF_ROWS + 65536 + (tok0 & 8191) + fr) * 128 + fq * 8;
        __syncthreads();
        bf16x8 af[2][4];
#pragma unroll
        for (int m = 0; m < 2; ++m)
#pragma unroll
            for (int ks = 0; ks < 4; ++ks) af[m][ks] = *(const bf16x8*)(Ab + (size_t)m * 16 * 128 + ks * 32);
#pragma unroll 1
        for (int nb = 0; nb < 4; ++nb) {
            bf16x8 bfr[4][4];
#pragma unroll
            for (int n = 0; n < 4; ++n)
#pragma unroll
                for (int ks = 0; ks < 4; ++ks) bfr[n][ks] = *(const bf16x8*)(Wb + (size_t)((nb * 4 + n) * 16) * 128 + ks * 32);
#pragma unroll
            for (int m = 0; m < 2; ++m)
#pragma unroll
                for (int n = 0; n < 4; ++n) {
                    f32x4 d = {0.f, 0.f, 0.f, 0.f};
#pragma unroll
                    for (int ks = 0; ks < 4; ++ks) d = __builtin_amdgcn_mfma_f32_16x16x32_bf16(af[m][ks], bfr[n][ks], d, 0, 0, 0);
                    const int col = wid * 256 + (nb * 4 + n) * 16 + fr;
#pragma unroll
                    for (int j = 0; j < 4; ++j) *(u16*)(smem + (m * 16 + fq * 4 + j) * P12_SLD + col * 2) = f2bf(d[j]);
                }
        }
        __syncthreads();
        for (int rr = 0; rr < 8; ++rr) {
            const int row = wid * 8 + rr, tok = tok0 + row;
            float* xrow = p.out + (size_t)tok * 1024 + lane * 16;
            float* orow = DUMMY ? (float*)(p.ws + OFF_HHS) + (size_t)(tok & 8191) * 1024 + lane * 16 : xrow;
            const float* g2 = WSP_mod + (tok >> 11) * 6144 + 5120 + lane * 16;
            float s[16];
#pragma unroll
            for (int i = 0; i < 16; ++i) s[i] = 0.f;
            const unsigned char* yp = Yd8 + (size_t)tok * 8 * 1024 + lane * 16;
            uint4 yv[8];
#pragma unroll
            for (int k = 0; k < 8; ++k) { const u32x4 t = __builtin_nontemporal_load((const u32x4*)(yp + k * 1024)); yv[k] = make_uint4(t[0], t[1], t[2], t[3]); }
#pragma unroll
            for (int k = 0; k < 8; ++k) {
                const unsigned w[4] = {yv[k].x, yv[k].y, yv[k].z, yv[k].w};
#pragma unroll
                for (int i = 0; i < 4; ++i) {
                    const auto lo = __builtin_amdgcn_cvt_pk_f32_fp8((int)w[i], false);
                    const auto hi = __builtin_amdgcn_cvt_pk_f32_fp8((int)w[i], true);
                    s[4 * i] += lo[0]; s[4 * i + 1] += lo[1]; s[4 * i + 2] += hi[0]; s[4 * i + 3] += hi[1];
                }
            }
            const uint4 sa = *(const uint4*)(smem + row * P12_SLD + lane * 32), sbv = *(const uint4*)(smem + row * P12_SLD + lane * 32 + 16);
            const unsigned sw[8] = {sa.x, sa.y, sa.z, sa.w, sbv.x, sbv.y, sbv.z, sbv.w};
#pragma unroll
            for (int i = 0; i < 8; ++i) {
                s[2 * i] = s[2 * i] * (1.f / YD_SCALE) + bf2f((u16)(sw[i] & 0xffffu));
                s[2 * i + 1] = s[2 * i + 1] * (1.f / YD_SCALE) + bf2f((u16)(sw[i] >> 16));
            }
            float ss = 0.f;
#pragma unroll
            for (int q = 0; q < 4; ++q) {
                const float4 xv = *(const float4*)(xrow + q * 4), gv = *(const float4*)(g2 + q * 4);
                s[4 * q] = xv.x + gv.x * s[4 * q]; s[4 * q + 1] = xv.y + gv.y * s[4 * q + 1];
                s[4 * q + 2] = xv.z + gv.z * s[4 * q + 2]; s[4 * q + 3] = xv.w + gv.w * s[4 * q + 3];
                ss += s[4 * q] * s[4 * q] + s[4 * q + 1] * s[4 * q + 1] + s[4 * q + 2] * s[4 * q + 2] + s[4 * q + 3] * s[4 * q + 3];
            }
            ss = wave_sum(ss);
            const float rs = rsqrtf(ss * (1.f / 1024.f) + EPS);
#pragma unroll
            for (int q = 0; q < 4; ++q) {
                const float4 g = *(const float4*)(p.norm_final + lane * 16 + q * 4);
                *(float4*)(orow + q * 4) = make_float4(s[4 * q] * rs * g.x, s[4 * q + 1] * rs * g.y, s[4 * q + 2] * rs * g.z, s[4 * q + 3] * rs * g.w);
            }
        }
    }
}

#define SMEM_TOTAL (73728 + 3072 + 64)

#if 1
__global__ void __launch_bounds__(NTHR, 2) k_mega(Params p) {
    volatile LAS unsigned* st = (volatile LAS unsigned*)(smem + SMEM_TOTAL - 16);
    if (TIDX == 0) { st[0] = 0u; st[1] = 0u; st[2] = 0u; st[3] = 0u; }
    __syncthreads();
    XcdBarrier bar = xcd_barrier_post(WSP_bar, st);
#define RUNP(N) do { phase##N(p); if (PROBE_DUP == N) phase##N(p); } while (0)
    RUNP(0);  xcd_barrier(bar);
    RUNP(1);  xcd_barrier(bar);
    RUNP(2);  xcd_barrier(bar);
    RUNP(3);  xcd_barrier(bar);
    RUNP(4);  xcd_barrier(bar);
    RUNP(5);  xcd_barrier(bar);
    RUNP(6);  xcd_barrier(bar);
    RUNP(8);  xcd_barrier(bar);
#if PROBE_DUP == 91
    phase9_t<1>(p); xcd_barrier(bar);
#endif
#if PROBE_DUP == 92
    phase9_t<2>(p); xcd_barrier(bar);
#endif
    phase9_t<0>(p); xcd_barrier(bar);
#if PROBE_DUP == 9
    if (blockIdx.x == 0 && TIDX < 128) WSP_ctr[CTR_ECNT + TIDX] = 0u;
    xcd_barrier(bar); phase9_t<0>(p); xcd_barrier(bar);
#endif
#ifndef MOE_FUSED
#define MOE_FUSED 1
#endif
#if MOE_FUSED
    phase11f<0>(p); xcd_barrier(bar);
#else
    phase11f<1>(p); xcd_barrier(bar);
    phase11f<2>(p); xcd_barrier(bar);
#endif
#if PROBE_DUP == 11
    if (blockIdx.x == 0 && TIDX < 8) WSP_ctr[CTR_Q11 + TIDX] = 0u;
    if (blockIdx.x == 1) for (int i = TIDX; i < 8 * FLAG_PER_CLASS; i += NTHR) WSP_flag[i] = 0u;
    xcd_barrier(bar); phase11f<0>(p); xcd_barrier(bar);
#endif
#if PROBE_DUP == 121
    phase12b_t<true>(p); xcd_barrier(bar);
#endif
    phase12b_t<false>(p);
}
#endif


extern "C" void kernel_launch(void* const* d_in, const int* in_sizes, int n_in,
                              void* d_out, int out_size, void* d_ws, size_t ws_size,
                              hipStream_t stream) {
    Params p{};
    const float** ip = (const float**)&p.x;
    for (int i = 0; i < 32; ++i) ip[i] = (const float*)d_in[i];
    p.out = (float*)d_out;
    p.ws = (char*)d_ws;
    if (OFF_END > ws_size) { fprintf(stderr, "workspace too small: need %zu have %zu\n", (size_t)OFF_END, ws_size); return; }

    static int grid = 0;
    if (!grid) {
        hipFuncSetAttribute((const void*)k_mega, hipFuncAttributeMaxDynamicSharedMemorySize, SMEM_TOTAL);
        int dev = 0, cus = 0, per_cu = 0;
        hipGetDevice(&dev);
        hipDeviceGetAttribute(&cus, hipDeviceAttributeMultiprocessorCount, dev);
        hipOccupancyMaxActiveBlocksPerMultiprocessor(&per_cu, (const void*)k_mega, NTHR, SMEM_TOTAL);
        if (per_cu < 1) per_cu = 1;
        grid = cus * (per_cu < 2 ? per_cu : 2);
    }
    hipMemsetAsync(p.ws + OFF_BAR, 0, ZERO_BYTES, stream);
    k_mega<<<grid, NTHR, SMEM_TOTAL, stream>>>(p);
}
```

```cpp
#include <hip/hip_runtime.h>
#include <hip/hip_bf16.h>
#include <stdint.h>
#include <stdio.h>

#ifndef MK_MULTI
#define MK_MULTI 0
#endif

typedef __attribute__((ext_vector_type(8))) short bf16x8;
typedef __attribute__((ext_vector_type(4))) short bf16x4;
typedef __attribute__((ext_vector_type(4))) float f32x4;
typedef unsigned short u16;
typedef __attribute__((ext_vector_type(4))) unsigned u32x4;

#ifndef PROBE_DUP
#define PROBE_DUP -1
#endif
#define NTHR 256
__device__ __forceinline__ int opaque_tid() { int t = (int)threadIdx.x; asm volatile("" : "+v"(t)); return t; }
#define TIDX opaque_tid()
#define LDS_BYTES 65536

#define D_MODEL 1024
#define BATCH 8
#define SEQ 2048
#define CTXL 256
#define NLAT (BATCH * SEQ)
#define NCTX (BATCH * CTXL)
#define NROWS (NLAT + NCTX)
#define INW 1280
#define NEXP 64
#define VT_LD (SEQ + CTXL)
#define NCHUNK_LAT 1024
#define NCHUNK_ALL 1152
#define EPS 1e-6f

#define XB_TMO      128
#define XB_XCNT(j)  (256  + 64 * (j))
#define XB_XSUB(j)  (1280 + 64 * (j))
#define XB_XGEN(j)  (2304 + 64 * (j))
#define XB_TOP      3328
#define XB_TOPGEN   3392
#define XCD_BAR_WORDS 3456
#define XB_SPIN_CAP (1u << 20)
#define LAS __attribute__((address_space(3)))

__device__ __forceinline__ unsigned xb_ld(unsigned* p)              { return __hip_atomic_load(p, __ATOMIC_RELAXED, __HIP_MEMORY_SCOPE_AGENT); }
__device__ __forceinline__ unsigned xb_add(unsigned* p, unsigned v) { return __hip_atomic_fetch_add(p, v, __ATOMIC_RELAXED, __HIP_MEMORY_SCOPE_AGENT); }
__device__ __forceinline__ unsigned xb_xcc_id() { return (unsigned)__builtin_amdgcn_s_getreg((3 << 11) | 20) & 0xFu; }
#define XB_SPIN(cond, bar) do { unsigned _sp = 0; while (cond) { __builtin_amdgcn_s_sleep(1); \
    if ((++_sp & 255u) == 0u) { if (xb_ld(&(bar)[XB_TMO])) break; if (_sp > XB_SPIN_CAP) { atomicAdd(&(bar)[XB_TMO], 1u); break; } } } } while (0)

struct XcdBarrier { unsigned* bar; unsigned x; volatile LAS unsigned* st; };

__device__ __forceinline__ XcdBarrier xcd_barrier_post(unsigned* bar, volatile LAS unsigned* st) {
    XcdBarrier b; b.bar = bar; b.x = xb_xcc_id(); b.st = st;
    if (TIDX == 0) (void)xb_add(&bar[XB_XCNT(b.x)], 1u);
    return b;
}
__device__ __forceinline__ void xcd_barrier_complete(unsigned* bar, unsigned x, unsigned& nloc, unsigned& nx) {
    const unsigned G = gridDim.x * gridDim.y * gridDim.z;
    unsigned sum, cnt, mine, sp = 0u;
    for (;;) {
        sum = 0u; cnt = 0u; mine = 0u;
#pragma unroll
        for (unsigned j = 0; j < 16; ++j) { const unsigned c = xb_ld(&bar[XB_XCNT(j)]); sum += c; cnt += (c > 0u) ? 1u : 0u; mine = (j == x) ? c : mine; }
        if (sum == G) break;
        __builtin_amdgcn_s_sleep(1);
        if ((++sp & 255u) == 0u) { if (xb_ld(&bar[XB_TMO])) break; if (sp > XB_SPIN_CAP) { atomicAdd(&bar[XB_TMO], 1u); break; } }
    }
    nloc = mine > 0u ? mine : 1u; nx = cnt > 0u ? cnt : 1u;
}
__device__ __forceinline__ void xcd_barrier(const XcdBarrier& b) {
    asm volatile("s_waitcnt vmcnt(0)" ::: "memory");
    __syncthreads();
    if (TIDX == 0) {
        unsigned* bar = b.bar;
        __builtin_amdgcn_s_waitcnt(0);
        unsigned nloc = b.st[0], nx = b.st[1];
        if (nloc == 0u) { xcd_barrier_complete(bar, b.x, nloc, nx); b.st[0] = nloc; b.st[1] = nx; }
        const unsigned old = xb_add(&bar[XB_XSUB(b.x)], 1u);
        const unsigned gen = old / nloc;
        if (old + 1u == (gen + 1u) * nloc) {
            __builtin_amdgcn_fence(__ATOMIC_RELEASE, "agent");
            asm volatile("s_waitcnt vmcnt(0)" ::: "memory");
            const unsigned og = xb_add(&bar[XB_TOP], 1u);
            const unsigned tg = og / nx;
            if (og + 1u == (tg + 1u) * nx) xb_add(&bar[XB_TOPGEN], 1u);
            else XB_SPIN(xb_ld(&bar[XB_TOPGEN]) == tg, bar);
            __builtin_amdgcn_fence(__ATOMIC_ACQUIRE, "agent");
            xb_add(&bar[XB_XGEN(b.x)], 1u);
            asm volatile("s_waitcnt vmcnt(0)" ::: "memory");
        } else {
            XB_SPIN(xb_ld(&bar[XB_XGEN(b.x)]) == gen, bar);
            __builtin_amdgcn_fence(__ATOMIC_ACQUIRE, "agent");
            asm volatile("s_waitcnt vmcnt(0)" ::: "memory");
        }
    }
    __syncthreads();
}

struct Params {
    const float *x, *c, *ctx, *c_ctx, *w_ada, *b_ada, *norm_mix, *norm_ffn, *w_in, *attn_sink,
        *a_re, *a_im, *log_dt, *b_re, *b_im, *c_re, *c_im, *ssm_d, *w_glu, *b_glu, *norm_attn_out, *norm_ssm_out,
        *w_out, *w_router, *router_bias, *w_gate_e, *w_up_e, *w_down_e, *w_gate_s, *w_up_s, *w_down_s, *norm_final;
    float* out;
    char* ws;
};

constexpr size_t A256(size_t v) { return (v + 255) & ~(size_t)255; }
constexpr size_t OFF_BAR   = 0;
constexpr size_t OFF_RSQ   = A256(OFF_BAR + XCD_BAR_WORDS * 4 + 1024);
#define FLAG_PER_CLASS 1280
constexpr size_t OFF_FLAG  = OFF_RSQ + (size_t)NLAT * 2 * 4;
constexpr size_t ZERO_BYTES = OFF_FLAG + (8 * FLAG_PER_CLASS + 64) * 4;
constexpr size_t OFF_MOD   = A256(ZERO_BYTES);
constexpr size_t OFF_ROPE  = A256(OFF_MOD + 9 * 6144 * 4);
constexpr size_t OFF_KBUF  = A256(OFF_ROPE + 64 * 16 * 8);
constexpr size_t OFF_ELIST = A256(OFF_KBUF + (size_t)32 * 2 * 4096 * 4);
constexpr size_t OFF_WSL   = A256(OFF_ELIST + (size_t)2 * 64 * 8192 * 4);
constexpr size_t OFF_WDT   = A256(OFF_WSL + (size_t)2 * 64 * 8192 * 4);
constexpr size_t OFF_HHS   = A256(OFF_WDT + (size_t)65 * 1024 * 128 * 2);
constexpr size_t OFF_WGUT  = A256(OFF_HHS + (size_t)2 * 73728 * 128 * 2);
constexpr size_t OFF_H2R   = A256(OFF_WGUT + (size_t)65 * 256 * 1024 * 2);
constexpr size_t OFF_ARENA = A256(OFF_H2R + (size_t)NLAT * 1024 * 2);
constexpr size_t OFF_TABS  = OFF_ARENA;
constexpr size_t OFF_TABY  = A256(OFF_TABS + (size_t)32 * 256 * 256 * 2);
constexpr size_t OFF_R1    = A256(OFF_TABY + (size_t)32 * 256 * 512 * 2);
constexpr size_t OFF_R2    = A256(OFF_R1 + (size_t)NROWS * 1024 * 2);
constexpr size_t OFF_R4    = A256(OFF_R2 + (size_t)NLAT * 1024 * 2);
constexpr size_t OFF_WINT  = A256(OFF_R4 + (size_t)NLAT * 512 * 2 * 2);
constexpr size_t OFF_WGLUT = A256(OFF_WINT + (size_t)1280 * 1024 * 2);
constexpr size_t OFF_WOUTT = A256(OFF_WGLUT + (size_t)512 * 512 * 2);
constexpr size_t OFF_WRT   = A256(OFF_WOUTT + (size_t)1024 * 1024 * 2);
constexpr size_t OFF_EARLY_END = A256(OFF_WRT + (size_t)128 * 1024 * 2);
constexpr size_t YD8_BYTES = (size_t)NLAT * 8 * 1024;
constexpr size_t OFF_END   = (OFF_EARLY_END > OFF_ARENA + YD8_BYTES) ? OFF_EARLY_END : A256(OFF_ARENA + YD8_BYTES);
static_assert(OFF_END <= (size_t)256 * 1024 * 1024, "workspace map must fit the guaranteed 256 MiB");
#define CTR_QS1 160
#define WSP_bar   ((unsigned*)(p.ws + OFF_BAR))
#define WSP_ctr   ((unsigned*)(p.ws + OFF_BAR) + XCD_BAR_WORDS)
#define WSP_rsq   ((float*)(p.ws + OFF_RSQ))
#define WSP_flag  ((unsigned*)(p.ws + OFF_FLAG))
#define WSP_mod   ((float*)(p.ws + OFF_MOD))
#define WSP_rope  ((float2*)(p.ws + OFF_ROPE))
#define WSP_Kbuf  ((float*)(p.ws + OFF_KBUF))
#define WSP_elist ((int*)(p.ws + OFF_ELIST))
#define WSP_wsl   ((float*)(p.ws + OFF_WSL))
#define WSP_WinT  ((u16*)(p.ws + OFF_WINT))
#define WSP_WgluT ((u16*)(p.ws + OFF_WGLUT))
#define WSP_WoutT ((u16*)(p.ws + OFF_WOUTT))
#define WSP_WrT   ((u16*)(p.ws + OFF_WRT))
#define WSP_WdT   ((u16*)(p.ws + OFF_WDT))
#define WSP_HHs   ((u16*)(p.ws + OFF_HHS))
#define WSP_WguT  ((u16*)(p.ws + OFF_WGUT))
#define WSP_TabS  ((u16*)(p.ws + OFF_TABS))
#define WSP_TabY  ((u16*)(p.ws + OFF_TABY))
#define WSP_Hb    ((u16*)(p.ws + OFF_R1))
#define WSP_S     ((float*)(p.ws + OFF_R1))
#define WSP_H2    ((u16*)(p.ws + OFF_H2R))
#define WSP_Q     ((u16*)(p.ws + OFF_R2))
#define WSP_Kb    ((u16*)(p.ws + OFF_R2 + (size_t)NLAT * 512 * 2))
#define WSP_Vt    ((u16*)(p.ws + OFF_R2 + (size_t)NLAT * 512 * 2 + (size_t)NROWS * 128 * 2))
#define WSP_Y     ((u16*)(p.ws + OFF_R2))
#define WSP_SO    ((u16*)(p.ws + OFF_R2 + (size_t)NLAT * 512 * 2))
#define WSP_U     ((u16*)(p.ws + OFF_H2R))
#define WSP_AO    ((u16*)(p.ws + OFF_R4))
#define WSP_Hin   ((u16*)(p.ws + OFF_R4 + (size_t)NLAT * 512 * 2))

extern __shared__ __attribute__((aligned(16))) char smem[];

typedef __bf16 bf2_t __attribute__((ext_vector_type(2)));
typedef float f2_t __attribute__((ext_vector_type(2)));
__device__ __forceinline__ unsigned pack2(float a, float b) {
    const f2_t v = {a, b};
    return __builtin_bit_cast(unsigned, __builtin_convertvector(v, bf2_t));
}
__device__ __forceinline__ u16 f2bf(float f) { return (u16)(pack2(f, 0.f) & 0xffffu); }
__device__ __forceinline__ float bf2f(u16 h) { return __uint_as_float(((unsigned)h) << 16); }
__device__ __forceinline__ void glds16(const void* g, void* l) {
    __builtin_amdgcn_global_load_lds((const unsigned*)g, (unsigned*)l, 16, 0, 0);
}
__device__ __forceinline__ void glds16_sc1(const void* g, void* l) {
    __builtin_amdgcn_global_load_lds((const unsigned*)g, (unsigned*)l, 16, 0, 16);
}
__device__ __forceinline__ int lds_byte(int r, int c) {
    int st = (r >> 4) * 2 + (c >> 5), rr = r & 15, cc = c & 31, ob = rr * 64 + cc * 2;
    return st * 1024 + (ob ^ (((ob >> 9) & 1) << 5));
}
template <int CTRL> __device__ __forceinline__ float dppf(float v) {
    return __int_as_float(__builtin_amdgcn_update_dpp(0, __float_as_int(v), CTRL, 0xf, 0xf, true));
}
__device__ __forceinline__ float sum_x16(float v) {
    const unsigned u = __float_as_uint(v);
    const auto r = __builtin_amdgcn_permlane16_swap(u, u, false, false);
    return __uint_as_float(r[0]) + __uint_as_float(r[1]);
}
__device__ __forceinline__ float sum_x32(float v) {
    const unsigned u = __float_as_uint(v);
    const auto r = __builtin_amdgcn_permlane32_swap(u, u, false, false);
    return __uint_as_float(r[0]) + __uint_as_float(r[1]);
}
__device__ __forceinline__ float max_x16(float v) {
    const unsigned u = __float_as_uint(v);
    const auto r = __builtin_amdgcn_permlane16_swap(u, u, false, false);
    return fmaxf(__uint_as_float(r[0]), __uint_as_float(r[1]));
}
__device__ __forceinline__ float max_x32(float v) {
    const unsigned u = __float_as_uint(v);
    const auto r = __builtin_amdgcn_permlane32_swap(u, u, false, false);
    return fmaxf(__uint_as_float(r[0]), __uint_as_float(r[1]));
}
__device__ __forceinline__ float sum16(float v) {
    v += dppf<0xB1>(v);
    v += dppf<0x4E>(v);
    v += dppf<0x141>(v);
    v += dppf<0x140>(v);
    return v;
}
__device__ __forceinline__ float wave_sum(float v) { return sum_x32(sum_x16(sum16(v))); }
template <int CTRL> __device__ __forceinline__ float dpp_f(float v) {
    return __int_as_float(__builtin_amdgcn_update_dpp(0, __float_as_int(v), CTRL, 0xf, 0xf, true));
}
__device__ __forceinline__ float max8(float v) {
    v = fmaxf(v, dpp_f<0xB1>(v));
    v = fmaxf(v, dpp_f<0x4E>(v));
    v = fmaxf(v, dpp_f<0x141>(v));
    return v;
}
__device__ __forceinline__ float sigmoidf_(float x) { return __builtin_amdgcn_rcpf(1.f + __expf(-x)); }
__device__ __forceinline__ float siluf_(float x) { return x * __builtin_amdgcn_rcpf(1.f + __expf(-x)); }
__device__ __forceinline__ float gelu_tanh(float x) {
    float u = 0.7978845608028654f * (x + 0.044715f * x * x * x);
    return x * __builtin_amdgcn_rcpf(1.f + __expf(-2.f * u));
}

template <class FA, class FB>
__device__ __forceinline__ void gemm_tile(int nkt, FA fa, FB fb, f32x4 (&acc)[4][4]) {
    const int tid = TIDX, lane = tid & 63, wid = tid >> 6, wr = wid >> 1, wc = wid & 1, fr = lane & 15, fq = lane >> 4;
    const int sb = lane * 16, swz = sb ^ (((sb >> 9) & 1) << 5);
    const int r_in = swz >> 6, c_in = (swz & 63) >> 1;
#pragma unroll
    for (int m = 0; m < 4; ++m)
#pragma unroll
        for (int n = 0; n < 4; ++n) acc[m][n] = (f32x4){0.f, 0.f, 0.f, 0.f};
    __syncthreads();
    auto stage = [&](int kt, int s) {
        char* sa = smem + s * 32768;
        char* sbm = sa + 16384;
#pragma unroll
        for (int i = 0; i < 4; ++i) {
            const int st = wid + 4 * i, R = (st >> 1) * 16 + r_in, C = (st & 1) * 32 + c_in;
            glds16(fa(R, C, kt), sa + tid * 16 + i * 4096);
            glds16(fb(R, C, kt), sbm + tid * 16 + i * 4096);
        }
    };
    stage(0, 0);
    for (int kt = 0; kt < nkt; ++kt) {
        asm volatile("s_waitcnt vmcnt(0)" ::: "memory");
        __syncthreads();
        if (kt + 1 < nkt) stage(kt + 1, (kt + 1) & 1);
        const char* sa = smem + (kt & 1) * 32768;
        const char* sbm = sa + 16384;
#pragma unroll
        for (int ks = 0; ks < 2; ++ks) {
            bf16x8 a[4], b[4];
#pragma unroll
            for (int m = 0; m < 4; ++m) a[m] = *(const bf16x8*)(sa + lds_byte(wr * 64 + m * 16 + fr, ks * 32 + fq * 8));
#pragma unroll
            for (int n = 0; n < 4; ++n) b[n] = *(const bf16x8*)(sbm + lds_byte(wc * 64 + n * 16 + fr, ks * 32 + fq * 8));
            __builtin_amdgcn_s_setprio(1);
#pragma unroll
            for (int m = 0; m < 4; ++m)
#pragma unroll
                for (int n = 0; n < 4; ++n) acc[m][n] = __builtin_amdgcn_mfma_f32_16x16x32_bf16(a[m], b[n], acc[m][n], 0, 0, 0);
            __builtin_amdgcn_s_setprio(0);
        }
    }
    __syncthreads();
}

__device__ __forceinline__ int lds32(int r, int c) {
    const int rr = r & 15;
    return (r >> 4) * 1024 + ((rr * 64 + c * 2) ^ (((rr >> 3) & 1) << 5));
}
struct NoHook { __device__ __forceinline__ void operator()(int) const {} };
template <bool A_SC1 = false, class FA, class FB, class HK = NoHook>
__device__ __forceinline__ void gemm_tile_w(int nkt, FA fa, FB fb, f32x4 (&acc)[4][8], HK hook = HK()) {
    constexpr bool ZERO = true;
    const int tid = TIDX, lane = tid & 63, wid = tid >> 6, wr = wid >> 1, wc = wid & 1, fr = lane & 15, fq = lane >> 4;
    const int sb = lane * 16, swz = sb ^ (((sb >> 9) & 1) << 5);
    const int r_in = swz >> 6, c_in = (swz & 63) >> 1;
    if (ZERO) {
#pragma unroll
        for (int m = 0; m < 4; ++m)
#pragma unroll
            for (int n = 0; n < 8; ++n) acc[m][n] = (f32x4){0.f, 0.f, 0.f, 0.f};
    }
    __syncthreads();
    auto stage = [&](int kt, int s) {
        char* sa = smem + s * 24576;
#pragma unroll
        for (int i = 0; i < 2; ++i) { if (A_SC1) glds16_sc1(fa(i, (wid + 4 * i) * 16 + r_in, c_in, kt), sa + tid * 16 + i * 4096); else glds16(fa(i, (wid + 4 * i) * 16 + r_in, c_in, kt), sa + tid * 16 + i * 4096); }
#pragma unroll
        for (int i = 0; i < 4; ++i) glds16(fb(i, (wid + 4 * i) * 16 + r_in, c_in, kt), sa + 8192 + tid * 16 + i * 4096);
    };
    stage(0, 0);
    if (nkt > 1) stage(1, 1);
    int s_cur = 0, s_nxt = 2;
    for (int kt = 0; kt < nkt; ++kt) {
        hook(kt);
        if (kt + 1 < nkt) asm volatile("s_waitcnt vmcnt(6) lgkmcnt(0)\n\ts_barrier" ::: "memory");
        else asm volatile("s_waitcnt vmcnt(0) lgkmcnt(0)\n\ts_barrier" ::: "memory");
        if (kt + 2 < nkt) stage(kt + 2, s_nxt);
        const char* sa = smem + s_cur * 24576;
        bf16x8 a[4];
#pragma unroll
        for (int m = 0; m < 4; ++m) a[m] = *(const bf16x8*)(sa + lds32(wr * 64 + m * 16 + fr, fq * 8));
#pragma unroll
        for (int nh = 0; nh < 2; ++nh) {
            bf16x8 b[4];
#pragma unroll
            for (int n = 0; n < 4; ++n) b[n] = *(const bf16x8*)(sa + 8192 + lds32(wc * 128 + (nh * 4 + n) * 16 + fr, fq * 8));
            __builtin_amdgcn_s_setprio(1);
#pragma unroll
            for (int m = 0; m < 4; ++m)
#pragma unroll
                for (int n = 0; n < 4; ++n) acc[m][nh * 4 + n] = __builtin_amdgcn_mfma_f32_16x16x32_bf16(a[m], b[n], acc[m][nh * 4 + n], 0, 0, 0);
            __builtin_amdgcn_s_setprio(0);
        }
        s_cur = (s_cur == 2) ? 0 : s_cur + 1;
        s_nxt = (s_nxt == 2) ? 0 : s_nxt + 1;
    }
    __syncthreads();
}

template <class FV, class FD>
__device__ __forceinline__ void wave_store_bf16_f(FV val, FD dst, bool write_through = false, const char* wt_base = nullptr, unsigned wt_bytes = 0) {
    const __amdgpu_buffer_rsrc_t wt_rsrc = __builtin_amdgcn_make_buffer_rsrc((void*)wt_base, 0, (int)wt_bytes, 0x00020000);
    const int lane = TIDX & 63, wid = TIDX >> 6, fr = lane & 15, fq = lane >> 4;
    char* base = smem + wid * 9216;
#pragma unroll
    for (int m = 0; m < 4; ++m)
#pragma unroll
        for (int n = 0; n < 4; ++n)
#pragma unroll
            for (int j = 0; j < 4; ++j)
                *(u16*)(base + (m * 16 + fq * 4 + j) * 144 + (n * 16 + fr) * 2) = f2bf(val(m, n, j));
    asm volatile("s_waitcnt lgkmcnt(0)" ::: "memory");
    __builtin_amdgcn_wave_barrier();
#pragma unroll
    for (int i = 0; i < 8; ++i) {
        const int id = i * 64 + lane, row = id >> 3, ch = id & 7;
        const uint4 d = *(const uint4*)(base + row * 144 + ch * 16);
        u16* p = dst(row);
        if (p) {
            if (write_through) {
                const u32x4 dv = {d.x, d.y, d.z, d.w};
                __builtin_amdgcn_raw_buffer_store_b128(dv, wt_rsrc, (int)((const char*)(p + ch * 8) - wt_base), 0, 16);
            } else *(uint4*)(p + ch * 8) = d;
        }
    }
    asm volatile("s_waitcnt lgkmcnt(0)" ::: "memory");
    __builtin_amdgcn_wave_barrier();
}

template <class FD>
__device__ __forceinline__ void wave_store_bf16(const float (&v)[4][4][4], FD dst) {
    wave_store_bf16_f([&](int m, int n, int j) { return v[m][n][j]; }, dst);
}

struct ConvD { const float* src; u16* dst; int ld, ldd, k0, n0, mode, zr; };
__device__ __forceinline__ void conv_load(const Params& p, const ConvD& d, float (&v)[16]) {
    const int tid = TIDX;
#pragma unroll
    for (int i = 0; i < 16; ++i) v[i] = d.src[(size_t)(d.k0 + i * 4 + (tid >> 6)) * d.ld + d.n0 + (tid & 63)];
    if (d.zr == 2) {
#pragma unroll
        for (int i = 0; i < 16; ++i) {
            const int k = d.k0 + i * 4 + (tid >> 6);
            v[i] *= (k < 512) ? p.norm_attn_out[k] : p.norm_ssm_out[k - 512];
        }
    }
}
__device__ __forceinline__ void conv_store(const Params& p, const ConvD& d, const float (&v)[16]) {
    float* t = (float*)smem;
    const int tid = TIDX;
    __syncthreads();
#pragma unroll
    for (int i = 0; i < 16; ++i) t[(i * 4 + (tid >> 6)) * 65 + (tid & 63)] = v[i];
    __syncthreads();
    const int n = tid >> 2, kq = tid & 3;
    unsigned w[8];
#pragma unroll
    for (int i = 0; i < 8; ++i) w[i] = pack2(t[(kq * 16 + 2 * i) * 65 + n], t[(kq * 16 + 2 * i + 1) * 65 + n]);
    const int gn = d.n0 + n;
    int row = gn;
    if (d.mode == 1) row = (gn >> 4) * 32 + (gn & 15);
    else if (d.mode == 2) row = (gn >> 4) * 32 + 16 + (gn & 15);
    else if (d.mode == 3) row = n;
    uint4* o = (uint4*)(d.dst + (size_t)row * d.ldd + d.k0 + kq * 16);
    o[0] = make_uint4(w[0], w[1], w[2], w[3]);
    o[1] = make_uint4(w[4], w[5], w[6], w[7]);
    if (d.zr == 1) {
        uint4* z = (uint4*)(WSP_WrT + (size_t)(64 + n) * 1024 + d.k0 + kq * 16);
        z[0] = make_uint4(0, 0, 0, 0); z[1] = make_uint4(0, 0, 0, 0);
    }
}

__device__ __forceinline__ void ada_item(const Params& p, int item) {
    float* sc = (float*)smem;
    float* red = sc + 9 * 1024;
    const int tid = TIDX;
    __syncthreads();
    for (int i = tid; i < 9 * 1024; i += NTHR) {
        const int r = i >> 10, k = i & 1023;
        const float cv = (r < 8) ? p.c[r * 1024 + k] : p.c_ctx[k];
        sc[i] = siluf_(cv);
    }
    __syncthreads();
    const int kq = tid >> 6, jl = tid & 63, j = item * 64 + jl;
    float acc[9];
#pragma unroll
    for (int r = 0; r < 9; ++r) acc[r] = 0.f;
#pragma unroll 16
    for (int k = kq; k < 1024; k += 4) {
        const float w = p.w_ada[(size_t)k * 6144 + j];
#pragma unroll
        for (int r = 0; r < 9; ++r) acc[r] += sc[r * 1024 + k] * w;
    }
#pragma unroll
    for (int r = 0; r < 9; ++r) red[(kq * 9 + r) * 64 + jl] = acc[r];
    __syncthreads();
    for (int i = tid; i < 9 * 64; i += NTHR) {
        const int r = i >> 6, l = i & 63;
        const float s = red[(0 * 9 + r) * 64 + l] + red[(1 * 9 + r) * 64 + l] + red[(2 * 9 + r) * 64 + l] + red[(3 * 9 + r) * 64 + l];
        WSP_mod[r * 6144 + item * 64 + l] = s + p.b_ada[item * 64 + l];
    }
}

__device__ __forceinline__ void rope_item(const Params& p) {
    for (int i = TIDX; i < 64 * 16; i += NTHR) {
        const int pos = i >> 4, k = i & 15;
        const float inv = exp2f(-(float)k * (13.287712379549449f / 16.f));
        float s, c;
        sincosf((float)pos * inv, &s, &c);
        WSP_rope[i] = make_float2(c, s);
    }
}

__device__ __forceinline__ void ssm_table_item(const Params& p, int g, int dir) {
    float* pw = (float*)smem;
    float* Bb = pw + 17 * 64 * 2;
    float* Cc = Bb + 64 * 16 * 2;
    const int tid = TIDX;
    u16* tabS = WSP_TabS + (size_t)g * 256 * 256;
    u16* tabY = WSP_TabY + (size_t)g * 256 * 512;
    float* Kf = WSP_Kbuf + (size_t)(g * 2 + dir) * 4096;
    __syncthreads();
    {
        const int pidx = dir * 32 + g;
        const float dt = __expf(p.log_dt[pidx]);
        for (int i = tid; i < 17 * 64; i += NTHR) {
            const int tau = i >> 6, n = i & 63;
            const float are = p.a_re[pidx * 64 + n], aim = p.a_im[pidx * 64 + n];
            const float mag = __expf((float)tau * dt * are);
            float rev = (float)tau * (dt * aim * 0.15915494309189535f);
            rev -= rintf(rev);
            pw[i * 2] = mag * __builtin_amdgcn_cosf(rev);
            pw[i * 2 + 1] = mag * __builtin_amdgcn_sinf(rev);
        }
        __syncthreads();
        for (int i = tid; i < 64 * 16; i += NTHR) {
            const int n = i >> 4;
            const float are = p.a_re[pidx * 64 + n], aim = p.a_im[pidx * 64 + n];
            const float abr = pw[(64 + n) * 2], abi = pw[(64 + n) * 2 + 1];
            const float den = are * are + aim * aim, nre = abr - 1.f;
            const float cre = (nre * are + abi * aim) / den, cim = (abi * are - nre * aim) / den;
            const float br = p.b_re[(size_t)pidx * 1024 + i], bi = p.b_im[(size_t)pidx * 1024 + i];
            Bb[i * 2] = cre * br - cim * bi;
            Bb[i * 2 + 1] = cre * bi + cim * br;
            Cc[i * 2] = p.c_re[(size_t)pidx * 1024 + i];
            Cc[i * 2 + 1] = p.c_im[(size_t)pidx * 1024 + i];
        }
        __syncthreads();
        {
            const int tau = tid >> 4, pp = tid & 15;
            float s[16];
#pragma unroll
            for (int q = 0; q < 16; ++q) s[q] = 0.f;
            for (int n = 0; n < 64; ++n) {
                const float2 cv = *(const float2*)&Cc[(pp * 64 + n) * 2];
                const float2 wv = *(const float2*)&pw[(tau * 64 + n) * 2];
                const float zr = cv.x * wv.x - cv.y * wv.y, zi = cv.x * wv.y + cv.y * wv.x;
#pragma unroll
                for (int q = 0; q < 16; ++q) {
                    const float2 bv = *(const float2*)&Bb[(n * 16 + q) * 2];
                    s[q] += zr * bv.x - zi * bv.y;
                }
            }
#pragma unroll
            for (int q = 0; q < 4; ++q)
                *(float4*)(Kf + tau * 256 + pp * 16 + q * 4) = make_float4(s[4 * q], s[4 * q + 1], s[4 * q + 2], s[4 * q + 3]);
        }
        for (int id = tid; id < 128 * 32; id += NTHR) {
            const int rr = id >> 5, ch = id & 31, cpart = rr >> 6, n = rr & 63, s_ = ch >> 1, q0 = (ch & 1) * 8;
            const int e = dir == 0 ? 15 - s_ : s_;
            const float wr_ = pw[(e * 64 + n) * 2], wi_ = pw[(e * 64 + n) * 2 + 1];
            unsigned w[4];
#pragma unroll
            for (int i = 0; i < 4; ++i) {
                float v[2];
#pragma unroll
                for (int h = 0; h < 2; ++h) {
                    const float br = Bb[(n * 16 + q0 + 2 * i + h) * 2], bi = Bb[(n * 16 + q0 + 2 * i + h) * 2 + 1];
                    v[h] = cpart == 0 ? (wr_ * br - wi_ * bi) : (wr_ * bi + wi_ * br);
                }
                w[i] = pack2(v[0], v[1]);
            }
            *(uint4*)(tabS + (size_t)(dir * 128 + rr) * 256 + s_ * 16 + q0) = make_uint4(w[0], w[1], w[2], w[3]);
        }
        for (int id = tid; id < 256 * 16; id += NTHR) {
            const int m = id >> 4, ch = id & 15, t = m >> 4, pp = m & 15, cpart = ch >> 3, n0 = (ch & 7) * 8;
            const int e = dir == 0 ? t + 1 : 16 - t;
            unsigned w[4];
#pragma unroll
            for (int i = 0; i < 4; ++i) {
                float v[2];
#pragma unroll
                for (int h = 0; h < 2; ++h) {
                    const int n = n0 + 2 * i + h;
                    const float cr = Cc[(pp * 64 + n) * 2], ci = Cc[(pp * 64 + n) * 2 + 1];
                    const float wr_ = pw[(e * 64 + n) * 2], wi_ = pw[(e * 64 + n) * 2 + 1];
                    v[h] = cpart == 0 ? (cr * wr_ - ci * wi_) : -(cr * wi_ + ci * wr_);
                }
                w[i] = pack2(v[0], v[1]);
            }
            *(uint4*)(tabY + (size_t)m * 512 + 256 + dir * 128 + cpart * 64 + n0) = make_uint4(w[0], w[1], w[2], w[3]);
        }
    }
}

__device__ __forceinline__ void ssm_toeplitz_item(const Params& p, int g) {
    float* Kf = (float*)smem;
    const int tid = TIDX;
    u16* tabY = WSP_TabY + (size_t)g * 256 * 512;
    __syncthreads();
    for (int i = tid; i < 2048; i += NTHR) ((float4*)Kf)[i] = ((const float4*)(WSP_Kbuf + (size_t)g * 8192))[i];
    __syncthreads();
    for (int id = tid; id < 256 * 32; id += NTHR) {
        const int m = id >> 5, ch = id & 31, t = m >> 4, pp = m & 15, s_ = ch >> 1, q0 = (ch & 1) * 8;
        unsigned w[4];
#pragma unroll
        for (int i = 0; i < 4; ++i) {
            float v[2];
#pragma unroll
            for (int h = 0; h < 2; ++h) {
                const int q = q0 + 2 * i + h;
                float val;
                if (s_ < t) val = Kf[((t - s_) * 16 + pp) * 16 + q];
                else if (s_ > t) val = Kf[4096 + ((s_ - t) * 16 + pp) * 16 + q];
                else val = Kf[(pp) * 16 + q] + Kf[4096 + pp * 16 + q] + (pp == q ? p.ssm_d[g * 16 + pp] : 0.f);
                v[h] = val;
            }
            w[i] = pack2(v[0], v[1]);
        }
        *(uint4*)(tabY + (size_t)m * 512 + s_ * 16 + q0) = make_uint4(w[0], w[1], w[2], w[3]);
    }
    __syncthreads();
}

#define N_CONV 6896
__device__ __forceinline__ ConvD conv_decode(const Params& p, int t) {
    ConvD d; d.mode = 0; d.zr = 0;
    if (t < 320) { d.src = p.w_in; d.ld = 1280; d.k0 = (t / 20) * 64; d.n0 = (t % 20) * 64; d.dst = WSP_WinT; d.ldd = 1024; return d; }
    t -= 320;
    if (t < 64) { d.src = p.w_glu; d.ld = 512; d.k0 = (t / 8) * 64; d.n0 = (t % 8) * 64; d.dst = WSP_WgluT; d.ldd = 512; return d; }
    t -= 64;
    if (t < 256) { d.src = p.w_out; d.ld = 1024; d.k0 = (t / 16) * 64; d.n0 = (t % 16) * 64; d.dst = WSP_WoutT; d.ldd = 1024; d.zr = 2; return d; }
    t -= 256;
    if (t < 16) { d.src = p.w_router; d.ld = 64; d.k0 = t * 64; d.n0 = 0; d.dst = WSP_WrT; d.ldd = 1024; d.zr = 1; return d; }
    t -= 16;
    if (t < 4096) {
        const int up = t >= 2048; const int tt = t & 2047, e = tt >> 5, r = tt & 31;
        d.src = (up ? p.w_up_e : p.w_gate_e) + (size_t)e * 131072; d.ld = 128; d.k0 = (r >> 1) * 64; d.n0 = (r & 1) * 64;
        d.dst = WSP_WguT + (size_t)e * 262144; d.ldd = 1024; d.mode = 1 + up; return d;
    }
    t -= 4096;
    if (t < 64) {
        const int up = t >= 32; const int r = t & 31;
        d.src = up ? p.w_up_s : p.w_gate_s; d.ld = 128; d.k0 = (r >> 1) * 64; d.n0 = (r & 1) * 64;
        d.dst = WSP_WguT + (size_t)64 * 262144; d.ldd = 1024; d.mode = 1 + up; return d;
    }
    t -= 64;
    if (t < 2048) { const int e = t >> 5, r = t & 31; d.src = p.w_down_e + (size_t)e * 131072; d.ld = 1024; d.k0 = (r >> 4) * 64; d.n0 = (r & 15) * 64; d.dst = WSP_WdT + (size_t)e * 131072; d.ldd = 128; return d; }
    t -= 2048;
    d.src = p.w_down_s; d.ld = 1024; d.k0 = (t >> 4) * 64; d.n0 = (t & 15) * 64; d.dst = WSP_WdT + (size_t)64 * 131072; d.ldd = 128; return d;
}

#define N_CONV_EARLY 4000
__device__ __forceinline__ void conv_range(const Params& p, int t0, int stride, int tend, int tbeg = 0) {
    int t = tbeg + t0;
    if (t < tend) {
        ConvD d = conv_decode(p, t);
        float v[16];
        conv_load(p, d, v);
        while (t < tend) {
            const int tn = t + stride;
            ConvD dn = d;
            float vn[16];
            if (tn < tend) { dn = conv_decode(p, tn); conv_load(p, dn, vn); }
            conv_store(p, d, v);
            d = dn;
#pragma unroll
            for (int i = 0; i < 16; ++i) v[i] = vn[i];
            t = tn;
        }
    }
}
#define P0_CONV_B0 161
__device__ __forceinline__ void phase0(const Params& p) {
    const int b = blockIdx.x, G = gridDim.x;
    if (G > P0_CONV_B0 + 32) {
        if (b < 64) ssm_table_item(p, b >> 1, b & 1);
        else if (b < 160) ada_item(p, b - 64);
        else if (b == 160) rope_item(p);
        else conv_range(p, b - P0_CONV_B0, G - P0_CONV_B0, N_CONV_EARLY);
    } else {
        const int NU = 64 + 96 + 1 + N_CONV_EARLY;
        for (int u = b; u < NU; u += G) {
            if (u < 64) ssm_table_item(p, u >> 1, u & 1);
            else if (u < 160) ada_item(p, u - 64);
            else if (u == 160) rope_item(p);
            else { ConvD d = conv_decode(p, u - 161); float v[16]; conv_load(p, d, v); conv_store(p, d, v); }
        }
    }
}
#if 0
    {
        {
            const int stride = G - P0_CONV_B0;
            int t = b - P0_CONV_B0;
            if (t < N_CONV) {
                ConvD d = conv_decode(p, t);
                float v[16];
                conv_load(p, d, v);
                while (t < N_CONV) {
                    const int tn = t + stride;
                    ConvD dn = d;
                    float vn[16];
                    if (tn < N_CONV) { dn = conv_decode(p, tn); conv_load(p, dn, vn); }
                    conv_store(p, d, v);
                    d = dn;
#pragma unroll
                    for (int i = 0; i < 16; ++i) v[i] = vn[i];
                    t = tn;
                }
            }
        }
    } else {
        const int NU = 64 + 96 + 1 + N_CONV;
        for (int u = b; u < NU; u += G) {
            if (u < 64) ssm_table_item(p, u >> 1, u & 1);
            else if (u < 160) ada_item(p, u - 64);
            else if (u == 160) rope_item(p);
            else { ConvD d = conv_decode(p, u - 161); float v[16]; conv_load(p, d, v); conv_store(p, d, v); }
        }
    }
}

#endif

__device__ __forceinline__ void norm_mod_row(const float* src, const float* gain, const float* sh, const float* scl, u16* dst) {
    const int lane = TIDX & 63;
    float4 v[4];
    float ss = 0.f;
#pragma unroll
    for (int i = 0; i < 4; ++i) {
        v[i] = *(const float4*)(src + i * 256 + lane * 4);
        ss += v[i].x * v[i].x + v[i].y * v[i].y + v[i].z * v[i].z + v[i].w * v[i].w;
    }
    ss = wave_sum(ss);
    const float rs = rsqrtf(ss * (1.f / 1024.f) + EPS);
#pragma unroll
    for (int i = 0; i < 4; ++i) {
        const int c0 = i * 256 + lane * 4;
        const float4 g = *(const float4*)(gain + c0), s = *(const float4*)(sh + c0), k = *(const float4*)(scl + c0);
        const float a = v[i].x * rs * g.x * (1.f + k.x) + s.x, b = v[i].y * rs * g.y * (1.f + k.y) + s.y;
        const float c = v[i].z * rs * g.z * (1.f + k.z) + s.z, d = v[i].w * rs * g.w * (1.f + k.w) + s.w;
        *(uint2*)(dst + c0) = make_uint2(pack2(a, b), pack2(c, d));
    }
}

__device__ __forceinline__ void phase1(const Params& p) {
    const int wv = blockIdx.x * 4 + (TIDX >> 6), nwv = gridDim.x * 4;
    const int lane = TIDX & 63;
    for (int r0 = wv * 4; r0 < NROWS; r0 += nwv * 4) {
        const float* src[4]; const float* md[4];
        float4 v[4][4];
#pragma unroll
        for (int q = 0; q < 4; ++q) {
            const int r = r0 + q;
            if (r < NLAT) { src[q] = p.x + (size_t)r * 1024; md[q] = WSP_mod + (r >> 11) * 6144; }
            else { src[q] = p.ctx + (size_t)(r - NLAT) * 1024; md[q] = WSP_mod + 8 * 6144; }
#pragma unroll
            for (int i = 0; i < 4; ++i) v[q][i] = *(const float4*)(src[q] + i * 256 + lane * 4);
        }
#pragma unroll
        for (int q = 0; q < 4; ++q) {
            float ss = 0.f;
#pragma unroll
            for (int i = 0; i < 4; ++i) ss += v[q][i].x * v[q][i].x + v[q][i].y * v[q][i].y + v[q][i].z * v[q][i].z + v[q][i].w * v[q][i].w;
            ss = wave_sum(ss);
            const float rs = rsqrtf(ss * (1.f / 1024.f) + EPS);
            u16* dst = WSP_Hb + (size_t)(r0 + q) * 1024;
#pragma unroll
            for (int i = 0; i < 4; ++i) {
                const int c0 = i * 256 + lane * 4;
                const float4 g = *(const float4*)(p.norm_mix + c0), s = *(const float4*)(md[q] + c0), k = *(const float4*)(md[q] + 1024 + c0);
                const float a = v[q][i].x * rs * g.x * (1.f + k.x) + s.x, b = v[q][i].y * rs * g.y * (1.f + k.y) + s.y;
                const float c = v[q][i].z * rs * g.z * (1.f + k.z) + s.z, d = v[q][i].w * rs * g.w * (1.f + k.w) + s.w;
                *(uint2*)(dst + c0) = make_uint2(pack2(a, b), pack2(c, d));
            }
        }
    }
}

__device__ __forceinline__ void phase2(const Params& p) {
    const int NU = 128 * 10 + 16 * 6;
    const int lane = TIDX & 63, wid = TIDX >> 6, wr = wid >> 1, wc = wid & 1, fr = lane & 15, fq = lane >> 4;
    for (int u = blockIdx.x; u < NU; u += gridDim.x) {
        int mt, nt;
        {
            const int xc = u & 7, r = u >> 3;
            if (r < 160) { mt = xc + 8 * (r / 10); nt = r % 10; } else { const int v = r - 160; mt = 128 + xc + 8 * (v / 6); nt = 4 + v % 6; }
        }
        const u16* A = WSP_Hb + (size_t)mt * 128 * 1024;
        const u16* B = WSP_WinT + (size_t)nt * 128 * 1024;
        f32x4 acc[4][4];
        gemm_tile(16,
            [&](int R, int C, int kt) { return (const void*)(A + (size_t)R * 1024 + kt * 64 + C); },
            [&](int R, int C, int kt) { return (const void*)(B + (size_t)R * 1024 + kt * 64 + C); }, acc);
        const int row0 = mt * 128 + wr * 64;
        const int col0 = nt * 128 + wc * 64;
        const bool is_lat = mt < 128;
        if (nt == 5) {
            const int kvh = wc;
#pragma unroll
            for (int m = 0; m < 4; ++m) {
                const int r = row0 + m * 16 + fq * 4;
                int b, pos;
                if (is_lat) { b = r >> 11; pos = r & 2047; } else { const int rc = r - NLAT; b = rc >> 8; pos = SEQ + (rc & 255); }
#pragma unroll
                for (int n = 0; n < 4; ++n) {
                    const int d = n * 16 + fr;
                    u16* dst = WSP_Vt + ((size_t)(b * 2 + kvh) * 64 + d) * VT_LD + pos;
                    *(uint2*)dst = make_uint2(pack2(acc[m][n][0], acc[m][n][1]), pack2(acc[m][n][2], acc[m][n][3]));
                }
            }
        } else {
            float v[4][4][4];
            const bool do_rope = is_lat && nt <= 4;
#pragma unroll
            for (int m = 0; m < 4; ++m)
#pragma unroll
                for (int j = 0; j < 4; ++j) {
                    if (do_rope) {
                        const int r = row0 + m * 16 + fq * 4 + j, pos = r & 2047;
                        const float2 cr = WSP_rope[(pos >> 6) * 16 + fr], cc = WSP_rope[(pos & 63) * 16 + fr];
                        const float x1 = acc[m][0][j], x2 = acc[m][1][j], y1 = acc[m][2][j], y2 = acc[m][3][j];
                        v[m][0][j] = x1 * cr.x - x2 * cr.y; v[m][1][j] = x1 * cr.y + x2 * cr.x;
                        v[m][2][j] = y1 * cc.x - y2 * cc.y; v[m][3][j] = y1 * cc.y + y2 * cc.x;
                    } else {
#pragma unroll
                        for (int n = 0; n < 4; ++n) v[m][n][j] = acc[m][n][j];
                    }
                }
            u16* dbase; int ldd;
            if (nt < 4) { dbase = WSP_Q + (size_t)row0 * 512 + col0; ldd = 512; }
            else if (nt == 4) { dbase = WSP_Kb + (size_t)row0 * 128 + (col0 - 512); ldd = 128; }
            else { dbase = WSP_U + (size_t)row0 * 512 + (col0 - 768); ldd = 512; }
            wave_store_bf16(v, [&](int row) { return dbase + (size_t)row * ldd; });
        }
    }
}

__device__ __forceinline__ void attn_unit(const Params& p, int u) {
    const int h = u & 7, qb = (u >> 3) & 15, b = u >> 7, kvh = h >> 2;
    const int tid = TIDX, lane = tid & 63, wid = tid >> 6, fr = lane & 15, fq = lane >> 4;
    const int sb = lane * 16, swz = sb ^ (((sb >> 9) & 1) << 5);
    const int r_in = swz >> 6, c_in = (swz & 63) >> 1;
    const int jstart = qb == 0 ? 2 : 0, jend = qb == 15 ? 4 : 6, nb = jend - jstart, ntile = nb + 4;
    const float SC = 0.125f * 1.4426950408889634f;
    bf16x8 qf[2][2];
    const int qrow0 = b * SEQ + qb * 128 + wid * 32;
#pragma unroll
    for (int qt = 0; qt < 2; ++qt)
#pragma unroll
        for (int ks = 0; ks < 2; ++ks)
            qf[qt][ks] = *(const bf16x8*)(WSP_Q + (size_t)(qrow0 + qt * 16 + fr) * 512 + h * 64 + ks * 32 + fq * 8);
    f32x4 o[4][2];
#pragma unroll
    for (int dt = 0; dt < 4; ++dt)
#pragma unroll
        for (int qt = 0; qt < 2; ++qt) o[dt][qt] = (f32x4){0.f, 0.f, 0.f, 0.f};
    float mrun[2], lrun[2];
    const float sinkv = p.attn_sink[h] * 1.4426950408889634f;
    mrun[0] = mrun[1] = sinkv;
    lrun[0] = lrun[1] = (fq == 0) ? 1.f : 0.f;
    __syncthreads();
    const u16* kp[2]; const u16* vp[2];
    {
        const int ks0 = qb * 128 - 128 + 64 * jstart;
#pragma unroll
        for (int it = 0; it < 2; ++it) {
            const int st = wid + 4 * it, R = (st >> 1) * 16 + r_in, C = (st & 1) * 32 + c_in;
            kp[it] = WSP_Kb + (size_t)(b * SEQ + ks0 + R) * 128 + kvh * 64 + C;
            vp[it] = WSP_Vt + ((size_t)(b * 2 + kvh) * 64 + R) * VT_LD + ks0 + C;
        }
    }
    auto stage = [&](int i, int s) {
        char* sk = smem + s * 16384;
        char* sv = sk + 8192;
#pragma unroll
        for (int it = 0; it < 2; ++it) {
            glds16(kp[it], sk + tid * 16 + it * 4096);
            glds16(vp[it], sv + tid * 16 + it * 4096);
        }
        if (i + 1 == nb) {
            const int ks0 = qb * 128 - 128 + 64 * (jstart + i);
#pragma unroll
            for (int it = 0; it < 2; ++it) {
                kp[it] += (size_t)(NLAT + b * CTXL - (b * SEQ + ks0)) * 128;
                vp[it] += SEQ - ks0;
            }
        } else {
#pragma unroll
            for (int it = 0; it < 2; ++it) { kp[it] += 64 * 128; vp[it] += 64; }
        }
    };
    stage(0, 0);
    for (int i = 0; i < ntile; ++i) {
        asm volatile("s_waitcnt vmcnt(0)" ::: "memory");
        __syncthreads();
        if (i + 1 < ntile) stage(i + 1, (i + 1) & 1);
        const char* sk = smem + (i & 1) * 16384;
        const char* sv = sk + 8192;
        f32x4 s[4][2];
#pragma unroll
        for (int kt = 0; kt < 4; ++kt)
#pragma unroll
            for (int qt = 0; qt < 2; ++qt) s[kt][qt] = (f32x4){0.f, 0.f, 0.f, 0.f};
#pragma unroll
        for (int ks = 0; ks < 2; ++ks)
#pragma unroll
            for (int kt = 0; kt < 4; ++kt) {
                const bf16x8 kf = *(const bf16x8*)(sk + lds_byte(32 * (kt >> 1) + 8 * (fr >> 2) + 4 * (kt & 1) + (fr & 3), ks * 32 + fq * 8));
#pragma unroll
                for (int qt = 0; qt < 2; ++qt) s[kt][qt] = __builtin_amdgcn_mfma_f32_16x16x32_bf16(kf, qf[qt][ks], s[kt][qt], 0, 0, 0);
            }
        const int ks0 = qb * 128 - 128 + 64 * (jstart + i);
        const int qlo = qb * 128 + wid * 32;
        const bool band = (i < nb) && ((qlo + 31 - ks0 > 128) || (ks0 + 63 - qlo > 128));
        bf16x8 pf[2][2];
#pragma unroll
        for (int qt = 0; qt < 2; ++qt) {
            const int qp = qb * 128 + wid * 32 + qt * 16 + fr;
            float mx = -1e30f;
            if (band) {
#pragma unroll
                for (int kt = 0; kt < 4; ++kt)
#pragma unroll
                    for (int j = 0; j < 4; ++j) {
                        const int kp = ks0 + 32 * (kt >> 1) + 8 * fq + 4 * (kt & 1) + j, d = qp - kp;
                        const float v = (d > 128 || d < -128) ? -1e30f : s[kt][qt][j];
                        s[kt][qt][j] = v;
                        mx = fmaxf(mx, v);
                    }
                asm volatile("" ::: "memory");
            } else {
#pragma unroll
                for (int kt = 0; kt < 4; ++kt)
#pragma unroll
                    for (int j = 0; j < 4; ++j) mx = fmaxf(mx, s[kt][qt][j]);
            }
            mx = max_x32(max_x16(mx));
            const float mnew = fmaxf(mrun[qt], mx * SC);
            const float alpha = __builtin_amdgcn_exp2f(mrun[qt] - mnew);
            mrun[qt] = mnew;
            float ls = 0.f;
#pragma unroll
            for (int kt = 0; kt < 4; ++kt)
#pragma unroll
                for (int j = 0; j < 4; ++j) {
                    const float pv = __builtin_amdgcn_exp2f(fmaf(s[kt][qt][j], SC, -mnew));
                    s[kt][qt][j] = pv;
                    ls += pv;
                }
            lrun[qt] = lrun[qt] * alpha + ls;
            if (!__all(alpha == 1.f)) {
#pragma unroll
                for (int dt = 0; dt < 4; ++dt) o[dt][qt] *= alpha;
            }
#pragma unroll
            for (int k2 = 0; k2 < 2; ++k2) {
                bf16x8 t;
#pragma unroll
                for (int j = 0; j < 4; ++j) { t[j] = (short)f2bf(s[2 * k2][qt][j]); t[4 + j] = (short)f2bf(s[2 * k2 + 1][qt][j]); }
                pf[qt][k2] = t;
            }
        }
#pragma unroll
        for (int k2 = 0; k2 < 2; ++k2)
#pragma unroll
            for (int dt = 0; dt < 4; ++dt) {
                const bf16x8 vf = *(const bf16x8*)(sv + lds_byte(dt * 16 + fr, k2 * 32 + fq * 8));
#pragma unroll
                for (int qt = 0; qt < 2; ++qt) o[dt][qt] = __builtin_amdgcn_mfma_f32_16x16x32_bf16(vf, pf[qt][k2], o[dt][qt], 0, 0, 0);
            }
    }
#pragma unroll
    for (int qt = 0; qt < 2; ++qt) {
        const float l = sum_x32(sum_x16(lrun[qt]));
        const float inv = 1.f / l;
        u16* dst = WSP_AO + (size_t)(qrow0 + qt * 16 + fr) * 512 + h * 64 + fq * 4;
        float sq = 0.f;
#pragma unroll
        for (int dt = 0; dt < 4; ++dt) {
            const unsigned w0 = pack2(o[dt][qt][0] * inv, o[dt][qt][1] * inv), w1 = pack2(o[dt][qt][2] * inv, o[dt][qt][3] * inv);
            *(uint2*)(dst + dt * 16) = make_uint2(w0, w1);
            const float a = bf2f((u16)(w0 & 0xffffu)), b = bf2f((u16)(w0 >> 16)), c = bf2f((u16)(w1 & 0xffffu)), d = bf2f((u16)(w1 >> 16));
            sq += a * a + b * b + c * c + d * d;
        }
        sq = sum_x32(sum_x16(sq));
        if (fq == 0) unsafeAtomicAdd(WSP_rsq + (size_t)(qrow0 + qt * 16 + fr) * 2, sq);
    }
}

__device__ __forceinline__ void ssm_s1_unit(const Params& p, int u) {
    const int ct = u % 9, mh = (u / 9) & 1, g = u / 18;
    const int lane = TIDX & 63, wid = TIDX >> 6, wr = wid >> 1, wc = wid & 1, fr = lane & 15, fq = lane >> 4;
    const u16* A = WSP_TabS + ((size_t)g * 256 + mh * 128) * 256;
    const u16* Ub = WSP_U + (size_t)ct * 128 * 16 * 512 + g * 16;
    f32x4 acc[4][4];
    gemm_tile(4,
        [&](int R, int C, int kt) { return (const void*)(A + (size_t)R * 256 + kt * 64 + C); },
        [&](int R, int C, int kt) { return (const void*)(Ub + (size_t)(R * 16 + kt * 4 + (C >> 4)) * 512 + (C & 15)); }, acc);
#pragma unroll
    for (int m = 0; m < 4; ++m)
#pragma unroll
        for (int n = 0; n < 4; ++n) {
            const int rho = mh * 128 + wr * 64 + m * 16 + fq * 4;
            const int cg = ct * 128 + wc * 64 + n * 16 + fr;
            *(f32x4*)(WSP_S + ((size_t)cg * 32 + g) * 256 + rho) = acc[m][n];
        }
}

__device__ __forceinline__ void phase3(const Params& p) {
    for (int u = blockIdx.x; u < 1024; u += gridDim.x) attn_unit(p, u);
    int* qv = (int*)(smem + 73728);
    for (;;) {
        __syncthreads();
        if (TIDX == 0) qv[0] = (int)atomicAdd(&WSP_ctr[CTR_QS1], 1u);
        __syncthreads();
        const int u = __builtin_amdgcn_readfirstlane(qv[0]);
        if (u >= 576) break;
        ssm_s1_unit(p, u);
    }
}

__device__ __forceinline__ void phase4(const Params& p) {
    if ((int)gridDim.x > 192) {
        if ((int)blockIdx.x >= 160) { conv_range(p, blockIdx.x - 160, gridDim.x - 160, N_CONV, N_CONV_EARLY); return; }
        if ((int)blockIdx.x >= 128) { ssm_toeplitz_item(p, blockIdx.x - 128); return; }
    } else {
        for (int g = blockIdx.x; g < 32; g += gridDim.x) ssm_toeplitz_item(p, g);
        conv_range(p, blockIdx.x, gridDim.x, N_CONV, N_CONV_EARLY);
    }
    const int gid = blockIdx.x * NTHR + TIDX;
    if (gid >= BATCH * 2 * 32 * 64) return;
    const int n = gid & 63, g = (gid >> 6) & 31, dir = (gid >> 11) & 1, b = gid >> 12;
    const int pidx = dir * 32 + g;
    const float dt = __expf(p.log_dt[pidx]);
    const float are = p.a_re[pidx * 64 + n], aim = p.a_im[pidx * 64 + n];
    const float mag = __expf(16.f * dt * are);
    float rev = 16.f * (dt * aim * 0.15915494309189535f);
    rev -= rintf(rev);
    const float ar = mag * __builtin_amdgcn_cosf(rev), ai = mag * __builtin_amdgcn_sinf(rev);
    float hr = 0.f, hi = 0.f;
    const size_t so = (size_t)g * 256 + dir * 128 + n;
#pragma unroll 8
    for (int i = 0; i < 16; ++i) {
        const int c = dir == 0 ? i : 15 - i;
        const float* sp = WSP_S + (size_t)(NCHUNK_LAT + b * 16 + c) * 8192 + so;
        const float sr = sp[0], si = sp[64];
        const float nr = ar * hr - ai * hi + sr, ni = ar * hi + ai * hr + si;
        hr = nr; hi = ni;
    }
#pragma unroll 8
    for (int i = 0; i < 128; ++i) {
        const int c = dir == 0 ? i : 127 - i;
        const size_t cg = (size_t)b * 128 + c;
        const float* sp = WSP_S + cg * 8192 + so;
        const float sr = sp[0], si = sp[64];
        u16* hp = WSP_Hin + cg * 8192 + so;
        hp[0] = f2bf(hr); hp[64] = f2bf(hi);
        const float nr = ar * hr - ai * hi + sr, ni = ar * hi + ai * hr + si;
        hr = nr; hi = ni;
    }
}

__device__ __forceinline__ void phase5(const Params& p) {
    const int NU = 512;
    const int lane = TIDX & 63, wid = TIDX >> 6, wr = wid >> 1, wc = wid & 1, fr = lane & 15, fq = lane >> 4;
    for (int u = blockIdx.x; u < NU; u += gridDim.x) {
        const int ct = u & 7, mh = (u >> 3) & 1, g = u >> 4;
        const u16* A = WSP_TabY + ((size_t)g * 256 + mh * 128) * 512;
        const u16* Ub = WSP_U + (size_t)ct * 128 * 16 * 512 + g * 16;
        const u16* Hb_ = WSP_Hin + (size_t)ct * 128 * 8192 + g * 256;
        f32x4 acc[4][4];
        gemm_tile(8,
            [&](int R, int C, int kt) { return (const void*)(A + (size_t)R * 512 + kt * 64 + C); },
            [&](int R, int C, int kt) {
                return kt < 4 ? (const void*)(Ub + (size_t)(R * 16 + kt * 4 + (C >> 4)) * 512 + (C & 15))
                              : (const void*)(Hb_ + (size_t)R * 8192 + (kt - 4) * 64 + C);
            }, acc);
#pragma unroll
        for (int m = 0; m < 4; ++m)
#pragma unroll
            for (int n = 0; n < 4; ++n) {
                const int t = mh * 8 + wr * 4 + m;
                const int cg = ct * 128 + wc * 64 + n * 16 + fr;
                u16* dst = WSP_Y + ((size_t)cg * 16 + t) * 512 + g * 16 + fq * 4;
                *(uint2*)dst = make_uint2(pack2(gelu_tanh(acc[m][n][0]), gelu_tanh(acc[m][n][1])),
                                          pack2(gelu_tanh(acc[m][n][2]), gelu_tanh(acc[m][n][3])));
            }
    }
}

__device__ __forceinline__ void phase6(const Params& p) {
    const int NU = 512;
    const int lane = TIDX & 63, wid = TIDX >> 6, wr = wid >> 1, wc = wid & 1, fr = lane & 15, fq = lane >> 4;
    for (int u = blockIdx.x; u < NU; u += gridDim.x) {
        const int mt = (u & 7) + 8 * (u >> 5), nt = (u >> 3) & 3;
        const u16* A = WSP_Y + (size_t)mt * 128 * 512;
        const u16* B = WSP_WgluT + (size_t)nt * 128 * 512;
        f32x4 acc[4][4];
        gemm_tile(8,
            [&](int R, int C, int kt) { return (const void*)(A + (size_t)R * 512 + kt * 64 + C); },
            [&](int R, int C, int kt) { return (const void*)(B + (size_t)R * 512 + kt * 64 + C); }, acc);
        const int row0 = mt * 128 + wr * 64, col0 = nt * 128 + wc * 64;
        char* base = smem + wid * 9216;
        float bg[4];
#pragma unroll
        for (int n = 0; n < 4; ++n) bg[n] = p.b_glu[col0 + n * 16 + fr];
#pragma unroll
        for (int i = 0; i < 8; ++i) {
            const int id = i * 64 + lane, row = id >> 3, ch = id & 7;
            *(uint4*)(base + row * 144 + ch * 16) = *(const uint4*)(WSP_Y + (size_t)(row0 + row) * 512 + col0 + ch * 8);
        }
        asm volatile("s_waitcnt lgkmcnt(0)" ::: "memory");
        __builtin_amdgcn_wave_barrier();
#pragma unroll
        for (int m = 0; m < 4; ++m)
#pragma unroll
            for (int j = 0; j < 4; ++j) {
                const int rl = m * 16 + fq * 4 + j, r = row0 + rl;
                float sq = 0.f;
#pragma unroll
                for (int n = 0; n < 4; ++n) {
                    const int c = col0 + n * 16 + fr;
                    const float yv = bf2f(*(const u16*)(base + rl * 144 + (n * 16 + fr) * 2));
                    const u16 ob = f2bf(yv * sigmoidf_(acc[m][n][j] + bg[n]));
                    *(u16*)(base + rl * 144 + (n * 16 + fr) * 2) = ob;
                    const float of = bf2f(ob);
                    sq += of * of;
                }
                sq = sum16(sq);
                if (fr == 0) unsafeAtomicAdd(WSP_rsq + (size_t)r * 2 + 1, sq);
            }
        asm volatile("s_waitcnt lgkmcnt(0)" ::: "memory");
        __builtin_amdgcn_wave_barrier();
        u16* dbase = WSP_SO + (size_t)row0 * 512 + col0;
#pragma unroll
        for (int i = 0; i < 8; ++i) {
            const int id = i * 64 + lane, row = id >> 3, ch = id & 7;
            *(uint4*)(dbase + (size_t)row * 512 + ch * 8) = *(const uint4*)(base + row * 144 + ch * 16);
        }
        asm volatile("s_waitcnt lgkmcnt(0)" ::: "memory");
        __builtin_amdgcn_wave_barrier();
    }
}

__device__ __forceinline__ void phase8(const Params& p) {
    const int NU = 512;
    for (int u = blockIdx.x; u < NU; u += gridDim.x) {
        const int mt = (u & 7) + 8 * (u >> 5), nt = (u >> 3) & 3;
        const u16* A1 = WSP_AO + (size_t)mt * 128 * 512;
        const u16* A2 = WSP_SO + (size_t)mt * 128 * 512;
        const u16* B = WSP_WoutT + (size_t)nt * 256 * 1024;
        f32x4 acc[4][8];
        {
        const int tid1 = TIDX, fq = (tid1 & 63) >> 4, row0 = mt * 128 + (tid1 >> 7) * 64;
        gemm_tile_w(32,
            [&](int i, int R, int C, int kt) { return (const void*)((kt < 16 ? A1 : A2) + (size_t)R * 512 + (kt & 15) * 32 + C); },
            [&](int i, int R, int C, int kt) { return (const void*)(B + (size_t)R * 1024 + kt * 32 + C); }, acc,
            [&](int kt) {
                if (kt == 16) {
#pragma unroll
                    for (int m = 0; m < 4; ++m) {
                        asm volatile("" ::: "memory");
#pragma unroll
                        for (int j = 0; j < 4; ++j) {
                            const float2 q = *(const float2*)(WSP_rsq + (size_t)(row0 + m * 16 + fq * 4 + j) * 2);
                            const float ratio = rsqrtf(q.x * (1.f / 512.f) + EPS) / rsqrtf(q.y * (1.f / 512.f) + EPS);
#pragma unroll
                            for (int n = 0; n < 8; ++n) acc[m][n][j] *= ratio;
                        }
                    }
                }
            });
        }
        const int tid2 = TIDX, lane = tid2 & 63, wid = tid2 >> 6, fr = lane & 15, fq = lane >> 4;
        const int row0 = mt * 128 + (wid >> 1) * 64, col0 = nt * 256 + (wid & 1) * 128;
        const float* g1 = WSP_mod + (mt >> 4) * 6144 + 2048 + col0;
        float* stg = (float*)(smem + wid * 8448);
#pragma unroll
        for (int m = 0; m < 4; ++m) {
#pragma unroll
            for (int n = 0; n < 8; ++n)
#pragma unroll
                for (int j = 0; j < 4; ++j) stg[(fq * 4 + j) * 132 + n * 16 + fr] = acc[m][n][j];
            asm volatile("s_waitcnt lgkmcnt(0)" ::: "memory");
            __builtin_amdgcn_wave_barrier();
#pragma unroll
            for (int i = 0; i < 8; ++i) {
                const int id = i * 64 + lane, rr = id >> 5, c4 = (id & 31) * 4;
                float4 v = *(const float4*)(stg + rr * 132 + c4);
                const float rsv = rsqrtf(WSP_rsq[(size_t)(row0 + m * 16 + rr) * 2 + 1] * (1.f / 512.f) + EPS);
                v.x *= rsv; v.y *= rsv; v.z *= rsv; v.w *= rsv;
                const float4 g = *(const float4*)(g1 + c4);
                const size_t o = (size_t)(row0 + m * 16 + rr) * 1024 + col0 + c4;
                const float4 xv = *(const float4*)(p.x + o);
                *(float4*)(p.out + o) = make_float4(xv.x + g.x * v.x, xv.y + g.y * v.y, xv.z + g.z * v.z, xv.w + g.w * v.w);
            }
            asm volatile("s_waitcnt lgkmcnt(0)" ::: "memory");
            __builtin_amdgcn_wave_barrier();
        }
    }
}

#define CTR_ECNT 0
#define CTR_Q11 128
#define CTR_Q12 136
#define HALF_TOK 8192
#define HH_HALF_ROWS 73728
#define ELIST_CAP 8192
template <int LEVEL>
__device__ __forceinline__ void phase9_t(const Params& p) {
    const int tid = TIDX, lane = tid & 63, wid = tid >> 6, fr = lane & 15, fq = lane >> 4;
    char* At = smem;
    float* sc = (float*)(smem + 65536);
    int* hist = (int*)(smem + 65536 + 8192);
    int* gbase = hist + 64;
    int* fill = gbase + 64;
    unsigned char* selk = (unsigned char*)(fill + 64);
    float* selw = (float*)(selk + 256);
    for (int chunk = blockIdx.x; chunk < NLAT / 32; chunk += gridDim.x) {
        const int tok0 = chunk * 32;
        __syncthreads();
        if (tid < 64) hist[tid] = 0;
#pragma unroll 1
        for (int hb = 0; hb < 2; ++hb) {
            float4 vall[4][4];
#pragma unroll
            for (int rr = 0; rr < 4; ++rr)
#pragma unroll
                for (int i = 0; i < 4; ++i) vall[rr][i] = *(const float4*)(p.out + (size_t)(tok0 + wid * 8 + hb * 4 + rr) * 1024 + i * 256 + lane * 4);
#pragma unroll
            for (int rr = 0; rr < 4; ++rr) {
                const int row = wid * 8 + hb * 4 + rr, tok = tok0 + row;
                const float* md = WSP_mod + (tok >> 11) * 6144;
                float ss = 0.f;
#pragma unroll
                for (int i = 0; i < 4; ++i) ss += vall[rr][i].x * vall[rr][i].x + vall[rr][i].y * vall[rr][i].y + vall[rr][i].z * vall[rr][i].z + vall[rr][i].w * vall[rr][i].w;
                ss = wave_sum(ss);
                const float rs = rsqrtf(ss * (1.f / 1024.f) + EPS);
#pragma unroll
                for (int i = 0; i < 4; ++i) {
                    const int c0 = i * 256 + lane * 4;
                    const float4 v = vall[rr][i];
                    const float4 g = *(const float4*)(p.norm_ffn + c0), s = *(const float4*)(md + 3072 + c0), k = *(const float4*)(md + 4096 + c0);
                    const float a = v.x * rs * g.x * (1.f + k.x) + s.x, b = v.y * rs * g.y * (1.f + k.y) + s.y;
                    const float c = v.z * rs * g.z * (1.f + k.z) + s.z, d = v.w * rs * g.w * (1.f + k.w) + s.w;
                    const uint2 pk = make_uint2(pack2(a, b), pack2(c, d));
                    *(uint2*)(WSP_H2 + (size_t)tok * 1024 + c0) = pk;
                    const int ch = c0 >> 3;
                    *(uint2*)(At + row * 2048 + ((ch ^ (row & 15)) << 4) + ((c0 & 4) << 1)) = pk;
                }
            }
        }
        __syncthreads();
        if (LEVEL == 1) continue;
        {
            f32x4 acc0 = {0.f, 0.f, 0.f, 0.f}, acc1 = {0.f, 0.f, 0.f, 0.f};
            const u16* bp = WSP_WrT + (size_t)(wid * 16 + fr) * 1024 + fq * 8;
#pragma unroll
            for (int kb = 0; kb < 4; ++kb) {
                bf16x8 bfr[8];
#pragma unroll
                for (int q = 0; q < 8; ++q) bfr[q] = *(const bf16x8*)(bp + (kb * 8 + q) * 32);
#pragma unroll
                for (int q = 0; q < 8; ++q) {
                    const int ch = (kb * 8 + q) * 4 + fq;
                    const bf16x8 a0 = *(const bf16x8*)(At + fr * 2048 + ((ch ^ fr) << 4));
                    const bf16x8 a1 = *(const bf16x8*)(At + (16 + fr) * 2048 + ((ch ^ fr) << 4));
                    acc0 = __builtin_amdgcn_mfma_f32_16x16x32_bf16(a0, bfr[q], acc0, 0, 0, 0);
                    acc1 = __builtin_amdgcn_mfma_f32_16x16x32_bf16(a1, bfr[q], acc1, 0, 0, 0);
                }
            }
#pragma unroll
            for (int j = 0; j < 4; ++j) {
                sc[(fq * 4 + j) * 64 + wid * 16 + fr] = sigmoidf_(acc0[j]);
                sc[(16 + fq * 4 + j) * 64 + wid * 16 + fr] = sigmoidf_(acc1[j]);
            }
        }
        __syncthreads();
        if (LEVEL == 2) continue;
        const float bias = p.router_bias[lane];
        const int eg = lane >> 3;
#pragma unroll 2
        for (int rr = 0; rr < 8; ++rr) {
            const int row = wid * 8 + rr;
            const float s = sc[row * 64 + lane];
            const float bz = s + bias;
            const float m1 = max8(bz);
            const unsigned long long eq = __ballot(bz == m1);
            const unsigned gb = (unsigned)((eq >> (eg * 8)) & 0xffull);
            const int first = __ffs(gb) - 1;
            const float v2 = max8(((lane & 7) == first) ? -1e30f : bz);
            const float gs = m1 + v2;
            int cnt = 0;
#pragma unroll
            for (int j = 0; j < 8; ++j) {
                const float gj = __int_as_float(__builtin_amdgcn_readlane(__float_as_int(gs), j * 8));
                cnt += (gj > gs || (gj == gs && j < eg)) ? 1 : 0;
            }
            const bool gsel = cnt < 4;
            const float mv = gsel ? bz : -1e30f;
            unsigned long long gm = __ballot(gsel);
            int rank = 0;
#pragma unroll 1
            for (int it = 0; it < 4; ++it) {
                const int jb = __builtin_amdgcn_readfirstlane(__ffsll((long long)gm) - 1);
                gm &= ~(0xffull << jb);
#pragma unroll
                for (int j = 0; j < 8; ++j) {
                    const float vj = __int_as_float(__builtin_amdgcn_readlane(__float_as_int(mv), jb + j));
                    rank += (vj > mv || (vj == mv && (jb + j) < lane)) ? 1 : 0;
                }
            }
            const bool sel = gsel && rank < 8;
            unsigned long long sm = __ballot(sel);
            float tot = 0.f;
#pragma unroll 1
            for (int it = 0; it < 8; ++it) {
                const int l = __builtin_amdgcn_readfirstlane(__ffsll((long long)sm) - 1);
                sm &= sm - 1;
                tot += __int_as_float(__builtin_amdgcn_readlane(__float_as_int(s), l));
            }
            if (sel) {
                selw[row * 8 + rank] = s / tot * 2.5f;
                selk[row * 8 + rank] = (unsigned char)lane;
                atomicAdd(&hist[lane], 1);
            }
        }
        __syncthreads();
        const int h = tok0 >> 13;
        if (tid < 64) {
            gbase[tid] = hist[tid] ? (int)atomicAdd(&WSP_ctr[CTR_ECNT + h * 64 + tid], (unsigned)hist[tid]) : 0;
            fill[tid] = 0;
        }
        __syncthreads();
        {
            const int e = selk[tid];
            const int pos = atomicAdd(&fill[e], 1);
            WSP_elist[(size_t)(h * 64 + e) * ELIST_CAP + gbase[e] + pos] = (tok0 + (tid >> 3)) * 8 + (tid & 7);
            WSP_wsl[(size_t)(h * 64 + e) * ELIST_CAP + gbase[e] + pos] = selw[tid];
        }
    }
}

struct MoeTab { int cnt[16]; int soff[16]; int pre[17]; };

template <class FV, class FD>
__device__ __forceinline__ void wave_store_fp8_f(FV val, FD dst) {
    const int lane = TIDX & 63, wid = TIDX >> 6, fr = lane & 15, fq = lane >> 4;
    char* base = smem + wid * 9216;
#pragma unroll
    for (int m = 0; m < 4; ++m)
#pragma unroll
        for (int n = 0; n < 8; ++n)
#pragma unroll
            for (int j = 0; j < 4; ++j)
                *(unsigned char*)(base + (m * 16 + fq * 4 + j) * 144 + n * 16 + fr) =
                    (unsigned char)(__builtin_amdgcn_cvt_pk_fp8_f32(val(m, n, j), 0.f, 0, false) & 0xff);
    asm volatile("s_waitcnt lgkmcnt(0)" ::: "memory");
    __builtin_amdgcn_wave_barrier();
#pragma unroll
    for (int i = 0; i < 8; ++i) {
        const int id = i * 64 + lane, row = id >> 3, ch = id & 7;
        const uint4 d = *(const uint4*)(base + row * 144 + ch * 16);
        unsigned char* q = dst(i, row);
        if (q) { const u32x4 t = {d.x, d.y, d.z, d.w}; __builtin_nontemporal_store(t, (u32x4*)(q + ch * 16)); }
    }
    asm volatile("s_waitcnt lgkmcnt(0)" ::: "memory");
    __builtin_amdgcn_wave_barrier();
}

#define YD_SCALE 8.0f
template <int MODE>
__device__ __forceinline__ void phase11f(const Params& p) {
    const int tid = TIDX;
    int* tab = (int*)(smem + 73728);
    int* t_cnt = tab, *t_soff = tab + 16, *t_pre = tab + 32, *t_q = tab + 52;
    int* t_all = tab + 64;
    const int x = blockIdx.x & 7;
    unsigned* flags = WSP_flag + x * FLAG_PER_CLASS;
    unsigned* tmo = WSP_flag + 8 * FLAG_PER_CLASS;
    unsigned char* Yd8 = (unsigned char*)(p.ws + OFF_ARENA);
    __syncthreads();
    if (tid < 128) t_all[tid] = (int)WSP_ctr[CTR_ECNT + tid];
    unsigned* qhead = &WSP_ctr[(MODE == 2 ? CTR_Q12 : CTR_Q11) + x];
    if (tid == 0) t_q[0] = (int)atomicAdd(qhead, 1u);
    __syncthreads();
    if (tid < 16) {
        const int i = tid >> 1, h = tid & 1, e = x + 8 * i;
        t_cnt[tid] = t_all[h * 64 + e];
        int so = 0;
        for (int e2 = 0; e2 < e; ++e2) so += t_all[h * 64 + e2];
        t_soff[tid] = so;
    }
    __syncthreads();
    if (tid == 0) {
        int s = 0;
        for (int j = 0; j < 16; ++j) { t_pre[j] = s; s += (t_cnt[j] + 127) >> 7; }
        t_pre[16] = s;
    }
    __syncthreads();
    const int T_r = t_pre[16], T11 = T_r + 16, T_all = (MODE == 1) ? T11 : T11 + T_r * 4;
    for (;;) {
        __syncthreads();
        const int q = __builtin_amdgcn_readfirstlane(t_q[0]) + (MODE == 2 ? T11 : 0);
        __syncthreads();
        if (q >= T_all) break;
        if (tid == 0) t_q[0] = (int)atomicAdd(qhead, 1u);
        const bool is_down = q >= T11;
        const int u = is_down ? (q - T11) >> 2 : q;
        int nt = is_down ? (q - T11) & 3 : 0;
        int e, h, mt, c, rowbase;
        if (u < T_r) {
            int j = 0;
#pragma unroll
            for (int qq = 1; qq < 16; ++qq) j += (u >= t_pre[qq]) ? 1 : 0;
            e = x + 8 * (j >> 1); h = j & 1; mt = u - t_pre[j]; c = t_cnt[j];
            rowbase = h * HH_HALF_ROWS + t_soff[j];
        } else {
            const int ms = x * 16 + (u - T_r);
            e = 64; h = ms >> 6; mt = ms & 63; c = HALF_TOK;
            rowbase = h * HH_HALF_ROWS + 65536;
        }
        e = __builtin_amdgcn_readfirstlane(e); h = __builtin_amdgcn_readfirstlane(h); mt = __builtin_amdgcn_readfirstlane(mt);
        nt = __builtin_amdgcn_readfirstlane(nt); c = __builtin_amdgcn_readfirstlane(c); rowbase = __builtin_amdgcn_readfirstlane(rowbase);
        const int* el = WSP_elist + (size_t)(h * 64 + (e & 63)) * ELIST_CAP;
        if (!is_down) {
            const int t2 = TIDX, lane = t2 & 63, wid = t2 >> 6, wr = wid >> 1, wc = wid & 1, fr = lane & 15, fq = lane >> 4;
            const int sb = lane * 16, swz = sb ^ (((sb >> 9) & 1) << 5);
            const int r_in = swz >> 6, c_in = (swz & 63) >> 1;
            const int vrows = c - mt * 128 - wr * 64;
            const float* wsl = WSP_wsl + (size_t)(h * 64 + (e & 63)) * ELIST_CAP;
            const u16* aptr[2];
#pragma unroll
            for (int i = 0; i < 2; ++i) {
                int li = mt * 128 + (wid + 4 * i) * 16 + r_in;
                li = li < c ? li : c - 1;
                const int tok = (e < 64) ? (el[li] >> 3) : (h * HALF_TOK + li);
                aptr[i] = WSP_H2 + (size_t)tok * 1024 + c_in;
            }
            const u16* Bw = WSP_WguT + (size_t)e * 262144 + c_in;
            f32x4 acc[4][8];
            gemm_tile_w(32,
                [&](int i, int R, int C, int kt) { return (const void*)(aptr[i] + kt * 32); },
                [&](int i, int R, int C, int kt) { return (const void*)(Bw + (size_t)R * 1024 + kt * 32); }, acc);
            float wgt[4][4];
#pragma unroll
            for (int m = 0; m < 4; ++m)
#pragma unroll
                for (int j = 0; j < 4; ++j) {
                    const int li = mt * 128 + wr * 64 + m * 16 + fq * 4 + j;
                    float w = 1.f;
                    if (e < 64) w = (li < c) ? wsl[li] : 0.f;
                    wgt[m][j] = w;
                }
            u16* dbase = WSP_HHs + ((size_t)rowbase + mt * 128 + wr * 64) * 128 + wc * 64;
            wave_store_bf16_f([&](int m, int n2, int j) { return siluf_(acc[m][2 * n2][j]) * acc[m][2 * n2 + 1][j] * wgt[m][j]; },
                              [&](int row) { return row < vrows ? dbase + (size_t)row * 128 : (u16*)nullptr; }, true, (const char*)WSP_HHs, (unsigned)((size_t)2 * HH_HALF_ROWS * 128 * 2));
            asm volatile("s_waitcnt vmcnt(0)" ::: "memory");
            __syncthreads();
            if (tid == 0) __hip_atomic_store(&flags[u], 1u, __ATOMIC_RELAXED, __HIP_MEMORY_SCOPE_AGENT);
        } else {
            const int t2 = TIDX, lane = t2 & 63, wid = t2 >> 6, wr = wid >> 1, wc = wid & 1, fr = lane & 15, fq = lane >> 4;
            const int sb = lane * 16, swz = sb ^ (((sb >> 9) & 1) << 5);
            const int r_in = swz >> 6, c_in = (swz & 63) >> 1;
            const int vrows = c - mt * 128 - wr * 64;
            if (MODE == 0 && tid == 0) {
                unsigned sp = 0;
                while (__hip_atomic_load(&flags[u], __ATOMIC_RELAXED, __HIP_MEMORY_SCOPE_AGENT) == 0u) {
                    __builtin_amdgcn_s_sleep(2);
                    if ((++sp & 255u) == 0u) {
                        if (__hip_atomic_load(tmo, __ATOMIC_RELAXED, __HIP_MEMORY_SCOPE_AGENT)) break;
                        if (sp > (1u << 20)) { atomicAdd(tmo, 1u); break; }
                    }
                }
            }
            __syncthreads();
            const u16* aptr[2];
#pragma unroll
            for (int i = 0; i < 2; ++i) {
                int li = mt * 128 + (wid + 4 * i) * 16 + r_in;
                li = li < c ? li : c - 1;
                aptr[i] = WSP_HHs + ((size_t)rowbase + li) * 128 + c_in;
            }
            const u16* Bw = WSP_WdT + ((size_t)e * 1024 + nt * 256) * 128 + c_in;
            int slot[8];
            if (e < 64) {
#pragma unroll
                for (int i = 0; i < 8; ++i) {
                    int li = mt * 128 + wr * 64 + ((i * 64 + lane) >> 3);
                    li = li < c ? li : c - 1;
                    slot[i] = el[li];
                }
            } else {
#pragma unroll
                for (int i = 0; i < 8; ++i) slot[i] = (h * HALF_TOK + mt * 128 + wr * 64 + ((i * 64 + lane) >> 3)) * 8;
            }
            f32x4 acc[4][8];
            gemm_tile_w<true>(4,
                [&](int i, int R, int C, int kt) { return (const void*)(aptr[i] + kt * 32); },
                [&](int i, int R, int C, int kt) { return (const void*)(Bw + (size_t)R * 128 + kt * 32); }, acc);
            const int colo = nt * 256 + wc * 128;
            if (e < 64) {
                wave_store_fp8_f([&](int m, int n, int j) { return acc[m][n][j] * YD_SCALE; }, [&](int i, int row) {
                    if (row >= vrows) return (unsigned char*)nullptr;
                    const int s = slot[i];
                    return Yd8 + ((size_t)(s >> 3) * 8 + (s & 7)) * 1024 + colo;
                });
            } else {
                const int tok0 = h * HALF_TOK + mt * 128 + wr * 64;
                const float* g2 = WSP_mod + (tok0 >> 11) * 6144 + 5120 + colo;
                float* stg = (float*)(smem + wid * 8448);
#pragma unroll
                for (int m = 0; m < 4; ++m) {
#pragma unroll
                    for (int n = 0; n < 8; ++n)
#pragma unroll
                        for (int j = 0; j < 4; ++j) stg[(fq * 4 + j) * 132 + n * 16 + fr] = acc[m][n][j];
                    asm volatile("s_waitcnt lgkmcnt(0)" ::: "memory");
                    __builtin_amdgcn_wave_barrier();
#pragma unroll
                    for (int i = 0; i < 8; ++i) {
                        const int id = i * 64 + lane, rr = id >> 5, c4 = (id & 31) * 4;
                        const float4 v = *(const float4*)(stg + rr * 132 + c4);
                        const float4 g = *(const float4*)(g2 + c4);
                        float* op = p.out + (size_t)(tok0 + m * 16 + rr) * 1024 + colo + c4;
                        const float4 xv = *(const float4*)op;
                        *(float4*)op = make_float4(xv.x + g.x * v.x, xv.y + g.y * v.y, xv.z + g.z * v.z, xv.w + g.w * v.w);
                    }
                    asm volatile("s_waitcnt lgkmcnt(0)" ::: "memory");
                    __builtin_amdgcn_wave_barrier();
                }
            }
        }
    }
}

#define P12_SLD 2064
template <bool DUMMY>
__device__ __forceinline__ void phase12b_t(const Params& p) {
    const int tid = TIDX, lane = tid & 63, wid = tid >> 6, fr = lane & 15, fq = lane >> 4;
    const unsigned char* Yd8 = (const unsigned char*)(p.ws + OFF_ARENA);
    const u16* Wb = WSP_WdT + (size_t)64 * 131072 + (size_t)(wid * 256 + fr) * 128 + fq * 8;
    for (int tile = blockIdx.x; tile < NLAT / 32; tile += gridDim.x) {
        const int tok0 = tile * 32;
        const int hh = tok0 >> 13;
        const u16* Ab = WSP_HHs + ((size_t)hh * HH_HALF_ROWS + 65536 + (tok0 & 8191) + fr) * 128 + fq * 8;
        __syncthreads();
        bf16x8 af[2][4];
#pragma unroll
        for (int m = 0; m < 2; ++m)
#pragma unroll
            for (int ks = 0; ks < 4; ++ks) af[m][ks] = *(const bf16x8*)(Ab + (size_t)m * 16 * 128 + ks * 32);
#pragma unroll 1
        for (int nb = 0; nb < 4; ++nb) {
            bf16x8 bfr[4][4];
#pragma unroll
            for (int n = 0; n < 4; ++n)
#pragma unroll
                for (int ks = 0; ks < 4; ++ks) bfr[n][ks] = *(const bf16x8*)(Wb + (size_t)((nb * 4 + n) * 16) * 128 + ks * 32);
#pragma unroll
            for (int m = 0; m < 2; ++m)
#pragma unroll
                for (int n = 0; n < 4; ++n) {
                    f32x4 d = {0.f, 0.f, 0.f, 0.f};
#pragma unroll
                    for (int ks = 0; ks < 4; ++ks) d = __builtin_amdgcn_mfma_f32_16x16x32_bf16(af[m][ks], bfr[n][ks], d, 0, 0, 0);
                    const int col = wid * 256 + (nb * 4 + n) * 16 + fr;
#pragma unroll
                    for (int j = 0; j < 4; ++j) *(u16*)(smem + (m * 16 + fq * 4 + j) * P12_SLD + col * 2) = f2bf(d[j]);
                }
        }
        __syncthreads();
        for (int rr = 0; rr < 8; ++rr) {
            const int row = wid * 8 + rr, tok = tok0 + row;
            float* xrow = p.out + (size_t)tok * 1024 + lane * 16;
            float* orow = DUMMY ? (float*)(p.ws + OFF_HHS) + (size_t)(tok & 8191) * 1024 + lane * 16 : xrow;
            const float* g2 = WSP_mod + (tok >> 11) * 6144 + 5120 + lane * 16;
            float s[16];
#pragma unroll
            for (int i = 0; i < 16; ++i) s[i] = 0.f;
            const unsigned char* yp = Yd8 + (size_t)tok * 8 * 1024 + lane * 16;
            uint4 yv[8];
#pragma unroll
            for (int k = 0; k < 8; ++k) { const u32x4 t = __builtin_nontemporal_load((const u32x4*)(yp + k * 1024)); yv[k] = make_uint4(t[0], t[1], t[2], t[3]); }
#pragma unroll
            for (int k = 0; k < 8; ++k) {
                const unsigned w[4] = {yv[k].x, yv[k].y, yv[k].z, yv[k].w};
#pragma unroll
                for (int i = 0; i < 4; ++i) {
                    const auto lo = __builtin_amdgcn_cvt_pk_f32_fp8((int)w[i], false);
                    const auto hi = __builtin_amdgcn_cvt_pk_f32_fp8((int)w[i], true);
                    s[4 * i] += lo[0]; s[4 * i + 1] += lo[1]; s[4 * i + 2] += hi[0]; s[4 * i + 3] += hi[1];
                }
            }
            const uint4 sa = *(const uint4*)(smem + row * P12_SLD + lane * 32), sbv = *(const uint4*)(smem + row * P12_SLD + lane * 32 + 16);
            const unsigned sw[8] = {sa.x, sa.y, sa.z, sa.w, sbv.x, sbv.y, sbv.z, sbv.w};
#pragma unroll
            for (int i = 0; i < 8; ++i) {
                s[2 * i] = s[2 * i] * (1.f / YD_SCALE) + bf2f((u16)(sw[i] & 0xffffu));
                s[2 * i + 1] = s[2 * i + 1] * (1.f / YD_SCALE) + bf2f((u16)(sw[i] >> 16));
            }
            float ss = 0.f;
#pragma unroll
            for (int q = 0; q < 4; ++q) {
                const float4 xv = *(const float4*)(xrow + q * 4), gv = *(const float4*)(g2 + q * 4);
                s[4 * q] = xv.x + gv.x * s[4 * q]; s[4 * q + 1] = xv.y + gv.y * s[4 * q + 1];
                s[4 * q + 2] = xv.z + gv.z * s[4 * q + 2]; s[4 * q + 3] = xv.w + gv.w * s[4 * q + 3];
                ss += s[4 * q] * s[4 * q] + s[4 * q + 1] * s[4 * q + 1] + s[4 * q + 2] * s[4 * q + 2] + s[4 * q + 3] * s[4 * q + 3];
            }
            ss = wave_sum(ss);
            const float rs = rsqrtf(ss * (1.f / 1024.f) + EPS);
#pragma unroll
            for (int q = 0; q < 4; ++q) {
                const float4 g = *(const float4*)(p.norm_final + lane * 16 + q * 4);
                *(float4*)(orow + q * 4) = make_float4(s[4 * q] * rs * g.x, s[4 * q + 1] * rs * g.y, s[4 * q + 2] * rs * g.z, s[4 * q + 3] * rs * g.w);
            }
        }
    }
}

#define SMEM_TOTAL (73728 + 3072 + 64)

#if 1
__global__ void __launch_bounds__(NTHR, 2) k_mega(Params p) {
    volatile LAS unsigned* st = (volatile LAS unsigned*)(smem + SMEM_TOTAL - 16);
    if (TIDX == 0) { st[0] = 0u; st[1] = 0u; st[2] = 0u; st[3] = 0u; }
    __syncthreads();
    XcdBarrier bar = xcd_barrier_post(WSP_bar, st);
#define RUNP(N) do { phase##N(p); if (PROBE_DUP == N) phase##N(p); } while (0)
    RUNP(0);  xcd_barrier(bar);
    RUNP(1);  xcd_barrier(bar);
    RUNP(2);  xcd_barrier(bar);
    RUNP(3);  xcd_barrier(bar);
    RUNP(4);  xcd_barrier(bar);
    RUNP(5);  xcd_barrier(bar);
    RUNP(6);  xcd_barrier(bar);
    RUNP(8);  xcd_barrier(bar);
#if PROBE_DUP == 91
    phase9_t<1>(p); xcd_barrier(bar);
#endif
#if PROBE_DUP == 92
    phase9_t<2>(p); xcd_barrier(bar);
#endif
    phase9_t<0>(p); xcd_barrier(bar);
#if PROBE_DUP == 9
    if (blockIdx.x == 0 && TIDX < 128) WSP_ctr[CTR_ECNT + TIDX] = 0u;
    xcd_barrier(bar); phase9_t<0>(p); xcd_barrier(bar);
#endif
#ifndef MOE_FUSED
#define MOE_FUSED 1
#endif
#if MOE_FUSED
    phase11f<0>(p); xcd_barrier(bar);
#else
    phase11f<1>(p); xcd_barrier(bar);
    phase11f<2>(p); xcd_barrier(bar);
#endif
#if PROBE_DUP == 11
    if (blockIdx.x == 0 && TIDX < 8) WSP_ctr[CTR_Q11 + TIDX] = 0u;
    if (blockIdx.x == 1) for (int i = TIDX; i < 8 * FLAG_PER_CLASS; i += NTHR) WSP_flag[i] = 0u;
    xcd_barrier(bar); phase11f<0>(p); xcd_barrier(bar);
#endif
#if PROBE_DUP == 121
    phase12b_t<true>(p); xcd_barrier(bar);
#endif
    phase12b_t<false>(p);
}
#endif


extern "C" void kernel_launch(void* const* d_in, const int* in_sizes, int n_in,
                              void* d_out, int out_size, void* d_ws, size_t ws_size,
                              hipStream_t stream) {
    Params p{};
    const float** ip = (const float**)&p.x;
    for (int i = 0; i < 32; ++i) ip[i] = (const float*)d_in[i];
    p.out = (float*)d_out;
    p.ws = (char*)d_ws;
    if (OFF_END > ws_size) { fprintf(stderr, "workspace too small: need %zu have %zu\n", (size_t)OFF_END, ws_size); return; }

    static int grid = 0;
    if (!grid) {
        hipFuncSetAttribute((const void*)k_mega, hipFuncAttributeMaxDynamicSharedMemorySize, SMEM_TOTAL);
        int dev = 0, cus = 0, per_cu = 0;
        hipGetDevice(&dev);
        hipDeviceGetAttribute(&cus, hipDeviceAttributeMultiprocessorCount, dev);
        hipOccupancyMaxActiveBlocksPerMultiprocessor(&per_cu, (const void*)k_mega, NTHR, SMEM_TOTAL);
        if (per_cu < 1) per_cu = 1;
        grid = cus * (per_cu < 2 ? per_cu : 2);
    }
    hipMemsetAsync(p.ws + OFF_BAR, 0, ZERO_BYTES, stream);
    k_mega<<<grid, NTHR, SMEM_TOTAL, stream>>>(p);
}
```

```cpp
#include <hip/hip_runtime.h>
#include <hip/hip_bf16.h>
#include <stdint.h>
#include <stdio.h>

#ifndef MK_MULTI
#define MK_MULTI 0
#endif

typedef __attribute__((ext_vector_type(8))) short bf16x8;
typedef __attribute__((ext_vector_type(4))) short bf16x4;
typedef __attribute__((ext_vector_type(4))) float f32x4;
typedef unsigned short u16;
typedef __attribute__((ext_vector_type(4))) unsigned u32x4;

#ifndef PROBE_DUP
#define PROBE_DUP -1
#endif
#define NTHR 256
__device__ __forceinline__ int opaque_tid() { int t = (int)threadIdx.x; asm volatile("" : "+v"(t)); return t; }
#define TIDX opaque_tid()
#define LDS_BYTES 65536

#define D_MODEL 1024
#define BATCH 8
#define SEQ 2048
#define CTXL 256
#define NLAT (BATCH * SEQ)
#define NCTX (BATCH * CTXL)
#define NROWS (NLAT + NCTX)
#define INW 1280
#define NEXP 64
#define VT_LD (SEQ + CTXL)
#define NCHUNK_LAT 1024
#define NCHUNK_ALL 1152
#define EPS 1e-6f

#define XB_TMO      128
#define XB_XCNT(j)  (256  + 64 * (j))
#define XB_XSUB(j)  (1280 + 64 * (j))
#define XB_XGEN(j)  (2304 + 64 * (j))
#define XB_TOP      3328
#define XB_TOPGEN   3392
#define XCD_BAR_WORDS 3456
#define XB_SPIN_CAP (1u << 20)
#define LAS __attribute__((address_space(3)))

__device__ __forceinline__ unsigned xb_ld(unsigned* p)              { return __hip_atomic_load(p, __ATOMIC_RELAXED, __HIP_MEMORY_SCOPE_AGENT); }
__device__ __forceinline__ unsigned xb_add(unsigned* p, unsigned v) { return __hip_atomic_fetch_add(p, v, __ATOMIC_RELAXED, __HIP_MEMORY_SCOPE_AGENT); }
__device__ __forceinline__ unsigned xb_xcc_id() { return (unsigned)__builtin_amdgcn_s_getreg((3 << 11) | 20) & 0xFu; }
#define XB_SPIN(cond, bar) do { unsigned _sp = 0; while (cond) { __builtin_amdgcn_s_sleep(1); \
    if ((++_sp & 255u) == 0u) { if (xb_ld(&(bar)[XB_TMO])) break; if (_sp > XB_SPIN_CAP) { atomicAdd(&(bar)[XB_TMO], 1u); break; } } } } while (0)

struct XcdBarrier { unsigned* bar; unsigned x; volatile LAS unsigned* st; };

__device__ __forceinline__ XcdBarrier xcd_barrier_post(unsigned* bar, volatile LAS unsigned* st) {
    XcdBarrier b; b.bar = bar; b.x = xb_xcc_id(); b.st = st;
    if (TIDX == 0) (void)xb_add(&bar[XB_XCNT(b.x)], 1u);
    return b;
}
__device__ __forceinline__ void xcd_barrier_complete(unsigned* bar, unsigned x, unsigned& nloc, unsigned& nx) {
    const unsigned G = gridDim.x * gridDim.y * gridDim.z;
    unsigned sum, cnt, mine, sp = 0u;
    for (;;) {
        sum = 0u; cnt = 0u; mine = 0u;
#pragma unroll
        for (unsigned j = 0; j < 16; ++j) { const unsigned c = xb_ld(&bar[XB_XCNT(j)]); sum += c; cnt += (c > 0u) ? 1u : 0u; mine = (j == x) ? c : mine; }
        if (sum == G) break;
        __builtin_amdgcn_s_sleep(1);
        if ((++sp & 255u) == 0u) { if (xb_ld(&bar[XB_TMO])) break; if (sp > XB_SPIN_CAP) { atomicAdd(&bar[XB_TMO], 1u); break; } }
    }
    nloc = mine > 0u ? mine : 1u; nx = cnt > 0u ? cnt : 1u;
}
__device__ __forceinline__ void xcd_barrier(const XcdBarrier& b) {
    asm volatile("s_waitcnt vmcnt(0)" ::: "memory");
    __syncthreads();
    if (TIDX == 0) {
        unsigned* bar = b.bar;
        __builtin_amdgcn_s_waitcnt(0);
        unsigned nloc = b.st[0], nx = b.st[1];
        if (nloc == 0u) { xcd_barrier_complete(bar, b.x, nloc, nx); b.st[0] = nloc; b.st[1] = nx; }
        const unsigned old = xb_add(&bar[XB_XSUB(b.x)], 1u);
        const unsigned gen = old / nloc;
        if (old + 1u == (gen + 1u) * nloc) {
            __builtin_amdgcn_fence(__ATOMIC_RELEASE, "agent");
            asm volatile("s_waitcnt vmcnt(0)" ::: "memory");
            const unsigned og = xb_add(&bar[XB_TOP], 1u);
            const unsigned tg = og / nx;
            if (og + 1u == (tg + 1u) * nx) xb_add(&bar[XB_TOPGEN], 1u);
            else XB_SPIN(xb_ld(&bar[XB_TOPGEN]) == tg, bar);
            __builtin_amdgcn_fence(__ATOMIC_ACQUIRE, "agent");
            xb_add(&bar[XB_XGEN(b.x)], 1u);
            asm volatile("s_waitcnt vmcnt(0)" ::: "memory");
        } else {
            XB_SPIN(xb_ld(&bar[XB_XGEN(b.x)]) == gen, bar);
            __builtin_amdgcn_fence(__ATOMIC_ACQUIRE, "agent");
            asm volatile("s_waitcnt vmcnt(0)" ::: "memory");
        }
    }
    __syncthreads();
}

struct Params {
    const float *x, *c, *ctx, *c_ctx, *w_ada, *b_ada, *norm_mix, *norm_ffn, *w_in, *attn_sink,
        *a_re, *a_im, *log_dt, *b_re, *b_im, *c_re, *c_im, *ssm_d, *w_glu, *b_glu, *norm_attn_out, *norm_ssm_out,
        *w_out, *w_router, *router_bias, *w_gate_e, *w_up_e, *w_down_e, *w_gate_s, *w_up_s, *w_down_s, *norm_final;
    float* out;
    char* ws;
};

constexpr size_t A256(size_t v) { return (v + 255) & ~(size_t)255; }
constexpr size_t OFF_BAR   = 0;
constexpr size_t OFF_RSQ   = A256(OFF_BAR + XCD_BAR_WORDS * 4 + 1024);
#define FLAG_PER_CLASS 1280
constexpr size_t OFF_FLAG  = OFF_RSQ + (size_t)NLAT * 2 * 4;
constexpr size_t ZERO_BYTES = OFF_FLAG + (8 * FLAG_PER_CLASS + 64) * 4;
constexpr size_t OFF_MOD   = A256(ZERO_BYTES);
constexpr size_t OFF_ROPE  = A256(OFF_MOD + 9 * 6144 * 4);
constexpr size_t OFF_KBUF  = A256(OFF_ROPE + 64 * 16 * 8);
constexpr size_t OFF_ELIST = A256(OFF_KBUF + (size_t)32 * 2 * 4096 * 4);
constexpr size_t OFF_WSL   = A256(OFF_ELIST + (size_t)2 * 64 * 8192 * 4);
constexpr size_t OFF_WDT   = A256(OFF_WSL + (size_t)2 * 64 * 8192 * 4);
constexpr size_t OFF_HHS   = A256(OFF_WDT + (size_t)65 * 1024 * 128 * 2);
constexpr size_t OFF_WGUT  = A256(OFF_HHS + (size_t)2 * 73728 * 128 * 2);
constexpr size_t OFF_H2R   = A256(OFF_WGUT + (size_t)65 * 256 * 1024 * 2);
constexpr size_t OFF_ARENA = A256(OFF_H2R + (size_t)NLAT * 1024 * 2);
constexpr size_t OFF_TABS  = OFF_ARENA;
constexpr size_t OFF_TABY  = A256(OFF_TABS + (size_t)32 * 256 * 256 * 2);
constexpr size_t OFF_R1    = A256(OFF_TABY + (size_t)32 * 256 * 512 * 2);
constexpr size_t OFF_R2    = A256(OFF_R1 + (size_t)NROWS * 1024 * 2);
constexpr size_t OFF_R4    = A256(OFF_R2 + (size_t)NLAT * 1024 * 2);
constexpr size_t OFF_WINT  = A256(OFF_R4 + (size_t)NLAT * 512 * 2 * 2);
constexpr size_t OFF_WGLUT = A256(OFF_WINT + (size_t)1280 * 1024 * 2);
constexpr size_t OFF_WOUTT = A256(OFF_WGLUT + (size_t)512 * 512 * 2);
constexpr size_t OFF_WRT   = A256(OFF_WOUTT + (size_t)1024 * 1024 * 2);
constexpr size_t OFF_EARLY_END = A256(OFF_WRT + (size_t)128 * 1024 * 2);
constexpr size_t YD8_BYTES = (size_t)NLAT * 8 * 1024;
constexpr size_t OFF_END   = (OFF_EARLY_END > OFF_ARENA + YD8_BYTES) ? OFF_EARLY_END : A256(OFF_ARENA + YD8_BYTES);
static_assert(OFF_END <= (size_t)256 * 1024 * 1024, "workspace map must fit the guaranteed 256 MiB");
#define CTR_QS1 160
#define WSP_bar   ((unsigned*)(p.ws + OFF_BAR))
#define WSP_ctr   ((unsigned*)(p.ws + OFF_BAR) + XCD_BAR_WORDS)
#define WSP_rsq   ((float*)(p.ws + OFF_RSQ))
#define WSP_flag  ((unsigned*)(p.ws + OFF_FLAG))
#define WSP_mod   ((float*)(p.ws + OFF_MOD))
#define WSP_rope  ((float2*)(p.ws + OFF_ROPE))
#define WSP_Kbuf  ((float*)(p.ws + OFF_KBUF))
#define WSP_elist ((int*)(p.ws + OFF_ELIST))
#define WSP_wsl   ((float*)(p.ws + OFF_WSL))
#define WSP_WinT  ((u16*)(p.ws + OFF_WINT))
#define WSP_WgluT ((u16*)(p.ws + OFF_WGLUT))
#define WSP_WoutT ((u16*)(p.ws + OFF_WOUTT))
#define WSP_WrT   ((u16*)(p.ws + OFF_WRT))
#define WSP_WdT   ((u16*)(p.ws + OFF_WDT))
#define WSP_HHs   ((u16*)(p.ws + OFF_HHS))
#define WSP_WguT  ((u16*)(p.ws + OFF_WGUT))
#define WSP_TabS  ((u16*)(p.ws + OFF_TABS))
#define WSP_TabY  ((u16*)(p.ws + OFF_TABY))
#define WSP_Hb    ((u16*)(p.ws + OFF_R1))
#define WSP_S     ((float*)(p.ws + OFF_R1))
#define WSP_H2    ((u16*)(p.ws + OFF_H2R))
#define WSP_Q     ((u16*)(p.ws + OFF_R2))
#define WSP_Kb    ((u16*)(p.ws + OFF_R2 + (size_t)NLAT * 512 * 2))
#define WSP_Vt    ((u16*)(p.ws + OFF_R2 + (size_t)NLAT * 512 * 2 + (size_t)NROWS * 128 * 2))
#define WSP_Y     ((u16*)(p.ws + OFF_R2))
#define WSP_SO    ((u16*)(p.ws + OFF_R2 + (size_t)NLAT * 512 * 2))
#define WSP_U     ((u16*)(p.ws + OFF_H2R))
#define WSP_AO    ((u16*)(p.ws + OFF_R4))
#define WSP_Hin   ((u16*)(p.ws + OFF_R4 + (size_t)NLAT * 512 * 2))

extern __shared__ __attribute__((aligned(16))) char smem[];

typedef __bf16 bf2_t __attribute__((ext_vector_type(2)));
typedef float f2_t __attribute__((ext_vector_type(2)));
__device__ __forceinline__ unsigned pack2(float a, float b) {
    const f2_t v = {a, b};
    return __builtin_bit_cast(unsigned, __builtin_convertvector(v, bf2_t));
}
__device__ __forceinline__ u16 f2bf(float f) { return (u16)(pack2(f, 0.f) & 0xffffu); }
__device__ __forceinline__ float bf2f(u16 h) { return __uint_as_float(((unsigned)h) << 16); }
__device__ __forceinline__ void glds16(const void* g, void* l) {
    __builtin_amdgcn_global_load_lds((const unsigned*)g, (unsigned*)l, 16, 0, 0);
}
__device__ __forceinline__ void glds16_sc1(const void* g, void* l) {
    __builtin_amdgcn_global_load_lds((const unsigned*)g, (unsigned*)l, 16, 0, 16);
}
__device__ __forceinline__ int lds_byte(int r, int c) {
    int st = (r >> 4) * 2 + (c >> 5), rr = r & 15, cc = c & 31, ob = rr * 64 + cc * 2;
    return st * 1024 + (ob ^ (((ob >> 9) & 1) << 5));
}
template <int CTRL> __device__ __forceinline__ float dppf(float v) {
    return __int_as_float(__builtin_amdgcn_update_dpp(0, __float_as_int(v), CTRL, 0xf, 0xf, true));
}
__device__ __forceinline__ float sum_x16(float v) {
    const unsigned u = __float_as_uint(v);
    const auto r = __builtin_amdgcn_permlane16_swap(u, u, false, false);
    return __uint_as_float(r[0]) + __uint_as_float(r[1]);
}
__device__ __forceinline__ float sum_x32(float v) {
    const unsigned u = __float_as_uint(v);
    const auto r = __builtin_amdgcn_permlane32_swap(u, u, false, false);
    return __uint_as_float(r[0]) + __uint_as_float(r[1]);
}
__device__ __forceinline__ float max_x16(float v) {
    const unsigned u = __float_as_uint(v);
    const auto r = __builtin_amdgcn_permlane16_swap(u, u, false, false);
    return fmaxf(__uint_as_float(r[0]), __uint_as_float(r[1]));
}
__device__ __forceinline__ float max_x32(float v) {
    const unsigned u = __float_as_uint(v);
    const auto r = __builtin_amdgcn_permlane32_swap(u, u, false, false);
    return fmaxf(__uint_as_float(r[0]), __uint_as_float(r[1]));
}
__device__ __forceinline__ float sum16(float v) {
    v += dppf<0xB1>(v);
    v += dppf<0x4E>(v);
    v += dppf<0x141>(v);
    v += dppf<0x140>(v);
    return v;
}
__device__ __forceinline__ float wave_sum(float v) { return sum_x32(sum_x16(sum16(v))); }
template <int CTRL> __device__ __forceinline__ float dpp_f(float v) {
    return __int_as_float(__builtin_amdgcn_update_dpp(0, __float_as_int(v), CTRL, 0xf, 0xf, true));
}
__device__ __forceinline__ float max8(float v) {
    v = fmaxf(v, dpp_f<0xB1>(v));
    v = fmaxf(v, dpp_f<0x4E>(v));
    v = fmaxf(v, dpp_f<0x141>(v));
    return v;
}
__device__ __forceinline__ float sigmoidf_(float x) { return __builtin_amdgcn_rcpf(1.f + __expf(-x)); }
__device__ __forceinline__ float siluf_(float x) { return x * __builtin_amdgcn_rcpf(1.f + __expf(-x)); }
__device__ __forceinline__ float gelu_tanh(float x) {
    float u = 0.7978845608028654f * (x + 0.044715f * x * x * x);
    return x * __builtin_amdgcn_rcpf(1.f + __expf(-2.f * u));
}

template <class FA, class FB>
__device__ __forceinline__ void gemm_tile(int nkt, FA fa, FB fb, f32x4 (&acc)[4][4]) {
    const int tid = TIDX, lane = tid & 63, wid = tid >> 6, wr = wid >> 1, wc = wid & 1, fr = lane & 15, fq = lane >> 4;
    const int sb = lane * 16, swz = sb ^ (((sb >> 9) & 1) << 5);
    const int r_in = swz >> 6, c_in = (swz & 63) >> 1;
#pragma unroll
    for (int m = 0; m < 4; ++m)
#pragma unroll
        for (int n = 0; n < 4; ++n) acc[m][n] = (f32x4){0.f, 0.f, 0.f, 0.f};
    __syncthreads();
    auto stage = [&](int kt, int s) {
        char* sa = smem + s * 32768;
        char* sbm = sa + 16384;
#pragma unroll
        for (int i = 0; i < 4; ++i) {
            const int st = wid + 4 * i, R = (st >> 1) * 16 + r_in, C = (st & 1) * 32 + c_in;
            glds16(fa(R, C, kt), sa + tid * 16 + i * 4096);
            glds16(fb(R, C, kt), sbm + tid * 16 + i * 4096);
        }
    };
    stage(0, 0);
    for (int kt = 0; kt < nkt; ++kt) {
        asm volatile("s_waitcnt vmcnt(0)" ::: "memory");
        __syncthreads();
        if (kt + 1 < nkt) stage(kt + 1, (kt + 1) & 1);
        const char* sa = smem + (kt & 1) * 32768;
        const char* sbm = sa + 16384;
#pragma unroll
        for (int ks = 0; ks < 2; ++ks) {
            bf16x8 a[4], b[4];
#pragma unroll
            for (int m = 0; m < 4; ++m) a[m] = *(const bf16x8*)(sa + lds_byte(wr * 64 + m * 16 + fr, ks * 32 + fq * 8));
#pragma unroll
            for (int n = 0; n < 4; ++n) b[n] = *(const bf16x8*)(sbm + lds_byte(wc * 64 + n * 16 + fr, ks * 32 + fq * 8));
            __builtin_amdgcn_s_setprio(1);
#pragma unroll
            for (int m = 0; m < 4; ++m)
#pragma unroll
                for (int n = 0; n < 4; ++n) acc[m][n] = __builtin_amdgcn_mfma_f32_16x16x32_bf16(a[m], b[n], acc[m][n], 0, 0, 0);
            __builtin_amdgcn_s_setprio(0);
        }
    }
    __syncthreads();
}

__device__ __forceinline__ int lds32(int r, int c) {
    const int rr = r & 15;
    return (r >> 4) * 1024 + ((rr * 64 + c * 2) ^ (((rr >> 3) & 1) << 5));
}
struct NoHook { __device__ __forceinline__ void operator()(int) const {} };
template <bool A_SC1 = false, class FA, class FB, class HK = NoHook>
__device__ __forceinline__ void gemm_tile_w(int nkt, FA fa, FB fb, f32x4 (&acc)[4][8], HK hook = HK()) {
    constexpr bool ZERO = true;
    const int tid = TIDX, lane = tid & 63, wid = tid >> 6, wr = wid >> 1, wc = wid & 1, fr = lane & 15, fq = lane >> 4;
    const int sb = lane * 16, swz = sb ^ (((sb >> 9) & 1) << 5);
    const int r_in = swz >> 6, c_in = (swz & 63) >> 1;
    if (ZERO) {
#pragma unroll
        for (int m = 0; m < 4; ++m)
#pragma unroll
            for (int n = 0; n < 8; ++n) acc[m][n] = (f32x4){0.f, 0.f, 0.f, 0.f};
    }
    __syncthreads();
    auto stage = [&](int kt, int s) {
        char* sa = smem + s * 24576;
#pragma unroll
        for (int i = 0; i < 2; ++i) { if (A_SC1) glds16_sc1(fa(i, (wid + 4 * i) * 16 + r_in, c_in, kt), sa + tid * 16 + i * 4096); else glds16(fa(i, (wid + 4 * i) * 16 + r_in, c_in, kt), sa + tid * 16 + i * 4096); }
#pragma unroll
        for (int i = 0; i < 4; ++i) glds16(fb(i, (wid + 4 * i) * 16 + r_in, c_in, kt), sa + 8192 + tid * 16 + i * 4096);
    };
    stage(0, 0);
    if (nkt > 1) stage(1, 1);
    int s_cur = 0, s_nxt = 2;
    for (int kt = 0; kt < nkt; ++kt) {
        hook(kt);
        if (kt + 1 < nkt) asm volatile("s_waitcnt vmcnt(6) lgkmcnt(0)\n\ts_barrier" ::: "memory");
        else asm volatile("s_waitcnt vmcnt(0) lgkmcnt(0)\n\ts_barrier" ::: "memory");
        if (kt + 2 < nkt) stage(kt + 2, s_nxt);
        const char* sa = smem + s_cur * 24576;
        bf16x8 a[4];
#pragma unroll
        for (int m = 0; m < 4; ++m) a[m] = *(const bf16x8*)(sa + lds32(wr * 64 + m * 16 + fr, fq * 8));
#pragma unroll
        for (int nh = 0; nh < 2; ++nh) {
            bf16x8 b[4];
#pragma unroll
            for (int n = 0; n < 4; ++n) b[n] = *(const bf16x8*)(sa + 8192 + lds32(wc * 128 + (nh * 4 + n) * 16 + fr, fq * 8));
            __builtin_amdgcn_s_setprio(1);
#pragma unroll
            for (int m = 0; m < 4; ++m)
#pragma unroll
                for (int n = 0; n < 4; ++n) acc[m][nh * 4 + n] = __builtin_amdgcn_mfma_f32_16x16x32_bf16(a[m], b[n], acc[m][nh * 4 + n], 0, 0, 0);
            __builtin_amdgcn_s_setprio(0);
        }
        s_cur = (s_cur == 2) ? 0 : s_cur + 1;
        s_nxt = (s_nxt == 2) ? 0 : s_nxt + 1;
    }
    __syncthreads();
}

template <class FV, class FD>
__device__ __forceinline__ void wave_store_bf16_f(FV val, FD dst, bool write_through = false, const char* wt_base = nullptr, unsigned wt_bytes = 0) {
    const __amdgpu_buffer_rsrc_t wt_rsrc = __builtin_amdgcn_make_buffer_rsrc((void*)wt_base, 0, (int)wt_bytes, 0x00020000);
    const int lane = TIDX & 63, wid = TIDX >> 6, fr = lane & 15, fq = lane >> 4;
    char* base = smem + wid * 9216;
#pragma unroll
    for (int m = 0; m < 4; ++m)
#pragma unroll
        for (int n = 0; n < 4; ++n)
#pragma unroll
            for (int j = 0; j < 4; ++j)
                *(u16*)(base + (m * 16 + fq * 4 + j) * 144 + (n * 16 + fr) * 2) = f2bf(val(m, n, j));
    asm volatile("s_waitcnt lgkmcnt(0)" ::: "memory");
    __builtin_amdgcn_wave_barrier();
#pragma unroll
    for (int i = 0; i < 8; ++i) {
        const int id = i * 64 + lane, row = id >> 3, ch = id & 7;
        const uint4 d = *(const uint4*)(base + row * 144 + ch * 16);
        u16* p = dst(row);
        if (p) {
            if (write_through) {
                const u32x4 dv = {d.x, d.y, d.z, d.w};
                __builtin_amdgcn_raw_buffer_store_b128(dv, wt_rsrc, (int)((const char*)(p + ch * 8) - wt_base), 0, 16);
            } else *(uint4*)(p + ch * 8) = d;
        }
    }
    asm volatile("s_waitcnt lgkmcnt(0)" ::: "memory");
    __builtin_amdgcn_wave_barrier();
}

template <class FV, class FD>
__device__ __forceinline__ void wave_store_bf16_pk(FV val, FD dst, const char* wt_base, unsigned wt_bytes) {
    const __amdgpu_buffer_rsrc_t wt_rsrc = __builtin_amdgcn_make_buffer_rsrc((void*)wt_base, 0, (int)wt_bytes, 0x00020000);
    const int lane = TIDX & 63, wid = TIDX >> 6, fr = lane & 15, fq = lane >> 4;
    char* base = smem + wid * 9216;
#pragma unroll
    for (int m = 0; m < 4; ++m)
#pragma unroll
        for (int j = 0; j < 4; ++j)
            *(uint2*)(base + (m * 16 + fq * 4 + j) * 144 + fr * 8) = make_uint2(pack2(val(m, 0, j), val(m, 1, j)), pack2(val(m, 2, j), val(m, 3, j)));
    asm volatile("s_waitcnt lgkmcnt(0)" ::: "memory");
    __builtin_amdgcn_wave_barrier();
#pragma unroll
    for (int i = 0; i < 8; ++i) {
        const int id = i * 64 + lane, row = id >> 3, ch = id & 7;
        const uint4 d = *(const uint4*)(base + row * 144 + ch * 16);
        u16* p = dst(row);
        if (p) {
            const u32x4 dv = {d.x, d.y, d.z, d.w};
            __builtin_amdgcn_raw_buffer_store_b128(dv, wt_rsrc, (int)((const char*)(p + ch * 8) - wt_base), 0, 16);
        }
    }
    asm volatile("s_waitcnt lgkmcnt(0)" ::: "memory");
    __builtin_amdgcn_wave_barrier();
}
template <class FD>
__device__ __forceinline__ void wave_store_bf16(const float (&v)[4][4][4], FD dst) {
    wave_store_bf16_f([&](int m, int n, int j) { return v[m][n][j]; }, dst);
}

struct ConvD { const float* src; u16* dst; int ld, ldd, k0, n0, mode, zr; };
__device__ __forceinline__ void conv_load(const Params& p, const ConvD& d, float (&v)[16]) {
    const int tid = TIDX;
#pragma unroll
    for (int i = 0; i < 16; ++i) v[i] = d.src[(size_t)(d.k0 + i * 4 + (tid >> 6)) * d.ld + d.n0 + (tid & 63)];
    if (d.zr == 2) {
#pragma unroll
        for (int i = 0; i < 16; ++i) {
            const int k = d.k0 + i * 4 + (tid >> 6);
            v[i] *= (k < 512) ? p.norm_attn_out[k] : p.norm_ssm_out[k - 512];
        }
    }
}
__device__ __forceinline__ void conv_store(const Params& p, const ConvD& d, const float (&v)[16]) {
    float* t = (float*)smem;
    const int tid = TIDX;
    __syncthreads();
#pragma unroll
    for (int i = 0; i < 16; ++i) t[(i * 4 + (tid >> 6)) * 65 + (tid & 63)] = v[i];
    __syncthreads();
    const int n = tid >> 2, kq = tid & 3;
    unsigned w[8];
#pragma unroll
    for (int i = 0; i < 8; ++i) w[i] = pack2(t[(kq * 16 + 2 * i) * 65 + n], t[(kq * 16 + 2 * i + 1) * 65 + n]);
    const int gn = d.n0 + n;
    int row = gn;
    if (d.mode == 1) row = (gn >> 4) * 32 + (gn & 15);
    else if (d.mode == 2) row = (gn >> 4) * 32 + 16 + (gn & 15);
    else if (d.mode == 3) row = n;
    uint4* o = (uint4*)(d.dst + (size_t)row * d.ldd + d.k0 + kq * 16);
    o[0] = make_uint4(w[0], w[1], w[2], w[3]);
    o[1] = make_uint4(w[4], w[5], w[6], w[7]);
    if (d.zr == 1) {
        uint4* z = (uint4*)(WSP_WrT + (size_t)(64 + n) * 1024 + d.k0 + kq * 16);
        z[0] = make_uint4(0, 0, 0, 0); z[1] = make_uint4(0, 0, 0, 0);
    }
}

__device__ __forceinline__ void ada_item(const Params& p, int item) {
    float* sc = (float*)smem;
    float* red = sc + 9 * 1024;
    const int tid = TIDX;
    __syncthreads();
    for (int i = tid; i < 9 * 1024; i += NTHR) {
        const int r = i >> 10, k = i & 1023;
        const float cv = (r < 8) ? p.c[r * 1024 + k] : p.c_ctx[k];
        sc[i] = siluf_(cv);
    }
    __syncthreads();
    const int kq = tid >> 6, jl = tid & 63, j = item * 64 + jl;
    float acc[9];
#pragma unroll
    for (int r = 0; r < 9; ++r) acc[r] = 0.f;
#pragma unroll 16
    for (int k = kq; k < 1024; k += 4) {
        const float w = p.w_ada[(size_t)k * 6144 + j];
#pragma unroll
        for (int r = 0; r < 9; ++r) acc[r] += sc[r * 1024 + k] * w;
    }
#pragma unroll
    for (int r = 0; r < 9; ++r) red[(kq * 9 + r) * 64 + jl] = acc[r];
    __syncthreads();
    for (int i = tid; i < 9 * 64; i += NTHR) {
        const int r = i >> 6, l = i & 63;
        const float s = red[(0 * 9 + r) * 64 + l] + red[(1 * 9 + r) * 64 + l] + red[(2 * 9 + r) * 64 + l] + red[(3 * 9 + r) * 64 + l];
        WSP_mod[r * 6144 + item * 64 + l] = s + p.b_ada[item * 64 + l];
    }
}

__device__ __forceinline__ void rope_item(const Params& p) {
    for (int i = TIDX; i < 64 * 16; i += NTHR) {
        const int pos = i >> 4, k = i & 15;
        const float inv = exp2f(-(float)k * (13.287712379549449f / 16.f));
        float s, c;
        sincosf((float)pos * inv, &s, &c);
        WSP_rope[i] = make_float2(c, s);
    }
}

__device__ __forceinline__ void ssm_table_item(const Params& p, int g, int dir) {
    float* pw = (float*)smem;
    float* Bb = pw + 17 * 64 * 2;
    float* Cc = Bb + 64 * 16 * 2;
    const int tid = TIDX;
    u16* tabS = WSP_TabS + (size_t)g * 256 * 256;
    u16* tabY = WSP_TabY + (size_t)g * 256 * 512;
    float* Kf = WSP_Kbuf + (size_t)(g * 2 + dir) * 4096;
    __syncthreads();
    {
        const int pidx = dir * 32 + g;
        const float dt = __expf(p.log_dt[pidx]);
        for (int i = tid; i < 17 * 64; i += NTHR) {
            const int tau = i >> 6, n = i & 63;
            const float are = p.a_re[pidx * 64 + n], aim = p.a_im[pidx * 64 + n];
            const float mag = __expf((float)tau * dt * are);
            float rev = (float)tau * (dt * aim * 0.15915494309189535f);
            rev -= rintf(rev);
            pw[i * 2] = mag * __builtin_amdgcn_cosf(rev);
            pw[i * 2 + 1] = mag * __builtin_amdgcn_sinf(rev);
        }
        __syncthreads();
        for (int i = tid; i < 64 * 16; i += NTHR) {
            const int n = i >> 4;
            const float are = p.a_re[pidx * 64 + n], aim = p.a_im[pidx * 64 + n];
            const float abr = pw[(64 + n) * 2], abi = pw[(64 + n) * 2 + 1];
            const float den = are * are + aim * aim, nre = abr - 1.f;
            const float cre = (nre * are + abi * aim) / den, cim = (abi * are - nre * aim) / den;
            const float br = p.b_re[(size_t)pidx * 1024 + i], bi = p.b_im[(size_t)pidx * 1024 + i];
            Bb[i * 2] = cre * br - cim * bi;
            Bb[i * 2 + 1] = cre * bi + cim * br;
            Cc[i * 2] = p.c_re[(size_t)pidx * 1024 + i];
            Cc[i * 2 + 1] = p.c_im[(size_t)pidx * 1024 + i];
        }
        __syncthreads();
        {
            const int tau = tid >> 4, pp = tid & 15;
            float s[16];
#pragma unroll
            for (int q = 0; q < 16; ++q) s[q] = 0.f;
            for (int n = 0; n < 64; ++n) {
                const float2 cv = *(const float2*)&Cc[(pp * 64 + n) * 2];
                const float2 wv = *(const float2*)&pw[(tau * 64 + n) * 2];
                const float zr = cv.x * wv.x - cv.y * wv.y, zi = cv.x * wv.y + cv.y * wv.x;
#pragma unroll
                for (int q = 0; q < 16; ++q) {
                    const float2 bv = *(const float2*)&Bb[(n * 16 + q) * 2];
                    s[q] += zr * bv.x - zi * bv.y;
                }
            }
#pragma unroll
            for (int q = 0; q < 4; ++q)
                *(float4*)(Kf + tau * 256 + pp * 16 + q * 4) = make_float4(s[4 * q], s[4 * q + 1], s[4 * q + 2], s[4 * q + 3]);
        }
        for (int id = tid; id < 128 * 32; id += NTHR) {
            const int rr = id >> 5, ch = id & 31, cpart = rr >> 6, n = rr & 63, s_ = ch >> 1, q0 = (ch & 1) * 8;
            const int e = dir == 0 ? 15 - s_ : s_;
            const float wr_ = pw[(e * 64 + n) * 2], wi_ = pw[(e * 64 + n) * 2 + 1];
            unsigned w[4];
#pragma unroll
            for (int i = 0; i < 4; ++i) {
                float v[2];
#pragma unroll
                for (int h = 0; h < 2; ++h) {
                    const float br = Bb[(n * 16 + q0 + 2 * i + h) * 2], bi = Bb[(n * 16 + q0 + 2 * i + h) * 2 + 1];
                    v[h] = cpart == 0 ? (wr_ * br - wi_ * bi) : (wr_ * bi + wi_ * br);
                }
                w[i] = pack2(v[0], v[1]);
            }
            *(uint4*)(tabS + (size_t)(dir * 128 + rr) * 256 + s_ * 16 + q0) = make_uint4(w[0], w[1], w[2], w[3]);
        }
        for (int id = tid; id < 256 * 16; id += NTHR) {
            const int m = id >> 4, ch = id & 15, t = m >> 4, pp = m & 15, cpart = ch >> 3, n0 = (ch & 7) * 8;
            const int e = dir == 0 ? t + 1 : 16 - t;
            unsigned w[4];
#pragma unroll
            for (int i = 0; i < 4; ++i) {
                float v[2];
#pragma unroll
                for (int h = 0; h < 2; ++h) {
                    const int n = n0 + 2 * i + h;
                    const float cr = Cc[(pp * 64 + n) * 2], ci = Cc[(pp * 64 + n) * 2 + 1];
                    const float wr_ = pw[(e * 64 + n) * 2], wi_ = pw[(e * 64 + n) * 2 + 1];
                    v[h] = cpart == 0 ? (cr * wr_ - ci * wi_) : -(cr * wi_ + ci * wr_);
                }
                w[i] = pack2(v[0], v[1]);
            }
            *(uint4*)(tabY + (size_t)m * 512 + 256 + dir * 128 + cpart * 64 + n0) = make_uint4(w[0], w[1], w[2], w[3]);
        }
    }
}

__device__ __forceinline__ void ssm_toeplitz_item(const Params& p, int g) {
    float* Kf = (float*)smem;
    const int tid = TIDX;
    u16* tabY = WSP_TabY + (size_t)g * 256 * 512;
    __syncthreads();
    for (int i = tid; i < 2048; i += NTHR) ((float4*)Kf)[i] = ((const float4*)(WSP_Kbuf + (size_t)g * 8192))[i];
    __syncthreads();
    for (int id = tid; id < 256 * 32; id += NTHR) {
        const int m = id >> 5, ch = id & 31, t = m >> 4, pp = m & 15, s_ = ch >> 1, q0 = (ch & 1) * 8;
        unsigned w[4];
#pragma unroll
        for (int i = 0; i < 4; ++i) {
            float v[2];
#pragma unroll
            for (int h = 0; h < 2; ++h) {
                const int q = q0 + 2 * i + h;
                float val;
                if (s_ < t) val = Kf[((t - s_) * 16 + pp) * 16 + q];
                else if (s_ > t) val = Kf[4096 + ((s_ - t) * 16 + pp) * 16 + q];
                else val = Kf[(pp) * 16 + q] + Kf[4096 + pp * 16 + q] + (pp == q ? p.ssm_d[g * 16 + pp] : 0.f);
                v[h] = val;
            }
            w[i] = pack2(v[0], v[1]);
        }
        *(uint4*)(tabY + (size_t)m * 512 + s_ * 16 + q0) = make_uint4(w[0], w[1], w[2], w[3]);
    }
    __syncthreads();
}

#define N_CONV 6896
__device__ __forceinline__ ConvD conv_decode(const Params& p, int t) {
    ConvD d; d.mode = 0; d.zr = 0;
    if (t < 320) { d.src = p.w_in; d.ld = 1280; d.k0 = (t / 20) * 64; d.n0 = (t % 20) * 64; d.dst = WSP_WinT; d.ldd = 1024; return d; }
    t -= 320;
    if (t < 64) { d.src = p.w_glu; d.ld = 512; d.k0 = (t / 8) * 64; d.n0 = (t % 8) * 64; d.dst = WSP_WgluT; d.ldd = 512; return d; }
    t -= 64;
    if (t < 256) { d.src = p.w_out; d.ld = 1024; d.k0 = (t / 16) * 64; d.n0 = (t % 16) * 64; d.dst = WSP_WoutT; d.ldd = 1024; d.zr = 2; return d; }
    t -= 256;
    if (t < 16) { d.src = p.w_router; d.ld = 64; d.k0 = t * 64; d.n0 = 0; d.dst = WSP_WrT; d.ldd = 1024; d.zr = 1; return d; }
    t -= 16;
    if (t < 4096) {
        const int up = t >= 2048; const int tt = t & 2047, e = tt >> 5, r = tt & 31;
        d.src = (up ? p.w_up_e : p.w_gate_e) + (size_t)e * 131072; d.ld = 128; d.k0 = (r >> 1) * 64; d.n0 = (r & 1) * 64;
        d.dst = WSP_WguT + (size_t)e * 262144; d.ldd = 1024; d.mode = 1 + up; return d;
    }
    t -= 4096;
    if (t < 64) {
        const int up = t >= 32; const int r = t & 31;
        d.src = up ? p.w_up_s : p.w_gate_s; d.ld = 128; d.k0 = (r >> 1) * 64; d.n0 = (r & 1) * 64;
        d.dst = WSP_WguT + (size_t)64 * 262144; d.ldd = 1024; d.mode = 1 + up; return d;
    }
    t -= 64;
    if (t < 2048) { const int e = t >> 5, r = t & 31; d.src = p.w_down_e + (size_t)e * 131072; d.ld = 1024; d.k0 = (r >> 4) * 64; d.n0 = (r & 15) * 64; d.dst = WSP_WdT + (size_t)e * 131072; d.ldd = 128; return d; }
    t -= 2048;
    d.src = p.w_down_s; d.ld = 1024; d.k0 = (t >> 4) * 64; d.n0 = (t & 15) * 64; d.dst = WSP_WdT + (size_t)64 * 131072; d.ldd = 128; return d;
}

#define N_CONV_EARLY 4000
__device__ __forceinline__ void conv_range(const Params& p, int t0, int stride, int tend, int tbeg = 0) {
    int t = tbeg + t0;
    if (t < tend) {
        ConvD d = conv_decode(p, t);
        float v[16];
        conv_load(p, d, v);
        while (t < tend) {
            const int tn = t + stride;
            ConvD dn = d;
            float vn[16];
            if (tn < tend) { dn = conv_decode(p, tn); conv_load(p, dn, vn); }
            conv_store(p, d, v);
            d = dn;
#pragma unroll
            for (int i = 0; i < 16; ++i) v[i] = vn[i];
            t = tn;
        }
    }
}
#define P0_CONV_B0 161
__device__ __forceinline__ void phase0(const Params& p) {
    const int b = blockIdx.x, G = gridDim.x;
    if (G > P0_CONV_B0 + 32) {
        if (b < 64) ssm_table_item(p, b >> 1, b & 1);
        else if (b < 160) ada_item(p, b - 64);
        else if (b == 160) rope_item(p);
        else conv_range(p, b - P0_CONV_B0, G - P0_CONV_B0, N_CONV_EARLY);
    } else {
        const int NU = 64 + 96 + 1 + N_CONV_EARLY;
        for (int u = b; u < NU; u += G) {
            if (u < 64) ssm_table_item(p, u >> 1, u & 1);
            else if (u < 160) ada_item(p, u - 64);
            else if (u == 160) rope_item(p);
            else { ConvD d = conv_decode(p, u - 161); float v[16]; conv_load(p, d, v); conv_store(p, d, v); }
        }
    }
}
#if 0
    {
        {
            const int stride = G - P0_CONV_B0;
            int t = b - P0_CONV_B0;
            if (t < N_CONV) {
                ConvD d = conv_decode(p, t);
                float v[16];
                conv_load(p, d, v);
                while (t < N_CONV) {
                    const int tn = t + stride;
                    ConvD dn = d;
                    float vn[16];
                    if (tn < N_CONV) { dn = conv_decode(p, tn); conv_load(p, dn, vn); }
                    conv_store(p, d, v);
                    d = dn;
#pragma unroll
                    for (int i = 0; i < 16; ++i) v[i] = vn[i];
                    t = tn;
                }
            }
        }
    } else {
        const int NU = 64 + 96 + 1 + N_CONV;
        for (int u = b; u < NU; u += G) {
            if (u < 64) ssm_table_item(p, u >> 1, u & 1);
            else if (u < 160) ada_item(p, u - 64);
            else if (u == 160) rope_item(p);
            else { ConvD d = conv_decode(p, u - 161); float v[16]; conv_load(p, d, v); conv_store(p, d, v); }
        }
    }
}

#endif

__device__ __forceinline__ void norm_mod_row(const float* src, const float* gain, const float* sh, const float* scl, u16* dst) {
    const int lane = TIDX & 63;
    float4 v[4];
    float ss = 0.f;
#pragma unroll
    for (int i = 0; i < 4; ++i) {
        v[i] = *(const float4*)(src + i * 256 + lane * 4);
        ss += v[i].x * v[i].x + v[i].y * v[i].y + v[i].z * v[i].z + v[i].w * v[i].w;
    }
    ss = wave_sum(ss);
    const float rs = rsqrtf(ss * (1.f / 1024.f) + EPS);
#pragma unroll
    for (int i = 0; i < 4; ++i) {
        const int c0 = i * 256 + lane * 4;
        const float4 g = *(const float4*)(gain + c0), s = *(const float4*)(sh + c0), k = *(const float4*)(scl + c0);
        const float a = v[i].x * rs * g.x * (1.f + k.x) + s.x, b = v[i].y * rs * g.y * (1.f + k.y) + s.y;
        const float c = v[i].z * rs * g.z * (1.f + k.z) + s.z, d = v[i].w * rs * g.w * (1.f + k.w) + s.w;
        *(uint2*)(dst + c0) = make_uint2(pack2(a, b), pack2(c, d));
    }
}

__device__ __forceinline__ void phase1(const Params& p) {
    const int wv = blockIdx.x * 4 + (TIDX >> 6), nwv = gridDim.x * 4;
    const int lane = TIDX & 63;
    for (int r0 = wv * 4; r0 < NROWS; r0 += nwv * 4) {
        const float* src[4]; const float* md[4];
        float4 v[4][4];
#pragma unroll
        for (int q = 0; q < 4; ++q) {
            const int r = r0 + q;
            if (r < NLAT) { src[q] = p.x + (size_t)r * 1024; md[q] = WSP_mod + (r >> 11) * 6144; }
            else { src[q] = p.ctx + (size_t)(r - NLAT) * 1024; md[q] = WSP_mod + 8 * 6144; }
#pragma unroll
            for (int i = 0; i < 4; ++i) v[q][i] = *(const float4*)(src[q] + i * 256 + lane * 4);
        }
#pragma unroll
        for (int q = 0; q < 4; ++q) {
            float ss = 0.f;
#pragma unroll
            for (int i = 0; i < 4; ++i) ss += v[q][i].x * v[q][i].x + v[q][i].y * v[q][i].y + v[q][i].z * v[q][i].z + v[q][i].w * v[q][i].w;
            ss = wave_sum(ss);
            const float rs = rsqrtf(ss * (1.f / 1024.f) + EPS);
            u16* dst = WSP_Hb + (size_t)(r0 + q) * 1024;
#pragma unroll
            for (int i = 0; i < 4; ++i) {
                const int c0 = i * 256 + lane * 4;
                const float4 g = *(const float4*)(p.norm_mix + c0), s = *(const float4*)(md[q] + c0), k = *(const float4*)(md[q] + 1024 + c0);
                const float a = v[q][i].x * rs * g.x * (1.f + k.x) + s.x, b = v[q][i].y * rs * g.y * (1.f + k.y) + s.y;
                const float c = v[q][i].z * rs * g.z * (1.f + k.z) + s.z, d = v[q][i].w * rs * g.w * (1.f + k.w) + s.w;
                *(uint2*)(dst + c0) = make_uint2(pack2(a, b), pack2(c, d));
            }
        }
    }
}

__device__ __forceinline__ void phase2(const Params& p) {
    const int NU = 128 * 10 + 16 * 6;
    const int lane = TIDX & 63, wid = TIDX >> 6, wr = wid >> 1, wc = wid & 1, fr = lane & 15, fq = lane >> 4;
    for (int u = blockIdx.x; u < NU; u += gridDim.x) {
        int mt, nt;
        {
            const int xc = u & 7, r = u >> 3;
            if (r < 160) { mt = xc + 8 * (r / 10); nt = r % 10; } else { const int v = r - 160; mt = 128 + xc + 8 * (v / 6); nt = 4 + v % 6; }
        }
        const u16* A = WSP_Hb + (size_t)mt * 128 * 1024;
        const u16* B = WSP_WinT + (size_t)nt * 128 * 1024;
        f32x4 acc[4][4];
        gemm_tile(16,
            [&](int R, int C, int kt) { return (const void*)(A + (size_t)R * 1024 + kt * 64 + C); },
            [&](int R, int C, int kt) { return (const void*)(B + (size_t)R * 1024 + kt * 64 + C); }, acc);
        const int row0 = mt * 128 + wr * 64;
        const int col0 = nt * 128 + wc * 64;
        const bool is_lat = mt < 128;
        if (nt == 5) {
            const int kvh = wc;
#pragma unroll
            for (int m = 0; m < 4; ++m) {
                const int r = row0 + m * 16 + fq * 4;
                int b, pos;
                if (is_lat) { b = r >> 11; pos = r & 2047; } else { const int rc = r - NLAT; b = rc >> 8; pos = SEQ + (rc & 255); }
#pragma unroll
                for (int n = 0; n < 4; ++n) {
                    const int d = n * 16 + fr;
                    u16* dst = WSP_Vt + ((size_t)(b * 2 + kvh) * 64 + d) * VT_LD + pos;
                    *(uint2*)dst = make_uint2(pack2(acc[m][n][0], acc[m][n][1]), pack2(acc[m][n][2], acc[m][n][3]));
                }
            }
        } else {
            float v[4][4][4];
            const bool do_rope = is_lat && nt <= 4;
#pragma unroll
            for (int m = 0; m < 4; ++m)
#pragma unroll
                for (int j = 0; j < 4; ++j) {
                    if (do_rope) {
                        const int r = row0 + m * 16 + fq * 4 + j, pos = r & 2047;
                        const float2 cr = WSP_rope[(pos >> 6) * 16 + fr], cc = WSP_rope[(pos & 63) * 16 + fr];
                        const float x1 = acc[m][0][j], x2 = acc[m][1][j], y1 = acc[m][2][j], y2 = acc[m][3][j];
                        v[m][0][j] = x1 * cr.x - x2 * cr.y; v[m][1][j] = x1 * cr.y + x2 * cr.x;
                        v[m][2][j] = y1 * cc.x - y2 * cc.y; v[m][3][j] = y1 * cc.y + y2 * cc.x;
                    } else {
#pragma unroll
                        for (int n = 0; n < 4; ++n) v[m][n][j] = acc[m][n][j];
                    }
                }
            u16* dbase; int ldd;
            if (nt < 4) { dbase = WSP_Q + (size_t)row0 * 512 + col0; ldd = 512; }
            else if (nt == 4) { dbase = WSP_Kb + (size_t)row0 * 128 + (col0 - 512); ldd = 128; }
            else { dbase = WSP_U + (size_t)row0 * 512 + (col0 - 768); ldd = 512; }
            wave_store_bf16(v, [&](int row) { return dbase + (size_t)row * ldd; });
        }
    }
}

__device__ __forceinline__ void attn_unit(const Params& p, int u) {
    const int h = u & 7, qb = (u >> 3) & 15, b = u >> 7, kvh = h >> 2;
    const int tid = TIDX, lane = tid & 63, wid = tid >> 6, fr = lane & 15, fq = lane >> 4;
    const int sb = lane * 16, swz = sb ^ (((sb >> 9) & 1) << 5);
    const int r_in = swz >> 6, c_in = (swz & 63) >> 1;
    const int jstart = qb == 0 ? 2 : 0, jend = qb == 15 ? 4 : 6, nb = jend - jstart, ntile = nb + 4;
    const float SC = 0.125f * 1.4426950408889634f;
    bf16x8 qf[2][2];
    const int qrow0 = b * SEQ + qb * 128 + wid * 32;
#pragma unroll
    for (int qt = 0; qt < 2; ++qt)
#pragma unroll
        for (int ks = 0; ks < 2; ++ks)
            qf[qt][ks] = *(const bf16x8*)(WSP_Q + (size_t)(qrow0 + qt * 16 + fr) * 512 + h * 64 + ks * 32 + fq * 8);
    f32x4 o[4][2];
#pragma unroll
    for (int dt = 0; dt < 4; ++dt)
#pragma unroll
        for (int qt = 0; qt < 2; ++qt) o[dt][qt] = (f32x4){0.f, 0.f, 0.f, 0.f};
    float mrun[2], lrun[2];
    const float sinkv = p.attn_sink[h] * 1.4426950408889634f;
    mrun[0] = mrun[1] = sinkv;
    lrun[0] = lrun[1] = (fq == 0) ? 1.f : 0.f;
    __syncthreads();
    const u16* kp[2]; const u16* vp[2];
    {
        const int ks0 = qb * 128 - 128 + 64 * jstart;
#pragma unroll
        for (int it = 0; it < 2; ++it) {
            const int st = wid + 4 * it, R = (st >> 1) * 16 + r_in, C = (st & 1) * 32 + c_in;
            kp[it] = WSP_Kb + (size_t)(b * SEQ + ks0 + R) * 128 + kvh * 64 + C;
            vp[it] = WSP_Vt + ((size_t)(b * 2 + kvh) * 64 + R) * VT_LD + ks0 + C;
        }
    }
    auto stage = [&](int i, int s) {
        char* sk = smem + s * 16384;
        char* sv = sk + 8192;
#pragma unroll
        for (int it = 0; it < 2; ++it) {
            glds16(kp[it], sk + tid * 16 + it * 4096);
            glds16(vp[it], sv + tid * 16 + it * 4096);
        }
        if (i + 1 == nb) {
            const int ks0 = qb * 128 - 128 + 64 * (jstart + i);
#pragma unroll
            for (int it = 0; it < 2; ++it) {
                kp[it] += (size_t)(NLAT + b * CTXL - (b * SEQ + ks0)) * 128;
                vp[it] += SEQ - ks0;
            }
        } else {
#pragma unroll
            for (int it = 0; it < 2; ++it) { kp[it] += 64 * 128; vp[it] += 64; }
        }
    };
    stage(0, 0);
    for (int i = 0; i < ntile; ++i) {
        asm volatile("s_waitcnt vmcnt(0)" ::: "memory");
        __syncthreads();
        if (i + 1 < ntile) stage(i + 1, (i + 1) & 1);
        const char* sk = smem + (i & 1) * 16384;
        const char* sv = sk + 8192;
        f32x4 s[4][2];
#pragma unroll
        for (int kt = 0; kt < 4; ++kt)
#pragma unroll
            for (int qt = 0; qt < 2; ++qt) s[kt][qt] = (f32x4){0.f, 0.f, 0.f, 0.f};
#pragma unroll
        for (int ks = 0; ks < 2; ++ks)
#pragma unroll
            for (int kt = 0; kt < 4; ++kt) {
                const bf16x8 kf = *(const bf16x8*)(sk + lds_byte(32 * (kt >> 1) + 8 * (fr >> 2) + 4 * (kt & 1) + (fr & 3), ks * 32 + fq * 8));
#pragma unroll
                for (int qt = 0; qt < 2; ++qt) s[kt][qt] = __builtin_amdgcn_mfma_f32_16x16x32_bf16(kf, qf[qt][ks], s[kt][qt], 0, 0, 0);
            }
        const int ks0 = qb * 128 - 128 + 64 * (jstart + i);
        const int qlo = qb * 128 + wid * 32;
        const bool band = (i < nb) && ((qlo + 31 - ks0 > 128) || (ks0 + 63 - qlo > 128));
        bf16x8 pf[2][2];
#pragma unroll
        for (int qt = 0; qt < 2; ++qt) {
            const int qp = qb * 128 + wid * 32 + qt * 16 + fr;
            float mx = -1e30f;
            if (band) {
#pragma unroll
                for (int kt = 0; kt < 4; ++kt)
#pragma unroll
                    for (int j = 0; j < 4; ++j) {
                        const int kp = ks0 + 32 * (kt >> 1) + 8 * fq + 4 * (kt & 1) + j, d = qp - kp;
                        const float v = (d > 128 || d < -128) ? -1e30f : s[kt][qt][j];
                        s[kt][qt][j] = v;
                        mx = fmaxf(mx, v);
                    }
                asm volatile("" ::: "memory");
            } else {
#pragma unroll
                for (int kt = 0; kt < 4; ++kt)
#pragma unroll
                    for (int j = 0; j < 4; ++j) mx = fmaxf(mx, s[kt][qt][j]);
            }
            mx = max_x32(max_x16(mx));
            const float mnew = fmaxf(mrun[qt], mx * SC);
            const float alpha = __builtin_amdgcn_exp2f(mrun[qt] - mnew);
            mrun[qt] = mnew;
            float ls = 0.f;
#pragma unroll
            for (int kt = 0; kt < 4; ++kt)
#pragma unroll
                for (int j = 0; j < 4; ++j) {
                    const float pv = __builtin_amdgcn_exp2f(fmaf(s[kt][qt][j], SC, -mnew));
                    s[kt][qt][j] = pv;
                    ls += pv;
                }
            lrun[qt] = lrun[qt] * alpha + ls;
            if (!__all(alpha == 1.f)) {
#pragma unroll
                for (int dt = 0; dt < 4; ++dt) o[dt][qt] *= alpha;
            }
#pragma unroll
            for (int k2 = 0; k2 < 2; ++k2) {
                bf16x8 t;
#pragma unroll
                for (int j = 0; j < 4; ++j) { t[j] = (short)f2bf(s[2 * k2][qt][j]); t[4 + j] = (short)f2bf(s[2 * k2 + 1][qt][j]); }
                pf[qt][k2] = t;
            }
        }
#pragma unroll
        for (int k2 = 0; k2 < 2; ++k2)
#pragma unroll
            for (int dt = 0; dt < 4; ++dt) {
                const bf16x8 vf = *(const bf16x8*)(sv + lds_byte(dt * 16 + fr, k2 * 32 + fq * 8));
#pragma unroll
                for (int qt = 0; qt < 2; ++qt) o[dt][qt] = __builtin_amdgcn_mfma_f32_16x16x32_bf16(vf, pf[qt][k2], o[dt][qt], 0, 0, 0);
            }
    }
#pragma unroll
    for (int qt = 0; qt < 2; ++qt) {
        const float l = sum_x32(sum_x16(lrun[qt]));
        const float inv = 1.f / l;
        u16* dst = WSP_AO + (size_t)(qrow0 + qt * 16 + fr) * 512 + h * 64 + fq * 4;
        float sq = 0.f;
#pragma unroll
        for (int dt = 0; dt < 4; ++dt) {
            const unsigned w0 = pack2(o[dt][qt][0] * inv, o[dt][qt][1] * inv), w1 = pack2(o[dt][qt][2] * inv, o[dt][qt][3] * inv);
            *(uint2*)(dst + dt * 16) = make_uint2(w0, w1);
            const float a = bf2f((u16)(w0 & 0xffffu)), b = bf2f((u16)(w0 >> 16)), c = bf2f((u16)(w1 & 0xffffu)), d = bf2f((u16)(w1 >> 16));
            sq += a * a + b * b + c * c + d * d;
        }
        sq = sum_x32(sum_x16(sq));
        if (fq == 0) unsafeAtomicAdd(WSP_rsq + (size_t)(qrow0 + qt * 16 + fr) * 2, sq);
    }
}

__device__ __forceinline__ void ssm_s1_unit(const Params& p, int u) {
    const int ct = u % 9, mh = (u / 9) & 1, g = u / 18;
    const int lane = TIDX & 63, wid = TIDX >> 6, wr = wid >> 1, wc = wid & 1, fr = lane & 15, fq = lane >> 4;
    const u16* A = WSP_TabS + ((size_t)g * 256 + mh * 128) * 256;
    const u16* Ub = WSP_U + (size_t)ct * 128 * 16 * 512 + g * 16;
    f32x4 acc[4][4];
    gemm_tile(4,
        [&](int R, int C, int kt) { return (const void*)(A + (size_t)R * 256 + kt * 64 + C); },
        [&](int R, int C, int kt) { return (const void*)(Ub + (size_t)(R * 16 + kt * 4 + (C >> 4)) * 512 + (C & 15)); }, acc);
#pragma unroll
    for (int m = 0; m < 4; ++m)
#pragma unroll
        for (int n = 0; n < 4; ++n) {
            const int rho = mh * 128 + wr * 64 + m * 16 + fq * 4;
            const int cg = ct * 128 + wc * 64 + n * 16 + fr;
            *(f32x4*)(WSP_S + ((size_t)cg * 32 + g) * 256 + rho) = acc[m][n];
        }
}

__device__ __forceinline__ void phase3(const Params& p) {
    for (int u = blockIdx.x; u < 1024; u += gridDim.x) attn_unit(p, u);
    int* qv = (int*)(smem + 73728);
    for (;;) {
        __syncthreads();
        if (TIDX == 0) qv[0] = (int)atomicAdd(&WSP_ctr[CTR_QS1], 1u);
        __syncthreads();
        const int u = __builtin_amdgcn_readfirstlane(qv[0]);
        if (u >= 576) break;
        ssm_s1_unit(p, u);
    }
}

__device__ __forceinline__ void phase4(const Params& p) {
    if ((int)gridDim.x > 192) {
        if ((int)blockIdx.x >= 160) { conv_range(p, blockIdx.x - 160, gridDim.x - 160, N_CONV, N_CONV_EARLY); return; }
        if ((int)blockIdx.x >= 128) { ssm_toeplitz_item(p, blockIdx.x - 128); return; }
    } else {
        for (int g = blockIdx.x; g < 32; g += gridDim.x) ssm_toeplitz_item(p, g);
        conv_range(p, blockIdx.x, gridDim.x, N_CONV, N_CONV_EARLY);
    }
    const int gid = blockIdx.x * NTHR + TIDX;
    if (gid >= BATCH * 2 * 32 * 64) return;
    const int n = gid & 63, g = (gid >> 6) & 31, dir = (gid >> 11) & 1, b = gid >> 12;
    const int pidx = dir * 32 + g;
    const float dt = __expf(p.log_dt[pidx]);
    const float are = p.a_re[pidx * 64 + n], aim = p.a_im[pidx * 64 + n];
    const float mag = __expf(16.f * dt * are);
    float rev = 16.f * (dt * aim * 0.15915494309189535f);
    rev -= rintf(rev);
    const float ar = mag * __builtin_amdgcn_cosf(rev), ai = mag * __builtin_amdgcn_sinf(rev);
    float hr = 0.f, hi = 0.f;
    const size_t so = (size_t)g * 256 + dir * 128 + n;
#pragma unroll 8
    for (int i = 0; i < 16; ++i) {
        const int c = dir == 0 ? i : 15 - i;
        const float* sp = WSP_S + (size_t)(NCHUNK_LAT + b * 16 + c) * 8192 + so;
        const float sr = sp[0], si = sp[64];
        const float nr = ar * hr - ai * hi + sr, ni = ar * hi + ai * hr + si;
        hr = nr; hi = ni;
    }
#pragma unroll 8
    for (int i = 0; i < 128; ++i) {
        const int c = dir == 0 ? i : 127 - i;
        const size_t cg = (size_t)b * 128 + c;
        const float* sp = WSP_S + cg * 8192 + so;
        const float sr = sp[0], si = sp[64];
        u16* hp = WSP_Hin + cg * 8192 + so;
        hp[0] = f2bf(hr); hp[64] = f2bf(hi);
        const float nr = ar * hr - ai * hi + sr, ni = ar * hi + ai * hr + si;
        hr = nr; hi = ni;
    }
}

__device__ __forceinline__ void phase5(const Params& p) {
    const int NU = 512;
    const int lane = TIDX & 63, wid = TIDX >> 6, wr = wid >> 1, wc = wid & 1, fr = lane & 15, fq = lane >> 4;
    for (int u = blockIdx.x; u < NU; u += gridDim.x) {
        const int ct = u & 7, mh = (u >> 3) & 1, g = u >> 4;
        const u16* A = WSP_TabY + ((size_t)g * 256 + mh * 128) * 512;
        const u16* Ub = WSP_U + (size_t)ct * 128 * 16 * 512 + g * 16;
        const u16* Hb_ = WSP_Hin + (size_t)ct * 128 * 8192 + g * 256;
        f32x4 acc[4][4];
        gemm_tile(8,
            [&](int R, int C, int kt) { return (const void*)(A + (size_t)R * 512 + kt * 64 + C); },
            [&](int R, int C, int kt) {
                return kt < 4 ? (const void*)(Ub + (size_t)(R * 16 + kt * 4 + (C >> 4)) * 512 + (C & 15))
                              : (const void*)(Hb_ + (size_t)R * 8192 + (kt - 4) * 64 + C);
            }, acc);
#pragma unroll
        for (int m = 0; m < 4; ++m)
#pragma unroll
            for (int n = 0; n < 4; ++n) {
                const int t = mh * 8 + wr * 4 + m;
                const int cg = ct * 128 + wc * 64 + n * 16 + fr;
                u16* dst = WSP_Y + ((size_t)cg * 16 + t) * 512 + g * 16 + fq * 4;
                *(uint2*)dst = make_uint2(pack2(gelu_tanh(acc[m][n][0]), gelu_tanh(acc[m][n][1])),
                                          pack2(gelu_tanh(acc[m][n][2]), gelu_tanh(acc[m][n][3])));
            }
    }
}

__device__ __forceinline__ void phase6(const Params& p) {
    const int NU = 512;
    const int lane = TIDX & 63, wid = TIDX >> 6, wr = wid >> 1, wc = wid & 1, fr = lane & 15, fq = lane >> 4;
    for (int u = blockIdx.x; u < NU; u += gridDim.x) {
        const int mt = (u & 7) + 8 * (u >> 5), nt = (u >> 3) & 3;
        const u16* A = WSP_Y + (size_t)mt * 128 * 512;
        const u16* B = WSP_WgluT + (size_t)nt * 128 * 512;
        f32x4 acc[4][4];
        gemm_tile(8,
            [&](int R, int C, int kt) { return (const void*)(A + (size_t)R * 512 + kt * 64 + C); },
            [&](int R, int C, int kt) { return (const void*)(B + (size_t)R * 512 + kt * 64 + C); }, acc);
        const int row0 = mt * 128 + wr * 64, col0 = nt * 128 + wc * 64;
        char* base = smem + wid * 9216;
        float bg[4];
#pragma unroll
        for (int n = 0; n < 4; ++n) bg[n] = p.b_glu[col0 + n * 16 + fr];
#pragma unroll
        for (int i = 0; i < 8; ++i) {
            const int id = i * 64 + lane, row = id >> 3, ch = id & 7;
            *(uint4*)(base + row * 144 + ch * 16) = *(const uint4*)(WSP_Y + (size_t)(row0 + row) * 512 + col0 + ch * 8);
        }
        asm volatile("s_waitcnt lgkmcnt(0)" ::: "memory");
        __builtin_amdgcn_wave_barrier();
#pragma unroll
        for (int m = 0; m < 4; ++m)
#pragma unroll
            for (int j = 0; j < 4; ++j) {
                const int rl = m * 16 + fq * 4 + j, r = row0 + rl;
                float sq = 0.f;
#pragma unroll
                for (int n = 0; n < 4; ++n) {
                    const int c = col0 + n * 16 + fr;
                    const float yv = bf2f(*(const u16*)(base + rl * 144 + (n * 16 + fr) * 2));
                    const u16 ob = f2bf(yv * sigmoidf_(acc[m][n][j] + bg[n]));
                    *(u16*)(base + rl * 144 + (n * 16 + fr) * 2) = ob;
                    const float of = bf2f(ob);
                    sq += of * of;
                }
                sq = sum16(sq);
                if (fr == 0) unsafeAtomicAdd(WSP_rsq + (size_t)r * 2 + 1, sq);
            }
        asm volatile("s_waitcnt lgkmcnt(0)" ::: "memory");
        __builtin_amdgcn_wave_barrier();
        u16* dbase = WSP_SO + (size_t)row0 * 512 + col0;
#pragma unroll
        for (int i = 0; i < 8; ++i) {
            const int id = i * 64 + lane, row = id >> 3, ch = id & 7;
            *(uint4*)(dbase + (size_t)row * 512 + ch * 8) = *(const uint4*)(base + row * 144 + ch * 16);
        }
        asm volatile("s_waitcnt lgkmcnt(0)" ::: "memory");
        __builtin_amdgcn_wave_barrier();
    }
}

__device__ __forceinline__ void phase8(const Params& p) {
    const int NU = 512;
    for (int u = blockIdx.x; u < NU; u += gridDim.x) {
        const int mt = (u & 7) + 8 * (u >> 5), nt = (u >> 3) & 3;
        const u16* A1 = WSP_AO + (size_t)mt * 128 * 512;
        const u16* A2 = WSP_SO + (size_t)mt * 128 * 512;
        const u16* B = WSP_WoutT + (size_t)nt * 256 * 1024;
        f32x4 acc[4][8];
        {
        const int tid1 = TIDX, fq = (tid1 & 63) >> 4, row0 = mt * 128 + (tid1 >> 7) * 64;
        gemm_tile_w(32,
            [&](int i, int R, int C, int kt) { return (const void*)((kt < 16 ? A1 : A2) + (size_t)R * 512 + (kt & 15) * 32 + C); },
            [&](int i, int R, int C, int kt) { return (const void*)(B + (size_t)R * 1024 + kt * 32 + C); }, acc,
            [&](int kt) {
                if (kt == 16) {
#pragma unroll
                    for (int m = 0; m < 4; ++m) {
                        asm volatile("" ::: "memory");
#pragma unroll
                        for (int j = 0; j < 4; ++j) {
                            const float2 q = *(const float2*)(WSP_rsq + (size_t)(row0 + m * 16 + fq * 4 + j) * 2);
                            const float ratio = rsqrtf(q.x * (1.f / 512.f) + EPS) / rsqrtf(q.y * (1.f / 512.f) + EPS);
#pragma unroll
                            for (int n = 0; n < 8; ++n) acc[m][n][j] *= ratio;
                        }
                    }
                }
            });
        }
        const int tid2 = TIDX, lane = tid2 & 63, wid = tid2 >> 6, fr = lane & 15, fq = lane >> 4;
        const int row0 = mt * 128 + (wid >> 1) * 64, col0 = nt * 256 + (wid & 1) * 128;
        const float* g1 = WSP_mod + (mt >> 4) * 6144 + 2048 + col0;
        float* stg = (float*)(smem + wid * 8448);
#pragma unroll
        for (int m = 0; m < 4; ++m) {
#pragma unroll
            for (int n = 0; n < 8; ++n)
#pragma unroll
                for (int j = 0; j < 4; ++j) stg[(fq * 4 + j) * 132 + n * 16 + fr] = acc[m][n][j];
            asm volatile("s_waitcnt lgkmcnt(0)" ::: "memory");
            __builtin_amdgcn_wave_barrier();
#pragma unroll
            for (int i = 0; i < 8; ++i) {
                const int id = i * 64 + lane, rr = id >> 5, c4 = (id & 31) * 4;
                float4 v = *(const float4*)(stg + rr * 132 + c4);
                const float rsv = rsqrtf(WSP_rsq[(size_t)(row0 + m * 16 + rr) * 2 + 1] * (1.f / 512.f) + EPS);
                v.x *= rsv; v.y *= rsv; v.z *= rsv; v.w *= rsv;
                const float4 g = *(const float4*)(g1 + c4);
                const size_t o = (size_t)(row0 + m * 16 + rr) * 1024 + col0 + c4;
                const float4 xv = *(const float4*)(p.x + o);
                *(float4*)(p.out + o) = make_float4(xv.x + g.x * v.x, xv.y + g.y * v.y, xv.z + g.z * v.z, xv.w + g.w * v.w);
            }
            asm volatile("s_waitcnt lgkmcnt(0)" ::: "memory");
            __builtin_amdgcn_wave_barrier();
        }
    }
}

#define CTR_ECNT 0
#define CTR_Q11 128
#define CTR_Q12 136
#define HALF_TOK 8192
#define HH_HALF_ROWS 73728
#define ELIST_CAP 8192
template <int LEVEL>
__device__ __forceinline__ void phase9_t(const Params& p) {
    const int tid = TIDX, lane = tid & 63, wid = tid >> 6, fr = lane & 15, fq = lane >> 4;
    char* At = smem;
    float* sc = (float*)(smem + 65536);
    int* hist = (int*)(smem + 65536 + 8192);
    int* gbase = hist + 64;
    int* fill = gbase + 64;
    unsigned char* selk = (unsigned char*)(fill + 64);
    float* selw = (float*)(selk + 256);
    for (int chunk = blockIdx.x; chunk < NLAT / 32; chunk += gridDim.x) {
        const int tok0 = chunk * 32;
        __syncthreads();
        if (tid < 64) hist[tid] = 0;
#pragma unroll 1
        for (int hb = 0; hb < 2; ++hb) {
            float4 vall[4][4];
#pragma unroll
            for (int rr = 0; rr < 4; ++rr)
#pragma unroll
                for (int i = 0; i < 4; ++i) vall[rr][i] = *(const float4*)(p.out + (size_t)(tok0 + wid * 8 + hb * 4 + rr) * 1024 + i * 256 + lane * 4);
#pragma unroll
            for (int rr = 0; rr < 4; ++rr) {
                const int row = wid * 8 + hb * 4 + rr, tok = tok0 + row;
                const float* md = WSP_mod + (tok >> 11) * 6144;
                float ss = 0.f;
#pragma unroll
                for (int i = 0; i < 4; ++i) ss += vall[rr][i].x * vall[rr][i].x + vall[rr][i].y * vall[rr][i].y + vall[rr][i].z * vall[rr][i].z + vall[rr][i].w * vall[rr][i].w;
                ss = wave_sum(ss);
                const float rs = rsqrtf(ss * (1.f / 1024.f) + EPS);
#pragma unroll
                for (int i = 0; i < 4; ++i) {
                    const int c0 = i * 256 + lane * 4;
                    const float4 v = vall[rr][i];
                    const float4 g = *(const float4*)(p.norm_ffn + c0), s = *(const float4*)(md + 3072 + c0), k = *(const float4*)(md + 4096 + c0);
                    const float a = v.x * rs * g.x * (1.f + k.x) + s.x, b = v.y * rs * g.y * (1.f + k.y) + s.y;
                    const float c = v.z * rs * g.z * (1.f + k.z) + s.z, d = v.w * rs * g.w * (1.f + k.w) + s.w;
                    const uint2 pk = make_uint2(pack2(a, b), pack2(c, d));
                    *(uint2*)(WSP_H2 + (size_t)tok * 1024 + c0) = pk;
                    const int ch = c0 >> 3;
                    *(uint2*)(At + row * 2048 + ((ch ^ (row & 15)) << 4) + ((c0 & 4) << 1)) = pk;
                }
            }
        }
        __syncthreads();
        if (LEVEL == 1) continue;
        {
            f32x4 acc0 = {0.f, 0.f, 0.f, 0.f}, acc1 = {0.f, 0.f, 0.f, 0.f};
            const u16* bp = WSP_WrT + (size_t)(wid * 16 + fr) * 1024 + fq * 8;
#pragma unroll
            for (int kb = 0; kb < 4; ++kb) {
                bf16x8 bfr[8];
#pragma unroll
                for (int q = 0; q < 8; ++q) bfr[q] = *(const bf16x8*)(bp + (kb * 8 + q) * 32);
#pragma unroll
                for (int q = 0; q < 8; ++q) {
                    const int ch = (kb * 8 + q) * 4 + fq;
                    const bf16x8 a0 = *(const bf16x8*)(At + fr * 2048 + ((ch ^ fr) << 4));
                    const bf16x8 a1 = *(const bf16x8*)(At + (16 + fr) * 2048 + ((ch ^ fr) << 4));
                    acc0 = __builtin_amdgcn_mfma_f32_16x16x32_bf16(a0, bfr[q], acc0, 0, 0, 0);
                    acc1 = __builtin_amdgcn_mfma_f32_16x16x32_bf16(a1, bfr[q], acc1, 0, 0, 0);
                }
            }
#pragma unroll
            for (int j = 0; j < 4; ++j) {
                sc[(fq * 4 + j) * 64 + wid * 16 + fr] = sigmoidf_(acc0[j]);
                sc[(16 + fq * 4 + j) * 64 + wid * 16 + fr] = sigmoidf_(acc1[j]);
            }
        }
        __syncthreads();
        if (LEVEL == 2) continue;
        const float bias = p.router_bias[lane];
        const int eg = lane >> 3;
#pragma unroll 2
        for (int rr = 0; rr < 8; ++rr) {
            const int row = wid * 8 + rr;
            const float s = sc[row * 64 + lane];
            const float bz = s + bias;
            const float m1 = max8(bz);
            const unsigned long long eq = __ballot(bz == m1);
            const unsigned gb = (unsigned)((eq >> (eg * 8)) & 0xffull);
            const int first = __ffs(gb) - 1;
            const float v2 = max8(((lane & 7) == first) ? -1e30f : bz);
            const float gs = m1 + v2;
            int cnt = 0;
#pragma unroll
            for (int j = 0; j < 8; ++j) {
                const float gj = __int_as_float(__builtin_amdgcn_readlane(__float_as_int(gs), j * 8));
                cnt += (gj > gs || (gj == gs && j < eg)) ? 1 : 0;
            }
            const bool gsel = cnt < 4;
            const float mv = gsel ? bz : -1e30f;
            unsigned long long gm = __ballot(gsel);
            int rank = 0;
#pragma unroll 1
            for (int it = 0; it < 4; ++it) {
                const int jb = __builtin_amdgcn_readfirstlane(__ffsll((long long)gm) - 1);
                gm &= ~(0xffull << jb);
#pragma unroll
                for (int j = 0; j < 8; ++j) {
                    const float vj = __int_as_float(__builtin_amdgcn_readlane(__float_as_int(mv), jb + j));
                    rank += (vj > mv || (vj == mv && (jb + j) < lane)) ? 1 : 0;
                }
            }
            const bool sel = gsel && rank < 8;
            unsigned long long sm = __ballot(sel);
            float tot = 0.f;
#pragma unroll 1
            for (int it = 0; it < 8; ++it) {
                const int l = __builtin_amdgcn_readfirstlane(__ffsll((long long)sm) - 1);
                sm &= sm - 1;
                tot += __int_as_float(__builtin_amdgcn_readlane(__float_as_int(s), l));
            }
            if (sel) {
                selw[row * 8 + rank] = s / tot * 2.5f;
                selk[row * 8 + rank] = (unsigned char)lane;
                atomicAdd(&hist[lane], 1);
            }
        }
        __syncthreads();
        const int h = tok0 >> 13;
        if (tid < 64) {
            gbase[tid] = hist[tid] ? (int)atomicAdd(&WSP_ctr[CTR_ECNT + h * 64 + tid], (unsigned)hist[tid]) : 0;
            fill[tid] = 0;
        }
        __syncthreads();
        {
            const int e = selk[tid];
            const int pos = atomicAdd(&fill[e], 1);
            WSP_elist[(size_t)(h * 64 + e) * ELIST_CAP + gbase[e] + pos] = (tok0 + (tid >> 3)) * 8 + (tid & 7);
            WSP_wsl[(size_t)(h * 64 + e) * ELIST_CAP + gbase[e] + pos] = selw[tid];
        }
    }
}

struct MoeTab { int cnt[16]; int soff[16]; int pre[17]; };

template <class FV, class FD>
__device__ __forceinline__ void wave_store_fp8_f(FV val, FD dst) {
    const int lane = TIDX & 63, wid = TIDX >> 6, fr = lane & 15, fq = lane >> 4;
    char* base = smem + wid * 9216;
#pragma unroll
    for (int m = 0; m < 4; ++m)
#pragma unroll
        for (int j = 0; j < 4; ++j) {
            int lo = __builtin_amdgcn_cvt_pk_fp8_f32(val(m, 0, j), val(m, 1, j), 0, false);
            lo = __builtin_amdgcn_cvt_pk_fp8_f32(val(m, 2, j), val(m, 3, j), lo, true);
            int hi = __builtin_amdgcn_cvt_pk_fp8_f32(val(m, 4, j), val(m, 5, j), 0, false);
            hi = __builtin_amdgcn_cvt_pk_fp8_f32(val(m, 6, j), val(m, 7, j), hi, true);
            *(uint2*)(base + (m * 16 + fq * 4 + j) * 144 + fr * 8) = make_uint2((unsigned)lo, (unsigned)hi);
        }
    asm volatile("s_waitcnt lgkmcnt(0)" ::: "memory");
    __builtin_amdgcn_wave_barrier();
#pragma unroll
    for (int i = 0; i < 8; ++i) {
        const int id = i * 64 + lane, row = id >> 3, ch = id & 7;
        const uint4 d = *(const uint4*)(base + row * 144 + ch * 16);
        unsigned char* q = dst(i, row);
        if (q) { const u32x4 t = {d.x, d.y, d.z, d.w}; __builtin_nontemporal_store(t, (u32x4*)(q + ch * 16)); }
    }
    asm volatile("s_waitcnt lgkmcnt(0)" ::: "memory");
    __builtin_amdgcn_wave_barrier();
}

#define YD_SCALE 8.0f
template <int MODE>
__device__ __forceinline__ void phase11f(const Params& p) {
    const int tid = TIDX;
    int* tab = (int*)(smem + 73728);
    int* t_cnt = tab, *t_soff = tab + 16, *t_pre = tab + 32, *t_q = tab + 52;
    int* t_all = tab + 64;
    const int x = blockIdx.x & 7;
    unsigned* flags = WSP_flag + x * FLAG_PER_CLASS;
    unsigned* tmo = WSP_flag + 8 * FLAG_PER_CLASS;
    unsigned char* Yd8 = (unsigned char*)(p.ws + OFF_ARENA);
    __syncthreads();
    if (tid < 128) t_all[tid] = (int)WSP_ctr[CTR_ECNT + tid];
    unsigned* qhead = &WSP_ctr[(MODE == 2 ? CTR_Q12 : CTR_Q11) + x];
    if (tid == 0) t_q[0] = (int)atomicAdd(qhead, 1u);
    __syncthreads();
    if (tid < 16) {
        const int i = tid >> 1, h = tid & 1, e = x + 8 * i;
        t_cnt[tid] = t_all[h * 64 + e];
        int so = 0;
        for (int e2 = 0; e2 < e; ++e2) so += t_all[h * 64 + e2];
        t_soff[tid] = so;
    }
    __syncthreads();
    if (tid == 0) {
        int s = 0;
        for (int j = 0; j < 16; ++j) { t_pre[j] = s; s += (t_cnt[j] + 127) >> 7; }
        t_pre[16] = s;
    }
    __syncthreads();
    const int T_r = t_pre[16], T11 = T_r + 16, T_all = (MODE == 1) ? T11 : T11 + T_r * 4;
    for (;;) {
        __syncthreads();
        const int q = __builtin_amdgcn_readfirstlane(t_q[0]) + (MODE == 2 ? T11 : 0);
        __syncthreads();
        if (q >= T_all) break;
        if (tid == 0) t_q[0] = (int)atomicAdd(qhead, 1u);
        const bool is_down = q >= T11;
        const int u = is_down ? (q - T11) >> 2 : q;
        int nt = is_down ? (q - T11) & 3 : 0;
        int e, h, mt, c, rowbase;
        if (u < T_r) {
            int j = 0;
#pragma unroll
            for (int qq = 1; qq < 16; ++qq) j += (u >= t_pre[qq]) ? 1 : 0;
            e = x + 8 * (j >> 1); h = j & 1; mt = u - t_pre[j]; c = t_cnt[j];
            rowbase = h * HH_HALF_ROWS + t_soff[j];
        } else {
            const int ms = x * 16 + (u - T_r);
            e = 64; h = ms >> 6; mt = ms & 63; c = HALF_TOK;
            rowbase = h * HH_HALF_ROWS + 65536;
        }
        e = __builtin_amdgcn_readfirstlane(e); h = __builtin_amdgcn_readfirstlane(h); mt = __builtin_amdgcn_readfirstlane(mt);
        nt = __builtin_amdgcn_readfirstlane(nt); c = __builtin_amdgcn_readfirstlane(c); rowbase = __builtin_amdgcn_readfirstlane(rowbase);
        const int* el = WSP_elist + (size_t)(h * 64 + (e & 63)) * ELIST_CAP;
        if (!is_down) {
            const int t2 = TIDX, lane = t2 & 63, wid = t2 >> 6, wr = wid >> 1, wc = wid & 1, fr = lane & 15, fq = lane >> 4;
            const int sb = lane * 16, swz = sb ^ (((sb >> 9) & 1) << 5);
            const int r_in = swz >> 6, c_in = (swz & 63) >> 1;
            const int vrows = c - mt * 128 - wr * 64;
            const float* wsl = WSP_wsl + (size_t)(h * 64 + (e & 63)) * ELIST_CAP;
            const u16* aptr[2];
#pragma unroll
            for (int i = 0; i < 2; ++i) {
                int li = mt * 128 + (wid + 4 * i) * 16 + r_in;
                li = li < c ? li : c - 1;
                const int tok = (e < 64) ? (el[li] >> 3) : (h * HALF_TOK + li);
                aptr[i] = WSP_H2 + (size_t)tok * 1024 + c_in;
            }
            const u16* Bw = WSP_WguT + (size_t)e * 262144 + c_in;
            f32x4 acc[4][8];
            gemm_tile_w(32,
                [&](int i, int R, int C, int kt) { return (const void*)(aptr[i] + kt * 32); },
                [&](int i, int R, int C, int kt) {
                    const int f = (R >> 7) * 64 + (R & 15) * 4 + ((R >> 5) & 3), gu = (R >> 4) & 1;
                    return (const void*)(Bw + (size_t)((f >> 4) * 32 + gu * 16 + (f & 15)) * 1024 + kt * 32); }, acc);
            float wgt[4][4];
#pragma unroll
            for (int m = 0; m < 4; ++m)
#pragma unroll
                for (int j = 0; j < 4; ++j) {
                    const int li = mt * 128 + wr * 64 + m * 16 + fq * 4 + j;
                    float w = 1.f;
                    if (e < 64) w = (li < c) ? wsl[li] : 0.f;
                    wgt[m][j] = w;
                }
            u16* dbase = WSP_HHs + ((size_t)rowbase + mt * 128 + wr * 64) * 128 + wc * 64;
            wave_store_bf16_pk([&](int m, int n2, int j) { return siluf_(acc[m][2 * n2][j]) * acc[m][2 * n2 + 1][j] * wgt[m][j]; },
                               [&](int row) { return row < vrows ? dbase + (size_t)row * 128 : (u16*)nullptr; }, (const char*)WSP_HHs, (unsigned)((size_t)2 * HH_HALF_ROWS * 128 * 2));
            asm volatile("s_waitcnt vmcnt(0)" ::: "memory");
            __syncthreads();
            if (tid == 0) __hip_atomic_store(&flags[u], 1u, __ATOMIC_RELAXED, __HIP_MEMORY_SCOPE_AGENT);
        } else {
            const int t2 = TIDX, lane = t2 & 63, wid = t2 >> 6, wr = wid >> 1, wc = wid & 1, fr = lane & 15, fq = lane >> 4;
            const int sb = lane * 16, swz = sb ^ (((sb >> 9) & 1) << 5);
            const int r_in = swz >> 6, c_in = (swz & 63) >> 1;
            const int vrows = c - mt * 128 - wr * 64;
            if (MODE == 0 && tid == 0) {
                unsigned sp = 0;
                while (__hip_atomic_load(&flags[u], __ATOMIC_RELAXED, __HIP_MEMORY_SCOPE_AGENT) == 0u) {
                    __builtin_amdgcn_s_sleep(2);
                    if ((++sp & 255u) == 0u) {
                        if (__hip_atomic_load(tmo, __ATOMIC_RELAXED, __HIP_MEMORY_SCOPE_AGENT)) break;
                        if (sp > (1u << 20)) { atomicAdd(tmo, 1u); break; }
                    }
                }
            }
            __syncthreads();
            const u16* aptr[2];
#pragma unroll
            for (int i = 0; i < 2; ++i) {
                int li = mt * 128 + (wid + 4 * i) * 16 + r_in;
                li = li < c ? li : c - 1;
                aptr[i] = WSP_HHs + ((size_t)rowbase + li) * 128 + c_in;
            }
            const u16* Bw = WSP_WdT + ((size_t)e * 1024 + nt * 256) * 128 + c_in;
            int slot[8];
            if (e < 64) {
#pragma unroll
                for (int i = 0; i < 8; ++i) {
                    int li = mt * 128 + wr * 64 + ((i * 64 + lane) >> 3);
                    li = li < c ? li : c - 1;
                    slot[i] = el[li];
                }
            } else {
#pragma unroll
                for (int i = 0; i < 8; ++i) slot[i] = (h * HALF_TOK + mt * 128 + wr * 64 + ((i * 64 + lane) >> 3)) * 8;
            }
            f32x4 acc[4][8];
            gemm_tile_w<true>(4,
                [&](int i, int R, int C, int kt) { return (const void*)(aptr[i] + kt * 32); },
                [&](int i, int R, int C, int kt) { return (const void*)(Bw + (size_t)((R & 128) | ((R & 15) << 3) | ((R >> 4) & 7)) * 128 + kt * 32); }, acc);
            const int colo = nt * 256 + wc * 128;
            if (e < 64) {
                wave_store_fp8_f([&](int m, int n, int j) { return acc[m][n][j] * YD_SCALE; }, [&](int i, int row) {
                    if (row >= vrows) return (unsigned char*)nullptr;
                    const int s = slot[i];
                    return Yd8 + ((size_t)(s >> 3) * 8 + (s & 7)) * 1024 + colo;
                });
            } else {
                const int tok0 = h * HALF_TOK + mt * 128 + wr * 64;
                const float* g2 = WSP_mod + (tok0 >> 11) * 6144 + 5120 + colo;
                float* stg = (float*)(smem + wid * 8448);
#pragma unroll
                for (int m = 0; m < 4; ++m) {
#pragma unroll
                    for (int n = 0; n < 8; ++n)
#pragma unroll
                        for (int j = 0; j < 4; ++j) stg[(fq * 4 + j) * 132 + n * 16 + fr] = acc[m][n][j];
                    asm volatile("s_waitcnt lgkmcnt(0)" ::: "memory");
                    __builtin_amdgcn_wave_barrier();
#pragma unroll
                    for (int i = 0; i < 8; ++i) {
                        const int id = i * 64 + lane, rr = id >> 5, c4 = (id & 31) * 4;
                        const float4 v = *(const float4*)(stg + rr * 132 + c4);
                        const float4 g = *(const float4*)(g2 + c4);
                        float* op = p.out + (size_t)(tok0 + m * 16 + rr) * 1024 + colo + c4;
                        const float4 xv = *(const float4*)op;
                        *(float4*)op = make_float4(xv.x + g.x * v.x, xv.y + g.y * v.y, xv.z + g.z * v.z, xv.w + g.w * v.w);
                    }
                    asm volatile("s_waitcnt lgkmcnt(0)" ::: "memory");
                    __builtin_amdgcn_wave_barrier();
                }
            }
        }
    }
}

#define P12_SLD 2064
template <bool DUMMY>
__device__ __forceinline__ void phase12b_t(const Params& p) {
    const int tid = TIDX, lane = tid & 63, wid = tid >> 6, fr = lane & 15, fq = lane >> 4;
    const unsigned char* Yd8 = (const unsigned char*)(p.ws + OFF_ARENA);
    const u16* Wb = WSP_WdT + (size_t)64 * 131072 + (size_t)(wid * 256 + fr) * 128 + fq * 8;
    for (int tile = blockIdx.x; tile < NLAT / 32; tile += gridDim.x) {
        const int tok0 = tile * 32;
        const int hh = tok0 >> 13;
        const u16* Ab = WSP_HHs + ((size_t)hh * HH_HALF_ROWS + 65536 + (tok0 & 8191) + fr) * 128 + fq * 8;
        __syncthreads();
        bf16x8 af[2][4];
#pragma unroll
        for (int m = 0; m < 2; ++m)
#pragma unroll
            for (int ks = 0; ks < 4; ++ks) af[m][ks] = *(const bf16x8*)(Ab + (size_t)m * 16 * 128 + ks * 32);
#pragma unroll 1
        for (int nb = 0; nb < 4; ++nb) {
            bf16x8 bfr[4][4];
#pragma unroll
            for (int n = 0; n < 4; ++n)
#pragma unroll
                for (int ks = 0; ks < 4; ++ks) bfr[n][ks] = *(const bf16x8*)(WSP_WdT + (size_t)64 * 131072 + (size_t)(wid * 256 + nb * 64 + fr * 4 + n) * 128 + fq * 8 + ks * 32);
#pragma unroll
            for (int m = 0; m < 2; ++m) {
                f32x4 d[4];
#pragma unroll
                for (int n = 0; n < 4; ++n) {
                    d[n] = (f32x4){0.f, 0.f, 0.f, 0.f};
#pragma unroll
                    for (int ks = 0; ks < 4; ++ks) d[n] = __builtin_amdgcn_mfma_f32_16x16x32_bf16(af[m][ks], bfr[n][ks], d[n], 0, 0, 0);
                }
                const int col = wid * 256 + nb * 64 + fr * 4;
#pragma unroll
                for (int j = 0; j < 4; ++j)
                    *(uint2*)(smem + (m * 16 + fq * 4 + j) * P12_SLD + col * 2) = make_uint2(pack2(d[0][j], d[1][j]), pack2(d[2][j], d[3][j]));
            }
        }
        __syncthreads();
        for (int rr = 0; rr < 8; ++rr) {
            const int row = wid * 8 + rr, tok = tok0 + row;
            float* xrow = p.out + (size_t)tok * 1024 + lane * 16;
            float* orow = DUMMY ? (float*)(p.ws + OFF_HHS) + (size_t)(tok & 8191) * 1024 + lane * 16 : xrow;
            const float* g2 = WSP_mod + (tok >> 11) * 6144 + 5120 + lane * 16;
            float s[16];
#pragma unroll
            for (int i = 0; i < 16; ++i) s[i] = 0.f;
            const unsigned char* yp = Yd8 + (size_t)tok * 8 * 1024 + lane * 16;
            uint4 yv[8];
#pragma unroll
            for (int k = 0; k < 8; ++k) { const u32x4 t = __builtin_nontemporal_load((const u32x4*)(yp + k * 1024)); yv[k] = make_uint4(t[0], t[1], t[2], t[3]); }
#pragma unroll
            for (int k = 0; k < 8; ++k) {
                const unsigned w[4] = {yv[k].x, yv[k].y, yv[k].z, yv[k].w};
#pragma unroll
                for (int i = 0; i < 4; ++i) {
                    const auto lo = __builtin_amdgcn_cvt_pk_f32_fp8((int)w[i], false);
                    const auto hi = __builtin_amdgcn_cvt_pk_f32_fp8((int)w[i], true);
                    s[4 * i] += lo[0]; s[4 * i + 1] += lo[1]; s[4 * i + 2] += hi[0]; s[4 * i + 3] += hi[1];
                }
            }
            const uint4 sa = *(const uint4*)(smem + row * P12_SLD + lane * 32), sbv = *(const uint4*)(smem + row * P12_SLD + lane * 32 + 16);
            const unsigned sw[8] = {sa.x, sa.y, sa.z, sa.w, sbv.x, sbv.y, sbv.z, sbv.w};
#pragma unroll
            for (int i = 0; i < 8; ++i) {
                s[2 * i] = s[2 * i] * (1.f / YD_SCALE) + bf2f((u16)(sw[i] & 0xffffu));
                s[2 * i + 1] = s[2 * i + 1] * (1.f / YD_SCALE) + bf2f((u16)(sw[i] >> 16));
            }
            float ss = 0.f;
#pragma unroll
            for (int q = 0; q < 4; ++q) {
                const float4 xv = *(const float4*)(xrow + q * 4), gv = *(const float4*)(g2 + q * 4);
                s[4 * q] = xv.x + gv.x * s[4 * q]; s[4 * q + 1] = xv.y + gv.y * s[4 * q + 1];
                s[4 * q + 2] = xv.z + gv.z * s[4 * q + 2]; s[4 * q + 3] = xv.w + gv.w * s[4 * q + 3];
                ss += s[4 * q] * s[4 * q] + s[4 * q + 1] * s[4 * q + 1] + s[4 * q + 2] * s[4 * q + 2] + s[4 * q + 3] * s[4 * q + 3];
            }
            ss = wave_sum(ss);
            const float rs = rsqrtf(ss * (1.f / 1024.f) + EPS);
#pragma unroll
            for (int q = 0; q < 4; ++q) {
                const float4 g = *(const float4*)(p.norm_final + lane * 16 + q * 4);
                *(float4*)(orow + q * 4) = make_float4(s[4 * q] * rs * g.x, s[4 * q + 1] * rs * g.y, s[4 * q + 2] * rs * g.z, s[4 * q + 3] * rs * g.w);
            }
        }
    }
}

#define SMEM_TOTAL (73728 + 3072 + 64)

#if 1
__global__ void __launch_bounds__(NTHR, 2) k_mega(Params p) {
    volatile LAS unsigned* st = (volatile LAS unsigned*)(smem + SMEM_TOTAL - 16);
    if (TIDX == 0) { st[0] = 0u; st[1] = 0u; st[2] = 0u; st[3] = 0u; }
    __syncthreads();
    XcdBarrier bar = xcd_barrier_post(WSP_bar, st);
#define RUNP(N) do { phase##N(p); if (PROBE_DUP == N) phase##N(p); } while (0)
    RUNP(0);  xcd_barrier(bar);
    RUNP(1);  xcd_barrier(bar);
    RUNP(2);  xcd_barrier(bar);
    RUNP(3);  xcd_barrier(bar);
    RUNP(4);  xcd_barrier(bar);
    RUNP(5);  xcd_barrier(bar);
    RUNP(6);  xcd_barrier(bar);
    RUNP(8);  xcd_barrier(bar);
#if PROBE_DUP == 91
    phase9_t<1>(p); xcd_barrier(bar);
#endif
#if PROBE_DUP == 92
    phase9_t<2>(p); xcd_barrier(bar);
#endif
    phase9_t<0>(p); xcd_barrier(bar);
#if PROBE_DUP == 9
    if (blockIdx.x == 0 && TIDX < 128) WSP_ctr[CTR_ECNT + TIDX] = 0u;
    xcd_barrier(bar); phase9_t<0>(p); xcd_barrier(bar);
#endif
#ifndef MOE_FUSED
#define MOE_FUSED 1
#endif
#if MOE_FUSED
    phase11f<0>(p); xcd_barrier(bar);
#else
    phase11f<1>(p); xcd_barrier(bar);
    phase11f<2>(p); xcd_barrier(bar);
#endif
#if PROBE_DUP == 11
    if (blockIdx.x == 0 && TIDX < 8) WSP_ctr[CTR_Q11 + TIDX] = 0u;
    if (blockIdx.x == 1) for (int i = TIDX; i < 8 * FLAG_PER_CLASS; i += NTHR) WSP_flag[i] = 0u;
    xcd_barrier(bar); phase11f<0>(p); xcd_barrier(bar);
#endif
#if PROBE_DUP == 121
    phase12b_t<true>(p); xcd_barrier(bar);
#endif
    phase12b_t<false>(p);
}
#endif


extern "C" void kernel_launch(void* const* d_in, const int* in_sizes, int n_in,
                              void* d_out, int out_size, void* d_ws, size_t ws_size,
                              hipStream_t stream) {
    Params p{};
    const float** ip = (const float**)&p.x;
    for (int i = 0; i < 32; ++i) ip[i] = (const float*)d_in[i];
    p.out = (float*)d_out;
    p.ws = (char*)d_ws;
    if (OFF_END > ws_size) { fprintf(stderr, "workspace too small: need %zu have %zu\n", (size_t)OFF_END, ws_size); return; }

    static int grid = 0;
    if (!grid) {
        hipFuncSetAttribute((const void*)k_mega, hipFuncAttributeMaxDynamicSharedMemorySize, SMEM_TOTAL);
        int dev = 0, cus = 0, per_cu = 0;
        hipGetDevice(&dev);
        hipDeviceGetAttribute(&cus, hipDeviceAttributeMultiprocessorCount, dev);
        hipOccupancyMaxActiveBlocksPerMultiprocessor(&per_cu, (const void*)k_mega, NTHR, SMEM_TOTAL);
        if (per_cu < 1) per_cu = 1;
        grid = cus * (per_cu < 2 ? per_cu : 2);
    }
    hipMemsetAsync(p.ws + OFF_BAR, 0, ZERO_BYTES, stream);
    k_mega<<<grid, NTHR, SMEM_TOTAL, stream>>>(p);
}
```

```cpp
#include <hip/hip_runtime.h>
#include <hip/hip_bf16.h>
#include <stdint.h>
#include <stdio.h>

#ifndef MK_MULTI
#define MK_MULTI 0
#endif

typedef __attribute__((ext_vector_type(8))) short bf16x8;
typedef __attribute__((ext_vector_type(4))) short bf16x4;
typedef __attribute__((ext_vector_type(4))) float f32x4;
typedef unsigned short u16;
typedef __attribute__((ext_vector_type(4))) unsigned u32x4;

#ifndef PROBE_DUP
#define PROBE_DUP -1
#endif
#define NTHR 256
__device__ __forceinline__ int opaque_tid() { int t = (int)threadIdx.x; asm volatile("" : "+v"(t)); return t; }
#define TIDX opaque_tid()
#define LDS_BYTES 65536

#define D_MODEL 1024
#define BATCH 8
#define SEQ 2048
#define CTXL 256
#define NLAT (BATCH * SEQ)
#define NCTX (BATCH * CTXL)
#define NROWS (NLAT + NCTX)
#define INW 1280
#define NEXP 64
#define VT_LD (SEQ + CTXL)
#define NCHUNK_LAT 1024
#define NCHUNK_ALL 1152
#define EPS 1e-6f

#define XB_TMO      128
#define XB_XCNT(j)  (256  + 64 * (j))
#define XB_XSUB(j)  (1280 + 64 * (j))
#define XB_XGEN(j)  (2304 + 64 * (j))
#define XB_TOP      3328
#define XB_TOPGEN   3392
#define XCD_BAR_WORDS 3456
#define XB_SPIN_CAP (1u << 20)
#define LAS __attribute__((address_space(3)))

__device__ __forceinline__ unsigned xb_ld(unsigned* p)              { return __hip_atomic_load(p, __ATOMIC_RELAXED, __HIP_MEMORY_SCOPE_AGENT); }
__device__ __forceinline__ unsigned xb_add(unsigned* p, unsigned v) { return __hip_atomic_fetch_add(p, v, __ATOMIC_RELAXED, __HIP_MEMORY_SCOPE_AGENT); }
__device__ __forceinline__ unsigned xb_xcc_id() { return (unsigned)__builtin_amdgcn_s_getreg((3 << 11) | 20) & 0xFu; }
#define XB_SPIN(cond, bar) do { unsigned _sp = 0; while (cond) { __builtin_amdgcn_s_sleep(1); \
    if ((++_sp & 255u) == 0u) { if (xb_ld(&(bar)[XB_TMO])) break; if (_sp > XB_SPIN_CAP) { atomicAdd(&(bar)[XB_TMO], 1u); break; } } } } while (0)

struct XcdBarrier { unsigned* bar; unsigned x; volatile LAS unsigned* st; };

__device__ __forceinline__ XcdBarrier xcd_barrier_post(unsigned* bar, volatile LAS unsigned* st) {
    XcdBarrier b; b.bar = bar; b.x = xb_xcc_id(); b.st = st;
    if (TIDX == 0) (void)xb_add(&bar[XB_XCNT(b.x)], 1u);
    return b;
}
__device__ __forceinline__ void xcd_barrier_complete(unsigned* bar, unsigned x, unsigned& nloc, unsigned& nx) {
    const unsigned G = gridDim.x * gridDim.y * gridDim.z;
    unsigned sum, cnt, mine, sp = 0u;
    for (;;) {
        sum = 0u; cnt = 0u; mine = 0u;
#pragma unroll
        for (unsigned j = 0; j < 16; ++j) { const unsigned c = xb_ld(&bar[XB_XCNT(j)]); sum += c; cnt += (c > 0u) ? 1u : 0u; mine = (j == x) ? c : mine; }
        if (sum == G) break;
        __builtin_amdgcn_s_sleep(1);
        if ((++sp & 255u) == 0u) { if (xb_ld(&bar[XB_TMO])) break; if (sp > XB_SPIN_CAP) { atomicAdd(&bar[XB_TMO], 1u); break; } }
    }
    nloc = mine > 0u ? mine : 1u; nx = cnt > 0u ? cnt : 1u;
}
__device__ __forceinline__ void xcd_barrier(const XcdBarrier& b) {
    asm volatile("s_waitcnt vmcnt(0)" ::: "memory");
    __syncthreads();
    if (TIDX == 0) {
        unsigned* bar = b.bar;
        __builtin_amdgcn_s_waitcnt(0);
        unsigned nloc = b.st[0], nx = b.st[1];
        if (nloc == 0u) { xcd_barrier_complete(bar, b.x, nloc, nx); b.st[0] = nloc; b.st[1] = nx; }
        const unsigned old = xb_add(&bar[XB_XSUB(b.x)], 1u);
        const unsigned gen = old / nloc;
        if (old + 1u == (gen + 1u) * nloc) {
            __builtin_amdgcn_fence(__ATOMIC_RELEASE, "agent");
            asm volatile("s_waitcnt vmcnt(0)" ::: "memory");
            const unsigned og = xb_add(&bar[XB_TOP], 1u);
            const unsigned tg = og / nx;
            if (og + 1u == (tg + 1u) * nx) xb_add(&bar[XB_TOPGEN], 1u);
            else XB_SPIN(xb_ld(&bar[XB_TOPGEN]) == tg, bar);
            __builtin_amdgcn_fence(__ATOMIC_ACQUIRE, "agent");
            xb_add(&bar[XB_XGEN(b.x)], 1u);
            asm volatile("s_waitcnt vmcnt(0)" ::: "memory");
        } else {
            XB_SPIN(xb_ld(&bar[XB_XGEN(b.x)]) == gen, bar);
            __builtin_amdgcn_fence(__ATOMIC_ACQUIRE, "agent");
            asm volatile("s_waitcnt vmcnt(0)" ::: "memory");
        }
    }
    __syncthreads();
}

struct Params {
    const float *x, *c, *ctx, *c_ctx, *w_ada, *b_ada, *norm_mix, *norm_ffn, *w_in, *attn_sink,
        *a_re, *a_im, *log_dt, *b_re, *b_im, *c_re, *c_im, *ssm_d, *w_glu, *b_glu, *norm_attn_out, *norm_ssm_out,
        *w_out, *w_router, *router_bias, *w_gate_e, *w_up_e, *w_down_e, *w_gate_s, *w_up_s, *w_down_s, *norm_final;
    float* out;
    char* ws;
};

constexpr size_t A256(size_t v) { return (v + 255) & ~(size_t)255; }
constexpr size_t OFF_BAR   = 0;
constexpr size_t OFF_RSQ   = A256(OFF_BAR + XCD_BAR_WORDS * 4 + 1024);
#define FLAG_PER_CLASS 1280
constexpr size_t OFF_FLAG  = OFF_RSQ + (size_t)NLAT * 2 * 4;
constexpr size_t ZERO_BYTES = OFF_FLAG + (8 * FLAG_PER_CLASS + 64) * 4;
constexpr size_t OFF_MOD   = A256(ZERO_BYTES);
constexpr size_t OFF_ROPE  = A256(OFF_MOD + 9 * 6144 * 4);
constexpr size_t OFF_KBUF  = A256(OFF_ROPE + 64 * 16 * 8);
constexpr size_t OFF_ELIST = A256(OFF_KBUF + (size_t)32 * 2 * 4096 * 4);
constexpr size_t OFF_WSL   = A256(OFF_ELIST + (size_t)2 * 64 * 8192 * 4);
constexpr size_t OFF_WDT   = A256(OFF_WSL + (size_t)2 * 64 * 8192 * 4);
constexpr size_t OFF_HHS   = A256(OFF_WDT + (size_t)65 * 1024 * 128 * 2);
constexpr size_t OFF_WGUT  = A256(OFF_HHS + (size_t)2 * 73728 * 128 * 2);
constexpr size_t OFF_H2R   = A256(OFF_WGUT + (size_t)65 * 256 * 1024 * 2);
constexpr size_t OFF_ARENA = A256(OFF_H2R + (size_t)NLAT * 1024 * 2);
constexpr size_t OFF_TABS  = OFF_ARENA;
constexpr size_t OFF_TABY  = A256(OFF_TABS + (size_t)32 * 256 * 256 * 2);
constexpr size_t OFF_R1    = A256(OFF_TABY + (size_t)32 * 256 * 512 * 2);
constexpr size_t OFF_R2    = A256(OFF_R1 + (size_t)NROWS * 1024 * 2);
constexpr size_t OFF_R4    = A256(OFF_R2 + (size_t)NLAT * 1024 * 2);
constexpr size_t OFF_WINT  = A256(OFF_R4 + (size_t)NLAT * 512 * 2 * 2);
constexpr size_t OFF_WGLUT = A256(OFF_WINT + (size_t)1280 * 1024 * 2);
constexpr size_t OFF_WOUTT = A256(OFF_WGLUT + (size_t)512 * 512 * 2);
constexpr size_t OFF_WRT   = A256(OFF_WOUTT + (size_t)1024 * 1024 * 2);
constexpr size_t OFF_EARLY_END = A256(OFF_WRT + (size_t)128 * 1024 * 2);
constexpr size_t YD8_BYTES = (size_t)NLAT * 8 * 1024;
constexpr size_t OFF_END   = (OFF_EARLY_END > OFF_ARENA + YD8_BYTES) ? OFF_EARLY_END : A256(OFF_ARENA + YD8_BYTES);
static_assert(OFF_END <= (size_t)256 * 1024 * 1024, "workspace map must fit the guaranteed 256 MiB");
#define CTR_QS1 160
#define WSP_bar   ((unsigned*)(p.ws + OFF_BAR))
#define WSP_ctr   ((unsigned*)(p.ws + OFF_BAR) + XCD_BAR_WORDS)
#define WSP_rsq   ((float*)(p.ws + OFF_RSQ))
#define WSP_flag  ((unsigned*)(p.ws + OFF_FLAG))
#define WSP_mod   ((float*)(p.ws + OFF_MOD))
#define WSP_rope  ((float2*)(p.ws + OFF_ROPE))
#define WSP_Kbuf  ((float*)(p.ws + OFF_KBUF))
#define WSP_elist ((int*)(p.ws + OFF_ELIST))
#define WSP_wsl   ((float*)(p.ws + OFF_WSL))
#define WSP_WinT  ((u16*)(p.ws + OFF_WINT))
#define WSP_WgluT ((u16*)(p.ws + OFF_WGLUT))
#define WSP_WoutT ((u16*)(p.ws + OFF_WOUTT))
#define WSP_WrT   ((u16*)(p.ws + OFF_WRT))
#define WSP_WdT   ((u16*)(p.ws + OFF_WDT))
#define WSP_HHs   ((u16*)(p.ws + OFF_HHS))
#define WSP_WguT  ((u16*)(p.ws + OFF_WGUT))
#define WSP_TabS  ((u16*)(p.ws + OFF_TABS))
#define WSP_TabY  ((u16*)(p.ws + OFF_TABY))
#define WSP_Hb    ((u16*)(p.ws + OFF_R1))
#define WSP_S     ((float*)(p.ws + OFF_R1))
#define WSP_H2    ((u16*)(p.ws + OFF_H2R))
#define WSP_Q     ((u16*)(p.ws + OFF_R2))
#define WSP_Kb    ((u16*)(p.ws + OFF_R2 + (size_t)NLAT * 512 * 2))
#define WSP_Vt    ((u16*)(p.ws + OFF_R2 + (size_t)NLAT * 512 * 2 + (size_t)NROWS * 128 * 2))
#define WSP_Y     ((u16*)(p.ws + OFF_R2))
#define WSP_SO    ((u16*)(p.ws + OFF_R2 + (size_t)NLAT * 512 * 2))
#define WSP_U     ((u16*)(p.ws + OFF_H2R))
#define WSP_AO    ((u16*)(p.ws + OFF_R4))
#define WSP_Hin   ((u16*)(p.ws + OFF_R4 + (size_t)NLAT * 512 * 2))
#define X1B(tok)  ((u16*)((char*)p.out + (size_t)(tok) * 4096 + 2048))

extern __shared__ __attribute__((aligned(16))) char smem[];

typedef __bf16 bf2_t __attribute__((ext_vector_type(2)));
typedef float f2_t __attribute__((ext_vector_type(2)));
__device__ __forceinline__ unsigned pack2(float a, float b) {
    const f2_t v = {a, b};
    return __builtin_bit_cast(unsigned, __builtin_convertvector(v, bf2_t));
}
__device__ __forceinline__ u16 f2bf(float f) { return (u16)(pack2(f, 0.f) & 0xffffu); }
__device__ __forceinline__ float bf2f(u16 h) { return __uint_as_float(((unsigned)h) << 16); }
__device__ __forceinline__ void glds16(const void* g, void* l) {
    __builtin_amdgcn_global_load_lds((const unsigned*)g, (unsigned*)l, 16, 0, 0);
}
__device__ __forceinline__ void glds16_sc1(const void* g, void* l) {
    __builtin_amdgcn_global_load_lds((const unsigned*)g, (unsigned*)l, 16, 0, 16);
}
__device__ __forceinline__ int lds_byte(int r, int c) {
    int st = (r >> 4) * 2 + (c >> 5), rr = r & 15, cc = c & 31, ob = rr * 64 + cc * 2;
    return st * 1024 + (ob ^ (((ob >> 9) & 1) << 5));
}
template <int CTRL> __device__ __forceinline__ float dppf(float v) {
    return __int_as_float(__builtin_amdgcn_update_dpp(0, __float_as_int(v), CTRL, 0xf, 0xf, true));
}
__device__ __forceinline__ float sum_x16(float v) {
    const unsigned u = __float_as_uint(v);
    const auto r = __builtin_amdgcn_permlane16_swap(u, u, false, false);
    return __uint_as_float(r[0]) + __uint_as_float(r[1]);
}
__device__ __forceinline__ float sum_x32(float v) {
    const unsigned u = __float_as_uint(v);
    const auto r = __builtin_amdgcn_permlane32_swap(u, u, false, false);
    return __uint_as_float(r[0]) + __uint_as_float(r[1]);
}
__device__ __forceinline__ float max_x16(float v) {
    const unsigned u = __float_as_uint(v);
    const auto r = __builtin_amdgcn_permlane16_swap(u, u, false, false);
    return fmaxf(__uint_as_float(r[0]), __uint_as_float(r[1]));
}
__device__ __forceinline__ float max_x32(float v) {
    const unsigned u = __float_as_uint(v);
    const auto r = __builtin_amdgcn_permlane32_swap(u, u, false, false);
    return fmaxf(__uint_as_float(r[0]), __uint_as_float(r[1]));
}
__device__ __forceinline__ float sum16(float v) {
    v += dppf<0xB1>(v);
    v += dppf<0x4E>(v);
    v += dppf<0x141>(v);
    v += dppf<0x140>(v);
    return v;
}
__device__ __forceinline__ float wave_sum(float v) { return sum_x32(sum_x16(sum16(v))); }
template <int CTRL> __device__ __forceinline__ float dpp_f(float v) {
    return __int_as_float(__builtin_amdgcn_update_dpp(0, __float_as_int(v), CTRL, 0xf, 0xf, true));
}
__device__ __forceinline__ float max8(float v) {
    v = fmaxf(v, dpp_f<0xB1>(v));
    v = fmaxf(v, dpp_f<0x4E>(v));
    v = fmaxf(v, dpp_f<0x141>(v));
    return v;
}
__device__ __forceinline__ float sigmoidf_(float x) { return __builtin_amdgcn_rcpf(1.f + __expf(-x)); }
__device__ __forceinline__ float siluf_(float x) { return x * __builtin_amdgcn_rcpf(1.f + __expf(-x)); }
__device__ __forceinline__ float gelu_tanh(float x) {
    float u = 0.7978845608028654f * (x + 0.044715f * x * x * x);
    return x * __builtin_amdgcn_rcpf(1.f + __expf(-2.f * u));
}

template <class FA, class FB>
__device__ __forceinline__ void gemm_tile(int nkt, FA fa, FB fb, f32x4 (&acc)[4][4]) {
    const int tid = TIDX, lane = tid & 63, wid = tid >> 6, wr = wid >> 1, wc = wid & 1, fr = lane & 15, fq = lane >> 4;
    const int sb = lane * 16, swz = sb ^ (((sb >> 9) & 1) << 5);
    const int r_in = swz >> 6, c_in = (swz & 63) >> 1;
#pragma unroll
    for (int m = 0; m < 4; ++m)
#pragma unroll
        for (int n = 0; n < 4; ++n) acc[m][n] = (f32x4){0.f, 0.f, 0.f, 0.f};
    __syncthreads();
    auto stage = [&](int kt, int s) {
        char* sa = smem + s * 32768;
        char* sbm = sa + 16384;
#pragma unroll
        for (int i = 0; i < 4; ++i) {
            const int st = wid + 4 * i, R = (st >> 1) * 16 + r_in, C = (st & 1) * 32 + c_in;
            glds16(fa(R, C, kt), sa + tid * 16 + i * 4096);
            glds16(fb(R, C, kt), sbm + tid * 16 + i * 4096);
        }
    };
    stage(0, 0);
    for (int kt = 0; kt < nkt; ++kt) {
        asm volatile("s_waitcnt vmcnt(0)" ::: "memory");
        __syncthreads();
        if (kt + 1 < nkt) stage(kt + 1, (kt + 1) & 1);
        const char* sa = smem + (kt & 1) * 32768;
        const char* sbm = sa + 16384;
#pragma unroll
        for (int ks = 0; ks < 2; ++ks) {
            bf16x8 a[4], b[4];
#pragma unroll
            for (int m = 0; m < 4; ++m) a[m] = *(const bf16x8*)(sa + lds_byte(wr * 64 + m * 16 + fr, ks * 32 + fq * 8));
#pragma unroll
            for (int n = 0; n < 4; ++n) b[n] = *(const bf16x8*)(sbm + lds_byte(wc * 64 + n * 16 + fr, ks * 32 + fq * 8));
            __builtin_amdgcn_s_setprio(1);
#pragma unroll
            for (int m = 0; m < 4; ++m)
#pragma unroll
                for (int n = 0; n < 4; ++n) acc[m][n] = __builtin_amdgcn_mfma_f32_16x16x32_bf16(a[m], b[n], acc[m][n], 0, 0, 0);
            __builtin_amdgcn_s_setprio(0);
        }
    }
    __syncthreads();
}

__device__ __forceinline__ int lds32(int r, int c) {
    const int rr = r & 15;
    return (r >> 4) * 1024 + ((rr * 64 + c * 2) ^ (((rr >> 3) & 1) << 5));
}
struct NoHook { __device__ __forceinline__ void operator()(int) const {} };
template <bool A_SC1 = false, class FA, class FB, class HK = NoHook>
__device__ __forceinline__ void gemm_tile_w(int nkt, FA fa, FB fb, f32x4 (&acc)[4][8], HK hook = HK()) {
    constexpr bool ZERO = true;
    const int tid = TIDX, lane = tid & 63, wid = tid >> 6, wr = wid >> 1, wc = wid & 1, fr = lane & 15, fq = lane >> 4;
    const int sb = lane * 16, swz = sb ^ (((sb >> 9) & 1) << 5);
    const int r_in = swz >> 6, c_in = (swz & 63) >> 1;
    if (ZERO) {
#pragma unroll
        for (int m = 0; m < 4; ++m)
#pragma unroll
            for (int n = 0; n < 8; ++n) acc[m][n] = (f32x4){0.f, 0.f, 0.f, 0.f};
    }
    __syncthreads();
    auto stage = [&](int kt, int s) {
        char* sa = smem + s * 24576;
#pragma unroll
        for (int i = 0; i < 2; ++i) { if (A_SC1) glds16_sc1(fa(i, (wid + 4 * i) * 16 + r_in, c_in, kt), sa + tid * 16 + i * 4096); else glds16(fa(i, (wid + 4 * i) * 16 + r_in, c_in, kt), sa + tid * 16 + i * 4096); }
#pragma unroll
        for (int i = 0; i < 4; ++i) glds16(fb(i, (wid + 4 * i) * 16 + r_in, c_in, kt), sa + 8192 + tid * 16 + i * 4096);
    };
    stage(0, 0);
    if (nkt > 1) stage(1, 1);
    int s_cur = 0, s_nxt = 2;
    for (int kt = 0; kt < nkt; ++kt) {
        hook(kt);
        if (kt + 1 < nkt) asm volatile("s_waitcnt vmcnt(6) lgkmcnt(0)\n\ts_barrier" ::: "memory");
        else asm volatile("s_waitcnt vmcnt(0) lgkmcnt(0)\n\ts_barrier" ::: "memory");
        if (kt + 2 < nkt) stage(kt + 2, s_nxt);
        const char* sa = smem + s_cur * 24576;
        bf16x8 a[4];
#pragma unroll
        for (int m = 0; m < 4; ++m) a[m] = *(const bf16x8*)(sa + lds32(wr * 64 + m * 16 + fr, fq * 8));
#pragma unroll
        for (int nh = 0; nh < 2; ++nh) {
            bf16x8 b[4];
#pragma unroll
            for (int n = 0; n < 4; ++n) b[n] = *(const bf16x8*)(sa + 8192 + lds32(wc * 128 + (nh * 4 + n) * 16 + fr, fq * 8));
            __builtin_amdgcn_s_setprio(1);
#pragma unroll
            for (int m = 0; m < 4; ++m)
#pragma unroll
                for (int n = 0; n < 4; ++n) acc[m][nh * 4 + n] = __builtin_amdgcn_mfma_f32_16x16x32_bf16(a[m], b[n], acc[m][nh * 4 + n], 0, 0, 0);
            __builtin_amdgcn_s_setprio(0);
        }
        s_cur = (s_cur == 2) ? 0 : s_cur + 1;
        s_nxt = (s_nxt == 2) ? 0 : s_nxt + 1;
    }
    __syncthreads();
}

template <class FV, class FD>
__device__ __forceinline__ void wave_store_bf16_f(FV val, FD dst, bool write_through = false, const char* wt_base = nullptr, unsigned wt_bytes = 0) {
    const __amdgpu_buffer_rsrc_t wt_rsrc = __builtin_amdgcn_make_buffer_rsrc((void*)wt_base, 0, (int)wt_bytes, 0x00020000);
    const int lane = TIDX & 63, wid = TIDX >> 6, fr = lane & 15, fq = lane >> 4;
    char* base = smem + wid * 9216;
#pragma unroll
    for (int m = 0; m < 4; ++m)
#pragma unroll
        for (int n = 0; n < 4; ++n)
#pragma unroll
            for (int j = 0; j < 4; ++j)
                *(u16*)(base + (m * 16 + fq * 4 + j) * 144 + (n * 16 + fr) * 2) = f2bf(val(m, n, j));
    asm volatile("s_waitcnt lgkmcnt(0)" ::: "memory");
    __builtin_amdgcn_wave_barrier();
#pragma unroll
    for (int i = 0; i < 8; ++i) {
        const int id = i * 64 + lane, row = id >> 3, ch = id & 7;
        const uint4 d = *(const uint4*)(base + row * 144 + ch * 16);
        u16* p = dst(row);
        if (p) {
            if (write_through) {
                const u32x4 dv = {d.x, d.y, d.z, d.w};
                __builtin_amdgcn_raw_buffer_store_b128(dv, wt_rsrc, (int)((const char*)(p + ch * 8) - wt_base), 0, 16);
            } else *(uint4*)(p + ch * 8) = d;
        }
    }
    asm volatile("s_waitcnt lgkmcnt(0)" ::: "memory");
    __builtin_amdgcn_wave_barrier();
}

template <class FV, class FD>
__device__ __forceinline__ void wave_store_bf16_pk(FV val, FD dst, const char* wt_base, unsigned wt_bytes) {
    const __amdgpu_buffer_rsrc_t wt_rsrc = __builtin_amdgcn_make_buffer_rsrc((void*)wt_base, 0, (int)wt_bytes, 0x00020000);
    const int lane = TIDX & 63, wid = TIDX >> 6, fr = lane & 15, fq = lane >> 4;
    char* base = smem + wid * 9216;
#pragma unroll
    for (int m = 0; m < 4; ++m)
#pragma unroll
        for (int j = 0; j < 4; ++j)
            *(uint2*)(base + (m * 16 + fq * 4 + j) * 144 + fr * 8) = make_uint2(pack2(val(m, 0, j), val(m, 1, j)), pack2(val(m, 2, j), val(m, 3, j)));
    asm volatile("s_waitcnt lgkmcnt(0)" ::: "memory");
    __builtin_amdgcn_wave_barrier();
#pragma unroll
    for (int i = 0; i < 8; ++i) {
        const int id = i * 64 + lane, row = id >> 3, ch = id & 7;
        const uint4 d = *(const uint4*)(base + row * 144 + ch * 16);
        u16* p = dst(row);
        if (p) {
            const u32x4 dv = {d.x, d.y, d.z, d.w};
            __builtin_amdgcn_raw_buffer_store_b128(dv, wt_rsrc, (int)((const char*)(p + ch * 8) - wt_base), 0, 16);
        }
    }
    asm volatile("s_waitcnt lgkmcnt(0)" ::: "memory");
    __builtin_amdgcn_wave_barrier();
}
template <class FD>
__device__ __forceinline__ void wave_store_bf16(const float (&v)[4][4][4], FD dst) {
    wave_store_bf16_f([&](int m, int n, int j) { return v[m][n][j]; }, dst);
}

struct ConvD { const float* src; u16* dst; int ld, ldd, k0, n0, mode, zr; };
__device__ __forceinline__ void conv_load(const Params& p, const ConvD& d, float (&v)[16]) {
    const int tid = TIDX;
#pragma unroll
    for (int i = 0; i < 16; ++i) v[i] = d.src[(size_t)(d.k0 + i * 4 + (tid >> 6)) * d.ld + d.n0 + (tid & 63)];
    if (d.zr == 2) {
#pragma unroll
        for (int i = 0; i < 16; ++i) {
            const int k = d.k0 + i * 4 + (tid >> 6);
            v[i] *= (k < 512) ? p.norm_attn_out[k] : p.norm_ssm_out[k - 512];
        }
    }
}
__device__ __forceinline__ void conv_store(const Params& p, const ConvD& d, const float (&v)[16]) {
    float* t = (float*)smem;
    const int tid = TIDX;
    __syncthreads();
#pragma unroll
    for (int i = 0; i < 16; ++i) t[(i * 4 + (tid >> 6)) * 65 + (tid & 63)] = v[i];
    __syncthreads();
    const int n = tid >> 2, kq = tid & 3;
    unsigned w[8];
#pragma unroll
    for (int i = 0; i < 8; ++i) w[i] = pack2(t[(kq * 16 + 2 * i) * 65 + n], t[(kq * 16 + 2 * i + 1) * 65 + n]);
    const int gn = d.n0 + n;
    int row = gn;
    if (d.mode == 1) row = (gn >> 4) * 32 + (gn & 15);
    else if (d.mode == 2) row = (gn >> 4) * 32 + 16 + (gn & 15);
    else if (d.mode == 3) row = n;
    uint4* o = (uint4*)(d.dst + (size_t)row * d.ldd + d.k0 + kq * 16);
    o[0] = make_uint4(w[0], w[1], w[2], w[3]);
    o[1] = make_uint4(w[4], w[5], w[6], w[7]);
    if (d.zr == 1) {
        uint4* z = (uint4*)(WSP_WrT + (size_t)(64 + n) * 1024 + d.k0 + kq * 16);
        z[0] = make_uint4(0, 0, 0, 0); z[1] = make_uint4(0, 0, 0, 0);
    }
}

__device__ __forceinline__ void ada_item(const Params& p, int item) {
    float* sc = (float*)smem;
    float* red = sc + 9 * 1024;
    const int tid = TIDX;
    __syncthreads();
    for (int i = tid; i < 9 * 1024; i += NTHR) {
        const int r = i >> 10, k = i & 1023;
        const float cv = (r < 8) ? p.c[r * 1024 + k] : p.c_ctx[k];
        sc[i] = siluf_(cv);
    }
    __syncthreads();
    const int kq = tid >> 6, jl = tid & 63, j = item * 64 + jl;
    float acc[9];
#pragma unroll
    for (int r = 0; r < 9; ++r) acc[r] = 0.f;
#pragma unroll 16
    for (int k = kq; k < 1024; k += 4) {
        const float w = p.w_ada[(size_t)k * 6144 + j];
#pragma unroll
        for (int r = 0; r < 9; ++r) acc[r] += sc[r * 1024 + k] * w;
    }
#pragma unroll
    for (int r = 0; r < 9; ++r) red[(kq * 9 + r) * 64 + jl] = acc[r];
    __syncthreads();
    for (int i = tid; i < 9 * 64; i += NTHR) {
        const int r = i >> 6, l = i & 63;
        const float s = red[(0 * 9 + r) * 64 + l] + red[(1 * 9 + r) * 64 + l] + red[(2 * 9 + r) * 64 + l] + red[(3 * 9 + r) * 64 + l];
        WSP_mod[r * 6144 + item * 64 + l] = s + p.b_ada[item * 64 + l];
    }
}

__device__ __forceinline__ void rope_item(const Params& p) {
    for (int i = TIDX; i < 64 * 16; i += NTHR) {
        const int pos = i >> 4, k = i & 15;
        const float inv = exp2f(-(float)k * (13.287712379549449f / 16.f));
        float s, c;
        sincosf((float)pos * inv, &s, &c);
        WSP_rope[i] = make_float2(c, s);
    }
}

__device__ __forceinline__ void ssm_table_item(const Params& p, int g, int dir) {
    float* pw = (float*)smem;
    float* Bb = pw + 17 * 64 * 2;
    float* Cc = Bb + 64 * 16 * 2;
    const int tid = TIDX;
    u16* tabS = WSP_TabS + (size_t)g * 256 * 256;
    u16* tabY = WSP_TabY + (size_t)g * 256 * 512;
    float* Kf = WSP_Kbuf + (size_t)(g * 2 + dir) * 4096;
    __syncthreads();
    {
        const int pidx = dir * 32 + g;
        const float dt = __expf(p.log_dt[pidx]);
        for (int i = tid; i < 17 * 64; i += NTHR) {
            const int tau = i >> 6, n = i & 63;
            const float are = p.a_re[pidx * 64 + n], aim = p.a_im[pidx * 64 + n];
            const float mag = __expf((float)tau * dt * are);
            float rev = (float)tau * (dt * aim * 0.15915494309189535f);
            rev -= rintf(rev);
            pw[i * 2] = mag * __builtin_amdgcn_cosf(rev);
            pw[i * 2 + 1] = mag * __builtin_amdgcn_sinf(rev);
        }
        __syncthreads();
        for (int i = tid; i < 64 * 16; i += NTHR) {
            const int n = i >> 4;
            const float are = p.a_re[pidx * 64 + n], aim = p.a_im[pidx * 64 + n];
            const float abr = pw[(64 + n) * 2], abi = pw[(64 + n) * 2 + 1];
            const float den = are * are + aim * aim, nre = abr - 1.f;
            const float cre = (nre * are + abi * aim) / den, cim = (abi * are - nre * aim) / den;
            const float br = p.b_re[(size_t)pidx * 1024 + i], bi = p.b_im[(size_t)pidx * 1024 + i];
            Bb[i * 2] = cre * br - cim * bi;
            Bb[i * 2 + 1] = cre * bi + cim * br;
            Cc[i * 2] = p.c_re[(size_t)pidx * 1024 + i];
            Cc[i * 2 + 1] = p.c_im[(size_t)pidx * 1024 + i];
        }
        __syncthreads();
        {
            const int tau = tid >> 4, pp = tid & 15;
            float s[16];
#pragma unroll
            for (int q = 0; q < 16; ++q) s[q] = 0.f;
            for (int n = 0; n < 64; ++n) {
                const float2 cv = *(const float2*)&Cc[(pp * 64 + n) * 2];
                const float2 wv = *(const float2*)&pw[(tau * 64 + n) * 2];
                const float zr = cv.x * wv.x - cv.y * wv.y, zi = cv.x * wv.y + cv.y * wv.x;
#pragma unroll
                for (int q = 0; q < 16; ++q) {
                    const float2 bv = *(const float2*)&Bb[(n * 16 + q) * 2];
                    s[q] += zr * bv.x - zi * bv.y;
                }
            }
#pragma unroll
            for (int q = 0; q < 4; ++q)
                *(float4*)(Kf + tau * 256 + pp * 16 + q * 4) = make_float4(s[4 * q], s[4 * q + 1], s[4 * q + 2], s[4 * q + 3]);
        }
        for (int id = tid; id < 128 * 32; id += NTHR) {
            const int rr = id >> 5, ch = id & 31, cpart = rr >> 6, n = rr & 63, s_ = ch >> 1, q0 = (ch & 1) * 8;
            const int e = dir == 0 ? 15 - s_ : s_;
            const float wr_ = pw[(e * 64 + n) * 2], wi_ = pw[(e * 64 + n) * 2 + 1];
            unsigned w[4];
#pragma unroll
            for (int i = 0; i < 4; ++i) {
                float v[2];
#pragma unroll
                for (int h = 0; h < 2; ++h) {
                    const float br = Bb[(n * 16 + q0 + 2 * i + h) * 2], bi = Bb[(n * 16 + q0 + 2 * i + h) * 2 + 1];
                    v[h] = cpart == 0 ? (wr_ * br - wi_ * bi) : (wr_ * bi + wi_ * br);
                }
                w[i] = pack2(v[0], v[1]);
            }
            *(uint4*)(tabS + (size_t)(dir * 128 + rr) * 256 + s_ * 16 + q0) = make_uint4(w[0], w[1], w[2], w[3]);
        }
        for (int id = tid; id < 256 * 16; id += NTHR) {
            const int m = id >> 4, ch = id & 15, t = m >> 4, pp = m & 15, cpart = ch >> 3, n0 = (ch & 7) * 8;
            const int e = dir == 0 ? t + 1 : 16 - t;
            unsigned w[4];
#pragma unroll
            for (int i = 0; i < 4; ++i) {
                float v[2];
#pragma unroll
                for (int h = 0; h < 2; ++h) {
                    const int n = n0 + 2 * i + h;
                    const float cr = Cc[(pp * 64 + n) * 2], ci = Cc[(pp * 64 + n) * 2 + 1];
                    const float wr_ = pw[(e * 64 + n) * 2], wi_ = pw[(e * 64 + n) * 2 + 1];
                    v[h] = cpart == 0 ? (cr * wr_ - ci * wi_) : -(cr * wi_ + ci * wr_);
                }
                w[i] = pack2(v[0], v[1]);
            }
            *(uint4*)(tabY + (size_t)m * 512 + 256 + dir * 128 + cpart * 64 + n0) = make_uint4(w[0], w[1], w[2], w[3]);
        }
    }
}

__device__ __forceinline__ void ssm_toeplitz_item(const Params& p, int g) {
    float* Kf = (float*)smem;
    const int tid = TIDX;
    u16* tabY = WSP_TabY + (size_t)g * 256 * 512;
    __syncthreads();
    for (int i = tid; i < 2048; i += NTHR) ((float4*)Kf)[i] = ((const float4*)(WSP_Kbuf + (size_t)g * 8192))[i];
    __syncthreads();
    for (int id = tid; id < 256 * 32; id += NTHR) {
        const int m = id >> 5, ch = id & 31, t = m >> 4, pp = m & 15, s_ = ch >> 1, q0 = (ch & 1) * 8;
        unsigned w[4];
#pragma unroll
        for (int i = 0; i < 4; ++i) {
            float v[2];
#pragma unroll
            for (int h = 0; h < 2; ++h) {
                const int q = q0 + 2 * i + h;
                float val;
                if (s_ < t) val = Kf[((t - s_) * 16 + pp) * 16 + q];
                else if (s_ > t) val = Kf[4096 + ((s_ - t) * 16 + pp) * 16 + q];
                else val = Kf[(pp) * 16 + q] + Kf[4096 + pp * 16 + q] + (pp == q ? p.ssm_d[g * 16 + pp] : 0.f);
                v[h] = val;
            }
            w[i] = pack2(v[0], v[1]);
        }
        *(uint4*)(tabY + (size_t)m * 512 + s_ * 16 + q0) = make_uint4(w[0], w[1], w[2], w[3]);
    }
    __syncthreads();
}

#define N_CONV 6896
__device__ __forceinline__ ConvD conv_decode(const Params& p, int t) {
    ConvD d; d.mode = 0; d.zr = 0;
    if (t < 320) { d.src = p.w_in; d.ld = 1280; d.k0 = (t / 20) * 64; d.n0 = (t % 20) * 64; d.dst = WSP_WinT; d.ldd = 1024; return d; }
    t -= 320;
    if (t < 64) { d.src = p.w_glu; d.ld = 512; d.k0 = (t / 8) * 64; d.n0 = (t % 8) * 64; d.dst = WSP_WgluT; d.ldd = 512; return d; }
    t -= 64;
    if (t < 256) { d.src = p.w_out; d.ld = 1024; d.k0 = (t / 16) * 64; d.n0 = (t % 16) * 64; d.dst = WSP_WoutT; d.ldd = 1024; d.zr = 2; return d; }
    t -= 256;
    if (t < 16) { d.src = p.w_router; d.ld = 64; d.k0 = t * 64; d.n0 = 0; d.dst = WSP_WrT; d.ldd = 1024; d.zr = 1; return d; }
    t -= 16;
    if (t < 4096) {
        const int up = t >= 2048; const int tt = t & 2047, e = tt >> 5, r = tt & 31;
        d.src = (up ? p.w_up_e : p.w_gate_e) + (size_t)e * 131072; d.ld = 128; d.k0 = (r >> 1) * 64; d.n0 = (r & 1) * 64;
        d.dst = WSP_WguT + (size_t)e * 262144; d.ldd = 1024; d.mode = 1 + up; return d;
    }
    t -= 4096;
    if (t < 64) {
        const int up = t >= 32; const int r = t & 31;
        d.src = up ? p.w_up_s : p.w_gate_s; d.ld = 128; d.k0 = (r >> 1) * 64; d.n0 = (r & 1) * 64;
        d.dst = WSP_WguT + (size_t)64 * 262144; d.ldd = 1024; d.mode = 1 + up; return d;
    }
    t -= 64;
    if (t < 2048) { const int e = t >> 5, r = t & 31; d.src = p.w_down_e + (size_t)e * 131072; d.ld = 1024; d.k0 = (r >> 4) * 64; d.n0 = (r & 15) * 64; d.dst = WSP_WdT + (size_t)e * 131072; d.ldd = 128; return d; }
    t -= 2048;
    d.src = p.w_down_s; d.ld = 1024; d.k0 = (t >> 4) * 64; d.n0 = (t & 15) * 64; d.dst = WSP_WdT + (size_t)64 * 131072; d.ldd = 128; return d;
}

#define N_CONV_EARLY 4000
__device__ __forceinline__ void conv_range(const Params& p, int t0, int stride, int tend, int tbeg = 0) {
    int t = tbeg + t0;
    if (t < tend) {
        ConvD d = conv_decode(p, t);
        float v[16];
        conv_load(p, d, v);
        while (t < tend) {
            const int tn = t + stride;
            ConvD dn = d;
            float vn[16];
            if (tn < tend) { dn = conv_decode(p, tn); conv_load(p, dn, vn); }
            conv_store(p, d, v);
            d = dn;
#pragma unroll
            for (int i = 0; i < 16; ++i) v[i] = vn[i];
            t = tn;
        }
    }
}
#define P0_CONV_B0 161
__device__ __forceinline__ void phase0(const Params& p) {
    const int b = blockIdx.x, G = gridDim.x;
    if (G > P0_CONV_B0 + 32) {
        if (b < 64) ssm_table_item(p, b >> 1, b & 1);
        else if (b < 160) ada_item(p, b - 64);
        else if (b == 160) rope_item(p);
        else conv_range(p, b - P0_CONV_B0, G - P0_CONV_B0, N_CONV_EARLY);
    } else {
        const int NU = 64 + 96 + 1 + N_CONV_EARLY;
        for (int u = b; u < NU; u += G) {
            if (u < 64) ssm_table_item(p, u >> 1, u & 1);
            else if (u < 160) ada_item(p, u - 64);
            else if (u == 160) rope_item(p);
            else { ConvD d = conv_decode(p, u - 161); float v[16]; conv_load(p, d, v); conv_store(p, d, v); }
        }
    }
}
#if 0
    {
        {
            const int stride = G - P0_CONV_B0;
            int t = b - P0_CONV_B0;
            if (t < N_CONV) {
                ConvD d = conv_decode(p, t);
                float v[16];
                conv_load(p, d, v);
                while (t < N_CONV) {
                    const int tn = t + stride;
                    ConvD dn = d;
                    float vn[16];
                    if (tn < N_CONV) { dn = conv_decode(p, tn); conv_load(p, dn, vn); }
                    conv_store(p, d, v);
                    d = dn;
#pragma unroll
                    for (int i = 0; i < 16; ++i) v[i] = vn[i];
                    t = tn;
                }
            }
        }
    } else {
        const int NU = 64 + 96 + 1 + N_CONV;
        for (int u = b; u < NU; u += G) {
            if (u < 64) ssm_table_item(p, u >> 1, u & 1);
            else if (u < 160) ada_item(p, u - 64);
            else if (u == 160) rope_item(p);
            else { ConvD d = conv_decode(p, u - 161); float v[16]; conv_load(p, d, v); conv_store(p, d, v); }
        }
    }
}

#endif

__device__ __forceinline__ void norm_mod_row(const float* src, const float* gain, const float* sh, const float* scl, u16* dst) {
    const int lane = TIDX & 63;
    float4 v[4];
    float ss = 0.f;
#pragma unroll
    for (int i = 0; i < 4; ++i) {
        v[i] = *(const float4*)(src + i * 256 + lane * 4);
        ss += v[i].x * v[i].x + v[i].y * v[i].y + v[i].z * v[i].z + v[i].w * v[i].w;
    }
    ss = wave_sum(ss);
    const float rs = rsqrtf(ss * (1.f / 1024.f) + EPS);
#pragma unroll
    for (int i = 0; i < 4; ++i) {
        const int c0 = i * 256 + lane * 4;
        const float4 g = *(const float4*)(gain + c0), s = *(const float4*)(sh + c0), k = *(const float4*)(scl + c0);
        const float a = v[i].x * rs * g.x * (1.f + k.x) + s.x, b = v[i].y * rs * g.y * (1.f + k.y) + s.y;
        const float c = v[i].z * rs * g.z * (1.f + k.z) + s.z, d = v[i].w * rs * g.w * (1.f + k.w) + s.w;
        *(uint2*)(dst + c0) = make_uint2(pack2(a, b), pack2(c, d));
    }
}

__device__ __forceinline__ void phase1(const Params& p) {
    const int wv = blockIdx.x * 4 + (TIDX >> 6), nwv = gridDim.x * 4;
    const int lane = TIDX & 63;
    for (int r0 = wv * 4; r0 < NROWS; r0 += nwv * 4) {
        const float* src[4]; const float* md[4];
        float4 v[4][4];
#pragma unroll
        for (int q = 0; q < 4; ++q) {
            const int r = r0 + q;
            if (r < NLAT) { src[q] = p.x + (size_t)r * 1024; md[q] = WSP_mod + (r >> 11) * 6144; }
            else { src[q] = p.ctx + (size_t)(r - NLAT) * 1024; md[q] = WSP_mod + 8 * 6144; }
#pragma unroll
            for (int i = 0; i < 4; ++i) v[q][i] = *(const float4*)(src[q] + i * 256 + lane * 4);
        }
#pragma unroll
        for (int q = 0; q < 4; ++q) {
            float ss = 0.f;
#pragma unroll
            for (int i = 0; i < 4; ++i) ss += v[q][i].x * v[q][i].x + v[q][i].y * v[q][i].y + v[q][i].z * v[q][i].z + v[q][i].w * v[q][i].w;
            ss = wave_sum(ss);
            const float rs = rsqrtf(ss * (1.f / 1024.f) + EPS);
            u16* dst = WSP_Hb + (size_t)(r0 + q) * 1024;
#pragma unroll
            for (int i = 0; i < 4; ++i) {
                const int c0 = i * 256 + lane * 4;
                const float4 g = *(const float4*)(p.norm_mix + c0), s = *(const float4*)(md[q] + c0), k = *(const float4*)(md[q] + 1024 + c0);
                const float a = v[q][i].x * rs * g.x * (1.f + k.x) + s.x, b = v[q][i].y * rs * g.y * (1.f + k.y) + s.y;
                const float c = v[q][i].z * rs * g.z * (1.f + k.z) + s.z, d = v[q][i].w * rs * g.w * (1.f + k.w) + s.w;
                *(uint2*)(dst + c0) = make_uint2(pack2(a, b), pack2(c, d));
            }
        }
    }
}

__device__ __forceinline__ void phase2(const Params& p) {
    const int NU = 128 * 10 + 16 * 6;
    const int lane = TIDX & 63, wid = TIDX >> 6, wr = wid >> 1, wc = wid & 1, fr = lane & 15, fq = lane >> 4;
    for (int u = blockIdx.x; u < NU; u += gridDim.x) {
        int mt, nt;
        {
            const int xc = u & 7, r = u >> 3;
            if (r < 160) { mt = xc + 8 * (r / 10); nt = r % 10; } else { const int v = r - 160; mt = 128 + xc + 8 * (v / 6); nt = 4 + v % 6; }
        }
        const u16* A = WSP_Hb + (size_t)mt * 128 * 1024;
        const u16* B = WSP_WinT + (size_t)nt * 128 * 1024;
        f32x4 acc[4][4];
        gemm_tile(16,
            [&](int R, int C, int kt) { return (const void*)(A + (size_t)R * 1024 + kt * 64 + C); },
            [&](int R, int C, int kt) { return (const void*)(B + (size_t)R * 1024 + kt * 64 + C); }, acc);
        const int row0 = mt * 128 + wr * 64;
        const int col0 = nt * 128 + wc * 64;
        const bool is_lat = mt < 128;
        if (nt == 5) {
            const int kvh = wc;
#pragma unroll
            for (int m = 0; m < 4; ++m) {
                const int r = row0 + m * 16 + fq * 4;
                int b, pos;
                if (is_lat) { b = r >> 11; pos = r & 2047; } else { const int rc = r - NLAT; b = rc >> 8; pos = SEQ + (rc & 255); }
#pragma unroll
                for (int n = 0; n < 4; ++n) {
                    const int d = n * 16 + fr;
                    u16* dst = WSP_Vt + ((size_t)(b * 2 + kvh) * 64 + d) * VT_LD + pos;
                    *(uint2*)dst = make_uint2(pack2(acc[m][n][0], acc[m][n][1]), pack2(acc[m][n][2], acc[m][n][3]));
                }
            }
        } else {
            float v[4][4][4];
            const bool do_rope = is_lat && nt <= 4;
#pragma unroll
            for (int m = 0; m < 4; ++m)
#pragma unroll
                for (int j = 0; j < 4; ++j) {
                    if (do_rope) {
                        const int r = row0 + m * 16 + fq * 4 + j, pos = r & 2047;
                        const float2 cr = WSP_rope[(pos >> 6) * 16 + fr], cc = WSP_rope[(pos & 63) * 16 + fr];
                        const float x1 = acc[m][0][j], x2 = acc[m][1][j], y1 = acc[m][2][j], y2 = acc[m][3][j];
                        v[m][0][j] = x1 * cr.x - x2 * cr.y; v[m][1][j] = x1 * cr.y + x2 * cr.x;
                        v[m][2][j] = y1 * cc.x - y2 * cc.y; v[m][3][j] = y1 * cc.y + y2 * cc.x;
                    } else {
#pragma unroll
                        for (int n = 0; n < 4; ++n) v[m][n][j] = acc[m][n][j];
                    }
                }
            u16* dbase; int ldd;
            if (nt < 4) { dbase = WSP_Q + (size_t)row0 * 512 + col0; ldd = 512; }
            else if (nt == 4) { dbase = WSP_Kb + (size_t)row0 * 128 + (col0 - 512); ldd = 128; }
            else { dbase = WSP_U + (size_t)row0 * 512 + (col0 - 768); ldd = 512; }
            wave_store_bf16(v, [&](int row) { return dbase + (size_t)row * ldd; });
        }
    }
}

__device__ __forceinline__ void attn_unit(const Params& p, int u) {
    const int h = u & 7, qb = (u >> 3) & 15, b = u >> 7, kvh = h >> 2;
    const int tid = TIDX, lane = tid & 63, wid = tid >> 6, fr = lane & 15, fq = lane >> 4;
    const int sb = lane * 16, swz = sb ^ (((sb >> 9) & 1) << 5);
    const int r_in = swz >> 6, c_in = (swz & 63) >> 1;
    const int jstart = qb == 0 ? 2 : 0, jend = qb == 15 ? 4 : 6, nb = jend - jstart, ntile = nb + 4;
    const float SC = 0.125f * 1.4426950408889634f;
    bf16x8 qf[2][2];
    const int qrow0 = b * SEQ + qb * 128 + wid * 32;
#pragma unroll
    for (int qt = 0; qt < 2; ++qt)
#pragma unroll
        for (int ks = 0; ks < 2; ++ks)
            qf[qt][ks] = *(const bf16x8*)(WSP_Q + (size_t)(qrow0 + qt * 16 + fr) * 512 + h * 64 + ks * 32 + fq * 8);
    f32x4 o[4][2];
#pragma unroll
    for (int dt = 0; dt < 4; ++dt)
#pragma unroll
        for (int qt = 0; qt < 2; ++qt) o[dt][qt] = (f32x4){0.f, 0.f, 0.f, 0.f};
    float mrun[2], lrun[2];
    const float sinkv = p.attn_sink[h] * 1.4426950408889634f;
    mrun[0] = mrun[1] = sinkv;
    lrun[0] = lrun[1] = (fq == 0) ? 1.f : 0.f;
    __syncthreads();
    const u16* kp[2]; const u16* vp[2];
    {
        const int ks0 = qb * 128 - 128 + 64 * jstart;
#pragma unroll
        for (int it = 0; it < 2; ++it) {
            const int st = wid + 4 * it, R = (st >> 1) * 16 + r_in, C = (st & 1) * 32 + c_in;
            kp[it] = WSP_Kb + (size_t)(b * SEQ + ks0 + R) * 128 + kvh * 64 + C;
            vp[it] = WSP_Vt + ((size_t)(b * 2 + kvh) * 64 + R) * VT_LD + ks0 + C;
        }
    }
    auto stage = [&](int i, int s) {
        char* sk = smem + s * 16384;
        char* sv = sk + 8192;
#pragma unroll
        for (int it = 0; it < 2; ++it) {
            glds16(kp[it], sk + tid * 16 + it * 4096);
            glds16(vp[it], sv + tid * 16 + it * 4096);
        }
        if (i + 1 == nb) {
            const int ks0 = qb * 128 - 128 + 64 * (jstart + i);
#pragma unroll
            for (int it = 0; it < 2; ++it) {
                kp[it] += (size_t)(NLAT + b * CTXL - (b * SEQ + ks0)) * 128;
                vp[it] += SEQ - ks0;
            }
        } else {
#pragma unroll
            for (int it = 0; it < 2; ++it) { kp[it] += 64 * 128; vp[it] += 64; }
        }
    };
    stage(0, 0);
    for (int i = 0; i < ntile; ++i) {
        asm volatile("s_waitcnt vmcnt(0)" ::: "memory");
        __syncthreads();
        if (i + 1 < ntile) stage(i + 1, (i + 1) & 1);
        const char* sk = smem + (i & 1) * 16384;
        const char* sv = sk + 8192;
        f32x4 s[4][2];
#pragma unroll
        for (int kt = 0; kt < 4; ++kt)
#pragma unroll
            for (int qt = 0; qt < 2; ++qt) s[kt][qt] = (f32x4){0.f, 0.f, 0.f, 0.f};
#pragma unroll
        for (int ks = 0; ks < 2; ++ks)
#pragma unroll
            for (int kt = 0; kt < 4; ++kt) {
                const bf16x8 kf = *(const bf16x8*)(sk + lds_byte(32 * (kt >> 1) + 8 * (fr >> 2) + 4 * (kt & 1) + (fr & 3), ks * 32 + fq * 8));
#pragma unroll
                for (int qt = 0; qt < 2; ++qt) s[kt][qt] = __builtin_amdgcn_mfma_f32_16x16x32_bf16(kf, qf[qt][ks], s[kt][qt], 0, 0, 0);
            }
        const int ks0 = qb * 128 - 128 + 64 * (jstart + i);
        const int qlo = qb * 128 + wid * 32;
        const bool band = (i < nb) && ((qlo + 31 - ks0 > 128) || (ks0 + 63 - qlo > 128));
        bf16x8 pf[2][2];
#pragma unroll
        for (int qt = 0; qt < 2; ++qt) {
            const int qp = qb * 128 + wid * 32 + qt * 16 + fr;
            float mx = -1e30f;
            if (band) {
#pragma unroll
                for (int kt = 0; kt < 4; ++kt)
#pragma unroll
                    for (int j = 0; j < 4; ++j) {
                        const int kp = ks0 + 32 * (kt >> 1) + 8 * fq + 4 * (kt & 1) + j, d = qp - kp;
                        const float v = (d > 128 || d < -128) ? -1e30f : s[kt][qt][j];
                        s[kt][qt][j] = v;
                        mx = fmaxf(mx, v);
                    }
                asm volatile("" ::: "memory");
            } else {
#pragma unroll
                for (int kt = 0; kt < 4; ++kt)
#pragma unroll
                    for (int j = 0; j < 4; ++j) mx = fmaxf(mx, s[kt][qt][j]);
            }
            mx = max_x32(max_x16(mx));
            const float mnew = fmaxf(mrun[qt], mx * SC);
            const float alpha = __builtin_amdgcn_exp2f(mrun[qt] - mnew);
            mrun[qt] = mnew;
            float ls = 0.f;
#pragma unroll
            for (int kt = 0; kt < 4; ++kt)
#pragma unroll
                for (int j = 0; j < 4; ++j) {
                    const float pv = __builtin_amdgcn_exp2f(fmaf(s[kt][qt][j], SC, -mnew));
                    s[kt][qt][j] = pv;
                    ls += pv;
                }
            lrun[qt] = lrun[qt] * alpha + ls;
            if (!__all(alpha == 1.f)) {
#pragma unroll
                for (int dt = 0; dt < 4; ++dt) o[dt][qt] *= alpha;
            }
#pragma unroll
            for (int k2 = 0; k2 < 2; ++k2) {
                bf16x8 t;
#pragma unroll
                for (int j = 0; j < 4; ++j) { t[j] = (short)f2bf(s[2 * k2][qt][j]); t[4 + j] = (short)f2bf(s[2 * k2 + 1][qt][j]); }
                pf[qt][k2] = t;
            }
        }
#pragma unroll
        for (int k2 = 0; k2 < 2; ++k2)
#pragma unroll
            for (int dt = 0; dt < 4; ++dt) {
                const bf16x8 vf = *(const bf16x8*)(sv + lds_byte(dt * 16 + fr, k2 * 32 + fq * 8));
#pragma unroll
                for (int qt = 0; qt < 2; ++qt) o[dt][qt] = __builtin_amdgcn_mfma_f32_16x16x32_bf16(vf, pf[qt][k2], o[dt][qt], 0, 0, 0);
            }
    }
#pragma unroll
    for (int qt = 0; qt < 2; ++qt) {
        const float l = sum_x32(sum_x16(lrun[qt]));
        const float inv = 1.f / l;
        u16* dst = WSP_AO + (size_t)(qrow0 + qt * 16 + fr) * 512 + h * 64 + fq * 4;
        float sq = 0.f;
#pragma unroll
        for (int dt = 0; dt < 4; ++dt) {
            const unsigned w0 = pack2(o[dt][qt][0] * inv, o[dt][qt][1] * inv), w1 = pack2(o[dt][qt][2] * inv, o[dt][qt][3] * inv);
            *(uint2*)(dst + dt * 16) = make_uint2(w0, w1);
            const float a = bf2f((u16)(w0 & 0xffffu)), b = bf2f((u16)(w0 >> 16)), c = bf2f((u16)(w1 & 0xffffu)), d = bf2f((u16)(w1 >> 16));
            sq += a * a + b * b + c * c + d * d;
        }
        sq = sum_x32(sum_x16(sq));
        if (fq == 0) unsafeAtomicAdd(WSP_rsq + (size_t)(qrow0 + qt * 16 + fr) * 2, sq);
    }
}

__device__ __forceinline__ void ssm_s1_unit(const Params& p, int u) {
    const int ct = u % 9, mh = (u / 9) & 1, g = u / 18;
    const int lane = TIDX & 63, wid = TIDX >> 6, wr = wid >> 1, wc = wid & 1, fr = lane & 15, fq = lane >> 4;
    const u16* A = WSP_TabS + ((size_t)g * 256 + mh * 128) * 256;
    const u16* Ub = WSP_U + (size_t)ct * 128 * 16 * 512 + g * 16;
    f32x4 acc[4][4];
    gemm_tile(4,
        [&](int R, int C, int kt) { return (const void*)(A + (size_t)R * 256 + kt * 64 + C); },
        [&](int R, int C, int kt) { return (const void*)(Ub + (size_t)(R * 16 + kt * 4 + (C >> 4)) * 512 + (C & 15)); }, acc);
#pragma unroll
    for (int m = 0; m < 4; ++m)
#pragma unroll
        for (int n = 0; n < 4; ++n) {
            const int rho = mh * 128 + wr * 64 + m * 16 + fq * 4;
            const int cg = ct * 128 + wc * 64 + n * 16 + fr;
            *(f32x4*)(WSP_S + ((size_t)cg * 32 + g) * 256 + rho) = acc[m][n];
        }
}

__device__ __forceinline__ void phase3(const Params& p) {
    for (int u = blockIdx.x; u < 1024; u += gridDim.x) attn_unit(p, u);
    int* qv = (int*)(smem + 73728);
    for (;;) {
        __syncthreads();
        if (TIDX == 0) qv[0] = (int)atomicAdd(&WSP_ctr[CTR_QS1], 1u);
        __syncthreads();
        const int u = __builtin_amdgcn_readfirstlane(qv[0]);
        if (u >= 576) break;
        ssm_s1_unit(p, u);
    }
}

__device__ __forceinline__ void phase4(const Params& p) {
    if ((int)gridDim.x > 192) {
        if ((int)blockIdx.x >= 160) { conv_range(p, blockIdx.x - 160, gridDim.x - 160, N_CONV, N_CONV_EARLY); return; }
        if ((int)blockIdx.x >= 128) { ssm_toeplitz_item(p, blockIdx.x - 128); return; }
    } else {
        for (int g = blockIdx.x; g < 32; g += gridDim.x) ssm_toeplitz_item(p, g);
        conv_range(p, blockIdx.x, gridDim.x, N_CONV, N_CONV_EARLY);
    }
    const int gid = blockIdx.x * NTHR + TIDX;
    if (gid >= BATCH * 2 * 32 * 64) return;
    const int n = gid & 63, g = (gid >> 6) & 31, dir = (gid >> 11) & 1, b = gid >> 12;
    const int pidx = dir * 32 + g;
    const float dt = __expf(p.log_dt[pidx]);
    const float are = p.a_re[pidx * 64 + n], aim = p.a_im[pidx * 64 + n];
    const float mag = __expf(16.f * dt * are);
    float rev = 16.f * (dt * aim * 0.15915494309189535f);
    rev -= rintf(rev);
    const float ar = mag * __builtin_amdgcn_cosf(rev), ai = mag * __builtin_amdgcn_sinf(rev);
    float hr = 0.f, hi = 0.f;
    const size_t so = (size_t)g * 256 + dir * 128 + n;
#pragma unroll 8
    for (int i = 0; i < 16; ++i) {
        const int c = dir == 0 ? i : 15 - i;
        const float* sp = WSP_S + (size_t)(NCHUNK_LAT + b * 16 + c) * 8192 + so;
        const float sr = sp[0], si = sp[64];
        const float nr = ar * hr - ai * hi + sr, ni = ar * hi + ai * hr + si;
        hr = nr; hi = ni;
    }
#pragma unroll 8
    for (int i = 0; i < 128; ++i) {
        const int c = dir == 0 ? i : 127 - i;
        const size_t cg = (size_t)b * 128 + c;
        const float* sp = WSP_S + cg * 8192 + so;
        const float sr = sp[0], si = sp[64];
        u16* hp = WSP_Hin + cg * 8192 + so;
        hp[0] = f2bf(hr); hp[64] = f2bf(hi);
        const float nr = ar * hr - ai * hi + sr, ni = ar * hi + ai * hr + si;
        hr = nr; hi = ni;
    }
}

__device__ __forceinline__ void phase5(const Params& p) {
    const int NU = 512;
    const int lane = TIDX & 63, wid = TIDX >> 6, wr = wid >> 1, wc = wid & 1, fr = lane & 15, fq = lane >> 4;
    for (int u = blockIdx.x; u < NU; u += gridDim.x) {
        const int ct = u & 7, mh = (u >> 3) & 1, g = u >> 4;
        const u16* A = WSP_TabY + ((size_t)g * 256 + mh * 128) * 512;
        const u16* Ub = WSP_U + (size_t)ct * 128 * 16 * 512 + g * 16;
        const u16* Hb_ = WSP_Hin + (size_t)ct * 128 * 8192 + g * 256;
        f32x4 acc[4][4];
        gemm_tile(8,
            [&](int R, int C, int kt) { return (const void*)(A + (size_t)R * 512 + kt * 64 + C); },
            [&](int R, int C, int kt) {
                return kt < 4 ? (const void*)(Ub + (size_t)(R * 16 + kt * 4 + (C >> 4)) * 512 + (C & 15))
                              : (const void*)(Hb_ + (size_t)R * 8192 + (kt - 4) * 64 + C);
            }, acc);
#pragma unroll
        for (int m = 0; m < 4; ++m)
#pragma unroll
            for (int n = 0; n < 4; ++n) {
                const int t = mh * 8 + wr * 4 + m;
                const int cg = ct * 128 + wc * 64 + n * 16 + fr;
                u16* dst = WSP_Y + ((size_t)cg * 16 + t) * 512 + g * 16 + fq * 4;
                *(uint2*)dst = make_uint2(pack2(gelu_tanh(acc[m][n][0]), gelu_tanh(acc[m][n][1])),
                                          pack2(gelu_tanh(acc[m][n][2]), gelu_tanh(acc[m][n][3])));
            }
    }
}

__device__ __forceinline__ void phase6(const Params& p) {
    const int NU = 512;
    const int lane = TIDX & 63, wid = TIDX >> 6, wr = wid >> 1, wc = wid & 1, fr = lane & 15, fq = lane >> 4;
    for (int u = blockIdx.x; u < NU; u += gridDim.x) {
        const int mt = (u & 7) + 8 * (u >> 5), nt = (u >> 3) & 3;
        const u16* A = WSP_Y + (size_t)mt * 128 * 512;
        const u16* B = WSP_WgluT + (size_t)nt * 128 * 512;
        f32x4 acc[4][4];
        gemm_tile(8,
            [&](int R, int C, int kt) { return (const void*)(A + (size_t)R * 512 + kt * 64 + C); },
            [&](int R, int C, int kt) { return (const void*)(B + (size_t)R * 512 + kt * 64 + C); }, acc);
        const int row0 = mt * 128 + wr * 64, col0 = nt * 128 + wc * 64;
        char* base = smem + wid * 9216;
        float bg[4];
#pragma unroll
        for (int n = 0; n < 4; ++n) bg[n] = p.b_glu[col0 + n * 16 + fr];
#pragma unroll
        for (int i = 0; i < 8; ++i) {
            const int id = i * 64 + lane, row = id >> 3, ch = id & 7;
            *(uint4*)(base + row * 144 + ch * 16) = *(const uint4*)(WSP_Y + (size_t)(row0 + row) * 512 + col0 + ch * 8);
        }
        asm volatile("s_waitcnt lgkmcnt(0)" ::: "memory");
        __builtin_amdgcn_wave_barrier();
#pragma unroll
        for (int m = 0; m < 4; ++m)
#pragma unroll
            for (int j = 0; j < 4; ++j) {
                const int rl = m * 16 + fq * 4 + j, r = row0 + rl;
                float sq = 0.f;
#pragma unroll
                for (int n = 0; n < 4; ++n) {
                    const int c = col0 + n * 16 + fr;
                    const float yv = bf2f(*(const u16*)(base + rl * 144 + (n * 16 + fr) * 2));
                    const u16 ob = f2bf(yv * sigmoidf_(acc[m][n][j] + bg[n]));
                    *(u16*)(base + rl * 144 + (n * 16 + fr) * 2) = ob;
                    const float of = bf2f(ob);
                    sq += of * of;
                }
                sq = sum16(sq);
                if (fr == 0) unsafeAtomicAdd(WSP_rsq + (size_t)r * 2 + 1, sq);
            }
        asm volatile("s_waitcnt lgkmcnt(0)" ::: "memory");
        __builtin_amdgcn_wave_barrier();
        u16* dbase = WSP_SO + (size_t)row0 * 512 + col0;
#pragma unroll
        for (int i = 0; i < 8; ++i) {
            const int id = i * 64 + lane, row = id >> 3, ch = id & 7;
            *(uint4*)(dbase + (size_t)row * 512 + ch * 8) = *(const uint4*)(base + row * 144 + ch * 16);
        }
        asm volatile("s_waitcnt lgkmcnt(0)" ::: "memory");
        __builtin_amdgcn_wave_barrier();
    }
}

__device__ __forceinline__ void phase8(const Params& p) {
    const int NU = 512;
    for (int u = blockIdx.x; u < NU; u += gridDim.x) {
        const int mt = (u & 7) + 8 * (u >> 5), nt = (u >> 3) & 3;
        const u16* A1 = WSP_AO + (size_t)mt * 128 * 512;
        const u16* A2 = WSP_SO + (size_t)mt * 128 * 512;
        const u16* B = WSP_WoutT + (size_t)nt * 256 * 1024;
        f32x4 acc[4][8];
        {
        const int tid1 = TIDX, fq = (tid1 & 63) >> 4, row0 = mt * 128 + (tid1 >> 7) * 64;
        gemm_tile_w(32,
            [&](int i, int R, int C, int kt) { return (const void*)((kt < 16 ? A1 : A2) + (size_t)R * 512 + (kt & 15) * 32 + C); },
            [&](int i, int R, int C, int kt) { return (const void*)(B + (size_t)R * 1024 + kt * 32 + C); }, acc,
            [&](int kt) {
                if (kt == 16) {
#pragma unroll
                    for (int m = 0; m < 4; ++m) {
                        asm volatile("" ::: "memory");
#pragma unroll
                        for (int j = 0; j < 4; ++j) {
                            const float2 q = *(const float2*)(WSP_rsq + (size_t)(row0 + m * 16 + fq * 4 + j) * 2);
                            const float ratio = rsqrtf(q.x * (1.f / 512.f) + EPS) / rsqrtf(q.y * (1.f / 512.f) + EPS);
#pragma unroll
                            for (int n = 0; n < 8; ++n) acc[m][n][j] *= ratio;
                        }
                    }
                }
            });
        }
        const int tid2 = TIDX, lane = tid2 & 63, wid = tid2 >> 6, fr = lane & 15, fq = lane >> 4;
        const int row0 = mt * 128 + (wid >> 1) * 64, col0 = nt * 256 + (wid & 1) * 128;
        const float* g1 = WSP_mod + (mt >> 4) * 6144 + 2048 + col0;
        float* stg = (float*)(smem + wid * 8448);
#pragma unroll
        for (int m = 0; m < 4; ++m) {
#pragma unroll
            for (int n = 0; n < 8; ++n)
#pragma unroll
                for (int j = 0; j < 4; ++j) stg[(fq * 4 + j) * 132 + n * 16 + fr] = acc[m][n][j];
            asm volatile("s_waitcnt lgkmcnt(0)" ::: "memory");
            __builtin_amdgcn_wave_barrier();
#pragma unroll
            for (int i = 0; i < 8; ++i) {
                const int id = i * 64 + lane, rr = id >> 5, c4 = (id & 31) * 4;
                float4 v = *(const float4*)(stg + rr * 132 + c4);
                const float rsv = rsqrtf(WSP_rsq[(size_t)(row0 + m * 16 + rr) * 2 + 1] * (1.f / 512.f) + EPS);
                v.x *= rsv; v.y *= rsv; v.z *= rsv; v.w *= rsv;
                const float4 g = *(const float4*)(g1 + c4);
                const size_t o = (size_t)(row0 + m * 16 + rr) * 1024 + col0 + c4;
                const float4 xv = *(const float4*)(p.x + o);
                *(uint2*)(X1B(row0 + m * 16 + rr) + col0 + c4) = make_uint2(pack2(xv.x + g.x * v.x, xv.y + g.y * v.y), pack2(xv.z + g.z * v.z, xv.w + g.w * v.w));
            }
            asm volatile("s_waitcnt lgkmcnt(0)" ::: "memory");
            __builtin_amdgcn_wave_barrier();
        }
    }
}

#define CTR_ECNT 0
#define CTR_Q11 128
#define CTR_Q12 136
#define HALF_TOK 8192
#define HH_HALF_ROWS 73728
#define ELIST_CAP 8192
template <int LEVEL>
__device__ __forceinline__ void phase9_t(const Params& p) {
    const int tid = TIDX, lane = tid & 63, wid = tid >> 6, fr = lane & 15, fq = lane >> 4;
    char* At = smem;
    float* sc = (float*)(smem + 65536);
    int* hist = (int*)(smem + 65536 + 8192);
    int* gbase = hist + 64;
    int* fill = gbase + 64;
    unsigned char* selk = (unsigned char*)(fill + 64);
    float* selw = (float*)(selk + 256);
    for (int chunk = blockIdx.x; chunk < NLAT / 32; chunk += gridDim.x) {
        const int tok0 = chunk * 32;
        __syncthreads();
        if (tid < 64) hist[tid] = 0;
        {
            uint4 vall[8][2];
#pragma unroll
            for (int rr = 0; rr < 8; ++rr)
#pragma unroll
                for (int i = 0; i < 2; ++i) vall[rr][i] = *(const uint4*)(X1B(tok0 + wid * 8 + rr) + i * 512 + lane * 8);
#pragma unroll
            for (int rr = 0; rr < 8; ++rr) {
                const int row = wid * 8 + rr, tok = tok0 + row;
                const float* md = WSP_mod + (tok >> 11) * 6144;
                float xv[2][8];
                float ss = 0.f;
#pragma unroll
                for (int i = 0; i < 2; ++i) {
                    const unsigned w[4] = {vall[rr][i].x, vall[rr][i].y, vall[rr][i].z, vall[rr][i].w};
#pragma unroll
                    for (int q = 0; q < 4; ++q) {
                        xv[i][2 * q] = __uint_as_float(w[q] << 16); xv[i][2 * q + 1] = __uint_as_float(w[q] & 0xffff0000u);
                        ss += xv[i][2 * q] * xv[i][2 * q] + xv[i][2 * q + 1] * xv[i][2 * q + 1];
                    }
                }
                ss = wave_sum(ss);
                const float rs = rsqrtf(ss * (1.f / 1024.f) + EPS);
#pragma unroll
                for (int i = 0; i < 2; ++i) {
                    const int c0 = i * 512 + lane * 8;
                    float o[8];
#pragma unroll
                    for (int q = 0; q < 2; ++q) {
                        const float4 g = *(const float4*)(p.norm_ffn + c0 + q * 4), s = *(const float4*)(md + 3072 + c0 + q * 4), k = *(const float4*)(md + 4096 + c0 + q * 4);
                        o[4 * q] = xv[i][4 * q] * rs * g.x * (1.f + k.x) + s.x; o[4 * q + 1] = xv[i][4 * q + 1] * rs * g.y * (1.f + k.y) + s.y;
                        o[4 * q + 2] = xv[i][4 * q + 2] * rs * g.z * (1.f + k.z) + s.z; o[4 * q + 3] = xv[i][4 * q + 3] * rs * g.w * (1.f + k.w) + s.w;
                    }
                    const uint4 pk = make_uint4(pack2(o[0], o[1]), pack2(o[2], o[3]), pack2(o[4], o[5]), pack2(o[6], o[7]));
                    *(uint4*)(WSP_H2 + (size_t)tok * 1024 + c0) = pk;
                    const int ch = c0 >> 3;
                    *(uint4*)(At + row * 2048 + ((ch ^ (row & 15)) << 4)) = pk;
                }
            }
        }
        __syncthreads();
        if (LEVEL == 1) continue;
        {
            f32x4 acc0 = {0.f, 0.f, 0.f, 0.f}, acc1 = {0.f, 0.f, 0.f, 0.f};
            const u16* bp = WSP_WrT + (size_t)(wid * 16 + fr) * 1024 + fq * 8;
#pragma unroll
            for (int kb = 0; kb < 4; ++kb) {
                bf16x8 bfr[8];
#pragma unroll
                for (int q = 0; q < 8; ++q) bfr[q] = *(const bf16x8*)(bp + (kb * 8 + q) * 32);
#pragma unroll
                for (int q = 0; q < 8; ++q) {
                    const int ch = (kb * 8 + q) * 4 + fq;
                    const bf16x8 a0 = *(const bf16x8*)(At + fr * 2048 + ((ch ^ fr) << 4));
                    const bf16x8 a1 = *(const bf16x8*)(At + (16 + fr) * 2048 + ((ch ^ fr) << 4));
                    acc0 = __builtin_amdgcn_mfma_f32_16x16x32_bf16(a0, bfr[q], acc0, 0, 0, 0);
                    acc1 = __builtin_amdgcn_mfma_f32_16x16x32_bf16(a1, bfr[q], acc1, 0, 0, 0);
                }
            }
#pragma unroll
            for (int j = 0; j < 4; ++j) {
                sc[(fq * 4 + j) * 64 + wid * 16 + fr] = sigmoidf_(acc0[j]);
                sc[(16 + fq * 4 + j) * 64 + wid * 16 + fr] = sigmoidf_(acc1[j]);
            }
        }
        __syncthreads();
        if (LEVEL == 2) continue;
        const float bias = p.router_bias[lane];
        const int eg = lane >> 3;
#pragma unroll 2
        for (int rr = 0; rr < 8; ++rr) {
            const int row = wid * 8 + rr;
            const float s = sc[row * 64 + lane];
            const float bz = s + bias;
            const float m1 = max8(bz);
            const unsigned long long eq = __ballot(bz == m1);
            const unsigned gb = (unsigned)((eq >> (eg * 8)) & 0xffull);
            const int first = __ffs(gb) - 1;
            const float v2 = max8(((lane & 7) == first) ? -1e30f : bz);
            const float gs = m1 + v2;
            int cnt = 0;
#pragma unroll
            for (int j = 0; j < 8; ++j) {
                const float gj = __int_as_float(__builtin_amdgcn_readlane(__float_as_int(gs), j * 8));
                cnt += (gj > gs || (gj == gs && j < eg)) ? 1 : 0;
            }
            const bool gsel = cnt < 4;
            const float mv = gsel ? bz : -1e30f;
            unsigned long long gm = __ballot(gsel);
            int rank = 0;
#pragma unroll 1
            for (int it = 0; it < 4; ++it) {
                const int jb = __builtin_amdgcn_readfirstlane(__ffsll((long long)gm) - 1);
                gm &= ~(0xffull << jb);
#pragma unroll
                for (int j = 0; j < 8; ++j) {
                    const float vj = __int_as_float(__builtin_amdgcn_readlane(__float_as_int(mv), jb + j));
                    rank += (vj > mv || (vj == mv && (jb + j) < lane)) ? 1 : 0;
                }
            }
            const bool sel = gsel && rank < 8;
            unsigned long long sm = __ballot(sel);
            float tot = 0.f;
#pragma unroll 1
            for (int it = 0; it < 8; ++it) {
                const int l = __builtin_amdgcn_readfirstlane(__ffsll((long long)sm) - 1);
                sm &= sm - 1;
                tot += __int_as_float(__builtin_amdgcn_readlane(__float_as_int(s), l));
            }
            if (sel) {
                selw[row * 8 + rank] = s / tot * 2.5f;
                selk[row * 8 + rank] = (unsigned char)lane;
                atomicAdd(&hist[lane], 1);
            }
        }
        __syncthreads();
        const int h = tok0 >> 13;
        if (tid < 64) {
            gbase[tid] = hist[tid] ? (int)atomicAdd(&WSP_ctr[CTR_ECNT + h * 64 + tid], (unsigned)hist[tid]) : 0;
            fill[tid] = 0;
        }
        __syncthreads();
        {
            const int e = selk[tid];
            const int pos = atomicAdd(&fill[e], 1);
            WSP_elist[(size_t)(h * 64 + e) * ELIST_CAP + gbase[e] + pos] = (tok0 + (tid >> 3)) * 8 + (tid & 7);
            WSP_wsl[(size_t)(h * 64 + e) * ELIST_CAP + gbase[e] + pos] = selw[tid];
        }
    }
}

struct MoeTab { int cnt[16]; int soff[16]; int pre[17]; };

template <class FV, class FD>
__device__ __forceinline__ void wave_store_fp8_f(FV val, FD dst) {
    const int lane = TIDX & 63, wid = TIDX >> 6, fr = lane & 15, fq = lane >> 4;
    char* base = smem + wid * 9216;
#pragma unroll
    for (int m = 0; m < 4; ++m)
#pragma unroll
        for (int j = 0; j < 4; ++j) {
            int lo = __builtin_amdgcn_cvt_pk_fp8_f32(val(m, 0, j), val(m, 1, j), 0, false);
            lo = __builtin_amdgcn_cvt_pk_fp8_f32(val(m, 2, j), val(m, 3, j), lo, true);
            int hi = __builtin_amdgcn_cvt_pk_fp8_f32(val(m, 4, j), val(m, 5, j), 0, false);
            hi = __builtin_amdgcn_cvt_pk_fp8_f32(val(m, 6, j), val(m, 7, j), hi, true);
            *(uint2*)(base + (m * 16 + fq * 4 + j) * 144 + fr * 8) = make_uint2((unsigned)lo, (unsigned)hi);
        }
    asm volatile("s_waitcnt lgkmcnt(0)" ::: "memory");
    __builtin_amdgcn_wave_barrier();
#pragma unroll
    for (int i = 0; i < 8; ++i) {
        const int id = i * 64 + lane, row = id >> 3, ch = id & 7;
        const uint4 d = *(const uint4*)(base + row * 144 + ch * 16);
        unsigned char* q = dst(i, row);
        if (q) { const u32x4 t = {d.x, d.y, d.z, d.w}; __builtin_nontemporal_store(t, (u32x4*)(q + ch * 16)); }
    }
    asm volatile("s_waitcnt lgkmcnt(0)" ::: "memory");
    __builtin_amdgcn_wave_barrier();
}

#define YD_SCALE 8.0f
template <int MODE>
__device__ __forceinline__ void phase11f(const Params& p) {
    const int tid = TIDX;
    int* tab = (int*)(smem + 73728);
    int* t_cnt = tab, *t_soff = tab + 16, *t_pre = tab + 32, *t_q = tab + 52;
    int* t_all = tab + 64;
    const int x = blockIdx.x & 7;
    unsigned* flags = WSP_flag + x * FLAG_PER_CLASS;
    unsigned* tmo = WSP_flag + 8 * FLAG_PER_CLASS;
    unsigned char* Yd8 = (unsigned char*)(p.ws + OFF_ARENA);
    __syncthreads();
    if (tid < 128) t_all[tid] = (int)WSP_ctr[CTR_ECNT + tid];
    unsigned* qhead = &WSP_ctr[(MODE == 2 ? CTR_Q12 : CTR_Q11) + x];
    if (tid == 0) t_q[0] = (int)atomicAdd(qhead, 1u);
    __syncthreads();
    if (tid < 16) {
        const int i = tid >> 1, h = tid & 1, e = x + 8 * i;
        t_cnt[tid] = t_all[h * 64 + e];
        int so = 0;
        for (int e2 = 0; e2 < e; ++e2) so += t_all[h * 64 + e2];
        t_soff[tid] = so;
    }
    __syncthreads();
    if (tid == 0) {
        int s = 0;
        for (int j = 0; j < 16; ++j) { t_pre[j] = s; s += (t_cnt[j] + 127) >> 7; }
        t_pre[16] = s;
    }
    __syncthreads();
    const int T_r = t_pre[16], T11 = T_r + 16, T_all = (MODE == 1) ? T11 : T11 + T_r * 4;
    for (;;) {
        __syncthreads();
        const int q = __builtin_amdgcn_readfirstlane(t_q[0]) + (MODE == 2 ? T11 : 0);
        __syncthreads();
        if (q >= T_all) break;
        if (tid == 0) t_q[0] = (int)atomicAdd(qhead, 1u);
        const bool is_down = q >= T11;
        const int u = is_down ? (q - T11) >> 2 : q;
        int nt = is_down ? (q - T11) & 3 : 0;
        int e, h, mt, c, rowbase;
        if (u < T_r) {
            int j = 0;
#pragma unroll
            for (int qq = 1; qq < 16; ++qq) j += (u >= t_pre[qq]) ? 1 : 0;
            e = x + 8 * (j >> 1); h = j & 1; mt = u - t_pre[j]; c = t_cnt[j];
            rowbase = h * HH_HALF_ROWS + t_soff[j];
        } else {
            const int ms = x * 16 + (u - T_r);
            e = 64; h = ms >> 6; mt = ms & 63; c = HALF_TOK;
            rowbase = h * HH_HALF_ROWS + 65536;
        }
        e = __builtin_amdgcn_readfirstlane(e); h = __builtin_amdgcn_readfirstlane(h); mt = __builtin_amdgcn_readfirstlane(mt);
        nt = __builtin_amdgcn_readfirstlane(nt); c = __builtin_amdgcn_readfirstlane(c); rowbase = __builtin_amdgcn_readfirstlane(rowbase);
        const int* el = WSP_elist + (size_t)(h * 64 + (e & 63)) * ELIST_CAP;
        if (!is_down) {
            const int t2 = TIDX, lane = t2 & 63, wid = t2 >> 6, wr = wid >> 1, wc = wid & 1, fr = lane & 15, fq = lane >> 4;
            const int sb = lane * 16, swz = sb ^ (((sb >> 9) & 1) << 5);
            const int r_in = swz >> 6, c_in = (swz & 63) >> 1;
            const int vrows = c - mt * 128 - wr * 64;
            const float* wsl = WSP_wsl + (size_t)(h * 64 + (e & 63)) * ELIST_CAP;
            const u16* aptr[2];
#pragma unroll
            for (int i = 0; i < 2; ++i) {
                int li = mt * 128 + (wid + 4 * i) * 16 + r_in;
                li = li < c ? li : c - 1;
                const int tok = (e < 64) ? (el[li] >> 3) : (h * HALF_TOK + li);
                aptr[i] = WSP_H2 + (size_t)tok * 1024 + c_in;
            }
            const u16* Bw = WSP_WguT + (size_t)e * 262144 + c_in;
            f32x4 acc[4][8];
            gemm_tile_w(32,
                [&](int i, int R, int C, int kt) { return (const void*)(aptr[i] + kt * 32); },
                [&](int i, int R, int C, int kt) {
                    const int f = (R >> 7) * 64 + (R & 15) * 4 + ((R >> 5) & 3), gu = (R >> 4) & 1;
                    return (const void*)(Bw + (size_t)((f >> 4) * 32 + gu * 16 + (f & 15)) * 1024 + kt * 32); }, acc);
            float wgt[4][4];
#pragma unroll
            for (int m = 0; m < 4; ++m)
#pragma unroll
                for (int j = 0; j < 4; ++j) {
                    const int li = mt * 128 + wr * 64 + m * 16 + fq * 4 + j;
                    float w = 1.f;
                    if (e < 64) w = (li < c) ? wsl[li] : 0.f;
                    wgt[m][j] = w;
                }
            u16* dbase = WSP_HHs + ((size_t)rowbase + mt * 128 + wr * 64) * 128 + wc * 64;
            wave_store_bf16_pk([&](int m, int n2, int j) { return siluf_(acc[m][2 * n2][j]) * acc[m][2 * n2 + 1][j] * wgt[m][j]; },
                               [&](int row) { return row < vrows ? dbase + (size_t)row * 128 : (u16*)nullptr; }, (const char*)WSP_HHs, (unsigned)((size_t)2 * HH_HALF_ROWS * 128 * 2));
            asm volatile("s_waitcnt vmcnt(0)" ::: "memory");
            __syncthreads();
            if (tid == 0) __hip_atomic_store(&flags[u], 1u, __ATOMIC_RELAXED, __HIP_MEMORY_SCOPE_AGENT);
        } else {
            const int t2 = TIDX, lane = t2 & 63, wid = t2 >> 6, wr = wid >> 1, wc = wid & 1, fr = lane & 15, fq = lane >> 4;
            const int sb = lane * 16, swz = sb ^ (((sb >> 9) & 1) << 5);
            const int r_in = swz >> 6, c_in = (swz & 63) >> 1;
            const int vrows = c - mt * 128 - wr * 64;
            if (MODE == 0 && tid == 0) {
                unsigned sp = 0;
                while (__hip_atomic_load(&flags[u], __ATOMIC_RELAXED, __HIP_MEMORY_SCOPE_AGENT) == 0u) {
                    __builtin_amdgcn_s_sleep(2);
                    if ((++sp & 255u) == 0u) {
                        if (__hip_atomic_load(tmo, __ATOMIC_RELAXED, __HIP_MEMORY_SCOPE_AGENT)) break;
                        if (sp > (1u << 20)) { atomicAdd(tmo, 1u); break; }
                    }
                }
            }
            __syncthreads();
            const u16* aptr[2];
#pragma unroll
            for (int i = 0; i < 2; ++i) {
                int li = mt * 128 + (wid + 4 * i) * 16 + r_in;
                li = li < c ? li : c - 1;
                aptr[i] = WSP_HHs + ((size_t)rowbase + li) * 128 + c_in;
            }
            const u16* Bw = WSP_WdT + ((size_t)e * 1024 + nt * 256) * 128 + c_in;
            int slot[8];
#pragma unroll
            for (int i = 0; i < 8; ++i) {
                int li = mt * 128 + wr * 64 + ((i * 64 + lane) >> 3);
                li = li < c ? li : c - 1;
                slot[i] = el[li];
            }
            f32x4 acc[4][8];
            gemm_tile_w<true>(4,
                [&](int i, int R, int C, int kt) { return (const void*)(aptr[i] + kt * 32); },
                [&](int i, int R, int C, int kt) { return (const void*)(Bw + (size_t)((R & 128) | ((R & 15) << 3) | ((R >> 4) & 7)) * 128 + kt * 32); }, acc);
            const int colo = nt * 256 + wc * 128;
            wave_store_fp8_f([&](int m, int n, int j) { return acc[m][n][j] * YD_SCALE; }, [&](int i, int row) {
                if (row >= vrows) return (unsigned char*)nullptr;
                const int s = slot[i];
                return Yd8 + ((size_t)(s >> 3) * 8 + (s & 7)) * 1024 + colo;
            });
        }
    }
}

#define P12_SLD 2064
template <bool DUMMY>
__device__ __forceinline__ void phase12b_t(const Params& p) {
    const int tid = TIDX, lane = tid & 63, wid = tid >> 6, fr = lane & 15, fq = lane >> 4;
    const unsigned char* Yd8 = (const unsigned char*)(p.ws + OFF_ARENA);
    const u16* Wb = WSP_WdT + (size_t)64 * 131072 + (size_t)(wid * 256 + fr) * 128 + fq * 8;
    for (int tile = blockIdx.x; tile < NLAT / 32; tile += gridDim.x) {
        const int tok0 = tile * 32;
        const int hh = tok0 >> 13;
        const u16* Ab = WSP_HHs + ((size_t)hh * HH_HALF_ROWS + 65536 + (tok0 & 8191) + fr) * 128 + fq * 8;
        __syncthreads();
        bf16x8 af[2][4];
#pragma unroll
        for (int m = 0; m < 2; ++m)
#pragma unroll
            for (int ks = 0; ks < 4; ++ks) af[m][ks] = *(const bf16x8*)(Ab + (size_t)m * 16 * 128 + ks * 32);
#pragma unroll 1
        for (int nb = 0; nb < 4; ++nb) {
            bf16x8 bfr[4][4];
#pragma unroll
            for (int n = 0; n < 4; ++n)
#pragma unroll
                for (int ks = 0; ks < 4; ++ks) bfr[n][ks] = *(const bf16x8*)(WSP_WdT + (size_t)64 * 131072 + (size_t)(wid * 256 + nb * 64 + fr * 4 + n) * 128 + fq * 8 + ks * 32);
#pragma unroll
            for (int m = 0; m < 2; ++m) {
                f32x4 d[4];
#pragma unroll
                for (int n = 0; n < 4; ++n) {
                    d[n] = (f32x4){0.f, 0.f, 0.f, 0.f};
#pragma unroll
                    for (int ks = 0; ks < 4; ++ks) d[n] = __builtin_amdgcn_mfma_f32_16x16x32_bf16(af[m][ks], bfr[n][ks], d[n], 0, 0, 0);
                }
                const int col = wid * 256 + nb * 64 + fr * 4;
#pragma unroll
                for (int j = 0; j < 4; ++j)
                    *(uint2*)(smem + (m * 16 + fq * 4 + j) * P12_SLD + col * 2) = make_uint2(pack2(d[0][j], d[1][j]), pack2(d[2][j], d[3][j]));
            }
        }
        __syncthreads();
        for (int rr = 0; rr < 8; ++rr) {
            const int row = wid * 8 + rr, tok = tok0 + row;
            const u16* xrow = X1B(tok) + lane * 16;
            float* orow = DUMMY ? (float*)(p.ws + OFF_HHS) + (size_t)(tok & 8191) * 1024 + lane * 16 : p.out + (size_t)tok * 1024 + lane * 16;
            const float* g2 = WSP_mod + (tok >> 11) * 6144 + 5120 + lane * 16;
            float s[16];
#pragma unroll
            for (int i = 0; i < 16; ++i) s[i] = 0.f;
            const unsigned char* yp = Yd8 + (size_t)tok * 8 * 1024 + lane * 16;
            uint4 yv[8];
#pragma unroll
            for (int k = 0; k < 8; ++k) { const u32x4 t = __builtin_nontemporal_load((const u32x4*)(yp + k * 1024)); yv[k] = make_uint4(t[0], t[1], t[2], t[3]); }
#pragma unroll
            for (int k = 0; k < 8; ++k) {
                const unsigned w[4] = {yv[k].x, yv[k].y, yv[k].z, yv[k].w};
#pragma unroll
                for (int i = 0; i < 4; ++i) {
                    const auto lo = __builtin_amdgcn_cvt_pk_f32_fp8((int)w[i], false);
                    const auto hi = __builtin_amdgcn_cvt_pk_f32_fp8((int)w[i], true);
                    s[4 * i] += lo[0]; s[4 * i + 1] += lo[1]; s[4 * i + 2] += hi[0]; s[4 * i + 3] += hi[1];
                }
            }
            const uint4 sa = *(const uint4*)(smem + row * P12_SLD + lane * 32), sbv = *(const uint4*)(smem + row * P12_SLD + lane * 32 + 16);
            const unsigned sw[8] = {sa.x, sa.y, sa.z, sa.w, sbv.x, sbv.y, sbv.z, sbv.w};
#pragma unroll
            for (int i = 0; i < 8; ++i) {
                s[2 * i] = s[2 * i] * (1.f / YD_SCALE) + bf2f((u16)(sw[i] & 0xffffu));
                s[2 * i + 1] = s[2 * i + 1] * (1.f / YD_SCALE) + bf2f((u16)(sw[i] >> 16));
            }
            float ss = 0.f;
            const uint4 xa = *(const uint4*)xrow, xb = *(const uint4*)(xrow + 8);
            const unsigned xw[8] = {xa.x, xa.y, xa.z, xa.w, xb.x, xb.y, xb.z, xb.w};
#pragma unroll
            for (int q = 0; q < 4; ++q) {
                const float4 xv = make_float4(__uint_as_float(xw[2 * q] << 16), __uint_as_float(xw[2 * q] & 0xffff0000u),
                                              __uint_as_float(xw[2 * q + 1] << 16), __uint_as_float(xw[2 * q + 1] & 0xffff0000u));
                const float4 gv = *(const float4*)(g2 + q * 4);
                s[4 * q] = xv.x + gv.x * s[4 * q]; s[4 * q + 1] = xv.y + gv.y * s[4 * q + 1];
                s[4 * q + 2] = xv.z + gv.z * s[4 * q + 2]; s[4 * q + 3] = xv.w + gv.w * s[4 * q + 3];
                ss += s[4 * q] * s[4 * q] + s[4 * q + 1] * s[4 * q + 1] + s[4 * q + 2] * s[4 * q + 2] + s[4 * q + 3] * s[4 * q + 3];
            }
            ss = wave_sum(ss);
            const float rs = rsqrtf(ss * (1.f / 1024.f) + EPS);
#pragma unroll
            for (int q = 0; q < 4; ++q) {
                const float4 g = *(const float4*)(p.norm_final + lane * 16 + q * 4);
                *(float4*)(orow + q * 4) = make_float4(s[4 * q] * rs * g.x, s[4 * q + 1] * rs * g.y, s[4 * q + 2] * rs * g.z, s[4 * q + 3] * rs * g.w);
            }
        }
    }
}

#define SMEM_TOTAL (73728 + 3072 + 64)

#if 1
__global__ void __launch_bounds__(NTHR, 2) k_mega(Params p) {
    volatile LAS unsigned* st = (volatile LAS unsigned*)(smem + SMEM_TOTAL - 16);
    if (TIDX == 0) { st[0] = 0u; st[1] = 0u; st[2] = 0u; st[3] = 0u; }
    __syncthreads();
    XcdBarrier bar = xcd_barrier_post(WSP_bar, st);
#define RUNP(N) do { phase##N(p); if (PROBE_DUP == N) phase##N(p); } while (0)
    RUNP(0);  xcd_barrier(bar);
    RUNP(1);  xcd_barrier(bar);
    RUNP(2);  xcd_barrier(bar);
    RUNP(3);  xcd_barrier(bar);
    RUNP(4);  xcd_barrier(bar);
    RUNP(5);  xcd_barrier(bar);
    RUNP(6);  xcd_barrier(bar);
    RUNP(8);  xcd_barrier(bar);
#if PROBE_DUP == 91
    phase9_t<1>(p); xcd_barrier(bar);
#endif
#if PROBE_DUP == 92
    phase9_t<2>(p); xcd_barrier(bar);
#endif
    phase9_t<0>(p); xcd_barrier(bar);
#if PROBE_DUP == 9
    if (blockIdx.x == 0 && TIDX < 128) WSP_ctr[CTR_ECNT + TIDX] = 0u;
    xcd_barrier(bar); phase9_t<0>(p); xcd_barrier(bar);
#endif
#ifndef MOE_FUSED
#define MOE_FUSED 1
#endif
#if MOE_FUSED
    phase11f<0>(p); xcd_barrier(bar);
#else
    phase11f<1>(p); xcd_barrier(bar);
    phase11f<2>(p); xcd_barrier(bar);
#endif
#if PROBE_DUP == 11
    if (blockIdx.x == 0 && TIDX < 8) WSP_ctr[CTR_Q11 + TIDX] = 0u;
    if (blockIdx.x == 1) for (int i = TIDX; i < 8 * FLAG_PER_CLASS; i += NTHR) WSP_flag[i] = 0u;
    xcd_barrier(bar); phase11f<0>(p); xcd_barrier(bar);
#endif
#if PROBE_DUP == 121
    phase12b_t<true>(p); xcd_barrier(bar);
#endif
    phase12b_t<false>(p);
}
#endif


extern "C" void kernel_launch(void* const* d_in, const int* in_sizes, int n_in,
                              void* d_out, int out_size, void* d_ws, size_t ws_size,
                              hipStream_t stream) {
    Params p{};
    const float** ip = (const float**)&p.x;
    for (int i = 0; i < 32; ++i) ip[i] = (const float*)d_in[i];
    p.out = (float*)d_out;
    p.ws = (char*)d_ws;
    if (OFF_END > ws_size) { fprintf(stderr, "workspace too small: need %zu have %zu\n", (size_t)OFF_END, ws_size); return; }

    static int grid = 0;
    if (!grid) {
        hipFuncSetAttribute((const void*)k_mega, hipFuncAttributeMaxDynamicSharedMemorySize, SMEM_TOTAL);
        int dev = 0, cus = 0, per_cu = 0;
        hipGetDevice(&dev);
        hipDeviceGetAttribute(&cus, hipDeviceAttributeMultiprocessorCount, dev);
        hipOccupancyMaxActiveBlocksPerMultiprocessor(&per_cu, (const void*)k_mega, NTHR, SMEM_TOTAL);
        if (per_cu < 1) per_cu = 1;
        grid = cus * (per_cu < 2 ? per_cu : 2);
    }
    hipMemsetAsync(p.ws + OFF_BAR, 0, ZERO_BYTES, stream);
    k_mega<<<grid, NTHR, SMEM_TOTAL, stream>>>(p);
}
```

```cpp
#include <hip/hip_runtime.h>
#include <hip/hip_bf16.h>
#include <stdint.h>
#include <stdio.h>

#ifndef MK_MULTI
#define MK_MULTI 0
#endif

typedef __attribute__((ext_vector_type(8))) short bf16x8;
typedef __attribute__((ext_vector_type(4))) short bf16x4;
typedef __attribute__((ext_vector_type(4))) float f32x4;
typedef unsigned short u16;
typedef __attribute__((ext_vector_type(4))) unsigned u32x4;

#ifndef PROBE_DUP
#define PROBE_DUP -1
#endif
#define NTHR 256
__device__ __forceinline__ int opaque_tid() { int t = (int)threadIdx.x; asm volatile("" : "+v"(t)); return t; }
#define TIDX opaque_tid()
#define LDS_BYTES 65536

#define D_MODEL 1024
#define BATCH 8
#define SEQ 2048
#define CTXL 256
#define NLAT (BATCH * SEQ)
#define NCTX (BATCH * CTXL)
#define NROWS (NLAT + NCTX)
#define INW 1280
#define NEXP 64
#define VT_LD (SEQ + CTXL)
#define NCHUNK_LAT 1024
#define NCHUNK_ALL 1152
#define EPS 1e-6f

#define XB_TMO      128
#define XB_XCNT(j)  (256  + 64 * (j))
#define XB_XSUB(j)  (1280 + 64 * (j))
#define XB_XGEN(j)  (2304 + 64 * (j))
#define XB_TOP      3328
#define XB_TOPGEN   3392
#define XCD_BAR_WORDS 3456
#define XB_SPIN_CAP (1u << 20)
#define LAS __attribute__((address_space(3)))

__device__ __forceinline__ unsigned xb_ld(unsigned* p)              { return __hip_atomic_load(p, __ATOMIC_RELAXED, __HIP_MEMORY_SCOPE_AGENT); }
__device__ __forceinline__ unsigned xb_add(unsigned* p, unsigned v) { return __hip_atomic_fetch_add(p, v, __ATOMIC_RELAXED, __HIP_MEMORY_SCOPE_AGENT); }
__device__ __forceinline__ unsigned xb_xcc_id() { return (unsigned)__builtin_amdgcn_s_getreg((3 << 11) | 20) & 0xFu; }
#define XB_SPIN(cond, bar) do { unsigned _sp = 0; while (cond) { __builtin_amdgcn_s_sleep(1); \
    if ((++_sp & 255u) == 0u) { if (xb_ld(&(bar)[XB_TMO])) break; if (_sp > XB_SPIN_CAP) { atomicAdd(&(bar)[XB_TMO], 1u); break; } } } } while (0)

struct XcdBarrier { unsigned* bar; unsigned x; volatile LAS unsigned* st; };

__device__ __forceinline__ XcdBarrier xcd_barrier_post(unsigned* bar, volatile LAS unsigned* st) {
    XcdBarrier b; b.bar = bar; b.x = xb_xcc_id(); b.st = st;
    if (TIDX == 0) (void)xb_add(&bar[XB_XCNT(b.x)], 1u);
    return b;
}
__device__ __forceinline__ void xcd_barrier_complete(unsigned* bar, unsigned x, unsigned& nloc, unsigned& nx) {
    const unsigned G = gridDim.x * gridDim.y * gridDim.z;
    unsigned sum, cnt, mine, sp = 0u;
    for (;;) {
        sum = 0u; cnt = 0u; mine = 0u;
#pragma unroll
        for (unsigned j = 0; j < 16; ++j) { const unsigned c = xb_ld(&bar[XB_XCNT(j)]); sum += c; cnt += (c > 0u) ? 1u : 0u; mine = (j == x) ? c : mine; }
        if (sum == G) break;
        __builtin_amdgcn_s_sleep(1);
        if ((++sp & 255u) == 0u) { if (xb_ld(&bar[XB_TMO])) break; if (sp > XB_SPIN_CAP) { atomicAdd(&bar[XB_TMO], 1u); break; } }
    }
    nloc = mine > 0u ? mine : 1u; nx = cnt > 0u ? cnt : 1u;
}
__device__ __forceinline__ void xcd_barrier(const XcdBarrier& b) {
    asm volatile("s_waitcnt vmcnt(0)" ::: "memory");
    __syncthreads();
    if (TIDX == 0) {
        unsigned* bar = b.bar;
        __builtin_amdgcn_s_waitcnt(0);
        unsigned nloc = b.st[0], nx = b.st[1];
        if (nloc == 0u) { xcd_barrier_complete(bar, b.x, nloc, nx); b.st[0] = nloc; b.st[1] = nx; }
        const unsigned old = xb_add(&bar[XB_XSUB(b.x)], 1u);
        const unsigned gen = old / nloc;
        if (old + 1u == (gen + 1u) * nloc) {
            __builtin_amdgcn_fence(__ATOMIC_RELEASE, "agent");
            asm volatile("s_waitcnt vmcnt(0)" ::: "memory");
            const unsigned og = xb_add(&bar[XB_TOP], 1u);
            const unsigned tg = og / nx;
            if (og + 1u == (tg + 1u) * nx) {
                xb_add(&bar[XB_XGEN(b.x)], 1u);
                asm volatile("buffer_inv sc1" ::: "memory");
            } else {
                asm volatile("buffer_inv sc1" ::: "memory");
                XB_SPIN(xb_ld(&bar[XB_TOP]) < (tg + 1u) * nx, bar);
                xb_add(&bar[XB_XGEN(b.x)], 1u);
            }
            asm volatile("s_waitcnt vmcnt(0)" ::: "memory");
        } else {
            asm volatile("buffer_inv sc1" ::: "memory");
            XB_SPIN(xb_ld(&bar[XB_XGEN(b.x)]) == gen, bar);
            asm volatile("s_waitcnt vmcnt(0)" ::: "memory");
        }
    }
    __syncthreads();
}

struct Params {
    const float *x, *c, *ctx, *c_ctx, *w_ada, *b_ada, *norm_mix, *norm_ffn, *w_in, *attn_sink,
        *a_re, *a_im, *log_dt, *b_re, *b_im, *c_re, *c_im, *ssm_d, *w_glu, *b_glu, *norm_attn_out, *norm_ssm_out,
        *w_out, *w_router, *router_bias, *w_gate_e, *w_up_e, *w_down_e, *w_gate_s, *w_up_s, *w_down_s, *norm_final;
    float* out;
    char* ws;
};

constexpr size_t A256(size_t v) { return (v + 255) & ~(size_t)255; }
constexpr size_t OFF_BAR   = 0;
constexpr size_t OFF_RSQ   = A256(OFF_BAR + XCD_BAR_WORDS * 4 + 1024);
#define FLAG_PER_CLASS 1280
constexpr size_t OFF_FLAG  = OFF_RSQ + (size_t)NLAT * 2 * 4;
constexpr size_t ZERO_BYTES = OFF_FLAG + (8 * FLAG_PER_CLASS + 64) * 4;
constexpr size_t OFF_MOD   = A256(ZERO_BYTES);
constexpr size_t OFF_ROPE  = A256(OFF_MOD + 9 * 6144 * 4);
constexpr size_t OFF_KBUF  = A256(OFF_ROPE + 64 * 16 * 8);
constexpr size_t OFF_ELIST = A256(OFF_KBUF + (size_t)32 * 2 * 4096 * 4);
constexpr size_t OFF_WSL   = A256(OFF_ELIST + (size_t)2 * 64 * 8192 * 4);
constexpr size_t OFF_WDT   = A256(OFF_WSL + (size_t)2 * 64 * 8192 * 4);
constexpr size_t OFF_HHS   = A256(OFF_WDT + (size_t)65 * 1024 * 128 * 2);
constexpr size_t OFF_WGUT  = A256(OFF_HHS + (size_t)2 * 74752 * 128 * 2);
constexpr size_t OFF_H2R   = A256(OFF_WGUT + (size_t)65 * 256 * 1024 * 2);
constexpr size_t OFF_ARENA = A256(OFF_H2R + (size_t)NLAT * 1024 * 2);
constexpr size_t OFF_TABS  = OFF_ARENA;
constexpr size_t OFF_TABY  = A256(OFF_TABS + (size_t)32 * 256 * 256 * 2);
constexpr size_t OFF_R1    = A256(OFF_TABY + (size_t)32 * 256 * 512 * 2);
constexpr size_t OFF_R2    = A256(OFF_R1 + (size_t)NROWS * 1024 * 2);
constexpr size_t OFF_R4    = A256(OFF_R2 + (size_t)NLAT * 1024 * 2);
constexpr size_t OFF_WINT  = A256(OFF_R4 + (size_t)NLAT * 512 * 2 * 2);
constexpr size_t OFF_WGLUT = A256(OFF_WINT + (size_t)1280 * 1024 * 2);
constexpr size_t OFF_WOUTT = A256(OFF_WGLUT + (size_t)512 * 512 * 2);
constexpr size_t OFF_WRT   = A256(OFF_WOUTT + (size_t)1024 * 1024 * 2);
constexpr size_t OFF_EARLY_END = A256(OFF_WRT + (size_t)128 * 1024 * 2);
constexpr size_t YD8_BYTES = (size_t)NLAT * 8 * 1024;
constexpr size_t OFF_END   = (OFF_EARLY_END > OFF_ARENA + YD8_BYTES) ? OFF_EARLY_END : A256(OFF_ARENA + YD8_BYTES);
static_assert(OFF_END <= (size_t)256 * 1024 * 1024, "workspace map must fit the guaranteed 256 MiB");
#define CTR_QS1 160
#define WSP_bar   ((unsigned*)(p.ws + OFF_BAR))
#define WSP_ctr   ((unsigned*)(p.ws + OFF_BAR) + XCD_BAR_WORDS)
#define WSP_rsqp  ((float*)(p.ws + OFF_ELIST))
#define WSP_flag  ((unsigned*)(p.ws + OFF_FLAG))
#define WSP_mod   ((float*)(p.ws + OFF_MOD))
#define WSP_rope  ((float2*)(p.ws + OFF_ROPE))
#define WSP_Kbuf  ((float*)(p.ws + OFF_KBUF))
#define WSP_elist ((int*)(p.ws + OFF_ELIST))
#define WSP_wsl   ((float*)(p.ws + OFF_WSL))
#define WSP_WinT  ((u16*)(p.ws + OFF_WINT))
#define WSP_WgluT ((u16*)(p.ws + OFF_WGLUT))
#define WSP_WoutT ((u16*)(p.ws + OFF_WOUTT))
#define WSP_WrT   ((u16*)(p.ws + OFF_WRT))
#define WSP_WdT   ((u16*)(p.ws + OFF_WDT))
#define WSP_HHs   ((u16*)(p.ws + OFF_HHS))
#define WSP_WguT  ((u16*)(p.ws + OFF_WGUT))
#define WSP_TabS  ((u16*)(p.ws + OFF_TABS))
#define WSP_TabY  ((u16*)(p.ws + OFF_TABY))
#define WSP_Hb    ((u16*)(p.ws + OFF_R1))
#define WSP_S     ((float*)(p.ws + OFF_R1))
#define WSP_H2    ((u16*)(p.ws + OFF_H2R))
#define WSP_Q     ((u16*)(p.ws + OFF_R2))
#define WSP_Kb    ((u16*)(p.ws + OFF_R2 + (size_t)NLAT * 512 * 2))
#define WSP_Vt    ((u16*)(p.ws + OFF_R2 + (size_t)NLAT * 512 * 2 + (size_t)NROWS * 128 * 2))
#define WSP_Y     ((u16*)(p.ws + OFF_R2))
#define WSP_SO    ((u16*)(p.ws + OFF_R2 + (size_t)NLAT * 512 * 2))
#define WSP_U     ((u16*)(p.ws + OFF_H2R))
#define WSP_AO    ((u16*)(p.ws + OFF_R4))
#define WSP_Hin   ((u16*)(p.ws + OFF_R4 + (size_t)NLAT * 512 * 2))
#define X1B(tok)  ((u16*)((char*)p.out + (size_t)(tok) * 4096 + 2048))

extern __shared__ __attribute__((aligned(16))) char smem[];

typedef __bf16 bf2_t __attribute__((ext_vector_type(2)));
typedef float f2_t __attribute__((ext_vector_type(2)));
__device__ __forceinline__ unsigned pack2(float a, float b) {
    const f2_t v = {a, b};
    return __builtin_bit_cast(unsigned, __builtin_convertvector(v, bf2_t));
}
__device__ __forceinline__ u16 f2bf(float f) { return (u16)(pack2(f, 0.f) & 0xffffu); }
__device__ __forceinline__ float bf2f(u16 h) { return __uint_as_float(((unsigned)h) << 16); }
__device__ __forceinline__ void glds16(const void* g, void* l) {
    __builtin_amdgcn_global_load_lds((const unsigned*)g, (unsigned*)l, 16, 0, 0);
}
__device__ __forceinline__ void glds16_sc1(const void* g, void* l) {
    __builtin_amdgcn_global_load_lds((const unsigned*)g, (unsigned*)l, 16, 0, 16);
}
__device__ __forceinline__ int lds_byte(int r, int c) {
    int st = (r >> 4) * 2 + (c >> 5), rr = r & 15, cc = c & 31, ob = rr * 64 + cc * 2;
    return st * 1024 + (ob ^ (((ob >> 9) & 1) << 5));
}
template <int CTRL> __device__ __forceinline__ float dppf(float v) {
    return __int_as_float(__builtin_amdgcn_update_dpp(0, __float_as_int(v), CTRL, 0xf, 0xf, true));
}
__device__ __forceinline__ float sum_x16(float v) {
    const unsigned u = __float_as_uint(v);
    const auto r = __builtin_amdgcn_permlane16_swap(u, u, false, false);
    return __uint_as_float(r[0]) + __uint_as_float(r[1]);
}
__device__ __forceinline__ float sum_x32(float v) {
    const unsigned u = __float_as_uint(v);
    const auto r = __builtin_amdgcn_permlane32_swap(u, u, false, false);
    return __uint_as_float(r[0]) + __uint_as_float(r[1]);
}
__device__ __forceinline__ float max_x16(float v) {
    const unsigned u = __float_as_uint(v);
    const auto r = __builtin_amdgcn_permlane16_swap(u, u, false, false);
    return fmaxf(__uint_as_float(r[0]), __uint_as_float(r[1]));
}
__device__ __forceinline__ float max_x32(float v) {
    const unsigned u = __float_as_uint(v);
    const auto r = __builtin_amdgcn_permlane32_swap(u, u, false, false);
    return fmaxf(__uint_as_float(r[0]), __uint_as_float(r[1]));
}
__device__ __forceinline__ float sum16(float v) {
    v += dppf<0xB1>(v);
    v += dppf<0x4E>(v);
    v += dppf<0x141>(v);
    v += dppf<0x140>(v);
    return v;
}
__device__ __forceinline__ float wave_sum(float v) { return sum_x32(sum_x16(sum16(v))); }
template <int CTRL> __device__ __forceinline__ float dpp_f(float v) {
    return __int_as_float(__builtin_amdgcn_update_dpp(0, __float_as_int(v), CTRL, 0xf, 0xf, true));
}
__device__ __forceinline__ float max8(float v) {
    v = fmaxf(v, dpp_f<0xB1>(v));
    v = fmaxf(v, dpp_f<0x4E>(v));
    v = fmaxf(v, dpp_f<0x141>(v));
    return v;
}
__device__ __forceinline__ float sigmoidf_(float x) { return __builtin_amdgcn_rcpf(1.f + __expf(-x)); }
__device__ __forceinline__ float siluf_(float x) { return x * __builtin_amdgcn_rcpf(1.f + __expf(-x)); }
__device__ __forceinline__ float gelu_tanh(float x) {
    float u = 0.7978845608028654f * (x + 0.044715f * x * x * x);
    return x * __builtin_amdgcn_rcpf(1.f + __expf(-2.f * u));
}

template <class FA, class FB>
__device__ __forceinline__ void gemm_tile(int nkt, FA fa, FB fb, f32x4 (&acc)[4][4]) {
    const int tid = TIDX, lane = tid & 63, wid = tid >> 6, wr = wid >> 1, wc = wid & 1, fr = lane & 15, fq = lane >> 4;
    const int sb = lane * 16, swz = sb ^ (((sb >> 9) & 1) << 5);
    const int r_in = swz >> 6, c_in = (swz & 63) >> 1;
#pragma unroll
    for (int m = 0; m < 4; ++m)
#pragma unroll
        for (int n = 0; n < 4; ++n) acc[m][n] = (f32x4){0.f, 0.f, 0.f, 0.f};
    __syncthreads();
    auto stage = [&](int kt, int s) {
        char* sa = smem + s * 32768;
        char* sbm = sa + 16384;
#pragma unroll
        for (int i = 0; i < 4; ++i) {
            const int st = wid + 4 * i, R = (st >> 1) * 16 + r_in, C = (st & 1) * 32 + c_in;
            glds16(fa(R, C, kt), sa + tid * 16 + i * 4096);
            glds16(fb(R, C, kt), sbm + tid * 16 + i * 4096);
        }
    };
    stage(0, 0);
    for (int kt = 0; kt < nkt; ++kt) {
        asm volatile("s_waitcnt vmcnt(0)" ::: "memory");
        __syncthreads();
        if (kt + 1 < nkt) stage(kt + 1, (kt + 1) & 1);
        const char* sa = smem + (kt & 1) * 32768;
        const char* sbm = sa + 16384;
#pragma unroll
        for (int ks = 0; ks < 2; ++ks) {
            bf16x8 a[4], b[4];
#pragma unroll
            for (int m = 0; m < 4; ++m) a[m] = *(const bf16x8*)(sa + lds_byte(wr * 64 + m * 16 + fr, ks * 32 + fq * 8));
#pragma unroll
            for (int n = 0; n < 4; ++n) b[n] = *(const bf16x8*)(sbm + lds_byte(wc * 64 + n * 16 + fr, ks * 32 + fq * 8));
            __builtin_amdgcn_s_setprio(1);
#pragma unroll
            for (int m = 0; m < 4; ++m)
#pragma unroll
                for (int n = 0; n < 4; ++n) acc[m][n] = __builtin_amdgcn_mfma_f32_16x16x32_bf16(a[m], b[n], acc[m][n], 0, 0, 0);
            __builtin_amdgcn_s_setprio(0);
        }
    }
    __syncthreads();
}

__device__ __forceinline__ int lds32(int r, int c) {
    const int rr = r & 15;
    return (r >> 4) * 1024 + ((rr * 64 + c * 2) ^ (((rr >> 3) & 1) << 5));
}
struct NoHook { __device__ __forceinline__ void operator()(int) const {} };
template <bool A_SC1 = false, class FA, class FB, class HK = NoHook>
__device__ __forceinline__ void gemm_tile_w(int nkt, FA fa, FB fb, f32x4 (&acc)[4][8], HK hook = HK()) {
    constexpr bool ZERO = true;
    const int tid = TIDX, lane = tid & 63, wid = tid >> 6, wr = wid >> 1, wc = wid & 1, fr = lane & 15, fq = lane >> 4;
    const int sb = lane * 16, swz = sb ^ (((sb >> 9) & 1) << 5);
    const int r_in = swz >> 6, c_in = (swz & 63) >> 1;
    if (ZERO) {
#pragma unroll
        for (int m = 0; m < 4; ++m)
#pragma unroll
            for (int n = 0; n < 8; ++n) acc[m][n] = (f32x4){0.f, 0.f, 0.f, 0.f};
    }
    __syncthreads();
    auto stage = [&](int kt, int s) {
        char* sa = smem + s * 24576;
#pragma unroll
        for (int i = 0; i < 2; ++i) { if (A_SC1) glds16_sc1(fa(i, (wid + 4 * i) * 16 + r_in, c_in, kt), sa + tid * 16 + i * 4096); else glds16(fa(i, (wid + 4 * i) * 16 + r_in, c_in, kt), sa + tid * 16 + i * 4096); }
#pragma unroll
        for (int i = 0; i < 4; ++i) glds16(fb(i, (wid + 4 * i) * 16 + r_in, c_in, kt), sa + 8192 + tid * 16 + i * 4096);
    };
    stage(0, 0);
    if (nkt > 1) stage(1, 1);
    int s_cur = 0, s_nxt = 2;
    for (int kt = 0; kt < nkt; ++kt) {
        hook(kt);
        if (kt + 1 < nkt) asm volatile("s_waitcnt vmcnt(6) lgkmcnt(0)\n\ts_barrier" ::: "memory");
        else asm volatile("s_waitcnt vmcnt(0) lgkmcnt(0)\n\ts_barrier" ::: "memory");
        if (kt + 2 < nkt) stage(kt + 2, s_nxt);
        const char* sa = smem + s_cur * 24576;
        bf16x8 a[4];
#pragma unroll
        for (int m = 0; m < 4; ++m) a[m] = *(const bf16x8*)(sa + lds32(wr * 64 + m * 16 + fr, fq * 8));
#pragma unroll
        for (int nh = 0; nh < 2; ++nh) {
            bf16x8 b[4];
#pragma unroll
            for (int n = 0; n < 4; ++n) b[n] = *(const bf16x8*)(sa + 8192 + lds32(wc * 128 + (nh * 4 + n) * 16 + fr, fq * 8));
            __builtin_amdgcn_s_setprio(1);
#pragma unroll
            for (int m = 0; m < 4; ++m)
#pragma unroll
                for (int n = 0; n < 4; ++n) acc[m][nh * 4 + n] = __builtin_amdgcn_mfma_f32_16x16x32_bf16(a[m], b[n], acc[m][nh * 4 + n], 0, 0, 0);
            __builtin_amdgcn_s_setprio(0);
        }
        s_cur = (s_cur == 2) ? 0 : s_cur + 1;
        s_nxt = (s_nxt == 2) ? 0 : s_nxt + 1;
    }
    __syncthreads();
}

template <class FA, class FB>
__device__ __forceinline__ void gemm_tile_n(int nkt, FA fa, FB fb, f32x4 (&acc)[4][4]) {
    const int tid = TIDX, lane = tid & 63, wid = tid >> 6, wr = wid >> 1, wc = wid & 1, fr = lane & 15, fq = lane >> 4;
    const int sb = lane * 16, swz = sb ^ (((sb >> 9) & 1) << 5);
    const int r_in = swz >> 6, c_in = (swz & 63) >> 1;
#pragma unroll
    for (int m = 0; m < 4; ++m)
#pragma unroll
        for (int n = 0; n < 4; ++n) acc[m][n] = (f32x4){0.f, 0.f, 0.f, 0.f};
    __syncthreads();
    auto stage = [&](int kt, int s) {
        char* sa = smem + s * 16384;
#pragma unroll
        for (int i = 0; i < 2; ++i) glds16(fa((wid + 4 * i) * 16 + r_in, c_in, kt), sa + tid * 16 + i * 4096);
#pragma unroll
        for (int i = 0; i < 2; ++i) glds16(fb((wid + 4 * i) * 16 + r_in, c_in, kt), sa + 8192 + tid * 16 + i * 4096);
    };
    stage(0, 0);
    if (nkt > 1) stage(1, 1);
    if (nkt > 2) stage(2, 2);
    for (int kt = 0; kt < nkt; ++kt) {
        if (kt + 2 < nkt) asm volatile("s_waitcnt vmcnt(8) lgkmcnt(0)\n\ts_barrier" ::: "memory");
        else if (kt + 1 < nkt) asm volatile("s_waitcnt vmcnt(4) lgkmcnt(0)\n\ts_barrier" ::: "memory");
        else asm volatile("s_waitcnt vmcnt(0) lgkmcnt(0)\n\ts_barrier" ::: "memory");
        if (kt + 3 < nkt) stage(kt + 3, (kt + 3) & 3);
        const char* sa = smem + (kt & 3) * 16384;
        bf16x8 a[4], b[4];
#pragma unroll
        for (int m = 0; m < 4; ++m) a[m] = *(const bf16x8*)(sa + lds32(wr * 64 + m * 16 + fr, fq * 8));
#pragma unroll
        for (int n = 0; n < 4; ++n) b[n] = *(const bf16x8*)(sa + 8192 + lds32(wc * 64 + n * 16 + fr, fq * 8));
        __builtin_amdgcn_s_setprio(1);
#pragma unroll
        for (int m = 0; m < 4; ++m)
#pragma unroll
            for (int n = 0; n < 4; ++n) acc[m][n] = __builtin_amdgcn_mfma_f32_16x16x32_bf16(a[m], b[n], acc[m][n], 0, 0, 0);
        __builtin_amdgcn_s_setprio(0);
    }
    __syncthreads();
}

template <class FV, class FD>
__device__ __forceinline__ void wave_store_bf16_f(FV val, FD dst, bool write_through = false, const char* wt_base = nullptr, unsigned wt_bytes = 0) {
    const __amdgpu_buffer_rsrc_t wt_rsrc = __builtin_amdgcn_make_buffer_rsrc((void*)wt_base, 0, (int)wt_bytes, 0x00020000);
    const int lane = TIDX & 63, wid = TIDX >> 6, fr = lane & 15, fq = lane >> 4;
    char* base = smem + wid * 9216;
#pragma unroll
    for (int m = 0; m < 4; ++m)
#pragma unroll
        for (int n = 0; n < 4; ++n)
#pragma unroll
            for (int j = 0; j < 4; ++j)
                *(u16*)(base + (m * 16 + fq * 4 + j) * 144 + (n * 16 + fr) * 2) = f2bf(val(m, n, j));
    asm volatile("s_waitcnt lgkmcnt(0)" ::: "memory");
    __builtin_amdgcn_wave_barrier();
#pragma unroll
    for (int i = 0; i < 8; ++i) {
        const int id = i * 64 + lane, row = id >> 3, ch = id & 7;
        const uint4 d = *(const uint4*)(base + row * 144 + ch * 16);
        u16* p = dst(row);
        if (p) {
            if (write_through) {
                const u32x4 dv = {d.x, d.y, d.z, d.w};
                __builtin_amdgcn_raw_buffer_store_b128(dv, wt_rsrc, (int)((const char*)(p + ch * 8) - wt_base), 0, 16);
            } else *(uint4*)(p + ch * 8) = d;
        }
    }
    asm volatile("s_waitcnt lgkmcnt(0)" ::: "memory");
    __builtin_amdgcn_wave_barrier();
}

template <class FV, class FD>
__device__ __forceinline__ void wave_store_bf16_pk(FV val, FD dst, const char* wt_base, unsigned wt_bytes) {
    const __amdgpu_buffer_rsrc_t wt_rsrc = __builtin_amdgcn_make_buffer_rsrc((void*)wt_base, 0, (int)wt_bytes, 0x00020000);
    const int lane = TIDX & 63, wid = TIDX >> 6, fr = lane & 15, fq = lane >> 4;
    char* base = smem + wid * 9216;
#pragma unroll
    for (int m = 0; m < 4; ++m)
#pragma unroll
        for (int j = 0; j < 4; ++j)
            *(uint2*)(base + (m * 16 + fq * 4 + j) * 144 + fr * 8) = make_uint2(pack2(val(m, 0, j), val(m, 1, j)), pack2(val(m, 2, j), val(m, 3, j)));
    asm volatile("s_waitcnt lgkmcnt(0)" ::: "memory");
    __builtin_amdgcn_wave_barrier();
#pragma unroll
    for (int i = 0; i < 8; ++i) {
        const int id = i * 64 + lane, row = id >> 3, ch = id & 7;
        const uint4 d = *(const uint4*)(base + row * 144 + ch * 16);
        u16* p = dst(row);
        if (p) {
            const u32x4 dv = {d.x, d.y, d.z, d.w};
            __builtin_amdgcn_raw_buffer_store_b128(dv, wt_rsrc, (int)((const char*)(p + ch * 8) - wt_base), 0, 16);
        }
    }
    asm volatile("s_waitcnt lgkmcnt(0)" ::: "memory");
    __builtin_amdgcn_wave_barrier();
}
template <class FD2>
__device__ __forceinline__ void wave_store_bf16_rc(const float (&v)[4][4][4], FD2 dst2) {
    const int lane = TIDX & 63, wid = TIDX >> 6, fr = lane & 15, fq = lane >> 4;
    char* base = smem + wid * 9216;
#pragma unroll
    for (int m = 0; m < 4; ++m)
#pragma unroll
        for (int n = 0; n < 4; ++n)
#pragma unroll
            for (int j = 0; j < 4; ++j)
                *(u16*)(base + (m * 16 + fq * 4 + j) * 144 + (n * 16 + fr) * 2) = f2bf(v[m][n][j]);
    asm volatile("s_waitcnt lgkmcnt(0)" ::: "memory");
    __builtin_amdgcn_wave_barrier();
#pragma unroll
    for (int i = 0; i < 8; ++i) {
        const int id = i * 64 + lane, row = id >> 3, ch = id & 7;
        *(uint4*)dst2(row, ch) = *(const uint4*)(base + row * 144 + ch * 16);
    }
    asm volatile("s_waitcnt lgkmcnt(0)" ::: "memory");
    __builtin_amdgcn_wave_barrier();
}
template <class FV, class FD2>
__device__ __forceinline__ void wave_store_bf16_pk_rc(FV val, FD2 dst2, const char* wt_base, unsigned wt_bytes) {
    const __amdgpu_buffer_rsrc_t wt_rsrc = __builtin_amdgcn_make_buffer_rsrc((void*)wt_base, 0, (int)wt_bytes, 0x00020000);
    const int lane = TIDX & 63, wid = TIDX >> 6, fr = lane & 15, fq = lane >> 4;
    char* base = smem + wid * 9216;
#pragma unroll
    for (int m = 0; m < 4; ++m)
#pragma unroll
        for (int j = 0; j < 4; ++j)
            *(uint2*)(base + (m * 16 + fq * 4 + j) * 144 + fr * 8) = make_uint2(pack2(val(m, 0, j), val(m, 1, j)), pack2(val(m, 2, j), val(m, 3, j)));
    asm volatile("s_waitcnt lgkmcnt(0)" ::: "memory");
    __builtin_amdgcn_wave_barrier();
#pragma unroll
    for (int i = 0; i < 8; ++i) {
        const int id = i * 64 + lane, row = id >> 3, ch = id & 7;
        const uint4 d = *(const uint4*)(base + row * 144 + ch * 16);
        u16* p = dst2(row, ch);
        if (p) {
            const u32x4 dv = {d.x, d.y, d.z, d.w};
            __builtin_amdgcn_raw_buffer_store_b128(dv, wt_rsrc, (int)((const char*)p - wt_base), 0, 16);
        }
    }
    asm volatile("s_waitcnt lgkmcnt(0)" ::: "memory");
    __builtin_amdgcn_wave_barrier();
}
template <class FD>
__device__ __forceinline__ void wave_store_bf16(const float (&v)[4][4][4], FD dst) {
    wave_store_bf16_f([&](int m, int n, int j) { return v[m][n][j]; }, dst);
}

struct ConvD { const float* src; u16* dst; int ld, ldd, k0, n0, mode, zr, kmaj; };
__device__ __forceinline__ void conv_load(const Params& p, const ConvD& d, float (&v)[16]) {
    const int tid = TIDX;
#pragma unroll
    for (int i = 0; i < 16; ++i) v[i] = d.src[(size_t)(d.k0 + i * 4 + (tid >> 6)) * d.ld + d.n0 + (tid & 63)];
    if (d.zr == 2) {
#pragma unroll
        for (int i = 0; i < 16; ++i) {
            const int k = d.k0 + i * 4 + (tid >> 6);
            v[i] *= (k < 512) ? p.norm_attn_out[k] : p.norm_ssm_out[k - 512];
        }
    }
}
__device__ __forceinline__ void conv_store(const Params& p, const ConvD& d, const float (&v)[16]) {
    float* t = (float*)smem;
    const int tid = TIDX;
    __syncthreads();
#pragma unroll
    for (int i = 0; i < 16; ++i) t[(i * 4 + (tid >> 6)) * 65 + (tid & 63)] = v[i];
    __syncthreads();
    const int n = tid >> 2, kq = tid & 3;
    unsigned w[8];
#pragma unroll
    for (int i = 0; i < 8; ++i) w[i] = pack2(t[(kq * 16 + 2 * i) * 65 + n], t[(kq * 16 + 2 * i + 1) * 65 + n]);
    const int gn = d.n0 + n;
    int row = gn;
    if (d.mode == 1 || d.mode == 2) row = (gn >> 6) * 128 + (gn & 3) * 32 + (d.mode - 1) * 16 + ((gn & 63) >> 2);
    else if (d.mode == 3) row = n;
    else if (d.mode == 4) row = (gn & ~255) | (gn & 128) | ((gn & 7) << 4) | ((gn >> 3) & 15);
    uint4* o = (uint4*)(d.dst + (size_t)row * d.ldd + d.k0 + kq * 16);
    if (d.kmaj) { const int k = d.k0 + kq * 16; o = (uint4*)(d.dst + ((size_t)(k >> 5) * d.kmaj + row) * 32 + (k & 31)); }
    o[0] = make_uint4(w[0], w[1], w[2], w[3]);
    o[1] = make_uint4(w[4], w[5], w[6], w[7]);
    if (d.zr == 1) {
        uint4* z = (uint4*)(WSP_WrT + (size_t)(64 + n) * 1024 + d.k0 + kq * 16);
        z[0] = make_uint4(0, 0, 0, 0); z[1] = make_uint4(0, 0, 0, 0);
    }
}

__device__ __forceinline__ float sum8(float v) {
    v += dppf<0xB1>(v);
    v += dppf<0x4E>(v);
    v += dppf<0x141>(v);
    return v;
}
__device__ __forceinline__ void ada_item(const Params& p, int item) {
    float* sc = (float*)smem;
    float* red = sc + 1024 * 12;
    const int tid = TIDX;
    const int lane = tid & 63, wid = tid >> 6, cl = lane >> 3, kg = wid * 8 + (lane & 7);
    const float* wb = p.w_ada + item * 32;
    const unsigned woff = (unsigned)(kg * 6144 + cl * 4);
    float4 w[16];
#pragma unroll
    for (int i = 0; i < 16; ++i) w[i] = *(const float4*)(wb + (size_t)i * 32 * 6144 + woff);
    float cv[36];
#pragma unroll
    for (int j = 0; j < 36; ++j) cv[j] = (j < 32) ? p.c[(j >> 2) * 1024 + (j & 3) * 256 + tid] : p.c_ctx[(j & 3) * 256 + tid];
    __syncthreads();
#pragma unroll
    for (int j = 0; j < 36; ++j) sc[((j & 3) * 256 + tid) * 12 + (j >> 2)] = siluf_(cv[j]);
    __syncthreads();
    float acc[9][4];
#pragma unroll
    for (int r = 0; r < 9; ++r)
#pragma unroll
        for (int c = 0; c < 4; ++c) acc[r][c] = 0.f;
#pragma unroll 1
    for (int h = 0; h < 2; ++h) {
        if (h == 1) {
            unsigned wo = woff;
            asm volatile("" : "+v"(wo));
#pragma unroll
            for (int i = 0; i < 16; ++i) w[i] = *(const float4*)(wb + (size_t)(16 + i) * 32 * 6144 + wo);
        }
#pragma unroll
        for (int i = 0; i < 16; ++i) {
            const int k = kg + 32 * (h * 16 + i);
            const float4 s0 = *(const float4*)(sc + k * 12), s1 = *(const float4*)(sc + k * 12 + 4);
            const float s8 = sc[k * 12 + 8];
            const float sv[9] = {s0.x, s0.y, s0.z, s0.w, s1.x, s1.y, s1.z, s1.w, s8};
#pragma unroll
            for (int r = 0; r < 9; ++r) { acc[r][0] += sv[r] * w[i].x; acc[r][1] += sv[r] * w[i].y; acc[r][2] += sv[r] * w[i].z; acc[r][3] += sv[r] * w[i].w; }
        }
    }
#pragma unroll
    for (int r = 0; r < 9; ++r)
#pragma unroll
        for (int c = 0; c < 4; ++c) {
            const float v = sum8(acc[r][c]);
            if ((lane & 7) == 0) red[(wid * 36 + r * 4 + c) * 8 + cl] = v;
        }
    __syncthreads();
    for (int i = tid; i < 9 * 32; i += NTHR) {
        const int r = i >> 5, l = i & 31, q = (r * 4 + (l & 3)) * 8 + (l >> 2);
        const float s = red[q] + red[36 * 8 + q] + red[2 * 36 * 8 + q] + red[3 * 36 * 8 + q];
        WSP_mod[r * 6144 + item * 32 + l] = s + p.b_ada[item * 32 + l];
    }
}

__device__ __forceinline__ void rope_item(const Params& p) {
    for (int i = TIDX; i < 64 * 16; i += NTHR) {
        const int pos = i >> 4, k = i & 15;
        const float inv = exp2f(-(float)k * (13.287712379549449f / 16.f));
        float s, c;
        sincosf((float)pos * inv, &s, &c);
        WSP_rope[i] = make_float2(c, s);
    }
}

__device__ __forceinline__ void ssm_table_item(const Params& p, int g, int dir, int half) {
    float* pw = (float*)smem;
    float* Bb = pw + 17 * 64 * 2;
    float* Cc = Bb + 64 * 16 * 2;
    const int tid = TIDX;
    u16* tabS = WSP_TabS + (size_t)g * 256 * 256;
    u16* tabY = WSP_TabY + (size_t)g * 256 * 512;
    float* Kf = WSP_Kbuf + (size_t)(g * 2 + dir) * 4096;
    __syncthreads();
    {
        const int pidx = dir * 32 + g;
        const float dt = __expf(p.log_dt[pidx]);
        const float are0 = p.a_re[pidx * 64 + (tid & 63)], aim0 = p.a_im[pidx * 64 + (tid & 63)];
        float are4[4], aim4[4], br4[4], bi4[4], cr4[4], ci4[4];
#pragma unroll
        for (int j = 0; j < 4; ++j) {
            const int i = tid + j * NTHR, n = i >> 4;
            are4[j] = p.a_re[pidx * 64 + n]; aim4[j] = p.a_im[pidx * 64 + n];
            br4[j] = p.b_re[(size_t)pidx * 1024 + i]; bi4[j] = p.b_im[(size_t)pidx * 1024 + i];
            cr4[j] = p.c_re[(size_t)pidx * 1024 + i]; ci4[j] = p.c_im[(size_t)pidx * 1024 + i];
        }
        for (int i = tid; i < 17 * 64; i += NTHR) {
            const int tau = i >> 6, n = i & 63;
            const float are = are0, aim = aim0;
            const float mag = __expf((float)tau * dt * are);
            float rev = (float)tau * (dt * aim * 0.15915494309189535f);
            rev -= rintf(rev);
            pw[i * 2] = mag * __builtin_amdgcn_cosf(rev);
            pw[i * 2 + 1] = mag * __builtin_amdgcn_sinf(rev);
        }
        __syncthreads();
#pragma unroll
        for (int j = 0; j < 4; ++j) {
            const int i = tid + j * NTHR, n = i >> 4;
            const float are = are4[j], aim = aim4[j];
            const float abr = pw[(64 + n) * 2], abi = pw[(64 + n) * 2 + 1];
            const float den = are * are + aim * aim, nre = abr - 1.f;
            const float cre = (nre * are + abi * aim) / den, cim = (abi * are - nre * aim) / den;
            const float br = br4[j], bi = bi4[j];
            Bb[i * 2] = cre * br - cim * bi;
            Bb[i * 2 + 1] = cre * bi + cim * br;
            Cc[i * 2] = cr4[j];
            Cc[i * 2 + 1] = ci4[j];
        }
        __syncthreads();
        {
            const int qh = tid >> 7, tau = half * 8 + ((tid >> 4) & 7), pp = tid & 15;
            float s[8];
#pragma unroll
            for (int q = 0; q < 8; ++q) s[q] = 0.f;
            for (int n = 0; n < 64; ++n) {
                const float2 cv = *(const float2*)&Cc[(pp * 64 + n) * 2];
                const float2 wv = *(const float2*)&pw[(tau * 64 + n) * 2];
                const float zr = cv.x * wv.x - cv.y * wv.y, zi = cv.x * wv.y + cv.y * wv.x;
#pragma unroll
                for (int q = 0; q < 4; ++q) {
                    const float4 bv = *(const float4*)&Bb[(n * 16 + qh * 8 + 2 * q) * 2];
                    s[2 * q] += zr * bv.x - zi * bv.y;
                    s[2 * q + 1] += zr * bv.z - zi * bv.w;
                }
            }
#pragma unroll
            for (int q = 0; q < 2; ++q)
                *(float4*)(Kf + tau * 256 + pp * 16 + qh * 8 + q * 4) = make_float4(s[4 * q], s[4 * q + 1], s[4 * q + 2], s[4 * q + 3]);
        }
        for (int id = half * 2048 + tid; id < half * 2048 + 2048; id += NTHR) {
            const int rr = id >> 5, ch = id & 31, cpart = rr >> 6, n = rr & 63, s_ = ch >> 1, q0 = (ch & 1) * 8;
            const int e = dir == 0 ? 15 - s_ : s_;
            const float wr_ = pw[(e * 64 + n) * 2], wi_ = pw[(e * 64 + n) * 2 + 1];
            unsigned w[4];
#pragma unroll
            for (int i = 0; i < 4; ++i) {
                float v[2];
#pragma unroll
                for (int h = 0; h < 2; ++h) {
                    const float br = Bb[(n * 16 + q0 + 2 * i + h) * 2], bi = Bb[(n * 16 + q0 + 2 * i + h) * 2 + 1];
                    v[h] = cpart == 0 ? (wr_ * br - wi_ * bi) : (wr_ * bi + wi_ * br);
                }
                w[i] = pack2(v[0], v[1]);
            }
            *(uint4*)(tabS + (size_t)(dir * 128 + rr) * 256 + s_ * 16 + q0) = make_uint4(w[0], w[1], w[2], w[3]);
        }
        for (int id = half * 2048 + tid; id < half * 2048 + 2048; id += NTHR) {
            const int m = id >> 4, ch = id & 15, t = m >> 4, pp = m & 15, cpart = ch >> 3, n0 = (ch & 7) * 8;
            const int e = dir == 0 ? t + 1 : 16 - t;
            unsigned w[4];
#pragma unroll
            for (int i = 0; i < 4; ++i) {
                float v[2];
#pragma unroll
                for (int h = 0; h < 2; ++h) {
                    const int n = n0 + 2 * i + h;
                    const float cr = Cc[(pp * 64 + n) * 2], ci = Cc[(pp * 64 + n) * 2 + 1];
                    const float wr_ = pw[(e * 64 + n) * 2], wi_ = pw[(e * 64 + n) * 2 + 1];
                    v[h] = cpart == 0 ? (cr * wr_ - ci * wi_) : -(cr * wi_ + ci * wr_);
                }
                w[i] = pack2(v[0], v[1]);
            }
            *(uint4*)(tabY + (size_t)m * 512 + 256 + dir * 128 + cpart * 64 + n0) = make_uint4(w[0], w[1], w[2], w[3]);
        }
    }
}

__device__ __forceinline__ void ssm_toeplitz_item(const Params& p, int g) {
    float* Kf = (float*)smem;
    const int tid = TIDX;
    u16* tabY = WSP_TabY + (size_t)g * 256 * 512;
    const float dsk0 = p.ssm_d[g * 16 + ((tid >> 5) & 15)], dsk1 = p.ssm_d[g * 16 + (((tid >> 5) + 8) & 15)];
    __syncthreads();
    for (int i = tid; i < 2048; i += NTHR) ((float4*)Kf)[i] = ((const float4*)(WSP_Kbuf + (size_t)g * 8192))[i];
    __syncthreads();
#pragma unroll 2
    for (int it = 0; it < 32; ++it) {
        const int id = it * NTHR + tid;
        const int m = id >> 5, ch = id & 31, t = m >> 4, pp = m & 15, s_ = ch >> 1, q0 = (ch & 1) * 8;
        const float dsk = (it & 1) ? dsk1 : dsk0;
        const int dlt = s_ - t;
        const float* k1 = Kf + (dlt < 0 ? ((-dlt) * 16 + pp) * 16 : 4096 + (dlt * 16 + pp) * 16) + q0;
        const float4 a0 = *(const float4*)k1, a1 = *(const float4*)(k1 + 4);
        float v[8] = {a0.x, a0.y, a0.z, a0.w, a1.x, a1.y, a1.z, a1.w};
        if (dlt == 0) {
            const float4 b0 = *(const float4*)(Kf + pp * 16 + q0), b1 = *(const float4*)(Kf + pp * 16 + q0 + 4);
            const float bb[8] = {b0.x, b0.y, b0.z, b0.w, b1.x, b1.y, b1.z, b1.w};
#pragma unroll
            for (int i = 0; i < 8; ++i) v[i] += bb[i] + ((pp == q0 + i) ? dsk : 0.f);
        }
        *(uint4*)(tabY + (size_t)m * 512 + s_ * 16 + q0) = make_uint4(pack2(v[0], v[1]), pack2(v[2], v[3]), pack2(v[4], v[5]), pack2(v[6], v[7]));
    }
    __syncthreads();
}

#define N_CONV 6896
__device__ __forceinline__ ConvD conv_decode(const Params& p, int t) {
    ConvD d; d.mode = 0; d.zr = 0; d.kmaj = 0;
    if (t < 320) { d.src = p.w_in; d.ld = 1280; d.k0 = (t / 20) * 64; d.n0 = (t % 20) * 64; d.dst = WSP_WinT; d.ldd = 1024; d.kmaj = 1280; return d; }
    t -= 320;
    if (t < 64) { d.src = p.w_glu; d.ld = 512; d.k0 = (t / 8) * 64; d.n0 = (t % 8) * 64; d.dst = WSP_WgluT; d.ldd = 512; return d; }
    t -= 64;
    if (t < 256) { d.src = p.w_out; d.ld = 1024; d.k0 = (t / 16) * 64; d.n0 = (t % 16) * 64; d.dst = WSP_WoutT; d.ldd = 1024; d.zr = 2; d.kmaj = 1024; return d; }
    t -= 256;
    if (t < 16) { d.src = p.w_router; d.ld = 64; d.k0 = t * 64; d.n0 = 0; d.dst = WSP_WrT; d.ldd = 1024; d.zr = 1; return d; }
    t -= 16;
    if (t < 4096) {
        const int up = t >= 2048; const int tt = t & 2047, e = tt >> 5, r = tt & 31;
        d.src = (up ? p.w_up_e : p.w_gate_e) + (size_t)e * 131072; d.ld = 128; d.k0 = (r >> 1) * 64; d.n0 = (r & 1) * 64;
        d.dst = WSP_WguT + (size_t)e * 262144; d.ldd = 1024; d.mode = 1 + up; d.kmaj = 256; return d;
    }
    t -= 4096;
    if (t < 64) {
        const int up = t >= 32; const int r = t & 31;
        d.src = up ? p.w_up_s : p.w_gate_s; d.ld = 128; d.k0 = (r >> 1) * 64; d.n0 = (r & 1) * 64;
        d.dst = WSP_WguT + (size_t)64 * 262144; d.ldd = 1024; d.mode = 1 + up; d.kmaj = 256; return d;
    }
    t -= 64;
    if (t < 2048) { const int e = t >> 5, r = t & 31; d.src = p.w_down_e + (size_t)e * 131072; d.ld = 1024; d.k0 = (r >> 4) * 64; d.n0 = (r & 15) * 64; d.dst = WSP_WdT + (size_t)e * 131072; d.ldd = 128; d.mode = 4; d.kmaj = 1024; return d; }
    t -= 2048;
    d.src = p.w_down_s; d.ld = 1024; d.k0 = (t >> 4) * 64; d.n0 = (t & 15) * 64; d.dst = WSP_WdT + (size_t)64 * 131072; d.ldd = 128; d.mode = 4; d.kmaj = 1024; return d;
}

__device__ __forceinline__ void conv_load_t(const Params& p, int t, float (&v)[16]) { const ConvD d = conv_decode(p, t); conv_load(p, d, v); }
__device__ __forceinline__ void conv_store_t(const Params& p, int t, const float (&v)[16]) { const ConvD d = conv_decode(p, t); conv_store(p, d, v); }
__device__ __forceinline__ void conv_range(const Params& p, int t0, int stride, int tend, int tbeg = 0) {
    int t = tbeg + t0;
    float vA[16], vB[16];
    if (t < tend) conv_load_t(p, t, vA);
    while (t < tend) {
        if (t + stride < tend) conv_load_t(p, t + stride, vB);
        conv_store_t(p, t, vA);
        if (t + 2 * stride < tend) conv_load_t(p, t + 2 * stride, vA);
        if (t + stride < tend) conv_store_t(p, t + stride, vB);
        t += 2 * stride;
    }
}
#define N_CONV_PLAIN0 656
__device__ __forceinline__ void conv_decode_plain(const Params& p, int t, const float*& src, u16*& dst, int& ld, int& k0, int& n0, int& mode, int& kmaj) {
    t -= N_CONV_PLAIN0;
    if (t < 4096 + 64) {
        const bool shared = t >= 4096;
        const int ts = shared ? t - 4096 : t;
        const int up = shared ? (ts >= 32) : (ts >= 2048);
        const int e = shared ? 64 : ((ts & 2047) >> 5), r = ts & 31;
        const float* base = shared ? (up ? p.w_up_s : p.w_gate_s) : (up ? p.w_up_e : p.w_gate_e) + (size_t)e * 131072;
        src = base; ld = 128; k0 = (r >> 1) * 64; n0 = (r & 1) * 64;
        dst = WSP_WguT + (size_t)e * 262144; mode = 1 + up; kmaj = 256;
    } else {
        t -= 4096 + 64;
        const bool shared = t >= 2048;
        const int e = shared ? 64 : (t >> 5), r = shared ? t - 2048 : (t & 31);
        src = shared ? p.w_down_s : p.w_down_e + (size_t)e * 131072; ld = 1024; k0 = (r >> 4) * 64; n0 = (r & 15) * 64;
        dst = WSP_WdT + (size_t)e * 131072; mode = 4; kmaj = 1024;
    }
}
__device__ __forceinline__ void conv_range_dma(const Params& p, int t0, int stride, int tend, int tbeg) {
    const int tid = TIDX, lane = tid & 63, wid = tid >> 6;
    const int first = tbeg + t0;
    if (first >= tend) return;
    const int cnt = (tend - first + stride - 1) / stride;
    __syncthreads();
    auto issue = [&](int j) {
        const float* dsrc; u16* ddst; int ld, k0, n0, mode, kmaj;
        conv_decode_plain(p, first + j * stride, dsrc, ddst, ld, k0, n0, mode, kmaj);
        char* slot = smem + (j & 3) * 16384;
        const float* src = dsrc + (size_t)(k0 + wid * 4 + (lane >> 4)) * ld + n0 + (lane & 15) * 4;
#pragma unroll
        for (int i = 0; i < 4; ++i) glds16(src + (size_t)i * 16 * ld, slot + i * 4096 + wid * 1024 + lane * 16);
    };
    issue(0);
    if (cnt > 1) issue(1);
    if (cnt > 2) issue(2);
    for (int j = 0; j < cnt; ++j) {
        if (j + 2 < cnt) asm volatile("s_waitcnt vmcnt(8)\n\ts_barrier" ::: "memory");
        else if (j + 1 < cnt) asm volatile("s_waitcnt vmcnt(4)\n\ts_barrier" ::: "memory");
        else asm volatile("s_waitcnt vmcnt(0)\n\ts_barrier" ::: "memory");
        if (j + 3 < cnt) issue(j + 3);
        const float* dsrc; u16* ddst; int ld, k0, n0, mode, kmaj;
        conv_decode_plain(p, first + j * stride, dsrc, ddst, ld, k0, n0, mode, kmaj);
        const float* t = (const float*)(smem + (j & 3) * 16384);
        const int n = tid >> 2, kq = tid & 3;
        unsigned w[8];
#pragma unroll
        for (int i = 0; i < 8; ++i) w[i] = pack2(t[(kq * 16 + 2 * i) * 64 + n], t[(kq * 16 + 2 * i + 1) * 64 + n]);
        const int gn = n0 + n;
        int row = (gn & ~255) | (gn & 128) | ((gn & 7) << 4) | ((gn >> 3) & 15);
        if (mode != 4) row = (gn >> 6) * 128 + (gn & 3) * 32 + (mode - 1) * 16 + ((gn & 63) >> 2);
        const int k = k0 + kq * 16;
        uint4* o = (uint4*)(ddst + ((size_t)(k >> 5) * kmaj + row) * 32 + (k & 31));
        o[0] = make_uint4(w[0], w[1], w[2], w[3]);
        o[1] = make_uint4(w[4], w[5], w[6], w[7]);
    }
    __syncthreads();
}
#define N_CONV_P0A 1146
#define N_CONV_P0 1146
#define N_CONV_P2 2906
#define P2_NU (128 * 10 + 16 * 6)
__device__ __forceinline__ int conv_p4_begin() { return ((P2_NU % (int)gridDim.x) != 0) ? N_CONV_P2 : N_CONV_P0; }
__device__ __forceinline__ void phase0(const Params& p) {
    const int b = blockIdx.x, G = gridDim.x;
    if (G > 321 + 32) {
        if (b < 128) ssm_table_item(p, b >> 2, (b >> 1) & 1, b & 1);
        else if (b < 320) { ada_item(p, b - 128); conv_range_dma(p, b - 128, 192, N_CONV_P0, N_CONV_P0A); }
        else if (b == 320) rope_item(p);
        else { conv_range(p, b - 321, G - 321, N_CONV_PLAIN0); conv_range_dma(p, b - 321, G - 321, N_CONV_P0A, N_CONV_PLAIN0); }
    } else {
        const int NU = 321 + N_CONV_P0;
        for (int u = b; u < NU; u += G) {
            if (u < 128) ssm_table_item(p, u >> 2, (u >> 1) & 1, u & 1);
            else if (u < 320) ada_item(p, u - 128);
            else if (u == 320) rope_item(p);
            else { ConvD d = conv_decode(p, u - 321); float v[16]; conv_load(p, d, v); conv_store(p, d, v); }
        }
    }
}

__device__ __forceinline__ void norm_mod_row(const float* src, const float* gain, const float* sh, const float* scl, u16* dst) {
    const int lane = TIDX & 63;
    float4 v[4];
    float ss = 0.f;
#pragma unroll
    for (int i = 0; i < 4; ++i) {
        v[i] = *(const float4*)(src + i * 256 + lane * 4);
        ss += v[i].x * v[i].x + v[i].y * v[i].y + v[i].z * v[i].z + v[i].w * v[i].w;
    }
    ss = wave_sum(ss);
    const float rs = rsqrtf(ss * (1.f / 1024.f) + EPS);
#pragma unroll
    for (int i = 0; i < 4; ++i) {
        const int c0 = i * 256 + lane * 4;
        const float4 g = *(const float4*)(gain + c0), s = *(const float4*)(sh + c0), k = *(const float4*)(scl + c0);
        const float a = v[i].x * rs * g.x * (1.f + k.x) + s.x, b = v[i].y * rs * g.y * (1.f + k.y) + s.y;
        const float c = v[i].z * rs * g.z * (1.f + k.z) + s.z, d = v[i].w * rs * g.w * (1.f + k.w) + s.w;
        *(uint2*)(dst + c0) = make_uint2(pack2(a, b), pack2(c, d));
    }
}

__device__ __forceinline__ void phase1(const Params& p) {
    const int wv = blockIdx.x * 4 + (TIDX >> 6), nwv = gridDim.x * 4;
    const int lane = TIDX & 63;
    for (int r0 = wv * 4; r0 < NROWS; r0 += nwv * 4) {
        const float* src[4]; const float* md[4];
        float4 v[4][4];
#pragma unroll
        for (int q = 0; q < 4; ++q) {
            const int r = r0 + q;
            if (r < NLAT) { src[q] = p.x + (size_t)r * 1024; md[q] = WSP_mod + (r >> 11) * 6144; }
            else { src[q] = p.ctx + (size_t)(r - NLAT) * 1024; md[q] = WSP_mod + 8 * 6144; }
#pragma unroll
            for (int i = 0; i < 4; ++i) v[q][i] = *(const float4*)(src[q] + i * 256 + lane * 4);
        }
#pragma unroll
        for (int q = 0; q < 4; ++q) {
            float ss = 0.f;
#pragma unroll
            for (int i = 0; i < 4; ++i) ss += v[q][i].x * v[q][i].x + v[q][i].y * v[q][i].y + v[q][i].z * v[q][i].z + v[q][i].w * v[q][i].w;
            ss = wave_sum(ss);
            const float rs = rsqrtf(ss * (1.f / 1024.f) + EPS);
            const int hr = r0 + q;
#pragma unroll
            for (int i = 0; i < 4; ++i) {
                const int c0 = i * 256 + lane * 4;
                const float4 g = *(const float4*)(p.norm_mix + c0), s = *(const float4*)(md[q] + c0), k = *(const float4*)(md[q] + 1024 + c0);
                const float a = v[q][i].x * rs * g.x * (1.f + k.x) + s.x, b = v[q][i].y * rs * g.y * (1.f + k.y) + s.y;
                const float c = v[q][i].z * rs * g.z * (1.f + k.z) + s.z, d = v[q][i].w * rs * g.w * (1.f + k.w) + s.w;
                *(uint2*)(WSP_Hb + ((size_t)(hr >> 4) * 32 + (c0 >> 5)) * 512 + (hr & 15) * 32 + (c0 & 31)) = make_uint2(pack2(a, b), pack2(c, d));
            }
        }
    }
}

__device__ __forceinline__ size_t g16_512(int row, int k) { return ((size_t)(row >> 4) * 16 + (k >> 5)) * 512 + (row & 15) * 32 + (k & 31); }

__device__ __forceinline__ void phase2(const Params& p) {
    const int NU = P2_NU;
    const int lane = TIDX & 63, wid = TIDX >> 6, wr = wid >> 1, wc = wid & 1, fr = lane & 15, fq = lane >> 4;
    for (int u = blockIdx.x; u < NU; u += gridDim.x) {
        int mt, nt;
        {
            const int xc = u & 7, r = u >> 3;
            if (r < 160) { mt = xc + 8 * (r / 10); nt = r % 10; } else { const int v = r - 160; mt = 128 + xc + 8 * (v / 6); nt = 4 + v % 6; }
        }
        const u16* A = WSP_Hb + (size_t)mt * 128 * 1024;
        const u16* B = WSP_WinT + (size_t)nt * 128 * 32;
        f32x4 acc[4][4];
        gemm_tile_n(32,
            [&](int R, int C, int kt) { return (const void*)(A + ((size_t)(R >> 4) * 32 + kt) * 512 + (R & 15) * 32 + C); },
            [&](int R, int C, int kt) { return (const void*)(B + ((size_t)kt * 1280 + R) * 32 + C); }, acc);
        const int row0 = mt * 128 + wr * 64;
        const int col0 = nt * 128 + wc * 64;
        const bool is_lat = mt < 128;
        if (nt == 5) {
            const int kvh = wc;
#pragma unroll
            for (int m = 0; m < 4; ++m) {
                const int r = row0 + m * 16 + fq * 4;
                int b, pos;
                if (is_lat) { b = r >> 11; pos = r & 2047; } else { const int rc = r - NLAT; b = rc >> 8; pos = SEQ + (rc & 255); }
#pragma unroll
                for (int n = 0; n < 4; ++n) {
                    const int d = n * 16 + fr;
                    u16* dst = WSP_Vt + ((size_t)(b * 2 + kvh) * 64 + d) * VT_LD + pos;
                    *(uint2*)dst = make_uint2(pack2(acc[m][n][0], acc[m][n][1]), pack2(acc[m][n][2], acc[m][n][3]));
                }
            }
        } else {
            float v[4][4][4];
            const bool do_rope = is_lat && nt <= 4;
#pragma unroll
            for (int m = 0; m < 4; ++m)
#pragma unroll
                for (int j = 0; j < 4; ++j) {
                    if (do_rope) {
                        const int r = row0 + m * 16 + fq * 4 + j, pos = r & 2047;
                        const float2 cr = WSP_rope[(pos >> 6) * 16 + fr], cc = WSP_rope[(pos & 63) * 16 + fr];
                        const float x1 = acc[m][0][j], x2 = acc[m][1][j], y1 = acc[m][2][j], y2 = acc[m][3][j];
                        v[m][0][j] = x1 * cr.x - x2 * cr.y; v[m][1][j] = x1 * cr.y + x2 * cr.x;
                        v[m][2][j] = y1 * cc.x - y2 * cc.y; v[m][3][j] = y1 * cc.y + y2 * cc.x;
                    } else {
#pragma unroll
                        for (int n = 0; n < 4; ++n) v[m][n][j] = acc[m][n][j];
                    }
                }
            if (nt >= 6) {
                const int g0 = (col0 - 768) >> 4;
                wave_store_bf16_rc(v, [&](int row, int ch) { return WSP_U + ((size_t)(g0 + (ch >> 1)) * NROWS + row0 + row) * 16 + (ch & 1) * 8; });
            } else {
                u16* dbase; int ldd;
                if (nt < 4) { dbase = WSP_Q + (size_t)row0 * 512 + col0; ldd = 512; }
                else { dbase = WSP_Kb + (size_t)row0 * 128 + (col0 - 512); ldd = 128; }
                wave_store_bf16(v, [&](int row) { return dbase + (size_t)row * ldd; });
            }
        }
    }
    {
        const int R = NU % (int)gridDim.x;
        if (conv_p4_begin() == N_CONV_P2 && (int)blockIdx.x >= R) conv_range_dma(p, blockIdx.x - R, gridDim.x - R, N_CONV_P2, N_CONV_P0);
    }
}

__device__ __forceinline__ void attn_unit(const Params& p, int u) {
    const int h = u & 7, qb = (u >> 3) & 15, b = u >> 7, kvh = h >> 2;
    const int tid = TIDX, lane = tid & 63, wid = tid >> 6, fr = lane & 15, fq = lane >> 4;
    const int sb = lane * 16, swz = sb ^ (((sb >> 9) & 1) << 5);
    const int r_in = swz >> 6, c_in = (swz & 63) >> 1;
    const int jstart = qb == 0 ? 2 : 0, jend = qb == 15 ? 4 : 6, nb = jend - jstart, ntile = nb + 4;
    const float SC = 0.125f * 1.4426950408889634f;
    bf16x8 qf[2][2];
    const int qrow0 = b * SEQ + qb * 128 + wid * 32;
#pragma unroll
    for (int qt = 0; qt < 2; ++qt)
#pragma unroll
        for (int ks = 0; ks < 2; ++ks)
            qf[qt][ks] = *(const bf16x8*)(WSP_Q + (size_t)(qrow0 + qt * 16 + fr) * 512 + h * 64 + ks * 32 + fq * 8);
    f32x4 o[4][2];
#pragma unroll
    for (int dt = 0; dt < 4; ++dt)
#pragma unroll
        for (int qt = 0; qt < 2; ++qt) o[dt][qt] = (f32x4){0.f, 0.f, 0.f, 0.f};
    float mrun[2], lrun[2];
    const float sinkv = p.attn_sink[h] * 1.4426950408889634f;
    mrun[0] = mrun[1] = sinkv;
    lrun[0] = lrun[1] = (fq == 0) ? 1.f : 0.f;
    __syncthreads();
    const u16* kp[2]; const u16* vp[2];
    {
        const int ks0 = qb * 128 - 128 + 64 * jstart;
#pragma unroll
        for (int it = 0; it < 2; ++it) {
            const int st = wid + 4 * it, R = (st >> 1) * 16 + r_in, C = (st & 1) * 32 + c_in;
            kp[it] = WSP_Kb + (size_t)(b * SEQ + ks0 + R) * 128 + kvh * 64 + C;
            vp[it] = WSP_Vt + ((size_t)(b * 2 + kvh) * 64 + R) * VT_LD + ks0 + C;
        }
    }
    auto stage = [&](int i, int s) {
        char* sk = smem + s * 16384;
        char* sv = sk + 8192;
#pragma unroll
        for (int it = 0; it < 2; ++it) {
            glds16(kp[it], sk + tid * 16 + it * 4096);
            glds16(vp[it], sv + tid * 16 + it * 4096);
        }
        if (i + 1 == nb) {
            const int ks0 = qb * 128 - 128 + 64 * (jstart + i);
#pragma unroll
            for (int it = 0; it < 2; ++it) {
                kp[it] += (size_t)(NLAT + b * CTXL - (b * SEQ + ks0)) * 128;
                vp[it] += SEQ - ks0;
            }
        } else {
#pragma unroll
            for (int it = 0; it < 2; ++it) { kp[it] += 64 * 128; vp[it] += 64; }
        }
    };
    stage(0, 0);
    for (int i = 0; i < ntile; ++i) {
        asm volatile("s_waitcnt vmcnt(0)" ::: "memory");
        __syncthreads();
        if (i + 1 < ntile) stage(i + 1, (i + 1) & 1);
        const char* sk = smem + (i & 1) * 16384;
        const char* sv = sk + 8192;
        f32x4 s[4][2];
#pragma unroll
        for (int kt = 0; kt < 4; ++kt)
#pragma unroll
            for (int qt = 0; qt < 2; ++qt) s[kt][qt] = (f32x4){0.f, 0.f, 0.f, 0.f};
#pragma unroll
        for (int ks = 0; ks < 2; ++ks)
#pragma unroll
            for (int kt = 0; kt < 4; ++kt) {
                const bf16x8 kf = *(const bf16x8*)(sk + lds_byte(32 * (kt >> 1) + 8 * (fr >> 2) + 4 * (kt & 1) + (fr & 3), ks * 32 + fq * 8));
#pragma unroll
                for (int qt = 0; qt < 2; ++qt) s[kt][qt] = __builtin_amdgcn_mfma_f32_16x16x32_bf16(kf, qf[qt][ks], s[kt][qt], 0, 0, 0);
            }
        const int ks0 = qb * 128 - 128 + 64 * (jstart + i);
        const int qlo = qb * 128 + wid * 32;
        const bool band = (i < nb) && ((qlo + 31 - ks0 > 128) || (ks0 + 63 - qlo > 128));
        bf16x8 pf[2][2];
#pragma unroll
        for (int qt = 0; qt < 2; ++qt) {
            const int qp = qb * 128 + wid * 32 + qt * 16 + fr;
            float mx = -1e30f;
            if (band) {
#pragma unroll
                for (int kt = 0; kt < 4; ++kt)
#pragma unroll
                    for (int j = 0; j < 4; ++j) {
                        const int kp = ks0 + 32 * (kt >> 1) + 8 * fq + 4 * (kt & 1) + j, d = qp - kp;
                        const float v = (d > 128 || d < -128) ? -1e30f : s[kt][qt][j];
                        s[kt][qt][j] = v;
                        mx = fmaxf(mx, v);
                    }
                asm volatile("" ::: "memory");
            } else {
#pragma unroll
                for (int kt = 0; kt < 4; ++kt)
#pragma unroll
                    for (int j = 0; j < 4; ++j) mx = fmaxf(mx, s[kt][qt][j]);
            }
            mx = max_x32(max_x16(mx));
            const float mnew = fmaxf(mrun[qt], mx * SC);
            const float alpha = __builtin_amdgcn_exp2f(mrun[qt] - mnew);
            mrun[qt] = mnew;
            float ls = 0.f;
#pragma unroll
            for (int kt = 0; kt < 4; ++kt)
#pragma unroll
                for (int j = 0; j < 4; ++j) {
                    const float pv = __builtin_amdgcn_exp2f(fmaf(s[kt][qt][j], SC, -mnew));
                    s[kt][qt][j] = pv;
                    ls += pv;
                }
            lrun[qt] = lrun[qt] * alpha + ls;
            if (!__all(alpha == 1.f)) {
#pragma unroll
                for (int dt = 0; dt < 4; ++dt) o[dt][qt] *= alpha;
            }
#pragma unroll
            for (int k2 = 0; k2 < 2; ++k2) {
                bf16x8 t;
#pragma unroll
                for (int j = 0; j < 4; ++j) { t[j] = (short)f2bf(s[2 * k2][qt][j]); t[4 + j] = (short)f2bf(s[2 * k2 + 1][qt][j]); }
                pf[qt][k2] = t;
            }
        }
#pragma unroll
        for (int k2 = 0; k2 < 2; ++k2)
#pragma unroll
            for (int dt = 0; dt < 4; ++dt) {
                const bf16x8 vf = *(const bf16x8*)(sv + lds_byte(dt * 16 + fr, k2 * 32 + fq * 8));
#pragma unroll
                for (int qt = 0; qt < 2; ++qt) o[dt][qt] = __builtin_amdgcn_mfma_f32_16x16x32_bf16(vf, pf[qt][k2], o[dt][qt], 0, 0, 0);
            }
    }
#pragma unroll
    for (int qt = 0; qt < 2; ++qt) {
        const float l = sum_x32(sum_x16(lrun[qt]));
        const float inv = 1.f / l;
        const int arow = qrow0 + qt * 16 + fr;
        float sq = 0.f;
#pragma unroll
        for (int dt = 0; dt < 4; ++dt) {
            const unsigned w0 = pack2(o[dt][qt][0] * inv, o[dt][qt][1] * inv), w1 = pack2(o[dt][qt][2] * inv, o[dt][qt][3] * inv);
            *(uint2*)(WSP_AO + g16_512(arow, h * 64 + dt * 16 + fq * 4)) = make_uint2(w0, w1);
            const float a = bf2f((u16)(w0 & 0xffffu)), b = bf2f((u16)(w0 >> 16)), c = bf2f((u16)(w1 & 0xffffu)), d = bf2f((u16)(w1 >> 16));
            sq += a * a + b * b + c * c + d * d;
        }
        sq = sum_x32(sum_x16(sq));
        if (fq == 0) WSP_rsqp[(size_t)(qrow0 + qt * 16 + fr) * 16 + h] = sq;
    }
}

__device__ __forceinline__ void ssm_s1_unit(const Params& p, int u) {
    const int ct = u % 9, mh = (u / 9) & 1, g = u / 18;
    const int lane = TIDX & 63, wid = TIDX >> 6, wr = wid >> 1, wc = wid & 1, fr = lane & 15, fq = lane >> 4;
    const u16* A = WSP_TabS + ((size_t)g * 256 + mh * 128) * 256;
    const u16* Ub = WSP_U + ((size_t)g * NROWS + ct * 2048) * 16;
    f32x4 acc[4][4];
    gemm_tile(4,
        [&](int R, int C, int kt) { return (const void*)(A + (size_t)R * 256 + kt * 64 + C); },
        [&](int R, int C, int kt) { return (const void*)(Ub + (size_t)(R * 16 + kt * 4) * 16 + C); }, acc);
#pragma unroll
    for (int m = 0; m < 4; ++m)
#pragma unroll
        for (int n = 0; n < 4; ++n) {
            const int rho = mh * 128 + wr * 64 + m * 16 + fq * 4;
            const int cg = ct * 128 + wc * 64 + n * 16 + fr;
            *(f32x4*)(WSP_S + ((size_t)cg * 32 + g) * 256 + rho) = acc[m][n];
        }
}

__device__ __forceinline__ void phase3(const Params& p) {
    for (int u = blockIdx.x; u < 1024; u += gridDim.x) attn_unit(p, u);
    int* qv = (int*)(smem + 73728);
    for (;;) {
        __syncthreads();
        if (TIDX == 0) qv[0] = (int)atomicAdd(&WSP_ctr[CTR_QS1], 1u);
        __syncthreads();
        const int u = __builtin_amdgcn_readfirstlane(qv[0]);
        if (u >= 576) break;
        ssm_s1_unit(p, u);
    }
}

__device__ __forceinline__ void phase4(const Params& p) {
    if ((int)gridDim.x > 192) {
        if ((int)blockIdx.x >= 160) { conv_range_dma(p, blockIdx.x - 160, gridDim.x - 160, N_CONV, conv_p4_begin()); return; }
        if ((int)blockIdx.x >= 128) { ssm_toeplitz_item(p, blockIdx.x - 128); return; }
    } else {
        for (int g = blockIdx.x; g < 32; g += gridDim.x) ssm_toeplitz_item(p, g);
        conv_range_dma(p, blockIdx.x, gridDim.x, N_CONV, conv_p4_begin());
    }
    const int gid = blockIdx.x * NTHR + TIDX;
    if (gid >= BATCH * 2 * 32 * 64) return;
    const int n = gid & 63, g = (gid >> 6) & 31, dir = (gid >> 11) & 1, b = gid >> 12;
    const int pidx = dir * 32 + g;
    const float dt = __expf(p.log_dt[pidx]);
    const float are = p.a_re[pidx * 64 + n], aim = p.a_im[pidx * 64 + n];
    const float mag = __expf(16.f * dt * are);
    float rev = 16.f * (dt * aim * 0.15915494309189535f);
    rev -= rintf(rev);
    const float ar = mag * __builtin_amdgcn_cosf(rev), ai = mag * __builtin_amdgcn_sinf(rev);
    float hr = 0.f, hi = 0.f;
    const size_t so = (size_t)g * 256 + dir * 128 + n;
    {
        float sr[16], si[16];
#pragma unroll
        for (int i = 0; i < 16; ++i) {
            const int c = dir == 0 ? i : 15 - i;
            const float* sp = WSP_S + (size_t)(NCHUNK_LAT + b * 16 + c) * 8192 + so;
            sr[i] = sp[0]; si[i] = sp[64];
        }
#pragma unroll
        for (int i = 0; i < 16; ++i) {
            const float nr = ar * hr - ai * hi + sr[i], ni = ar * hi + ai * hr + si[i];
            hr = nr; hi = ni;
        }
    }
#pragma unroll 1
    for (int i0 = 0; i0 < 128; i0 += 32) {
        float sr[32], si[32];
#pragma unroll
        for (int j = 0; j < 32; ++j) {
            const int c = dir == 0 ? i0 + j : 127 - i0 - j;
            const float* sp = WSP_S + ((size_t)b * 128 + c) * 8192 + so;
            sr[j] = sp[0]; si[j] = sp[64];
        }
#pragma unroll
        for (int j = 0; j < 32; ++j) {
            const int c = dir == 0 ? i0 + j : 127 - i0 - j;
            u16* hp = WSP_Hin + ((size_t)b * 128 + c) * 8192 + so;
            hp[0] = f2bf(hr); hp[64] = f2bf(hi);
            const float nr = ar * hr - ai * hi + sr[j], ni = ar * hi + ai * hr + si[j];
            hr = nr; hi = ni;
        }
    }
}

__device__ __forceinline__ void phase5(const Params& p) {
    const int NU = 512;
    const int lane = TIDX & 63, wid = TIDX >> 6, wr = wid >> 1, wc = wid & 1, fr = lane & 15, fq = lane >> 4;
    for (int u = blockIdx.x; u < NU; u += gridDim.x) {
        const int ct = u & 7, mh = (u >> 8) & 1, g = (u >> 3) & 31;
        const u16* A = WSP_TabY + ((size_t)g * 256 + mh * 128) * 512;
        const u16* Ub = WSP_U + ((size_t)g * NROWS + ct * 2048) * 16;
        const u16* Hb_ = WSP_Hin + (size_t)ct * 128 * 8192 + g * 256;
        f32x4 acc[4][4];
        gemm_tile(8,
            [&](int R, int C, int kt) { return (const void*)(A + (size_t)R * 512 + kt * 64 + C); },
            [&](int R, int C, int kt) {
                return kt < 4 ? (const void*)(Ub + (size_t)(R * 16 + kt * 4) * 16 + C)
                              : (const void*)(Hb_ + (size_t)R * 8192 + (kt - 4) * 64 + C);
            }, acc);
#pragma unroll
        for (int m = 0; m < 4; ++m)
#pragma unroll
            for (int n = 0; n < 4; ++n) {
                const int t = mh * 8 + wr * 4 + m;
                const int cg = ct * 128 + wc * 64 + n * 16 + fr;
                u16* dst = WSP_Y + ((size_t)cg * 16 + t) * 512 + g * 16 + fq * 4;
                *(uint2*)dst = make_uint2(pack2(gelu_tanh(acc[m][n][0]), gelu_tanh(acc[m][n][1])),
                                          pack2(gelu_tanh(acc[m][n][2]), gelu_tanh(acc[m][n][3])));
            }
    }
}

__device__ __forceinline__ void phase6(const Params& p) {
    const int NU = 512;
    const int lane = TIDX & 63, wid = TIDX >> 6, wr = wid >> 1, wc = wid & 1, fr = lane & 15, fq = lane >> 4;
    for (int u = blockIdx.x; u < NU; u += gridDim.x) {
        const int mt = (u & 7) + 8 * (u >> 5), nt = (u >> 3) & 3;
        const u16* A = WSP_Y + (size_t)mt * 128 * 512;
        const u16* B = WSP_WgluT + (size_t)nt * 128 * 512;
        f32x4 acc[4][4];
        gemm_tile(8,
            [&](int R, int C, int kt) { return (const void*)(A + (size_t)R * 512 + kt * 64 + C); },
            [&](int R, int C, int kt) { return (const void*)(B + (size_t)R * 512 + kt * 64 + C); }, acc);
        const int row0 = mt * 128 + wr * 64, col0 = nt * 128 + wc * 64;
        char* base = smem + wid * 9216;
        float bg[4];
#pragma unroll
        for (int n = 0; n < 4; ++n) bg[n] = p.b_glu[col0 + n * 16 + fr];
#pragma unroll
        for (int i = 0; i < 8; ++i) {
            const int id = i * 64 + lane, row = id >> 3, ch = id & 7;
            *(uint4*)(base + row * 144 + ch * 16) = *(const uint4*)(WSP_Y + (size_t)(row0 + row) * 512 + col0 + ch * 8);
        }
        asm volatile("s_waitcnt lgkmcnt(0)" ::: "memory");
        __builtin_amdgcn_wave_barrier();
#pragma unroll
        for (int m = 0; m < 4; ++m)
#pragma unroll
            for (int j = 0; j < 4; ++j) {
                const int rl = m * 16 + fq * 4 + j, r = row0 + rl;
                float sq = 0.f;
#pragma unroll
                for (int n = 0; n < 4; ++n) {
                    const int c = col0 + n * 16 + fr;
                    const float yv = bf2f(*(const u16*)(base + rl * 144 + (n * 16 + fr) * 2));
                    const u16 ob = f2bf(yv * sigmoidf_(acc[m][n][j] + bg[n]));
                    *(u16*)(base + rl * 144 + (n * 16 + fr) * 2) = ob;
                    const float of = bf2f(ob);
                    sq += of * of;
                }
                sq = sum16(sq);
                if (fr == 0) WSP_rsqp[(size_t)r * 16 + 8 + nt * 2 + wc] = sq;
            }
        asm volatile("s_waitcnt lgkmcnt(0)" ::: "memory");
        __builtin_amdgcn_wave_barrier();
#pragma unroll
        for (int i = 0; i < 8; ++i) {
            const int id = i * 64 + lane, row = id >> 3, ch = id & 7;
            *(uint4*)(WSP_SO + g16_512(row0 + row, col0 + ch * 8)) = *(const uint4*)(base + row * 144 + ch * 16);
        }
        asm volatile("s_waitcnt lgkmcnt(0)" ::: "memory");
        __builtin_amdgcn_wave_barrier();
    }
}

__device__ __forceinline__ void phase8(const Params& p) {
    const int NU = 512;
    for (int u = blockIdx.x; u < NU; u += gridDim.x) {
        const int mt = (u & 7) + 8 * (u >> 5), nt = (u >> 3) & 3;
        const u16* A1 = WSP_AO + (size_t)mt * 128 * 512;
        const u16* A2 = WSP_SO + (size_t)mt * 128 * 512;
        const u16* B = WSP_WoutT + (size_t)nt * 256 * 32;
        f32x4 acc[4][8];
        float* t_r = (float*)(smem + 73728);
        {
        const int tid1 = TIDX, fq = (tid1 & 63) >> 4, rloc0 = (tid1 >> 7) * 64;
        __syncthreads();
        if (tid1 < 128) {
            const float4* pp = (const float4*)(WSP_rsqp + (size_t)(mt * 128 + tid1) * 16);
            const float4 a0 = pp[0], a1 = pp[1], s0 = pp[2], s1 = pp[3];
            t_r[tid1 * 2] = ((a0.x + a0.y) + (a0.z + a0.w)) + ((a1.x + a1.y) + (a1.z + a1.w));
            t_r[tid1 * 2 + 1] = ((s0.x + s0.y) + (s0.z + s0.w)) + ((s1.x + s1.y) + (s1.z + s1.w));
        }
        gemm_tile_w(32,
            [&](int i, int R, int C, int kt) { return (const void*)((kt < 16 ? A1 : A2) + ((size_t)(R >> 4) * 16 + (kt & 15)) * 512 + (R & 15) * 32 + C); },
            [&](int i, int R, int C, int kt) { return (const void*)(B + ((size_t)kt * 1024 + R) * 32 + C); }, acc,
            [&](int kt) {
                if (kt == 16) {
#pragma unroll
                    for (int m = 0; m < 4; ++m) {
                        asm volatile("" ::: "memory");
#pragma unroll
                        for (int j = 0; j < 4; ++j) {
                            const float2 q = *(const float2*)(t_r + (rloc0 + m * 16 + fq * 4 + j) * 2);
                            const float ratio = rsqrtf(q.x * (1.f / 512.f) + EPS) / rsqrtf(q.y * (1.f / 512.f) + EPS);
#pragma unroll
                            for (int n = 0; n < 8; ++n) acc[m][n][j] *= ratio;
                        }
                    }
                }
            });
        }
        const int tid2 = TIDX, lane = tid2 & 63, wid = tid2 >> 6, fr = lane & 15, fq = lane >> 4;
        const int row0 = mt * 128 + (wid >> 1) * 64, col0 = nt * 256 + (wid & 1) * 128;
        const float* g1 = WSP_mod + (mt >> 4) * 6144 + 2048 + col0;
        float* stg = (float*)(smem + wid * 8448);
        const int c4 = (lane & 31) * 4, rl = lane >> 5;
        const float4 g = *(const float4*)(g1 + c4);
        float4 xq[2][8];
        float rq[2][8];
#pragma unroll
        for (int i = 0; i < 8; ++i) {
            const int r = row0 + i * 2 + rl;
            xq[0][i] = *(const float4*)(p.x + (size_t)r * 1024 + col0 + c4);
            rq[0][i] = t_r[((wid >> 1) * 64 + i * 2 + rl) * 2 + 1];
        }
#pragma unroll
        for (int m = 0; m < 4; ++m) {
#pragma unroll
            for (int n = 0; n < 8; ++n)
#pragma unroll
                for (int j = 0; j < 4; ++j) stg[(fq * 4 + j) * 132 + n * 16 + fr] = acc[m][n][j];
            asm volatile("s_waitcnt lgkmcnt(0)" ::: "memory");
            __builtin_amdgcn_wave_barrier();
            if (m + 1 < 4) {
#pragma unroll
                for (int i = 0; i < 8; ++i) {
                    const int r = row0 + (m + 1) * 16 + i * 2 + rl;
                    xq[(m + 1) & 1][i] = *(const float4*)(p.x + (size_t)r * 1024 + col0 + c4);
                    rq[(m + 1) & 1][i] = t_r[((wid >> 1) * 64 + (m + 1) * 16 + i * 2 + rl) * 2 + 1];
                }
            }
#pragma unroll
            for (int i = 0; i < 8; ++i) {
                const int rr = i * 2 + rl;
                float4 v = *(const float4*)(stg + rr * 132 + c4);
                const float rsv = rsqrtf(rq[m & 1][i] * (1.f / 512.f) + EPS);
                v.x *= rsv; v.y *= rsv; v.z *= rsv; v.w *= rsv;
                const float4 xv = xq[m & 1][i];
                *(uint2*)(X1B(row0 + m * 16 + rr) + col0 + c4) = make_uint2(pack2(xv.x + g.x * v.x, xv.y + g.y * v.y), pack2(xv.z + g.z * v.z, xv.w + g.w * v.w));
            }
            asm volatile("s_waitcnt lgkmcnt(0)" ::: "memory");
            __builtin_amdgcn_wave_barrier();
        }
    }
}

#define CTR_ECNT 0
#define CTR_Q11 128
#define CTR_Q12 136
#define HALF_TOK 8192
#define HH_SHARED0 66560
#define HH_HALF_ROWS (HH_SHARED0 + 8192)
__device__ __forceinline__ size_t hh_addr(int row, int k) { return ((size_t)(row >> 4) * 4 + (k >> 5)) * 512 + (row & 15) * 32 + (k & 31); }
#define ELIST_CAP 8192
template <int LEVEL>
__device__ __forceinline__ void phase9_t(const Params& p) {
    const int tid = TIDX, lane = tid & 63, wid = tid >> 6, fr = lane & 15, fq = lane >> 4;
    char* At = smem;
    float* sc = (float*)(smem + 65536);
    int* hist = (int*)(smem + 65536 + 8192);
    int* gbase = hist + 64;
    int* fill = gbase + 64;
    unsigned char* selk = (unsigned char*)(fill + 64);
    float* selw = (float*)(selk + 256);
    for (int chunk = blockIdx.x; chunk < NLAT / 32; chunk += gridDim.x) {
        const int tok0 = chunk * 32;
        __syncthreads();
        if (tid < 64) hist[tid] = 0;
        {
            uint4 vall[8][2];
#pragma unroll
            for (int rr = 0; rr < 8; ++rr)
#pragma unroll
                for (int i = 0; i < 2; ++i) vall[rr][i] = *(const uint4*)(X1B(tok0 + wid * 8 + rr) + i * 512 + lane * 8);
            const float* md = WSP_mod + (tok0 >> 11) * 6144;
            float mg[2][8], ms[2][8];
#pragma unroll
            for (int i = 0; i < 2; ++i)
#pragma unroll
                for (int q = 0; q < 2; ++q) {
                    const int c0 = i * 512 + lane * 8 + q * 4;
                    const float4 g = *(const float4*)(p.norm_ffn + c0), sh = *(const float4*)(md + 3072 + c0), k = *(const float4*)(md + 4096 + c0);
                    mg[i][4 * q] = g.x * (1.f + k.x); mg[i][4 * q + 1] = g.y * (1.f + k.y); mg[i][4 * q + 2] = g.z * (1.f + k.z); mg[i][4 * q + 3] = g.w * (1.f + k.w);
                    ms[i][4 * q] = sh.x; ms[i][4 * q + 1] = sh.y; ms[i][4 * q + 2] = sh.z; ms[i][4 * q + 3] = sh.w;
                }
#pragma unroll
            for (int rr = 0; rr < 8; ++rr) {
                const int row = wid * 8 + rr, tok = tok0 + row;
                float xv[2][8];
                float ss = 0.f;
#pragma unroll
                for (int i = 0; i < 2; ++i) {
                    const unsigned w[4] = {vall[rr][i].x, vall[rr][i].y, vall[rr][i].z, vall[rr][i].w};
#pragma unroll
                    for (int q = 0; q < 4; ++q) {
                        xv[i][2 * q] = __uint_as_float(w[q] << 16); xv[i][2 * q + 1] = __uint_as_float(w[q] & 0xffff0000u);
                        ss += xv[i][2 * q] * xv[i][2 * q] + xv[i][2 * q + 1] * xv[i][2 * q + 1];
                    }
                }
                ss = wave_sum(ss);
                const float rs = rsqrtf(ss * (1.f / 1024.f) + EPS);
#pragma unroll
                for (int i = 0; i < 2; ++i) {
                    const int c0 = i * 512 + lane * 8;
                    float o[8];
#pragma unroll
                    for (int q = 0; q < 8; ++q) o[q] = xv[i][q] * rs * mg[i][q] + ms[i][q];
                    const uint4 pk = make_uint4(pack2(o[0], o[1]), pack2(o[2], o[3]), pack2(o[4], o[5]), pack2(o[6], o[7]));
                    *(uint4*)(WSP_H2 + (size_t)tok * 1024 + c0) = pk;
                    const int ch = c0 >> 3;
                    *(uint4*)(At + row * 2048 + ((ch ^ (row & 15)) << 4)) = pk;
                }
            }
        }
        __syncthreads();
        if (LEVEL == 1) continue;
        {
            f32x4 acc0 = {0.f, 0.f, 0.f, 0.f}, acc1 = {0.f, 0.f, 0.f, 0.f};
            const u16* bp = WSP_WrT + (size_t)(wid * 16 + fr) * 1024 + fq * 8;
#pragma unroll
            for (int kb = 0; kb < 4; ++kb) {
                bf16x8 bfr[8];
#pragma unroll
                for (int q = 0; q < 8; ++q) bfr[q] = *(const bf16x8*)(bp + (kb * 8 + q) * 32);
#pragma unroll
                for (int q = 0; q < 8; ++q) {
                    const int ch = (kb * 8 + q) * 4 + fq;
                    const bf16x8 a0 = *(const bf16x8*)(At + fr * 2048 + ((ch ^ fr) << 4));
                    const bf16x8 a1 = *(const bf16x8*)(At + (16 + fr) * 2048 + ((ch ^ fr) << 4));
                    acc0 = __builtin_amdgcn_mfma_f32_16x16x32_bf16(a0, bfr[q], acc0, 0, 0, 0);
                    acc1 = __builtin_amdgcn_mfma_f32_16x16x32_bf16(a1, bfr[q], acc1, 0, 0, 0);
                }
            }
#pragma unroll
            for (int j = 0; j < 4; ++j) {
                sc[(fq * 4 + j) * 64 + wid * 16 + fr] = sigmoidf_(acc0[j]);
                sc[(16 + fq * 4 + j) * 64 + wid * 16 + fr] = sigmoidf_(acc1[j]);
            }
        }
        __syncthreads();
        if (LEVEL == 2) continue;
        const float bias = p.router_bias[lane];
        const int eg = lane >> 3;
#pragma unroll 2
        for (int rr = 0; rr < 8; ++rr) {
            const int row = wid * 8 + rr;
            const float s = sc[row * 64 + lane];
            const float bz = s + bias;
            const float m1 = max8(bz);
            const unsigned long long eq = __ballot(bz == m1);
            const unsigned gb = (unsigned)((eq >> (eg * 8)) & 0xffull);
            const int first = __ffs(gb) - 1;
            const float v2 = max8(((lane & 7) == first) ? -1e30f : bz);
            const float gs = m1 + v2;
            int cnt = 0;
#pragma unroll
            for (int j = 0; j < 8; ++j) {
                const float gj = __int_as_float(__builtin_amdgcn_readlane(__float_as_int(gs), j * 8));
                cnt += (int)(gj > gs) + (int)((gj == gs) & (j < eg));
            }
            const bool gsel = cnt < 4;
            const float mv = gsel ? bz : -1e30f;
            const unsigned ub = __float_as_uint(mv);
            const unsigned long long key = ((unsigned long long)(ub ^ ((unsigned)((int)ub >> 31) | 0x80000000u)) << 6) | (unsigned)(63 - lane);
            unsigned long long* kb = (unsigned long long*)At + row * 64;
            kb[lane] = key;
            unsigned long long gm = __ballot(gsel);
            int rank = 0;
#pragma unroll
            for (int it = 0; it < 4; ++it) {
                const int jb = __builtin_amdgcn_readfirstlane(__ffsll((long long)gm) - 1);
                gm &= ~(0xffull << jb);
#pragma unroll
                for (int j = 0; j < 4; ++j) {
                    const ulonglong2 kk = *(const ulonglong2*)(kb + jb + 2 * j);
                    rank += (int)(kk.x > key) + (int)(kk.y > key);
                }
            }
            const bool sel = gsel && rank < 8;
            const float tot = wave_sum(sel ? s : 0.f);
            if (sel) {
                selw[row * 8 + rank] = s / tot * 2.5f;
                selk[row * 8 + rank] = (unsigned char)lane;
                atomicAdd(&hist[lane], 1);
            }
        }
        __syncthreads();
        const int h = tok0 >> 13;
        if (tid < 64) {
            gbase[tid] = hist[tid] ? (int)atomicAdd(&WSP_ctr[CTR_ECNT + h * 64 + tid], (unsigned)hist[tid]) : 0;
            fill[tid] = 0;
        }
        __syncthreads();
        {
            const int e = selk[tid];
            const int pos = atomicAdd(&fill[e], 1);
            WSP_elist[(size_t)(h * 64 + e) * ELIST_CAP + gbase[e] + pos] = (tok0 + (tid >> 3)) * 8 + (tid & 7);
            WSP_wsl[(size_t)(h * 64 + e) * ELIST_CAP + gbase[e] + pos] = selw[tid];
        }
    }
}

struct MoeTab { int cnt[16]; int soff[16]; int pre[17]; };

template <class FV, class FD>
__device__ __forceinline__ void wave_store_fp8_f(FV val, FD dst) {
    const int lane = TIDX & 63, wid = TIDX >> 6, fr = lane & 15, fq = lane >> 4;
    char* base = smem + wid * 9216;
#pragma unroll
    for (int m = 0; m < 4; ++m)
#pragma unroll
        for (int j = 0; j < 4; ++j) {
            int lo = __builtin_amdgcn_cvt_pk_fp8_f32(val(m, 0, j), val(m, 1, j), 0, false);
            lo = __builtin_amdgcn_cvt_pk_fp8_f32(val(m, 2, j), val(m, 3, j), lo, true);
            int hi = __builtin_amdgcn_cvt_pk_fp8_f32(val(m, 4, j), val(m, 5, j), 0, false);
            hi = __builtin_amdgcn_cvt_pk_fp8_f32(val(m, 6, j), val(m, 7, j), hi, true);
            *(uint2*)(base + (m * 16 + fq * 4 + j) * 144 + fr * 8) = make_uint2((unsigned)lo, (unsigned)hi);
        }
    asm volatile("s_waitcnt lgkmcnt(0)" ::: "memory");
    __builtin_amdgcn_wave_barrier();
#pragma unroll
    for (int i = 0; i < 8; ++i) {
        const int id = i * 64 + lane, row = id >> 3, ch = id & 7;
        const uint4 d = *(const uint4*)(base + row * 144 + ch * 16);
        unsigned char* q = dst(i, row);
        if (q) { const u32x4 t = {d.x, d.y, d.z, d.w}; __builtin_nontemporal_store(t, (u32x4*)(q + ch * 16)); }
    }
    asm volatile("s_waitcnt lgkmcnt(0)" ::: "memory");
    __builtin_amdgcn_wave_barrier();
}

#define YD_SCALE 8.0f
template <int MODE>
__device__ __forceinline__ void phase11f(const Params& p) {
    const int tid = TIDX;
    int* tab = (int*)(smem + 73728);
    int* t_cnt = tab, *t_soff = tab + 16, *t_pre = tab + 32, *t_q = tab + 52;
    int* t_all = tab + 64;
    const int x = blockIdx.x & 7;
    unsigned* flags = WSP_flag + x * FLAG_PER_CLASS;
    unsigned* tmo = WSP_flag + 8 * FLAG_PER_CLASS;
    unsigned char* Yd8 = (unsigned char*)(p.ws + OFF_ARENA);
    __syncthreads();
    if (tid < 128) t_all[tid] = (int)WSP_ctr[CTR_ECNT + tid];
    unsigned* qhead = &WSP_ctr[(MODE == 2 ? CTR_Q12 : CTR_Q11) + x];
    const int nb = ((int)gridDim.x - x + 7) >> 3, kb = blockIdx.x >> 3;
    if (tid == 0) t_q[0] = (nb & 1) ? kb : 2 * (kb % (nb >> 1)) + kb / (nb >> 1);
    __syncthreads();
    if (tid < 16) {
        const int i = tid >> 1, h = tid & 1, e = x + 8 * i;
        t_cnt[tid] = t_all[h * 64 + e];
        int so = 0;
        for (int e2 = 0; e2 < e; ++e2) so += (t_all[h * 64 + e2] + 15) & ~15;
        t_soff[tid] = so;
    }
    __syncthreads();
    if (tid == 0) {
        int s = 0;
        for (int j = 0; j < 16; ++j) { t_pre[j] = s; s += (t_cnt[j] + 127) >> 7; }
        t_pre[16] = s;
    }
    __syncthreads();
    const int T_r = t_pre[16], T11 = T_r + 16, T_all = (MODE == 1) ? T11 : T11 + T_r * 4;
    for (;;) {
        __syncthreads();
        const int q = __builtin_amdgcn_readfirstlane(t_q[0]) + (MODE == 2 ? T11 : 0);
        __syncthreads();
        if (q >= T_all) break;
        if (tid == 0) t_q[0] = nb + (int)atomicAdd(qhead, 1u);
        const bool is_down = q >= T11;
        const int u = is_down ? (q - T11) >> 2 : q;
        int nt = is_down ? (q - T11) & 3 : 0;
        int e, h, mt, c, rowbase;
        if (u < T_r) {
            int j = 0;
#pragma unroll
            for (int qq = 1; qq < 16; ++qq) j += (u >= t_pre[qq]) ? 1 : 0;
            e = x + 8 * (j >> 1); h = j & 1; mt = u - t_pre[j]; c = t_cnt[j];
            rowbase = h * HH_HALF_ROWS + t_soff[j];
        } else {
            const int ms = x * 16 + (u - T_r);
            e = 64; h = ms >> 6; mt = ms & 63; c = HALF_TOK;
            rowbase = h * HH_HALF_ROWS + HH_SHARED0;
        }
        e = __builtin_amdgcn_readfirstlane(e); h = __builtin_amdgcn_readfirstlane(h); mt = __builtin_amdgcn_readfirstlane(mt);
        nt = __builtin_amdgcn_readfirstlane(nt); c = __builtin_amdgcn_readfirstlane(c); rowbase = __builtin_amdgcn_readfirstlane(rowbase);
        const int* el = WSP_elist + (size_t)(h * 64 + (e & 63)) * ELIST_CAP;
        if (!is_down) {
            const int t2 = TIDX, lane = t2 & 63, wid = t2 >> 6, wr = wid >> 1, wc = wid & 1, fr = lane & 15, fq = lane >> 4;
            const int sb = lane * 16, swz = sb ^ (((sb >> 9) & 1) << 5);
            const int r_in = swz >> 6, c_in = (swz & 63) >> 1;
            const int vrows = c - mt * 128 - wr * 64;
            const float* wsl = WSP_wsl + (size_t)(h * 64 + (e & 63)) * ELIST_CAP;
            const u16* aptr[2];
#pragma unroll
            for (int i = 0; i < 2; ++i) {
                int li = mt * 128 + (wid + 4 * i) * 16 + r_in;
                li = li < c ? li : c - 1;
                const int tok = (e < 64) ? (el[li] >> 3) : (h * HALF_TOK + li);
                aptr[i] = WSP_H2 + (size_t)tok * 1024 + c_in;
            }
            const u16* Bw = WSP_WguT + (size_t)e * 262144 + c_in;
            float wpre = 1.f;
            if (e < 64) { const int li = mt * 128 + (t2 & 127); wpre = (li < c && t2 < 128) ? wsl[li < c ? li : c - 1] : 0.f; }
            f32x4 acc[4][8];
            gemm_tile_w(32,
                [&](int i, int R, int C, int kt) { return (const void*)(aptr[i] + kt * 32); },
                [&](int i, int R, int C, int kt) { return (const void*)(Bw + ((size_t)kt * 256 + R) * 32); }, acc);
            float* t_w = (float*)(smem + 40960);
            if (t2 < 128) t_w[t2] = wpre;
            __syncthreads();
            float wgt[4][4];
#pragma unroll
            for (int m = 0; m < 4; ++m) {
                const float4 w4 = *(const float4*)(t_w + wr * 64 + m * 16 + fq * 4);
                wgt[m][0] = w4.x; wgt[m][1] = w4.y; wgt[m][2] = w4.z; wgt[m][3] = w4.w;
            }
            const int hrow0 = rowbase + mt * 128 + wr * 64;
            wave_store_bf16_pk_rc([&](int m, int n2, int j) { return siluf_(acc[m][2 * n2][j]) * acc[m][2 * n2 + 1][j] * wgt[m][j]; },
                                  [&](int row, int ch) { return row < vrows ? WSP_HHs + hh_addr(hrow0 + row, wc * 64 + ch * 8) : (u16*)nullptr; },
                                  (const char*)WSP_HHs, (unsigned)((size_t)2 * HH_HALF_ROWS * 128 * 2));
            asm volatile("s_waitcnt vmcnt(0)" ::: "memory");
            __syncthreads();
            if (tid == 0) __hip_atomic_store(&flags[u], 1u, __ATOMIC_RELAXED, __HIP_MEMORY_SCOPE_AGENT);
        } else {
            const int t2 = TIDX, lane = t2 & 63, wid = t2 >> 6, wr = wid >> 1, wc = wid & 1, fr = lane & 15, fq = lane >> 4;
            const int sb = lane * 16, swz = sb ^ (((sb >> 9) & 1) << 5);
            const int r_in = swz >> 6, c_in = (swz & 63) >> 1;
            const int vrows = c - mt * 128 - wr * 64;
            if (MODE == 0 && tid == 0) {
                unsigned sp = 0;
                while (__hip_atomic_load(&flags[u], __ATOMIC_RELAXED, __HIP_MEMORY_SCOPE_AGENT) == 0u) {
                    __builtin_amdgcn_s_sleep(2);
                    if ((++sp & 255u) == 0u) {
                        if (__hip_atomic_load(tmo, __ATOMIC_RELAXED, __HIP_MEMORY_SCOPE_AGENT)) break;
                        if (sp > (1u << 20)) { atomicAdd(tmo, 1u); break; }
                    }
                }
            }
            __syncthreads();
            const u16* aptr[2];
#pragma unroll
            for (int i = 0; i < 2; ++i) {
                int li = mt * 128 + (wid + 4 * i) * 16 + r_in;
                li = li < c ? li : c - 1;
                aptr[i] = WSP_HHs + hh_addr(rowbase + li, 0) + c_in;
            }
            const u16* Bw = WSP_WdT + (size_t)e * 131072 + (size_t)nt * 256 * 32 + c_in;
            int slot[8];
#pragma unroll
            for (int i = 0; i < 8; ++i) {
                int li = mt * 128 + wr * 64 + ((i * 64 + lane) >> 3);
                li = li < c ? li : c - 1;
                slot[i] = el[li];
            }
            f32x4 acc[4][8];
            gemm_tile_w<true>(4,
                [&](int i, int R, int C, int kt) { return (const void*)(aptr[i] + kt * 512); },
                [&](int i, int R, int C, int kt) { return (const void*)(Bw + ((size_t)kt * 1024 + R) * 32); }, acc);
            const int colo = nt * 256 + wc * 128;
            wave_store_fp8_f([&](int m, int n, int j) { return acc[m][n][j] * YD_SCALE; }, [&](int i, int row) {
                if (row >= vrows) return (unsigned char*)nullptr;
                const int s = slot[i];
                return Yd8 + ((size_t)(s >> 3) * 8 + (s & 7)) * 1024 + colo;
            });
        }
    }
}

#define P12_SLD 2064
template <bool DUMMY>
__device__ __forceinline__ void phase12b_t(const Params& p) {
    const int tid = TIDX, lane = tid & 63, wid = tid >> 6, fr = lane & 15, fq = lane >> 4;
    const unsigned char* Yd8 = (const unsigned char*)(p.ws + OFF_ARENA);
    for (int tile = blockIdx.x; tile < NLAT / 32; tile += gridDim.x) {
        const int tok0 = tile * 32;
        const int hh = tok0 >> 13;
        const int arow = hh * HH_HALF_ROWS + HH_SHARED0 + (tok0 & 8191) + fr;
        __syncthreads();
        u32x4 ya[8], yb[8];
        uint4 xa[2], xb[2];
        auto load_row = [&](int rr, u32x4 (&yv)[8], uint4 (&xv)[2]) {
            const int tok = tok0 + wid * 8 + rr;
            const unsigned char* yp = Yd8 + (size_t)tok * 8 * 1024 + lane * 16;
#pragma unroll
            for (int k = 0; k < 8; ++k) yv[k] = __builtin_nontemporal_load((const u32x4*)(yp + k * 1024));
            const u16* xrow = X1B(tok) + lane * 16;
            xv[0] = *(const uint4*)xrow; xv[1] = *(const uint4*)(xrow + 8);
        };
        load_row(0, ya, xa);
        bf16x8 af[2][4];
#pragma unroll
        for (int m = 0; m < 2; ++m)
#pragma unroll
            for (int ks = 0; ks < 4; ++ks) af[m][ks] = *(const bf16x8*)(WSP_HHs + hh_addr(arow + m * 16, ks * 32 + fq * 8));
#pragma unroll 2
        for (int nb = 0; nb < 4; ++nb) {
            bf16x8 bfr[4][4];
#pragma unroll
            for (int n = 0; n < 4; ++n)
#pragma unroll
                for (int ks = 0; ks < 4; ++ks) {
                    const int w8 = nb * 64 + fr * 4 + n, rw = wid * 256 + ((w8 & 128) | ((w8 & 7) << 4) | ((w8 >> 3) & 15));
                    bfr[n][ks] = *(const bf16x8*)(WSP_WdT + (size_t)64 * 131072 + ((size_t)ks * 1024 + rw) * 32 + fq * 8);
                }
#pragma unroll
            for (int m = 0; m < 2; ++m) {
                f32x4 d[4];
#pragma unroll
                for (int n = 0; n < 4; ++n) {
                    d[n] = (f32x4){0.f, 0.f, 0.f, 0.f};
#pragma unroll
                    for (int ks = 0; ks < 4; ++ks) d[n] = __builtin_amdgcn_mfma_f32_16x16x32_bf16(af[m][ks], bfr[n][ks], d[n], 0, 0, 0);
                }
                const int col = wid * 256 + nb * 64 + fr * 4;
#pragma unroll
                for (int j = 0; j < 4; ++j)
                    *(uint2*)(smem + (m * 16 + fq * 4 + j) * P12_SLD + col * 2) = make_uint2(pack2(d[0][j], d[1][j]), pack2(d[2][j], d[3][j]));
            }
        }
        __syncthreads();
        {
            const float* g2 = WSP_mod + (tok0 >> 11) * 6144 + 5120 + lane * 16;
            float4 gv[4], nf[4];
#pragma unroll
            for (int q = 0; q < 4; ++q) { gv[q] = *(const float4*)(g2 + q * 4); nf[q] = *(const float4*)(p.norm_final + lane * 16 + q * 4); }
            auto do_row = [&](int rr, const u32x4 (&yv)[8], const uint4 (&xv)[2]) {
                const int row = wid * 8 + rr, tok = tok0 + row;
                float* orow = DUMMY ? (float*)(p.ws + OFF_HHS) + (size_t)(tok & 8191) * 1024 + lane * 16 : p.out + (size_t)tok * 1024 + lane * 16;
                float s[16];
#pragma unroll
                for (int i = 0; i < 16; ++i) s[i] = 0.f;
#pragma unroll
                for (int k = 0; k < 8; ++k) {
#pragma unroll
                    for (int i = 0; i < 4; ++i) {
                        const auto lo = __builtin_amdgcn_cvt_pk_f32_fp8((int)yv[k][i], false);
                        const auto hi = __builtin_amdgcn_cvt_pk_f32_fp8((int)yv[k][i], true);
                        s[4 * i] += lo[0]; s[4 * i + 1] += lo[1]; s[4 * i + 2] += hi[0]; s[4 * i + 3] += hi[1];
                    }
                }
                const uint4 sa = *(const uint4*)(smem + row * P12_SLD + lane * 32), sbv = *(const uint4*)(smem + row * P12_SLD + lane * 32 + 16);
                const unsigned sw[8] = {sa.x, sa.y, sa.z, sa.w, sbv.x, sbv.y, sbv.z, sbv.w};
#pragma unroll
                for (int i = 0; i < 8; ++i) {
                    s[2 * i] = s[2 * i] * (1.f / YD_SCALE) + bf2f((u16)(sw[i] & 0xffffu));
                    s[2 * i + 1] = s[2 * i + 1] * (1.f / YD_SCALE) + bf2f((u16)(sw[i] >> 16));
                }
                float ss = 0.f;
                const unsigned xw[8] = {xv[0].x, xv[0].y, xv[0].z, xv[0].w, xv[1].x, xv[1].y, xv[1].z, xv[1].w};
#pragma unroll
                for (int q = 0; q < 4; ++q) {
                    const float4 x4 = make_float4(__uint_as_float(xw[2 * q] << 16), __uint_as_float(xw[2 * q] & 0xffff0000u),
                                                  __uint_as_float(xw[2 * q + 1] << 16), __uint_as_float(xw[2 * q + 1] & 0xffff0000u));
                    s[4 * q] = x4.x + gv[q].x * s[4 * q]; s[4 * q + 1] = x4.y + gv[q].y * s[4 * q + 1];
                    s[4 * q + 2] = x4.z + gv[q].z * s[4 * q + 2]; s[4 * q + 3] = x4.w + gv[q].w * s[4 * q + 3];
                    ss += s[4 * q] * s[4 * q] + s[4 * q + 1] * s[4 * q + 1] + s[4 * q + 2] * s[4 * q + 2] + s[4 * q + 3] * s[4 * q + 3];
                }
                ss = wave_sum(ss);
                const float rs = rsqrtf(ss * (1.f / 1024.f) + EPS);
#pragma unroll
                for (int q = 0; q < 4; ++q)
                    *(float4*)(orow + q * 4) = make_float4(s[4 * q] * rs * nf[q].x, s[4 * q + 1] * rs * nf[q].y, s[4 * q + 2] * rs * nf[q].z, s[4 * q + 3] * rs * nf[q].w);
            };
#pragma unroll 1
            for (int rr = 0; rr < 8; rr += 2) {
                load_row(rr + 1, yb, xb);
                do_row(rr, ya, xa);
                if (rr + 2 < 8) load_row(rr + 2, ya, xa);
                do_row(rr + 1, yb, xb);
            }
        }
    }
}

#define SMEM_TOTAL (73728 + 3072 + 64)

#if 1
__global__ void __launch_bounds__(NTHR, 2) k_mega(Params p) {
    volatile LAS unsigned* st = (volatile LAS unsigned*)(smem + SMEM_TOTAL - 16);
    if (TIDX == 0) { st[0] = 0u; st[1] = 0u; st[2] = 0u; st[3] = 0u; }
    __syncthreads();
    XcdBarrier bar = xcd_barrier_post(WSP_bar, st);
#define RUNP(N) do { phase##N(p); if (PROBE_DUP == N) phase##N(p); } while (0)
    RUNP(0);  xcd_barrier(bar);
    RUNP(1);  xcd_barrier(bar);
    RUNP(2);  xcd_barrier(bar);
    RUNP(3);  xcd_barrier(bar);
    RUNP(4);  xcd_barrier(bar);
    RUNP(5);  xcd_barrier(bar);
    RUNP(6);  xcd_barrier(bar);
    RUNP(8);  xcd_barrier(bar);
#if PROBE_DUP == 91
    phase9_t<1>(p); xcd_barrier(bar);
#endif
#if PROBE_DUP == 92
    phase9_t<2>(p); xcd_barrier(bar);
#endif
    phase9_t<0>(p); xcd_barrier(bar);
#if PROBE_DUP == 9
    if (blockIdx.x == 0 && TIDX < 128) WSP_ctr[CTR_ECNT + TIDX] = 0u;
    xcd_barrier(bar); phase9_t<0>(p); xcd_barrier(bar);
#endif
#ifndef MOE_FUSED
#define MOE_FUSED 1
#endif
#if MOE_FUSED
    phase11f<0>(p); xcd_barrier(bar);
#else
    phase11f<1>(p); xcd_barrier(bar);
    phase11f<2>(p); xcd_barrier(bar);
#endif
#if PROBE_DUP == 11
    if (blockIdx.x == 0 && TIDX < 8) WSP_ctr[CTR_Q11 + TIDX] = 0u;
    if (blockIdx.x == 1) for (int i = TIDX; i < 8 * FLAG_PER_CLASS; i += NTHR) WSP_flag[i] = 0u;
    xcd_barrier(bar); phase11f<0>(p); xcd_barrier(bar);
#endif
#if PROBE_DUP == 121
    phase12b_t<true>(p); xcd_barrier(bar);
#endif
    phase12b_t<false>(p);
}
#endif


extern "C" void kernel_launch(void* const* d_in, const int* in_sizes, int n_in,
                              void* d_out, int out_size, void* d_ws, size_t ws_size,
                              hipStream_t stream) {
    Params p{};
    const float** ip = (const float**)&p.x;
    for (int i = 0; i < 32; ++i) ip[i] = (const float*)d_in[i];
    p.out = (float*)d_out;
    p.ws = (char*)d_ws;
    if (OFF_END > ws_size) { fprintf(stderr, "workspace too small: need %zu have %zu\n", (size_t)OFF_END, ws_size); return; }

    static int grid = 0;
    if (!grid) {
        hipFuncSetAttribute((const void*)k_mega, hipFuncAttributeMaxDynamicSharedMemorySize, SMEM_TOTAL);
        int dev = 0, cus = 0, per_cu = 0;
        hipGetDevice(&dev);
        hipDeviceGetAttribute(&cus, hipDeviceAttributeMultiprocessorCount, dev);
        hipOccupancyMaxActiveBlocksPerMultiprocessor(&per_cu, (const void*)k_mega, NTHR, SMEM_TOTAL);
        if (per_cu < 1) per_cu = 1;
        grid = cus * (per_cu < 2 ? per_cu : 2);
    }
    hipMemsetAsync(p.ws + OFF_BAR, 0, ZERO_BYTES, stream);
    k_mega<<<grid, NTHR, SMEM_TOTAL, stream>>>(p);
}
```
